# Optimizing an MI355X kernel written in HIP

```python
import jax, jax.numpy as jnp
from jax import lax
import numpy as np

D_MODEL = 1024
BATCH = 16
SEQ = 2048
DEPTH = 2

CTX_LEN = 256
GRID_W = 64

MIX_WIDTH = D_MODEL
CONV_CH = MIX_WIDTH // 4
CONV_K = 31
RET_HEADS = 4
RET_QK_DIM = 32
RET_V_DIM = 64
RET_CHUNK = 128
MLA_HEADS = 8
MLA_NOPE_DIM = 64
MLA_ROPE_DIM = 32
MLA_V_DIM = 64
MLA_Q_RANK = 256
MLA_KV_RANK = 128
Q_BLOCK = 128
ROPE_BASE = 10000.0
N_EXPERTS = 64
TOP_K = 6
EXPERT_DIM = 256
ROUTED_SCALE = 2.5
MOE_BLOCK = 128
NORM_EPS = 1e-6

IN_WIDTHS = (2 * CONV_CH,
             RET_HEADS * RET_QK_DIM, RET_HEADS * RET_QK_DIM, RET_HEADS * RET_V_DIM, RET_HEADS * RET_V_DIM,
             MLA_Q_RANK, MLA_KV_RANK, MLA_ROPE_DIM)
IN_SPLITS = tuple(sum(IN_WIDTHS[:i + 1]) for i in range(len(IN_WIDTHS) - 1))
IN_COLS = sum(IN_WIDTHS)

kernel_name = 'hybrid_conv_retention_mla_moe_dit'


def rms_norm(x, w):
    xf = x.astype(jnp.float32)
    y = xf * lax.rsqrt(jnp.mean(xf * xf, axis=-1, keepdims=True) + NORM_EPS)
    return y.astype(x.dtype) * w


def layer_norm(x, w, b):
    xf = x.astype(jnp.float32)
    mu = jnp.mean(xf, axis=-1, keepdims=True)
    var = jnp.mean(jnp.square(xf - mu), axis=-1, keepdims=True)
    return ((xf - mu) * lax.rsqrt(var + NORM_EPS)).astype(x.dtype) * w + b


def modulate(h, shift, scale):
    return h * (1 + scale) + shift


def axial_rope_tables(rows, dim):
    pos_r = jnp.repeat(jnp.arange(rows, dtype=jnp.float32), GRID_W)
    pos_c = jnp.tile(jnp.arange(GRID_W, dtype=jnp.float32), rows)
    n_freq = dim // 4
    inv = ROPE_BASE ** (-jnp.arange(n_freq, dtype=jnp.float32) / n_freq)
    ang = jnp.concatenate([pos_r[:, None] * inv, pos_c[:, None] * inv], axis=-1)
    return jnp.cos(ang), jnp.sin(ang)


def apply_rope(x, cos, sin):
    x1, x2 = jnp.split(x, 2, axis=-1)
    cos = cos.astype(x.dtype)
    sin = sin.astype(x.dtype)
    return jnp.concatenate([x1 * cos - x2 * sin, x1 * sin + x2 * cos], axis=-1)


def conformer_conv(u, conv_w, conv_b, ln_w, ln_b):
    a, g = jnp.split(u, 2, axis=-1)
    h = a * jax.nn.sigmoid(g)
    h = lax.conv_general_dilated(h, conv_w[:, None, :], window_strides=(1,),
                                 padding=[(CONV_K // 2, CONV_K // 2)],
                                 dimension_numbers=('NWC', 'WIO', 'NWC'),
                                 feature_group_count=CONV_CH) + conv_b
    return jax.nn.silu(layer_norm(h, ln_w, ln_b))


def retention_scan(q, k, v, log_gamma, s0):
    b, n_tok, h, dk = q.shape
    dv = v.shape[-1]
    n_chunks = n_tok // RET_CHUNK

    def to_chunks(t):
        return t.reshape(b, n_chunks, RET_CHUNK, h, t.shape[-1]).transpose(1, 0, 3, 2, 4)

    idx = jnp.arange(RET_CHUNK, dtype=jnp.float32)
    rel = idx[:, None] - idx[None, :]
    decay_in = jnp.where(rel >= 0, jnp.exp(log_gamma[:, None, None] * jnp.maximum(rel, 0.0)), 0.0)
    decay_q = jnp.exp(log_gamma[:, None] * (idx + 1.0))[:, :, None]
    decay_k = jnp.exp(log_gamma[:, None] * (RET_CHUNK - 1.0 - idx))[:, :, None]
    decay_chunk = jnp.exp(log_gamma * RET_CHUNK)[:, None, None]

    def step(s, qkv):
        qc, kc, vc = qkv
        inner = jnp.einsum('bhqd,bhkd->bhqk', qc, kc) * decay_in
        y = (jnp.einsum('bhqk,bhkv->bhqv', inner, vc)
             + jnp.einsum('bhqd,bhdv->bhqv', qc * decay_q, s))
        s = s * decay_chunk + jnp.einsum('bhkd,bhkv->bhdv', kc * decay_k, vc)
        return s, y

    s_final, ys = lax.scan(step, s0, (to_chunks(q), to_chunks(k), to_chunks(v)))
    return ys.transpose(1, 0, 3, 2, 4).reshape(b, n_tok, h, dv), s_final


def retention_qkv(zq, zk, zv, rope):
    b, n_tok, _ = zq.shape
    q = zq.reshape(b, n_tok, RET_HEADS, RET_QK_DIM).astype(jnp.float32)
    k = zk.reshape(b, n_tok, RET_HEADS, RET_QK_DIM).astype(jnp.float32) * (RET_QK_DIM ** -0.5)
    v = zv.reshape(b, n_tok, RET_HEADS, RET_V_DIM).astype(jnp.float32)
    if rope is not None:
        cos, sin = rope
        q = apply_rope(q, cos[None, :, None, :], sin[None, :, None, :])
        k = apply_rope(k, cos[None, :, None, :], sin[None, :, None, :])
    return q, k, v


def retention_out(y, g, gn_w):
    b, n_tok, h, dv = y.shape
    mu = jnp.mean(y, axis=-1, keepdims=True)
    var = jnp.mean(jnp.square(y - mu), axis=-1, keepdims=True)
    yn = ((y - mu) * lax.rsqrt(var + NORM_EPS)).reshape(b, n_tok, h * dv).astype(g.dtype)
    return jax.nn.silu(g) * (yn * gn_w)


def mla_q(cq, q_norm_w, w_uq, rope):
    b, n_tok, _ = cq.shape
    q = (rms_norm(cq, q_norm_w) @ w_uq).reshape(b, n_tok, MLA_HEADS, MLA_NOPE_DIM + MLA_ROPE_DIM)
    if rope is not None:
        cos, sin = rope
        q = jnp.concatenate([q[..., :MLA_NOPE_DIM],
                             apply_rope(q[..., MLA_NOPE_DIM:], cos[None, :, None, :], sin[None, :, None, :])], axis=-1)
    return q


def mla_kv(ckv, k_rope, kv_norm_w, w_ukv, rope):
    b, n_tok, _ = ckv.shape
    kv = (rms_norm(ckv, kv_norm_w) @ w_ukv).reshape(b, n_tok, MLA_HEADS, MLA_NOPE_DIM + MLA_V_DIM)
    k_nope, v = kv[..., :MLA_NOPE_DIM], kv[..., MLA_NOPE_DIM:]
    if rope is not None:
        cos, sin = rope
        k_rope = apply_rope(k_rope, cos[None], sin[None])
    k = jnp.concatenate([k_nope, jnp.broadcast_to(k_rope[:, :, None, :], (b, n_tok, MLA_HEADS, MLA_ROPE_DIM))], axis=-1)
    return k, v


def block_attention(q, k, v):
    b, n_q, h, dq = q.shape
    n_blocks = n_q // Q_BLOCK
    scale = dq ** -0.5
    qb = q.reshape(b, n_blocks, Q_BLOCK, h, dq).swapaxes(0, 1)

    def one_block(qi):
        s = jnp.einsum('bqhd,bkhd->bhqk', qi, k).astype(jnp.float32) * scale
        p = jax.nn.softmax(s, axis=-1).astype(v.dtype)
        return jnp.einsum('bhqk,bkhd->bqhd', p, v)

    o = lax.map(one_block, qb)
    return o.swapaxes(0, 1).reshape(b, n_q, h * v.shape[-1])


def token_mixer(hl, hc, w_in, conv_w, conv_b, conv_ln_w, conv_ln_b, ret_decay_logit, ret_gn_w,
                q_norm_w, w_uq, kv_norm_w, w_ukv, w_out, rope_ret, rope_mla, with_ctx_out):
    zl = jnp.split(hl @ w_in, IN_SPLITS, axis=-1)
    zc = jnp.split(hc @ w_in, IN_SPLITS, axis=-1)

    conv_l = conformer_conv(zl[0], conv_w, conv_b, conv_ln_w, conv_ln_b)

    ql, kl, vl = retention_qkv(zl[1], zl[2], zl[3], rope_ret)
    qc, kc, vc = retention_qkv(zc[1], zc[2], zc[3], None)
    log_gamma = jax.nn.log_sigmoid(ret_decay_logit.astype(jnp.float32))
    s0 = jnp.zeros((hl.shape[0], RET_HEADS, RET_QK_DIM, RET_V_DIM), jnp.float32)
    flip = lambda t: t[:, ::-1]
    yc_f, sc_f = retention_scan(qc, kc, vc, log_gamma[0], s0)
    yc_b, sc_b = retention_scan(flip(qc), flip(kc), flip(vc), log_gamma[1], s0)
    yl_f, _ = retention_scan(ql, kl, vl, log_gamma[0], sc_f)
    yl_b, _ = retention_scan(flip(ql), flip(kl), flip(vl), log_gamma[1], sc_b)
    ret_l = retention_out(yl_f + flip(yl_b), zl[4], ret_gn_w)

    k_ctx, v_ctx = mla_kv(zc[6], zc[7], kv_norm_w, w_ukv, None)
    k_lat, v_lat = mla_kv(zl[6], zl[7], kv_norm_w, w_ukv, rope_mla)
    q_lat = mla_q(zl[5], q_norm_w, w_uq, rope_mla)
    mla_l = block_attention(q_lat, jnp.concatenate([k_ctx, k_lat], axis=1), jnp.concatenate([v_ctx, v_lat], axis=1))

    yl = jnp.concatenate([conv_l, ret_l, mla_l], axis=-1) @ w_out
    if not with_ctx_out:
        return yl, None
    conv_c = conformer_conv(zc[0], conv_w, conv_b, conv_ln_w, conv_ln_b)
    ret_c = retention_out(yc_f + flip(yc_b), zc[4], ret_gn_w)
    mla_c = block_attention(mla_q(zc[5], q_norm_w, w_uq, None), k_ctx, v_ctx)
    yc = jnp.concatenate([conv_c, ret_c, mla_c], axis=-1) @ w_out
    return yl, yc


def swiglu(h, w_gate, w_up, w_down):
    return (jax.nn.silu(h @ w_gate) * (h @ w_up)) @ w_down


def routed_experts(h, expert_idx, expert_w, e_gate, e_up, e_down):
    n_tok, d = h.shape
    n_assign = n_tok * TOP_K
    n_blocks = -(-n_assign // MOE_BLOCK) + N_EXPERTS
    flat_e = expert_idx.reshape(-1)
    flat_tok = jnp.repeat(jnp.arange(n_tok, dtype=jnp.int32), TOP_K)
    flat_w = expert_w.reshape(-1)
    order = jnp.argsort(flat_e)
    sorted_e = flat_e[order]
    counts = jnp.bincount(flat_e, length=N_EXPERTS)
    padded = (counts + MOE_BLOCK - 1) // MOE_BLOCK * MOE_BLOCK
    pad_end = jnp.cumsum(padded)
    pad_start = pad_end - padded
    start = jnp.cumsum(counts) - counts
    dest = pad_start[sorted_e] + jnp.arange(n_assign, dtype=jnp.int32) - start[sorted_e]
    slot_tok = jnp.full((n_blocks * MOE_BLOCK,), n_tok, jnp.int32).at[dest].set(flat_tok[order])
    slot_w = jnp.zeros((n_blocks * MOE_BLOCK,), h.dtype).at[dest].set(flat_w[order])
    block_e = jnp.minimum(jnp.searchsorted(pad_end, jnp.arange(n_blocks, dtype=jnp.int32) * MOE_BLOCK, side='right'),
                          N_EXPERTS - 1)
    h_pad = jnp.concatenate([h, jnp.zeros((1, d), h.dtype)], axis=0)

    def step(y, blk):
        tok, wt, e = blk
        out = swiglu(h_pad[tok], e_gate[e], e_up[e], e_down[e])
        return y.at[tok].add(out * wt[:, None]), None

    y, _ = lax.scan(step, jnp.zeros((n_tok + 1, d), h.dtype),
                    (slot_tok.reshape(n_blocks, MOE_BLOCK), slot_w.reshape(n_blocks, MOE_BLOCK), block_e))
    return y[:n_tok]


def moe_ffn(h, router_w, router_b, e_gate, e_up, e_down, s_gate, s_up, s_down):
    scores = jax.nn.sigmoid((h @ router_w).astype(jnp.float32))
    _, idx = lax.top_k(scores + router_b.astype(jnp.float32), TOP_K)
    w = jnp.take_along_axis(scores, idx, axis=-1)
    w = (w / jnp.sum(w, axis=-1, keepdims=True) * ROUTED_SCALE).astype(h.dtype)
    return routed_experts(h, idx, w, e_gate, e_up, e_down) + swiglu(h, s_gate, s_up, s_down)


def setup_inputs(seed: int = 0) -> dict:
    key = jax.random.key(seed)
    ks = jax.random.split(key, 32)
    f32 = jnp.float32
    nrm = lambda k, shape, scale: jax.random.normal(k, shape, f32) * scale
    gain = lambda k, shape: 1.0 + 0.02 * jax.random.normal(k, shape, f32)
    ret_logit0 = jnp.log(2.0 ** (5.0 + jnp.arange(RET_HEADS, dtype=f32)) - 1.0)
    return {
        'x': nrm(ks[0], (BATCH, SEQ, D_MODEL), 1.0),
        'c': nrm(ks[1], (BATCH, D_MODEL), 1.0),
        'ctx': nrm(ks[2], (BATCH, CTX_LEN, D_MODEL), 1.0),
        'c_ctx': nrm(ks[3], (D_MODEL,), 1.0),
        'mod_w': nrm(ks[4], (DEPTH, D_MODEL, 6 * D_MODEL), 0.5 * D_MODEL ** -0.5),
        'mod_b': nrm(ks[5], (DEPTH, 6 * D_MODEL), 0.02),
        'norm1_w': gain(ks[6], (DEPTH, D_MODEL)),
        'w_in': nrm(ks[7], (DEPTH, D_MODEL, IN_COLS), D_MODEL ** -0.5),
        'conv_w': nrm(ks[8], (DEPTH, CONV_K, CONV_CH), CONV_K ** -0.5),
        'conv_b': nrm(ks[9], (DEPTH, CONV_CH), 0.02),
        'conv_ln_w': gain(ks[10], (DEPTH, CONV_CH)),
        'conv_ln_b': nrm(ks[11], (DEPTH, CONV_CH), 0.02),
        'ret_decay_logit': ret_logit0 + 0.1 * jax.random.normal(ks[12], (DEPTH, 2, RET_HEADS), f32),
        'ret_gn_w': gain(ks[13], (DEPTH, RET_HEADS * RET_V_DIM)),
        'q_norm_w': gain(ks[14], (DEPTH, MLA_Q_RANK)),
        'w_uq': nrm(ks[15], (DEPTH, MLA_Q_RANK, MLA_HEADS * (MLA_NOPE_DIM + MLA_ROPE_DIM)), MLA_Q_RANK ** -0.5),
        'kv_norm_w': gain(ks[16], (DEPTH, MLA_KV_RANK)),
        'w_ukv': nrm(ks[17], (DEPTH, MLA_KV_RANK, MLA_HEADS * (MLA_NOPE_DIM + MLA_V_DIM)), MLA_KV_RANK ** -0.5),
        'w_out': nrm(ks[18], (DEPTH, MIX_WIDTH, D_MODEL), MIX_WIDTH ** -0.5),
        'norm2_w': gain(ks[19], (DEPTH, D_MODEL)),
        'router_w': nrm(ks[20], (DEPTH, D_MODEL, N_EXPERTS), D_MODEL ** -0.5),
        'router_b': nrm(ks[21], (DEPTH, N_EXPERTS), 0.01),
        'exp_w_gate': nrm(ks[22], (DEPTH, N_EXPERTS, D_MODEL, EXPERT_DIM), D_MODEL ** -0.5),
        'exp_w_up': nrm(ks[23], (DEPTH, N_EXPERTS, D_MODEL, EXPERT_DIM), D_MODEL ** -0.5),
        'exp_w_down': nrm(ks[24], (DEPTH, N_EXPERTS, EXPERT_DIM, D_MODEL), EXPERT_DIM ** -0.5),
        'sh_w_gate': nrm(ks[25], (DEPTH, D_MODEL, EXPERT_DIM), D_MODEL ** -0.5),
        'sh_w_up': nrm(ks[26], (DEPTH, D_MODEL, EXPERT_DIM), D_MODEL ** -0.5),
        'sh_w_down': nrm(ks[27], (DEPTH, EXPERT_DIM, D_MODEL), EXPERT_DIM ** -0.5),
        'final_norm_w': gain(ks[28], (D_MODEL,)),
    }


def reference(x, c, ctx, c_ctx, mod_w, mod_b, norm1_w, w_in, conv_w, conv_b, conv_ln_w, conv_ln_b,
              ret_decay_logit, ret_gn_w, q_norm_w, w_uq, kv_norm_w, w_ukv, w_out, norm2_w,
              router_w, router_b, exp_w_gate, exp_w_up, exp_w_down, sh_w_gate, sh_w_up, sh_w_down,
              final_norm_w):
    b, n_lat, d = x.shape
    n_ctx = ctx.shape[1]
    rows = n_lat // GRID_W
    rope_ret = axial_rope_tables(rows, RET_QK_DIM)
    rope_mla = axial_rope_tables(rows, MLA_ROPE_DIM)
    xl, xc = x, ctx
    for i in range(DEPTH):
        last = i == DEPTH - 1
        mod_l = jax.nn.silu(c) @ mod_w[i] + mod_b[i]
        mod_c = jax.nn.silu(c_ctx) @ mod_w[i] + mod_b[i]
        sh1, sc1, g1, sh2, sc2, g2 = jnp.split(mod_l[:, None, :], 6, axis=-1)
        csh1, csc1, cg1, csh2, csc2, cg2 = jnp.split(mod_c, 6)

        hl = modulate(rms_norm(xl, norm1_w[i]), sh1, sc1)
        hc = modulate(rms_norm(xc, norm1_w[i]), csh1, csc1)
        yl, yc = token_mixer(hl, hc, w_in[i], conv_w[i], conv_b[i], conv_ln_w[i], conv_ln_b[i],
                             ret_decay_logit[i], ret_gn_w[i], q_norm_w[i], w_uq[i], kv_norm_w[i], w_ukv[i],
                             w_out[i], rope_ret, rope_mla, not last)
        xl = xl + g1 * yl

        hl2 = modulate(rms_norm(xl, norm2_w[i]), sh2, sc2).reshape(b * n_lat, d)
        if last:
            out = moe_ffn(hl2, router_w[i], router_b[i], exp_w_gate[i], exp_w_up[i], exp_w_down[i],
                          sh_w_gate[i], sh_w_up[i], sh_w_down[i])
            xl = xl + g2 * out.reshape(b, n_lat, d)
        else:
            xc = xc + cg1 * yc
            hc2 = modulate(rms_norm(xc, norm2_w[i]), csh2, csc2).reshape(b * n_ctx, d)
            out = moe_ffn(jnp.concatenate([hl2, hc2], axis=0), router_w[i], router_b[i], exp_w_gate[i],
                          exp_w_up[i], exp_w_down[i], sh_w_gate[i], sh_w_up[i], sh_w_down[i])
            xl = xl + g2 * out[:b * n_lat].reshape(b, n_lat, d)
            xc = xc + cg2 * out[b * n_lat:].reshape(b, n_ctx, d)
    return rms_norm(xl, final_norm_w)
```

```cpp
#include <hip/hip_runtime.h>
#include <cstdio>
#include <cstdint>

#ifndef MK_PER_PHASE
#define MK_PER_PHASE 0
#endif

typedef unsigned short bf16_t;
typedef short bf16x8 __attribute__((ext_vector_type(8)));
typedef float f32x4 __attribute__((ext_vector_type(4)));
typedef unsigned u32x4 __attribute__((ext_vector_type(4)));
typedef unsigned u32x2 __attribute__((ext_vector_type(2)));
#define LAS __attribute__((address_space(3)))

constexpr int D = 1024, BATCH = 16, SEQ = 2048, CTXL = 256;
constexpr int NLAT = BATCH * SEQ, NCTX = BATCH * CTXL, NTOK = NLAT + NCTX;
constexpr int ZC = 1792;
constexpr int Z_RQ = 512, Z_RK = 640, Z_RV = 768, Z_RG = 1024, Z_CQ = 1280, Z_CKV = 1536, Z_KR = 1664, Z_END = 1696;
constexpr int NEXP = 64, TOPK = 6, EDIM = 256;
constexpr int LCAP = NTOK;
constexpr float NORM_EPS = 1e-6f;
constexpr int NTHREADS = 512, NWAVES = 8;

constexpr size_t MiB = 1u << 20;
constexpr size_t WS_CTL = 0, CTL_ZERO_BYTES = 1 * MiB;
constexpr size_t WS_MODV = 1 * MiB;
constexpr size_t WS_ROPE = 2 * MiB;
constexpr size_t WS_WIN = 3 * MiB;
constexpr size_t WS_WUQ = 10 * MiB;
constexpr size_t WS_WUKV = 11 * MiB;
constexpr size_t WS_WOUT = 12 * MiB;
constexpr size_t WS_RT = 16 * MiB;
constexpr size_t WS_SHGU = 17 * MiB;
constexpr size_t WS_SHD = 19 * MiB;
constexpr size_t WS_EGU = 20 * MiB;
constexpr size_t WS_ED = 84 * MiB;
constexpr size_t WS_XC = 116 * MiB;
constexpr size_t WS_H = 132 * MiB;
constexpr size_t WS_KV = WS_H;
constexpr size_t WS_R = 204 * MiB;
constexpr size_t WS_Z = WS_R;
constexpr size_t WS_Q = WS_R + 126 * MiB;
constexpr size_t WS_K = WS_R + 180 * MiB;
constexpr size_t WS_V = WS_R + 234 * MiB;
constexpr size_t WS_CC = WS_R + 270 * MiB;
constexpr size_t WS_LTOK = WS_R;
constexpr size_t WS_LW = WS_R + 9 * MiB;
constexpr size_t WS_ACT = WS_R + 18 * MiB;
constexpr size_t WS_ACTSH = WS_R + 130 * MiB;
constexpr size_t WS_SLOT = WS_R + 148 * MiB;
constexpr size_t WS_END = WS_R + 342 * MiB;
static_assert(WS_SLOT + (size_t)NTOK * 6 * 256 * 2 <= WS_CC, "slots end before CC");

constexpr int CW_TMO = 0;
constexpr int CW_BAR = 4096;
constexpr int CW_ECNT = 8192;

constexpr int LDS_BYTES = 147456;
constexpr int MISC_OFF = LDS_BYTES - 256;
constexpr int ETAB_OFF = 143360;
constexpr int GEMM_LDS = 36864;
constexpr int ROWSS_OFF = 36864;
constexpr int LG_OFF = 37376;

#define XB_TMO      128
#define XB_XCNT(j)  (256  + 64 * (j))
#define XB_XSUB(j)  (1280 + 64 * (j))
#define XB_XGEN(j)  (2304 + 64 * (j))
#define XB_TOP      3328
#define XB_TOPGEN   3392
#define XCD_BAR_WORDS 3456
#define XB_SPIN_CAP (1u << 24)
__device__ __forceinline__ unsigned xb_ld(unsigned* p)              { return __hip_atomic_load(p, __ATOMIC_RELAXED, __HIP_MEMORY_SCOPE_AGENT); }
__device__ __forceinline__ unsigned xb_add(unsigned* p, unsigned v) { return __hip_atomic_fetch_add(p, v, __ATOMIC_RELAXED, __HIP_MEMORY_SCOPE_AGENT); }
__device__ __forceinline__ unsigned xb_xcc_id() { return (unsigned)__builtin_amdgcn_s_getreg((3 << 11) | 20) & 0xFu; }
#define XB_SPIN(cond, bar) do { unsigned _sp = 0; while (cond) { __builtin_amdgcn_s_sleep(1); \
    if ((++_sp & 255u) == 0u) { if (xb_ld(&(bar)[XB_TMO])) break; if (_sp > XB_SPIN_CAP) { atomicAdd(&(bar)[XB_TMO], 1u); break; } } } } while (0)
struct XcdBarrier { unsigned* bar; unsigned x; volatile LAS unsigned* st; };
__device__ __forceinline__ XcdBarrier xcd_barrier_post(unsigned* bar, volatile LAS unsigned* st) {
    XcdBarrier b; b.bar = bar; b.x = xb_xcc_id(); b.st = st;
    if (threadIdx.x == 0) (void)xb_add(&bar[XB_XCNT(b.x)], 1u);
    return b;
}
__device__ __forceinline__ void xcd_barrier_complete(unsigned* bar, unsigned x, unsigned& nloc, unsigned& nx) {
    const unsigned G = gridDim.x * gridDim.y * gridDim.z;
    unsigned sum, cnt, mine, sp = 0u;
    for (;;) {
        sum = 0u; cnt = 0u; mine = 0u;
#pragma unroll
        for (unsigned j = 0; j < 16; ++j) { const unsigned c = xb_ld(&bar[XB_XCNT(j)]); sum += c; cnt += (c > 0u) ? 1u : 0u; mine = (j == x) ? c : mine; }
        if (sum == G) break;
        __builtin_amdgcn_s_sleep(1);
        if ((++sp & 255u) == 0u) { if (xb_ld(&bar[XB_TMO])) break; if (sp > XB_SPIN_CAP) { atomicAdd(&bar[XB_TMO], 1u); break; } }
    }
    nloc = mine > 0u ? mine : 1u; nx = cnt > 0u ? cnt : 1u;
}
__device__ __forceinline__ void xcd_barrier(const XcdBarrier& b) {
    asm volatile("s_waitcnt vmcnt(0)" ::: "memory");
    __syncthreads();
    if (threadIdx.x == 0) {
        unsigned* bar = b.bar;
        __builtin_amdgcn_s_waitcnt(0);
        unsigned nloc = b.st[0], nx = b.st[1];
        if (nloc == 0u) { xcd_barrier_complete(bar, b.x, nloc, nx); b.st[0] = nloc; b.st[1] = nx; }
        const unsigned old = xb_add(&bar[XB_XSUB(b.x)], 1u);
        const unsigned gen = old / nloc;
        if (old + 1u == (gen + 1u) * nloc) {
            __builtin_amdgcn_fence(__ATOMIC_RELEASE, "agent");
            asm volatile("s_waitcnt vmcnt(0)" ::: "memory");
            const unsigned og = xb_add(&bar[XB_TOP], 1u);
            const unsigned tg = og / nx;
            if (og + 1u == (tg + 1u) * nx) xb_add(&bar[XB_TOPGEN], 1u);
            else XB_SPIN(xb_ld(&bar[XB_TOPGEN]) == tg, bar);
            __builtin_amdgcn_fence(__ATOMIC_ACQUIRE, "agent");
            xb_add(&bar[XB_XGEN(b.x)], 1u);
            asm volatile("s_waitcnt vmcnt(0)" ::: "memory");
        } else {
            XB_SPIN(xb_ld(&bar[XB_XGEN(b.x)]) == gen, bar);
            __builtin_amdgcn_fence(__ATOMIC_ACQUIRE, "agent");
            asm volatile("s_waitcnt vmcnt(0)" ::: "memory");
        }
    }
    __syncthreads();
}

__device__ __forceinline__ float bf2f(unsigned h) { return __uint_as_float(h << 16); }
__device__ __forceinline__ unsigned f2bf(float f) { unsigned u = __float_as_uint(f); return (u + 0x7fffu + ((u >> 16) & 1u)) >> 16; }
__device__ __forceinline__ unsigned pk2(float lo, float hi) { return f2bf(lo) | (f2bf(hi) << 16); }
__device__ __forceinline__ float lo16(unsigned w) { return __uint_as_float(w << 16); }
__device__ __forceinline__ float hi16(unsigned w) { return __uint_as_float(w & 0xffff0000u); }
__device__ __forceinline__ float wave_sum(float v) {
#pragma unroll
    for (int o = 1; o < 64; o <<= 1) v += __shfl_xor(v, o);
    return v;
}
__device__ __forceinline__ float siluf(float v) { return v / (1.f + __expf(-v)); }
__device__ __forceinline__ int mod_row(int tok) { return tok < NLAT ? (tok >> 11) : 16; }

struct P { const float* in[29]; float* out; unsigned char* ws; int ph_lo, ph_hi; };

__device__ __forceinline__ float* x_row(const P& p, int tok) {
    return tok < NLAT ? p.out + (size_t)tok * D : (float*)(p.ws + WS_XC) + (size_t)(tok - NLAT) * D;
}

template <bool ROWSS, class RowSrc, class Epi>
__device__ __forceinline__ void gemm_tile(unsigned char* lds, const RowSrc& rs, const bf16_t* Bt, int ldb, int K, const Epi& epi) {
    const int tid = threadIdx.x, lane = tid & 63, wid = tid >> 6, wr = wid >> 2, wc = wid & 3, fr = lane & 15, fq = lane >> 4;
    bf16_t* As = (bf16_t*)lds; bf16_t* Bs = As + 128 * 72;
    float* rowss = (float*)(lds + ROWSS_OFF);
    const int lr = tid >> 2, lc = (tid & 3) * 16;
    const bf16_t* ap = rs(lr) + lc;
    const bf16_t* bp = Bt + (size_t)lr * ldb + lc;
    u32x4 a0 = *(const u32x4*)ap, a1 = *(const u32x4*)(ap + 8), b0 = *(const u32x4*)bp, b1 = *(const u32x4*)(bp + 8);
    f32x4 acc[4][2];
#pragma unroll
    for (int m = 0; m < 4; ++m)
#pragma unroll
        for (int n = 0; n < 2; ++n) acc[m][n] = (f32x4){0.f, 0.f, 0.f, 0.f};
    float ss = 0.f;
    for (int k0 = 0; k0 < K; k0 += 64) {
        __syncthreads();
        *(u32x4*)(As + lr * 72 + lc) = a0; *(u32x4*)(As + lr * 72 + lc + 8) = a1;
        *(u32x4*)(Bs + lr * 72 + lc) = b0; *(u32x4*)(Bs + lr * 72 + lc + 8) = b1;
        if (ROWSS) {
#pragma unroll
            for (int i = 0; i < 4; ++i) { float x0 = lo16(a0[i]), x1 = hi16(a0[i]), y0 = lo16(a1[i]), y1 = hi16(a1[i]); ss += x0 * x0 + x1 * x1 + y0 * y0 + y1 * y1; }
        }
        __syncthreads();
        if (k0 + 64 < K) { ap += 64; bp += 64; a0 = *(const u32x4*)ap; a1 = *(const u32x4*)(ap + 8); b0 = *(const u32x4*)bp; b1 = *(const u32x4*)(bp + 8); }
#pragma unroll
        for (int kk = 0; kk < 2; ++kk) {
            bf16x8 af[4], bfr[2];
#pragma unroll
            for (int m = 0; m < 4; ++m) af[m] = *(const bf16x8*)(As + (wr * 64 + m * 16 + fr) * 72 + kk * 32 + fq * 8);
#pragma unroll
            for (int n = 0; n < 2; ++n) bfr[n] = *(const bf16x8*)(Bs + (wc * 32 + n * 16 + fr) * 72 + kk * 32 + fq * 8);
#pragma unroll
            for (int m = 0; m < 4; ++m)
#pragma unroll
                for (int n = 0; n < 2; ++n) acc[m][n] = __builtin_amdgcn_mfma_f32_16x16x32_bf16(bfr[n], af[m], acc[m][n], 0, 0, 0);
        }
    }
    if (ROWSS) {
        ss += __shfl_xor(ss, 1); ss += __shfl_xor(ss, 2);
        if ((tid & 3) == 0) rowss[lr] = ss;
        __syncthreads();
    }
#pragma unroll
    for (int m = 0; m < 4; ++m)
#pragma unroll
        for (int n = 0; n < 2; ++n) epi(wr * 64 + m * 16 + fr, wc * 32 + n * 16 + 4 * fq, acc[m][n]);
}

struct TMap { const float* s0; const float* s1; int ld; int nvalid; const float* ksc; float gsc; };
template <int MODE> __device__ __forceinline__ const float* tmap_src(const float* s0, const float* s1, int nvalid, int n) {
    if (MODE == 0) return n < nvalid ? s0 + n : nullptr;
    if (MODE == 1) { const int h = n / 96, j = n % 96; const int c = j < 64 ? j : 64 + ((j - 64) & 1) * 16 + ((j - 64) >> 1); return s0 + h * 96 + c; }
    return ((n & 1) ? s1 : s0) + (n >> 1);
}
template <int MODE> __device__ __forceinline__ void transpose_unit(float* scr, const float* s0, const float* s1, int ld, int nvalid, const float* ksc, float gsc, int K, bf16_t* dst, int kb, int nb) {
    const int tid = threadIdx.x, k0 = kb * 64, n0 = nb * 64;
    const int nn = tid & 63; const float* sp = tmap_src<MODE>(s0, s1, nvalid, n0 + nn);
#pragma unroll
    for (int i = 0; i < 8; ++i) {
        const int kk = (tid >> 6) + 8 * i; float v = sp ? sp[(size_t)(k0 + kk) * ld] : 0.f;
        if (ksc) v *= ksc[k0 + kk];
        scr[kk * 65 + nn] = v * gsc;
    }
    __syncthreads();
    {
        const int n2 = tid >> 3, kc = tid & 7; const float* s = scr + (kc * 8) * 65 + n2;
        u32x4 o; o.x = pk2(s[0], s[65]); o.y = pk2(s[2 * 65], s[3 * 65]); o.z = pk2(s[4 * 65], s[5 * 65]); o.w = pk2(s[6 * 65], s[7 * 65]);
        *(u32x4*)(dst + (size_t)(n0 + n2) * K + k0 + kc * 8) = o;
    }
    __syncthreads();
}
template <int MODE> __device__ __forceinline__ void transpose_matrix(float* scr, const float* s0, const float* s1, int ld, int nvalid, const float* ksc, float gsc, int K, int Nd, bf16_t* dst, int& rot) {
    const int nkb = K / 64, nnb = Nd / 64, nu = nkb * nnb, G = gridDim.x;
    int first = ((int)blockIdx.x - rot) % G; if (first < 0) first += G;
    for (int u = first; u < nu; u += G) transpose_unit<MODE>(scr, s0, s1, ld, nvalid, ksc, gsc, K, dst, u / nnb, u % nnb);
    rot = (rot + nu) % G;
}
__device__ __forceinline__ void convert_expert_weights(unsigned char* lds, const P& p, int L) {
    float* scr = (float*)lds; const int G = gridDim.x;
    bf16_t* egu = (bf16_t*)(p.ws + WS_EGU); bf16_t* ed = (bf16_t*)(p.ws + WS_ED);
    for (int u = blockIdx.x; u < NEXP * 192; u += G) {
        const int e = u / 192, r = u % 192;
        if (r < 128) {
            transpose_unit<2>(scr, p.in[22] + ((size_t)L * NEXP + e) * D * EDIM, p.in[23] + ((size_t)L * NEXP + e) * D * EDIM, EDIM, 512, nullptr, 1.f, D, egu + (size_t)e * 512 * D, r / 8, r % 8);
        } else {
            const int r2 = r - 128;
            transpose_unit<0>(scr, p.in[24] + ((size_t)L * NEXP + e) * EDIM * D, nullptr, D, D, nullptr, 1.f, EDIM, ed + (size_t)e * D * EDIM, r2 / 16, r2 % 16);
        }
    }
}
__device__ __forceinline__ void prep_mod_unit(unsigned char* lds, const P& p, int u) {
    float* sc = (float*)lds;
    float* part = sc + 17 * 1024;
    const int tid = threadIdx.x;
    const float* c = p.in[1]; const float* cctx = p.in[3];
    for (int i = tid; i < 17 * 1024; i += NTHREADS) { const int r = i >> 10, k = i & 1023; const float v = r < 16 ? c[r * 1024 + k] : cctx[k]; sc[i] = v / (1.f + expf(-v)); }
    __syncthreads();
    const int L = u / 48, cg = u % 48, kq = tid >> 7, cl = tid & 127, col = cg * 128 + cl;
    const float* w = p.in[4] + (size_t)L * 1024 * 6144 + col;
    float acc[17];
#pragma unroll
    for (int r = 0; r < 17; ++r) acc[r] = 0.f;
    for (int k = kq * 256; k < kq * 256 + 256; ++k) {
        const float wv = w[(size_t)k * 6144];
#pragma unroll
        for (int r = 0; r < 17; ++r) acc[r] += sc[r * 1024 + k] * wv;
    }
#pragma unroll
    for (int r = 0; r < 17; ++r) part[(kq * 17 + r) * 128 + cl] = acc[r];
    __syncthreads();
    float* modv = (float*)(p.ws + WS_MODV);
    for (int i = tid; i < 17 * 128; i += NTHREADS) {
        const int r = i >> 7, c2 = i & 127;
        float s = part[(0 * 17 + r) * 128 + c2] + part[(1 * 17 + r) * 128 + c2] + part[(2 * 17 + r) * 128 + c2] + part[(3 * 17 + r) * 128 + c2];
        s += p.in[5][L * 6144 + cg * 128 + c2];
        modv[((size_t)L * 17 + r) * 6144 + cg * 128 + c2] = s;
    }
    __syncthreads();
}
__device__ __forceinline__ void phase_prep(unsigned char* lds, const P& p) {
    const int tid = threadIdx.x, G = gridDim.x, bid = blockIdx.x;
    {
        float* ct = (float*)(p.ws + WS_ROPE); float* st = ct + 2048 * 16;
        for (int i = bid * NTHREADS + tid; i < 2048 * 16; i += G * NTHREADS) {
            const int pos = i >> 4, f = i & 15;
            const float inv = powf(10000.f, -(float)(f & 7) / 8.f);
            const float ang = (float)(f < 8 ? (pos >> 6) : (pos & 63)) * inv;
            ct[i] = cosf(ang); st[i] = sinf(ang);
        }
    }
    for (int u = G - 1 - bid; u < 96; u += G) prep_mod_unit(lds, p, u);
    float* scr = (float*)lds; int rot = 0;
    for (int L = 0; L < 2; ++L) {
        transpose_matrix<0>(scr, p.in[7] + (size_t)L * D * Z_END, nullptr, Z_END, Z_END, nullptr, 1.f, D, ZC, (bf16_t*)(p.ws + WS_WIN) + (size_t)L * ZC * D, rot);
        transpose_matrix<1>(scr, p.in[15] + (size_t)L * 256 * 768, nullptr, 768, 768, p.in[14] + L * 256, 0.14724574f, 256, 768, (bf16_t*)(p.ws + WS_WUQ) + (size_t)L * 768 * 256, rot);
        transpose_matrix<0>(scr, p.in[17] + (size_t)L * 128 * 1024, nullptr, 1024, 1024, p.in[16] + L * 128, 1.f, 128, 1024, (bf16_t*)(p.ws + WS_WUKV) + (size_t)L * 1024 * 128, rot);
        transpose_matrix<0>(scr, p.in[18] + (size_t)L * D * D, nullptr, D, D, nullptr, 1.f, D, D, (bf16_t*)(p.ws + WS_WOUT) + (size_t)L * D * D, rot);
        transpose_matrix<0>(scr, p.in[20] + (size_t)L * D * NEXP, nullptr, NEXP, NEXP, nullptr, 1.f, D, 128, (bf16_t*)(p.ws + WS_RT) + (size_t)L * 128 * D, rot);
        transpose_matrix<2>(scr, p.in[25] + (size_t)L * D * EDIM, p.in[26] + (size_t)L * D * EDIM, EDIM, 512, nullptr, 1.f, D, 512, (bf16_t*)(p.ws + WS_SHGU) + (size_t)L * 512 * D, rot);
        transpose_matrix<0>(scr, p.in[27] + (size_t)L * EDIM * D, nullptr, D, D, nullptr, 1.f, EDIM, D, (bf16_t*)(p.ws + WS_SHD) + (size_t)L * D * EDIM, rot);
    }
    convert_expert_weights(lds, p, 0);
    {
        const f32x4* xs = (const f32x4*)p.in[0]; f32x4* xd = (f32x4*)p.out;
        for (size_t i = (size_t)bid * NTHREADS + tid; i < (size_t)NLAT * D / 4; i += (size_t)G * NTHREADS) xd[i] = xs[i];
        const f32x4* cs = (const f32x4*)p.in[2]; f32x4* cd = (f32x4*)(p.ws + WS_XC);
        for (size_t i = (size_t)bid * NTHREADS + tid; i < (size_t)NCTX * D / 4; i += (size_t)G * NTHREADS) cd[i] = cs[i];
    }
}

__device__ __forceinline__ void phase_norm_mod(const P& p, int L, int which  , int ntok) {
    const int tid = threadIdx.x, lane = tid & 63, wave = tid >> 6, gw = blockIdx.x * NWAVES + wave, NGW = gridDim.x * NWAVES;
    const float* nw = (which == 0 ? p.in[6] : p.in[19]) + L * D;
    const float* modv = (const float*)(p.ws + WS_MODV) + (size_t)L * 17 * 6144;
    bf16_t* H = (bf16_t*)(p.ws + WS_H);
    for (int tok = gw; tok < ntok; tok += NGW) {
        const f32x4* xr = (const f32x4*)x_row(p, tok) + lane;
        const float* mrow = modv + (size_t)mod_row(tok) * 6144 + which * 3072;
        f32x4 v[4]; float s = 0.f;
#pragma unroll
        for (int j = 0; j < 4; ++j) { v[j] = xr[64 * j]; s += v[j].x * v[j].x + v[j].y * v[j].y + v[j].z * v[j].z + v[j].w * v[j].w; }
        const float rstd = rsqrtf(wave_sum(s) * (1.f / D) + NORM_EPS);
        u32x2* o = (u32x2*)(H + (size_t)tok * D) + lane;
#pragma unroll
        for (int j = 0; j < 4; ++j) {
            const int k = 4 * lane + 256 * j;
            const f32x4 w4 = *(const f32x4*)(nw + k), sh = *(const f32x4*)(mrow + k), sc = *(const f32x4*)(mrow + 1024 + k);
            const float y0 = v[j].x * rstd * w4.x * (1.f + sc.x) + sh.x, y1 = v[j].y * rstd * w4.y * (1.f + sc.y) + sh.y;
            const float y2 = v[j].z * rstd * w4.z * (1.f + sc.z) + sh.z, y3 = v[j].w * rstd * w4.w * (1.f + sc.w) + sh.w;
            u32x2 w; w.x = pk2(y0, y1); w.y = pk2(y2, y3); o[64 * j] = w;
        }
    }
}

__device__ __forceinline__ void phase_zgemm(unsigned char* lds, const P& p, int L) {
    const bf16_t* H = (const bf16_t*)(p.ws + WS_H); const bf16_t* W = (const bf16_t*)(p.ws + WS_WIN) + (size_t)L * ZC * D;
    bf16_t* Z = (bf16_t*)(p.ws + WS_Z);
    constexpr int NNT = ZC / 128, NU = (NTOK / 128) * NNT;
    for (int u = blockIdx.x; u < NU; u += gridDim.x) {
        const int mt = u / NNT, nt = u % NNT;
        auto rs = [&](int pr) { return H + (size_t)(mt * 128 + pr) * D; };
        auto epi = [&](int r, int c, f32x4 v) { u32x2 w; w.x = pk2(v.x, v.y); w.y = pk2(v.z, v.w); *(u32x2*)(Z + (size_t)(mt * 128 + r) * ZC + nt * 128 + c) = w; };
        gemm_tile<false>(lds, rs, W + (size_t)nt * 128 * D, D, D, epi);
    }
}

__device__ __forceinline__ void conv_unit(unsigned char* lds, const P& p, int L, int s, int tt) {
    float* hg = (float*)lds;
    const int tid = threadIdx.x, lane = tid & 63, wave = tid >> 6;
    const int rb = s < 16 ? s * SEQ : NLAT + (s - 16) * CTXL, len = s < 16 ? SEQ : CTXL, t0 = tt * 64;
    const bf16_t* Z = (const bf16_t*)(p.ws + WS_Z);
    for (int i = tid; i < 94 * 64; i += NTHREADS) {
        const int jj = i >> 6, c4 = (i & 63) * 4, t = t0 - 15 + jj;
        f32x4 h = (f32x4){0.f, 0.f, 0.f, 0.f};
        if (t >= 0 && t < len) {
            const bf16_t* zr = Z + (size_t)(rb + t) * ZC;
            const u32x2 a = *(const u32x2*)(zr + c4), g = *(const u32x2*)(zr + 256 + c4);
            const float g0 = lo16(g.x), g1 = hi16(g.x), g2 = lo16(g.y), g3 = hi16(g.y);
            h.x = lo16(a.x) / (1.f + __expf(-g0)); h.y = hi16(a.x) / (1.f + __expf(-g1));
            h.z = lo16(a.y) / (1.f + __expf(-g2)); h.w = hi16(a.y) / (1.f + __expf(-g3));
        }
        *(f32x4*)(hg + jj * 256 + c4) = h;
    }
    float* wl = hg + 94 * 256;
    for (int i = tid; i < 31 * 64; i += NTHREADS) *(f32x4*)(wl + i * 4) = *(const f32x4*)(p.in[8] + (size_t)L * 31 * 256 + i * 4);
    __syncthreads();
    const int c0 = lane * 4;
    const f32x4 cb = *(const f32x4*)(p.in[9] + L * 256 + c0), lw = *(const f32x4*)(p.in[10] + L * 256 + c0), lb = *(const f32x4*)(p.in[11] + L * 256 + c0);
    bf16_t* CC = (bf16_t*)(p.ws + WS_CC);
    for (int q = 0; q < 8; ++q) {
        const int tl = wave * 8 + q;
        f32x4 acc = cb;
#pragma unroll 4
        for (int j = 0; j < 31; ++j) { const f32x4 h = *(const f32x4*)(hg + (tl + j) * 256 + c0); acc += h * *(const f32x4*)(wl + j * 256 + c0); }
        const float mean = wave_sum(acc.x + acc.y + acc.z + acc.w) * (1.f / 256.f);
        const f32x4 d = acc - mean;
        const float var = wave_sum(d.x * d.x + d.y * d.y + d.z * d.z + d.w * d.w) * (1.f / 256.f);
        const float rstd = rsqrtf(var + NORM_EPS);
        const f32x4 y = d * rstd * lw + lb;
        u32x2 o; o.x = pk2(siluf(y.x), siluf(y.y)); o.y = pk2(siluf(y.z), siluf(y.w));
        *(u32x2*)(CC + (size_t)(rb + t0 + tl) * D + c0) = o;
    }
    __syncthreads();
}

__device__ __forceinline__ float log2_gamma(const P& p, int L, int dir, int h) {
    const float x = p.in[12][(L * 2 + dir) * 4 + h];
    const float ls = fminf(x, 0.f) - log1pf(expf(-fabsf(x)));
    return ls * 1.4426950408889634f;
}
__device__ __forceinline__ void load_ret_qk(float* dst, const P& p, int gc, int h, int zoff, float scale) {
    const int tid = threadIdx.x, j = tid >> 2, i0 = (tid & 3) * 4, row = gc * 128 + j;
    const bf16_t* zr = (const bf16_t*)(p.ws + WS_Z) + (size_t)row * ZC + zoff + h * 32;
    const u32x2 a = *(const u32x2*)(zr + i0), b = *(const u32x2*)(zr + 16 + i0);
    float x1[4] = {lo16(a.x), hi16(a.x), lo16(a.y), hi16(a.y)}, x2[4] = {lo16(b.x), hi16(b.x), lo16(b.y), hi16(b.y)};
    const bool lat = row < NLAT; const int pos = row & (SEQ - 1);
    const float* ct = (const float*)(p.ws + WS_ROPE) + pos * 16 + i0; const float* st = ct + 2048 * 16;
#pragma unroll
    for (int i = 0; i < 4; ++i) {
        const float c = lat ? ct[i] : 1.f, s = lat ? st[i] : 0.f;
        dst[j * 33 + i0 + i] = (x1[i] * c - x2[i] * s) * scale;
        dst[j * 33 + 16 + i0 + i] = (x1[i] * s + x2[i] * c) * scale;
    }
}
__device__ __forceinline__ void load_ret_v(float* dst  , const P& p, int gc, int h) {
    const int tid = threadIdx.x, j = tid >> 2, e0 = (tid & 3) * 16;
    const bf16_t* zr = (const bf16_t*)(p.ws + WS_Z) + (size_t)(gc * 128 + j) * ZC + Z_RV + h * 64 + e0;
    const u32x4 a = *(const u32x4*)zr, b = *(const u32x4*)(zr + 8);
#pragma unroll
    for (int i = 0; i < 4; ++i) { dst[j * 64 + e0 + 2 * i] = lo16(a[i]); dst[j * 64 + e0 + 2 * i + 1] = hi16(a[i]); dst[j * 64 + e0 + 8 + 2 * i] = lo16(b[i]); dst[j * 64 + e0 + 8 + 2 * i + 1] = hi16(b[i]); }
}
__device__ __forceinline__ void retkv_unit(unsigned char* lds, const P& p, int L, int gc, int h) {
    float* ks = (float*)lds; float* vs = ks + 128 * 33; float* wf = vs + 128 * 64; float* wb = wf + 128;
    const int tid = threadIdx.x;
    const float l2f = log2_gamma(p, L, 0, h), l2b = log2_gamma(p, L, 1, h);
    load_ret_qk(ks, p, gc, h, Z_RK, 0.17677669529663687f);
    load_ret_v(vs, p, gc, h);
    if (tid < 128) { wf[tid] = exp2f(l2f * (float)(127 - tid)); wb[tid] = exp2f(l2b * (float)tid); }
    __syncthreads();
    const int d = tid >> 4, e0 = (tid & 15) * 4;
    f32x4 af = (f32x4){0.f, 0.f, 0.f, 0.f}, ab = af;
    for (int j = 0; j < 128; ++j) {
        const float kd = ks[j * 33 + d]; const f32x4 v4 = *(const f32x4*)(vs + j * 64 + e0);
        af += (kd * wf[j]) * v4; ab += (kd * wb[j]) * v4;
    }
    float* KV = (float*)(p.ws + WS_KV) + ((size_t)(gc * 4 + h) * 2) * 2048;
    *(f32x4*)(KV + d * 64 + e0) = af; *(f32x4*)(KV + 2048 + d * 64 + e0) = ab;
    __syncthreads();
}
__device__ __forceinline__ void qproj_unit(unsigned char* lds, const P& p, int L, int mt, int nt) {
    const bf16_t* Z = (const bf16_t*)(p.ws + WS_Z); const bf16_t* W = (const bf16_t*)(p.ws + WS_WUQ) + (size_t)L * 768 * 256;
    bf16_t* Q = (bf16_t*)(p.ws + WS_Q); const float* rowss = (const float*)(lds + ROWSS_OFF);
    const float* ct = (const float*)(p.ws + WS_ROPE); const float* st = ct + 2048 * 16;
    auto rs = [&](int pr) { return Z + (size_t)(mt * 128 + pr) * ZC + Z_CQ; };
    auto epi = [&](int r, int c, f32x4 v) {
        const int row = mt * 128 + r, col = nt * 128 + c, j = col % 96;
        const float rstd = rsqrtf(rowss[r] * (1.f / 256.f) + NORM_EPS);
        v = v * rstd;
        if (j >= 64 && row < NLAT) {
            const int i = (j - 64) >> 1, pos = row & (SEQ - 1);
            const float c0 = ct[pos * 16 + i], s0 = st[pos * 16 + i], c1 = ct[pos * 16 + i + 1], s1 = st[pos * 16 + i + 1];
            const float a0 = v.x * c0 - v.y * s0, b0 = v.x * s0 + v.y * c0, a1 = v.z * c1 - v.w * s1, b1 = v.z * s1 + v.w * c1;
            v = (f32x4){a0, b0, a1, b1};
        }
        u32x2 w; w.x = pk2(v.x, v.y); w.y = pk2(v.z, v.w); *(u32x2*)(Q + (size_t)row * 768 + col) = w;
    };
    gemm_tile<true>(lds, rs, W + (size_t)nt * 128 * 256, 256, 256, epi);
}
__device__ __forceinline__ void kvproj_unit(unsigned char* lds, const P& p, int L, int mt, int nt) {
    const bf16_t* Z = (const bf16_t*)(p.ws + WS_Z); const bf16_t* W = (const bf16_t*)(p.ws + WS_WUKV) + (size_t)L * 1024 * 128;
    bf16_t* Kb = (bf16_t*)(p.ws + WS_K); bf16_t* Vb = (bf16_t*)(p.ws + WS_V); const float* rowss = (const float*)(lds + ROWSS_OFF);
    auto rs = [&](int pr) { return Z + (size_t)(mt * 128 + pr) * ZC + Z_CKV; };
    auto epi = [&](int r, int c, f32x4 v) {
        const int row = mt * 128 + r, col = nt * 128 + c, h = col >> 7, j = col & 127;
        const float rstd = rsqrtf(rowss[r] * (1.f / 128.f) + NORM_EPS);
        v = v * rstd;
        u32x2 w; w.x = pk2(v.x, v.y); w.y = pk2(v.z, v.w);
        if (j < 64) *(u32x2*)(Kb + (size_t)row * 768 + h * 96 + j) = w;
        else *(u32x2*)(Vb + (size_t)row * 512 + h * 64 + (j - 64)) = w;
    };
    gemm_tile<true>(lds, rs, W + (size_t)nt * 128 * 128, 128, 128, epi);
    if (nt == 0) {
        const int tid = threadIdx.x, r = tid >> 2, i0 = (tid & 3) * 4, row = mt * 128 + r;
        const bf16_t* zr = Z + (size_t)row * ZC + Z_KR;
        const u32x2 a = *(const u32x2*)(zr + i0), b = *(const u32x2*)(zr + 16 + i0);
        const float x1[4] = {lo16(a.x), hi16(a.x), lo16(a.y), hi16(a.y)}, x2[4] = {lo16(b.x), hi16(b.x), lo16(b.y), hi16(b.y)};
        const bool lat = row < NLAT; const int pos = row & (SEQ - 1);
        const float* ct = (const float*)(p.ws + WS_ROPE) + pos * 16 + i0; const float* st = ct + 2048 * 16;
        unsigned o[4];
#pragma unroll
        for (int i = 0; i < 4; ++i) { const float c = lat ? ct[i] : 1.f, s = lat ? st[i] : 0.f; o[i] = pk2(x1[i] * c - x2[i] * s, x1[i] * s + x2[i] * c); }
        u32x4 ov; ov.x = o[0]; ov.y = o[1]; ov.z = o[2]; ov.w = o[3];
#pragma unroll
        for (int h = 0; h < 8; ++h) *(u32x4*)(Kb + (size_t)row * 768 + h * 96 + 64 + 2 * i0) = ov;
    }
}
__device__ __forceinline__ void phase_b(unsigned char* lds, const P& p, int L) {
    const int G = gridDim.x, bid = blockIdx.x;
    const int nconv = (L == 0) ? 576 : 512;
    const int nkv = 288 * 4, nq = (NTOK / 128) * 6, nkvp = (NTOK / 128) * 8;
    const int total = nconv + nkv + nq + nkvp;
    for (int u = bid; u < total; u += G) {
        int r = u;
        if (r < nq) { qproj_unit(lds, p, L, r / 6, r % 6); continue; } r -= nq;
        if (r < nkvp) { kvproj_unit(lds, p, L, r / 8, r % 8); continue; } r -= nkvp;
        if (r < nconv) { if (r < 512) conv_unit(lds, p, L, r >> 5, r & 31); else conv_unit(lds, p, L, 16 + ((r - 512) >> 2), (r - 512) & 3); continue; } r -= nconv;
        retkv_unit(lds, p, L, r >> 2, r & 3);
    }
}

__device__ __forceinline__ void attn_unit_naive(unsigned char* lds, const P& p, int b, int h, int qb, bool ctxq) {
    float* Ks = (float*)lds;
    float* Vs = Ks + 64 * 96;
    const int tid = threadIdx.x, half = tid & 1, qi = tid >> 1;
    const bf16_t* Qb = (const bf16_t*)(p.ws + WS_Q); const bf16_t* Kb = (const bf16_t*)(p.ws + WS_K); const bf16_t* Vb = (const bf16_t*)(p.ws + WS_V);
    const int qrow = ctxq ? NLAT + b * CTXL + qi : b * SEQ + qb * 256 + qi;
    float q[48];
    {
        const u32x4* qp = (const u32x4*)(Qb + (size_t)qrow * 768 + h * 96 + half * 48);
#pragma unroll
        for (int i = 0; i < 6; ++i) { const u32x4 w = qp[i];
#pragma unroll
            for (int k = 0; k < 4; ++k) { q[i * 8 + 2 * k] = lo16(w[k]); q[i * 8 + 2 * k + 1] = hi16(w[k]); } }
    }
    float o[32];
#pragma unroll
    for (int e = 0; e < 32; ++e) o[e] = 0.f;
    float m = -1e30f, l = 0.f;
    const int ntiles = ctxq ? 4 : 36;
#pragma unroll 1
    for (int t = 0; t < ntiles; ++t) {
        const int krow0 = t < 4 ? NLAT + b * CTXL + t * 64 : b * SEQ + (t - 4) * 64;
        __syncthreads();
        for (int i = tid; i < 64 * 12; i += NTHREADS) { const int key = i / 12, c = i % 12; const u32x4 w = *(const u32x4*)(Kb + (size_t)(krow0 + key) * 768 + h * 96 + c * 8);
            float* d = Ks + key * 96 + c * 8;
#pragma unroll
            for (int k = 0; k < 4; ++k) { d[2 * k] = lo16(w[k]); d[2 * k + 1] = hi16(w[k]); } }
        for (int i = tid; i < 64 * 8; i += NTHREADS) { const int key = i >> 3, c = i & 7; const u32x4 w = *(const u32x4*)(Vb + (size_t)(krow0 + key) * 512 + h * 64 + c * 8);
            float* d = Vs + key * 64 + c * 8;
#pragma unroll
            for (int k = 0; k < 4; ++k) { d[2 * k] = lo16(w[k]); d[2 * k + 1] = hi16(w[k]); } }
        __syncthreads();
#pragma unroll 1
        for (int j0 = 0; j0 < 64; j0 += 2) {
            float s[2]; float mt = -1e30f;
#pragma unroll
            for (int jj = 0; jj < 2; ++jj) {
                const f32x4* kr = (const f32x4*)(Ks + (j0 + jj) * 96 + half * 48);
                float a = 0.f;
#pragma unroll
                for (int d4 = 0; d4 < 12; ++d4) { const f32x4 kv = kr[d4]; a += q[4 * d4] * kv.x + q[4 * d4 + 1] * kv.y + q[4 * d4 + 2] * kv.z + q[4 * d4 + 3] * kv.w; }
                a += __shfl_xor(a, 1);
                s[jj] = a; mt = fmaxf(mt, a);
            }
            const float mn = fmaxf(m, mt), alpha = exp2f(m - mn);
            m = mn; l *= alpha;
#pragma unroll
            for (int e = 0; e < 32; ++e) o[e] *= alpha;
#pragma unroll
            for (int jj = 0; jj < 2; ++jj) {
                const float pj = exp2f(s[jj] - mn); l += pj;
                const f32x4* vr = (const f32x4*)(Vs + (j0 + jj) * 64 + half * 32);
#pragma unroll
                for (int e4 = 0; e4 < 8; ++e4) { const f32x4 vv = vr[e4]; o[4 * e4] += pj * vv.x; o[4 * e4 + 1] += pj * vv.y; o[4 * e4 + 2] += pj * vv.z; o[4 * e4 + 3] += pj * vv.w; }
            }
        }
    }
    {
        const float rl = 1.f / l;
        u32x4* op = (u32x4*)((bf16_t*)(p.ws + WS_CC) + (size_t)qrow * D + 512 + h * 64 + half * 32);
#pragma unroll
        for (int i = 0; i < 4; ++i) { u32x4 w; w.x = pk2(o[8 * i] * rl, o[8 * i + 1] * rl); w.y = pk2(o[8 * i + 2] * rl, o[8 * i + 3] * rl); w.z = pk2(o[8 * i + 4] * rl, o[8 * i + 5] * rl); w.w = pk2(o[8 * i + 6] * rl, o[8 * i + 7] * rl); op[i] = w; }
    }
    __syncthreads();
}
__device__ __forceinline__ void retout_unit(unsigned char* lds, const P& p, int L, int gc, int h) {
    float* qs = (float*)lds; float* ks = qs + 128 * 33; float* vs = ks + 128 * 33; float* Sf = vs + 128 * 64; float* Sb = Sf + 2048;
    const int tid = threadIdx.x;
    const float l2f = log2_gamma(p, L, 0, h), l2b = log2_gamma(p, L, 1, h);
    load_ret_qk(qs, p, gc, h, Z_RQ, 1.f);
    load_ret_qk(ks, p, gc, h, Z_RK, 0.17677669529663687f);
    load_ret_v(vs, p, gc, h);
    {
        const bool lat = gc < 256; const int b = lat ? gc >> 4 : (gc - 256) >> 1;
        const int mme = lat ? 2 + (gc & 15) : (gc - 256) & 1;
        const int u = mme, w = mme < 2 ? 1 - mme : 19 - mme;
        f32x4 sf = (f32x4){0.f, 0.f, 0.f, 0.f}, sb = sf;
        const float* KVb = (const float*)(p.ws + WS_KV);
#pragma unroll 1
        for (int mm = 0; mm < 18; ++mm) {
            const int gcm = mm < 2 ? 256 + b * 2 + mm : b * 16 + (mm - 2);
            const int um = mm, wm = mm < 2 ? 1 - mm : 19 - mm;
            const float* kv = KVb + ((size_t)(gcm * 4 + h) * 2) * 2048 + tid * 4;
            if (um < u) { const float wgt = exp2f(l2f * 128.f * (float)(u - 1 - um)); sf += wgt * *(const f32x4*)kv; }
            if (wm < w) { const float wgt = exp2f(l2b * 128.f * (float)(w - 1 - wm)); sb += wgt * *(const f32x4*)(kv + 2048); }
        }
        *(f32x4*)(Sf + tid * 4) = sf; *(f32x4*)(Sb + tid * 4) = sb;
    }
    __syncthreads();
    const int i = tid >> 2, e0 = (tid & 3) * 16;
    float q[32];
#pragma unroll
    for (int d = 0; d < 32; ++d) q[d] = qs[i * 33 + d];
    float acc[16];
#pragma unroll
    for (int e = 0; e < 16; ++e) acc[e] = 0.f;
#pragma unroll 1
    for (int j = 0; j < 128; ++j) {
        float s = 0.f;
#pragma unroll
        for (int d = 0; d < 32; ++d) s += q[d] * ks[j * 33 + d];
        float wgt = 0.f;
        if (j <= i) wgt += exp2f(l2f * (float)(i - j));
        if (j >= i) wgt += exp2f(l2b * (float)(j - i));
        s *= wgt;
#pragma unroll
        for (int e4 = 0; e4 < 4; ++e4) { const f32x4 v4 = *(const f32x4*)(vs + j * 64 + e0 + 4 * e4); acc[4 * e4] += s * v4.x; acc[4 * e4 + 1] += s * v4.y; acc[4 * e4 + 2] += s * v4.z; acc[4 * e4 + 3] += s * v4.w; }
    }
    {
        const float cf = exp2f(l2f * (float)(i + 1)), cb = exp2f(l2b * (float)(128 - i));
#pragma unroll 2
        for (int d = 0; d < 32; ++d) {
            const float qd = qs[i * 33 + d]; const float qf = qd * cf, qb = qd * cb;
#pragma unroll
            for (int e4 = 0; e4 < 4; ++e4) { const f32x4 a = *(const f32x4*)(Sf + d * 64 + e0 + 4 * e4), bq = *(const f32x4*)(Sb + d * 64 + e0 + 4 * e4);
                acc[4 * e4] += qf * a.x + qb * bq.x; acc[4 * e4 + 1] += qf * a.y + qb * bq.y; acc[4 * e4 + 2] += qf * a.z + qb * bq.z; acc[4 * e4 + 3] += qf * a.w + qb * bq.w; }
        }
    }
    float s1 = 0.f;
#pragma unroll
    for (int e = 0; e < 16; ++e) s1 += acc[e];
    s1 += __shfl_xor(s1, 1); s1 += __shfl_xor(s1, 2);
    const float mu = s1 * (1.f / 64.f);
    float s2 = 0.f;
#pragma unroll
    for (int e = 0; e < 16; ++e) { const float dd = acc[e] - mu; s2 += dd * dd; }
    s2 += __shfl_xor(s2, 1); s2 += __shfl_xor(s2, 2);
    const float rstd = rsqrtf(s2 * (1.f / 64.f) + NORM_EPS);
    const int row = gc * 128 + i;
    const bf16_t* zg = (const bf16_t*)(p.ws + WS_Z) + (size_t)row * ZC + Z_RG + h * 64 + e0;
    const float* gw = p.in[13] + L * 256 + h * 64 + e0;
    const u32x4 g0 = *(const u32x4*)zg, g1 = *(const u32x4*)(zg + 8);
    float g[16];
#pragma unroll
    for (int k = 0; k < 4; ++k) { g[2 * k] = lo16(g0[k]); g[2 * k + 1] = hi16(g0[k]); g[8 + 2 * k] = lo16(g1[k]); g[8 + 2 * k + 1] = hi16(g1[k]); }
    unsigned o[8];
#pragma unroll
    for (int k = 0; k < 8; ++k) {
        const float y0 = siluf(g[2 * k]) * ((acc[2 * k] - mu) * rstd * gw[2 * k]), y1 = siluf(g[2 * k + 1]) * ((acc[2 * k + 1] - mu) * rstd * gw[2 * k + 1]);
        o[k] = pk2(y0, y1);
    }
    u32x4* op = (u32x4*)((bf16_t*)(p.ws + WS_CC) + (size_t)row * D + 256 + h * 64 + e0);
    u32x4 w0; w0.x = o[0]; w0.y = o[1]; w0.z = o[2]; w0.w = o[3]; u32x4 w1; w1.x = o[4]; w1.y = o[5]; w1.z = o[6]; w1.w = o[7];
    op[0] = w0; op[1] = w1;
    __syncthreads();
}
__device__ __forceinline__ void phase_c(unsigned char* lds, const P& p, int L) {
    const int G = gridDim.x, bid = blockIdx.x;
    const int nat = 16 * 8 * 8, nac = (L == 0) ? 128 : 0, nro = (L == 0 ? 288 : 256) * 4;
    const int total = nat + nac + nro;
    for (int u = bid; u < total; u += G) {
        int r = u;
#ifndef TEST_C
#define TEST_C 3
#endif
        if (r < nat) { if (TEST_C & 1) attn_unit_naive(lds, p, r >> 6, (r >> 3) & 7, r & 7, false); continue; } r -= nat;
        if (r < nac) { if (TEST_C & 1) attn_unit_naive(lds, p, r >> 3, r & 7, 0, true); continue; } r -= nac;
        if (TEST_C & 2) retout_unit(lds, p, L, r >> 2, r & 3);
    }
}

__device__ __forceinline__ void phase_d(unsigned char* lds, const P& p, int L) {
    const bf16_t* CC = (const bf16_t*)(p.ws + WS_CC); const bf16_t* W = (const bf16_t*)(p.ws + WS_WOUT) + (size_t)L * D * D;
    const float* modv = (const float*)(p.ws + WS_MODV) + (size_t)L * 17 * 6144;
    const int nmt = (L == 0 ? NTOK : NLAT) / 128, NU = nmt * 8;
    for (int u = blockIdx.x; u < NU; u += gridDim.x) {
        const int mt = u >> 3, nt = u & 7;
        auto rs = [&](int pr) { return CC + (size_t)(mt * 128 + pr) * D; };
        auto epi = [&](int r, int c, f32x4 v) {
            const int row = mt * 128 + r, col = nt * 128 + c;
            const f32x4 g = *(const f32x4*)(modv + (size_t)mod_row(row) * 6144 + 2048 + col);
            f32x4* xp = (f32x4*)(x_row(p, row) + col);
            *xp = *xp + g * v;
        };
        gemm_tile<false>(lds, rs, W + (size_t)nt * 128 * D, D, D, epi);
    }
}

__device__ __forceinline__ void phase_router(unsigned char* lds, const P& p, int L) {
    const bf16_t* H = (const bf16_t*)(p.ws + WS_H); const bf16_t* W = (const bf16_t*)(p.ws + WS_RT) + (size_t)L * 128 * D;
    float* lg = (float*)(lds + LG_OFF);
    unsigned* ecnt = (unsigned*)(p.ws + WS_CTL) + CW_ECNT + L * 4096;
    int* ltok = (int*)(p.ws + WS_LTOK); float* lw = (float*)(p.ws + WS_LW);
    const int tid = threadIdx.x, lane = tid & 63, wave = tid >> 6;
    const float rb = p.in[21][L * NEXP + lane];
    const int nmt = (L == 0 ? NTOK : NLAT) / 128;
    for (int mt = blockIdx.x; mt < nmt; mt += gridDim.x) {
        auto rs = [&](int pr) { return H + (size_t)(mt * 128 + pr) * D; };
        auto epi = [&](int r, int c, f32x4 v) { if (c < 64) *(f32x4*)(lg + r * 64 + c) = v; };
        gemm_tile<false>(lds, rs, W, D, D, epi);
        __syncthreads();
        for (int q = 0; q < 16; ++q) {
            const int tl = wave * 16 + q, tok = mt * 128 + tl;
            const float x = lg[tl * 64 + lane];
            const float sc = 1.f / (1.f + expf(-x));
            float sel = sc + rb; float wsum = 0.f; int myk = -1;
#pragma unroll
            for (int k = 0; k < TOPK; ++k) {
                float bv = sel; int bi = lane;
#pragma unroll
                for (int off = 32; off >= 1; off >>= 1) {
                    const float ov = __shfl_xor(bv, off); const int oi = __shfl_xor(bi, off);
                    if (ov > bv || (ov == bv && oi < bi)) { bv = ov; bi = oi; }
                }
                wsum += __shfl(sc, bi);
                if (lane == bi) { myk = k; sel = -INFINITY; }
            }
            if (myk >= 0) {
                const unsigned pos = atomicAdd(ecnt + lane * 64, 1u);
                ltok[(size_t)lane * LCAP + pos] = tok * 8 + myk;
                lw[(size_t)lane * LCAP + pos] = sc / wsum * 2.5f;
            }
        }
    }
}

__device__ __forceinline__ int build_etab(unsigned char* lds, const P& p, int L) {
    int* tstart = (int*)(lds + ETAB_OFF); int* cnt = tstart + 80;
    unsigned* ecnt = (unsigned*)(p.ws + WS_CTL) + CW_ECNT + L * 4096;
    __syncthreads();
    if (threadIdx.x < 64) cnt[threadIdx.x] = (int)__hip_atomic_load(ecnt + threadIdx.x * 64, __ATOMIC_RELAXED, __HIP_MEMORY_SCOPE_AGENT);
    __syncthreads();
    if (threadIdx.x == 0) { int s = 0; for (int e = 0; e < 64; ++e) { tstart[e] = s; s += (cnt[e] + 127) >> 7; } tstart[64] = s; }
    __syncthreads();
    return tstart[64];
}
__device__ __forceinline__ int find_expert(const int* tstart, int t) {
    int lo = 0, hi = 63;
    while (lo < hi) { const int mid = (lo + hi + 1) >> 1; if (tstart[mid] <= t) lo = mid; else hi = mid - 1; }
    return lo;
}
__device__ __forceinline__ void phase_gateup(unsigned char* lds, const P& p, int L) {
    const int TR = build_etab(lds, p, L);
    const int* tstart = (const int*)(lds + ETAB_OFF); const int* cnt = tstart + 80;
    const bf16_t* H = (const bf16_t*)(p.ws + WS_H);
    const int* ltok = (const int*)(p.ws + WS_LTOK); const float* lw = (const float*)(p.ws + WS_LW);
    bf16_t* ACT = (bf16_t*)(p.ws + WS_ACT); bf16_t* ACTSH = (bf16_t*)(p.ws + WS_ACTSH);
    const int ntok = (L == 0 ? NTOK : NLAT), nsh = (ntok / 128) * 4, NU = TR * 4 + nsh;
    for (int u = blockIdx.x; u < NU; u += gridDim.x) {
        if (u < TR * 4) {
            const int t = u >> 2, nt = u & 3, e = find_expert(tstart, t), mt = t - tstart[e], ce = cnt[e];
            const int* le = ltok + (size_t)e * LCAP; const float* we = lw + (size_t)e * LCAP;
            auto rs = [&](int pr) { const int lp = mt * 128 + pr; const int tok = lp < ce ? (le[lp] >> 3) : 0; return H + (size_t)tok * D; };
            auto epi = [&](int r, int c, f32x4 v) {
                const int lp = mt * 128 + r;
                const float wgt = lp < ce ? we[lp] : 0.f;
                const float a0 = siluf(v.x) * v.y * wgt, a1 = siluf(v.z) * v.w * wgt;
                *(unsigned*)(ACT + (size_t)(t * 128 + r) * EDIM + ((nt * 128 + c) >> 1)) = pk2(a0, a1);
            };
            gemm_tile<false>(lds, rs, (const bf16_t*)(p.ws + WS_EGU) + ((size_t)e * 512 + nt * 128) * D, D, D, epi);
        } else {
            const int r2 = u - TR * 4, mt = r2 >> 2, nt = r2 & 3;
            auto rs = [&](int pr) { return H + (size_t)(mt * 128 + pr) * D; };
            auto epi = [&](int r, int c, f32x4 v) {
                const float a0 = siluf(v.x) * v.y, a1 = siluf(v.z) * v.w;
                *(unsigned*)(ACTSH + (size_t)(mt * 128 + r) * EDIM + ((nt * 128 + c) >> 1)) = pk2(a0, a1);
            };
            gemm_tile<false>(lds, rs, (const bf16_t*)(p.ws + WS_SHGU) + ((size_t)L * 512 + nt * 128) * D, D, D, epi);
        }
    }
}
__device__ __forceinline__ void phase_down(unsigned char* lds, const P& p, int L, int cc) {
    const int TR = build_etab(lds, p, L);
    const int* tstart = (const int*)(lds + ETAB_OFF); const int* cnt = tstart + 80;
    const int* ltok = (const int*)(p.ws + WS_LTOK);
    const bf16_t* ACT = (const bf16_t*)(p.ws + WS_ACT); bf16_t* SLOT = (bf16_t*)(p.ws + WS_SLOT);
    const int NU = TR * 2;
    for (int u = blockIdx.x; u < NU; u += gridDim.x) {
        const int t = u >> 1, n2 = u & 1, e = find_expert(tstart, t), mt = t - tstart[e], ce = cnt[e];
        const int* le = ltok + (size_t)e * LCAP;
        auto rs = [&](int pr) { return ACT + (size_t)(t * 128 + pr) * EDIM; };
        auto epi = [&](int r, int c, f32x4 v) {
            const int lp = mt * 128 + r;
            if (lp < ce) { const int ent = le[lp]; const int srow = (ent >> 3) * TOPK + (ent & 7);
                u32x2 w; w.x = pk2(v.x, v.y); w.y = pk2(v.z, v.w); *(u32x2*)(SLOT + (size_t)srow * 256 + n2 * 128 + c) = w; }
        };
        gemm_tile<false>(lds, rs, (const bf16_t*)(p.ws + WS_ED) + ((size_t)e * D + cc * 256 + n2 * 128) * EDIM, EDIM, EDIM, epi);
    }
}
__device__ __forceinline__ void phase_combine(unsigned char* lds, const P& p, int L, int cc) {
    const bf16_t* ACTSH = (const bf16_t*)(p.ws + WS_ACTSH); const bf16_t* SLOT = (const bf16_t*)(p.ws + WS_SLOT);
    const float* modv = (const float*)(p.ws + WS_MODV) + (size_t)L * 17 * 6144;
    const int ntok = (L == 0 ? NTOK : NLAT), NU = (ntok / 128) * 2;
    for (int u = blockIdx.x; u < NU; u += gridDim.x) {
        const int mt = u >> 1, n2 = u & 1;
        auto rs = [&](int pr) { return ACTSH + (size_t)(mt * 128 + pr) * EDIM; };
        auto epi = [&](int r, int c, f32x4 v) {
            const int row = mt * 128 + r, lc = n2 * 128 + c, col = cc * 256 + lc;
#pragma unroll
            for (int k = 0; k < TOPK; ++k) { const u32x2 w = *(const u32x2*)(SLOT + (size_t)(row * TOPK + k) * 256 + lc); v.x += lo16(w.x); v.y += hi16(w.x); v.z += lo16(w.y); v.w += hi16(w.y); }
            const f32x4 g = *(const f32x4*)(modv + (size_t)mod_row(row) * 6144 + 5120 + col);
            f32x4* xp = (f32x4*)(x_row(p, row) + col);
            *xp = *xp + g * v;
        };
        gemm_tile<false>(lds, rs, (const bf16_t*)(p.ws + WS_SHD) + ((size_t)L * D + cc * 256 + n2 * 128) * EDIM, EDIM, EDIM, epi);
    }
}
__device__ __forceinline__ void phase_final(const P& p) {
    const int tid = threadIdx.x, lane = tid & 63, wave = tid >> 6, gw = blockIdx.x * NWAVES + wave, NGW = gridDim.x * NWAVES;
    const float* nw = p.in[28];
    for (int tok = gw; tok < NLAT; tok += NGW) {
        f32x4* xr = (f32x4*)(p.out + (size_t)tok * D) + lane;
        f32x4 v[4]; float s = 0.f;
#pragma unroll
        for (int j = 0; j < 4; ++j) { v[j] = xr[64 * j]; s += v[j].x * v[j].x + v[j].y * v[j].y + v[j].z * v[j].z + v[j].w * v[j].w; }
        const float rstd = rsqrtf(wave_sum(s) * (1.f / D) + NORM_EPS);
#pragma unroll
        for (int j = 0; j < 4; ++j) { const f32x4 w4 = *(const f32x4*)(nw + 4 * lane + 256 * j); xr[64 * j] = v[j] * rstd * w4; }
    }
}

constexpr int PH_LAYER0 = 2, PH_PER_LAYER = 15, PH_T0 = PH_LAYER0 + PH_PER_LAYER, PH_LAYER1 = PH_T0 + 1, PH_FINAL = PH_LAYER1 + PH_PER_LAYER, NPHASES = PH_FINAL + 1;

__global__ void __launch_bounds__(NTHREADS, 2) mk_fwd(P p) {
    extern __shared__ __attribute__((aligned(16))) unsigned char lds[];
    volatile LAS unsigned* MISC = (volatile LAS unsigned*)((LAS unsigned char*)lds + MISC_OFF);
    if (threadIdx.x < 64) MISC[threadIdx.x] = 0u;
    __syncthreads();
    unsigned* ctl = (unsigned*)(p.ws + WS_CTL);
    XcdBarrier bar; bar.bar = ctl + CW_BAR; bar.x = 0; bar.st = MISC + 8;
    if (!MK_PER_PHASE) bar = xcd_barrier_post(ctl + CW_BAR, MISC + 8);
    const int lo = p.ph_lo, hi = p.ph_hi;
#ifndef PH_MASK
#define PH_MASK 0xffffu
#endif
#define HAS(b) ((PH_MASK >> (b)) & 1u)
#define IN(k) (lo <= (k) && (k) < hi)
#define SEAM(k) do { if (IN(k) && IN((k) + 1)) xcd_barrier(bar); } while (0)

    if (HAS(0) && IN(0)) { phase_prep(lds, p); } SEAM(0);
    if (HAS(1) && IN(1)) { phase_norm_mod(p, 0, 0, NTOK); } SEAM(1);
#define DOWN_COMBINE(L, pb, cc) \
        if (HAS(9) && IN(pb + 7 + 2 * cc)) { phase_down(lds, p, L, cc); } SEAM(pb + 7 + 2 * cc); \
        if (HAS(10) && IN(pb + 8 + 2 * cc)) { phase_combine(lds, p, L, cc); } SEAM(pb + 8 + 2 * cc);
#define LAYER(L, pb, ntok) \
        if (HAS(2) && IN(pb + 0)) { phase_zgemm(lds, p, L); } SEAM(pb + 0); \
        if (HAS(3) && IN(pb + 1)) { phase_b(lds, p, L); } SEAM(pb + 1); \
        if (HAS(4) && IN(pb + 2)) { phase_c(lds, p, L); } SEAM(pb + 2); \
        if (HAS(5) && IN(pb + 3)) { phase_d(lds, p, L); } SEAM(pb + 3); \
        if (HAS(6) && IN(pb + 4)) { phase_norm_mod(p, L, 1, ntok); } SEAM(pb + 4); \
        if (HAS(7) && IN(pb + 5)) { phase_router(lds, p, L); } SEAM(pb + 5); \
        if (HAS(8) && IN(pb + 6)) { phase_gateup(lds, p, L); } SEAM(pb + 6); \
        DOWN_COMBINE(L, pb, 0) DOWN_COMBINE(L, pb, 1) DOWN_COMBINE(L, pb, 2) DOWN_COMBINE(L, pb, 3)
    LAYER(0, PH_LAYER0, NTOK)
    if (HAS(11) && IN(PH_T0)) { convert_expert_weights(lds, p, 1); phase_norm_mod(p, 1, 0, NTOK); } SEAM(PH_T0);
    LAYER(1, PH_LAYER1, NLAT)
    if (HAS(12) && IN(PH_FINAL)) { phase_final(p); }
#undef IN
#undef SEAM
}

extern "C" void kernel_launch(void* const* d_in, const int* in_sizes, int n_in, void* d_out, int out_size, void* d_ws, size_t ws_size, hipStream_t stream) {
    static int grid = 0;
    if (grid == 0) {
        if (n_in != 29 || in_sizes[0] != NLAT * D || out_size != NLAT * D || ws_size < WS_END) {
            fprintf(stderr, "kernel_launch: unexpected shapes / workspace (n_in %d, ws %zu, need %zu); nothing launched\n", n_in, ws_size, (size_t)WS_END); grid = -1; return; }
        int dev = 0, cus = 0, per_cu = 0;
        if (hipGetDevice(&dev) != hipSuccess || hipDeviceGetAttribute(&cus, hipDeviceAttributeMultiprocessorCount, dev) != hipSuccess) { grid = -1; return; }
        if (hipFuncSetAttribute((const void*)mk_fwd, hipFuncAttributeMaxDynamicSharedMemorySize, LDS_BYTES) != hipSuccess) { grid = -1; return; }
        if (hipOccupancyMaxActiveBlocksPerMultiprocessor(&per_cu, (const void*)mk_fwd, NTHREADS, LDS_BYTES) != hipSuccess || per_cu < 1) { fprintf(stderr, "kernel_launch: occupancy query says %d\n", per_cu); }
        (void)hipGetLastError();
        grid = cus;
    }
    if (grid < 0) return;
    (void)hipMemsetAsync((char*)d_ws + WS_CTL, 0, CTL_ZERO_BYTES, stream);
    P a{};
    for (int i = 0; i < 29; ++i) a.in[i] = (const float*)d_in[i];
    a.out = (float*)d_out; a.ws = (unsigned char*)d_ws;
#if MK_PER_PHASE
    for (int ph = 0; ph < NPHASES; ++ph) { a.ph_lo = ph; a.ph_hi = ph + 1; hipLaunchKernelGGL(mk_fwd, dim3(grid), dim3(NTHREADS), LDS_BYTES, stream, a); }
#else
    a.ph_lo = 0; a.ph_hi = NPHASES;
    hipLaunchKernelGGL(mk_fwd, dim3(grid), dim3(NTHREADS), LDS_BYTES, stream, a);
#endif
}
```

```cpp
#include <hip/hip_runtime.h>
#include <cstdio>
#include <cstdint>

#ifndef MK_PER_PHASE
#define MK_PER_PHASE 0
#endif

typedef unsigned short bf16_t;
typedef short bf16x8 __attribute__((ext_vector_type(8)));
typedef float f32x4 __attribute__((ext_vector_type(4)));
typedef unsigned u32x4 __attribute__((ext_vector_type(4)));
typedef unsigned u32x2 __attribute__((ext_vector_type(2)));
#define LAS __attribute__((address_space(3)))

constexpr int D = 1024, BATCH = 16, SEQ = 2048, CTXL = 256;
constexpr int NLAT = BATCH * SEQ, NCTX = BATCH * CTXL, NTOK = NLAT + NCTX;
constexpr int ZC = 1792;
constexpr int Z_RQ = 512, Z_RK = 640, Z_RV = 768, Z_RG = 1024, Z_CQ = 1280, Z_CKV = 1536, Z_KR = 1664, Z_END = 1696;
constexpr int NEXP = 64, TOPK = 6, EDIM = 256;
constexpr int LCAP = NTOK;
constexpr float NORM_EPS = 1e-6f;
constexpr int NTHREADS = 512, NWAVES = 8;

constexpr size_t MiB = 1u << 20;
constexpr size_t WS_CTL = 0, CTL_ZERO_BYTES = 1 * MiB;
constexpr size_t WS_MODV = 1 * MiB;
constexpr size_t WS_ROPE = 2 * MiB;
constexpr size_t WS_WIN = 3 * MiB;
constexpr size_t WS_WUQ = 10 * MiB;
constexpr size_t WS_WUKV = 11 * MiB;
constexpr size_t WS_WOUT = 12 * MiB;
constexpr size_t WS_RT = 16 * MiB;
constexpr size_t WS_SHGU = 17 * MiB;
constexpr size_t WS_SHD = 19 * MiB;
constexpr size_t WS_EGU = 20 * MiB;
constexpr size_t WS_ED = 84 * MiB;
constexpr size_t WS_XC = 116 * MiB;
constexpr size_t WS_H = 132 * MiB;
constexpr size_t WS_KV = WS_H;
constexpr size_t WS_R = 204 * MiB;
constexpr size_t WS_Z = WS_R;
constexpr size_t WS_Q = WS_R + 126 * MiB;
constexpr size_t WS_K = WS_R + 180 * MiB;
constexpr size_t WS_V = WS_R + 234 * MiB;
constexpr size_t WS_CC = WS_R + 270 * MiB;
constexpr size_t WS_LTOK = WS_R;
constexpr size_t WS_LW = WS_R + 9 * MiB;
constexpr size_t WS_ACT = WS_R + 18 * MiB;
constexpr size_t WS_ACTSH = WS_R + 130 * MiB;
constexpr size_t WS_SLOT = WS_R + 148 * MiB;
constexpr size_t WS_END = WS_R + 342 * MiB;
static_assert(WS_SLOT + (size_t)NTOK * 6 * 256 * 2 <= WS_CC, "slots end before CC");

constexpr int CW_TMO = 0;
constexpr int CW_BAR = 4096;
constexpr int CW_ECNT = 8192;

constexpr int LDS_BYTES = 147456;
constexpr int MISC_OFF = LDS_BYTES - 256;
constexpr int ETAB_OFF = 143360;
constexpr int GEMM_LDS = 36864;
constexpr int ROWSS_OFF = 36864;
constexpr int LG_OFF = 37376;

#define XB_TMO      128
#define XB_XCNT(j)  (256  + 64 * (j))
#define XB_XSUB(j)  (1280 + 64 * (j))
#define XB_XGEN(j)  (2304 + 64 * (j))
#define XB_TOP      3328
#define XB_TOPGEN   3392
#define XCD_BAR_WORDS 3456
#define XB_SPIN_CAP (1u << 24)
__device__ __forceinline__ unsigned xb_ld(unsigned* p)              { return __hip_atomic_load(p, __ATOMIC_RELAXED, __HIP_MEMORY_SCOPE_AGENT); }
__device__ __forceinline__ unsigned xb_add(unsigned* p, unsigned v) { return __hip_atomic_fetch_add(p, v, __ATOMIC_RELAXED, __HIP_MEMORY_SCOPE_AGENT); }
__device__ __forceinline__ unsigned xb_xcc_id() { return (unsigned)__builtin_amdgcn_s_getreg((3 << 11) | 20) & 0xFu; }
#define XB_SPIN(cond, bar) do { unsigned _sp = 0; while (cond) { __builtin_amdgcn_s_sleep(1); \
    if ((++_sp & 255u) == 0u) { if (xb_ld(&(bar)[XB_TMO])) break; if (_sp > XB_SPIN_CAP) { atomicAdd(&(bar)[XB_TMO], 1u); break; } } } } while (0)
struct XcdBarrier { unsigned* bar; unsigned x; volatile LAS unsigned* st; };
__device__ __forceinline__ XcdBarrier xcd_barrier_post(unsigned* bar, volatile LAS unsigned* st) {
    XcdBarrier b; b.bar = bar; b.x = xb_xcc_id(); b.st = st;
    if (threadIdx.x == 0) (void)xb_add(&bar[XB_XCNT(b.x)], 1u);
    return b;
}
__device__ __forceinline__ void xcd_barrier_complete(unsigned* bar, unsigned x, unsigned& nloc, unsigned& nx) {
    const unsigned G = gridDim.x * gridDim.y * gridDim.z;
    unsigned sum, cnt, mine, sp = 0u;
    for (;;) {
        sum = 0u; cnt = 0u; mine = 0u;
#pragma unroll
        for (unsigned j = 0; j < 16; ++j) { const unsigned c = xb_ld(&bar[XB_XCNT(j)]); sum += c; cnt += (c > 0u) ? 1u : 0u; mine = (j == x) ? c : mine; }
        if (sum == G) break;
        __builtin_amdgcn_s_sleep(1);
        if ((++sp & 255u) == 0u) { if (xb_ld(&bar[XB_TMO])) break; if (sp > XB_SPIN_CAP) { atomicAdd(&bar[XB_TMO], 1u); break; } }
    }
    nloc = mine > 0u ? mine : 1u; nx = cnt > 0u ? cnt : 1u;
}
__device__ __forceinline__ void xcd_barrier(const XcdBarrier& b) {
    asm volatile("s_waitcnt vmcnt(0)" ::: "memory");
    __syncthreads();
    if (threadIdx.x == 0) {
        unsigned* bar = b.bar;
        __builtin_amdgcn_s_waitcnt(0);
        unsigned nloc = b.st[0], nx = b.st[1];
        if (nloc == 0u) { xcd_barrier_complete(bar, b.x, nloc, nx); b.st[0] = nloc; b.st[1] = nx; }
        const unsigned old = xb_add(&bar[XB_XSUB(b.x)], 1u);
        const unsigned gen = old / nloc;
        if (old + 1u == (gen + 1u) * nloc) {
            __builtin_amdgcn_fence(__ATOMIC_RELEASE, "agent");
            asm volatile("s_waitcnt vmcnt(0)" ::: "memory");
            const unsigned og = xb_add(&bar[XB_TOP], 1u);
            const unsigned tg = og / nx;
            if (og + 1u == (tg + 1u) * nx) xb_add(&bar[XB_TOPGEN], 1u);
            else XB_SPIN(xb_ld(&bar[XB_TOPGEN]) == tg, bar);
            __builtin_amdgcn_fence(__ATOMIC_ACQUIRE, "agent");
            xb_add(&bar[XB_XGEN(b.x)], 1u);
            asm volatile("s_waitcnt vmcnt(0)" ::: "memory");
        } else {
            XB_SPIN(xb_ld(&bar[XB_XGEN(b.x)]) == gen, bar);
            __builtin_amdgcn_fence(__ATOMIC_ACQUIRE, "agent");
            asm volatile("s_waitcnt vmcnt(0)" ::: "memory");
        }
    }
    __syncthreads();
}

__device__ __forceinline__ float bf2f(unsigned h) { return __uint_as_float(h << 16); }
__device__ __forceinline__ unsigned f2bf(float f) { unsigned u = __float_as_uint(f); return (u + 0x7fffu + ((u >> 16) & 1u)) >> 16; }
__device__ __forceinline__ unsigned pk2(float lo, float hi) { return f2bf(lo) | (f2bf(hi) << 16); }
__device__ __forceinline__ float lo16(unsigned w) { return __uint_as_float(w << 16); }
__device__ __forceinline__ float hi16(unsigned w) { return __uint_as_float(w & 0xffff0000u); }
__device__ __forceinline__ float wave_sum(float v) {
#pragma unroll
    for (int o = 1; o < 64; o <<= 1) v += __shfl_xor(v, o);
    return v;
}
__device__ __forceinline__ float siluf(float v) { return v / (1.f + __expf(-v)); }
__device__ __forceinline__ int mod_row(int tok) { return tok < NLAT ? (tok >> 11) : 16; }

struct P { const float* in[29]; float* out; unsigned char* ws; int ph_lo, ph_hi; };

__device__ __forceinline__ float* x_row(const P& p, int tok) {
    return tok < NLAT ? p.out + (size_t)tok * D : (float*)(p.ws + WS_XC) + (size_t)(tok - NLAT) * D;
}

template <bool ROWSS, class RowSrc, class Epi>
__device__ __forceinline__ void gemm_tile(unsigned char* lds, const RowSrc& rs, const bf16_t* Bt, int ldb, int K, const Epi& epi) {
    const int tid = threadIdx.x, lane = tid & 63, wid = tid >> 6, wr = wid >> 2, wc = wid & 3, fr = lane & 15, fq = lane >> 4;
    bf16_t* As = (bf16_t*)lds; bf16_t* Bs = As + 128 * 72;
    float* rowss = (float*)(lds + ROWSS_OFF);
    const int lr = tid >> 2, lc = (tid & 3) * 16;
    const bf16_t* ap = rs(lr) + lc;
    const bf16_t* bp = Bt + (size_t)lr * ldb + lc;
    u32x4 a0 = *(const u32x4*)ap, a1 = *(const u32x4*)(ap + 8), b0 = *(const u32x4*)bp, b1 = *(const u32x4*)(bp + 8);
    f32x4 acc[4][2];
#pragma unroll
    for (int m = 0; m < 4; ++m)
#pragma unroll
        for (int n = 0; n < 2; ++n) acc[m][n] = (f32x4){0.f, 0.f, 0.f, 0.f};
    float ss = 0.f;
    for (int k0 = 0; k0 < K; k0 += 64) {
        __syncthreads();
        *(u32x4*)(As + lr * 72 + lc) = a0; *(u32x4*)(As + lr * 72 + lc + 8) = a1;
        *(u32x4*)(Bs + lr * 72 + lc) = b0; *(u32x4*)(Bs + lr * 72 + lc + 8) = b1;
        if (ROWSS) {
#pragma unroll
            for (int i = 0; i < 4; ++i) { float x0 = lo16(a0[i]), x1 = hi16(a0[i]), y0 = lo16(a1[i]), y1 = hi16(a1[i]); ss += x0 * x0 + x1 * x1 + y0 * y0 + y1 * y1; }
        }
        __syncthreads();
        if (k0 + 64 < K) { ap += 64; bp += 64; a0 = *(const u32x4*)ap; a1 = *(const u32x4*)(ap + 8); b0 = *(const u32x4*)bp; b1 = *(const u32x4*)(bp + 8); }
#pragma unroll
        for (int kk = 0; kk < 2; ++kk) {
            bf16x8 af[4], bfr[2];
#pragma unroll
            for (int m = 0; m < 4; ++m) af[m] = *(const bf16x8*)(As + (wr * 64 + m * 16 + fr) * 72 + kk * 32 + fq * 8);
#pragma unroll
            for (int n = 0; n < 2; ++n) bfr[n] = *(const bf16x8*)(Bs + (wc * 32 + n * 16 + fr) * 72 + kk * 32 + fq * 8);
#pragma unroll
            for (int m = 0; m < 4; ++m)
#pragma unroll
                for (int n = 0; n < 2; ++n) acc[m][n] = __builtin_amdgcn_mfma_f32_16x16x32_bf16(bfr[n], af[m], acc[m][n], 0, 0, 0);
        }
    }
    if (ROWSS) {
        ss += __shfl_xor(ss, 1); ss += __shfl_xor(ss, 2);
        if ((tid & 3) == 0) rowss[lr] = ss;
        __syncthreads();
    }
#pragma unroll
    for (int m = 0; m < 4; ++m)
#pragma unroll
        for (int n = 0; n < 2; ++n) epi(wr * 64 + m * 16 + fr, wc * 32 + n * 16 + 4 * fq, acc[m][n]);
}

struct TMap { const float* s0; const float* s1; int ld; int nvalid; const float* ksc; float gsc; };
template <int MODE> __device__ __forceinline__ const float* tmap_src(const float* s0, const float* s1, int nvalid, int n) {
    if (MODE == 0) return n < nvalid ? s0 + n : nullptr;
    if (MODE == 1) { const int h = n / 96, j = n % 96; const int c = j < 64 ? j : 64 + ((j - 64) & 1) * 16 + ((j - 64) >> 1); return s0 + h * 96 + c; }
    return ((n & 1) ? s1 : s0) + (n >> 1);
}
template <int MODE> __device__ __forceinline__ void transpose_unit(float* scr, const float* s0, const float* s1, int ld, int nvalid, const float* ksc, float gsc, int K, bf16_t* dst, int kb, int nb) {
    const int tid = threadIdx.x, k0 = kb * 64, n0 = nb * 64;
    const int nn = tid & 63; const float* sp = tmap_src<MODE>(s0, s1, nvalid, n0 + nn);
#pragma unroll
    for (int i = 0; i < 8; ++i) {
        const int kk = (tid >> 6) + 8 * i; float v = sp ? sp[(size_t)(k0 + kk) * ld] : 0.f;
        if (ksc) v *= ksc[k0 + kk];
        scr[kk * 65 + nn] = v * gsc;
    }
    __syncthreads();
    {
        const int n2 = tid >> 3, kc = tid & 7; const float* s = scr + (kc * 8) * 65 + n2;
        u32x4 o; o.x = pk2(s[0], s[65]); o.y = pk2(s[2 * 65], s[3 * 65]); o.z = pk2(s[4 * 65], s[5 * 65]); o.w = pk2(s[6 * 65], s[7 * 65]);
        *(u32x4*)(dst + (size_t)(n0 + n2) * K + k0 + kc * 8) = o;
    }
    __syncthreads();
}
template <int MODE> __device__ __forceinline__ void transpose_matrix(float* scr, const float* s0, const float* s1, int ld, int nvalid, const float* ksc, float gsc, int K, int Nd, bf16_t* dst, int& rot) {
    const int nkb = K / 64, nnb = Nd / 64, nu = nkb * nnb, G = gridDim.x;
    int first = ((int)blockIdx.x - rot) % G; if (first < 0) first += G;
    for (int u = first; u < nu; u += G) transpose_unit<MODE>(scr, s0, s1, ld, nvalid, ksc, gsc, K, dst, u / nnb, u % nnb);
    rot = (rot + nu) % G;
}
__device__ __forceinline__ void convert_expert_weights(unsigned char* lds, const P& p, int L) {
    float* scr = (float*)lds; const int G = gridDim.x;
    bf16_t* egu = (bf16_t*)(p.ws + WS_EGU); bf16_t* ed = (bf16_t*)(p.ws + WS_ED);
    for (int u = blockIdx.x; u < NEXP * 192; u += G) {
        const int e = u / 192, r = u % 192;
        if (r < 128) {
            transpose_unit<2>(scr, p.in[22] + ((size_t)L * NEXP + e) * D * EDIM, p.in[23] + ((size_t)L * NEXP + e) * D * EDIM, EDIM, 512, nullptr, 1.f, D, egu + (size_t)e * 512 * D, r / 8, r % 8);
        } else {
            const int r2 = r - 128;
            transpose_unit<0>(scr, p.in[24] + ((size_t)L * NEXP + e) * EDIM * D, nullptr, D, D, nullptr, 1.f, EDIM, ed + (size_t)e * D * EDIM, r2 / 16, r2 % 16);
        }
    }
}
__device__ __forceinline__ void prep_mod_unit(unsigned char* lds, const P& p, int u) {
    float* sc = (float*)lds;
    float* part = sc + 17 * 1024;
    const int tid = threadIdx.x;
    const float* c = p.in[1]; const float* cctx = p.in[3];
    for (int i = tid; i < 17 * 1024; i += NTHREADS) { const int r = i >> 10, k = i & 1023; const float v = r < 16 ? c[r * 1024 + k] : cctx[k]; sc[i] = v / (1.f + expf(-v)); }
    __syncthreads();
    const int L = u / 48, cg = u % 48, kq = tid >> 7, cl = tid & 127, col = cg * 128 + cl;
    const float* w = p.in[4] + (size_t)L * 1024 * 6144 + col;
    float acc[17];
#pragma unroll
    for (int r = 0; r < 17; ++r) acc[r] = 0.f;
    for (int k = kq * 256; k < kq * 256 + 256; ++k) {
        const float wv = w[(size_t)k * 6144];
#pragma unroll
        for (int r = 0; r < 17; ++r) acc[r] += sc[r * 1024 + k] * wv;
    }
#pragma unroll
    for (int r = 0; r < 17; ++r) part[(kq * 17 + r) * 128 + cl] = acc[r];
    __syncthreads();
    float* modv = (float*)(p.ws + WS_MODV);
    for (int i = tid; i < 17 * 128; i += NTHREADS) {
        const int r = i >> 7, c2 = i & 127;
        float s = part[(0 * 17 + r) * 128 + c2] + part[(1 * 17 + r) * 128 + c2] + part[(2 * 17 + r) * 128 + c2] + part[(3 * 17 + r) * 128 + c2];
        s += p.in[5][L * 6144 + cg * 128 + c2];
        modv[((size_t)L * 17 + r) * 6144 + cg * 128 + c2] = s;
    }
    __syncthreads();
}
__device__ __forceinline__ void phase_prep(unsigned char* lds, const P& p) {
    const int tid = threadIdx.x, G = gridDim.x, bid = blockIdx.x;
    {
        float* ct = (float*)(p.ws + WS_ROPE); float* st = ct + 2048 * 16;
        for (int i = bid * NTHREADS + tid; i < 2048 * 16; i += G * NTHREADS) {
            const int pos = i >> 4, f = i & 15;
            const float inv = powf(10000.f, -(float)(f & 7) / 8.f);
            const float ang = (float)(f < 8 ? (pos >> 6) : (pos & 63)) * inv;
            ct[i] = cosf(ang); st[i] = sinf(ang);
        }
    }
    for (int u = G - 1 - bid; u < 96; u += G) prep_mod_unit(lds, p, u);
    float* scr = (float*)lds; int rot = 0;
    for (int L = 0; L < 2; ++L) {
        transpose_matrix<0>(scr, p.in[7] + (size_t)L * D * Z_END, nullptr, Z_END, Z_END, nullptr, 1.f, D, ZC, (bf16_t*)(p.ws + WS_WIN) + (size_t)L * ZC * D, rot);
        transpose_matrix<1>(scr, p.in[15] + (size_t)L * 256 * 768, nullptr, 768, 768, p.in[14] + L * 256, 0.14724574f, 256, 768, (bf16_t*)(p.ws + WS_WUQ) + (size_t)L * 768 * 256, rot);
        transpose_matrix<0>(scr, p.in[17] + (size_t)L * 128 * 1024, nullptr, 1024, 1024, p.in[16] + L * 128, 1.f, 128, 1024, (bf16_t*)(p.ws + WS_WUKV) + (size_t)L * 1024 * 128, rot);
        transpose_matrix<0>(scr, p.in[18] + (size_t)L * D * D, nullptr, D, D, nullptr, 1.f, D, D, (bf16_t*)(p.ws + WS_WOUT) + (size_t)L * D * D, rot);
        transpose_matrix<0>(scr, p.in[20] + (size_t)L * D * NEXP, nullptr, NEXP, NEXP, nullptr, 1.f, D, 128, (bf16_t*)(p.ws + WS_RT) + (size_t)L * 128 * D, rot);
        transpose_matrix<2>(scr, p.in[25] + (size_t)L * D * EDIM, p.in[26] + (size_t)L * D * EDIM, EDIM, 512, nullptr, 1.f, D, 512, (bf16_t*)(p.ws + WS_SHGU) + (size_t)L * 512 * D, rot);
        transpose_matrix<0>(scr, p.in[27] + (size_t)L * EDIM * D, nullptr, D, D, nullptr, 1.f, EDIM, D, (bf16_t*)(p.ws + WS_SHD) + (size_t)L * D * EDIM, rot);
    }
    convert_expert_weights(lds, p, 0);
    {
        const f32x4* xs = (const f32x4*)p.in[0]; f32x4* xd = (f32x4*)p.out;
        for (size_t i = (size_t)bid * NTHREADS + tid; i < (size_t)NLAT * D / 4; i += (size_t)G * NTHREADS) xd[i] = xs[i];
        const f32x4* cs = (const f32x4*)p.in[2]; f32x4* cd = (f32x4*)(p.ws + WS_XC);
        for (size_t i = (size_t)bid * NTHREADS + tid; i < (size_t)NCTX * D / 4; i += (size_t)G * NTHREADS) cd[i] = cs[i];
    }
}

__device__ __forceinline__ void phase_norm_mod(const P& p, int L, int which  , int ntok) {
    const int tid = threadIdx.x, lane = tid & 63, wave = tid >> 6, gw = blockIdx.x * NWAVES + wave, NGW = gridDim.x * NWAVES;
    const float* nw = (which == 0 ? p.in[6] : p.in[19]) + L * D;
    const float* modv = (const float*)(p.ws + WS_MODV) + (size_t)L * 17 * 6144;
    bf16_t* H = (bf16_t*)(p.ws + WS_H);
    for (int tok = gw; tok < ntok; tok += NGW) {
        const f32x4* xr = (const f32x4*)x_row(p, tok) + lane;
        const float* mrow = modv + (size_t)mod_row(tok) * 6144 + which * 3072;
        f32x4 v[4]; float s = 0.f;
#pragma unroll
        for (int j = 0; j < 4; ++j) { v[j] = xr[64 * j]; s += v[j].x * v[j].x + v[j].y * v[j].y + v[j].z * v[j].z + v[j].w * v[j].w; }
        const float rstd = rsqrtf(wave_sum(s) * (1.f / D) + NORM_EPS);
        u32x2* o = (u32x2*)(H + (size_t)tok * D) + lane;
#pragma unroll
        for (int j = 0; j < 4; ++j) {
            const int k = 4 * lane + 256 * j;
            const f32x4 w4 = *(const f32x4*)(nw + k), sh = *(const f32x4*)(mrow + k), sc = *(const f32x4*)(mrow + 1024 + k);
            const float y0 = v[j].x * rstd * w4.x * (1.f + sc.x) + sh.x, y1 = v[j].y * rstd * w4.y * (1.f + sc.y) + sh.y;
            const float y2 = v[j].z * rstd * w4.z * (1.f + sc.z) + sh.z, y3 = v[j].w * rstd * w4.w * (1.f + sc.w) + sh.w;
            u32x2 w; w.x = pk2(y0, y1); w.y = pk2(y2, y3); o[64 * j] = w;
        }
    }
}

__device__ __forceinline__ void phase_zgemm(unsigned char* lds, const P& p, int L) {
    const bf16_t* H = (const bf16_t*)(p.ws + WS_H); const bf16_t* W = (const bf16_t*)(p.ws + WS_WIN) + (size_t)L * ZC * D;
    bf16_t* Z = (bf16_t*)(p.ws + WS_Z);
    constexpr int NNT = ZC / 128, NU = (NTOK / 128) * NNT;
    for (int u = blockIdx.x; u < NU; u += gridDim.x) {
        const int mt = u / NNT, nt = u % NNT;
        auto rs = [&](int pr) { return H + (size_t)(mt * 128 + pr) * D; };
        auto epi = [&](int r, int c, f32x4 v) { u32x2 w; w.x = pk2(v.x, v.y); w.y = pk2(v.z, v.w); *(u32x2*)(Z + (size_t)(mt * 128 + r) * ZC + nt * 128 + c) = w; };
        gemm_tile<false>(lds, rs, W + (size_t)nt * 128 * D, D, D, epi);
    }
}

__device__ __forceinline__ void conv_unit(unsigned char* lds, const P& p, int L, int s, int tt) {
    float* hg = (float*)lds;
    const int tid = threadIdx.x, lane = tid & 63, wave = tid >> 6;
    const int rb = s < 16 ? s * SEQ : NLAT + (s - 16) * CTXL, len = s < 16 ? SEQ : CTXL, t0 = tt * 64;
    const bf16_t* Z = (const bf16_t*)(p.ws + WS_Z);
    for (int i = tid; i < 94 * 64; i += NTHREADS) {
        const int jj = i >> 6, c4 = (i & 63) * 4, t = t0 - 15 + jj;
        f32x4 h = (f32x4){0.f, 0.f, 0.f, 0.f};
        if (t >= 0 && t < len) {
            const bf16_t* zr = Z + (size_t)(rb + t) * ZC;
            const u32x2 a = *(const u32x2*)(zr + c4), g = *(const u32x2*)(zr + 256 + c4);
            const float g0 = lo16(g.x), g1 = hi16(g.x), g2 = lo16(g.y), g3 = hi16(g.y);
            h.x = lo16(a.x) / (1.f + __expf(-g0)); h.y = hi16(a.x) / (1.f + __expf(-g1));
            h.z = lo16(a.y) / (1.f + __expf(-g2)); h.w = hi16(a.y) / (1.f + __expf(-g3));
        }
        *(f32x4*)(hg + jj * 256 + c4) = h;
    }
    float* wl = hg + 94 * 256;
    for (int i = tid; i < 31 * 64; i += NTHREADS) *(f32x4*)(wl + i * 4) = *(const f32x4*)(p.in[8] + (size_t)L * 31 * 256 + i * 4);
    __syncthreads();
    const int c0 = lane * 4;
    const f32x4 cb = *(const f32x4*)(p.in[9] + L * 256 + c0), lw = *(const f32x4*)(p.in[10] + L * 256 + c0), lb = *(const f32x4*)(p.in[11] + L * 256 + c0);
    bf16_t* CC = (bf16_t*)(p.ws + WS_CC);
    for (int q = 0; q < 8; ++q) {
        const int tl = wave * 8 + q;
        f32x4 acc = cb;
#pragma unroll 4
        for (int j = 0; j < 31; ++j) { const f32x4 h = *(const f32x4*)(hg + (tl + j) * 256 + c0); acc += h * *(const f32x4*)(wl + j * 256 + c0); }
        const float mean = wave_sum(acc.x + acc.y + acc.z + acc.w) * (1.f / 256.f);
        const f32x4 d = acc - mean;
        const float var = wave_sum(d.x * d.x + d.y * d.y + d.z * d.z + d.w * d.w) * (1.f / 256.f);
        const float rstd = rsqrtf(var + NORM_EPS);
        const f32x4 y = d * rstd * lw + lb;
        u32x2 o; o.x = pk2(siluf(y.x), siluf(y.y)); o.y = pk2(siluf(y.z), siluf(y.w));
        *(u32x2*)(CC + (size_t)(rb + t0 + tl) * D + c0) = o;
    }
    __syncthreads();
}

__device__ __forceinline__ float log2_gamma(const P& p, int L, int dir, int h) {
    const float x = p.in[12][(L * 2 + dir) * 4 + h];
    const float ls = fminf(x, 0.f) - log1pf(expf(-fabsf(x)));
    return ls * 1.4426950408889634f;
}
__device__ __forceinline__ void load_ret_qk(float* dst, const P& p, int gc, int h, int zoff, float scale) {
    const int tid = threadIdx.x, j = tid >> 2, i0 = (tid & 3) * 4, row = gc * 128 + j;
    const bf16_t* zr = (const bf16_t*)(p.ws + WS_Z) + (size_t)row * ZC + zoff + h * 32;
    const u32x2 a = *(const u32x2*)(zr + i0), b = *(const u32x2*)(zr + 16 + i0);
    float x1[4] = {lo16(a.x), hi16(a.x), lo16(a.y), hi16(a.y)}, x2[4] = {lo16(b.x), hi16(b.x), lo16(b.y), hi16(b.y)};
    const bool lat = row < NLAT; const int pos = row & (SEQ - 1);
    const float* ct = (const float*)(p.ws + WS_ROPE) + pos * 16 + i0; const float* st = ct + 2048 * 16;
#pragma unroll
    for (int i = 0; i < 4; ++i) {
        const float c = lat ? ct[i] : 1.f, s = lat ? st[i] : 0.f;
        dst[j * 33 + i0 + i] = (x1[i] * c - x2[i] * s) * scale;
        dst[j * 33 + 16 + i0 + i] = (x1[i] * s + x2[i] * c) * scale;
    }
}
__device__ __forceinline__ void load_ret_v(float* dst  , const P& p, int gc, int h) {
    const int tid = threadIdx.x, j = tid >> 2, e0 = (tid & 3) * 16;
    const bf16_t* zr = (const bf16_t*)(p.ws + WS_Z) + (size_t)(gc * 128 + j) * ZC + Z_RV + h * 64 + e0;
    const u32x4 a = *(const u32x4*)zr, b = *(const u32x4*)(zr + 8);
#pragma unroll
    for (int i = 0; i < 4; ++i) { dst[j * 64 + e0 + 2 * i] = lo16(a[i]); dst[j * 64 + e0 + 2 * i + 1] = hi16(a[i]); dst[j * 64 + e0 + 8 + 2 * i] = lo16(b[i]); dst[j * 64 + e0 + 8 + 2 * i + 1] = hi16(b[i]); }
}
__device__ __forceinline__ void retkv_unit(unsigned char* lds, const P& p, int L, int gc, int h) {
    float* ks = (float*)lds; float* vs = ks + 128 * 33; float* wf = vs + 128 * 64; float* wb = wf + 128;
    const int tid = threadIdx.x;
    const float l2f = log2_gamma(p, L, 0, h), l2b = log2_gamma(p, L, 1, h);
    load_ret_qk(ks, p, gc, h, Z_RK, 0.17677669529663687f);
    load_ret_v(vs, p, gc, h);
    if (tid < 128) { wf[tid] = exp2f(l2f * (float)(127 - tid)); wb[tid] = exp2f(l2b * (float)tid); }
    __syncthreads();
    const int d = tid >> 4, e0 = (tid & 15) * 4;
    f32x4 af = (f32x4){0.f, 0.f, 0.f, 0.f}, ab = af;
    for (int j = 0; j < 128; ++j) {
        const float kd = ks[j * 33 + d]; const f32x4 v4 = *(const f32x4*)(vs + j * 64 + e0);
        af += (kd * wf[j]) * v4; ab += (kd * wb[j]) * v4;
    }
    float* KV = (float*)(p.ws + WS_KV) + ((size_t)(gc * 4 + h) * 2) * 2048;
    *(f32x4*)(KV + d * 64 + e0) = af; *(f32x4*)(KV + 2048 + d * 64 + e0) = ab;
    __syncthreads();
}
__device__ __forceinline__ void qproj_unit(unsigned char* lds, const P& p, int L, int mt, int nt) {
    const bf16_t* Z = (const bf16_t*)(p.ws + WS_Z); const bf16_t* W = (const bf16_t*)(p.ws + WS_WUQ) + (size_t)L * 768 * 256;
    bf16_t* Q = (bf16_t*)(p.ws + WS_Q); const float* rowss = (const float*)(lds + ROWSS_OFF);
    const float* ct = (const float*)(p.ws + WS_ROPE); const float* st = ct + 2048 * 16;
    auto rs = [&](int pr) { return Z + (size_t)(mt * 128 + pr) * ZC + Z_CQ; };
    auto epi = [&](int r, int c, f32x4 v) {
        const int row = mt * 128 + r, col = nt * 128 + c, j = col % 96;
        const float rstd = rsqrtf(rowss[r] * (1.f / 256.f) + NORM_EPS);
        v = v * rstd;
        if (j >= 64 && row < NLAT) {
            const int i = (j - 64) >> 1, pos = row & (SEQ - 1);
            const float c0 = ct[pos * 16 + i], s0 = st[pos * 16 + i], c1 = ct[pos * 16 + i + 1], s1 = st[pos * 16 + i + 1];
            const float a0 = v.x * c0 - v.y * s0, b0 = v.x * s0 + v.y * c0, a1 = v.z * c1 - v.w * s1, b1 = v.z * s1 + v.w * c1;
            v = (f32x4){a0, b0, a1, b1};
        }
        u32x2 w; w.x = pk2(v.x, v.y); w.y = pk2(v.z, v.w); *(u32x2*)(Q + (size_t)row * 768 + col) = w;
    };
    gemm_tile<true>(lds, rs, W + (size_t)nt * 128 * 256, 256, 256, epi);
}
__device__ __forceinline__ void kvproj_unit(unsigned char* lds, const P& p, int L, int mt, int nt) {
    const bf16_t* Z = (const bf16_t*)(p.ws + WS_Z); const bf16_t* W = (const bf16_t*)(p.ws + WS_WUKV) + (size_t)L * 1024 * 128;
    bf16_t* Kb = (bf16_t*)(p.ws + WS_K); bf16_t* Vb = (bf16_t*)(p.ws + WS_V); const float* rowss = (const float*)(lds + ROWSS_OFF);
    auto rs = [&](int pr) { return Z + (size_t)(mt * 128 + pr) * ZC + Z_CKV; };
    auto epi = [&](int r, int c, f32x4 v) {
        const int row = mt * 128 + r, col = nt * 128 + c, h = col >> 7, j = col & 127;
        const float rstd = rsqrtf(rowss[r] * (1.f / 128.f) + NORM_EPS);
        v = v * rstd;
        u32x2 w; w.x = pk2(v.x, v.y); w.y = pk2(v.z, v.w);
        if (j < 64) *(u32x2*)(Kb + (size_t)row * 768 + h * 96 + j) = w;
        else *(u32x2*)(Vb + (size_t)row * 512 + h * 64 + (j - 64)) = w;
    };
    gemm_tile<true>(lds, rs, W + (size_t)nt * 128 * 128, 128, 128, epi);
    if (nt == 0) {
        const int tid = threadIdx.x, r = tid >> 2, i0 = (tid & 3) * 4, row = mt * 128 + r;
        const bf16_t* zr = Z + (size_t)row * ZC + Z_KR;
        const u32x2 a = *(const u32x2*)(zr + i0), b = *(const u32x2*)(zr + 16 + i0);
        const float x1[4] = {lo16(a.x), hi16(a.x), lo16(a.y), hi16(a.y)}, x2[4] = {lo16(b.x), hi16(b.x), lo16(b.y), hi16(b.y)};
        const bool lat = row < NLAT; const int pos = row & (SEQ - 1);
        const float* ct = (const float*)(p.ws + WS_ROPE) + pos * 16 + i0; const float* st = ct + 2048 * 16;
        unsigned o[4];
#pragma unroll
        for (int i = 0; i < 4; ++i) { const float c = lat ? ct[i] : 1.f, s = lat ? st[i] : 0.f; o[i] = pk2(x1[i] * c - x2[i] * s, x1[i] * s + x2[i] * c); }
        u32x4 ov; ov.x = o[0]; ov.y = o[1]; ov.z = o[2]; ov.w = o[3];
#pragma unroll
        for (int h = 0; h < 8; ++h) *(u32x4*)(Kb + (size_t)row * 768 + h * 96 + 64 + 2 * i0) = ov;
    }
}
__device__ __forceinline__ void phase_b(unsigned char* lds, const P& p, int L) {
    const int G = gridDim.x, bid = blockIdx.x;
    const int nconv = (L == 0) ? 576 : 512;
    const int nkv = 288 * 4, nq = (NTOK / 128) * 6, nkvp = (NTOK / 128) * 8;
    const int total = nconv + nkv + nq + nkvp;
    for (int u = bid; u < total; u += G) {
        int r = u;
        if (r < nq) { qproj_unit(lds, p, L, r / 6, r % 6); continue; } r -= nq;
        if (r < nkvp) { kvproj_unit(lds, p, L, r / 8, r % 8); continue; } r -= nkvp;
        if (r < nconv) { if (r < 512) conv_unit(lds, p, L, r >> 5, r & 31); else conv_unit(lds, p, L, 16 + ((r - 512) >> 2), (r - 512) & 3); continue; } r -= nconv;
        retkv_unit(lds, p, L, r >> 2, r & 3);
    }
}

__device__ __forceinline__ void attn_unit_naive(unsigned char* lds, const P& p, int b, int h, int qb, bool ctxq) {
    float* Ks = (float*)lds;
    float* Vs = Ks + 64 * 96;
    const int tid = threadIdx.x, half = tid & 1, qi = tid >> 1;
    const bf16_t* Qb = (const bf16_t*)(p.ws + WS_Q); const bf16_t* Kb = (const bf16_t*)(p.ws + WS_K); const bf16_t* Vb = (const bf16_t*)(p.ws + WS_V);
    const int qrow = ctxq ? NLAT + b * CTXL + qi : b * SEQ + qb * 256 + qi;
    float q[48];
    {
        const u32x4* qp = (const u32x4*)(Qb + (size_t)qrow * 768 + h * 96 + half * 48);
#pragma unroll
        for (int i = 0; i < 6; ++i) { const u32x4 w = qp[i];
#pragma unroll
            for (int k = 0; k < 4; ++k) { q[i * 8 + 2 * k] = lo16(w[k]); q[i * 8 + 2 * k + 1] = hi16(w[k]); } }
    }
    float o[32];
#pragma unroll
    for (int e = 0; e < 32; ++e) o[e] = 0.f;
    float m = -1e30f, l = 0.f;
    const int ntiles = ctxq ? 4 : 36;
#pragma unroll 1
    for (int t = 0; t < ntiles; ++t) {
        const int krow0 = t < 4 ? NLAT + b * CTXL + t * 64 : b * SEQ + (t - 4) * 64;
        __syncthreads();
        for (int i = tid; i < 64 * 12; i += NTHREADS) { const int key = i / 12, c = i % 12; const u32x4 w = *(const u32x4*)(Kb + (size_t)(krow0 + key) * 768 + h * 96 + c * 8);
            float* d = Ks + key * 96 + c * 8;
#pragma unroll
            for (int k = 0; k < 4; ++k) { d[2 * k] = lo16(w[k]); d[2 * k + 1] = hi16(w[k]); } }
        for (int i = tid; i < 64 * 8; i += NTHREADS) { const int key = i >> 3, c = i & 7; const u32x4 w = *(const u32x4*)(Vb + (size_t)(krow0 + key) * 512 + h * 64 + c * 8);
            float* d = Vs + key * 64 + c * 8;
#pragma unroll
            for (int k = 0; k < 4; ++k) { d[2 * k] = lo16(w[k]); d[2 * k + 1] = hi16(w[k]); } }
        __syncthreads();
#pragma unroll 1
        for (int j0 = 0; j0 < 64; j0 += 2) {
            float s[2]; float mt = -1e30f;
#pragma unroll
            for (int jj = 0; jj < 2; ++jj) {
                const f32x4* kr = (const f32x4*)(Ks + (j0 + jj) * 96 + half * 48);
                float a = 0.f;
#pragma unroll
                for (int d4 = 0; d4 < 12; ++d4) { const f32x4 kv = kr[d4]; a += q[4 * d4] * kv.x + q[4 * d4 + 1] * kv.y + q[4 * d4 + 2] * kv.z + q[4 * d4 + 3] * kv.w; }
                a += __shfl_xor(a, 1);
                s[jj] = a; mt = fmaxf(mt, a);
            }
            const float mn = fmaxf(m, mt), alpha = exp2f(m - mn);
            m = mn; l *= alpha;
#pragma unroll
            for (int e = 0; e < 32; ++e) o[e] *= alpha;
#pragma unroll
            for (int jj = 0; jj < 2; ++jj) {
                const float pj = exp2f(s[jj] - mn); l += pj;
                const f32x4* vr = (const f32x4*)(Vs + (j0 + jj) * 64 + half * 32);
#pragma unroll
                for (int e4 = 0; e4 < 8; ++e4) { const f32x4 vv = vr[e4]; o[4 * e4] += pj * vv.x; o[4 * e4 + 1] += pj * vv.y; o[4 * e4 + 2] += pj * vv.z; o[4 * e4 + 3] += pj * vv.w; }
            }
        }
    }
    {
        const float rl = 1.f / l;
        u32x4* op = (u32x4*)((bf16_t*)(p.ws + WS_CC) + (size_t)qrow * D + 512 + h * 64 + half * 32);
#pragma unroll
        for (int i = 0; i < 4; ++i) { u32x4 w; w.x = pk2(o[8 * i] * rl, o[8 * i + 1] * rl); w.y = pk2(o[8 * i + 2] * rl, o[8 * i + 3] * rl); w.z = pk2(o[8 * i + 4] * rl, o[8 * i + 5] * rl); w.w = pk2(o[8 * i + 6] * rl, o[8 * i + 7] * rl); op[i] = w; }
    }
    __syncthreads();
}
typedef float f32x16 __attribute__((ext_vector_type(16)));
typedef short v4i16_t __attribute__((ext_vector_type(4)));
typedef float f32x2_t __attribute__((ext_vector_type(2)));
typedef __bf16 bf16x2_t __attribute__((ext_vector_type(2)));
__device__ __forceinline__ unsigned cvtpk(float lo, float hi) { f32x2_t v = {lo, hi}; bf16x2_t b = __builtin_convertvector(v, bf16x2_t); return __builtin_bit_cast(unsigned, b); }
constexpr int AT_KROW = 208;
constexpr int AT_KBUF = 64 * AT_KROW;
constexpr int AT_VBUF = 8192;
constexpr int AT_BUF = AT_KBUF + AT_VBUF;
__device__ __forceinline__ void attn_unit_mfma(unsigned char* lds, const P& p, int b, int h, int qb, bool ctxq) {
    const int tid = threadIdx.x, lane = tid & 63, wid = tid >> 6, r32 = lane & 31, hh = lane >> 5;
    const bf16_t* Qb = (const bf16_t*)(p.ws + WS_Q); const bf16_t* Kb = (const bf16_t*)(p.ws + WS_K); const bf16_t* Vb = (const bf16_t*)(p.ws + WS_V);
    const int qrow = (ctxq ? NLAT + b * CTXL : b * SEQ + qb * 256) + wid * 32 + r32;
    bf16x8 qf[6];
#pragma unroll
    for (int s = 0; s < 6; ++s) qf[s] = *(const bf16x8*)(Qb + (size_t)qrow * 768 + h * 96 + 16 * s + 8 * hh);
    f32x16 o0, o1;
#pragma unroll
    for (int r = 0; r < 16; ++r) { o0[r] = 0.f; o1[r] = 0.f; }
    float m = -1e30f, l = 0.f;
    const int ntiles = ctxq ? 4 : 36;
    const int kk0 = tid / 12, kc0 = tid % 12, kk1 = (512 + tid) / 12, kc1 = (512 + tid) % 12, vk = tid >> 3, vc = tid & 7;
    const size_t kg0 = (size_t)kk0 * 768 + h * 96 + kc0 * 8, kg1 = (size_t)kk1 * 768 + h * 96 + kc1 * 8, vg = (size_t)vk * 512 + h * 64 + vc * 8;
    const int kl0 = kk0 * AT_KROW + kc0 * 16, kl1 = kk1 * AT_KROW + kc1 * 16, vl = AT_KBUF + (vc >> 2) * 4096 + vk * 64 + (vc & 3) * 16;
    auto krow0 = [&](int t) { return t < 4 ? NLAT + b * CTXL + t * 64 : b * SEQ + (t - 4) * 64; };
    u32x4 sk0, sk1, sv;
    { const int kr = krow0(0); sk0 = *(const u32x4*)(Kb + (size_t)kr * 768 + kg0); if (tid < 256) sk1 = *(const u32x4*)(Kb + (size_t)kr * 768 + kg1); sv = *(const u32x4*)(Vb + (size_t)kr * 512 + vg); }
    __syncthreads();
    *(u32x4*)(lds + kl0) = sk0; if (tid < 256) *(u32x4*)(lds + kl1) = sk1; *(u32x4*)(lds + vl) = sv;
    __syncthreads();
    const int koff = r32 * AT_KROW + 16 * hh;
    const int voff = AT_KBUF + (4 * hh + ((lane & 15) >> 2)) * 64 + ((lane >> 4) & 1) * 32 + (lane & 3) * 8;
#pragma unroll 1
    for (int t = 0; t < ntiles; ++t) {
        unsigned char* buf = lds + (t & 1) * AT_BUF;
        if (t + 1 < ntiles) { const int kr = krow0(t + 1); sk0 = *(const u32x4*)(Kb + (size_t)kr * 768 + kg0); if (tid < 256) sk1 = *(const u32x4*)(Kb + (size_t)kr * 768 + kg1); sv = *(const u32x4*)(Vb + (size_t)kr * 512 + vg); }
        f32x16 p0, p1;
#pragma unroll
        for (int r = 0; r < 16; ++r) { p0[r] = 0.f; p1[r] = 0.f; }
#pragma unroll
        for (int s = 0; s < 6; ++s) {
            const bf16x8 k0f = *(const bf16x8*)(buf + koff + 32 * s), k1f = *(const bf16x8*)(buf + koff + 32 * AT_KROW + 32 * s);
            p0 = __builtin_amdgcn_mfma_f32_32x32x16_bf16(k0f, qf[s], p0, 0, 0, 0);
            p1 = __builtin_amdgcn_mfma_f32_32x32x16_bf16(k1f, qf[s], p1, 0, 0, 0);
        }
        float mt = fmaxf(p0[0], p1[0]);
#pragma unroll
        for (int r = 1; r < 16; ++r) mt = fmaxf(mt, fmaxf(p0[r], p1[r]));
        mt = fmaxf(mt, __shfl_xor(mt, 32));
        const float mn = fmaxf(m, mt), alpha = __builtin_amdgcn_exp2f(m - mn);
        m = mn;
        float ls = 0.f;
#pragma unroll
        for (int r = 0; r < 16; ++r) { p0[r] = __builtin_amdgcn_exp2f(p0[r] - mn); p1[r] = __builtin_amdgcn_exp2f(p1[r] - mn); ls += p0[r] + p1[r]; }
        l = l * alpha + ls;
#pragma unroll
        for (int r = 0; r < 16; ++r) { o0[r] *= alpha; o1[r] *= alpha; }
        u32x4 pw[4];
#pragma unroll
        for (int s2 = 0; s2 < 2; ++s2) {
            pw[s2] = (u32x4){cvtpk(p0[8 * s2], p0[8 * s2 + 1]), cvtpk(p0[8 * s2 + 2], p0[8 * s2 + 3]), cvtpk(p0[8 * s2 + 4], p0[8 * s2 + 5]), cvtpk(p0[8 * s2 + 6], p0[8 * s2 + 7])};
            pw[2 + s2] = (u32x4){cvtpk(p1[8 * s2], p1[8 * s2 + 1]), cvtpk(p1[8 * s2 + 2], p1[8 * s2 + 3]), cvtpk(p1[8 * s2 + 4], p1[8 * s2 + 5]), cvtpk(p1[8 * s2 + 6], p1[8 * s2 + 7])};
        }
#pragma unroll
        for (int ks = 0; ks < 4; ++ks) {
            const LAS unsigned char* vb = (const LAS unsigned char*)(buf + voff + ks * 16 * 64);
            const v4i16_t a0 = __builtin_amdgcn_ds_read_tr16_b64_v4i16((LAS v4i16_t*)(vb)), a1 = __builtin_amdgcn_ds_read_tr16_b64_v4i16((LAS v4i16_t*)(vb + 8 * 64));
            const v4i16_t c0 = __builtin_amdgcn_ds_read_tr16_b64_v4i16((LAS v4i16_t*)(vb + 4096)), c1 = __builtin_amdgcn_ds_read_tr16_b64_v4i16((LAS v4i16_t*)(vb + 4096 + 8 * 64));
            const bf16x8 va = (bf16x8){a0[0], a0[1], a0[2], a0[3], a1[0], a1[1], a1[2], a1[3]}, vc2 = (bf16x8){c0[0], c0[1], c0[2], c0[3], c1[0], c1[1], c1[2], c1[3]};
            const bf16x8 pf = __builtin_bit_cast(bf16x8, pw[ks]);
            o0 = __builtin_amdgcn_mfma_f32_32x32x16_bf16(va, pf, o0, 0, 0, 0);
            o1 = __builtin_amdgcn_mfma_f32_32x32x16_bf16(vc2, pf, o1, 0, 0, 0);
        }
        if (t + 1 < ntiles) { unsigned char* nb = lds + ((t + 1) & 1) * AT_BUF; *(u32x4*)(nb + kl0) = sk0; if (tid < 256) *(u32x4*)(nb + kl1) = sk1; *(u32x4*)(nb + vl) = sv; }
        __syncthreads();
    }
    l += __shfl_xor(l, 32);
    const float rl = 1.f / l;
    bf16_t* orow = (bf16_t*)(p.ws + WS_CC) + (size_t)qrow * D + 512 + h * 64 + 4 * hh;
#pragma unroll
    for (int r4 = 0; r4 < 4; ++r4) {
        u32x2 w0; w0.x = cvtpk(o0[4 * r4] * rl, o0[4 * r4 + 1] * rl); w0.y = cvtpk(o0[4 * r4 + 2] * rl, o0[4 * r4 + 3] * rl);
        u32x2 w1; w1.x = cvtpk(o1[4 * r4] * rl, o1[4 * r4 + 1] * rl); w1.y = cvtpk(o1[4 * r4 + 2] * rl, o1[4 * r4 + 3] * rl);
        *(u32x2*)(orow + 8 * r4) = w0; *(u32x2*)(orow + 32 + 8 * r4) = w1;
    }
}
__device__ __forceinline__ void retout_unit(unsigned char* lds, const P& p, int L, int gc, int h) {
    float* qs = (float*)lds; float* ks = qs + 128 * 33; float* vs = ks + 128 * 33; float* Sf = vs + 128 * 64; float* Sb = Sf + 2048;
    const int tid = threadIdx.x;
    const float l2f = log2_gamma(p, L, 0, h), l2b = log2_gamma(p, L, 1, h);
    load_ret_qk(qs, p, gc, h, Z_RQ, 1.f);
    load_ret_qk(ks, p, gc, h, Z_RK, 0.17677669529663687f);
    load_ret_v(vs, p, gc, h);
    {
        const bool lat = gc < 256; const int b = lat ? gc >> 4 : (gc - 256) >> 1;
        const int mme = lat ? 2 + (gc & 15) : (gc - 256) & 1;
        const int u = mme, w = mme < 2 ? 1 - mme : 19 - mme;
        f32x4 sf = (f32x4){0.f, 0.f, 0.f, 0.f}, sb = sf;
        const float* KVb = (const float*)(p.ws + WS_KV);
#pragma unroll 1
        for (int mm = 0; mm < 18; ++mm) {
            const int gcm = mm < 2 ? 256 + b * 2 + mm : b * 16 + (mm - 2);
            const int um = mm, wm = mm < 2 ? 1 - mm : 19 - mm;
            const float* kv = KVb + ((size_t)(gcm * 4 + h) * 2) * 2048 + tid * 4;
            if (um < u) { const float wgt = exp2f(l2f * 128.f * (float)(u - 1 - um)); sf += wgt * *(const f32x4*)kv; }
            if (wm < w) { const float wgt = exp2f(l2b * 128.f * (float)(w - 1 - wm)); sb += wgt * *(const f32x4*)(kv + 2048); }
        }
        *(f32x4*)(Sf + tid * 4) = sf; *(f32x4*)(Sb + tid * 4) = sb;
    }
    __syncthreads();
    const int i = tid >> 2, e0 = (tid & 3) * 16;
    float q[32];
#pragma unroll
    for (int d = 0; d < 32; ++d) q[d] = qs[i * 33 + d];
    float acc[16];
#pragma unroll
    for (int e = 0; e < 16; ++e) acc[e] = 0.f;
#pragma unroll 1
    for (int j = 0; j < 128; ++j) {
        float s = 0.f;
#pragma unroll
        for (int d = 0; d < 32; ++d) s += q[d] * ks[j * 33 + d];
        float wgt = 0.f;
        if (j <= i) wgt += exp2f(l2f * (float)(i - j));
        if (j >= i) wgt += exp2f(l2b * (float)(j - i));
        s *= wgt;
#pragma unroll
        for (int e4 = 0; e4 < 4; ++e4) { const f32x4 v4 = *(const f32x4*)(vs + j * 64 + e0 + 4 * e4); acc[4 * e4] += s * v4.x; acc[4 * e4 + 1] += s * v4.y; acc[4 * e4 + 2] += s * v4.z; acc[4 * e4 + 3] += s * v4.w; }
    }
    {
        const float cf = exp2f(l2f * (float)(i + 1)), cb = exp2f(l2b * (float)(128 - i));
#pragma unroll 2
        for (int d = 0; d < 32; ++d) {
            const float qd = qs[i * 33 + d]; const float qf = qd * cf, qb = qd * cb;
#pragma unroll
            for (int e4 = 0; e4 < 4; ++e4) { const f32x4 a = *(const f32x4*)(Sf + d * 64 + e0 + 4 * e4), bq = *(const f32x4*)(Sb + d * 64 + e0 + 4 * e4);
                acc[4 * e4] += qf * a.x + qb * bq.x; acc[4 * e4 + 1] += qf * a.y + qb * bq.y; acc[4 * e4 + 2] += qf * a.z + qb * bq.z; acc[4 * e4 + 3] += qf * a.w + qb * bq.w; }
        }
    }
    float s1 = 0.f;
#pragma unroll
    for (int e = 0; e < 16; ++e) s1 += acc[e];
    s1 += __shfl_xor(s1, 1); s1 += __shfl_xor(s1, 2);
    const float mu = s1 * (1.f / 64.f);
    float s2 = 0.f;
#pragma unroll
    for (int e = 0; e < 16; ++e) { const float dd = acc[e] - mu; s2 += dd * dd; }
    s2 += __shfl_xor(s2, 1); s2 += __shfl_xor(s2, 2);
    const float rstd = rsqrtf(s2 * (1.f / 64.f) + NORM_EPS);
    const int row = gc * 128 + i;
    const bf16_t* zg = (const bf16_t*)(p.ws + WS_Z) + (size_t)row * ZC + Z_RG + h * 64 + e0;
    const float* gw = p.in[13] + L * 256 + h * 64 + e0;
    const u32x4 g0 = *(const u32x4*)zg, g1 = *(const u32x4*)(zg + 8);
    float g[16];
#pragma unroll
    for (int k = 0; k < 4; ++k) { g[2 * k] = lo16(g0[k]); g[2 * k + 1] = hi16(g0[k]); g[8 + 2 * k] = lo16(g1[k]); g[8 + 2 * k + 1] = hi16(g1[k]); }
    unsigned o[8];
#pragma unroll
    for (int k = 0; k < 8; ++k) {
        const float y0 = siluf(g[2 * k]) * ((acc[2 * k] - mu) * rstd * gw[2 * k]), y1 = siluf(g[2 * k + 1]) * ((acc[2 * k + 1] - mu) * rstd * gw[2 * k + 1]);
        o[k] = pk2(y0, y1);
    }
    u32x4* op = (u32x4*)((bf16_t*)(p.ws + WS_CC) + (size_t)row * D + 256 + h * 64 + e0);
    u32x4 w0; w0.x = o[0]; w0.y = o[1]; w0.z = o[2]; w0.w = o[3]; u32x4 w1; w1.x = o[4]; w1.y = o[5]; w1.z = o[6]; w1.w = o[7];
    op[0] = w0; op[1] = w1;
    __syncthreads();
}
__device__ __forceinline__ void phase_c(unsigned char* lds, const P& p, int L) {
    const int G = gridDim.x, bid = blockIdx.x;
    const int nat = 16 * 8 * 8, nac = (L == 0) ? 128 : 0, nro = (L == 0 ? 288 : 256) * 4;
    const int total = nat + nac + nro;
    for (int u = bid; u < total; u += G) {
        int r = u;
#ifndef TEST_C
#define TEST_C 3
#endif
        if (r < nat) { if (TEST_C & 1) attn_unit_mfma(lds, p, r >> 6, (r >> 3) & 7, r & 7, false); continue; } r -= nat;
        if (r < nac) { if (TEST_C & 1) attn_unit_mfma(lds, p, r >> 3, r & 7, 0, true); continue; } r -= nac;
        if (TEST_C & 2) retout_unit(lds, p, L, r >> 2, r & 3);
    }
}

__device__ __forceinline__ void phase_d(unsigned char* lds, const P& p, int L) {
    const bf16_t* CC = (const bf16_t*)(p.ws + WS_CC); const bf16_t* W = (const bf16_t*)(p.ws + WS_WOUT) + (size_t)L * D * D;
    const float* modv = (const float*)(p.ws + WS_MODV) + (size_t)L * 17 * 6144;
    const int nmt = (L == 0 ? NTOK : NLAT) / 128, NU = nmt * 8;
    for (int u = blockIdx.x; u < NU; u += gridDim.x) {
        const int mt = u >> 3, nt = u & 7;
        auto rs = [&](int pr) { return CC + (size_t)(mt * 128 + pr) * D; };
        auto epi = [&](int r, int c, f32x4 v) {
            const int row = mt * 128 + r, col = nt * 128 + c;
            const f32x4 g = *(const f32x4*)(modv + (size_t)mod_row(row) * 6144 + 2048 + col);
            f32x4* xp = (f32x4*)(x_row(p, row) + col);
            *xp = *xp + g * v;
        };
        gemm_tile<false>(lds, rs, W + (size_t)nt * 128 * D, D, D, epi);
    }
}

__device__ __forceinline__ void phase_router(unsigned char* lds, const P& p, int L) {
    const bf16_t* H = (const bf16_t*)(p.ws + WS_H); const bf16_t* W = (const bf16_t*)(p.ws + WS_RT) + (size_t)L * 128 * D;
    float* lg = (float*)(lds + LG_OFF);
    unsigned* ecnt = (unsigned*)(p.ws + WS_CTL) + CW_ECNT + L * 4096;
    int* ltok = (int*)(p.ws + WS_LTOK); float* lw = (float*)(p.ws + WS_LW);
    const int tid = threadIdx.x, lane = tid & 63, wave = tid >> 6;
    const float rb = p.in[21][L * NEXP + lane];
    const int nmt = (L == 0 ? NTOK : NLAT) / 128;
    for (int mt = blockIdx.x; mt < nmt; mt += gridDim.x) {
        auto rs = [&](int pr) { return H + (size_t)(mt * 128 + pr) * D; };
        auto epi = [&](int r, int c, f32x4 v) { if (c < 64) *(f32x4*)(lg + r * 64 + c) = v; };
        gemm_tile<false>(lds, rs, W, D, D, epi);
        __syncthreads();
        for (int q = 0; q < 16; ++q) {
            const int tl = wave * 16 + q, tok = mt * 128 + tl;
            const float x = lg[tl * 64 + lane];
            const float sc = 1.f / (1.f + expf(-x));
            float sel = sc + rb; float wsum = 0.f; int myk = -1;
#pragma unroll
            for (int k = 0; k < TOPK; ++k) {
                float bv = sel; int bi = lane;
#pragma unroll
                for (int off = 32; off >= 1; off >>= 1) {
                    const float ov = __shfl_xor(bv, off); const int oi = __shfl_xor(bi, off);
                    if (ov > bv || (ov == bv && oi < bi)) { bv = ov; bi = oi; }
                }
                wsum += __shfl(sc, bi);
                if (lane == bi) { myk = k; sel = -INFINITY; }
            }
            if (myk >= 0) {
                const unsigned pos = atomicAdd(ecnt + lane * 64, 1u);
                ltok[(size_t)lane * LCAP + pos] = tok * 8 + myk;
                lw[(size_t)lane * LCAP + pos] = sc / wsum * 2.5f;
            }
        }
    }
}

__device__ __forceinline__ int build_etab(unsigned char* lds, const P& p, int L) {
    int* tstart = (int*)(lds + ETAB_OFF); int* cnt = tstart + 80;
    unsigned* ecnt = (unsigned*)(p.ws + WS_CTL) + CW_ECNT + L * 4096;
    __syncthreads();
    if (threadIdx.x < 64) cnt[threadIdx.x] = (int)__hip_atomic_load(ecnt + threadIdx.x * 64, __ATOMIC_RELAXED, __HIP_MEMORY_SCOPE_AGENT);
    __syncthreads();
    if (threadIdx.x == 0) { int s = 0; for (int e = 0; e < 64; ++e) { tstart[e] = s; s += (cnt[e] + 127) >> 7; } tstart[64] = s; }
    __syncthreads();
    return tstart[64];
}
__device__ __forceinline__ int find_expert(const int* tstart, int t) {
    int lo = 0, hi = 63;
    while (lo < hi) { const int mid = (lo + hi + 1) >> 1; if (tstart[mid] <= t) lo = mid; else hi = mid - 1; }
    return lo;
}
__device__ __forceinline__ void phase_gateup(unsigned char* lds, const P& p, int L) {
    const int TR = build_etab(lds, p, L);
    const int* tstart = (const int*)(lds + ETAB_OFF); const int* cnt = tstart + 80;
    const bf16_t* H = (const bf16_t*)(p.ws + WS_H);
    const int* ltok = (const int*)(p.ws + WS_LTOK); const float* lw = (const float*)(p.ws + WS_LW);
    bf16_t* ACT = (bf16_t*)(p.ws + WS_ACT); bf16_t* ACTSH = (bf16_t*)(p.ws + WS_ACTSH);
    const int ntok = (L == 0 ? NTOK : NLAT), nsh = (ntok / 128) * 4, NU = TR * 4 + nsh;
    for (int u = blockIdx.x; u < NU; u += gridDim.x) {
        if (u < TR * 4) {
            const int t = u >> 2, nt = u & 3, e = find_expert(tstart, t), mt = t - tstart[e], ce = cnt[e];
            const int* le = ltok + (size_t)e * LCAP; const float* we = lw + (size_t)e * LCAP;
            auto rs = [&](int pr) { const int lp = mt * 128 + pr; const int tok = lp < ce ? (le[lp] >> 3) : 0; return H + (size_t)tok * D; };
            auto epi = [&](int r, int c, f32x4 v) {
                const int lp = mt * 128 + r;
                const float wgt = lp < ce ? we[lp] : 0.f;
                const float a0 = siluf(v.x) * v.y * wgt, a1 = siluf(v.z) * v.w * wgt;
                *(unsigned*)(ACT + (size_t)(t * 128 + r) * EDIM + ((nt * 128 + c) >> 1)) = pk2(a0, a1);
            };
            gemm_tile<false>(lds, rs, (const bf16_t*)(p.ws + WS_EGU) + ((size_t)e * 512 + nt * 128) * D, D, D, epi);
        } else {
            const int r2 = u - TR * 4, mt = r2 >> 2, nt = r2 & 3;
            auto rs = [&](int pr) { return H + (size_t)(mt * 128 + pr) * D; };
            auto epi = [&](int r, int c, f32x4 v) {
                const float a0 = siluf(v.x) * v.y, a1 = siluf(v.z) * v.w;
                *(unsigned*)(ACTSH + (size_t)(mt * 128 + r) * EDIM + ((nt * 128 + c) >> 1)) = pk2(a0, a1);
            };
            gemm_tile<false>(lds, rs, (const bf16_t*)(p.ws + WS_SHGU) + ((size_t)L * 512 + nt * 128) * D, D, D, epi);
        }
    }
}
__device__ __forceinline__ void phase_down(unsigned char* lds, const P& p, int L, int cc) {
    const int TR = build_etab(lds, p, L);
    const int* tstart = (const int*)(lds + ETAB_OFF); const int* cnt = tstart + 80;
    const int* ltok = (const int*)(p.ws + WS_LTOK);
    const bf16_t* ACT = (const bf16_t*)(p.ws + WS_ACT); bf16_t* SLOT = (bf16_t*)(p.ws + WS_SLOT);
    const int NU = TR * 2;
    for (int u = blockIdx.x; u < NU; u += gridDim.x) {
        const int t = u >> 1, n2 = u & 1, e = find_expert(tstart, t), mt = t - tstart[e], ce = cnt[e];
        const int* le = ltok + (size_t)e * LCAP;
        auto rs = [&](int pr) { return ACT + (size_t)(t * 128 + pr) * EDIM; };
        auto epi = [&](int r, int c, f32x4 v) {
            const int lp = mt * 128 + r;
            if (lp < ce) { const int ent = le[lp]; const int srow = (ent >> 3) * TOPK + (ent & 7);
                u32x2 w; w.x = pk2(v.x, v.y); w.y = pk2(v.z, v.w); *(u32x2*)(SLOT + (size_t)srow * 256 + n2 * 128 + c) = w; }
        };
        gemm_tile<false>(lds, rs, (const bf16_t*)(p.ws + WS_ED) + ((size_t)e * D + cc * 256 + n2 * 128) * EDIM, EDIM, EDIM, epi);
    }
}
__device__ __forceinline__ void phase_combine(unsigned char* lds, const P& p, int L, int cc) {
    const bf16_t* ACTSH = (const bf16_t*)(p.ws + WS_ACTSH); const bf16_t* SLOT = (const bf16_t*)(p.ws + WS_SLOT);
    const float* modv = (const float*)(p.ws + WS_MODV) + (size_t)L * 17 * 6144;
    const int ntok = (L == 0 ? NTOK : NLAT), NU = (ntok / 128) * 2;
    for (int u = blockIdx.x; u < NU; u += gridDim.x) {
        const int mt = u >> 1, n2 = u & 1;
        auto rs = [&](int pr) { return ACTSH + (size_t)(mt * 128 + pr) * EDIM; };
        auto epi = [&](int r, int c, f32x4 v) {
            const int row = mt * 128 + r, lc = n2 * 128 + c, col = cc * 256 + lc;
#pragma unroll
            for (int k = 0; k < TOPK; ++k) { const u32x2 w = *(const u32x2*)(SLOT + (size_t)(row * TOPK + k) * 256 + lc); v.x += lo16(w.x); v.y += hi16(w.x); v.z += lo16(w.y); v.w += hi16(w.y); }
            const f32x4 g = *(const f32x4*)(modv + (size_t)mod_row(row) * 6144 + 5120 + col);
            f32x4* xp = (f32x4*)(x_row(p, row) + col);
            *xp = *xp + g * v;
        };
        gemm_tile<false>(lds, rs, (const bf16_t*)(p.ws + WS_SHD) + ((size_t)L * D + cc * 256 + n2 * 128) * EDIM, EDIM, EDIM, epi);
    }
}
__device__ __forceinline__ void phase_final(const P& p) {
    const int tid = threadIdx.x, lane = tid & 63, wave = tid >> 6, gw = blockIdx.x * NWAVES + wave, NGW = gridDim.x * NWAVES;
    const float* nw = p.in[28];
    for (int tok = gw; tok < NLAT; tok += NGW) {
        f32x4* xr = (f32x4*)(p.out + (size_t)tok * D) + lane;
        f32x4 v[4]; float s = 0.f;
#pragma unroll
        for (int j = 0; j < 4; ++j) { v[j] = xr[64 * j]; s += v[j].x * v[j].x + v[j].y * v[j].y + v[j].z * v[j].z + v[j].w * v[j].w; }
        const float rstd = rsqrtf(wave_sum(s) * (1.f / D) + NORM_EPS);
#pragma unroll
        for (int j = 0; j < 4; ++j) { const f32x4 w4 = *(const f32x4*)(nw + 4 * lane + 256 * j); xr[64 * j] = v[j] * rstd * w4; }
    }
}

constexpr int PH_LAYER0 = 2, PH_PER_LAYER = 15, PH_T0 = PH_LAYER0 + PH_PER_LAYER, PH_LAYER1 = PH_T0 + 1, PH_FINAL = PH_LAYER1 + PH_PER_LAYER, NPHASES = PH_FINAL + 1;

__global__ void __launch_bounds__(NTHREADS, 2) mk_fwd(P p) {
    extern __shared__ __attribute__((aligned(16))) unsigned char lds[];
    volatile LAS unsigned* MISC = (volatile LAS unsigned*)((LAS unsigned char*)lds + MISC_OFF);
    if (threadIdx.x < 64) MISC[threadIdx.x] = 0u;
    __syncthreads();
    unsigned* ctl = (unsigned*)(p.ws + WS_CTL);
    XcdBarrier bar; bar.bar = ctl + CW_BAR; bar.x = 0; bar.st = MISC + 8;
    if (!MK_PER_PHASE) bar = xcd_barrier_post(ctl + CW_BAR, MISC + 8);
    const int lo = p.ph_lo, hi = p.ph_hi;
#ifndef PH_MASK
#define PH_MASK 0xffffu
#endif
#define HAS(b) ((PH_MASK >> (b)) & 1u)
#define IN(k) (lo <= (k) && (k) < hi)
#define SEAM(k) do { if (IN(k) && IN((k) + 1)) xcd_barrier(bar); } while (0)

    if (HAS(0) && IN(0)) { phase_prep(lds, p); } SEAM(0);
    if (HAS(1) && IN(1)) { phase_norm_mod(p, 0, 0, NTOK); } SEAM(1);
#define DOWN_COMBINE(L, pb, cc) \
        if (HAS(9) && IN(pb + 7 + 2 * cc)) { phase_down(lds, p, L, cc); } SEAM(pb + 7 + 2 * cc); \
        if (HAS(10) && IN(pb + 8 + 2 * cc)) { phase_combine(lds, p, L, cc); } SEAM(pb + 8 + 2 * cc);
#define LAYER(L, pb, ntok) \
        if (HAS(2) && IN(pb + 0)) { phase_zgemm(lds, p, L); } SEAM(pb + 0); \
        if (HAS(3) && IN(pb + 1)) { phase_b(lds, p, L); } SEAM(pb + 1); \
        if (HAS(4) && IN(pb + 2)) { phase_c(lds, p, L); } SEAM(pb + 2); \
        if (HAS(5) && IN(pb + 3)) { phase_d(lds, p, L); } SEAM(pb + 3); \
        if (HAS(6) && IN(pb + 4)) { phase_norm_mod(p, L, 1, ntok); } SEAM(pb + 4); \
        if (HAS(7) && IN(pb + 5)) { phase_router(lds, p, L); } SEAM(pb + 5); \
        if (HAS(8) && IN(pb + 6)) { phase_gateup(lds, p, L); } SEAM(pb + 6); \
        DOWN_COMBINE(L, pb, 0) DOWN_COMBINE(L, pb, 1) DOWN_COMBINE(L, pb, 2) DOWN_COMBINE(L, pb, 3)
    LAYER(0, PH_LAYER0, NTOK)
    if (HAS(11) && IN(PH_T0)) { convert_expert_weights(lds, p, 1); phase_norm_mod(p, 1, 0, NTOK); } SEAM(PH_T0);
    LAYER(1, PH_LAYER1, NLAT)
    if (HAS(12) && IN(PH_FINAL)) { phase_final(p); }
#undef IN
#undef SEAM
}

extern "C" void kernel_launch(void* const* d_in, const int* in_sizes, int n_in, void* d_out, int out_size, void* d_ws, size_t ws_size, hipStream_t stream) {
    static int grid = 0;
    if (grid == 0) {
        if (n_in != 29 || in_sizes[0] != NLAT * D || out_size != NLAT * D || ws_size < WS_END) {
            fprintf(stderr, "kernel_launch: unexpected shapes / workspace (n_in %d, ws %zu, need %zu); nothing launched\n", n_in, ws_size, (size_t)WS_END); grid = -1; return; }
        int dev = 0, cus = 0, per_cu = 0;
        if (hipGetDevice(&dev) != hipSuccess || hipDeviceGetAttribute(&cus, hipDeviceAttributeMultiprocessorCount, dev) != hipSuccess) { grid = -1; return; }
        if (hipFuncSetAttribute((const void*)mk_fwd, hipFuncAttributeMaxDynamicSharedMemorySize, LDS_BYTES) != hipSuccess) { grid = -1; return; }
        if (hipOccupancyMaxActiveBlocksPerMultiprocessor(&per_cu, (const void*)mk_fwd, NTHREADS, LDS_BYTES) != hipSuccess || per_cu < 1) { fprintf(stderr, "kernel_launch: occupancy query says %d\n", per_cu); }
        (void)hipGetLastError();
        grid = cus;
    }
    if (grid < 0) return;
    (void)hipMemsetAsync((char*)d_ws + WS_CTL, 0, CTL_ZERO_BYTES, stream);
    P a{};
    for (int i = 0; i < 29; ++i) a.in[i] = (const float*)d_in[i];
    a.out = (float*)d_out; a.ws = (unsigned char*)d_ws;
#if MK_PER_PHASE
    for (int ph = 0; ph < NPHASES; ++ph) { a.ph_lo = ph; a.ph_hi = ph + 1; hipLaunchKernelGGL(mk_fwd, dim3(grid), dim3(NTHREADS), LDS_BYTES, stream, a); }
#else
    a.ph_lo = 0; a.ph_hi = NPHASES;
    hipLaunchKernelGGL(mk_fwd, dim3(grid), dim3(NTHREADS), LDS_BYTES, stream, a);
#endif
}
```

```cpp
#include <hip/hip_runtime.h>
#include <cstdio>
#include <cstdint>

#ifndef MK_PER_PHASE
#define MK_PER_PHASE 0
#endif

typedef unsigned short bf16_t;
typedef short bf16x8 __attribute__((ext_vector_type(8)));
typedef float f32x4 __attribute__((ext_vector_type(4)));
typedef unsigned u32x4 __attribute__((ext_vector_type(4)));
typedef unsigned u32x2 __attribute__((ext_vector_type(2)));
#define LAS __attribute__((address_space(3)))

constexpr int D = 1024, BATCH = 16, SEQ = 2048, CTXL = 256;
constexpr int NLAT = BATCH * SEQ, NCTX = BATCH * CTXL, NTOK = NLAT + NCTX;
constexpr int ZC = 1792;
constexpr int Z_RQ = 512, Z_RK = 640, Z_RV = 768, Z_RG = 1024, Z_CQ = 1280, Z_CKV = 1536, Z_KR = 1664, Z_END = 1696;
constexpr int NEXP = 64, TOPK = 6, EDIM = 256;
constexpr int LCAP = NTOK;
constexpr float NORM_EPS = 1e-6f;
constexpr int NTHREADS = 512, NWAVES = 8;

constexpr size_t MiB = 1u << 20;
constexpr size_t WS_CTL = 0, CTL_ZERO_BYTES = 1 * MiB;
constexpr size_t WS_MODV = 1 * MiB;
constexpr size_t WS_ROPE = 2 * MiB;
constexpr size_t WS_WIN = 3 * MiB;
constexpr size_t WS_WUQ = 10 * MiB;
constexpr size_t WS_WUKV = 11 * MiB;
constexpr size_t WS_WOUT = 12 * MiB;
constexpr size_t WS_RT = 16 * MiB;
constexpr size_t WS_SHGU = 17 * MiB;
constexpr size_t WS_SHD = 19 * MiB;
constexpr size_t WS_EGU = 20 * MiB;
constexpr size_t WS_ED = 84 * MiB;
constexpr size_t WS_XC = 116 * MiB;
constexpr size_t WS_H = 132 * MiB;
constexpr size_t WS_KV = WS_H;
constexpr size_t WS_R = 204 * MiB;
constexpr size_t WS_Z = WS_R;
constexpr size_t WS_Q = WS_R + 126 * MiB;
constexpr size_t WS_K = WS_R + 180 * MiB;
constexpr size_t WS_V = WS_R + 234 * MiB;
constexpr size_t WS_CC = WS_R + 270 * MiB;
constexpr size_t WS_LTOK = WS_R;
constexpr size_t WS_LW = WS_R + 9 * MiB;
constexpr size_t WS_ACT = WS_R + 18 * MiB;
constexpr size_t WS_SLOT = WS_R + 152 * MiB;
constexpr size_t WS_SS = WS_R + 342 * MiB;
constexpr size_t WS_END = WS_SS + 2 * MiB;
static_assert(WS_SLOT + (size_t)NTOK * 7 * 256 * 2 <= WS_SS, "slots end inside R");

constexpr int CW_TMO = 0;
constexpr int CW_BAR = 4096;
constexpr int CW_ECNT = 8192;

constexpr int LDS_BYTES = 155648;
constexpr int MISC_OFF = LDS_BYTES - 256;
constexpr int RB0_OFF = 131072;
constexpr int RB1_OFF = 141312;
constexpr int ETAB_OFF = 151552;
constexpr int GEMM_LDS = 36864;
constexpr int ROWSS_OFF = 36864;
constexpr int LG_OFF = 37376;

#define XB_TMO      128
#define XB_XCNT(j)  (256  + 64 * (j))
#define XB_XSUB(j)  (1280 + 64 * (j))
#define XB_XGEN(j)  (2304 + 64 * (j))
#define XB_TOP      3328
#define XB_TOPGEN   3392
#define XCD_BAR_WORDS 3456
#define XB_SPIN_CAP (1u << 24)
__device__ __forceinline__ unsigned xb_ld(unsigned* p)              { return __hip_atomic_load(p, __ATOMIC_RELAXED, __HIP_MEMORY_SCOPE_AGENT); }
__device__ __forceinline__ unsigned xb_add(unsigned* p, unsigned v) { return __hip_atomic_fetch_add(p, v, __ATOMIC_RELAXED, __HIP_MEMORY_SCOPE_AGENT); }
__device__ __forceinline__ unsigned xb_xcc_id() { return (unsigned)__builtin_amdgcn_s_getreg((3 << 11) | 20) & 0xFu; }
#define XB_SPIN(cond, bar) do { unsigned _sp = 0; while (cond) { __builtin_amdgcn_s_sleep(1); \
    if ((++_sp & 255u) == 0u) { if (xb_ld(&(bar)[XB_TMO])) break; if (_sp > XB_SPIN_CAP) { atomicAdd(&(bar)[XB_TMO], 1u); break; } } } } while (0)
struct XcdBarrier { unsigned* bar; unsigned x; volatile LAS unsigned* st; };
__device__ __forceinline__ XcdBarrier xcd_barrier_post(unsigned* bar, volatile LAS unsigned* st) {
    XcdBarrier b; b.bar = bar; b.x = xb_xcc_id(); b.st = st;
    if (threadIdx.x == 0) (void)xb_add(&bar[XB_XCNT(b.x)], 1u);
    return b;
}
__device__ __forceinline__ void xcd_barrier_complete(unsigned* bar, unsigned x, unsigned& nloc, unsigned& nx) {
    const unsigned G = gridDim.x * gridDim.y * gridDim.z;
    unsigned sum, cnt, mine, sp = 0u;
    for (;;) {
        sum = 0u; cnt = 0u; mine = 0u;
#pragma unroll
        for (unsigned j = 0; j < 16; ++j) { const unsigned c = xb_ld(&bar[XB_XCNT(j)]); sum += c; cnt += (c > 0u) ? 1u : 0u; mine = (j == x) ? c : mine; }
        if (sum == G) break;
        __builtin_amdgcn_s_sleep(1);
        if ((++sp & 255u) == 0u) { if (xb_ld(&bar[XB_TMO])) break; if (sp > XB_SPIN_CAP) { atomicAdd(&bar[XB_TMO], 1u); break; } }
    }
    nloc = mine > 0u ? mine : 1u; nx = cnt > 0u ? cnt : 1u;
}
__device__ __forceinline__ void xcd_barrier(const XcdBarrier& b) {
    asm volatile("s_waitcnt vmcnt(0)" ::: "memory");
    __syncthreads();
    if (threadIdx.x == 0) {
        unsigned* bar = b.bar;
        __builtin_amdgcn_s_waitcnt(0);
        unsigned nloc = b.st[0], nx = b.st[1];
        if (nloc == 0u) { xcd_barrier_complete(bar, b.x, nloc, nx); b.st[0] = nloc; b.st[1] = nx; }
        const unsigned old = xb_add(&bar[XB_XSUB(b.x)], 1u);
        const unsigned gen = old / nloc;
        if (old + 1u == (gen + 1u) * nloc) {
            __builtin_amdgcn_fence(__ATOMIC_RELEASE, "agent");
            asm volatile("s_waitcnt vmcnt(0)" ::: "memory");
            const unsigned og = xb_add(&bar[XB_TOP], 1u);
            const unsigned tg = og / nx;
            if (og + 1u == (tg + 1u) * nx) xb_add(&bar[XB_TOPGEN], 1u);
            else XB_SPIN(xb_ld(&bar[XB_TOPGEN]) == tg, bar);
            __builtin_amdgcn_fence(__ATOMIC_ACQUIRE, "agent");
            xb_add(&bar[XB_XGEN(b.x)], 1u);
            asm volatile("s_waitcnt vmcnt(0)" ::: "memory");
        } else {
            XB_SPIN(xb_ld(&bar[XB_XGEN(b.x)]) == gen, bar);
            __builtin_amdgcn_fence(__ATOMIC_ACQUIRE, "agent");
            asm volatile("s_waitcnt vmcnt(0)" ::: "memory");
        }
    }
    __syncthreads();
}

__device__ __forceinline__ float bf2f(unsigned h) { return __uint_as_float(h << 16); }
__device__ __forceinline__ unsigned f2bf(float f) { unsigned u = __float_as_uint(f); return (u + 0x7fffu + ((u >> 16) & 1u)) >> 16; }
__device__ __forceinline__ unsigned pk2(float lo, float hi) { return f2bf(lo) | (f2bf(hi) << 16); }
typedef float f32x2_t __attribute__((ext_vector_type(2)));
typedef __bf16 bf16x2_t __attribute__((ext_vector_type(2)));
__device__ __forceinline__ unsigned cvtpk(float lo, float hi) { f32x2_t v = {lo, hi}; bf16x2_t b = __builtin_convertvector(v, bf16x2_t); return __builtin_bit_cast(unsigned, b); }
__device__ __forceinline__ float lo16(unsigned w) { return __uint_as_float(w << 16); }
__device__ __forceinline__ float hi16(unsigned w) { return __uint_as_float(w & 0xffff0000u); }
__device__ __forceinline__ float wave_sum(float v) {
#pragma unroll
    for (int o = 1; o < 64; o <<= 1) v += __shfl_xor(v, o);
    return v;
}
__device__ __forceinline__ float siluf(float v) { return v / (1.f + __expf(-v)); }
__device__ __forceinline__ int mod_row(int tok) { return tok < NLAT ? (tok >> 11) : 16; }

struct P { const float* in[29]; float* out; unsigned char* ws; int ph_lo, ph_hi; };

__device__ __forceinline__ float* x_row(const P& p, int tok) {
    return tok < NLAT ? p.out + (size_t)tok * D : (float*)(p.ws + WS_XC) + (size_t)(tok - NLAT) * D;
}

template <bool ROWSS, class RowSrc, class Epi>
__device__ __forceinline__ void gemm_tile(unsigned char* lds, const RowSrc& rs, const bf16_t* Bt, int ldb, int K, const Epi& epi) {
    const int tid = threadIdx.x, lane = tid & 63, wid = tid >> 6, wr = wid >> 2, wc = wid & 3, fr = lane & 15, fq = lane >> 4;
    bf16_t* As = (bf16_t*)lds; bf16_t* Bs = As + 128 * 72;
    float* rowss = (float*)(lds + ROWSS_OFF);
    const int lr = tid >> 2, lc = (tid & 3) * 16;
    const bf16_t* ap = rs(lr) + lc;
    const bf16_t* bp = Bt + (size_t)lr * ldb + lc;
    u32x4 a0 = *(const u32x4*)ap, a1 = *(const u32x4*)(ap + 8), b0 = *(const u32x4*)bp, b1 = *(const u32x4*)(bp + 8);
    f32x4 acc[4][2];
#pragma unroll
    for (int m = 0; m < 4; ++m)
#pragma unroll
        for (int n = 0; n < 2; ++n) acc[m][n] = (f32x4){0.f, 0.f, 0.f, 0.f};
    float ss = 0.f;
    for (int k0 = 0; k0 < K; k0 += 64) {
        __syncthreads();
        *(u32x4*)(As + lr * 72 + lc) = a0; *(u32x4*)(As + lr * 72 + lc + 8) = a1;
        *(u32x4*)(Bs + lr * 72 + lc) = b0; *(u32x4*)(Bs + lr * 72 + lc + 8) = b1;
        if (ROWSS) {
#pragma unroll
            for (int i = 0; i < 4; ++i) { float x0 = lo16(a0[i]), x1 = hi16(a0[i]), y0 = lo16(a1[i]), y1 = hi16(a1[i]); ss += x0 * x0 + x1 * x1 + y0 * y0 + y1 * y1; }
        }
        __syncthreads();
        if (k0 + 64 < K) { ap += 64; bp += 64; a0 = *(const u32x4*)ap; a1 = *(const u32x4*)(ap + 8); b0 = *(const u32x4*)bp; b1 = *(const u32x4*)(bp + 8); }
#pragma unroll
        for (int kk = 0; kk < 2; ++kk) {
            bf16x8 af[4], bfr[2];
#pragma unroll
            for (int m = 0; m < 4; ++m) af[m] = *(const bf16x8*)(As + (wr * 64 + m * 16 + fr) * 72 + kk * 32 + fq * 8);
#pragma unroll
            for (int n = 0; n < 2; ++n) bfr[n] = *(const bf16x8*)(Bs + (wc * 32 + n * 16 + fr) * 72 + kk * 32 + fq * 8);
#pragma unroll
            for (int m = 0; m < 4; ++m)
#pragma unroll
                for (int n = 0; n < 2; ++n) acc[m][n] = __builtin_amdgcn_mfma_f32_16x16x32_bf16(bfr[n], af[m], acc[m][n], 0, 0, 0);
        }
    }
    if (ROWSS) {
        ss += __shfl_xor(ss, 1); ss += __shfl_xor(ss, 2);
        if ((tid & 3) == 0) rowss[lr] = ss;
        __syncthreads();
    }
#pragma unroll
    for (int m = 0; m < 4; ++m)
#pragma unroll
        for (int n = 0; n < 2; ++n) epi(wr * 64 + m * 16 + fr, wc * 32 + n * 16 + 4 * fq, acc[m][n]);
}


namespace ge {
constexpr int BM = 256, BK = 64, HALF = 128, HTB = HALF * BK * 2;
__device__ __forceinline__ int lds_byte(int r, int c) { const int st = (r >> 4) * 2 + (c >> 5), rr = r & 15, cc = c & 31, ob = rr * 64 + cc * 2; return st * 1024 + (ob ^ (((ob >> 9) & 1) << 5)); }
__device__ __forceinline__ void stage_rc(int b, int& R, int& C) { const int st = b / 1024, sb = b % 1024, swz = sb ^ (((sb >> 9) & 1) << 5); R = (st >> 1) * 16 + swz / 64; C = (st & 1) * 32 + (swz % 64) / 2; }
struct Unit { const char* B; int a, b, c, d; };
typedef f32x4 Acc[2][2][4][2];

template <class Sched, class Epi, bool ALIGN_EPI>
__device__ __forceinline__ void gemm_stream(LAS unsigned char* lds, const char* Ab, int K, const Sched& S, const Epi& E) {
    const int tid = threadIdx.x, wid = __builtin_amdgcn_readfirstlane(tid >> 6), lane = tid & 63, wr = wid >> 2, wc = wid & 3, fr = lane & 15, fq = lane >> 4;
    const int nt = K / BK;
    int Rr[2], Cc[2]; unsigned voffB[2];
#pragma unroll
    for (int i = 0; i < 2; ++i) { stage_rc(tid * 16 + i * 8192, Rr[i], Cc[i]); voffB[i] = (unsigned)(Rr[i] * K + Cc[i]) * 2u; }
    const size_t kstep = (size_t)(BK * 2), hstepB = (size_t)HALF * K * 2;
    const unsigned ldsw = (unsigned)wid * 1024u;
    const int aoff = lds_byte(wr * 64 + fr, fq * 8), boff = lds_byte(wc * 32 + fr, fq * 8);
#define GE_SA(b, h) (((b) * 2 + (h)) * HTB)
#define GE_SB(b, h) ((4 + (b) * 2 + (h)) * HTB)
#define GE_GLDS(gp, ldsoff) __builtin_amdgcn_global_load_lds((const unsigned*)(gp), (LAS unsigned*)(lds + (ldsoff)), 16, 0, 0)
#define GE_STAGE_B(bufoff, gbase) do { GE_GLDS((const char*)(gbase) + voffB[0], (bufoff) + ldsw); GE_GLDS((const char*)(gbase) + voffB[1], (bufoff) + ldsw + 8192); } while (0)
#define GE_STAGE_A(bufoff, kbytes, o0, o1) do { GE_GLDS(Ab + (kbytes) + (o0), (bufoff) + ldsw); GE_GLDS(Ab + (kbytes) + (o1), (bufoff) + ldsw + 8192); } while (0)
#define GE_LDA(dst, b, h) do { _Pragma("unroll") for (int m = 0; m < 4; ++m) _Pragma("unroll") for (int k = 0; k < 2; ++k) dst[m][k] = *(const LAS bf16x8*)(lds + GE_SA(b, h) + aoff + m * 2048 + k * 1024); } while (0)
#define GE_LDB(dst, b, h) do { _Pragma("unroll") for (int n = 0; n < 2; ++n) _Pragma("unroll") for (int k = 0; k < 2; ++k) dst[n][k] = *(const LAS bf16x8*)(lds + GE_SB(b, h) + boff + n * 2048 + k * 1024); } while (0)
#define GE_MMA(ai, bj, At, Bt) do { __builtin_amdgcn_s_setprio(1); _Pragma("unroll") for (int m = 0; m < 4; ++m) _Pragma("unroll") for (int n = 0; n < 2; ++n) _Pragma("unroll") for (int k = 0; k < 2; ++k) \
        acc[ai][bj][m][n] = __builtin_amdgcn_mfma_f32_16x16x32_bf16(Bt[n][k], At[m][k], acc[ai][bj][m][n], 0, 0, 0); __builtin_amdgcn_s_setprio(0); } while (0)
#define GE_WAIT_V(n) asm volatile("s_waitcnt vmcnt(" #n ")" ::: "memory")
#define GE_WAIT_L(n) asm volatile("s_waitcnt lgkmcnt(" #n ")" ::: "memory")
#define GE_BAR __builtin_amdgcn_s_barrier()
#define GE_SCHED __builtin_amdgcn_sched_barrier(0)
    Unit cur, nxt; int ui = 0;
    if (!S.next(0, cur)) return;
    Acc acc;
#pragma unroll
    for (int a = 0; a < 2; ++a)
#pragma unroll
        for (int b = 0; b < 2; ++b)
#pragma unroll
            for (int m = 0; m < 4; ++m)
#pragma unroll
                for (int n = 0; n < 2; ++n) acc[a][b][m][n] = (f32x4){0.f, 0.f, 0.f, 0.f};
    bf16x8 At[4][2], B0[2][2], B1[2][2];
    unsigned oc00, oc01, oc10, oc11, on00, on01, on10, on11;
    oc00 = S.aoff(0, cur, Rr[0]) + (unsigned)Cc[0] * 2u; oc01 = S.aoff(0, cur, Rr[1]) + (unsigned)Cc[1] * 2u;
    oc10 = S.aoff(0, cur, Rr[0] + 128) + (unsigned)Cc[0] * 2u; oc11 = S.aoff(0, cur, Rr[1] + 128) + (unsigned)Cc[1] * 2u;
    const char* cB = cur.B;
    GE_STAGE_B(GE_SB(0, 0), cB); GE_STAGE_B(GE_SB(0, 1), cB + hstepB); GE_STAGE_A(GE_SA(0, 0), 0, oc00, oc01); GE_STAGE_A(GE_SA(0, 1), 0, oc10, oc11);
    if (wr == 1) GE_BAR;
    GE_WAIT_V(2); GE_BAR;
    GE_STAGE_B(GE_SB(1, 0), cB + kstep); GE_STAGE_A(GE_SA(1, 0), kstep, oc00, oc01); GE_STAGE_B(GE_SB(1, 1), cB + hstepB + kstep);
    GE_WAIT_V(6); GE_BAR;
    for (;;) {
        const bool has_next = S.next(ui + 1, nxt);
        const char* nB = has_next ? nxt.B : cB;
        if (has_next) {
            on00 = S.aoff(ui + 1, nxt, Rr[0]) + (unsigned)Cc[0] * 2u; on01 = S.aoff(ui + 1, nxt, Rr[1]) + (unsigned)Cc[1] * 2u;
            on10 = S.aoff(ui + 1, nxt, Rr[0] + 128) + (unsigned)Cc[0] * 2u; on11 = S.aoff(ui + 1, nxt, Rr[1] + 128) + (unsigned)Cc[1] * 2u;
        } else { on00 = oc00; on01 = oc01; on10 = oc10; on11 = oc11; }
#pragma unroll 1
        for (int t = 0; t < nt; t += 2) {
            const bool last = (t == nt - 2);
            const size_t k1 = (size_t)(t + 1) * kstep;
            const size_t k2 = last ? 0 : (size_t)(t + 2) * kstep, k3 = k2 + kstep;
            const char* b2 = last ? nB : cB + (size_t)(t + 2) * kstep; const char* b3 = b2 + kstep;
            const unsigned o00 = last ? on00 : oc00, o01 = last ? on01 : oc01, o10 = last ? on10 : oc10, o11 = last ? on11 : oc11;
            GE_LDB(B0, 0, 0); GE_LDB(B1, 0, 1); GE_SCHED; GE_LDA(At, 0, 0); GE_STAGE_A(GE_SA(1, 1), k1, oc10, oc11);
            GE_WAIT_V(8); GE_WAIT_L(0); GE_BAR; GE_MMA(0, 0, At, B0); GE_MMA(0, 1, At, B1); GE_BAR; GE_SCHED;
            GE_LDA(At, 0, 1); GE_STAGE_B(GE_SB(0, 0), b2); GE_STAGE_B(GE_SB(0, 1), b2 + hstepB); GE_STAGE_A(GE_SA(0, 0), k2, o00, o01);
            GE_WAIT_V(8); GE_WAIT_L(0); GE_BAR; GE_MMA(1, 0, At, B0); GE_MMA(1, 1, At, B1); GE_BAR; GE_SCHED;
            GE_LDB(B0, 1, 0); GE_LDB(B1, 1, 1); GE_SCHED; GE_LDA(At, 1, 0); GE_STAGE_A(GE_SA(0, 1), k2, o10, o11);
            GE_WAIT_V(8); GE_WAIT_L(0); GE_BAR; GE_MMA(0, 0, At, B0); GE_MMA(0, 1, At, B1); GE_BAR; GE_SCHED;
            GE_LDA(At, 1, 1); GE_STAGE_B(GE_SB(1, 0), b3); GE_STAGE_B(GE_SB(1, 1), b3 + hstepB); GE_STAGE_A(GE_SA(1, 0), k3, o00, o01);
            GE_WAIT_V(8); GE_WAIT_L(0); GE_BAR; GE_MMA(1, 0, At, B0); GE_MMA(1, 1, At, B1); GE_BAR; GE_SCHED;
        }
        if constexpr (ALIGN_EPI) { if (wr == 0) GE_BAR; }
        E(acc, cur, wr, wc, fr, fq);
        if (!has_next) break;
#pragma unroll
        for (int a = 0; a < 2; ++a)
#pragma unroll
            for (int b = 0; b < 2; ++b)
#pragma unroll
                for (int m = 0; m < 4; ++m)
#pragma unroll
                    for (int n = 0; n < 2; ++n) acc[a][b][m][n] = (f32x4){0.f, 0.f, 0.f, 0.f};
        cur = nxt; cB = nB; ++ui; oc00 = on00; oc01 = on01; oc10 = on10; oc11 = on11;
        if constexpr (ALIGN_EPI) { if (wr == 1) GE_BAR; }
    }
    GE_WAIT_V(0);
    if constexpr (!ALIGN_EPI) { if (wr == 0) GE_BAR; }
    GE_BAR;
#undef GE_SA
#undef GE_SB
#undef GE_GLDS
#undef GE_STAGE_A
#undef GE_STAGE_B
#undef GE_LDA
#undef GE_LDB
#undef GE_MMA
#undef GE_WAIT_V
#undef GE_WAIT_L
#undef GE_BAR
#undef GE_SCHED
}
template <class F> struct EpiFn {
    F f;
    __device__ __forceinline__ void operator()(const Acc& acc, const Unit& u, int wr, int wc, int fr, int fq) const {
#pragma unroll
        for (int ai = 0; ai < 2; ++ai)
#pragma unroll
            for (int m = 0; m < 4; ++m)
#pragma unroll
                for (int bj = 0; bj < 2; ++bj)
#pragma unroll
                    for (int n = 0; n < 2; ++n) f(u, ai * 128 + wr * 64 + m * 16 + fr, bj * 128 + wc * 32 + n * 16 + 4 * fq, acc[ai][bj][m][n]);
    }
};
struct DenseOrder {
    int nM, nN, nwg, G, c; const char* Bt; size_t btile; unsigned arow;
    __device__ __forceinline__ bool next(int i, Unit& u) const {
        const long L = (long)i * G + c; if (L >= nwg) return false;
        int wgid = (int)L; { const int q = nwg / 8, r = nwg % 8, xcd = wgid % 8, off = wgid / 8; wgid = (xcd < r ? xcd * (q + 1) : r * (q + 1) + (xcd - r) * q) + off; }
        const int nig = 8 * nN, gid = wgid / nig, fm = gid * 8, gsz = (nM - fm) < 8 ? (nM - fm) : 8;
        u.a = fm + ((wgid % nig) % gsz); u.b = (wgid % nig) / gsz; u.c = 0; u.d = 0; u.B = Bt + (size_t)u.b * btile; return true;
    }
    __device__ __forceinline__ unsigned aoff(int, const Unit& u, int R) const { return (unsigned)(u.a * 256 + R) * arow; }
};
}

struct TMap { const float* s0; const float* s1; int ld; int nvalid; const float* ksc; float gsc; };
template <int MODE> __device__ __forceinline__ const float* tmap_src(const float* s0, const float* s1, int nvalid, int n) {
    if (MODE == 0) return n < nvalid ? s0 + n : nullptr;
    if (MODE == 1) { const int h = n / 96, j = n % 96; const int c = j < 64 ? j : 64 + ((j - 64) & 1) * 16 + ((j - 64) >> 1); return s0 + h * 96 + c; }
    return ((n & 1) ? s1 : s0) + (n >> 1);
}
template <int MODE> __device__ __forceinline__ void transpose_unit(float* scr, const float* s0, const float* s1, int ld, int nvalid, const float* ksc, float gsc, int K, bf16_t* dst, int kb, int nb, int kvalid = 1 << 30) {
    const int tid = threadIdx.x, k0 = kb * 64, n0 = nb * 64;
    const int nn = tid & 63; const float* sp = tmap_src<MODE>(s0, s1, nvalid, n0 + nn);
#pragma unroll
    for (int i = 0; i < 8; ++i) {
        const int kk = (tid >> 6) + 8 * i; float v = (sp && k0 + kk < kvalid) ? sp[(size_t)(k0 + kk) * ld] : 0.f;
        if (ksc && k0 + kk < kvalid) v *= ksc[k0 + kk];
        scr[kk * 65 + nn] = v * gsc;
    }
    __syncthreads();
    {
        const int n2 = tid >> 3, kc = tid & 7; const float* s = scr + (kc * 8) * 65 + n2;
        u32x4 o; o.x = pk2(s[0], s[65]); o.y = pk2(s[2 * 65], s[3 * 65]); o.z = pk2(s[4 * 65], s[5 * 65]); o.w = pk2(s[6 * 65], s[7 * 65]);
        *(u32x4*)(dst + (size_t)(n0 + n2) * K + k0 + kc * 8) = o;
    }
    __syncthreads();
}
template <int MODE> __device__ __forceinline__ void transpose_matrix(float* scr, const float* s0, const float* s1, int ld, int nvalid, const float* ksc, float gsc, int K, int Nd, bf16_t* dst, int& rot, int kvalid = 1 << 30) {
    const int nkb = K / 64, nnb = Nd / 64, nu = nkb * nnb, G = gridDim.x;
    int first = ((int)blockIdx.x - rot) % G; if (first < 0) first += G;
    for (int u = first; u < nu; u += G) transpose_unit<MODE>(scr, s0, s1, ld, nvalid, ksc, gsc, K, dst, u / nnb, u % nnb, kvalid);
    rot = (rot + nu) % G;
}
__device__ __forceinline__ void convert_expert_weights(unsigned char* lds, const P& p, int L) {
    float* scr = (float*)lds; const int G = gridDim.x;
    bf16_t* egu = (bf16_t*)(p.ws + WS_EGU); bf16_t* ed = (bf16_t*)(p.ws + WS_ED);
    for (int u = blockIdx.x; u < NEXP * 192; u += G) {
        const int e = u / 192, r = u % 192;
        if (r < 128) {
            transpose_unit<2>(scr, p.in[22] + ((size_t)L * NEXP + e) * D * EDIM, p.in[23] + ((size_t)L * NEXP + e) * D * EDIM, EDIM, 512, nullptr, 1.f, D, egu + (size_t)e * 512 * D, r / 8, r % 8);
        } else {
            const int r2 = r - 128;
            transpose_unit<0>(scr, p.in[24] + ((size_t)L * NEXP + e) * EDIM * D, nullptr, D, D, nullptr, 1.f, EDIM, ed + (size_t)e * D * EDIM, r2 / 16, r2 % 16);
        }
    }
}
__device__ __forceinline__ void prep_mod_unit(unsigned char* lds, const P& p, int u) {
    float* sc = (float*)lds;
    float* part = sc + 17 * 1024;
    const int tid = threadIdx.x;
    const float* c = p.in[1]; const float* cctx = p.in[3];
    for (int i = tid; i < 17 * 1024; i += NTHREADS) { const int r = i >> 10, k = i & 1023; const float v = r < 16 ? c[r * 1024 + k] : cctx[k]; sc[i] = v / (1.f + expf(-v)); }
    __syncthreads();
    const int L = u / 48, cg = u % 48, kq = tid >> 7, cl = tid & 127, col = cg * 128 + cl;
    const float* w = p.in[4] + (size_t)L * 1024 * 6144 + col;
    float acc[17];
#pragma unroll
    for (int r = 0; r < 17; ++r) acc[r] = 0.f;
    for (int k = kq * 256; k < kq * 256 + 256; ++k) {
        const float wv = w[(size_t)k * 6144];
#pragma unroll
        for (int r = 0; r < 17; ++r) acc[r] += sc[r * 1024 + k] * wv;
    }
#pragma unroll
    for (int r = 0; r < 17; ++r) part[(kq * 17 + r) * 128 + cl] = acc[r];
    __syncthreads();
    float* modv = (float*)(p.ws + WS_MODV);
    for (int i = tid; i < 17 * 128; i += NTHREADS) {
        const int r = i >> 7, c2 = i & 127;
        float s = part[(0 * 17 + r) * 128 + c2] + part[(1 * 17 + r) * 128 + c2] + part[(2 * 17 + r) * 128 + c2] + part[(3 * 17 + r) * 128 + c2];
        s += p.in[5][L * 6144 + cg * 128 + c2];
        modv[((size_t)L * 17 + r) * 6144 + cg * 128 + c2] = s;
    }
    __syncthreads();
}
__device__ __forceinline__ void phase_prep(unsigned char* lds, const P& p) {
    const int tid = threadIdx.x, G = gridDim.x, bid = blockIdx.x;
    {
        float* ct = (float*)(p.ws + WS_ROPE); float* st = ct + 2048 * 16;
        for (int i = bid * NTHREADS + tid; i < 2048 * 16; i += G * NTHREADS) {
            const int pos = i >> 4, f = i & 15;
            const float inv = powf(10000.f, -(float)(f & 7) / 8.f);
            const float ang = (float)(f < 8 ? (pos >> 6) : (pos & 63)) * inv;
            ct[i] = cosf(ang); st[i] = sinf(ang);
        }
    }
    for (int u = G - 1 - bid; u < 96; u += G) prep_mod_unit(lds, p, u);
    float* scr = (float*)lds; int rot = 0;
    for (int L = 0; L < 2; ++L) {
        transpose_matrix<0>(scr, p.in[7] + (size_t)L * D * Z_END, nullptr, Z_END, Z_END, nullptr, 1.f, D, ZC, (bf16_t*)(p.ws + WS_WIN) + (size_t)L * ZC * D, rot);
        transpose_matrix<1>(scr, p.in[15] + (size_t)L * 256 * 768, nullptr, 768, 768, p.in[14] + L * 256, 0.14724574f, 256, 768, (bf16_t*)(p.ws + WS_WUQ) + (size_t)L * 768 * 256, rot);
        transpose_matrix<0>(scr, p.in[17] + (size_t)L * 128 * 1024, nullptr, 1024, 1024, p.in[16] + L * 128, 1.f, 256, 1024, (bf16_t*)(p.ws + WS_WUKV) + (size_t)L * 1024 * 256, rot, 128);
        transpose_matrix<0>(scr, p.in[18] + (size_t)L * D * D, nullptr, D, D, nullptr, 1.f, D, D, (bf16_t*)(p.ws + WS_WOUT) + (size_t)L * D * D, rot);
        transpose_matrix<0>(scr, p.in[20] + (size_t)L * D * NEXP, nullptr, NEXP, NEXP, nullptr, 1.f, D, 128, (bf16_t*)(p.ws + WS_RT) + (size_t)L * 128 * D, rot);
        transpose_matrix<2>(scr, p.in[25] + (size_t)L * D * EDIM, p.in[26] + (size_t)L * D * EDIM, EDIM, 512, nullptr, 1.f, D, 512, (bf16_t*)(p.ws + WS_SHGU) + (size_t)L * 512 * D, rot);
        transpose_matrix<0>(scr, p.in[27] + (size_t)L * EDIM * D, nullptr, D, D, nullptr, 1.f, EDIM, D, (bf16_t*)(p.ws + WS_SHD) + (size_t)L * D * EDIM, rot);
    }
    convert_expert_weights(lds, p, 0);
    {
        const f32x4* xs = (const f32x4*)p.in[0]; f32x4* xd = (f32x4*)p.out;
        for (size_t i = (size_t)bid * NTHREADS + tid; i < (size_t)NLAT * D / 4; i += (size_t)G * NTHREADS) xd[i] = xs[i];
        const f32x4* cs = (const f32x4*)p.in[2]; f32x4* cd = (f32x4*)(p.ws + WS_XC);
        for (size_t i = (size_t)bid * NTHREADS + tid; i < (size_t)NCTX * D / 4; i += (size_t)G * NTHREADS) cd[i] = cs[i];
    }
}

__device__ __forceinline__ void phase_norm_mod(const P& p, int L, int which  , int ntok) {
    const int tid = threadIdx.x, lane = tid & 63, wave = tid >> 6, gw = blockIdx.x * NWAVES + wave, NGW = gridDim.x * NWAVES;
    const float* nw = (which == 0 ? p.in[6] : p.in[19]) + L * D;
    const float* modv = (const float*)(p.ws + WS_MODV) + (size_t)L * 17 * 6144;
    bf16_t* H = (bf16_t*)(p.ws + WS_H);
    for (int tok = gw; tok < ntok; tok += NGW) {
        const f32x4* xr = (const f32x4*)x_row(p, tok) + lane;
        const float* mrow = modv + (size_t)mod_row(tok) * 6144 + which * 3072;
        f32x4 v[4]; float s = 0.f;
#pragma unroll
        for (int j = 0; j < 4; ++j) { v[j] = xr[64 * j]; s += v[j].x * v[j].x + v[j].y * v[j].y + v[j].z * v[j].z + v[j].w * v[j].w; }
        const float rstd = rsqrtf(wave_sum(s) * (1.f / D) + NORM_EPS);
        u32x2* o = (u32x2*)(H + (size_t)tok * D) + lane;
#pragma unroll
        for (int j = 0; j < 4; ++j) {
            const int k = 4 * lane + 256 * j;
            const f32x4 w4 = *(const f32x4*)(nw + k), sh = *(const f32x4*)(mrow + k), sc = *(const f32x4*)(mrow + 1024 + k);
            const float y0 = v[j].x * rstd * w4.x * (1.f + sc.x) + sh.x, y1 = v[j].y * rstd * w4.y * (1.f + sc.y) + sh.y;
            const float y2 = v[j].z * rstd * w4.z * (1.f + sc.z) + sh.z, y3 = v[j].w * rstd * w4.w * (1.f + sc.w) + sh.w;
            u32x2 w; w.x = pk2(y0, y1); w.y = pk2(y2, y3); o[64 * j] = w;
        }
    }
}

struct EpiZ {
    bf16_t* Z; float* ssq; float* sskv; bf16_t* Kb; const float* ct; const float* st;
    __device__ __forceinline__ void operator()(const ge::Acc& acc, const ge::Unit& u, int wr, int wc, int fr, int fq) const {
#pragma unroll
        for (int ai = 0; ai < 2; ++ai)
#pragma unroll
            for (int m = 0; m < 4; ++m) {
                const int row = u.a * 256 + ai * 128 + wr * 64 + m * 16 + fr;
#pragma unroll
                for (int bj = 0; bj < 2; ++bj)
#pragma unroll
                    for (int n = 0; n < 2; ++n) {
                        const f32x4 v = acc[ai][bj][m][n]; u32x2 w; w.x = cvtpk(v.x, v.y); w.y = cvtpk(v.z, v.w);
                        *(u32x2*)(Z + (size_t)row * ZC + u.b * 256 + bj * 128 + wc * 32 + n * 16 + 4 * fq) = w;
                    }
                if (u.b == 5) {
                    float sq = 0.f;
#pragma unroll
                    for (int bj = 0; bj < 2; ++bj)
#pragma unroll
                        for (int n = 0; n < 2; ++n) { const f32x4 v = acc[ai][bj][m][n]; sq += v.x * v.x + v.y * v.y + v.z * v.z + v.w * v.w; }
                    sq += __shfl_xor(sq, 16); sq += __shfl_xor(sq, 32);
                    if (fq == 0) ssq[(size_t)row * 4 + wc] = sq;
                }
                if (u.b == 6) {
                    float sq = 0.f;
#pragma unroll
                    for (int n = 0; n < 2; ++n) { const f32x4 v = acc[ai][0][m][n]; sq += v.x * v.x + v.y * v.y + v.z * v.z + v.w * v.w; }
                    sq += __shfl_xor(sq, 16); sq += __shfl_xor(sq, 32);
                    if (fq == 0) sskv[(size_t)row * 4 + wc] = sq;
                    if (wc == 0) {
                        const f32x4 x1 = acc[ai][1][m][0], x2 = acc[ai][1][m][1];
                        f32x4 c4 = (f32x4){1.f, 1.f, 1.f, 1.f}, s4 = (f32x4){0.f, 0.f, 0.f, 0.f};
                        if (row < NLAT) { const int pos = row & (SEQ - 1); c4 = *(const f32x4*)(ct + pos * 16 + 4 * fq); s4 = *(const f32x4*)(st + pos * 16 + 4 * fq); }
                        const f32x4 o1 = x1 * c4 - x2 * s4, o2 = x1 * s4 + x2 * c4;
                        u32x4 ov; ov.x = cvtpk(o1.x, o2.x); ov.y = cvtpk(o1.y, o2.y); ov.z = cvtpk(o1.z, o2.z); ov.w = cvtpk(o1.w, o2.w);
#pragma unroll
                        for (int h = 0; h < 8; ++h) *(u32x4*)(Kb + (size_t)row * 768 + h * 96 + 64 + 8 * fq) = ov;
                    }
                }
            }
    }
};
__device__ __forceinline__ void phase_zgemm(unsigned char* lds, const P& p, int L) {
    const bf16_t* W = (const bf16_t*)(p.ws + WS_WIN) + (size_t)L * ZC * D;
    ge::DenseOrder S; S.nM = NTOK / 256; S.nN = ZC / 256; S.nwg = S.nM * S.nN; S.G = gridDim.x; S.c = blockIdx.x; S.Bt = (const char*)W; S.btile = (size_t)256 * D * 2; S.arow = D * 2;
    EpiZ E{(bf16_t*)(p.ws + WS_Z), (float*)(p.ws + WS_SS), (float*)(p.ws + WS_SS) + (size_t)NTOK * 4, (bf16_t*)(p.ws + WS_K), (const float*)(p.ws + WS_ROPE), (const float*)(p.ws + WS_ROPE) + 2048 * 16};
    ge::gemm_stream<ge::DenseOrder, EpiZ, true>((LAS unsigned char*)lds, (const char*)(p.ws + WS_H), D, S, E);
}

__device__ __forceinline__ void conv_unit(unsigned char* lds, const P& p, int L, int s, int tt) {
    float* hg = (float*)lds;
    const int tid = threadIdx.x, lane = tid & 63, wave = tid >> 6;
    const int rb = s < 16 ? s * SEQ : NLAT + (s - 16) * CTXL, len = s < 16 ? SEQ : CTXL, t0 = tt * 64;
    const bf16_t* Z = (const bf16_t*)(p.ws + WS_Z);
    for (int i = tid; i < 94 * 64; i += NTHREADS) {
        const int jj = i >> 6, c4 = (i & 63) * 4, t = t0 - 15 + jj;
        f32x4 h = (f32x4){0.f, 0.f, 0.f, 0.f};
        if (t >= 0 && t < len) {
            const bf16_t* zr = Z + (size_t)(rb + t) * ZC;
            const u32x2 a = *(const u32x2*)(zr + c4), g = *(const u32x2*)(zr + 256 + c4);
            const float g0 = lo16(g.x), g1 = hi16(g.x), g2 = lo16(g.y), g3 = hi16(g.y);
            h.x = lo16(a.x) / (1.f + __expf(-g0)); h.y = hi16(a.x) / (1.f + __expf(-g1));
            h.z = lo16(a.y) / (1.f + __expf(-g2)); h.w = hi16(a.y) / (1.f + __expf(-g3));
        }
        *(f32x4*)(hg + jj * 256 + c4) = h;
    }
    float* wl = hg + 94 * 256;
    for (int i = tid; i < 31 * 64; i += NTHREADS) *(f32x4*)(wl + i * 4) = *(const f32x4*)(p.in[8] + (size_t)L * 31 * 256 + i * 4);
    __syncthreads();
    const int c0 = lane * 4;
    const f32x4 cb = *(const f32x4*)(p.in[9] + L * 256 + c0), lw = *(const f32x4*)(p.in[10] + L * 256 + c0), lb = *(const f32x4*)(p.in[11] + L * 256 + c0);
    bf16_t* CC = (bf16_t*)(p.ws + WS_CC);
    for (int q = 0; q < 8; ++q) {
        const int tl = wave * 8 + q;
        f32x4 acc = cb;
#pragma unroll 4
        for (int j = 0; j < 31; ++j) { const f32x4 h = *(const f32x4*)(hg + (tl + j) * 256 + c0); acc += h * *(const f32x4*)(wl + j * 256 + c0); }
        const float mean = wave_sum(acc.x + acc.y + acc.z + acc.w) * (1.f / 256.f);
        const f32x4 d = acc - mean;
        const float var = wave_sum(d.x * d.x + d.y * d.y + d.z * d.z + d.w * d.w) * (1.f / 256.f);
        const float rstd = rsqrtf(var + NORM_EPS);
        const f32x4 y = d * rstd * lw + lb;
        u32x2 o; o.x = pk2(siluf(y.x), siluf(y.y)); o.y = pk2(siluf(y.z), siluf(y.w));
        *(u32x2*)(CC + (size_t)(rb + t0 + tl) * D + c0) = o;
    }
    __syncthreads();
}

__device__ __forceinline__ float log2_gamma(const P& p, int L, int dir, int h) {
    const float x = p.in[12][(L * 2 + dir) * 4 + h];
    const float ls = fminf(x, 0.f) - log1pf(expf(-fabsf(x)));
    return ls * 1.4426950408889634f;
}
__device__ __forceinline__ void load_ret_qk(float* dst, const P& p, int gc, int h, int zoff, float scale) {
    const int tid = threadIdx.x, j = tid >> 2, i0 = (tid & 3) * 4, row = gc * 128 + j;
    const bf16_t* zr = (const bf16_t*)(p.ws + WS_Z) + (size_t)row * ZC + zoff + h * 32;
    const u32x2 a = *(const u32x2*)(zr + i0), b = *(const u32x2*)(zr + 16 + i0);
    float x1[4] = {lo16(a.x), hi16(a.x), lo16(a.y), hi16(a.y)}, x2[4] = {lo16(b.x), hi16(b.x), lo16(b.y), hi16(b.y)};
    const bool lat = row < NLAT; const int pos = row & (SEQ - 1);
    const float* ct = (const float*)(p.ws + WS_ROPE) + pos * 16 + i0; const float* st = ct + 2048 * 16;
#pragma unroll
    for (int i = 0; i < 4; ++i) {
        const float c = lat ? ct[i] : 1.f, s = lat ? st[i] : 0.f;
        dst[j * 33 + i0 + i] = (x1[i] * c - x2[i] * s) * scale;
        dst[j * 33 + 16 + i0 + i] = (x1[i] * s + x2[i] * c) * scale;
    }
}
__device__ __forceinline__ void load_ret_v(float* dst  , const P& p, int gc, int h) {
    const int tid = threadIdx.x, j = tid >> 2, e0 = (tid & 3) * 16;
    const bf16_t* zr = (const bf16_t*)(p.ws + WS_Z) + (size_t)(gc * 128 + j) * ZC + Z_RV + h * 64 + e0;
    const u32x4 a = *(const u32x4*)zr, b = *(const u32x4*)(zr + 8);
#pragma unroll
    for (int i = 0; i < 4; ++i) { dst[j * 64 + e0 + 2 * i] = lo16(a[i]); dst[j * 64 + e0 + 2 * i + 1] = hi16(a[i]); dst[j * 64 + e0 + 8 + 2 * i] = lo16(b[i]); dst[j * 64 + e0 + 8 + 2 * i + 1] = hi16(b[i]); }
}
__device__ __forceinline__ void retkv_unit(unsigned char* lds, const P& p, int L, int gc, int h) {
    float* ks = (float*)lds; float* vs = ks + 128 * 33; float* wf = vs + 128 * 64; float* wb = wf + 128;
    const int tid = threadIdx.x;
    const float l2f = log2_gamma(p, L, 0, h), l2b = log2_gamma(p, L, 1, h);
    load_ret_qk(ks, p, gc, h, Z_RK, 0.17677669529663687f);
    load_ret_v(vs, p, gc, h);
    if (tid < 128) { wf[tid] = exp2f(l2f * (float)(127 - tid)); wb[tid] = exp2f(l2b * (float)tid); }
    __syncthreads();
    const int d = tid >> 4, e0 = (tid & 15) * 4;
    f32x4 af = (f32x4){0.f, 0.f, 0.f, 0.f}, ab = af;
    for (int j = 0; j < 128; ++j) {
        const float kd = ks[j * 33 + d]; const f32x4 v4 = *(const f32x4*)(vs + j * 64 + e0);
        af += (kd * wf[j]) * v4; ab += (kd * wb[j]) * v4;
    }
    float* KV = (float*)(p.ws + WS_KV) + ((size_t)(gc * 4 + h) * 2) * 2048;
    *(f32x4*)(KV + d * 64 + e0) = af; *(f32x4*)(KV + 2048 + d * 64 + e0) = ab;
    __syncthreads();
}
__device__ __forceinline__ void qkv_proj(unsigned char* lds, const P& p, int L) {
    const float* ct = (const float*)(p.ws + WS_ROPE); const float* st = ct + 2048 * 16;
    const float* ssq = (const float*)(p.ws + WS_SS); const float* sskv = ssq + (size_t)NTOK * 4;
    const int G = gridDim.x, bid = blockIdx.x;
    {
        bf16_t* Q = (bf16_t*)(p.ws + WS_Q);
        ge::DenseOrder S; S.nM = NTOK / 256; S.nN = 3; S.nwg = S.nM * 3; S.G = G; S.c = bid; S.Bt = (const char*)((const bf16_t*)(p.ws + WS_WUQ) + (size_t)L * 768 * 256); S.btile = (size_t)256 * 256 * 2; S.arow = ZC * 2;
        auto f = [&](const ge::Unit& u, int r, int c, f32x4 v) {
            const int row = u.a * 256 + r, col = u.b * 256 + c, j = col % 96;
            const f32x4 s4 = *(const f32x4*)(ssq + (size_t)row * 4);
            const float rstd = rsqrtf((s4.x + s4.y + s4.z + s4.w) * (1.f / 256.f) + NORM_EPS);
            v = v * rstd;
            if (j >= 64 && row < NLAT) {
                const int i = (j - 64) >> 1, pos = row & (SEQ - 1);
                const float c0 = ct[pos * 16 + i], s0 = st[pos * 16 + i], c1 = ct[pos * 16 + i + 1], s1 = st[pos * 16 + i + 1];
                v = (f32x4){v.x * c0 - v.y * s0, v.x * s0 + v.y * c0, v.z * c1 - v.w * s1, v.z * s1 + v.w * c1};
            }
            u32x2 w; w.x = cvtpk(v.x, v.y); w.y = cvtpk(v.z, v.w); *(u32x2*)(Q + (size_t)row * 768 + col) = w;
        };
        ge::EpiFn<decltype(f)> E{f};
        ge::gemm_stream<ge::DenseOrder, ge::EpiFn<decltype(f)>, true>((LAS unsigned char*)lds, (const char*)(p.ws + WS_Z) + Z_CQ * 2, 256, S, E);
    }
    {
        bf16_t* Kb = (bf16_t*)(p.ws + WS_K); bf16_t* Vb = (bf16_t*)(p.ws + WS_V);
        ge::DenseOrder S; S.nM = NTOK / 256; S.nN = 4; S.nwg = S.nM * 4; S.G = G; S.c = (bid + 176) % G; S.Bt = (const char*)((const bf16_t*)(p.ws + WS_WUKV) + (size_t)L * 1024 * 256); S.btile = (size_t)256 * 256 * 2; S.arow = ZC * 2;
        auto f = [&](const ge::Unit& u, int r, int c, f32x4 v) {
            const int row = u.a * 256 + r, col = u.b * 256 + c, h = col >> 7, j = col & 127;
            const f32x4 s4 = *(const f32x4*)(sskv + (size_t)row * 4);
            const float rstd = rsqrtf((s4.x + s4.y + s4.z + s4.w) * (1.f / 128.f) + NORM_EPS);
            v = v * rstd;
            u32x2 w; w.x = cvtpk(v.x, v.y); w.y = cvtpk(v.z, v.w);
            if (j < 64) *(u32x2*)(Kb + (size_t)row * 768 + h * 96 + j) = w;
            else *(u32x2*)(Vb + (size_t)row * 512 + h * 64 + (j - 64)) = w;
        };
        ge::EpiFn<decltype(f)> E{f};
        ge::gemm_stream<ge::DenseOrder, ge::EpiFn<decltype(f)>, true>((LAS unsigned char*)lds, (const char*)(p.ws + WS_Z) + Z_CKV * 2, 256, S, E);
    }
}
__device__ __forceinline__ void phase_b(unsigned char* lds, const P& p, int L) {
    const int G = gridDim.x, bid = blockIdx.x;
    qkv_proj(lds, p, L);
    const int nconv = (L == 0) ? 576 : 512;
    const int nkv = 288 * 4;
    const int total = nconv + nkv;
    for (int u = (bid + 96) % G; u < total; u += G) {
        int r = u;
        if (r < nconv) { if (r < 512) conv_unit(lds, p, L, r >> 5, r & 31); else conv_unit(lds, p, L, 16 + ((r - 512) >> 2), (r - 512) & 3); continue; } r -= nconv;
        retkv_unit(lds, p, L, r >> 2, r & 3);
    }
    if (L == 1) convert_expert_weights(lds, p, 1);
}

__device__ __forceinline__ void attn_unit_naive(unsigned char* lds, const P& p, int b, int h, int qb, bool ctxq) {
    float* Ks = (float*)lds;
    float* Vs = Ks + 64 * 96;
    const int tid = threadIdx.x, half = tid & 1, qi = tid >> 1;
    const bf16_t* Qb = (const bf16_t*)(p.ws + WS_Q); const bf16_t* Kb = (const bf16_t*)(p.ws + WS_K); const bf16_t* Vb = (const bf16_t*)(p.ws + WS_V);
    const int qrow = ctxq ? NLAT + b * CTXL + qi : b * SEQ + qb * 256 + qi;
    float q[48];
    {
        const u32x4* qp = (const u32x4*)(Qb + (size_t)qrow * 768 + h * 96 + half * 48);
#pragma unroll
        for (int i = 0; i < 6; ++i) { const u32x4 w = qp[i];
#pragma unroll
            for (int k = 0; k < 4; ++k) { q[i * 8 + 2 * k] = lo16(w[k]); q[i * 8 + 2 * k + 1] = hi16(w[k]); } }
    }
    float o[32];
#pragma unroll
    for (int e = 0; e < 32; ++e) o[e] = 0.f;
    float m = -1e30f, l = 0.f;
    const int ntiles = ctxq ? 4 : 36;
#pragma unroll 1
    for (int t = 0; t < ntiles; ++t) {
        const int krow0 = t < 4 ? NLAT + b * CTXL + t * 64 : b * SEQ + (t - 4) * 64;
        __syncthreads();
        for (int i = tid; i < 64 * 12; i += NTHREADS) { const int key = i / 12, c = i % 12; const u32x4 w = *(const u32x4*)(Kb + (size_t)(krow0 + key) * 768 + h * 96 + c * 8);
            float* d = Ks + key * 96 + c * 8;
#pragma unroll
            for (int k = 0; k < 4; ++k) { d[2 * k] = lo16(w[k]); d[2 * k + 1] = hi16(w[k]); } }
        for (int i = tid; i < 64 * 8; i += NTHREADS) { const int key = i >> 3, c = i & 7; const u32x4 w = *(const u32x4*)(Vb + (size_t)(krow0 + key) * 512 + h * 64 + c * 8);
            float* d = Vs + key * 64 + c * 8;
#pragma unroll
            for (int k = 0; k < 4; ++k) { d[2 * k] = lo16(w[k]); d[2 * k + 1] = hi16(w[k]); } }
        __syncthreads();
#pragma unroll 1
        for (int j0 = 0; j0 < 64; j0 += 2) {
            float s[2]; float mt = -1e30f;
#pragma unroll
            for (int jj = 0; jj < 2; ++jj) {
                const f32x4* kr = (const f32x4*)(Ks + (j0 + jj) * 96 + half * 48);
                float a = 0.f;
#pragma unroll
                for (int d4 = 0; d4 < 12; ++d4) { const f32x4 kv = kr[d4]; a += q[4 * d4] * kv.x + q[4 * d4 + 1] * kv.y + q[4 * d4 + 2] * kv.z + q[4 * d4 + 3] * kv.w; }
                a += __shfl_xor(a, 1);
                s[jj] = a; mt = fmaxf(mt, a);
            }
            const float mn = fmaxf(m, mt), alpha = exp2f(m - mn);
            m = mn; l *= alpha;
#pragma unroll
            for (int e = 0; e < 32; ++e) o[e] *= alpha;
#pragma unroll
            for (int jj = 0; jj < 2; ++jj) {
                const float pj = exp2f(s[jj] - mn); l += pj;
                const f32x4* vr = (const f32x4*)(Vs + (j0 + jj) * 64 + half * 32);
#pragma unroll
                for (int e4 = 0; e4 < 8; ++e4) { const f32x4 vv = vr[e4]; o[4 * e4] += pj * vv.x; o[4 * e4 + 1] += pj * vv.y; o[4 * e4 + 2] += pj * vv.z; o[4 * e4 + 3] += pj * vv.w; }
            }
        }
    }
    {
        const float rl = 1.f / l;
        u32x4* op = (u32x4*)((bf16_t*)(p.ws + WS_CC) + (size_t)qrow * D + 512 + h * 64 + half * 32);
#pragma unroll
        for (int i = 0; i < 4; ++i) { u32x4 w; w.x = pk2(o[8 * i] * rl, o[8 * i + 1] * rl); w.y = pk2(o[8 * i + 2] * rl, o[8 * i + 3] * rl); w.z = pk2(o[8 * i + 4] * rl, o[8 * i + 5] * rl); w.w = pk2(o[8 * i + 6] * rl, o[8 * i + 7] * rl); op[i] = w; }
    }
    __syncthreads();
}
typedef float f32x16 __attribute__((ext_vector_type(16)));
typedef short v4i16_t __attribute__((ext_vector_type(4)));
constexpr int AT_KROW = 208;
constexpr int AT_KBUF = 64 * AT_KROW;
constexpr int AT_VBUF = 8192;
constexpr int AT_BUF = AT_KBUF + AT_VBUF;
__device__ __forceinline__ void attn_unit_mfma(unsigned char* lds, const P& p, int b, int h, int qb, bool ctxq) {
    const int tid = threadIdx.x, lane = tid & 63, wid = tid >> 6, r32 = lane & 31, hh = lane >> 5;
    const bf16_t* Qb = (const bf16_t*)(p.ws + WS_Q); const bf16_t* Kb = (const bf16_t*)(p.ws + WS_K); const bf16_t* Vb = (const bf16_t*)(p.ws + WS_V);
    const int qrow = (ctxq ? NLAT + b * CTXL : b * SEQ + qb * 256) + wid * 32 + r32;
    bf16x8 qf[6];
#pragma unroll
    for (int s = 0; s < 6; ++s) qf[s] = *(const bf16x8*)(Qb + (size_t)qrow * 768 + h * 96 + 16 * s + 8 * hh);
    f32x16 o0, o1;
#pragma unroll
    for (int r = 0; r < 16; ++r) { o0[r] = 0.f; o1[r] = 0.f; }
    float m = -1e30f, l = 0.f;
    const int ntiles = ctxq ? 4 : 36;
    const int kk0 = tid / 12, kc0 = tid % 12, kk1 = (512 + tid) / 12, kc1 = (512 + tid) % 12, vk = tid >> 3, vc = tid & 7;
    const size_t kg0 = (size_t)kk0 * 768 + h * 96 + kc0 * 8, kg1 = (size_t)kk1 * 768 + h * 96 + kc1 * 8, vg = (size_t)vk * 512 + h * 64 + vc * 8;
    const int kl0 = kk0 * AT_KROW + kc0 * 16, kl1 = kk1 * AT_KROW + kc1 * 16, vl = AT_KBUF + (vc >> 2) * 4096 + vk * 64 + (vc & 3) * 16;
    auto krow0 = [&](int t) { return t < 4 ? NLAT + b * CTXL + t * 64 : b * SEQ + (t - 4) * 64; };
    u32x4 sk0, sk1, sv;
    { const int kr = krow0(0); sk0 = *(const u32x4*)(Kb + (size_t)kr * 768 + kg0); if (tid < 256) sk1 = *(const u32x4*)(Kb + (size_t)kr * 768 + kg1); sv = *(const u32x4*)(Vb + (size_t)kr * 512 + vg); }
    __syncthreads();
    *(u32x4*)(lds + kl0) = sk0; if (tid < 256) *(u32x4*)(lds + kl1) = sk1; *(u32x4*)(lds + vl) = sv;
    __syncthreads();
    const int koff = r32 * AT_KROW + 16 * hh;
    const int voff = AT_KBUF + (4 * hh + ((lane & 15) >> 2)) * 64 + ((lane >> 4) & 1) * 32 + (lane & 3) * 8;
#pragma unroll 1
    for (int t = 0; t < ntiles; ++t) {
        unsigned char* buf = lds + (t & 1) * AT_BUF;
        if (t + 1 < ntiles) { const int kr = krow0(t + 1); sk0 = *(const u32x4*)(Kb + (size_t)kr * 768 + kg0); if (tid < 256) sk1 = *(const u32x4*)(Kb + (size_t)kr * 768 + kg1); sv = *(const u32x4*)(Vb + (size_t)kr * 512 + vg); }
        f32x16 p0, p1;
#pragma unroll
        for (int r = 0; r < 16; ++r) { p0[r] = 0.f; p1[r] = 0.f; }
#pragma unroll
        for (int s = 0; s < 6; ++s) {
            const bf16x8 k0f = *(const bf16x8*)(buf + koff + 32 * s), k1f = *(const bf16x8*)(buf + koff + 32 * AT_KROW + 32 * s);
            p0 = __builtin_amdgcn_mfma_f32_32x32x16_bf16(k0f, qf[s], p0, 0, 0, 0);
            p1 = __builtin_amdgcn_mfma_f32_32x32x16_bf16(k1f, qf[s], p1, 0, 0, 0);
        }
        float mt = fmaxf(p0[0], p1[0]);
#pragma unroll
        for (int r = 1; r < 16; ++r) mt = fmaxf(mt, fmaxf(p0[r], p1[r]));
        mt = fmaxf(mt, __shfl_xor(mt, 32));
        const float mn = fmaxf(m, mt), alpha = __builtin_amdgcn_exp2f(m - mn);
        m = mn;
        float ls = 0.f;
#pragma unroll
        for (int r = 0; r < 16; ++r) { p0[r] = __builtin_amdgcn_exp2f(p0[r] - mn); p1[r] = __builtin_amdgcn_exp2f(p1[r] - mn); ls += p0[r] + p1[r]; }
        l = l * alpha + ls;
#pragma unroll
        for (int r = 0; r < 16; ++r) { o0[r] *= alpha; o1[r] *= alpha; }
        u32x4 pw[4];
#pragma unroll
        for (int s2 = 0; s2 < 2; ++s2) {
            pw[s2] = (u32x4){cvtpk(p0[8 * s2], p0[8 * s2 + 1]), cvtpk(p0[8 * s2 + 2], p0[8 * s2 + 3]), cvtpk(p0[8 * s2 + 4], p0[8 * s2 + 5]), cvtpk(p0[8 * s2 + 6], p0[8 * s2 + 7])};
            pw[2 + s2] = (u32x4){cvtpk(p1[8 * s2], p1[8 * s2 + 1]), cvtpk(p1[8 * s2 + 2], p1[8 * s2 + 3]), cvtpk(p1[8 * s2 + 4], p1[8 * s2 + 5]), cvtpk(p1[8 * s2 + 6], p1[8 * s2 + 7])};
        }
#pragma unroll
        for (int ks = 0; ks < 4; ++ks) {
            const LAS unsigned char* vb = (const LAS unsigned char*)(buf + voff + ks * 16 * 64);
            const v4i16_t a0 = __builtin_amdgcn_ds_read_tr16_b64_v4i16((LAS v4i16_t*)(vb)), a1 = __builtin_amdgcn_ds_read_tr16_b64_v4i16((LAS v4i16_t*)(vb + 8 * 64));
            const v4i16_t c0 = __builtin_amdgcn_ds_read_tr16_b64_v4i16((LAS v4i16_t*)(vb + 4096)), c1 = __builtin_amdgcn_ds_read_tr16_b64_v4i16((LAS v4i16_t*)(vb + 4096 + 8 * 64));
            const bf16x8 va = (bf16x8){a0[0], a0[1], a0[2], a0[3], a1[0], a1[1], a1[2], a1[3]}, vc2 = (bf16x8){c0[0], c0[1], c0[2], c0[3], c1[0], c1[1], c1[2], c1[3]};
            const bf16x8 pf = __builtin_bit_cast(bf16x8, pw[ks]);
            o0 = __builtin_amdgcn_mfma_f32_32x32x16_bf16(va, pf, o0, 0, 0, 0);
            o1 = __builtin_amdgcn_mfma_f32_32x32x16_bf16(vc2, pf, o1, 0, 0, 0);
        }
        if (t + 1 < ntiles) { unsigned char* nb = lds + ((t + 1) & 1) * AT_BUF; *(u32x4*)(nb + kl0) = sk0; if (tid < 256) *(u32x4*)(nb + kl1) = sk1; *(u32x4*)(nb + vl) = sv; }
        __syncthreads();
    }
    l += __shfl_xor(l, 32);
    const float rl = 1.f / l;
    bf16_t* orow = (bf16_t*)(p.ws + WS_CC) + (size_t)qrow * D + 512 + h * 64 + 4 * hh;
#pragma unroll
    for (int r4 = 0; r4 < 4; ++r4) {
        u32x2 w0; w0.x = cvtpk(o0[4 * r4] * rl, o0[4 * r4 + 1] * rl); w0.y = cvtpk(o0[4 * r4 + 2] * rl, o0[4 * r4 + 3] * rl);
        u32x2 w1; w1.x = cvtpk(o1[4 * r4] * rl, o1[4 * r4 + 1] * rl); w1.y = cvtpk(o1[4 * r4 + 2] * rl, o1[4 * r4 + 3] * rl);
        *(u32x2*)(orow + 8 * r4) = w0; *(u32x2*)(orow + 32 + 8 * r4) = w1;
    }
}
__device__ __forceinline__ void retout_unit(unsigned char* lds, const P& p, int L, int gc, int h) {
    float* qs = (float*)lds; float* ks = qs + 128 * 33; float* vs = ks + 128 * 33; float* Sf = vs + 128 * 64; float* Sb = Sf + 2048;
    const int tid = threadIdx.x;
    const float l2f = log2_gamma(p, L, 0, h), l2b = log2_gamma(p, L, 1, h);
    load_ret_qk(qs, p, gc, h, Z_RQ, 1.f);
    load_ret_qk(ks, p, gc, h, Z_RK, 0.17677669529663687f);
    load_ret_v(vs, p, gc, h);
    {
        const bool lat = gc < 256; const int b = lat ? gc >> 4 : (gc - 256) >> 1;
        const int mme = lat ? 2 + (gc & 15) : (gc - 256) & 1;
        const int u = mme, w = mme < 2 ? 1 - mme : 19 - mme;
        f32x4 sf = (f32x4){0.f, 0.f, 0.f, 0.f}, sb = sf;
        const float* KVb = (const float*)(p.ws + WS_KV);
#pragma unroll 1
        for (int mm = 0; mm < 18; ++mm) {
            const int gcm = mm < 2 ? 256 + b * 2 + mm : b * 16 + (mm - 2);
            const int um = mm, wm = mm < 2 ? 1 - mm : 19 - mm;
            const float* kv = KVb + ((size_t)(gcm * 4 + h) * 2) * 2048 + tid * 4;
            if (um < u) { const float wgt = exp2f(l2f * 128.f * (float)(u - 1 - um)); sf += wgt * *(const f32x4*)kv; }
            if (wm < w) { const float wgt = exp2f(l2b * 128.f * (float)(w - 1 - wm)); sb += wgt * *(const f32x4*)(kv + 2048); }
        }
        *(f32x4*)(Sf + tid * 4) = sf; *(f32x4*)(Sb + tid * 4) = sb;
    }
    __syncthreads();
    const int i = tid >> 2, e0 = (tid & 3) * 16;
    float q[32];
#pragma unroll
    for (int d = 0; d < 32; ++d) q[d] = qs[i * 33 + d];
    float acc[16];
#pragma unroll
    for (int e = 0; e < 16; ++e) acc[e] = 0.f;
#pragma unroll 1
    for (int j = 0; j < 128; ++j) {
        float s = 0.f;
#pragma unroll
        for (int d = 0; d < 32; ++d) s += q[d] * ks[j * 33 + d];
        float wgt = 0.f;
        if (j <= i) wgt += exp2f(l2f * (float)(i - j));
        if (j >= i) wgt += exp2f(l2b * (float)(j - i));
        s *= wgt;
#pragma unroll
        for (int e4 = 0; e4 < 4; ++e4) { const f32x4 v4 = *(const f32x4*)(vs + j * 64 + e0 + 4 * e4); acc[4 * e4] += s * v4.x; acc[4 * e4 + 1] += s * v4.y; acc[4 * e4 + 2] += s * v4.z; acc[4 * e4 + 3] += s * v4.w; }
    }
    {
        const float cf = exp2f(l2f * (float)(i + 1)), cb = exp2f(l2b * (float)(128 - i));
#pragma unroll 2
        for (int d = 0; d < 32; ++d) {
            const float qd = qs[i * 33 + d]; const float qf = qd * cf, qb = qd * cb;
#pragma unroll
            for (int e4 = 0; e4 < 4; ++e4) { const f32x4 a = *(const f32x4*)(Sf + d * 64 + e0 + 4 * e4), bq = *(const f32x4*)(Sb + d * 64 + e0 + 4 * e4);
                acc[4 * e4] += qf * a.x + qb * bq.x; acc[4 * e4 + 1] += qf * a.y + qb * bq.y; acc[4 * e4 + 2] += qf * a.z + qb * bq.z; acc[4 * e4 + 3] += qf * a.w + qb * bq.w; }
        }
    }
    float s1 = 0.f;
#pragma unroll
    for (int e = 0; e < 16; ++e) s1 += acc[e];
    s1 += __shfl_xor(s1, 1); s1 += __shfl_xor(s1, 2);
    const float mu = s1 * (1.f / 64.f);
    float s2 = 0.f;
#pragma unroll
    for (int e = 0; e < 16; ++e) { const float dd = acc[e] - mu; s2 += dd * dd; }
    s2 += __shfl_xor(s2, 1); s2 += __shfl_xor(s2, 2);
    const float rstd = rsqrtf(s2 * (1.f / 64.f) + NORM_EPS);
    const int row = gc * 128 + i;
    const bf16_t* zg = (const bf16_t*)(p.ws + WS_Z) + (size_t)row * ZC + Z_RG + h * 64 + e0;
    const float* gw = p.in[13] + L * 256 + h * 64 + e0;
    const u32x4 g0 = *(const u32x4*)zg, g1 = *(const u32x4*)(zg + 8);
    float g[16];
#pragma unroll
    for (int k = 0; k < 4; ++k) { g[2 * k] = lo16(g0[k]); g[2 * k + 1] = hi16(g0[k]); g[8 + 2 * k] = lo16(g1[k]); g[8 + 2 * k + 1] = hi16(g1[k]); }
    unsigned o[8];
#pragma unroll
    for (int k = 0; k < 8; ++k) {
        const float y0 = siluf(g[2 * k]) * ((acc[2 * k] - mu) * rstd * gw[2 * k]), y1 = siluf(g[2 * k + 1]) * ((acc[2 * k + 1] - mu) * rstd * gw[2 * k + 1]);
        o[k] = pk2(y0, y1);
    }
    u32x4* op = (u32x4*)((bf16_t*)(p.ws + WS_CC) + (size_t)row * D + 256 + h * 64 + e0);
    u32x4 w0; w0.x = o[0]; w0.y = o[1]; w0.z = o[2]; w0.w = o[3]; u32x4 w1; w1.x = o[4]; w1.y = o[5]; w1.z = o[6]; w1.w = o[7];
    op[0] = w0; op[1] = w1;
    __syncthreads();
}
__device__ __forceinline__ void phase_c(unsigned char* lds, const P& p, int L) {
    const int G = gridDim.x, bid = blockIdx.x;
    const int nat = 16 * 8 * 8, nac = (L == 0) ? 128 : 0, nro = (L == 0 ? 288 : 256) * 4;
    const int total = nat + nac + nro;
    for (int u = bid; u < total; u += G) {
        int r = u;
#ifndef TEST_C
#define TEST_C 3
#endif
        if (r < nat) { if (TEST_C & 1) attn_unit_mfma(lds, p, r >> 6, (r >> 3) & 7, r & 7, false); continue; } r -= nat;
        if (r < nac) { if (TEST_C & 1) attn_unit_mfma(lds, p, r >> 3, r & 7, 0, true); continue; } r -= nac;
        if (TEST_C & 2) retout_unit(lds, p, L, r >> 2, r & 3);
    }
}

__device__ __forceinline__ void phase_d(unsigned char* lds, const P& p, int L) {
    const float* modv = (const float*)(p.ws + WS_MODV) + (size_t)L * 17 * 6144;
    ge::DenseOrder S; S.nM = (L == 0 ? NTOK : NLAT) / 256; S.nN = 4; S.nwg = S.nM * 4; S.G = gridDim.x; S.c = blockIdx.x;
    S.Bt = (const char*)((const bf16_t*)(p.ws + WS_WOUT) + (size_t)L * D * D); S.btile = (size_t)256 * D * 2; S.arow = D * 2;
    auto f = [&](const ge::Unit& u, int r, int c, f32x4 v) {
        const int row = u.a * 256 + r, col = u.b * 256 + c;
        const f32x4 g = *(const f32x4*)(modv + (size_t)mod_row(row) * 6144 + 2048 + col);
        f32x4* xp = (f32x4*)(x_row(p, row) + col);
        *xp = *xp + g * v;
    };
    ge::EpiFn<decltype(f)> E{f};
    ge::gemm_stream<ge::DenseOrder, ge::EpiFn<decltype(f)>, true>((LAS unsigned char*)lds, (const char*)(p.ws + WS_CC), D, S, E);
}

__device__ __forceinline__ void norm_mod_row(const P& p, int L, int which, int tok, int lane) {
    const float* nw = (which == 0 ? p.in[6] : p.in[19]) + L * D;
    const float* mrow = (const float*)(p.ws + WS_MODV) + ((size_t)L * 17 + mod_row(tok)) * 6144 + which * 3072;
    const f32x4* xr = (const f32x4*)x_row(p, tok) + lane;
    f32x4 v[4]; float s = 0.f;
#pragma unroll
    for (int j = 0; j < 4; ++j) { v[j] = xr[64 * j]; s += v[j].x * v[j].x + v[j].y * v[j].y + v[j].z * v[j].z + v[j].w * v[j].w; }
    const float rstd = rsqrtf(wave_sum(s) * (1.f / D) + NORM_EPS);
    u32x2* o = (u32x2*)((bf16_t*)(p.ws + WS_H) + (size_t)tok * D) + lane;
#pragma unroll
    for (int j = 0; j < 4; ++j) {
        const int k = 4 * lane + 256 * j;
        const f32x4 w4 = *(const f32x4*)(nw + k), sh = *(const f32x4*)(mrow + k), sc = *(const f32x4*)(mrow + 1024 + k);
        const f32x4 y = v[j] * rstd * w4 * (sc + 1.f) + sh;
        u32x2 w; w.x = cvtpk(y.x, y.y); w.y = cvtpk(y.z, y.w); o[64 * j] = w;
    }
}
__device__ __forceinline__ void phase_router(unsigned char* lds, const P& p, int L) {
    const bf16_t* H = (const bf16_t*)(p.ws + WS_H); const bf16_t* W = (const bf16_t*)(p.ws + WS_RT) + (size_t)L * 128 * D;
    float* lg = (float*)(lds + LG_OFF);
    unsigned* ecnt = (unsigned*)(p.ws + WS_CTL) + CW_ECNT + L * 4096;
    int* ltok = (int*)(p.ws + WS_LTOK); float* lw = (float*)(p.ws + WS_LW);
    const int tid = threadIdx.x, lane = tid & 63, wave = tid >> 6;
    const float rb = p.in[21][L * NEXP + lane];
    const int nmt = (L == 0 ? NTOK : NLAT) / 128;
    for (int mt = blockIdx.x; mt < nmt; mt += gridDim.x) {
        for (int q = 0; q < 16; ++q) norm_mod_row(p, L, 1, mt * 128 + wave * 16 + q, lane);
        asm volatile("s_waitcnt vmcnt(0)" ::: "memory");
        __syncthreads();
        auto rs = [&](int pr) { return H + (size_t)(mt * 128 + pr) * D; };
        auto epi = [&](int r, int c, f32x4 v) { if (c < 64) *(f32x4*)(lg + r * 64 + c) = v; };
        gemm_tile<false>(lds, rs, W, D, D, epi);
        __syncthreads();
        for (int q = 0; q < 16; ++q) {
            const int tl = wave * 16 + q, tok = mt * 128 + tl;
            const float x = lg[tl * 64 + lane];
            const float sc = 1.f / (1.f + expf(-x));
            float sel = sc + rb; float wsum = 0.f; int myk = -1;
#pragma unroll
            for (int k = 0; k < TOPK; ++k) {
                float bv = sel; int bi = lane;
#pragma unroll
                for (int off = 32; off >= 1; off >>= 1) {
                    const float ov = __shfl_xor(bv, off); const int oi = __shfl_xor(bi, off);
                    if (ov > bv || (ov == bv && oi < bi)) { bv = ov; bi = oi; }
                }
                wsum += __shfl(sc, bi);
                if (lane == bi) { myk = k; sel = -INFINITY; }
            }
            if (myk >= 0) {
                const unsigned pos = atomicAdd(ecnt + lane * 64, 1u);
                ltok[(size_t)lane * LCAP + pos] = tok * 8 + myk;
                lw[(size_t)lane * LCAP + pos] = sc / wsum * 2.5f;
            }
        }
    }
}

__device__ __forceinline__ int build_etab(unsigned char* lds, const P& p, int L) {
    int* tstart = (int*)(lds + ETAB_OFF); int* cnt = tstart + 80;
    unsigned* ecnt = (unsigned*)(p.ws + WS_CTL) + CW_ECNT + L * 4096;
    __syncthreads();
    if (threadIdx.x < 64) cnt[threadIdx.x] = (int)__hip_atomic_load(ecnt + threadIdx.x * 64, __ATOMIC_RELAXED, __HIP_MEMORY_SCOPE_AGENT);
    __syncthreads();
    if (threadIdx.x == 0) { int s = 0; for (int e = 0; e < 64; ++e) { tstart[e] = s; s += (cnt[e] + 255) >> 8; } tstart[64] = s; tstart[65] = s + (L == 0 ? NTOK : NLAT) / 256; }
    __syncthreads();
    return tstart[65];
}
struct MoeOrder {
    int TT, nN, G, c; const int* tstart; const char* Bexp; size_t bexp; const char* Bsh; size_t btile; const int* rowbuf; unsigned arow; bool ident;
    __device__ __forceinline__ bool next(int i, ge::Unit& u) const {
        const int Lq = i * G + c; if (Lq >= TT * nN) return false;
        const int t = Lq / nN, pn = Lq % nN;
        int lo = 0, hi = 64;
        while (lo < hi) { const int mid = (lo + hi + 1) >> 1; if (tstart[mid] <= t) lo = mid; else hi = mid - 1; }
        const int e = __builtin_amdgcn_readfirstlane(lo);
        u.a = t; u.b = pn; u.c = e; u.d = i;
        u.B = (e < 64 ? Bexp + (size_t)e * bexp : Bsh) + (size_t)pn * btile;
        return true;
    }
    __device__ __forceinline__ unsigned aoff(int i, const ge::Unit& u, int R) const { return (unsigned)(ident ? u.a * 256 + R : rowbuf[i * 256 + R]) * arow; }
};
__device__ __forceinline__ void phase_gateup(unsigned char* lds, const P& p, int L) {
    const int TT = build_etab(lds, p, L);
    const int* tstart = (const int*)(lds + ETAB_OFF); const int* cnt = tstart + 80;
    int* rowbuf = (int*)(lds + RB0_OFF); float* wbuf = (float*)(lds + RB1_OFF);
    const int* ltok = (const int*)(p.ws + WS_LTOK); const float* lw = (const float*)(p.ws + WS_LW);
    bf16_t* ACT = (bf16_t*)(p.ws + WS_ACT);
    const int G = gridDim.x, bid = blockIdx.x, vcu = (G % 8 == 0) ? (bid % 8) * (G / 8) + bid / 8 : bid;
    MoeOrder S; S.TT = TT; S.nN = 2; S.G = G; S.c = vcu; S.tstart = tstart; S.Bexp = (const char*)(p.ws + WS_EGU); S.bexp = (size_t)512 * D * 2;
    S.Bsh = (const char*)((const bf16_t*)(p.ws + WS_SHGU) + (size_t)L * 512 * D); S.btile = (size_t)256 * D * 2; S.rowbuf = rowbuf; S.arow = D * 2; S.ident = false;
    {
        ge::Unit u;
        for (int i = 0; i < 10 && S.next(i, u); ++i) {
            if (threadIdx.x < 256) {
                const int R = threadIdx.x, e = u.c, mt = u.a - tstart[e];
                int tok; float w;
                if (e < 64) { const int lp = mt * 256 + R; const bool ok = lp < cnt[e]; tok = ok ? (ltok[(size_t)e * LCAP + lp] >> 3) : 0; w = ok ? lw[(size_t)e * LCAP + lp] : 0.f; }
                else { tok = mt * 256 + R; w = 1.f; }
                rowbuf[i * 256 + R] = tok; wbuf[i * 256 + R] = w;
            }
        }
        __syncthreads();
    }
    auto f = [&](const ge::Unit& u, int r, int c, f32x4 v) {
        const float w = wbuf[u.d * 256 + r];
        const float a0 = siluf(v.x) * v.y * w, a1 = siluf(v.z) * v.w * w;
        *(unsigned*)(ACT + (size_t)(u.a * 256 + r) * EDIM + ((u.b * 256 + c) >> 1)) = cvtpk(a0, a1);
    };
    ge::EpiFn<decltype(f)> E{f};
    ge::gemm_stream<MoeOrder, ge::EpiFn<decltype(f)>, true>((LAS unsigned char*)lds, (const char*)(p.ws + WS_H), D, S, E);
}
__device__ __forceinline__ void phase_down(unsigned char* lds, const P& p, int L, int cc) {
    const int TT = build_etab(lds, p, L);
    const int* tstart = (const int*)(lds + ETAB_OFF); const int* cnt = tstart + 80;
    int* sbuf = (int*)(lds + RB0_OFF);
    const int* ltok = (const int*)(p.ws + WS_LTOK);
    bf16_t* SLOT = (bf16_t*)(p.ws + WS_SLOT);
    const int G = gridDim.x, bid = blockIdx.x, vcu = (G % 8 == 0) ? (bid % 8) * (G / 8) + bid / 8 : bid;
    MoeOrder S; S.TT = TT; S.nN = 1; S.G = G; S.c = vcu; S.tstart = tstart; S.Bexp = (const char*)(p.ws + WS_ED) + (size_t)cc * 256 * EDIM * 2; S.bexp = (size_t)D * EDIM * 2;
    S.Bsh = (const char*)((const bf16_t*)(p.ws + WS_SHD) + (size_t)L * D * EDIM) + (size_t)cc * 256 * EDIM * 2; S.btile = 0; S.rowbuf = sbuf; S.arow = EDIM * 2; S.ident = true;
    {
        ge::Unit u;
        for (int i = 0; i < 10 && S.next(i, u); ++i) {
            if (threadIdx.x < 256) {
                const int R = threadIdx.x, e = u.c, mt = u.a - tstart[e];
                int srow;
                if (e < 64) { const int lp = mt * 256 + R; if (lp < cnt[e]) { const int ent = ltok[(size_t)e * LCAP + lp]; srow = (ent >> 3) * 7 + (ent & 7); } else srow = -1; }
                else srow = (mt * 256 + R) * 7 + 6;
                sbuf[i * 256 + R] = srow;
            }
        }
        __syncthreads();
    }
    auto f = [&](const ge::Unit& u, int r, int c, f32x4 v) {
        const int srow = sbuf[u.d * 256 + r];
        if (srow >= 0) { u32x2 w; w.x = cvtpk(v.x, v.y); w.y = cvtpk(v.z, v.w); *(u32x2*)(SLOT + (size_t)srow * 256 + c) = w; }
    };
    ge::EpiFn<decltype(f)> E{f};
    ge::gemm_stream<MoeOrder, ge::EpiFn<decltype(f)>, true>((LAS unsigned char*)lds, (const char*)(p.ws + WS_ACT), EDIM, S, E);
}
__device__ __forceinline__ void phase_combine(const P& p, int L, int cc) {
    const int tid = threadIdx.x, lane = tid & 63, wave = tid >> 6, gw = blockIdx.x * NWAVES + wave, NGW = gridDim.x * NWAVES;
    const bf16_t* SLOT = (const bf16_t*)(p.ws + WS_SLOT);
    const float* modv = (const float*)(p.ws + WS_MODV) + (size_t)L * 17 * 6144;
    const int ntok = (L == 0 ? NTOK : NLAT);
    for (int tok = gw; tok < ntok; tok += NGW) {
        f32x4 acc = (f32x4){0.f, 0.f, 0.f, 0.f};
#pragma unroll
        for (int k = 0; k < 7; ++k) { const u32x2 w = *(const u32x2*)(SLOT + ((size_t)tok * 7 + k) * 256 + lane * 4); acc.x += lo16(w.x); acc.y += hi16(w.x); acc.z += lo16(w.y); acc.w += hi16(w.y); }
        const int col = cc * 256 + lane * 4;
        const f32x4 g = *(const f32x4*)(modv + (size_t)mod_row(tok) * 6144 + 5120 + col);
        f32x4* xp = (f32x4*)(x_row(p, tok) + col);
        *xp = *xp + g * acc;
        if (cc == 3) {
            asm volatile("s_waitcnt vmcnt(0)" ::: "memory");
            if (L == 0) norm_mod_row(p, 1, 0, tok, lane);
            else {
                f32x4* xr = (f32x4*)(p.out + (size_t)tok * D) + lane; const float* nw = p.in[28];
                f32x4 v[4]; float s = 0.f;
#pragma unroll
                for (int j = 0; j < 4; ++j) { v[j] = xr[64 * j]; s += v[j].x * v[j].x + v[j].y * v[j].y + v[j].z * v[j].z + v[j].w * v[j].w; }
                const float rstd = rsqrtf(wave_sum(s) * (1.f / D) + NORM_EPS);
#pragma unroll
                for (int j = 0; j < 4; ++j) { const f32x4 w4 = *(const f32x4*)(nw + 4 * lane + 256 * j); xr[64 * j] = v[j] * rstd * w4; }
            }
        }
    }
}

constexpr int PH_LAYER0 = 2, PH_PER_LAYER = 14, PH_LAYER1 = PH_LAYER0 + PH_PER_LAYER, NPHASES = PH_LAYER1 + PH_PER_LAYER;

__global__ void __launch_bounds__(NTHREADS, 2) mk_fwd(P p) {
    extern __shared__ __attribute__((aligned(16))) unsigned char lds[];
    volatile LAS unsigned* MISC = (volatile LAS unsigned*)((LAS unsigned char*)lds + MISC_OFF);
    if (threadIdx.x < 64) MISC[threadIdx.x] = 0u;
    __syncthreads();
    unsigned* ctl = (unsigned*)(p.ws + WS_CTL);
    XcdBarrier bar; bar.bar = ctl + CW_BAR; bar.x = 0; bar.st = MISC + 8;
    if (!MK_PER_PHASE) bar = xcd_barrier_post(ctl + CW_BAR, MISC + 8);
    const int lo = p.ph_lo, hi = p.ph_hi;
#ifndef PH_MASK
#define PH_MASK 0xffffu
#endif
#define HAS(b) ((PH_MASK >> (b)) & 1u)
#define IN(k) (lo <= (k) && (k) < hi)
#define SEAM(k) do { if (IN(k) && IN((k) + 1)) xcd_barrier(bar); } while (0)

    if (HAS(0) && IN(0)) { phase_prep(lds, p); } SEAM(0);
    if (HAS(1) && IN(1)) { phase_norm_mod(p, 0, 0, NTOK); } SEAM(1);
#define DOWN_COMBINE(L, pb, cc) \
        if (HAS(9) && IN(pb + 6 + 2 * cc)) { phase_down(lds, p, L, cc); } SEAM(pb + 6 + 2 * cc); \
        if (HAS(10) && IN(pb + 7 + 2 * cc)) { phase_combine(p, L, cc); } SEAM(pb + 7 + 2 * cc);
#define LAYER(L, pb) \
        if (HAS(2) && IN(pb + 0)) { phase_zgemm(lds, p, L); } SEAM(pb + 0); \
        if (HAS(3) && IN(pb + 1)) { phase_b(lds, p, L); } SEAM(pb + 1); \
        if (HAS(4) && IN(pb + 2)) { phase_c(lds, p, L); } SEAM(pb + 2); \
        if (HAS(5) && IN(pb + 3)) { phase_d(lds, p, L); } SEAM(pb + 3); \
        if (HAS(7) && IN(pb + 4)) { phase_router(lds, p, L); } SEAM(pb + 4); \
        if (HAS(8) && IN(pb + 5)) { phase_gateup(lds, p, L); } SEAM(pb + 5); \
        DOWN_COMBINE(L, pb, 0) DOWN_COMBINE(L, pb, 1) DOWN_COMBINE(L, pb, 2) DOWN_COMBINE(L, pb, 3)
    LAYER(0, PH_LAYER0)
    LAYER(1, PH_LAYER1)
#undef IN
#undef SEAM
}

extern "C" void kernel_launch(void* const* d_in, const int* in_sizes, int n_in, void* d_out, int out_size, void* d_ws, size_t ws_size, hipStream_t stream) {
    static int grid = 0;
    if (grid == 0) {
        if (n_in != 29 || in_sizes[0] != NLAT * D || out_size != NLAT * D || ws_size < WS_END) {
            fprintf(stderr, "kernel_launch: unexpected shapes / workspace (n_in %d, ws %zu, need %zu); nothing launched\n", n_in, ws_size, (size_t)WS_END); grid = -1; return; }
        int dev = 0, cus = 0, per_cu = 0;
        if (hipGetDevice(&dev) != hipSuccess || hipDeviceGetAttribute(&cus, hipDeviceAttributeMultiprocessorCount, dev) != hipSuccess) { grid = -1; return; }
        if (hipFuncSetAttribute((const void*)mk_fwd, hipFuncAttributeMaxDynamicSharedMemorySize, LDS_BYTES) != hipSuccess) { grid = -1; return; }
        if (hipOccupancyMaxActiveBlocksPerMultiprocessor(&per_cu, (const void*)mk_fwd, NTHREADS, LDS_BYTES) != hipSuccess || per_cu < 1) { fprintf(stderr, "kernel_launch: occupancy query says %d\n", per_cu); }
        (void)hipGetLastError();
        grid = cus;
    }
    if (grid < 0) return;
    (void)hipMemsetAsync((char*)d_ws + WS_CTL, 0, CTL_ZERO_BYTES, stream);
    P a{};
    for (int i = 0; i < 29; ++i) a.in[i] = (const float*)d_in[i];
    a.out = (float*)d_out; a.ws = (unsigned char*)d_ws;
#if MK_PER_PHASE
    for (int ph = 0; ph < NPHASES; ++ph) { a.ph_lo = ph; a.ph_hi = ph + 1; hipLaunchKernelGGL(mk_fwd, dim3(grid), dim3(NTHREADS), LDS_BYTES, stream, a); }
#else
    a.ph_lo = 0; a.ph_hi = NPHASES;
    hipLaunchKernelGGL(mk_fwd, dim3(grid), dim3(NTHREADS), LDS_BYTES, stream, a);
#endif
}
```

```cpp
#include <hip/hip_runtime.h>
#include <cstdio>
#include <cstdint>

#ifndef MK_PER_PHASE
#define MK_PER_PHASE 0
#endif

typedef unsigned short bf16_t;
typedef short bf16x8 __attribute__((ext_vector_type(8)));
typedef float f32x4 __attribute__((ext_vector_type(4)));
typedef unsigned u32x4 __attribute__((ext_vector_type(4)));
typedef unsigned u32x2 __attribute__((ext_vector_type(2)));
typedef float f32x16 __attribute__((ext_vector_type(16)));
typedef short v4i16_t __attribute__((ext_vector_type(4)));
#define LAS __attribute__((address_space(3)))

constexpr int D = 1024, BATCH = 16, SEQ = 2048, CTXL = 256;
constexpr int NLAT = BATCH * SEQ, NCTX = BATCH * CTXL, NTOK = NLAT + NCTX;
constexpr int ZC = 1792;
constexpr int Z_RQ = 512, Z_RK = 640, Z_RV = 768, Z_RG = 1024, Z_CQ = 1280, Z_CKV = 1536, Z_KR = 1664, Z_END = 1696;
constexpr int NEXP = 64, TOPK = 6, EDIM = 256;
constexpr float NORM_EPS = 1e-6f;
constexpr int NTHREADS = 512, NWAVES = 8;

constexpr size_t MiB = 1u << 20;
constexpr size_t WS_CTL = 0, CTL_ZERO_BYTES = 1 * MiB;
constexpr size_t WS_MODV = 1 * MiB;
constexpr size_t WS_ROPE = 2 * MiB;
constexpr size_t WS_WIN = 3 * MiB;
constexpr size_t WS_WUQ = 10 * MiB;
constexpr size_t WS_WUKV = 11 * MiB;
constexpr size_t WS_WOUT = 12 * MiB;
constexpr size_t WS_RT = 16 * MiB;
constexpr size_t WS_SHGU = 17 * MiB;
constexpr size_t WS_SHD = 19 * MiB;
constexpr size_t WS_EGU = 20 * MiB;
constexpr size_t WS_ED = 84 * MiB;
constexpr size_t WS_XC = 116 * MiB;
constexpr size_t WS_H = 132 * MiB;
constexpr size_t WS_H1 = 20 * MiB;
constexpr size_t WS_KV = WS_H;
constexpr size_t WS_R = 204 * MiB;
constexpr size_t WS_Z = WS_R;
constexpr size_t WS_Q = WS_R + 126 * MiB;
constexpr size_t WS_K = WS_R + 180 * MiB;
constexpr size_t WS_V = WS_R + 234 * MiB;
constexpr size_t WS_CC = WS_R + 270 * MiB;
constexpr size_t WS_SS = WS_R + 342 * MiB;
constexpr size_t WS_Y = WS_Z;
constexpr size_t WS_SLOT = 132 * MiB;
constexpr size_t WS_ACT = 410 * MiB;
constexpr size_t WS_LTOK = 552 * MiB;
constexpr size_t WS_LW = 561 * MiB;
constexpr size_t WS_END = 570 * MiB;
constexpr int LCAPH = 18432;
static_assert(WS_SLOT + (size_t)18432 * 7 * 1024 * 2 <= WS_ACT && WS_ACT + (size_t)1136 * 256 * 512 <= WS_LTOK, "MoE buffers");

constexpr int CW_TMO = 0;
constexpr int CW_BAR = 4096;
constexpr int CW_ECNT = 8192;

constexpr int LDS_BYTES = 155648;
constexpr int MISC_OFF = LDS_BYTES - 256;
constexpr int RB0_OFF = 131072;
constexpr int RB1_OFF = 141312;
constexpr int ETAB_OFF = 151552;
constexpr int GEMM_LDS = 36864;
constexpr int ROWSS_OFF = 36864;
constexpr int LG_OFF = 37376;

#define XB_TMO      128
#define XB_XCNT(j)  (256  + 64 * (j))
#define XB_XSUB(j)  (1280 + 64 * (j))
#define XB_XGEN(j)  (2304 + 64 * (j))
#define XB_TOP      3328
#define XB_TOPGEN   3392
#define XCD_BAR_WORDS 3456
#define XB_SPIN_CAP (1u << 24)
__device__ __forceinline__ unsigned xb_ld(unsigned* p)              { return __hip_atomic_load(p, __ATOMIC_RELAXED, __HIP_MEMORY_SCOPE_AGENT); }
__device__ __forceinline__ unsigned xb_add(unsigned* p, unsigned v) { return __hip_atomic_fetch_add(p, v, __ATOMIC_RELAXED, __HIP_MEMORY_SCOPE_AGENT); }
__device__ __forceinline__ unsigned xb_xcc_id() { return (unsigned)__builtin_amdgcn_s_getreg((3 << 11) | 20) & 0xFu; }
#define XB_SPIN(cond, bar) do { unsigned _sp = 0; while (cond) { __builtin_amdgcn_s_sleep(1); \
    if ((++_sp & 255u) == 0u) { if (xb_ld(&(bar)[XB_TMO])) break; if (_sp > XB_SPIN_CAP) { atomicAdd(&(bar)[XB_TMO], 1u); break; } } } } while (0)
struct XcdBarrier { unsigned* bar; unsigned x; volatile LAS unsigned* st; };
__device__ __forceinline__ XcdBarrier xcd_barrier_post(unsigned* bar, volatile LAS unsigned* st) {
    XcdBarrier b; b.bar = bar; b.x = xb_xcc_id(); b.st = st;
    if (threadIdx.x == 0) (void)xb_add(&bar[XB_XCNT(b.x)], 1u);
    return b;
}
__device__ __forceinline__ void xcd_barrier_complete(unsigned* bar, unsigned x, unsigned& nloc, unsigned& nx) {
    const unsigned G = gridDim.x * gridDim.y * gridDim.z;
    unsigned sum, cnt, mine, sp = 0u;
    for (;;) {
        sum = 0u; cnt = 0u; mine = 0u;
#pragma unroll
        for (unsigned j = 0; j < 16; ++j) { const unsigned c = xb_ld(&bar[XB_XCNT(j)]); sum += c; cnt += (c > 0u) ? 1u : 0u; mine = (j == x) ? c : mine; }
        if (sum == G) break;
        __builtin_amdgcn_s_sleep(1);
        if ((++sp & 255u) == 0u) { if (xb_ld(&bar[XB_TMO])) break; if (sp > XB_SPIN_CAP) { atomicAdd(&bar[XB_TMO], 1u); break; } }
    }
    nloc = mine > 0u ? mine : 1u; nx = cnt > 0u ? cnt : 1u;
}
__device__ __forceinline__ void xcd_barrier(const XcdBarrier& b) {
    asm volatile("s_waitcnt vmcnt(0)" ::: "memory");
    __syncthreads();
    if (threadIdx.x == 0) {
        unsigned* bar = b.bar;
        __builtin_amdgcn_s_waitcnt(0);
        unsigned nloc = b.st[0], nx = b.st[1];
        if (nloc == 0u) { xcd_barrier_complete(bar, b.x, nloc, nx); b.st[0] = nloc; b.st[1] = nx; }
        const unsigned old = xb_add(&bar[XB_XSUB(b.x)], 1u);
        const unsigned gen = old / nloc;
        if (old + 1u == (gen + 1u) * nloc) {
            __builtin_amdgcn_fence(__ATOMIC_RELEASE, "agent");
            asm volatile("s_waitcnt vmcnt(0)" ::: "memory");
            const unsigned og = xb_add(&bar[XB_TOP], 1u);
            const unsigned tg = og / nx;
            if (og + 1u == (tg + 1u) * nx) xb_add(&bar[XB_TOPGEN], 1u);
            else XB_SPIN(xb_ld(&bar[XB_TOPGEN]) == tg, bar);
            __builtin_amdgcn_fence(__ATOMIC_ACQUIRE, "agent");
            xb_add(&bar[XB_XGEN(b.x)], 1u);
            asm volatile("s_waitcnt vmcnt(0)" ::: "memory");
        } else {
            XB_SPIN(xb_ld(&bar[XB_XGEN(b.x)]) == gen, bar);
            __builtin_amdgcn_fence(__ATOMIC_ACQUIRE, "agent");
            asm volatile("s_waitcnt vmcnt(0)" ::: "memory");
        }
    }
    __syncthreads();
}

__device__ __forceinline__ float bf2f(unsigned h) { return __uint_as_float(h << 16); }
__device__ __forceinline__ unsigned f2bf(float f) { unsigned u = __float_as_uint(f); return (u + 0x7fffu + ((u >> 16) & 1u)) >> 16; }
__device__ __forceinline__ unsigned pk2(float lo, float hi) { return f2bf(lo) | (f2bf(hi) << 16); }
typedef float f32x2_t __attribute__((ext_vector_type(2)));
typedef __bf16 bf16x2_t __attribute__((ext_vector_type(2)));
__device__ __forceinline__ unsigned cvtpk(float lo, float hi) { f32x2_t v = {lo, hi}; bf16x2_t b = __builtin_convertvector(v, bf16x2_t); return __builtin_bit_cast(unsigned, b); }
__device__ __forceinline__ float lo16(unsigned w) { return __uint_as_float(w << 16); }
__device__ __forceinline__ float hi16(unsigned w) { return __uint_as_float(w & 0xffff0000u); }
__device__ __forceinline__ float wave_sum(float v) {
#pragma unroll
    for (int o = 1; o < 64; o <<= 1) v += __shfl_xor(v, o);
    return v;
}
__device__ __forceinline__ float siluf(float v) { return v / (1.f + __expf(-v)); }
__device__ __forceinline__ int mod_row(int tok) { return tok < NLAT ? (tok >> 11) : 16; }

struct P { const float* in[29]; float* out; unsigned char* ws; int ph_lo, ph_hi; };

__device__ __forceinline__ float* x_row(const P& p, int tok) {
    return tok < NLAT ? p.out + (size_t)tok * D : (float*)(p.ws + WS_XC) + (size_t)(tok - NLAT) * D;
}
__device__ __forceinline__ const float* x_in_row(const P& p, int tok) {
    return tok < NLAT ? p.in[0] + (size_t)tok * D : p.in[2] + (size_t)(tok - NLAT) * D;
}

template <bool ROWSS, class RowSrc, class Epi>
__device__ __forceinline__ void gemm_tile(unsigned char* lds, const RowSrc& rs, const bf16_t* Bt, int ldb, int K, const Epi& epi) {
    const int tid = threadIdx.x, lane = tid & 63, wid = tid >> 6, wr = wid >> 2, wc = wid & 3, fr = lane & 15, fq = lane >> 4;
    bf16_t* As = (bf16_t*)lds; bf16_t* Bs = As + 128 * 72;
    float* rowss = (float*)(lds + ROWSS_OFF);
    const int lr = tid >> 2, lc = (tid & 3) * 16;
    const bf16_t* ap = rs(lr) + lc;
    const bf16_t* bp = Bt + (size_t)lr * ldb + lc;
    u32x4 a0 = *(const u32x4*)ap, a1 = *(const u32x4*)(ap + 8), b0 = *(const u32x4*)bp, b1 = *(const u32x4*)(bp + 8);
    f32x4 acc[4][2];
#pragma unroll
    for (int m = 0; m < 4; ++m)
#pragma unroll
        for (int n = 0; n < 2; ++n) acc[m][n] = (f32x4){0.f, 0.f, 0.f, 0.f};
    float ss = 0.f;
    for (int k0 = 0; k0 < K; k0 += 64) {
        __syncthreads();
        *(u32x4*)(As + lr * 72 + lc) = a0; *(u32x4*)(As + lr * 72 + lc + 8) = a1;
        *(u32x4*)(Bs + lr * 72 + lc) = b0; *(u32x4*)(Bs + lr * 72 + lc + 8) = b1;
        if (ROWSS) {
#pragma unroll
            for (int i = 0; i < 4; ++i) { float x0 = lo16(a0[i]), x1 = hi16(a0[i]), y0 = lo16(a1[i]), y1 = hi16(a1[i]); ss += x0 * x0 + x1 * x1 + y0 * y0 + y1 * y1; }
        }
        __syncthreads();
        if (k0 + 64 < K) { ap += 64; bp += 64; a0 = *(const u32x4*)ap; a1 = *(const u32x4*)(ap + 8); b0 = *(const u32x4*)bp; b1 = *(const u32x4*)(bp + 8); }
#pragma unroll
        for (int kk = 0; kk < 2; ++kk) {
            bf16x8 af[4], bfr[2];
#pragma unroll
            for (int m = 0; m < 4; ++m) af[m] = *(const bf16x8*)(As + (wr * 64 + m * 16 + fr) * 72 + kk * 32 + fq * 8);
#pragma unroll
            for (int n = 0; n < 2; ++n) bfr[n] = *(const bf16x8*)(Bs + (wc * 32 + n * 16 + fr) * 72 + kk * 32 + fq * 8);
#pragma unroll
            for (int m = 0; m < 4; ++m)
#pragma unroll
                for (int n = 0; n < 2; ++n) acc[m][n] = __builtin_amdgcn_mfma_f32_16x16x32_bf16(bfr[n], af[m], acc[m][n], 0, 0, 0);
        }
    }
    if (ROWSS) {
        ss += __shfl_xor(ss, 1); ss += __shfl_xor(ss, 2);
        if ((tid & 3) == 0) rowss[lr] = ss;
        __syncthreads();
    }
#pragma unroll
    for (int m = 0; m < 4; ++m)
#pragma unroll
        for (int n = 0; n < 2; ++n) epi(wr * 64 + m * 16 + fr, wc * 32 + n * 16 + 4 * fq, acc[m][n]);
}


namespace ge {
constexpr int BM = 256, BK = 64, HALF = 128, HTB = HALF * BK * 2;
__device__ __forceinline__ int lds_byte(int r, int c) { const int st = (r >> 4) * 2 + (c >> 5), rr = r & 15, cc = c & 31, ob = rr * 64 + cc * 2; return st * 1024 + (ob ^ (((ob >> 9) & 1) << 5)); }
__device__ __forceinline__ void stage_rc(int b, int& R, int& C) { const int st = b / 1024, sb = b % 1024, swz = sb ^ (((sb >> 9) & 1) << 5); R = (st >> 1) * 16 + swz / 64; C = (st & 1) * 32 + (swz % 64) / 2; }
struct Unit { const char* B; int a, b, c, d; };
typedef f32x4 Acc[2][2][4][2];

template <class Sched, class Epi, bool ALIGN_EPI>
__device__ __forceinline__ void gemm_stream(LAS unsigned char* lds, const char* Ab, int K, const Sched& S, const Epi& E) {
    const int tid = threadIdx.x, wid = __builtin_amdgcn_readfirstlane(tid >> 6), lane = tid & 63, wr = wid >> 2, wc = wid & 3, fr = lane & 15, fq = lane >> 4;
    const int nt = K / BK;
    int Rr[2], Cc[2]; unsigned voffB[2];
#pragma unroll
    for (int i = 0; i < 2; ++i) { stage_rc(tid * 16 + i * 8192, Rr[i], Cc[i]); voffB[i] = (unsigned)(Rr[i] * K + Cc[i]) * 2u; }
    const size_t kstep = (size_t)(BK * 2), hstepB = (size_t)HALF * K * 2;
    const unsigned ldsw = (unsigned)wid * 1024u;
    const int aoff = lds_byte(wr * 64 + fr, fq * 8), boff = lds_byte(wc * 32 + fr, fq * 8);
#define GE_SA(b, h) (((b) * 2 + (h)) * HTB)
#define GE_SB(b, h) ((4 + (b) * 2 + (h)) * HTB)
#define GE_GLDS(gp, ldsoff) __builtin_amdgcn_global_load_lds((const unsigned*)(gp), (LAS unsigned*)(lds + (ldsoff)), 16, 0, 0)
#define GE_STAGE_B(bufoff, gbase) do { GE_GLDS((const char*)(gbase) + voffB[0], (bufoff) + ldsw); GE_GLDS((const char*)(gbase) + voffB[1], (bufoff) + ldsw + 8192); } while (0)
#define GE_STAGE_A(bufoff, kbytes, o0, o1) do { GE_GLDS(Ab + (kbytes) + (o0), (bufoff) + ldsw); GE_GLDS(Ab + (kbytes) + (o1), (bufoff) + ldsw + 8192); } while (0)
#define GE_LDA(dst, b, h) do { _Pragma("unroll") for (int m = 0; m < 4; ++m) _Pragma("unroll") for (int k = 0; k < 2; ++k) dst[m][k] = *(const LAS bf16x8*)(lds + GE_SA(b, h) + aoff + m * 2048 + k * 1024); } while (0)
#define GE_LDB(dst, b, h) do { _Pragma("unroll") for (int n = 0; n < 2; ++n) _Pragma("unroll") for (int k = 0; k < 2; ++k) dst[n][k] = *(const LAS bf16x8*)(lds + GE_SB(b, h) + boff + n * 2048 + k * 1024); } while (0)
#define GE_MMA(ai, bj, At, Bt) do { __builtin_amdgcn_s_setprio(1); _Pragma("unroll") for (int m = 0; m < 4; ++m) _Pragma("unroll") for (int n = 0; n < 2; ++n) _Pragma("unroll") for (int k = 0; k < 2; ++k) \
        acc[ai][bj][m][n] = __builtin_amdgcn_mfma_f32_16x16x32_bf16(Bt[n][k], At[m][k], acc[ai][bj][m][n], 0, 0, 0); __builtin_amdgcn_s_setprio(0); } while (0)
#define GE_WAIT_V(n) asm volatile("s_waitcnt vmcnt(" #n ")" ::: "memory")
#define GE_WAIT_L(n) asm volatile("s_waitcnt lgkmcnt(" #n ")" ::: "memory")
#define GE_BAR __builtin_amdgcn_s_barrier()
#define GE_SCHED __builtin_amdgcn_sched_barrier(0)
    Unit cur, nxt; int ui = 0;
    if (!S.next(0, cur)) return;
    Acc acc;
#pragma unroll
    for (int a = 0; a < 2; ++a)
#pragma unroll
        for (int b = 0; b < 2; ++b)
#pragma unroll
            for (int m = 0; m < 4; ++m)
#pragma unroll
                for (int n = 0; n < 2; ++n) acc[a][b][m][n] = (f32x4){0.f, 0.f, 0.f, 0.f};
    bf16x8 At[4][2], B0[2][2], B1[2][2];
    unsigned oc00, oc01, oc10, oc11, on00, on01, on10, on11;
    oc00 = S.aoff(0, cur, Rr[0]) + (unsigned)Cc[0] * 2u; oc01 = S.aoff(0, cur, Rr[1]) + (unsigned)Cc[1] * 2u;
    oc10 = S.aoff(0, cur, Rr[0] + 128) + (unsigned)Cc[0] * 2u; oc11 = S.aoff(0, cur, Rr[1] + 128) + (unsigned)Cc[1] * 2u;
    const char* cB = cur.B;
    GE_STAGE_B(GE_SB(0, 0), cB); GE_STAGE_B(GE_SB(0, 1), cB + hstepB); GE_STAGE_A(GE_SA(0, 0), 0, oc00, oc01); GE_STAGE_A(GE_SA(0, 1), 0, oc10, oc11);
    if (wr == 1) GE_BAR;
    GE_WAIT_V(2); GE_BAR;
    GE_STAGE_B(GE_SB(1, 0), cB + kstep); GE_STAGE_A(GE_SA(1, 0), kstep, oc00, oc01); GE_STAGE_B(GE_SB(1, 1), cB + hstepB + kstep);
    GE_WAIT_V(6); GE_BAR;
    for (;;) {
        const bool has_next = S.next(ui + 1, nxt);
        const char* nB = has_next ? nxt.B : cB;
        if (has_next) {
            on00 = S.aoff(ui + 1, nxt, Rr[0]) + (unsigned)Cc[0] * 2u; on01 = S.aoff(ui + 1, nxt, Rr[1]) + (unsigned)Cc[1] * 2u;
            on10 = S.aoff(ui + 1, nxt, Rr[0] + 128) + (unsigned)Cc[0] * 2u; on11 = S.aoff(ui + 1, nxt, Rr[1] + 128) + (unsigned)Cc[1] * 2u;
        } else { on00 = oc00; on01 = oc01; on10 = oc10; on11 = oc11; }
#pragma unroll 1
        for (int t = 0; t < nt; t += 2) {
            const bool last = (t == nt - 2);
            const size_t k1 = (size_t)(t + 1) * kstep;
            const size_t k2 = last ? 0 : (size_t)(t + 2) * kstep, k3 = k2 + kstep;
            const char* b2 = last ? nB : cB + (size_t)(t + 2) * kstep; const char* b3 = b2 + kstep;
            const unsigned o00 = last ? on00 : oc00, o01 = last ? on01 : oc01, o10 = last ? on10 : oc10, o11 = last ? on11 : oc11;
            GE_LDB(B0, 0, 0); GE_LDB(B1, 0, 1); GE_SCHED; GE_LDA(At, 0, 0); GE_STAGE_A(GE_SA(1, 1), k1, oc10, oc11);
            GE_WAIT_V(8); GE_WAIT_L(0); GE_BAR; GE_MMA(0, 0, At, B0); GE_MMA(0, 1, At, B1); GE_BAR; GE_SCHED;
            GE_LDA(At, 0, 1); GE_STAGE_B(GE_SB(0, 0), b2); GE_STAGE_B(GE_SB(0, 1), b2 + hstepB); GE_STAGE_A(GE_SA(0, 0), k2, o00, o01);
            GE_WAIT_V(8); GE_WAIT_L(0); GE_BAR; GE_MMA(1, 0, At, B0); GE_MMA(1, 1, At, B1); GE_BAR; GE_SCHED;
            GE_LDB(B0, 1, 0); GE_LDB(B1, 1, 1); GE_SCHED; GE_LDA(At, 1, 0); GE_STAGE_A(GE_SA(0, 1), k2, o10, o11);
            GE_WAIT_V(8); GE_WAIT_L(0); GE_BAR; GE_MMA(0, 0, At, B0); GE_MMA(0, 1, At, B1); GE_BAR; GE_SCHED;
            GE_LDA(At, 1, 1); GE_STAGE_B(GE_SB(1, 0), b3); GE_STAGE_B(GE_SB(1, 1), b3 + hstepB); GE_STAGE_A(GE_SA(1, 0), k3, o00, o01);
            GE_WAIT_V(8); GE_WAIT_L(0); GE_BAR; GE_MMA(1, 0, At, B0); GE_MMA(1, 1, At, B1); GE_BAR; GE_SCHED;
        }
        if constexpr (ALIGN_EPI) { if (wr == 0) GE_BAR; }
        E(acc, cur, wr, wc, fr, fq);
        if (!has_next) break;
#pragma unroll
        for (int a = 0; a < 2; ++a)
#pragma unroll
            for (int b = 0; b < 2; ++b)
#pragma unroll
                for (int m = 0; m < 4; ++m)
#pragma unroll
                    for (int n = 0; n < 2; ++n) acc[a][b][m][n] = (f32x4){0.f, 0.f, 0.f, 0.f};
        cur = nxt; cB = nB; ++ui; oc00 = on00; oc01 = on01; oc10 = on10; oc11 = on11;
        if constexpr (ALIGN_EPI) { if (wr == 1) GE_BAR; }
    }
    GE_WAIT_V(0);
    if constexpr (!ALIGN_EPI) { if (wr == 0) GE_BAR; }
    GE_BAR;
#undef GE_SA
#undef GE_SB
#undef GE_GLDS
#undef GE_STAGE_A
#undef GE_STAGE_B
#undef GE_LDA
#undef GE_LDB
#undef GE_MMA
#undef GE_WAIT_V
#undef GE_WAIT_L
#undef GE_BAR
#undef GE_SCHED
}
template <class F> struct EpiFn {
    F f;
    __device__ __forceinline__ void operator()(const Acc& acc, const Unit& u, int wr, int wc, int fr, int fq) const {
#pragma unroll
        for (int ai = 0; ai < 2; ++ai)
#pragma unroll
            for (int m = 0; m < 4; ++m)
#pragma unroll
                for (int bj = 0; bj < 2; ++bj)
#pragma unroll
                    for (int n = 0; n < 2; ++n) f(u, ai * 128 + wr * 64 + m * 16 + fr, bj * 128 + wc * 32 + n * 16 + 4 * fq, acc[ai][bj][m][n]);
    }
};
struct DenseOrder {
    int nM, nN, nwg, G, c; const char* Bt; size_t btile; unsigned arow;
    __device__ __forceinline__ bool next(int i, Unit& u) const {
        const long L = (long)i * G + c; if (L >= nwg) return false;
        int wgid = (int)L; { const int q = nwg / 8, r = nwg % 8, xcd = wgid % 8, off = wgid / 8; wgid = (xcd < r ? xcd * (q + 1) : r * (q + 1) + (xcd - r) * q) + off; }
        const int nig = 8 * nN, gid = wgid / nig, fm = gid * 8, gsz = (nM - fm) < 8 ? (nM - fm) : 8;
        u.a = fm + ((wgid % nig) % gsz); u.b = (wgid % nig) / gsz; u.c = 0; u.d = 0; u.B = Bt + (size_t)u.b * btile; return true;
    }
    __device__ __forceinline__ unsigned aoff(int, const Unit& u, int R) const { return (unsigned)(u.a * 256 + R) * arow; }
};
}

struct TMap { const float* s0; const float* s1; int ld; int nvalid; const float* ksc; float gsc; };
template <int MODE> __device__ __forceinline__ const float* tmap_src(const float* s0, const float* s1, int nvalid, int n) {
    if (MODE == 0) return n < nvalid ? s0 + n : nullptr;
    if (MODE == 1) { const int h = n / 96, j = n % 96; const int c = j < 64 ? j : 64 + ((j - 64) & 1) * 16 + ((j - 64) >> 1); return s0 + h * 96 + c; }
    return ((n & 1) ? s1 : s0) + (n >> 1);
}
template <int MODE> __device__ __forceinline__ void transpose_unit(float* scr, const float* s0, const float* s1, int ld, int nvalid, const float* ksc, float gsc, int K, bf16_t* dst, int kb, int nb, int kvalid = 1 << 30) {
    const int tid = threadIdx.x, k0 = kb * 64, n0 = nb * 64;
    const int nn = tid & 63; const float* sp = tmap_src<MODE>(s0, s1, nvalid, n0 + nn);
#pragma unroll
    for (int i = 0; i < 8; ++i) {
        const int kk = (tid >> 6) + 8 * i; float v = (sp && k0 + kk < kvalid) ? sp[(size_t)(k0 + kk) * ld] : 0.f;
        if (ksc && k0 + kk < kvalid) v *= ksc[k0 + kk];
        scr[kk * 65 + nn] = v * gsc;
    }
    __syncthreads();
    {
        const int n2 = tid >> 3, kc = tid & 7; const float* s = scr + (kc * 8) * 65 + n2;
        u32x4 o; o.x = pk2(s[0], s[65]); o.y = pk2(s[2 * 65], s[3 * 65]); o.z = pk2(s[4 * 65], s[5 * 65]); o.w = pk2(s[6 * 65], s[7 * 65]);
        *(u32x4*)(dst + (size_t)(n0 + n2) * K + k0 + kc * 8) = o;
    }
    __syncthreads();
}
template <int MODE> __device__ __forceinline__ void transpose_matrix(float* scr, const float* s0, const float* s1, int ld, int nvalid, const float* ksc, float gsc, int K, int Nd, bf16_t* dst, int& rot, int kvalid = 1 << 30) {
    const int nkb = K / 64, nnb = Nd / 64, nu = nkb * nnb, G = gridDim.x;
    int first = ((int)blockIdx.x - rot) % G; if (first < 0) first += G;
    for (int u = first; u < nu; u += G) transpose_unit<MODE>(scr, s0, s1, ld, nvalid, ksc, gsc, K, dst, u / nnb, u % nnb, kvalid);
    rot = (rot + nu) % G;
}
__device__ __forceinline__ void convert_expert_weights(unsigned char* lds, const P& p, int L) {
    float* scr = (float*)lds; const int G = gridDim.x;
    bf16_t* egu = (bf16_t*)(p.ws + WS_EGU); bf16_t* ed = (bf16_t*)(p.ws + WS_ED);
    for (int u = blockIdx.x; u < NEXP * 192; u += G) {
        const int e = u / 192, r = u % 192;
        if (r < 128) {
            transpose_unit<2>(scr, p.in[22] + ((size_t)L * NEXP + e) * D * EDIM, p.in[23] + ((size_t)L * NEXP + e) * D * EDIM, EDIM, 512, nullptr, 1.f, D, egu + (size_t)e * 512 * D, r / 8, r % 8);
        } else {
            const int r2 = r - 128;
            transpose_unit<0>(scr, p.in[24] + ((size_t)L * NEXP + e) * EDIM * D, nullptr, D, D, nullptr, 1.f, EDIM, ed + (size_t)e * D * EDIM, r2 / 16, r2 % 16);
        }
    }
}
__device__ __forceinline__ void prep_mod_unit(unsigned char* lds, const P& p, int u) {
    float* sc = (float*)lds;
    float* part = sc + 17 * 1024;
    const int tid = threadIdx.x;
    const float* c = p.in[1]; const float* cctx = p.in[3];
    for (int i = tid; i < 17 * 1024; i += NTHREADS) { const int r = i >> 10, k = i & 1023; const float v = r < 16 ? c[r * 1024 + k] : cctx[k]; sc[i] = v / (1.f + expf(-v)); }
    __syncthreads();
    const int L = u / 48, cg = u % 48, kq = tid >> 7, cl = tid & 127, col = cg * 128 + cl;
    const float* w = p.in[4] + (size_t)L * 1024 * 6144 + col;
    float acc[17];
#pragma unroll
    for (int r = 0; r < 17; ++r) acc[r] = 0.f;
    for (int k = kq * 256; k < kq * 256 + 256; ++k) {
        const float wv = w[(size_t)k * 6144];
#pragma unroll
        for (int r = 0; r < 17; ++r) acc[r] += sc[r * 1024 + k] * wv;
    }
#pragma unroll
    for (int r = 0; r < 17; ++r) part[(kq * 17 + r) * 128 + cl] = acc[r];
    __syncthreads();
    float* modv = (float*)(p.ws + WS_MODV);
    for (int i = tid; i < 17 * 128; i += NTHREADS) {
        const int r = i >> 7, c2 = i & 127;
        float s = part[(0 * 17 + r) * 128 + c2] + part[(1 * 17 + r) * 128 + c2] + part[(2 * 17 + r) * 128 + c2] + part[(3 * 17 + r) * 128 + c2];
        s += p.in[5][L * 6144 + cg * 128 + c2];
        modv[((size_t)L * 17 + r) * 6144 + cg * 128 + c2] = s;
    }
    __syncthreads();
}
__device__ __forceinline__ void phase_prep(unsigned char* lds, const P& p) {
    const int tid = threadIdx.x, G = gridDim.x, bid = blockIdx.x;
    {
        float* ct = (float*)(p.ws + WS_ROPE); float* st = ct + 2048 * 16;
        for (int i = bid * NTHREADS + tid; i < 2048 * 16; i += G * NTHREADS) {
            const int pos = i >> 4, f = i & 15;
            const float inv = powf(10000.f, -(float)(f & 7) / 8.f);
            const float ang = (float)(f < 8 ? (pos >> 6) : (pos & 63)) * inv;
            ct[i] = cosf(ang); st[i] = sinf(ang);
        }
    }
    for (int u = G - 1 - bid; u < 96; u += G) prep_mod_unit(lds, p, u);
    float* scr = (float*)lds; int rot = 0;
    for (int L = 0; L < 2; ++L) {
        transpose_matrix<0>(scr, p.in[7] + (size_t)L * D * Z_END, nullptr, Z_END, Z_END, nullptr, 1.f, D, ZC, (bf16_t*)(p.ws + WS_WIN) + (size_t)L * ZC * D, rot);
        transpose_matrix<1>(scr, p.in[15] + (size_t)L * 256 * 768, nullptr, 768, 768, p.in[14] + L * 256, 0.14724574f, 256, 768, (bf16_t*)(p.ws + WS_WUQ) + (size_t)L * 768 * 256, rot);
        transpose_matrix<0>(scr, p.in[17] + (size_t)L * 128 * 1024, nullptr, 1024, 1024, p.in[16] + L * 128, 1.f, 256, 1024, (bf16_t*)(p.ws + WS_WUKV) + (size_t)L * 1024 * 256, rot, 128);
        transpose_matrix<0>(scr, p.in[18] + (size_t)L * D * D, nullptr, D, D, nullptr, 1.f, D, D, (bf16_t*)(p.ws + WS_WOUT) + (size_t)L * D * D, rot);
        transpose_matrix<0>(scr, p.in[20] + (size_t)L * D * NEXP, nullptr, NEXP, NEXP, nullptr, 1.f, D, 128, (bf16_t*)(p.ws + WS_RT) + (size_t)L * 128 * D, rot);
        transpose_matrix<2>(scr, p.in[25] + (size_t)L * D * EDIM, p.in[26] + (size_t)L * D * EDIM, EDIM, 512, nullptr, 1.f, D, 512, (bf16_t*)(p.ws + WS_SHGU) + (size_t)L * 512 * D, rot);
        transpose_matrix<0>(scr, p.in[27] + (size_t)L * EDIM * D, nullptr, D, D, nullptr, 1.f, EDIM, D, (bf16_t*)(p.ws + WS_SHD) + (size_t)L * D * EDIM, rot);
    }
}

__device__ __forceinline__ void phase_norm_mod(const P& p, int L, int which  , int ntok) {
    const int tid = threadIdx.x, lane = tid & 63, wave = tid >> 6, gw = blockIdx.x * NWAVES + wave, NGW = gridDim.x * NWAVES;
    const float* nw = (which == 0 ? p.in[6] : p.in[19]) + L * D;
    const float* modv = (const float*)(p.ws + WS_MODV) + (size_t)L * 17 * 6144;
    bf16_t* H = (bf16_t*)(p.ws + WS_H);
    for (int tok = gw; tok < ntok; tok += NGW) {
        const f32x4* xr = (const f32x4*)x_in_row(p, tok) + lane;
        const float* mrow = modv + (size_t)mod_row(tok) * 6144 + which * 3072;
        f32x4 v[4]; float s = 0.f;
#pragma unroll
        for (int j = 0; j < 4; ++j) { v[j] = xr[64 * j]; s += v[j].x * v[j].x + v[j].y * v[j].y + v[j].z * v[j].z + v[j].w * v[j].w; }
        const float rstd = rsqrtf(wave_sum(s) * (1.f / D) + NORM_EPS);
        u32x2* o = (u32x2*)(H + (size_t)tok * D) + lane;
#pragma unroll
        for (int j = 0; j < 4; ++j) {
            const int k = 4 * lane + 256 * j;
            const f32x4 w4 = *(const f32x4*)(nw + k), sh = *(const f32x4*)(mrow + k), sc = *(const f32x4*)(mrow + 1024 + k);
            const float y0 = v[j].x * rstd * w4.x * (1.f + sc.x) + sh.x, y1 = v[j].y * rstd * w4.y * (1.f + sc.y) + sh.y;
            const float y2 = v[j].z * rstd * w4.z * (1.f + sc.z) + sh.z, y3 = v[j].w * rstd * w4.w * (1.f + sc.w) + sh.w;
            u32x2 w; w.x = pk2(y0, y1); w.y = pk2(y2, y3); o[64 * j] = w;
        }
    }
}

struct EpiZ {
    bf16_t* Z; float* ssq; float* sskv; bf16_t* Kb; const float* ct; const float* st;
    __device__ __forceinline__ void operator()(const ge::Acc& acc, const ge::Unit& u, int wr, int wc, int fr, int fq) const {
#pragma unroll
        for (int ai = 0; ai < 2; ++ai)
#pragma unroll
            for (int m = 0; m < 4; ++m) {
                const int row = u.a * 256 + ai * 128 + wr * 64 + m * 16 + fr;
#pragma unroll
                for (int bj = 0; bj < 2; ++bj)
#pragma unroll
                    for (int n = 0; n < 2; ++n) {
                        const f32x4 v = acc[ai][bj][m][n]; u32x2 w; w.x = cvtpk(v.x, v.y); w.y = cvtpk(v.z, v.w);
                        *(u32x2*)(Z + (size_t)row * ZC + u.b * 256 + bj * 128 + wc * 32 + n * 16 + 4 * fq) = w;
                    }
                if (u.b == 5) {
                    float sq = 0.f;
#pragma unroll
                    for (int bj = 0; bj < 2; ++bj)
#pragma unroll
                        for (int n = 0; n < 2; ++n) { const f32x4 v = acc[ai][bj][m][n]; sq += v.x * v.x + v.y * v.y + v.z * v.z + v.w * v.w; }
                    sq += __shfl_xor(sq, 16); sq += __shfl_xor(sq, 32);
                    if (fq == 0) ssq[(size_t)row * 4 + wc] = sq;
                }
                if (u.b == 6) {
                    float sq = 0.f;
#pragma unroll
                    for (int n = 0; n < 2; ++n) { const f32x4 v = acc[ai][0][m][n]; sq += v.x * v.x + v.y * v.y + v.z * v.z + v.w * v.w; }
                    sq += __shfl_xor(sq, 16); sq += __shfl_xor(sq, 32);
                    if (fq == 0) sskv[(size_t)row * 4 + wc] = sq;
                    if (wc == 0) {
                        const f32x4 x1 = acc[ai][1][m][0], x2 = acc[ai][1][m][1];
                        f32x4 c4 = (f32x4){1.f, 1.f, 1.f, 1.f}, s4 = (f32x4){0.f, 0.f, 0.f, 0.f};
                        if (row < NLAT) { const int pos = row & (SEQ - 1); c4 = *(const f32x4*)(ct + pos * 16 + 4 * fq); s4 = *(const f32x4*)(st + pos * 16 + 4 * fq); }
                        const f32x4 o1 = x1 * c4 - x2 * s4, o2 = x1 * s4 + x2 * c4;
                        u32x4 ov; ov.x = cvtpk(o1.x, o2.x); ov.y = cvtpk(o1.y, o2.y); ov.z = cvtpk(o1.z, o2.z); ov.w = cvtpk(o1.w, o2.w);
#pragma unroll
                        for (int h = 0; h < 8; ++h) *(u32x4*)(Kb + (size_t)row * 768 + h * 96 + 64 + 8 * fq) = ov;
                    }
                }
            }
    }
};
__device__ __forceinline__ void phase_zgemm(unsigned char* lds, const P& p, int L) {
    const bf16_t* W = (const bf16_t*)(p.ws + WS_WIN) + (size_t)L * ZC * D;
    ge::DenseOrder S; S.nM = NTOK / 256; S.nN = ZC / 256; S.nwg = S.nM * S.nN; S.G = gridDim.x; S.c = blockIdx.x; S.Bt = (const char*)W; S.btile = (size_t)256 * D * 2; S.arow = D * 2;
    EpiZ E{(bf16_t*)(p.ws + WS_Z), (float*)(p.ws + WS_SS), (float*)(p.ws + WS_SS) + (size_t)NTOK * 4, (bf16_t*)(p.ws + WS_K), (const float*)(p.ws + WS_ROPE), (const float*)(p.ws + WS_ROPE) + 2048 * 16};
    ge::gemm_stream<ge::DenseOrder, EpiZ, true>((LAS unsigned char*)lds, (const char*)(p.ws + (L == 0 ? WS_H : WS_H1)), D, S, E);
}

__device__ __forceinline__ void conv_unit(unsigned char* lds, const P& p, int L, int s, int tt) {
    float* hg = (float*)lds;
    const int tid = threadIdx.x, lane = tid & 63, wave = tid >> 6;
    const int rb = s < 16 ? s * SEQ : NLAT + (s - 16) * CTXL, len = s < 16 ? SEQ : CTXL, t0 = tt * 64;
    const bf16_t* Z = (const bf16_t*)(p.ws + WS_Z);
    for (int i = tid; i < 94 * 64; i += NTHREADS) {
        const int jj = i >> 6, c4 = (i & 63) * 4, t = t0 - 15 + jj;
        f32x4 h = (f32x4){0.f, 0.f, 0.f, 0.f};
        if (t >= 0 && t < len) {
            const bf16_t* zr = Z + (size_t)(rb + t) * ZC;
            const u32x2 a = *(const u32x2*)(zr + c4), g = *(const u32x2*)(zr + 256 + c4);
            const float g0 = lo16(g.x), g1 = hi16(g.x), g2 = lo16(g.y), g3 = hi16(g.y);
            h.x = lo16(a.x) / (1.f + __expf(-g0)); h.y = hi16(a.x) / (1.f + __expf(-g1));
            h.z = lo16(a.y) / (1.f + __expf(-g2)); h.w = hi16(a.y) / (1.f + __expf(-g3));
        }
        *(f32x4*)(hg + jj * 256 + c4) = h;
    }
    float* wl = hg + 94 * 256;
    for (int i = tid; i < 31 * 64; i += NTHREADS) *(f32x4*)(wl + i * 4) = *(const f32x4*)(p.in[8] + (size_t)L * 31 * 256 + i * 4);
    __syncthreads();
    const int c0 = lane * 4;
    const f32x4 cb = *(const f32x4*)(p.in[9] + L * 256 + c0), lw = *(const f32x4*)(p.in[10] + L * 256 + c0), lb = *(const f32x4*)(p.in[11] + L * 256 + c0);
    bf16_t* CC = (bf16_t*)(p.ws + WS_CC);
    for (int q = 0; q < 8; ++q) {
        const int tl = wave * 8 + q;
        f32x4 acc = cb;
#pragma unroll 4
        for (int j = 0; j < 31; ++j) { const f32x4 h = *(const f32x4*)(hg + (tl + j) * 256 + c0); acc += h * *(const f32x4*)(wl + j * 256 + c0); }
        const float mean = wave_sum(acc.x + acc.y + acc.z + acc.w) * (1.f / 256.f);
        const f32x4 d = acc - mean;
        const float var = wave_sum(d.x * d.x + d.y * d.y + d.z * d.z + d.w * d.w) * (1.f / 256.f);
        const float rstd = rsqrtf(var + NORM_EPS);
        const f32x4 y = d * rstd * lw + lb;
        u32x2 o; o.x = pk2(siluf(y.x), siluf(y.y)); o.y = pk2(siluf(y.z), siluf(y.w));
        *(u32x2*)(CC + (size_t)(rb + t0 + tl) * D + c0) = o;
    }
    __syncthreads();
}

__device__ __forceinline__ float log2_gamma(const P& p, int L, int dir, int h) {
    const float x = p.in[12][(L * 2 + dir) * 4 + h];
    const float ls = fminf(x, 0.f) - log1pf(expf(-fabsf(x)));
    return ls * 1.4426950408889634f;
}
__device__ __forceinline__ void load_ret_qk(float* dst, const P& p, int gc, int h, int zoff, float scale) {
    const int tid = threadIdx.x, j = tid >> 2, i0 = (tid & 3) * 4, row = gc * 128 + j;
    const bf16_t* zr = (const bf16_t*)(p.ws + WS_Z) + (size_t)row * ZC + zoff + h * 32;
    const u32x2 a = *(const u32x2*)(zr + i0), b = *(const u32x2*)(zr + 16 + i0);
    float x1[4] = {lo16(a.x), hi16(a.x), lo16(a.y), hi16(a.y)}, x2[4] = {lo16(b.x), hi16(b.x), lo16(b.y), hi16(b.y)};
    const bool lat = row < NLAT; const int pos = row & (SEQ - 1);
    const float* ct = (const float*)(p.ws + WS_ROPE) + pos * 16 + i0; const float* st = ct + 2048 * 16;
#pragma unroll
    for (int i = 0; i < 4; ++i) {
        const float c = lat ? ct[i] : 1.f, s = lat ? st[i] : 0.f;
        dst[j * 33 + i0 + i] = (x1[i] * c - x2[i] * s) * scale;
        dst[j * 33 + 16 + i0 + i] = (x1[i] * s + x2[i] * c) * scale;
    }
}
__device__ __forceinline__ void load_ret_v(float* dst  , const P& p, int gc, int h) {
    const int tid = threadIdx.x, j = tid >> 2, e0 = (tid & 3) * 16;
    const bf16_t* zr = (const bf16_t*)(p.ws + WS_Z) + (size_t)(gc * 128 + j) * ZC + Z_RV + h * 64 + e0;
    const u32x4 a = *(const u32x4*)zr, b = *(const u32x4*)(zr + 8);
#pragma unroll
    for (int i = 0; i < 4; ++i) { dst[j * 64 + e0 + 2 * i] = lo16(a[i]); dst[j * 64 + e0 + 2 * i + 1] = hi16(a[i]); dst[j * 64 + e0 + 8 + 2 * i] = lo16(b[i]); dst[j * 64 + e0 + 8 + 2 * i + 1] = hi16(b[i]); }
}
__device__ __forceinline__ void retkv_unit(unsigned char* lds, const P& p, int L, int gc, int h) {
    float* ks = (float*)lds; float* vs = ks + 128 * 33; float* wf = vs + 128 * 64; float* wb = wf + 128;
    const int tid = threadIdx.x;
    const float l2f = log2_gamma(p, L, 0, h), l2b = log2_gamma(p, L, 1, h);
    load_ret_qk(ks, p, gc, h, Z_RK, 0.17677669529663687f);
    load_ret_v(vs, p, gc, h);
    if (tid < 128) { wf[tid] = exp2f(l2f * (float)(127 - tid)); wb[tid] = exp2f(l2b * (float)tid); }
    __syncthreads();
    const int d = tid >> 4, e0 = (tid & 15) * 4;
    f32x4 af = (f32x4){0.f, 0.f, 0.f, 0.f}, ab = af;
    for (int j = 0; j < 128; ++j) {
        const float kd = ks[j * 33 + d]; const f32x4 v4 = *(const f32x4*)(vs + j * 64 + e0);
        af += (kd * wf[j]) * v4; ab += (kd * wb[j]) * v4;
    }
    float* KV = (float*)(p.ws + WS_KV) + ((size_t)(gc * 4 + h) * 2) * 2048;
    *(f32x4*)(KV + d * 64 + e0) = af; *(f32x4*)(KV + 2048 + d * 64 + e0) = ab;
    __syncthreads();
}
__device__ __forceinline__ void ret_stage_k(unsigned char* kf, unsigned char* kb, int rowb, const P& p, int gc, int h, float ef, float jf0, float eb, float jb0) {
    const int tid = threadIdx.x, j = tid >> 2, i0 = (tid & 3) * 4, row = gc * 128 + j;
    const bf16_t* zr = (const bf16_t*)(p.ws + WS_Z) + (size_t)row * ZC + Z_RK + h * 32;
    const u32x2 a = *(const u32x2*)(zr + i0), b = *(const u32x2*)(zr + 16 + i0);
    const float x1[4] = {lo16(a.x), hi16(a.x), lo16(a.y), hi16(a.y)}, x2[4] = {lo16(b.x), hi16(b.x), lo16(b.y), hi16(b.y)};
    f32x4 c4 = (f32x4){1.f, 1.f, 1.f, 1.f}, s4 = (f32x4){0.f, 0.f, 0.f, 0.f};
    if (row < NLAT) { const int pos = row & (SEQ - 1); const float* ct = (const float*)(p.ws + WS_ROPE) + pos * 16 + i0; c4 = *(const f32x4*)ct; s4 = *(const f32x4*)(ct + 2048 * 16); }
    const float wf = exp2f(ef * ((float)j - jf0)) * 0.17677669529663687f, wb = exp2f(eb * ((float)j - jb0)) * 0.17677669529663687f;
    float o1[4], o2[4];
#pragma unroll
    for (int i = 0; i < 4; ++i) { o1[i] = x1[i] * c4[i] - x2[i] * s4[i]; o2[i] = x1[i] * s4[i] + x2[i] * c4[i]; }
    u32x2 w;
    w.x = cvtpk(o1[0] * wf, o1[1] * wf); w.y = cvtpk(o1[2] * wf, o1[3] * wf); *(u32x2*)(kf + j * rowb + i0 * 2) = w;
    w.x = cvtpk(o2[0] * wf, o2[1] * wf); w.y = cvtpk(o2[2] * wf, o2[3] * wf); *(u32x2*)(kf + j * rowb + 32 + i0 * 2) = w;
    w.x = cvtpk(o1[0] * wb, o1[1] * wb); w.y = cvtpk(o1[2] * wb, o1[3] * wb); *(u32x2*)(kb + j * rowb + i0 * 2) = w;
    w.x = cvtpk(o2[0] * wb, o2[1] * wb); w.y = cvtpk(o2[2] * wb, o2[3] * wb); *(u32x2*)(kb + j * rowb + 32 + i0 * 2) = w;
}
__device__ __forceinline__ void ret_stage_v(unsigned char* vt, const P& p, int gc, int h) {
    const int tid = threadIdx.x, j = tid >> 2, e0 = (tid & 3) * 16;
    const bf16_t* zr = (const bf16_t*)(p.ws + WS_Z) + (size_t)(gc * 128 + j) * ZC + Z_RV + h * 64 + e0;
    const u32x4 a = *(const u32x4*)zr, b = *(const u32x4*)(zr + 8);
    unsigned char* d = vt + (e0 >> 5) * 8192 + j * 64 + (e0 & 31) * 2;
    *(u32x4*)d = a; *(u32x4*)(d + 16) = b;
}
__device__ __forceinline__ bf16x8 tr8(const unsigned char* p0, const unsigned char* p1) {
    const v4i16_t a = __builtin_amdgcn_ds_read_tr16_b64_v4i16((LAS v4i16_t*)(const LAS unsigned char*)p0), b = __builtin_amdgcn_ds_read_tr16_b64_v4i16((LAS v4i16_t*)(const LAS unsigned char*)p1);
    return (bf16x8){a[0], a[1], a[2], a[3], b[0], b[1], b[2], b[3]};
}
__device__ __forceinline__ void retkv_unit_mfma(unsigned char* lds, const P& p, int L, int gc, int h) {
    const int tid = threadIdx.x, lane = tid & 63, wid = tid >> 6;
    const float l2f = log2_gamma(p, L, 0, h), l2b = log2_gamma(p, L, 1, h);
    ret_stage_k(lds, lds + 8192, 64, p, gc, h, -l2f, 127.f, l2b, 0.f);
    ret_stage_v(lds + 16384, p, gc, h);
    __syncthreads();
    if (wid < 4) {
        const int dir = wid >> 1, eb = wid & 1, g = lane >> 4, i = lane & 15, hh = lane >> 5;
        const int off = (8 * hh + (i >> 2)) * 64 + (g & 1) * 32 + (i & 3) * 8;
        const unsigned char* Kt = lds + dir * 8192 + off; const unsigned char* Vt = lds + 16384 + eb * 8192 + off;
        f32x16 acc;
#pragma unroll
        for (int r = 0; r < 16; ++r) acc[r] = 0.f;
#pragma unroll
        for (int s = 0; s < 8; ++s) acc = __builtin_amdgcn_mfma_f32_32x32x16_bf16(tr8(Vt + s * 1024, Vt + s * 1024 + 256), tr8(Kt + s * 1024, Kt + s * 1024 + 256), acc, 0, 0, 0);
        float* KV = (float*)(p.ws + WS_KV) + ((size_t)(gc * 4 + h) * 2 + dir) * 2048 + (lane & 31) * 64 + eb * 32 + 4 * hh;
#pragma unroll
        for (int r4 = 0; r4 < 4; ++r4) *(f32x4*)(KV + 8 * r4) = (f32x4){acc[4 * r4], acc[4 * r4 + 1], acc[4 * r4 + 2], acc[4 * r4 + 3]};
    }
    __syncthreads();
}
__device__ __forceinline__ void retout_unit_mfma(unsigned char* lds, const P& p, int L, int gc, int h) {
    constexpr int KROW = 80, O_KF = 0, O_KB = 10240, O_V = 20480, O_SF = 36864, O_SB = 41984, O_RED = 47104;
    const int tid = threadIdx.x, lane = tid & 63, wid = tid >> 6, r32 = lane & 31, hh = lane >> 5;
    const float l2f = log2_gamma(p, L, 0, h), l2b = log2_gamma(p, L, 1, h);
    ret_stage_k(lds + O_KF, lds + O_KB, KROW, p, gc, h, -l2f, 0.f, l2b, 0.f);
    ret_stage_v(lds + O_V, p, gc, h);
    {
        const bool lat = gc < 256; const int b = lat ? gc >> 4 : (gc - 256) >> 1;
        const int mme = lat ? 2 + (gc & 15) : (gc - 256) & 1;
        const int u = mme, w = mme < 2 ? 1 - mme : 19 - mme;
        f32x4 sf = (f32x4){0.f, 0.f, 0.f, 0.f}, sb = sf;
        const float* KVb = (const float*)(p.ws + WS_KV);
#pragma unroll 1
        for (int mm = 0; mm < 18; ++mm) {
            const int gcm = mm < 2 ? 256 + b * 2 + mm : b * 16 + (mm - 2);
            const int um = mm, wm = mm < 2 ? 1 - mm : 19 - mm;
            const float* kv = KVb + ((size_t)(gcm * 4 + h) * 2) * 2048 + tid * 4;
            if (um < u) { const float wgt = exp2f(l2f * 128.f * (float)(u - 1 - um)); sf += wgt * *(const f32x4*)kv; }
            if (wm < w) { const float wgt = exp2f(l2b * 128.f * (float)(w - 1 - wm)); sb += wgt * *(const f32x4*)(kv + 2048); }
        }
        const int d = tid >> 4, e0 = (tid & 15) * 4;
#pragma unroll
        for (int k = 0; k < 4; ++k) { *(bf16_t*)(lds + O_SF + (e0 + k) * KROW + d * 2) = (bf16_t)(cvtpk(sf[k], 0.f) & 0xffffu); *(bf16_t*)(lds + O_SB + (e0 + k) * KROW + d * 2) = (bf16_t)(cvtpk(sb[k], 0.f) & 0xffffu); }
    }
    __syncthreads();
    const int qb = wid & 3, eb = wid >> 2, i = qb * 32 + r32, row = gc * 128 + i;
    bf16x8 qf[2];
    {
        const bf16_t* zr = (const bf16_t*)(p.ws + WS_Z) + (size_t)row * ZC + Z_RQ + h * 32 + 8 * hh;
        const u32x4 a = *(const u32x4*)zr, b = *(const u32x4*)(zr + 16);
        float x1[8], x2[8];
#pragma unroll
        for (int k = 0; k < 4; ++k) { x1[2 * k] = lo16(a[k]); x1[2 * k + 1] = hi16(a[k]); x2[2 * k] = lo16(b[k]); x2[2 * k + 1] = hi16(b[k]); }
        if (row < NLAT) {
            const float* ct = (const float*)(p.ws + WS_ROPE) + (row & (SEQ - 1)) * 16 + 8 * hh; const float* st = ct + 2048 * 16;
#pragma unroll
            for (int k = 0; k < 8; ++k) { const float c = ct[k], sn = st[k], u1 = x1[k], u2 = x2[k]; x1[k] = u1 * c - u2 * sn; x2[k] = u1 * sn + u2 * c; }
        }
        const u32x4 q0 = (u32x4){cvtpk(x1[0], x1[1]), cvtpk(x1[2], x1[3]), cvtpk(x1[4], x1[5]), cvtpk(x1[6], x1[7])};
        const u32x4 q1 = (u32x4){cvtpk(x2[0], x2[1]), cvtpk(x2[2], x2[3]), cvtpk(x2[4], x2[5]), cvtpk(x2[6], x2[7])};
        qf[0] = __builtin_bit_cast(bf16x8, q0); qf[1] = __builtin_bit_cast(bf16x8, q1);
    }
    const float af = exp2f(l2f * (float)i), ab = exp2f(-l2b * (float)i), cf = exp2f(l2f * (float)(i + 1)), cb = exp2f(l2b * (float)(128 - i));
    f32x16 y, zero;
#pragma unroll
    for (int r = 0; r < 16; ++r) { y[r] = 0.f; zero[r] = 0.f; }
    const int koff = r32 * KROW + 16 * hh;
    const int voff = O_V + eb * 8192 + (4 * hh + ((lane & 15) >> 2)) * 64 + ((lane >> 4) & 1) * 32 + (lane & 3) * 8;
#pragma unroll
    for (int kb = 0; kb < 4; ++kb) {
        f32x16 pt;
        if (kb <= qb) {
            f32x16 sF = __builtin_amdgcn_mfma_f32_32x32x16_bf16(*(const bf16x8*)(lds + O_KF + kb * 32 * KROW + koff), qf[0], zero, 0, 0, 0);
            sF = __builtin_amdgcn_mfma_f32_32x32x16_bf16(*(const bf16x8*)(lds + O_KF + kb * 32 * KROW + koff + 32), qf[1], sF, 0, 0, 0);
            if (kb < qb) {
#pragma unroll
                for (int r = 0; r < 16; ++r) pt[r] = sF[r] * af;
            } else {
#pragma unroll
                for (int r = 0; r < 16; ++r) { const int j = (r & 3) + 8 * (r >> 2) + 4 * hh; pt[r] = (j <= r32) ? sF[r] * af : 0.f; }
            }
        }
        if (kb >= qb) {
            f32x16 sB = __builtin_amdgcn_mfma_f32_32x32x16_bf16(*(const bf16x8*)(lds + O_KB + kb * 32 * KROW + koff), qf[0], zero, 0, 0, 0);
            sB = __builtin_amdgcn_mfma_f32_32x32x16_bf16(*(const bf16x8*)(lds + O_KB + kb * 32 * KROW + koff + 32), qf[1], sB, 0, 0, 0);
            if (kb > qb) {
#pragma unroll
                for (int r = 0; r < 16; ++r) pt[r] = sB[r] * ab;
            } else {
#pragma unroll
                for (int r = 0; r < 16; ++r) { const int j = (r & 3) + 8 * (r >> 2) + 4 * hh; pt[r] += (j >= r32) ? sB[r] * ab : 0.f; }
            }
        }
#pragma unroll
        for (int s2 = 0; s2 < 2; ++s2) {
            const u32x4 pw = (u32x4){cvtpk(pt[8 * s2], pt[8 * s2 + 1]), cvtpk(pt[8 * s2 + 2], pt[8 * s2 + 3]), cvtpk(pt[8 * s2 + 4], pt[8 * s2 + 5]), cvtpk(pt[8 * s2 + 6], pt[8 * s2 + 7])};
            const unsigned char* vb = lds + voff + (kb * 32 + s2 * 16) * 64;
            y = __builtin_amdgcn_mfma_f32_32x32x16_bf16(tr8(vb, vb + 8 * 64), __builtin_bit_cast(bf16x8, pw), y, 0, 0, 0);
        }
    }
    {
        const int soff = (eb * 32 + r32) * KROW + 16 * hh;
        f32x16 tF = __builtin_amdgcn_mfma_f32_32x32x16_bf16(*(const bf16x8*)(lds + O_SF + soff), qf[0], zero, 0, 0, 0);
        tF = __builtin_amdgcn_mfma_f32_32x32x16_bf16(*(const bf16x8*)(lds + O_SF + soff + 32), qf[1], tF, 0, 0, 0);
        f32x16 tB = __builtin_amdgcn_mfma_f32_32x32x16_bf16(*(const bf16x8*)(lds + O_SB + soff), qf[0], zero, 0, 0, 0);
        tB = __builtin_amdgcn_mfma_f32_32x32x16_bf16(*(const bf16x8*)(lds + O_SB + soff + 32), qf[1], tB, 0, 0, 0);
#pragma unroll
        for (int r = 0; r < 16; ++r) y[r] += tF[r] * cf + tB[r] * cb;
    }
    float s1 = 0.f, s2 = 0.f;
#pragma unroll
    for (int r = 0; r < 16; ++r) { s1 += y[r]; s2 += y[r] * y[r]; }
    s1 += __shfl_xor(s1, 32); s2 += __shfl_xor(s2, 32);
    float* red = (float*)(lds + O_RED);
    if (hh == 0) { red[(eb * 128 + i) * 2] = s1; red[(eb * 128 + i) * 2 + 1] = s2; }
    __syncthreads();
    s1 = red[i * 2] + red[(128 + i) * 2]; s2 = red[i * 2 + 1] + red[(128 + i) * 2 + 1];
    const float mu = s1 * (1.f / 64.f), var = fmaxf(s2 * (1.f / 64.f) - mu * mu, 0.f), rstd = rsqrtf(var + NORM_EPS);
    const bf16_t* zg = (const bf16_t*)(p.ws + WS_Z) + (size_t)row * ZC + Z_RG + h * 64 + eb * 32 + 4 * hh;
    const float* gw = p.in[13] + L * 256 + h * 64 + eb * 32 + 4 * hh;
    bf16_t* orow = (bf16_t*)(p.ws + WS_CC) + (size_t)row * D + 256 + h * 64 + eb * 32 + 4 * hh;
#pragma unroll
    for (int r4 = 0; r4 < 4; ++r4) {
        const u32x2 gz = *(const u32x2*)(zg + 8 * r4); const f32x4 w4 = *(const f32x4*)(gw + 8 * r4);
        const float g0 = lo16(gz.x), g1 = hi16(gz.x), g2 = lo16(gz.y), g3 = hi16(gz.y);
        u32x2 o; o.x = cvtpk(siluf(g0) * ((y[4 * r4] - mu) * rstd * w4.x), siluf(g1) * ((y[4 * r4 + 1] - mu) * rstd * w4.y));
        o.y = cvtpk(siluf(g2) * ((y[4 * r4 + 2] - mu) * rstd * w4.z), siluf(g3) * ((y[4 * r4 + 3] - mu) * rstd * w4.w));
        *(u32x2*)(orow + 8 * r4) = o;
    }
    __syncthreads();
}
__device__ __forceinline__ void qkv_proj(unsigned char* lds, const P& p, int L) {
    const float* sskv = (const float*)(p.ws + WS_SS) + (size_t)NTOK * 4;
    const int G = gridDim.x, bid = blockIdx.x;
    {
        bf16_t* Q = (bf16_t*)(p.ws + WS_Q);
        ge::DenseOrder S; S.nM = NTOK / 256; S.nN = 3; S.nwg = S.nM * 3; S.G = G; S.c = bid; S.Bt = (const char*)((const bf16_t*)(p.ws + WS_WUQ) + (size_t)L * 768 * 256); S.btile = (size_t)256 * 256 * 2; S.arow = ZC * 2;
        auto f = [&](const ge::Unit& u, int r, int c, f32x4 v) {
            u32x2 w; w.x = cvtpk(v.x, v.y); w.y = cvtpk(v.z, v.w); *(u32x2*)(Q + (size_t)(u.a * 256 + r) * 768 + u.b * 256 + c) = w;
        };
        ge::EpiFn<decltype(f)> E{f};
        ge::gemm_stream<ge::DenseOrder, ge::EpiFn<decltype(f)>, true>((LAS unsigned char*)lds, (const char*)(p.ws + WS_Z) + Z_CQ * 2, 256, S, E);
    }
    {
        bf16_t* Kb = (bf16_t*)(p.ws + WS_K); bf16_t* Vb = (bf16_t*)(p.ws + WS_V);
        ge::DenseOrder S; S.nM = NTOK / 256; S.nN = 4; S.nwg = S.nM * 4; S.G = G; S.c = (bid + 176) % G; S.Bt = (const char*)((const bf16_t*)(p.ws + WS_WUKV) + (size_t)L * 1024 * 256); S.btile = (size_t)256 * 256 * 2; S.arow = ZC * 2;
        struct EpiKV {
            bf16_t* Kb; bf16_t* Vb; const float* sskv;
            __device__ __forceinline__ void operator()(const ge::Acc& acc, const ge::Unit& u, int wr, int wc, int fr, int fq) const {
                float rstd[2][4];
#pragma unroll
                for (int ai = 0; ai < 2; ++ai)
#pragma unroll
                    for (int m = 0; m < 4; ++m) { const f32x4 s4 = *(const f32x4*)(sskv + (size_t)(u.a * 256 + ai * 128 + wr * 64 + m * 16 + fr) * 4); rstd[ai][m] = rsqrtf((s4.x + s4.y + s4.z + s4.w) * (1.f / 128.f) + NORM_EPS); }
#pragma unroll
                for (int ai = 0; ai < 2; ++ai)
#pragma unroll
                    for (int m = 0; m < 4; ++m) {
                        const int row = u.a * 256 + ai * 128 + wr * 64 + m * 16 + fr;
#pragma unroll
                        for (int bj = 0; bj < 2; ++bj)
#pragma unroll
                            for (int n = 0; n < 2; ++n) {
                                const int col = u.b * 256 + bj * 128 + wc * 32 + n * 16 + 4 * fq, h = col >> 7, j = col & 127;
                                const f32x4 v = acc[ai][bj][m][n] * rstd[ai][m];
                                u32x2 w; w.x = cvtpk(v.x, v.y); w.y = cvtpk(v.z, v.w);
                                if (j < 64) *(u32x2*)(Kb + (size_t)row * 768 + h * 96 + j) = w;
                                else *(u32x2*)(Vb + (size_t)row * 512 + h * 64 + (j - 64)) = w;
                            }
                    }
            }
        };
        EpiKV E{Kb, Vb, sskv};
        ge::gemm_stream<ge::DenseOrder, EpiKV, true>((LAS unsigned char*)lds, (const char*)(p.ws + WS_Z) + Z_CKV * 2, 256, S, E);
    }
}
__device__ __forceinline__ void phase_b(unsigned char* lds, const P& p, int L) {
    const int G = gridDim.x, bid = blockIdx.x;
    qkv_proj(lds, p, L);
    const int nconv = (L == 0) ? 576 : 512;
    const int nkv = 288 * 4;
    const int total = nconv + nkv;
    for (int u = (bid + 96) % G; u < total; u += G) {
        int r = u;
        if (r < nconv) { if (r < 512) conv_unit(lds, p, L, r >> 5, r & 31); else conv_unit(lds, p, L, 16 + ((r - 512) >> 2), (r - 512) & 3); continue; } r -= nconv;
        retkv_unit_mfma(lds, p, L, r >> 2, r & 3);
    }
    if (L == 1) convert_expert_weights(lds, p, 1);
}

__device__ __forceinline__ void attn_unit_naive(unsigned char* lds, const P& p, int b, int h, int qb, bool ctxq) {
    float* Ks = (float*)lds;
    float* Vs = Ks + 64 * 96;
    const int tid = threadIdx.x, half = tid & 1, qi = tid >> 1;
    const bf16_t* Qb = (const bf16_t*)(p.ws + WS_Q); const bf16_t* Kb = (const bf16_t*)(p.ws + WS_K); const bf16_t* Vb = (const bf16_t*)(p.ws + WS_V);
    const int qrow = ctxq ? NLAT + b * CTXL + qi : b * SEQ + qb * 256 + qi;
    float q[48];
    {
        const u32x4* qp = (const u32x4*)(Qb + (size_t)qrow * 768 + h * 96 + half * 48);
#pragma unroll
        for (int i = 0; i < 6; ++i) { const u32x4 w = qp[i];
#pragma unroll
            for (int k = 0; k < 4; ++k) { q[i * 8 + 2 * k] = lo16(w[k]); q[i * 8 + 2 * k + 1] = hi16(w[k]); } }
    }
    float o[32];
#pragma unroll
    for (int e = 0; e < 32; ++e) o[e] = 0.f;
    float m = -1e30f, l = 0.f;
    const int ntiles = ctxq ? 4 : 36;
#pragma unroll 1
    for (int t = 0; t < ntiles; ++t) {
        const int krow0 = t < 4 ? NLAT + b * CTXL + t * 64 : b * SEQ + (t - 4) * 64;
        __syncthreads();
        for (int i = tid; i < 64 * 12; i += NTHREADS) { const int key = i / 12, c = i % 12; const u32x4 w = *(const u32x4*)(Kb + (size_t)(krow0 + key) * 768 + h * 96 + c * 8);
            float* d = Ks + key * 96 + c * 8;
#pragma unroll
            for (int k = 0; k < 4; ++k) { d[2 * k] = lo16(w[k]); d[2 * k + 1] = hi16(w[k]); } }
        for (int i = tid; i < 64 * 8; i += NTHREADS) { const int key = i >> 3, c = i & 7; const u32x4 w = *(const u32x4*)(Vb + (size_t)(krow0 + key) * 512 + h * 64 + c * 8);
            float* d = Vs + key * 64 + c * 8;
#pragma unroll
            for (int k = 0; k < 4; ++k) { d[2 * k] = lo16(w[k]); d[2 * k + 1] = hi16(w[k]); } }
        __syncthreads();
#pragma unroll 1
        for (int j0 = 0; j0 < 64; j0 += 2) {
            float s[2]; float mt = -1e30f;
#pragma unroll
            for (int jj = 0; jj < 2; ++jj) {
                const f32x4* kr = (const f32x4*)(Ks + (j0 + jj) * 96 + half * 48);
                float a = 0.f;
#pragma unroll
                for (int d4 = 0; d4 < 12; ++d4) { const f32x4 kv = kr[d4]; a += q[4 * d4] * kv.x + q[4 * d4 + 1] * kv.y + q[4 * d4 + 2] * kv.z + q[4 * d4 + 3] * kv.w; }
                a += __shfl_xor(a, 1);
                s[jj] = a; mt = fmaxf(mt, a);
            }
            const float mn = fmaxf(m, mt), alpha = exp2f(m - mn);
            m = mn; l *= alpha;
#pragma unroll
            for (int e = 0; e < 32; ++e) o[e] *= alpha;
#pragma unroll
            for (int jj = 0; jj < 2; ++jj) {
                const float pj = exp2f(s[jj] - mn); l += pj;
                const f32x4* vr = (const f32x4*)(Vs + (j0 + jj) * 64 + half * 32);
#pragma unroll
                for (int e4 = 0; e4 < 8; ++e4) { const f32x4 vv = vr[e4]; o[4 * e4] += pj * vv.x; o[4 * e4 + 1] += pj * vv.y; o[4 * e4 + 2] += pj * vv.z; o[4 * e4 + 3] += pj * vv.w; }
            }
        }
    }
    {
        const float rl = 1.f / l;
        u32x4* op = (u32x4*)((bf16_t*)(p.ws + WS_CC) + (size_t)qrow * D + 512 + h * 64 + half * 32);
#pragma unroll
        for (int i = 0; i < 4; ++i) { u32x4 w; w.x = pk2(o[8 * i] * rl, o[8 * i + 1] * rl); w.y = pk2(o[8 * i + 2] * rl, o[8 * i + 3] * rl); w.z = pk2(o[8 * i + 4] * rl, o[8 * i + 5] * rl); w.w = pk2(o[8 * i + 6] * rl, o[8 * i + 7] * rl); op[i] = w; }
    }
    __syncthreads();
}
constexpr int AT_KROW = 208;
constexpr int AT_KBUF = 64 * AT_KROW;
constexpr int AT_VBUF = 8192;
constexpr int AT_BUF = AT_KBUF + AT_VBUF;
__device__ __forceinline__ void attn_unit_mfma(unsigned char* lds, const P& p, int b, int h, int qb, bool ctxq) {
    const int tid = threadIdx.x, lane = tid & 63, wid = tid >> 6, r32 = lane & 31, hh = lane >> 5;
    const bf16_t* Qb = (const bf16_t*)(p.ws + WS_Q); const bf16_t* Kb = (const bf16_t*)(p.ws + WS_K); const bf16_t* Vb = (const bf16_t*)(p.ws + WS_V);
    const int qrow = (ctxq ? NLAT + b * CTXL : b * SEQ + qb * 256) + wid * 32 + r32;
    bf16x8 qf[6];
    {
        const f32x4 s4 = *(const f32x4*)((const float*)(p.ws + WS_SS) + (size_t)qrow * 4);
        const float rstd = rsqrtf((s4.x + s4.y + s4.z + s4.w) * (1.f / 256.f) + NORM_EPS);
        const float* ct = (const float*)(p.ws + WS_ROPE) + (qrow & (SEQ - 1)) * 16; const float* st = ct + 2048 * 16;
#pragma unroll
        for (int s = 0; s < 6; ++s) {
            const u32x4 w = *(const u32x4*)(Qb + (size_t)qrow * 768 + h * 96 + 16 * s + 8 * hh);
            float x[8];
#pragma unroll
            for (int k = 0; k < 4; ++k) { x[2 * k] = lo16(w[k]) * rstd; x[2 * k + 1] = hi16(w[k]) * rstd; }
            if (s >= 4 && !ctxq) {
                const f32x4 c4 = *(const f32x4*)(ct + 8 * (s - 4) + 4 * hh), sn = *(const f32x4*)(st + 8 * (s - 4) + 4 * hh);
#pragma unroll
                for (int k = 0; k < 4; ++k) { const float a = x[2 * k], b2 = x[2 * k + 1]; x[2 * k] = a * c4[k] - b2 * sn[k]; x[2 * k + 1] = a * sn[k] + b2 * c4[k]; }
            }
            const u32x4 o = (u32x4){cvtpk(x[0], x[1]), cvtpk(x[2], x[3]), cvtpk(x[4], x[5]), cvtpk(x[6], x[7])};
            qf[s] = __builtin_bit_cast(bf16x8, o);
        }
    }
    f32x16 o0, o1, negm;
#pragma unroll
    for (int r = 0; r < 16; ++r) { o0[r] = 0.f; o1[r] = 0.f; negm[r] = 0.f; }
    float mhat = 0.f, l = 0.f;
    const int ntiles = ctxq ? 4 : 36;
    const int kk0 = tid / 12, kc0 = tid % 12, kk1 = (512 + tid) / 12, kc1 = (512 + tid) % 12, vk = tid >> 3, vc = tid & 7;
    const size_t kg0 = (size_t)kk0 * 768 + h * 96 + kc0 * 8, kg1 = (size_t)kk1 * 768 + h * 96 + kc1 * 8, vg = (size_t)vk * 512 + h * 64 + vc * 8;
    const int kl0 = kk0 * AT_KROW + kc0 * 16, kl1 = kk1 * AT_KROW + kc1 * 16, vl = AT_KBUF + (vc >> 2) * 4096 + vk * 64 + (vc & 3) * 16;
    auto krow0 = [&](int t) { return t < 4 ? NLAT + b * CTXL + t * 64 : b * SEQ + (t - 4) * 64; };
    u32x4 sk0, sk1, sv;
    { const int kr = krow0(0); sk0 = *(const u32x4*)(Kb + (size_t)kr * 768 + kg0); if (tid < 256) sk1 = *(const u32x4*)(Kb + (size_t)kr * 768 + kg1); sv = *(const u32x4*)(Vb + (size_t)kr * 512 + vg); }
    __syncthreads();
    *(u32x4*)(lds + kl0) = sk0; if (tid < 256) *(u32x4*)(lds + kl1) = sk1; *(u32x4*)(lds + vl) = sv;
    __syncthreads();
    const int koff = r32 * AT_KROW + 16 * hh;
    const int voff = AT_KBUF + (4 * hh + ((lane & 15) >> 2)) * 64 + ((lane >> 4) & 1) * 32 + (lane & 3) * 8;
#pragma unroll 1
    for (int t = 0; t < ntiles; ++t) {
        unsigned char* buf = lds + (t & 1) * AT_BUF;
        if (t + 1 < ntiles) { const int kr = krow0(t + 1); sk0 = *(const u32x4*)(Kb + (size_t)kr * 768 + kg0); if (tid < 256) sk1 = *(const u32x4*)(Kb + (size_t)kr * 768 + kg1); sv = *(const u32x4*)(Vb + (size_t)kr * 512 + vg); }
        f32x16 p0, p1;
        {
            const bf16x8 k0f = *(const bf16x8*)(buf + koff), k1f = *(const bf16x8*)(buf + koff + 32 * AT_KROW);
            p0 = __builtin_amdgcn_mfma_f32_32x32x16_bf16(k0f, qf[0], negm, 0, 0, 0);
            p1 = __builtin_amdgcn_mfma_f32_32x32x16_bf16(k1f, qf[0], negm, 0, 0, 0);
        }
#pragma unroll
        for (int s = 1; s < 6; ++s) {
            const bf16x8 k0f = *(const bf16x8*)(buf + koff + 32 * s), k1f = *(const bf16x8*)(buf + koff + 32 * AT_KROW + 32 * s);
            p0 = __builtin_amdgcn_mfma_f32_32x32x16_bf16(k0f, qf[s], p0, 0, 0, 0);
            p1 = __builtin_amdgcn_mfma_f32_32x32x16_bf16(k1f, qf[s], p1, 0, 0, 0);
        }
        float rm = fmaxf(fmaxf(p0[0], p0[1]), p1[0]);
#pragma unroll
        for (int r = 1; r < 16; ++r) rm = fmaxf(rm, r < 15 ? fmaxf(p0[r + (r > 0)], p1[r]) : p1[r]);
        rm = fmaxf(rm, __shfl_xor(rm, 32));
        if (__any(rm > 8.f)) {
            const float dl = fmaxf(rm, 0.f), f = __builtin_amdgcn_exp2f(-dl);
            mhat += dl; l *= f;
#pragma unroll
            for (int r = 0; r < 16; ++r) { p0[r] -= dl; p1[r] -= dl; o0[r] *= f; o1[r] *= f; negm[r] = -mhat; }
        }
        float ls = 0.f;
#pragma unroll
        for (int r = 0; r < 16; ++r) { p0[r] = __builtin_amdgcn_exp2f(p0[r]); p1[r] = __builtin_amdgcn_exp2f(p1[r]); ls += p0[r] + p1[r]; }
        l += ls;
        u32x4 pw[4];
#pragma unroll
        for (int s2 = 0; s2 < 2; ++s2) {
            pw[s2] = (u32x4){cvtpk(p0[8 * s2], p0[8 * s2 + 1]), cvtpk(p0[8 * s2 + 2], p0[8 * s2 + 3]), cvtpk(p0[8 * s2 + 4], p0[8 * s2 + 5]), cvtpk(p0[8 * s2 + 6], p0[8 * s2 + 7])};
            pw[2 + s2] = (u32x4){cvtpk(p1[8 * s2], p1[8 * s2 + 1]), cvtpk(p1[8 * s2 + 2], p1[8 * s2 + 3]), cvtpk(p1[8 * s2 + 4], p1[8 * s2 + 5]), cvtpk(p1[8 * s2 + 6], p1[8 * s2 + 7])};
        }
#pragma unroll
        for (int ks = 0; ks < 4; ++ks) {
            const LAS unsigned char* vb = (const LAS unsigned char*)(buf + voff + ks * 16 * 64);
            const v4i16_t a0 = __builtin_amdgcn_ds_read_tr16_b64_v4i16((LAS v4i16_t*)(vb)), a1 = __builtin_amdgcn_ds_read_tr16_b64_v4i16((LAS v4i16_t*)(vb + 8 * 64));
            const v4i16_t c0 = __builtin_amdgcn_ds_read_tr16_b64_v4i16((LAS v4i16_t*)(vb + 4096)), c1 = __builtin_amdgcn_ds_read_tr16_b64_v4i16((LAS v4i16_t*)(vb + 4096 + 8 * 64));
            const bf16x8 va = (bf16x8){a0[0], a0[1], a0[2], a0[3], a1[0], a1[1], a1[2], a1[3]}, vc2 = (bf16x8){c0[0], c0[1], c0[2], c0[3], c1[0], c1[1], c1[2], c1[3]};
            const bf16x8 pf = __builtin_bit_cast(bf16x8, pw[ks]);
            o0 = __builtin_amdgcn_mfma_f32_32x32x16_bf16(va, pf, o0, 0, 0, 0);
            o1 = __builtin_amdgcn_mfma_f32_32x32x16_bf16(vc2, pf, o1, 0, 0, 0);
        }
        if (t + 1 < ntiles) { unsigned char* nb = lds + ((t + 1) & 1) * AT_BUF; *(u32x4*)(nb + kl0) = sk0; if (tid < 256) *(u32x4*)(nb + kl1) = sk1; *(u32x4*)(nb + vl) = sv; }
        __syncthreads();
    }
    l += __shfl_xor(l, 32);
    const float rl = 1.f / l;
    bf16_t* orow = (bf16_t*)(p.ws + WS_CC) + (size_t)qrow * D + 512 + h * 64 + 4 * hh;
#pragma unroll
    for (int r4 = 0; r4 < 4; ++r4) {
        u32x2 w0; w0.x = cvtpk(o0[4 * r4] * rl, o0[4 * r4 + 1] * rl); w0.y = cvtpk(o0[4 * r4 + 2] * rl, o0[4 * r4 + 3] * rl);
        u32x2 w1; w1.x = cvtpk(o1[4 * r4] * rl, o1[4 * r4 + 1] * rl); w1.y = cvtpk(o1[4 * r4 + 2] * rl, o1[4 * r4 + 3] * rl);
        *(u32x2*)(orow + 8 * r4) = w0; *(u32x2*)(orow + 32 + 8 * r4) = w1;
    }
}
__device__ __forceinline__ void retout_unit(unsigned char* lds, const P& p, int L, int gc, int h) {
    float* qs = (float*)lds; float* ks = qs + 128 * 33; float* vs = ks + 128 * 33; float* Sf = vs + 128 * 64; float* Sb = Sf + 2048;
    const int tid = threadIdx.x;
    const float l2f = log2_gamma(p, L, 0, h), l2b = log2_gamma(p, L, 1, h);
    load_ret_qk(qs, p, gc, h, Z_RQ, 1.f);
    load_ret_qk(ks, p, gc, h, Z_RK, 0.17677669529663687f);
    load_ret_v(vs, p, gc, h);
    {
        const bool lat = gc < 256; const int b = lat ? gc >> 4 : (gc - 256) >> 1;
        const int mme = lat ? 2 + (gc & 15) : (gc - 256) & 1;
        const int u = mme, w = mme < 2 ? 1 - mme : 19 - mme;
        f32x4 sf = (f32x4){0.f, 0.f, 0.f, 0.f}, sb = sf;
        const float* KVb = (const float*)(p.ws + WS_KV);
#pragma unroll 1
        for (int mm = 0; mm < 18; ++mm) {
            const int gcm = mm < 2 ? 256 + b * 2 + mm : b * 16 + (mm - 2);
            const int um = mm, wm = mm < 2 ? 1 - mm : 19 - mm;
            const float* kv = KVb + ((size_t)(gcm * 4 + h) * 2) * 2048 + tid * 4;
            if (um < u) { const float wgt = exp2f(l2f * 128.f * (float)(u - 1 - um)); sf += wgt * *(const f32x4*)kv; }
            if (wm < w) { const float wgt = exp2f(l2b * 128.f * (float)(w - 1 - wm)); sb += wgt * *(const f32x4*)(kv + 2048); }
        }
        *(f32x4*)(Sf + tid * 4) = sf; *(f32x4*)(Sb + tid * 4) = sb;
    }
    __syncthreads();
    const int i = tid >> 2, e0 = (tid & 3) * 16;
    float q[32];
#pragma unroll
    for (int d = 0; d < 32; ++d) q[d] = qs[i * 33 + d];
    float acc[16];
#pragma unroll
    for (int e = 0; e < 16; ++e) acc[e] = 0.f;
#pragma unroll 1
    for (int j = 0; j < 128; ++j) {
        float s = 0.f;
#pragma unroll
        for (int d = 0; d < 32; ++d) s += q[d] * ks[j * 33 + d];
        float wgt = 0.f;
        if (j <= i) wgt += exp2f(l2f * (float)(i - j));
        if (j >= i) wgt += exp2f(l2b * (float)(j - i));
        s *= wgt;
#pragma unroll
        for (int e4 = 0; e4 < 4; ++e4) { const f32x4 v4 = *(const f32x4*)(vs + j * 64 + e0 + 4 * e4); acc[4 * e4] += s * v4.x; acc[4 * e4 + 1] += s * v4.y; acc[4 * e4 + 2] += s * v4.z; acc[4 * e4 + 3] += s * v4.w; }
    }
    {
        const float cf = exp2f(l2f * (float)(i + 1)), cb = exp2f(l2b * (float)(128 - i));
#pragma unroll 2
        for (int d = 0; d < 32; ++d) {
            const float qd = qs[i * 33 + d]; const float qf = qd * cf, qb = qd * cb;
#pragma unroll
            for (int e4 = 0; e4 < 4; ++e4) { const f32x4 a = *(const f32x4*)(Sf + d * 64 + e0 + 4 * e4), bq = *(const f32x4*)(Sb + d * 64 + e0 + 4 * e4);
                acc[4 * e4] += qf * a.x + qb * bq.x; acc[4 * e4 + 1] += qf * a.y + qb * bq.y; acc[4 * e4 + 2] += qf * a.z + qb * bq.z; acc[4 * e4 + 3] += qf * a.w + qb * bq.w; }
        }
    }
    float s1 = 0.f;
#pragma unroll
    for (int e = 0; e < 16; ++e) s1 += acc[e];
    s1 += __shfl_xor(s1, 1); s1 += __shfl_xor(s1, 2);
    const float mu = s1 * (1.f / 64.f);
    float s2 = 0.f;
#pragma unroll
    for (int e = 0; e < 16; ++e) { const float dd = acc[e] - mu; s2 += dd * dd; }
    s2 += __shfl_xor(s2, 1); s2 += __shfl_xor(s2, 2);
    const float rstd = rsqrtf(s2 * (1.f / 64.f) + NORM_EPS);
    const int row = gc * 128 + i;
    const bf16_t* zg = (const bf16_t*)(p.ws + WS_Z) + (size_t)row * ZC + Z_RG + h * 64 + e0;
    const float* gw = p.in[13] + L * 256 + h * 64 + e0;
    const u32x4 g0 = *(const u32x4*)zg, g1 = *(const u32x4*)(zg + 8);
    float g[16];
#pragma unroll
    for (int k = 0; k < 4; ++k) { g[2 * k] = lo16(g0[k]); g[2 * k + 1] = hi16(g0[k]); g[8 + 2 * k] = lo16(g1[k]); g[8 + 2 * k + 1] = hi16(g1[k]); }
    unsigned o[8];
#pragma unroll
    for (int k = 0; k < 8; ++k) {
        const float y0 = siluf(g[2 * k]) * ((acc[2 * k] - mu) * rstd * gw[2 * k]), y1 = siluf(g[2 * k + 1]) * ((acc[2 * k + 1] - mu) * rstd * gw[2 * k + 1]);
        o[k] = pk2(y0, y1);
    }
    u32x4* op = (u32x4*)((bf16_t*)(p.ws + WS_CC) + (size_t)row * D + 256 + h * 64 + e0);
    u32x4 w0; w0.x = o[0]; w0.y = o[1]; w0.z = o[2]; w0.w = o[3]; u32x4 w1; w1.x = o[4]; w1.y = o[5]; w1.z = o[6]; w1.w = o[7];
    op[0] = w0; op[1] = w1;
    __syncthreads();
}
__device__ __forceinline__ void phase_c(unsigned char* lds, const P& p, int L) {
    const int G = gridDim.x, bid = blockIdx.x;
    const int nat = 16 * 8 * 8, nac = (L == 0) ? 128 : 0, nro = (L == 0 ? 288 : 256) * 4;
    const int total = nat + nac + nro;
    for (int u = bid; u < total; u += G) {
        int r = u;
#ifndef TEST_C
#define TEST_C 3
#endif
        if (r < nat) { if (TEST_C & 1) attn_unit_mfma(lds, p, r >> 6, (r >> 3) & 7, r & 7, false); continue; } r -= nat;
        if (r < nac) { if (TEST_C & 1) attn_unit_mfma(lds, p, r >> 3, r & 7, 0, true); continue; } r -= nac;
        if (TEST_C & 2) retout_unit_mfma(lds, p, L, r >> 2, r & 3);
    }
    if (L == 0) convert_expert_weights(lds, p, 0);
}

struct EpiY {
    bf16_t* Y; const float* g1;
    __device__ __forceinline__ void operator()(const ge::Acc& acc, const ge::Unit& u, int wr, int wc, int fr, int fq) const {
        const float* gr = g1 + (size_t)mod_row(u.a * 256) * 6144 + u.b * 256 + wc * 32 + 4 * fq;
        f32x4 g[2][2];
#pragma unroll
        for (int bj = 0; bj < 2; ++bj)
#pragma unroll
            for (int n = 0; n < 2; ++n) g[bj][n] = *(const f32x4*)(gr + bj * 128 + n * 16);
#pragma unroll
        for (int ai = 0; ai < 2; ++ai)
#pragma unroll
            for (int m = 0; m < 4; ++m) {
                bf16_t* yr = Y + (size_t)(u.a * 256 + ai * 128 + wr * 64 + m * 16 + fr) * D + u.b * 256 + wc * 32 + 4 * fq;
#pragma unroll
                for (int bj = 0; bj < 2; ++bj)
#pragma unroll
                    for (int n = 0; n < 2; ++n) { const f32x4 v = acc[ai][bj][m][n] * g[bj][n]; u32x2 w; w.x = cvtpk(v.x, v.y); w.y = cvtpk(v.z, v.w); *(u32x2*)(yr + bj * 128 + n * 16) = w; }
            }
    }
};
__device__ __forceinline__ void phase_d(unsigned char* lds, const P& p, int L) {
    ge::DenseOrder S; S.nM = (L == 0 ? NTOK : NLAT) / 256; S.nN = 4; S.nwg = S.nM * 4; S.G = gridDim.x; S.c = blockIdx.x;
    S.Bt = (const char*)((const bf16_t*)(p.ws + WS_WOUT) + (size_t)L * D * D); S.btile = (size_t)256 * D * 2; S.arow = D * 2;
    EpiY E{(bf16_t*)(p.ws + WS_Y), (const float*)(p.ws + WS_MODV) + (size_t)L * 17 * 6144 + 2048};
    ge::gemm_stream<ge::DenseOrder, EpiY, true>((LAS unsigned char*)lds, (const char*)(p.ws + WS_CC), D, S, E);
}

__device__ __forceinline__ void norm_mod_store(const P& p, int L, int which, int tok, int lane, const f32x4 (&v)[4], bf16_t* Hdst) {
    const float* nw = (which == 0 ? p.in[6] : p.in[19]) + L * D;
    const float* mrow = (const float*)(p.ws + WS_MODV) + ((size_t)L * 17 + mod_row(tok)) * 6144 + which * 3072;
    float s = 0.f;
#pragma unroll
    for (int j = 0; j < 4; ++j) s += v[j].x * v[j].x + v[j].y * v[j].y + v[j].z * v[j].z + v[j].w * v[j].w;
    const float rstd = rsqrtf(wave_sum(s) * (1.f / D) + NORM_EPS);
    u32x2* o = (u32x2*)(Hdst + (size_t)tok * D) + lane;
#pragma unroll
    for (int j = 0; j < 4; ++j) {
        const int k = 4 * lane + 256 * j;
        const f32x4 w4 = *(const f32x4*)(nw + k), sh = *(const f32x4*)(mrow + k), sc = *(const f32x4*)(mrow + 1024 + k);
        const f32x4 y = v[j] * rstd * w4 * (sc + 1.f) + sh;
        u32x2 w; w.x = cvtpk(y.x, y.y); w.y = cvtpk(y.z, y.w); o[64 * j] = w;
    }
}
__device__ __forceinline__ int half_n(int L) { return L == 0 ? NTOK / 2 : NLAT / 2; }
__device__ __forceinline__ void phase_router(unsigned char* lds, const P& p, int L) {
    const bf16_t* H = (const bf16_t*)(p.ws + WS_H); const bf16_t* W = (const bf16_t*)(p.ws + WS_RT) + (size_t)L * 128 * D;
    const bf16_t* Y = (const bf16_t*)(p.ws + WS_Y);
    float* lg = (float*)(lds + LG_OFF);
    int* lcnt = (int*)(lds + LG_OFF + 32768);
    int* sel = (int*)(lds + LG_OFF + 33280);
    float* selw = (float*)(lds + LG_OFF + 36352);
    int* ltok = (int*)(p.ws + WS_LTOK); float* lw = (float*)(p.ws + WS_LW);
    const int tid = threadIdx.x, lane = tid & 63, wave = tid >> 6;
    const float rb = p.in[21][L * NEXP + lane];
    const int ntok = (L == 0 ? NTOK : NLAT), nmt = ntok / 128, HN = half_n(L);
    for (int mt = blockIdx.x; mt < nmt; mt += gridDim.x) {
        if (tid < 64) lcnt[tid] = 0;
        for (int q = 0; q < 16; ++q) {
            const int tok = mt * 128 + wave * 16 + q;
            const f32x4* xi = (const f32x4*)(L == 0 ? x_in_row(p, tok) : (const float*)x_row(p, tok)) + lane;
            const u32x2* yr = (const u32x2*)(Y + (size_t)tok * D) + lane;
            f32x4* xo = (f32x4*)x_row(p, tok) + lane;
            f32x4 v[4];
#pragma unroll
            for (int j = 0; j < 4; ++j) { const f32x4 a = xi[64 * j]; const u32x2 y = yr[64 * j]; v[j] = (f32x4){a.x + lo16(y.x), a.y + hi16(y.x), a.z + lo16(y.y), a.w + hi16(y.y)}; xo[64 * j] = v[j]; }
            norm_mod_store(p, L, 1, tok, lane, v, (bf16_t*)(p.ws + WS_H));
        }
        asm volatile("s_waitcnt vmcnt(0)" ::: "memory");
        __syncthreads();
        auto rs = [&](int pr) { return H + (size_t)(mt * 128 + pr) * D; };
        auto epi = [&](int r, int c, f32x4 v) { if (c < 64) *(f32x4*)(lg + r * 64 + c) = v; };
        gemm_tile<false>(lds, rs, W, D, D, epi);
        __syncthreads();
        for (int q = 0; q < 16; ++q) {
            const int tl = wave * 16 + q;
            const float x = lg[tl * 64 + lane];
            const float sc = 1.f / (1.f + expf(-x));
            float sel_v = sc + rb; float wsum = 0.f; int myk = -1;
#pragma unroll
            for (int k = 0; k < TOPK; ++k) {
                float bv = sel_v; int bi = lane;
#pragma unroll
                for (int off = 32; off >= 1; off >>= 1) {
                    const float ov = __shfl_xor(bv, off); const int oi = __shfl_xor(bi, off);
                    if (ov > bv || (ov == bv && oi < bi)) { bv = ov; bi = oi; }
                }
                wsum += __shfl(sc, bi);
                if (lane == bi) { myk = k; sel_v = -INFINITY; }
            }
            if (myk >= 0) {
                const int rank = atomicAdd(&lcnt[lane], 1);
                sel[tl * 6 + myk] = (lane << 8) | rank; selw[tl * 6 + myk] = sc / wsum * 2.5f;
            }
        }
        __syncthreads();
        const int hf = (mt * 128) / HN;
        if (tid < 64) {
            unsigned* ecnt = (unsigned*)(p.ws + WS_CTL) + CW_ECNT + (L * 2 + hf) * 4096;
            const int c = lcnt[tid];
            lcnt[64 + tid] = c ? (int)atomicAdd(ecnt + tid * 64, (unsigned)c) : 0;
        }
        __syncthreads();
        for (int i = tid; i < 768; i += NTHREADS) {
            const int sv = sel[i], e = sv >> 8, pos = lcnt[64 + e] + (sv & 255), tok = mt * 128 + i / 6, k = i % 6;
            ltok[(size_t)(hf * 64 + e) * LCAPH + pos] = tok * 8 + k;
            lw[(size_t)(hf * 64 + e) * LCAPH + pos] = selw[i];
        }
        __syncthreads();
    }
}

__device__ __forceinline__ void build_etab(unsigned char* lds, const P& p, int L) {
    int* tstart = (int*)(lds + ETAB_OFF); int* cnt = tstart + 160;
    __syncthreads();
    if (threadIdx.x < 128) { const unsigned* ecnt = (const unsigned*)(p.ws + WS_CTL) + CW_ECNT + (L * 2 + (threadIdx.x >> 6)) * 4096;
        cnt[threadIdx.x] = (int)__hip_atomic_load(ecnt + (threadIdx.x & 63) * 64, __ATOMIC_RELAXED, __HIP_MEMORY_SCOPE_AGENT); }
    __syncthreads();
    if (threadIdx.x == 0) { int s = 0; for (int hf = 0; hf < 2; ++hf) { for (int e = 0; e < 64; ++e) { tstart[hf * 66 + e] = s; s += (cnt[hf * 64 + e] + 255) >> 8; } tstart[hf * 66 + 64] = s; s += half_n(L) / 256; tstart[hf * 66 + 65] = s; } }
    __syncthreads();
}
struct MoeOrder {
    int tlo, thi, nN, G, c; const int* tstart; const char* Bexp; size_t bexp; const char* Bsh; size_t btile; const int* rowbuf; unsigned arow; bool ident;
    __device__ __forceinline__ bool next(int i, ge::Unit& u) const {
        const int Lq = i * G + c; if (Lq >= (thi - tlo) * nN) return false;
        const int t = tlo + Lq / nN, pn = Lq % nN;
        const int hf = t >= tstart[66] ? 1 : 0; const int* ts = tstart + hf * 66;
        int lo = 0, hi = 64;
        while (lo < hi) { const int mid = (lo + hi + 1) >> 1; if (ts[mid] <= t) lo = mid; else hi = mid - 1; }
        const int e = __builtin_amdgcn_readfirstlane(lo);
        u.a = t; u.b = pn; u.c = hf * 128 + e; u.d = i;
        u.B = (e < 64 ? Bexp + (size_t)e * bexp : Bsh) + (size_t)pn * btile;
        return true;
    }
    __device__ __forceinline__ unsigned aoff(int i, const ge::Unit& u, int R) const { return (unsigned)(ident ? u.a * 256 + R : rowbuf[i * 256 + R]) * arow; }
};
__device__ __forceinline__ void phase_gateup(unsigned char* lds, const P& p, int L) {
    build_etab(lds, p, L);
    const int* tstart = (const int*)(lds + ETAB_OFF); const int* cnt = tstart + 160;
    int* rowbuf = (int*)(lds + RB0_OFF); float* wbuf = (float*)(lds + RB1_OFF);
    const int* ltok = (const int*)(p.ws + WS_LTOK); const float* lw = (const float*)(p.ws + WS_LW);
    bf16_t* ACT = (bf16_t*)(p.ws + WS_ACT);
    const int G = gridDim.x, bid = blockIdx.x, vcu = (G % 8 == 0) ? (bid % 8) * (G / 8) + bid / 8 : bid, HN = half_n(L);
    MoeOrder S; S.tlo = 0; S.thi = tstart[66 + 65]; S.nN = 2; S.G = G; S.c = vcu; S.tstart = tstart; S.Bexp = (const char*)(p.ws + WS_EGU); S.bexp = (size_t)512 * D * 2;
    S.Bsh = (const char*)((const bf16_t*)(p.ws + WS_SHGU) + (size_t)L * 512 * D); S.btile = (size_t)256 * D * 2; S.rowbuf = rowbuf; S.arow = D * 2; S.ident = false;
    {
        ge::Unit u;
        for (int i = 0; i < 10 && S.next(i, u); ++i) {
            if (threadIdx.x < 256) {
                const int R = threadIdx.x, hf = u.c >> 7, e = u.c & 127, mt = u.a - tstart[hf * 66 + e];
                int tok; float w;
                if (e < 64) { const int lp = mt * 256 + R; const bool ok = lp < cnt[hf * 64 + e]; tok = ok ? (ltok[(size_t)(hf * 64 + e) * LCAPH + lp] >> 3) : 0; w = ok ? lw[(size_t)(hf * 64 + e) * LCAPH + lp] : 0.f; }
                else { tok = hf * HN + mt * 256 + R; w = 1.f; }
                rowbuf[i * 256 + R] = tok; wbuf[i * 256 + R] = w;
            }
        }
        __syncthreads();
    }
    auto f = [&](const ge::Unit& u, int r, int c, f32x4 v) {
        const float w = wbuf[u.d * 256 + r];
        const float a0 = siluf(v.x) * v.y * w, a1 = siluf(v.z) * v.w * w;
        *(unsigned*)(ACT + (size_t)(u.a * 256 + r) * EDIM + ((u.b * 256 + c) >> 1)) = cvtpk(a0, a1);
    };
    ge::EpiFn<decltype(f)> E{f};
    ge::gemm_stream<MoeOrder, ge::EpiFn<decltype(f)>, true>((LAS unsigned char*)lds, (const char*)(p.ws + (L == 0 ? WS_H : WS_H)), D, S, E);
}
__device__ __forceinline__ void phase_down(unsigned char* lds, const P& p, int L, int hf) {
    build_etab(lds, p, L);
    const int* tstart = (const int*)(lds + ETAB_OFF); const int* cnt = tstart + 160;
    int* sbuf = (int*)(lds + RB0_OFF);
    const int* ltok = (const int*)(p.ws + WS_LTOK);
    bf16_t* SLOT = (bf16_t*)(p.ws + WS_SLOT);
    const int G = gridDim.x, bid = blockIdx.x, vcu = (G % 8 == 0) ? (bid % 8) * (G / 8) + bid / 8 : bid, HN = half_n(L);
    MoeOrder S; S.tlo = tstart[hf * 66]; S.thi = tstart[hf * 66 + 65]; S.nN = 4; S.G = G; S.c = vcu; S.tstart = tstart; S.Bexp = (const char*)(p.ws + WS_ED); S.bexp = (size_t)D * EDIM * 2;
    S.Bsh = (const char*)((const bf16_t*)(p.ws + WS_SHD) + (size_t)L * D * EDIM); S.btile = (size_t)256 * EDIM * 2; S.rowbuf = sbuf; S.arow = EDIM * 2; S.ident = true;
    {
        ge::Unit u;
        for (int i = 0; i < 10 && S.next(i, u); ++i) {
            if (threadIdx.x < 256) {
                const int R = threadIdx.x, e = u.c & 127, mt = u.a - tstart[hf * 66 + e];
                int srow;
                if (e < 64) { const int lp = mt * 256 + R; if (lp < cnt[hf * 64 + e]) { const int ent = ltok[(size_t)(hf * 64 + e) * LCAPH + lp]; srow = ((ent >> 3) - hf * HN) * 7 + (ent & 7); } else srow = -1; }
                else srow = (mt * 256 + R) * 7 + 6;
                sbuf[i * 256 + R] = srow;
            }
        }
        __syncthreads();
    }
    auto f = [&](const ge::Unit& u, int r, int c, f32x4 v) {
        const int srow = sbuf[u.d * 256 + r];
        if (srow >= 0) { u32x2 w; w.x = cvtpk(v.x, v.y); w.y = cvtpk(v.z, v.w); *(u32x2*)(SLOT + (size_t)srow * D + u.b * 256 + c) = w; }
    };
    ge::EpiFn<decltype(f)> E{f};
    ge::gemm_stream<MoeOrder, ge::EpiFn<decltype(f)>, true>((LAS unsigned char*)lds, (const char*)(p.ws + WS_ACT), EDIM, S, E);
}
__device__ __forceinline__ void phase_combine(const P& p, int L, int hf) {
    const int tid = threadIdx.x, lane = tid & 63, wave = tid >> 6, gw = blockIdx.x * NWAVES + wave, NGW = gridDim.x * NWAVES;
    const bf16_t* SLOT = (const bf16_t*)(p.ws + WS_SLOT);
    const float* modv = (const float*)(p.ws + WS_MODV) + (size_t)L * 17 * 6144;
    const int HN = half_n(L);
    for (int tl = gw; tl < HN; tl += NGW) {
        const int tok = hf * HN + tl;
        f32x4 acc[4];
#pragma unroll
        for (int j = 0; j < 4; ++j) acc[j] = (f32x4){0.f, 0.f, 0.f, 0.f};
#pragma unroll
        for (int k = 0; k < 7; ++k) {
            const u32x2* sr = (const u32x2*)(SLOT + ((size_t)tl * 7 + k) * D) + lane;
#pragma unroll
            for (int j = 0; j < 4; ++j) { const u32x2 w = sr[64 * j]; acc[j].x += lo16(w.x); acc[j].y += hi16(w.x); acc[j].z += lo16(w.y); acc[j].w += hi16(w.y); }
        }
        const float* g2 = modv + (size_t)mod_row(tok) * 6144 + 5120;
        f32x4* xr = (f32x4*)x_row(p, tok) + lane;
        f32x4 v[4];
#pragma unroll
        for (int j = 0; j < 4; ++j) { const f32x4 g = *(const f32x4*)(g2 + 4 * lane + 256 * j); v[j] = xr[64 * j] + g * acc[j]; }
        if (L == 0) {
#pragma unroll
            for (int j = 0; j < 4; ++j) xr[64 * j] = v[j];
            norm_mod_store(p, 1, 0, tok, lane, v, (bf16_t*)(p.ws + WS_H1));
        } else {
            const float* nw = p.in[28]; float s = 0.f;
#pragma unroll
            for (int j = 0; j < 4; ++j) s += v[j].x * v[j].x + v[j].y * v[j].y + v[j].z * v[j].z + v[j].w * v[j].w;
            const float rstd = rsqrtf(wave_sum(s) * (1.f / D) + NORM_EPS);
#pragma unroll
            for (int j = 0; j < 4; ++j) { const f32x4 w4 = *(const f32x4*)(nw + 4 * lane + 256 * j); xr[64 * j] = v[j] * rstd * w4; }
        }
    }
}

constexpr int PH_LAYER0 = 2, PH_PER_LAYER = 10, PH_LAYER1 = PH_LAYER0 + PH_PER_LAYER, NPHASES = PH_LAYER1 + PH_PER_LAYER;

__global__ void __launch_bounds__(NTHREADS, 2) mk_fwd(P p) {
    extern __shared__ __attribute__((aligned(16))) unsigned char lds[];
    volatile LAS unsigned* MISC = (volatile LAS unsigned*)((LAS unsigned char*)lds + MISC_OFF);
    if (threadIdx.x < 64) MISC[threadIdx.x] = 0u;
    __syncthreads();
    unsigned* ctl = (unsigned*)(p.ws + WS_CTL);
    XcdBarrier bar; bar.bar = ctl + CW_BAR; bar.x = 0; bar.st = MISC + 8;
    if (!MK_PER_PHASE) bar = xcd_barrier_post(ctl + CW_BAR, MISC + 8);
    const int lo = p.ph_lo, hi = p.ph_hi;
#ifndef PH_MASK
#define PH_MASK 0xffffu
#endif
#define HAS(b) ((PH_MASK >> (b)) & 1u)
#define IN(k) (lo <= (k) && (k) < hi)
#define SEAM(k) do { if (IN(k) && IN((k) + 1)) xcd_barrier(bar); } while (0)

#ifdef PROBE_MASK
    unsigned long long tacc = 0ull, t0p = 0ull;
#define PT0() t0p = __builtin_amdgcn_s_memrealtime()
#define PT1(b) do { if ((PROBE_MASK >> (b)) & 1u) tacc += __builtin_amdgcn_s_memrealtime() - t0p; } while (0)
#else
#define PT0() do {} while (0)
#define PT1(b) do {} while (0)
#endif
#define PH(b, k, body) do { PT0(); if (HAS(b) && IN(k)) { body; } SEAM(k); PT1(b); } while (0)
    PH(0, 0, phase_prep(lds, p));
    PH(1, 1, phase_norm_mod(p, 0, 0, NTOK));
#define DOWN_COMBINE(L, pb, hf) \
        PH(9, pb + 6 + 2 * hf, phase_down(lds, p, L, hf)); \
        PH(10, pb + 7 + 2 * hf, phase_combine(p, L, hf));
#define LAYER(L, pb) \
        PH(2, pb + 0, phase_zgemm(lds, p, L)); \
        PH(3, pb + 1, phase_b(lds, p, L)); \
        PH(4, pb + 2, phase_c(lds, p, L)); \
        PH(5, pb + 3, phase_d(lds, p, L)); \
        PH(7, pb + 4, phase_router(lds, p, L)); \
        PH(8, pb + 5, phase_gateup(lds, p, L)); \
        DOWN_COMBINE(L, pb, 0) DOWN_COMBINE(L, pb, 1)
    LAYER(0, PH_LAYER0)
    LAYER(1, PH_LAYER1)
#ifdef PROBE_MASK
    if (blockIdx.x == 0) {
        const unsigned long long tend = __builtin_amdgcn_s_memrealtime();
        while (__builtin_amdgcn_s_memrealtime() - tend < (unsigned long long)PROBE_AMP * tacc) __builtin_amdgcn_s_sleep(8);
    }
#endif
#undef IN
#undef SEAM
}

extern "C" void kernel_launch(void* const* d_in, const int* in_sizes, int n_in, void* d_out, int out_size, void* d_ws, size_t ws_size, hipStream_t stream) {
    static int grid = 0;
    if (grid == 0) {
        if (n_in != 29 || in_sizes[0] != NLAT * D || out_size != NLAT * D || ws_size < WS_END) {
            fprintf(stderr, "kernel_launch: unexpected shapes / workspace (n_in %d, ws %zu, need %zu); nothing launched\n", n_in, ws_size, (size_t)WS_END); grid = -1; return; }
        int dev = 0, cus = 0, per_cu = 0;
        if (hipGetDevice(&dev) != hipSuccess || hipDeviceGetAttribute(&cus, hipDeviceAttributeMultiprocessorCount, dev) != hipSuccess) { grid = -1; return; }
        if (hipFuncSetAttribute((const void*)mk_fwd, hipFuncAttributeMaxDynamicSharedMemorySize, LDS_BYTES) != hipSuccess) { grid = -1; return; }
        if (hipOccupancyMaxActiveBlocksPerMultiprocessor(&per_cu, (const void*)mk_fwd, NTHREADS, LDS_BYTES) != hipSuccess || per_cu < 1) { fprintf(stderr, "kernel_launch: occupancy query says %d\n", per_cu); }
        (void)hipGetLastError();
        grid = cus;
    }
    if (grid < 0) return;
    (void)hipMemsetAsync((char*)d_ws + WS_CTL, 0, CTL_ZERO_BYTES, stream);
    P a{};
    for (int i = 0; i < 29; ++i) a.in[i] = (const float*)d_in[i];
    a.out = (float*)d_out; a.ws = (unsigned char*)d_ws;
#if MK_PER_PHASE
    for (int ph = 0; ph < NPHASES; ++ph) { a.ph_lo = ph; a.ph_hi = ph + 1; hipLaunchKernelGGL(mk_fwd, dim3(grid), dim3(NTHREADS), LDS_BYTES, stream, a); }
#else
    a.ph_lo = 0; a.ph_hi = NPHASES;
    hipLaunchKernelGGL(mk_fwd, dim3(grid), dim3(NTHREADS), LDS_BYTES, stream, a);
#endif
}
```

```cpp
#include <hip/hip_runtime.h>
#include <cstdio>
#include <cstdint>

#ifndef MK_PER_PHASE
#define MK_PER_PHASE 0
#endif

typedef unsigned short bf16_t;
typedef short bf16x8 __attribute__((ext_vector_type(8)));
typedef float f32x4 __attribute__((ext_vector_type(4)));
typedef unsigned u32x4 __attribute__((ext_vector_type(4)));
typedef unsigned u32x2 __attribute__((ext_vector_type(2)));
typedef float f32x16 __attribute__((ext_vector_type(16)));
typedef short v4i16_t __attribute__((ext_vector_type(4)));
#define LAS __attribute__((address_space(3)))

constexpr int D = 1024, BATCH = 16, SEQ = 2048, CTXL = 256;
constexpr int NLAT = BATCH * SEQ, NCTX = BATCH * CTXL, NTOK = NLAT + NCTX;
constexpr int ZC = 1792;
constexpr int Z_RQ = 512, Z_RK = 640, Z_RV = 768, Z_RG = 1024, Z_CQ = 1280, Z_CKV = 1536, Z_KR = 1664, Z_END = 1696;
constexpr int NEXP = 64, TOPK = 6, EDIM = 256;
constexpr float NORM_EPS = 1e-6f;
constexpr int NTHREADS = 512, NWAVES = 8;

constexpr size_t MiB = 1u << 20;
constexpr size_t WS_CTL = 0, CTL_ZERO_BYTES = 1 * MiB;
constexpr size_t WS_MODV = 1 * MiB;
constexpr size_t WS_ROPE = 2 * MiB;
constexpr size_t WS_WIN = 3 * MiB;
constexpr size_t WS_WUQ = 10 * MiB;
constexpr size_t WS_WUKV = 11 * MiB;
constexpr size_t WS_WOUT = 12 * MiB;
constexpr size_t WS_RT = 16 * MiB;
constexpr size_t WS_SHGU = 17 * MiB;
constexpr size_t WS_SHD = 19 * MiB;
constexpr size_t WS_EGU = 20 * MiB;
constexpr size_t WS_ED = 84 * MiB;
constexpr size_t WS_XC = 116 * MiB;
constexpr size_t WS_H = 132 * MiB;
constexpr size_t WS_H1 = 20 * MiB;
constexpr size_t WS_KV = WS_H;
constexpr size_t WS_R = 204 * MiB;
constexpr size_t WS_Z = WS_R;
constexpr size_t WS_Q = WS_R + 126 * MiB;
constexpr size_t WS_K = WS_R + 180 * MiB;
constexpr size_t WS_V = WS_R + 234 * MiB;
constexpr size_t WS_CC = WS_R + 270 * MiB;
constexpr size_t WS_SS = WS_R + 342 * MiB;
constexpr size_t WS_Y = WS_Z;
constexpr size_t WS_SLOT = 132 * MiB;
constexpr size_t WS_ACT = 410 * MiB;
constexpr size_t WS_LTOK = 552 * MiB;
constexpr size_t WS_LW = 561 * MiB;
constexpr size_t WS_END = 570 * MiB;
constexpr int LCAPH = 18432;
static_assert(WS_SLOT + (size_t)18432 * 7 * 1024 * 2 <= WS_ACT && WS_ACT + (size_t)1136 * 256 * 512 <= WS_LTOK, "MoE buffers");

constexpr int CW_TMO = 0;
constexpr int CW_BAR = 4096;
constexpr int CW_ECNT = 8192;

constexpr int LDS_BYTES = 155648;
constexpr int MISC_OFF = LDS_BYTES - 256;
constexpr int RB0_OFF = 131072;
constexpr int RB1_OFF = 141312;
constexpr int ETAB_OFF = 151552;
constexpr int GEMM_LDS = 36864;
constexpr int ROWSS_OFF = 36864;
constexpr int LG_OFF = 37376;

#define XB_TMO      128
#define XB_XCNT(j)  (256  + 64 * (j))
#define XB_XSUB(j)  (1280 + 64 * (j))
#define XB_XGEN(j)  (2304 + 64 * (j))
#define XB_TOP      3328
#define XB_TOPGEN   3392
#define XCD_BAR_WORDS 3456
#define XB_SPIN_CAP (1u << 24)
__device__ __forceinline__ unsigned xb_ld(unsigned* p)              { return __hip_atomic_load(p, __ATOMIC_RELAXED, __HIP_MEMORY_SCOPE_AGENT); }
__device__ __forceinline__ unsigned xb_add(unsigned* p, unsigned v) { return __hip_atomic_fetch_add(p, v, __ATOMIC_RELAXED, __HIP_MEMORY_SCOPE_AGENT); }
__device__ __forceinline__ unsigned xb_xcc_id() { return (unsigned)__builtin_amdgcn_s_getreg((3 << 11) | 20) & 0xFu; }
#define XB_SPIN(cond, bar) do { unsigned _sp = 0; while (cond) { __builtin_amdgcn_s_sleep(1); \
    if ((++_sp & 255u) == 0u) { if (xb_ld(&(bar)[XB_TMO])) break; if (_sp > XB_SPIN_CAP) { atomicAdd(&(bar)[XB_TMO], 1u); break; } } } } while (0)
struct XcdBarrier { unsigned* bar; unsigned x; volatile LAS unsigned* st; };
__device__ __forceinline__ XcdBarrier xcd_barrier_post(unsigned* bar, volatile LAS unsigned* st) {
    XcdBarrier b; b.bar = bar; b.x = xb_xcc_id(); b.st = st;
    if (threadIdx.x == 0) (void)xb_add(&bar[XB_XCNT(b.x)], 1u);
    return b;
}
__device__ __forceinline__ void xcd_barrier_complete(unsigned* bar, unsigned x, unsigned& nloc, unsigned& nx) {
    const unsigned G = gridDim.x * gridDim.y * gridDim.z;
    unsigned sum, cnt, mine, sp = 0u;
    for (;;) {
        sum = 0u; cnt = 0u; mine = 0u;
#pragma unroll
        for (unsigned j = 0; j < 16; ++j) { const unsigned c = xb_ld(&bar[XB_XCNT(j)]); sum += c; cnt += (c > 0u) ? 1u : 0u; mine = (j == x) ? c : mine; }
        if (sum == G) break;
        __builtin_amdgcn_s_sleep(1);
        if ((++sp & 255u) == 0u) { if (xb_ld(&bar[XB_TMO])) break; if (sp > XB_SPIN_CAP) { atomicAdd(&bar[XB_TMO], 1u); break; } }
    }
    nloc = mine > 0u ? mine : 1u; nx = cnt > 0u ? cnt : 1u;
}
__device__ __forceinline__ void xcd_barrier(const XcdBarrier& b) {
    asm volatile("s_waitcnt vmcnt(0)" ::: "memory");
    __syncthreads();
    if (threadIdx.x == 0) {
        unsigned* bar = b.bar;
        __builtin_amdgcn_s_waitcnt(0);
        unsigned nloc = b.st[0], nx = b.st[1];
        if (nloc == 0u) { xcd_barrier_complete(bar, b.x, nloc, nx); b.st[0] = nloc; b.st[1] = nx; }
        const unsigned old = xb_add(&bar[XB_XSUB(b.x)], 1u);
        const unsigned gen = old / nloc;
        if (old + 1u == (gen + 1u) * nloc) {
            __builtin_amdgcn_fence(__ATOMIC_RELEASE, "agent");
            asm volatile("s_waitcnt vmcnt(0)" ::: "memory");
            const unsigned og = xb_add(&bar[XB_TOP], 1u);
            const unsigned tg = og / nx;
            if (og + 1u == (tg + 1u) * nx) xb_add(&bar[XB_TOPGEN], 1u);
            else XB_SPIN(xb_ld(&bar[XB_TOPGEN]) == tg, bar);
            __builtin_amdgcn_fence(__ATOMIC_ACQUIRE, "agent");
            xb_add(&bar[XB_XGEN(b.x)], 1u);
            asm volatile("s_waitcnt vmcnt(0)" ::: "memory");
        } else {
            XB_SPIN(xb_ld(&bar[XB_XGEN(b.x)]) == gen, bar);
            __builtin_amdgcn_fence(__ATOMIC_ACQUIRE, "agent");
            asm volatile("s_waitcnt vmcnt(0)" ::: "memory");
        }
    }
    __syncthreads();
}

__device__ __forceinline__ float bf2f(unsigned h) { return __uint_as_float(h << 16); }
__device__ __forceinline__ unsigned f2bf(float f) { unsigned u = __float_as_uint(f); return (u + 0x7fffu + ((u >> 16) & 1u)) >> 16; }
__device__ __forceinline__ unsigned pk2(float lo, float hi) { return f2bf(lo) | (f2bf(hi) << 16); }
typedef float f32x2_t __attribute__((ext_vector_type(2)));
typedef __bf16 bf16x2_t __attribute__((ext_vector_type(2)));
__device__ __forceinline__ unsigned cvtpk(float lo, float hi) { f32x2_t v = {lo, hi}; bf16x2_t b = __builtin_convertvector(v, bf16x2_t); return __builtin_bit_cast(unsigned, b); }
__device__ __forceinline__ float lo16(unsigned w) { return __uint_as_float(w << 16); }
__device__ __forceinline__ float hi16(unsigned w) { return __uint_as_float(w & 0xffff0000u); }
__device__ __forceinline__ float wave_sum(float v) {
#pragma unroll
    for (int o = 1; o < 64; o <<= 1) v += __shfl_xor(v, o);
    return v;
}
__device__ __forceinline__ float siluf(float v) { return v / (1.f + __expf(-v)); }
__device__ __forceinline__ int mod_row(int tok) { return tok < NLAT ? (tok >> 11) : 16; }

struct P { const float* in[29]; float* out; unsigned char* ws; int ph_lo, ph_hi; };

__device__ __forceinline__ float* x_row(const P& p, int tok) {
    return tok < NLAT ? p.out + (size_t)tok * D : (float*)(p.ws + WS_XC) + (size_t)(tok - NLAT) * D;
}
__device__ __forceinline__ const float* x_in_row(const P& p, int tok) {
    return tok < NLAT ? p.in[0] + (size_t)tok * D : p.in[2] + (size_t)(tok - NLAT) * D;
}

template <int MF, class RowSrc, class Epi>
__device__ __forceinline__ void gemm_tile(unsigned char* lds, const RowSrc& rs, const bf16_t* Bt, int ldb, int K, const Epi& epi) {
    constexpr int ROWS = 32 * MF, NPA = ROWS * 8;
    const int tid = threadIdx.x, lane = tid & 63, wid = tid >> 6, wr = wid >> 2, wc = wid & 3, fr = lane & 15, fq = lane >> 4;
    bf16_t* As = (bf16_t*)lds; bf16_t* Bs = As + ROWS * 72;
    const bf16_t* ap[3]; int al[3];
#pragma unroll
    for (int i = 0; i < 3; ++i) { const int id = tid + 512 * i, r = id >> 3, c = (id & 7) * 8; ap[i] = (id < NPA) ? rs(r) + c : nullptr; al[i] = r * 72 + c; }
    const int lr = tid >> 2, lc = (tid & 3) * 16;
    const bf16_t* bp = Bt + (size_t)lr * ldb + lc;
    u32x4 a[3], b0 = *(const u32x4*)bp, b1 = *(const u32x4*)(bp + 8);
#pragma unroll
    for (int i = 0; i < 3; ++i) if (ap[i]) a[i] = *(const u32x4*)ap[i];
    f32x4 acc[MF][2];
#pragma unroll
    for (int m = 0; m < MF; ++m)
#pragma unroll
        for (int n = 0; n < 2; ++n) acc[m][n] = (f32x4){0.f, 0.f, 0.f, 0.f};
    for (int k0 = 0; k0 < K; k0 += 64) {
        __syncthreads();
#pragma unroll
        for (int i = 0; i < 3; ++i) if (ap[i]) *(u32x4*)(As + al[i]) = a[i];
        *(u32x4*)(Bs + lr * 72 + lc) = b0; *(u32x4*)(Bs + lr * 72 + lc + 8) = b1;
        __syncthreads();
        if (k0 + 64 < K) {
#pragma unroll
            for (int i = 0; i < 3; ++i) if (ap[i]) { ap[i] += 64; a[i] = *(const u32x4*)ap[i]; }
            bp += 64; b0 = *(const u32x4*)bp; b1 = *(const u32x4*)(bp + 8);
        }
#pragma unroll
        for (int kk = 0; kk < 2; ++kk) {
            bf16x8 af[MF], bfr[2];
#pragma unroll
            for (int m = 0; m < MF; ++m) af[m] = *(const bf16x8*)(As + (wr * 16 * MF + m * 16 + fr) * 72 + kk * 32 + fq * 8);
#pragma unroll
            for (int n = 0; n < 2; ++n) bfr[n] = *(const bf16x8*)(Bs + (wc * 32 + n * 16 + fr) * 72 + kk * 32 + fq * 8);
#pragma unroll
            for (int m = 0; m < MF; ++m)
#pragma unroll
                for (int n = 0; n < 2; ++n) acc[m][n] = __builtin_amdgcn_mfma_f32_16x16x32_bf16(bfr[n], af[m], acc[m][n], 0, 0, 0);
        }
    }
#pragma unroll
    for (int m = 0; m < MF; ++m)
#pragma unroll
        for (int n = 0; n < 2; ++n) epi(wr * 16 * MF + m * 16 + fr, wc * 32 + n * 16 + 4 * fq, acc[m][n]);
}

namespace ge {
constexpr int BM = 256, BK = 64, HALF = 128, HTB = HALF * BK * 2;
__device__ __forceinline__ int lds_byte(int r, int c) { const int st = (r >> 4) * 2 + (c >> 5), rr = r & 15, cc = c & 31, ob = rr * 64 + cc * 2; return st * 1024 + (ob ^ (((ob >> 9) & 1) << 5)); }
__device__ __forceinline__ void stage_rc(int b, int& R, int& C) { const int st = b / 1024, sb = b % 1024, swz = sb ^ (((sb >> 9) & 1) << 5); R = (st >> 1) * 16 + swz / 64; C = (st & 1) * 32 + (swz % 64) / 2; }
struct Unit { const char* B; int a, b, c, d; };
typedef f32x4 Acc[2][2][4][2];

template <class Sched, class Epi, bool ALIGN_EPI>
__device__ __forceinline__ void gemm_stream(LAS unsigned char* lds, const char* Ab, int K, const Sched& S, const Epi& E) {
    const int tid = threadIdx.x, wid = __builtin_amdgcn_readfirstlane(tid >> 6), lane = tid & 63, wr = wid >> 2, wc = wid & 3, fr = lane & 15, fq = lane >> 4;
    const int nt = K / BK;
    int Rr[2], Cc[2]; unsigned voffB[2];
#pragma unroll
    for (int i = 0; i < 2; ++i) { stage_rc(tid * 16 + i * 8192, Rr[i], Cc[i]);
        const int rho = Rr[i] & 31, Rb = (Rr[i] & ~31) + 8 * ((rho & 15) >> 2) + 4 * (rho >> 4) + (rho & 3);
        voffB[i] = (unsigned)(Rb * K + Cc[i]) * 2u; }
    const size_t kstep = (size_t)(BK * 2), hstepB = (size_t)HALF * K * 2;
    const unsigned ldsw = (unsigned)wid * 1024u;
    const int aoff = lds_byte(wr * 64 + fr, fq * 8), boff = lds_byte(wc * 32 + fr, fq * 8);
#define GE_SA(b, h) (((b) * 2 + (h)) * HTB)
#define GE_SB(b, h) ((4 + (b) * 2 + (h)) * HTB)
#define GE_GLDS(gp, ldsoff) __builtin_amdgcn_global_load_lds((const unsigned*)(gp), (LAS unsigned*)(lds + (ldsoff)), 16, 0, 0)
#define GE_STAGE_B(bufoff, gbase) do { GE_GLDS((const char*)(gbase) + voffB[0], (bufoff) + ldsw); GE_GLDS((const char*)(gbase) + voffB[1], (bufoff) + ldsw + 8192); } while (0)
#define GE_STAGE_A(bufoff, kbytes, o0, o1) do { GE_GLDS(Ab + (kbytes) + (o0), (bufoff) + ldsw); GE_GLDS(Ab + (kbytes) + (o1), (bufoff) + ldsw + 8192); } while (0)
#define GE_LDA(dst, b, h) do { _Pragma("unroll") for (int m = 0; m < 4; ++m) _Pragma("unroll") for (int k = 0; k < 2; ++k) dst[m][k] = *(const LAS bf16x8*)(lds + GE_SA(b, h) + aoff + m * 2048 + k * 1024); } while (0)
#define GE_LDB(dst, b, h) do { _Pragma("unroll") for (int n = 0; n < 2; ++n) _Pragma("unroll") for (int k = 0; k < 2; ++k) dst[n][k] = *(const LAS bf16x8*)(lds + GE_SB(b, h) + boff + n * 2048 + k * 1024); } while (0)
#define GE_MMA(ai, bj, At, Bt) do { __builtin_amdgcn_s_setprio(1); _Pragma("unroll") for (int m = 0; m < 4; ++m) _Pragma("unroll") for (int n = 0; n < 2; ++n) _Pragma("unroll") for (int k = 0; k < 2; ++k) \
        acc[ai][bj][m][n] = __builtin_amdgcn_mfma_f32_16x16x32_bf16(Bt[n][k], At[m][k], acc[ai][bj][m][n], 0, 0, 0); __builtin_amdgcn_s_setprio(0); } while (0)
#define GE_WAIT_V(n) asm volatile("s_waitcnt vmcnt(" #n ")" ::: "memory")
#define GE_WAIT_L(n) asm volatile("s_waitcnt lgkmcnt(" #n ")" ::: "memory")
#define GE_BAR __builtin_amdgcn_s_barrier()
#define GE_SCHED __builtin_amdgcn_sched_barrier(0)
    Unit cur, nxt; int ui = 0;
    if (!S.next(0, cur)) return;
    Acc acc;
#pragma unroll
    for (int a = 0; a < 2; ++a)
#pragma unroll
        for (int b = 0; b < 2; ++b)
#pragma unroll
            for (int m = 0; m < 4; ++m)
#pragma unroll
                for (int n = 0; n < 2; ++n) acc[a][b][m][n] = (f32x4){0.f, 0.f, 0.f, 0.f};
    bf16x8 At[4][2], B0[2][2], B1[2][2];
    unsigned oc00, oc01, oc10, oc11, on00, on01, on10, on11;
    oc00 = S.aoff(0, cur, Rr[0]) + (unsigned)Cc[0] * 2u; oc01 = S.aoff(0, cur, Rr[1]) + (unsigned)Cc[1] * 2u;
    oc10 = S.aoff(0, cur, Rr[0] + 128) + (unsigned)Cc[0] * 2u; oc11 = S.aoff(0, cur, Rr[1] + 128) + (unsigned)Cc[1] * 2u;
    const char* cB = cur.B;
    GE_STAGE_B(GE_SB(0, 0), cB); GE_STAGE_B(GE_SB(0, 1), cB + hstepB); GE_STAGE_A(GE_SA(0, 0), 0, oc00, oc01); GE_STAGE_A(GE_SA(0, 1), 0, oc10, oc11);
    if (wr == 1) GE_BAR;
    GE_WAIT_V(2); GE_BAR;
    GE_STAGE_B(GE_SB(1, 0), cB + kstep); GE_STAGE_A(GE_SA(1, 0), kstep, oc00, oc01); GE_STAGE_B(GE_SB(1, 1), cB + hstepB + kstep);
    GE_WAIT_V(6); GE_BAR;
    for (;;) {
        const bool has_next = S.next(ui + 1, nxt);
        const char* nB = has_next ? nxt.B : cB;
        if (has_next) {
            on00 = S.aoff(ui + 1, nxt, Rr[0]) + (unsigned)Cc[0] * 2u; on01 = S.aoff(ui + 1, nxt, Rr[1]) + (unsigned)Cc[1] * 2u;
            on10 = S.aoff(ui + 1, nxt, Rr[0] + 128) + (unsigned)Cc[0] * 2u; on11 = S.aoff(ui + 1, nxt, Rr[1] + 128) + (unsigned)Cc[1] * 2u;
        } else { on00 = oc00; on01 = oc01; on10 = oc10; on11 = oc11; }
#pragma unroll 1
        for (int t = 0; t < nt; t += 2) {
            const bool last = (t == nt - 2);
            const size_t k1 = (size_t)(t + 1) * kstep;
            const size_t k2 = last ? 0 : (size_t)(t + 2) * kstep, k3 = k2 + kstep;
            const char* b2 = last ? nB : cB + (size_t)(t + 2) * kstep; const char* b3 = b2 + kstep;
            const unsigned o00 = last ? on00 : oc00, o01 = last ? on01 : oc01, o10 = last ? on10 : oc10, o11 = last ? on11 : oc11;
            GE_LDB(B0, 0, 0); GE_LDB(B1, 0, 1); GE_SCHED; GE_LDA(At, 0, 0); GE_STAGE_A(GE_SA(1, 1), k1, oc10, oc11);
            GE_WAIT_V(8); GE_WAIT_L(0); GE_BAR; GE_MMA(0, 0, At, B0); GE_MMA(0, 1, At, B1); GE_BAR; GE_SCHED;
            GE_LDA(At, 0, 1); GE_STAGE_B(GE_SB(0, 0), b2); GE_STAGE_B(GE_SB(0, 1), b2 + hstepB); GE_STAGE_A(GE_SA(0, 0), k2, o00, o01);
            GE_WAIT_V(8); GE_WAIT_L(0); GE_BAR; GE_MMA(1, 0, At, B0); GE_MMA(1, 1, At, B1); GE_BAR; GE_SCHED;
            GE_LDB(B0, 1, 0); GE_LDB(B1, 1, 1); GE_SCHED; GE_LDA(At, 1, 0); GE_STAGE_A(GE_SA(0, 1), k2, o10, o11);
            GE_WAIT_V(8); GE_WAIT_L(0); GE_BAR; GE_MMA(0, 0, At, B0); GE_MMA(0, 1, At, B1); GE_BAR; GE_SCHED;
            GE_LDA(At, 1, 1); GE_STAGE_B(GE_SB(1, 0), b3); GE_STAGE_B(GE_SB(1, 1), b3 + hstepB); GE_STAGE_A(GE_SA(1, 0), k3, o00, o01);
            GE_WAIT_V(8); GE_WAIT_L(0); GE_BAR; GE_MMA(1, 0, At, B0); GE_MMA(1, 1, At, B1); GE_BAR; GE_SCHED;
        }
        if constexpr (ALIGN_EPI) { if (wr == 0) GE_BAR; }
        E(acc, cur, wr, wc, fr, fq);
        if (!has_next) break;
#pragma unroll
        for (int a = 0; a < 2; ++a)
#pragma unroll
            for (int b = 0; b < 2; ++b)
#pragma unroll
                for (int m = 0; m < 4; ++m)
#pragma unroll
                    for (int n = 0; n < 2; ++n) acc[a][b][m][n] = (f32x4){0.f, 0.f, 0.f, 0.f};
        cur = nxt; cB = nB; ++ui; oc00 = on00; oc01 = on01; oc10 = on10; oc11 = on11;
        if constexpr (ALIGN_EPI) { if (wr == 1) GE_BAR; }
    }
    GE_WAIT_V(0);
    if constexpr (!ALIGN_EPI) { if (wr == 0) GE_BAR; }
    GE_BAR;
#undef GE_SA
#undef GE_SB
#undef GE_GLDS
#undef GE_STAGE_A
#undef GE_STAGE_B
#undef GE_LDA
#undef GE_LDB
#undef GE_MMA
#undef GE_WAIT_V
#undef GE_WAIT_L
#undef GE_BAR
#undef GE_SCHED
}
template <class F> struct EpiFn {
    F f;
    __device__ __forceinline__ void operator()(const Acc& acc, const Unit& u, int wr, int wc, int fr, int fq) const {
#pragma unroll
        for (int ai = 0; ai < 2; ++ai)
#pragma unroll
            for (int m = 0; m < 4; ++m)
#pragma unroll
                for (int bj = 0; bj < 2; ++bj) f(u, ai * 128 + wr * 64 + m * 16 + fr, bj * 128 + wc * 32 + 8 * fq, acc[ai][bj][m][0], acc[ai][bj][m][1]);
    }
};
struct DenseOrder {
    int nM, nN, nwg, G, c; const char* Bt; size_t btile; unsigned arow;
    __device__ __forceinline__ bool next(int i, Unit& u) const {
        const long L = (long)i * G + c; if (L >= nwg) return false;
        int wgid = (int)L; { const int q = nwg / 8, r = nwg % 8, xcd = wgid % 8, off = wgid / 8; wgid = (xcd < r ? xcd * (q + 1) : r * (q + 1) + (xcd - r) * q) + off; }
        const int nig = 8 * nN, gid = wgid / nig, fm = gid * 8, gsz = (nM - fm) < 8 ? (nM - fm) : 8;
        u.a = fm + ((wgid % nig) % gsz); u.b = (wgid % nig) / gsz; u.c = 0; u.d = 0; u.B = Bt + (size_t)u.b * btile; return true;
    }
    __device__ __forceinline__ unsigned aoff(int, const Unit& u, int R) const { return (unsigned)(u.a * 256 + R) * arow; }
};
}

struct TMap { const float* s0; const float* s1; int ld; int nvalid; const float* ksc; float gsc; };
template <int MODE> __device__ __forceinline__ const float* tmap_src(const float* s0, const float* s1, int nvalid, int n) {
    if (MODE == 0) return n < nvalid ? s0 + n : nullptr;
    if (MODE == 1) { const int h = n / 96, j = n % 96; const int c = j < 64 ? j : 64 + ((j - 64) & 1) * 16 + ((j - 64) >> 1); return s0 + h * 96 + c; }
    return ((n & 1) ? s1 : s0) + (n >> 1);
}
template <int MODE> __device__ __forceinline__ void transpose_unit(float* scr, const float* s0, const float* s1, int ld, int nvalid, const float* ksc, float gsc, int K, bf16_t* dst, int kb, int nb, int kvalid = 1 << 30) {
    const int tid = threadIdx.x, k0 = kb * 64, n0 = nb * 64;
    const int nn = tid & 63; const float* sp = tmap_src<MODE>(s0, s1, nvalid, n0 + nn);
#pragma unroll
    for (int i = 0; i < 8; ++i) {
        const int kk = (tid >> 6) + 8 * i; float v = (sp && k0 + kk < kvalid) ? sp[(size_t)(k0 + kk) * ld] : 0.f;
        if (ksc && k0 + kk < kvalid) v *= ksc[k0 + kk];
        scr[kk * 65 + nn] = v * gsc;
    }
    __syncthreads();
    {
        const int n2 = tid >> 3, kc = tid & 7; const float* s = scr + (kc * 8) * 65 + n2;
        u32x4 o; o.x = pk2(s[0], s[65]); o.y = pk2(s[2 * 65], s[3 * 65]); o.z = pk2(s[4 * 65], s[5 * 65]); o.w = pk2(s[6 * 65], s[7 * 65]);
        *(u32x4*)(dst + (size_t)(n0 + n2) * K + k0 + kc * 8) = o;
    }
    __syncthreads();
}
template <int MODE> __device__ __forceinline__ void transpose_matrix(float* scr, const float* s0, const float* s1, int ld, int nvalid, const float* ksc, float gsc, int K, int Nd, bf16_t* dst, int& rot, int kvalid = 1 << 30) {
    const int nkb = K / 64, nnb = Nd / 64, nu = nkb * nnb, G = gridDim.x;
    int first = ((int)blockIdx.x - rot) % G; if (first < 0) first += G;
    for (int u = first; u < nu; u += G) transpose_unit<MODE>(scr, s0, s1, ld, nvalid, ksc, gsc, K, dst, u / nnb, u % nnb, kvalid);
    rot = (rot + nu) % G;
}
__device__ __forceinline__ void convert_expert_weights(unsigned char* lds, const P& p, int L) {
    float* scr = (float*)lds; const int G = gridDim.x, tid = threadIdx.x;
    constexpr int S = 261;
    bf16_t* egu = (bf16_t*)(p.ws + WS_EGU); bf16_t* ed = (bf16_t*)(p.ws + WS_ED);
    for (int ub = blockIdx.x; ub < NEXP * 48; ub += G) {
        const int e = ub / 48, r = (ub % 48) * 4;
        bf16_t* dst; int K, k0;
        if (r < 128) {
            const int kb = r >> 3, nb0 = r & 7; k0 = kb * 64; K = D; dst = egu + ((size_t)e * 512 + nb0 * 64) * D;
            const float* gsrc = p.in[22] + ((size_t)L * NEXP + e) * D * EDIM + nb0 * 32; const float* usrc = p.in[23] + ((size_t)L * NEXP + e) * D * EDIM + nb0 * 32;
            f32x4 v[8];
#pragma unroll
            for (int i = 0; i < 8; ++i) { const int idx = tid + 512 * i, kk = idx >> 6, c = idx & 63; v[i] = *(const f32x4*)((c < 32 ? gsrc : usrc) + (size_t)(k0 + kk) * EDIM + (c & 31) * 4); }
#pragma unroll
            for (int i = 0; i < 8; ++i) { const int idx = tid + 512 * i, kk = idx >> 6, c = idx & 63; float* d = scr + kk * S + 8 * (c & 31) + (c >> 5);
                d[0] = v[i].x; d[2] = v[i].y; d[4] = v[i].z; d[6] = v[i].w; }
        } else {
            const int r2 = r - 128, kb = r2 >> 4, nb0 = r2 & 15; k0 = kb * 64; K = EDIM; dst = ed + ((size_t)e * D + nb0 * 64) * EDIM;
            const float* src = p.in[24] + ((size_t)L * NEXP + e) * EDIM * D + nb0 * 64;
            f32x4 v[8];
#pragma unroll
            for (int i = 0; i < 8; ++i) { const int idx = tid + 512 * i, kk = idx >> 6, c = idx & 63; v[i] = *(const f32x4*)(src + (size_t)(k0 + kk) * D + c * 4); }
#pragma unroll
            for (int i = 0; i < 8; ++i) { const int idx = tid + 512 * i, kk = idx >> 6, c = idx & 63; float* d = scr + kk * S + 4 * c;
                d[0] = v[i].x; d[1] = v[i].y; d[2] = v[i].z; d[3] = v[i].w; }
        }
        __syncthreads();
#pragma unroll
        for (int i = 0; i < 4; ++i) {
            const int id = tid + 512 * i, n = id >> 3, kc = id & 7; const float* sp = scr + (kc * 8) * S + n;
            u32x4 o; o.x = cvtpk(sp[0], sp[S]); o.y = cvtpk(sp[2 * S], sp[3 * S]); o.z = cvtpk(sp[4 * S], sp[5 * S]); o.w = cvtpk(sp[6 * S], sp[7 * S]);
            *(u32x4*)(dst + (size_t)n * K + k0 + kc * 8) = o;
        }
        __syncthreads();
    }
}
__device__ __forceinline__ void prep_mod_unit(unsigned char* lds, const P& p, int u) {
    float* sc = (float*)lds;
    float* part = sc + 17 * 1024;
    const int tid = threadIdx.x;
    const float* c = p.in[1]; const float* cctx = p.in[3];
    for (int i = tid; i < 17 * 1024; i += NTHREADS) { const int r = i >> 10, k = i & 1023; const float v = r < 16 ? c[r * 1024 + k] : cctx[k]; sc[i] = v / (1.f + expf(-v)); }
    __syncthreads();
    const int L = u / 192, cg = u % 192, ks = tid >> 5, cl = tid & 31, col = cg * 32 + cl;
    const float* w = p.in[4] + (size_t)L * 1024 * 6144 + (size_t)(ks * 64) * 6144 + col;
    float acc[17];
#pragma unroll
    for (int r = 0; r < 17; ++r) acc[r] = 0.f;
#pragma unroll 8
    for (int k = 0; k < 64; ++k) {
        const float wv = w[(size_t)k * 6144];
#pragma unroll
        for (int r = 0; r < 17; ++r) acc[r] += sc[r * 1024 + ks * 64 + k] * wv;
    }
#pragma unroll
    for (int r = 0; r < 17; ++r) part[(ks * 17 + r) * 32 + cl] = acc[r];
    __syncthreads();
    float* modv = (float*)(p.ws + WS_MODV);
    for (int i = tid; i < 17 * 32; i += NTHREADS) {
        const int r = i >> 5, c2 = i & 31;
        float s2 = p.in[5][L * 6144 + cg * 32 + c2];
#pragma unroll
        for (int q = 0; q < 16; ++q) s2 += part[(q * 17 + r) * 32 + c2];
        modv[((size_t)L * 17 + r) * 6144 + cg * 32 + c2] = s2;
    }
    __syncthreads();
}
__device__ __forceinline__ void phase_prep(unsigned char* lds, const P& p) {
    const int tid = threadIdx.x, G = gridDim.x, bid = blockIdx.x;
    {
        float* ct = (float*)(p.ws + WS_ROPE); float* st = ct + 2048 * 16;
        for (int i = bid * NTHREADS + tid; i < 2048 * 16; i += G * NTHREADS) {
            const int pos = i >> 4, f = i & 15;
            const float inv = powf(10000.f, -(float)(f & 7) / 8.f);
            const float ang = (float)(f < 8 ? (pos >> 6) : (pos & 63)) * inv;
            ct[i] = cosf(ang); st[i] = sinf(ang);
        }
    }
    for (int u = G - 1 - bid; u < 384; u += G) prep_mod_unit(lds, p, u);
    float* scr = (float*)lds; int rot = 0;
    for (int L = 0; L < 2; ++L) {
        transpose_matrix<0>(scr, p.in[7] + (size_t)L * D * Z_END, nullptr, Z_END, Z_END, nullptr, 1.f, D, ZC, (bf16_t*)(p.ws + WS_WIN) + (size_t)L * ZC * D, rot);
        transpose_matrix<1>(scr, p.in[15] + (size_t)L * 256 * 768, nullptr, 768, 768, p.in[14] + L * 256, 0.14724574f, 256, 768, (bf16_t*)(p.ws + WS_WUQ) + (size_t)L * 768 * 256, rot);
        transpose_matrix<0>(scr, p.in[17] + (size_t)L * 128 * 1024, nullptr, 1024, 1024, p.in[16] + L * 128, 1.f, 256, 1024, (bf16_t*)(p.ws + WS_WUKV) + (size_t)L * 1024 * 256, rot, 128);
        transpose_matrix<0>(scr, p.in[18] + (size_t)L * D * D, nullptr, D, D, nullptr, 1.f, D, D, (bf16_t*)(p.ws + WS_WOUT) + (size_t)L * D * D, rot);
        transpose_matrix<0>(scr, p.in[20] + (size_t)L * D * NEXP, nullptr, NEXP, NEXP, nullptr, 1.f, D, 128, (bf16_t*)(p.ws + WS_RT) + (size_t)L * 128 * D, rot);
        transpose_matrix<2>(scr, p.in[25] + (size_t)L * D * EDIM, p.in[26] + (size_t)L * D * EDIM, EDIM, 512, nullptr, 1.f, D, 512, (bf16_t*)(p.ws + WS_SHGU) + (size_t)L * 512 * D, rot);
        transpose_matrix<0>(scr, p.in[27] + (size_t)L * EDIM * D, nullptr, D, D, nullptr, 1.f, EDIM, D, (bf16_t*)(p.ws + WS_SHD) + (size_t)L * D * EDIM, rot);
    }
}

__device__ __forceinline__ void phase_norm_mod(const P& p, int L, int which  , int ntok) {
    const int tid = threadIdx.x, lane = tid & 63, wave = tid >> 6, gw = blockIdx.x * NWAVES + wave, NGW = gridDim.x * NWAVES;
    const float* nw = (which == 0 ? p.in[6] : p.in[19]) + L * D;
    const float* modv = (const float*)(p.ws + WS_MODV) + (size_t)L * 17 * 6144;
    bf16_t* H = (bf16_t*)(p.ws + WS_H);
    for (int tok = gw; tok < ntok; tok += NGW) {
        const f32x4* xr = (const f32x4*)x_in_row(p, tok) + lane;
        const float* mrow = modv + (size_t)mod_row(tok) * 6144 + which * 3072;
        f32x4 v[4]; float s = 0.f;
#pragma unroll
        for (int j = 0; j < 4; ++j) { v[j] = xr[64 * j]; s += v[j].x * v[j].x + v[j].y * v[j].y + v[j].z * v[j].z + v[j].w * v[j].w; }
        const float rstd = rsqrtf(wave_sum(s) * (1.f / D) + NORM_EPS);
        u32x2* o = (u32x2*)(H + (size_t)tok * D) + lane;
#pragma unroll
        for (int j = 0; j < 4; ++j) {
            const int k = 4 * lane + 256 * j;
            const f32x4 w4 = *(const f32x4*)(nw + k), sh = *(const f32x4*)(mrow + k), sc = *(const f32x4*)(mrow + 1024 + k);
            const float y0 = v[j].x * rstd * w4.x * (1.f + sc.x) + sh.x, y1 = v[j].y * rstd * w4.y * (1.f + sc.y) + sh.y;
            const float y2 = v[j].z * rstd * w4.z * (1.f + sc.z) + sh.z, y3 = v[j].w * rstd * w4.w * (1.f + sc.w) + sh.w;
            u32x2 w; w.x = pk2(y0, y1); w.y = pk2(y2, y3); o[64 * j] = w;
        }
    }
}

struct EpiZ {
    bf16_t* Z; float* ssq; float* sskv; bf16_t* Kb; const float* ct; const float* st;
    __device__ __forceinline__ void operator()(const ge::Acc& acc, const ge::Unit& u, int wr, int wc, int fr, int fq) const {
#pragma unroll
        for (int ai = 0; ai < 2; ++ai)
#pragma unroll
            for (int m = 0; m < 4; ++m) {
                const int row = u.a * 256 + ai * 128 + wr * 64 + m * 16 + fr;
#pragma unroll
                for (int bj = 0; bj < 2; ++bj) {
                    const f32x4 v0 = acc[ai][bj][m][0], v1 = acc[ai][bj][m][1];
                    u32x4 w; w.x = cvtpk(v0.x, v0.y); w.y = cvtpk(v0.z, v0.w); w.z = cvtpk(v1.x, v1.y); w.w = cvtpk(v1.z, v1.w);
                    *(u32x4*)(Z + (size_t)row * ZC + u.b * 256 + bj * 128 + wc * 32 + 8 * fq) = w;
                }
                if (u.b == 5) {
                    float sq = 0.f;
#pragma unroll
                    for (int bj = 0; bj < 2; ++bj)
#pragma unroll
                        for (int n = 0; n < 2; ++n) { const f32x4 v = acc[ai][bj][m][n]; sq += v.x * v.x + v.y * v.y + v.z * v.z + v.w * v.w; }
                    sq += __shfl_xor(sq, 16); sq += __shfl_xor(sq, 32);
                    if (fq == 0) ssq[(size_t)row * 4 + wc] = sq;
                }
                if (u.b == 6) {
                    float sq = 0.f;
#pragma unroll
                    for (int n = 0; n < 2; ++n) { const f32x4 v = acc[ai][0][m][n]; sq += v.x * v.x + v.y * v.y + v.z * v.z + v.w * v.w; }
                    sq += __shfl_xor(sq, 16); sq += __shfl_xor(sq, 32);
                    if (fq == 0) sskv[(size_t)row * 4 + wc] = sq;
                    if (wc == 0) {
                        const f32x4 a0 = acc[ai][1][m][0], a1 = acc[ai][1][m][1];
                        f32x4 b0, b1;
#pragma unroll
                        for (int j = 0; j < 4; ++j) { b0[j] = __shfl_xor(a0[j], 32); b1[j] = __shfl_xor(a1[j], 32); }
                        if (fq < 2) {
                            f32x4 c0 = (f32x4){1.f, 1.f, 1.f, 1.f}, c1 = c0, s0 = (f32x4){0.f, 0.f, 0.f, 0.f}, s1 = s0;
                            if (row < NLAT) { const int pos = row & (SEQ - 1); c0 = *(const f32x4*)(ct + pos * 16 + 8 * fq); c1 = *(const f32x4*)(ct + pos * 16 + 8 * fq + 4); s0 = *(const f32x4*)(st + pos * 16 + 8 * fq); s1 = *(const f32x4*)(st + pos * 16 + 8 * fq + 4); }
                            const f32x4 o10 = a0 * c0 - b0 * s0, o20 = a0 * s0 + b0 * c0, o11 = a1 * c1 - b1 * s1, o21 = a1 * s1 + b1 * c1;
                            u32x4 w0, w1; w0.x = cvtpk(o10.x, o20.x); w0.y = cvtpk(o10.y, o20.y); w0.z = cvtpk(o10.z, o20.z); w0.w = cvtpk(o10.w, o20.w);
                            w1.x = cvtpk(o11.x, o21.x); w1.y = cvtpk(o11.y, o21.y); w1.z = cvtpk(o11.z, o21.z); w1.w = cvtpk(o11.w, o21.w);
#pragma unroll
                            for (int h = 0; h < 8; ++h) { bf16_t* kp = Kb + (size_t)row * 768 + h * 96 + 64 + 16 * fq; *(u32x4*)kp = w0; *(u32x4*)(kp + 8) = w1; }
                        }
                    }
                }
            }
    }
};
__device__ __forceinline__ void phase_zgemm(unsigned char* lds, const P& p, int L) {
    const bf16_t* W = (const bf16_t*)(p.ws + WS_WIN) + (size_t)L * ZC * D;
    ge::DenseOrder S; S.nM = NTOK / 256; S.nN = ZC / 256; S.nwg = S.nM * S.nN; S.G = gridDim.x; S.c = blockIdx.x; S.Bt = (const char*)W; S.btile = (size_t)256 * D * 2; S.arow = D * 2;
    EpiZ E{(bf16_t*)(p.ws + WS_Z), (float*)(p.ws + WS_SS), (float*)(p.ws + WS_SS) + (size_t)NTOK * 4, (bf16_t*)(p.ws + WS_K), (const float*)(p.ws + WS_ROPE), (const float*)(p.ws + WS_ROPE) + 2048 * 16};
    ge::gemm_stream<ge::DenseOrder, EpiZ, true>((LAS unsigned char*)lds, (const char*)(p.ws + (L == 0 ? WS_H : WS_H1)), D, S, E);
}

__device__ __forceinline__ void conv_unit(unsigned char* lds, const P& p, int L, int s, int tt) {
    float* hg = (float*)lds;
    const int tid = threadIdx.x, lane = tid & 63, wave = tid >> 6;
    const int rb = s < 16 ? s * SEQ : NLAT + (s - 16) * CTXL, len = s < 16 ? SEQ : CTXL, t0 = tt * 64;
    const bf16_t* Z = (const bf16_t*)(p.ws + WS_Z);
    for (int i = tid; i < 94 * 64; i += NTHREADS) {
        const int jj = i >> 6, c4 = (i & 63) * 4, t = t0 - 15 + jj;
        f32x4 h = (f32x4){0.f, 0.f, 0.f, 0.f};
        if (t >= 0 && t < len) {
            const bf16_t* zr = Z + (size_t)(rb + t) * ZC;
            const u32x2 a = *(const u32x2*)(zr + c4), g = *(const u32x2*)(zr + 256 + c4);
            const float g0 = lo16(g.x), g1 = hi16(g.x), g2 = lo16(g.y), g3 = hi16(g.y);
            h.x = lo16(a.x) / (1.f + __expf(-g0)); h.y = hi16(a.x) / (1.f + __expf(-g1));
            h.z = lo16(a.y) / (1.f + __expf(-g2)); h.w = hi16(a.y) / (1.f + __expf(-g3));
        }
        *(f32x4*)(hg + jj * 256 + c4) = h;
    }
    float* wl = hg + 94 * 256;
    for (int i = tid; i < 31 * 64; i += NTHREADS) *(f32x4*)(wl + i * 4) = *(const f32x4*)(p.in[8] + (size_t)L * 31 * 256 + i * 4);
    __syncthreads();
    const int c0 = lane * 4;
    const f32x4 cb = *(const f32x4*)(p.in[9] + L * 256 + c0), lw = *(const f32x4*)(p.in[10] + L * 256 + c0), lb = *(const f32x4*)(p.in[11] + L * 256 + c0);
    bf16_t* CC = (bf16_t*)(p.ws + WS_CC);
    for (int q = 0; q < 8; ++q) {
        const int tl = wave * 8 + q;
        f32x4 acc = cb;
#pragma unroll 4
        for (int j = 0; j < 31; ++j) { const f32x4 h = *(const f32x4*)(hg + (tl + j) * 256 + c0); acc += h * *(const f32x4*)(wl + j * 256 + c0); }
        const float mean = wave_sum(acc.x + acc.y + acc.z + acc.w) * (1.f / 256.f);
        const f32x4 d = acc - mean;
        const float var = wave_sum(d.x * d.x + d.y * d.y + d.z * d.z + d.w * d.w) * (1.f / 256.f);
        const float rstd = rsqrtf(var + NORM_EPS);
        const f32x4 y = d * rstd * lw + lb;
        u32x2 o; o.x = pk2(siluf(y.x), siluf(y.y)); o.y = pk2(siluf(y.z), siluf(y.w));
        *(u32x2*)(CC + (size_t)(rb + t0 + tl) * D + c0) = o;
    }
    __syncthreads();
}

__device__ __forceinline__ float log2_gamma(const P& p, int L, int dir, int h) {
    const float x = p.in[12][(L * 2 + dir) * 4 + h];
    const float ls = fminf(x, 0.f) - log1pf(expf(-fabsf(x)));
    return ls * 1.4426950408889634f;
}
__device__ __forceinline__ void load_ret_qk(float* dst, const P& p, int gc, int h, int zoff, float scale) {
    const int tid = threadIdx.x, j = tid >> 2, i0 = (tid & 3) * 4, row = gc * 128 + j;
    const bf16_t* zr = (const bf16_t*)(p.ws + WS_Z) + (size_t)row * ZC + zoff + h * 32;
    const u32x2 a = *(const u32x2*)(zr + i0), b = *(const u32x2*)(zr + 16 + i0);
    float x1[4] = {lo16(a.x), hi16(a.x), lo16(a.y), hi16(a.y)}, x2[4] = {lo16(b.x), hi16(b.x), lo16(b.y), hi16(b.y)};
    const bool lat = row < NLAT; const int pos = row & (SEQ - 1);
    const float* ct = (const float*)(p.ws + WS_ROPE) + pos * 16 + i0; const float* st = ct + 2048 * 16;
#pragma unroll
    for (int i = 0; i < 4; ++i) {
        const float c = lat ? ct[i] : 1.f, s = lat ? st[i] : 0.f;
        dst[j * 33 + i0 + i] = (x1[i] * c - x2[i] * s) * scale;
        dst[j * 33 + 16 + i0 + i] = (x1[i] * s + x2[i] * c) * scale;
    }
}
__device__ __forceinline__ void load_ret_v(float* dst  , const P& p, int gc, int h) {
    const int tid = threadIdx.x, j = tid >> 2, e0 = (tid & 3) * 16;
    const bf16_t* zr = (const bf16_t*)(p.ws + WS_Z) + (size_t)(gc * 128 + j) * ZC + Z_RV + h * 64 + e0;
    const u32x4 a = *(const u32x4*)zr, b = *(const u32x4*)(zr + 8);
#pragma unroll
    for (int i = 0; i < 4; ++i) { dst[j * 64 + e0 + 2 * i] = lo16(a[i]); dst[j * 64 + e0 + 2 * i + 1] = hi16(a[i]); dst[j * 64 + e0 + 8 + 2 * i] = lo16(b[i]); dst[j * 64 + e0 + 8 + 2 * i + 1] = hi16(b[i]); }
}
__device__ __forceinline__ void retkv_unit(unsigned char* lds, const P& p, int L, int gc, int h) {
    float* ks = (float*)lds; float* vs = ks + 128 * 33; float* wf = vs + 128 * 64; float* wb = wf + 128;
    const int tid = threadIdx.x;
    const float l2f = log2_gamma(p, L, 0, h), l2b = log2_gamma(p, L, 1, h);
    load_ret_qk(ks, p, gc, h, Z_RK, 0.17677669529663687f);
    load_ret_v(vs, p, gc, h);
    if (tid < 128) { wf[tid] = exp2f(l2f * (float)(127 - tid)); wb[tid] = exp2f(l2b * (float)tid); }
    __syncthreads();
    const int d = tid >> 4, e0 = (tid & 15) * 4;
    f32x4 af = (f32x4){0.f, 0.f, 0.f, 0.f}, ab = af;
    for (int j = 0; j < 128; ++j) {
        const float kd = ks[j * 33 + d]; const f32x4 v4 = *(const f32x4*)(vs + j * 64 + e0);
        af += (kd * wf[j]) * v4; ab += (kd * wb[j]) * v4;
    }
    float* KV = (float*)(p.ws + WS_KV) + ((size_t)(gc * 4 + h) * 2) * 2048;
    *(f32x4*)(KV + d * 64 + e0) = af; *(f32x4*)(KV + 2048 + d * 64 + e0) = ab;
    __syncthreads();
}
__device__ __forceinline__ void ret_stage_k(unsigned char* kf, unsigned char* kb, int rowb, const P& p, int gc, int h, float ef, float jf0, float eb, float jb0) {
    const int tid = threadIdx.x, j = tid >> 2, i0 = (tid & 3) * 4, row = gc * 128 + j;
    const bf16_t* zr = (const bf16_t*)(p.ws + WS_Z) + (size_t)row * ZC + Z_RK + h * 32;
    const u32x2 a = *(const u32x2*)(zr + i0), b = *(const u32x2*)(zr + 16 + i0);
    const float x1[4] = {lo16(a.x), hi16(a.x), lo16(a.y), hi16(a.y)}, x2[4] = {lo16(b.x), hi16(b.x), lo16(b.y), hi16(b.y)};
    f32x4 c4 = (f32x4){1.f, 1.f, 1.f, 1.f}, s4 = (f32x4){0.f, 0.f, 0.f, 0.f};
    if (row < NLAT) { const int pos = row & (SEQ - 1); const float* ct = (const float*)(p.ws + WS_ROPE) + pos * 16 + i0; c4 = *(const f32x4*)ct; s4 = *(const f32x4*)(ct + 2048 * 16); }
    const float wf = exp2f(ef * ((float)j - jf0)) * 0.17677669529663687f, wb = exp2f(eb * ((float)j - jb0)) * 0.17677669529663687f;
    float o1[4], o2[4];
#pragma unroll
    for (int i = 0; i < 4; ++i) { o1[i] = x1[i] * c4[i] - x2[i] * s4[i]; o2[i] = x1[i] * s4[i] + x2[i] * c4[i]; }
    u32x2 w;
    w.x = cvtpk(o1[0] * wf, o1[1] * wf); w.y = cvtpk(o1[2] * wf, o1[3] * wf); *(u32x2*)(kf + j * rowb + i0 * 2) = w;
    w.x = cvtpk(o2[0] * wf, o2[1] * wf); w.y = cvtpk(o2[2] * wf, o2[3] * wf); *(u32x2*)(kf + j * rowb + 32 + i0 * 2) = w;
    w.x = cvtpk(o1[0] * wb, o1[1] * wb); w.y = cvtpk(o1[2] * wb, o1[3] * wb); *(u32x2*)(kb + j * rowb + i0 * 2) = w;
    w.x = cvtpk(o2[0] * wb, o2[1] * wb); w.y = cvtpk(o2[2] * wb, o2[3] * wb); *(u32x2*)(kb + j * rowb + 32 + i0 * 2) = w;
}
__device__ __forceinline__ void ret_stage_v(unsigned char* vt, const P& p, int gc, int h) {
    const int tid = threadIdx.x, j = tid >> 2, e0 = (tid & 3) * 16;
    const bf16_t* zr = (const bf16_t*)(p.ws + WS_Z) + (size_t)(gc * 128 + j) * ZC + Z_RV + h * 64 + e0;
    const u32x4 a = *(const u32x4*)zr, b = *(const u32x4*)(zr + 8);
    unsigned char* d = vt + (e0 >> 5) * 8192 + j * 64 + (e0 & 31) * 2;
    *(u32x4*)d = a; *(u32x4*)(d + 16) = b;
}
__device__ __forceinline__ bf16x8 tr8(const unsigned char* p0, const unsigned char* p1) {
    const v4i16_t a = __builtin_amdgcn_ds_read_tr16_b64_v4i16((LAS v4i16_t*)(const LAS unsigned char*)p0), b = __builtin_amdgcn_ds_read_tr16_b64_v4i16((LAS v4i16_t*)(const LAS unsigned char*)p1);
    return (bf16x8){a[0], a[1], a[2], a[3], b[0], b[1], b[2], b[3]};
}
__device__ __forceinline__ void retkv_unit_mfma(unsigned char* lds, const P& p, int L, int gc, int h) {
    const int tid = threadIdx.x, lane = tid & 63, wid = tid >> 6;
    const float l2f = log2_gamma(p, L, 0, h), l2b = log2_gamma(p, L, 1, h);
    ret_stage_k(lds, lds + 8192, 64, p, gc, h, -l2f, 127.f, l2b, 0.f);
    ret_stage_v(lds + 16384, p, gc, h);
    __syncthreads();
    if (wid < 4) {
        const int dir = wid >> 1, eb = wid & 1, g = lane >> 4, i = lane & 15, hh = lane >> 5;
        const int off = (8 * hh + (i >> 2)) * 64 + (g & 1) * 32 + (i & 3) * 8;
        const unsigned char* Kt = lds + dir * 8192 + off; const unsigned char* Vt = lds + 16384 + eb * 8192 + off;
        f32x16 acc;
#pragma unroll
        for (int r = 0; r < 16; ++r) acc[r] = 0.f;
#pragma unroll
        for (int s = 0; s < 8; ++s) acc = __builtin_amdgcn_mfma_f32_32x32x16_bf16(tr8(Vt + s * 1024, Vt + s * 1024 + 256), tr8(Kt + s * 1024, Kt + s * 1024 + 256), acc, 0, 0, 0);
        float* KV = (float*)(p.ws + WS_KV) + ((size_t)(gc * 4 + h) * 2 + dir) * 2048 + (lane & 31) * 64 + eb * 32 + 4 * hh;
#pragma unroll
        for (int r4 = 0; r4 < 4; ++r4) *(f32x4*)(KV + 8 * r4) = (f32x4){acc[4 * r4], acc[4 * r4 + 1], acc[4 * r4 + 2], acc[4 * r4 + 3]};
    }
    __syncthreads();
}
__device__ __forceinline__ void retout_unit_mfma(unsigned char* lds, const P& p, int L, int gc, int h) {
    constexpr int KROW = 80, O_KF = 0, O_KB = 10240, O_V = 20480, O_SF = 36864, O_SB = 41984, O_RED = 47104;
    const int tid = threadIdx.x, lane = tid & 63, wid = tid >> 6, r32 = lane & 31, hh = lane >> 5;
    const float l2f = log2_gamma(p, L, 0, h), l2b = log2_gamma(p, L, 1, h);
    ret_stage_k(lds + O_KF, lds + O_KB, KROW, p, gc, h, -l2f, 0.f, l2b, 0.f);
    ret_stage_v(lds + O_V, p, gc, h);
    {
        const bool lat = gc < 256; const int b = lat ? gc >> 4 : (gc - 256) >> 1;
        const int mme = lat ? 2 + (gc & 15) : (gc - 256) & 1;
        const int u = mme, w = mme < 2 ? 1 - mme : 19 - mme;
        f32x4 sf = (f32x4){0.f, 0.f, 0.f, 0.f}, sb = sf;
        const float* KVb = (const float*)(p.ws + WS_KV);
#pragma unroll 1
        for (int mm = 0; mm < 18; ++mm) {
            const int gcm = mm < 2 ? 256 + b * 2 + mm : b * 16 + (mm - 2);
            const int um = mm, wm = mm < 2 ? 1 - mm : 19 - mm;
            const float* kv = KVb + ((size_t)(gcm * 4 + h) * 2) * 2048 + tid * 4;
            if (um < u) { const float wgt = exp2f(l2f * 128.f * (float)(u - 1 - um)); sf += wgt * *(const f32x4*)kv; }
            if (wm < w) { const float wgt = exp2f(l2b * 128.f * (float)(w - 1 - wm)); sb += wgt * *(const f32x4*)(kv + 2048); }
        }
        const int d = tid >> 4, e0 = (tid & 15) * 4;
#pragma unroll
        for (int k = 0; k < 4; ++k) { *(bf16_t*)(lds + O_SF + (e0 + k) * KROW + d * 2) = (bf16_t)(cvtpk(sf[k], 0.f) & 0xffffu); *(bf16_t*)(lds + O_SB + (e0 + k) * KROW + d * 2) = (bf16_t)(cvtpk(sb[k], 0.f) & 0xffffu); }
    }
    __syncthreads();
    const int qb = wid & 3, eb = wid >> 2, i = qb * 32 + r32, row = gc * 128 + i;
    bf16x8 qf[2];
    {
        const bf16_t* zr = (const bf16_t*)(p.ws + WS_Z) + (size_t)row * ZC + Z_RQ + h * 32 + 8 * hh;
        const u32x4 a = *(const u32x4*)zr, b = *(const u32x4*)(zr + 16);
        float x1[8], x2[8];
#pragma unroll
        for (int k = 0; k < 4; ++k) { x1[2 * k] = lo16(a[k]); x1[2 * k + 1] = hi16(a[k]); x2[2 * k] = lo16(b[k]); x2[2 * k + 1] = hi16(b[k]); }
        if (row < NLAT) {
            const float* ct = (const float*)(p.ws + WS_ROPE) + (row & (SEQ - 1)) * 16 + 8 * hh; const float* st = ct + 2048 * 16;
#pragma unroll
            for (int k = 0; k < 8; ++k) { const float c = ct[k], sn = st[k], u1 = x1[k], u2 = x2[k]; x1[k] = u1 * c - u2 * sn; x2[k] = u1 * sn + u2 * c; }
        }
        const u32x4 q0 = (u32x4){cvtpk(x1[0], x1[1]), cvtpk(x1[2], x1[3]), cvtpk(x1[4], x1[5]), cvtpk(x1[6], x1[7])};
        const u32x4 q1 = (u32x4){cvtpk(x2[0], x2[1]), cvtpk(x2[2], x2[3]), cvtpk(x2[4], x2[5]), cvtpk(x2[6], x2[7])};
        qf[0] = __builtin_bit_cast(bf16x8, q0); qf[1] = __builtin_bit_cast(bf16x8, q1);
    }
    const float af = exp2f(l2f * (float)i), ab = exp2f(-l2b * (float)i), cf = exp2f(l2f * (float)(i + 1)), cb = exp2f(l2b * (float)(128 - i));
    f32x16 y, zero;
#pragma unroll
    for (int r = 0; r < 16; ++r) { y[r] = 0.f; zero[r] = 0.f; }
    const int koff = r32 * KROW + 16 * hh;
    const int voff = O_V + eb * 8192 + (4 * hh + ((lane & 15) >> 2)) * 64 + ((lane >> 4) & 1) * 32 + (lane & 3) * 8;
#pragma unroll
    for (int kb = 0; kb < 4; ++kb) {
        f32x16 pt;
        if (kb <= qb) {
            f32x16 sF = __builtin_amdgcn_mfma_f32_32x32x16_bf16(*(const bf16x8*)(lds + O_KF + kb * 32 * KROW + koff), qf[0], zero, 0, 0, 0);
            sF = __builtin_amdgcn_mfma_f32_32x32x16_bf16(*(const bf16x8*)(lds + O_KF + kb * 32 * KROW + koff + 32), qf[1], sF, 0, 0, 0);
            if (kb < qb) {
#pragma unroll
                for (int r = 0; r < 16; ++r) pt[r] = sF[r] * af;
            } else {
#pragma unroll
                for (int r = 0; r < 16; ++r) { const int j = (r & 3) + 8 * (r >> 2) + 4 * hh; pt[r] = (j <= r32) ? sF[r] * af : 0.f; }
            }
        }
        if (kb >= qb) {
            f32x16 sB = __builtin_amdgcn_mfma_f32_32x32x16_bf16(*(const bf16x8*)(lds + O_KB + kb * 32 * KROW + koff), qf[0], zero, 0, 0, 0);
            sB = __builtin_amdgcn_mfma_f32_32x32x16_bf16(*(const bf16x8*)(lds + O_KB + kb * 32 * KROW + koff + 32), qf[1], sB, 0, 0, 0);
            if (kb > qb) {
#pragma unroll
                for (int r = 0; r < 16; ++r) pt[r] = sB[r] * ab;
            } else {
#pragma unroll
                for (int r = 0; r < 16; ++r) { const int j = (r & 3) + 8 * (r >> 2) + 4 * hh; pt[r] += (j >= r32) ? sB[r] * ab : 0.f; }
            }
        }
#pragma unroll
        for (int s2 = 0; s2 < 2; ++s2) {
            const u32x4 pw = (u32x4){cvtpk(pt[8 * s2], pt[8 * s2 + 1]), cvtpk(pt[8 * s2 + 2], pt[8 * s2 + 3]), cvtpk(pt[8 * s2 + 4], pt[8 * s2 + 5]), cvtpk(pt[8 * s2 + 6], pt[8 * s2 + 7])};
            const unsigned char* vb = lds + voff + (kb * 32 + s2 * 16) * 64;
            y = __builtin_amdgcn_mfma_f32_32x32x16_bf16(tr8(vb, vb + 8 * 64), __builtin_bit_cast(bf16x8, pw), y, 0, 0, 0);
        }
    }
    {
        const int soff = (eb * 32 + r32) * KROW + 16 * hh;
        f32x16 tF = __builtin_amdgcn_mfma_f32_32x32x16_bf16(*(const bf16x8*)(lds + O_SF + soff), qf[0], zero, 0, 0, 0);
        tF = __builtin_amdgcn_mfma_f32_32x32x16_bf16(*(const bf16x8*)(lds + O_SF + soff + 32), qf[1], tF, 0, 0, 0);
        f32x16 tB = __builtin_amdgcn_mfma_f32_32x32x16_bf16(*(const bf16x8*)(lds + O_SB + soff), qf[0], zero, 0, 0, 0);
        tB = __builtin_amdgcn_mfma_f32_32x32x16_bf16(*(const bf16x8*)(lds + O_SB + soff + 32), qf[1], tB, 0, 0, 0);
#pragma unroll
        for (int r = 0; r < 16; ++r) y[r] += tF[r] * cf + tB[r] * cb;
    }
    float s1 = 0.f, s2 = 0.f;
#pragma unroll
    for (int r = 0; r < 16; ++r) { s1 += y[r]; s2 += y[r] * y[r]; }
    s1 += __shfl_xor(s1, 32); s2 += __shfl_xor(s2, 32);
    float* red = (float*)(lds + O_RED);
    if (hh == 0) { red[(eb * 128 + i) * 2] = s1; red[(eb * 128 + i) * 2 + 1] = s2; }
    __syncthreads();
    s1 = red[i * 2] + red[(128 + i) * 2]; s2 = red[i * 2 + 1] + red[(128 + i) * 2 + 1];
    const float mu = s1 * (1.f / 64.f), var = fmaxf(s2 * (1.f / 64.f) - mu * mu, 0.f), rstd = rsqrtf(var + NORM_EPS);
    const bf16_t* zg = (const bf16_t*)(p.ws + WS_Z) + (size_t)row * ZC + Z_RG + h * 64 + eb * 32 + 4 * hh;
    const float* gw = p.in[13] + L * 256 + h * 64 + eb * 32 + 4 * hh;
    bf16_t* orow = (bf16_t*)(p.ws + WS_CC) + (size_t)row * D + 256 + h * 64 + eb * 32 + 4 * hh;
#pragma unroll
    for (int r4 = 0; r4 < 4; ++r4) {
        const u32x2 gz = *(const u32x2*)(zg + 8 * r4); const f32x4 w4 = *(const f32x4*)(gw + 8 * r4);
        const float g0 = lo16(gz.x), g1 = hi16(gz.x), g2 = lo16(gz.y), g3 = hi16(gz.y);
        u32x2 o; o.x = cvtpk(siluf(g0) * ((y[4 * r4] - mu) * rstd * w4.x), siluf(g1) * ((y[4 * r4 + 1] - mu) * rstd * w4.y));
        o.y = cvtpk(siluf(g2) * ((y[4 * r4 + 2] - mu) * rstd * w4.z), siluf(g3) * ((y[4 * r4 + 3] - mu) * rstd * w4.w));
        *(u32x2*)(orow + 8 * r4) = o;
    }
    __syncthreads();
}
__device__ __forceinline__ void qkv_proj(unsigned char* lds, const P& p, int L) {
    const float* sskv = (const float*)(p.ws + WS_SS) + (size_t)NTOK * 4;
    const int G = gridDim.x, bid = blockIdx.x;
    {
        bf16_t* Q = (bf16_t*)(p.ws + WS_Q);
        ge::DenseOrder S; S.nM = NTOK / 256; S.nN = 3; S.nwg = S.nM * 3; S.G = G; S.c = bid; S.Bt = (const char*)((const bf16_t*)(p.ws + WS_WUQ) + (size_t)L * 768 * 256); S.btile = (size_t)256 * 256 * 2; S.arow = ZC * 2;
        auto f = [&](const ge::Unit& u, int r, int c, f32x4 v0, f32x4 v1) {
            u32x4 w; w.x = cvtpk(v0.x, v0.y); w.y = cvtpk(v0.z, v0.w); w.z = cvtpk(v1.x, v1.y); w.w = cvtpk(v1.z, v1.w); *(u32x4*)(Q + (size_t)(u.a * 256 + r) * 768 + u.b * 256 + c) = w;
        };
        ge::EpiFn<decltype(f)> E{f};
        ge::gemm_stream<ge::DenseOrder, ge::EpiFn<decltype(f)>, true>((LAS unsigned char*)lds, (const char*)(p.ws + WS_Z) + Z_CQ * 2, 256, S, E);
    }
    {
        bf16_t* Kb = (bf16_t*)(p.ws + WS_K); bf16_t* Vb = (bf16_t*)(p.ws + WS_V);
        ge::DenseOrder S; S.nM = NTOK / 256; S.nN = 4; S.nwg = S.nM * 4; S.G = G; S.c = (bid + 176) % G; S.Bt = (const char*)((const bf16_t*)(p.ws + WS_WUKV) + (size_t)L * 1024 * 256); S.btile = (size_t)256 * 256 * 2; S.arow = ZC * 2;
        struct EpiKV {
            bf16_t* Kb; bf16_t* Vb; const float* sskv;
            __device__ __forceinline__ void operator()(const ge::Acc& acc, const ge::Unit& u, int wr, int wc, int fr, int fq) const {
                float rstd[2][4];
#pragma unroll
                for (int ai = 0; ai < 2; ++ai)
#pragma unroll
                    for (int m = 0; m < 4; ++m) { const f32x4 s4 = *(const f32x4*)(sskv + (size_t)(u.a * 256 + ai * 128 + wr * 64 + m * 16 + fr) * 4); rstd[ai][m] = rsqrtf((s4.x + s4.y + s4.z + s4.w) * (1.f / 128.f) + NORM_EPS); }
#pragma unroll
                for (int ai = 0; ai < 2; ++ai)
#pragma unroll
                    for (int m = 0; m < 4; ++m) {
                        const int row = u.a * 256 + ai * 128 + wr * 64 + m * 16 + fr;
#pragma unroll
                        for (int bj = 0; bj < 2; ++bj) {
                            const int col = u.b * 256 + bj * 128 + wc * 32 + 8 * fq, h = col >> 7, j = col & 127;
                            const f32x4 v0 = acc[ai][bj][m][0] * rstd[ai][m], v1 = acc[ai][bj][m][1] * rstd[ai][m];
                            u32x4 w; w.x = cvtpk(v0.x, v0.y); w.y = cvtpk(v0.z, v0.w); w.z = cvtpk(v1.x, v1.y); w.w = cvtpk(v1.z, v1.w);
                            if (j < 64) *(u32x4*)(Kb + (size_t)row * 768 + h * 96 + j) = w;
                            else *(u32x4*)(Vb + (size_t)row * 512 + h * 64 + (j - 64)) = w;
                        }
                    }
            }
        };
        EpiKV E{Kb, Vb, sskv};
        ge::gemm_stream<ge::DenseOrder, EpiKV, true>((LAS unsigned char*)lds, (const char*)(p.ws + WS_Z) + Z_CKV * 2, 256, S, E);
    }
}
__device__ __forceinline__ void phase_b(unsigned char* lds, const P& p, int L) {
    const int G = gridDim.x, bid = blockIdx.x;
    qkv_proj(lds, p, L);
    const int nconv = (L == 0) ? 576 : 512;
    const int nkv = 288 * 4;
    const int total = nconv + nkv;
    for (int u = (bid + 96) % G; u < total; u += G) {
        int r = u;
        if (r < nconv) { if (r < 512) conv_unit(lds, p, L, r >> 5, r & 31); else conv_unit(lds, p, L, 16 + ((r - 512) >> 2), (r - 512) & 3); continue; } r -= nconv;
        retkv_unit_mfma(lds, p, L, r >> 2, r & 3);
    }
    if (L == 1) convert_expert_weights(lds, p, 1);
}

__device__ __forceinline__ void attn_unit_naive(unsigned char* lds, const P& p, int b, int h, int qb, bool ctxq) {
    float* Ks = (float*)lds;
    float* Vs = Ks + 64 * 96;
    const int tid = threadIdx.x, half = tid & 1, qi = tid >> 1;
    const bf16_t* Qb = (const bf16_t*)(p.ws + WS_Q); const bf16_t* Kb = (const bf16_t*)(p.ws + WS_K); const bf16_t* Vb = (const bf16_t*)(p.ws + WS_V);
    const int qrow = ctxq ? NLAT + b * CTXL + qi : b * SEQ + qb * 256 + qi;
    float q[48];
    {
        const u32x4* qp = (const u32x4*)(Qb + (size_t)qrow * 768 + h * 96 + half * 48);
#pragma unroll
        for (int i = 0; i < 6; ++i) { const u32x4 w = qp[i];
#pragma unroll
            for (int k = 0; k < 4; ++k) { q[i * 8 + 2 * k] = lo16(w[k]); q[i * 8 + 2 * k + 1] = hi16(w[k]); } }
    }
    float o[32];
#pragma unroll
    for (int e = 0; e < 32; ++e) o[e] = 0.f;
    float m = -1e30f, l = 0.f;
    const int ntiles = ctxq ? 4 : 36;
#pragma unroll 1
    for (int t = 0; t < ntiles; ++t) {
        const int krow0 = t < 4 ? NLAT + b * CTXL + t * 64 : b * SEQ + (t - 4) * 64;
        __syncthreads();
        for (int i = tid; i < 64 * 12; i += NTHREADS) { const int key = i / 12, c = i % 12; const u32x4 w = *(const u32x4*)(Kb + (size_t)(krow0 + key) * 768 + h * 96 + c * 8);
            float* d = Ks + key * 96 + c * 8;
#pragma unroll
            for (int k = 0; k < 4; ++k) { d[2 * k] = lo16(w[k]); d[2 * k + 1] = hi16(w[k]); } }
        for (int i = tid; i < 64 * 8; i += NTHREADS) { const int key = i >> 3, c = i & 7; const u32x4 w = *(const u32x4*)(Vb + (size_t)(krow0 + key) * 512 + h * 64 + c * 8);
            float* d = Vs + key * 64 + c * 8;
#pragma unroll
            for (int k = 0; k < 4; ++k) { d[2 * k] = lo16(w[k]); d[2 * k + 1] = hi16(w[k]); } }
        __syncthreads();
#pragma unroll 1
        for (int j0 = 0; j0 < 64; j0 += 2) {
            float s[2]; float mt = -1e30f;
#pragma unroll
            for (int jj = 0; jj < 2; ++jj) {
                const f32x4* kr = (const f32x4*)(Ks + (j0 + jj) * 96 + half * 48);
                float a = 0.f;
#pragma unroll
                for (int d4 = 0; d4 < 12; ++d4) { const f32x4 kv = kr[d4]; a += q[4 * d4] * kv.x + q[4 * d4 + 1] * kv.y + q[4 * d4 + 2] * kv.z + q[4 * d4 + 3] * kv.w; }
                a += __shfl_xor(a, 1);
                s[jj] = a; mt = fmaxf(mt, a);
            }
            const float mn = fmaxf(m, mt), alpha = exp2f(m - mn);
            m = mn; l *= alpha;
#pragma unroll
            for (int e = 0; e < 32; ++e) o[e] *= alpha;
#pragma unroll
            for (int jj = 0; jj < 2; ++jj) {
                const float pj = exp2f(s[jj] - mn); l += pj;
                const f32x4* vr = (const f32x4*)(Vs + (j0 + jj) * 64 + half * 32);
#pragma unroll
                for (int e4 = 0; e4 < 8; ++e4) { const f32x4 vv = vr[e4]; o[4 * e4] += pj * vv.x; o[4 * e4 + 1] += pj * vv.y; o[4 * e4 + 2] += pj * vv.z; o[4 * e4 + 3] += pj * vv.w; }
            }
        }
    }
    {
        const float rl = 1.f / l;
        u32x4* op = (u32x4*)((bf16_t*)(p.ws + WS_CC) + (size_t)qrow * D + 512 + h * 64 + half * 32);
#pragma unroll
        for (int i = 0; i < 4; ++i) { u32x4 w; w.x = pk2(o[8 * i] * rl, o[8 * i + 1] * rl); w.y = pk2(o[8 * i + 2] * rl, o[8 * i + 3] * rl); w.z = pk2(o[8 * i + 4] * rl, o[8 * i + 5] * rl); w.w = pk2(o[8 * i + 6] * rl, o[8 * i + 7] * rl); op[i] = w; }
    }
    __syncthreads();
}
__device__ __forceinline__ float max3f(float a, float b, float c) { float r; asm("v_max3_f32 %0, %1, %2, %3" : "=v"(r) : "v"(a), "v"(b), "v"(c)); return r; }
constexpr int AT_KROW = 208;
constexpr int AT_KBUF = 64 * AT_KROW;
constexpr int AT_VBUF = 8192;
constexpr int AT_BUF = AT_KBUF + AT_VBUF;
__device__ __forceinline__ void attn_unit_mfma(unsigned char* lds, const P& p, int b, int h, int qb, bool ctxq) {
    const int tid = threadIdx.x, lane = tid & 63, wid = tid >> 6, r32 = lane & 31, hh = lane >> 5;
    const bf16_t* Qb = (const bf16_t*)(p.ws + WS_Q); const bf16_t* Kb = (const bf16_t*)(p.ws + WS_K); const bf16_t* Vb = (const bf16_t*)(p.ws + WS_V);
    const int qrow = (ctxq ? NLAT + b * CTXL : b * SEQ + qb * 256) + wid * 32 + r32;
    bf16x8 qf[6];
    {
        const f32x4 s4 = *(const f32x4*)((const float*)(p.ws + WS_SS) + (size_t)qrow * 4);
        const float rstd = rsqrtf((s4.x + s4.y + s4.z + s4.w) * (1.f / 256.f) + NORM_EPS);
        const float* ct = (const float*)(p.ws + WS_ROPE) + (qrow & (SEQ - 1)) * 16; const float* st = ct + 2048 * 16;
#pragma unroll
        for (int s = 0; s < 6; ++s) {
            const u32x4 w = *(const u32x4*)(Qb + (size_t)qrow * 768 + h * 96 + 16 * s + 8 * hh);
            float x[8];
#pragma unroll
            for (int k = 0; k < 4; ++k) { x[2 * k] = lo16(w[k]) * rstd; x[2 * k + 1] = hi16(w[k]) * rstd; }
            if (s >= 4 && !ctxq) {
                const f32x4 c4 = *(const f32x4*)(ct + 8 * (s - 4) + 4 * hh), sn = *(const f32x4*)(st + 8 * (s - 4) + 4 * hh);
#pragma unroll
                for (int k = 0; k < 4; ++k) { const float a = x[2 * k], b2 = x[2 * k + 1]; x[2 * k] = a * c4[k] - b2 * sn[k]; x[2 * k + 1] = a * sn[k] + b2 * c4[k]; }
            }
            const u32x4 o = (u32x4){cvtpk(x[0], x[1]), cvtpk(x[2], x[3]), cvtpk(x[4], x[5]), cvtpk(x[6], x[7])};
            qf[s] = __builtin_bit_cast(bf16x8, o);
        }
    }
    f32x16 o0, o1, negm;
#pragma unroll
    for (int r = 0; r < 16; ++r) { o0[r] = 0.f; o1[r] = 0.f; negm[r] = 0.f; }
    asm volatile("" : "+v"(negm));
    float mhat = 0.f, l = 0.f;
    const int ntiles = ctxq ? 4 : 36;
    const int wv = __builtin_amdgcn_readfirstlane(wid);
    const int ia = wv, ib = (wv + 8 < 13) ? wv + 8 : 12;
    const int qa = ia * 64 + lane, qb2 = ib * 64 + lane, qv = wv * 64 + lane;
    const int ca = qa % 13, cb = qb2 % 13;
    const size_t ka = (size_t)(qa / 13) * 768 + h * 96 + (ca < 12 ? ca : 11) * 8, kbo = (size_t)(qb2 / 13) * 768 + h * 96 + (cb < 12 ? cb : 11) * 8;
    const size_t vo = (size_t)((qv >> 2) & 63) * 512 + h * 64 + (qv >> 8) * 32 + (qv & 3) * 8;
    auto krow0 = [&](int t) { return t < 4 ? NLAT + b * CTXL + t * 64 : b * SEQ + (t - 4) * 64; };
    const unsigned lds0 = (unsigned)(uintptr_t)lds;
#define AT_GLDS(gp, ldsoff) do { unsigned keep_; asm volatile("s_mov_b32 %0, m0\n\ts_mov_b32 m0, %2\n\ts_nop 0\n\tglobal_load_lds_dwordx4 %1, off\n\ts_mov_b32 m0, %0" : "=&s"(keep_) : "v"(gp), "s"((unsigned)__builtin_amdgcn_readfirstlane(lds0 + (unsigned)(ldsoff))) : "memory"); } while (0)
#define AT_ISSUE(t2, slot) do { const int kr_ = krow0(t2); const bf16_t* kb_ = Kb + (size_t)kr_ * 768; const bf16_t* vb_ = Vb + (size_t)kr_ * 512; \
        AT_GLDS(kb_ + ka, (slot) + ia * 1024); AT_GLDS(kb_ + kbo, (slot) + ib * 1024); AT_GLDS(vb_ + vo, (slot) + AT_KBUF + wv * 1024); } while (0)
    __builtin_amdgcn_s_barrier();
    AT_ISSUE(0, 0);
    if (ntiles > 1) AT_ISSUE(1, AT_BUF);
    const int koff = r32 * AT_KROW + 16 * hh;
    const int voff = AT_KBUF + (4 * hh + ((lane & 15) >> 2)) * 64 + ((lane >> 4) & 1) * 32 + (lane & 3) * 8;
    int slot_c = 0, slot_n = 2 * AT_BUF;
#pragma unroll 1
    for (int t = 0; t < ntiles; ++t) {
        if (t + 1 < ntiles) asm volatile("s_waitcnt vmcnt(3)" ::: "memory"); else asm volatile("s_waitcnt vmcnt(0)" ::: "memory");
        __builtin_amdgcn_s_barrier();
        asm volatile("" ::: "memory");
        if (t + 2 < ntiles) AT_ISSUE(t + 2, slot_n);
        unsigned char* buf = lds + slot_c;
        slot_n = slot_c; slot_c = (slot_c == 2 * AT_BUF) ? 0 : slot_c + AT_BUF;
        f32x16 p0, p1;
        {
            const bf16x8 k0f = *(const bf16x8*)(buf + koff), k1f = *(const bf16x8*)(buf + koff + 32 * AT_KROW);
            p0 = __builtin_amdgcn_mfma_f32_32x32x16_bf16(k0f, qf[0], negm, 0, 0, 0);
            p1 = __builtin_amdgcn_mfma_f32_32x32x16_bf16(k1f, qf[0], negm, 0, 0, 0);
        }
#pragma unroll
        for (int s = 1; s < 6; ++s) {
            const bf16x8 k0f = *(const bf16x8*)(buf + koff + 32 * s), k1f = *(const bf16x8*)(buf + koff + 32 * AT_KROW + 32 * s);
            p0 = __builtin_amdgcn_mfma_f32_32x32x16_bf16(k0f, qf[s], p0, 0, 0, 0);
            p1 = __builtin_amdgcn_mfma_f32_32x32x16_bf16(k1f, qf[s], p1, 0, 0, 0);
        }
        asm volatile("s_nop 15\n\ts_nop 7" : "+v"(p0), "+v"(p1));
        float rma = max3f(p0[0], p0[1], p1[0]), rmb = max3f(p0[2], p0[3], p1[1]);
        rma = max3f(rma, p1[2], p1[3]);
#pragma unroll
        for (int r = 4; r < 16; r += 4) { rma = max3f(rma, p0[r], p0[r + 1]); rmb = max3f(rmb, p0[r + 2], p0[r + 3]); rma = max3f(rma, p1[r], p1[r + 1]); rmb = max3f(rmb, p1[r + 2], p1[r + 3]); }
        float rm = fmaxf(rma, rmb);
        rm = fmaxf(rm, __shfl_xor(rm, 32));
        if (__any(rm > 8.f)) {
            const float dl = fmaxf(rm, 0.f), f = __builtin_amdgcn_exp2f(-dl);
            mhat += dl; l *= f;
#pragma unroll
            for (int r = 0; r < 16; ++r) { p0[r] -= dl; p1[r] -= dl; o0[r] *= f; o1[r] *= f; negm[r] = -mhat; }
            asm volatile("" : "+v"(negm));
        }
        float ls = 0.f;
#pragma unroll
        for (int r = 0; r < 16; ++r) { p0[r] = __builtin_amdgcn_exp2f(p0[r]); p1[r] = __builtin_amdgcn_exp2f(p1[r]); ls += p0[r] + p1[r]; }
        l += ls;
        u32x4 pw[4];
#pragma unroll
        for (int s2 = 0; s2 < 2; ++s2) {
            pw[s2] = (u32x4){cvtpk(p0[8 * s2], p0[8 * s2 + 1]), cvtpk(p0[8 * s2 + 2], p0[8 * s2 + 3]), cvtpk(p0[8 * s2 + 4], p0[8 * s2 + 5]), cvtpk(p0[8 * s2 + 6], p0[8 * s2 + 7])};
            pw[2 + s2] = (u32x4){cvtpk(p1[8 * s2], p1[8 * s2 + 1]), cvtpk(p1[8 * s2 + 2], p1[8 * s2 + 3]), cvtpk(p1[8 * s2 + 4], p1[8 * s2 + 5]), cvtpk(p1[8 * s2 + 6], p1[8 * s2 + 7])};
        }
#pragma unroll
        for (int ks = 0; ks < 4; ++ks) {
            const unsigned char* vb = buf + voff + ks * 16 * 64;
            const bf16x8 pf = __builtin_bit_cast(bf16x8, pw[ks]);
            o0 = __builtin_amdgcn_mfma_f32_32x32x16_bf16(tr8(vb, vb + 8 * 64), pf, o0, 0, 0, 0);
            o1 = __builtin_amdgcn_mfma_f32_32x32x16_bf16(tr8(vb + 4096, vb + 4096 + 8 * 64), pf, o1, 0, 0, 0);
        }
    }
#undef AT_GLDS
#undef AT_ISSUE
    l += __shfl_xor(l, 32);
    const float rl = 1.f / l;
    bf16_t* orow = (bf16_t*)(p.ws + WS_CC) + (size_t)qrow * D + 512 + h * 64 + 4 * hh;
#pragma unroll
    for (int r4 = 0; r4 < 4; ++r4) {
        u32x2 w0; w0.x = cvtpk(o0[4 * r4] * rl, o0[4 * r4 + 1] * rl); w0.y = cvtpk(o0[4 * r4 + 2] * rl, o0[4 * r4 + 3] * rl);
        u32x2 w1; w1.x = cvtpk(o1[4 * r4] * rl, o1[4 * r4 + 1] * rl); w1.y = cvtpk(o1[4 * r4 + 2] * rl, o1[4 * r4 + 3] * rl);
        *(u32x2*)(orow + 8 * r4) = w0; *(u32x2*)(orow + 32 + 8 * r4) = w1;
    }
}
__device__ __forceinline__ void retout_unit(unsigned char* lds, const P& p, int L, int gc, int h) {
    float* qs = (float*)lds; float* ks = qs + 128 * 33; float* vs = ks + 128 * 33; float* Sf = vs + 128 * 64; float* Sb = Sf + 2048;
    const int tid = threadIdx.x;
    const float l2f = log2_gamma(p, L, 0, h), l2b = log2_gamma(p, L, 1, h);
    load_ret_qk(qs, p, gc, h, Z_RQ, 1.f);
    load_ret_qk(ks, p, gc, h, Z_RK, 0.17677669529663687f);
    load_ret_v(vs, p, gc, h);
    {
        const bool lat = gc < 256; const int b = lat ? gc >> 4 : (gc - 256) >> 1;
        const int mme = lat ? 2 + (gc & 15) : (gc - 256) & 1;
        const int u = mme, w = mme < 2 ? 1 - mme : 19 - mme;
        f32x4 sf = (f32x4){0.f, 0.f, 0.f, 0.f}, sb = sf;
        const float* KVb = (const float*)(p.ws + WS_KV);
#pragma unroll 1
        for (int mm = 0; mm < 18; ++mm) {
            const int gcm = mm < 2 ? 256 + b * 2 + mm : b * 16 + (mm - 2);
            const int um = mm, wm = mm < 2 ? 1 - mm : 19 - mm;
            const float* kv = KVb + ((size_t)(gcm * 4 + h) * 2) * 2048 + tid * 4;
            if (um < u) { const float wgt = exp2f(l2f * 128.f * (float)(u - 1 - um)); sf += wgt * *(const f32x4*)kv; }
            if (wm < w) { const float wgt = exp2f(l2b * 128.f * (float)(w - 1 - wm)); sb += wgt * *(const f32x4*)(kv + 2048); }
        }
        *(f32x4*)(Sf + tid * 4) = sf; *(f32x4*)(Sb + tid * 4) = sb;
    }
    __syncthreads();
    const int i = tid >> 2, e0 = (tid & 3) * 16;
    float q[32];
#pragma unroll
    for (int d = 0; d < 32; ++d) q[d] = qs[i * 33 + d];
    float acc[16];
#pragma unroll
    for (int e = 0; e < 16; ++e) acc[e] = 0.f;
#pragma unroll 1
    for (int j = 0; j < 128; ++j) {
        float s = 0.f;
#pragma unroll
        for (int d = 0; d < 32; ++d) s += q[d] * ks[j * 33 + d];
        float wgt = 0.f;
        if (j <= i) wgt += exp2f(l2f * (float)(i - j));
        if (j >= i) wgt += exp2f(l2b * (float)(j - i));
        s *= wgt;
#pragma unroll
        for (int e4 = 0; e4 < 4; ++e4) { const f32x4 v4 = *(const f32x4*)(vs + j * 64 + e0 + 4 * e4); acc[4 * e4] += s * v4.x; acc[4 * e4 + 1] += s * v4.y; acc[4 * e4 + 2] += s * v4.z; acc[4 * e4 + 3] += s * v4.w; }
    }
    {
        const float cf = exp2f(l2f * (float)(i + 1)), cb = exp2f(l2b * (float)(128 - i));
#pragma unroll 2
        for (int d = 0; d < 32; ++d) {
            const float qd = qs[i * 33 + d]; const float qf = qd * cf, qb = qd * cb;
#pragma unroll
            for (int e4 = 0; e4 < 4; ++e4) { const f32x4 a = *(const f32x4*)(Sf + d * 64 + e0 + 4 * e4), bq = *(const f32x4*)(Sb + d * 64 + e0 + 4 * e4);
                acc[4 * e4] += qf * a.x + qb * bq.x; acc[4 * e4 + 1] += qf * a.y + qb * bq.y; acc[4 * e4 + 2] += qf * a.z + qb * bq.z; acc[4 * e4 + 3] += qf * a.w + qb * bq.w; }
        }
    }
    float s1 = 0.f;
#pragma unroll
    for (int e = 0; e < 16; ++e) s1 += acc[e];
    s1 += __shfl_xor(s1, 1); s1 += __shfl_xor(s1, 2);
    const float mu = s1 * (1.f / 64.f);
    float s2 = 0.f;
#pragma unroll
    for (int e = 0; e < 16; ++e) { const float dd = acc[e] - mu; s2 += dd * dd; }
    s2 += __shfl_xor(s2, 1); s2 += __shfl_xor(s2, 2);
    const float rstd = rsqrtf(s2 * (1.f / 64.f) + NORM_EPS);
    const int row = gc * 128 + i;
    const bf16_t* zg = (const bf16_t*)(p.ws + WS_Z) + (size_t)row * ZC + Z_RG + h * 64 + e0;
    const float* gw = p.in[13] + L * 256 + h * 64 + e0;
    const u32x4 g0 = *(const u32x4*)zg, g1 = *(const u32x4*)(zg + 8);
    float g[16];
#pragma unroll
    for (int k = 0; k < 4; ++k) { g[2 * k] = lo16(g0[k]); g[2 * k + 1] = hi16(g0[k]); g[8 + 2 * k] = lo16(g1[k]); g[8 + 2 * k + 1] = hi16(g1[k]); }
    unsigned o[8];
#pragma unroll
    for (int k = 0; k < 8; ++k) {
        const float y0 = siluf(g[2 * k]) * ((acc[2 * k] - mu) * rstd * gw[2 * k]), y1 = siluf(g[2 * k + 1]) * ((acc[2 * k + 1] - mu) * rstd * gw[2 * k + 1]);
        o[k] = pk2(y0, y1);
    }
    u32x4* op = (u32x4*)((bf16_t*)(p.ws + WS_CC) + (size_t)row * D + 256 + h * 64 + e0);
    u32x4 w0; w0.x = o[0]; w0.y = o[1]; w0.z = o[2]; w0.w = o[3]; u32x4 w1; w1.x = o[4]; w1.y = o[5]; w1.z = o[6]; w1.w = o[7];
    op[0] = w0; op[1] = w1;
    __syncthreads();
}
__device__ __forceinline__ void phase_c(unsigned char* lds, const P& p, int L) {
    const int G = gridDim.x, bid = blockIdx.x;
    const int nat = 16 * 8 * 8, nac = (L == 0) ? 128 : 0, nro = (L == 0 ? 288 : 256) * 4;
    const int total = nat + nac + nro;
    for (int u = bid; u < total; u += G) {
        int r = u;
#ifndef TEST_C
#define TEST_C 3
#endif
        if (r < nat) { if (TEST_C & 1) attn_unit_mfma(lds, p, r >> 6, (r >> 3) & 7, r & 7, false); continue; } r -= nat;
        if (r < nac) { if (TEST_C & 1) attn_unit_mfma(lds, p, r >> 3, r & 7, 0, true); continue; } r -= nac;
        if (TEST_C & 2) retout_unit_mfma(lds, p, L, r >> 2, r & 3);
    }
    if (L == 0) convert_expert_weights(lds, p, 0);
}

struct EpiY {
    bf16_t* Y; const float* g1;
    __device__ __forceinline__ void operator()(const ge::Acc& acc, const ge::Unit& u, int wr, int wc, int fr, int fq) const {
        const float* gr = g1 + (size_t)mod_row(u.a * 256) * 6144 + u.b * 256 + wc * 32 + 8 * fq;
        f32x4 g[2][2];
#pragma unroll
        for (int bj = 0; bj < 2; ++bj)
#pragma unroll
            for (int n = 0; n < 2; ++n) g[bj][n] = *(const f32x4*)(gr + bj * 128 + n * 4);
#pragma unroll
        for (int ai = 0; ai < 2; ++ai)
#pragma unroll
            for (int m = 0; m < 4; ++m) {
                bf16_t* yr = Y + (size_t)(u.a * 256 + ai * 128 + wr * 64 + m * 16 + fr) * D + u.b * 256 + wc * 32 + 8 * fq;
#pragma unroll
                for (int bj = 0; bj < 2; ++bj) { const f32x4 v0 = acc[ai][bj][m][0] * g[bj][0], v1 = acc[ai][bj][m][1] * g[bj][1];
                    u32x4 w; w.x = cvtpk(v0.x, v0.y); w.y = cvtpk(v0.z, v0.w); w.z = cvtpk(v1.x, v1.y); w.w = cvtpk(v1.z, v1.w); *(u32x4*)(yr + bj * 128) = w; }
            }
    }
};
__device__ __forceinline__ void phase_d(unsigned char* lds, const P& p, int L) {
    ge::DenseOrder S; S.nM = (L == 0 ? NTOK : NLAT) / 256; S.nN = 4; S.nwg = S.nM * 4; S.G = gridDim.x; S.c = blockIdx.x;
    S.Bt = (const char*)((const bf16_t*)(p.ws + WS_WOUT) + (size_t)L * D * D); S.btile = (size_t)256 * D * 2; S.arow = D * 2;
    EpiY E{(bf16_t*)(p.ws + WS_Y), (const float*)(p.ws + WS_MODV) + (size_t)L * 17 * 6144 + 2048};
    ge::gemm_stream<ge::DenseOrder, EpiY, true>((LAS unsigned char*)lds, (const char*)(p.ws + WS_CC), D, S, E);
}

__device__ __forceinline__ void norm_mod_store(const P& p, int L, int which, int tok, int lane, const f32x4 (&v)[4], bf16_t* Hdst) {
    const float* nw = (which == 0 ? p.in[6] : p.in[19]) + L * D;
    const float* mrow = (const float*)(p.ws + WS_MODV) + ((size_t)L * 17 + mod_row(tok)) * 6144 + which * 3072;
    float s = 0.f;
#pragma unroll
    for (int j = 0; j < 4; ++j) s += v[j].x * v[j].x + v[j].y * v[j].y + v[j].z * v[j].z + v[j].w * v[j].w;
    const float rstd = rsqrtf(wave_sum(s) * (1.f / D) + NORM_EPS);
    u32x2* o = (u32x2*)(Hdst + (size_t)tok * D) + lane;
#pragma unroll
    for (int j = 0; j < 4; ++j) {
        const int k = 4 * lane + 256 * j;
        const f32x4 w4 = *(const f32x4*)(nw + k), sh = *(const f32x4*)(mrow + k), sc = *(const f32x4*)(mrow + 1024 + k);
        const f32x4 y = v[j] * rstd * w4 * (sc + 1.f) + sh;
        u32x2 w; w.x = cvtpk(y.x, y.y); w.y = cvtpk(y.z, y.w); o[64 * j] = w;
    }
}
__device__ __forceinline__ int half_n(int L) { return L == 0 ? NTOK / 2 : NLAT / 2; }
__device__ __forceinline__ void phase_router(unsigned char* lds, const P& p, int L) {
    constexpr int O_LG = 41472, O_CNT = 83072, O_SEL = 83584, O_SELW = 87424;
    const bf16_t* H = (const bf16_t*)(p.ws + WS_H); const bf16_t* W = (const bf16_t*)(p.ws + WS_RT) + (size_t)L * 128 * D;
    const bf16_t* Y = (const bf16_t*)(p.ws + WS_Y);
    float* lg = (float*)(lds + O_LG);
    int* lcnt = (int*)(lds + O_CNT);
    int* sel = (int*)(lds + O_SEL);
    float* selw = (float*)(lds + O_SELW);
    int* ltok = (int*)(p.ws + WS_LTOK); float* lw = (float*)(p.ws + WS_LW);
    const int tid = threadIdx.x, lane = tid & 63, wave = tid >> 6;
    const int ntok = (L == 0 ? NTOK : NLAT), TS = (L == 0 ? 144 : 128), nmt = ntok / TS, RW = TS / 8, HN = half_n(L);
    for (int mt = blockIdx.x; mt < nmt; mt += gridDim.x) {
        const int t0 = mt * TS;
        if (tid < 64) lcnt[tid] = 0;
#pragma unroll 2
        for (int q = 0; q < RW; ++q) {
            const int tok = t0 + wave * RW + q;
            const f32x4* xi = (const f32x4*)(L == 0 ? x_in_row(p, tok) : (const float*)x_row(p, tok)) + lane;
            const u32x2* yr = (const u32x2*)(Y + (size_t)tok * D) + lane;
            f32x4* xo = (f32x4*)x_row(p, tok) + lane;
            f32x4 v[4];
#pragma unroll
            for (int j = 0; j < 4; ++j) { const f32x4 a = xi[64 * j]; const u32x2 y = yr[64 * j]; v[j] = (f32x4){a.x + lo16(y.x), a.y + hi16(y.x), a.z + lo16(y.y), a.w + hi16(y.y)}; xo[64 * j] = v[j]; }
            norm_mod_store(p, L, 1, tok, lane, v, (bf16_t*)(p.ws + WS_H));
        }
        asm volatile("s_waitcnt vmcnt(0)" ::: "memory");
        __syncthreads();
        auto rs = [&](int pr) { return H + (size_t)(t0 + (pr < TS ? pr : TS - 1)) * D; };
        auto epi = [&](int r, int c, f32x4 v) { if (c < 64) { float* d = lg + r * 65 + c; d[0] = v.x; d[1] = v.y; d[2] = v.z; d[3] = v.w; } };
        gemm_tile<5>(lds, rs, W, D, D, epi);
        __syncthreads();
        if (tid < TS) {
            const float* rbp = p.in[21] + L * NEXP; const float* lrow = lg + tid * 65;
            float bv[6], bs[6]; int bi[6];
#pragma unroll
            for (int k = 0; k < 6; ++k) { bv[k] = -INFINITY; bs[k] = 0.f; bi[k] = 0; }
#pragma unroll 4
            for (int e = 0; e < NEXP; ++e) {
                float sc = 1.f / (1.f + __expf(-lrow[e])); float sv = sc + rbp[e]; int ei = e;
#pragma unroll
                for (int k = 0; k < 6; ++k) { const bool gt = sv > bv[k]; const float tv = gt ? bv[k] : sv, ts = gt ? bs[k] : sc; const int ti = gt ? bi[k] : ei;
                    bv[k] = gt ? sv : bv[k]; bs[k] = gt ? sc : bs[k]; bi[k] = gt ? ei : bi[k]; sv = tv; sc = ts; ei = ti; }
            }
            const float rs6 = 2.5f / (bs[0] + bs[1] + bs[2] + bs[3] + bs[4] + bs[5]);
#pragma unroll
            for (int k = 0; k < 6; ++k) { const int rank = atomicAdd(&lcnt[bi[k]], 1); sel[tid * 6 + k] = (bi[k] << 8) | rank; selw[tid * 6 + k] = bs[k] * rs6; }
        }
        __syncthreads();
        const int hf = t0 / HN;
        if (tid < 64) {
            unsigned* ecnt = (unsigned*)(p.ws + WS_CTL) + CW_ECNT + (L * 2 + hf) * 4096;
            const int c = lcnt[tid];
            lcnt[64 + tid] = c ? (int)atomicAdd(ecnt + tid * 64, (unsigned)c) : 0;
        }
        __syncthreads();
        for (int i = tid; i < TS * 6; i += NTHREADS) {
            const int sv = sel[i], e = sv >> 8, pos = lcnt[64 + e] + (sv & 255), tok = t0 + i / 6, k = i % 6;
            ltok[(size_t)(hf * 64 + e) * LCAPH + pos] = tok * 8 + k;
            lw[(size_t)(hf * 64 + e) * LCAPH + pos] = selw[i];
        }
        __syncthreads();
    }
}

__device__ __forceinline__ void build_etab(unsigned char* lds, const P& p, int L) {
    int* tstart = (int*)(lds + ETAB_OFF); int* cnt = tstart + 160;
    __syncthreads();
    if (threadIdx.x < 128) { const unsigned* ecnt = (const unsigned*)(p.ws + WS_CTL) + CW_ECNT + (L * 2 + (threadIdx.x >> 6)) * 4096;
        cnt[threadIdx.x] = (int)__hip_atomic_load(ecnt + (threadIdx.x & 63) * 64, __ATOMIC_RELAXED, __HIP_MEMORY_SCOPE_AGENT); }
    __syncthreads();
    if (threadIdx.x == 0) { int s = 0; for (int hf = 0; hf < 2; ++hf) { for (int e = 0; e < 64; ++e) { tstart[hf * 66 + e] = s; s += (cnt[hf * 64 + e] + 255) >> 8; } tstart[hf * 66 + 64] = s; s += half_n(L) / 256; tstart[hf * 66 + 65] = s; } }
    __syncthreads();
}
struct MoeOrder {
    int tlo, thi, nN, G, c; const int* tstart; const char* Bexp; size_t bexp; const char* Bsh; size_t btile; const int* rowbuf; unsigned arow; bool ident;
    __device__ __forceinline__ bool next(int i, ge::Unit& u) const {
        const int Lq = i * G + c; if (Lq >= (thi - tlo) * nN) return false;
        const int t = tlo + Lq / nN, pn = Lq % nN;
        const int hf = t >= tstart[66] ? 1 : 0; const int* ts = tstart + hf * 66;
        int lo = 0, hi = 64;
        while (lo < hi) { const int mid = (lo + hi + 1) >> 1; if (ts[mid] <= t) lo = mid; else hi = mid - 1; }
        const int e = __builtin_amdgcn_readfirstlane(lo);
        u.a = t; u.b = pn; u.c = hf * 128 + e; u.d = i;
        u.B = (e < 64 ? Bexp + (size_t)e * bexp : Bsh) + (size_t)pn * btile;
        return true;
    }
    __device__ __forceinline__ unsigned aoff(int i, const ge::Unit& u, int R) const { return (unsigned)(ident ? u.a * 256 + R : rowbuf[i * 256 + R]) * arow; }
};
__device__ __forceinline__ void phase_gateup(unsigned char* lds, const P& p, int L) {
    build_etab(lds, p, L);
    const int* tstart = (const int*)(lds + ETAB_OFF); const int* cnt = tstart + 160;
    int* rowbuf = (int*)(lds + RB0_OFF); float* wbuf = (float*)(lds + RB1_OFF);
    const int* ltok = (const int*)(p.ws + WS_LTOK); const float* lw = (const float*)(p.ws + WS_LW);
    bf16_t* ACT = (bf16_t*)(p.ws + WS_ACT);
    const int G = gridDim.x, bid = blockIdx.x, vcu = (G % 8 == 0) ? (bid % 8) * (G / 8) + bid / 8 : bid, HN = half_n(L);
    MoeOrder S; S.tlo = 0; S.thi = tstart[66 + 65]; S.nN = 2; S.G = G; S.c = vcu; S.tstart = tstart; S.Bexp = (const char*)(p.ws + WS_EGU); S.bexp = (size_t)512 * D * 2;
    S.Bsh = (const char*)((const bf16_t*)(p.ws + WS_SHGU) + (size_t)L * 512 * D); S.btile = (size_t)256 * D * 2; S.rowbuf = rowbuf; S.arow = D * 2; S.ident = false;
    {
        ge::Unit u;
        for (int i = 0; i < 10 && S.next(i, u); ++i) {
            if (threadIdx.x < 256) {
                const int R = threadIdx.x, hf = u.c >> 7, e = u.c & 127, mt = u.a - tstart[hf * 66 + e];
                int tok; float w;
                if (e < 64) { const int lp = mt * 256 + R; const bool ok = lp < cnt[hf * 64 + e]; tok = ok ? (ltok[(size_t)(hf * 64 + e) * LCAPH + lp] >> 3) : 0; w = ok ? lw[(size_t)(hf * 64 + e) * LCAPH + lp] : 0.f; }
                else { tok = hf * HN + mt * 256 + R; w = 1.f; }
                rowbuf[i * 256 + R] = tok; wbuf[i * 256 + R] = w;
            }
        }
        __syncthreads();
    }
    auto f = [&](const ge::Unit& u, int r, int c, f32x4 v0, f32x4 v1) {
        const float w = wbuf[u.d * 256 + r];
        u32x2 o; o.x = cvtpk(siluf(v0.x) * v0.y * w, siluf(v0.z) * v0.w * w); o.y = cvtpk(siluf(v1.x) * v1.y * w, siluf(v1.z) * v1.w * w);
        *(u32x2*)(ACT + (size_t)(u.a * 256 + r) * EDIM + ((u.b * 256 + c) >> 1)) = o;
    };
    ge::EpiFn<decltype(f)> E{f};
    ge::gemm_stream<MoeOrder, ge::EpiFn<decltype(f)>, true>((LAS unsigned char*)lds, (const char*)(p.ws + (L == 0 ? WS_H : WS_H)), D, S, E);
}
__device__ __forceinline__ void phase_down(unsigned char* lds, const P& p, int L, int hf) {
    build_etab(lds, p, L);
    const int* tstart = (const int*)(lds + ETAB_OFF); const int* cnt = tstart + 160;
    int* sbuf = (int*)(lds + RB0_OFF);
    const int* ltok = (const int*)(p.ws + WS_LTOK);
    bf16_t* SLOT = (bf16_t*)(p.ws + WS_SLOT);
    const int G = gridDim.x, bid = blockIdx.x, vcu = (G % 8 == 0) ? (bid % 8) * (G / 8) + bid / 8 : bid, HN = half_n(L);
    MoeOrder S; S.tlo = tstart[hf * 66]; S.thi = tstart[hf * 66 + 65]; S.nN = 4; S.G = G; S.c = vcu; S.tstart = tstart; S.Bexp = (const char*)(p.ws + WS_ED); S.bexp = (size_t)D * EDIM * 2;
    S.Bsh = (const char*)((const bf16_t*)(p.ws + WS_SHD) + (size_t)L * D * EDIM); S.btile = (size_t)256 * EDIM * 2; S.rowbuf = sbuf; S.arow = EDIM * 2; S.ident = true;
    {
        ge::Unit u;
        for (int i = 0; i < 10 && S.next(i, u); ++i) {
            if (threadIdx.x < 256) {
                const int R = threadIdx.x, e = u.c & 127, mt = u.a - tstart[hf * 66 + e];
                int srow;
                if (e < 64) { const int lp = mt * 256 + R; if (lp < cnt[hf * 64 + e]) { const int ent = ltok[(size_t)(hf * 64 + e) * LCAPH + lp]; srow = ((ent >> 3) - hf * HN) * 7 + (ent & 7); } else srow = -1; }
                else srow = (mt * 256 + R) * 7 + 6;
                sbuf[i * 256 + R] = srow;
            }
        }
        __syncthreads();
    }
    auto f = [&](const ge::Unit& u, int r, int c, f32x4 v0, f32x4 v1) {
        const int srow = sbuf[u.d * 256 + r];
        if (srow >= 0) { u32x4 w; w.x = cvtpk(v0.x, v0.y); w.y = cvtpk(v0.z, v0.w); w.z = cvtpk(v1.x, v1.y); w.w = cvtpk(v1.z, v1.w); *(u32x4*)(SLOT + (size_t)srow * D + u.b * 256 + c) = w; }
    };
    ge::EpiFn<decltype(f)> E{f};
    ge::gemm_stream<MoeOrder, ge::EpiFn<decltype(f)>, true>((LAS unsigned char*)lds, (const char*)(p.ws + WS_ACT), EDIM, S, E);
}
__device__ __forceinline__ void phase_combine(const P& p, int L, int hf) {
    const int tid = threadIdx.x, lane = tid & 63, wave = tid >> 6, gw = blockIdx.x * NWAVES + wave, NGW = gridDim.x * NWAVES;
    const bf16_t* SLOT = (const bf16_t*)(p.ws + WS_SLOT);
    const float* modv = (const float*)(p.ws + WS_MODV) + (size_t)L * 17 * 6144;
    const int HN = half_n(L);
    for (int tl = gw; tl < HN; tl += NGW) {
        const int tok = hf * HN + tl;
        f32x4 acc[4];
#pragma unroll
        for (int j = 0; j < 4; ++j) acc[j] = (f32x4){0.f, 0.f, 0.f, 0.f};
#pragma unroll
        for (int k = 0; k < 7; ++k) {
            const u32x2* sr = (const u32x2*)(SLOT + ((size_t)tl * 7 + k) * D) + lane;
#pragma unroll
            for (int j = 0; j < 4; ++j) { const u32x2 w = sr[64 * j]; acc[j].x += lo16(w.x); acc[j].y += hi16(w.x); acc[j].z += lo16(w.y); acc[j].w += hi16(w.y); }
        }
        const float* g2 = modv + (size_t)mod_row(tok) * 6144 + 5120;
        f32x4* xr = (f32x4*)x_row(p, tok) + lane;
        f32x4 v[4];
#pragma unroll
        for (int j = 0; j < 4; ++j) { const f32x4 g = *(const f32x4*)(g2 + 4 * lane + 256 * j); v[j] = xr[64 * j] + g * acc[j]; }
        if (L == 0) {
#pragma unroll
            for (int j = 0; j < 4; ++j) xr[64 * j] = v[j];
            norm_mod_store(p, 1, 0, tok, lane, v, (bf16_t*)(p.ws + WS_H1));
        } else {
            const float* nw = p.in[28]; float s = 0.f;
#pragma unroll
            for (int j = 0; j < 4; ++j) s += v[j].x * v[j].x + v[j].y * v[j].y + v[j].z * v[j].z + v[j].w * v[j].w;
            const float rstd = rsqrtf(wave_sum(s) * (1.f / D) + NORM_EPS);
#pragma unroll
            for (int j = 0; j < 4; ++j) { const f32x4 w4 = *(const f32x4*)(nw + 4 * lane + 256 * j); xr[64 * j] = v[j] * rstd * w4; }
        }
    }
}

constexpr int PH_LAYER0 = 2, PH_PER_LAYER = 10, PH_LAYER1 = PH_LAYER0 + PH_PER_LAYER, NPHASES = PH_LAYER1 + PH_PER_LAYER;

__global__ void __launch_bounds__(NTHREADS, 2) mk_fwd(P p) {
    extern __shared__ __attribute__((aligned(16))) unsigned char lds[];
    volatile LAS unsigned* MISC = (volatile LAS unsigned*)((LAS unsigned char*)lds + MISC_OFF);
    if (threadIdx.x < 64) MISC[threadIdx.x] = 0u;
    __syncthreads();
    unsigned* ctl = (unsigned*)(p.ws + WS_CTL);
    XcdBarrier bar; bar.bar = ctl + CW_BAR; bar.x = 0; bar.st = MISC + 8;
    if (!MK_PER_PHASE) bar = xcd_barrier_post(ctl + CW_BAR, MISC + 8);
    const int lo = p.ph_lo, hi = p.ph_hi;
#ifndef PH_MASK
#define PH_MASK 0xffffu
#endif
#define HAS(b) ((PH_MASK >> (b)) & 1u)
#define IN(k) (lo <= (k) && (k) < hi)
#define SEAM(k) do { if (IN(k) && IN((k) + 1)) xcd_barrier(bar); } while (0)

#ifdef PROBE_MASK
    unsigned long long tacc = 0ull, t0p = 0ull;
#define PT0() t0p = __builtin_amdgcn_s_memrealtime()
#define PT1(b) do { if ((PROBE_MASK >> (b)) & 1u) tacc += __builtin_amdgcn_s_memrealtime() - t0p; } while (0)
#else
#define PT0() do {} while (0)
#define PT1(b) do {} while (0)
#endif
#define PH(b, k, body) do { PT0(); if (HAS(b) && IN(k)) { body; } SEAM(k); PT1(b); } while (0)
    PH(0, 0, phase_prep(lds, p));
    PH(1, 1, phase_norm_mod(p, 0, 0, NTOK));
#define DOWN_COMBINE(L, pb, hf) \
        PH(9, pb + 6 + 2 * hf, phase_down(lds, p, L, hf)); \
        PH(10, pb + 7 + 2 * hf, phase_combine(p, L, hf));
#define LAYER(L, pb) \
        PH(2, pb + 0, phase_zgemm(lds, p, L)); \
        PH(3, pb + 1, phase_b(lds, p, L)); \
        PH(4, pb + 2, phase_c(lds, p, L)); \
        PH(5, pb + 3, phase_d(lds, p, L)); \
        PH(7, pb + 4, phase_router(lds, p, L)); \
        PH(8, pb + 5, phase_gateup(lds, p, L)); \
        DOWN_COMBINE(L, pb, 0) DOWN_COMBINE(L, pb, 1)
    LAYER(0, PH_LAYER0)
    LAYER(1, PH_LAYER1)
#ifdef PROBE_MASK
    if (blockIdx.x == 0) {
        const unsigned long long tend = __builtin_amdgcn_s_memrealtime();
        while (__builtin_amdgcn_s_memrealtime() - tend < (unsigned long long)PROBE_AMP * tacc) __builtin_amdgcn_s_sleep(8);
    }
#endif
#undef IN
#undef SEAM
}

extern "C" void kernel_launch(void* const* d_in, const int* in_sizes, int n_in, void* d_out, int out_size, void* d_ws, size_t ws_size, hipStream_t stream) {
    static int grid = 0;
    if (grid == 0) {
        if (n_in != 29 || in_sizes[0] != NLAT * D || out_size != NLAT * D || ws_size < WS_END) {
            fprintf(stderr, "kernel_launch: unexpected shapes / workspace (n_in %d, ws %zu, need %zu); nothing launched\n", n_in, ws_size, (size_t)WS_END); grid = -1; return; }
        int dev = 0, cus = 0, per_cu = 0;
        if (hipGetDevice(&dev) != hipSuccess || hipDeviceGetAttribute(&cus, hipDeviceAttributeMultiprocessorCount, dev) != hipSuccess) { grid = -1; return; }
        if (hipFuncSetAttribute((const void*)mk_fwd, hipFuncAttributeMaxDynamicSharedMemorySize, LDS_BYTES) != hipSuccess) { grid = -1; return; }
        if (hipOccupancyMaxActiveBlocksPerMultiprocessor(&per_cu, (const void*)mk_fwd, NTHREADS, LDS_BYTES) != hipSuccess || per_cu < 1) { fprintf(stderr, "kernel_launch: occupancy query says %d\n", per_cu); }
        (void)hipGetLastError();
        grid = cus;
    }
    if (grid < 0) return;
    (void)hipMemsetAsync((char*)d_ws + WS_CTL, 0, CTL_ZERO_BYTES, stream);
    P a{};
    for (int i = 0; i < 29; ++i) a.in[i] = (const float*)d_in[i];
    a.out = (float*)d_out; a.ws = (unsigned char*)d_ws;
#if MK_PER_PHASE
    for (int ph = 0; ph < NPHASES; ++ph) { a.ph_lo = ph; a.ph_hi = ph + 1; hipLaunchKernelGGL(mk_fwd, dim3(grid), dim3(NTHREADS), LDS_BYTES, stream, a); }
#else
    a.ph_lo = 0; a.ph_hi = NPHASES;
    hipLaunchKernelGGL(mk_fwd, dim3(grid), dim3(NTHREADS), LDS_BYTES, stream, a);
#endif
}
```

```cpp
#include <hip/hip_runtime.h>
#include <cstdio>
#include <cstdint>

#ifndef MK_PER_PHASE
#define MK_PER_PHASE 0
#endif

typedef unsigned short bf16_t;
typedef short bf16x8 __attribute__((ext_vector_type(8)));
typedef float f32x4 __attribute__((ext_vector_type(4)));
typedef unsigned u32x4 __attribute__((ext_vector_type(4)));
typedef unsigned u32x2 __attribute__((ext_vector_type(2)));
typedef float f32x16 __attribute__((ext_vector_type(16)));
typedef short v4i16_t __attribute__((ext_vector_type(4)));
#define LAS __attribute__((address_space(3)))

constexpr int D = 1024, BATCH = 16, SEQ = 2048, CTXL = 256;
constexpr int NLAT = BATCH * SEQ, NCTX = BATCH * CTXL, NTOK = NLAT + NCTX;
constexpr int ZC = 1792;
constexpr int Z_RQ = 512, Z_RK = 640, Z_RV = 768, Z_RG = 1024, Z_CQ = 1280, Z_CKV = 1536, Z_KR = 1664, Z_END = 1696;
constexpr int NEXP = 64, TOPK = 6, EDIM = 256;
constexpr float NORM_EPS = 1e-6f;
constexpr int NTHREADS = 512, NWAVES = 8;

constexpr size_t MiB = 1u << 20;
constexpr size_t WS_CTL = 0, CTL_ZERO_BYTES = 1 * MiB;
constexpr size_t WS_MODV = 1 * MiB;
constexpr size_t WS_ROPE = 2 * MiB;
constexpr size_t WS_WIN = 3 * MiB;
constexpr size_t WS_WUQ = 10 * MiB;
constexpr size_t WS_WUKV = 11 * MiB;
constexpr size_t WS_WOUT = 12 * MiB;
constexpr size_t WS_RT = 16 * MiB;
constexpr size_t WS_SHGU = 17 * MiB;
constexpr size_t WS_SHD = 19 * MiB;
constexpr size_t WS_EGU = 20 * MiB;
constexpr size_t WS_ED = 84 * MiB;
constexpr size_t WS_H = 132 * MiB;
constexpr size_t WS_H1 = 20 * MiB;
constexpr size_t WS_CC = WS_H;
constexpr size_t WS_R = 204 * MiB;
constexpr size_t WS_Z = WS_R;
constexpr size_t WS_Q = 330 * MiB;
constexpr size_t WS_K = 384 * MiB;
constexpr size_t WS_V = 438 * MiB;
constexpr size_t WS_KV = 474 * MiB;
constexpr size_t WS_X = 492 * MiB;
constexpr size_t WS_LTOK = 564 * MiB;
constexpr size_t WS_LW = 573 * MiB;
constexpr size_t WS_SS = 582 * MiB;
constexpr size_t WS_END = 584 * MiB;
constexpr size_t WS_Y = WS_Z;
constexpr size_t WS_SLOT = 132 * MiB;
constexpr size_t WS_ACT = 258 * MiB;
constexpr int LCAPH = 18432;
static_assert(WS_SLOT + (size_t)18432 * 7 * 1024 <= WS_ACT && WS_ACT + (size_t)1136 * 256 * 512 <= WS_V, "MoE buffers");

constexpr int CW_TMO = 0;
constexpr int CW_BAR = 4096;
constexpr int CW_ECNT = 8192;

constexpr int LDS_BYTES = 155648;
constexpr int MISC_OFF = LDS_BYTES - 256;
constexpr int RB0_OFF = 131072;
constexpr int RB1_OFF = 141312;
constexpr int ETAB_OFF = 151552;
constexpr int GEMM_LDS = 36864;
constexpr int ROWSS_OFF = 36864;
constexpr int LG_OFF = 37376;

#define XB_TMO      128
#define XB_XCNT(j)  (256  + 64 * (j))
#define XB_XSUB(j)  (1280 + 64 * (j))
#define XB_XGEN(j)  (2304 + 64 * (j))
#define XB_TOP      3328
#define XB_TOPGEN   3392
#define XCD_BAR_WORDS 3456
#define XB_SPIN_CAP (1u << 24)
__device__ __forceinline__ unsigned xb_ld(unsigned* p)              { return __hip_atomic_load(p, __ATOMIC_RELAXED, __HIP_MEMORY_SCOPE_AGENT); }
__device__ __forceinline__ unsigned xb_add(unsigned* p, unsigned v) { return __hip_atomic_fetch_add(p, v, __ATOMIC_RELAXED, __HIP_MEMORY_SCOPE_AGENT); }
__device__ __forceinline__ unsigned xb_xcc_id() { return (unsigned)__builtin_amdgcn_s_getreg((3 << 11) | 20) & 0xFu; }
#define XB_SPIN(cond, bar) do { unsigned _sp = 0; while (cond) { __builtin_amdgcn_s_sleep(1); \
    if ((++_sp & 255u) == 0u) { if (xb_ld(&(bar)[XB_TMO])) break; if (_sp > XB_SPIN_CAP) { atomicAdd(&(bar)[XB_TMO], 1u); break; } } } } while (0)
struct XcdBarrier { unsigned* bar; unsigned x; volatile LAS unsigned* st; };
__device__ __forceinline__ XcdBarrier xcd_barrier_post(unsigned* bar, volatile LAS unsigned* st) {
    XcdBarrier b; b.bar = bar; b.x = xb_xcc_id(); b.st = st;
    if (threadIdx.x == 0) (void)xb_add(&bar[XB_XCNT(b.x)], 1u);
    return b;
}
__device__ __forceinline__ void xcd_barrier_complete(unsigned* bar, unsigned x, unsigned& nloc, unsigned& nx) {
    const unsigned G = gridDim.x * gridDim.y * gridDim.z;
    unsigned sum, cnt, mine, sp = 0u;
    for (;;) {
        sum = 0u; cnt = 0u; mine = 0u;
#pragma unroll
        for (unsigned j = 0; j < 16; ++j) { const unsigned c = xb_ld(&bar[XB_XCNT(j)]); sum += c; cnt += (c > 0u) ? 1u : 0u; mine = (j == x) ? c : mine; }
        if (sum == G) break;
        __builtin_amdgcn_s_sleep(1);
        if ((++sp & 255u) == 0u) { if (xb_ld(&bar[XB_TMO])) break; if (sp > XB_SPIN_CAP) { atomicAdd(&bar[XB_TMO], 1u); break; } }
    }
    nloc = mine > 0u ? mine : 1u; nx = cnt > 0u ? cnt : 1u;
}
__device__ __forceinline__ void xcd_barrier(const XcdBarrier& b) {
    asm volatile("s_waitcnt vmcnt(0)" ::: "memory");
    __syncthreads();
    if (threadIdx.x == 0) {
        unsigned* bar = b.bar;
        __builtin_amdgcn_s_waitcnt(0);
        unsigned nloc = b.st[0], nx = b.st[1];
        if (nloc == 0u) { xcd_barrier_complete(bar, b.x, nloc, nx); b.st[0] = nloc; b.st[1] = nx; }
        const unsigned old = xb_add(&bar[XB_XSUB(b.x)], 1u);
        const unsigned gen = old / nloc;
        if (old + 1u == (gen + 1u) * nloc) {
            __builtin_amdgcn_fence(__ATOMIC_RELEASE, "agent");
            asm volatile("s_waitcnt vmcnt(0)" ::: "memory");
            const unsigned og = xb_add(&bar[XB_TOP], 1u);
            const unsigned tg = og / nx;
            if (og + 1u == (tg + 1u) * nx) xb_add(&bar[XB_TOPGEN], 1u);
            else XB_SPIN(xb_ld(&bar[XB_TOPGEN]) == tg, bar);
            __builtin_amdgcn_fence(__ATOMIC_ACQUIRE, "agent");
            xb_add(&bar[XB_XGEN(b.x)], 1u);
            asm volatile("s_waitcnt vmcnt(0)" ::: "memory");
        } else {
            XB_SPIN(xb_ld(&bar[XB_XGEN(b.x)]) == gen, bar);
            __builtin_amdgcn_fence(__ATOMIC_ACQUIRE, "agent");
            asm volatile("s_waitcnt vmcnt(0)" ::: "memory");
        }
    }
    __syncthreads();
}

__device__ __forceinline__ float bf2f(unsigned h) { return __uint_as_float(h << 16); }
__device__ __forceinline__ unsigned f2bf(float f) { unsigned u = __float_as_uint(f); return (u + 0x7fffu + ((u >> 16) & 1u)) >> 16; }
__device__ __forceinline__ unsigned pk2(float lo, float hi) { return f2bf(lo) | (f2bf(hi) << 16); }
typedef float f32x2_t __attribute__((ext_vector_type(2)));
typedef __bf16 bf16x2_t __attribute__((ext_vector_type(2)));
__device__ __forceinline__ unsigned cvtpk(float lo, float hi) { f32x2_t v = {lo, hi}; bf16x2_t b = __builtin_convertvector(v, bf16x2_t); return __builtin_bit_cast(unsigned, b); }
__device__ __forceinline__ float lo16(unsigned w) { return __uint_as_float(w << 16); }
__device__ __forceinline__ float hi16(unsigned w) { return __uint_as_float(w & 0xffff0000u); }
__device__ __forceinline__ float wave_sum(float v) {
#pragma unroll
    for (int o = 1; o < 64; o <<= 1) v += __shfl_xor(v, o);
    return v;
}
__device__ __forceinline__ float siluf(float v) { return v / (1.f + __expf(-v)); }
__device__ __forceinline__ int mod_row(int tok) { return tok < NLAT ? (tok >> 11) : 16; }

struct P { const float* in[29]; float* out; unsigned char* ws; int ph_lo, ph_hi; };

__device__ __forceinline__ bf16_t* x_row(const P& p, int tok) { return (bf16_t*)(p.ws + WS_X) + (size_t)tok * D; }
__device__ __forceinline__ const float* x_in_row(const P& p, int tok) {
    return tok < NLAT ? p.in[0] + (size_t)tok * D : p.in[2] + (size_t)(tok - NLAT) * D;
}

template <int MF, class RowSrc, class Epi>
__device__ __forceinline__ void gemm_tile(unsigned char* lds, const RowSrc& rs, const bf16_t* Bt, int ldb, int K, const Epi& epi) {
    constexpr int ROWS = 32 * MF, NPA = ROWS * 8;
    const int tid = threadIdx.x, lane = tid & 63, wid = tid >> 6, wr = wid >> 2, wc = wid & 3, fr = lane & 15, fq = lane >> 4;
    bf16_t* As = (bf16_t*)lds; bf16_t* Bs = As + ROWS * 72;
    const bf16_t* ap[3]; int al[3];
#pragma unroll
    for (int i = 0; i < 3; ++i) { const int id = tid + 512 * i, r = id >> 3, c = (id & 7) * 8; ap[i] = (id < NPA) ? rs(r) + c : nullptr; al[i] = r * 72 + c; }
    const int lr = tid >> 2, lc = (tid & 3) * 16;
    const bf16_t* bp = Bt + (size_t)lr * ldb + lc;
    u32x4 a[3], b0 = *(const u32x4*)bp, b1 = *(const u32x4*)(bp + 8);
#pragma unroll
    for (int i = 0; i < 3; ++i) if (ap[i]) a[i] = *(const u32x4*)ap[i];
    f32x4 acc[MF][2];
#pragma unroll
    for (int m = 0; m < MF; ++m)
#pragma unroll
        for (int n = 0; n < 2; ++n) acc[m][n] = (f32x4){0.f, 0.f, 0.f, 0.f};
    for (int k0 = 0; k0 < K; k0 += 64) {
        __syncthreads();
#pragma unroll
        for (int i = 0; i < 3; ++i) if (ap[i]) *(u32x4*)(As + al[i]) = a[i];
        *(u32x4*)(Bs + lr * 72 + lc) = b0; *(u32x4*)(Bs + lr * 72 + lc + 8) = b1;
        __syncthreads();
        if (k0 + 64 < K) {
#pragma unroll
            for (int i = 0; i < 3; ++i) if (ap[i]) { ap[i] += 64; a[i] = *(const u32x4*)ap[i]; }
            bp += 64; b0 = *(const u32x4*)bp; b1 = *(const u32x4*)(bp + 8);
        }
#pragma unroll
        for (int kk = 0; kk < 2; ++kk) {
            bf16x8 af[MF], bfr[2];
#pragma unroll
            for (int m = 0; m < MF; ++m) af[m] = *(const bf16x8*)(As + (wr * 16 * MF + m * 16 + fr) * 72 + kk * 32 + fq * 8);
#pragma unroll
            for (int n = 0; n < 2; ++n) bfr[n] = *(const bf16x8*)(Bs + (wc * 32 + n * 16 + fr) * 72 + kk * 32 + fq * 8);
#pragma unroll
            for (int m = 0; m < MF; ++m)
#pragma unroll
                for (int n = 0; n < 2; ++n) acc[m][n] = __builtin_amdgcn_mfma_f32_16x16x32_bf16(bfr[n], af[m], acc[m][n], 0, 0, 0);
        }
    }
#pragma unroll
    for (int m = 0; m < MF; ++m)
#pragma unroll
        for (int n = 0; n < 2; ++n) epi(wr * 16 * MF + m * 16 + fr, wc * 32 + n * 16 + 4 * fq, acc[m][n]);
}

namespace ge {
constexpr int BM = 256, BK = 64, HALF = 128, HTB = HALF * BK * 2;
__device__ __forceinline__ int lds_byte(int r, int c) { const int st = (r >> 4) * 2 + (c >> 5), rr = r & 15, cc = c & 31, ob = rr * 64 + cc * 2; return st * 1024 + (ob ^ (((ob >> 9) & 1) << 5)); }
__device__ __forceinline__ void stage_rc(int b, int& R, int& C) { const int st = b / 1024, sb = b % 1024, swz = sb ^ (((sb >> 9) & 1) << 5); R = (st >> 1) * 16 + swz / 64; C = (st & 1) * 32 + (swz % 64) / 2; }
struct Unit { const char* B; int a, b, c, d; };
typedef f32x4 Acc[2][2][4][2];

template <class Sched, class Epi, bool ALIGN_EPI>
__device__ __forceinline__ void gemm_stream(LAS unsigned char* lds, const char* Ab, int K, const Sched& S, const Epi& E) {
    const int tid = threadIdx.x, wid = __builtin_amdgcn_readfirstlane(tid >> 6), lane = tid & 63, wr = wid >> 2, wc = wid & 3, fr = lane & 15, fq = lane >> 4;
    const int nt = K / BK;
    int Rr[2], Cc[2]; unsigned voffB[2];
#pragma unroll
    for (int i = 0; i < 2; ++i) { stage_rc(tid * 16 + i * 8192, Rr[i], Cc[i]);
        const int rho = Rr[i] & 31, Rb = (Rr[i] & ~31) + 8 * ((rho & 15) >> 2) + 4 * (rho >> 4) + (rho & 3);
        voffB[i] = (unsigned)(Rb * K + Cc[i]) * 2u; }
    const size_t kstep = (size_t)(BK * 2), hstepB = (size_t)HALF * K * 2;
    const unsigned ldsw = (unsigned)wid * 1024u;
    const int aoff = lds_byte(wr * 64 + fr, fq * 8), boff = lds_byte(wc * 32 + fr, fq * 8);
#define GE_SA(b, h) (((b) * 2 + (h)) * HTB)
#define GE_SB(b, h) ((4 + (b) * 2 + (h)) * HTB)
#define GE_GLDS(gp, ldsoff) __builtin_amdgcn_global_load_lds((const unsigned*)(gp), (LAS unsigned*)(lds + (ldsoff)), 16, 0, 0)
#define GE_STAGE_B(bufoff, gbase) do { GE_GLDS((const char*)(gbase) + voffB[0], (bufoff) + ldsw); GE_GLDS((const char*)(gbase) + voffB[1], (bufoff) + ldsw + 8192); } while (0)
#define GE_STAGE_A(bufoff, kbytes, o0, o1) do { GE_GLDS(Ab + (kbytes) + (o0), (bufoff) + ldsw); GE_GLDS(Ab + (kbytes) + (o1), (bufoff) + ldsw + 8192); } while (0)
#define GE_LDA(dst, b, h) do { _Pragma("unroll") for (int m = 0; m < 4; ++m) _Pragma("unroll") for (int k = 0; k < 2; ++k) dst[m][k] = *(const LAS bf16x8*)(lds + GE_SA(b, h) + aoff + m * 2048 + k * 1024); } while (0)
#define GE_LDB(dst, b, h) do { _Pragma("unroll") for (int n = 0; n < 2; ++n) _Pragma("unroll") for (int k = 0; k < 2; ++k) dst[n][k] = *(const LAS bf16x8*)(lds + GE_SB(b, h) + boff + n * 2048 + k * 1024); } while (0)
#define GE_MMA(ai, bj, At, Bt) do { __builtin_amdgcn_s_setprio(1); _Pragma("unroll") for (int m = 0; m < 4; ++m) _Pragma("unroll") for (int n = 0; n < 2; ++n) _Pragma("unroll") for (int k = 0; k < 2; ++k) \
        acc[ai][bj][m][n] = __builtin_amdgcn_mfma_f32_16x16x32_bf16(Bt[n][k], At[m][k], acc[ai][bj][m][n], 0, 0, 0); __builtin_amdgcn_s_setprio(0); } while (0)
#define GE_WAIT_V(n) asm volatile("s_waitcnt vmcnt(" #n ")" ::: "memory")
#define GE_WAIT_L(n) asm volatile("s_waitcnt lgkmcnt(" #n ")" ::: "memory")
#define GE_BAR __builtin_amdgcn_s_barrier()
#define GE_SCHED __builtin_amdgcn_sched_barrier(0)
    Unit cur, nxt; int ui = 0;
    if (!S.next(0, cur)) return;
    Acc acc;
#pragma unroll
    for (int a = 0; a < 2; ++a)
#pragma unroll
        for (int b = 0; b < 2; ++b)
#pragma unroll
            for (int m = 0; m < 4; ++m)
#pragma unroll
                for (int n = 0; n < 2; ++n) acc[a][b][m][n] = (f32x4){0.f, 0.f, 0.f, 0.f};
    bf16x8 At[4][2], B0[2][2], B1[2][2];
    unsigned oc00, oc01, oc10, oc11, on00, on01, on10, on11;
    oc00 = S.aoff(0, cur, Rr[0]) + (unsigned)Cc[0] * 2u; oc01 = S.aoff(0, cur, Rr[1]) + (unsigned)Cc[1] * 2u;
    oc10 = S.aoff(0, cur, Rr[0] + 128) + (unsigned)Cc[0] * 2u; oc11 = S.aoff(0, cur, Rr[1] + 128) + (unsigned)Cc[1] * 2u;
    const char* cB = cur.B;
    GE_STAGE_B(GE_SB(0, 0), cB); GE_STAGE_B(GE_SB(0, 1), cB + hstepB); GE_STAGE_A(GE_SA(0, 0), 0, oc00, oc01); GE_STAGE_A(GE_SA(0, 1), 0, oc10, oc11);
    if (wr == 1) GE_BAR;
    GE_WAIT_V(2); GE_BAR;
    GE_STAGE_B(GE_SB(1, 0), cB + kstep); GE_STAGE_A(GE_SA(1, 0), kstep, oc00, oc01); GE_STAGE_B(GE_SB(1, 1), cB + hstepB + kstep);
    GE_WAIT_V(6); GE_BAR;
    for (;;) {
        const bool has_next = S.next(ui + 1, nxt);
        const char* nB = has_next ? nxt.B : cB;
        if (has_next) {
            on00 = S.aoff(ui + 1, nxt, Rr[0]) + (unsigned)Cc[0] * 2u; on01 = S.aoff(ui + 1, nxt, Rr[1]) + (unsigned)Cc[1] * 2u;
            on10 = S.aoff(ui + 1, nxt, Rr[0] + 128) + (unsigned)Cc[0] * 2u; on11 = S.aoff(ui + 1, nxt, Rr[1] + 128) + (unsigned)Cc[1] * 2u;
        } else { on00 = oc00; on01 = oc01; on10 = oc10; on11 = oc11; }
#pragma unroll 1
        for (int t = 0; t < nt; t += 2) {
            const bool last = (t == nt - 2);
            const size_t k1 = (size_t)(t + 1) * kstep;
            const size_t k2 = last ? 0 : (size_t)(t + 2) * kstep, k3 = k2 + kstep;
            const char* b2 = last ? nB : cB + (size_t)(t + 2) * kstep; const char* b3 = b2 + kstep;
            const unsigned o00 = last ? on00 : oc00, o01 = last ? on01 : oc01, o10 = last ? on10 : oc10, o11 = last ? on11 : oc11;
            GE_LDB(B0, 0, 0); GE_LDB(B1, 0, 1); GE_SCHED; GE_LDA(At, 0, 0); GE_STAGE_A(GE_SA(1, 1), k1, oc10, oc11);
            GE_WAIT_V(8); GE_WAIT_L(0); GE_BAR; GE_MMA(0, 0, At, B0); GE_MMA(0, 1, At, B1); GE_BAR; GE_SCHED;
            GE_LDA(At, 0, 1); GE_STAGE_B(GE_SB(0, 0), b2); GE_STAGE_B(GE_SB(0, 1), b2 + hstepB); GE_STAGE_A(GE_SA(0, 0), k2, o00, o01);
            GE_WAIT_V(8); GE_WAIT_L(0); GE_BAR; GE_MMA(1, 0, At, B0); GE_MMA(1, 1, At, B1); GE_BAR; GE_SCHED;
            GE_LDB(B0, 1, 0); GE_LDB(B1, 1, 1); GE_SCHED; GE_LDA(At, 1, 0); GE_STAGE_A(GE_SA(0, 1), k2, o10, o11);
            GE_WAIT_V(8); GE_WAIT_L(0); GE_BAR; GE_MMA(0, 0, At, B0); GE_MMA(0, 1, At, B1); GE_BAR; GE_SCHED;
            GE_LDA(At, 1, 1); GE_STAGE_B(GE_SB(1, 0), b3); GE_STAGE_B(GE_SB(1, 1), b3 + hstepB); GE_STAGE_A(GE_SA(1, 0), k3, o00, o01);
            GE_WAIT_V(8); GE_WAIT_L(0); GE_BAR; GE_MMA(1, 0, At, B0); GE_MMA(1, 1, At, B1); GE_BAR; GE_SCHED;
        }
        if constexpr (ALIGN_EPI) { if (wr == 0) GE_BAR; }
        E(acc, cur, wr, wc, fr, fq);
        if (!has_next) break;
#pragma unroll
        for (int a = 0; a < 2; ++a)
#pragma unroll
            for (int b = 0; b < 2; ++b)
#pragma unroll
                for (int m = 0; m < 4; ++m)
#pragma unroll
                    for (int n = 0; n < 2; ++n) acc[a][b][m][n] = (f32x4){0.f, 0.f, 0.f, 0.f};
        cur = nxt; cB = nB; ++ui; oc00 = on00; oc01 = on01; oc10 = on10; oc11 = on11;
        if constexpr (ALIGN_EPI) { if (wr == 1) GE_BAR; }
    }
    GE_WAIT_V(0);
    if constexpr (!ALIGN_EPI) { if (wr == 0) GE_BAR; }
    GE_BAR;
#undef GE_SA
#undef GE_SB
#undef GE_GLDS
#undef GE_STAGE_A
#undef GE_STAGE_B
#undef GE_LDA
#undef GE_LDB
#undef GE_MMA
#undef GE_WAIT_V
#undef GE_WAIT_L
#undef GE_BAR
#undef GE_SCHED
}
template <class F> struct EpiFn {
    F f;
    __device__ __forceinline__ void operator()(const Acc& acc, const Unit& u, int wr, int wc, int fr, int fq) const {
#pragma unroll
        for (int ai = 0; ai < 2; ++ai)
#pragma unroll
            for (int m = 0; m < 4; ++m)
#pragma unroll
                for (int bj = 0; bj < 2; ++bj) f(u, ai * 128 + wr * 64 + m * 16 + fr, bj * 128 + wc * 32 + 8 * fq, acc[ai][bj][m][0], acc[ai][bj][m][1]);
    }
};
struct DenseOrder {
    int nM, nN, nwg, G, c; const char* Bt; size_t btile; unsigned arow;
    __device__ __forceinline__ bool next(int i, Unit& u) const {
        const long L = (long)i * G + c; if (L >= nwg) return false;
        int wgid = (int)L; { const int q = nwg / 8, r = nwg % 8, xcd = wgid % 8, off = wgid / 8; wgid = (xcd < r ? xcd * (q + 1) : r * (q + 1) + (xcd - r) * q) + off; }
        const int nig = 8 * nN, gid = wgid / nig, fm = gid * 8, gsz = (nM - fm) < 8 ? (nM - fm) : 8;
        u.a = fm + ((wgid % nig) % gsz); u.b = (wgid % nig) / gsz; u.c = 0; u.d = 0; u.B = Bt + (size_t)u.b * btile; return true;
    }
    __device__ __forceinline__ unsigned aoff(int, const Unit& u, int R) const { return (unsigned)(u.a * 256 + R) * arow; }
};
}

struct TMap { const float* s0; const float* s1; int ld; int nvalid; const float* ksc; float gsc; };
template <int MODE> __device__ __forceinline__ const float* tmap_src(const float* s0, const float* s1, int nvalid, int n) {
    if (MODE == 0) return n < nvalid ? s0 + n : nullptr;
    if (MODE == 1) { const int h = n / 96, j = n % 96; const int c = j < 64 ? j : 64 + ((j - 64) & 1) * 16 + ((j - 64) >> 1); return s0 + h * 96 + c; }
    return ((n & 1) ? s1 : s0) + (n >> 1);
}
template <int MODE> __device__ __forceinline__ void transpose_unit(float* scr, const float* s0, const float* s1, int ld, int nvalid, const float* ksc, float gsc, int K, bf16_t* dst, int kb, int nb, int kvalid = 1 << 30) {
    const int tid = threadIdx.x, k0 = kb * 64, n0 = nb * 64;
    const int nn = tid & 63; const float* sp = tmap_src<MODE>(s0, s1, nvalid, n0 + nn);
#pragma unroll
    for (int i = 0; i < 8; ++i) {
        const int kk = (tid >> 6) + 8 * i; float v = (sp && k0 + kk < kvalid) ? sp[(size_t)(k0 + kk) * ld] : 0.f;
        if (ksc && k0 + kk < kvalid) v *= ksc[k0 + kk];
        scr[kk * 65 + nn] = v * gsc;
    }
    __syncthreads();
    {
        const int n2 = tid >> 3, kc = tid & 7; const float* s = scr + (kc * 8) * 65 + n2;
        u32x4 o; o.x = pk2(s[0], s[65]); o.y = pk2(s[2 * 65], s[3 * 65]); o.z = pk2(s[4 * 65], s[5 * 65]); o.w = pk2(s[6 * 65], s[7 * 65]);
        *(u32x4*)(dst + (size_t)(n0 + n2) * K + k0 + kc * 8) = o;
    }
    __syncthreads();
}
template <int MODE> __device__ __forceinline__ void transpose_matrix(float* scr, const float* s0, const float* s1, int ld, int nvalid, const float* ksc, float gsc, int K, int Nd, bf16_t* dst, int& rot, int kvalid = 1 << 30) {
    const int nkb = K / 64, nnb = Nd / 64, nu = nkb * nnb, G = gridDim.x;
    int first = ((int)blockIdx.x - rot) % G; if (first < 0) first += G;
    for (int u = first; u < nu; u += G) transpose_unit<MODE>(scr, s0, s1, ld, nvalid, ksc, gsc, K, dst, u / nnb, u % nnb, kvalid);
    rot = (rot + nu) % G;
}
__device__ __forceinline__ void convert_expert_weights(unsigned char* lds, const P& p, int L) {
    float* scr = (float*)lds; const int G = gridDim.x, tid = threadIdx.x;
    constexpr int S = 261;
    bf16_t* egu = (bf16_t*)(p.ws + WS_EGU); bf16_t* ed = (bf16_t*)(p.ws + WS_ED);
    for (int ub = blockIdx.x; ub < NEXP * 48; ub += G) {
        const int e = ub / 48, r = (ub % 48) * 4;
        bf16_t* dst; int K, k0;
        if (r < 128) {
            const int kb = r >> 3, nb0 = r & 7; k0 = kb * 64; K = D; dst = egu + ((size_t)e * 512 + nb0 * 64) * D;
            const float* gsrc = p.in[22] + ((size_t)L * NEXP + e) * D * EDIM + nb0 * 32; const float* usrc = p.in[23] + ((size_t)L * NEXP + e) * D * EDIM + nb0 * 32;
            f32x4 v[8];
#pragma unroll
            for (int i = 0; i < 8; ++i) { const int idx = tid + 512 * i, kk = idx >> 6, c = idx & 63; v[i] = *(const f32x4*)((c < 32 ? gsrc : usrc) + (size_t)(k0 + kk) * EDIM + (c & 31) * 4); }
#pragma unroll
            for (int i = 0; i < 8; ++i) { const int idx = tid + 512 * i, kk = idx >> 6, c = idx & 63; float* d = scr + kk * S + 8 * (c & 31) + (c >> 5);
                d[0] = v[i].x; d[2] = v[i].y; d[4] = v[i].z; d[6] = v[i].w; }
        } else {
            const int r2 = r - 128, kb = r2 >> 4, nb0 = r2 & 15; k0 = kb * 64; K = EDIM; dst = ed + ((size_t)e * D + nb0 * 64) * EDIM;
            const float* src = p.in[24] + ((size_t)L * NEXP + e) * EDIM * D + nb0 * 64;
            f32x4 v[8];
#pragma unroll
            for (int i = 0; i < 8; ++i) { const int idx = tid + 512 * i, kk = idx >> 6, c = idx & 63; v[i] = *(const f32x4*)(src + (size_t)(k0 + kk) * D + c * 4); }
#pragma unroll
            for (int i = 0; i < 8; ++i) { const int idx = tid + 512 * i, kk = idx >> 6, c = idx & 63; float* d = scr + kk * S + 4 * c;
                d[0] = v[i].x; d[1] = v[i].y; d[2] = v[i].z; d[3] = v[i].w; }
        }
        __syncthreads();
#pragma unroll
        for (int i = 0; i < 4; ++i) {
            const int id = tid + 512 * i, n = id >> 3, kc = id & 7; const float* sp = scr + (kc * 8) * S + n;
            u32x4 o; o.x = cvtpk(sp[0], sp[S]); o.y = cvtpk(sp[2 * S], sp[3 * S]); o.z = cvtpk(sp[4 * S], sp[5 * S]); o.w = cvtpk(sp[6 * S], sp[7 * S]);
            *(u32x4*)(dst + (size_t)n * K + k0 + kc * 8) = o;
        }
        __syncthreads();
    }
}
__device__ __forceinline__ void prep_mod_unit(unsigned char* lds, const P& p, int u) {
    float* sc = (float*)lds;
    float* part = sc + 17 * 1024;
    const int tid = threadIdx.x;
    const float* c = p.in[1]; const float* cctx = p.in[3];
    for (int i = tid; i < 17 * 1024; i += NTHREADS) { const int r = i >> 10, k = i & 1023; const float v = r < 16 ? c[r * 1024 + k] : cctx[k]; sc[i] = v / (1.f + expf(-v)); }
    __syncthreads();
    const int L = u / 192, cg = u % 192, ks = tid >> 5, cl = tid & 31, col = cg * 32 + cl;
    const float* w = p.in[4] + (size_t)L * 1024 * 6144 + (size_t)(ks * 64) * 6144 + col;
    float acc[17];
#pragma unroll
    for (int r = 0; r < 17; ++r) acc[r] = 0.f;
#pragma unroll 8
    for (int k = 0; k < 64; ++k) {
        const float wv = w[(size_t)k * 6144];
#pragma unroll
        for (int r = 0; r < 17; ++r) acc[r] += sc[r * 1024 + ks * 64 + k] * wv;
    }
#pragma unroll
    for (int r = 0; r < 17; ++r) part[(ks * 17 + r) * 32 + cl] = acc[r];
    __syncthreads();
    float* modv = (float*)(p.ws + WS_MODV);
    for (int i = tid; i < 17 * 32; i += NTHREADS) {
        const int r = i >> 5, c2 = i & 31;
        float s2 = p.in[5][L * 6144 + cg * 32 + c2];
#pragma unroll
        for (int q = 0; q < 16; ++q) s2 += part[(q * 17 + r) * 32 + c2];
        modv[((size_t)L * 17 + r) * 6144 + cg * 32 + c2] = s2;
    }
    __syncthreads();
}
__device__ __forceinline__ void phase_prep(unsigned char* lds, const P& p) {
    const int tid = threadIdx.x, G = gridDim.x, bid = blockIdx.x;
    {
        float* ct = (float*)(p.ws + WS_ROPE); float* st = ct + 2048 * 16;
        for (int i = bid * NTHREADS + tid; i < 2048 * 16; i += G * NTHREADS) {
            const int pos = i >> 4, f = i & 15;
            const float inv = powf(10000.f, -(float)(f & 7) / 8.f);
            const float ang = (float)(f < 8 ? (pos >> 6) : (pos & 63)) * inv;
            ct[i] = cosf(ang); st[i] = sinf(ang);
        }
    }
    for (int u = G - 1 - bid; u < 384; u += G) prep_mod_unit(lds, p, u);
    float* scr = (float*)lds; int rot = 0;
    for (int L = 0; L < 2; ++L) {
        transpose_matrix<0>(scr, p.in[7] + (size_t)L * D * Z_END, nullptr, Z_END, Z_END, nullptr, 1.f, D, ZC, (bf16_t*)(p.ws + WS_WIN) + (size_t)L * ZC * D, rot);
        transpose_matrix<1>(scr, p.in[15] + (size_t)L * 256 * 768, nullptr, 768, 768, p.in[14] + L * 256, 0.14724574f, 256, 768, (bf16_t*)(p.ws + WS_WUQ) + (size_t)L * 768 * 256, rot);
        transpose_matrix<0>(scr, p.in[17] + (size_t)L * 128 * 1024, nullptr, 1024, 1024, p.in[16] + L * 128, 1.f, 256, 1024, (bf16_t*)(p.ws + WS_WUKV) + (size_t)L * 1024 * 256, rot, 128);
        transpose_matrix<0>(scr, p.in[18] + (size_t)L * D * D, nullptr, D, D, nullptr, 1.f, D, D, (bf16_t*)(p.ws + WS_WOUT) + (size_t)L * D * D, rot);
        transpose_matrix<0>(scr, p.in[20] + (size_t)L * D * NEXP, nullptr, NEXP, NEXP, nullptr, 1.f, D, 128, (bf16_t*)(p.ws + WS_RT) + (size_t)L * 128 * D, rot);
        transpose_matrix<2>(scr, p.in[25] + (size_t)L * D * EDIM, p.in[26] + (size_t)L * D * EDIM, EDIM, 512, nullptr, 1.f, D, 512, (bf16_t*)(p.ws + WS_SHGU) + (size_t)L * 512 * D, rot);
        transpose_matrix<0>(scr, p.in[27] + (size_t)L * EDIM * D, nullptr, D, D, nullptr, 1.f, EDIM, D, (bf16_t*)(p.ws + WS_SHD) + (size_t)L * D * EDIM, rot);
    }
}

__device__ __forceinline__ void phase_norm_mod(const P& p, int L, int which  , int ntok) {
    const int tid = threadIdx.x, lane = tid & 63, wave = tid >> 6, gw = blockIdx.x * NWAVES + wave, NGW = gridDim.x * NWAVES;
    const float* nw = (which == 0 ? p.in[6] : p.in[19]) + L * D;
    const float* modv = (const float*)(p.ws + WS_MODV) + (size_t)L * 17 * 6144;
    bf16_t* H = (bf16_t*)(p.ws + WS_H);
    for (int tok = gw; tok < ntok; tok += NGW) {
        const f32x4* xr = (const f32x4*)x_in_row(p, tok) + lane;
        const float* mrow = modv + (size_t)mod_row(tok) * 6144 + which * 3072;
        f32x4 v[4]; float s = 0.f;
#pragma unroll
        for (int j = 0; j < 4; ++j) { v[j] = xr[64 * j]; s += v[j].x * v[j].x + v[j].y * v[j].y + v[j].z * v[j].z + v[j].w * v[j].w; }
        const float rstd = rsqrtf(wave_sum(s) * (1.f / D) + NORM_EPS);
        u32x2* o = (u32x2*)(H + (size_t)tok * D) + lane;
#pragma unroll
        for (int j = 0; j < 4; ++j) {
            const int k = 4 * lane + 256 * j;
            const f32x4 w4 = *(const f32x4*)(nw + k), sh = *(const f32x4*)(mrow + k), sc = *(const f32x4*)(mrow + 1024 + k);
            const float y0 = v[j].x * rstd * w4.x * (1.f + sc.x) + sh.x, y1 = v[j].y * rstd * w4.y * (1.f + sc.y) + sh.y;
            const float y2 = v[j].z * rstd * w4.z * (1.f + sc.z) + sh.z, y3 = v[j].w * rstd * w4.w * (1.f + sc.w) + sh.w;
            u32x2 w; w.x = pk2(y0, y1); w.y = pk2(y2, y3); o[64 * j] = w;
        }
    }
}

struct EpiZ {
    bf16_t* Z; float* ssq; float* sskv; bf16_t* Kb; const float* ct; const float* st;
    __device__ __forceinline__ void operator()(const ge::Acc& acc, const ge::Unit& u, int wr, int wc, int fr, int fq) const {
#pragma unroll
        for (int ai = 0; ai < 2; ++ai)
#pragma unroll
            for (int m = 0; m < 4; ++m) {
                const int row = u.a * 256 + ai * 128 + wr * 64 + m * 16 + fr;
#pragma unroll
                for (int bj = 0; bj < 2; ++bj) {
                    const f32x4 v0 = acc[ai][bj][m][0], v1 = acc[ai][bj][m][1];
                    u32x4 w; w.x = cvtpk(v0.x, v0.y); w.y = cvtpk(v0.z, v0.w); w.z = cvtpk(v1.x, v1.y); w.w = cvtpk(v1.z, v1.w);
                    *(u32x4*)(Z + (size_t)row * ZC + u.b * 256 + bj * 128 + wc * 32 + 8 * fq) = w;
                }
                if (u.b == 5) {
                    float sq = 0.f;
#pragma unroll
                    for (int bj = 0; bj < 2; ++bj)
#pragma unroll
                        for (int n = 0; n < 2; ++n) { const f32x4 v = acc[ai][bj][m][n]; sq += v.x * v.x + v.y * v.y + v.z * v.z + v.w * v.w; }
                    sq += __shfl_xor(sq, 16); sq += __shfl_xor(sq, 32);
                    if (fq == 0) ssq[(size_t)row * 4 + wc] = sq;
                }
                if (u.b == 6) {
                    float sq = 0.f;
#pragma unroll
                    for (int n = 0; n < 2; ++n) { const f32x4 v = acc[ai][0][m][n]; sq += v.x * v.x + v.y * v.y + v.z * v.z + v.w * v.w; }
                    sq += __shfl_xor(sq, 16); sq += __shfl_xor(sq, 32);
                    if (fq == 0) sskv[(size_t)row * 4 + wc] = sq;
                    if (wc == 0) {
                        const f32x4 a0 = acc[ai][1][m][0], a1 = acc[ai][1][m][1];
                        f32x4 b0, b1;
#pragma unroll
                        for (int j = 0; j < 4; ++j) { b0[j] = __shfl_xor(a0[j], 32); b1[j] = __shfl_xor(a1[j], 32); }
                        if (fq < 2) {
                            f32x4 c0 = (f32x4){1.f, 1.f, 1.f, 1.f}, c1 = c0, s0 = (f32x4){0.f, 0.f, 0.f, 0.f}, s1 = s0;
                            if (row < NLAT) { const int pos = row & (SEQ - 1); c0 = *(const f32x4*)(ct + pos * 16 + 8 * fq); c1 = *(const f32x4*)(ct + pos * 16 + 8 * fq + 4); s0 = *(const f32x4*)(st + pos * 16 + 8 * fq); s1 = *(const f32x4*)(st + pos * 16 + 8 * fq + 4); }
                            const f32x4 o10 = a0 * c0 - b0 * s0, o20 = a0 * s0 + b0 * c0, o11 = a1 * c1 - b1 * s1, o21 = a1 * s1 + b1 * c1;
                            u32x4 w0, w1; w0.x = cvtpk(o10.x, o20.x); w0.y = cvtpk(o10.y, o20.y); w0.z = cvtpk(o10.z, o20.z); w0.w = cvtpk(o10.w, o20.w);
                            w1.x = cvtpk(o11.x, o21.x); w1.y = cvtpk(o11.y, o21.y); w1.z = cvtpk(o11.z, o21.z); w1.w = cvtpk(o11.w, o21.w);
#pragma unroll
                            for (int h = 0; h < 8; ++h) { bf16_t* kp = Kb + (size_t)row * 768 + h * 96 + 64 + 16 * fq; *(u32x4*)kp = w0; *(u32x4*)(kp + 8) = w1; }
                        }
                    }
                }
            }
    }
};
__device__ __forceinline__ void phase_zgemm(unsigned char* lds, const P& p, int L) {
    const bf16_t* W = (const bf16_t*)(p.ws + WS_WIN) + (size_t)L * ZC * D;
    ge::DenseOrder S; S.nM = NTOK / 256; S.nN = ZC / 256; S.nwg = S.nM * S.nN; S.G = gridDim.x; S.c = blockIdx.x; S.Bt = (const char*)W; S.btile = (size_t)256 * D * 2; S.arow = D * 2;
    EpiZ E{(bf16_t*)(p.ws + WS_Z), (float*)(p.ws + WS_SS), (float*)(p.ws + WS_SS) + (size_t)NTOK * 4, (bf16_t*)(p.ws + WS_K), (const float*)(p.ws + WS_ROPE), (const float*)(p.ws + WS_ROPE) + 2048 * 16};
    ge::gemm_stream<ge::DenseOrder, EpiZ, true>((LAS unsigned char*)lds, (const char*)(p.ws + (L == 0 ? WS_H : WS_H1)), D, S, E);
}

__device__ __forceinline__ void conv_unit(unsigned char* lds, const P& p, int L, int s, int tt) {
    float* hg = (float*)lds;
    const int tid = threadIdx.x, lane = tid & 63, wave = tid >> 6;
    const int rb = s < 16 ? s * SEQ : NLAT + (s - 16) * CTXL, len = s < 16 ? SEQ : CTXL, t0 = tt * 64;
    const bf16_t* Z = (const bf16_t*)(p.ws + WS_Z);
    for (int i = tid; i < 94 * 64; i += NTHREADS) {
        const int jj = i >> 6, c4 = (i & 63) * 4, t = t0 - 15 + jj;
        f32x4 h = (f32x4){0.f, 0.f, 0.f, 0.f};
        if (t >= 0 && t < len) {
            const bf16_t* zr = Z + (size_t)(rb + t) * ZC;
            const u32x2 a = *(const u32x2*)(zr + c4), g = *(const u32x2*)(zr + 256 + c4);
            const float g0 = lo16(g.x), g1 = hi16(g.x), g2 = lo16(g.y), g3 = hi16(g.y);
            h.x = lo16(a.x) / (1.f + __expf(-g0)); h.y = hi16(a.x) / (1.f + __expf(-g1));
            h.z = lo16(a.y) / (1.f + __expf(-g2)); h.w = hi16(a.y) / (1.f + __expf(-g3));
        }
        *(f32x4*)(hg + jj * 256 + c4) = h;
    }
    float* wl = hg + 94 * 256;
    for (int i = tid; i < 31 * 64; i += NTHREADS) *(f32x4*)(wl + i * 4) = *(const f32x4*)(p.in[8] + (size_t)L * 31 * 256 + i * 4);
    __syncthreads();
    const int c0 = lane * 4;
    const f32x4 cb = *(const f32x4*)(p.in[9] + L * 256 + c0), lw = *(const f32x4*)(p.in[10] + L * 256 + c0), lb = *(const f32x4*)(p.in[11] + L * 256 + c0);
    bf16_t* CC = (bf16_t*)(p.ws + WS_CC);
    for (int q = 0; q < 8; ++q) {
        const int tl = wave * 8 + q;
        f32x4 acc = cb;
#pragma unroll 4
        for (int j = 0; j < 31; ++j) { const f32x4 h = *(const f32x4*)(hg + (tl + j) * 256 + c0); acc += h * *(const f32x4*)(wl + j * 256 + c0); }
        const float mean = wave_sum(acc.x + acc.y + acc.z + acc.w) * (1.f / 256.f);
        const f32x4 d = acc - mean;
        const float var = wave_sum(d.x * d.x + d.y * d.y + d.z * d.z + d.w * d.w) * (1.f / 256.f);
        const float rstd = rsqrtf(var + NORM_EPS);
        const f32x4 y = d * rstd * lw + lb;
        u32x2 o; o.x = pk2(siluf(y.x), siluf(y.y)); o.y = pk2(siluf(y.z), siluf(y.w));
        *(u32x2*)(CC + (size_t)(rb + t0 + tl) * D + c0) = o;
    }
    __syncthreads();
}

__device__ __forceinline__ float log2_gamma(const P& p, int L, int dir, int h) {
    const float x = p.in[12][(L * 2 + dir) * 4 + h];
    const float ls = fminf(x, 0.f) - log1pf(expf(-fabsf(x)));
    return ls * 1.4426950408889634f;
}
__device__ __forceinline__ void load_ret_qk(float* dst, const P& p, int gc, int h, int zoff, float scale) {
    const int tid = threadIdx.x, j = tid >> 2, i0 = (tid & 3) * 4, row = gc * 128 + j;
    const bf16_t* zr = (const bf16_t*)(p.ws + WS_Z) + (size_t)row * ZC + zoff + h * 32;
    const u32x2 a = *(const u32x2*)(zr + i0), b = *(const u32x2*)(zr + 16 + i0);
    float x1[4] = {lo16(a.x), hi16(a.x), lo16(a.y), hi16(a.y)}, x2[4] = {lo16(b.x), hi16(b.x), lo16(b.y), hi16(b.y)};
    const bool lat = row < NLAT; const int pos = row & (SEQ - 1);
    const float* ct = (const float*)(p.ws + WS_ROPE) + pos * 16 + i0; const float* st = ct + 2048 * 16;
#pragma unroll
    for (int i = 0; i < 4; ++i) {
        const float c = lat ? ct[i] : 1.f, s = lat ? st[i] : 0.f;
        dst[j * 33 + i0 + i] = (x1[i] * c - x2[i] * s) * scale;
        dst[j * 33 + 16 + i0 + i] = (x1[i] * s + x2[i] * c) * scale;
    }
}
__device__ __forceinline__ void load_ret_v(float* dst  , const P& p, int gc, int h) {
    const int tid = threadIdx.x, j = tid >> 2, e0 = (tid & 3) * 16;
    const bf16_t* zr = (const bf16_t*)(p.ws + WS_Z) + (size_t)(gc * 128 + j) * ZC + Z_RV + h * 64 + e0;
    const u32x4 a = *(const u32x4*)zr, b = *(const u32x4*)(zr + 8);
#pragma unroll
    for (int i = 0; i < 4; ++i) { dst[j * 64 + e0 + 2 * i] = lo16(a[i]); dst[j * 64 + e0 + 2 * i + 1] = hi16(a[i]); dst[j * 64 + e0 + 8 + 2 * i] = lo16(b[i]); dst[j * 64 + e0 + 8 + 2 * i + 1] = hi16(b[i]); }
}
__device__ __forceinline__ void retkv_unit(unsigned char* lds, const P& p, int L, int gc, int h) {
    float* ks = (float*)lds; float* vs = ks + 128 * 33; float* wf = vs + 128 * 64; float* wb = wf + 128;
    const int tid = threadIdx.x;
    const float l2f = log2_gamma(p, L, 0, h), l2b = log2_gamma(p, L, 1, h);
    load_ret_qk(ks, p, gc, h, Z_RK, 0.17677669529663687f);
    load_ret_v(vs, p, gc, h);
    if (tid < 128) { wf[tid] = exp2f(l2f * (float)(127 - tid)); wb[tid] = exp2f(l2b * (float)tid); }
    __syncthreads();
    const int d = tid >> 4, e0 = (tid & 15) * 4;
    f32x4 af = (f32x4){0.f, 0.f, 0.f, 0.f}, ab = af;
    for (int j = 0; j < 128; ++j) {
        const float kd = ks[j * 33 + d]; const f32x4 v4 = *(const f32x4*)(vs + j * 64 + e0);
        af += (kd * wf[j]) * v4; ab += (kd * wb[j]) * v4;
    }
    float* KV = (float*)(p.ws + WS_KV) + ((size_t)(gc * 4 + h) * 2) * 2048;
    *(f32x4*)(KV + d * 64 + e0) = af; *(f32x4*)(KV + 2048 + d * 64 + e0) = ab;
    __syncthreads();
}
__device__ __forceinline__ void ret_stage_k(unsigned char* kf, unsigned char* kb, int rowb, const P& p, int gc, int h, float ef, float jf0, float eb, float jb0) {
    const int tid = threadIdx.x, j = tid >> 2, i0 = (tid & 3) * 4, row = gc * 128 + j;
    const bf16_t* zr = (const bf16_t*)(p.ws + WS_Z) + (size_t)row * ZC + Z_RK + h * 32;
    const u32x2 a = *(const u32x2*)(zr + i0), b = *(const u32x2*)(zr + 16 + i0);
    const float x1[4] = {lo16(a.x), hi16(a.x), lo16(a.y), hi16(a.y)}, x2[4] = {lo16(b.x), hi16(b.x), lo16(b.y), hi16(b.y)};
    f32x4 c4 = (f32x4){1.f, 1.f, 1.f, 1.f}, s4 = (f32x4){0.f, 0.f, 0.f, 0.f};
    if (row < NLAT) { const int pos = row & (SEQ - 1); const float* ct = (const float*)(p.ws + WS_ROPE) + pos * 16 + i0; c4 = *(const f32x4*)ct; s4 = *(const f32x4*)(ct + 2048 * 16); }
    const float wf = exp2f(ef * ((float)j - jf0)) * 0.17677669529663687f, wb = exp2f(eb * ((float)j - jb0)) * 0.17677669529663687f;
    float o1[4], o2[4];
#pragma unroll
    for (int i = 0; i < 4; ++i) { o1[i] = x1[i] * c4[i] - x2[i] * s4[i]; o2[i] = x1[i] * s4[i] + x2[i] * c4[i]; }
    u32x2 w;
    w.x = cvtpk(o1[0] * wf, o1[1] * wf); w.y = cvtpk(o1[2] * wf, o1[3] * wf); *(u32x2*)(kf + j * rowb + i0 * 2) = w;
    w.x = cvtpk(o2[0] * wf, o2[1] * wf); w.y = cvtpk(o2[2] * wf, o2[3] * wf); *(u32x2*)(kf + j * rowb + 32 + i0 * 2) = w;
    w.x = cvtpk(o1[0] * wb, o1[1] * wb); w.y = cvtpk(o1[2] * wb, o1[3] * wb); *(u32x2*)(kb + j * rowb + i0 * 2) = w;
    w.x = cvtpk(o2[0] * wb, o2[1] * wb); w.y = cvtpk(o2[2] * wb, o2[3] * wb); *(u32x2*)(kb + j * rowb + 32 + i0 * 2) = w;
}
__device__ __forceinline__ void ret_stage_v(unsigned char* vt, const P& p, int gc, int h) {
    const int tid = threadIdx.x, j = tid >> 2, e0 = (tid & 3) * 16;
    const bf16_t* zr = (const bf16_t*)(p.ws + WS_Z) + (size_t)(gc * 128 + j) * ZC + Z_RV + h * 64 + e0;
    const u32x4 a = *(const u32x4*)zr, b = *(const u32x4*)(zr + 8);
    unsigned char* d = vt + (e0 >> 5) * 8192 + j * 64 + (e0 & 31) * 2;
    *(u32x4*)d = a; *(u32x4*)(d + 16) = b;
}
__device__ __forceinline__ bf16x8 tr8(const unsigned char* p0, const unsigned char* p1) {
    const v4i16_t a = __builtin_amdgcn_ds_read_tr16_b64_v4i16((LAS v4i16_t*)(const LAS unsigned char*)p0), b = __builtin_amdgcn_ds_read_tr16_b64_v4i16((LAS v4i16_t*)(const LAS unsigned char*)p1);
    return (bf16x8){a[0], a[1], a[2], a[3], b[0], b[1], b[2], b[3]};
}
__device__ __forceinline__ void retkv_unit_mfma(unsigned char* lds, const P& p, int L, int gc, int h) {
    const int tid = threadIdx.x, lane = tid & 63, wid = tid >> 6;
    const float l2f = log2_gamma(p, L, 0, h), l2b = log2_gamma(p, L, 1, h);
    ret_stage_k(lds, lds + 8192, 64, p, gc, h, -l2f, 127.f, l2b, 0.f);
    ret_stage_v(lds + 16384, p, gc, h);
    __syncthreads();
    if (wid < 4) {
        const int dir = wid >> 1, eb = wid & 1, g = lane >> 4, i = lane & 15, hh = lane >> 5;
        const int off = (8 * hh + (i >> 2)) * 64 + (g & 1) * 32 + (i & 3) * 8;
        const unsigned char* Kt = lds + dir * 8192 + off; const unsigned char* Vt = lds + 16384 + eb * 8192 + off;
        f32x16 acc;
#pragma unroll
        for (int r = 0; r < 16; ++r) acc[r] = 0.f;
#pragma unroll
        for (int s = 0; s < 8; ++s) acc = __builtin_amdgcn_mfma_f32_32x32x16_bf16(tr8(Vt + s * 1024, Vt + s * 1024 + 256), tr8(Kt + s * 1024, Kt + s * 1024 + 256), acc, 0, 0, 0);
        float* KV = (float*)(p.ws + WS_KV) + ((size_t)(gc * 4 + h) * 2 + dir) * 2048 + (lane & 31) * 64 + eb * 32 + 4 * hh;
#pragma unroll
        for (int r4 = 0; r4 < 4; ++r4) *(f32x4*)(KV + 8 * r4) = (f32x4){acc[4 * r4], acc[4 * r4 + 1], acc[4 * r4 + 2], acc[4 * r4 + 3]};
    }
    __syncthreads();
}
__device__ __forceinline__ void retout_unit_mfma(unsigned char* lds, const P& p, int L, int gc, int h) {
    constexpr int KROW = 80, O_KF = 0, O_KB = 10240, O_V = 20480, O_SF = 36864, O_SB = 41984, O_RED = 47104;
    const int tid = threadIdx.x, lane = tid & 63, wid = tid >> 6, r32 = lane & 31, hh = lane >> 5;
    const float l2f = log2_gamma(p, L, 0, h), l2b = log2_gamma(p, L, 1, h);
    ret_stage_k(lds + O_KF, lds + O_KB, KROW, p, gc, h, -l2f, 0.f, l2b, 0.f);
    ret_stage_v(lds + O_V, p, gc, h);
    {
        const bool lat = gc < 256; const int b = lat ? gc >> 4 : (gc - 256) >> 1;
        const int mme = lat ? 2 + (gc & 15) : (gc - 256) & 1;
        const int u = mme, w = mme < 2 ? 1 - mme : 19 - mme;
        f32x4 sf = (f32x4){0.f, 0.f, 0.f, 0.f}, sb = sf;
        const float* KVb = (const float*)(p.ws + WS_KV);
#pragma unroll 1
        for (int mm = 0; mm < 18; ++mm) {
            const int gcm = mm < 2 ? 256 + b * 2 + mm : b * 16 + (mm - 2);
            const int um = mm, wm = mm < 2 ? 1 - mm : 19 - mm;
            const float* kv = KVb + ((size_t)(gcm * 4 + h) * 2) * 2048 + tid * 4;
            if (um < u) { const float wgt = exp2f(l2f * 128.f * (float)(u - 1 - um)); sf += wgt * *(const f32x4*)kv; }
            if (wm < w) { const float wgt = exp2f(l2b * 128.f * (float)(w - 1 - wm)); sb += wgt * *(const f32x4*)(kv + 2048); }
        }
        const int d = tid >> 4, e0 = (tid & 15) * 4;
#pragma unroll
        for (int k = 0; k < 4; ++k) { *(bf16_t*)(lds + O_SF + (e0 + k) * KROW + d * 2) = (bf16_t)(cvtpk(sf[k], 0.f) & 0xffffu); *(bf16_t*)(lds + O_SB + (e0 + k) * KROW + d * 2) = (bf16_t)(cvtpk(sb[k], 0.f) & 0xffffu); }
    }
    __syncthreads();
    const int qb = wid & 3, eb = wid >> 2, i = qb * 32 + r32, row = gc * 128 + i;
    bf16x8 qf[2];
    {
        const bf16_t* zr = (const bf16_t*)(p.ws + WS_Z) + (size_t)row * ZC + Z_RQ + h * 32 + 8 * hh;
        const u32x4 a = *(const u32x4*)zr, b = *(const u32x4*)(zr + 16);
        float x1[8], x2[8];
#pragma unroll
        for (int k = 0; k < 4; ++k) { x1[2 * k] = lo16(a[k]); x1[2 * k + 1] = hi16(a[k]); x2[2 * k] = lo16(b[k]); x2[2 * k + 1] = hi16(b[k]); }
        if (row < NLAT) {
            const float* ct = (const float*)(p.ws + WS_ROPE) + (row & (SEQ - 1)) * 16 + 8 * hh; const float* st = ct + 2048 * 16;
#pragma unroll
            for (int k = 0; k < 8; ++k) { const float c = ct[k], sn = st[k], u1 = x1[k], u2 = x2[k]; x1[k] = u1 * c - u2 * sn; x2[k] = u1 * sn + u2 * c; }
        }
        const u32x4 q0 = (u32x4){cvtpk(x1[0], x1[1]), cvtpk(x1[2], x1[3]), cvtpk(x1[4], x1[5]), cvtpk(x1[6], x1[7])};
        const u32x4 q1 = (u32x4){cvtpk(x2[0], x2[1]), cvtpk(x2[2], x2[3]), cvtpk(x2[4], x2[5]), cvtpk(x2[6], x2[7])};
        qf[0] = __builtin_bit_cast(bf16x8, q0); qf[1] = __builtin_bit_cast(bf16x8, q1);
    }
    const float af = exp2f(l2f * (float)i), ab = exp2f(-l2b * (float)i), cf = exp2f(l2f * (float)(i + 1)), cb = exp2f(l2b * (float)(128 - i));
    f32x16 y, zero;
#pragma unroll
    for (int r = 0; r < 16; ++r) { y[r] = 0.f; zero[r] = 0.f; }
    const int koff = r32 * KROW + 16 * hh;
    const int voff = O_V + eb * 8192 + (4 * hh + ((lane & 15) >> 2)) * 64 + ((lane >> 4) & 1) * 32 + (lane & 3) * 8;
#pragma unroll
    for (int kb = 0; kb < 4; ++kb) {
        f32x16 pt;
        if (kb <= qb) {
            f32x16 sF = __builtin_amdgcn_mfma_f32_32x32x16_bf16(*(const bf16x8*)(lds + O_KF + kb * 32 * KROW + koff), qf[0], zero, 0, 0, 0);
            sF = __builtin_amdgcn_mfma_f32_32x32x16_bf16(*(const bf16x8*)(lds + O_KF + kb * 32 * KROW + koff + 32), qf[1], sF, 0, 0, 0);
            if (kb < qb) {
#pragma unroll
                for (int r = 0; r < 16; ++r) pt[r] = sF[r] * af;
            } else {
#pragma unroll
                for (int r = 0; r < 16; ++r) { const int j = (r & 3) + 8 * (r >> 2) + 4 * hh; pt[r] = (j <= r32) ? sF[r] * af : 0.f; }
            }
        }
        if (kb >= qb) {
            f32x16 sB = __builtin_amdgcn_mfma_f32_32x32x16_bf16(*(const bf16x8*)(lds + O_KB + kb * 32 * KROW + koff), qf[0], zero, 0, 0, 0);
            sB = __builtin_amdgcn_mfma_f32_32x32x16_bf16(*(const bf16x8*)(lds + O_KB + kb * 32 * KROW + koff + 32), qf[1], sB, 0, 0, 0);
            if (kb > qb) {
#pragma unroll
                for (int r = 0; r < 16; ++r) pt[r] = sB[r] * ab;
            } else {
#pragma unroll
                for (int r = 0; r < 16; ++r) { const int j = (r & 3) + 8 * (r >> 2) + 4 * hh; pt[r] += (j >= r32) ? sB[r] * ab : 0.f; }
            }
        }
#pragma unroll
        for (int s2 = 0; s2 < 2; ++s2) {
            const u32x4 pw = (u32x4){cvtpk(pt[8 * s2], pt[8 * s2 + 1]), cvtpk(pt[8 * s2 + 2], pt[8 * s2 + 3]), cvtpk(pt[8 * s2 + 4], pt[8 * s2 + 5]), cvtpk(pt[8 * s2 + 6], pt[8 * s2 + 7])};
            const unsigned char* vb = lds + voff + (kb * 32 + s2 * 16) * 64;
            y = __builtin_amdgcn_mfma_f32_32x32x16_bf16(tr8(vb, vb + 8 * 64), __builtin_bit_cast(bf16x8, pw), y, 0, 0, 0);
        }
    }
    {
        const int soff = (eb * 32 + r32) * KROW + 16 * hh;
        f32x16 tF = __builtin_amdgcn_mfma_f32_32x32x16_bf16(*(const bf16x8*)(lds + O_SF + soff), qf[0], zero, 0, 0, 0);
        tF = __builtin_amdgcn_mfma_f32_32x32x16_bf16(*(const bf16x8*)(lds + O_SF + soff + 32), qf[1], tF, 0, 0, 0);
        f32x16 tB = __builtin_amdgcn_mfma_f32_32x32x16_bf16(*(const bf16x8*)(lds + O_SB + soff), qf[0], zero, 0, 0, 0);
        tB = __builtin_amdgcn_mfma_f32_32x32x16_bf16(*(const bf16x8*)(lds + O_SB + soff + 32), qf[1], tB, 0, 0, 0);
#pragma unroll
        for (int r = 0; r < 16; ++r) y[r] += tF[r] * cf + tB[r] * cb;
    }
    float s1 = 0.f, s2 = 0.f;
#pragma unroll
    for (int r = 0; r < 16; ++r) { s1 += y[r]; s2 += y[r] * y[r]; }
    s1 += __shfl_xor(s1, 32); s2 += __shfl_xor(s2, 32);
    float* red = (float*)(lds + O_RED);
    if (hh == 0) { red[(eb * 128 + i) * 2] = s1; red[(eb * 128 + i) * 2 + 1] = s2; }
    __syncthreads();
    s1 = red[i * 2] + red[(128 + i) * 2]; s2 = red[i * 2 + 1] + red[(128 + i) * 2 + 1];
    const float mu = s1 * (1.f / 64.f), var = fmaxf(s2 * (1.f / 64.f) - mu * mu, 0.f), rstd = rsqrtf(var + NORM_EPS);
    const bf16_t* zg = (const bf16_t*)(p.ws + WS_Z) + (size_t)row * ZC + Z_RG + h * 64 + eb * 32 + 4 * hh;
    const float* gw = p.in[13] + L * 256 + h * 64 + eb * 32 + 4 * hh;
    bf16_t* orow = (bf16_t*)(p.ws + WS_CC) + (size_t)row * D + 256 + h * 64 + eb * 32 + 4 * hh;
#pragma unroll
    for (int r4 = 0; r4 < 4; ++r4) {
        const u32x2 gz = *(const u32x2*)(zg + 8 * r4); const f32x4 w4 = *(const f32x4*)(gw + 8 * r4);
        const float g0 = lo16(gz.x), g1 = hi16(gz.x), g2 = lo16(gz.y), g3 = hi16(gz.y);
        u32x2 o; o.x = cvtpk(siluf(g0) * ((y[4 * r4] - mu) * rstd * w4.x), siluf(g1) * ((y[4 * r4 + 1] - mu) * rstd * w4.y));
        o.y = cvtpk(siluf(g2) * ((y[4 * r4 + 2] - mu) * rstd * w4.z), siluf(g3) * ((y[4 * r4 + 3] - mu) * rstd * w4.w));
        *(u32x2*)(orow + 8 * r4) = o;
    }
    __syncthreads();
}
__device__ __forceinline__ void qkv_proj(unsigned char* lds, const P& p, int L) {
    const float* sskv = (const float*)(p.ws + WS_SS) + (size_t)NTOK * 4;
    const int G = gridDim.x, bid = blockIdx.x;
    {
        bf16_t* Q = (bf16_t*)(p.ws + WS_Q);
        ge::DenseOrder S; S.nM = NTOK / 256; S.nN = 3; S.nwg = S.nM * 3; S.G = G; S.c = bid; S.Bt = (const char*)((const bf16_t*)(p.ws + WS_WUQ) + (size_t)L * 768 * 256); S.btile = (size_t)256 * 256 * 2; S.arow = ZC * 2;
        auto f = [&](const ge::Unit& u, int r, int c, f32x4 v0, f32x4 v1) {
            u32x4 w; w.x = cvtpk(v0.x, v0.y); w.y = cvtpk(v0.z, v0.w); w.z = cvtpk(v1.x, v1.y); w.w = cvtpk(v1.z, v1.w); *(u32x4*)(Q + (size_t)(u.a * 256 + r) * 768 + u.b * 256 + c) = w;
        };
        ge::EpiFn<decltype(f)> E{f};
        ge::gemm_stream<ge::DenseOrder, ge::EpiFn<decltype(f)>, true>((LAS unsigned char*)lds, (const char*)(p.ws + WS_Z) + Z_CQ * 2, 256, S, E);
    }
    {
        bf16_t* Kb = (bf16_t*)(p.ws + WS_K); bf16_t* Vb = (bf16_t*)(p.ws + WS_V);
        ge::DenseOrder S; S.nM = NTOK / 256; S.nN = 4; S.nwg = S.nM * 4; S.G = G; S.c = (bid + 176) % G; S.Bt = (const char*)((const bf16_t*)(p.ws + WS_WUKV) + (size_t)L * 1024 * 256); S.btile = (size_t)256 * 256 * 2; S.arow = ZC * 2;
        struct EpiKV {
            bf16_t* Kb; bf16_t* Vb; const float* sskv;
            __device__ __forceinline__ void operator()(const ge::Acc& acc, const ge::Unit& u, int wr, int wc, int fr, int fq) const {
                float rstd[2][4];
#pragma unroll
                for (int ai = 0; ai < 2; ++ai)
#pragma unroll
                    for (int m = 0; m < 4; ++m) { const f32x4 s4 = *(const f32x4*)(sskv + (size_t)(u.a * 256 + ai * 128 + wr * 64 + m * 16 + fr) * 4); rstd[ai][m] = rsqrtf((s4.x + s4.y + s4.z + s4.w) * (1.f / 128.f) + NORM_EPS); }
#pragma unroll
                for (int ai = 0; ai < 2; ++ai)
#pragma unroll
                    for (int m = 0; m < 4; ++m) {
                        const int row = u.a * 256 + ai * 128 + wr * 64 + m * 16 + fr;
#pragma unroll
                        for (int bj = 0; bj < 2; ++bj) {
                            const int col = u.b * 256 + bj * 128 + wc * 32 + 8 * fq, h = col >> 7, j = col & 127;
                            const f32x4 v0 = acc[ai][bj][m][0] * rstd[ai][m], v1 = acc[ai][bj][m][1] * rstd[ai][m];
                            u32x4 w; w.x = cvtpk(v0.x, v0.y); w.y = cvtpk(v0.z, v0.w); w.z = cvtpk(v1.x, v1.y); w.w = cvtpk(v1.z, v1.w);
                            if (j < 64) *(u32x4*)(Kb + (size_t)row * 768 + h * 96 + j) = w;
                            else *(u32x4*)(Vb + (size_t)row * 512 + h * 64 + (j - 64)) = w;
                        }
                    }
            }
        };
        EpiKV E{Kb, Vb, sskv};
        ge::gemm_stream<ge::DenseOrder, EpiKV, true>((LAS unsigned char*)lds, (const char*)(p.ws + WS_Z) + Z_CKV * 2, 256, S, E);
    }
}
__device__ __forceinline__ void phase_b(unsigned char* lds, const P& p, int L) {
    const int G = gridDim.x, bid = blockIdx.x;
    qkv_proj(lds, p, L);
    const int nconv = (L == 0) ? 576 : 512;
    const int nkv = 288 * 4;
    const int total = nconv + nkv;
    for (int u = (bid + 96) % G; u < total; u += G) {
        int r = u;
        if (r < nconv) { if (r < 512) conv_unit(lds, p, L, r >> 5, r & 31); else conv_unit(lds, p, L, 16 + ((r - 512) >> 2), (r - 512) & 3); continue; } r -= nconv;
        retkv_unit_mfma(lds, p, L, r >> 2, r & 3);
    }
    if (L == 1) convert_expert_weights(lds, p, 1);
}

__device__ __forceinline__ void attn_unit_naive(unsigned char* lds, const P& p, int b, int h, int qb, bool ctxq) {
    float* Ks = (float*)lds;
    float* Vs = Ks + 64 * 96;
    const int tid = threadIdx.x, half = tid & 1, qi = tid >> 1;
    const bf16_t* Qb = (const bf16_t*)(p.ws + WS_Q); const bf16_t* Kb = (const bf16_t*)(p.ws + WS_K); const bf16_t* Vb = (const bf16_t*)(p.ws + WS_V);
    const int qrow = ctxq ? NLAT + b * CTXL + qi : b * SEQ + qb * 256 + qi;
    float q[48];
    {
        const u32x4* qp = (const u32x4*)(Qb + (size_t)qrow * 768 + h * 96 + half * 48);
#pragma unroll
        for (int i = 0; i < 6; ++i) { const u32x4 w = qp[i];
#pragma unroll
            for (int k = 0; k < 4; ++k) { q[i * 8 + 2 * k] = lo16(w[k]); q[i * 8 + 2 * k + 1] = hi16(w[k]); } }
    }
    float o[32];
#pragma unroll
    for (int e = 0; e < 32; ++e) o[e] = 0.f;
    float m = -1e30f, l = 0.f;
    const int ntiles = ctxq ? 4 : 36;
#pragma unroll 1
    for (int t = 0; t < ntiles; ++t) {
        const int krow0 = t < 4 ? NLAT + b * CTXL + t * 64 : b * SEQ + (t - 4) * 64;
        __syncthreads();
        for (int i = tid; i < 64 * 12; i += NTHREADS) { const int key = i / 12, c = i % 12; const u32x4 w = *(const u32x4*)(Kb + (size_t)(krow0 + key) * 768 + h * 96 + c * 8);
            float* d = Ks + key * 96 + c * 8;
#pragma unroll
            for (int k = 0; k < 4; ++k) { d[2 * k] = lo16(w[k]); d[2 * k + 1] = hi16(w[k]); } }
        for (int i = tid; i < 64 * 8; i += NTHREADS) { const int key = i >> 3, c = i & 7; const u32x4 w = *(const u32x4*)(Vb + (size_t)(krow0 + key) * 512 + h * 64 + c * 8);
            float* d = Vs + key * 64 + c * 8;
#pragma unroll
            for (int k = 0; k < 4; ++k) { d[2 * k] = lo16(w[k]); d[2 * k + 1] = hi16(w[k]); } }
        __syncthreads();
#pragma unroll 1
        for (int j0 = 0; j0 < 64; j0 += 2) {
            float s[2]; float mt = -1e30f;
#pragma unroll
            for (int jj = 0; jj < 2; ++jj) {
                const f32x4* kr = (const f32x4*)(Ks + (j0 + jj) * 96 + half * 48);
                float a = 0.f;
#pragma unroll
                for (int d4 = 0; d4 < 12; ++d4) { const f32x4 kv = kr[d4]; a += q[4 * d4] * kv.x + q[4 * d4 + 1] * kv.y + q[4 * d4 + 2] * kv.z + q[4 * d4 + 3] * kv.w; }
                a += __shfl_xor(a, 1);
                s[jj] = a; mt = fmaxf(mt, a);
            }
            const float mn = fmaxf(m, mt), alpha = exp2f(m - mn);
            m = mn; l *= alpha;
#pragma unroll
            for (int e = 0; e < 32; ++e) o[e] *= alpha;
#pragma unroll
            for (int jj = 0; jj < 2; ++jj) {
                const float pj = exp2f(s[jj] - mn); l += pj;
                const f32x4* vr = (const f32x4*)(Vs + (j0 + jj) * 64 + half * 32);
#pragma unroll
                for (int e4 = 0; e4 < 8; ++e4) { const f32x4 vv = vr[e4]; o[4 * e4] += pj * vv.x; o[4 * e4 + 1] += pj * vv.y; o[4 * e4 + 2] += pj * vv.z; o[4 * e4 + 3] += pj * vv.w; }
            }
        }
    }
    {
        const float rl = 1.f / l;
        u32x4* op = (u32x4*)((bf16_t*)(p.ws + WS_CC) + (size_t)qrow * D + 512 + h * 64 + half * 32);
#pragma unroll
        for (int i = 0; i < 4; ++i) { u32x4 w; w.x = pk2(o[8 * i] * rl, o[8 * i + 1] * rl); w.y = pk2(o[8 * i + 2] * rl, o[8 * i + 3] * rl); w.z = pk2(o[8 * i + 4] * rl, o[8 * i + 5] * rl); w.w = pk2(o[8 * i + 6] * rl, o[8 * i + 7] * rl); op[i] = w; }
    }
    __syncthreads();
}
__device__ __forceinline__ float max3f(float a, float b, float c) { float r; asm("v_max3_f32 %0, %1, %2, %3" : "=v"(r) : "v"(a), "v"(b), "v"(c)); return r; }
constexpr int AT_KROW = 208;
constexpr int AT_KBUF = 64 * AT_KROW;
constexpr int AT_VBUF = 8192;
constexpr int AT_BUF = AT_KBUF + AT_VBUF;
__device__ __forceinline__ void attn_unit_mfma(unsigned char* lds, const P& p, int b, int h, int qb, bool ctxq) {
    const int tid = threadIdx.x, lane = tid & 63, wid = tid >> 6, r32 = lane & 31, hh = lane >> 5;
    const bf16_t* Qb = (const bf16_t*)(p.ws + WS_Q); const bf16_t* Kb = (const bf16_t*)(p.ws + WS_K); const bf16_t* Vb = (const bf16_t*)(p.ws + WS_V);
    const int qrow = (ctxq ? NLAT + b * CTXL : b * SEQ + qb * 256) + wid * 32 + r32;
    bf16x8 qf[6];
    {
        const f32x4 s4 = *(const f32x4*)((const float*)(p.ws + WS_SS) + (size_t)qrow * 4);
        const float rstd = rsqrtf((s4.x + s4.y + s4.z + s4.w) * (1.f / 256.f) + NORM_EPS);
        const float* ct = (const float*)(p.ws + WS_ROPE) + (qrow & (SEQ - 1)) * 16; const float* st = ct + 2048 * 16;
#pragma unroll
        for (int s = 0; s < 6; ++s) {
            const u32x4 w = *(const u32x4*)(Qb + (size_t)qrow * 768 + h * 96 + 16 * s + 8 * hh);
            float x[8];
#pragma unroll
            for (int k = 0; k < 4; ++k) { x[2 * k] = lo16(w[k]) * rstd; x[2 * k + 1] = hi16(w[k]) * rstd; }
            if (s >= 4 && !ctxq) {
                const f32x4 c4 = *(const f32x4*)(ct + 8 * (s - 4) + 4 * hh), sn = *(const f32x4*)(st + 8 * (s - 4) + 4 * hh);
#pragma unroll
                for (int k = 0; k < 4; ++k) { const float a = x[2 * k], b2 = x[2 * k + 1]; x[2 * k] = a * c4[k] - b2 * sn[k]; x[2 * k + 1] = a * sn[k] + b2 * c4[k]; }
            }
            const u32x4 o = (u32x4){cvtpk(x[0], x[1]), cvtpk(x[2], x[3]), cvtpk(x[4], x[5]), cvtpk(x[6], x[7])};
            qf[s] = __builtin_bit_cast(bf16x8, o);
        }
    }
    f32x16 o0, o1, negm;
#pragma unroll
    for (int r = 0; r < 16; ++r) { o0[r] = 0.f; o1[r] = 0.f; negm[r] = 0.f; }
    asm volatile("" : "+v"(negm));
    float mhat = 0.f, l = 0.f;
    const int ntiles = ctxq ? 4 : 36;
    const int wv = __builtin_amdgcn_readfirstlane(wid);
    const int ia = wv, ib = (wv + 8 < 13) ? wv + 8 : 12;
    const int qa = ia * 64 + lane, qb2 = ib * 64 + lane, qv = wv * 64 + lane;
    const int ca = qa % 13, cb = qb2 % 13;
    const size_t ka = (size_t)(qa / 13) * 768 + h * 96 + (ca < 12 ? ca : 11) * 8, kbo = (size_t)(qb2 / 13) * 768 + h * 96 + (cb < 12 ? cb : 11) * 8;
    const size_t vo = (size_t)((qv >> 2) & 63) * 512 + h * 64 + (qv >> 8) * 32 + (qv & 3) * 8;
    auto krow0 = [&](int t) { return t < 4 ? NLAT + b * CTXL + t * 64 : b * SEQ + (t - 4) * 64; };
    const unsigned lds0 = (unsigned)(uintptr_t)lds;
#define AT_GLDS(gp, ldsoff) do { unsigned keep_; asm volatile("s_mov_b32 %0, m0\n\ts_mov_b32 m0, %2\n\ts_nop 0\n\tglobal_load_lds_dwordx4 %1, off\n\ts_mov_b32 m0, %0" : "=&s"(keep_) : "v"(gp), "s"((unsigned)__builtin_amdgcn_readfirstlane(lds0 + (unsigned)(ldsoff))) : "memory"); } while (0)
#define AT_ISSUE(t2, slot) do { const int kr_ = krow0(t2); const bf16_t* kb_ = Kb + (size_t)kr_ * 768; const bf16_t* vb_ = Vb + (size_t)kr_ * 512; \
        AT_GLDS(kb_ + ka, (slot) + ia * 1024); AT_GLDS(kb_ + kbo, (slot) + ib * 1024); AT_GLDS(vb_ + vo, (slot) + AT_KBUF + wv * 1024); } while (0)
    __builtin_amdgcn_s_barrier();
    AT_ISSUE(0, 0);
    if (ntiles > 1) AT_ISSUE(1, AT_BUF);
    const int koff = r32 * AT_KROW + 16 * hh;
    const int voff = AT_KBUF + (4 * hh + ((lane & 15) >> 2)) * 64 + ((lane >> 4) & 1) * 32 + (lane & 3) * 8;
    int slot_c = 0, slot_n = 2 * AT_BUF;
#pragma unroll 1
    for (int t = 0; t < ntiles; ++t) {
        if (t + 1 < ntiles) asm volatile("s_waitcnt vmcnt(3)" ::: "memory"); else asm volatile("s_waitcnt vmcnt(0)" ::: "memory");
        __builtin_amdgcn_s_barrier();
        asm volatile("" ::: "memory");
        if (t + 2 < ntiles) AT_ISSUE(t + 2, slot_n);
        unsigned char* buf = lds + slot_c;
        slot_n = slot_c; slot_c = (slot_c == 2 * AT_BUF) ? 0 : slot_c + AT_BUF;
        f32x16 p0, p1;
        {
            const bf16x8 k0f = *(const bf16x8*)(buf + koff), k1f = *(const bf16x8*)(buf + koff + 32 * AT_KROW);
            p0 = __builtin_amdgcn_mfma_f32_32x32x16_bf16(k0f, qf[0], negm, 0, 0, 0);
            p1 = __builtin_amdgcn_mfma_f32_32x32x16_bf16(k1f, qf[0], negm, 0, 0, 0);
        }
#pragma unroll
        for (int s = 1; s < 6; ++s) {
            const bf16x8 k0f = *(const bf16x8*)(buf + koff + 32 * s), k1f = *(const bf16x8*)(buf + koff + 32 * AT_KROW + 32 * s);
            p0 = __builtin_amdgcn_mfma_f32_32x32x16_bf16(k0f, qf[s], p0, 0, 0, 0);
            p1 = __builtin_amdgcn_mfma_f32_32x32x16_bf16(k1f, qf[s], p1, 0, 0, 0);
        }
        asm volatile("s_nop 15\n\ts_nop 7" : "+v"(p0), "+v"(p1));
        float rma = max3f(p0[0], p0[1], p1[0]), rmb = max3f(p0[2], p0[3], p1[1]);
        rma = max3f(rma, p1[2], p1[3]);
#pragma unroll
        for (int r = 4; r < 16; r += 4) { rma = max3f(rma, p0[r], p0[r + 1]); rmb = max3f(rmb, p0[r + 2], p0[r + 3]); rma = max3f(rma, p1[r], p1[r + 1]); rmb = max3f(rmb, p1[r + 2], p1[r + 3]); }
        float rm = fmaxf(rma, rmb);
        rm = fmaxf(rm, __shfl_xor(rm, 32));
        if (__any(rm > 8.f)) {
            const float dl = fmaxf(rm, 0.f), f = __builtin_amdgcn_exp2f(-dl);
            mhat += dl; l *= f;
#pragma unroll
            for (int r = 0; r < 16; ++r) { p0[r] -= dl; p1[r] -= dl; o0[r] *= f; o1[r] *= f; negm[r] = -mhat; }
            asm volatile("" : "+v"(negm));
        }
        float ls = 0.f;
#pragma unroll
        for (int r = 0; r < 16; ++r) { p0[r] = __builtin_amdgcn_exp2f(p0[r]); p1[r] = __builtin_amdgcn_exp2f(p1[r]); ls += p0[r] + p1[r]; }
        l += ls;
        u32x4 pw[4];
#pragma unroll
        for (int s2 = 0; s2 < 2; ++s2) {
            pw[s2] = (u32x4){cvtpk(p0[8 * s2], p0[8 * s2 + 1]), cvtpk(p0[8 * s2 + 2], p0[8 * s2 + 3]), cvtpk(p0[8 * s2 + 4], p0[8 * s2 + 5]), cvtpk(p0[8 * s2 + 6], p0[8 * s2 + 7])};
            pw[2 + s2] = (u32x4){cvtpk(p1[8 * s2], p1[8 * s2 + 1]), cvtpk(p1[8 * s2 + 2], p1[8 * s2 + 3]), cvtpk(p1[8 * s2 + 4], p1[8 * s2 + 5]), cvtpk(p1[8 * s2 + 6], p1[8 * s2 + 7])};
        }
#pragma unroll
        for (int ks = 0; ks < 4; ++ks) {
            const unsigned char* vb = buf + voff + ks * 16 * 64;
            const bf16x8 pf = __builtin_bit_cast(bf16x8, pw[ks]);
            o0 = __builtin_amdgcn_mfma_f32_32x32x16_bf16(tr8(vb, vb + 8 * 64), pf, o0, 0, 0, 0);
            o1 = __builtin_amdgcn_mfma_f32_32x32x16_bf16(tr8(vb + 4096, vb + 4096 + 8 * 64), pf, o1, 0, 0, 0);
        }
    }
#undef AT_GLDS
#undef AT_ISSUE
    l += __shfl_xor(l, 32);
    const float rl = 1.f / l;
    bf16_t* orow = (bf16_t*)(p.ws + WS_CC) + (size_t)qrow * D + 512 + h * 64 + 4 * hh;
#pragma unroll
    for (int r4 = 0; r4 < 4; ++r4) {
        u32x2 w0; w0.x = cvtpk(o0[4 * r4] * rl, o0[4 * r4 + 1] * rl); w0.y = cvtpk(o0[4 * r4 + 2] * rl, o0[4 * r4 + 3] * rl);
        u32x2 w1; w1.x = cvtpk(o1[4 * r4] * rl, o1[4 * r4 + 1] * rl); w1.y = cvtpk(o1[4 * r4 + 2] * rl, o1[4 * r4 + 3] * rl);
        *(u32x2*)(orow + 8 * r4) = w0; *(u32x2*)(orow + 32 + 8 * r4) = w1;
    }
}
__device__ __forceinline__ void retout_unit(unsigned char* lds, const P& p, int L, int gc, int h) {
    float* qs = (float*)lds; float* ks = qs + 128 * 33; float* vs = ks + 128 * 33; float* Sf = vs + 128 * 64; float* Sb = Sf + 2048;
    const int tid = threadIdx.x;
    const float l2f = log2_gamma(p, L, 0, h), l2b = log2_gamma(p, L, 1, h);
    load_ret_qk(qs, p, gc, h, Z_RQ, 1.f);
    load_ret_qk(ks, p, gc, h, Z_RK, 0.17677669529663687f);
    load_ret_v(vs, p, gc, h);
    {
        const bool lat = gc < 256; const int b = lat ? gc >> 4 : (gc - 256) >> 1;
        const int mme = lat ? 2 + (gc & 15) : (gc - 256) & 1;
        const int u = mme, w = mme < 2 ? 1 - mme : 19 - mme;
        f32x4 sf = (f32x4){0.f, 0.f, 0.f, 0.f}, sb = sf;
        const float* KVb = (const float*)(p.ws + WS_KV);
#pragma unroll 1
        for (int mm = 0; mm < 18; ++mm) {
            const int gcm = mm < 2 ? 256 + b * 2 + mm : b * 16 + (mm - 2);
            const int um = mm, wm = mm < 2 ? 1 - mm : 19 - mm;
            const float* kv = KVb + ((size_t)(gcm * 4 + h) * 2) * 2048 + tid * 4;
            if (um < u) { const float wgt = exp2f(l2f * 128.f * (float)(u - 1 - um)); sf += wgt * *(const f32x4*)kv; }
            if (wm < w) { const float wgt = exp2f(l2b * 128.f * (float)(w - 1 - wm)); sb += wgt * *(const f32x4*)(kv + 2048); }
        }
        *(f32x4*)(Sf + tid * 4) = sf; *(f32x4*)(Sb + tid * 4) = sb;
    }
    __syncthreads();
    const int i = tid >> 2, e0 = (tid & 3) * 16;
    float q[32];
#pragma unroll
    for (int d = 0; d < 32; ++d) q[d] = qs[i * 33 + d];
    float acc[16];
#pragma unroll
    for (int e = 0; e < 16; ++e) acc[e] = 0.f;
#pragma unroll 1
    for (int j = 0; j < 128; ++j) {
        float s = 0.f;
#pragma unroll
        for (int d = 0; d < 32; ++d) s += q[d] * ks[j * 33 + d];
        float wgt = 0.f;
        if (j <= i) wgt += exp2f(l2f * (float)(i - j));
        if (j >= i) wgt += exp2f(l2b * (float)(j - i));
        s *= wgt;
#pragma unroll
        for (int e4 = 0; e4 < 4; ++e4) { const f32x4 v4 = *(const f32x4*)(vs + j * 64 + e0 + 4 * e4); acc[4 * e4] += s * v4.x; acc[4 * e4 + 1] += s * v4.y; acc[4 * e4 + 2] += s * v4.z; acc[4 * e4 + 3] += s * v4.w; }
    }
    {
        const float cf = exp2f(l2f * (float)(i + 1)), cb = exp2f(l2b * (float)(128 - i));
#pragma unroll 2
        for (int d = 0; d < 32; ++d) {
            const float qd = qs[i * 33 + d]; const float qf = qd * cf, qb = qd * cb;
#pragma unroll
            for (int e4 = 0; e4 < 4; ++e4) { const f32x4 a = *(const f32x4*)(Sf + d * 64 + e0 + 4 * e4), bq = *(const f32x4*)(Sb + d * 64 + e0 + 4 * e4);
                acc[4 * e4] += qf * a.x + qb * bq.x; acc[4 * e4 + 1] += qf * a.y + qb * bq.y; acc[4 * e4 + 2] += qf * a.z + qb * bq.z; acc[4 * e4 + 3] += qf * a.w + qb * bq.w; }
        }
    }
    float s1 = 0.f;
#pragma unroll
    for (int e = 0; e < 16; ++e) s1 += acc[e];
    s1 += __shfl_xor(s1, 1); s1 += __shfl_xor(s1, 2);
    const float mu = s1 * (1.f / 64.f);
    float s2 = 0.f;
#pragma unroll
    for (int e = 0; e < 16; ++e) { const float dd = acc[e] - mu; s2 += dd * dd; }
    s2 += __shfl_xor(s2, 1); s2 += __shfl_xor(s2, 2);
    const float rstd = rsqrtf(s2 * (1.f / 64.f) + NORM_EPS);
    const int row = gc * 128 + i;
    const bf16_t* zg = (const bf16_t*)(p.ws + WS_Z) + (size_t)row * ZC + Z_RG + h * 64 + e0;
    const float* gw = p.in[13] + L * 256 + h * 64 + e0;
    const u32x4 g0 = *(const u32x4*)zg, g1 = *(const u32x4*)(zg + 8);
    float g[16];
#pragma unroll
    for (int k = 0; k < 4; ++k) { g[2 * k] = lo16(g0[k]); g[2 * k + 1] = hi16(g0[k]); g[8 + 2 * k] = lo16(g1[k]); g[8 + 2 * k + 1] = hi16(g1[k]); }
    unsigned o[8];
#pragma unroll
    for (int k = 0; k < 8; ++k) {
        const float y0 = siluf(g[2 * k]) * ((acc[2 * k] - mu) * rstd * gw[2 * k]), y1 = siluf(g[2 * k + 1]) * ((acc[2 * k + 1] - mu) * rstd * gw[2 * k + 1]);
        o[k] = pk2(y0, y1);
    }
    u32x4* op = (u32x4*)((bf16_t*)(p.ws + WS_CC) + (size_t)row * D + 256 + h * 64 + e0);
    u32x4 w0; w0.x = o[0]; w0.y = o[1]; w0.z = o[2]; w0.w = o[3]; u32x4 w1; w1.x = o[4]; w1.y = o[5]; w1.z = o[6]; w1.w = o[7];
    op[0] = w0; op[1] = w1;
    __syncthreads();
}
__device__ __forceinline__ void phase_c(unsigned char* lds, const P& p, int L) {
    const int G = gridDim.x, bid = blockIdx.x;
    const int nat = 16 * 8 * 8, nac = (L == 0) ? 128 : 0, nro = (L == 0 ? 288 : 256) * 4;
    const int total = nat + nac + nro;
    for (int u = bid; u < total; u += G) {
        int r = u;
#ifndef TEST_C
#define TEST_C 3
#endif
        if (r < nat) { if (TEST_C & 1) attn_unit_mfma(lds, p, r >> 6, (r >> 3) & 7, r & 7, false); continue; } r -= nat;
        if (r < nac) { if (TEST_C & 1) attn_unit_mfma(lds, p, r >> 3, r & 7, 0, true); continue; } r -= nac;
        if (TEST_C & 2) retout_unit_mfma(lds, p, L, r >> 2, r & 3);
    }
    if (L == 0) convert_expert_weights(lds, p, 0);
}

struct EpiY {
    bf16_t* Y; const float* g1;
    __device__ __forceinline__ void operator()(const ge::Acc& acc, const ge::Unit& u, int wr, int wc, int fr, int fq) const {
        const float* gr = g1 + (size_t)mod_row(u.a * 256) * 6144 + u.b * 256 + wc * 32 + 8 * fq;
        f32x4 g[2][2];
#pragma unroll
        for (int bj = 0; bj < 2; ++bj)
#pragma unroll
            for (int n = 0; n < 2; ++n) g[bj][n] = *(const f32x4*)(gr + bj * 128 + n * 4);
#pragma unroll
        for (int ai = 0; ai < 2; ++ai)
#pragma unroll
            for (int m = 0; m < 4; ++m) {
                bf16_t* yr = Y + (size_t)(u.a * 256 + ai * 128 + wr * 64 + m * 16 + fr) * D + u.b * 256 + wc * 32 + 8 * fq;
#pragma unroll
                for (int bj = 0; bj < 2; ++bj) { const f32x4 v0 = acc[ai][bj][m][0] * g[bj][0], v1 = acc[ai][bj][m][1] * g[bj][1];
                    u32x4 w; w.x = cvtpk(v0.x, v0.y); w.y = cvtpk(v0.z, v0.w); w.z = cvtpk(v1.x, v1.y); w.w = cvtpk(v1.z, v1.w); *(u32x4*)(yr + bj * 128) = w; }
            }
    }
};
__device__ __forceinline__ void phase_d(unsigned char* lds, const P& p, int L) {
    ge::DenseOrder S; S.nM = (L == 0 ? NTOK : NLAT) / 256; S.nN = 4; S.nwg = S.nM * 4; S.G = gridDim.x; S.c = blockIdx.x;
    S.Bt = (const char*)((const bf16_t*)(p.ws + WS_WOUT) + (size_t)L * D * D); S.btile = (size_t)256 * D * 2; S.arow = D * 2;
    EpiY E{(bf16_t*)(p.ws + WS_Y), (const float*)(p.ws + WS_MODV) + (size_t)L * 17 * 6144 + 2048};
    ge::gemm_stream<ge::DenseOrder, EpiY, true>((LAS unsigned char*)lds, (const char*)(p.ws + WS_CC), D, S, E);
}

__device__ __forceinline__ void norm_mod_store(const P& p, int L, int which, int tok, int lane, const f32x4 (&v)[4], bf16_t* Hdst) {
    const float* nw = (which == 0 ? p.in[6] : p.in[19]) + L * D;
    const float* mrow = (const float*)(p.ws + WS_MODV) + ((size_t)L * 17 + mod_row(tok)) * 6144 + which * 3072;
    float s = 0.f;
#pragma unroll
    for (int j = 0; j < 4; ++j) s += v[j].x * v[j].x + v[j].y * v[j].y + v[j].z * v[j].z + v[j].w * v[j].w;
    const float rstd = rsqrtf(wave_sum(s) * (1.f / D) + NORM_EPS);
    u32x2* o = (u32x2*)(Hdst + (size_t)tok * D) + lane;
#pragma unroll
    for (int j = 0; j < 4; ++j) {
        const int k = 4 * lane + 256 * j;
        const f32x4 w4 = *(const f32x4*)(nw + k), sh = *(const f32x4*)(mrow + k), sc = *(const f32x4*)(mrow + 1024 + k);
        const f32x4 y = v[j] * rstd * w4 * (sc + 1.f) + sh;
        u32x2 w; w.x = cvtpk(y.x, y.y); w.y = cvtpk(y.z, y.w); o[64 * j] = w;
    }
}
__device__ __forceinline__ int half_n(int L) { return L == 0 ? NTOK / 2 : NLAT / 2; }
__device__ __forceinline__ void phase_router(unsigned char* lds, const P& p, int L) {
    constexpr int O_LG = 41472, O_CNT = 83072, O_SEL = 83584, O_SELW = 87424;
    const bf16_t* H = (const bf16_t*)(p.ws + WS_H); const bf16_t* W = (const bf16_t*)(p.ws + WS_RT) + (size_t)L * 128 * D;
    const bf16_t* Y = (const bf16_t*)(p.ws + WS_Y);
    float* lg = (float*)(lds + O_LG);
    int* lcnt = (int*)(lds + O_CNT);
    int* sel = (int*)(lds + O_SEL);
    float* selw = (float*)(lds + O_SELW);
    int* ltok = (int*)(p.ws + WS_LTOK); float* lw = (float*)(p.ws + WS_LW);
    const int tid = threadIdx.x, lane = tid & 63, wave = tid >> 6;
    const int ntok = (L == 0 ? NTOK : NLAT), TS = (L == 0 ? 144 : 128), nmt = ntok / TS, RW = TS / 8, HN = half_n(L);
    for (int mt = blockIdx.x; mt < nmt; mt += gridDim.x) {
        const int t0 = mt * TS;
        if (tid < 64) lcnt[tid] = 0;
#pragma unroll 2
        for (int q = 0; q < RW; ++q) {
            const int tok = t0 + wave * RW + q;
            const u32x2* yr = (const u32x2*)(Y + (size_t)tok * D) + lane;
            u32x2* xo = (u32x2*)x_row(p, tok) + lane;
            f32x4 v[4];
            if (L == 0) {
                const f32x4* xi = (const f32x4*)x_in_row(p, tok) + lane;
#pragma unroll
                for (int j = 0; j < 4; ++j) { const f32x4 a = xi[64 * j]; const u32x2 y = yr[64 * j]; v[j] = (f32x4){a.x + lo16(y.x), a.y + hi16(y.x), a.z + lo16(y.y), a.w + hi16(y.y)}; }
            } else {
#pragma unroll
                for (int j = 0; j < 4; ++j) { const u32x2 a = xo[64 * j]; const u32x2 y = yr[64 * j]; v[j] = (f32x4){lo16(a.x) + lo16(y.x), hi16(a.x) + hi16(y.x), lo16(a.y) + lo16(y.y), hi16(a.y) + hi16(y.y)}; }
            }
#pragma unroll
            for (int j = 0; j < 4; ++j) { u32x2 w; w.x = cvtpk(v[j].x, v[j].y); w.y = cvtpk(v[j].z, v[j].w); xo[64 * j] = w; }
            norm_mod_store(p, L, 1, tok, lane, v, (bf16_t*)(p.ws + WS_H));
        }
        asm volatile("s_waitcnt vmcnt(0)" ::: "memory");
        __syncthreads();
        auto rs = [&](int pr) { return H + (size_t)(t0 + (pr < TS ? pr : TS - 1)) * D; };
        auto epi = [&](int r, int c, f32x4 v) { if (c < 64) { float* d = lg + r * 65 + c; d[0] = v.x; d[1] = v.y; d[2] = v.z; d[3] = v.w; } };
        gemm_tile<5>(lds, rs, W, D, D, epi);
        __syncthreads();
        if (tid < TS) {
            const float* rbp = p.in[21] + L * NEXP; const float* lrow = lg + tid * 65;
            float bv[6], bs[6]; int bi[6];
#pragma unroll
            for (int k = 0; k < 6; ++k) { bv[k] = -INFINITY; bs[k] = 0.f; bi[k] = 0; }
#pragma unroll 4
            for (int e = 0; e < NEXP; ++e) {
                float sc = 1.f / (1.f + __expf(-lrow[e])); float sv = sc + rbp[e]; int ei = e;
#pragma unroll
                for (int k = 0; k < 6; ++k) { const bool gt = sv > bv[k]; const float tv = gt ? bv[k] : sv, ts = gt ? bs[k] : sc; const int ti = gt ? bi[k] : ei;
                    bv[k] = gt ? sv : bv[k]; bs[k] = gt ? sc : bs[k]; bi[k] = gt ? ei : bi[k]; sv = tv; sc = ts; ei = ti; }
            }
            const float rs6 = 2.5f / (bs[0] + bs[1] + bs[2] + bs[3] + bs[4] + bs[5]);
#pragma unroll
            for (int k = 0; k < 6; ++k) { const int rank = atomicAdd(&lcnt[bi[k]], 1); sel[tid * 6 + k] = (bi[k] << 8) | rank; selw[tid * 6 + k] = bs[k] * rs6; }
        }
        __syncthreads();
        const int hf = t0 / HN;
        if (tid < 64) {
            unsigned* ecnt = (unsigned*)(p.ws + WS_CTL) + CW_ECNT + (L * 2 + hf) * 4096;
            const int c = lcnt[tid];
            lcnt[64 + tid] = c ? (int)atomicAdd(ecnt + tid * 64, (unsigned)c) : 0;
        }
        __syncthreads();
        for (int i = tid; i < TS * 6; i += NTHREADS) {
            const int sv = sel[i], e = sv >> 8, pos = lcnt[64 + e] + (sv & 255), tok = t0 + i / 6, k = i % 6;
            ltok[(size_t)(hf * 64 + e) * LCAPH + pos] = tok * 8 + k;
            lw[(size_t)(hf * 64 + e) * LCAPH + pos] = selw[i];
        }
        __syncthreads();
    }
}

__device__ __forceinline__ void build_etab(unsigned char* lds, const P& p, int L) {
    int* tstart = (int*)(lds + ETAB_OFF); int* cnt = tstart + 160;
    __syncthreads();
    if (threadIdx.x < 128) { const unsigned* ecnt = (const unsigned*)(p.ws + WS_CTL) + CW_ECNT + (L * 2 + (threadIdx.x >> 6)) * 4096;
        cnt[threadIdx.x] = (int)__hip_atomic_load(ecnt + (threadIdx.x & 63) * 64, __ATOMIC_RELAXED, __HIP_MEMORY_SCOPE_AGENT); }
    __syncthreads();
    if (threadIdx.x == 0) { int s = 0; for (int hf = 0; hf < 2; ++hf) { for (int e = 0; e < 64; ++e) { tstart[hf * 66 + e] = s; s += (cnt[hf * 64 + e] + 255) >> 8; } tstart[hf * 66 + 64] = s; s += half_n(L) / 256; tstart[hf * 66 + 65] = s; } }
    __syncthreads();
}
struct MoeOrder {
    int tlo, thi, nN, G, c; const int* tstart; const char* Bexp; size_t bexp; const char* Bsh; size_t btile; const int* rowbuf; unsigned arow; bool ident;
    __device__ __forceinline__ bool next(int i, ge::Unit& u) const {
        const int Lq = i * G + c; if (Lq >= (thi - tlo) * nN) return false;
        const int t = tlo + Lq / nN, pn = Lq % nN;
        const int hf = t >= tstart[66] ? 1 : 0; const int* ts = tstart + hf * 66;
        int lo = 0, hi = 64;
        while (lo < hi) { const int mid = (lo + hi + 1) >> 1; if (ts[mid] <= t) lo = mid; else hi = mid - 1; }
        const int e = __builtin_amdgcn_readfirstlane(lo);
        u.a = t; u.b = pn; u.c = hf * 128 + e; u.d = i;
        u.B = (e < 64 ? Bexp + (size_t)e * bexp : Bsh) + (size_t)pn * btile;
        return true;
    }
    __device__ __forceinline__ unsigned aoff(int i, const ge::Unit& u, int R) const { return (unsigned)(ident ? u.a * 256 + R : rowbuf[i * 256 + R]) * arow; }
};
__device__ __forceinline__ void phase_gateup(unsigned char* lds, const P& p, int L) {
    build_etab(lds, p, L);
    const int* tstart = (const int*)(lds + ETAB_OFF); const int* cnt = tstart + 160;
    int* rowbuf = (int*)(lds + RB0_OFF); float* wbuf = (float*)(lds + RB1_OFF);
    const int* ltok = (const int*)(p.ws + WS_LTOK); const float* lw = (const float*)(p.ws + WS_LW);
    bf16_t* ACT = (bf16_t*)(p.ws + WS_ACT);
    const int G = gridDim.x, bid = blockIdx.x, vcu = (G % 8 == 0) ? (bid % 8) * (G / 8) + bid / 8 : bid, HN = half_n(L);
    MoeOrder S; S.tlo = 0; S.thi = tstart[66 + 65]; S.nN = 2; S.G = G; S.c = vcu; S.tstart = tstart; S.Bexp = (const char*)(p.ws + WS_EGU); S.bexp = (size_t)512 * D * 2;
    S.Bsh = (const char*)((const bf16_t*)(p.ws + WS_SHGU) + (size_t)L * 512 * D); S.btile = (size_t)256 * D * 2; S.rowbuf = rowbuf; S.arow = D * 2; S.ident = false;
    {
        ge::Unit u;
        for (int i = 0; i < 10 && S.next(i, u); ++i) {
            if (threadIdx.x < 256) {
                const int R = threadIdx.x, hf = u.c >> 7, e = u.c & 127, mt = u.a - tstart[hf * 66 + e];
                int tok; float w;
                if (e < 64) { const int lp = mt * 256 + R; const bool ok = lp < cnt[hf * 64 + e]; tok = ok ? (ltok[(size_t)(hf * 64 + e) * LCAPH + lp] >> 3) : 0; w = ok ? lw[(size_t)(hf * 64 + e) * LCAPH + lp] : 0.f; }
                else { tok = hf * HN + mt * 256 + R; w = 1.f; }
                rowbuf[i * 256 + R] = tok; wbuf[i * 256 + R] = w;
            }
        }
        __syncthreads();
    }
    auto f = [&](const ge::Unit& u, int r, int c, f32x4 v0, f32x4 v1) {
        const float w = wbuf[u.d * 256 + r];
        u32x2 o; o.x = cvtpk(siluf(v0.x) * v0.y * w, siluf(v0.z) * v0.w * w); o.y = cvtpk(siluf(v1.x) * v1.y * w, siluf(v1.z) * v1.w * w);
        *(u32x2*)(ACT + (size_t)(u.a * 256 + r) * EDIM + ((u.b * 256 + c) >> 1)) = o;
    };
    ge::EpiFn<decltype(f)> E{f};
    ge::gemm_stream<MoeOrder, ge::EpiFn<decltype(f)>, true>((LAS unsigned char*)lds, (const char*)(p.ws + (L == 0 ? WS_H : WS_H)), D, S, E);
}
__device__ __forceinline__ void phase_down(unsigned char* lds, const P& p, int L, int hf) {
    build_etab(lds, p, L);
    const int* tstart = (const int*)(lds + ETAB_OFF); const int* cnt = tstart + 160;
    int* sbuf = (int*)(lds + RB0_OFF);
    const int* ltok = (const int*)(p.ws + WS_LTOK);
    unsigned char* SLOT = (unsigned char*)(p.ws + WS_SLOT);
    const int G = gridDim.x, bid = blockIdx.x, vcu = (G % 8 == 0) ? (bid % 8) * (G / 8) + bid / 8 : bid, HN = half_n(L);
    MoeOrder S; S.tlo = tstart[hf * 66]; S.thi = tstart[hf * 66 + 65]; S.nN = 4; S.G = G; S.c = vcu; S.tstart = tstart; S.Bexp = (const char*)(p.ws + WS_ED); S.bexp = (size_t)D * EDIM * 2;
    S.Bsh = (const char*)((const bf16_t*)(p.ws + WS_SHD) + (size_t)L * D * EDIM); S.btile = (size_t)256 * EDIM * 2; S.rowbuf = sbuf; S.arow = EDIM * 2; S.ident = true;
    {
        ge::Unit u;
        for (int i = 0; i < 10 && S.next(i, u); ++i) {
            if (threadIdx.x < 256) {
                const int R = threadIdx.x, e = u.c & 127, mt = u.a - tstart[hf * 66 + e];
                int srow;
                if (e < 64) { const int lp = mt * 256 + R; if (lp < cnt[hf * 64 + e]) { const int ent = ltok[(size_t)(hf * 64 + e) * LCAPH + lp]; srow = ((ent >> 3) - hf * HN) * 7 + (ent & 7); } else srow = -1; }
                else srow = (mt * 256 + R) * 7 + 6;
                sbuf[i * 256 + R] = srow;
            }
        }
        __syncthreads();
    }
    auto f = [&](const ge::Unit& u, int r, int c, f32x4 v0, f32x4 v1) {
        const int srow = sbuf[u.d * 256 + r];
        if (srow >= 0) {
            int w0 = 0, w1 = 0;
            w0 = __builtin_amdgcn_cvt_pk_fp8_f32(__builtin_amdgcn_fmed3f(v0.x, -440.f, 440.f), __builtin_amdgcn_fmed3f(v0.y, -440.f, 440.f), w0, false);
            w0 = __builtin_amdgcn_cvt_pk_fp8_f32(__builtin_amdgcn_fmed3f(v0.z, -440.f, 440.f), __builtin_amdgcn_fmed3f(v0.w, -440.f, 440.f), w0, true);
            w1 = __builtin_amdgcn_cvt_pk_fp8_f32(__builtin_amdgcn_fmed3f(v1.x, -440.f, 440.f), __builtin_amdgcn_fmed3f(v1.y, -440.f, 440.f), w1, false);
            w1 = __builtin_amdgcn_cvt_pk_fp8_f32(__builtin_amdgcn_fmed3f(v1.z, -440.f, 440.f), __builtin_amdgcn_fmed3f(v1.w, -440.f, 440.f), w1, true);
            u32x2 w; w.x = (unsigned)w0; w.y = (unsigned)w1; *(u32x2*)(SLOT + (size_t)srow * D + u.b * 256 + c) = w;
        }
    };
    ge::EpiFn<decltype(f)> E{f};
    ge::gemm_stream<MoeOrder, ge::EpiFn<decltype(f)>, true>((LAS unsigned char*)lds, (const char*)(p.ws + WS_ACT), EDIM, S, E);
}
__device__ __forceinline__ void phase_combine(const P& p, int L, int hf) {
    const int tid = threadIdx.x, lane = tid & 63, wave = tid >> 6, gw = blockIdx.x * NWAVES + wave, NGW = gridDim.x * NWAVES;
    const unsigned char* SLOT = (const unsigned char*)(p.ws + WS_SLOT);
    const float* modv = (const float*)(p.ws + WS_MODV) + (size_t)L * 17 * 6144;
    const int HN = half_n(L);
    for (int tl = gw; tl < HN; tl += NGW) {
        const int tok = hf * HN + tl;
        f32x4 acc[4];
#pragma unroll
        for (int j = 0; j < 4; ++j) acc[j] = (f32x4){0.f, 0.f, 0.f, 0.f};
#pragma unroll
        for (int k = 0; k < 7; ++k) {
            const int* sr = (const int*)(SLOT + ((size_t)tl * 7 + k) * D) + lane;
#pragma unroll
            for (int j = 0; j < 4; ++j) { const int w = sr[64 * j]; const f32x2_t a = __builtin_amdgcn_cvt_pk_f32_fp8(w, false), b = __builtin_amdgcn_cvt_pk_f32_fp8(w, true); acc[j].x += a.x; acc[j].y += a.y; acc[j].z += b.x; acc[j].w += b.y; }
        }
        const float* g2 = modv + (size_t)mod_row(tok) * 6144 + 5120;
        u32x2* xr = (u32x2*)x_row(p, tok) + lane;
        f32x4 v[4];
#pragma unroll
        for (int j = 0; j < 4; ++j) { const f32x4 g = *(const f32x4*)(g2 + 4 * lane + 256 * j); const u32x2 a = xr[64 * j];
            v[j] = (f32x4){lo16(a.x), hi16(a.x), lo16(a.y), hi16(a.y)} + g * acc[j]; }
        if (L == 0) {
#pragma unroll
            for (int j = 0; j < 4; ++j) { u32x2 w; w.x = cvtpk(v[j].x, v[j].y); w.y = cvtpk(v[j].z, v[j].w); xr[64 * j] = w; }
            norm_mod_store(p, 1, 0, tok, lane, v, (bf16_t*)(p.ws + WS_H1));
        } else {
            const float* nw = p.in[28]; float s = 0.f;
#pragma unroll
            for (int j = 0; j < 4; ++j) s += v[j].x * v[j].x + v[j].y * v[j].y + v[j].z * v[j].z + v[j].w * v[j].w;
            const float rstd = rsqrtf(wave_sum(s) * (1.f / D) + NORM_EPS);
            f32x4* orow = (f32x4*)(p.out + (size_t)tok * D) + lane;
#pragma unroll
            for (int j = 0; j < 4; ++j) { const f32x4 w4 = *(const f32x4*)(nw + 4 * lane + 256 * j); orow[64 * j] = v[j] * rstd * w4; }
        }
    }
}

constexpr int PH_LAYER0 = 2, PH_PER_LAYER = 10, PH_LAYER1 = PH_LAYER0 + PH_PER_LAYER, NPHASES = PH_LAYER1 + PH_PER_LAYER;

__global__ void __launch_bounds__(NTHREADS, 2) mk_fwd(P p) {
    extern __shared__ __attribute__((aligned(16))) unsigned char lds[];
    volatile LAS unsigned* MISC = (volatile LAS unsigned*)((LAS unsigned char*)lds + MISC_OFF);
    if (threadIdx.x < 64) MISC[threadIdx.x] = 0u;
    __syncthreads();
    unsigned* ctl = (unsigned*)(p.ws + WS_CTL);
    XcdBarrier bar; bar.bar = ctl + CW_BAR; bar.x = 0; bar.st = MISC + 8;
    if (!MK_PER_PHASE) bar = xcd_barrier_post(ctl + CW_BAR, MISC + 8);
    const int lo = p.ph_lo, hi = p.ph_hi;
#ifndef PH_MASK
#define PH_MASK 0xffffu
#endif
#define HAS(b) ((PH_MASK >> (b)) & 1u)
#define IN(k) (lo <= (k) && (k) < hi)
#define SEAM(k) do { if (IN(k) && IN((k) + 1)) xcd_barrier(bar); } while (0)

#ifdef PROBE_MASK
    unsigned long long tacc = 0ull, t0p = 0ull;
#define PT0() t0p = __builtin_amdgcn_s_memrealtime()
#define PT1(b) do { if ((PROBE_MASK >> (b)) & 1u) tacc += __builtin_amdgcn_s_memrealtime() - t0p; } while (0)
#else
#define PT0() do {} while (0)
#define PT1(b) do {} while (0)
#endif
#define PH(b, k, body) do { PT0(); if (HAS(b) && IN(k)) { body; } SEAM(k); PT1(b); } while (0)
    PH(0, 0, phase_prep(lds, p));
    PH(1, 1, phase_norm_mod(p, 0, 0, NTOK));
#define DOWN_COMBINE(L, pb, hf) \
        PH(9, pb + 6 + 2 * hf, phase_down(lds, p, L, hf)); \
        PH(10, pb + 7 + 2 * hf, phase_combine(p, L, hf));
#define LAYER(L, pb) \
        PH(2, pb + 0, phase_zgemm(lds, p, L)); \
        PH(3, pb + 1, phase_b(lds, p, L)); \
        PH(4, pb + 2, phase_c(lds, p, L)); \
        PH(5, pb + 3, phase_d(lds, p, L)); \
        PH(7, pb + 4, phase_router(lds, p, L)); \
        PH(8, pb + 5, phase_gateup(lds, p, L)); \
        DOWN_COMBINE(L, pb, 0) DOWN_COMBINE(L, pb, 1)
    LAYER(0, PH_LAYER0)
    LAYER(1, PH_LAYER1)
#ifdef PROBE_MASK
    if (blockIdx.x == 0) {
        const unsigned long long tend = __builtin_amdgcn_s_memrealtime();
        while (__builtin_amdgcn_s_memrealtime() - tend < (unsigned long long)PROBE_AMP * tacc) __builtin_amdgcn_s_sleep(8);
    }
#endif
#undef IN
#undef SEAM
}

extern "C" void kernel_launch(void* const* d_in, const int* in_sizes, int n_in, void* d_out, int out_size, void* d_ws, size_t ws_size, hipStream_t stream) {
    static int grid = 0;
    if (grid == 0) {
        if (n_in != 29 || in_sizes[0] != NLAT * D || out_size != NLAT * D || ws_size < WS_END) {
            fprintf(stderr, "kernel_launch: unexpected shapes / workspace (n_in %d, ws %zu, need %zu); nothing launched\n", n_in, ws_size, (size_t)WS_END); grid = -1; return; }
        int dev = 0, cus = 0, per_cu = 0;
        if (hipGetDevice(&dev) != hipSuccess || hipDeviceGetAttribute(&cus, hipDeviceAttributeMultiprocessorCount, dev) != hipSuccess) { grid = -1; return; }
        if (hipFuncSetAttribute((const void*)mk_fwd, hipFuncAttributeMaxDynamicSharedMemorySize, LDS_BYTES) != hipSuccess) { grid = -1; return; }
        if (hipOccupancyMaxActiveBlocksPerMultiprocessor(&per_cu, (const void*)mk_fwd, NTHREADS, LDS_BYTES) != hipSuccess || per_cu < 1) { fprintf(stderr, "kernel_launch: occupancy query says %d\n", per_cu); }
        (void)hipGetLastError();
        grid = cus;
    }
    if (grid < 0) return;
    (void)hipMemsetAsync((char*)d_ws + WS_CTL, 0, CTL_ZERO_BYTES, stream);
    P a{};
    for (int i = 0; i < 29; ++i) a.in[i] = (const float*)d_in[i];
    a.out = (float*)d_out; a.ws = (unsigned char*)d_ws;
#if MK_PER_PHASE
    for (int ph = 0; ph < NPHASES; ++ph) { a.ph_lo = ph; a.ph_hi = ph + 1; hipLaunchKernelGGL(mk_fwd, dim3(grid), dim3(NTHREADS), LDS_BYTES, stream, a); }
#else
    a.ph_lo = 0; a.ph_hi = NPHASES;
    hipLaunchKernelGGL(mk_fwd, dim3(grid), dim3(NTHREADS), LDS_BYTES, stream, a);
#endif
}
```

```cpp
#include <hip/hip_runtime.h>
#include <cstdio>
#include <cstdint>

#ifndef MK_PER_PHASE
#define MK_PER_PHASE 0
#endif

typedef unsigned short bf16_t;
typedef short bf16x8 __attribute__((ext_vector_type(8)));
typedef float f32x4 __attribute__((ext_vector_type(4)));
typedef unsigned u32x4 __attribute__((ext_vector_type(4)));
typedef unsigned u32x2 __attribute__((ext_vector_type(2)));
typedef float f32x16 __attribute__((ext_vector_type(16)));
typedef short v4i16_t __attribute__((ext_vector_type(4)));
#define LAS __attribute__((address_space(3)))

constexpr int D = 1024, BATCH = 16, SEQ = 2048, CTXL = 256;
constexpr int NLAT = BATCH * SEQ, NCTX = BATCH * CTXL, NTOK = NLAT + NCTX;
constexpr int ZC = 1792;
constexpr int Z_RQ = 512, Z_RK = 640, Z_RV = 768, Z_RG = 1024, Z_CQ = 1280, Z_CKV = 1536, Z_KR = 1664, Z_END = 1696;
constexpr int NEXP = 64, TOPK = 6, EDIM = 256;
constexpr float NORM_EPS = 1e-6f;
constexpr int NTHREADS = 512, NWAVES = 8;

constexpr size_t MiB = 1u << 20;
constexpr size_t WS_CTL = 0, CTL_ZERO_BYTES = 1 * MiB;
constexpr size_t WS_MODV = 1 * MiB;
constexpr size_t WS_ROPE = 2 * MiB;
constexpr size_t WS_WIN = 3 * MiB;
constexpr size_t WS_WUQ = 10 * MiB;
constexpr size_t WS_WUKV = 11 * MiB;
constexpr size_t WS_WOUT = 12 * MiB;
constexpr size_t WS_RT = 16 * MiB;
constexpr size_t WS_SHGU = 17 * MiB;
constexpr size_t WS_SHD = 19 * MiB;
constexpr size_t WS_EGU = 20 * MiB;
constexpr size_t WS_ED = 84 * MiB;
constexpr size_t WS_H = 132 * MiB;
constexpr size_t WS_H1 = 20 * MiB;
constexpr size_t WS_CC = WS_H;
constexpr size_t WS_R = 204 * MiB;
constexpr size_t WS_Z = WS_R;
constexpr size_t WS_Q = 330 * MiB;
constexpr size_t WS_K = 384 * MiB;
constexpr size_t WS_V = 438 * MiB;
constexpr size_t WS_KV = 474 * MiB;
constexpr size_t WS_X = 492 * MiB;
constexpr size_t WS_LTOK = 564 * MiB;
constexpr size_t WS_LW = 573 * MiB;
constexpr size_t WS_SS = 582 * MiB;
constexpr size_t WS_END = 584 * MiB;
constexpr size_t WS_Y = WS_Z;
constexpr size_t WS_SLOT = 132 * MiB;
constexpr size_t WS_ACT = 258 * MiB;
constexpr int LCAPH = 18432;
static_assert(WS_SLOT + (size_t)18432 * 7 * 1024 <= WS_ACT && WS_ACT + (size_t)1136 * 256 * 512 <= WS_V, "MoE buffers");

constexpr int CW_TMO = 0;
constexpr int CW_BAR = 4096;
constexpr int CW_ECNT = 8192;

constexpr int LDS_BYTES = 155648;
constexpr int MISC_OFF = LDS_BYTES - 256;
constexpr int RB0_OFF = 131072;
constexpr int RB1_OFF = 141312;
constexpr int ETAB_OFF = 151552;
constexpr int GEMM_LDS = 36864;
constexpr int ROWSS_OFF = 36864;
constexpr int LG_OFF = 37376;

#define XB_TMO      128
#define XB_XCNT(j)  (256  + 64 * (j))
#define XB_XSUB(j)  (1280 + 64 * (j))
#define XB_XGEN(j)  (2304 + 64 * (j))
#define XB_TOP      3328
#define XB_TOPGEN   3392
#define XCD_BAR_WORDS 3456
#define XB_SPIN_CAP (1u << 24)
__device__ __forceinline__ unsigned xb_ld(unsigned* p)              { return __hip_atomic_load(p, __ATOMIC_RELAXED, __HIP_MEMORY_SCOPE_AGENT); }
__device__ __forceinline__ unsigned xb_add(unsigned* p, unsigned v) { return __hip_atomic_fetch_add(p, v, __ATOMIC_RELAXED, __HIP_MEMORY_SCOPE_AGENT); }
__device__ __forceinline__ unsigned xb_xcc_id() { return (unsigned)__builtin_amdgcn_s_getreg((3 << 11) | 20) & 0xFu; }
#define XB_SPIN(cond, bar) do { unsigned _sp = 0; while (cond) { __builtin_amdgcn_s_sleep(1); \
    if ((++_sp & 255u) == 0u) { if (xb_ld(&(bar)[XB_TMO])) break; if (_sp > XB_SPIN_CAP) { atomicAdd(&(bar)[XB_TMO], 1u); break; } } } } while (0)
struct XcdBarrier { unsigned* bar; unsigned x; volatile LAS unsigned* st; };
__device__ __forceinline__ XcdBarrier xcd_barrier_post(unsigned* bar, volatile LAS unsigned* st) {
    XcdBarrier b; b.bar = bar; b.x = xb_xcc_id(); b.st = st;
    if (threadIdx.x == 0) (void)xb_add(&bar[XB_XCNT(b.x)], 1u);
    return b;
}
__device__ __forceinline__ void xcd_barrier_complete(unsigned* bar, unsigned x, unsigned& nloc, unsigned& nx) {
    const unsigned G = gridDim.x * gridDim.y * gridDim.z;
    unsigned sum, cnt, mine, sp = 0u;
    for (;;) {
        sum = 0u; cnt = 0u; mine = 0u;
#pragma unroll
        for (unsigned j = 0; j < 16; ++j) { const unsigned c = xb_ld(&bar[XB_XCNT(j)]); sum += c; cnt += (c > 0u) ? 1u : 0u; mine = (j == x) ? c : mine; }
        if (sum == G) break;
        __builtin_amdgcn_s_sleep(1);
        if ((++sp & 255u) == 0u) { if (xb_ld(&bar[XB_TMO])) break; if (sp > XB_SPIN_CAP) { atomicAdd(&bar[XB_TMO], 1u); break; } }
    }
    nloc = mine > 0u ? mine : 1u; nx = cnt > 0u ? cnt : 1u;
}
__device__ __forceinline__ void xcd_barrier(const XcdBarrier& b) {
    asm volatile("s_waitcnt vmcnt(0)" ::: "memory");
    __syncthreads();
    if (threadIdx.x == 0) {
        unsigned* bar = b.bar;
        __builtin_amdgcn_s_waitcnt(0);
        unsigned nloc = b.st[0], nx = b.st[1];
        if (nloc == 0u) { xcd_barrier_complete(bar, b.x, nloc, nx); b.st[0] = nloc; b.st[1] = nx; }
        const unsigned old = xb_add(&bar[XB_XSUB(b.x)], 1u);
        const unsigned gen = old / nloc;
        if (old + 1u == (gen + 1u) * nloc) {
            __builtin_amdgcn_fence(__ATOMIC_RELEASE, "agent");
            asm volatile("s_waitcnt vmcnt(0)" ::: "memory");
            const unsigned og = xb_add(&bar[XB_TOP], 1u);
            const unsigned tg = og / nx;
            if (og + 1u == (tg + 1u) * nx) xb_add(&bar[XB_TOPGEN], 1u);
            else XB_SPIN(xb_ld(&bar[XB_TOPGEN]) == tg, bar);
            __builtin_amdgcn_fence(__ATOMIC_ACQUIRE, "agent");
            xb_add(&bar[XB_XGEN(b.x)], 1u);
            asm volatile("s_waitcnt vmcnt(0)" ::: "memory");
        } else {
            XB_SPIN(xb_ld(&bar[XB_XGEN(b.x)]) == gen, bar);
            __builtin_amdgcn_fence(__ATOMIC_ACQUIRE, "agent");
            asm volatile("s_waitcnt vmcnt(0)" ::: "memory");
        }
    }
    __syncthreads();
}

__device__ __forceinline__ float bf2f(unsigned h) { return __uint_as_float(h << 16); }
__device__ __forceinline__ unsigned f2bf(float f) { unsigned u = __float_as_uint(f); return (u + 0x7fffu + ((u >> 16) & 1u)) >> 16; }
__device__ __forceinline__ unsigned pk2(float lo, float hi) { return f2bf(lo) | (f2bf(hi) << 16); }
typedef float f32x2_t __attribute__((ext_vector_type(2)));
typedef __bf16 bf16x2_t __attribute__((ext_vector_type(2)));
__device__ __forceinline__ unsigned cvtpk(float lo, float hi) { f32x2_t v = {lo, hi}; bf16x2_t b = __builtin_convertvector(v, bf16x2_t); return __builtin_bit_cast(unsigned, b); }
__device__ __forceinline__ float lo16(unsigned w) { return __uint_as_float(w << 16); }
__device__ __forceinline__ float hi16(unsigned w) { return __uint_as_float(w & 0xffff0000u); }
__device__ __forceinline__ float wave_sum(float v) {
#pragma unroll
    for (int o = 1; o < 64; o <<= 1) v += __shfl_xor(v, o);
    return v;
}
__device__ __forceinline__ float siluf(float v) { return v / (1.f + __expf(-v)); }
__device__ __forceinline__ int mod_row(int tok) { return tok < NLAT ? (tok >> 11) : 16; }

struct P { const float* in[29]; float* out; unsigned char* ws; int ph_lo, ph_hi; };

__device__ __forceinline__ bf16_t* x_row(const P& p, int tok) { return (bf16_t*)(p.ws + WS_X) + (size_t)tok * D; }
__device__ __forceinline__ const float* x_in_row(const P& p, int tok) {
    return tok < NLAT ? p.in[0] + (size_t)tok * D : p.in[2] + (size_t)(tok - NLAT) * D;
}

template <int MF, class RowSrc, class Epi>
__device__ __forceinline__ void gemm_tile(unsigned char* lds, const RowSrc& rs, const bf16_t* Bt, int ldb, int K, const Epi& epi) {
    constexpr int ROWS = 32 * MF, NPA = ROWS * 8;
    const int tid = threadIdx.x, lane = tid & 63, wid = tid >> 6, wr = wid >> 2, wc = wid & 3, fr = lane & 15, fq = lane >> 4;
    bf16_t* As = (bf16_t*)lds; bf16_t* Bs = As + ROWS * 72;
    const bf16_t* ap[3]; int al[3];
#pragma unroll
    for (int i = 0; i < 3; ++i) { const int id = tid + 512 * i, r = id >> 3, c = (id & 7) * 8; ap[i] = (id < NPA) ? rs(r) + c : nullptr; al[i] = r * 72 + c; }
    const int lr = tid >> 2, lc = (tid & 3) * 16;
    const bf16_t* bp = Bt + (size_t)lr * ldb + lc;
    u32x4 a[3], b0 = *(const u32x4*)bp, b1 = *(const u32x4*)(bp + 8);
#pragma unroll
    for (int i = 0; i < 3; ++i) if (ap[i]) a[i] = *(const u32x4*)ap[i];
    f32x4 acc[MF][2];
#pragma unroll
    for (int m = 0; m < MF; ++m)
#pragma unroll
        for (int n = 0; n < 2; ++n) acc[m][n] = (f32x4){0.f, 0.f, 0.f, 0.f};
    for (int k0 = 0; k0 < K; k0 += 64) {
        __syncthreads();
#pragma unroll
        for (int i = 0; i < 3; ++i) if (ap[i]) *(u32x4*)(As + al[i]) = a[i];
        *(u32x4*)(Bs + lr * 72 + lc) = b0; *(u32x4*)(Bs + lr * 72 + lc + 8) = b1;
        __syncthreads();
        if (k0 + 64 < K) {
#pragma unroll
            for (int i = 0; i < 3; ++i) if (ap[i]) { ap[i] += 64; a[i] = *(const u32x4*)ap[i]; }
            bp += 64; b0 = *(const u32x4*)bp; b1 = *(const u32x4*)(bp + 8);
        }
#pragma unroll
        for (int kk = 0; kk < 2; ++kk) {
            bf16x8 af[MF], bfr[2];
#pragma unroll
            for (int m = 0; m < MF; ++m) af[m] = *(const bf16x8*)(As + (wr * 16 * MF + m * 16 + fr) * 72 + kk * 32 + fq * 8);
#pragma unroll
            for (int n = 0; n < 2; ++n) bfr[n] = *(const bf16x8*)(Bs + (wc * 32 + n * 16 + fr) * 72 + kk * 32 + fq * 8);
#pragma unroll
            for (int m = 0; m < MF; ++m)
#pragma unroll
                for (int n = 0; n < 2; ++n) acc[m][n] = __builtin_amdgcn_mfma_f32_16x16x32_bf16(bfr[n], af[m], acc[m][n], 0, 0, 0);
        }
    }
#pragma unroll
    for (int m = 0; m < MF; ++m)
#pragma unroll
        for (int n = 0; n < 2; ++n) epi(wr * 16 * MF + m * 16 + fr, wc * 32 + n * 16 + 4 * fq, acc[m][n]);
}

namespace ge {
constexpr int BM = 256, BK = 64, HALF = 128, HTB = HALF * BK * 2;
__device__ __forceinline__ int lds_byte(int r, int c) { const int st = (r >> 4) * 2 + (c >> 5), rr = r & 15, cc = c & 31, ob = rr * 64 + cc * 2; return st * 1024 + (ob ^ (((ob >> 9) & 1) << 5)); }
__device__ __forceinline__ void stage_rc(int b, int& R, int& C) { const int st = b / 1024, sb = b % 1024, swz = sb ^ (((sb >> 9) & 1) << 5); R = (st >> 1) * 16 + swz / 64; C = (st & 1) * 32 + (swz % 64) / 2; }
struct Unit { const char* B; int a, b, c, d; };
typedef f32x4 Acc[2][2][4][2];

template <class Sched, class Epi, bool ALIGN_EPI>
__device__ __forceinline__ void gemm_stream(LAS unsigned char* lds, const char* Ab, int K, const Sched& S, const Epi& E) {
    const int tid = threadIdx.x, wid = __builtin_amdgcn_readfirstlane(tid >> 6), lane = tid & 63, wr = wid >> 2, wc = wid & 3, fr = lane & 15, fq = lane >> 4;
    const int nt = K / BK;
    int Rr[2], Cc[2]; unsigned voffB[2];
#pragma unroll
    for (int i = 0; i < 2; ++i) { stage_rc(tid * 16 + i * 8192, Rr[i], Cc[i]);
        const int rho = Rr[i] & 31, Rb = (Rr[i] & ~31) + 8 * ((rho & 15) >> 2) + 4 * (rho >> 4) + (rho & 3);
        voffB[i] = (unsigned)(Rb * K + Cc[i]) * 2u; }
    const size_t kstep = (size_t)(BK * 2), hstepB = (size_t)HALF * K * 2;
    const unsigned ldsw = (unsigned)wid * 1024u;
    const int aoff = lds_byte(wr * 64 + fr, fq * 8), boff = lds_byte(wc * 32 + fr, fq * 8);
#define GE_SA(b, h) (((b) * 2 + (h)) * HTB)
#define GE_SB(b, h) ((4 + (b) * 2 + (h)) * HTB)
#define GE_GLDS(gp, ldsoff) __builtin_amdgcn_global_load_lds((const unsigned*)(gp), (LAS unsigned*)(lds + (ldsoff)), 16, 0, 0)
#define GE_STAGE_B(bufoff, gbase) do { GE_GLDS((const char*)(gbase) + voffB[0], (bufoff) + ldsw); GE_GLDS((const char*)(gbase) + voffB[1], (bufoff) + ldsw + 8192); } while (0)
#define GE_STAGE_A(bufoff, kbytes, o0, o1) do { GE_GLDS(Ab + (kbytes) + (o0), (bufoff) + ldsw); GE_GLDS(Ab + (kbytes) + (o1), (bufoff) + ldsw + 8192); } while (0)
#define GE_LDA(dst, b, h) do { _Pragma("unroll") for (int m = 0; m < 4; ++m) _Pragma("unroll") for (int k = 0; k < 2; ++k) dst[m][k] = *(const LAS bf16x8*)(lds + GE_SA(b, h) + aoff + m * 2048 + k * 1024); } while (0)
#define GE_LDB(dst, b, h) do { _Pragma("unroll") for (int n = 0; n < 2; ++n) _Pragma("unroll") for (int k = 0; k < 2; ++k) dst[n][k] = *(const LAS bf16x8*)(lds + GE_SB(b, h) + boff + n * 2048 + k * 1024); } while (0)
#define GE_MMA(ai, bj, At, Bt) do { __builtin_amdgcn_s_setprio(1); _Pragma("unroll") for (int m = 0; m < 4; ++m) _Pragma("unroll") for (int n = 0; n < 2; ++n) _Pragma("unroll") for (int k = 0; k < 2; ++k) \
        acc[ai][bj][m][n] = __builtin_amdgcn_mfma_f32_16x16x32_bf16(Bt[n][k], At[m][k], acc[ai][bj][m][n], 0, 0, 0); __builtin_amdgcn_s_setprio(0); } while (0)
#define GE_WAIT_V(n) asm volatile("s_waitcnt vmcnt(" #n ")" ::: "memory")
#define GE_WAIT_L(n) asm volatile("s_waitcnt lgkmcnt(" #n ")" ::: "memory")
#define GE_BAR __builtin_amdgcn_s_barrier()
#define GE_SCHED __builtin_amdgcn_sched_barrier(0)
    Unit cur, nxt; int ui = 0;
    if (!S.next(0, cur)) return;
    Acc acc;
#pragma unroll
    for (int a = 0; a < 2; ++a)
#pragma unroll
        for (int b = 0; b < 2; ++b)
#pragma unroll
            for (int m = 0; m < 4; ++m)
#pragma unroll
                for (int n = 0; n < 2; ++n) acc[a][b][m][n] = (f32x4){0.f, 0.f, 0.f, 0.f};
    bf16x8 At[4][2], B0[2][2], B1[2][2];
    unsigned oc00, oc01, oc10, oc11, on00, on01, on10, on11;
    oc00 = S.aoff(0, cur, Rr[0]) + (unsigned)Cc[0] * 2u; oc01 = S.aoff(0, cur, Rr[1]) + (unsigned)Cc[1] * 2u;
    oc10 = S.aoff(0, cur, Rr[0] + 128) + (unsigned)Cc[0] * 2u; oc11 = S.aoff(0, cur, Rr[1] + 128) + (unsigned)Cc[1] * 2u;
    const char* cB = cur.B;
    GE_STAGE_B(GE_SB(0, 0), cB); GE_STAGE_B(GE_SB(0, 1), cB + hstepB); GE_STAGE_A(GE_SA(0, 0), 0, oc00, oc01); GE_STAGE_A(GE_SA(0, 1), 0, oc10, oc11);
    if (wr == 1) GE_BAR;
    GE_WAIT_V(2); GE_BAR;
    GE_STAGE_B(GE_SB(1, 0), cB + kstep); GE_STAGE_A(GE_SA(1, 0), kstep, oc00, oc01); GE_STAGE_B(GE_SB(1, 1), cB + hstepB + kstep);
    GE_WAIT_V(6); GE_BAR;
    for (;;) {
        const bool has_next = S.next(ui + 1, nxt);
        const char* nB = has_next ? nxt.B : cB;
        if (has_next) {
            on00 = S.aoff(ui + 1, nxt, Rr[0]) + (unsigned)Cc[0] * 2u; on01 = S.aoff(ui + 1, nxt, Rr[1]) + (unsigned)Cc[1] * 2u;
            on10 = S.aoff(ui + 1, nxt, Rr[0] + 128) + (unsigned)Cc[0] * 2u; on11 = S.aoff(ui + 1, nxt, Rr[1] + 128) + (unsigned)Cc[1] * 2u;
        } else { on00 = oc00; on01 = oc01; on10 = oc10; on11 = oc11; }
#pragma unroll 1
        for (int t = 0; t < nt; t += 2) {
            const bool last = (t == nt - 2);
            const size_t k1 = (size_t)(t + 1) * kstep;
            const size_t k2 = last ? 0 : (size_t)(t + 2) * kstep, k3 = k2 + kstep;
            const char* b2 = last ? nB : cB + (size_t)(t + 2) * kstep; const char* b3 = b2 + kstep;
            const unsigned o00 = last ? on00 : oc00, o01 = last ? on01 : oc01, o10 = last ? on10 : oc10, o11 = last ? on11 : oc11;
            GE_LDB(B0, 0, 0); GE_LDB(B1, 0, 1); GE_SCHED; GE_LDA(At, 0, 0); GE_STAGE_A(GE_SA(1, 1), k1, oc10, oc11);
            GE_WAIT_V(8); GE_WAIT_L(0); GE_BAR; GE_MMA(0, 0, At, B0); GE_MMA(0, 1, At, B1); GE_BAR; GE_SCHED;
            GE_LDA(At, 0, 1); GE_STAGE_B(GE_SB(0, 0), b2); GE_STAGE_B(GE_SB(0, 1), b2 + hstepB); GE_STAGE_A(GE_SA(0, 0), k2, o00, o01);
            GE_WAIT_V(8); GE_WAIT_L(0); GE_BAR; GE_MMA(1, 0, At, B0); GE_MMA(1, 1, At, B1); GE_BAR; GE_SCHED;
            GE_LDB(B0, 1, 0); GE_LDB(B1, 1, 1); GE_SCHED; GE_LDA(At, 1, 0); GE_STAGE_A(GE_SA(0, 1), k2, o10, o11);
            GE_WAIT_V(8); GE_WAIT_L(0); GE_BAR; GE_MMA(0, 0, At, B0); GE_MMA(0, 1, At, B1); GE_BAR; GE_SCHED;
            GE_LDA(At, 1, 1); GE_STAGE_B(GE_SB(1, 0), b3); GE_STAGE_B(GE_SB(1, 1), b3 + hstepB); GE_STAGE_A(GE_SA(1, 0), k3, o00, o01);
            GE_WAIT_V(8); GE_WAIT_L(0); GE_BAR; GE_MMA(1, 0, At, B0); GE_MMA(1, 1, At, B1); GE_BAR; GE_SCHED;
        }
        if constexpr (ALIGN_EPI) { if (wr == 0) GE_BAR; }
        E(acc, cur, wr, wc, fr, fq);
        if (!has_next) break;
#pragma unroll
        for (int a = 0; a < 2; ++a)
#pragma unroll
            for (int b = 0; b < 2; ++b)
#pragma unroll
                for (int m = 0; m < 4; ++m)
#pragma unroll
                    for (int n = 0; n < 2; ++n) acc[a][b][m][n] = (f32x4){0.f, 0.f, 0.f, 0.f};
        cur = nxt; cB = nB; ++ui; oc00 = on00; oc01 = on01; oc10 = on10; oc11 = on11;
        if constexpr (ALIGN_EPI) { if (wr == 1) GE_BAR; }
    }
    GE_WAIT_V(0);
    if constexpr (!ALIGN_EPI) { if (wr == 0) GE_BAR; }
    GE_BAR;
#undef GE_SA
#undef GE_SB
#undef GE_GLDS
#undef GE_STAGE_A
#undef GE_STAGE_B
#undef GE_LDA
#undef GE_LDB
#undef GE_MMA
#undef GE_WAIT_V
#undef GE_WAIT_L
#undef GE_BAR
#undef GE_SCHED
}
template <class F> struct EpiFn {
    F f;
    __device__ __forceinline__ void operator()(const Acc& acc, const Unit& u, int wr, int wc, int fr, int fq) const {
#pragma unroll
        for (int ai = 0; ai < 2; ++ai)
#pragma unroll
            for (int m = 0; m < 4; ++m)
#pragma unroll
                for (int bj = 0; bj < 2; ++bj) f(u, ai * 128 + wr * 64 + m * 16 + fr, bj * 128 + wc * 32 + 8 * fq, acc[ai][bj][m][0], acc[ai][bj][m][1]);
    }
};
struct DenseOrder {
    int nM, nN, nwg, G, c; const char* Bt; size_t btile; unsigned arow;
    __device__ __forceinline__ bool next(int i, Unit& u) const {
        const long L = (long)i * G + c; if (L >= nwg) return false;
        int wgid = (int)L; { const int q = nwg / 8, r = nwg % 8, xcd = wgid % 8, off = wgid / 8; wgid = (xcd < r ? xcd * (q + 1) : r * (q + 1) + (xcd - r) * q) + off; }
        const int nig = 8 * nN, gid = wgid / nig, fm = gid * 8, gsz = (nM - fm) < 8 ? (nM - fm) : 8;
        u.a = fm + ((wgid % nig) % gsz); u.b = (wgid % nig) / gsz; u.c = 0; u.d = 0; u.B = Bt + (size_t)u.b * btile; return true;
    }
    __device__ __forceinline__ unsigned aoff(int, const Unit& u, int R) const { return (unsigned)(u.a * 256 + R) * arow; }
};
}

struct TMap { const float* s0; const float* s1; int ld; int nvalid; const float* ksc; float gsc; };
template <int MODE> __device__ __forceinline__ const float* tmap_src(const float* s0, const float* s1, int nvalid, int n) {
    if (MODE == 0) return n < nvalid ? s0 + n : nullptr;
    if (MODE == 1) { const int h = n / 96, j = n % 96; const int c = j < 64 ? j : 64 + ((j - 64) & 1) * 16 + ((j - 64) >> 1); return s0 + h * 96 + c; }
    return ((n & 1) ? s1 : s0) + (n >> 1);
}
template <int MODE> __device__ __forceinline__ void transpose_unit(float* scr, const float* s0, const float* s1, int ld, int nvalid, const float* ksc, float gsc, int K, bf16_t* dst, int kb, int nb, int kvalid = 1 << 30) {
    const int tid = threadIdx.x, k0 = kb * 64, n0 = nb * 64;
    const int nn = tid & 63; const float* sp = tmap_src<MODE>(s0, s1, nvalid, n0 + nn);
#pragma unroll
    for (int i = 0; i < 8; ++i) {
        const int kk = (tid >> 6) + 8 * i; float v = (sp && k0 + kk < kvalid) ? sp[(size_t)(k0 + kk) * ld] : 0.f;
        if (ksc && k0 + kk < kvalid) v *= ksc[k0 + kk];
        scr[kk * 65 + nn] = v * gsc;
    }
    __syncthreads();
    {
        const int n2 = tid >> 3, kc = tid & 7; const float* s = scr + (kc * 8) * 65 + n2;
        u32x4 o; o.x = pk2(s[0], s[65]); o.y = pk2(s[2 * 65], s[3 * 65]); o.z = pk2(s[4 * 65], s[5 * 65]); o.w = pk2(s[6 * 65], s[7 * 65]);
        *(u32x4*)(dst + (size_t)(n0 + n2) * K + k0 + kc * 8) = o;
    }
    __syncthreads();
}
template <int MODE> __device__ __forceinline__ void transpose_matrix(float* scr, const float* s0, const float* s1, int ld, int nvalid, const float* ksc, float gsc, int K, int Nd, bf16_t* dst, int& rot, int kvalid = 1 << 30) {
    const int nkb = K / 64, nnb = Nd / 64, nu = nkb * nnb, G = gridDim.x;
    int first = ((int)blockIdx.x - rot) % G; if (first < 0) first += G;
    for (int u = first; u < nu; u += G) transpose_unit<MODE>(scr, s0, s1, ld, nvalid, ksc, gsc, K, dst, u / nnb, u % nnb, kvalid);
    rot = (rot + nu) % G;
}
__device__ __forceinline__ void convert_expert_weights(unsigned char* lds, const P& p, int L) {
    float* scr = (float*)lds; const int G = gridDim.x, tid = threadIdx.x;
    constexpr int S = 261;
    bf16_t* egu = (bf16_t*)(p.ws + WS_EGU); bf16_t* ed = (bf16_t*)(p.ws + WS_ED);
    for (int ub = blockIdx.x; ub < NEXP * 48; ub += G) {
        const int e = ub / 48, r = (ub % 48) * 4;
        bf16_t* dst; int K, k0;
        if (r < 128) {
            const int kb = r >> 3, nb0 = r & 7; k0 = kb * 64; K = D; dst = egu + ((size_t)e * 512 + nb0 * 64) * D;
            const float* gsrc = p.in[22] + ((size_t)L * NEXP + e) * D * EDIM + nb0 * 32; const float* usrc = p.in[23] + ((size_t)L * NEXP + e) * D * EDIM + nb0 * 32;
            f32x4 v[8];
#pragma unroll
            for (int i = 0; i < 8; ++i) { const int idx = tid + 512 * i, kk = idx >> 6, c = idx & 63; v[i] = *(const f32x4*)((c < 32 ? gsrc : usrc) + (size_t)(k0 + kk) * EDIM + (c & 31) * 4); }
#pragma unroll
            for (int i = 0; i < 8; ++i) { const int idx = tid + 512 * i, kk = idx >> 6, c = idx & 63; float* d = scr + kk * S + 8 * (c & 31) + (c >> 5);
                d[0] = v[i].x; d[2] = v[i].y; d[4] = v[i].z; d[6] = v[i].w; }
        } else {
            const int r2 = r - 128, kb = r2 >> 4, nb0 = r2 & 15; k0 = kb * 64; K = EDIM; dst = ed + ((size_t)e * D + nb0 * 64) * EDIM;
            const float* src = p.in[24] + ((size_t)L * NEXP + e) * EDIM * D + nb0 * 64;
            f32x4 v[8];
#pragma unroll
            for (int i = 0; i < 8; ++i) { const int idx = tid + 512 * i, kk = idx >> 6, c = idx & 63; v[i] = *(const f32x4*)(src + (size_t)(k0 + kk) * D + c * 4); }
#pragma unroll
            for (int i = 0; i < 8; ++i) { const int idx = tid + 512 * i, kk = idx >> 6, c = idx & 63; float* d = scr + kk * S + 4 * c;
                d[0] = v[i].x; d[1] = v[i].y; d[2] = v[i].z; d[3] = v[i].w; }
        }
        __syncthreads();
#pragma unroll
        for (int i = 0; i < 4; ++i) {
            const int id = tid + 512 * i, n = id >> 3, kc = id & 7; const float* sp = scr + (kc * 8) * S + n;
            u32x4 o; o.x = cvtpk(sp[0], sp[S]); o.y = cvtpk(sp[2 * S], sp[3 * S]); o.z = cvtpk(sp[4 * S], sp[5 * S]); o.w = cvtpk(sp[6 * S], sp[7 * S]);
            *(u32x4*)(dst + (size_t)n * K + k0 + kc * 8) = o;
        }
        __syncthreads();
    }
}
__device__ __forceinline__ void prep_mod_unit(unsigned char* lds, const P& p, int u) {
    float* sc = (float*)lds;
    float* part = sc + 17 * 1024;
    const int tid = threadIdx.x;
    const float* c = p.in[1]; const float* cctx = p.in[3];
    for (int i = tid; i < 17 * 1024; i += NTHREADS) { const int r = i >> 10, k = i & 1023; const float v = r < 16 ? c[r * 1024 + k] : cctx[k]; sc[i] = v / (1.f + expf(-v)); }
    __syncthreads();
    const int L = u / 192, cg = u % 192, ks = tid >> 5, cl = tid & 31, col = cg * 32 + cl;
    const float* w = p.in[4] + (size_t)L * 1024 * 6144 + (size_t)(ks * 64) * 6144 + col;
    float acc[17];
#pragma unroll
    for (int r = 0; r < 17; ++r) acc[r] = 0.f;
#pragma unroll 8
    for (int k = 0; k < 64; ++k) {
        const float wv = w[(size_t)k * 6144];
#pragma unroll
        for (int r = 0; r < 17; ++r) acc[r] += sc[r * 1024 + ks * 64 + k] * wv;
    }
#pragma unroll
    for (int r = 0; r < 17; ++r) part[(ks * 17 + r) * 32 + cl] = acc[r];
    __syncthreads();
    float* modv = (float*)(p.ws + WS_MODV);
    for (int i = tid; i < 17 * 32; i += NTHREADS) {
        const int r = i >> 5, c2 = i & 31;
        float s2 = p.in[5][L * 6144 + cg * 32 + c2];
#pragma unroll
        for (int q = 0; q < 16; ++q) s2 += part[(q * 17 + r) * 32 + c2];
        modv[((size_t)L * 17 + r) * 6144 + cg * 32 + c2] = s2;
    }
    __syncthreads();
}
__device__ __forceinline__ void phase_prep(unsigned char* lds, const P& p) {
    const int tid = threadIdx.x, G = gridDim.x, bid = blockIdx.x;
    {
        float* ct = (float*)(p.ws + WS_ROPE); float* st = ct + 2048 * 16;
        for (int i = bid * NTHREADS + tid; i < 2048 * 16; i += G * NTHREADS) {
            const int pos = i >> 4, f = i & 15;
            const float inv = powf(10000.f, -(float)(f & 7) / 8.f);
            const float ang = (float)(f < 8 ? (pos >> 6) : (pos & 63)) * inv;
            ct[i] = cosf(ang); st[i] = sinf(ang);
        }
    }
    for (int u = G - 1 - bid; u < 384; u += G) prep_mod_unit(lds, p, u);
    float* scr = (float*)lds; int rot = 0;
    for (int L = 0; L < 2; ++L) {
        transpose_matrix<0>(scr, p.in[7] + (size_t)L * D * Z_END, nullptr, Z_END, Z_END, nullptr, 1.f, D, ZC, (bf16_t*)(p.ws + WS_WIN) + (size_t)L * ZC * D, rot);
        transpose_matrix<1>(scr, p.in[15] + (size_t)L * 256 * 768, nullptr, 768, 768, p.in[14] + L * 256, 0.14724574f, 256, 768, (bf16_t*)(p.ws + WS_WUQ) + (size_t)L * 768 * 256, rot);
        transpose_matrix<0>(scr, p.in[17] + (size_t)L * 128 * 1024, nullptr, 1024, 1024, p.in[16] + L * 128, 1.f, 256, 1024, (bf16_t*)(p.ws + WS_WUKV) + (size_t)L * 1024 * 256, rot, 128);
        transpose_matrix<0>(scr, p.in[18] + (size_t)L * D * D, nullptr, D, D, nullptr, 1.f, D, D, (bf16_t*)(p.ws + WS_WOUT) + (size_t)L * D * D, rot);
        transpose_matrix<0>(scr, p.in[20] + (size_t)L * D * NEXP, nullptr, NEXP, NEXP, nullptr, 1.f, D, 128, (bf16_t*)(p.ws + WS_RT) + (size_t)L * 128 * D, rot);
        transpose_matrix<2>(scr, p.in[25] + (size_t)L * D * EDIM, p.in[26] + (size_t)L * D * EDIM, EDIM, 512, nullptr, 1.f, D, 512, (bf16_t*)(p.ws + WS_SHGU) + (size_t)L * 512 * D, rot);
        transpose_matrix<0>(scr, p.in[27] + (size_t)L * EDIM * D, nullptr, D, D, nullptr, 1.f, EDIM, D, (bf16_t*)(p.ws + WS_SHD) + (size_t)L * D * EDIM, rot);
    }
}

__device__ __forceinline__ void phase_norm_mod(const P& p, int L, int which  , int ntok) {
    const int tid = threadIdx.x, lane = tid & 63, wave = tid >> 6, gw = blockIdx.x * NWAVES + wave, NGW = gridDim.x * NWAVES;
    const float* nw = (which == 0 ? p.in[6] : p.in[19]) + L * D;
    const float* modv = (const float*)(p.ws + WS_MODV) + (size_t)L * 17 * 6144;
    bf16_t* H = (bf16_t*)(p.ws + WS_H);
    for (int tok = gw; tok < ntok; tok += NGW) {
        const f32x4* xr = (const f32x4*)x_in_row(p, tok) + lane;
        const float* mrow = modv + (size_t)mod_row(tok) * 6144 + which * 3072;
        f32x4 v[4]; float s = 0.f;
#pragma unroll
        for (int j = 0; j < 4; ++j) { v[j] = xr[64 * j]; s += v[j].x * v[j].x + v[j].y * v[j].y + v[j].z * v[j].z + v[j].w * v[j].w; }
        const float rstd = rsqrtf(wave_sum(s) * (1.f / D) + NORM_EPS);
        u32x2* o = (u32x2*)(H + (size_t)tok * D) + lane;
#pragma unroll
        for (int j = 0; j < 4; ++j) {
            const int k = 4 * lane + 256 * j;
            const f32x4 w4 = *(const f32x4*)(nw + k), sh = *(const f32x4*)(mrow + k), sc = *(const f32x4*)(mrow + 1024 + k);
            const float y0 = v[j].x * rstd * w4.x * (1.f + sc.x) + sh.x, y1 = v[j].y * rstd * w4.y * (1.f + sc.y) + sh.y;
            const float y2 = v[j].z * rstd * w4.z * (1.f + sc.z) + sh.z, y3 = v[j].w * rstd * w4.w * (1.f + sc.w) + sh.w;
            u32x2 w; w.x = pk2(y0, y1); w.y = pk2(y2, y3); o[64 * j] = w;
        }
    }
}

struct EpiZ {
    bf16_t* Z; float* ssq; float* sskv; bf16_t* Kb; const float* ct; const float* st;
    __device__ __forceinline__ void operator()(const ge::Acc& acc, const ge::Unit& u, int wr, int wc, int fr, int fq) const {
#pragma unroll
        for (int ai = 0; ai < 2; ++ai)
#pragma unroll
            for (int m = 0; m < 4; ++m) {
                const int row = u.a * 256 + ai * 128 + wr * 64 + m * 16 + fr;
#pragma unroll
                for (int bj = 0; bj < 2; ++bj) {
                    const f32x4 v0 = acc[ai][bj][m][0], v1 = acc[ai][bj][m][1];
                    u32x4 w; w.x = cvtpk(v0.x, v0.y); w.y = cvtpk(v0.z, v0.w); w.z = cvtpk(v1.x, v1.y); w.w = cvtpk(v1.z, v1.w);
                    *(u32x4*)(Z + (size_t)row * ZC + u.b * 256 + bj * 128 + wc * 32 + 8 * fq) = w;
                }
                if (u.b == 5) {
                    float sq = 0.f;
#pragma unroll
                    for (int bj = 0; bj < 2; ++bj)
#pragma unroll
                        for (int n = 0; n < 2; ++n) { const f32x4 v = acc[ai][bj][m][n]; sq += v.x * v.x + v.y * v.y + v.z * v.z + v.w * v.w; }
                    sq += __shfl_xor(sq, 16); sq += __shfl_xor(sq, 32);
                    if (fq == 0) ssq[(size_t)row * 4 + wc] = sq;
                }
                if (u.b == 6) {
                    float sq = 0.f;
#pragma unroll
                    for (int n = 0; n < 2; ++n) { const f32x4 v = acc[ai][0][m][n]; sq += v.x * v.x + v.y * v.y + v.z * v.z + v.w * v.w; }
                    sq += __shfl_xor(sq, 16); sq += __shfl_xor(sq, 32);
                    if (fq == 0) sskv[(size_t)row * 4 + wc] = sq;
                    if (wc == 0) {
                        const f32x4 a0 = acc[ai][1][m][0], a1 = acc[ai][1][m][1];
                        f32x4 b0, b1;
#pragma unroll
                        for (int j = 0; j < 4; ++j) { b0[j] = __shfl_xor(a0[j], 32); b1[j] = __shfl_xor(a1[j], 32); }
                        if (fq < 2) {
                            f32x4 c0 = (f32x4){1.f, 1.f, 1.f, 1.f}, c1 = c0, s0 = (f32x4){0.f, 0.f, 0.f, 0.f}, s1 = s0;
                            if (row < NLAT) { const int pos = row & (SEQ - 1); c0 = *(const f32x4*)(ct + pos * 16 + 8 * fq); c1 = *(const f32x4*)(ct + pos * 16 + 8 * fq + 4); s0 = *(const f32x4*)(st + pos * 16 + 8 * fq); s1 = *(const f32x4*)(st + pos * 16 + 8 * fq + 4); }
                            const f32x4 o10 = a0 * c0 - b0 * s0, o20 = a0 * s0 + b0 * c0, o11 = a1 * c1 - b1 * s1, o21 = a1 * s1 + b1 * c1;
                            u32x4 w0, w1; w0.x = cvtpk(o10.x, o20.x); w0.y = cvtpk(o10.y, o20.y); w0.z = cvtpk(o10.z, o20.z); w0.w = cvtpk(o10.w, o20.w);
                            w1.x = cvtpk(o11.x, o21.x); w1.y = cvtpk(o11.y, o21.y); w1.z = cvtpk(o11.z, o21.z); w1.w = cvtpk(o11.w, o21.w);
#pragma unroll
                            for (int h = 0; h < 8; ++h) { bf16_t* kp = Kb + (size_t)row * 768 + h * 96 + 64 + 16 * fq; *(u32x4*)kp = w0; *(u32x4*)(kp + 8) = w1; }
                        }
                    }
                }
            }
    }
};
__device__ __forceinline__ void phase_zgemm(unsigned char* lds, const P& p, int L) {
    const bf16_t* W = (const bf16_t*)(p.ws + WS_WIN) + (size_t)L * ZC * D;
    ge::DenseOrder S; S.nM = NTOK / 256; S.nN = ZC / 256; S.nwg = S.nM * S.nN; S.G = gridDim.x; S.c = blockIdx.x; S.Bt = (const char*)W; S.btile = (size_t)256 * D * 2; S.arow = D * 2;
    EpiZ E{(bf16_t*)(p.ws + WS_Z), (float*)(p.ws + WS_SS), (float*)(p.ws + WS_SS) + (size_t)NTOK * 4, (bf16_t*)(p.ws + WS_K), (const float*)(p.ws + WS_ROPE), (const float*)(p.ws + WS_ROPE) + 2048 * 16};
    ge::gemm_stream<ge::DenseOrder, EpiZ, true>((LAS unsigned char*)lds, (const char*)(p.ws + (L == 0 ? WS_H : WS_H1)), D, S, E);
}

__device__ __forceinline__ void conv_unit(unsigned char* lds, const P& p, int L, int s, int tt) {
    float* hg = (float*)lds;
    const int tid = threadIdx.x, lane = tid & 63, wave = tid >> 6;
    const int rb = s < 16 ? s * SEQ : NLAT + (s - 16) * CTXL, len = s < 16 ? SEQ : CTXL, t0 = tt * 64;
    const bf16_t* Z = (const bf16_t*)(p.ws + WS_Z);
    for (int i = tid; i < 94 * 64; i += NTHREADS) {
        const int jj = i >> 6, c4 = (i & 63) * 4, t = t0 - 15 + jj;
        f32x4 h = (f32x4){0.f, 0.f, 0.f, 0.f};
        if (t >= 0 && t < len) {
            const bf16_t* zr = Z + (size_t)(rb + t) * ZC;
            const u32x2 a = *(const u32x2*)(zr + c4), g = *(const u32x2*)(zr + 256 + c4);
            const float g0 = lo16(g.x), g1 = hi16(g.x), g2 = lo16(g.y), g3 = hi16(g.y);
            h.x = lo16(a.x) / (1.f + __expf(-g0)); h.y = hi16(a.x) / (1.f + __expf(-g1));
            h.z = lo16(a.y) / (1.f + __expf(-g2)); h.w = hi16(a.y) / (1.f + __expf(-g3));
        }
        *(f32x4*)(hg + jj * 256 + c4) = h;
    }
    float* wl = hg + 94 * 256;
    for (int i = tid; i < 31 * 64; i += NTHREADS) *(f32x4*)(wl + i * 4) = *(const f32x4*)(p.in[8] + (size_t)L * 31 * 256 + i * 4);
    __syncthreads();
    const int c0 = lane * 4;
    const f32x4 cb = *(const f32x4*)(p.in[9] + L * 256 + c0), lw = *(const f32x4*)(p.in[10] + L * 256 + c0), lb = *(const f32x4*)(p.in[11] + L * 256 + c0);
    bf16_t* CC = (bf16_t*)(p.ws + WS_CC);
    for (int q = 0; q < 8; ++q) {
        const int tl = wave * 8 + q;
        f32x4 acc = cb;
#pragma unroll 4
        for (int j = 0; j < 31; ++j) { const f32x4 h = *(const f32x4*)(hg + (tl + j) * 256 + c0); acc += h * *(const f32x4*)(wl + j * 256 + c0); }
        const float mean = wave_sum(acc.x + acc.y + acc.z + acc.w) * (1.f / 256.f);
        const f32x4 d = acc - mean;
        const float var = wave_sum(d.x * d.x + d.y * d.y + d.z * d.z + d.w * d.w) * (1.f / 256.f);
        const float rstd = rsqrtf(var + NORM_EPS);
        const f32x4 y = d * rstd * lw + lb;
        u32x2 o; o.x = pk2(siluf(y.x), siluf(y.y)); o.y = pk2(siluf(y.z), siluf(y.w));
        *(u32x2*)(CC + (size_t)(rb + t0 + tl) * D + c0) = o;
    }
    __syncthreads();
}

__device__ __forceinline__ float log2_gamma(const P& p, int L, int dir, int h) {
    const float x = p.in[12][(L * 2 + dir) * 4 + h];
    const float ls = fminf(x, 0.f) - log1pf(expf(-fabsf(x)));
    return ls * 1.4426950408889634f;
}
__device__ __forceinline__ void load_ret_qk(float* dst, const P& p, int gc, int h, int zoff, float scale) {
    const int tid = threadIdx.x, j = tid >> 2, i0 = (tid & 3) * 4, row = gc * 128 + j;
    const bf16_t* zr = (const bf16_t*)(p.ws + WS_Z) + (size_t)row * ZC + zoff + h * 32;
    const u32x2 a = *(const u32x2*)(zr + i0), b = *(const u32x2*)(zr + 16 + i0);
    float x1[4] = {lo16(a.x), hi16(a.x), lo16(a.y), hi16(a.y)}, x2[4] = {lo16(b.x), hi16(b.x), lo16(b.y), hi16(b.y)};
    const bool lat = row < NLAT; const int pos = row & (SEQ - 1);
    const float* ct = (const float*)(p.ws + WS_ROPE) + pos * 16 + i0; const float* st = ct + 2048 * 16;
#pragma unroll
    for (int i = 0; i < 4; ++i) {
        const float c = lat ? ct[i] : 1.f, s = lat ? st[i] : 0.f;
        dst[j * 33 + i0 + i] = (x1[i] * c - x2[i] * s) * scale;
        dst[j * 33 + 16 + i0 + i] = (x1[i] * s + x2[i] * c) * scale;
    }
}
__device__ __forceinline__ void load_ret_v(float* dst  , const P& p, int gc, int h) {
    const int tid = threadIdx.x, j = tid >> 2, e0 = (tid & 3) * 16;
    const bf16_t* zr = (const bf16_t*)(p.ws + WS_Z) + (size_t)(gc * 128 + j) * ZC + Z_RV + h * 64 + e0;
    const u32x4 a = *(const u32x4*)zr, b = *(const u32x4*)(zr + 8);
#pragma unroll
    for (int i = 0; i < 4; ++i) { dst[j * 64 + e0 + 2 * i] = lo16(a[i]); dst[j * 64 + e0 + 2 * i + 1] = hi16(a[i]); dst[j * 64 + e0 + 8 + 2 * i] = lo16(b[i]); dst[j * 64 + e0 + 8 + 2 * i + 1] = hi16(b[i]); }
}
__device__ __forceinline__ void retkv_unit(unsigned char* lds, const P& p, int L, int gc, int h) {
    float* ks = (float*)lds; float* vs = ks + 128 * 33; float* wf = vs + 128 * 64; float* wb = wf + 128;
    const int tid = threadIdx.x;
    const float l2f = log2_gamma(p, L, 0, h), l2b = log2_gamma(p, L, 1, h);
    load_ret_qk(ks, p, gc, h, Z_RK, 0.17677669529663687f);
    load_ret_v(vs, p, gc, h);
    if (tid < 128) { wf[tid] = exp2f(l2f * (float)(127 - tid)); wb[tid] = exp2f(l2b * (float)tid); }
    __syncthreads();
    const int d = tid >> 4, e0 = (tid & 15) * 4;
    f32x4 af = (f32x4){0.f, 0.f, 0.f, 0.f}, ab = af;
    for (int j = 0; j < 128; ++j) {
        const float kd = ks[j * 33 + d]; const f32x4 v4 = *(const f32x4*)(vs + j * 64 + e0);
        af += (kd * wf[j]) * v4; ab += (kd * wb[j]) * v4;
    }
    float* KV = (float*)(p.ws + WS_KV) + ((size_t)(gc * 4 + h) * 2) * 2048;
    *(f32x4*)(KV + d * 64 + e0) = af; *(f32x4*)(KV + 2048 + d * 64 + e0) = ab;
    __syncthreads();
}
__device__ __forceinline__ void ret_stage_k(unsigned char* kf, unsigned char* kb, int rowb, const P& p, int gc, int h, float ef, float jf0, float eb, float jb0) {
    const int tid = threadIdx.x, j = tid >> 2, i0 = (tid & 3) * 4, row = gc * 128 + j;
    const bf16_t* zr = (const bf16_t*)(p.ws + WS_Z) + (size_t)row * ZC + Z_RK + h * 32;
    const u32x2 a = *(const u32x2*)(zr + i0), b = *(const u32x2*)(zr + 16 + i0);
    const float x1[4] = {lo16(a.x), hi16(a.x), lo16(a.y), hi16(a.y)}, x2[4] = {lo16(b.x), hi16(b.x), lo16(b.y), hi16(b.y)};
    f32x4 c4 = (f32x4){1.f, 1.f, 1.f, 1.f}, s4 = (f32x4){0.f, 0.f, 0.f, 0.f};
    if (row < NLAT) { const int pos = row & (SEQ - 1); const float* ct = (const float*)(p.ws + WS_ROPE) + pos * 16 + i0; c4 = *(const f32x4*)ct; s4 = *(const f32x4*)(ct + 2048 * 16); }
    const float wf = exp2f(ef * ((float)j - jf0)) * 0.17677669529663687f, wb = exp2f(eb * ((float)j - jb0)) * 0.17677669529663687f;
    float o1[4], o2[4];
#pragma unroll
    for (int i = 0; i < 4; ++i) { o1[i] = x1[i] * c4[i] - x2[i] * s4[i]; o2[i] = x1[i] * s4[i] + x2[i] * c4[i]; }
    u32x2 w;
    w.x = cvtpk(o1[0] * wf, o1[1] * wf); w.y = cvtpk(o1[2] * wf, o1[3] * wf); *(u32x2*)(kf + j * rowb + i0 * 2) = w;
    w.x = cvtpk(o2[0] * wf, o2[1] * wf); w.y = cvtpk(o2[2] * wf, o2[3] * wf); *(u32x2*)(kf + j * rowb + 32 + i0 * 2) = w;
    w.x = cvtpk(o1[0] * wb, o1[1] * wb); w.y = cvtpk(o1[2] * wb, o1[3] * wb); *(u32x2*)(kb + j * rowb + i0 * 2) = w;
    w.x = cvtpk(o2[0] * wb, o2[1] * wb); w.y = cvtpk(o2[2] * wb, o2[3] * wb); *(u32x2*)(kb + j * rowb + 32 + i0 * 2) = w;
}
__device__ __forceinline__ void ret_stage_v(unsigned char* vt, const P& p, int gc, int h) {
    const int tid = threadIdx.x, j = tid >> 2, e0 = (tid & 3) * 16;
    const bf16_t* zr = (const bf16_t*)(p.ws + WS_Z) + (size_t)(gc * 128 + j) * ZC + Z_RV + h * 64 + e0;
    const u32x4 a = *(const u32x4*)zr, b = *(const u32x4*)(zr + 8);
    unsigned char* d = vt + (e0 >> 5) * 8192 + j * 64 + (e0 & 31) * 2;
    *(u32x4*)d = a; *(u32x4*)(d + 16) = b;
}
__device__ __forceinline__ bf16x8 tr8(const unsigned char* p0, const unsigned char* p1) {
    const v4i16_t a = __builtin_amdgcn_ds_read_tr16_b64_v4i16((LAS v4i16_t*)(const LAS unsigned char*)p0), b = __builtin_amdgcn_ds_read_tr16_b64_v4i16((LAS v4i16_t*)(const LAS unsigned char*)p1);
    return (bf16x8){a[0], a[1], a[2], a[3], b[0], b[1], b[2], b[3]};
}
__device__ __forceinline__ void retkv_unit_mfma(unsigned char* lds, const P& p, int L, int gc, int h) {
    const int tid = threadIdx.x, lane = tid & 63, wid = tid >> 6;
    const float l2f = log2_gamma(p, L, 0, h), l2b = log2_gamma(p, L, 1, h);
    ret_stage_k(lds, lds + 8192, 64, p, gc, h, -l2f, 127.f, l2b, 0.f);
    ret_stage_v(lds + 16384, p, gc, h);
    __syncthreads();
    if (wid < 4) {
        const int dir = wid >> 1, eb = wid & 1, g = lane >> 4, i = lane & 15, hh = lane >> 5;
        const int off = (8 * hh + (i >> 2)) * 64 + (g & 1) * 32 + (i & 3) * 8;
        const unsigned char* Kt = lds + dir * 8192 + off; const unsigned char* Vt = lds + 16384 + eb * 8192 + off;
        f32x16 acc;
#pragma unroll
        for (int r = 0; r < 16; ++r) acc[r] = 0.f;
#pragma unroll
        for (int s = 0; s < 8; ++s) acc = __builtin_amdgcn_mfma_f32_32x32x16_bf16(tr8(Vt + s * 1024, Vt + s * 1024 + 256), tr8(Kt + s * 1024, Kt + s * 1024 + 256), acc, 0, 0, 0);
        float* KV = (float*)(p.ws + WS_KV) + ((size_t)(gc * 4 + h) * 2 + dir) * 2048 + (lane & 31) * 64 + eb * 32 + 4 * hh;
#pragma unroll
        for (int r4 = 0; r4 < 4; ++r4) *(f32x4*)(KV + 8 * r4) = (f32x4){acc[4 * r4], acc[4 * r4 + 1], acc[4 * r4 + 2], acc[4 * r4 + 3]};
    }
    __syncthreads();
}
__device__ __forceinline__ void retout_unit_mfma(unsigned char* lds, const P& p, int L, int gc, int h) {
    constexpr int KROW = 80, O_KF = 0, O_KB = 10240, O_V = 20480, O_SF = 36864, O_SB = 41984, O_RED = 47104;
    const int tid = threadIdx.x, lane = tid & 63, wid = tid >> 6, r32 = lane & 31, hh = lane >> 5;
    const float l2f = log2_gamma(p, L, 0, h), l2b = log2_gamma(p, L, 1, h);
    ret_stage_k(lds + O_KF, lds + O_KB, KROW, p, gc, h, -l2f, 0.f, l2b, 0.f);
    ret_stage_v(lds + O_V, p, gc, h);
    {
        const bool lat = gc < 256; const int b = lat ? gc >> 4 : (gc - 256) >> 1;
        const int mme = lat ? 2 + (gc & 15) : (gc - 256) & 1;
        const int u = mme, w = mme < 2 ? 1 - mme : 19 - mme;
        f32x4 sf = (f32x4){0.f, 0.f, 0.f, 0.f}, sb = sf;
        const float* KVb = (const float*)(p.ws + WS_KV);
#pragma unroll 1
        for (int mm = 0; mm < 18; ++mm) {
            const int gcm = mm < 2 ? 256 + b * 2 + mm : b * 16 + (mm - 2);
            const int um = mm, wm = mm < 2 ? 1 - mm : 19 - mm;
            const float* kv = KVb + ((size_t)(gcm * 4 + h) * 2) * 2048 + tid * 4;
            if (um < u) { const float wgt = exp2f(l2f * 128.f * (float)(u - 1 - um)); sf += wgt * *(const f32x4*)kv; }
            if (wm < w) { const float wgt = exp2f(l2b * 128.f * (float)(w - 1 - wm)); sb += wgt * *(const f32x4*)(kv + 2048); }
        }
        const int d = tid >> 4, e0 = (tid & 15) * 4;
#pragma unroll
        for (int k = 0; k < 4; ++k) { *(bf16_t*)(lds + O_SF + (e0 + k) * KROW + d * 2) = (bf16_t)(cvtpk(sf[k], 0.f) & 0xffffu); *(bf16_t*)(lds + O_SB + (e0 + k) * KROW + d * 2) = (bf16_t)(cvtpk(sb[k], 0.f) & 0xffffu); }
    }
    __syncthreads();
    const int qb = wid & 3, eb = wid >> 2, i = qb * 32 + r32, row = gc * 128 + i;
    bf16x8 qf[2];
    {
        const bf16_t* zr = (const bf16_t*)(p.ws + WS_Z) + (size_t)row * ZC + Z_RQ + h * 32 + 8 * hh;
        const u32x4 a = *(const u32x4*)zr, b = *(const u32x4*)(zr + 16);
        float x1[8], x2[8];
#pragma unroll
        for (int k = 0; k < 4; ++k) { x1[2 * k] = lo16(a[k]); x1[2 * k + 1] = hi16(a[k]); x2[2 * k] = lo16(b[k]); x2[2 * k + 1] = hi16(b[k]); }
        if (row < NLAT) {
            const float* ct = (const float*)(p.ws + WS_ROPE) + (row & (SEQ - 1)) * 16 + 8 * hh; const float* st = ct + 2048 * 16;
#pragma unroll
            for (int k = 0; k < 8; ++k) { const float c = ct[k], sn = st[k], u1 = x1[k], u2 = x2[k]; x1[k] = u1 * c - u2 * sn; x2[k] = u1 * sn + u2 * c; }
        }
        const u32x4 q0 = (u32x4){cvtpk(x1[0], x1[1]), cvtpk(x1[2], x1[3]), cvtpk(x1[4], x1[5]), cvtpk(x1[6], x1[7])};
        const u32x4 q1 = (u32x4){cvtpk(x2[0], x2[1]), cvtpk(x2[2], x2[3]), cvtpk(x2[4], x2[5]), cvtpk(x2[6], x2[7])};
        qf[0] = __builtin_bit_cast(bf16x8, q0); qf[1] = __builtin_bit_cast(bf16x8, q1);
    }
    const float af = exp2f(l2f * (float)i), ab = exp2f(-l2b * (float)i), cf = exp2f(l2f * (float)(i + 1)), cb = exp2f(l2b * (float)(128 - i));
    f32x16 y, zero;
#pragma unroll
    for (int r = 0; r < 16; ++r) { y[r] = 0.f; zero[r] = 0.f; }
    const int koff = r32 * KROW + 16 * hh;
    const int voff = O_V + eb * 8192 + (4 * hh + ((lane & 15) >> 2)) * 64 + ((lane >> 4) & 1) * 32 + (lane & 3) * 8;
#pragma unroll
    for (int kb = 0; kb < 4; ++kb) {
        f32x16 pt;
        if (kb <= qb) {
            f32x16 sF = __builtin_amdgcn_mfma_f32_32x32x16_bf16(*(const bf16x8*)(lds + O_KF + kb * 32 * KROW + koff), qf[0], zero, 0, 0, 0);
            sF = __builtin_amdgcn_mfma_f32_32x32x16_bf16(*(const bf16x8*)(lds + O_KF + kb * 32 * KROW + koff + 32), qf[1], sF, 0, 0, 0);
            if (kb < qb) {
#pragma unroll
                for (int r = 0; r < 16; ++r) pt[r] = sF[r] * af;
            } else {
#pragma unroll
                for (int r = 0; r < 16; ++r) { const int j = (r & 3) + 8 * (r >> 2) + 4 * hh; pt[r] = (j <= r32) ? sF[r] * af : 0.f; }
            }
        }
        if (kb >= qb) {
            f32x16 sB = __builtin_amdgcn_mfma_f32_32x32x16_bf16(*(const bf16x8*)(lds + O_KB + kb * 32 * KROW + koff), qf[0], zero, 0, 0, 0);
            sB = __builtin_amdgcn_mfma_f32_32x32x16_bf16(*(const bf16x8*)(lds + O_KB + kb * 32 * KROW + koff + 32), qf[1], sB, 0, 0, 0);
            if (kb > qb) {
#pragma unroll
                for (int r = 0; r < 16; ++r) pt[r] = sB[r] * ab;
            } else {
#pragma unroll
                for (int r = 0; r < 16; ++r) { const int j = (r & 3) + 8 * (r >> 2) + 4 * hh; pt[r] += (j >= r32) ? sB[r] * ab : 0.f; }
            }
        }
#pragma unroll
        for (int s2 = 0; s2 < 2; ++s2) {
            const u32x4 pw = (u32x4){cvtpk(pt[8 * s2], pt[8 * s2 + 1]), cvtpk(pt[8 * s2 + 2], pt[8 * s2 + 3]), cvtpk(pt[8 * s2 + 4], pt[8 * s2 + 5]), cvtpk(pt[8 * s2 + 6], pt[8 * s2 + 7])};
            const unsigned char* vb = lds + voff + (kb * 32 + s2 * 16) * 64;
            y = __builtin_amdgcn_mfma_f32_32x32x16_bf16(tr8(vb, vb + 8 * 64), __builtin_bit_cast(bf16x8, pw), y, 0, 0, 0);
        }
    }
    {
        const int soff = (eb * 32 + r32) * KROW + 16 * hh;
        f32x16 tF = __builtin_amdgcn_mfma_f32_32x32x16_bf16(*(const bf16x8*)(lds + O_SF + soff), qf[0], zero, 0, 0, 0);
        tF = __builtin_amdgcn_mfma_f32_32x32x16_bf16(*(const bf16x8*)(lds + O_SF + soff + 32), qf[1], tF, 0, 0, 0);
        f32x16 tB = __builtin_amdgcn_mfma_f32_32x32x16_bf16(*(const bf16x8*)(lds + O_SB + soff), qf[0], zero, 0, 0, 0);
        tB = __builtin_amdgcn_mfma_f32_32x32x16_bf16(*(const bf16x8*)(lds + O_SB + soff + 32), qf[1], tB, 0, 0, 0);
#pragma unroll
        for (int r = 0; r < 16; ++r) y[r] += tF[r] * cf + tB[r] * cb;
    }
    float s1 = 0.f, s2 = 0.f;
#pragma unroll
    for (int r = 0; r < 16; ++r) { s1 += y[r]; s2 += y[r] * y[r]; }
    s1 += __shfl_xor(s1, 32); s2 += __shfl_xor(s2, 32);
    float* red = (float*)(lds + O_RED);
    if (hh == 0) { red[(eb * 128 + i) * 2] = s1; red[(eb * 128 + i) * 2 + 1] = s2; }
    __syncthreads();
    s1 = red[i * 2] + red[(128 + i) * 2]; s2 = red[i * 2 + 1] + red[(128 + i) * 2 + 1];
    const float mu = s1 * (1.f / 64.f), var = fmaxf(s2 * (1.f / 64.f) - mu * mu, 0.f), rstd = rsqrtf(var + NORM_EPS);
    const bf16_t* zg = (const bf16_t*)(p.ws + WS_Z) + (size_t)row * ZC + Z_RG + h * 64 + eb * 32 + 4 * hh;
    const float* gw = p.in[13] + L * 256 + h * 64 + eb * 32 + 4 * hh;
    bf16_t* orow = (bf16_t*)(p.ws + WS_CC) + (size_t)row * D + 256 + h * 64 + eb * 32 + 4 * hh;
#pragma unroll
    for (int r4 = 0; r4 < 4; ++r4) {
        const u32x2 gz = *(const u32x2*)(zg + 8 * r4); const f32x4 w4 = *(const f32x4*)(gw + 8 * r4);
        const float g0 = lo16(gz.x), g1 = hi16(gz.x), g2 = lo16(gz.y), g3 = hi16(gz.y);
        u32x2 o; o.x = cvtpk(siluf(g0) * ((y[4 * r4] - mu) * rstd * w4.x), siluf(g1) * ((y[4 * r4 + 1] - mu) * rstd * w4.y));
        o.y = cvtpk(siluf(g2) * ((y[4 * r4 + 2] - mu) * rstd * w4.z), siluf(g3) * ((y[4 * r4 + 3] - mu) * rstd * w4.w));
        *(u32x2*)(orow + 8 * r4) = o;
    }
    __syncthreads();
}
__device__ __forceinline__ void qkv_proj(unsigned char* lds, const P& p, int L) {
    const float* sskv = (const float*)(p.ws + WS_SS) + (size_t)NTOK * 4;
    const int G = gridDim.x, bid = blockIdx.x;
    {
        bf16_t* Q = (bf16_t*)(p.ws + WS_Q);
        ge::DenseOrder S; S.nM = NTOK / 256; S.nN = 3; S.nwg = S.nM * 3; S.G = G; S.c = bid; S.Bt = (const char*)((const bf16_t*)(p.ws + WS_WUQ) + (size_t)L * 768 * 256); S.btile = (size_t)256 * 256 * 2; S.arow = ZC * 2;
        auto f = [&](const ge::Unit& u, int r, int c, f32x4 v0, f32x4 v1) {
            u32x4 w; w.x = cvtpk(v0.x, v0.y); w.y = cvtpk(v0.z, v0.w); w.z = cvtpk(v1.x, v1.y); w.w = cvtpk(v1.z, v1.w); *(u32x4*)(Q + (size_t)(u.a * 256 + r) * 768 + u.b * 256 + c) = w;
        };
        ge::EpiFn<decltype(f)> E{f};
        ge::gemm_stream<ge::DenseOrder, ge::EpiFn<decltype(f)>, true>((LAS unsigned char*)lds, (const char*)(p.ws + WS_Z) + Z_CQ * 2, 256, S, E);
    }
    {
        bf16_t* Kb = (bf16_t*)(p.ws + WS_K); bf16_t* Vb = (bf16_t*)(p.ws + WS_V);
        ge::DenseOrder S; S.nM = NTOK / 256; S.nN = 4; S.nwg = S.nM * 4; S.G = G; S.c = (bid + 176) % G; S.Bt = (const char*)((const bf16_t*)(p.ws + WS_WUKV) + (size_t)L * 1024 * 256); S.btile = (size_t)256 * 256 * 2; S.arow = ZC * 2;
        struct EpiKV {
            bf16_t* Kb; bf16_t* Vb; const float* sskv;
            __device__ __forceinline__ void operator()(const ge::Acc& acc, const ge::Unit& u, int wr, int wc, int fr, int fq) const {
                float rstd[2][4];
#pragma unroll
                for (int ai = 0; ai < 2; ++ai)
#pragma unroll
                    for (int m = 0; m < 4; ++m) { const f32x4 s4 = *(const f32x4*)(sskv + (size_t)(u.a * 256 + ai * 128 + wr * 64 + m * 16 + fr) * 4); rstd[ai][m] = rsqrtf((s4.x + s4.y + s4.z + s4.w) * (1.f / 128.f) + NORM_EPS); }
#pragma unroll
                for (int ai = 0; ai < 2; ++ai)
#pragma unroll
                    for (int m = 0; m < 4; ++m) {
                        const int row = u.a * 256 + ai * 128 + wr * 64 + m * 16 + fr;
#pragma unroll
                        for (int bj = 0; bj < 2; ++bj) {
                            const int col = u.b * 256 + bj * 128 + wc * 32 + 8 * fq, h = col >> 7, j = col & 127;
                            const f32x4 v0 = acc[ai][bj][m][0] * rstd[ai][m], v1 = acc[ai][bj][m][1] * rstd[ai][m];
                            u32x4 w; w.x = cvtpk(v0.x, v0.y); w.y = cvtpk(v0.z, v0.w); w.z = cvtpk(v1.x, v1.y); w.w = cvtpk(v1.z, v1.w);
                            if (j < 64) *(u32x4*)(Kb + (size_t)row * 768 + h * 96 + j) = w;
                            else *(u32x4*)(Vb + (size_t)row * 512 + h * 64 + (j - 64)) = w;
                        }
                    }
            }
        };
        EpiKV E{Kb, Vb, sskv};
        ge::gemm_stream<ge::DenseOrder, EpiKV, true>((LAS unsigned char*)lds, (const char*)(p.ws + WS_Z) + Z_CKV * 2, 256, S, E);
    }
}
__device__ __forceinline__ void phase_b(unsigned char* lds, const P& p, int L) {
    const int G = gridDim.x, bid = blockIdx.x;
    qkv_proj(lds, p, L);
    const int nconv = (L == 0) ? 576 : 512;
    const int nkv = 288 * 4;
    const int total = nconv + nkv;
    for (int u = (bid + 96) % G; u < total; u += G) {
        int r = u;
        if (r < nconv) { if (r < 512) conv_unit(lds, p, L, r >> 5, r & 31); else conv_unit(lds, p, L, 16 + ((r - 512) >> 2), (r - 512) & 3); continue; } r -= nconv;
        retkv_unit_mfma(lds, p, L, r >> 2, r & 3);
    }
    if (L == 1) convert_expert_weights(lds, p, 1);
}

__device__ __forceinline__ void attn_unit_naive(unsigned char* lds, const P& p, int b, int h, int qb, bool ctxq) {
    float* Ks = (float*)lds;
    float* Vs = Ks + 64 * 96;
    const int tid = threadIdx.x, half = tid & 1, qi = tid >> 1;
    const bf16_t* Qb = (const bf16_t*)(p.ws + WS_Q); const bf16_t* Kb = (const bf16_t*)(p.ws + WS_K); const bf16_t* Vb = (const bf16_t*)(p.ws + WS_V);
    const int qrow = ctxq ? NLAT + b * CTXL + qi : b * SEQ + qb * 256 + qi;
    float q[48];
    {
        const u32x4* qp = (const u32x4*)(Qb + (size_t)qrow * 768 + h * 96 + half * 48);
#pragma unroll
        for (int i = 0; i < 6; ++i) { const u32x4 w = qp[i];
#pragma unroll
            for (int k = 0; k < 4; ++k) { q[i * 8 + 2 * k] = lo16(w[k]); q[i * 8 + 2 * k + 1] = hi16(w[k]); } }
    }
    float o[32];
#pragma unroll
    for (int e = 0; e < 32; ++e) o[e] = 0.f;
    float m = -1e30f, l = 0.f;
    const int ntiles = ctxq ? 4 : 36;
#pragma unroll 1
    for (int t = 0; t < ntiles; ++t) {
        const int krow0 = t < 4 ? NLAT + b * CTXL + t * 64 : b * SEQ + (t - 4) * 64;
        __syncthreads();
        for (int i = tid; i < 64 * 12; i += NTHREADS) { const int key = i / 12, c = i % 12; const u32x4 w = *(const u32x4*)(Kb + (size_t)(krow0 + key) * 768 + h * 96 + c * 8);
            float* d = Ks + key * 96 + c * 8;
#pragma unroll
            for (int k = 0; k < 4; ++k) { d[2 * k] = lo16(w[k]); d[2 * k + 1] = hi16(w[k]); } }
        for (int i = tid; i < 64 * 8; i += NTHREADS) { const int key = i >> 3, c = i & 7; const u32x4 w = *(const u32x4*)(Vb + (size_t)(krow0 + key) * 512 + h * 64 + c * 8);
            float* d = Vs + key * 64 + c * 8;
#pragma unroll
            for (int k = 0; k < 4; ++k) { d[2 * k] = lo16(w[k]); d[2 * k + 1] = hi16(w[k]); } }
        __syncthreads();
#pragma unroll 1
        for (int j0 = 0; j0 < 64; j0 += 2) {
            float s[2]; float mt = -1e30f;
#pragma unroll
            for (int jj = 0; jj < 2; ++jj) {
                const f32x4* kr = (const f32x4*)(Ks + (j0 + jj) * 96 + half * 48);
                float a = 0.f;
#pragma unroll
                for (int d4 = 0; d4 < 12; ++d4) { const f32x4 kv = kr[d4]; a += q[4 * d4] * kv.x + q[4 * d4 + 1] * kv.y + q[4 * d4 + 2] * kv.z + q[4 * d4 + 3] * kv.w; }
                a += __shfl_xor(a, 1);
                s[jj] = a; mt = fmaxf(mt, a);
            }
            const float mn = fmaxf(m, mt), alpha = exp2f(m - mn);
            m = mn; l *= alpha;
#pragma unroll
            for (int e = 0; e < 32; ++e) o[e] *= alpha;
#pragma unroll
            for (int jj = 0; jj < 2; ++jj) {
                const float pj = exp2f(s[jj] - mn); l += pj;
                const f32x4* vr = (const f32x4*)(Vs + (j0 + jj) * 64 + half * 32);
#pragma unroll
                for (int e4 = 0; e4 < 8; ++e4) { const f32x4 vv = vr[e4]; o[4 * e4] += pj * vv.x; o[4 * e4 + 1] += pj * vv.y; o[4 * e4 + 2] += pj * vv.z; o[4 * e4 + 3] += pj * vv.w; }
            }
        }
    }
    {
        const float rl = 1.f / l;
        u32x4* op = (u32x4*)((bf16_t*)(p.ws + WS_CC) + (size_t)qrow * D + 512 + h * 64 + half * 32);
#pragma unroll
        for (int i = 0; i < 4; ++i) { u32x4 w; w.x = pk2(o[8 * i] * rl, o[8 * i + 1] * rl); w.y = pk2(o[8 * i + 2] * rl, o[8 * i + 3] * rl); w.z = pk2(o[8 * i + 4] * rl, o[8 * i + 5] * rl); w.w = pk2(o[8 * i + 6] * rl, o[8 * i + 7] * rl); op[i] = w; }
    }
    __syncthreads();
}
__device__ __forceinline__ float max3f(float a, float b, float c) { float r; asm("v_max3_f32 %0, %1, %2, %3" : "=v"(r) : "v"(a), "v"(b), "v"(c)); return r; }
constexpr int AT_KROW = 208;
constexpr int AT_KBUF = 64 * AT_KROW;
constexpr int AT_VBUF = 8192;
constexpr int AT_BUF = AT_KBUF + AT_VBUF;
__device__ __forceinline__ void attn_unit_mfma(unsigned char* lds, const P& p, int b, int h, int qb, bool ctxq) {
    const int tid = threadIdx.x, lane = tid & 63, wid = tid >> 6, r32 = lane & 31, hh = lane >> 5;
    const bf16_t* Qb = (const bf16_t*)(p.ws + WS_Q); const bf16_t* Kb = (const bf16_t*)(p.ws + WS_K); const bf16_t* Vb = (const bf16_t*)(p.ws + WS_V);
    const int qrow = (ctxq ? NLAT + b * CTXL : b * SEQ + qb * 256) + wid * 32 + r32;
    bf16x8 qf[6];
    {
        const f32x4 s4 = *(const f32x4*)((const float*)(p.ws + WS_SS) + (size_t)qrow * 4);
        const float rstd = rsqrtf((s4.x + s4.y + s4.z + s4.w) * (1.f / 256.f) + NORM_EPS);
        const float* ct = (const float*)(p.ws + WS_ROPE) + (qrow & (SEQ - 1)) * 16; const float* st = ct + 2048 * 16;
#pragma unroll
        for (int s = 0; s < 6; ++s) {
            const u32x4 w = *(const u32x4*)(Qb + (size_t)qrow * 768 + h * 96 + 16 * s + 8 * hh);
            float x[8];
#pragma unroll
            for (int k = 0; k < 4; ++k) { x[2 * k] = lo16(w[k]) * rstd; x[2 * k + 1] = hi16(w[k]) * rstd; }
            if (s >= 4 && !ctxq) {
                const f32x4 c4 = *(const f32x4*)(ct + 8 * (s - 4) + 4 * hh), sn = *(const f32x4*)(st + 8 * (s - 4) + 4 * hh);
#pragma unroll
                for (int k = 0; k < 4; ++k) { const float a = x[2 * k], b2 = x[2 * k + 1]; x[2 * k] = a * c4[k] - b2 * sn[k]; x[2 * k + 1] = a * sn[k] + b2 * c4[k]; }
            }
            const u32x4 o = (u32x4){cvtpk(x[0], x[1]), cvtpk(x[2], x[3]), cvtpk(x[4], x[5]), cvtpk(x[6], x[7])};
            qf[s] = __builtin_bit_cast(bf16x8, o);
        }
    }
    f32x16 o0, o1, negm;
#pragma unroll
    for (int r = 0; r < 16; ++r) { o0[r] = 0.f; o1[r] = 0.f; negm[r] = 0.f; }
    asm volatile("" : "+v"(negm));
    float mhat = 0.f, l = 0.f;
    const int ntiles = ctxq ? 4 : 36;
    const int wv = __builtin_amdgcn_readfirstlane(wid);
    const int ia = wv, ib = (wv + 8 < 13) ? wv + 8 : 12;
    const int qa = ia * 64 + lane, qb2 = ib * 64 + lane, qv = wv * 64 + lane;
    const int ca = qa % 13, cb = qb2 % 13;
    const size_t ka = (size_t)(qa / 13) * 768 + h * 96 + (ca < 12 ? ca : 11) * 8, kbo = (size_t)(qb2 / 13) * 768 + h * 96 + (cb < 12 ? cb : 11) * 8;
    const size_t vo = (size_t)((qv >> 2) & 63) * 512 + h * 64 + (qv >> 8) * 32 + (qv & 3) * 8;
    auto krow0 = [&](int t) { return t < 4 ? NLAT + b * CTXL + t * 64 : b * SEQ + (t - 4) * 64; };
    const unsigned lds0 = (unsigned)(uintptr_t)lds;
#define AT_GLDS(gp, ldsoff) do { unsigned keep_; asm volatile("s_mov_b32 %0, m0\n\ts_mov_b32 m0, %2\n\ts_nop 0\n\tglobal_load_lds_dwordx4 %1, off\n\ts_mov_b32 m0, %0" : "=&s"(keep_) : "v"(gp), "s"((unsigned)__builtin_amdgcn_readfirstlane(lds0 + (unsigned)(ldsoff))) : "memory"); } while (0)
#define AT_ISSUE(t2, slot) do { const int kr_ = krow0(t2); const bf16_t* kb_ = Kb + (size_t)kr_ * 768; const bf16_t* vb_ = Vb + (size_t)kr_ * 512; \
        AT_GLDS(kb_ + ka, (slot) + ia * 1024); AT_GLDS(kb_ + kbo, (slot) + ib * 1024); AT_GLDS(vb_ + vo, (slot) + AT_KBUF + wv * 1024); } while (0)
    __builtin_amdgcn_s_barrier();
    AT_ISSUE(0, 0);
    if (ntiles > 1) AT_ISSUE(1, AT_BUF);
    const int koff = r32 * AT_KROW + 16 * hh;
    const int voff = AT_KBUF + (4 * hh + ((lane & 15) >> 2)) * 64 + ((lane >> 4) & 1) * 32 + (lane & 3) * 8;
    int slot_c = 0, slot_n = 2 * AT_BUF;
#pragma unroll 1
    for (int t = 0; t < ntiles; ++t) {
        if (t + 1 < ntiles) asm volatile("s_waitcnt vmcnt(3)" ::: "memory"); else asm volatile("s_waitcnt vmcnt(0)" ::: "memory");
        __builtin_amdgcn_s_barrier();
        asm volatile("" ::: "memory");
        if (t + 2 < ntiles) AT_ISSUE(t + 2, slot_n);
        unsigned char* buf = lds + slot_c;
        slot_n = slot_c; slot_c = (slot_c == 2 * AT_BUF) ? 0 : slot_c + AT_BUF;
        f32x16 p0, p1;
        __builtin_amdgcn_s_setprio(1);
        {
            const bf16x8 k0f = *(const bf16x8*)(buf + koff), k1f = *(const bf16x8*)(buf + koff + 32 * AT_KROW);
            p0 = __builtin_amdgcn_mfma_f32_32x32x16_bf16(k0f, qf[0], negm, 0, 0, 0);
            p1 = __builtin_amdgcn_mfma_f32_32x32x16_bf16(k1f, qf[0], negm, 0, 0, 0);
        }
#pragma unroll
        for (int s = 1; s < 6; ++s) {
            const bf16x8 k0f = *(const bf16x8*)(buf + koff + 32 * s), k1f = *(const bf16x8*)(buf + koff + 32 * AT_KROW + 32 * s);
            p0 = __builtin_amdgcn_mfma_f32_32x32x16_bf16(k0f, qf[s], p0, 0, 0, 0);
            p1 = __builtin_amdgcn_mfma_f32_32x32x16_bf16(k1f, qf[s], p1, 0, 0, 0);
        }
        __builtin_amdgcn_s_setprio(0);
        asm volatile("s_nop 15\n\ts_nop 7" : "+v"(p0), "+v"(p1));
        float rma = max3f(p0[0], p0[1], p1[0]), rmb = max3f(p0[2], p0[3], p1[1]);
        rma = max3f(rma, p1[2], p1[3]);
#pragma unroll
        for (int r = 4; r < 16; r += 4) { rma = max3f(rma, p0[r], p0[r + 1]); rmb = max3f(rmb, p0[r + 2], p0[r + 3]); rma = max3f(rma, p1[r], p1[r + 1]); rmb = max3f(rmb, p1[r + 2], p1[r + 3]); }
        float rm = fmaxf(rma, rmb);
        rm = fmaxf(rm, __shfl_xor(rm, 32));
        if (__any(rm > 8.f)) {
            const float dl = fmaxf(rm, 0.f), f = __builtin_amdgcn_exp2f(-dl);
            mhat += dl; l *= f;
#pragma unroll
            for (int r = 0; r < 16; ++r) { p0[r] -= dl; p1[r] -= dl; o0[r] *= f; o1[r] *= f; negm[r] = -mhat; }
            asm volatile("" : "+v"(negm));
        }
        float ls = 0.f;
#pragma unroll
        for (int r = 0; r < 16; ++r) { p0[r] = __builtin_amdgcn_exp2f(p0[r]); p1[r] = __builtin_amdgcn_exp2f(p1[r]); ls += p0[r] + p1[r]; }
        l += ls;
        u32x4 pw[4];
#pragma unroll
        for (int s2 = 0; s2 < 2; ++s2) {
            pw[s2] = (u32x4){cvtpk(p0[8 * s2], p0[8 * s2 + 1]), cvtpk(p0[8 * s2 + 2], p0[8 * s2 + 3]), cvtpk(p0[8 * s2 + 4], p0[8 * s2 + 5]), cvtpk(p0[8 * s2 + 6], p0[8 * s2 + 7])};
            pw[2 + s2] = (u32x4){cvtpk(p1[8 * s2], p1[8 * s2 + 1]), cvtpk(p1[8 * s2 + 2], p1[8 * s2 + 3]), cvtpk(p1[8 * s2 + 4], p1[8 * s2 + 5]), cvtpk(p1[8 * s2 + 6], p1[8 * s2 + 7])};
        }
        __builtin_amdgcn_s_setprio(1);
#pragma unroll
        for (int ks = 0; ks < 4; ++ks) {
            const unsigned char* vb = buf + voff + ks * 16 * 64;
            const bf16x8 pf = __builtin_bit_cast(bf16x8, pw[ks]);
            o0 = __builtin_amdgcn_mfma_f32_32x32x16_bf16(tr8(vb, vb + 8 * 64), pf, o0, 0, 0, 0);
            o1 = __builtin_amdgcn_mfma_f32_32x32x16_bf16(tr8(vb + 4096, vb + 4096 + 8 * 64), pf, o1, 0, 0, 0);
        }
        __builtin_amdgcn_s_setprio(0);
    }
#undef AT_GLDS
#undef AT_ISSUE
    l += __shfl_xor(l, 32);
    const float rl = 1.f / l;
    bf16_t* orow = (bf16_t*)(p.ws + WS_CC) + (size_t)qrow * D + 512 + h * 64 + 4 * hh;
#pragma unroll
    for (int r4 = 0; r4 < 4; ++r4) {
        u32x2 w0; w0.x = cvtpk(o0[4 * r4] * rl, o0[4 * r4 + 1] * rl); w0.y = cvtpk(o0[4 * r4 + 2] * rl, o0[4 * r4 + 3] * rl);
        u32x2 w1; w1.x = cvtpk(o1[4 * r4] * rl, o1[4 * r4 + 1] * rl); w1.y = cvtpk(o1[4 * r4 + 2] * rl, o1[4 * r4 + 3] * rl);
        *(u32x2*)(orow + 8 * r4) = w0; *(u32x2*)(orow + 32 + 8 * r4) = w1;
    }
}
__device__ __forceinline__ void retout_unit(unsigned char* lds, const P& p, int L, int gc, int h) {
    float* qs = (float*)lds; float* ks = qs + 128 * 33; float* vs = ks + 128 * 33; float* Sf = vs + 128 * 64; float* Sb = Sf + 2048;
    const int tid = threadIdx.x;
    const float l2f = log2_gamma(p, L, 0, h), l2b = log2_gamma(p, L, 1, h);
    load_ret_qk(qs, p, gc, h, Z_RQ, 1.f);
    load_ret_qk(ks, p, gc, h, Z_RK, 0.17677669529663687f);
    load_ret_v(vs, p, gc, h);
    {
        const bool lat = gc < 256; const int b = lat ? gc >> 4 : (gc - 256) >> 1;
        const int mme = lat ? 2 + (gc & 15) : (gc - 256) & 1;
        const int u = mme, w = mme < 2 ? 1 - mme : 19 - mme;
        f32x4 sf = (f32x4){0.f, 0.f, 0.f, 0.f}, sb = sf;
        const float* KVb = (const float*)(p.ws + WS_KV);
#pragma unroll 1
        for (int mm = 0; mm < 18; ++mm) {
            const int gcm = mm < 2 ? 256 + b * 2 + mm : b * 16 + (mm - 2);
            const int um = mm, wm = mm < 2 ? 1 - mm : 19 - mm;
            const float* kv = KVb + ((size_t)(gcm * 4 + h) * 2) * 2048 + tid * 4;
            if (um < u) { const float wgt = exp2f(l2f * 128.f * (float)(u - 1 - um)); sf += wgt * *(const f32x4*)kv; }
            if (wm < w) { const float wgt = exp2f(l2b * 128.f * (float)(w - 1 - wm)); sb += wgt * *(const f32x4*)(kv + 2048); }
        }
        *(f32x4*)(Sf + tid * 4) = sf; *(f32x4*)(Sb + tid * 4) = sb;
    }
    __syncthreads();
    const int i = tid >> 2, e0 = (tid & 3) * 16;
    float q[32];
#pragma unroll
    for (int d = 0; d < 32; ++d) q[d] = qs[i * 33 + d];
    float acc[16];
#pragma unroll
    for (int e = 0; e < 16; ++e) acc[e] = 0.f;
#pragma unroll 1
    for (int j = 0; j < 128; ++j) {
        float s = 0.f;
#pragma unroll
        for (int d = 0; d < 32; ++d) s += q[d] * ks[j * 33 + d];
        float wgt = 0.f;
        if (j <= i) wgt += exp2f(l2f * (float)(i - j));
        if (j >= i) wgt += exp2f(l2b * (float)(j - i));
        s *= wgt;
#pragma unroll
        for (int e4 = 0; e4 < 4; ++e4) { const f32x4 v4 = *(const f32x4*)(vs + j * 64 + e0 + 4 * e4); acc[4 * e4] += s * v4.x; acc[4 * e4 + 1] += s * v4.y; acc[4 * e4 + 2] += s * v4.z; acc[4 * e4 + 3] += s * v4.w; }
    }
    {
        const float cf = exp2f(l2f * (float)(i + 1)), cb = exp2f(l2b * (float)(128 - i));
#pragma unroll 2
        for (int d = 0; d < 32; ++d) {
            const float qd = qs[i * 33 + d]; const float qf = qd * cf, qb = qd * cb;
#pragma unroll
            for (int e4 = 0; e4 < 4; ++e4) { const f32x4 a = *(const f32x4*)(Sf + d * 64 + e0 + 4 * e4), bq = *(const f32x4*)(Sb + d * 64 + e0 + 4 * e4);
                acc[4 * e4] += qf * a.x + qb * bq.x; acc[4 * e4 + 1] += qf * a.y + qb * bq.y; acc[4 * e4 + 2] += qf * a.z + qb * bq.z; acc[4 * e4 + 3] += qf * a.w + qb * bq.w; }
        }
    }
    float s1 = 0.f;
#pragma unroll
    for (int e = 0; e < 16; ++e) s1 += acc[e];
    s1 += __shfl_xor(s1, 1); s1 += __shfl_xor(s1, 2);
    const float mu = s1 * (1.f / 64.f);
    float s2 = 0.f;
#pragma unroll
    for (int e = 0; e < 16; ++e) { const float dd = acc[e] - mu; s2 += dd * dd; }
    s2 += __shfl_xor(s2, 1); s2 += __shfl_xor(s2, 2);
    const float rstd = rsqrtf(s2 * (1.f / 64.f) + NORM_EPS);
    const int row = gc * 128 + i;
    const bf16_t* zg = (const bf16_t*)(p.ws + WS_Z) + (size_t)row * ZC + Z_RG + h * 64 + e0;
    const float* gw = p.in[13] + L * 256 + h * 64 + e0;
    const u32x4 g0 = *(const u32x4*)zg, g1 = *(const u32x4*)(zg + 8);
    float g[16];
#pragma unroll
    for (int k = 0; k < 4; ++k) { g[2 * k] = lo16(g0[k]); g[2 * k + 1] = hi16(g0[k]); g[8 + 2 * k] = lo16(g1[k]); g[8 + 2 * k + 1] = hi16(g1[k]); }
    unsigned o[8];
#pragma unroll
    for (int k = 0; k < 8; ++k) {
        const float y0 = siluf(g[2 * k]) * ((acc[2 * k] - mu) * rstd * gw[2 * k]), y1 = siluf(g[2 * k + 1]) * ((acc[2 * k + 1] - mu) * rstd * gw[2 * k + 1]);
        o[k] = pk2(y0, y1);
    }
    u32x4* op = (u32x4*)((bf16_t*)(p.ws + WS_CC) + (size_t)row * D + 256 + h * 64 + e0);
    u32x4 w0; w0.x = o[0]; w0.y = o[1]; w0.z = o[2]; w0.w = o[3]; u32x4 w1; w1.x = o[4]; w1.y = o[5]; w1.z = o[6]; w1.w = o[7];
    op[0] = w0; op[1] = w1;
    __syncthreads();
}
__device__ __forceinline__ void phase_c(unsigned char* lds, const P& p, int L) {
    const int G = gridDim.x, bid = blockIdx.x;
    const int nat = 16 * 8 * 8, nac = (L == 0) ? 128 : 0, nro = (L == 0 ? 288 : 256) * 4;
    const int total = nat + nac + nro;
    for (int u = bid; u < total; u += G) {
        int r = u;
#ifndef TEST_C
#define TEST_C 3
#endif
        if (r < nat) { if (TEST_C & 1) attn_unit_mfma(lds, p, r >> 6, (r >> 3) & 7, r & 7, false); continue; } r -= nat;
        if (r < nac) { if (TEST_C & 1) attn_unit_mfma(lds, p, r >> 3, r & 7, 0, true); continue; } r -= nac;
        if (TEST_C & 2) retout_unit_mfma(lds, p, L, r >> 2, r & 3);
    }
    if (L == 0) convert_expert_weights(lds, p, 0);
}

struct EpiY {
    bf16_t* Y; const float* g1;
    __device__ __forceinline__ void operator()(const ge::Acc& acc, const ge::Unit& u, int wr, int wc, int fr, int fq) const {
        const float* gr = g1 + (size_t)mod_row(u.a * 256) * 6144 + u.b * 256 + wc * 32 + 8 * fq;
        f32x4 g[2][2];
#pragma unroll
        for (int bj = 0; bj < 2; ++bj)
#pragma unroll
            for (int n = 0; n < 2; ++n) g[bj][n] = *(const f32x4*)(gr + bj * 128 + n * 4);
#pragma unroll
        for (int ai = 0; ai < 2; ++ai)
#pragma unroll
            for (int m = 0; m < 4; ++m) {
                bf16_t* yr = Y + (size_t)(u.a * 256 + ai * 128 + wr * 64 + m * 16 + fr) * D + u.b * 256 + wc * 32 + 8 * fq;
#pragma unroll
                for (int bj = 0; bj < 2; ++bj) { const f32x4 v0 = acc[ai][bj][m][0] * g[bj][0], v1 = acc[ai][bj][m][1] * g[bj][1];
                    u32x4 w; w.x = cvtpk(v0.x, v0.y); w.y = cvtpk(v0.z, v0.w); w.z = cvtpk(v1.x, v1.y); w.w = cvtpk(v1.z, v1.w); *(u32x4*)(yr + bj * 128) = w; }
            }
    }
};
__device__ __forceinline__ void phase_d(unsigned char* lds, const P& p, int L) {
    ge::DenseOrder S; S.nM = (L == 0 ? NTOK : NLAT) / 256; S.nN = 4; S.nwg = S.nM * 4; S.G = gridDim.x; S.c = blockIdx.x;
    S.Bt = (const char*)((const bf16_t*)(p.ws + WS_WOUT) + (size_t)L * D * D); S.btile = (size_t)256 * D * 2; S.arow = D * 2;
    EpiY E{(bf16_t*)(p.ws + WS_Y), (const float*)(p.ws + WS_MODV) + (size_t)L * 17 * 6144 + 2048};
    ge::gemm_stream<ge::DenseOrder, EpiY, true>((LAS unsigned char*)lds, (const char*)(p.ws + WS_CC), D, S, E);
}

__device__ __forceinline__ void norm_mod_store(const P& p, int L, int which, int tok, int lane, const f32x4 (&v)[4], bf16_t* Hdst) {
    const float* nw = (which == 0 ? p.in[6] : p.in[19]) + L * D;
    const float* mrow = (const float*)(p.ws + WS_MODV) + ((size_t)L * 17 + mod_row(tok)) * 6144 + which * 3072;
    float s = 0.f;
#pragma unroll
    for (int j = 0; j < 4; ++j) s += v[j].x * v[j].x + v[j].y * v[j].y + v[j].z * v[j].z + v[j].w * v[j].w;
    const float rstd = rsqrtf(wave_sum(s) * (1.f / D) + NORM_EPS);
    u32x2* o = (u32x2*)(Hdst + (size_t)tok * D) + lane;
#pragma unroll
    for (int j = 0; j < 4; ++j) {
        const int k = 4 * lane + 256 * j;
        const f32x4 w4 = *(const f32x4*)(nw + k), sh = *(const f32x4*)(mrow + k), sc = *(const f32x4*)(mrow + 1024 + k);
        const f32x4 y = v[j] * rstd * w4 * (sc + 1.f) + sh;
        u32x2 w; w.x = cvtpk(y.x, y.y); w.y = cvtpk(y.z, y.w); o[64 * j] = w;
    }
}
__device__ __forceinline__ int half_n(int L) { return L == 0 ? NTOK / 2 : NLAT / 2; }
__device__ __forceinline__ void phase_router(unsigned char* lds, const P& p, int L) {
    constexpr int O_LG = 41472, O_CNT = 83072, O_SEL = 83584, O_SELW = 87424;
    const bf16_t* H = (const bf16_t*)(p.ws + WS_H); const bf16_t* W = (const bf16_t*)(p.ws + WS_RT) + (size_t)L * 128 * D;
    const bf16_t* Y = (const bf16_t*)(p.ws + WS_Y);
    float* lg = (float*)(lds + O_LG);
    int* lcnt = (int*)(lds + O_CNT);
    int* sel = (int*)(lds + O_SEL);
    float* selw = (float*)(lds + O_SELW);
    int* ltok = (int*)(p.ws + WS_LTOK); float* lw = (float*)(p.ws + WS_LW);
    const int tid = threadIdx.x, lane = tid & 63, wave = tid >> 6;
    const int ntok = (L == 0 ? NTOK : NLAT), TS = (L == 0 ? 144 : 128), nmt = ntok / TS, RW = TS / 8, HN = half_n(L);
    for (int mt = blockIdx.x; mt < nmt; mt += gridDim.x) {
        const int t0 = mt * TS;
        if (tid < 64) lcnt[tid] = 0;
#pragma unroll 2
        for (int q = 0; q < RW; ++q) {
            const int tok = t0 + wave * RW + q;
            const u32x2* yr = (const u32x2*)(Y + (size_t)tok * D) + lane;
            u32x2* xo = (u32x2*)x_row(p, tok) + lane;
            f32x4 v[4];
            if (L == 0) {
                const f32x4* xi = (const f32x4*)x_in_row(p, tok) + lane;
#pragma unroll
                for (int j = 0; j < 4; ++j) { const f32x4 a = xi[64 * j]; const u32x2 y = yr[64 * j]; v[j] = (f32x4){a.x + lo16(y.x), a.y + hi16(y.x), a.z + lo16(y.y), a.w + hi16(y.y)}; }
            } else {
#pragma unroll
                for (int j = 0; j < 4; ++j) { const u32x2 a = xo[64 * j]; const u32x2 y = yr[64 * j]; v[j] = (f32x4){lo16(a.x) + lo16(y.x), hi16(a.x) + hi16(y.x), lo16(a.y) + lo16(y.y), hi16(a.y) + hi16(y.y)}; }
            }
#pragma unroll
            for (int j = 0; j < 4; ++j) { u32x2 w; w.x = cvtpk(v[j].x, v[j].y); w.y = cvtpk(v[j].z, v[j].w); xo[64 * j] = w; }
            norm_mod_store(p, L, 1, tok, lane, v, (bf16_t*)(p.ws + WS_H));
        }
        asm volatile("s_waitcnt vmcnt(0)" ::: "memory");
        __syncthreads();
        auto rs = [&](int pr) { return H + (size_t)(t0 + (pr < TS ? pr : TS - 1)) * D; };
        auto epi = [&](int r, int c, f32x4 v) { if (c < 64) { float* d = lg + r * 65 + c; d[0] = v.x; d[1] = v.y; d[2] = v.z; d[3] = v.w; } };
        gemm_tile<5>(lds, rs, W, D, D, epi);
        __syncthreads();
        if (tid < TS) {
            const float* rbp = p.in[21] + L * NEXP; const float* lrow = lg + tid * 65;
            float bv[6], bs[6]; int bi[6];
#pragma unroll
            for (int k = 0; k < 6; ++k) { bv[k] = -INFINITY; bs[k] = 0.f; bi[k] = 0; }
#pragma unroll 4
            for (int e = 0; e < NEXP; ++e) {
                float sc = 1.f / (1.f + __expf(-lrow[e])); float sv = sc + rbp[e]; int ei = e;
#pragma unroll
                for (int k = 0; k < 6; ++k) { const bool gt = sv > bv[k]; const float tv = gt ? bv[k] : sv, ts = gt ? bs[k] : sc; const int ti = gt ? bi[k] : ei;
                    bv[k] = gt ? sv : bv[k]; bs[k] = gt ? sc : bs[k]; bi[k] = gt ? ei : bi[k]; sv = tv; sc = ts; ei = ti; }
            }
            const float rs6 = 2.5f / (bs[0] + bs[1] + bs[2] + bs[3] + bs[4] + bs[5]);
#pragma unroll
            for (int k = 0; k < 6; ++k) { const int rank = atomicAdd(&lcnt[bi[k]], 1); sel[tid * 6 + k] = (bi[k] << 8) | rank; selw[tid * 6 + k] = bs[k] * rs6; }
        }
        __syncthreads();
        const int hf = t0 / HN;
        if (tid < 64) {
            unsigned* ecnt = (unsigned*)(p.ws + WS_CTL) + CW_ECNT + (L * 2 + hf) * 4096;
            const int c = lcnt[tid];
            lcnt[64 + tid] = c ? (int)atomicAdd(ecnt + tid * 64, (unsigned)c) : 0;
        }
        __syncthreads();
        for (int i = tid; i < TS * 6; i += NTHREADS) {
            const int sv = sel[i], e = sv >> 8, pos = lcnt[64 + e] + (sv & 255), tok = t0 + i / 6, k = i % 6;
            ltok[(size_t)(hf * 64 + e) * LCAPH + pos] = tok * 8 + k;
            lw[(size_t)(hf * 64 + e) * LCAPH + pos] = selw[i];
        }
        __syncthreads();
    }
}

__device__ __forceinline__ void build_etab(unsigned char* lds, const P& p, int L) {
    int* tstart = (int*)(lds + ETAB_OFF); int* cnt = tstart + 160;
    __syncthreads();
    if (threadIdx.x < 128) { const unsigned* ecnt = (const unsigned*)(p.ws + WS_CTL) + CW_ECNT + (L * 2 + (threadIdx.x >> 6)) * 4096;
        cnt[threadIdx.x] = (int)__hip_atomic_load(ecnt + (threadIdx.x & 63) * 64, __ATOMIC_RELAXED, __HIP_MEMORY_SCOPE_AGENT); }
    __syncthreads();
    if (threadIdx.x == 0) { int s = 0; for (int hf = 0; hf < 2; ++hf) { for (int e = 0; e < 64; ++e) { tstart[hf * 66 + e] = s; s += (cnt[hf * 64 + e] + 255) >> 8; } tstart[hf * 66 + 64] = s; s += half_n(L) / 256; tstart[hf * 66 + 65] = s; } }
    __syncthreads();
}
struct MoeOrder {
    int tlo, thi, nN, G, c; const int* tstart; const char* Bexp; size_t bexp; const char* Bsh; size_t btile; const int* rowbuf; unsigned arow; bool ident;
    __device__ __forceinline__ bool next(int i, ge::Unit& u) const {
        const int Lq = i * G + c; if (Lq >= (thi - tlo) * nN) return false;
        const int t = tlo + Lq / nN, pn = Lq % nN;
        const int hf = t >= tstart[66] ? 1 : 0; const int* ts = tstart + hf * 66;
        int lo = 0, hi = 64;
        while (lo < hi) { const int mid = (lo + hi + 1) >> 1; if (ts[mid] <= t) lo = mid; else hi = mid - 1; }
        const int e = __builtin_amdgcn_readfirstlane(lo);
        u.a = t; u.b = pn; u.c = hf * 128 + e; u.d = i;
        u.B = (e < 64 ? Bexp + (size_t)e * bexp : Bsh) + (size_t)pn * btile;
        return true;
    }
    __device__ __forceinline__ unsigned aoff(int i, const ge::Unit& u, int R) const { return (unsigned)(ident ? u.a * 256 + R : rowbuf[i * 256 + R]) * arow; }
};
__device__ __forceinline__ void phase_gateup(unsigned char* lds, const P& p, int L) {
    build_etab(lds, p, L);
    const int* tstart = (const int*)(lds + ETAB_OFF); const int* cnt = tstart + 160;
    int* rowbuf = (int*)(lds + RB0_OFF); float* wbuf = (float*)(lds + RB1_OFF);
    const int* ltok = (const int*)(p.ws + WS_LTOK); const float* lw = (const float*)(p.ws + WS_LW);
    bf16_t* ACT = (bf16_t*)(p.ws + WS_ACT);
    const int G = gridDim.x, bid = blockIdx.x, vcu = (G % 8 == 0) ? (bid % 8) * (G / 8) + bid / 8 : bid, HN = half_n(L);
    MoeOrder S; S.tlo = 0; S.thi = tstart[66 + 65]; S.nN = 2; S.G = G; S.c = vcu; S.tstart = tstart; S.Bexp = (const char*)(p.ws + WS_EGU); S.bexp = (size_t)512 * D * 2;
    S.Bsh = (const char*)((const bf16_t*)(p.ws + WS_SHGU) + (size_t)L * 512 * D); S.btile = (size_t)256 * D * 2; S.rowbuf = rowbuf; S.arow = D * 2; S.ident = false;
    {
        ge::Unit u;
        for (int i = 0; i < 10 && S.next(i, u); ++i) {
            if (threadIdx.x < 256) {
                const int R = threadIdx.x, hf = u.c >> 7, e = u.c & 127, mt = u.a - tstart[hf * 66 + e];
                int tok; float w;
                if (e < 64) { const int lp = mt * 256 + R; const bool ok = lp < cnt[hf * 64 + e]; tok = ok ? (ltok[(size_t)(hf * 64 + e) * LCAPH + lp] >> 3) : 0; w = ok ? lw[(size_t)(hf * 64 + e) * LCAPH + lp] : 0.f; }
                else { tok = hf * HN + mt * 256 + R; w = 1.f; }
                rowbuf[i * 256 + R] = tok; wbuf[i * 256 + R] = w;
            }
        }
        __syncthreads();
    }
    auto f = [&](const ge::Unit& u, int r, int c, f32x4 v0, f32x4 v1) {
        const float w = wbuf[u.d * 256 + r];
        u32x2 o; o.x = cvtpk(siluf(v0.x) * v0.y * w, siluf(v0.z) * v0.w * w); o.y = cvtpk(siluf(v1.x) * v1.y * w, siluf(v1.z) * v1.w * w);
        *(u32x2*)(ACT + (size_t)(u.a * 256 + r) * EDIM + ((u.b * 256 + c) >> 1)) = o;
    };
    ge::EpiFn<decltype(f)> E{f};
    ge::gemm_stream<MoeOrder, ge::EpiFn<decltype(f)>, true>((LAS unsigned char*)lds, (const char*)(p.ws + (L == 0 ? WS_H : WS_H)), D, S, E);
}
__device__ __forceinline__ void phase_down(unsigned char* lds, const P& p, int L, int hf) {
    build_etab(lds, p, L);
    const int* tstart = (const int*)(lds + ETAB_OFF); const int* cnt = tstart + 160;
    int* sbuf = (int*)(lds + RB0_OFF);
    const int* ltok = (const int*)(p.ws + WS_LTOK);
    unsigned char* SLOT = (unsigned char*)(p.ws + WS_SLOT);
    const int G = gridDim.x, bid = blockIdx.x, vcu = (G % 8 == 0) ? (bid % 8) * (G / 8) + bid / 8 : bid, HN = half_n(L);
    MoeOrder S; S.tlo = tstart[hf * 66]; S.thi = tstart[hf * 66 + 65]; S.nN = 4; S.G = G; S.c = vcu; S.tstart = tstart; S.Bexp = (const char*)(p.ws + WS_ED); S.bexp = (size_t)D * EDIM * 2;
    S.Bsh = (const char*)((const bf16_t*)(p.ws + WS_SHD) + (size_t)L * D * EDIM); S.btile = (size_t)256 * EDIM * 2; S.rowbuf = sbuf; S.arow = EDIM * 2; S.ident = true;
    {
        ge::Unit u;
        for (int i = 0; i < 10 && S.next(i, u); ++i) {
            if (threadIdx.x < 256) {
                const int R = threadIdx.x, e = u.c & 127, mt = u.a - tstart[hf * 66 + e];
                int srow;
                if (e < 64) { const int lp = mt * 256 + R; if (lp < cnt[hf * 64 + e]) { const int ent = ltok[(size_t)(hf * 64 + e) * LCAPH + lp]; srow = ((ent >> 3) - hf * HN) * 7 + (ent & 7); } else srow = -1; }
                else srow = (mt * 256 + R) * 7 + 6;
                sbuf[i * 256 + R] = srow;
            }
        }
        __syncthreads();
    }
    auto f = [&](const ge::Unit& u, int r, int c, f32x4 v0, f32x4 v1) {
        const int srow = sbuf[u.d * 256 + r];
        if (srow >= 0) {
            int w0 = 0, w1 = 0;
            w0 = __builtin_amdgcn_cvt_pk_fp8_f32(__builtin_amdgcn_fmed3f(v0.x, -440.f, 440.f), __builtin_amdgcn_fmed3f(v0.y, -440.f, 440.f), w0, false);
            w0 = __builtin_amdgcn_cvt_pk_fp8_f32(__builtin_amdgcn_fmed3f(v0.z, -440.f, 440.f), __builtin_amdgcn_fmed3f(v0.w, -440.f, 440.f), w0, true);
            w1 = __builtin_amdgcn_cvt_pk_fp8_f32(__builtin_amdgcn_fmed3f(v1.x, -440.f, 440.f), __builtin_amdgcn_fmed3f(v1.y, -440.f, 440.f), w1, false);
            w1 = __builtin_amdgcn_cvt_pk_fp8_f32(__builtin_amdgcn_fmed3f(v1.z, -440.f, 440.f), __builtin_amdgcn_fmed3f(v1.w, -440.f, 440.f), w1, true);
            u32x2 w; w.x = (unsigned)w0; w.y = (unsigned)w1; *(u32x2*)(SLOT + (size_t)srow * D + u.b * 256 + c) = w;
        }
    };
    ge::EpiFn<decltype(f)> E{f};
    ge::gemm_stream<MoeOrder, ge::EpiFn<decltype(f)>, true>((LAS unsigned char*)lds, (const char*)(p.ws + WS_ACT), EDIM, S, E);
}
__device__ __forceinline__ void phase_combine(const P& p, int L, int hf) {
    const int tid = threadIdx.x, lane = tid & 63, wave = tid >> 6, gw = blockIdx.x * NWAVES + wave, NGW = gridDim.x * NWAVES;
    const unsigned char* SLOT = (const unsigned char*)(p.ws + WS_SLOT);
    const float* modv = (const float*)(p.ws + WS_MODV) + (size_t)L * 17 * 6144;
    const int HN = half_n(L);
    for (int tl = gw; tl < HN; tl += NGW) {
        const int tok = hf * HN + tl;
        f32x4 acc[4];
#pragma unroll
        for (int j = 0; j < 4; ++j) acc[j] = (f32x4){0.f, 0.f, 0.f, 0.f};
#pragma unroll
        for (int k = 0; k < 7; ++k) {
            const int* sr = (const int*)(SLOT + ((size_t)tl * 7 + k) * D) + lane;
#pragma unroll
            for (int j = 0; j < 4; ++j) { const int w = sr[64 * j]; const f32x2_t a = __builtin_amdgcn_cvt_pk_f32_fp8(w, false), b = __builtin_amdgcn_cvt_pk_f32_fp8(w, true); acc[j].x += a.x; acc[j].y += a.y; acc[j].z += b.x; acc[j].w += b.y; }
        }
        const float* g2 = modv + (size_t)mod_row(tok) * 6144 + 5120;
        u32x2* xr = (u32x2*)x_row(p, tok) + lane;
        f32x4 v[4];
#pragma unroll
        for (int j = 0; j < 4; ++j) { const f32x4 g = *(const f32x4*)(g2 + 4 * lane + 256 * j); const u32x2 a = xr[64 * j];
            v[j] = (f32x4){lo16(a.x), hi16(a.x), lo16(a.y), hi16(a.y)} + g * acc[j]; }
        if (L == 0) {
#pragma unroll
            for (int j = 0; j < 4; ++j) { u32x2 w; w.x = cvtpk(v[j].x, v[j].y); w.y = cvtpk(v[j].z, v[j].w); xr[64 * j] = w; }
            norm_mod_store(p, 1, 0, tok, lane, v, (bf16_t*)(p.ws + WS_H1));
        } else {
            const float* nw = p.in[28]; float s = 0.f;
#pragma unroll
            for (int j = 0; j < 4; ++j) s += v[j].x * v[j].x + v[j].y * v[j].y + v[j].z * v[j].z + v[j].w * v[j].w;
            const float rstd = rsqrtf(wave_sum(s) * (1.f / D) + NORM_EPS);
            f32x4* orow = (f32x4*)(p.out + (size_t)tok * D) + lane;
#pragma unroll
            for (int j = 0; j < 4; ++j) { const f32x4 w4 = *(const f32x4*)(nw + 4 * lane + 256 * j); orow[64 * j] = v[j] * rstd * w4; }
        }
    }
}

constexpr int PH_LAYER0 = 2, PH_PER_LAYER = 10, PH_LAYER1 = PH_LAYER0 + PH_PER_LAYER, NPHASES = PH_LAYER1 + PH_PER_LAYER;

__global__ void __launch_bounds__(NTHREADS, 2) mk_fwd(P p) {
    extern __shared__ __attribute__((aligned(16))) unsigned char lds[];
    volatile LAS unsigned* MISC = (volatile LAS unsigned*)((LAS unsigned char*)lds + MISC_OFF);
    if (threadIdx.x < 64) MISC[threadIdx.x] = 0u;
    __syncthreads();
    unsigned* ctl = (unsigned*)(p.ws + WS_CTL);
    XcdBarrier bar; bar.bar = ctl + CW_BAR; bar.x = 0; bar.st = MISC + 8;
    if (!MK_PER_PHASE) bar = xcd_barrier_post(ctl + CW_BAR, MISC + 8);
    const int lo = p.ph_lo, hi = p.ph_hi;
#ifndef PH_MASK
#define PH_MASK 0xffffu
#endif
#define HAS(b) ((PH_MASK >> (b)) & 1u)
#define IN(k) (lo <= (k) && (k) < hi)
#define SEAM(k) do { if (IN(k) && IN((k) + 1)) xcd_barrier(bar); } while (0)

#ifdef PROBE_MASK
    unsigned long long tacc = 0ull, t0p = 0ull;
#define PT0() t0p = __builtin_amdgcn_s_memrealtime()
#define PT1(b) do { if ((PROBE_MASK >> (b)) & 1u) tacc += __builtin_amdgcn_s_memrealtime() - t0p; } while (0)
#else
#define PT0() do {} while (0)
#define PT1(b) do {} while (0)
#endif
#define PH(b, k, body) do { PT0(); if (HAS(b) && IN(k)) { body; } SEAM(k); PT1(b); } while (0)
    PH(0, 0, phase_prep(lds, p));
    PH(1, 1, phase_norm_mod(p, 0, 0, NTOK));
#define DOWN_COMBINE(L, pb, hf) \
        PH(9, pb + 6 + 2 * hf, phase_down(lds, p, L, hf)); \
        PH(10, pb + 7 + 2 * hf, phase_combine(p, L, hf));
#define LAYER(L, pb) \
        PH(2, pb + 0, phase_zgemm(lds, p, L)); \
        PH(3, pb + 1, phase_b(lds, p, L)); \
        PH(4, pb + 2, phase_c(lds, p, L)); \
        PH(5, pb + 3, phase_d(lds, p, L)); \
        PH(7, pb + 4, phase_router(lds, p, L)); \
        PH(8, pb + 5, phase_gateup(lds, p, L)); \
        DOWN_COMBINE(L, pb, 0) DOWN_COMBINE(L, pb, 1)
    LAYER(0, PH_LAYER0)
    LAYER(1, PH_LAYER1)
#ifdef PROBE_MASK
    if (blockIdx.x == 0) {
        const unsigned long long tend = __builtin_amdgcn_s_memrealtime();
        while (__builtin_amdgcn_s_memrealtime() - tend < (unsigned long long)PROBE_AMP * tacc) __builtin_amdgcn_s_sleep(8);
    }
#endif
#undef IN
#undef SEAM
}

extern "C" void kernel_launch(void* const* d_in, const int* in_sizes, int n_in, void* d_out, int out_size, void* d_ws, size_t ws_size, hipStream_t stream) {
    static int grid = 0;
    if (grid == 0) {
        if (n_in != 29 || in_sizes[0] != NLAT * D || out_size != NLAT * D || ws_size < WS_END) {
            fprintf(stderr, "kernel_launch: unexpected shapes / workspace (n_in %d, ws %zu, need %zu); nothing launched\n", n_in, ws_size, (size_t)WS_END); grid = -1; return; }
        int dev = 0, cus = 0, per_cu = 0;
        if (hipGetDevice(&dev) != hipSuccess || hipDeviceGetAttribute(&cus, hipDeviceAttributeMultiprocessorCount, dev) != hipSuccess) { grid = -1; return; }
        if (hipFuncSetAttribute((const void*)mk_fwd, hipFuncAttributeMaxDynamicSharedMemorySize, LDS_BYTES) != hipSuccess) { grid = -1; return; }
        if (hipOccupancyMaxActiveBlocksPerMultiprocessor(&per_cu, (const void*)mk_fwd, NTHREADS, LDS_BYTES) != hipSuccess || per_cu < 1) { fprintf(stderr, "kernel_launch: occupancy query says %d\n", per_cu); }
        (void)hipGetLastError();
        grid = cus;
    }
    if (grid < 0) return;
    (void)hipMemsetAsync((char*)d_ws + WS_CTL, 0, CTL_ZERO_BYTES, stream);
    P a{};
    for (int i = 0; i < 29; ++i) a.in[i] = (const float*)d_in[i];
    a.out = (float*)d_out; a.ws = (unsigned char*)d_ws;
#if MK_PER_PHASE
    for (int ph = 0; ph < NPHASES; ++ph) { a.ph_lo = ph; a.ph_hi = ph + 1; hipLaunchKernelGGL(mk_fwd, dim3(grid), dim3(NTHREADS), LDS_BYTES, stream, a); }
#else
    a.ph_lo = 0; a.ph_hi = NPHASES;
    hipLaunchKernelGGL(mk_fwd, dim3(grid), dim3(NTHREADS), LDS_BYTES, stream, a);
#endif
}
```

```cpp
#include <hip/hip_runtime.h>
#include <cstdio>
#include <cstdint>

#ifndef MK_PER_PHASE
#define MK_PER_PHASE 0
#endif

typedef unsigned short bf16_t;
typedef short bf16x8 __attribute__((ext_vector_type(8)));
typedef float f32x4 __attribute__((ext_vector_type(4)));
typedef unsigned u32x4 __attribute__((ext_vector_type(4)));
typedef unsigned u32x2 __attribute__((ext_vector_type(2)));
typedef float f32x16 __attribute__((ext_vector_type(16)));
typedef short v4i16_t __attribute__((ext_vector_type(4)));
#define LAS __attribute__((address_space(3)))

constexpr int D = 1024, BATCH = 16, SEQ = 2048, CTXL = 256;
constexpr int NLAT = BATCH * SEQ, NCTX = BATCH * CTXL, NTOK = NLAT + NCTX;
constexpr int ZC = 1792;
constexpr int Z_RQ = 512, Z_RK = 640, Z_RV = 768, Z_RG = 1024, Z_CQ = 1280, Z_CKV = 1536, Z_KR = 1664, Z_END = 1696;
constexpr int NEXP = 64, TOPK = 6, EDIM = 256;
constexpr float NORM_EPS = 1e-6f;
constexpr int NTHREADS = 512, NWAVES = 8;

constexpr size_t MiB = 1u << 20;
constexpr size_t WS_CTL = 0, CTL_ZERO_BYTES = 1 * MiB;
constexpr size_t WS_MODV = 1 * MiB;
constexpr size_t WS_ROPE = 2 * MiB;
constexpr size_t WS_WIN = 3 * MiB;
constexpr size_t WS_WUQ = 10 * MiB;
constexpr size_t WS_WUKV = 11 * MiB;
constexpr size_t WS_WOUT = 12 * MiB;
constexpr size_t WS_RT = 16 * MiB;
constexpr size_t WS_SHGU = 17 * MiB;
constexpr size_t WS_SHD = 19 * MiB;
constexpr size_t WS_EGU = 20 * MiB;
constexpr size_t WS_ED = 84 * MiB;
constexpr size_t WS_H1 = 20 * MiB;
constexpr size_t WS_X = 116 * MiB;
constexpr size_t WS_H = 188 * MiB;
constexpr size_t WS_CC = WS_H;
constexpr size_t WS_Z = 260 * MiB;
constexpr size_t WS_Y = WS_Z;
constexpr size_t WS_Q = 386 * MiB;
constexpr size_t WS_K = 440 * MiB;
constexpr size_t WS_V = 494 * MiB;
constexpr size_t WS_KV = 530 * MiB;
constexpr size_t WS_SLOT = 188 * MiB;
constexpr size_t WS_ACT = 441 * MiB;
constexpr size_t WS_LTOK = 583 * MiB;
constexpr size_t WS_LW = 592 * MiB;
constexpr size_t WS_SS = 601 * MiB;
constexpr size_t WS_END = 603 * MiB;
constexpr int LCAP = NTOK;
static_assert(WS_SLOT + ((size_t)NTOK * 7 + 1) * 1024 <= WS_ACT && WS_ACT + (size_t)1136 * 256 * 512 <= WS_LTOK, "MoE buffers");

constexpr int CW_TMO = 0;
constexpr int CW_BAR = 4096;
constexpr int CW_ECNT = 8192;

constexpr int LDS_BYTES = 162816;
constexpr int MISC_OFF = LDS_BYTES - 256;
constexpr int RB0_OFF = 131072;
constexpr int RB1_OFF = 149504;
constexpr int ETAB_OFF = 159744;
constexpr int GEMM_LDS = 36864;
constexpr int ROWSS_OFF = 36864;
constexpr int LG_OFF = 37376;

#define XB_TMO      128
#define XB_XCNT(j)  (256  + 64 * (j))
#define XB_XSUB(j)  (1280 + 64 * (j))
#define XB_XGEN(j)  (2304 + 64 * (j))
#define XB_TOP      3328
#define XB_TOPGEN   3392
#define XCD_BAR_WORDS 3456
#define XB_SPIN_CAP (1u << 24)
__device__ __forceinline__ unsigned xb_ld(unsigned* p)              { return __hip_atomic_load(p, __ATOMIC_RELAXED, __HIP_MEMORY_SCOPE_AGENT); }
__device__ __forceinline__ unsigned xb_add(unsigned* p, unsigned v) { return __hip_atomic_fetch_add(p, v, __ATOMIC_RELAXED, __HIP_MEMORY_SCOPE_AGENT); }
__device__ __forceinline__ unsigned xb_xcc_id() { return (unsigned)__builtin_amdgcn_s_getreg((3 << 11) | 20) & 0xFu; }
#define XB_SPIN(cond, bar) do { unsigned _sp = 0; while (cond) { __builtin_amdgcn_s_sleep(1); \
    if ((++_sp & 255u) == 0u) { if (xb_ld(&(bar)[XB_TMO])) break; if (_sp > XB_SPIN_CAP) { atomicAdd(&(bar)[XB_TMO], 1u); break; } } } } while (0)
struct XcdBarrier { unsigned* bar; unsigned x; volatile LAS unsigned* st; };
__device__ __forceinline__ XcdBarrier xcd_barrier_post(unsigned* bar, volatile LAS unsigned* st) {
    XcdBarrier b; b.bar = bar; b.x = xb_xcc_id(); b.st = st;
    if (threadIdx.x == 0) (void)xb_add(&bar[XB_XCNT(b.x)], 1u);
    return b;
}
__device__ __forceinline__ void xcd_barrier_complete(unsigned* bar, unsigned x, unsigned& nloc, unsigned& nx) {
    const unsigned G = gridDim.x * gridDim.y * gridDim.z;
    unsigned sum, cnt, mine, sp = 0u;
    for (;;) {
        sum = 0u; cnt = 0u; mine = 0u;
#pragma unroll
        for (unsigned j = 0; j < 16; ++j) { const unsigned c = xb_ld(&bar[XB_XCNT(j)]); sum += c; cnt += (c > 0u) ? 1u : 0u; mine = (j == x) ? c : mine; }
        if (sum == G) break;
        __builtin_amdgcn_s_sleep(1);
        if ((++sp & 255u) == 0u) { if (xb_ld(&bar[XB_TMO])) break; if (sp > XB_SPIN_CAP) { atomicAdd(&bar[XB_TMO], 1u); break; } }
    }
    nloc = mine > 0u ? mine : 1u; nx = cnt > 0u ? cnt : 1u;
}
__device__ __forceinline__ void xcd_barrier(const XcdBarrier& b) {
    asm volatile("s_waitcnt vmcnt(0)" ::: "memory");
    __syncthreads();
    if (threadIdx.x == 0) {
        unsigned* bar = b.bar;
        __builtin_amdgcn_s_waitcnt(0);
        unsigned nloc = b.st[0], nx = b.st[1];
        if (nloc == 0u) { xcd_barrier_complete(bar, b.x, nloc, nx); b.st[0] = nloc; b.st[1] = nx; }
        const unsigned old = xb_add(&bar[XB_XSUB(b.x)], 1u);
        const unsigned gen = old / nloc;
        if (old + 1u == (gen + 1u) * nloc) {
            __builtin_amdgcn_fence(__ATOMIC_RELEASE, "agent");
            asm volatile("s_waitcnt vmcnt(0)" ::: "memory");
            const unsigned og = xb_add(&bar[XB_TOP], 1u);
            const unsigned tg = og / nx;
            if (og + 1u == (tg + 1u) * nx) xb_add(&bar[XB_TOPGEN], 1u);
            else XB_SPIN(xb_ld(&bar[XB_TOPGEN]) == tg, bar);
            __builtin_amdgcn_fence(__ATOMIC_ACQUIRE, "agent");
            xb_add(&bar[XB_XGEN(b.x)], 1u);
            asm volatile("s_waitcnt vmcnt(0)" ::: "memory");
        } else {
            XB_SPIN(xb_ld(&bar[XB_XGEN(b.x)]) == gen, bar);
            __builtin_amdgcn_fence(__ATOMIC_ACQUIRE, "agent");
            asm volatile("s_waitcnt vmcnt(0)" ::: "memory");
        }
    }
    __syncthreads();
}

__device__ __forceinline__ float bf2f(unsigned h) { return __uint_as_float(h << 16); }
__device__ __forceinline__ unsigned f2bf(float f) { unsigned u = __float_as_uint(f); return (u + 0x7fffu + ((u >> 16) & 1u)) >> 16; }
__device__ __forceinline__ unsigned pk2(float lo, float hi) { return f2bf(lo) | (f2bf(hi) << 16); }
typedef float f32x2_t __attribute__((ext_vector_type(2)));
typedef __bf16 bf16x2_t __attribute__((ext_vector_type(2)));
__device__ __forceinline__ unsigned cvtpk(float lo, float hi) { f32x2_t v = {lo, hi}; bf16x2_t b = __builtin_convertvector(v, bf16x2_t); return __builtin_bit_cast(unsigned, b); }
__device__ __forceinline__ float lo16(unsigned w) { return __uint_as_float(w << 16); }
__device__ __forceinline__ float hi16(unsigned w) { return __uint_as_float(w & 0xffff0000u); }
__device__ __forceinline__ float wave_sum(float v) {
#pragma unroll
    for (int o = 1; o < 64; o <<= 1) v += __shfl_xor(v, o);
    return v;
}
__device__ __forceinline__ float siluf(float v) { return v / (1.f + __expf(-v)); }
__device__ __forceinline__ int mod_row(int tok) { return tok < NLAT ? (tok >> 11) : 16; }

struct P { const float* in[29]; float* out; unsigned char* ws; int ph_lo, ph_hi; };

__device__ __forceinline__ bf16_t* x_row(const P& p, int tok) { return (bf16_t*)(p.ws + WS_X) + (size_t)tok * D; }
__device__ __forceinline__ const float* x_in_row(const P& p, int tok) {
    return tok < NLAT ? p.in[0] + (size_t)tok * D : p.in[2] + (size_t)(tok - NLAT) * D;
}

template <int MF, class RowSrc, class Epi>
__device__ __forceinline__ void gemm_tile(unsigned char* lds, const RowSrc& rs, const bf16_t* Bt, int ldb, int K, const Epi& epi) {
    constexpr int ROWS = 32 * MF, NPA = ROWS * 8;
    const int tid = threadIdx.x, lane = tid & 63, wid = tid >> 6, wr = wid >> 2, wc = wid & 3, fr = lane & 15, fq = lane >> 4;
    bf16_t* As = (bf16_t*)lds; bf16_t* Bs = As + ROWS * 72;
    const bf16_t* ap[3]; int al[3];
#pragma unroll
    for (int i = 0; i < 3; ++i) { const int id = tid + 512 * i, r = id >> 3, c = (id & 7) * 8; ap[i] = (id < NPA) ? rs(r) + c : nullptr; al[i] = r * 72 + c; }
    const int lr = tid >> 2, lc = (tid & 3) * 16;
    const bf16_t* bp = Bt + (size_t)lr * ldb + lc;
    u32x4 a[3], b0 = *(const u32x4*)bp, b1 = *(const u32x4*)(bp + 8);
#pragma unroll
    for (int i = 0; i < 3; ++i) if (ap[i]) a[i] = *(const u32x4*)ap[i];
    f32x4 acc[MF][2];
#pragma unroll
    for (int m = 0; m < MF; ++m)
#pragma unroll
        for (int n = 0; n < 2; ++n) acc[m][n] = (f32x4){0.f, 0.f, 0.f, 0.f};
    for (int k0 = 0; k0 < K; k0 += 64) {
        __syncthreads();
#pragma unroll
        for (int i = 0; i < 3; ++i) if (ap[i]) *(u32x4*)(As + al[i]) = a[i];
        *(u32x4*)(Bs + lr * 72 + lc) = b0; *(u32x4*)(Bs + lr * 72 + lc + 8) = b1;
        __syncthreads();
        if (k0 + 64 < K) {
#pragma unroll
            for (int i = 0; i < 3; ++i) if (ap[i]) { ap[i] += 64; a[i] = *(const u32x4*)ap[i]; }
            bp += 64; b0 = *(const u32x4*)bp; b1 = *(const u32x4*)(bp + 8);
        }
#pragma unroll
        for (int kk = 0; kk < 2; ++kk) {
            bf16x8 af[MF], bfr[2];
#pragma unroll
            for (int m = 0; m < MF; ++m) af[m] = *(const bf16x8*)(As + (wr * 16 * MF + m * 16 + fr) * 72 + kk * 32 + fq * 8);
#pragma unroll
            for (int n = 0; n < 2; ++n) bfr[n] = *(const bf16x8*)(Bs + (wc * 32 + n * 16 + fr) * 72 + kk * 32 + fq * 8);
#pragma unroll
            for (int m = 0; m < MF; ++m)
#pragma unroll
                for (int n = 0; n < 2; ++n) acc[m][n] = __builtin_amdgcn_mfma_f32_16x16x32_bf16(bfr[n], af[m], acc[m][n], 0, 0, 0);
        }
    }
#pragma unroll
    for (int m = 0; m < MF; ++m)
#pragma unroll
        for (int n = 0; n < 2; ++n) epi(wr * 16 * MF + m * 16 + fr, wc * 32 + n * 16 + 4 * fq, acc[m][n]);
}

namespace ge {
constexpr int BM = 256, BK = 64, HALF = 128, HTB = HALF * BK * 2;
__device__ __forceinline__ int lds_byte(int r, int c) { const int st = (r >> 4) * 2 + (c >> 5), rr = r & 15, cc = c & 31, ob = rr * 64 + cc * 2; return st * 1024 + (ob ^ (((ob >> 9) & 1) << 5)); }
__device__ __forceinline__ void stage_rc(int b, int& R, int& C) { const int st = b / 1024, sb = b % 1024, swz = sb ^ (((sb >> 9) & 1) << 5); R = (st >> 1) * 16 + swz / 64; C = (st & 1) * 32 + (swz % 64) / 2; }
struct Unit { const char* B; int a, b, c, d; };
typedef f32x4 Acc[2][2][4][2];

template <class Sched, class Epi, bool ALIGN_EPI>
__device__ __forceinline__ void gemm_stream(LAS unsigned char* lds, const char* Ab, int K, const Sched& S, const Epi& E) {
    const int tid = threadIdx.x, wid = __builtin_amdgcn_readfirstlane(tid >> 6), lane = tid & 63, wr = wid >> 2, wc = wid & 3, fr = lane & 15, fq = lane >> 4;
    const int nt = K / BK;
    int Rr[2], Cc[2]; unsigned voffB[2];
#pragma unroll
    for (int i = 0; i < 2; ++i) { stage_rc(tid * 16 + i * 8192, Rr[i], Cc[i]);
        const int rho = Rr[i] & 31, Rb = (Rr[i] & ~31) + 8 * ((rho & 15) >> 2) + 4 * (rho >> 4) + (rho & 3);
        voffB[i] = (unsigned)(Rb * K + Cc[i]) * 2u; }
    const size_t kstep = (size_t)(BK * 2), hstepB = (size_t)HALF * K * 2;
    const unsigned ldsw = (unsigned)wid * 1024u;
    const int aoff = lds_byte(wr * 64 + fr, fq * 8), boff = lds_byte(wc * 32 + fr, fq * 8);
#define GE_SA(b, h) (((b) * 2 + (h)) * HTB)
#define GE_SB(b, h) ((4 + (b) * 2 + (h)) * HTB)
#define GE_GLDS(gp, ldsoff) __builtin_amdgcn_global_load_lds((const unsigned*)(gp), (LAS unsigned*)(lds + (ldsoff)), 16, 0, 0)
#define GE_STAGE_B(bufoff, gbase) do { GE_GLDS((const char*)(gbase) + voffB[0], (bufoff) + ldsw); GE_GLDS((const char*)(gbase) + voffB[1], (bufoff) + ldsw + 8192); } while (0)
#define GE_STAGE_A(bufoff, kbytes, o0, o1) do { GE_GLDS(Ab + (kbytes) + (o0), (bufoff) + ldsw); GE_GLDS(Ab + (kbytes) + (o1), (bufoff) + ldsw + 8192); } while (0)
#define GE_LDA(dst, b, h) do { _Pragma("unroll") for (int m = 0; m < 4; ++m) _Pragma("unroll") for (int k = 0; k < 2; ++k) dst[m][k] = *(const LAS bf16x8*)(lds + GE_SA(b, h) + aoff + m * 2048 + k * 1024); } while (0)
#define GE_LDB(dst, b, h) do { _Pragma("unroll") for (int n = 0; n < 2; ++n) _Pragma("unroll") for (int k = 0; k < 2; ++k) dst[n][k] = *(const LAS bf16x8*)(lds + GE_SB(b, h) + boff + n * 2048 + k * 1024); } while (0)
#define GE_MMA(ai, bj, At, Bt) do { __builtin_amdgcn_s_setprio(1); _Pragma("unroll") for (int m = 0; m < 4; ++m) _Pragma("unroll") for (int n = 0; n < 2; ++n) _Pragma("unroll") for (int k = 0; k < 2; ++k) \
        acc[ai][bj][m][n] = __builtin_amdgcn_mfma_f32_16x16x32_bf16(Bt[n][k], At[m][k], acc[ai][bj][m][n], 0, 0, 0); __builtin_amdgcn_s_setprio(0); } while (0)
#define GE_WAIT_V(n) asm volatile("s_waitcnt vmcnt(" #n ")" ::: "memory")
#define GE_WAIT_L(n) asm volatile("s_waitcnt lgkmcnt(" #n ")" ::: "memory")
#define GE_BAR __builtin_amdgcn_s_barrier()
#define GE_SCHED __builtin_amdgcn_sched_barrier(0)
    Unit cur, nxt; int ui = 0;
    if (!S.next(0, cur)) return;
    Acc acc;
#pragma unroll
    for (int a = 0; a < 2; ++a)
#pragma unroll
        for (int b = 0; b < 2; ++b)
#pragma unroll
            for (int m = 0; m < 4; ++m)
#pragma unroll
                for (int n = 0; n < 2; ++n) acc[a][b][m][n] = (f32x4){0.f, 0.f, 0.f, 0.f};
    bf16x8 At[4][2], B0[2][2], B1[2][2];
    unsigned oc00, oc01, oc10, oc11, on00, on01, on10, on11;
    oc00 = S.aoff(0, cur, Rr[0]) + (unsigned)Cc[0] * 2u; oc01 = S.aoff(0, cur, Rr[1]) + (unsigned)Cc[1] * 2u;
    oc10 = S.aoff(0, cur, Rr[0] + 128) + (unsigned)Cc[0] * 2u; oc11 = S.aoff(0, cur, Rr[1] + 128) + (unsigned)Cc[1] * 2u;
    const char* cB = cur.B;
    GE_STAGE_B(GE_SB(0, 0), cB); GE_STAGE_B(GE_SB(0, 1), cB + hstepB); GE_STAGE_A(GE_SA(0, 0), 0, oc00, oc01); GE_STAGE_A(GE_SA(0, 1), 0, oc10, oc11);
    if (wr == 1) GE_BAR;
    GE_WAIT_V(2); GE_BAR;
    GE_STAGE_B(GE_SB(1, 0), cB + kstep); GE_STAGE_A(GE_SA(1, 0), kstep, oc00, oc01); GE_STAGE_B(GE_SB(1, 1), cB + hstepB + kstep);
    GE_WAIT_V(6); GE_BAR;
    for (;;) {
        const bool has_next = S.next(ui + 1, nxt);
        const char* nB = has_next ? nxt.B : cB;
        if (has_next) {
            on00 = S.aoff(ui + 1, nxt, Rr[0]) + (unsigned)Cc[0] * 2u; on01 = S.aoff(ui + 1, nxt, Rr[1]) + (unsigned)Cc[1] * 2u;
            on10 = S.aoff(ui + 1, nxt, Rr[0] + 128) + (unsigned)Cc[0] * 2u; on11 = S.aoff(ui + 1, nxt, Rr[1] + 128) + (unsigned)Cc[1] * 2u;
        } else { on00 = oc00; on01 = oc01; on10 = oc10; on11 = oc11; }
#pragma unroll 1
        for (int t = 0; t < nt; t += 2) {
            const bool last = (t == nt - 2);
            const size_t k1 = (size_t)(t + 1) * kstep;
            const size_t k2 = last ? 0 : (size_t)(t + 2) * kstep, k3 = k2 + kstep;
            const char* b2 = last ? nB : cB + (size_t)(t + 2) * kstep; const char* b3 = b2 + kstep;
            const unsigned o00 = last ? on00 : oc00, o01 = last ? on01 : oc01, o10 = last ? on10 : oc10, o11 = last ? on11 : oc11;
            GE_LDB(B0, 0, 0); GE_LDB(B1, 0, 1); GE_SCHED; GE_LDA(At, 0, 0); GE_STAGE_A(GE_SA(1, 1), k1, oc10, oc11);
            GE_WAIT_V(8); GE_WAIT_L(0); GE_BAR; GE_MMA(0, 0, At, B0); GE_MMA(0, 1, At, B1); GE_BAR; GE_SCHED;
            GE_LDA(At, 0, 1); GE_STAGE_B(GE_SB(0, 0), b2); GE_STAGE_B(GE_SB(0, 1), b2 + hstepB); GE_STAGE_A(GE_SA(0, 0), k2, o00, o01);
            GE_WAIT_V(8); GE_WAIT_L(0); GE_BAR; GE_MMA(1, 0, At, B0); GE_MMA(1, 1, At, B1); GE_BAR; GE_SCHED;
            GE_LDB(B0, 1, 0); GE_LDB(B1, 1, 1); GE_SCHED; GE_LDA(At, 1, 0); GE_STAGE_A(GE_SA(0, 1), k2, o10, o11);
            GE_WAIT_V(8); GE_WAIT_L(0); GE_BAR; GE_MMA(0, 0, At, B0); GE_MMA(0, 1, At, B1); GE_BAR; GE_SCHED;
            GE_LDA(At, 1, 1); GE_STAGE_B(GE_SB(1, 0), b3); GE_STAGE_B(GE_SB(1, 1), b3 + hstepB); GE_STAGE_A(GE_SA(1, 0), k3, o00, o01);
            GE_WAIT_V(8); GE_WAIT_L(0); GE_BAR; GE_MMA(1, 0, At, B0); GE_MMA(1, 1, At, B1); GE_BAR; GE_SCHED;
        }
        if constexpr (ALIGN_EPI) { if (wr == 0) GE_BAR; }
        E(acc, cur, wr, wc, fr, fq);
        if (!has_next) break;
#pragma unroll
        for (int a = 0; a < 2; ++a)
#pragma unroll
            for (int b = 0; b < 2; ++b)
#pragma unroll
                for (int m = 0; m < 4; ++m)
#pragma unroll
                    for (int n = 0; n < 2; ++n) acc[a][b][m][n] = (f32x4){0.f, 0.f, 0.f, 0.f};
        cur = nxt; cB = nB; ++ui; oc00 = on00; oc01 = on01; oc10 = on10; oc11 = on11;
        if constexpr (ALIGN_EPI) { if (wr == 1) GE_BAR; }
    }
    GE_WAIT_V(0);
    if constexpr (!ALIGN_EPI) { if (wr == 0) GE_BAR; }
    GE_BAR;
#undef GE_SA
#undef GE_SB
#undef GE_GLDS
#undef GE_STAGE_A
#undef GE_STAGE_B
#undef GE_LDA
#undef GE_LDB
#undef GE_MMA
#undef GE_WAIT_V
#undef GE_WAIT_L
#undef GE_BAR
#undef GE_SCHED
}
template <class F> struct EpiFn {
    F f;
    __device__ __forceinline__ void operator()(const Acc& acc, const Unit& u, int wr, int wc, int fr, int fq) const {
#pragma unroll
        for (int ai = 0; ai < 2; ++ai)
#pragma unroll
            for (int m = 0; m < 4; ++m)
#pragma unroll
                for (int bj = 0; bj < 2; ++bj) f(u, ai * 128 + wr * 64 + m * 16 + fr, bj * 128 + wc * 32 + 8 * fq, acc[ai][bj][m][0], acc[ai][bj][m][1]);
    }
};
struct DenseOrder {
    int nM, nN, nwg, G, c; const char* Bt; size_t btile; unsigned arow;
    __device__ __forceinline__ bool next(int i, Unit& u) const {
        const long L = (long)i * G + c; if (L >= nwg) return false;
        int wgid = (int)L; { const int q = nwg / 8, r = nwg % 8, xcd = wgid % 8, off = wgid / 8; wgid = (xcd < r ? xcd * (q + 1) : r * (q + 1) + (xcd - r) * q) + off; }
        const int nig = 8 * nN, gid = wgid / nig, fm = gid * 8, gsz = (nM - fm) < 8 ? (nM - fm) : 8;
        u.a = fm + ((wgid % nig) % gsz); u.b = (wgid % nig) / gsz; u.c = 0; u.d = 0; u.B = Bt + (size_t)u.b * btile; return true;
    }
    __device__ __forceinline__ unsigned aoff(int, const Unit& u, int R) const { return (unsigned)(u.a * 256 + R) * arow; }
};
}

struct TMap { const float* s0; const float* s1; int ld; int nvalid; const float* ksc; float gsc; };
template <int MODE> __device__ __forceinline__ const float* tmap_src(const float* s0, const float* s1, int nvalid, int n) {
    if (MODE == 0) return n < nvalid ? s0 + n : nullptr;
    if (MODE == 1) { const int h = n / 96, j = n % 96; const int c = j < 64 ? j : 64 + ((j - 64) & 1) * 16 + ((j - 64) >> 1); return s0 + h * 96 + c; }
    return ((n & 1) ? s1 : s0) + (n >> 1);
}
template <int MODE> __device__ __forceinline__ void transpose_unit(float* scr, const float* s0, const float* s1, int ld, int nvalid, const float* ksc, float gsc, int K, bf16_t* dst, int kb, int nb, int kvalid = 1 << 30) {
    const int tid = threadIdx.x, k0 = kb * 64, n0 = nb * 64;
    const int nn = tid & 63; const float* sp = tmap_src<MODE>(s0, s1, nvalid, n0 + nn);
#pragma unroll
    for (int i = 0; i < 8; ++i) {
        const int kk = (tid >> 6) + 8 * i; float v = (sp && k0 + kk < kvalid) ? sp[(size_t)(k0 + kk) * ld] : 0.f;
        if (ksc && k0 + kk < kvalid) v *= ksc[k0 + kk];
        scr[kk * 65 + nn] = v * gsc;
    }
    __syncthreads();
    {
        const int n2 = tid >> 3, kc = tid & 7; const float* s = scr + (kc * 8) * 65 + n2;
        u32x4 o; o.x = pk2(s[0], s[65]); o.y = pk2(s[2 * 65], s[3 * 65]); o.z = pk2(s[4 * 65], s[5 * 65]); o.w = pk2(s[6 * 65], s[7 * 65]);
        *(u32x4*)(dst + (size_t)(n0 + n2) * K + k0 + kc * 8) = o;
    }
    __syncthreads();
}
template <int MODE> __device__ __forceinline__ void transpose_matrix(float* scr, const float* s0, const float* s1, int ld, int nvalid, const float* ksc, float gsc, int K, int Nd, bf16_t* dst, int& rot, int kvalid = 1 << 30) {
    const int nkb = K / 64, nnb = Nd / 64, nu = nkb * nnb, G = gridDim.x;
    int first = ((int)blockIdx.x - rot) % G; if (first < 0) first += G;
    for (int u = first; u < nu; u += G) transpose_unit<MODE>(scr, s0, s1, ld, nvalid, ksc, gsc, K, dst, u / nnb, u % nnb, kvalid);
    rot = (rot + nu) % G;
}
__device__ __forceinline__ void convert_expert_weights(unsigned char* lds, const P& p, int L) {
    float* scr = (float*)lds; const int G = gridDim.x, tid = threadIdx.x;
    constexpr int S = 261;
    bf16_t* egu = (bf16_t*)(p.ws + WS_EGU); bf16_t* ed = (bf16_t*)(p.ws + WS_ED);
    for (int ub = blockIdx.x; ub < NEXP * 48; ub += G) {
        const int e = ub / 48, r = (ub % 48) * 4;
        bf16_t* dst; int K, k0;
        if (r < 128) {
            const int kb = r >> 3, nb0 = r & 7; k0 = kb * 64; K = D; dst = egu + ((size_t)e * 512 + nb0 * 64) * D;
            const float* gsrc = p.in[22] + ((size_t)L * NEXP + e) * D * EDIM + nb0 * 32; const float* usrc = p.in[23] + ((size_t)L * NEXP + e) * D * EDIM + nb0 * 32;
            f32x4 v[8];
#pragma unroll
            for (int i = 0; i < 8; ++i) { const int idx = tid + 512 * i, kk = idx >> 6, c = idx & 63; v[i] = *(const f32x4*)((c < 32 ? gsrc : usrc) + (size_t)(k0 + kk) * EDIM + (c & 31) * 4); }
#pragma unroll
            for (int i = 0; i < 8; ++i) { const int idx = tid + 512 * i, kk = idx >> 6, c = idx & 63; float* d = scr + kk * S + 8 * (c & 31) + (c >> 5);
                d[0] = v[i].x; d[2] = v[i].y; d[4] = v[i].z; d[6] = v[i].w; }
        } else {
            const int r2 = r - 128, kb = r2 >> 4, nb0 = r2 & 15; k0 = kb * 64; K = EDIM; dst = ed + ((size_t)e * D + nb0 * 64) * EDIM;
            const float* src = p.in[24] + ((size_t)L * NEXP + e) * EDIM * D + nb0 * 64;
            f32x4 v[8];
#pragma unroll
            for (int i = 0; i < 8; ++i) { const int idx = tid + 512 * i, kk = idx >> 6, c = idx & 63; v[i] = *(const f32x4*)(src + (size_t)(k0 + kk) * D + c * 4); }
#pragma unroll
            for (int i = 0; i < 8; ++i) { const int idx = tid + 512 * i, kk = idx >> 6, c = idx & 63; float* d = scr + kk * S + 4 * c;
                d[0] = v[i].x; d[1] = v[i].y; d[2] = v[i].z; d[3] = v[i].w; }
        }
        __syncthreads();
#pragma unroll
        for (int i = 0; i < 4; ++i) {
            const int id = tid + 512 * i, n = id >> 3, kc = id & 7; const float* sp = scr + (kc * 8) * S + n;
            u32x4 o; o.x = cvtpk(sp[0], sp[S]); o.y = cvtpk(sp[2 * S], sp[3 * S]); o.z = cvtpk(sp[4 * S], sp[5 * S]); o.w = cvtpk(sp[6 * S], sp[7 * S]);
            *(u32x4*)(dst + (size_t)n * K + k0 + kc * 8) = o;
        }
        __syncthreads();
    }
}
__device__ __forceinline__ void prep_mod_unit(unsigned char* lds, const P& p, int u) {
    float* sc = (float*)lds;
    float* part = sc + 17 * 1024;
    const int tid = threadIdx.x;
    const float* c = p.in[1]; const float* cctx = p.in[3];
    for (int i = tid; i < 17 * 1024; i += NTHREADS) { const int r = i >> 10, k = i & 1023; const float v = r < 16 ? c[r * 1024 + k] : cctx[k]; sc[i] = v / (1.f + expf(-v)); }
    __syncthreads();
    const int L = u / 192, cg = u % 192, ks = tid >> 5, cl = tid & 31, col = cg * 32 + cl;
    const float* w = p.in[4] + (size_t)L * 1024 * 6144 + (size_t)(ks * 64) * 6144 + col;
    float acc[17];
#pragma unroll
    for (int r = 0; r < 17; ++r) acc[r] = 0.f;
#pragma unroll 8
    for (int k = 0; k < 64; ++k) {
        const float wv = w[(size_t)k * 6144];
#pragma unroll
        for (int r = 0; r < 17; ++r) acc[r] += sc[r * 1024 + ks * 64 + k] * wv;
    }
#pragma unroll
    for (int r = 0; r < 17; ++r) part[(ks * 17 + r) * 32 + cl] = acc[r];
    __syncthreads();
    float* modv = (float*)(p.ws + WS_MODV);
    for (int i = tid; i < 17 * 32; i += NTHREADS) {
        const int r = i >> 5, c2 = i & 31;
        float s2 = p.in[5][L * 6144 + cg * 32 + c2];
#pragma unroll
        for (int q = 0; q < 16; ++q) s2 += part[(q * 17 + r) * 32 + c2];
        modv[((size_t)L * 17 + r) * 6144 + cg * 32 + c2] = s2;
    }
    __syncthreads();
}
__device__ __forceinline__ void phase_prep(unsigned char* lds, const P& p) {
    const int tid = threadIdx.x, G = gridDim.x, bid = blockIdx.x;
    {
        float* ct = (float*)(p.ws + WS_ROPE); float* st = ct + 2048 * 16;
        for (int i = bid * NTHREADS + tid; i < 2048 * 16; i += G * NTHREADS) {
            const int pos = i >> 4, f = i & 15;
            const float inv = powf(10000.f, -(float)(f & 7) / 8.f);
            const float ang = (float)(f < 8 ? (pos >> 6) : (pos & 63)) * inv;
            ct[i] = cosf(ang); st[i] = sinf(ang);
        }
    }
    for (int u = G - 1 - bid; u < 384; u += G) prep_mod_unit(lds, p, u);
    float* scr = (float*)lds; int rot = 0;
    for (int L = 0; L < 2; ++L) {
        transpose_matrix<0>(scr, p.in[7] + (size_t)L * D * Z_END, nullptr, Z_END, Z_END, nullptr, 1.f, D, ZC, (bf16_t*)(p.ws + WS_WIN) + (size_t)L * ZC * D, rot);
        transpose_matrix<1>(scr, p.in[15] + (size_t)L * 256 * 768, nullptr, 768, 768, p.in[14] + L * 256, 0.14724574f, 256, 768, (bf16_t*)(p.ws + WS_WUQ) + (size_t)L * 768 * 256, rot);
        transpose_matrix<0>(scr, p.in[17] + (size_t)L * 128 * 1024, nullptr, 1024, 1024, p.in[16] + L * 128, 1.f, 256, 1024, (bf16_t*)(p.ws + WS_WUKV) + (size_t)L * 1024 * 256, rot, 128);
        transpose_matrix<0>(scr, p.in[18] + (size_t)L * D * D, nullptr, D, D, nullptr, 1.f, D, D, (bf16_t*)(p.ws + WS_WOUT) + (size_t)L * D * D, rot);
        transpose_matrix<0>(scr, p.in[20] + (size_t)L * D * NEXP, nullptr, NEXP, NEXP, nullptr, 1.f, D, 128, (bf16_t*)(p.ws + WS_RT) + (size_t)L * 128 * D, rot);
        transpose_matrix<2>(scr, p.in[25] + (size_t)L * D * EDIM, p.in[26] + (size_t)L * D * EDIM, EDIM, 512, nullptr, 1.f, D, 512, (bf16_t*)(p.ws + WS_SHGU) + (size_t)L * 512 * D, rot);
        transpose_matrix<0>(scr, p.in[27] + (size_t)L * EDIM * D, nullptr, D, D, nullptr, 1.f, EDIM, D, (bf16_t*)(p.ws + WS_SHD) + (size_t)L * D * EDIM, rot);
    }
}

__device__ __forceinline__ void phase_norm_mod(const P& p, int L, int which  , int ntok) {
    const int tid = threadIdx.x, lane = tid & 63, wave = tid >> 6, gw = blockIdx.x * NWAVES + wave, NGW = gridDim.x * NWAVES;
    const float* nw = (which == 0 ? p.in[6] : p.in[19]) + L * D;
    const float* modv = (const float*)(p.ws + WS_MODV) + (size_t)L * 17 * 6144;
    bf16_t* H = (bf16_t*)(p.ws + WS_H);
    for (int tok = gw; tok < ntok; tok += NGW) {
        const f32x4* xr = (const f32x4*)x_in_row(p, tok) + lane;
        const float* mrow = modv + (size_t)mod_row(tok) * 6144 + which * 3072;
        f32x4 v[4]; float s = 0.f;
#pragma unroll
        for (int j = 0; j < 4; ++j) { v[j] = xr[64 * j]; s += v[j].x * v[j].x + v[j].y * v[j].y + v[j].z * v[j].z + v[j].w * v[j].w; }
        const float rstd = rsqrtf(wave_sum(s) * (1.f / D) + NORM_EPS);
        u32x2* o = (u32x2*)(H + (size_t)tok * D) + lane;
#pragma unroll
        for (int j = 0; j < 4; ++j) {
            const int k = 4 * lane + 256 * j;
            const f32x4 w4 = *(const f32x4*)(nw + k), sh = *(const f32x4*)(mrow + k), sc = *(const f32x4*)(mrow + 1024 + k);
            const float y0 = v[j].x * rstd * w4.x * (1.f + sc.x) + sh.x, y1 = v[j].y * rstd * w4.y * (1.f + sc.y) + sh.y;
            const float y2 = v[j].z * rstd * w4.z * (1.f + sc.z) + sh.z, y3 = v[j].w * rstd * w4.w * (1.f + sc.w) + sh.w;
            u32x2 w; w.x = pk2(y0, y1); w.y = pk2(y2, y3); o[64 * j] = w;
        }
    }
}

struct EpiZ {
    bf16_t* Z; float* ssq; float* sskv; bf16_t* Kb; const float* ct; const float* st;
    __device__ __forceinline__ void operator()(const ge::Acc& acc, const ge::Unit& u, int wr, int wc, int fr, int fq) const {
#pragma unroll
        for (int ai = 0; ai < 2; ++ai)
#pragma unroll
            for (int m = 0; m < 4; ++m) {
                const int row = u.a * 256 + ai * 128 + wr * 64 + m * 16 + fr;
#pragma unroll
                for (int bj = 0; bj < 2; ++bj) {
                    const f32x4 v0 = acc[ai][bj][m][0], v1 = acc[ai][bj][m][1];
                    u32x4 w; w.x = cvtpk(v0.x, v0.y); w.y = cvtpk(v0.z, v0.w); w.z = cvtpk(v1.x, v1.y); w.w = cvtpk(v1.z, v1.w);
                    *(u32x4*)(Z + (size_t)row * ZC + u.b * 256 + bj * 128 + wc * 32 + 8 * fq) = w;
                }
                if (u.b == 5) {
                    float sq = 0.f;
#pragma unroll
                    for (int bj = 0; bj < 2; ++bj)
#pragma unroll
                        for (int n = 0; n < 2; ++n) { const f32x4 v = acc[ai][bj][m][n]; sq += v.x * v.x + v.y * v.y + v.z * v.z + v.w * v.w; }
                    sq += __shfl_xor(sq, 16); sq += __shfl_xor(sq, 32);
                    if (fq == 0) ssq[(size_t)row * 4 + wc] = sq;
                }
                if (u.b == 6) {
                    float sq = 0.f;
#pragma unroll
                    for (int n = 0; n < 2; ++n) { const f32x4 v = acc[ai][0][m][n]; sq += v.x * v.x + v.y * v.y + v.z * v.z + v.w * v.w; }
                    sq += __shfl_xor(sq, 16); sq += __shfl_xor(sq, 32);
                    if (fq == 0) sskv[(size_t)row * 4 + wc] = sq;
                    if (wc == 0) {
                        const f32x4 a0 = acc[ai][1][m][0], a1 = acc[ai][1][m][1];
                        f32x4 b0, b1;
#pragma unroll
                        for (int j = 0; j < 4; ++j) { b0[j] = __shfl_xor(a0[j], 32); b1[j] = __shfl_xor(a1[j], 32); }
                        if (fq < 2) {
                            f32x4 c0 = (f32x4){1.f, 1.f, 1.f, 1.f}, c1 = c0, s0 = (f32x4){0.f, 0.f, 0.f, 0.f}, s1 = s0;
                            if (row < NLAT) { const int pos = row & (SEQ - 1); c0 = *(const f32x4*)(ct + pos * 16 + 8 * fq); c1 = *(const f32x4*)(ct + pos * 16 + 8 * fq + 4); s0 = *(const f32x4*)(st + pos * 16 + 8 * fq); s1 = *(const f32x4*)(st + pos * 16 + 8 * fq + 4); }
                            const f32x4 o10 = a0 * c0 - b0 * s0, o20 = a0 * s0 + b0 * c0, o11 = a1 * c1 - b1 * s1, o21 = a1 * s1 + b1 * c1;
                            u32x4 w0, w1; w0.x = cvtpk(o10.x, o20.x); w0.y = cvtpk(o10.y, o20.y); w0.z = cvtpk(o10.z, o20.z); w0.w = cvtpk(o10.w, o20.w);
                            w1.x = cvtpk(o11.x, o21.x); w1.y = cvtpk(o11.y, o21.y); w1.z = cvtpk(o11.z, o21.z); w1.w = cvtpk(o11.w, o21.w);
#pragma unroll
                            for (int h = 0; h < 8; ++h) { bf16_t* kp = Kb + (size_t)row * 768 + h * 96 + 64 + 16 * fq; *(u32x4*)kp = w0; *(u32x4*)(kp + 8) = w1; }
                        }
                    }
                }
            }
    }
};
__device__ __forceinline__ void phase_zgemm(unsigned char* lds, const P& p, int L) {
    const bf16_t* W = (const bf16_t*)(p.ws + WS_WIN) + (size_t)L * ZC * D;
    ge::DenseOrder S; S.nM = NTOK / 256; S.nN = ZC / 256; S.nwg = S.nM * S.nN; S.G = gridDim.x; S.c = blockIdx.x; S.Bt = (const char*)W; S.btile = (size_t)256 * D * 2; S.arow = D * 2;
    EpiZ E{(bf16_t*)(p.ws + WS_Z), (float*)(p.ws + WS_SS), (float*)(p.ws + WS_SS) + (size_t)NTOK * 4, (bf16_t*)(p.ws + WS_K), (const float*)(p.ws + WS_ROPE), (const float*)(p.ws + WS_ROPE) + 2048 * 16};
    ge::gemm_stream<ge::DenseOrder, EpiZ, true>((LAS unsigned char*)lds, (const char*)(p.ws + (L == 0 ? WS_H : WS_H1)), D, S, E);
}

__device__ __forceinline__ void conv_unit(unsigned char* lds, const P& p, int L, int s, int tt) {
    float* hg = (float*)lds;
    const int tid = threadIdx.x, lane = tid & 63, wave = tid >> 6;
    const int rb = s < 16 ? s * SEQ : NLAT + (s - 16) * CTXL, len = s < 16 ? SEQ : CTXL, t0 = tt * 64;
    const bf16_t* Z = (const bf16_t*)(p.ws + WS_Z);
    for (int i = tid; i < 94 * 64; i += NTHREADS) {
        const int jj = i >> 6, c4 = (i & 63) * 4, t = t0 - 15 + jj;
        f32x4 h = (f32x4){0.f, 0.f, 0.f, 0.f};
        if (t >= 0 && t < len) {
            const bf16_t* zr = Z + (size_t)(rb + t) * ZC;
            const u32x2 a = *(const u32x2*)(zr + c4), g = *(const u32x2*)(zr + 256 + c4);
            const float g0 = lo16(g.x), g1 = hi16(g.x), g2 = lo16(g.y), g3 = hi16(g.y);
            h.x = lo16(a.x) / (1.f + __expf(-g0)); h.y = hi16(a.x) / (1.f + __expf(-g1));
            h.z = lo16(a.y) / (1.f + __expf(-g2)); h.w = hi16(a.y) / (1.f + __expf(-g3));
        }
        *(f32x4*)(hg + jj * 256 + c4) = h;
    }
    float* wl = hg + 94 * 256;
    for (int i = tid; i < 31 * 64; i += NTHREADS) *(f32x4*)(wl + i * 4) = *(const f32x4*)(p.in[8] + (size_t)L * 31 * 256 + i * 4);
    __syncthreads();
    const int c0 = lane * 4;
    const f32x4 cb = *(const f32x4*)(p.in[9] + L * 256 + c0), lw = *(const f32x4*)(p.in[10] + L * 256 + c0), lb = *(const f32x4*)(p.in[11] + L * 256 + c0);
    bf16_t* CC = (bf16_t*)(p.ws + WS_CC);
    for (int q = 0; q < 8; ++q) {
        const int tl = wave * 8 + q;
        f32x4 acc = cb;
#pragma unroll 4
        for (int j = 0; j < 31; ++j) { const f32x4 h = *(const f32x4*)(hg + (tl + j) * 256 + c0); acc += h * *(const f32x4*)(wl + j * 256 + c0); }
        const float mean = wave_sum(acc.x + acc.y + acc.z + acc.w) * (1.f / 256.f);
        const f32x4 d = acc - mean;
        const float var = wave_sum(d.x * d.x + d.y * d.y + d.z * d.z + d.w * d.w) * (1.f / 256.f);
        const float rstd = rsqrtf(var + NORM_EPS);
        const f32x4 y = d * rstd * lw + lb;
        u32x2 o; o.x = pk2(siluf(y.x), siluf(y.y)); o.y = pk2(siluf(y.z), siluf(y.w));
        *(u32x2*)(CC + (size_t)(rb + t0 + tl) * D + c0) = o;
    }
    __syncthreads();
}

__device__ __forceinline__ float log2_gamma(const P& p, int L, int dir, int h) {
    const float x = p.in[12][(L * 2 + dir) * 4 + h];
    const float ls = fminf(x, 0.f) - log1pf(expf(-fabsf(x)));
    return ls * 1.4426950408889634f;
}
__device__ __forceinline__ void load_ret_qk(float* dst, const P& p, int gc, int h, int zoff, float scale) {
    const int tid = threadIdx.x, j = tid >> 2, i0 = (tid & 3) * 4, row = gc * 128 + j;
    const bf16_t* zr = (const bf16_t*)(p.ws + WS_Z) + (size_t)row * ZC + zoff + h * 32;
    const u32x2 a = *(const u32x2*)(zr + i0), b = *(const u32x2*)(zr + 16 + i0);
    float x1[4] = {lo16(a.x), hi16(a.x), lo16(a.y), hi16(a.y)}, x2[4] = {lo16(b.x), hi16(b.x), lo16(b.y), hi16(b.y)};
    const bool lat = row < NLAT; const int pos = row & (SEQ - 1);
    const float* ct = (const float*)(p.ws + WS_ROPE) + pos * 16 + i0; const float* st = ct + 2048 * 16;
#pragma unroll
    for (int i = 0; i < 4; ++i) {
        const float c = lat ? ct[i] : 1.f, s = lat ? st[i] : 0.f;
        dst[j * 33 + i0 + i] = (x1[i] * c - x2[i] * s) * scale;
        dst[j * 33 + 16 + i0 + i] = (x1[i] * s + x2[i] * c) * scale;
    }
}
__device__ __forceinline__ void load_ret_v(float* dst  , const P& p, int gc, int h) {
    const int tid = threadIdx.x, j = tid >> 2, e0 = (tid & 3) * 16;
    const bf16_t* zr = (const bf16_t*)(p.ws + WS_Z) + (size_t)(gc * 128 + j) * ZC + Z_RV + h * 64 + e0;
    const u32x4 a = *(const u32x4*)zr, b = *(const u32x4*)(zr + 8);
#pragma unroll
    for (int i = 0; i < 4; ++i) { dst[j * 64 + e0 + 2 * i] = lo16(a[i]); dst[j * 64 + e0 + 2 * i + 1] = hi16(a[i]); dst[j * 64 + e0 + 8 + 2 * i] = lo16(b[i]); dst[j * 64 + e0 + 8 + 2 * i + 1] = hi16(b[i]); }
}
__device__ __forceinline__ void retkv_unit(unsigned char* lds, const P& p, int L, int gc, int h) {
    float* ks = (float*)lds; float* vs = ks + 128 * 33; float* wf = vs + 128 * 64; float* wb = wf + 128;
    const int tid = threadIdx.x;
    const float l2f = log2_gamma(p, L, 0, h), l2b = log2_gamma(p, L, 1, h);
    load_ret_qk(ks, p, gc, h, Z_RK, 0.17677669529663687f);
    load_ret_v(vs, p, gc, h);
    if (tid < 128) { wf[tid] = exp2f(l2f * (float)(127 - tid)); wb[tid] = exp2f(l2b * (float)tid); }
    __syncthreads();
    const int d = tid >> 4, e0 = (tid & 15) * 4;
    f32x4 af = (f32x4){0.f, 0.f, 0.f, 0.f}, ab = af;
    for (int j = 0; j < 128; ++j) {
        const float kd = ks[j * 33 + d]; const f32x4 v4 = *(const f32x4*)(vs + j * 64 + e0);
        af += (kd * wf[j]) * v4; ab += (kd * wb[j]) * v4;
    }
    float* KV = (float*)(p.ws + WS_KV) + ((size_t)(gc * 4 + h) * 2) * 2048;
    *(f32x4*)(KV + d * 64 + e0) = af; *(f32x4*)(KV + 2048 + d * 64 + e0) = ab;
    __syncthreads();
}
__device__ __forceinline__ void ret_stage_k(unsigned char* kf, unsigned char* kb, int rowb, const P& p, int gc, int h, float ef, float jf0, float eb, float jb0) {
    const int tid = threadIdx.x, j = tid >> 2, i0 = (tid & 3) * 4, row = gc * 128 + j;
    const bf16_t* zr = (const bf16_t*)(p.ws + WS_Z) + (size_t)row * ZC + Z_RK + h * 32;
    const u32x2 a = *(const u32x2*)(zr + i0), b = *(const u32x2*)(zr + 16 + i0);
    const float x1[4] = {lo16(a.x), hi16(a.x), lo16(a.y), hi16(a.y)}, x2[4] = {lo16(b.x), hi16(b.x), lo16(b.y), hi16(b.y)};
    f32x4 c4 = (f32x4){1.f, 1.f, 1.f, 1.f}, s4 = (f32x4){0.f, 0.f, 0.f, 0.f};
    if (row < NLAT) { const int pos = row & (SEQ - 1); const float* ct = (const float*)(p.ws + WS_ROPE) + pos * 16 + i0; c4 = *(const f32x4*)ct; s4 = *(const f32x4*)(ct + 2048 * 16); }
    const float wf = exp2f(ef * ((float)j - jf0)) * 0.17677669529663687f, wb = exp2f(eb * ((float)j - jb0)) * 0.17677669529663687f;
    float o1[4], o2[4];
#pragma unroll
    for (int i = 0; i < 4; ++i) { o1[i] = x1[i] * c4[i] - x2[i] * s4[i]; o2[i] = x1[i] * s4[i] + x2[i] * c4[i]; }
    u32x2 w;
    w.x = cvtpk(o1[0] * wf, o1[1] * wf); w.y = cvtpk(o1[2] * wf, o1[3] * wf); *(u32x2*)(kf + j * rowb + i0 * 2) = w;
    w.x = cvtpk(o2[0] * wf, o2[1] * wf); w.y = cvtpk(o2[2] * wf, o2[3] * wf); *(u32x2*)(kf + j * rowb + 32 + i0 * 2) = w;
    w.x = cvtpk(o1[0] * wb, o1[1] * wb); w.y = cvtpk(o1[2] * wb, o1[3] * wb); *(u32x2*)(kb + j * rowb + i0 * 2) = w;
    w.x = cvtpk(o2[0] * wb, o2[1] * wb); w.y = cvtpk(o2[2] * wb, o2[3] * wb); *(u32x2*)(kb + j * rowb + 32 + i0 * 2) = w;
}
__device__ __forceinline__ void ret_stage_v(unsigned char* vt, const P& p, int gc, int h) {
    const int tid = threadIdx.x, j = tid >> 2, e0 = (tid & 3) * 16;
    const bf16_t* zr = (const bf16_t*)(p.ws + WS_Z) + (size_t)(gc * 128 + j) * ZC + Z_RV + h * 64 + e0;
    const u32x4 a = *(const u32x4*)zr, b = *(const u32x4*)(zr + 8);
    unsigned char* d = vt + (e0 >> 5) * 8192 + j * 64 + (e0 & 31) * 2;
    *(u32x4*)d = a; *(u32x4*)(d + 16) = b;
}
__device__ __forceinline__ bf16x8 tr8(const unsigned char* p0, const unsigned char* p1) {
    const v4i16_t a = __builtin_amdgcn_ds_read_tr16_b64_v4i16((LAS v4i16_t*)(const LAS unsigned char*)p0), b = __builtin_amdgcn_ds_read_tr16_b64_v4i16((LAS v4i16_t*)(const LAS unsigned char*)p1);
    return (bf16x8){a[0], a[1], a[2], a[3], b[0], b[1], b[2], b[3]};
}
__device__ __forceinline__ void retkv_unit_mfma(unsigned char* lds, const P& p, int L, int gc, int h) {
    const int tid = threadIdx.x, lane = tid & 63, wid = tid >> 6;
    const float l2f = log2_gamma(p, L, 0, h), l2b = log2_gamma(p, L, 1, h);
    ret_stage_k(lds, lds + 8192, 64, p, gc, h, -l2f, 127.f, l2b, 0.f);
    ret_stage_v(lds + 16384, p, gc, h);
    __syncthreads();
    if (wid < 4) {
        const int dir = wid >> 1, eb = wid & 1, g = lane >> 4, i = lane & 15, hh = lane >> 5;
        const int off = (8 * hh + (i >> 2)) * 64 + (g & 1) * 32 + (i & 3) * 8;
        const unsigned char* Kt = lds + dir * 8192 + off; const unsigned char* Vt = lds + 16384 + eb * 8192 + off;
        f32x16 acc;
#pragma unroll
        for (int r = 0; r < 16; ++r) acc[r] = 0.f;
#pragma unroll
        for (int s = 0; s < 8; ++s) acc = __builtin_amdgcn_mfma_f32_32x32x16_bf16(tr8(Vt + s * 1024, Vt + s * 1024 + 256), tr8(Kt + s * 1024, Kt + s * 1024 + 256), acc, 0, 0, 0);
        float* KV = (float*)(p.ws + WS_KV) + ((size_t)(gc * 4 + h) * 2 + dir) * 2048 + (lane & 31) * 64 + eb * 32 + 4 * hh;
#pragma unroll
        for (int r4 = 0; r4 < 4; ++r4) *(f32x4*)(KV + 8 * r4) = (f32x4){acc[4 * r4], acc[4 * r4 + 1], acc[4 * r4 + 2], acc[4 * r4 + 3]};
    }
    __syncthreads();
}
__device__ __forceinline__ void retout_unit_mfma(unsigned char* lds, const P& p, int L, int gc, int h) {
    constexpr int KROW = 80, O_KF = 0, O_KB = 10240, O_V = 20480, O_SF = 36864, O_SB = 41984, O_RED = 47104;
    const int tid = threadIdx.x, lane = tid & 63, wid = tid >> 6, r32 = lane & 31, hh = lane >> 5;
    const float l2f = log2_gamma(p, L, 0, h), l2b = log2_gamma(p, L, 1, h);
    ret_stage_k(lds + O_KF, lds + O_KB, KROW, p, gc, h, -l2f, 0.f, l2b, 0.f);
    ret_stage_v(lds + O_V, p, gc, h);
    {
        const bool lat = gc < 256; const int b = lat ? gc >> 4 : (gc - 256) >> 1;
        const int mme = lat ? 2 + (gc & 15) : (gc - 256) & 1;
        const int u = mme, w = mme < 2 ? 1 - mme : 19 - mme;
        f32x4 sf = (f32x4){0.f, 0.f, 0.f, 0.f}, sb = sf;
        const float* KVb = (const float*)(p.ws + WS_KV);
#pragma unroll 1
        for (int mm = 0; mm < 18; ++mm) {
            const int gcm = mm < 2 ? 256 + b * 2 + mm : b * 16 + (mm - 2);
            const int um = mm, wm = mm < 2 ? 1 - mm : 19 - mm;
            const float* kv = KVb + ((size_t)(gcm * 4 + h) * 2) * 2048 + tid * 4;
            if (um < u) { const float wgt = exp2f(l2f * 128.f * (float)(u - 1 - um)); sf += wgt * *(const f32x4*)kv; }
            if (wm < w) { const float wgt = exp2f(l2b * 128.f * (float)(w - 1 - wm)); sb += wgt * *(const f32x4*)(kv + 2048); }
        }
        const int d = tid >> 4, e0 = (tid & 15) * 4;
#pragma unroll
        for (int k = 0; k < 4; ++k) { *(bf16_t*)(lds + O_SF + (e0 + k) * KROW + d * 2) = (bf16_t)(cvtpk(sf[k], 0.f) & 0xffffu); *(bf16_t*)(lds + O_SB + (e0 + k) * KROW + d * 2) = (bf16_t)(cvtpk(sb[k], 0.f) & 0xffffu); }
    }
    __syncthreads();
    const int qb = wid & 3, eb = wid >> 2, i = qb * 32 + r32, row = gc * 128 + i;
    bf16x8 qf[2];
    {
        const bf16_t* zr = (const bf16_t*)(p.ws + WS_Z) + (size_t)row * ZC + Z_RQ + h * 32 + 8 * hh;
        const u32x4 a = *(const u32x4*)zr, b = *(const u32x4*)(zr + 16);
        float x1[8], x2[8];
#pragma unroll
        for (int k = 0; k < 4; ++k) { x1[2 * k] = lo16(a[k]); x1[2 * k + 1] = hi16(a[k]); x2[2 * k] = lo16(b[k]); x2[2 * k + 1] = hi16(b[k]); }
        if (row < NLAT) {
            const float* ct = (const float*)(p.ws + WS_ROPE) + (row & (SEQ - 1)) * 16 + 8 * hh; const float* st = ct + 2048 * 16;
#pragma unroll
            for (int k = 0; k < 8; ++k) { const float c = ct[k], sn = st[k], u1 = x1[k], u2 = x2[k]; x1[k] = u1 * c - u2 * sn; x2[k] = u1 * sn + u2 * c; }
        }
        const u32x4 q0 = (u32x4){cvtpk(x1[0], x1[1]), cvtpk(x1[2], x1[3]), cvtpk(x1[4], x1[5]), cvtpk(x1[6], x1[7])};
        const u32x4 q1 = (u32x4){cvtpk(x2[0], x2[1]), cvtpk(x2[2], x2[3]), cvtpk(x2[4], x2[5]), cvtpk(x2[6], x2[7])};
        qf[0] = __builtin_bit_cast(bf16x8, q0); qf[1] = __builtin_bit_cast(bf16x8, q1);
    }
    const float af = exp2f(l2f * (float)i), ab = exp2f(-l2b * (float)i), cf = exp2f(l2f * (float)(i + 1)), cb = exp2f(l2b * (float)(128 - i));
    f32x16 y, zero;
#pragma unroll
    for (int r = 0; r < 16; ++r) { y[r] = 0.f; zero[r] = 0.f; }
    const int koff = r32 * KROW + 16 * hh;
    const int voff = O_V + eb * 8192 + (4 * hh + ((lane & 15) >> 2)) * 64 + ((lane >> 4) & 1) * 32 + (lane & 3) * 8;
#pragma unroll
    for (int kb = 0; kb < 4; ++kb) {
        f32x16 pt;
        if (kb <= qb) {
            f32x16 sF = __builtin_amdgcn_mfma_f32_32x32x16_bf16(*(const bf16x8*)(lds + O_KF + kb * 32 * KROW + koff), qf[0], zero, 0, 0, 0);
            sF = __builtin_amdgcn_mfma_f32_32x32x16_bf16(*(const bf16x8*)(lds + O_KF + kb * 32 * KROW + koff + 32), qf[1], sF, 0, 0, 0);
            if (kb < qb) {
#pragma unroll
                for (int r = 0; r < 16; ++r) pt[r] = sF[r] * af;
            } else {
#pragma unroll
                for (int r = 0; r < 16; ++r) { const int j = (r & 3) + 8 * (r >> 2) + 4 * hh; pt[r] = (j <= r32) ? sF[r] * af : 0.f; }
            }
        }
        if (kb >= qb) {
            f32x16 sB = __builtin_amdgcn_mfma_f32_32x32x16_bf16(*(const bf16x8*)(lds + O_KB + kb * 32 * KROW + koff), qf[0], zero, 0, 0, 0);
            sB = __builtin_amdgcn_mfma_f32_32x32x16_bf16(*(const bf16x8*)(lds + O_KB + kb * 32 * KROW + koff + 32), qf[1], sB, 0, 0, 0);
            if (kb > qb) {
#pragma unroll
                for (int r = 0; r < 16; ++r) pt[r] = sB[r] * ab;
            } else {
#pragma unroll
                for (int r = 0; r < 16; ++r) { const int j = (r & 3) + 8 * (r >> 2) + 4 * hh; pt[r] += (j >= r32) ? sB[r] * ab : 0.f; }
            }
        }
#pragma unroll
        for (int s2 = 0; s2 < 2; ++s2) {
            const u32x4 pw = (u32x4){cvtpk(pt[8 * s2], pt[8 * s2 + 1]), cvtpk(pt[8 * s2 + 2], pt[8 * s2 + 3]), cvtpk(pt[8 * s2 + 4], pt[8 * s2 + 5]), cvtpk(pt[8 * s2 + 6], pt[8 * s2 + 7])};
            const unsigned char* vb = lds + voff + (kb * 32 + s2 * 16) * 64;
            y = __builtin_amdgcn_mfma_f32_32x32x16_bf16(tr8(vb, vb + 8 * 64), __builtin_bit_cast(bf16x8, pw), y, 0, 0, 0);
        }
    }
    {
        const int soff = (eb * 32 + r32) * KROW + 16 * hh;
        f32x16 tF = __builtin_amdgcn_mfma_f32_32x32x16_bf16(*(const bf16x8*)(lds + O_SF + soff), qf[0], zero, 0, 0, 0);
        tF = __builtin_amdgcn_mfma_f32_32x32x16_bf16(*(const bf16x8*)(lds + O_SF + soff + 32), qf[1], tF, 0, 0, 0);
        f32x16 tB = __builtin_amdgcn_mfma_f32_32x32x16_bf16(*(const bf16x8*)(lds + O_SB + soff), qf[0], zero, 0, 0, 0);
        tB = __builtin_amdgcn_mfma_f32_32x32x16_bf16(*(const bf16x8*)(lds + O_SB + soff + 32), qf[1], tB, 0, 0, 0);
#pragma unroll
        for (int r = 0; r < 16; ++r) y[r] += tF[r] * cf + tB[r] * cb;
    }
    float s1 = 0.f, s2 = 0.f;
#pragma unroll
    for (int r = 0; r < 16; ++r) { s1 += y[r]; s2 += y[r] * y[r]; }
    s1 += __shfl_xor(s1, 32); s2 += __shfl_xor(s2, 32);
    float* red = (float*)(lds + O_RED);
    if (hh == 0) { red[(eb * 128 + i) * 2] = s1; red[(eb * 128 + i) * 2 + 1] = s2; }
    __syncthreads();
    s1 = red[i * 2] + red[(128 + i) * 2]; s2 = red[i * 2 + 1] + red[(128 + i) * 2 + 1];
    const float mu = s1 * (1.f / 64.f), var = fmaxf(s2 * (1.f / 64.f) - mu * mu, 0.f), rstd = rsqrtf(var + NORM_EPS);
    const bf16_t* zg = (const bf16_t*)(p.ws + WS_Z) + (size_t)row * ZC + Z_RG + h * 64 + eb * 32 + 4 * hh;
    const float* gw = p.in[13] + L * 256 + h * 64 + eb * 32 + 4 * hh;
    bf16_t* orow = (bf16_t*)(p.ws + WS_CC) + (size_t)row * D + 256 + h * 64 + eb * 32 + 4 * hh;
#pragma unroll
    for (int r4 = 0; r4 < 4; ++r4) {
        const u32x2 gz = *(const u32x2*)(zg + 8 * r4); const f32x4 w4 = *(const f32x4*)(gw + 8 * r4);
        const float g0 = lo16(gz.x), g1 = hi16(gz.x), g2 = lo16(gz.y), g3 = hi16(gz.y);
        u32x2 o; o.x = cvtpk(siluf(g0) * ((y[4 * r4] - mu) * rstd * w4.x), siluf(g1) * ((y[4 * r4 + 1] - mu) * rstd * w4.y));
        o.y = cvtpk(siluf(g2) * ((y[4 * r4 + 2] - mu) * rstd * w4.z), siluf(g3) * ((y[4 * r4 + 3] - mu) * rstd * w4.w));
        *(u32x2*)(orow + 8 * r4) = o;
    }
    __syncthreads();
}
__device__ __forceinline__ void qkv_proj(unsigned char* lds, const P& p, int L) {
    const float* sskv = (const float*)(p.ws + WS_SS) + (size_t)NTOK * 4;
    const int G = gridDim.x, bid = blockIdx.x;
    {
        bf16_t* Q = (bf16_t*)(p.ws + WS_Q);
        ge::DenseOrder S; S.nM = NTOK / 256; S.nN = 3; S.nwg = S.nM * 3; S.G = G; S.c = bid; S.Bt = (const char*)((const bf16_t*)(p.ws + WS_WUQ) + (size_t)L * 768 * 256); S.btile = (size_t)256 * 256 * 2; S.arow = ZC * 2;
        auto f = [&](const ge::Unit& u, int r, int c, f32x4 v0, f32x4 v1) {
            u32x4 w; w.x = cvtpk(v0.x, v0.y); w.y = cvtpk(v0.z, v0.w); w.z = cvtpk(v1.x, v1.y); w.w = cvtpk(v1.z, v1.w); *(u32x4*)(Q + (size_t)(u.a * 256 + r) * 768 + u.b * 256 + c) = w;
        };
        ge::EpiFn<decltype(f)> E{f};
        ge::gemm_stream<ge::DenseOrder, ge::EpiFn<decltype(f)>, true>((LAS unsigned char*)lds, (const char*)(p.ws + WS_Z) + Z_CQ * 2, 256, S, E);
    }
    {
        bf16_t* Kb = (bf16_t*)(p.ws + WS_K); bf16_t* Vb = (bf16_t*)(p.ws + WS_V);
        ge::DenseOrder S; S.nM = NTOK / 256; S.nN = 4; S.nwg = S.nM * 4; S.G = G; S.c = (bid + 176) % G; S.Bt = (const char*)((const bf16_t*)(p.ws + WS_WUKV) + (size_t)L * 1024 * 256); S.btile = (size_t)256 * 256 * 2; S.arow = ZC * 2;
        struct EpiKV {
            bf16_t* Kb; bf16_t* Vb; const float* sskv;
            __device__ __forceinline__ void operator()(const ge::Acc& acc, const ge::Unit& u, int wr, int wc, int fr, int fq) const {
                float rstd[2][4];
#pragma unroll
                for (int ai = 0; ai < 2; ++ai)
#pragma unroll
                    for (int m = 0; m < 4; ++m) { const f32x4 s4 = *(const f32x4*)(sskv + (size_t)(u.a * 256 + ai * 128 + wr * 64 + m * 16 + fr) * 4); rstd[ai][m] = rsqrtf((s4.x + s4.y + s4.z + s4.w) * (1.f / 128.f) + NORM_EPS); }
#pragma unroll
                for (int ai = 0; ai < 2; ++ai)
#pragma unroll
                    for (int m = 0; m < 4; ++m) {
                        const int row = u.a * 256 + ai * 128 + wr * 64 + m * 16 + fr;
#pragma unroll
                        for (int bj = 0; bj < 2; ++bj) {
                            const int col = u.b * 256 + bj * 128 + wc * 32 + 8 * fq, h = col >> 7, j = col & 127;
                            const f32x4 v0 = acc[ai][bj][m][0] * rstd[ai][m], v1 = acc[ai][bj][m][1] * rstd[ai][m];
                            u32x4 w; w.x = cvtpk(v0.x, v0.y); w.y = cvtpk(v0.z, v0.w); w.z = cvtpk(v1.x, v1.y); w.w = cvtpk(v1.z, v1.w);
                            if (j < 64) *(u32x4*)(Kb + (size_t)row * 768 + h * 96 + j) = w;
                            else *(u32x4*)(Vb + (size_t)row * 512 + h * 64 + (j - 64)) = w;
                        }
                    }
            }
        };
        EpiKV E{Kb, Vb, sskv};
        ge::gemm_stream<ge::DenseOrder, EpiKV, true>((LAS unsigned char*)lds, (const char*)(p.ws + WS_Z) + Z_CKV * 2, 256, S, E);
    }
}
__device__ __forceinline__ void phase_b(unsigned char* lds, const P& p, int L) {
    const int G = gridDim.x, bid = blockIdx.x;
    qkv_proj(lds, p, L);
    const int nconv = (L == 0) ? 576 : 512;
    const int nkv = 288 * 4;
    const int total = nconv + nkv;
    for (int u = (bid + 96) % G; u < total; u += G) {
        int r = u;
        if (r < nconv) { if (r < 512) conv_unit(lds, p, L, r >> 5, r & 31); else conv_unit(lds, p, L, 16 + ((r - 512) >> 2), (r - 512) & 3); continue; } r -= nconv;
        retkv_unit_mfma(lds, p, L, r >> 2, r & 3);
    }
    if (L == 1) convert_expert_weights(lds, p, 1);
}

__device__ __forceinline__ void attn_unit_naive(unsigned char* lds, const P& p, int b, int h, int qb, bool ctxq) {
    float* Ks = (float*)lds;
    float* Vs = Ks + 64 * 96;
    const int tid = threadIdx.x, half = tid & 1, qi = tid >> 1;
    const bf16_t* Qb = (const bf16_t*)(p.ws + WS_Q); const bf16_t* Kb = (const bf16_t*)(p.ws + WS_K); const bf16_t* Vb = (const bf16_t*)(p.ws + WS_V);
    const int qrow = ctxq ? NLAT + b * CTXL + qi : b * SEQ + qb * 256 + qi;
    float q[48];
    {
        const u32x4* qp = (const u32x4*)(Qb + (size_t)qrow * 768 + h * 96 + half * 48);
#pragma unroll
        for (int i = 0; i < 6; ++i) { const u32x4 w = qp[i];
#pragma unroll
            for (int k = 0; k < 4; ++k) { q[i * 8 + 2 * k] = lo16(w[k]); q[i * 8 + 2 * k + 1] = hi16(w[k]); } }
    }
    float o[32];
#pragma unroll
    for (int e = 0; e < 32; ++e) o[e] = 0.f;
    float m = -1e30f, l = 0.f;
    const int ntiles = ctxq ? 4 : 36;
#pragma unroll 1
    for (int t = 0; t < ntiles; ++t) {
        const int krow0 = t < 4 ? NLAT + b * CTXL + t * 64 : b * SEQ + (t - 4) * 64;
        __syncthreads();
        for (int i = tid; i < 64 * 12; i += NTHREADS) { const int key = i / 12, c = i % 12; const u32x4 w = *(const u32x4*)(Kb + (size_t)(krow0 + key) * 768 + h * 96 + c * 8);
            float* d = Ks + key * 96 + c * 8;
#pragma unroll
            for (int k = 0; k < 4; ++k) { d[2 * k] = lo16(w[k]); d[2 * k + 1] = hi16(w[k]); } }
        for (int i = tid; i < 64 * 8; i += NTHREADS) { const int key = i >> 3, c = i & 7; const u32x4 w = *(const u32x4*)(Vb + (size_t)(krow0 + key) * 512 + h * 64 + c * 8);
            float* d = Vs + key * 64 + c * 8;
#pragma unroll
            for (int k = 0; k < 4; ++k) { d[2 * k] = lo16(w[k]); d[2 * k + 1] = hi16(w[k]); } }
        __syncthreads();
#pragma unroll 1
        for (int j0 = 0; j0 < 64; j0 += 2) {
            float s[2]; float mt = -1e30f;
#pragma unroll
            for (int jj = 0; jj < 2; ++jj) {
                const f32x4* kr = (const f32x4*)(Ks + (j0 + jj) * 96 + half * 48);
                float a = 0.f;
#pragma unroll
                for (int d4 = 0; d4 < 12; ++d4) { const f32x4 kv = kr[d4]; a += q[4 * d4] * kv.x + q[4 * d4 + 1] * kv.y + q[4 * d4 + 2] * kv.z + q[4 * d4 + 3] * kv.w; }
                a += __shfl_xor(a, 1);
                s[jj] = a; mt = fmaxf(mt, a);
            }
            const float mn = fmaxf(m, mt), alpha = exp2f(m - mn);
            m = mn; l *= alpha;
#pragma unroll
            for (int e = 0; e < 32; ++e) o[e] *= alpha;
#pragma unroll
            for (int jj = 0; jj < 2; ++jj) {
                const float pj = exp2f(s[jj] - mn); l += pj;
                const f32x4* vr = (const f32x4*)(Vs + (j0 + jj) * 64 + half * 32);
#pragma unroll
                for (int e4 = 0; e4 < 8; ++e4) { const f32x4 vv = vr[e4]; o[4 * e4] += pj * vv.x; o[4 * e4 + 1] += pj * vv.y; o[4 * e4 + 2] += pj * vv.z; o[4 * e4 + 3] += pj * vv.w; }
            }
        }
    }
    {
        const float rl = 1.f / l;
        u32x4* op = (u32x4*)((bf16_t*)(p.ws + WS_CC) + (size_t)qrow * D + 512 + h * 64 + half * 32);
#pragma unroll
        for (int i = 0; i < 4; ++i) { u32x4 w; w.x = pk2(o[8 * i] * rl, o[8 * i + 1] * rl); w.y = pk2(o[8 * i + 2] * rl, o[8 * i + 3] * rl); w.z = pk2(o[8 * i + 4] * rl, o[8 * i + 5] * rl); w.w = pk2(o[8 * i + 6] * rl, o[8 * i + 7] * rl); op[i] = w; }
    }
    __syncthreads();
}
__device__ __forceinline__ float max3f(float a, float b, float c) { float r; asm("v_max3_f32 %0, %1, %2, %3" : "=v"(r) : "v"(a), "v"(b), "v"(c)); return r; }
constexpr int AT_KROW = 208;
constexpr int AT_KBUF = 64 * AT_KROW;
constexpr int AT_VBUF = 8192;
constexpr int AT_BUF = AT_KBUF + AT_VBUF;
__device__ __forceinline__ void attn_unit_mfma(unsigned char* lds, const P& p, int b, int h, int qb, bool ctxq) {
    const int tid = threadIdx.x, lane = tid & 63, wid = tid >> 6, r32 = lane & 31, hh = lane >> 5;
    const bf16_t* Qb = (const bf16_t*)(p.ws + WS_Q); const bf16_t* Kb = (const bf16_t*)(p.ws + WS_K); const bf16_t* Vb = (const bf16_t*)(p.ws + WS_V);
    const int qrow = (ctxq ? NLAT + b * CTXL : b * SEQ + qb * 256) + wid * 32 + r32;
    bf16x8 qf[6];
    {
        const f32x4 s4 = *(const f32x4*)((const float*)(p.ws + WS_SS) + (size_t)qrow * 4);
        const float rstd = rsqrtf((s4.x + s4.y + s4.z + s4.w) * (1.f / 256.f) + NORM_EPS);
        const float* ct = (const float*)(p.ws + WS_ROPE) + (qrow & (SEQ - 1)) * 16; const float* st = ct + 2048 * 16;
#pragma unroll
        for (int s = 0; s < 6; ++s) {
            const u32x4 w = *(const u32x4*)(Qb + (size_t)qrow * 768 + h * 96 + 16 * s + 8 * hh);
            float x[8];
#pragma unroll
            for (int k = 0; k < 4; ++k) { x[2 * k] = lo16(w[k]) * rstd; x[2 * k + 1] = hi16(w[k]) * rstd; }
            if (s >= 4 && !ctxq) {
                const f32x4 c4 = *(const f32x4*)(ct + 8 * (s - 4) + 4 * hh), sn = *(const f32x4*)(st + 8 * (s - 4) + 4 * hh);
#pragma unroll
                for (int k = 0; k < 4; ++k) { const float a = x[2 * k], b2 = x[2 * k + 1]; x[2 * k] = a * c4[k] - b2 * sn[k]; x[2 * k + 1] = a * sn[k] + b2 * c4[k]; }
            }
            const u32x4 o = (u32x4){cvtpk(x[0], x[1]), cvtpk(x[2], x[3]), cvtpk(x[4], x[5]), cvtpk(x[6], x[7])};
            qf[s] = __builtin_bit_cast(bf16x8, o);
        }
    }
    f32x16 o0, o1, negm;
#pragma unroll
    for (int r = 0; r < 16; ++r) { o0[r] = 0.f; o1[r] = 0.f; negm[r] = 0.f; }
    asm volatile("" : "+v"(negm));
    float mhat = 0.f, l = 0.f;
    const int ntiles = ctxq ? 4 : 36;
    const int wv = __builtin_amdgcn_readfirstlane(wid);
    const int ia = wv, ib = (wv + 8 < 13) ? wv + 8 : 12;
    const int qa = ia * 64 + lane, qb2 = ib * 64 + lane, qv = wv * 64 + lane;
    const int ca = qa % 13, cb = qb2 % 13;
    const size_t ka = (size_t)(qa / 13) * 768 + h * 96 + (ca < 12 ? ca : 11) * 8, kbo = (size_t)(qb2 / 13) * 768 + h * 96 + (cb < 12 ? cb : 11) * 8;
    const size_t vo = (size_t)((qv >> 2) & 63) * 512 + h * 64 + (qv >> 8) * 32 + (qv & 3) * 8;
    auto krow0 = [&](int t) { return t < 4 ? NLAT + b * CTXL + t * 64 : b * SEQ + (t - 4) * 64; };
    const unsigned lds0 = (unsigned)(uintptr_t)lds;
#define AT_GLDS(gp, ldsoff) do { unsigned keep_; asm volatile("s_mov_b32 %0, m0\n\ts_mov_b32 m0, %2\n\ts_nop 0\n\tglobal_load_lds_dwordx4 %1, off\n\ts_mov_b32 m0, %0" : "=&s"(keep_) : "v"(gp), "s"((unsigned)__builtin_amdgcn_readfirstlane(lds0 + (unsigned)(ldsoff))) : "memory"); } while (0)
#define AT_ISSUE(t2, slot) do { const int kr_ = krow0(t2); const bf16_t* kb_ = Kb + (size_t)kr_ * 768; const bf16_t* vb_ = Vb + (size_t)kr_ * 512; \
        AT_GLDS(kb_ + ka, (slot) + ia * 1024); AT_GLDS(kb_ + kbo, (slot) + ib * 1024); AT_GLDS(vb_ + vo, (slot) + AT_KBUF + wv * 1024); } while (0)
    __builtin_amdgcn_s_barrier();
    AT_ISSUE(0, 0);
    if (ntiles > 1) AT_ISSUE(1, AT_BUF);
    const int koff = r32 * AT_KROW + 16 * hh;
    const int voff = AT_KBUF + (4 * hh + ((lane & 15) >> 2)) * 64 + ((lane >> 4) & 1) * 32 + (lane & 3) * 8;
    int slot_c = 0, slot_n = 2 * AT_BUF;
#pragma unroll 1
    for (int t = 0; t < ntiles; ++t) {
        if (t + 1 < ntiles) asm volatile("s_waitcnt vmcnt(3)" ::: "memory"); else asm volatile("s_waitcnt vmcnt(0)" ::: "memory");
        __builtin_amdgcn_s_barrier();
        asm volatile("" ::: "memory");
        if (t + 2 < ntiles) AT_ISSUE(t + 2, slot_n);
        unsigned char* buf = lds + slot_c;
        slot_n = slot_c; slot_c = (slot_c == 2 * AT_BUF) ? 0 : slot_c + AT_BUF;
        f32x16 p0, p1;
        __builtin_amdgcn_s_setprio(1);
        {
            const bf16x8 k0f = *(const bf16x8*)(buf + koff), k1f = *(const bf16x8*)(buf + koff + 32 * AT_KROW);
            p0 = __builtin_amdgcn_mfma_f32_32x32x16_bf16(k0f, qf[0], negm, 0, 0, 0);
            p1 = __builtin_amdgcn_mfma_f32_32x32x16_bf16(k1f, qf[0], negm, 0, 0, 0);
        }
#pragma unroll
        for (int s = 1; s < 6; ++s) {
            const bf16x8 k0f = *(const bf16x8*)(buf + koff + 32 * s), k1f = *(const bf16x8*)(buf + koff + 32 * AT_KROW + 32 * s);
            p0 = __builtin_amdgcn_mfma_f32_32x32x16_bf16(k0f, qf[s], p0, 0, 0, 0);
            p1 = __builtin_amdgcn_mfma_f32_32x32x16_bf16(k1f, qf[s], p1, 0, 0, 0);
        }
        __builtin_amdgcn_s_setprio(0);
        asm volatile("s_nop 15\n\ts_nop 7" : "+v"(p0), "+v"(p1));
        float rma = max3f(p0[0], p0[1], p1[0]), rmb = max3f(p0[2], p0[3], p1[1]);
        rma = max3f(rma, p1[2], p1[3]);
#pragma unroll
        for (int r = 4; r < 16; r += 4) { rma = max3f(rma, p0[r], p0[r + 1]); rmb = max3f(rmb, p0[r + 2], p0[r + 3]); rma = max3f(rma, p1[r], p1[r + 1]); rmb = max3f(rmb, p1[r + 2], p1[r + 3]); }
        float rm = fmaxf(rma, rmb);
        rm = fmaxf(rm, __shfl_xor(rm, 32));
        if (__any(rm > 8.f)) {
            const float dl = fmaxf(rm, 0.f), f = __builtin_amdgcn_exp2f(-dl);
            mhat += dl; l *= f;
#pragma unroll
            for (int r = 0; r < 16; ++r) { p0[r] -= dl; p1[r] -= dl; o0[r] *= f; o1[r] *= f; negm[r] = -mhat; }
            asm volatile("" : "+v"(negm));
        }
        float ls = 0.f;
#pragma unroll
        for (int r = 0; r < 16; ++r) { p0[r] = __builtin_amdgcn_exp2f(p0[r]); p1[r] = __builtin_amdgcn_exp2f(p1[r]); ls += p0[r] + p1[r]; }
        l += ls;
        u32x4 pw[4];
#pragma unroll
        for (int s2 = 0; s2 < 2; ++s2) {
            pw[s2] = (u32x4){cvtpk(p0[8 * s2], p0[8 * s2 + 1]), cvtpk(p0[8 * s2 + 2], p0[8 * s2 + 3]), cvtpk(p0[8 * s2 + 4], p0[8 * s2 + 5]), cvtpk(p0[8 * s2 + 6], p0[8 * s2 + 7])};
            pw[2 + s2] = (u32x4){cvtpk(p1[8 * s2], p1[8 * s2 + 1]), cvtpk(p1[8 * s2 + 2], p1[8 * s2 + 3]), cvtpk(p1[8 * s2 + 4], p1[8 * s2 + 5]), cvtpk(p1[8 * s2 + 6], p1[8 * s2 + 7])};
        }
        __builtin_amdgcn_s_setprio(1);
#pragma unroll
        for (int ks = 0; ks < 4; ++ks) {
            const unsigned char* vb = buf + voff + ks * 16 * 64;
            const bf16x8 pf = __builtin_bit_cast(bf16x8, pw[ks]);
            o0 = __builtin_amdgcn_mfma_f32_32x32x16_bf16(tr8(vb, vb + 8 * 64), pf, o0, 0, 0, 0);
            o1 = __builtin_amdgcn_mfma_f32_32x32x16_bf16(tr8(vb + 4096, vb + 4096 + 8 * 64), pf, o1, 0, 0, 0);
        }
        __builtin_amdgcn_s_setprio(0);
    }
#undef AT_GLDS
#undef AT_ISSUE
    l += __shfl_xor(l, 32);
    const float rl = 1.f / l;
    bf16_t* orow = (bf16_t*)(p.ws + WS_CC) + (size_t)qrow * D + 512 + h * 64 + 4 * hh;
#pragma unroll
    for (int r4 = 0; r4 < 4; ++r4) {
        u32x2 w0; w0.x = cvtpk(o0[4 * r4] * rl, o0[4 * r4 + 1] * rl); w0.y = cvtpk(o0[4 * r4 + 2] * rl, o0[4 * r4 + 3] * rl);
        u32x2 w1; w1.x = cvtpk(o1[4 * r4] * rl, o1[4 * r4 + 1] * rl); w1.y = cvtpk(o1[4 * r4 + 2] * rl, o1[4 * r4 + 3] * rl);
        *(u32x2*)(orow + 8 * r4) = w0; *(u32x2*)(orow + 32 + 8 * r4) = w1;
    }
}
__device__ __forceinline__ void retout_unit(unsigned char* lds, const P& p, int L, int gc, int h) {
    float* qs = (float*)lds; float* ks = qs + 128 * 33; float* vs = ks + 128 * 33; float* Sf = vs + 128 * 64; float* Sb = Sf + 2048;
    const int tid = threadIdx.x;
    const float l2f = log2_gamma(p, L, 0, h), l2b = log2_gamma(p, L, 1, h);
    load_ret_qk(qs, p, gc, h, Z_RQ, 1.f);
    load_ret_qk(ks, p, gc, h, Z_RK, 0.17677669529663687f);
    load_ret_v(vs, p, gc, h);
    {
        const bool lat = gc < 256; const int b = lat ? gc >> 4 : (gc - 256) >> 1;
        const int mme = lat ? 2 + (gc & 15) : (gc - 256) & 1;
        const int u = mme, w = mme < 2 ? 1 - mme : 19 - mme;
        f32x4 sf = (f32x4){0.f, 0.f, 0.f, 0.f}, sb = sf;
        const float* KVb = (const float*)(p.ws + WS_KV);
#pragma unroll 1
        for (int mm = 0; mm < 18; ++mm) {
            const int gcm = mm < 2 ? 256 + b * 2 + mm : b * 16 + (mm - 2);
            const int um = mm, wm = mm < 2 ? 1 - mm : 19 - mm;
            const float* kv = KVb + ((size_t)(gcm * 4 + h) * 2) * 2048 + tid * 4;
            if (um < u) { const float wgt = exp2f(l2f * 128.f * (float)(u - 1 - um)); sf += wgt * *(const f32x4*)kv; }
            if (wm < w) { const float wgt = exp2f(l2b * 128.f * (float)(w - 1 - wm)); sb += wgt * *(const f32x4*)(kv + 2048); }
        }
        *(f32x4*)(Sf + tid * 4) = sf; *(f32x4*)(Sb + tid * 4) = sb;
    }
    __syncthreads();
    const int i = tid >> 2, e0 = (tid & 3) * 16;
    float q[32];
#pragma unroll
    for (int d = 0; d < 32; ++d) q[d] = qs[i * 33 + d];
    float acc[16];
#pragma unroll
    for (int e = 0; e < 16; ++e) acc[e] = 0.f;
#pragma unroll 1
    for (int j = 0; j < 128; ++j) {
        float s = 0.f;
#pragma unroll
        for (int d = 0; d < 32; ++d) s += q[d] * ks[j * 33 + d];
        float wgt = 0.f;
        if (j <= i) wgt += exp2f(l2f * (float)(i - j));
        if (j >= i) wgt += exp2f(l2b * (float)(j - i));
        s *= wgt;
#pragma unroll
        for (int e4 = 0; e4 < 4; ++e4) { const f32x4 v4 = *(const f32x4*)(vs + j * 64 + e0 + 4 * e4); acc[4 * e4] += s * v4.x; acc[4 * e4 + 1] += s * v4.y; acc[4 * e4 + 2] += s * v4.z; acc[4 * e4 + 3] += s * v4.w; }
    }
    {
        const float cf = exp2f(l2f * (float)(i + 1)), cb = exp2f(l2b * (float)(128 - i));
#pragma unroll 2
        for (int d = 0; d < 32; ++d) {
            const float qd = qs[i * 33 + d]; const float qf = qd * cf, qb = qd * cb;
#pragma unroll
            for (int e4 = 0; e4 < 4; ++e4) { const f32x4 a = *(const f32x4*)(Sf + d * 64 + e0 + 4 * e4), bq = *(const f32x4*)(Sb + d * 64 + e0 + 4 * e4);
                acc[4 * e4] += qf * a.x + qb * bq.x; acc[4 * e4 + 1] += qf * a.y + qb * bq.y; acc[4 * e4 + 2] += qf * a.z + qb * bq.z; acc[4 * e4 + 3] += qf * a.w + qb * bq.w; }
        }
    }
    float s1 = 0.f;
#pragma unroll
    for (int e = 0; e < 16; ++e) s1 += acc[e];
    s1 += __shfl_xor(s1, 1); s1 += __shfl_xor(s1, 2);
    const float mu = s1 * (1.f / 64.f);
    float s2 = 0.f;
#pragma unroll
    for (int e = 0; e < 16; ++e) { const float dd = acc[e] - mu; s2 += dd * dd; }
    s2 += __shfl_xor(s2, 1); s2 += __shfl_xor(s2, 2);
    const float rstd = rsqrtf(s2 * (1.f / 64.f) + NORM_EPS);
    const int row = gc * 128 + i;
    const bf16_t* zg = (const bf16_t*)(p.ws + WS_Z) + (size_t)row * ZC + Z_RG + h * 64 + e0;
    const float* gw = p.in[13] + L * 256 + h * 64 + e0;
    const u32x4 g0 = *(const u32x4*)zg, g1 = *(const u32x4*)(zg + 8);
    float g[16];
#pragma unroll
    for (int k = 0; k < 4; ++k) { g[2 * k] = lo16(g0[k]); g[2 * k + 1] = hi16(g0[k]); g[8 + 2 * k] = lo16(g1[k]); g[8 + 2 * k + 1] = hi16(g1[k]); }
    unsigned o[8];
#pragma unroll
    for (int k = 0; k < 8; ++k) {
        const float y0 = siluf(g[2 * k]) * ((acc[2 * k] - mu) * rstd * gw[2 * k]), y1 = siluf(g[2 * k + 1]) * ((acc[2 * k + 1] - mu) * rstd * gw[2 * k + 1]);
        o[k] = pk2(y0, y1);
    }
    u32x4* op = (u32x4*)((bf16_t*)(p.ws + WS_CC) + (size_t)row * D + 256 + h * 64 + e0);
    u32x4 w0; w0.x = o[0]; w0.y = o[1]; w0.z = o[2]; w0.w = o[3]; u32x4 w1; w1.x = o[4]; w1.y = o[5]; w1.z = o[6]; w1.w = o[7];
    op[0] = w0; op[1] = w1;
    __syncthreads();
}
__device__ __forceinline__ void phase_c(unsigned char* lds, const P& p, int L) {
    const int G = gridDim.x, bid = blockIdx.x;
    const int nat = 16 * 8 * 8, nac = (L == 0) ? 128 : 0, nro = (L == 0 ? 288 : 256) * 4;
    const int total = nat + nac + nro;
    for (int u = bid; u < total; u += G) {
        int r = u;
#ifndef TEST_C
#define TEST_C 3
#endif
        if (r < nat) { if (TEST_C & 1) attn_unit_mfma(lds, p, r >> 6, (r >> 3) & 7, r & 7, false); continue; } r -= nat;
        if (r < nac) { if (TEST_C & 1) attn_unit_mfma(lds, p, r >> 3, r & 7, 0, true); continue; } r -= nac;
        if (TEST_C & 2) retout_unit_mfma(lds, p, L, r >> 2, r & 3);
    }
    if (L == 0) convert_expert_weights(lds, p, 0);
}

struct EpiY {
    bf16_t* Y; const float* g1;
    __device__ __forceinline__ void operator()(const ge::Acc& acc, const ge::Unit& u, int wr, int wc, int fr, int fq) const {
        const float* gr = g1 + (size_t)mod_row(u.a * 256) * 6144 + u.b * 256 + wc * 32 + 8 * fq;
        f32x4 g[2][2];
#pragma unroll
        for (int bj = 0; bj < 2; ++bj)
#pragma unroll
            for (int n = 0; n < 2; ++n) g[bj][n] = *(const f32x4*)(gr + bj * 128 + n * 4);
#pragma unroll
        for (int ai = 0; ai < 2; ++ai)
#pragma unroll
            for (int m = 0; m < 4; ++m) {
                bf16_t* yr = Y + (size_t)(u.a * 256 + ai * 128 + wr * 64 + m * 16 + fr) * D + u.b * 256 + wc * 32 + 8 * fq;
#pragma unroll
                for (int bj = 0; bj < 2; ++bj) { const f32x4 v0 = acc[ai][bj][m][0] * g[bj][0], v1 = acc[ai][bj][m][1] * g[bj][1];
                    u32x4 w; w.x = cvtpk(v0.x, v0.y); w.y = cvtpk(v0.z, v0.w); w.z = cvtpk(v1.x, v1.y); w.w = cvtpk(v1.z, v1.w); *(u32x4*)(yr + bj * 128) = w; }
            }
    }
};
__device__ __forceinline__ void phase_d(unsigned char* lds, const P& p, int L) {
    ge::DenseOrder S; S.nM = (L == 0 ? NTOK : NLAT) / 256; S.nN = 4; S.nwg = S.nM * 4; S.G = gridDim.x; S.c = blockIdx.x;
    S.Bt = (const char*)((const bf16_t*)(p.ws + WS_WOUT) + (size_t)L * D * D); S.btile = (size_t)256 * D * 2; S.arow = D * 2;
    EpiY E{(bf16_t*)(p.ws + WS_Y), (const float*)(p.ws + WS_MODV) + (size_t)L * 17 * 6144 + 2048};
    ge::gemm_stream<ge::DenseOrder, EpiY, true>((LAS unsigned char*)lds, (const char*)(p.ws + WS_CC), D, S, E);
}

__device__ __forceinline__ void norm_mod_store(const P& p, int L, int which, int tok, int lane, const f32x4 (&v)[4], bf16_t* Hdst) {
    const float* nw = (which == 0 ? p.in[6] : p.in[19]) + L * D;
    const float* mrow = (const float*)(p.ws + WS_MODV) + ((size_t)L * 17 + mod_row(tok)) * 6144 + which * 3072;
    float s = 0.f;
#pragma unroll
    for (int j = 0; j < 4; ++j) s += v[j].x * v[j].x + v[j].y * v[j].y + v[j].z * v[j].z + v[j].w * v[j].w;
    const float rstd = rsqrtf(wave_sum(s) * (1.f / D) + NORM_EPS);
    u32x2* o = (u32x2*)(Hdst + (size_t)tok * D) + lane;
#pragma unroll
    for (int j = 0; j < 4; ++j) {
        const int k = 4 * lane + 256 * j;
        const f32x4 w4 = *(const f32x4*)(nw + k), sh = *(const f32x4*)(mrow + k), sc = *(const f32x4*)(mrow + 1024 + k);
        const f32x4 y = v[j] * rstd * w4 * (sc + 1.f) + sh;
        u32x2 w; w.x = cvtpk(y.x, y.y); w.y = cvtpk(y.z, y.w); o[64 * j] = w;
    }
}
__device__ __forceinline__ int half_n(int L) { return L == 0 ? NTOK / 2 : NLAT / 2; }
__device__ __forceinline__ void phase_router(unsigned char* lds, const P& p, int L) {
    constexpr int O_LG = 41472, O_CNT = 83072, O_SEL = 83584, O_SELW = 87424;
    const bf16_t* H = (const bf16_t*)(p.ws + WS_H); const bf16_t* W = (const bf16_t*)(p.ws + WS_RT) + (size_t)L * 128 * D;
    const bf16_t* Y = (const bf16_t*)(p.ws + WS_Y);
    float* lg = (float*)(lds + O_LG);
    int* lcnt = (int*)(lds + O_CNT);
    int* sel = (int*)(lds + O_SEL);
    float* selw = (float*)(lds + O_SELW);
    int* ltok = (int*)(p.ws + WS_LTOK); float* lw = (float*)(p.ws + WS_LW);
    const int tid = threadIdx.x, lane = tid & 63, wave = tid >> 6;
    const int ntok = (L == 0 ? NTOK : NLAT), TS = (L == 0 ? 144 : 128), nmt = ntok / TS, RW = TS / 8;
    for (int mt = blockIdx.x; mt < nmt; mt += gridDim.x) {
        const int t0 = mt * TS;
        if (tid < 64) lcnt[tid] = 0;
#pragma unroll 2
        for (int q = 0; q < RW; ++q) {
            const int tok = t0 + wave * RW + q;
            const u32x2* yr = (const u32x2*)(Y + (size_t)tok * D) + lane;
            u32x2* xo = (u32x2*)x_row(p, tok) + lane;
            f32x4 v[4];
            if (L == 0) {
                const f32x4* xi = (const f32x4*)x_in_row(p, tok) + lane;
#pragma unroll
                for (int j = 0; j < 4; ++j) { const f32x4 a = xi[64 * j]; const u32x2 y = yr[64 * j]; v[j] = (f32x4){a.x + lo16(y.x), a.y + hi16(y.x), a.z + lo16(y.y), a.w + hi16(y.y)}; }
            } else {
#pragma unroll
                for (int j = 0; j < 4; ++j) { const u32x2 a = xo[64 * j]; const u32x2 y = yr[64 * j]; v[j] = (f32x4){lo16(a.x) + lo16(y.x), hi16(a.x) + hi16(y.x), lo16(a.y) + lo16(y.y), hi16(a.y) + hi16(y.y)}; }
            }
#pragma unroll
            for (int j = 0; j < 4; ++j) { u32x2 w; w.x = cvtpk(v[j].x, v[j].y); w.y = cvtpk(v[j].z, v[j].w); xo[64 * j] = w; }
            norm_mod_store(p, L, 1, tok, lane, v, (bf16_t*)(p.ws + WS_H));
        }
        asm volatile("s_waitcnt vmcnt(0)" ::: "memory");
        __syncthreads();
        auto rs = [&](int pr) { return H + (size_t)(t0 + (pr < TS ? pr : TS - 1)) * D; };
        auto epi = [&](int r, int c, f32x4 v) { if (c < 64) { float* d = lg + r * 65 + c; d[0] = v.x; d[1] = v.y; d[2] = v.z; d[3] = v.w; } };
        gemm_tile<5>(lds, rs, W, D, D, epi);
        __syncthreads();
        if (tid < TS) {
            const float* rbp = p.in[21] + L * NEXP; const float* lrow = lg + tid * 65;
            float bv[6], bs[6]; int bi[6];
#pragma unroll
            for (int k = 0; k < 6; ++k) { bv[k] = -INFINITY; bs[k] = 0.f; bi[k] = 0; }
#pragma unroll 4
            for (int e = 0; e < NEXP; ++e) {
                float sc = 1.f / (1.f + __expf(-lrow[e])); float sv = sc + rbp[e]; int ei = e;
#pragma unroll
                for (int k = 0; k < 6; ++k) { const bool gt = sv > bv[k]; const float tv = gt ? bv[k] : sv, ts = gt ? bs[k] : sc; const int ti = gt ? bi[k] : ei;
                    bv[k] = gt ? sv : bv[k]; bs[k] = gt ? sc : bs[k]; bi[k] = gt ? ei : bi[k]; sv = tv; sc = ts; ei = ti; }
            }
            const float rs6 = 2.5f / (bs[0] + bs[1] + bs[2] + bs[3] + bs[4] + bs[5]);
#pragma unroll
            for (int k = 0; k < 6; ++k) { const int rank = atomicAdd(&lcnt[bi[k]], 1); sel[tid * 6 + k] = (bi[k] << 8) | rank; selw[tid * 6 + k] = bs[k] * rs6; }
        }
        __syncthreads();
        if (tid < 64) {
            unsigned* ecnt = (unsigned*)(p.ws + WS_CTL) + CW_ECNT + L * 4096;
            const int c = lcnt[tid];
            lcnt[64 + tid] = c ? (int)atomicAdd(ecnt + tid * 64, (unsigned)c) : 0;
        }
        __syncthreads();
        for (int i = tid; i < TS * 6; i += NTHREADS) {
            const int sv = sel[i], e = sv >> 8, pos = lcnt[64 + e] + (sv & 255), tok = t0 + i / 6, k = i % 6;
            ltok[(size_t)e * LCAP + pos] = tok * 8 + k;
            lw[(size_t)e * LCAP + pos] = selw[i];
        }
        __syncthreads();
    }
}

__device__ __forceinline__ void build_etab(unsigned char* lds, const P& p, int L) {
    int* tstart = (int*)(lds + ETAB_OFF); int* cnt = tstart + 80;
    __syncthreads();
    if (threadIdx.x < 64) { const unsigned* ecnt = (const unsigned*)(p.ws + WS_CTL) + CW_ECNT + L * 4096;
        cnt[threadIdx.x] = (int)__hip_atomic_load(ecnt + threadIdx.x * 64, __ATOMIC_RELAXED, __HIP_MEMORY_SCOPE_AGENT); }
    __syncthreads();
    if (threadIdx.x == 0) { int s = 0; for (int e = 0; e < 64; ++e) { tstart[e] = s; s += (cnt[e] + 255) >> 8; } tstart[64] = s; s += (L == 0 ? NTOK : NLAT) / 256; tstart[65] = s; }
    __syncthreads();
}
struct MoeOrder {
    int TT, nN, G, c; const int* tstart; const char* Bexp; size_t bexp; const char* Bsh; size_t btile; const int* rowbuf; unsigned arow; bool ident;
    __device__ __forceinline__ bool next(int i, ge::Unit& u) const {
        const int Lq = i * G + c; if (Lq >= TT * nN) return false;
        const int t = Lq / nN, pn = Lq % nN;
        int lo = 0, hi = 64;
        while (lo < hi) { const int mid = (lo + hi + 1) >> 1; if (tstart[mid] <= t) lo = mid; else hi = mid - 1; }
        const int e = __builtin_amdgcn_readfirstlane(lo);
        u.a = t; u.b = pn; u.c = e; u.d = i;
        u.B = (e < 64 ? Bexp + (size_t)e * bexp : Bsh) + (size_t)pn * btile;
        return true;
    }
    __device__ __forceinline__ unsigned aoff(int i, const ge::Unit& u, int R) const { return (unsigned)(ident ? u.a * 256 + R : rowbuf[i * 256 + R]) * arow; }
};
__device__ __forceinline__ void phase_gateup(unsigned char* lds, const P& p, int L) {
    build_etab(lds, p, L);
    const int* tstart = (const int*)(lds + ETAB_OFF); const int* cnt = tstart + 80;
    int* rowbuf = (int*)(lds + RB0_OFF); float* wbuf = (float*)(lds + RB1_OFF);
    const int* ltok = (const int*)(p.ws + WS_LTOK); const float* lw = (const float*)(p.ws + WS_LW);
    bf16_t* ACT = (bf16_t*)(p.ws + WS_ACT);
    const int G = gridDim.x, bid = blockIdx.x, vcu = (G % 8 == 0) ? (bid % 8) * (G / 8) + bid / 8 : bid;
    MoeOrder S; S.TT = tstart[65]; S.nN = 2; S.G = G; S.c = vcu; S.tstart = tstart; S.Bexp = (const char*)(p.ws + WS_EGU); S.bexp = (size_t)512 * D * 2;
    S.Bsh = (const char*)((const bf16_t*)(p.ws + WS_SHGU) + (size_t)L * 512 * D); S.btile = (size_t)256 * D * 2; S.rowbuf = rowbuf; S.arow = D * 2; S.ident = false;
    {
        ge::Unit u;
        for (int i = 0; i < 10 && S.next(i, u); ++i) {
            if (threadIdx.x < 256) {
                const int R = threadIdx.x, e = u.c, mt = u.a - tstart[e];
                int tok; float w;
                if (e < 64) { const int lp = mt * 256 + R; const bool ok = lp < cnt[e]; tok = ok ? (ltok[(size_t)e * LCAP + lp] >> 3) : 0; w = ok ? lw[(size_t)e * LCAP + lp] : 0.f; }
                else { tok = mt * 256 + R; w = 1.f; }
                rowbuf[i * 256 + R] = tok; wbuf[i * 256 + R] = w;
            }
        }
        __syncthreads();
    }
    auto f = [&](const ge::Unit& u, int r, int c, f32x4 v0, f32x4 v1) {
        const float w = wbuf[u.d * 256 + r];
        u32x2 o; o.x = cvtpk(siluf(v0.x) * v0.y * w, siluf(v0.z) * v0.w * w); o.y = cvtpk(siluf(v1.x) * v1.y * w, siluf(v1.z) * v1.w * w);
        *(u32x2*)(ACT + (size_t)(u.a * 256 + r) * EDIM + ((u.b * 256 + c) >> 1)) = o;
    };
    ge::EpiFn<decltype(f)> E{f};
    ge::gemm_stream<MoeOrder, ge::EpiFn<decltype(f)>, true>((LAS unsigned char*)lds, (const char*)(p.ws + WS_H), D, S, E);
}
__device__ __forceinline__ void phase_down(unsigned char* lds, const P& p, int L) {
    build_etab(lds, p, L);
    const int* tstart = (const int*)(lds + ETAB_OFF); const int* cnt = tstart + 80;
    int* sbuf = (int*)(lds + RB0_OFF);
    const int* ltok = (const int*)(p.ws + WS_LTOK);
    unsigned char* SLOT = (unsigned char*)(p.ws + WS_SLOT);
    const int G = gridDim.x, bid = blockIdx.x, vcu = (G % 8 == 0) ? (bid % 8) * (G / 8) + bid / 8 : bid;
    MoeOrder S; S.TT = tstart[65]; S.nN = 4; S.G = G; S.c = vcu; S.tstart = tstart; S.Bexp = (const char*)(p.ws + WS_ED); S.bexp = (size_t)D * EDIM * 2;
    S.Bsh = (const char*)((const bf16_t*)(p.ws + WS_SHD) + (size_t)L * D * EDIM); S.btile = (size_t)256 * EDIM * 2; S.rowbuf = sbuf; S.arow = EDIM * 2; S.ident = true;
    {
        ge::Unit u;
        for (int i = 0; i < 18 && S.next(i, u); ++i) {
            if (threadIdx.x < 256) {
                const int R = threadIdx.x, e = u.c, mt = u.a - tstart[e];
                int srow;
                if (e < 64) { const int lp = mt * 256 + R; if (lp < cnt[e]) { const int ent = ltok[(size_t)e * LCAP + lp]; srow = (ent >> 3) * 7 + (ent & 7); } else srow = NTOK * 7; }
                else srow = (mt * 256 + R) * 7 + 6;
                sbuf[i * 256 + R] = srow;
            }
        }
        __syncthreads();
    }
    auto f = [&](const ge::Unit& u, int r, int c, f32x4 v0, f32x4 v1) {
        const int srow = sbuf[u.d * 256 + r];
        int w0 = 0, w1 = 0;
        w0 = __builtin_amdgcn_cvt_pk_fp8_f32(__builtin_amdgcn_fmed3f(v0.x, -440.f, 440.f), __builtin_amdgcn_fmed3f(v0.y, -440.f, 440.f), w0, false);
        w0 = __builtin_amdgcn_cvt_pk_fp8_f32(__builtin_amdgcn_fmed3f(v0.z, -440.f, 440.f), __builtin_amdgcn_fmed3f(v0.w, -440.f, 440.f), w0, true);
        w1 = __builtin_amdgcn_cvt_pk_fp8_f32(__builtin_amdgcn_fmed3f(v1.x, -440.f, 440.f), __builtin_amdgcn_fmed3f(v1.y, -440.f, 440.f), w1, false);
        w1 = __builtin_amdgcn_cvt_pk_fp8_f32(__builtin_amdgcn_fmed3f(v1.z, -440.f, 440.f), __builtin_amdgcn_fmed3f(v1.w, -440.f, 440.f), w1, true);
        u32x2 w; w.x = (unsigned)w0; w.y = (unsigned)w1; *(u32x2*)(SLOT + (size_t)srow * D + u.b * 256 + c) = w;
    };
    ge::EpiFn<decltype(f)> E{f};
    ge::gemm_stream<MoeOrder, ge::EpiFn<decltype(f)>, true>((LAS unsigned char*)lds, (const char*)(p.ws + WS_ACT), EDIM, S, E);
}
__device__ __forceinline__ void phase_combine(const P& p, int L) {
    const int tid = threadIdx.x, lane = tid & 63, wave = tid >> 6, gw = blockIdx.x * NWAVES + wave, NGW = gridDim.x * NWAVES;
    const unsigned char* SLOT = (const unsigned char*)(p.ws + WS_SLOT);
    const float* modv = (const float*)(p.ws + WS_MODV) + (size_t)L * 17 * 6144;
    const int ntok = (L == 0 ? NTOK : NLAT);
    for (int tok = gw; tok < ntok; tok += NGW) {
        f32x4 acc[4];
#pragma unroll
        for (int j = 0; j < 4; ++j) acc[j] = (f32x4){0.f, 0.f, 0.f, 0.f};
#pragma unroll
        for (int k = 0; k < 7; ++k) {
            const int* sr = (const int*)(SLOT + ((size_t)tok * 7 + k) * D) + lane;
#pragma unroll
            for (int j = 0; j < 4; ++j) { const int w = sr[64 * j]; const f32x2_t a = __builtin_amdgcn_cvt_pk_f32_fp8(w, false), b = __builtin_amdgcn_cvt_pk_f32_fp8(w, true); acc[j].x += a.x; acc[j].y += a.y; acc[j].z += b.x; acc[j].w += b.y; }
        }
        const float* g2 = modv + (size_t)mod_row(tok) * 6144 + 5120;
        u32x2* xr = (u32x2*)x_row(p, tok) + lane;
        f32x4 v[4];
#pragma unroll
        for (int j = 0; j < 4; ++j) { const f32x4 g = *(const f32x4*)(g2 + 4 * lane + 256 * j); const u32x2 a = xr[64 * j];
            v[j] = (f32x4){lo16(a.x), hi16(a.x), lo16(a.y), hi16(a.y)} + g * acc[j]; }
        if (L == 0) {
#pragma unroll
            for (int j = 0; j < 4; ++j) { u32x2 w; w.x = cvtpk(v[j].x, v[j].y); w.y = cvtpk(v[j].z, v[j].w); xr[64 * j] = w; }
            norm_mod_store(p, 1, 0, tok, lane, v, (bf16_t*)(p.ws + WS_H1));
        } else {
            const float* nw = p.in[28]; float s = 0.f;
#pragma unroll
            for (int j = 0; j < 4; ++j) s += v[j].x * v[j].x + v[j].y * v[j].y + v[j].z * v[j].z + v[j].w * v[j].w;
            const float rstd = rsqrtf(wave_sum(s) * (1.f / D) + NORM_EPS);
            f32x4* orow = (f32x4*)(p.out + (size_t)tok * D) + lane;
#pragma unroll
            for (int j = 0; j < 4; ++j) { const f32x4 w4 = *(const f32x4*)(nw + 4 * lane + 256 * j); orow[64 * j] = v[j] * rstd * w4; }
        }
    }
}

constexpr int PH_LAYER0 = 2, PH_PER_LAYER = 8, PH_LAYER1 = PH_LAYER0 + PH_PER_LAYER, NPHASES = PH_LAYER1 + PH_PER_LAYER;

__global__ void __launch_bounds__(NTHREADS, 2) mk_fwd(P p) {
    extern __shared__ __attribute__((aligned(16))) unsigned char lds[];
    volatile LAS unsigned* MISC = (volatile LAS unsigned*)((LAS unsigned char*)lds + MISC_OFF);
    if (threadIdx.x < 64) MISC[threadIdx.x] = 0u;
    __syncthreads();
    unsigned* ctl = (unsigned*)(p.ws + WS_CTL);
    XcdBarrier bar; bar.bar = ctl + CW_BAR; bar.x = 0; bar.st = MISC + 8;
    if (!MK_PER_PHASE) bar = xcd_barrier_post(ctl + CW_BAR, MISC + 8);
    const int lo = p.ph_lo, hi = p.ph_hi;
#ifndef PH_MASK
#define PH_MASK 0xffffu
#endif
#define HAS(b) ((PH_MASK >> (b)) & 1u)
#define IN(k) (lo <= (k) && (k) < hi)
#define SEAM(k) do { if (IN(k) && IN((k) + 1)) xcd_barrier(bar); } while (0)

#ifdef PROBE_MASK
    unsigned long long tacc = 0ull, t0p = 0ull;
#define PT0() t0p = __builtin_amdgcn_s_memrealtime()
#define PT1(b) do { if ((PROBE_MASK >> (b)) & 1u) tacc += __builtin_amdgcn_s_memrealtime() - t0p; } while (0)
#else
#define PT0() do {} while (0)
#define PT1(b) do {} while (0)
#endif
#define PH(b, k, body) do { PT0(); if (HAS(b) && IN(k)) { body; } SEAM(k); PT1(b); } while (0)
    PH(0, 0, phase_prep(lds, p));
    PH(1, 1, phase_norm_mod(p, 0, 0, NTOK));
#define LAYER(L, pb) \
        PH(2, pb + 0, phase_zgemm(lds, p, L)); \
        PH(3, pb + 1, phase_b(lds, p, L)); \
        PH(4, pb + 2, phase_c(lds, p, L)); \
        PH(5, pb + 3, phase_d(lds, p, L)); \
        PH(7, pb + 4, phase_router(lds, p, L)); \
        PH(8, pb + 5, phase_gateup(lds, p, L)); \
        PH(9, pb + 6, phase_down(lds, p, L)); \
        PH(10, pb + 7, phase_combine(p, L));
    LAYER(0, PH_LAYER0)
    LAYER(1, PH_LAYER1)
#ifdef PROBE_MASK
    if (blockIdx.x == 0) {
        const unsigned long long tend = __builtin_amdgcn_s_memrealtime();
        while (__builtin_amdgcn_s_memrealtime() - tend < (unsigned long long)PROBE_AMP * tacc) __builtin_amdgcn_s_sleep(8);
    }
#endif
#undef IN
#undef SEAM
}

extern "C" void kernel_launch(void* const* d_in, const int* in_sizes, int n_in, void* d_out, int out_size, void* d_ws, size_t ws_size, hipStream_t stream) {
    static int grid = 0;
    if (grid == 0) {
        if (n_in != 29 || in_sizes[0] != NLAT * D || out_size != NLAT * D || ws_size < WS_END) {
            fprintf(stderr, "kernel_launch: unexpected shapes / workspace (n_in %d, ws %zu, need %zu); nothing launched\n", n_in, ws_size, (size_t)WS_END); grid = -1; return; }
        int dev = 0, cus = 0, per_cu = 0;
        if (hipGetDevice(&dev) != hipSuccess || hipDeviceGetAttribute(&cus, hipDeviceAttributeMultiprocessorCount, dev) != hipSuccess) { grid = -1; return; }
        if (hipFuncSetAttribute((const void*)mk_fwd, hipFuncAttributeMaxDynamicSharedMemorySize, LDS_BYTES) != hipSuccess) { grid = -1; return; }
        if (hipOccupancyMaxActiveBlocksPerMultiprocessor(&per_cu, (const void*)mk_fwd, NTHREADS, LDS_BYTES) != hipSuccess || per_cu < 1) { fprintf(stderr, "kernel_launch: occupancy query says %d\n", per_cu); }
        (void)hipGetLastError();
        grid = cus;
    }
    if (grid < 0) return;
    (void)hipMemsetAsync((char*)d_ws + WS_CTL, 0, CTL_ZERO_BYTES, stream);
    P a{};
    for (int i = 0; i < 29; ++i) a.in[i] = (const float*)d_in[i];
    a.out = (float*)d_out; a.ws = (unsigned char*)d_ws;
#if MK_PER_PHASE
    for (int ph = 0; ph < NPHASES; ++ph) { a.ph_lo = ph; a.ph_hi = ph + 1; hipLaunchKernelGGL(mk_fwd, dim3(grid), dim3(NTHREADS), LDS_BYTES, stream, a); }
#else
    a.ph_lo = 0; a.ph_hi = NPHASES;
    hipLaunchKernelGGL(mk_fwd, dim3(grid), dim3(NTHREADS), LDS_BYTES, stream, a);
#endif
}
```

```cpp
#include <hip/hip_runtime.h>
#include <cstdio>
#include <cstdint>

#ifndef MK_PER_PHASE
#define MK_PER_PHASE 0
#endif

typedef unsigned short bf16_t;
typedef short bf16x8 __attribute__((ext_vector_type(8)));
typedef float f32x4 __attribute__((ext_vector_type(4)));
typedef unsigned u32x4 __attribute__((ext_vector_type(4)));
typedef unsigned u32x2 __attribute__((ext_vector_type(2)));
typedef float f32x16 __attribute__((ext_vector_type(16)));
typedef short v4i16_t __attribute__((ext_vector_type(4)));
#define LAS __attribute__((address_space(3)))

constexpr int D = 1024, BATCH = 16, SEQ = 2048, CTXL = 256;
constexpr int NLAT = BATCH * SEQ, NCTX = BATCH * CTXL, NTOK = NLAT + NCTX;
constexpr int ZC = 1792;
constexpr int Z_RQ = 512, Z_RK = 640, Z_RV = 768, Z_RG = 1024, Z_CQ = 1280, Z_CKV = 1536, Z_KR = 1664, Z_END = 1696;
constexpr int NEXP = 64, TOPK = 6, EDIM = 256;
constexpr float NORM_EPS = 1e-6f;
constexpr int NTHREADS = 512, NWAVES = 8;

constexpr size_t MiB = 1u << 20;
constexpr size_t WS_CTL = 0, CTL_ZERO_BYTES = 1 * MiB;
constexpr size_t WS_MODV = 1 * MiB;
constexpr size_t WS_ROPE = 2 * MiB;
constexpr size_t WS_WIN = 3 * MiB;
constexpr size_t WS_WUQ = 10 * MiB;
constexpr size_t WS_WUKV = 11 * MiB;
constexpr size_t WS_WOUT = 12 * MiB;
constexpr size_t WS_RT = 16 * MiB;
constexpr size_t WS_SHGU = 17 * MiB;
constexpr size_t WS_SHD = 19 * MiB;
constexpr size_t WS_EGU = 20 * MiB;
constexpr size_t WS_ED = 84 * MiB;
constexpr size_t WS_H1 = 20 * MiB;
constexpr size_t WS_X = 116 * MiB;
constexpr size_t WS_H = 188 * MiB;
constexpr size_t WS_CC = WS_H;
constexpr size_t WS_Z = 260 * MiB;
constexpr size_t WS_Y = WS_Z;
constexpr size_t WS_Q = 386 * MiB;
constexpr size_t WS_K = 440 * MiB;
constexpr size_t WS_V = 494 * MiB;
constexpr size_t WS_KV = 530 * MiB;
constexpr size_t WS_SLOT = 188 * MiB;
constexpr size_t WS_ACT = 441 * MiB;
constexpr size_t WS_LTOK = 583 * MiB;
constexpr size_t WS_LW = 592 * MiB;
constexpr size_t WS_SS = 601 * MiB;
constexpr size_t WS_END = 603 * MiB;
constexpr int LCAP = NTOK;
static_assert(WS_SLOT + ((size_t)NTOK * 7 + 1) * 1024 <= WS_ACT && WS_ACT + (size_t)1136 * 256 * 512 <= WS_LTOK, "MoE buffers");

constexpr int CW_TMO = 0;
constexpr int CW_BAR = 4096;
constexpr int CW_ECNT = 8192;

constexpr int LDS_BYTES = 162816;
constexpr int MISC_OFF = LDS_BYTES - 256;
constexpr int RB0_OFF = 131072;
constexpr int RB1_OFF = 149504;
constexpr int ETAB_OFF = 159744;
constexpr int GEMM_LDS = 36864;
constexpr int ROWSS_OFF = 36864;
constexpr int LG_OFF = 37376;

#define XB_TMO      128
#define XB_XCNT(j)  (256  + 64 * (j))
#define XB_XSUB(j)  (1280 + 64 * (j))
#define XB_XGEN(j)  (2304 + 64 * (j))
#define XB_TOP      3328
#define XB_TOPGEN   3392
#define XCD_BAR_WORDS 3456
#define XB_SPIN_CAP (1u << 24)
__device__ __forceinline__ unsigned xb_ld(unsigned* p)              { return __hip_atomic_load(p, __ATOMIC_RELAXED, __HIP_MEMORY_SCOPE_AGENT); }
__device__ __forceinline__ unsigned xb_add(unsigned* p, unsigned v) { return __hip_atomic_fetch_add(p, v, __ATOMIC_RELAXED, __HIP_MEMORY_SCOPE_AGENT); }
__device__ __forceinline__ unsigned xb_xcc_id() { return (unsigned)__builtin_amdgcn_s_getreg((3 << 11) | 20) & 0xFu; }
#define XB_SPIN(cond, bar) do { unsigned _sp = 0; while (cond) { __builtin_amdgcn_s_sleep(1); \
    if ((++_sp & 255u) == 0u) { if (xb_ld(&(bar)[XB_TMO])) break; if (_sp > XB_SPIN_CAP) { atomicAdd(&(bar)[XB_TMO], 1u); break; } } } } while (0)
struct XcdBarrier { unsigned* bar; unsigned x; volatile LAS unsigned* st; };
__device__ __forceinline__ XcdBarrier xcd_barrier_post(unsigned* bar, volatile LAS unsigned* st) {
    XcdBarrier b; b.bar = bar; b.x = xb_xcc_id(); b.st = st;
    if (threadIdx.x == 0) (void)xb_add(&bar[XB_XCNT(b.x)], 1u);
    return b;
}
__device__ __forceinline__ void xcd_barrier_complete(unsigned* bar, unsigned x, unsigned& nloc, unsigned& nx) {
    const unsigned G = gridDim.x * gridDim.y * gridDim.z;
    unsigned sum, cnt, mine, sp = 0u;
    for (;;) {
        sum = 0u; cnt = 0u; mine = 0u;
#pragma unroll
        for (unsigned j = 0; j < 16; ++j) { const unsigned c = xb_ld(&bar[XB_XCNT(j)]); sum += c; cnt += (c > 0u) ? 1u : 0u; mine = (j == x) ? c : mine; }
        if (sum == G) break;
        __builtin_amdgcn_s_sleep(1);
        if ((++sp & 255u) == 0u) { if (xb_ld(&bar[XB_TMO])) break; if (sp > XB_SPIN_CAP) { atomicAdd(&bar[XB_TMO], 1u); break; } }
    }
    nloc = mine > 0u ? mine : 1u; nx = cnt > 0u ? cnt : 1u;
}
__device__ __forceinline__ void xcd_barrier(const XcdBarrier& b) {
    asm volatile("s_waitcnt vmcnt(0)" ::: "memory");
    __syncthreads();
    if (threadIdx.x == 0) {
        unsigned* bar = b.bar;
        __builtin_amdgcn_s_waitcnt(0);
        unsigned nloc = b.st[0], nx = b.st[1];
        if (nloc == 0u) { xcd_barrier_complete(bar, b.x, nloc, nx); b.st[0] = nloc; b.st[1] = nx; }
        const unsigned old = xb_add(&bar[XB_XSUB(b.x)], 1u);
        const unsigned gen = old / nloc;
        if (old + 1u == (gen + 1u) * nloc) {
            __builtin_amdgcn_fence(__ATOMIC_RELEASE, "agent");
            asm volatile("s_waitcnt vmcnt(0)" ::: "memory");
            const unsigned og = xb_add(&bar[XB_TOP], 1u);
            const unsigned tg = og / nx;
            if (og + 1u == (tg + 1u) * nx) xb_add(&bar[XB_TOPGEN], 1u);
            else XB_SPIN(xb_ld(&bar[XB_TOPGEN]) == tg, bar);
            __builtin_amdgcn_fence(__ATOMIC_ACQUIRE, "agent");
            xb_add(&bar[XB_XGEN(b.x)], 1u);
            asm volatile("s_waitcnt vmcnt(0)" ::: "memory");
        } else {
            XB_SPIN(xb_ld(&bar[XB_XGEN(b.x)]) == gen, bar);
            __builtin_amdgcn_fence(__ATOMIC_ACQUIRE, "agent");
            asm volatile("s_waitcnt vmcnt(0)" ::: "memory");
        }
    }
    __syncthreads();
}

__device__ __forceinline__ float bf2f(unsigned h) { return __uint_as_float(h << 16); }
__device__ __forceinline__ unsigned f2bf(float f) { unsigned u = __float_as_uint(f); return (u + 0x7fffu + ((u >> 16) & 1u)) >> 16; }
__device__ __forceinline__ unsigned pk2(float lo, float hi) { return f2bf(lo) | (f2bf(hi) << 16); }
typedef float f32x2_t __attribute__((ext_vector_type(2)));
typedef __bf16 bf16x2_t __attribute__((ext_vector_type(2)));
__device__ __forceinline__ unsigned cvtpk(float lo, float hi) { f32x2_t v = {lo, hi}; bf16x2_t b = __builtin_convertvector(v, bf16x2_t); return __builtin_bit_cast(unsigned, b); }
__device__ __forceinline__ float lo16(unsigned w) { return __uint_as_float(w << 16); }
__device__ __forceinline__ float hi16(unsigned w) { return __uint_as_float(w & 0xffff0000u); }
__device__ __forceinline__ float wave_sum(float v) {
#pragma unroll
    for (int o = 1; o < 64; o <<= 1) v += __shfl_xor(v, o);
    return v;
}
__device__ __forceinline__ float siluf(float v) { return v / (1.f + __expf(-v)); }
__device__ __forceinline__ int mod_row(int tok) { return tok < NLAT ? (tok >> 11) : 16; }

struct P { const float* in[29]; float* out; unsigned char* ws; int ph_lo, ph_hi; };

__device__ __forceinline__ bf16_t* x_row(const P& p, int tok) { return (bf16_t*)(p.ws + WS_X) + (size_t)tok * D; }
__device__ __forceinline__ const float* x_in_row(const P& p, int tok) {
    return tok < NLAT ? p.in[0] + (size_t)tok * D : p.in[2] + (size_t)(tok - NLAT) * D;
}

template <int MF, class RowSrc, class Epi>
__device__ __forceinline__ void gemm_tile(unsigned char* lds, const RowSrc& rs, const bf16_t* Bt, int ldb, int K, const Epi& epi) {
    constexpr int ROWS = 32 * MF, NPA = ROWS * 8;
    const int tid = threadIdx.x, lane = tid & 63, wid = tid >> 6, wr = wid >> 2, wc = wid & 3, fr = lane & 15, fq = lane >> 4;
    bf16_t* As = (bf16_t*)lds; bf16_t* Bs = As + ROWS * 72;
    const bf16_t* ap[3]; int al[3];
#pragma unroll
    for (int i = 0; i < 3; ++i) { const int id = tid + 512 * i, r = id >> 3, c = (id & 7) * 8; ap[i] = (id < NPA) ? rs(r) + c : nullptr; al[i] = r * 72 + c; }
    const int lr = tid >> 2, lc = (tid & 3) * 16;
    const bf16_t* bp = Bt + (size_t)lr * ldb + lc;
    u32x4 a[3], b0 = *(const u32x4*)bp, b1 = *(const u32x4*)(bp + 8);
#pragma unroll
    for (int i = 0; i < 3; ++i) if (ap[i]) a[i] = *(const u32x4*)ap[i];
    f32x4 acc[MF][2];
#pragma unroll
    for (int m = 0; m < MF; ++m)
#pragma unroll
        for (int n = 0; n < 2; ++n) acc[m][n] = (f32x4){0.f, 0.f, 0.f, 0.f};
    for (int k0 = 0; k0 < K; k0 += 64) {
        __syncthreads();
#pragma unroll
        for (int i = 0; i < 3; ++i) if (ap[i]) *(u32x4*)(As + al[i]) = a[i];
        *(u32x4*)(Bs + lr * 72 + lc) = b0; *(u32x4*)(Bs + lr * 72 + lc + 8) = b1;
        __syncthreads();
        if (k0 + 64 < K) {
#pragma unroll
            for (int i = 0; i < 3; ++i) if (ap[i]) { ap[i] += 64; a[i] = *(const u32x4*)ap[i]; }
            bp += 64; b0 = *(const u32x4*)bp; b1 = *(const u32x4*)(bp + 8);
        }
#pragma unroll
        for (int kk = 0; kk < 2; ++kk) {
            bf16x8 af[MF], bfr[2];
#pragma unroll
            for (int m = 0; m < MF; ++m) af[m] = *(const bf16x8*)(As + (wr * 16 * MF + m * 16 + fr) * 72 + kk * 32 + fq * 8);
#pragma unroll
            for (int n = 0; n < 2; ++n) bfr[n] = *(const bf16x8*)(Bs + (wc * 32 + n * 16 + fr) * 72 + kk * 32 + fq * 8);
#pragma unroll
            for (int m = 0; m < MF; ++m)
#pragma unroll
                for (int n = 0; n < 2; ++n) acc[m][n] = __builtin_amdgcn_mfma_f32_16x16x32_bf16(bfr[n], af[m], acc[m][n], 0, 0, 0);
        }
    }
#pragma unroll
    for (int m = 0; m < MF; ++m)
#pragma unroll
        for (int n = 0; n < 2; ++n) epi(wr * 16 * MF + m * 16 + fr, wc * 32 + n * 16 + 4 * fq, acc[m][n]);
}

namespace ge {
constexpr int BM = 256, BK = 64, HALF = 128, HTB = HALF * BK * 2;
__device__ __forceinline__ int lds_byte(int r, int c) { const int st = (r >> 4) * 2 + (c >> 5), rr = r & 15, cc = c & 31, ob = rr * 64 + cc * 2; return st * 1024 + (ob ^ (((ob >> 9) & 1) << 5)); }
__device__ __forceinline__ void stage_rc(int b, int& R, int& C) { const int st = b / 1024, sb = b % 1024, swz = sb ^ (((sb >> 9) & 1) << 5); R = (st >> 1) * 16 + swz / 64; C = (st & 1) * 32 + (swz % 64) / 2; }
struct Unit { const char* B; int a, b, c, d; };
typedef f32x4 Acc[2][2][4][2];

template <class Sched, class Epi, bool ALIGN_EPI>
__device__ __forceinline__ void gemm_stream(LAS unsigned char* lds, const char* Ab, int K, const Sched& S, const Epi& E) {
    const int tid = threadIdx.x, wid = __builtin_amdgcn_readfirstlane(tid >> 6), lane = tid & 63, wr = wid >> 2, wc = wid & 3, fr = lane & 15, fq = lane >> 4;
    const int nt = K / BK;
    int Rr[2], Cc[2]; unsigned voffB[2];
#pragma unroll
    for (int i = 0; i < 2; ++i) { stage_rc(tid * 16 + i * 8192, Rr[i], Cc[i]);
        const int rho = Rr[i] & 31, Rb = (Rr[i] & ~31) + 8 * ((rho & 15) >> 2) + 4 * (rho >> 4) + (rho & 3);
        voffB[i] = (unsigned)(Rb * K + Cc[i]) * 2u; }
    const size_t kstep = (size_t)(BK * 2), hstepB = (size_t)HALF * K * 2;
    const unsigned ldsw = (unsigned)wid * 1024u;
    const int aoff = lds_byte(wr * 64 + fr, fq * 8), boff = lds_byte(wc * 32 + fr, fq * 8);
#define GE_SA(b, h) (((b) * 2 + (h)) * HTB)
#define GE_SB(b, h) ((4 + (b) * 2 + (h)) * HTB)
#define GE_GLDS(gp, ldsoff) __builtin_amdgcn_global_load_lds((const unsigned*)(gp), (LAS unsigned*)(lds + (ldsoff)), 16, 0, 0)
#define GE_STAGE_B(bufoff, gbase) do { GE_GLDS((const char*)(gbase) + voffB[0], (bufoff) + ldsw); GE_GLDS((const char*)(gbase) + voffB[1], (bufoff) + ldsw + 8192); } while (0)
#define GE_STAGE_A(bufoff, kbytes, o0, o1) do { GE_GLDS(Ab + (kbytes) + (o0), (bufoff) + ldsw); GE_GLDS(Ab + (kbytes) + (o1), (bufoff) + ldsw + 8192); } while (0)
#define GE_LDA(dst, b, h) do { _Pragma("unroll") for (int m = 0; m < 4; ++m) _Pragma("unroll") for (int k = 0; k < 2; ++k) dst[m][k] = *(const LAS bf16x8*)(lds + GE_SA(b, h) + aoff + m * 2048 + k * 1024); } while (0)
#define GE_LDB(dst, b, h) do { _Pragma("unroll") for (int n = 0; n < 2; ++n) _Pragma("unroll") for (int k = 0; k < 2; ++k) dst[n][k] = *(const LAS bf16x8*)(lds + GE_SB(b, h) + boff + n * 2048 + k * 1024); } while (0)
#define GE_MMA(ai, bj, At, Bt) do { __builtin_amdgcn_s_setprio(1); _Pragma("unroll") for (int m = 0; m < 4; ++m) _Pragma("unroll") for (int n = 0; n < 2; ++n) _Pragma("unroll") for (int k = 0; k < 2; ++k) \
        acc[ai][bj][m][n] = __builtin_amdgcn_mfma_f32_16x16x32_bf16(Bt[n][k], At[m][k], acc[ai][bj][m][n], 0, 0, 0); __builtin_amdgcn_s_setprio(0); } while (0)
#define GE_WAIT_V(n) asm volatile("s_waitcnt vmcnt(" #n ")" ::: "memory")
#define GE_WAIT_L(n) asm volatile("s_waitcnt lgkmcnt(" #n ")" ::: "memory")
#define GE_BAR __builtin_amdgcn_s_barrier()
#define GE_SCHED __builtin_amdgcn_sched_barrier(0)
    Unit cur, nxt; int ui = 0;
    if (!S.next(0, cur)) return;
    Acc acc;
#pragma unroll
    for (int a = 0; a < 2; ++a)
#pragma unroll
        for (int b = 0; b < 2; ++b)
#pragma unroll
            for (int m = 0; m < 4; ++m)
#pragma unroll
                for (int n = 0; n < 2; ++n) acc[a][b][m][n] = (f32x4){0.f, 0.f, 0.f, 0.f};
    bf16x8 At[4][2], B0[2][2], B1[2][2];
    unsigned oc00, oc01, oc10, oc11, on00, on01, on10, on11;
    oc00 = S.aoff(0, cur, Rr[0]) + (unsigned)Cc[0] * 2u; oc01 = S.aoff(0, cur, Rr[1]) + (unsigned)Cc[1] * 2u;
    oc10 = S.aoff(0, cur, Rr[0] + 128) + (unsigned)Cc[0] * 2u; oc11 = S.aoff(0, cur, Rr[1] + 128) + (unsigned)Cc[1] * 2u;
    const char* cB = cur.B;
    GE_STAGE_B(GE_SB(0, 0), cB); GE_STAGE_B(GE_SB(0, 1), cB + hstepB); GE_STAGE_A(GE_SA(0, 0), 0, oc00, oc01); GE_STAGE_A(GE_SA(0, 1), 0, oc10, oc11);
    if (wr == 1) GE_BAR;
    GE_WAIT_V(2); GE_BAR;
    GE_STAGE_B(GE_SB(1, 0), cB + kstep); GE_STAGE_A(GE_SA(1, 0), kstep, oc00, oc01); GE_STAGE_B(GE_SB(1, 1), cB + hstepB + kstep);
    GE_WAIT_V(6); GE_BAR;
    for (;;) {
        const bool has_next = S.next(ui + 1, nxt);
        const char* nB = has_next ? nxt.B : cB;
        if (has_next) {
            on00 = S.aoff(ui + 1, nxt, Rr[0]) + (unsigned)Cc[0] * 2u; on01 = S.aoff(ui + 1, nxt, Rr[1]) + (unsigned)Cc[1] * 2u;
            on10 = S.aoff(ui + 1, nxt, Rr[0] + 128) + (unsigned)Cc[0] * 2u; on11 = S.aoff(ui + 1, nxt, Rr[1] + 128) + (unsigned)Cc[1] * 2u;
        } else { on00 = oc00; on01 = oc01; on10 = oc10; on11 = oc11; }
#pragma unroll 1
        for (int t = 0; t < nt; t += 2) {
            const bool last = (t == nt - 2);
            const size_t k1 = (size_t)(t + 1) * kstep;
            const size_t k2 = last ? 0 : (size_t)(t + 2) * kstep, k3 = k2 + kstep;
            const char* b2 = last ? nB : cB + (size_t)(t + 2) * kstep; const char* b3 = b2 + kstep;
            const unsigned o00 = last ? on00 : oc00, o01 = last ? on01 : oc01, o10 = last ? on10 : oc10, o11 = last ? on11 : oc11;
            GE_LDB(B0, 0, 0); GE_LDB(B1, 0, 1); GE_SCHED; GE_LDA(At, 0, 0); GE_STAGE_A(GE_SA(1, 1), k1, oc10, oc11);
            GE_WAIT_V(8); GE_WAIT_L(0); GE_BAR; GE_MMA(0, 0, At, B0); GE_MMA(0, 1, At, B1); GE_BAR; GE_SCHED;
            GE_LDA(At, 0, 1); GE_STAGE_B(GE_SB(0, 0), b2); GE_STAGE_B(GE_SB(0, 1), b2 + hstepB); GE_STAGE_A(GE_SA(0, 0), k2, o00, o01);
            GE_WAIT_V(8); GE_WAIT_L(0); GE_BAR; GE_MMA(1, 0, At, B0); GE_MMA(1, 1, At, B1); GE_BAR; GE_SCHED;
            GE_LDB(B0, 1, 0); GE_LDB(B1, 1, 1); GE_SCHED; GE_LDA(At, 1, 0); GE_STAGE_A(GE_SA(0, 1), k2, o10, o11);
            GE_WAIT_V(8); GE_WAIT_L(0); GE_BAR; GE_MMA(0, 0, At, B0); GE_MMA(0, 1, At, B1); GE_BAR; GE_SCHED;
            GE_LDA(At, 1, 1); GE_STAGE_B(GE_SB(1, 0), b3); GE_STAGE_B(GE_SB(1, 1), b3 + hstepB); GE_STAGE_A(GE_SA(1, 0), k3, o00, o01);
            GE_WAIT_V(8); GE_WAIT_L(0); GE_BAR; GE_MMA(1, 0, At, B0); GE_MMA(1, 1, At, B1); GE_BAR; GE_SCHED;
        }
        if constexpr (ALIGN_EPI) { if (wr == 0) GE_BAR; }
        E(acc, cur, wr, wc, fr, fq);
        if (!has_next) break;
#pragma unroll
        for (int a = 0; a < 2; ++a)
#pragma unroll
            for (int b = 0; b < 2; ++b)
#pragma unroll
                for (int m = 0; m < 4; ++m)
#pragma unroll
                    for (int n = 0; n < 2; ++n) acc[a][b][m][n] = (f32x4){0.f, 0.f, 0.f, 0.f};
        cur = nxt; cB = nB; ++ui; oc00 = on00; oc01 = on01; oc10 = on10; oc11 = on11;
        if constexpr (ALIGN_EPI) { if (wr == 1) GE_BAR; }
    }
    GE_WAIT_V(0);
    if constexpr (!ALIGN_EPI) { if (wr == 0) GE_BAR; }
    GE_BAR;
#undef GE_SA
#undef GE_SB
#undef GE_GLDS
#undef GE_STAGE_A
#undef GE_STAGE_B
#undef GE_LDA
#undef GE_LDB
#undef GE_MMA
#undef GE_WAIT_V
#undef GE_WAIT_L
#undef GE_BAR
#undef GE_SCHED
}
template <class F> struct EpiFn {
    F f;
    __device__ __forceinline__ void operator()(const Acc& acc, const Unit& u, int wr, int wc, int fr, int fq) const {
#pragma unroll
        for (int ai = 0; ai < 2; ++ai)
#pragma unroll
            for (int m = 0; m < 4; ++m)
#pragma unroll
                for (int bj = 0; bj < 2; ++bj) f(u, ai * 128 + wr * 64 + m * 16 + fr, bj * 128 + wc * 32 + 8 * fq, acc[ai][bj][m][0], acc[ai][bj][m][1]);
    }
};
struct DenseOrder {
    int nM, nN, nwg, G, c; const char* Bt; size_t btile; unsigned arow;
    __device__ __forceinline__ bool next(int i, Unit& u) const {
        const long L = (long)i * G + c; if (L >= nwg) return false;
        int wgid = (int)L; { const int q = nwg / 8, r = nwg % 8, xcd = wgid % 8, off = wgid / 8; wgid = (xcd < r ? xcd * (q + 1) : r * (q + 1) + (xcd - r) * q) + off; }
        const int nig = 8 * nN, gid = wgid / nig, fm = gid * 8, gsz = (nM - fm) < 8 ? (nM - fm) : 8;
        u.a = fm + ((wgid % nig) % gsz); u.b = (wgid % nig) / gsz; u.c = 0; u.d = 0; u.B = Bt + (size_t)u.b * btile; return true;
    }
    __device__ __forceinline__ unsigned aoff(int, const Unit& u, int R) const { return (unsigned)(u.a * 256 + R) * arow; }
};
}

struct TMap { const float* s0; const float* s1; int ld; int nvalid; const float* ksc; float gsc; };
template <int MODE> __device__ __forceinline__ const float* tmap_src(const float* s0, const float* s1, int nvalid, int n) {
    if (MODE == 0) return n < nvalid ? s0 + n : nullptr;
    if (MODE == 1) { const int h = n / 96, j = n % 96; const int c = j < 64 ? j : 64 + ((j - 64) & 1) * 16 + ((j - 64) >> 1); return s0 + h * 96 + c; }
    return ((n & 1) ? s1 : s0) + (n >> 1);
}
template <int MODE> __device__ __forceinline__ void transpose_unit(float* scr, const float* s0, const float* s1, int ld, int nvalid, const float* ksc, float gsc, int K, bf16_t* dst, int kb, int nb, int kvalid = 1 << 30) {
    const int tid = threadIdx.x, k0 = kb * 64, n0 = nb * 64;
    const int nn = tid & 63; const float* sp = tmap_src<MODE>(s0, s1, nvalid, n0 + nn);
#pragma unroll
    for (int i = 0; i < 8; ++i) {
        const int kk = (tid >> 6) + 8 * i; float v = (sp && k0 + kk < kvalid) ? sp[(size_t)(k0 + kk) * ld] : 0.f;
        if (ksc && k0 + kk < kvalid) v *= ksc[k0 + kk];
        scr[kk * 65 + nn] = v * gsc;
    }
    __syncthreads();
    {
        const int n2 = tid >> 3, kc = tid & 7; const float* s = scr + (kc * 8) * 65 + n2;
        u32x4 o; o.x = pk2(s[0], s[65]); o.y = pk2(s[2 * 65], s[3 * 65]); o.z = pk2(s[4 * 65], s[5 * 65]); o.w = pk2(s[6 * 65], s[7 * 65]);
        *(u32x4*)(dst + (size_t)(n0 + n2) * K + k0 + kc * 8) = o;
    }
    __syncthreads();
}
template <int MODE> __device__ __forceinline__ void transpose_matrix(float* scr, const float* s0, const float* s1, int ld, int nvalid, const float* ksc, float gsc, int K, int Nd, bf16_t* dst, int& rot, int kvalid = 1 << 30) {
    const int nkb = K / 64, nnb = Nd / 64, nu = nkb * nnb, G = gridDim.x;
    int first = ((int)blockIdx.x - rot) % G; if (first < 0) first += G;
    for (int u = first; u < nu; u += G) transpose_unit<MODE>(scr, s0, s1, ld, nvalid, ksc, gsc, K, dst, u / nnb, u % nnb, kvalid);
    rot = (rot + nu) % G;
}
__device__ __forceinline__ void convert_expert_weights(unsigned char* lds, const P& p, int L) {
    float* scr = (float*)lds; const int G = gridDim.x, tid = threadIdx.x;
    constexpr int S = 261;
    bf16_t* egu = (bf16_t*)(p.ws + WS_EGU); bf16_t* ed = (bf16_t*)(p.ws + WS_ED);
    for (int ub = blockIdx.x; ub < NEXP * 48; ub += G) {
        const int e = ub / 48, r = (ub % 48) * 4;
        bf16_t* dst; int K, k0;
        if (r < 128) {
            const int kb = r >> 3, nb0 = r & 7; k0 = kb * 64; K = D; dst = egu + ((size_t)e * 512 + nb0 * 64) * D;
            const float* gsrc = p.in[22] + ((size_t)L * NEXP + e) * D * EDIM + nb0 * 32; const float* usrc = p.in[23] + ((size_t)L * NEXP + e) * D * EDIM + nb0 * 32;
            f32x4 v[8];
#pragma unroll
            for (int i = 0; i < 8; ++i) { const int idx = tid + 512 * i, kk = idx >> 6, c = idx & 63; v[i] = *(const f32x4*)((c < 32 ? gsrc : usrc) + (size_t)(k0 + kk) * EDIM + (c & 31) * 4); }
#pragma unroll
            for (int i = 0; i < 8; ++i) { const int idx = tid + 512 * i, kk = idx >> 6, c = idx & 63; float* d = scr + kk * S + 8 * (c & 31) + (c >> 5);
                d[0] = v[i].x; d[2] = v[i].y; d[4] = v[i].z; d[6] = v[i].w; }
        } else {
            const int r2 = r - 128, kb = r2 >> 4, nb0 = r2 & 15; k0 = kb * 64; K = EDIM; dst = ed + ((size_t)e * D + nb0 * 64) * EDIM;
            const float* src = p.in[24] + ((size_t)L * NEXP + e) * EDIM * D + nb0 * 64;
            f32x4 v[8];
#pragma unroll
            for (int i = 0; i < 8; ++i) { const int idx = tid + 512 * i, kk = idx >> 6, c = idx & 63; v[i] = *(const f32x4*)(src + (size_t)(k0 + kk) * D + c * 4); }
#pragma unroll
            for (int i = 0; i < 8; ++i) { const int idx = tid + 512 * i, kk = idx >> 6, c = idx & 63; float* d = scr + kk * S + 4 * c;
                d[0] = v[i].x; d[1] = v[i].y; d[2] = v[i].z; d[3] = v[i].w; }
        }
        __syncthreads();
#pragma unroll
        for (int i = 0; i < 4; ++i) {
            const int id = tid + 512 * i, n = id >> 3, kc = id & 7; const float* sp = scr + (kc * 8) * S + n;
            u32x4 o; o.x = cvtpk(sp[0], sp[S]); o.y = cvtpk(sp[2 * S], sp[3 * S]); o.z = cvtpk(sp[4 * S], sp[5 * S]); o.w = cvtpk(sp[6 * S], sp[7 * S]);
            *(u32x4*)(dst + (size_t)n * K + k0 + kc * 8) = o;
        }
        __syncthreads();
    }
}
__device__ __forceinline__ void prep_mod_unit(unsigned char* lds, const P& p, int u) {
    float* sc = (float*)lds;
    float* part = sc + 17 * 1024;
    const int tid = threadIdx.x;
    const float* c = p.in[1]; const float* cctx = p.in[3];
    for (int i = tid; i < 17 * 1024; i += NTHREADS) { const int r = i >> 10, k = i & 1023; const float v = r < 16 ? c[r * 1024 + k] : cctx[k]; sc[i] = v / (1.f + expf(-v)); }
    __syncthreads();
    const int L = u / 192, cg = u % 192, ks = tid >> 5, cl = tid & 31, col = cg * 32 + cl;
    const float* w = p.in[4] + (size_t)L * 1024 * 6144 + (size_t)(ks * 64) * 6144 + col;
    float acc[17];
#pragma unroll
    for (int r = 0; r < 17; ++r) acc[r] = 0.f;
#pragma unroll 8
    for (int k = 0; k < 64; ++k) {
        const float wv = w[(size_t)k * 6144];
#pragma unroll
        for (int r = 0; r < 17; ++r) acc[r] += sc[r * 1024 + ks * 64 + k] * wv;
    }
#pragma unroll
    for (int r = 0; r < 17; ++r) part[(ks * 17 + r) * 32 + cl] = acc[r];
    __syncthreads();
    float* modv = (float*)(p.ws + WS_MODV);
    for (int i = tid; i < 17 * 32; i += NTHREADS) {
        const int r = i >> 5, c2 = i & 31;
        float s2 = p.in[5][L * 6144 + cg * 32 + c2];
#pragma unroll
        for (int q = 0; q < 16; ++q) s2 += part[(q * 17 + r) * 32 + c2];
        modv[((size_t)L * 17 + r) * 6144 + cg * 32 + c2] = s2;
    }
    __syncthreads();
}
__device__ __forceinline__ void phase_prep(unsigned char* lds, const P& p) {
    const int tid = threadIdx.x, G = gridDim.x, bid = blockIdx.x;
    {
        float* ct = (float*)(p.ws + WS_ROPE); float* st = ct + 2048 * 16;
        for (int i = bid * NTHREADS + tid; i < 2048 * 16; i += G * NTHREADS) {
            const int pos = i >> 4, f = i & 15;
            const float inv = powf(10000.f, -(float)(f & 7) / 8.f);
            const float ang = (float)(f < 8 ? (pos >> 6) : (pos & 63)) * inv;
            ct[i] = cosf(ang); st[i] = sinf(ang);
        }
    }
    for (int u = G - 1 - bid; u < 384; u += G) prep_mod_unit(lds, p, u);
    float* scr = (float*)lds; int rot = 0;
    for (int L = 0; L < 2; ++L) {
        transpose_matrix<0>(scr, p.in[7] + (size_t)L * D * Z_END, nullptr, Z_END, Z_END, nullptr, 1.f, D, ZC, (bf16_t*)(p.ws + WS_WIN) + (size_t)L * ZC * D, rot);
        transpose_matrix<1>(scr, p.in[15] + (size_t)L * 256 * 768, nullptr, 768, 768, p.in[14] + L * 256, 0.14724574f, 256, 768, (bf16_t*)(p.ws + WS_WUQ) + (size_t)L * 768 * 256, rot);
        transpose_matrix<0>(scr, p.in[17] + (size_t)L * 128 * 1024, nullptr, 1024, 1024, p.in[16] + L * 128, 1.f, 256, 1024, (bf16_t*)(p.ws + WS_WUKV) + (size_t)L * 1024 * 256, rot, 128);
        transpose_matrix<0>(scr, p.in[18] + (size_t)L * D * D, nullptr, D, D, nullptr, 1.f, D, D, (bf16_t*)(p.ws + WS_WOUT) + (size_t)L * D * D, rot);
        transpose_matrix<0>(scr, p.in[20] + (size_t)L * D * NEXP, nullptr, NEXP, NEXP, nullptr, 1.f, D, 128, (bf16_t*)(p.ws + WS_RT) + (size_t)L * 128 * D, rot);
        transpose_matrix<2>(scr, p.in[25] + (size_t)L * D * EDIM, p.in[26] + (size_t)L * D * EDIM, EDIM, 512, nullptr, 1.f, D, 512, (bf16_t*)(p.ws + WS_SHGU) + (size_t)L * 512 * D, rot);
        transpose_matrix<0>(scr, p.in[27] + (size_t)L * EDIM * D, nullptr, D, D, nullptr, 1.f, EDIM, D, (bf16_t*)(p.ws + WS_SHD) + (size_t)L * D * EDIM, rot);
    }
}

__device__ __forceinline__ void phase_norm_mod(const P& p, int L, int which  , int ntok) {
    const int tid = threadIdx.x, lane = tid & 63, wave = tid >> 6, gw = blockIdx.x * NWAVES + wave, NGW = gridDim.x * NWAVES;
    const float* nw = (which == 0 ? p.in[6] : p.in[19]) + L * D;
    const float* modv = (const float*)(p.ws + WS_MODV) + (size_t)L * 17 * 6144;
    bf16_t* H = (bf16_t*)(p.ws + WS_H);
    for (int tok = gw; tok < ntok; tok += NGW) {
        const f32x4* xr = (const f32x4*)x_in_row(p, tok) + lane;
        const float* mrow = modv + (size_t)mod_row(tok) * 6144 + which * 3072;
        f32x4 v[4]; float s = 0.f;
#pragma unroll
        for (int j = 0; j < 4; ++j) { v[j] = xr[64 * j]; s += v[j].x * v[j].x + v[j].y * v[j].y + v[j].z * v[j].z + v[j].w * v[j].w; }
        const float rstd = rsqrtf(wave_sum(s) * (1.f / D) + NORM_EPS);
        u32x2* o = (u32x2*)(H + (size_t)tok * D) + lane;
#pragma unroll
        for (int j = 0; j < 4; ++j) {
            const int k = 4 * lane + 256 * j;
            const f32x4 w4 = *(const f32x4*)(nw + k), sh = *(const f32x4*)(mrow + k), sc = *(const f32x4*)(mrow + 1024 + k);
            const float y0 = v[j].x * rstd * w4.x * (1.f + sc.x) + sh.x, y1 = v[j].y * rstd * w4.y * (1.f + sc.y) + sh.y;
            const float y2 = v[j].z * rstd * w4.z * (1.f + sc.z) + sh.z, y3 = v[j].w * rstd * w4.w * (1.f + sc.w) + sh.w;
            u32x2 w; w.x = pk2(y0, y1); w.y = pk2(y2, y3); o[64 * j] = w;
        }
    }
}

struct EpiZ {
    bf16_t* Z; float* ssq; float* sskv; bf16_t* Kb; const float* ct; const float* st;
    __device__ __forceinline__ void operator()(const ge::Acc& acc, const ge::Unit& u, int wr, int wc, int fr, int fq) const {
#pragma unroll
        for (int ai = 0; ai < 2; ++ai)
#pragma unroll
            for (int m = 0; m < 4; ++m) {
                const int row = u.a * 256 + ai * 128 + wr * 64 + m * 16 + fr;
#pragma unroll
                for (int bj = 0; bj < 2; ++bj) {
                    const f32x4 v0 = acc[ai][bj][m][0], v1 = acc[ai][bj][m][1];
                    u32x4 w; w.x = cvtpk(v0.x, v0.y); w.y = cvtpk(v0.z, v0.w); w.z = cvtpk(v1.x, v1.y); w.w = cvtpk(v1.z, v1.w);
                    *(u32x4*)(Z + (size_t)row * ZC + u.b * 256 + bj * 128 + wc * 32 + 8 * fq) = w;
                }
                if (u.b == 5) {
                    float sq = 0.f;
#pragma unroll
                    for (int bj = 0; bj < 2; ++bj)
#pragma unroll
                        for (int n = 0; n < 2; ++n) { const f32x4 v = acc[ai][bj][m][n]; sq += v.x * v.x + v.y * v.y + v.z * v.z + v.w * v.w; }
                    sq += __shfl_xor(sq, 16); sq += __shfl_xor(sq, 32);
                    if (fq == 0) ssq[(size_t)row * 4 + wc] = sq;
                }
                if (u.b == 6) {
                    float sq = 0.f;
#pragma unroll
                    for (int n = 0; n < 2; ++n) { const f32x4 v = acc[ai][0][m][n]; sq += v.x * v.x + v.y * v.y + v.z * v.z + v.w * v.w; }
                    sq += __shfl_xor(sq, 16); sq += __shfl_xor(sq, 32);
                    if (fq == 0) sskv[(size_t)row * 4 + wc] = sq;
                    if (wc == 0) {
                        const f32x4 a0 = acc[ai][1][m][0], a1 = acc[ai][1][m][1];
                        f32x4 b0, b1;
#pragma unroll
                        for (int j = 0; j < 4; ++j) { b0[j] = __shfl_xor(a0[j], 32); b1[j] = __shfl_xor(a1[j], 32); }
                        if (fq < 2) {
                            f32x4 c0 = (f32x4){1.f, 1.f, 1.f, 1.f}, c1 = c0, s0 = (f32x4){0.f, 0.f, 0.f, 0.f}, s1 = s0;
                            if (row < NLAT) { const int pos = row & (SEQ - 1); c0 = *(const f32x4*)(ct + pos * 16 + 8 * fq); c1 = *(const f32x4*)(ct + pos * 16 + 8 * fq + 4); s0 = *(const f32x4*)(st + pos * 16 + 8 * fq); s1 = *(const f32x4*)(st + pos * 16 + 8 * fq + 4); }
                            const f32x4 o10 = a0 * c0 - b0 * s0, o20 = a0 * s0 + b0 * c0, o11 = a1 * c1 - b1 * s1, o21 = a1 * s1 + b1 * c1;
                            u32x4 w0, w1; w0.x = cvtpk(o10.x, o20.x); w0.y = cvtpk(o10.y, o20.y); w0.z = cvtpk(o10.z, o20.z); w0.w = cvtpk(o10.w, o20.w);
                            w1.x = cvtpk(o11.x, o21.x); w1.y = cvtpk(o11.y, o21.y); w1.z = cvtpk(o11.z, o21.z); w1.w = cvtpk(o11.w, o21.w);
#pragma unroll
                            for (int h = 0; h < 8; ++h) { bf16_t* kp = Kb + (size_t)row * 768 + h * 96 + 64 + 16 * fq; *(u32x4*)kp = w0; *(u32x4*)(kp + 8) = w1; }
                        }
                    }
                }
            }
    }
};
__device__ __forceinline__ void phase_zgemm(unsigned char* lds, const P& p, int L) {
    const bf16_t* W = (const bf16_t*)(p.ws + WS_WIN) + (size_t)L * ZC * D;
    ge::DenseOrder S; S.nM = NTOK / 256; S.nN = ZC / 256; S.nwg = S.nM * S.nN; S.G = gridDim.x; S.c = blockIdx.x; S.Bt = (const char*)W; S.btile = (size_t)256 * D * 2; S.arow = D * 2;
    EpiZ E{(bf16_t*)(p.ws + WS_Z), (float*)(p.ws + WS_SS), (float*)(p.ws + WS_SS) + (size_t)NTOK * 4, (bf16_t*)(p.ws + WS_K), (const float*)(p.ws + WS_ROPE), (const float*)(p.ws + WS_ROPE) + 2048 * 16};
    ge::gemm_stream<ge::DenseOrder, EpiZ, true>((LAS unsigned char*)lds, (const char*)(p.ws + (L == 0 ? WS_H : WS_H1)), D, S, E);
}

__device__ __forceinline__ void conv_unit(unsigned char* lds, const P& p, int L, int s, int tt) {
    float* hg = (float*)lds;
    const int tid = threadIdx.x, lane = tid & 63, wave = tid >> 6;
    const int rb = s < 16 ? s * SEQ : NLAT + (s - 16) * CTXL, len = s < 16 ? SEQ : CTXL, t0 = tt * 64;
    const bf16_t* Z = (const bf16_t*)(p.ws + WS_Z);
    for (int i = tid; i < 94 * 64; i += NTHREADS) {
        const int jj = i >> 6, c4 = (i & 63) * 4, t = t0 - 15 + jj;
        f32x4 h = (f32x4){0.f, 0.f, 0.f, 0.f};
        if (t >= 0 && t < len) {
            const bf16_t* zr = Z + (size_t)(rb + t) * ZC;
            const u32x2 a = *(const u32x2*)(zr + c4), g = *(const u32x2*)(zr + 256 + c4);
            const float g0 = lo16(g.x), g1 = hi16(g.x), g2 = lo16(g.y), g3 = hi16(g.y);
            h.x = lo16(a.x) / (1.f + __expf(-g0)); h.y = hi16(a.x) / (1.f + __expf(-g1));
            h.z = lo16(a.y) / (1.f + __expf(-g2)); h.w = hi16(a.y) / (1.f + __expf(-g3));
        }
        *(f32x4*)(hg + jj * 256 + c4) = h;
    }
    float* wl = hg + 94 * 256;
    for (int i = tid; i < 31 * 64; i += NTHREADS) *(f32x4*)(wl + i * 4) = *(const f32x4*)(p.in[8] + (size_t)L * 31 * 256 + i * 4);
    __syncthreads();
    const int c0 = lane * 4;
    const f32x4 cb = *(const f32x4*)(p.in[9] + L * 256 + c0), lw = *(const f32x4*)(p.in[10] + L * 256 + c0), lb = *(const f32x4*)(p.in[11] + L * 256 + c0);
    bf16_t* CC = (bf16_t*)(p.ws + WS_CC);
    for (int q = 0; q < 8; ++q) {
        const int tl = wave * 8 + q;
        f32x4 acc = cb;
#pragma unroll 4
        for (int j = 0; j < 31; ++j) { const f32x4 h = *(const f32x4*)(hg + (tl + j) * 256 + c0); acc += h * *(const f32x4*)(wl + j * 256 + c0); }
        const float mean = wave_sum(acc.x + acc.y + acc.z + acc.w) * (1.f / 256.f);
        const f32x4 d = acc - mean;
        const float var = wave_sum(d.x * d.x + d.y * d.y + d.z * d.z + d.w * d.w) * (1.f / 256.f);
        const float rstd = rsqrtf(var + NORM_EPS);
        const f32x4 y = d * rstd * lw + lb;
        u32x2 o; o.x = pk2(siluf(y.x), siluf(y.y)); o.y = pk2(siluf(y.z), siluf(y.w));
        *(u32x2*)(CC + (size_t)(rb + t0 + tl) * D + c0) = o;
    }
    __syncthreads();
}

__device__ __forceinline__ float log2_gamma(const P& p, int L, int dir, int h) {
    const float x = p.in[12][(L * 2 + dir) * 4 + h];
    const float ls = fminf(x, 0.f) - log1pf(expf(-fabsf(x)));
    return ls * 1.4426950408889634f;
}
__device__ __forceinline__ void load_ret_qk(float* dst, const P& p, int gc, int h, int zoff, float scale) {
    const int tid = threadIdx.x, j = tid >> 2, i0 = (tid & 3) * 4, row = gc * 128 + j;
    const bf16_t* zr = (const bf16_t*)(p.ws + WS_Z) + (size_t)row * ZC + zoff + h * 32;
    const u32x2 a = *(const u32x2*)(zr + i0), b = *(const u32x2*)(zr + 16 + i0);
    float x1[4] = {lo16(a.x), hi16(a.x), lo16(a.y), hi16(a.y)}, x2[4] = {lo16(b.x), hi16(b.x), lo16(b.y), hi16(b.y)};
    const bool lat = row < NLAT; const int pos = row & (SEQ - 1);
    const float* ct = (const float*)(p.ws + WS_ROPE) + pos * 16 + i0; const float* st = ct + 2048 * 16;
#pragma unroll
    for (int i = 0; i < 4; ++i) {
        const float c = lat ? ct[i] : 1.f, s = lat ? st[i] : 0.f;
        dst[j * 33 + i0 + i] = (x1[i] * c - x2[i] * s) * scale;
        dst[j * 33 + 16 + i0 + i] = (x1[i] * s + x2[i] * c) * scale;
    }
}
__device__ __forceinline__ void load_ret_v(float* dst  , const P& p, int gc, int h) {
    const int tid = threadIdx.x, j = tid >> 2, e0 = (tid & 3) * 16;
    const bf16_t* zr = (const bf16_t*)(p.ws + WS_Z) + (size_t)(gc * 128 + j) * ZC + Z_RV + h * 64 + e0;
    const u32x4 a = *(const u32x4*)zr, b = *(const u32x4*)(zr + 8);
#pragma unroll
    for (int i = 0; i < 4; ++i) { dst[j * 64 + e0 + 2 * i] = lo16(a[i]); dst[j * 64 + e0 + 2 * i + 1] = hi16(a[i]); dst[j * 64 + e0 + 8 + 2 * i] = lo16(b[i]); dst[j * 64 + e0 + 8 + 2 * i + 1] = hi16(b[i]); }
}
__device__ __forceinline__ void retkv_unit(unsigned char* lds, const P& p, int L, int gc, int h) {
    float* ks = (float*)lds; float* vs = ks + 128 * 33; float* wf = vs + 128 * 64; float* wb = wf + 128;
    const int tid = threadIdx.x;
    const float l2f = log2_gamma(p, L, 0, h), l2b = log2_gamma(p, L, 1, h);
    load_ret_qk(ks, p, gc, h, Z_RK, 0.17677669529663687f);
    load_ret_v(vs, p, gc, h);
    if (tid < 128) { wf[tid] = exp2f(l2f * (float)(127 - tid)); wb[tid] = exp2f(l2b * (float)tid); }
    __syncthreads();
    const int d = tid >> 4, e0 = (tid & 15) * 4;
    f32x4 af = (f32x4){0.f, 0.f, 0.f, 0.f}, ab = af;
    for (int j = 0; j < 128; ++j) {
        const float kd = ks[j * 33 + d]; const f32x4 v4 = *(const f32x4*)(vs + j * 64 + e0);
        af += (kd * wf[j]) * v4; ab += (kd * wb[j]) * v4;
    }
    float* KV = (float*)(p.ws + WS_KV) + ((size_t)(gc * 4 + h) * 2) * 2048;
    *(f32x4*)(KV + d * 64 + e0) = af; *(f32x4*)(KV + 2048 + d * 64 + e0) = ab;
    __syncthreads();
}
__device__ __forceinline__ void ret_stage_k(unsigned char* kf, unsigned char* kb, int rowb, const P& p, int gc, int h, float ef, float jf0, float eb, float jb0) {
    const int tid = threadIdx.x, j = tid >> 2, i0 = (tid & 3) * 4, row = gc * 128 + j;
    const bf16_t* zr = (const bf16_t*)(p.ws + WS_Z) + (size_t)row * ZC + Z_RK + h * 32;
    const u32x2 a = *(const u32x2*)(zr + i0), b = *(const u32x2*)(zr + 16 + i0);
    const float x1[4] = {lo16(a.x), hi16(a.x), lo16(a.y), hi16(a.y)}, x2[4] = {lo16(b.x), hi16(b.x), lo16(b.y), hi16(b.y)};
    f32x4 c4 = (f32x4){1.f, 1.f, 1.f, 1.f}, s4 = (f32x4){0.f, 0.f, 0.f, 0.f};
    if (row < NLAT) { const int pos = row & (SEQ - 1); const float* ct = (const float*)(p.ws + WS_ROPE) + pos * 16 + i0; c4 = *(const f32x4*)ct; s4 = *(const f32x4*)(ct + 2048 * 16); }
    const float wf = exp2f(ef * ((float)j - jf0)) * 0.17677669529663687f, wb = exp2f(eb * ((float)j - jb0)) * 0.17677669529663687f;
    float o1[4], o2[4];
#pragma unroll
    for (int i = 0; i < 4; ++i) { o1[i] = x1[i] * c4[i] - x2[i] * s4[i]; o2[i] = x1[i] * s4[i] + x2[i] * c4[i]; }
    u32x2 w;
    w.x = cvtpk(o1[0] * wf, o1[1] * wf); w.y = cvtpk(o1[2] * wf, o1[3] * wf); *(u32x2*)(kf + j * rowb + i0 * 2) = w;
    w.x = cvtpk(o2[0] * wf, o2[1] * wf); w.y = cvtpk(o2[2] * wf, o2[3] * wf); *(u32x2*)(kf + j * rowb + 32 + i0 * 2) = w;
    w.x = cvtpk(o1[0] * wb, o1[1] * wb); w.y = cvtpk(o1[2] * wb, o1[3] * wb); *(u32x2*)(kb + j * rowb + i0 * 2) = w;
    w.x = cvtpk(o2[0] * wb, o2[1] * wb); w.y = cvtpk(o2[2] * wb, o2[3] * wb); *(u32x2*)(kb + j * rowb + 32 + i0 * 2) = w;
}
__device__ __forceinline__ void ret_stage_v(unsigned char* vt, const P& p, int gc, int h) {
    const int tid = threadIdx.x, j = tid >> 2, e0 = (tid & 3) * 16;
    const bf16_t* zr = (const bf16_t*)(p.ws + WS_Z) + (size_t)(gc * 128 + j) * ZC + Z_RV + h * 64 + e0;
    const u32x4 a = *(const u32x4*)zr, b = *(const u32x4*)(zr + 8);
    unsigned char* d = vt + (e0 >> 5) * 8192 + j * 64 + (e0 & 31) * 2;
    *(u32x4*)d = a; *(u32x4*)(d + 16) = b;
}
__device__ __forceinline__ bf16x8 tr8(const unsigned char* p0, const unsigned char* p1) {
    const v4i16_t a = __builtin_amdgcn_ds_read_tr16_b64_v4i16((LAS v4i16_t*)(const LAS unsigned char*)p0), b = __builtin_amdgcn_ds_read_tr16_b64_v4i16((LAS v4i16_t*)(const LAS unsigned char*)p1);
    return (bf16x8){a[0], a[1], a[2], a[3], b[0], b[1], b[2], b[3]};
}
__device__ __forceinline__ void retkv_unit_mfma(unsigned char* lds, const P& p, int L, int gc, int h) {
    const int tid = threadIdx.x, lane = tid & 63, wid = tid >> 6;
    const float l2f = log2_gamma(p, L, 0, h), l2b = log2_gamma(p, L, 1, h);
    ret_stage_k(lds, lds + 8192, 64, p, gc, h, -l2f, 127.f, l2b, 0.f);
    ret_stage_v(lds + 16384, p, gc, h);
    __syncthreads();
    if (wid < 4) {
        const int dir = wid >> 1, eb = wid & 1, g = lane >> 4, i = lane & 15, hh = lane >> 5;
        const int off = (8 * hh + (i >> 2)) * 64 + (g & 1) * 32 + (i & 3) * 8;
        const unsigned char* Kt = lds + dir * 8192 + off; const unsigned char* Vt = lds + 16384 + eb * 8192 + off;
        f32x16 acc;
#pragma unroll
        for (int r = 0; r < 16; ++r) acc[r] = 0.f;
#pragma unroll
        for (int s = 0; s < 8; ++s) acc = __builtin_amdgcn_mfma_f32_32x32x16_bf16(tr8(Vt + s * 1024, Vt + s * 1024 + 256), tr8(Kt + s * 1024, Kt + s * 1024 + 256), acc, 0, 0, 0);
        float* KV = (float*)(p.ws + WS_KV) + ((size_t)(gc * 4 + h) * 2 + dir) * 2048 + (lane & 31) * 64 + eb * 32 + 4 * hh;
#pragma unroll
        for (int r4 = 0; r4 < 4; ++r4) *(f32x4*)(KV + 8 * r4) = (f32x4){acc[4 * r4], acc[4 * r4 + 1], acc[4 * r4 + 2], acc[4 * r4 + 3]};
    }
    __syncthreads();
}
__device__ __forceinline__ void retout_unit_mfma(unsigned char* lds, const P& p, int L, int gc, int h) {
    constexpr int KROW = 80, O_KF = 0, O_KB = 10240, O_V = 20480, O_SF = 36864, O_SB = 41984, O_RED = 47104;
    const int tid = threadIdx.x, lane = tid & 63, wid = tid >> 6, r32 = lane & 31, hh = lane >> 5;
    const float l2f = log2_gamma(p, L, 0, h), l2b = log2_gamma(p, L, 1, h);
    ret_stage_k(lds + O_KF, lds + O_KB, KROW, p, gc, h, -l2f, 0.f, l2b, 0.f);
    ret_stage_v(lds + O_V, p, gc, h);
    {
        const bool lat = gc < 256; const int b = lat ? gc >> 4 : (gc - 256) >> 1;
        const int mme = lat ? 2 + (gc & 15) : (gc - 256) & 1;
        const int u = mme, w = mme < 2 ? 1 - mme : 19 - mme;
        f32x4 sf = (f32x4){0.f, 0.f, 0.f, 0.f}, sb = sf;
        const float* KVb = (const float*)(p.ws + WS_KV);
#pragma unroll 1
        for (int mm = 0; mm < 18; ++mm) {
            const int gcm = mm < 2 ? 256 + b * 2 + mm : b * 16 + (mm - 2);
            const int um = mm, wm = mm < 2 ? 1 - mm : 19 - mm;
            const float* kv = KVb + ((size_t)(gcm * 4 + h) * 2) * 2048 + tid * 4;
            if (um < u) { const float wgt = exp2f(l2f * 128.f * (float)(u - 1 - um)); sf += wgt * *(const f32x4*)kv; }
            if (wm < w) { const float wgt = exp2f(l2b * 128.f * (float)(w - 1 - wm)); sb += wgt * *(const f32x4*)(kv + 2048); }
        }
        const int d = tid >> 4, e0 = (tid & 15) * 4;
#pragma unroll
        for (int k = 0; k < 4; ++k) { *(bf16_t*)(lds + O_SF + (e0 + k) * KROW + d * 2) = (bf16_t)(cvtpk(sf[k], 0.f) & 0xffffu); *(bf16_t*)(lds + O_SB + (e0 + k) * KROW + d * 2) = (bf16_t)(cvtpk(sb[k], 0.f) & 0xffffu); }
    }
    __syncthreads();
    const int qb = wid & 3, eb = wid >> 2, i = qb * 32 + r32, row = gc * 128 + i;
    bf16x8 qf[2];
    {
        const bf16_t* zr = (const bf16_t*)(p.ws + WS_Z) + (size_t)row * ZC + Z_RQ + h * 32 + 8 * hh;
        const u32x4 a = *(const u32x4*)zr, b = *(const u32x4*)(zr + 16);
        float x1[8], x2[8];
#pragma unroll
        for (int k = 0; k < 4; ++k) { x1[2 * k] = lo16(a[k]); x1[2 * k + 1] = hi16(a[k]); x2[2 * k] = lo16(b[k]); x2[2 * k + 1] = hi16(b[k]); }
        if (row < NLAT) {
            const float* ct = (const float*)(p.ws + WS_ROPE) + (row & (SEQ - 1)) * 16 + 8 * hh; const float* st = ct + 2048 * 16;
#pragma unroll
            for (int k = 0; k < 8; ++k) { const float c = ct[k], sn = st[k], u1 = x1[k], u2 = x2[k]; x1[k] = u1 * c - u2 * sn; x2[k] = u1 * sn + u2 * c; }
        }
        const u32x4 q0 = (u32x4){cvtpk(x1[0], x1[1]), cvtpk(x1[2], x1[3]), cvtpk(x1[4], x1[5]), cvtpk(x1[6], x1[7])};
        const u32x4 q1 = (u32x4){cvtpk(x2[0], x2[1]), cvtpk(x2[2], x2[3]), cvtpk(x2[4], x2[5]), cvtpk(x2[6], x2[7])};
        qf[0] = __builtin_bit_cast(bf16x8, q0); qf[1] = __builtin_bit_cast(bf16x8, q1);
    }
    const float af = exp2f(l2f * (float)i), ab = exp2f(-l2b * (float)i), cf = exp2f(l2f * (float)(i + 1)), cb = exp2f(l2b * (float)(128 - i));
    f32x16 y, zero;
#pragma unroll
    for (int r = 0; r < 16; ++r) { y[r] = 0.f; zero[r] = 0.f; }
    const int koff = r32 * KROW + 16 * hh;
    const int voff = O_V + eb * 8192 + (4 * hh + ((lane & 15) >> 2)) * 64 + ((lane >> 4) & 1) * 32 + (lane & 3) * 8;
#pragma unroll
    for (int kb = 0; kb < 4; ++kb) {
        f32x16 pt;
        if (kb <= qb) {
            f32x16 sF = __builtin_amdgcn_mfma_f32_32x32x16_bf16(*(const bf16x8*)(lds + O_KF + kb * 32 * KROW + koff), qf[0], zero, 0, 0, 0);
            sF = __builtin_amdgcn_mfma_f32_32x32x16_bf16(*(const bf16x8*)(lds + O_KF + kb * 32 * KROW + koff + 32), qf[1], sF, 0, 0, 0);
            if (kb < qb) {
#pragma unroll
                for (int r = 0; r < 16; ++r) pt[r] = sF[r] * af;
            } else {
#pragma unroll
                for (int r = 0; r < 16; ++r) { const int j = (r & 3) + 8 * (r >> 2) + 4 * hh; pt[r] = (j <= r32) ? sF[r] * af : 0.f; }
            }
        }
        if (kb >= qb) {
            f32x16 sB = __builtin_amdgcn_mfma_f32_32x32x16_bf16(*(const bf16x8*)(lds + O_KB + kb * 32 * KROW + koff), qf[0], zero, 0, 0, 0);
            sB = __builtin_amdgcn_mfma_f32_32x32x16_bf16(*(const bf16x8*)(lds + O_KB + kb * 32 * KROW + koff + 32), qf[1], sB, 0, 0, 0);
            if (kb > qb) {
#pragma unroll
                for (int r = 0; r < 16; ++r) pt[r] = sB[r] * ab;
            } else {
#pragma unroll
                for (int r = 0; r < 16; ++r) { const int j = (r & 3) + 8 * (r >> 2) + 4 * hh; pt[r] += (j >= r32) ? sB[r] * ab : 0.f; }
            }
        }
#pragma unroll
        for (int s2 = 0; s2 < 2; ++s2) {
            const u32x4 pw = (u32x4){cvtpk(pt[8 * s2], pt[8 * s2 + 1]), cvtpk(pt[8 * s2 + 2], pt[8 * s2 + 3]), cvtpk(pt[8 * s2 + 4], pt[8 * s2 + 5]), cvtpk(pt[8 * s2 + 6], pt[8 * s2 + 7])};
            const unsigned char* vb = lds + voff + (kb * 32 + s2 * 16) * 64;
            y = __builtin_amdgcn_mfma_f32_32x32x16_bf16(tr8(vb, vb + 8 * 64), __builtin_bit_cast(bf16x8, pw), y, 0, 0, 0);
        }
    }
    {
        const int soff = (eb * 32 + r32) * KROW + 16 * hh;
        f32x16 tF = __builtin_amdgcn_mfma_f32_32x32x16_bf16(*(const bf16x8*)(lds + O_SF + soff), qf[0], zero, 0, 0, 0);
        tF = __builtin_amdgcn_mfma_f32_32x32x16_bf16(*(const bf16x8*)(lds + O_SF + soff + 32), qf[1], tF, 0, 0, 0);
        f32x16 tB = __builtin_amdgcn_mfma_f32_32x32x16_bf16(*(const bf16x8*)(lds + O_SB + soff), qf[0], zero, 0, 0, 0);
        tB = __builtin_amdgcn_mfma_f32_32x32x16_bf16(*(const bf16x8*)(lds + O_SB + soff + 32), qf[1], tB, 0, 0, 0);
#pragma unroll
        for (int r = 0; r < 16; ++r) y[r] += tF[r] * cf + tB[r] * cb;
    }
    float s1 = 0.f, s2 = 0.f;
#pragma unroll
    for (int r = 0; r < 16; ++r) { s1 += y[r]; s2 += y[r] * y[r]; }
    s1 += __shfl_xor(s1, 32); s2 += __shfl_xor(s2, 32);
    float* red = (float*)(lds + O_RED);
    if (hh == 0) { red[(eb * 128 + i) * 2] = s1; red[(eb * 128 + i) * 2 + 1] = s2; }
    __syncthreads();
    s1 = red[i * 2] + red[(128 + i) * 2]; s2 = red[i * 2 + 1] + red[(128 + i) * 2 + 1];
    const float mu = s1 * (1.f / 64.f), var = fmaxf(s2 * (1.f / 64.f) - mu * mu, 0.f), rstd = rsqrtf(var + NORM_EPS);
    const bf16_t* zg = (const bf16_t*)(p.ws + WS_Z) + (size_t)row * ZC + Z_RG + h * 64 + eb * 32 + 4 * hh;
    const float* gw = p.in[13] + L * 256 + h * 64 + eb * 32 + 4 * hh;
    bf16_t* orow = (bf16_t*)(p.ws + WS_CC) + (size_t)row * D + 256 + h * 64 + eb * 32 + 4 * hh;
#pragma unroll
    for (int r4 = 0; r4 < 4; ++r4) {
        const u32x2 gz = *(const u32x2*)(zg + 8 * r4); const f32x4 w4 = *(const f32x4*)(gw + 8 * r4);
        const float g0 = lo16(gz.x), g1 = hi16(gz.x), g2 = lo16(gz.y), g3 = hi16(gz.y);
        u32x2 o; o.x = cvtpk(siluf(g0) * ((y[4 * r4] - mu) * rstd * w4.x), siluf(g1) * ((y[4 * r4 + 1] - mu) * rstd * w4.y));
        o.y = cvtpk(siluf(g2) * ((y[4 * r4 + 2] - mu) * rstd * w4.z), siluf(g3) * ((y[4 * r4 + 3] - mu) * rstd * w4.w));
        *(u32x2*)(orow + 8 * r4) = o;
    }
    __syncthreads();
}
__device__ __forceinline__ void qkv_proj(unsigned char* lds, const P& p, int L) {
    const float* sskv = (const float*)(p.ws + WS_SS) + (size_t)NTOK * 4;
    const int G = gridDim.x, bid = blockIdx.x;
    {
        bf16_t* Q = (bf16_t*)(p.ws + WS_Q);
        ge::DenseOrder S; S.nM = NTOK / 256; S.nN = 3; S.nwg = S.nM * 3; S.G = G; S.c = bid; S.Bt = (const char*)((const bf16_t*)(p.ws + WS_WUQ) + (size_t)L * 768 * 256); S.btile = (size_t)256 * 256 * 2; S.arow = ZC * 2;
        auto f = [&](const ge::Unit& u, int r, int c, f32x4 v0, f32x4 v1) {
            u32x4 w; w.x = cvtpk(v0.x, v0.y); w.y = cvtpk(v0.z, v0.w); w.z = cvtpk(v1.x, v1.y); w.w = cvtpk(v1.z, v1.w); *(u32x4*)(Q + (size_t)(u.a * 256 + r) * 768 + u.b * 256 + c) = w;
        };
        ge::EpiFn<decltype(f)> E{f};
        ge::gemm_stream<ge::DenseOrder, ge::EpiFn<decltype(f)>, true>((LAS unsigned char*)lds, (const char*)(p.ws + WS_Z) + Z_CQ * 2, 256, S, E);
    }
    {
        bf16_t* Kb = (bf16_t*)(p.ws + WS_K); bf16_t* Vb = (bf16_t*)(p.ws + WS_V);
        ge::DenseOrder S; S.nM = NTOK / 256; S.nN = 4; S.nwg = S.nM * 4; S.G = G; S.c = (bid + 176) % G; S.Bt = (const char*)((const bf16_t*)(p.ws + WS_WUKV) + (size_t)L * 1024 * 256); S.btile = (size_t)256 * 256 * 2; S.arow = ZC * 2;
        struct EpiKV {
            bf16_t* Kb; bf16_t* Vb; const float* sskv;
            __device__ __forceinline__ void operator()(const ge::Acc& acc, const ge::Unit& u, int wr, int wc, int fr, int fq) const {
                float rstd[2][4];
#pragma unroll
                for (int ai = 0; ai < 2; ++ai)
#pragma unroll
                    for (int m = 0; m < 4; ++m) { const f32x4 s4 = *(const f32x4*)(sskv + (size_t)(u.a * 256 + ai * 128 + wr * 64 + m * 16 + fr) * 4); rstd[ai][m] = rsqrtf((s4.x + s4.y + s4.z + s4.w) * (1.f / 128.f) + NORM_EPS); }
#pragma unroll
                for (int ai = 0; ai < 2; ++ai)
#pragma unroll
                    for (int m = 0; m < 4; ++m) {
                        const int row = u.a * 256 + ai * 128 + wr * 64 + m * 16 + fr;
#pragma unroll
                        for (int bj = 0; bj < 2; ++bj) {
                            const int col = u.b * 256 + bj * 128 + wc * 32 + 8 * fq, h = col >> 7, j = col & 127;
                            const f32x4 v0 = acc[ai][bj][m][0] * rstd[ai][m], v1 = acc[ai][bj][m][1] * rstd[ai][m];
                            u32x4 w; w.x = cvtpk(v0.x, v0.y); w.y = cvtpk(v0.z, v0.w); w.z = cvtpk(v1.x, v1.y); w.w = cvtpk(v1.z, v1.w);
                            if (j < 64) *(u32x4*)(Kb + (size_t)row * 768 + h * 96 + j) = w;
                            else *(u32x4*)(Vb + (size_t)row * 512 + h * 64 + (j - 64)) = w;
                        }
                    }
            }
        };
        EpiKV E{Kb, Vb, sskv};
        ge::gemm_stream<ge::DenseOrder, EpiKV, true>((LAS unsigned char*)lds, (const char*)(p.ws + WS_Z) + Z_CKV * 2, 256, S, E);
    }
}
__device__ __forceinline__ void phase_b(unsigned char* lds, const P& p, int L) {
    const int G = gridDim.x, bid = blockIdx.x;
    qkv_proj(lds, p, L);
    const int nconv = (L == 0) ? 576 : 512;
    const int nkv = 288 * 4;
    const int total = nconv + nkv;
    for (int u = (bid + 96) % G; u < total; u += G) {
        int r = u;
        if (r < nconv) { if (r < 512) conv_unit(lds, p, L, r >> 5, r & 31); else conv_unit(lds, p, L, 16 + ((r - 512) >> 2), (r - 512) & 3); continue; } r -= nconv;
        retkv_unit_mfma(lds, p, L, r >> 2, r & 3);
    }
    if (L == 1) convert_expert_weights(lds, p, 1);
}

__device__ __forceinline__ void attn_unit_naive(unsigned char* lds, const P& p, int b, int h, int qb, bool ctxq) {
    float* Ks = (float*)lds;
    float* Vs = Ks + 64 * 96;
    const int tid = threadIdx.x, half = tid & 1, qi = tid >> 1;
    const bf16_t* Qb = (const bf16_t*)(p.ws + WS_Q); const bf16_t* Kb = (const bf16_t*)(p.ws + WS_K); const bf16_t* Vb = (const bf16_t*)(p.ws + WS_V);
    const int qrow = ctxq ? NLAT + b * CTXL + qi : b * SEQ + qb * 256 + qi;
    float q[48];
    {
        const u32x4* qp = (const u32x4*)(Qb + (size_t)qrow * 768 + h * 96 + half * 48);
#pragma unroll
        for (int i = 0; i < 6; ++i) { const u32x4 w = qp[i];
#pragma unroll
            for (int k = 0; k < 4; ++k) { q[i * 8 + 2 * k] = lo16(w[k]); q[i * 8 + 2 * k + 1] = hi16(w[k]); } }
    }
    float o[32];
#pragma unroll
    for (int e = 0; e < 32; ++e) o[e] = 0.f;
    float m = -1e30f, l = 0.f;
    const int ntiles = ctxq ? 4 : 36;
#pragma unroll 1
    for (int t = 0; t < ntiles; ++t) {
        const int krow0 = t < 4 ? NLAT + b * CTXL + t * 64 : b * SEQ + (t - 4) * 64;
        __syncthreads();
        for (int i = tid; i < 64 * 12; i += NTHREADS) { const int key = i / 12, c = i % 12; const u32x4 w = *(const u32x4*)(Kb + (size_t)(krow0 + key) * 768 + h * 96 + c * 8);
            float* d = Ks + key * 96 + c * 8;
#pragma unroll
            for (int k = 0; k < 4; ++k) { d[2 * k] = lo16(w[k]); d[2 * k + 1] = hi16(w[k]); } }
        for (int i = tid; i < 64 * 8; i += NTHREADS) { const int key = i >> 3, c = i & 7; const u32x4 w = *(const u32x4*)(Vb + (size_t)(krow0 + key) * 512 + h * 64 + c * 8);
            float* d = Vs + key * 64 + c * 8;
#pragma unroll
            for (int k = 0; k < 4; ++k) { d[2 * k] = lo16(w[k]); d[2 * k + 1] = hi16(w[k]); } }
        __syncthreads();
#pragma unroll 1
        for (int j0 = 0; j0 < 64; j0 += 2) {
            float s[2]; float mt = -1e30f;
#pragma unroll
            for (int jj = 0; jj < 2; ++jj) {
                const f32x4* kr = (const f32x4*)(Ks + (j0 + jj) * 96 + half * 48);
                float a = 0.f;
#pragma unroll
                for (int d4 = 0; d4 < 12; ++d4) { const f32x4 kv = kr[d4]; a += q[4 * d4] * kv.x + q[4 * d4 + 1] * kv.y + q[4 * d4 + 2] * kv.z + q[4 * d4 + 3] * kv.w; }
                a += __shfl_xor(a, 1);
                s[jj] = a; mt = fmaxf(mt, a);
            }
            const float mn = fmaxf(m, mt), alpha = exp2f(m - mn);
            m = mn; l *= alpha;
#pragma unroll
            for (int e = 0; e < 32; ++e) o[e] *= alpha;
#pragma unroll
            for (int jj = 0; jj < 2; ++jj) {
                const float pj = exp2f(s[jj] - mn); l += pj;
                const f32x4* vr = (const f32x4*)(Vs + (j0 + jj) * 64 + half * 32);
#pragma unroll
                for (int e4 = 0; e4 < 8; ++e4) { const f32x4 vv = vr[e4]; o[4 * e4] += pj * vv.x; o[4 * e4 + 1] += pj * vv.y; o[4 * e4 + 2] += pj * vv.z; o[4 * e4 + 3] += pj * vv.w; }
            }
        }
    }
    {
        const float rl = 1.f / l;
        u32x4* op = (u32x4*)((bf16_t*)(p.ws + WS_CC) + (size_t)qrow * D + 512 + h * 64 + half * 32);
#pragma unroll
        for (int i = 0; i < 4; ++i) { u32x4 w; w.x = pk2(o[8 * i] * rl, o[8 * i + 1] * rl); w.y = pk2(o[8 * i + 2] * rl, o[8 * i + 3] * rl); w.z = pk2(o[8 * i + 4] * rl, o[8 * i + 5] * rl); w.w = pk2(o[8 * i + 6] * rl, o[8 * i + 7] * rl); op[i] = w; }
    }
    __syncthreads();
}
__device__ __forceinline__ float max3f(float a, float b, float c) { float r; asm("v_max3_f32 %0, %1, %2, %3" : "=v"(r) : "v"(a), "v"(b), "v"(c)); return r; }
constexpr int AT_KROW = 208;
constexpr int AT_KBUF = 64 * AT_KROW;
constexpr int AT_VBUF = 8192;
constexpr int AT_BUF = AT_KBUF + AT_VBUF;
__device__ __forceinline__ void attn_unit_mfma(unsigned char* lds, const P& p, int b, int h, int qb, bool ctxq) {
    const int tid = threadIdx.x, lane = tid & 63, wid = tid >> 6, r32 = lane & 31, hh = lane >> 5;
    const bf16_t* Qb = (const bf16_t*)(p.ws + WS_Q); const bf16_t* Kb = (const bf16_t*)(p.ws + WS_K); const bf16_t* Vb = (const bf16_t*)(p.ws + WS_V);
    const int qrow = (ctxq ? NLAT + b * CTXL : b * SEQ + qb * 256) + wid * 32 + r32;
    bf16x8 qf[6];
    {
        const f32x4 s4 = *(const f32x4*)((const float*)(p.ws + WS_SS) + (size_t)qrow * 4);
        const float rstd = rsqrtf((s4.x + s4.y + s4.z + s4.w) * (1.f / 256.f) + NORM_EPS);
        const float* ct = (const float*)(p.ws + WS_ROPE) + (qrow & (SEQ - 1)) * 16; const float* st = ct + 2048 * 16;
#pragma unroll
        for (int s = 0; s < 6; ++s) {
            const u32x4 w = *(const u32x4*)(Qb + (size_t)qrow * 768 + h * 96 + 16 * s + 8 * hh);
            float x[8];
#pragma unroll
            for (int k = 0; k < 4; ++k) { x[2 * k] = lo16(w[k]) * rstd; x[2 * k + 1] = hi16(w[k]) * rstd; }
            if (s >= 4 && !ctxq) {
                const f32x4 c4 = *(const f32x4*)(ct + 8 * (s - 4) + 4 * hh), sn = *(const f32x4*)(st + 8 * (s - 4) + 4 * hh);
#pragma unroll
                for (int k = 0; k < 4; ++k) { const float a = x[2 * k], b2 = x[2 * k + 1]; x[2 * k] = a * c4[k] - b2 * sn[k]; x[2 * k + 1] = a * sn[k] + b2 * c4[k]; }
            }
            const u32x4 o = (u32x4){cvtpk(x[0], x[1]), cvtpk(x[2], x[3]), cvtpk(x[4], x[5]), cvtpk(x[6], x[7])};
            qf[s] = __builtin_bit_cast(bf16x8, o);
        }
    }
    f32x16 o0, o1, negm;
#pragma unroll
    for (int r = 0; r < 16; ++r) { o0[r] = 0.f; o1[r] = 0.f; negm[r] = 0.f; }
    asm volatile("" : "+v"(negm));
    float mhat = 0.f, l = 0.f;
    const int ntiles = ctxq ? 4 : 36;
    const int wv = __builtin_amdgcn_readfirstlane(wid);
    const int ia = wv, ib = (wv + 8 < 13) ? wv + 8 : 12;
    const int qa = ia * 64 + lane, qb2 = ib * 64 + lane, qv = wv * 64 + lane;
    const int ca = qa % 13, cb = qb2 % 13;
    const size_t ka = (size_t)(qa / 13) * 768 + h * 96 + (ca < 12 ? ca : 11) * 8, kbo = (size_t)(qb2 / 13) * 768 + h * 96 + (cb < 12 ? cb : 11) * 8;
    const size_t vo = (size_t)((qv >> 2) & 63) * 512 + h * 64 + (qv >> 8) * 32 + (qv & 3) * 8;
    auto krow0 = [&](int t) { return t < 4 ? NLAT + b * CTXL + t * 64 : b * SEQ + (t - 4) * 64; };
    const unsigned lds0 = (unsigned)(uintptr_t)lds;
#define AT_GLDS(gp, ldsoff) do { unsigned keep_; asm volatile("s_mov_b32 %0, m0\n\ts_mov_b32 m0, %2\n\ts_nop 0\n\tglobal_load_lds_dwordx4 %1, off\n\ts_mov_b32 m0, %0" : "=&s"(keep_) : "v"(gp), "s"((unsigned)__builtin_amdgcn_readfirstlane(lds0 + (unsigned)(ldsoff))) : "memory"); } while (0)
#define AT_ISSUE(t2, slot) do { const int kr_ = krow0(t2); const bf16_t* kb_ = Kb + (size_t)kr_ * 768; const bf16_t* vb_ = Vb + (size_t)kr_ * 512; \
        AT_GLDS(kb_ + ka, (slot) + ia * 1024); AT_GLDS(kb_ + kbo, (slot) + ib * 1024); AT_GLDS(vb_ + vo, (slot) + AT_KBUF + wv * 1024); } while (0)
#define AT_SB() __builtin_amdgcn_sched_barrier(0)
#define AT_PIN(x) asm volatile("" : "+v"(x))
#define AT_NEXT(x) ((x) == 3 * AT_BUF ? 0 : (x) + AT_BUF)
    __builtin_amdgcn_s_barrier();
    AT_ISSUE(0, 0);
    if (ntiles > 1) AT_ISSUE(1, AT_BUF);
    const int koff = r32 * AT_KROW + 16 * hh;
    const int voff = AT_KBUF + (4 * hh + ((lane & 15) >> 2)) * 64 + ((lane >> 4) & 1) * 32 + (lane & 3) * 8;
#define AT_SYNC(t, slot_issue) do { if ((t) + 1 < ntiles) asm volatile("s_waitcnt vmcnt(3)" ::: "memory"); else asm volatile("s_waitcnt vmcnt(0)" ::: "memory"); \
        __builtin_amdgcn_s_barrier(); asm volatile("" ::: "memory"); if ((t) + 2 < ntiles) AT_ISSUE((t) + 2, slot_issue); } while (0)
#define AT_DECIDE(C0, C1) do { \
        asm volatile("s_nop 15\n\ts_nop 7" : "+v"(C0), "+v"(C1)); \
        float rma = max3f(C0[0], C0[1], C1[0]), rmb = max3f(C0[2], C0[3], C1[1]); rma = max3f(rma, C1[2], C1[3]); \
        _Pragma("unroll") for (int r = 4; r < 16; r += 4) { rma = max3f(rma, C0[r], C0[r + 1]); rmb = max3f(rmb, C0[r + 2], C0[r + 3]); rma = max3f(rma, C1[r], C1[r + 1]); rmb = max3f(rmb, C1[r + 2], C1[r + 3]); } \
        float rm = fmaxf(rma, rmb); rm = fmaxf(rm, __shfl_xor(rm, 32)); \
        resc = false; \
        if (__any(rm > 8.f)) { const float dl = fmaxf(rm, 0.f); fres = __builtin_amdgcn_exp2f(-dl); mhat += dl; l *= fres; resc = true; \
            _Pragma("unroll") for (int r = 0; r < 16; ++r) { C0[r] -= dl; C1[r] -= dl; negm[r] = -mhat; } \
            asm volatile("" : "+v"(negm)); } \
    } while (0)
#define AT_MFS(kfrag, s_, C, first) C = __builtin_amdgcn_mfma_f32_32x32x16_bf16(kfrag, qf[s_], (first) ? negm : C, 0, 0, 0)
#define AT_KF(bk_, g) (*(const bf16x8*)((bk_) + koff + ((g) & 1) * 32 * AT_KROW + ((g) >> 1) * 32))
#define AT_STEP(C0, C1, P0, P1, bk, bv) do { \
        bf16x8 kf[12], vfa[4], vfc[4]; u32x4 pw[4]; float sacc = 0.f; \
        kf[0] = AT_KF(bk, 0); kf[1] = AT_KF(bk, 1); kf[2] = AT_KF(bk, 2); kf[3] = AT_KF(bk, 3); \
        AT_SB(); \
        AT_MFS(kf[0], 0, C0, true);  kf[4] = AT_KF(bk, 4);  sacc += (P0[0] + P0[1]) + (P0[2] + P0[3]); pw[0].x = cvtpk(P0[0], P0[1]); pw[0].y = cvtpk(P0[2], P0[3]); AT_PIN(sacc); AT_PIN(pw[0]); AT_SB(); \
        AT_MFS(kf[1], 0, C1, true);  kf[5] = AT_KF(bk, 5);  sacc += (P0[4] + P0[5]) + (P0[6] + P0[7]); pw[0].z = cvtpk(P0[4], P0[5]); pw[0].w = cvtpk(P0[6], P0[7]); AT_PIN(sacc); AT_PIN(pw[0]); AT_SB(); \
        AT_MFS(kf[2], 1, C0, false); kf[6] = AT_KF(bk, 6);  sacc += (P0[8] + P0[9]) + (P0[10] + P0[11]); pw[1].x = cvtpk(P0[8], P0[9]); pw[1].y = cvtpk(P0[10], P0[11]); AT_PIN(sacc); AT_PIN(pw[1]); AT_SB(); \
        AT_MFS(kf[3], 1, C1, false); kf[7] = AT_KF(bk, 7);  sacc += (P0[12] + P0[13]) + (P0[14] + P0[15]); pw[1].z = cvtpk(P0[12], P0[13]); pw[1].w = cvtpk(P0[14], P0[15]); AT_PIN(sacc); AT_PIN(pw[1]); AT_SB(); \
        AT_MFS(kf[4], 2, C0, false); kf[8] = AT_KF(bk, 8);  sacc += (P1[0] + P1[1]) + (P1[2] + P1[3]); pw[2].x = cvtpk(P1[0], P1[1]); pw[2].y = cvtpk(P1[2], P1[3]); AT_PIN(sacc); AT_PIN(pw[2]); AT_SB(); \
        AT_MFS(kf[5], 2, C1, false); kf[9] = AT_KF(bk, 9);  sacc += (P1[4] + P1[5]) + (P1[6] + P1[7]); pw[2].z = cvtpk(P1[4], P1[5]); pw[2].w = cvtpk(P1[6], P1[7]); AT_PIN(sacc); AT_PIN(pw[2]); AT_SB(); \
        AT_MFS(kf[6], 3, C0, false); kf[10] = AT_KF(bk, 10); sacc += (P1[8] + P1[9]) + (P1[10] + P1[11]); pw[3].x = cvtpk(P1[8], P1[9]); pw[3].y = cvtpk(P1[10], P1[11]); AT_PIN(sacc); AT_PIN(pw[3]); AT_SB(); \
        AT_MFS(kf[7], 3, C1, false); kf[11] = AT_KF(bk, 11); sacc += (P1[12] + P1[13]) + (P1[14] + P1[15]); pw[3].z = cvtpk(P1[12], P1[13]); pw[3].w = cvtpk(P1[14], P1[15]); AT_PIN(sacc); AT_PIN(pw[3]); AT_SB(); \
        AT_MFS(kf[8], 4, C0, false); { const unsigned char* vb_ = (bv) + voff; vfa[0] = tr8(vb_, vb_ + 512); vfc[0] = tr8(vb_ + 4096, vb_ + 4608); } AT_SB(); \
        AT_MFS(kf[9], 4, C1, false); { const unsigned char* vb_ = (bv) + voff + 1024; vfa[1] = tr8(vb_, vb_ + 512); vfc[1] = tr8(vb_ + 4096, vb_ + 4608); } AT_SB(); \
        AT_MFS(kf[10], 5, C0, false); { const unsigned char* vb_ = (bv) + voff + 2048; vfa[2] = tr8(vb_, vb_ + 512); vfc[2] = tr8(vb_ + 4096, vb_ + 4608); } AT_SB(); \
        AT_MFS(kf[11], 5, C1, false); { const unsigned char* vb_ = (bv) + voff + 3072; vfa[3] = tr8(vb_, vb_ + 512); vfc[3] = tr8(vb_ + 4096, vb_ + 4608); } AT_SB(); \
        l += sacc; \
        AT_DECIDE(C0, C1); \
        AT_SB(); \
        o0 = __builtin_amdgcn_mfma_f32_32x32x16_bf16(vfa[0], __builtin_bit_cast(bf16x8, pw[0]), o0, 0, 0, 0); C0[0] = __builtin_amdgcn_exp2f(C0[0]); C0[1] = __builtin_amdgcn_exp2f(C0[1]); C0[2] = __builtin_amdgcn_exp2f(C0[2]); C0[3] = __builtin_amdgcn_exp2f(C0[3]); AT_PIN(C0); AT_SB(); \
        o1 = __builtin_amdgcn_mfma_f32_32x32x16_bf16(vfc[0], __builtin_bit_cast(bf16x8, pw[0]), o1, 0, 0, 0); C0[4] = __builtin_amdgcn_exp2f(C0[4]); C0[5] = __builtin_amdgcn_exp2f(C0[5]); C0[6] = __builtin_amdgcn_exp2f(C0[6]); C0[7] = __builtin_amdgcn_exp2f(C0[7]); AT_PIN(C0); AT_SB(); \
        o0 = __builtin_amdgcn_mfma_f32_32x32x16_bf16(vfa[1], __builtin_bit_cast(bf16x8, pw[1]), o0, 0, 0, 0); C0[8] = __builtin_amdgcn_exp2f(C0[8]); C0[9] = __builtin_amdgcn_exp2f(C0[9]); C0[10] = __builtin_amdgcn_exp2f(C0[10]); C0[11] = __builtin_amdgcn_exp2f(C0[11]); AT_PIN(C0); AT_SB(); \
        o1 = __builtin_amdgcn_mfma_f32_32x32x16_bf16(vfc[1], __builtin_bit_cast(bf16x8, pw[1]), o1, 0, 0, 0); C0[12] = __builtin_amdgcn_exp2f(C0[12]); C0[13] = __builtin_amdgcn_exp2f(C0[13]); C0[14] = __builtin_amdgcn_exp2f(C0[14]); C0[15] = __builtin_amdgcn_exp2f(C0[15]); AT_PIN(C0); AT_SB(); \
        o0 = __builtin_amdgcn_mfma_f32_32x32x16_bf16(vfa[2], __builtin_bit_cast(bf16x8, pw[2]), o0, 0, 0, 0); C1[0] = __builtin_amdgcn_exp2f(C1[0]); C1[1] = __builtin_amdgcn_exp2f(C1[1]); C1[2] = __builtin_amdgcn_exp2f(C1[2]); C1[3] = __builtin_amdgcn_exp2f(C1[3]); AT_PIN(C1); AT_SB(); \
        o1 = __builtin_amdgcn_mfma_f32_32x32x16_bf16(vfc[2], __builtin_bit_cast(bf16x8, pw[2]), o1, 0, 0, 0); C1[4] = __builtin_amdgcn_exp2f(C1[4]); C1[5] = __builtin_amdgcn_exp2f(C1[5]); C1[6] = __builtin_amdgcn_exp2f(C1[6]); C1[7] = __builtin_amdgcn_exp2f(C1[7]); AT_PIN(C1); AT_SB(); \
        o0 = __builtin_amdgcn_mfma_f32_32x32x16_bf16(vfa[3], __builtin_bit_cast(bf16x8, pw[3]), o0, 0, 0, 0); C1[8] = __builtin_amdgcn_exp2f(C1[8]); C1[9] = __builtin_amdgcn_exp2f(C1[9]); C1[10] = __builtin_amdgcn_exp2f(C1[10]); C1[11] = __builtin_amdgcn_exp2f(C1[11]); AT_PIN(C1); AT_SB(); \
        o1 = __builtin_amdgcn_mfma_f32_32x32x16_bf16(vfc[3], __builtin_bit_cast(bf16x8, pw[3]), o1, 0, 0, 0); C1[12] = __builtin_amdgcn_exp2f(C1[12]); C1[13] = __builtin_amdgcn_exp2f(C1[13]); C1[14] = __builtin_amdgcn_exp2f(C1[14]); C1[15] = __builtin_amdgcn_exp2f(C1[15]); AT_PIN(C1); AT_SB(); \
        if (resc) { _Pragma("unroll") for (int r = 0; r < 16; ++r) { o0[r] *= fres; o1[r] *= fres; } } \
    } while (0)
    f32x16 pA0, pA1, pB0, pB1; bool resc = false; float fres = 1.f;
    int s_prev = 0, s_cur = 0, s_iss = 2 * AT_BUF;
    AT_SYNC(0, s_iss); s_iss = AT_NEXT(s_iss);
    {
        const unsigned char* bk = lds + s_cur;
#pragma unroll
        for (int s_ = 0; s_ < 6; ++s_) {
            const bf16x8 k0f = *(const bf16x8*)(bk + koff + 32 * s_), k1f = *(const bf16x8*)(bk + koff + 32 * AT_KROW + 32 * s_);
            pA0 = __builtin_amdgcn_mfma_f32_32x32x16_bf16(k0f, qf[s_], s_ == 0 ? negm : pA0, 0, 0, 0);
            pA1 = __builtin_amdgcn_mfma_f32_32x32x16_bf16(k1f, qf[s_], s_ == 0 ? negm : pA1, 0, 0, 0);
        }
        AT_DECIDE(pA0, pA1);
#pragma unroll
        for (int r = 0; r < 16; ++r) { pA0[r] = __builtin_amdgcn_exp2f(pA0[r]); pA1[r] = __builtin_amdgcn_exp2f(pA1[r]); }
    }
    int t = 1;
#pragma unroll 1
    for (; t + 1 < ntiles; t += 2) {
        s_prev = s_cur; s_cur = AT_NEXT(s_cur); AT_SYNC(t, s_iss); s_iss = AT_NEXT(s_iss);
        AT_STEP(pB0, pB1, pA0, pA1, lds + s_cur, lds + s_prev);
        s_prev = s_cur; s_cur = AT_NEXT(s_cur); AT_SYNC(t + 1, s_iss); s_iss = AT_NEXT(s_iss);
        AT_STEP(pA0, pA1, pB0, pB1, lds + s_cur, lds + s_prev);
    }
    {
        s_prev = s_cur; s_cur = AT_NEXT(s_cur); AT_SYNC(t, s_iss); s_iss = AT_NEXT(s_iss);
        AT_STEP(pB0, pB1, pA0, pA1, lds + s_cur, lds + s_prev);
    }
    {
        float sacc = 0.f;
#pragma unroll
        for (int r = 0; r < 16; ++r) sacc += pB0[r] + pB1[r];
        l += sacc;
        u32x4 pw[4];
#pragma unroll
        for (int s2 = 0; s2 < 2; ++s2) {
            pw[s2] = (u32x4){cvtpk(pB0[8 * s2], pB0[8 * s2 + 1]), cvtpk(pB0[8 * s2 + 2], pB0[8 * s2 + 3]), cvtpk(pB0[8 * s2 + 4], pB0[8 * s2 + 5]), cvtpk(pB0[8 * s2 + 6], pB0[8 * s2 + 7])};
            pw[2 + s2] = (u32x4){cvtpk(pB1[8 * s2], pB1[8 * s2 + 1]), cvtpk(pB1[8 * s2 + 2], pB1[8 * s2 + 3]), cvtpk(pB1[8 * s2 + 4], pB1[8 * s2 + 5]), cvtpk(pB1[8 * s2 + 6], pB1[8 * s2 + 7])};
        }
        const unsigned char* bv = lds + s_cur;
#pragma unroll
        for (int ks = 0; ks < 4; ++ks) {
            const unsigned char* vb = bv + voff + ks * 16 * 64; const bf16x8 pf = __builtin_bit_cast(bf16x8, pw[ks]);
            o0 = __builtin_amdgcn_mfma_f32_32x32x16_bf16(tr8(vb, vb + 8 * 64), pf, o0, 0, 0, 0);
            o1 = __builtin_amdgcn_mfma_f32_32x32x16_bf16(tr8(vb + 4096, vb + 4096 + 8 * 64), pf, o1, 0, 0, 0);
        }
    }
#undef AT_GLDS
#undef AT_ISSUE
#undef AT_SB
#undef AT_PIN
#undef AT_NEXT
#undef AT_SYNC
#undef AT_DECIDE
#undef AT_MFS
#undef AT_KF
#undef AT_STEP
    l += __shfl_xor(l, 32);
    const float rl = 1.f / l;
    bf16_t* orow = (bf16_t*)(p.ws + WS_CC) + (size_t)qrow * D + 512 + h * 64 + 4 * hh;
#pragma unroll
    for (int r4 = 0; r4 < 4; ++r4) {
        u32x2 w0; w0.x = cvtpk(o0[4 * r4] * rl, o0[4 * r4 + 1] * rl); w0.y = cvtpk(o0[4 * r4 + 2] * rl, o0[4 * r4 + 3] * rl);
        u32x2 w1; w1.x = cvtpk(o1[4 * r4] * rl, o1[4 * r4 + 1] * rl); w1.y = cvtpk(o1[4 * r4 + 2] * rl, o1[4 * r4 + 3] * rl);
        *(u32x2*)(orow + 8 * r4) = w0; *(u32x2*)(orow + 32 + 8 * r4) = w1;
    }
}
__device__ __forceinline__ void retout_unit(unsigned char* lds, const P& p, int L, int gc, int h) {
    float* qs = (float*)lds; float* ks = qs + 128 * 33; float* vs = ks + 128 * 33; float* Sf = vs + 128 * 64; float* Sb = Sf + 2048;
    const int tid = threadIdx.x;
    const float l2f = log2_gamma(p, L, 0, h), l2b = log2_gamma(p, L, 1, h);
    load_ret_qk(qs, p, gc, h, Z_RQ, 1.f);
    load_ret_qk(ks, p, gc, h, Z_RK, 0.17677669529663687f);
    load_ret_v(vs, p, gc, h);
    {
        const bool lat = gc < 256; const int b = lat ? gc >> 4 : (gc - 256) >> 1;
        const int mme = lat ? 2 + (gc & 15) : (gc - 256) & 1;
        const int u = mme, w = mme < 2 ? 1 - mme : 19 - mme;
        f32x4 sf = (f32x4){0.f, 0.f, 0.f, 0.f}, sb = sf;
        const float* KVb = (const float*)(p.ws + WS_KV);
#pragma unroll 1
        for (int mm = 0; mm < 18; ++mm) {
            const int gcm = mm < 2 ? 256 + b * 2 + mm : b * 16 + (mm - 2);
            const int um = mm, wm = mm < 2 ? 1 - mm : 19 - mm;
            const float* kv = KVb + ((size_t)(gcm * 4 + h) * 2) * 2048 + tid * 4;
            if (um < u) { const float wgt = exp2f(l2f * 128.f * (float)(u - 1 - um)); sf += wgt * *(const f32x4*)kv; }
            if (wm < w) { const float wgt = exp2f(l2b * 128.f * (float)(w - 1 - wm)); sb += wgt * *(const f32x4*)(kv + 2048); }
        }
        *(f32x4*)(Sf + tid * 4) = sf; *(f32x4*)(Sb + tid * 4) = sb;
    }
    __syncthreads();
    const int i = tid >> 2, e0 = (tid & 3) * 16;
    float q[32];
#pragma unroll
    for (int d = 0; d < 32; ++d) q[d] = qs[i * 33 + d];
    float acc[16];
#pragma unroll
    for (int e = 0; e < 16; ++e) acc[e] = 0.f;
#pragma unroll 1
    for (int j = 0; j < 128; ++j) {
        float s = 0.f;
#pragma unroll
        for (int d = 0; d < 32; ++d) s += q[d] * ks[j * 33 + d];
        float wgt = 0.f;
        if (j <= i) wgt += exp2f(l2f * (float)(i - j));
        if (j >= i) wgt += exp2f(l2b * (float)(j - i));
        s *= wgt;
#pragma unroll
        for (int e4 = 0; e4 < 4; ++e4) { const f32x4 v4 = *(const f32x4*)(vs + j * 64 + e0 + 4 * e4); acc[4 * e4] += s * v4.x; acc[4 * e4 + 1] += s * v4.y; acc[4 * e4 + 2] += s * v4.z; acc[4 * e4 + 3] += s * v4.w; }
    }
    {
        const float cf = exp2f(l2f * (float)(i + 1)), cb = exp2f(l2b * (float)(128 - i));
#pragma unroll 2
        for (int d = 0; d < 32; ++d) {
            const float qd = qs[i * 33 + d]; const float qf = qd * cf, qb = qd * cb;
#pragma unroll
            for (int e4 = 0; e4 < 4; ++e4) { const f32x4 a = *(const f32x4*)(Sf + d * 64 + e0 + 4 * e4), bq = *(const f32x4*)(Sb + d * 64 + e0 + 4 * e4);
                acc[4 * e4] += qf * a.x + qb * bq.x; acc[4 * e4 + 1] += qf * a.y + qb * bq.y; acc[4 * e4 + 2] += qf * a.z + qb * bq.z; acc[4 * e4 + 3] += qf * a.w + qb * bq.w; }
        }
    }
    float s1 = 0.f;
#pragma unroll
    for (int e = 0; e < 16; ++e) s1 += acc[e];
    s1 += __shfl_xor(s1, 1); s1 += __shfl_xor(s1, 2);
    const float mu = s1 * (1.f / 64.f);
    float s2 = 0.f;
#pragma unroll
    for (int e = 0; e < 16; ++e) { const float dd = acc[e] - mu; s2 += dd * dd; }
    s2 += __shfl_xor(s2, 1); s2 += __shfl_xor(s2, 2);
    const float rstd = rsqrtf(s2 * (1.f / 64.f) + NORM_EPS);
    const int row = gc * 128 + i;
    const bf16_t* zg = (const bf16_t*)(p.ws + WS_Z) + (size_t)row * ZC + Z_RG + h * 64 + e0;
    const float* gw = p.in[13] + L * 256 + h * 64 + e0;
    const u32x4 g0 = *(const u32x4*)zg, g1 = *(const u32x4*)(zg + 8);
    float g[16];
#pragma unroll
    for (int k = 0; k < 4; ++k) { g[2 * k] = lo16(g0[k]); g[2 * k + 1] = hi16(g0[k]); g[8 + 2 * k] = lo16(g1[k]); g[8 + 2 * k + 1] = hi16(g1[k]); }
    unsigned o[8];
#pragma unroll
    for (int k = 0; k < 8; ++k) {
        const float y0 = siluf(g[2 * k]) * ((acc[2 * k] - mu) * rstd * gw[2 * k]), y1 = siluf(g[2 * k + 1]) * ((acc[2 * k + 1] - mu) * rstd * gw[2 * k + 1]);
        o[k] = pk2(y0, y1);
    }
    u32x4* op = (u32x4*)((bf16_t*)(p.ws + WS_CC) + (size_t)row * D + 256 + h * 64 + e0);
    u32x4 w0; w0.x = o[0]; w0.y = o[1]; w0.z = o[2]; w0.w = o[3]; u32x4 w1; w1.x = o[4]; w1.y = o[5]; w1.z = o[6]; w1.w = o[7];
    op[0] = w0; op[1] = w1;
    __syncthreads();
}
__device__ __forceinline__ void phase_c(unsigned char* lds, const P& p, int L) {
    const int G = gridDim.x, bid = blockIdx.x;
    const int nat = 16 * 8 * 8, nac = (L == 0) ? 128 : 0, nro = (L == 0 ? 288 : 256) * 4;
    const int total = nat + nac + nro;
    for (int u = bid; u < total; u += G) {
        int r = u;
#ifndef TEST_C
#define TEST_C 3
#endif
        if (r < nat) { if (TEST_C & 1) attn_unit_mfma(lds, p, r >> 6, (r >> 3) & 7, r & 7, false); continue; } r -= nat;
        if (r < nac) { if (TEST_C & 1) attn_unit_mfma(lds, p, r >> 3, r & 7, 0, true); continue; } r -= nac;
        if (TEST_C & 2) retout_unit_mfma(lds, p, L, r >> 2, r & 3);
    }
    if (L == 0) convert_expert_weights(lds, p, 0);
}

struct EpiY {
    bf16_t* Y; const float* g1;
    __device__ __forceinline__ void operator()(const ge::Acc& acc, const ge::Unit& u, int wr, int wc, int fr, int fq) const {
        const float* gr = g1 + (size_t)mod_row(u.a * 256) * 6144 + u.b * 256 + wc * 32 + 8 * fq;
        f32x4 g[2][2];
#pragma unroll
        for (int bj = 0; bj < 2; ++bj)
#pragma unroll
            for (int n = 0; n < 2; ++n) g[bj][n] = *(const f32x4*)(gr + bj * 128 + n * 4);
#pragma unroll
        for (int ai = 0; ai < 2; ++ai)
#pragma unroll
            for (int m = 0; m < 4; ++m) {
                bf16_t* yr = Y + (size_t)(u.a * 256 + ai * 128 + wr * 64 + m * 16 + fr) * D + u.b * 256 + wc * 32 + 8 * fq;
#pragma unroll
                for (int bj = 0; bj < 2; ++bj) { const f32x4 v0 = acc[ai][bj][m][0] * g[bj][0], v1 = acc[ai][bj][m][1] * g[bj][1];
                    u32x4 w; w.x = cvtpk(v0.x, v0.y); w.y = cvtpk(v0.z, v0.w); w.z = cvtpk(v1.x, v1.y); w.w = cvtpk(v1.z, v1.w); *(u32x4*)(yr + bj * 128) = w; }
            }
    }
};
__device__ __forceinline__ void phase_d(unsigned char* lds, const P& p, int L) {
    ge::DenseOrder S; S.nM = (L == 0 ? NTOK : NLAT) / 256; S.nN = 4; S.nwg = S.nM * 4; S.G = gridDim.x; S.c = blockIdx.x;
    S.Bt = (const char*)((const bf16_t*)(p.ws + WS_WOUT) + (size_t)L * D * D); S.btile = (size_t)256 * D * 2; S.arow = D * 2;
    EpiY E{(bf16_t*)(p.ws + WS_Y), (const float*)(p.ws + WS_MODV) + (size_t)L * 17 * 6144 + 2048};
    ge::gemm_stream<ge::DenseOrder, EpiY, true>((LAS unsigned char*)lds, (const char*)(p.ws + WS_CC), D, S, E);
}

__device__ __forceinline__ void norm_mod_store(const P& p, int L, int which, int tok, int lane, const f32x4 (&v)[4], bf16_t* Hdst) {
    const float* nw = (which == 0 ? p.in[6] : p.in[19]) + L * D;
    const float* mrow = (const float*)(p.ws + WS_MODV) + ((size_t)L * 17 + mod_row(tok)) * 6144 + which * 3072;
    float s = 0.f;
#pragma unroll
    for (int j = 0; j < 4; ++j) s += v[j].x * v[j].x + v[j].y * v[j].y + v[j].z * v[j].z + v[j].w * v[j].w;
    const float rstd = rsqrtf(wave_sum(s) * (1.f / D) + NORM_EPS);
    u32x2* o = (u32x2*)(Hdst + (size_t)tok * D) + lane;
#pragma unroll
    for (int j = 0; j < 4; ++j) {
        const int k = 4 * lane + 256 * j;
        const f32x4 w4 = *(const f32x4*)(nw + k), sh = *(const f32x4*)(mrow + k), sc = *(const f32x4*)(mrow + 1024 + k);
        const f32x4 y = v[j] * rstd * w4 * (sc + 1.f) + sh;
        u32x2 w; w.x = cvtpk(y.x, y.y); w.y = cvtpk(y.z, y.w); o[64 * j] = w;
    }
}
__device__ __forceinline__ int half_n(int L) { return L == 0 ? NTOK / 2 : NLAT / 2; }
__device__ __forceinline__ void phase_router(unsigned char* lds, const P& p, int L) {
    constexpr int O_LG = 41472, O_CNT = 83072, O_SEL = 83584, O_SELW = 87424;
    const bf16_t* H = (const bf16_t*)(p.ws + WS_H); const bf16_t* W = (const bf16_t*)(p.ws + WS_RT) + (size_t)L * 128 * D;
    const bf16_t* Y = (const bf16_t*)(p.ws + WS_Y);
    float* lg = (float*)(lds + O_LG);
    int* lcnt = (int*)(lds + O_CNT);
    int* sel = (int*)(lds + O_SEL);
    float* selw = (float*)(lds + O_SELW);
    int* ltok = (int*)(p.ws + WS_LTOK); float* lw = (float*)(p.ws + WS_LW);
    const int tid = threadIdx.x, lane = tid & 63, wave = tid >> 6;
    const int ntok = (L == 0 ? NTOK : NLAT), TS = (L == 0 ? 144 : 128), nmt = ntok / TS, RW = TS / 8;
    for (int mt = blockIdx.x; mt < nmt; mt += gridDim.x) {
        const int t0 = mt * TS;
        if (tid < 64) lcnt[tid] = 0;
#pragma unroll 2
        for (int q = 0; q < RW; ++q) {
            const int tok = t0 + wave * RW + q;
            const u32x2* yr = (const u32x2*)(Y + (size_t)tok * D) + lane;
            u32x2* xo = (u32x2*)x_row(p, tok) + lane;
            f32x4 v[4];
            if (L == 0) {
                const f32x4* xi = (const f32x4*)x_in_row(p, tok) + lane;
#pragma unroll
                for (int j = 0; j < 4; ++j) { const f32x4 a = xi[64 * j]; const u32x2 y = yr[64 * j]; v[j] = (f32x4){a.x + lo16(y.x), a.y + hi16(y.x), a.z + lo16(y.y), a.w + hi16(y.y)}; }
            } else {
#pragma unroll
                for (int j = 0; j < 4; ++j) { const u32x2 a = xo[64 * j]; const u32x2 y = yr[64 * j]; v[j] = (f32x4){lo16(a.x) + lo16(y.x), hi16(a.x) + hi16(y.x), lo16(a.y) + lo16(y.y), hi16(a.y) + hi16(y.y)}; }
            }
#pragma unroll
            for (int j = 0; j < 4; ++j) { u32x2 w; w.x = cvtpk(v[j].x, v[j].y); w.y = cvtpk(v[j].z, v[j].w); xo[64 * j] = w; }
            norm_mod_store(p, L, 1, tok, lane, v, (bf16_t*)(p.ws + WS_H));
        }
        asm volatile("s_waitcnt vmcnt(0)" ::: "memory");
        __syncthreads();
        auto rs = [&](int pr) { return H + (size_t)(t0 + (pr < TS ? pr : TS - 1)) * D; };
        auto epi = [&](int r, int c, f32x4 v) { if (c < 64) { float* d = lg + r * 65 + c; d[0] = v.x; d[1] = v.y; d[2] = v.z; d[3] = v.w; } };
        gemm_tile<5>(lds, rs, W, D, D, epi);
        __syncthreads();
        if (tid < TS) {
            const float* rbp = p.in[21] + L * NEXP; const float* lrow = lg + tid * 65;
            float bv[6], bs[6]; int bi[6];
#pragma unroll
            for (int k = 0; k < 6; ++k) { bv[k] = -INFINITY; bs[k] = 0.f; bi[k] = 0; }
#pragma unroll 4
            for (int e = 0; e < NEXP; ++e) {
                float sc = 1.f / (1.f + __expf(-lrow[e])); float sv = sc + rbp[e]; int ei = e;
#pragma unroll
                for (int k = 0; k < 6; ++k) { const bool gt = sv > bv[k]; const float tv = gt ? bv[k] : sv, ts = gt ? bs[k] : sc; const int ti = gt ? bi[k] : ei;
                    bv[k] = gt ? sv : bv[k]; bs[k] = gt ? sc : bs[k]; bi[k] = gt ? ei : bi[k]; sv = tv; sc = ts; ei = ti; }
            }
            const float rs6 = 2.5f / (bs[0] + bs[1] + bs[2] + bs[3] + bs[4] + bs[5]);
#pragma unroll
            for (int k = 0; k < 6; ++k) { const int rank = atomicAdd(&lcnt[bi[k]], 1); sel[tid * 6 + k] = (bi[k] << 8) | rank; selw[tid * 6 + k] = bs[k] * rs6; }
        }
        __syncthreads();
        if (tid < 64) {
            unsigned* ecnt = (unsigned*)(p.ws + WS_CTL) + CW_ECNT + L * 4096;
            const int c = lcnt[tid];
            lcnt[64 + tid] = c ? (int)atomicAdd(ecnt + tid * 64, (unsigned)c) : 0;
        }
        __syncthreads();
        for (int i = tid; i < TS * 6; i += NTHREADS) {
            const int sv = sel[i], e = sv >> 8, pos = lcnt[64 + e] + (sv & 255), tok = t0 + i / 6, k = i % 6;
            ltok[(size_t)e * LCAP + pos] = tok * 8 + k;
            lw[(size_t)e * LCAP + pos] = selw[i];
        }
        __syncthreads();
    }
}

__device__ __forceinline__ void build_etab(unsigned char* lds, const P& p, int L) {
    int* tstart = (int*)(lds + ETAB_OFF); int* cnt = tstart + 80;
    __syncthreads();
    if (threadIdx.x < 64) { const unsigned* ecnt = (const unsigned*)(p.ws + WS_CTL) + CW_ECNT + L * 4096;
        cnt[threadIdx.x] = (int)__hip_atomic_load(ecnt + threadIdx.x * 64, __ATOMIC_RELAXED, __HIP_MEMORY_SCOPE_AGENT); }
    __syncthreads();
    if (threadIdx.x == 0) { int s = 0; for (int e = 0; e < 64; ++e) { tstart[e] = s; s += (cnt[e] + 255) >> 8; } tstart[64] = s; s += (L == 0 ? NTOK : NLAT) / 256; tstart[65] = s; }
    __syncthreads();
}
struct MoeOrder {
    int TT, nN, G, c; const int* tstart; const char* Bexp; size_t bexp; const char* Bsh; size_t btile; const int* rowbuf; unsigned arow; bool ident;
    __device__ __forceinline__ bool next(int i, ge::Unit& u) const {
        const int Lq = i * G + c; if (Lq >= TT * nN) return false;
        const int t = Lq / nN, pn = Lq % nN;
        int lo = 0, hi = 64;
        while (lo < hi) { const int mid = (lo + hi + 1) >> 1; if (tstart[mid] <= t) lo = mid; else hi = mid - 1; }
        const int e = __builtin_amdgcn_readfirstlane(lo);
        u.a = t; u.b = pn; u.c = e; u.d = i;
        u.B = (e < 64 ? Bexp + (size_t)e * bexp : Bsh) + (size_t)pn * btile;
        return true;
    }
    __device__ __forceinline__ unsigned aoff(int i, const ge::Unit& u, int R) const { return (unsigned)(ident ? u.a * 256 + R : rowbuf[i * 256 + R]) * arow; }
};
__device__ __forceinline__ void phase_gateup(unsigned char* lds, const P& p, int L) {
    build_etab(lds, p, L);
    const int* tstart = (const int*)(lds + ETAB_OFF); const int* cnt = tstart + 80;
    int* rowbuf = (int*)(lds + RB0_OFF); float* wbuf = (float*)(lds + RB1_OFF);
    const int* ltok = (const int*)(p.ws + WS_LTOK); const float* lw = (const float*)(p.ws + WS_LW);
    bf16_t* ACT = (bf16_t*)(p.ws + WS_ACT);
    const int G = gridDim.x, bid = blockIdx.x, vcu = (G % 8 == 0) ? (bid % 8) * (G / 8) + bid / 8 : bid;
    MoeOrder S; S.TT = tstart[65]; S.nN = 2; S.G = G; S.c = vcu; S.tstart = tstart; S.Bexp = (const char*)(p.ws + WS_EGU); S.bexp = (size_t)512 * D * 2;
    S.Bsh = (const char*)((const bf16_t*)(p.ws + WS_SHGU) + (size_t)L * 512 * D); S.btile = (size_t)256 * D * 2; S.rowbuf = rowbuf; S.arow = D * 2; S.ident = false;
    {
        ge::Unit u;
        for (int i = 0; i < 10 && S.next(i, u); ++i) {
            if (threadIdx.x < 256) {
                const int R = threadIdx.x, e = u.c, mt = u.a - tstart[e];
                int tok; float w;
                if (e < 64) { const int lp = mt * 256 + R; const bool ok = lp < cnt[e]; tok = ok ? (ltok[(size_t)e * LCAP + lp] >> 3) : 0; w = ok ? lw[(size_t)e * LCAP + lp] : 0.f; }
                else { tok = mt * 256 + R; w = 1.f; }
                rowbuf[i * 256 + R] = tok; wbuf[i * 256 + R] = w;
            }
        }
        __syncthreads();
    }
    auto f = [&](const ge::Unit& u, int r, int c, f32x4 v0, f32x4 v1) {
        const float w = wbuf[u.d * 256 + r];
        u32x2 o; o.x = cvtpk(siluf(v0.x) * v0.y * w, siluf(v0.z) * v0.w * w); o.y = cvtpk(siluf(v1.x) * v1.y * w, siluf(v1.z) * v1.w * w);
        *(u32x2*)(ACT + (size_t)(u.a * 256 + r) * EDIM + ((u.b * 256 + c) >> 1)) = o;
    };
    ge::EpiFn<decltype(f)> E{f};
    ge::gemm_stream<MoeOrder, ge::EpiFn<decltype(f)>, true>((LAS unsigned char*)lds, (const char*)(p.ws + WS_H), D, S, E);
}
__device__ __forceinline__ void phase_down(unsigned char* lds, const P& p, int L) {
    build_etab(lds, p, L);
    const int* tstart = (const int*)(lds + ETAB_OFF); const int* cnt = tstart + 80;
    int* sbuf = (int*)(lds + RB0_OFF);
    const int* ltok = (const int*)(p.ws + WS_LTOK);
    unsigned char* SLOT = (unsigned char*)(p.ws + WS_SLOT);
    const int G = gridDim.x, bid = blockIdx.x, vcu = (G % 8 == 0) ? (bid % 8) * (G / 8) + bid / 8 : bid;
    MoeOrder S; S.TT = tstart[65]; S.nN = 4; S.G = G; S.c = vcu; S.tstart = tstart; S.Bexp = (const char*)(p.ws + WS_ED); S.bexp = (size_t)D * EDIM * 2;
    S.Bsh = (const char*)((const bf16_t*)(p.ws + WS_SHD) + (size_t)L * D * EDIM); S.btile = (size_t)256 * EDIM * 2; S.rowbuf = sbuf; S.arow = EDIM * 2; S.ident = true;
    {
        ge::Unit u;
        for (int i = 0; i < 18 && S.next(i, u); ++i) {
            if (threadIdx.x < 256) {
                const int R = threadIdx.x, e = u.c, mt = u.a - tstart[e];
                int srow;
                if (e < 64) { const int lp = mt * 256 + R; if (lp < cnt[e]) { const int ent = ltok[(size_t)e * LCAP + lp]; srow = (ent >> 3) * 7 + (ent & 7); } else srow = NTOK * 7; }
                else srow = (mt * 256 + R) * 7 + 6;
                sbuf[i * 256 + R] = srow;
            }
        }
        __syncthreads();
    }
    auto f = [&](const ge::Unit& u, int r, int c, f32x4 v0, f32x4 v1) {
        const int srow = sbuf[u.d * 256 + r];
        int w0 = 0, w1 = 0;
        w0 = __builtin_amdgcn_cvt_pk_fp8_f32(__builtin_amdgcn_fmed3f(v0.x, -440.f, 440.f), __builtin_amdgcn_fmed3f(v0.y, -440.f, 440.f), w0, false);
        w0 = __builtin_amdgcn_cvt_pk_fp8_f32(__builtin_amdgcn_fmed3f(v0.z, -440.f, 440.f), __builtin_amdgcn_fmed3f(v0.w, -440.f, 440.f), w0, true);
        w1 = __builtin_amdgcn_cvt_pk_fp8_f32(__builtin_amdgcn_fmed3f(v1.x, -440.f, 440.f), __builtin_amdgcn_fmed3f(v1.y, -440.f, 440.f), w1, false);
        w1 = __builtin_amdgcn_cvt_pk_fp8_f32(__builtin_amdgcn_fmed3f(v1.z, -440.f, 440.f), __builtin_amdgcn_fmed3f(v1.w, -440.f, 440.f), w1, true);
        u32x2 w; w.x = (unsigned)w0; w.y = (unsigned)w1; *(u32x2*)(SLOT + (size_t)srow * D + u.b * 256 + c) = w;
    };
    ge::EpiFn<decltype(f)> E{f};
    ge::gemm_stream<MoeOrder, ge::EpiFn<decltype(f)>, true>((LAS unsigned char*)lds, (const char*)(p.ws + WS_ACT), EDIM, S, E);
}
__device__ __forceinline__ void phase_combine(const P& p, int L) {
    const int tid = threadIdx.x, lane = tid & 63, wave = tid >> 6, gw = blockIdx.x * NWAVES + wave, NGW = gridDim.x * NWAVES;
    const unsigned char* SLOT = (const unsigned char*)(p.ws + WS_SLOT);
    const float* modv = (const float*)(p.ws + WS_MODV) + (size_t)L * 17 * 6144;
    const int ntok = (L == 0 ? NTOK : NLAT);
    for (int tok = gw; tok < ntok; tok += NGW) {
        f32x4 acc[4];
#pragma unroll
        for (int j = 0; j < 4; ++j) acc[j] = (f32x4){0.f, 0.f, 0.f, 0.f};
#pragma unroll
        for (int k = 0; k < 7; ++k) {
            const int* sr = (const int*)(SLOT + ((size_t)tok * 7 + k) * D) + lane;
#pragma unroll
            for (int j = 0; j < 4; ++j) { const int w = sr[64 * j]; const f32x2_t a = __builtin_amdgcn_cvt_pk_f32_fp8(w, false), b = __builtin_amdgcn_cvt_pk_f32_fp8(w, true); acc[j].x += a.x; acc[j].y += a.y; acc[j].z += b.x; acc[j].w += b.y; }
        }
        const float* g2 = modv + (size_t)mod_row(tok) * 6144 + 5120;
        u32x2* xr = (u32x2*)x_row(p, tok) + lane;
        f32x4 v[4];
#pragma unroll
        for (int j = 0; j < 4; ++j) { const f32x4 g = *(const f32x4*)(g2 + 4 * lane + 256 * j); const u32x2 a = xr[64 * j];
            v[j] = (f32x4){lo16(a.x), hi16(a.x), lo16(a.y), hi16(a.y)} + g * acc[j]; }
        if (L == 0) {
#pragma unroll
            for (int j = 0; j < 4; ++j) { u32x2 w; w.x = cvtpk(v[j].x, v[j].y); w.y = cvtpk(v[j].z, v[j].w); xr[64 * j] = w; }
            norm_mod_store(p, 1, 0, tok, lane, v, (bf16_t*)(p.ws + WS_H1));
        } else {
            const float* nw = p.in[28]; float s = 0.f;
#pragma unroll
            for (int j = 0; j < 4; ++j) s += v[j].x * v[j].x + v[j].y * v[j].y + v[j].z * v[j].z + v[j].w * v[j].w;
            const float rstd = rsqrtf(wave_sum(s) * (1.f / D) + NORM_EPS);
            f32x4* orow = (f32x4*)(p.out + (size_t)tok * D) + lane;
#pragma unroll
            for (int j = 0; j < 4; ++j) { const f32x4 w4 = *(const f32x4*)(nw + 4 * lane + 256 * j); orow[64 * j] = v[j] * rstd * w4; }
        }
    }
}

constexpr int PH_LAYER0 = 2, PH_PER_LAYER = 8, PH_LAYER1 = PH_LAYER0 + PH_PER_LAYER, NPHASES = PH_LAYER1 + PH_PER_LAYER;

__global__ void __launch_bounds__(NTHREADS, 2) mk_fwd(P p) {
    extern __shared__ __attribute__((aligned(16))) unsigned char lds[];
    volatile LAS unsigned* MISC = (volatile LAS unsigned*)((LAS unsigned char*)lds + MISC_OFF);
    if (threadIdx.x < 64) MISC[threadIdx.x] = 0u;
    __syncthreads();
    unsigned* ctl = (unsigned*)(p.ws + WS_CTL);
    XcdBarrier bar; bar.bar = ctl + CW_BAR; bar.x = 0; bar.st = MISC + 8;
    if (!MK_PER_PHASE) bar = xcd_barrier_post(ctl + CW_BAR, MISC + 8);
    const int lo = p.ph_lo, hi = p.ph_hi;
#ifndef PH_MASK
#define PH_MASK 0xffffu
#endif
#define HAS(b) ((PH_MASK >> (b)) & 1u)
#define IN(k) (lo <= (k) && (k) < hi)
#define SEAM(k) do { if (IN(k) && IN((k) + 1)) xcd_barrier(bar); } while (0)

#ifdef PROBE_MASK
    unsigned long long tacc = 0ull, t0p = 0ull;
#define PT0() t0p = __builtin_amdgcn_s_memrealtime()
#define PT1(b) do { if ((PROBE_MASK >> (b)) & 1u) tacc += __builtin_amdgcn_s_memrealtime() - t0p; } while (0)
#else
#define PT0() do {} while (0)
#define PT1(b) do {} while (0)
#endif
#define PH(b, k, body) do { PT0(); if (HAS(b) && IN(k)) { body; } SEAM(k); PT1(b); } while (0)
    PH(0, 0, phase_prep(lds, p));
    PH(1, 1, phase_norm_mod(p, 0, 0, NTOK));
#define LAYER(L, pb) \
        PH(2, pb + 0, phase_zgemm(lds, p, L)); \
        PH(3, pb + 1, phase_b(lds, p, L)); \
        PH(4, pb + 2, phase_c(lds, p, L)); \
        PH(5, pb + 3, phase_d(lds, p, L)); \
        PH(7, pb + 4, phase_router(lds, p, L)); \
        PH(8, pb + 5, phase_gateup(lds, p, L)); \
        PH(9, pb + 6, phase_down(lds, p, L)); \
        PH(10, pb + 7, phase_combine(p, L));
    LAYER(0, PH_LAYER0)
    LAYER(1, PH_LAYER1)
#ifdef PROBE_MASK
    if (blockIdx.x == 0) {
        const unsigned long long tend = __builtin_amdgcn_s_memrealtime();
        while (__builtin_amdgcn_s_memrealtime() - tend < (unsigned long long)PROBE_AMP * tacc) __builtin_amdgcn_s_sleep(8);
    }
#endif
#undef IN
#undef SEAM
}

extern "C" void kernel_launch(void* const* d_in, const int* in_sizes, int n_in, void* d_out, int out_size, void* d_ws, size_t ws_size, hipStream_t stream) {
    static int grid = 0;
    if (grid == 0) {
        if (n_in != 29 || in_sizes[0] != NLAT * D || out_size != NLAT * D || ws_size < WS_END) {
            fprintf(stderr, "kernel_launch: unexpected shapes / workspace (n_in %d, ws %zu, need %zu); nothing launched\n", n_in, ws_size, (size_t)WS_END); grid = -1; return; }
        int dev = 0, cus = 0, per_cu = 0;
        if (hipGetDevice(&dev) != hipSuccess || hipDeviceGetAttribute(&cus, hipDeviceAttributeMultiprocessorCount, dev) != hipSuccess) { grid = -1; return; }
        if (hipFuncSetAttribute((const void*)mk_fwd, hipFuncAttributeMaxDynamicSharedMemorySize, LDS_BYTES) != hipSuccess) { grid = -1; return; }
        if (hipOccupancyMaxActiveBlocksPerMultiprocessor(&per_cu, (const void*)mk_fwd, NTHREADS, LDS_BYTES) != hipSuccess || per_cu < 1) { fprintf(stderr, "kernel_launch: occupancy query says %d\n", per_cu); }
        (void)hipGetLastError();
        grid = cus;
    }
    if (grid < 0) return;
    (void)hipMemsetAsync((char*)d_ws + WS_CTL, 0, CTL_ZERO_BYTES, stream);
    P a{};
    for (int i = 0; i < 29; ++i) a.in[i] = (const float*)d_in[i];
    a.out = (float*)d_out; a.ws = (unsigned char*)d_ws;
#if MK_PER_PHASE
    for (int ph = 0; ph < NPHASES; ++ph) { a.ph_lo = ph; a.ph_hi = ph + 1; hipLaunchKernelGGL(mk_fwd, dim3(grid), dim3(NTHREADS), LDS_BYTES, stream, a); }
#else
    a.ph_lo = 0; a.ph_hi = NPHASES;
    hipLaunchKernelGGL(mk_fwd, dim3(grid), dim3(NTHREADS), LDS_BYTES, stream, a);
#endif
}
```

```cpp
#include <hip/hip_runtime.h>
#include <cstdio>
#include <cstdint>

#ifndef MK_PER_PHASE
#define MK_PER_PHASE 0
#endif

typedef unsigned short bf16_t;
typedef short bf16x8 __attribute__((ext_vector_type(8)));
typedef float f32x4 __attribute__((ext_vector_type(4)));
typedef unsigned u32x4 __attribute__((ext_vector_type(4)));
typedef unsigned u32x2 __attribute__((ext_vector_type(2)));
typedef float f32x16 __attribute__((ext_vector_type(16)));
typedef short v4i16_t __attribute__((ext_vector_type(4)));
#define LAS __attribute__((address_space(3)))

constexpr int D = 1024, BATCH = 16, SEQ = 2048, CTXL = 256;
constexpr int NLAT = BATCH * SEQ, NCTX = BATCH * CTXL, NTOK = NLAT + NCTX;
constexpr int ZC = 1792;
constexpr int Z_RQ = 512, Z_RK = 640, Z_RV = 768, Z_RG = 1024, Z_CQ = 1280, Z_CKV = 1536, Z_KR = 1664, Z_END = 1696;
constexpr int NEXP = 64, TOPK = 6, EDIM = 256;
constexpr float NORM_EPS = 1e-6f;
constexpr int NTHREADS = 512, NWAVES = 8;

constexpr size_t MiB = 1u << 20;
constexpr size_t WS_CTL = 0, CTL_ZERO_BYTES = 1 * MiB;
constexpr size_t WS_MODV = 1 * MiB;
constexpr size_t WS_ROPE = 2 * MiB;
constexpr size_t WS_WIN = 3 * MiB;
constexpr size_t WS_WUQ = 10 * MiB;
constexpr size_t WS_WUKV = 11 * MiB;
constexpr size_t WS_WOUT = 12 * MiB;
constexpr size_t WS_RT = 16 * MiB;
constexpr size_t WS_SHGU = 17 * MiB;
constexpr size_t WS_SHD = 19 * MiB;
constexpr size_t WS_EGU = 20 * MiB;
constexpr size_t WS_ED = 84 * MiB;
constexpr size_t WS_H1 = 20 * MiB;
constexpr size_t WS_X = 116 * MiB;
constexpr size_t WS_H = 188 * MiB;
constexpr size_t WS_CC = WS_H;
constexpr size_t WS_Z = 260 * MiB;
constexpr size_t WS_Y = WS_Z;
constexpr size_t WS_Q = 386 * MiB;
constexpr size_t WS_K = 440 * MiB;
constexpr size_t WS_V = 494 * MiB;
constexpr size_t WS_KV = 530 * MiB;
constexpr size_t WS_SLOT = 188 * MiB;
constexpr size_t WS_ACT = 441 * MiB;
constexpr size_t WS_LTOK = 583 * MiB;
constexpr size_t WS_LW = 592 * MiB;
constexpr size_t WS_SS = 601 * MiB;
constexpr size_t WS_END = 603 * MiB;
constexpr int LCAP = NTOK;
static_assert(WS_SLOT + ((size_t)NTOK * 7 + 1) * 1024 <= WS_ACT && WS_ACT + (size_t)1136 * 256 * 512 <= WS_LTOK, "MoE buffers");

constexpr int CW_TMO = 0;
constexpr int CW_BAR = 4096;
constexpr int CW_ECNT = 8192;

constexpr int LDS_BYTES = 162816;
constexpr int MISC_OFF = LDS_BYTES - 256;
constexpr int RB0_OFF = 131072;
constexpr int RB1_OFF = 149504;
constexpr int ETAB_OFF = 159744;
constexpr int GEMM_LDS = 36864;
constexpr int ROWSS_OFF = 36864;
constexpr int LG_OFF = 37376;

#define XB_TMO      128
#define XB_XCNT(j)  (256  + 64 * (j))
#define XB_XSUB(j)  (1280 + 64 * (j))
#define XB_XGEN(j)  (2304 + 64 * (j))
#define XB_TOP      3328
#define XB_TOPGEN   3392
#define XCD_BAR_WORDS 3456
#define XB_SPIN_CAP (1u << 24)
__device__ __forceinline__ unsigned xb_ld(unsigned* p)              { return __hip_atomic_load(p, __ATOMIC_RELAXED, __HIP_MEMORY_SCOPE_AGENT); }
__device__ __forceinline__ unsigned xb_add(unsigned* p, unsigned v) { return __hip_atomic_fetch_add(p, v, __ATOMIC_RELAXED, __HIP_MEMORY_SCOPE_AGENT); }
__device__ __forceinline__ unsigned xb_xcc_id() { return (unsigned)__builtin_amdgcn_s_getreg((3 << 11) | 20) & 0xFu; }
#define XB_SPIN(cond, bar) do { unsigned _sp = 0; while (cond) { __builtin_amdgcn_s_sleep(1); \
    if ((++_sp & 255u) == 0u) { if (xb_ld(&(bar)[XB_TMO])) break; if (_sp > XB_SPIN_CAP) { atomicAdd(&(bar)[XB_TMO], 1u); break; } } } } while (0)
struct XcdBarrier { unsigned* bar; unsigned x; volatile LAS unsigned* st; };
__device__ __forceinline__ XcdBarrier xcd_barrier_post(unsigned* bar, volatile LAS unsigned* st) {
    XcdBarrier b; b.bar = bar; b.x = xb_xcc_id(); b.st = st;
    if (threadIdx.x == 0) (void)xb_add(&bar[XB_XCNT(b.x)], 1u);
    return b;
}
__device__ __forceinline__ void xcd_barrier_complete(unsigned* bar, unsigned x, unsigned& nloc, unsigned& nx) {
    const unsigned G = gridDim.x * gridDim.y * gridDim.z;
    unsigned sum, cnt, mine, sp = 0u;
    for (;;) {
        sum = 0u; cnt = 0u; mine = 0u;
#pragma unroll
        for (unsigned j = 0; j < 16; ++j) { const unsigned c = xb_ld(&bar[XB_XCNT(j)]); sum += c; cnt += (c > 0u) ? 1u : 0u; mine = (j == x) ? c : mine; }
        if (sum == G) break;
        __builtin_amdgcn_s_sleep(1);
        if ((++sp & 255u) == 0u) { if (xb_ld(&bar[XB_TMO])) break; if (sp > XB_SPIN_CAP) { atomicAdd(&bar[XB_TMO], 1u); break; } }
    }
    nloc = mine > 0u ? mine : 1u; nx = cnt > 0u ? cnt : 1u;
}
__device__ __forceinline__ void xcd_barrier(const XcdBarrier& b) {
    asm volatile("s_waitcnt vmcnt(0)" ::: "memory");
    __syncthreads();
    if (threadIdx.x == 0) {
        unsigned* bar = b.bar;
        __builtin_amdgcn_s_waitcnt(0);
        unsigned nloc = b.st[0], nx = b.st[1];
        if (nloc == 0u) { xcd_barrier_complete(bar, b.x, nloc, nx); b.st[0] = nloc; b.st[1] = nx; }
        const unsigned old = xb_add(&bar[XB_XSUB(b.x)], 1u);
        const unsigned gen = old / nloc;
        if (old + 1u == (gen + 1u) * nloc) {
            __builtin_amdgcn_fence(__ATOMIC_RELEASE, "agent");
            asm volatile("s_waitcnt vmcnt(0)" ::: "memory");
            const unsigned og = xb_add(&bar[XB_TOP], 1u);
            const unsigned tg = og / nx;
            if (og + 1u == (tg + 1u) * nx) xb_add(&bar[XB_TOPGEN], 1u);
            else XB_SPIN(xb_ld(&bar[XB_TOPGEN]) == tg, bar);
            __builtin_amdgcn_fence(__ATOMIC_ACQUIRE, "agent");
            xb_add(&bar[XB_XGEN(b.x)], 1u);
            asm volatile("s_waitcnt vmcnt(0)" ::: "memory");
        } else {
            XB_SPIN(xb_ld(&bar[XB_XGEN(b.x)]) == gen, bar);
            __builtin_amdgcn_fence(__ATOMIC_ACQUIRE, "agent");
            asm volatile("s_waitcnt vmcnt(0)" ::: "memory");
        }
    }
    __syncthreads();
}

__device__ __forceinline__ float bf2f(unsigned h) { return __uint_as_float(h << 16); }
__device__ __forceinline__ unsigned f2bf(float f) { unsigned u = __float_as_uint(f); return (u + 0x7fffu + ((u >> 16) & 1u)) >> 16; }
__device__ __forceinline__ unsigned pk2(float lo, float hi) { return f2bf(lo) | (f2bf(hi) << 16); }
typedef float f32x2_t __attribute__((ext_vector_type(2)));
typedef __bf16 bf16x2_t __attribute__((ext_vector_type(2)));
__device__ __forceinline__ unsigned cvtpk(float lo, float hi) { f32x2_t v = {lo, hi}; bf16x2_t b = __builtin_convertvector(v, bf16x2_t); return __builtin_bit_cast(unsigned, b); }
__device__ __forceinline__ float lo16(unsigned w) { return __uint_as_float(w << 16); }
__device__ __forceinline__ float hi16(unsigned w) { return __uint_as_float(w & 0xffff0000u); }
__device__ __forceinline__ float wave_sum(float v) {
#pragma unroll
    for (int o = 1; o < 64; o <<= 1) v += __shfl_xor(v, o);
    return v;
}
__device__ __forceinline__ float siluf(float v) { return v * __builtin_amdgcn_rcpf(1.f + __expf(-v)); }
__device__ __forceinline__ int mod_row(int tok) { return tok < NLAT ? (tok >> 11) : 16; }

struct P { const float* in[29]; float* out; unsigned char* ws; int ph_lo, ph_hi; };

__device__ __forceinline__ bf16_t* x_row(const P& p, int tok) { return (bf16_t*)(p.ws + WS_X) + (size_t)tok * D; }
__device__ __forceinline__ const float* x_in_row(const P& p, int tok) {
    return tok < NLAT ? p.in[0] + (size_t)tok * D : p.in[2] + (size_t)(tok - NLAT) * D;
}

template <int MF, class RowSrc, class Epi>
__device__ __forceinline__ void gemm_tile(unsigned char* lds, const RowSrc& rs, const bf16_t* Bt, int ldb, int K, const Epi& epi) {
    constexpr int ROWS = 32 * MF, NPA = ROWS * 8;
    const int tid = threadIdx.x, lane = tid & 63, wid = tid >> 6, wr = wid >> 2, wc = wid & 3, fr = lane & 15, fq = lane >> 4;
    bf16_t* As = (bf16_t*)lds; bf16_t* Bs = As + ROWS * 72;
    const bf16_t* ap[3]; int al[3];
#pragma unroll
    for (int i = 0; i < 3; ++i) { const int id = tid + 512 * i, r = id >> 3, c = (id & 7) * 8; ap[i] = (id < NPA) ? rs(r) + c : nullptr; al[i] = r * 72 + c; }
    const int lr = tid >> 2, lc = (tid & 3) * 16;
    const bf16_t* bp = Bt + (size_t)lr * ldb + lc;
    u32x4 a[3], b0 = *(const u32x4*)bp, b1 = *(const u32x4*)(bp + 8);
#pragma unroll
    for (int i = 0; i < 3; ++i) if (ap[i]) a[i] = *(const u32x4*)ap[i];
    f32x4 acc[MF][2];
#pragma unroll
    for (int m = 0; m < MF; ++m)
#pragma unroll
        for (int n = 0; n < 2; ++n) acc[m][n] = (f32x4){0.f, 0.f, 0.f, 0.f};
    for (int k0 = 0; k0 < K; k0 += 64) {
        __syncthreads();
#pragma unroll
        for (int i = 0; i < 3; ++i) if (ap[i]) *(u32x4*)(As + al[i]) = a[i];
        *(u32x4*)(Bs + lr * 72 + lc) = b0; *(u32x4*)(Bs + lr * 72 + lc + 8) = b1;
        __syncthreads();
        if (k0 + 64 < K) {
#pragma unroll
            for (int i = 0; i < 3; ++i) if (ap[i]) { ap[i] += 64; a[i] = *(const u32x4*)ap[i]; }
            bp += 64; b0 = *(const u32x4*)bp; b1 = *(const u32x4*)(bp + 8);
        }
#pragma unroll
        for (int kk = 0; kk < 2; ++kk) {
            bf16x8 af[MF], bfr[2];
#pragma unroll
            for (int m = 0; m < MF; ++m) af[m] = *(const bf16x8*)(As + (wr * 16 * MF + m * 16 + fr) * 72 + kk * 32 + fq * 8);
#pragma unroll
            for (int n = 0; n < 2; ++n) bfr[n] = *(const bf16x8*)(Bs + (wc * 32 + n * 16 + fr) * 72 + kk * 32 + fq * 8);
#pragma unroll
            for (int m = 0; m < MF; ++m)
#pragma unroll
                for (int n = 0; n < 2; ++n) acc[m][n] = __builtin_amdgcn_mfma_f32_16x16x32_bf16(bfr[n], af[m], acc[m][n], 0, 0, 0);
        }
    }
#pragma unroll
    for (int m = 0; m < MF; ++m)
#pragma unroll
        for (int n = 0; n < 2; ++n) epi(wr * 16 * MF + m * 16 + fr, wc * 32 + n * 16 + 4 * fq, acc[m][n]);
}

namespace ge {
constexpr int BM = 256, BK = 64, HALF = 128, HTB = HALF * BK * 2;
__device__ __forceinline__ int lds_byte(int r, int c) { const int st = (r >> 4) * 2 + (c >> 5), rr = r & 15, cc = c & 31, ob = rr * 64 + cc * 2; return st * 1024 + (ob ^ (((ob >> 9) & 1) << 5)); }
__device__ __forceinline__ void stage_rc(int b, int& R, int& C) { const int st = b / 1024, sb = b % 1024, swz = sb ^ (((sb >> 9) & 1) << 5); R = (st >> 1) * 16 + swz / 64; C = (st & 1) * 32 + (swz % 64) / 2; }
struct Unit { const char* B; int a, b, c, d; };
typedef f32x4 Acc[2][2][4][2];

template <class Sched, class Epi, bool ALIGN_EPI>
__device__ __forceinline__ void gemm_stream(LAS unsigned char* lds, const char* Ab, int K, const Sched& S, const Epi& E) {
    const int tid = threadIdx.x, wid = __builtin_amdgcn_readfirstlane(tid >> 6), lane = tid & 63, wr = wid >> 2, wc = wid & 3, fr = lane & 15, fq = lane >> 4;
    const int nt = K / BK;
    int Rr[2], Cc[2]; unsigned voffB[2];
#pragma unroll
    for (int i = 0; i < 2; ++i) { stage_rc(tid * 16 + i * 8192, Rr[i], Cc[i]);
        const int rho = Rr[i] & 31, Rb = (Rr[i] & ~31) + 8 * ((rho & 15) >> 2) + 4 * (rho >> 4) + (rho & 3);
        voffB[i] = (unsigned)(Rb * K + Cc[i]) * 2u; }
    const size_t kstep = (size_t)(BK * 2), hstepB = (size_t)HALF * K * 2;
    const unsigned ldsw = (unsigned)wid * 1024u;
    const int aoff = lds_byte(wr * 64 + fr, fq * 8), boff = lds_byte(wc * 32 + fr, fq * 8);
#define GE_SA(b, h) (((b) * 2 + (h)) * HTB)
#define GE_SB(b, h) ((4 + (b) * 2 + (h)) * HTB)
#define GE_GLDS(gp, ldsoff) __builtin_amdgcn_global_load_lds((const unsigned*)(gp), (LAS unsigned*)(lds + (ldsoff)), 16, 0, 0)
#define GE_STAGE_B(bufoff, gbase) do { GE_GLDS((const char*)(gbase) + voffB[0], (bufoff) + ldsw); GE_GLDS((const char*)(gbase) + voffB[1], (bufoff) + ldsw + 8192); } while (0)
#define GE_STAGE_A(bufoff, kbytes, o0, o1) do { GE_GLDS(Ab + (kbytes) + (o0), (bufoff) + ldsw); GE_GLDS(Ab + (kbytes) + (o1), (bufoff) + ldsw + 8192); } while (0)
#define GE_LDA(dst, b, h) do { _Pragma("unroll") for (int m = 0; m < 4; ++m) _Pragma("unroll") for (int k = 0; k < 2; ++k) dst[m][k] = *(const LAS bf16x8*)(lds + GE_SA(b, h) + aoff + m * 2048 + k * 1024); } while (0)
#define GE_LDB(dst, b, h) do { _Pragma("unroll") for (int n = 0; n < 2; ++n) _Pragma("unroll") for (int k = 0; k < 2; ++k) dst[n][k] = *(const LAS bf16x8*)(lds + GE_SB(b, h) + boff + n * 2048 + k * 1024); } while (0)
#define GE_MMA(ai, bj, At, Bt) do { __builtin_amdgcn_s_setprio(1); _Pragma("unroll") for (int m = 0; m < 4; ++m) _Pragma("unroll") for (int n = 0; n < 2; ++n) _Pragma("unroll") for (int k = 0; k < 2; ++k) \
        acc[ai][bj][m][n] = __builtin_amdgcn_mfma_f32_16x16x32_bf16(Bt[n][k], At[m][k], acc[ai][bj][m][n], 0, 0, 0); __builtin_amdgcn_s_setprio(0); } while (0)
#define GE_WAIT_V(n) asm volatile("s_waitcnt vmcnt(" #n ")" ::: "memory")
#define GE_WAIT_L(n) asm volatile("s_waitcnt lgkmcnt(" #n ")" ::: "memory")
#define GE_BAR __builtin_amdgcn_s_barrier()
#define GE_SCHED __builtin_amdgcn_sched_barrier(0)
    Unit cur, nxt; int ui = 0;
    if (!S.next(0, cur)) return;
    Acc acc;
#pragma unroll
    for (int a = 0; a < 2; ++a)
#pragma unroll
        for (int b = 0; b < 2; ++b)
#pragma unroll
            for (int m = 0; m < 4; ++m)
#pragma unroll
                for (int n = 0; n < 2; ++n) acc[a][b][m][n] = (f32x4){0.f, 0.f, 0.f, 0.f};
    bf16x8 At[4][2], B0[2][2], B1[2][2];
    unsigned oc00, oc01, oc10, oc11, on00, on01, on10, on11;
    oc00 = S.aoff(0, cur, Rr[0]) + (unsigned)Cc[0] * 2u; oc01 = S.aoff(0, cur, Rr[1]) + (unsigned)Cc[1] * 2u;
    oc10 = S.aoff(0, cur, Rr[0] + 128) + (unsigned)Cc[0] * 2u; oc11 = S.aoff(0, cur, Rr[1] + 128) + (unsigned)Cc[1] * 2u;
    const char* cB = cur.B;
    GE_STAGE_B(GE_SB(0, 0), cB); GE_STAGE_B(GE_SB(0, 1), cB + hstepB); GE_STAGE_A(GE_SA(0, 0), 0, oc00, oc01); GE_STAGE_A(GE_SA(0, 1), 0, oc10, oc11);
    if (wr == 1) GE_BAR;
    GE_WAIT_V(2); GE_BAR;
    GE_STAGE_B(GE_SB(1, 0), cB + kstep); GE_STAGE_A(GE_SA(1, 0), kstep, oc00, oc01); GE_STAGE_B(GE_SB(1, 1), cB + hstepB + kstep);
    GE_WAIT_V(6); GE_BAR;
    for (;;) {
        const bool has_next = S.next(ui + 1, nxt);
        const char* nB = has_next ? nxt.B : cB;
        if (has_next) {
            on00 = S.aoff(ui + 1, nxt, Rr[0]) + (unsigned)Cc[0] * 2u; on01 = S.aoff(ui + 1, nxt, Rr[1]) + (unsigned)Cc[1] * 2u;
            on10 = S.aoff(ui + 1, nxt, Rr[0] + 128) + (unsigned)Cc[0] * 2u; on11 = S.aoff(ui + 1, nxt, Rr[1] + 128) + (unsigned)Cc[1] * 2u;
        } else { on00 = oc00; on01 = oc01; on10 = oc10; on11 = oc11; }
#pragma unroll 1
        for (int t = 0; t < nt; t += 2) {
            const bool last = (t == nt - 2);
            const size_t k1 = (size_t)(t + 1) * kstep;
            const size_t k2 = last ? 0 : (size_t)(t + 2) * kstep, k3 = k2 + kstep;
            const char* b2 = last ? nB : cB + (size_t)(t + 2) * kstep; const char* b3 = b2 + kstep;
            const unsigned o00 = last ? on00 : oc00, o01 = last ? on01 : oc01, o10 = last ? on10 : oc10, o11 = last ? on11 : oc11;
            GE_LDB(B0, 0, 0); GE_LDB(B1, 0, 1); GE_SCHED; GE_LDA(At, 0, 0); GE_STAGE_A(GE_SA(1, 1), k1, oc10, oc11);
            GE_WAIT_V(8); GE_WAIT_L(0); GE_BAR; GE_MMA(0, 0, At, B0); GE_MMA(0, 1, At, B1); GE_BAR; GE_SCHED;
            GE_LDA(At, 0, 1); GE_STAGE_B(GE_SB(0, 0), b2); GE_STAGE_B(GE_SB(0, 1), b2 + hstepB); GE_STAGE_A(GE_SA(0, 0), k2, o00, o01);
            GE_WAIT_V(8); GE_WAIT_L(0); GE_BAR; GE_MMA(1, 0, At, B0); GE_MMA(1, 1, At, B1); GE_BAR; GE_SCHED;
            GE_LDB(B0, 1, 0); GE_LDB(B1, 1, 1); GE_SCHED; GE_LDA(At, 1, 0); GE_STAGE_A(GE_SA(0, 1), k2, o10, o11);
            GE_WAIT_V(8); GE_WAIT_L(0); GE_BAR; GE_MMA(0, 0, At, B0); GE_MMA(0, 1, At, B1); GE_BAR; GE_SCHED;
            GE_LDA(At, 1, 1); GE_STAGE_B(GE_SB(1, 0), b3); GE_STAGE_B(GE_SB(1, 1), b3 + hstepB); GE_STAGE_A(GE_SA(1, 0), k3, o00, o01);
            GE_WAIT_V(8); GE_WAIT_L(0); GE_BAR; GE_MMA(1, 0, At, B0); GE_MMA(1, 1, At, B1); GE_BAR; GE_SCHED;
        }
        if constexpr (ALIGN_EPI) { if (wr == 0) GE_BAR; }
        E(acc, cur, wr, wc, fr, fq);
        if (!has_next) break;
#pragma unroll
        for (int a = 0; a < 2; ++a)
#pragma unroll
            for (int b = 0; b < 2; ++b)
#pragma unroll
                for (int m = 0; m < 4; ++m)
#pragma unroll
                    for (int n = 0; n < 2; ++n) acc[a][b][m][n] = (f32x4){0.f, 0.f, 0.f, 0.f};
        cur = nxt; cB = nB; ++ui; oc00 = on00; oc01 = on01; oc10 = on10; oc11 = on11;
        if constexpr (ALIGN_EPI) { if (wr == 1) GE_BAR; }
    }
    GE_WAIT_V(0);
    if constexpr (!ALIGN_EPI) { if (wr == 0) GE_BAR; }
    GE_BAR;
#undef GE_SA
#undef GE_SB
#undef GE_GLDS
#undef GE_STAGE_A
#undef GE_STAGE_B
#undef GE_LDA
#undef GE_LDB
#undef GE_MMA
#undef GE_WAIT_V
#undef GE_WAIT_L
#undef GE_BAR
#undef GE_SCHED
}
template <class F> struct EpiFn {
    F f;
    __device__ __forceinline__ void operator()(const Acc& acc, const Unit& u, int wr, int wc, int fr, int fq) const {
#pragma unroll
        for (int ai = 0; ai < 2; ++ai)
#pragma unroll
            for (int m = 0; m < 4; ++m)
#pragma unroll
                for (int bj = 0; bj < 2; ++bj) f(u, ai * 128 + wr * 64 + m * 16 + fr, bj * 128 + wc * 32 + 8 * fq, acc[ai][bj][m][0], acc[ai][bj][m][1]);
    }
};
struct DenseOrder {
    int nM, nN, nwg, G, c; const char* Bt; size_t btile; unsigned arow;
    __device__ __forceinline__ bool next(int i, Unit& u) const {
        const long L = (long)i * G + c; if (L >= nwg) return false;
        int wgid = (int)L; { const int q = nwg / 8, r = nwg % 8, xcd = wgid % 8, off = wgid / 8; wgid = (xcd < r ? xcd * (q + 1) : r * (q + 1) + (xcd - r) * q) + off; }
        const int nig = 8 * nN, gid = wgid / nig, fm = gid * 8, gsz = (nM - fm) < 8 ? (nM - fm) : 8;
        u.a = fm + ((wgid % nig) % gsz); u.b = (wgid % nig) / gsz; u.c = 0; u.d = 0; u.B = Bt + (size_t)u.b * btile; return true;
    }
    __device__ __forceinline__ unsigned aoff(int, const Unit& u, int R) const { return (unsigned)(u.a * 256 + R) * arow; }
};
}

struct TMap { const float* s0; const float* s1; int ld; int nvalid; const float* ksc; float gsc; };
template <int MODE> __device__ __forceinline__ const float* tmap_src(const float* s0, const float* s1, int nvalid, int n) {
    if (MODE == 0) return n < nvalid ? s0 + n : nullptr;
    if (MODE == 1) { const int h = n / 96, j = n % 96; const int c = j < 64 ? j : 64 + ((j - 64) & 1) * 16 + ((j - 64) >> 1); return s0 + h * 96 + c; }
    return ((n & 1) ? s1 : s0) + (n >> 1);
}
template <int MODE> __device__ __forceinline__ void transpose_unit(float* scr, const float* s0, const float* s1, int ld, int nvalid, const float* ksc, float gsc, int K, bf16_t* dst, int kb, int nb, int kvalid = 1 << 30) {
    const int tid = threadIdx.x, k0 = kb * 64, n0 = nb * 64;
    const int nn = tid & 63; const float* sp = tmap_src<MODE>(s0, s1, nvalid, n0 + nn);
#pragma unroll
    for (int i = 0; i < 8; ++i) {
        const int kk = (tid >> 6) + 8 * i; float v = (sp && k0 + kk < kvalid) ? sp[(size_t)(k0 + kk) * ld] : 0.f;
        if (ksc && k0 + kk < kvalid) v *= ksc[k0 + kk];
        scr[kk * 65 + nn] = v * gsc;
    }
    __syncthreads();
    {
        const int n2 = tid >> 3, kc = tid & 7; const float* s = scr + (kc * 8) * 65 + n2;
        u32x4 o; o.x = pk2(s[0], s[65]); o.y = pk2(s[2 * 65], s[3 * 65]); o.z = pk2(s[4 * 65], s[5 * 65]); o.w = pk2(s[6 * 65], s[7 * 65]);
        *(u32x4*)(dst + (size_t)(n0 + n2) * K + k0 + kc * 8) = o;
    }
    __syncthreads();
}
template <int MODE> __device__ __forceinline__ void transpose_matrix(float* scr, const float* s0, const float* s1, int ld, int nvalid, const float* ksc, float gsc, int K, int Nd, bf16_t* dst, int& rot, int kvalid = 1 << 30) {
    const int nkb = K / 64, nnb = Nd / 64, nu = nkb * nnb, G = gridDim.x;
    int first = ((int)blockIdx.x - rot) % G; if (first < 0) first += G;
    for (int u = first; u < nu; u += G) transpose_unit<MODE>(scr, s0, s1, ld, nvalid, ksc, gsc, K, dst, u / nnb, u % nnb, kvalid);
    rot = (rot + nu) % G;
}
__device__ __forceinline__ void convert_expert_weights(unsigned char* lds, const P& p, int L) {
    float* scr = (float*)lds; const int G = gridDim.x, tid = threadIdx.x;
    constexpr int S = 261;
    bf16_t* egu = (bf16_t*)(p.ws + WS_EGU); bf16_t* ed = (bf16_t*)(p.ws + WS_ED);
    for (int ub = blockIdx.x; ub < NEXP * 48; ub += G) {
        const int e = ub / 48, r = (ub % 48) * 4;
        bf16_t* dst; int K, k0;
        if (r < 128) {
            const int kb = r >> 3, nb0 = r & 7; k0 = kb * 64; K = D; dst = egu + ((size_t)e * 512 + nb0 * 64) * D;
            const float* gsrc = p.in[22] + ((size_t)L * NEXP + e) * D * EDIM + nb0 * 32; const float* usrc = p.in[23] + ((size_t)L * NEXP + e) * D * EDIM + nb0 * 32;
            f32x4 v[8];
#pragma unroll
            for (int i = 0; i < 8; ++i) { const int idx = tid + 512 * i, kk = idx >> 6, c = idx & 63; v[i] = *(const f32x4*)((c < 32 ? gsrc : usrc) + (size_t)(k0 + kk) * EDIM + (c & 31) * 4); }
#pragma unroll
            for (int i = 0; i < 8; ++i) { const int idx = tid + 512 * i, kk = idx >> 6, c = idx & 63; float* d = scr + kk * S + 8 * (c & 31) + (c >> 5);
                d[0] = v[i].x; d[2] = v[i].y; d[4] = v[i].z; d[6] = v[i].w; }
        } else {
            const int r2 = r - 128, kb = r2 >> 4, nb0 = r2 & 15; k0 = kb * 64; K = EDIM; dst = ed + ((size_t)e * D + nb0 * 64) * EDIM;
            const float* src = p.in[24] + ((size_t)L * NEXP + e) * EDIM * D + nb0 * 64;
            f32x4 v[8];
#pragma unroll
            for (int i = 0; i < 8; ++i) { const int idx = tid + 512 * i, kk = idx >> 6, c = idx & 63; v[i] = *(const f32x4*)(src + (size_t)(k0 + kk) * D + c * 4); }
#pragma unroll
            for (int i = 0; i < 8; ++i) { const int idx = tid + 512 * i, kk = idx >> 6, c = idx & 63; float* d = scr + kk * S + 4 * c;
                d[0] = v[i].x; d[1] = v[i].y; d[2] = v[i].z; d[3] = v[i].w; }
        }
        __syncthreads();
#pragma unroll
        for (int i = 0; i < 4; ++i) {
            const int id = tid + 512 * i, n = id >> 3, kc = id & 7; const float* sp = scr + (kc * 8) * S + n;
            u32x4 o; o.x = cvtpk(sp[0], sp[S]); o.y = cvtpk(sp[2 * S], sp[3 * S]); o.z = cvtpk(sp[4 * S], sp[5 * S]); o.w = cvtpk(sp[6 * S], sp[7 * S]);
            *(u32x4*)(dst + (size_t)n * K + k0 + kc * 8) = o;
        }
        __syncthreads();
    }
}
__device__ __forceinline__ void prep_mod_unit(unsigned char* lds, const P& p, int u) {
    float* sc = (float*)lds;
    float* part = sc + 17 * 1024;
    const int tid = threadIdx.x;
    const float* c = p.in[1]; const float* cctx = p.in[3];
    for (int i = tid; i < 17 * 1024; i += NTHREADS) { const int r = i >> 10, k = i & 1023; const float v = r < 16 ? c[r * 1024 + k] : cctx[k]; sc[i] = v * __builtin_amdgcn_rcpf(1.f + __expf(-v)); }
    __syncthreads();
    const int L = u / 192, cg = u % 192, ks = tid >> 5, cl = tid & 31, col = cg * 32 + cl;
    const float* w = p.in[4] + (size_t)L * 1024 * 6144 + (size_t)(ks * 64) * 6144 + col;
    float acc[17];
#pragma unroll
    for (int r = 0; r < 17; ++r) acc[r] = 0.f;
#pragma unroll 8
    for (int k = 0; k < 64; ++k) {
        const float wv = w[(size_t)k * 6144];
#pragma unroll
        for (int r = 0; r < 17; ++r) acc[r] += sc[r * 1024 + ks * 64 + k] * wv;
    }
#pragma unroll
    for (int r = 0; r < 17; ++r) part[(ks * 17 + r) * 32 + cl] = acc[r];
    __syncthreads();
    float* modv = (float*)(p.ws + WS_MODV);
    for (int i = tid; i < 17 * 32; i += NTHREADS) {
        const int r = i >> 5, c2 = i & 31;
        float s2 = p.in[5][L * 6144 + cg * 32 + c2];
#pragma unroll
        for (int q = 0; q < 16; ++q) s2 += part[(q * 17 + r) * 32 + c2];
        modv[((size_t)L * 17 + r) * 6144 + cg * 32 + c2] = s2;
    }
    __syncthreads();
}
__device__ __forceinline__ void phase_prep0(unsigned char* lds, const P& p) {
    const int tid = threadIdx.x, G = gridDim.x, bid = blockIdx.x;
    {
        float* ct = (float*)(p.ws + WS_ROPE); float* st = ct + 2048 * 16;
        for (int i = bid * NTHREADS + tid; i < 2048 * 16; i += G * NTHREADS) {
            const int pos = i >> 4, f = i & 15;
            const float inv = powf(10000.f, -(float)(f & 7) / 8.f);
            const float ang = (float)(f < 8 ? (pos >> 6) : (pos & 63)) * inv;
            ct[i] = cosf(ang); st[i] = sinf(ang);
        }
    }
    for (int u = bid; u < 384; u += G) prep_mod_unit(lds, p, u);
}
__device__ __forceinline__ void phase_prep1(unsigned char* lds, const P& p) {
    float* scr = (float*)lds; int rot = 0;
    for (int L = 0; L < 2; ++L) {
        transpose_matrix<0>(scr, p.in[7] + (size_t)L * D * Z_END, nullptr, Z_END, Z_END, nullptr, 1.f, D, ZC, (bf16_t*)(p.ws + WS_WIN) + (size_t)L * ZC * D, rot);
        transpose_matrix<1>(scr, p.in[15] + (size_t)L * 256 * 768, nullptr, 768, 768, p.in[14] + L * 256, 0.14724574f, 256, 768, (bf16_t*)(p.ws + WS_WUQ) + (size_t)L * 768 * 256, rot);
        transpose_matrix<0>(scr, p.in[17] + (size_t)L * 128 * 1024, nullptr, 1024, 1024, p.in[16] + L * 128, 1.f, 256, 1024, (bf16_t*)(p.ws + WS_WUKV) + (size_t)L * 1024 * 256, rot, 128);
        transpose_matrix<0>(scr, p.in[18] + (size_t)L * D * D, nullptr, D, D, nullptr, 1.f, D, D, (bf16_t*)(p.ws + WS_WOUT) + (size_t)L * D * D, rot);
        transpose_matrix<0>(scr, p.in[20] + (size_t)L * D * NEXP, nullptr, NEXP, NEXP, nullptr, 1.f, D, 128, (bf16_t*)(p.ws + WS_RT) + (size_t)L * 128 * D, rot);
        transpose_matrix<2>(scr, p.in[25] + (size_t)L * D * EDIM, p.in[26] + (size_t)L * D * EDIM, EDIM, 512, nullptr, 1.f, D, 512, (bf16_t*)(p.ws + WS_SHGU) + (size_t)L * 512 * D, rot);
        transpose_matrix<0>(scr, p.in[27] + (size_t)L * EDIM * D, nullptr, D, D, nullptr, 1.f, EDIM, D, (bf16_t*)(p.ws + WS_SHD) + (size_t)L * D * EDIM, rot);
    }
}

__device__ __forceinline__ void phase_norm_mod(const P& p, int L, int which  , int ntok) {
    const int tid = threadIdx.x, lane = tid & 63, wave = tid >> 6, gw = blockIdx.x * NWAVES + wave, NGW = gridDim.x * NWAVES;
    const float* nw = (which == 0 ? p.in[6] : p.in[19]) + L * D;
    const float* modv = (const float*)(p.ws + WS_MODV) + (size_t)L * 17 * 6144;
    bf16_t* H = (bf16_t*)(p.ws + WS_H);
    for (int tok = gw; tok < ntok; tok += NGW) {
        const f32x4* xr = (const f32x4*)x_in_row(p, tok) + lane;
        const float* mrow = modv + (size_t)mod_row(tok) * 6144 + which * 3072;
        f32x4 v[4]; float s = 0.f;
#pragma unroll
        for (int j = 0; j < 4; ++j) { v[j] = xr[64 * j]; s += v[j].x * v[j].x + v[j].y * v[j].y + v[j].z * v[j].z + v[j].w * v[j].w; }
        const float rstd = rsqrtf(wave_sum(s) * (1.f / D) + NORM_EPS);
        u32x2* o = (u32x2*)(H + (size_t)tok * D) + lane;
#pragma unroll
        for (int j = 0; j < 4; ++j) {
            const int k = 4 * lane + 256 * j;
            const f32x4 w4 = *(const f32x4*)(nw + k), sh = *(const f32x4*)(mrow + k), sc = *(const f32x4*)(mrow + 1024 + k);
            const float y0 = v[j].x * rstd * w4.x * (1.f + sc.x) + sh.x, y1 = v[j].y * rstd * w4.y * (1.f + sc.y) + sh.y;
            const float y2 = v[j].z * rstd * w4.z * (1.f + sc.z) + sh.z, y3 = v[j].w * rstd * w4.w * (1.f + sc.w) + sh.w;
            u32x2 w; w.x = pk2(y0, y1); w.y = pk2(y2, y3); o[64 * j] = w;
        }
    }
}

struct EpiZ {
    bf16_t* Z; float* ssq; float* sskv; bf16_t* Kb; const float* ct; const float* st;
    __device__ __forceinline__ void operator()(const ge::Acc& acc, const ge::Unit& u, int wr, int wc, int fr, int fq) const {
#pragma unroll
        for (int ai = 0; ai < 2; ++ai)
#pragma unroll
            for (int m = 0; m < 4; ++m) {
                const int row = u.a * 256 + ai * 128 + wr * 64 + m * 16 + fr;
#pragma unroll
                for (int bj = 0; bj < 2; ++bj) {
                    const f32x4 v0 = acc[ai][bj][m][0], v1 = acc[ai][bj][m][1];
                    u32x4 w; w.x = cvtpk(v0.x, v0.y); w.y = cvtpk(v0.z, v0.w); w.z = cvtpk(v1.x, v1.y); w.w = cvtpk(v1.z, v1.w);
                    *(u32x4*)(Z + (size_t)row * ZC + u.b * 256 + bj * 128 + wc * 32 + 8 * fq) = w;
                }
                if (u.b == 5) {
                    float sq = 0.f;
#pragma unroll
                    for (int bj = 0; bj < 2; ++bj)
#pragma unroll
                        for (int n = 0; n < 2; ++n) { const f32x4 v = acc[ai][bj][m][n]; sq += v.x * v.x + v.y * v.y + v.z * v.z + v.w * v.w; }
                    sq += __shfl_xor(sq, 16); sq += __shfl_xor(sq, 32);
                    if (fq == 0) ssq[(size_t)row * 4 + wc] = sq;
                }
                if (u.b == 6) {
                    float sq = 0.f;
#pragma unroll
                    for (int n = 0; n < 2; ++n) { const f32x4 v = acc[ai][0][m][n]; sq += v.x * v.x + v.y * v.y + v.z * v.z + v.w * v.w; }
                    sq += __shfl_xor(sq, 16); sq += __shfl_xor(sq, 32);
                    if (fq == 0) sskv[(size_t)row * 4 + wc] = sq;
                    if (wc == 0) {
                        const f32x4 a0 = acc[ai][1][m][0], a1 = acc[ai][1][m][1];
                        f32x4 b0, b1;
#pragma unroll
                        for (int j = 0; j < 4; ++j) { b0[j] = __shfl_xor(a0[j], 32); b1[j] = __shfl_xor(a1[j], 32); }
                        if (fq < 2) {
                            f32x4 c0 = (f32x4){1.f, 1.f, 1.f, 1.f}, c1 = c0, s0 = (f32x4){0.f, 0.f, 0.f, 0.f}, s1 = s0;
                            if (row < NLAT) { const int pos = row & (SEQ - 1); c0 = *(const f32x4*)(ct + pos * 16 + 8 * fq); c1 = *(const f32x4*)(ct + pos * 16 + 8 * fq + 4); s0 = *(const f32x4*)(st + pos * 16 + 8 * fq); s1 = *(const f32x4*)(st + pos * 16 + 8 * fq + 4); }
                            const f32x4 o10 = a0 * c0 - b0 * s0, o20 = a0 * s0 + b0 * c0, o11 = a1 * c1 - b1 * s1, o21 = a1 * s1 + b1 * c1;
                            u32x4 w0, w1; w0.x = cvtpk(o10.x, o20.x); w0.y = cvtpk(o10.y, o20.y); w0.z = cvtpk(o10.z, o20.z); w0.w = cvtpk(o10.w, o20.w);
                            w1.x = cvtpk(o11.x, o21.x); w1.y = cvtpk(o11.y, o21.y); w1.z = cvtpk(o11.z, o21.z); w1.w = cvtpk(o11.w, o21.w);
#pragma unroll
                            for (int h = 0; h < 8; ++h) { bf16_t* kp = Kb + (size_t)row * 768 + h * 96 + 64 + 16 * fq; *(u32x4*)kp = w0; *(u32x4*)(kp + 8) = w1; }
                        }
                    }
                }
            }
    }
};
__device__ __forceinline__ void phase_zgemm(unsigned char* lds, const P& p, int L) {
    const bf16_t* W = (const bf16_t*)(p.ws + WS_WIN) + (size_t)L * ZC * D;
    ge::DenseOrder S; S.nM = NTOK / 256; S.nN = ZC / 256; S.nwg = S.nM * S.nN; S.G = gridDim.x; S.c = blockIdx.x; S.Bt = (const char*)W; S.btile = (size_t)256 * D * 2; S.arow = D * 2;
    EpiZ E{(bf16_t*)(p.ws + WS_Z), (float*)(p.ws + WS_SS), (float*)(p.ws + WS_SS) + (size_t)NTOK * 4, (bf16_t*)(p.ws + WS_K), (const float*)(p.ws + WS_ROPE), (const float*)(p.ws + WS_ROPE) + 2048 * 16};
    ge::gemm_stream<ge::DenseOrder, EpiZ, true>((LAS unsigned char*)lds, (const char*)(p.ws + (L == 0 ? WS_H : WS_H1)), D, S, E);
}

__device__ __forceinline__ void conv_unit(unsigned char* lds, const P& p, int L, int s, int tt) {
    float* hg = (float*)lds;
    const int tid = threadIdx.x, lane = tid & 63, wave = tid >> 6;
    const int rb = s < 16 ? s * SEQ : NLAT + (s - 16) * CTXL, len = s < 16 ? SEQ : CTXL, t0 = tt * 64;
    const bf16_t* Z = (const bf16_t*)(p.ws + WS_Z);
    for (int i = tid; i < 94 * 64; i += NTHREADS) {
        const int jj = i >> 6, c4 = (i & 63) * 4, t = t0 - 15 + jj;
        f32x4 h = (f32x4){0.f, 0.f, 0.f, 0.f};
        if (t >= 0 && t < len) {
            const bf16_t* zr = Z + (size_t)(rb + t) * ZC;
            const u32x2 a = *(const u32x2*)(zr + c4), g = *(const u32x2*)(zr + 256 + c4);
            const float g0 = lo16(g.x), g1 = hi16(g.x), g2 = lo16(g.y), g3 = hi16(g.y);
            h.x = lo16(a.x) * __builtin_amdgcn_rcpf(1.f + __expf(-g0)); h.y = hi16(a.x) * __builtin_amdgcn_rcpf(1.f + __expf(-g1));
            h.z = lo16(a.y) * __builtin_amdgcn_rcpf(1.f + __expf(-g2)); h.w = hi16(a.y) * __builtin_amdgcn_rcpf(1.f + __expf(-g3));
        }
        *(f32x4*)(hg + jj * 256 + c4) = h;
    }
    float* wl = hg + 94 * 256;
    for (int i = tid; i < 31 * 64; i += NTHREADS) *(f32x4*)(wl + i * 4) = *(const f32x4*)(p.in[8] + (size_t)L * 31 * 256 + i * 4);
    __syncthreads();
    const int c0 = lane * 4;
    const f32x4 cb = *(const f32x4*)(p.in[9] + L * 256 + c0), lw = *(const f32x4*)(p.in[10] + L * 256 + c0), lb = *(const f32x4*)(p.in[11] + L * 256 + c0);
    bf16_t* CC = (bf16_t*)(p.ws + WS_CC);
    for (int q = 0; q < 8; ++q) {
        const int tl = wave * 8 + q;
        f32x4 acc = cb;
#pragma unroll 4
        for (int j = 0; j < 31; ++j) { const f32x4 h = *(const f32x4*)(hg + (tl + j) * 256 + c0); acc += h * *(const f32x4*)(wl + j * 256 + c0); }
        const float mean = wave_sum(acc.x + acc.y + acc.z + acc.w) * (1.f / 256.f);
        const f32x4 d = acc - mean;
        const float var = wave_sum(d.x * d.x + d.y * d.y + d.z * d.z + d.w * d.w) * (1.f / 256.f);
        const float rstd = rsqrtf(var + NORM_EPS);
        const f32x4 y = d * rstd * lw + lb;
        u32x2 o; o.x = pk2(siluf(y.x), siluf(y.y)); o.y = pk2(siluf(y.z), siluf(y.w));
        *(u32x2*)(CC + (size_t)(rb + t0 + tl) * D + c0) = o;
    }
    __syncthreads();
}

__device__ __forceinline__ float log2_gamma(const P& p, int L, int dir, int h) {
    const float x = p.in[12][(L * 2 + dir) * 4 + h];
    const float ls = fminf(x, 0.f) - log1pf(expf(-fabsf(x)));
    return ls * 1.4426950408889634f;
}
__device__ __forceinline__ void load_ret_qk(float* dst, const P& p, int gc, int h, int zoff, float scale) {
    const int tid = threadIdx.x, j = tid >> 2, i0 = (tid & 3) * 4, row = gc * 128 + j;
    const bf16_t* zr = (const bf16_t*)(p.ws + WS_Z) + (size_t)row * ZC + zoff + h * 32;
    const u32x2 a = *(const u32x2*)(zr + i0), b = *(const u32x2*)(zr + 16 + i0);
    float x1[4] = {lo16(a.x), hi16(a.x), lo16(a.y), hi16(a.y)}, x2[4] = {lo16(b.x), hi16(b.x), lo16(b.y), hi16(b.y)};
    const bool lat = row < NLAT; const int pos = row & (SEQ - 1);
    const float* ct = (const float*)(p.ws + WS_ROPE) + pos * 16 + i0; const float* st = ct + 2048 * 16;
#pragma unroll
    for (int i = 0; i < 4; ++i) {
        const float c = lat ? ct[i] : 1.f, s = lat ? st[i] : 0.f;
        dst[j * 33 + i0 + i] = (x1[i] * c - x2[i] * s) * scale;
        dst[j * 33 + 16 + i0 + i] = (x1[i] * s + x2[i] * c) * scale;
    }
}
__device__ __forceinline__ void load_ret_v(float* dst  , const P& p, int gc, int h) {
    const int tid = threadIdx.x, j = tid >> 2, e0 = (tid & 3) * 16;
    const bf16_t* zr = (const bf16_t*)(p.ws + WS_Z) + (size_t)(gc * 128 + j) * ZC + Z_RV + h * 64 + e0;
    const u32x4 a = *(const u32x4*)zr, b = *(const u32x4*)(zr + 8);
#pragma unroll
    for (int i = 0; i < 4; ++i) { dst[j * 64 + e0 + 2 * i] = lo16(a[i]); dst[j * 64 + e0 + 2 * i + 1] = hi16(a[i]); dst[j * 64 + e0 + 8 + 2 * i] = lo16(b[i]); dst[j * 64 + e0 + 8 + 2 * i + 1] = hi16(b[i]); }
}
__device__ __forceinline__ void retkv_unit(unsigned char* lds, const P& p, int L, int gc, int h) {
    float* ks = (float*)lds; float* vs = ks + 128 * 33; float* wf = vs + 128 * 64; float* wb = wf + 128;
    const int tid = threadIdx.x;
    const float l2f = log2_gamma(p, L, 0, h), l2b = log2_gamma(p, L, 1, h);
    load_ret_qk(ks, p, gc, h, Z_RK, 0.17677669529663687f);
    load_ret_v(vs, p, gc, h);
    if (tid < 128) { wf[tid] = exp2f(l2f * (float)(127 - tid)); wb[tid] = exp2f(l2b * (float)tid); }
    __syncthreads();
    const int d = tid >> 4, e0 = (tid & 15) * 4;
    f32x4 af = (f32x4){0.f, 0.f, 0.f, 0.f}, ab = af;
    for (int j = 0; j < 128; ++j) {
        const float kd = ks[j * 33 + d]; const f32x4 v4 = *(const f32x4*)(vs + j * 64 + e0);
        af += (kd * wf[j]) * v4; ab += (kd * wb[j]) * v4;
    }
    float* KV = (float*)(p.ws + WS_KV) + ((size_t)(gc * 4 + h) * 2) * 2048;
    *(f32x4*)(KV + d * 64 + e0) = af; *(f32x4*)(KV + 2048 + d * 64 + e0) = ab;
    __syncthreads();
}
__device__ __forceinline__ void ret_stage_k(unsigned char* kf, unsigned char* kb, int rowb, const P& p, int gc, int h, float ef, float jf0, float eb, float jb0) {
    const int tid = threadIdx.x, j = tid >> 2, i0 = (tid & 3) * 4, row = gc * 128 + j;
    const bf16_t* zr = (const bf16_t*)(p.ws + WS_Z) + (size_t)row * ZC + Z_RK + h * 32;
    const u32x2 a = *(const u32x2*)(zr + i0), b = *(const u32x2*)(zr + 16 + i0);
    const float x1[4] = {lo16(a.x), hi16(a.x), lo16(a.y), hi16(a.y)}, x2[4] = {lo16(b.x), hi16(b.x), lo16(b.y), hi16(b.y)};
    f32x4 c4 = (f32x4){1.f, 1.f, 1.f, 1.f}, s4 = (f32x4){0.f, 0.f, 0.f, 0.f};
    if (row < NLAT) { const int pos = row & (SEQ - 1); const float* ct = (const float*)(p.ws + WS_ROPE) + pos * 16 + i0; c4 = *(const f32x4*)ct; s4 = *(const f32x4*)(ct + 2048 * 16); }
    const float wf = __builtin_amdgcn_exp2f(ef * ((float)j - jf0)) * 0.17677669529663687f, wb = __builtin_amdgcn_exp2f(eb * ((float)j - jb0)) * 0.17677669529663687f;
    float o1[4], o2[4];
#pragma unroll
    for (int i = 0; i < 4; ++i) { o1[i] = x1[i] * c4[i] - x2[i] * s4[i]; o2[i] = x1[i] * s4[i] + x2[i] * c4[i]; }
    u32x2 w;
    w.x = cvtpk(o1[0] * wf, o1[1] * wf); w.y = cvtpk(o1[2] * wf, o1[3] * wf); *(u32x2*)(kf + j * rowb + i0 * 2) = w;
    w.x = cvtpk(o2[0] * wf, o2[1] * wf); w.y = cvtpk(o2[2] * wf, o2[3] * wf); *(u32x2*)(kf + j * rowb + 32 + i0 * 2) = w;
    w.x = cvtpk(o1[0] * wb, o1[1] * wb); w.y = cvtpk(o1[2] * wb, o1[3] * wb); *(u32x2*)(kb + j * rowb + i0 * 2) = w;
    w.x = cvtpk(o2[0] * wb, o2[1] * wb); w.y = cvtpk(o2[2] * wb, o2[3] * wb); *(u32x2*)(kb + j * rowb + 32 + i0 * 2) = w;
}
__device__ __forceinline__ void ret_stage_v(unsigned char* vt, const P& p, int gc, int h) {
    const int tid = threadIdx.x, j = tid >> 2, e0 = (tid & 3) * 16;
    const bf16_t* zr = (const bf16_t*)(p.ws + WS_Z) + (size_t)(gc * 128 + j) * ZC + Z_RV + h * 64 + e0;
    const u32x4 a = *(const u32x4*)zr, b = *(const u32x4*)(zr + 8);
    unsigned char* d = vt + (e0 >> 5) * 8192 + j * 64 + (e0 & 31) * 2;
    *(u32x4*)d = a; *(u32x4*)(d + 16) = b;
}
__device__ __forceinline__ bf16x8 tr8(const unsigned char* p0, const unsigned char* p1) {
    const v4i16_t a = __builtin_amdgcn_ds_read_tr16_b64_v4i16((LAS v4i16_t*)(const LAS unsigned char*)p0), b = __builtin_amdgcn_ds_read_tr16_b64_v4i16((LAS v4i16_t*)(const LAS unsigned char*)p1);
    return (bf16x8){a[0], a[1], a[2], a[3], b[0], b[1], b[2], b[3]};
}
__device__ __forceinline__ void retkv_unit_mfma(unsigned char* lds, const P& p, int L, int gc, int h) {
    const int tid = threadIdx.x, lane = tid & 63, wid = tid >> 6;
    const float l2f = log2_gamma(p, L, 0, h), l2b = log2_gamma(p, L, 1, h);
    ret_stage_k(lds, lds + 8192, 64, p, gc, h, -l2f, 127.f, l2b, 0.f);
    ret_stage_v(lds + 16384, p, gc, h);
    __syncthreads();
    if (wid < 4) {
        const int dir = wid >> 1, eb = wid & 1, g = lane >> 4, i = lane & 15, hh = lane >> 5;
        const int off = (8 * hh + (i >> 2)) * 64 + (g & 1) * 32 + (i & 3) * 8;
        const unsigned char* Kt = lds + dir * 8192 + off; const unsigned char* Vt = lds + 16384 + eb * 8192 + off;
        f32x16 acc;
#pragma unroll
        for (int r = 0; r < 16; ++r) acc[r] = 0.f;
#pragma unroll
        for (int s = 0; s < 8; ++s) acc = __builtin_amdgcn_mfma_f32_32x32x16_bf16(tr8(Vt + s * 1024, Vt + s * 1024 + 256), tr8(Kt + s * 1024, Kt + s * 1024 + 256), acc, 0, 0, 0);
        float* KV = (float*)(p.ws + WS_KV) + ((size_t)(gc * 4 + h) * 2 + dir) * 2048 + (lane & 31) * 64 + eb * 32 + 4 * hh;
#pragma unroll
        for (int r4 = 0; r4 < 4; ++r4) *(f32x4*)(KV + 8 * r4) = (f32x4){acc[4 * r4], acc[4 * r4 + 1], acc[4 * r4 + 2], acc[4 * r4 + 3]};
    }
    __syncthreads();
}
__device__ __forceinline__ void retout_unit_mfma(unsigned char* lds, const P& p, int L, int gc, int h) {
    constexpr int KROW = 80, O_KF = 0, O_KB = 10240, O_V = 20480, O_SF = 36864, O_SB = 41984, O_RED = 47104;
    const int tid = threadIdx.x, lane = tid & 63, wid = tid >> 6, r32 = lane & 31, hh = lane >> 5;
    const float l2f = log2_gamma(p, L, 0, h), l2b = log2_gamma(p, L, 1, h);
    ret_stage_k(lds + O_KF, lds + O_KB, KROW, p, gc, h, -l2f, 0.f, l2b, 0.f);
    ret_stage_v(lds + O_V, p, gc, h);
    {
        const bool lat = gc < 256; const int b = lat ? gc >> 4 : (gc - 256) >> 1;
        const int mme = lat ? 2 + (gc & 15) : (gc - 256) & 1;
        const int u = mme, w = mme < 2 ? 1 - mme : 19 - mme;
        f32x4 sf = (f32x4){0.f, 0.f, 0.f, 0.f}, sb = sf;
        const float* KVb = (const float*)(p.ws + WS_KV);
#pragma unroll 1
        for (int mm = 0; mm < 18; ++mm) {
            const int gcm = mm < 2 ? 256 + b * 2 + mm : b * 16 + (mm - 2);
            const int um = mm, wm = mm < 2 ? 1 - mm : 19 - mm;
            const float* kv = KVb + ((size_t)(gcm * 4 + h) * 2) * 2048 + tid * 4;
            if (um < u) { const float wgt = __builtin_amdgcn_exp2f(l2f * 128.f * (float)(u - 1 - um)); sf += wgt * *(const f32x4*)kv; }
            if (wm < w) { const float wgt = __builtin_amdgcn_exp2f(l2b * 128.f * (float)(w - 1 - wm)); sb += wgt * *(const f32x4*)(kv + 2048); }
        }
        const int d = tid >> 4, e0 = (tid & 15) * 4;
#pragma unroll
        for (int k = 0; k < 4; ++k) { *(bf16_t*)(lds + O_SF + (e0 + k) * KROW + d * 2) = (bf16_t)(cvtpk(sf[k], 0.f) & 0xffffu); *(bf16_t*)(lds + O_SB + (e0 + k) * KROW + d * 2) = (bf16_t)(cvtpk(sb[k], 0.f) & 0xffffu); }
    }
    __syncthreads();
    const int qb = wid & 3, eb = wid >> 2, i = qb * 32 + r32, row = gc * 128 + i;
    bf16x8 qf[2];
    {
        const bf16_t* zr = (const bf16_t*)(p.ws + WS_Z) + (size_t)row * ZC + Z_RQ + h * 32 + 8 * hh;
        const u32x4 a = *(const u32x4*)zr, b = *(const u32x4*)(zr + 16);
        float x1[8], x2[8];
#pragma unroll
        for (int k = 0; k < 4; ++k) { x1[2 * k] = lo16(a[k]); x1[2 * k + 1] = hi16(a[k]); x2[2 * k] = lo16(b[k]); x2[2 * k + 1] = hi16(b[k]); }
        if (row < NLAT) {
            const float* ct = (const float*)(p.ws + WS_ROPE) + (row & (SEQ - 1)) * 16 + 8 * hh; const float* st = ct + 2048 * 16;
#pragma unroll
            for (int k = 0; k < 8; ++k) { const float c = ct[k], sn = st[k], u1 = x1[k], u2 = x2[k]; x1[k] = u1 * c - u2 * sn; x2[k] = u1 * sn + u2 * c; }
        }
        const u32x4 q0 = (u32x4){cvtpk(x1[0], x1[1]), cvtpk(x1[2], x1[3]), cvtpk(x1[4], x1[5]), cvtpk(x1[6], x1[7])};
        const u32x4 q1 = (u32x4){cvtpk(x2[0], x2[1]), cvtpk(x2[2], x2[3]), cvtpk(x2[4], x2[5]), cvtpk(x2[6], x2[7])};
        qf[0] = __builtin_bit_cast(bf16x8, q0); qf[1] = __builtin_bit_cast(bf16x8, q1);
    }
    const float af = __builtin_amdgcn_exp2f(l2f * (float)i), ab = __builtin_amdgcn_exp2f(-l2b * (float)i), cf = __builtin_amdgcn_exp2f(l2f * (float)(i + 1)), cb = __builtin_amdgcn_exp2f(l2b * (float)(128 - i));
    f32x16 y, zero;
#pragma unroll
    for (int r = 0; r < 16; ++r) { y[r] = 0.f; zero[r] = 0.f; }
    const int koff = r32 * KROW + 16 * hh;
    const int voff = O_V + eb * 8192 + (4 * hh + ((lane & 15) >> 2)) * 64 + ((lane >> 4) & 1) * 32 + (lane & 3) * 8;
#pragma unroll
    for (int kb = 0; kb < 4; ++kb) {
        f32x16 pt;
        if (kb <= qb) {
            f32x16 sF = __builtin_amdgcn_mfma_f32_32x32x16_bf16(*(const bf16x8*)(lds + O_KF + kb * 32 * KROW + koff), qf[0], zero, 0, 0, 0);
            sF = __builtin_amdgcn_mfma_f32_32x32x16_bf16(*(const bf16x8*)(lds + O_KF + kb * 32 * KROW + koff + 32), qf[1], sF, 0, 0, 0);
            if (kb < qb) {
#pragma unroll
                for (int r = 0; r < 16; ++r) pt[r] = sF[r] * af;
            } else {
#pragma unroll
                for (int r = 0; r < 16; ++r) { const int j = (r & 3) + 8 * (r >> 2) + 4 * hh; pt[r] = (j <= r32) ? sF[r] * af : 0.f; }
            }
        }
        if (kb >= qb) {
            f32x16 sB = __builtin_amdgcn_mfma_f32_32x32x16_bf16(*(const bf16x8*)(lds + O_KB + kb * 32 * KROW + koff), qf[0], zero, 0, 0, 0);
            sB = __builtin_amdgcn_mfma_f32_32x32x16_bf16(*(const bf16x8*)(lds + O_KB + kb * 32 * KROW + koff + 32), qf[1], sB, 0, 0, 0);
            if (kb > qb) {
#pragma unroll
                for (int r = 0; r < 16; ++r) pt[r] = sB[r] * ab;
            } else {
#pragma unroll
                for (int r = 0; r < 16; ++r) { const int j = (r & 3) + 8 * (r >> 2) + 4 * hh; pt[r] += (j >= r32) ? sB[r] * ab : 0.f; }
            }
        }
#pragma unroll
        for (int s2 = 0; s2 < 2; ++s2) {
            const u32x4 pw = (u32x4){cvtpk(pt[8 * s2], pt[8 * s2 + 1]), cvtpk(pt[8 * s2 + 2], pt[8 * s2 + 3]), cvtpk(pt[8 * s2 + 4], pt[8 * s2 + 5]), cvtpk(pt[8 * s2 + 6], pt[8 * s2 + 7])};
            const unsigned char* vb = lds + voff + (kb * 32 + s2 * 16) * 64;
            y = __builtin_amdgcn_mfma_f32_32x32x16_bf16(tr8(vb, vb + 8 * 64), __builtin_bit_cast(bf16x8, pw), y, 0, 0, 0);
        }
    }
    {
        const int soff = (eb * 32 + r32) * KROW + 16 * hh;
        f32x16 tF = __builtin_amdgcn_mfma_f32_32x32x16_bf16(*(const bf16x8*)(lds + O_SF + soff), qf[0], zero, 0, 0, 0);
        tF = __builtin_amdgcn_mfma_f32_32x32x16_bf16(*(const bf16x8*)(lds + O_SF + soff + 32), qf[1], tF, 0, 0, 0);
        f32x16 tB = __builtin_amdgcn_mfma_f32_32x32x16_bf16(*(const bf16x8*)(lds + O_SB + soff), qf[0], zero, 0, 0, 0);
        tB = __builtin_amdgcn_mfma_f32_32x32x16_bf16(*(const bf16x8*)(lds + O_SB + soff + 32), qf[1], tB, 0, 0, 0);
#pragma unroll
        for (int r = 0; r < 16; ++r) y[r] += tF[r] * cf + tB[r] * cb;
    }
    float s1 = 0.f, s2 = 0.f;
#pragma unroll
    for (int r = 0; r < 16; ++r) { s1 += y[r]; s2 += y[r] * y[r]; }
    s1 += __shfl_xor(s1, 32); s2 += __shfl_xor(s2, 32);
    float* red = (float*)(lds + O_RED);
    if (hh == 0) { red[(eb * 128 + i) * 2] = s1; red[(eb * 128 + i) * 2 + 1] = s2; }
    __syncthreads();
    s1 = red[i * 2] + red[(128 + i) * 2]; s2 = red[i * 2 + 1] + red[(128 + i) * 2 + 1];
    const float mu = s1 * (1.f / 64.f), var = fmaxf(s2 * (1.f / 64.f) - mu * mu, 0.f), rstd = rsqrtf(var + NORM_EPS);
    const bf16_t* zg = (const bf16_t*)(p.ws + WS_Z) + (size_t)row * ZC + Z_RG + h * 64 + eb * 32 + 4 * hh;
    const float* gw = p.in[13] + L * 256 + h * 64 + eb * 32 + 4 * hh;
    bf16_t* orow = (bf16_t*)(p.ws + WS_CC) + (size_t)row * D + 256 + h * 64 + eb * 32 + 4 * hh;
#pragma unroll
    for (int r4 = 0; r4 < 4; ++r4) {
        const u32x2 gz = *(const u32x2*)(zg + 8 * r4); const f32x4 w4 = *(const f32x4*)(gw + 8 * r4);
        const float g0 = lo16(gz.x), g1 = hi16(gz.x), g2 = lo16(gz.y), g3 = hi16(gz.y);
        u32x2 o; o.x = cvtpk(siluf(g0) * ((y[4 * r4] - mu) * rstd * w4.x), siluf(g1) * ((y[4 * r4 + 1] - mu) * rstd * w4.y));
        o.y = cvtpk(siluf(g2) * ((y[4 * r4 + 2] - mu) * rstd * w4.z), siluf(g3) * ((y[4 * r4 + 3] - mu) * rstd * w4.w));
        *(u32x2*)(orow + 8 * r4) = o;
    }
    __syncthreads();
}
__device__ __forceinline__ void qkv_proj(unsigned char* lds, const P& p, int L) {
    const float* sskv = (const float*)(p.ws + WS_SS) + (size_t)NTOK * 4;
    const int G = gridDim.x, bid = blockIdx.x;
    {
        bf16_t* Q = (bf16_t*)(p.ws + WS_Q);
        ge::DenseOrder S; S.nM = NTOK / 256; S.nN = 3; S.nwg = S.nM * 3; S.G = G; S.c = bid; S.Bt = (const char*)((const bf16_t*)(p.ws + WS_WUQ) + (size_t)L * 768 * 256); S.btile = (size_t)256 * 256 * 2; S.arow = ZC * 2;
        auto f = [&](const ge::Unit& u, int r, int c, f32x4 v0, f32x4 v1) {
            u32x4 w; w.x = cvtpk(v0.x, v0.y); w.y = cvtpk(v0.z, v0.w); w.z = cvtpk(v1.x, v1.y); w.w = cvtpk(v1.z, v1.w); *(u32x4*)(Q + (size_t)(u.a * 256 + r) * 768 + u.b * 256 + c) = w;
        };
        ge::EpiFn<decltype(f)> E{f};
        ge::gemm_stream<ge::DenseOrder, ge::EpiFn<decltype(f)>, true>((LAS unsigned char*)lds, (const char*)(p.ws + WS_Z) + Z_CQ * 2, 256, S, E);
    }
    {
        bf16_t* Kb = (bf16_t*)(p.ws + WS_K); bf16_t* Vb = (bf16_t*)(p.ws + WS_V);
        ge::DenseOrder S; S.nM = NTOK / 256; S.nN = 4; S.nwg = S.nM * 4; S.G = G; S.c = (bid + 176) % G; S.Bt = (const char*)((const bf16_t*)(p.ws + WS_WUKV) + (size_t)L * 1024 * 256); S.btile = (size_t)256 * 256 * 2; S.arow = ZC * 2;
        struct EpiKV {
            bf16_t* Kb; bf16_t* Vb; const float* sskv;
            __device__ __forceinline__ void operator()(const ge::Acc& acc, const ge::Unit& u, int wr, int wc, int fr, int fq) const {
                float rstd[2][4];
#pragma unroll
                for (int ai = 0; ai < 2; ++ai)
#pragma unroll
                    for (int m = 0; m < 4; ++m) { const f32x4 s4 = *(const f32x4*)(sskv + (size_t)(u.a * 256 + ai * 128 + wr * 64 + m * 16 + fr) * 4); rstd[ai][m] = rsqrtf((s4.x + s4.y + s4.z + s4.w) * (1.f / 128.f) + NORM_EPS); }
#pragma unroll
                for (int ai = 0; ai < 2; ++ai)
#pragma unroll
                    for (int m = 0; m < 4; ++m) {
                        const int row = u.a * 256 + ai * 128 + wr * 64 + m * 16 + fr;
#pragma unroll
                        for (int bj = 0; bj < 2; ++bj) {
                            const int col = u.b * 256 + bj * 128 + wc * 32 + 8 * fq, h = col >> 7, j = col & 127;
                            const f32x4 v0 = acc[ai][bj][m][0] * rstd[ai][m], v1 = acc[ai][bj][m][1] * rstd[ai][m];
                            u32x4 w; w.x = cvtpk(v0.x, v0.y); w.y = cvtpk(v0.z, v0.w); w.z = cvtpk(v1.x, v1.y); w.w = cvtpk(v1.z, v1.w);
                            if (j < 64) *(u32x4*)(Kb + (size_t)row * 768 + h * 96 + j) = w;
                            else *(u32x4*)(Vb + (size_t)row * 512 + h * 64 + (j - 64)) = w;
                        }
                    }
            }
        };
        EpiKV E{Kb, Vb, sskv};
        ge::gemm_stream<ge::DenseOrder, EpiKV, true>((LAS unsigned char*)lds, (const char*)(p.ws + WS_Z) + Z_CKV * 2, 256, S, E);
    }
}
__device__ __forceinline__ void phase_b(unsigned char* lds, const P& p, int L) {
    const int G = gridDim.x, bid = blockIdx.x;
    qkv_proj(lds, p, L);
    const int nconv = (L == 0) ? 576 : 512;
    const int nkv = 288 * 4;
    const int total = nconv + nkv;
    for (int u = (bid + 96) % G; u < total; u += G) {
        int r = u;
        if (r < nconv) { if (r < 512) conv_unit(lds, p, L, r >> 5, r & 31); else conv_unit(lds, p, L, 16 + ((r - 512) >> 2), (r - 512) & 3); continue; } r -= nconv;
        retkv_unit_mfma(lds, p, L, r >> 2, r & 3);
    }
    if (L == 1) convert_expert_weights(lds, p, 1);
}

__device__ __forceinline__ void attn_unit_naive(unsigned char* lds, const P& p, int b, int h, int qb, bool ctxq) {
    float* Ks = (float*)lds;
    float* Vs = Ks + 64 * 96;
    const int tid = threadIdx.x, half = tid & 1, qi = tid >> 1;
    const bf16_t* Qb = (const bf16_t*)(p.ws + WS_Q); const bf16_t* Kb = (const bf16_t*)(p.ws + WS_K); const bf16_t* Vb = (const bf16_t*)(p.ws + WS_V);
    const int qrow = ctxq ? NLAT + b * CTXL + qi : b * SEQ + qb * 256 + qi;
    float q[48];
    {
        const u32x4* qp = (const u32x4*)(Qb + (size_t)qrow * 768 + h * 96 + half * 48);
#pragma unroll
        for (int i = 0; i < 6; ++i) { const u32x4 w = qp[i];
#pragma unroll
            for (int k = 0; k < 4; ++k) { q[i * 8 + 2 * k] = lo16(w[k]); q[i * 8 + 2 * k + 1] = hi16(w[k]); } }
    }
    float o[32];
#pragma unroll
    for (int e = 0; e < 32; ++e) o[e] = 0.f;
    float m = -1e30f, l = 0.f;
    const int ntiles = ctxq ? 4 : 36;
#pragma unroll 1
    for (int t = 0; t < ntiles; ++t) {
        const int krow0 = t < 4 ? NLAT + b * CTXL + t * 64 : b * SEQ + (t - 4) * 64;
        __syncthreads();
        for (int i = tid; i < 64 * 12; i += NTHREADS) { const int key = i / 12, c = i % 12; const u32x4 w = *(const u32x4*)(Kb + (size_t)(krow0 + key) * 768 + h * 96 + c * 8);
            float* d = Ks + key * 96 + c * 8;
#pragma unroll
            for (int k = 0; k < 4; ++k) { d[2 * k] = lo16(w[k]); d[2 * k + 1] = hi16(w[k]); } }
        for (int i = tid; i < 64 * 8; i += NTHREADS) { const int key = i >> 3, c = i & 7; const u32x4 w = *(const u32x4*)(Vb + (size_t)(krow0 + key) * 512 + h * 64 + c * 8);
            float* d = Vs + key * 64 + c * 8;
#pragma unroll
            for (int k = 0; k < 4; ++k) { d[2 * k] = lo16(w[k]); d[2 * k + 1] = hi16(w[k]); } }
        __syncthreads();
#pragma unroll 1
        for (int j0 = 0; j0 < 64; j0 += 2) {
            float s[2]; float mt = -1e30f;
#pragma unroll
            for (int jj = 0; jj < 2; ++jj) {
                const f32x4* kr = (const f32x4*)(Ks + (j0 + jj) * 96 + half * 48);
                float a = 0.f;
#pragma unroll
                for (int d4 = 0; d4 < 12; ++d4) { const f32x4 kv = kr[d4]; a += q[4 * d4] * kv.x + q[4 * d4 + 1] * kv.y + q[4 * d4 + 2] * kv.z + q[4 * d4 + 3] * kv.w; }
                a += __shfl_xor(a, 1);
                s[jj] = a; mt = fmaxf(mt, a);
            }
            const float mn = fmaxf(m, mt), alpha = exp2f(m - mn);
            m = mn; l *= alpha;
#pragma unroll
            for (int e = 0; e < 32; ++e) o[e] *= alpha;
#pragma unroll
            for (int jj = 0; jj < 2; ++jj) {
                const float pj = exp2f(s[jj] - mn); l += pj;
                const f32x4* vr = (const f32x4*)(Vs + (j0 + jj) * 64 + half * 32);
#pragma unroll
                for (int e4 = 0; e4 < 8; ++e4) { const f32x4 vv = vr[e4]; o[4 * e4] += pj * vv.x; o[4 * e4 + 1] += pj * vv.y; o[4 * e4 + 2] += pj * vv.z; o[4 * e4 + 3] += pj * vv.w; }
            }
        }
    }
    {
        const float rl = 1.f / l;
        u32x4* op = (u32x4*)((bf16_t*)(p.ws + WS_CC) + (size_t)qrow * D + 512 + h * 64 + half * 32);
#pragma unroll
        for (int i = 0; i < 4; ++i) { u32x4 w; w.x = pk2(o[8 * i] * rl, o[8 * i + 1] * rl); w.y = pk2(o[8 * i + 2] * rl, o[8 * i + 3] * rl); w.z = pk2(o[8 * i + 4] * rl, o[8 * i + 5] * rl); w.w = pk2(o[8 * i + 6] * rl, o[8 * i + 7] * rl); op[i] = w; }
    }
    __syncthreads();
}
__device__ __forceinline__ float max3f(float a, float b, float c) { float r; asm("v_max3_f32 %0, %1, %2, %3" : "=v"(r) : "v"(a), "v"(b), "v"(c)); return r; }
constexpr int AT_KROW = 208;
constexpr int AT_KBUF = 64 * AT_KROW;
constexpr int AT_VBUF = 8192;
constexpr int AT_BUF = AT_KBUF + AT_VBUF;
__device__ __forceinline__ void attn_unit_mfma(unsigned char* lds, const P& p, int b, int h, int qb, bool ctxq) {
    const int tid = threadIdx.x, lane = tid & 63, wid = tid >> 6, r32 = lane & 31, hh = lane >> 5;
    const bf16_t* Qb = (const bf16_t*)(p.ws + WS_Q); const bf16_t* Kb = (const bf16_t*)(p.ws + WS_K); const bf16_t* Vb = (const bf16_t*)(p.ws + WS_V);
    const int qrow = (ctxq ? NLAT + b * CTXL : b * SEQ + qb * 256) + wid * 32 + r32;
    bf16x8 qf[6];
    {
        const f32x4 s4 = *(const f32x4*)((const float*)(p.ws + WS_SS) + (size_t)qrow * 4);
        const float rstd = rsqrtf((s4.x + s4.y + s4.z + s4.w) * (1.f / 256.f) + NORM_EPS);
        const float* ct = (const float*)(p.ws + WS_ROPE) + (qrow & (SEQ - 1)) * 16; const float* st = ct + 2048 * 16;
#pragma unroll
        for (int s = 0; s < 6; ++s) {
            const u32x4 w = *(const u32x4*)(Qb + (size_t)qrow * 768 + h * 96 + 16 * s + 8 * hh);
            float x[8];
#pragma unroll
            for (int k = 0; k < 4; ++k) { x[2 * k] = lo16(w[k]) * rstd; x[2 * k + 1] = hi16(w[k]) * rstd; }
            if (s >= 4 && !ctxq) {
                const f32x4 c4 = *(const f32x4*)(ct + 8 * (s - 4) + 4 * hh), sn = *(const f32x4*)(st + 8 * (s - 4) + 4 * hh);
#pragma unroll
                for (int k = 0; k < 4; ++k) { const float a = x[2 * k], b2 = x[2 * k + 1]; x[2 * k] = a * c4[k] - b2 * sn[k]; x[2 * k + 1] = a * sn[k] + b2 * c4[k]; }
            }
            const u32x4 o = (u32x4){cvtpk(x[0], x[1]), cvtpk(x[2], x[3]), cvtpk(x[4], x[5]), cvtpk(x[6], x[7])};
            qf[s] = __builtin_bit_cast(bf16x8, o);
        }
    }
    f32x16 o0, o1, negm;
#pragma unroll
    for (int r = 0; r < 16; ++r) { o0[r] = 0.f; o1[r] = 0.f; negm[r] = 0.f; }
    asm volatile("" : "+v"(negm));
    float mhat = 0.f, l = 0.f;
    const int ntiles = ctxq ? 4 : 36;
    const int wv = __builtin_amdgcn_readfirstlane(wid);
    const int ia = wv, ib = (wv + 8 < 13) ? wv + 8 : 12;
    const int qa = ia * 64 + lane, qb2 = ib * 64 + lane, qv = wv * 64 + lane;
    const int ca = qa % 13, cb = qb2 % 13;
    const size_t ka = (size_t)(qa / 13) * 768 + h * 96 + (ca < 12 ? ca : 11) * 8, kbo = (size_t)(qb2 / 13) * 768 + h * 96 + (cb < 12 ? cb : 11) * 8;
    const size_t vo = (size_t)((qv >> 2) & 63) * 512 + h * 64 + (qv >> 8) * 32 + (qv & 3) * 8;
    auto krow0 = [&](int t) { return t < 4 ? NLAT + b * CTXL + t * 64 : b * SEQ + (t - 4) * 64; };
    const unsigned lds0 = (unsigned)(uintptr_t)lds;
#define AT_GLDS(gp, ldsoff) do { unsigned keep_; asm volatile("s_mov_b32 %0, m0\n\ts_mov_b32 m0, %2\n\ts_nop 0\n\tglobal_load_lds_dwordx4 %1, off\n\ts_mov_b32 m0, %0" : "=&s"(keep_) : "v"(gp), "s"((unsigned)__builtin_amdgcn_readfirstlane(lds0 + (unsigned)(ldsoff))) : "memory"); } while (0)
#define AT_ISSUE(t2, slot) do { const int kr_ = krow0(t2); const bf16_t* kb_ = Kb + (size_t)kr_ * 768; const bf16_t* vb_ = Vb + (size_t)kr_ * 512; \
        AT_GLDS(kb_ + ka, (slot) + ia * 1024); AT_GLDS(kb_ + kbo, (slot) + ib * 1024); AT_GLDS(vb_ + vo, (slot) + AT_KBUF + wv * 1024); } while (0)
#define AT_SB() __builtin_amdgcn_sched_barrier(0)
#define AT_PIN(x) asm volatile("" : "+v"(x))
#define AT_NEXT(x) ((x) == 3 * AT_BUF ? 0 : (x) + AT_BUF)
    __builtin_amdgcn_s_barrier();
    AT_ISSUE(0, 0);
    if (ntiles > 1) AT_ISSUE(1, AT_BUF);
    const int koff = r32 * AT_KROW + 16 * hh;
    const int voff = AT_KBUF + (4 * hh + ((lane & 15) >> 2)) * 64 + ((lane >> 4) & 1) * 32 + (lane & 3) * 8;
#define AT_SYNC(t, slot_issue) do { if ((t) + 1 < ntiles) asm volatile("s_waitcnt vmcnt(3)" ::: "memory"); else asm volatile("s_waitcnt vmcnt(0)" ::: "memory"); \
        __builtin_amdgcn_s_barrier(); asm volatile("" ::: "memory"); if ((t) + 2 < ntiles) AT_ISSUE((t) + 2, slot_issue); } while (0)
#define AT_DECIDE(C0, C1) do { \
        asm volatile("s_nop 15\n\ts_nop 7" : "+v"(C0), "+v"(C1)); \
        float rma = max3f(C0[0], C0[1], C1[0]), rmb = max3f(C0[2], C0[3], C1[1]); rma = max3f(rma, C1[2], C1[3]); \
        _Pragma("unroll") for (int r = 4; r < 16; r += 4) { rma = max3f(rma, C0[r], C0[r + 1]); rmb = max3f(rmb, C0[r + 2], C0[r + 3]); rma = max3f(rma, C1[r], C1[r + 1]); rmb = max3f(rmb, C1[r + 2], C1[r + 3]); } \
        float rm = fmaxf(rma, rmb); rm = fmaxf(rm, __shfl_xor(rm, 32)); \
        resc = false; \
        if (__any(rm > 8.f)) { const float dl = fmaxf(rm, 0.f); fres = __builtin_amdgcn_exp2f(-dl); mhat += dl; l *= fres; resc = true; \
            _Pragma("unroll") for (int r = 0; r < 16; ++r) { C0[r] -= dl; C1[r] -= dl; negm[r] = -mhat; } \
            asm volatile("" : "+v"(negm)); } \
    } while (0)
#define AT_MFS(kfrag, s_, C, first) C = __builtin_amdgcn_mfma_f32_32x32x16_bf16(kfrag, qf[s_], (first) ? negm : C, 0, 0, 0)
#define AT_KF(bk_, g) (*(const bf16x8*)((bk_) + koff + ((g) & 1) * 32 * AT_KROW + ((g) >> 1) * 32))
#define AT_STEP(C0, C1, P0, P1, bk, bv) do { \
        bf16x8 kf[12], vfa[4], vfc[4]; u32x4 pw[4]; float sacc = 0.f; \
        kf[0] = AT_KF(bk, 0); kf[1] = AT_KF(bk, 1); kf[2] = AT_KF(bk, 2); kf[3] = AT_KF(bk, 3); \
        AT_SB(); \
        AT_MFS(kf[0], 0, C0, true);  kf[4] = AT_KF(bk, 4);  sacc += (P0[0] + P0[1]) + (P0[2] + P0[3]); pw[0].x = cvtpk(P0[0], P0[1]); pw[0].y = cvtpk(P0[2], P0[3]); AT_PIN(sacc); AT_PIN(pw[0]); AT_SB(); \
        AT_MFS(kf[1], 0, C1, true);  kf[5] = AT_KF(bk, 5);  sacc += (P0[4] + P0[5]) + (P0[6] + P0[7]); pw[0].z = cvtpk(P0[4], P0[5]); pw[0].w = cvtpk(P0[6], P0[7]); AT_PIN(sacc); AT_PIN(pw[0]); AT_SB(); \
        AT_MFS(kf[2], 1, C0, false); kf[6] = AT_KF(bk, 6);  sacc += (P0[8] + P0[9]) + (P0[10] + P0[11]); pw[1].x = cvtpk(P0[8], P0[9]); pw[1].y = cvtpk(P0[10], P0[11]); AT_PIN(sacc); AT_PIN(pw[1]); AT_SB(); \
        AT_MFS(kf[3], 1, C1, false); kf[7] = AT_KF(bk, 7);  sacc += (P0[12] + P0[13]) + (P0[14] + P0[15]); pw[1].z = cvtpk(P0[12], P0[13]); pw[1].w = cvtpk(P0[14], P0[15]); AT_PIN(sacc); AT_PIN(pw[1]); AT_SB(); \
        AT_MFS(kf[4], 2, C0, false); kf[8] = AT_KF(bk, 8);  sacc += (P1[0] + P1[1]) + (P1[2] + P1[3]); pw[2].x = cvtpk(P1[0], P1[1]); pw[2].y = cvtpk(P1[2], P1[3]); AT_PIN(sacc); AT_PIN(pw[2]); AT_SB(); \
        AT_MFS(kf[5], 2, C1, false); kf[9] = AT_KF(bk, 9);  sacc += (P1[4] + P1[5]) + (P1[6] + P1[7]); pw[2].z = cvtpk(P1[4], P1[5]); pw[2].w = cvtpk(P1[6], P1[7]); AT_PIN(sacc); AT_PIN(pw[2]); AT_SB(); \
        AT_MFS(kf[6], 3, C0, false); kf[10] = AT_KF(bk, 10); sacc += (P1[8] + P1[9]) + (P1[10] + P1[11]); pw[3].x = cvtpk(P1[8], P1[9]); pw[3].y = cvtpk(P1[10], P1[11]); AT_PIN(sacc); AT_PIN(pw[3]); AT_SB(); \
        AT_MFS(kf[7], 3, C1, false); kf[11] = AT_KF(bk, 11); sacc += (P1[12] + P1[13]) + (P1[14] + P1[15]); pw[3].z = cvtpk(P1[12], P1[13]); pw[3].w = cvtpk(P1[14], P1[15]); AT_PIN(sacc); AT_PIN(pw[3]); AT_SB(); \
        AT_MFS(kf[8], 4, C0, false); { const unsigned char* vb_ = (bv) + voff; vfa[0] = tr8(vb_, vb_ + 512); vfc[0] = tr8(vb_ + 4096, vb_ + 4608); } AT_SB(); \
        AT_MFS(kf[9], 4, C1, false); { const unsigned char* vb_ = (bv) + voff + 1024; vfa[1] = tr8(vb_, vb_ + 512); vfc[1] = tr8(vb_ + 4096, vb_ + 4608); } AT_SB(); \
        AT_MFS(kf[10], 5, C0, false); { const unsigned char* vb_ = (bv) + voff + 2048; vfa[2] = tr8(vb_, vb_ + 512); vfc[2] = tr8(vb_ + 4096, vb_ + 4608); } AT_SB(); \
        AT_MFS(kf[11], 5, C1, false); { const unsigned char* vb_ = (bv) + voff + 3072; vfa[3] = tr8(vb_, vb_ + 512); vfc[3] = tr8(vb_ + 4096, vb_ + 4608); } AT_SB(); \
        l += sacc; \
        AT_DECIDE(C0, C1); \
        AT_SB(); \
        o0 = __builtin_amdgcn_mfma_f32_32x32x16_bf16(vfa[0], __builtin_bit_cast(bf16x8, pw[0]), o0, 0, 0, 0); C0[0] = __builtin_amdgcn_exp2f(C0[0]); C0[1] = __builtin_amdgcn_exp2f(C0[1]); C0[2] = __builtin_amdgcn_exp2f(C0[2]); C0[3] = __builtin_amdgcn_exp2f(C0[3]); AT_PIN(C0); AT_SB(); \
        o1 = __builtin_amdgcn_mfma_f32_32x32x16_bf16(vfc[0], __builtin_bit_cast(bf16x8, pw[0]), o1, 0, 0, 0); C0[4] = __builtin_amdgcn_exp2f(C0[4]); C0[5] = __builtin_amdgcn_exp2f(C0[5]); C0[6] = __builtin_amdgcn_exp2f(C0[6]); C0[7] = __builtin_amdgcn_exp2f(C0[7]); AT_PIN(C0); AT_SB(); \
        o0 = __builtin_amdgcn_mfma_f32_32x32x16_bf16(vfa[1], __builtin_bit_cast(bf16x8, pw[1]), o0, 0, 0, 0); C0[8] = __builtin_amdgcn_exp2f(C0[8]); C0[9] = __builtin_amdgcn_exp2f(C0[9]); C0[10] = __builtin_amdgcn_exp2f(C0[10]); C0[11] = __builtin_amdgcn_exp2f(C0[11]); AT_PIN(C0); AT_SB(); \
        o1 = __builtin_amdgcn_mfma_f32_32x32x16_bf16(vfc[1], __builtin_bit_cast(bf16x8, pw[1]), o1, 0, 0, 0); C0[12] = __builtin_amdgcn_exp2f(C0[12]); C0[13] = __builtin_amdgcn_exp2f(C0[13]); C0[14] = __builtin_amdgcn_exp2f(C0[14]); C0[15] = __builtin_amdgcn_exp2f(C0[15]); AT_PIN(C0); AT_SB(); \
        o0 = __builtin_amdgcn_mfma_f32_32x32x16_bf16(vfa[2], __builtin_bit_cast(bf16x8, pw[2]), o0, 0, 0, 0); C1[0] = __builtin_amdgcn_exp2f(C1[0]); C1[1] = __builtin_amdgcn_exp2f(C1[1]); C1[2] = __builtin_amdgcn_exp2f(C1[2]); C1[3] = __builtin_amdgcn_exp2f(C1[3]); AT_PIN(C1); AT_SB(); \
        o1 = __builtin_amdgcn_mfma_f32_32x32x16_bf16(vfc[2], __builtin_bit_cast(bf16x8, pw[2]), o1, 0, 0, 0); C1[4] = __builtin_amdgcn_exp2f(C1[4]); C1[5] = __builtin_amdgcn_exp2f(C1[5]); C1[6] = __builtin_amdgcn_exp2f(C1[6]); C1[7] = __builtin_amdgcn_exp2f(C1[7]); AT_PIN(C1); AT_SB(); \
        o0 = __builtin_amdgcn_mfma_f32_32x32x16_bf16(vfa[3], __builtin_bit_cast(bf16x8, pw[3]), o0, 0, 0, 0); C1[8] = __builtin_amdgcn_exp2f(C1[8]); C1[9] = __builtin_amdgcn_exp2f(C1[9]); C1[10] = __builtin_amdgcn_exp2f(C1[10]); C1[11] = __builtin_amdgcn_exp2f(C1[11]); AT_PIN(C1); AT_SB(); \
        o1 = __builtin_amdgcn_mfma_f32_32x32x16_bf16(vfc[3], __builtin_bit_cast(bf16x8, pw[3]), o1, 0, 0, 0); C1[12] = __builtin_amdgcn_exp2f(C1[12]); C1[13] = __builtin_amdgcn_exp2f(C1[13]); C1[14] = __builtin_amdgcn_exp2f(C1[14]); C1[15] = __builtin_amdgcn_exp2f(C1[15]); AT_PIN(C1); AT_SB(); \
        if (resc) { _Pragma("unroll") for (int r = 0; r < 16; ++r) { o0[r] *= fres; o1[r] *= fres; } } \
    } while (0)
    f32x16 pA0, pA1, pB0, pB1; bool resc = false; float fres = 1.f;
    int s_prev = 0, s_cur = 0, s_iss = 2 * AT_BUF;
    AT_SYNC(0, s_iss); s_iss = AT_NEXT(s_iss);
    {
        const unsigned char* bk = lds + s_cur;
#pragma unroll
        for (int s_ = 0; s_ < 6; ++s_) {
            const bf16x8 k0f = *(const bf16x8*)(bk + koff + 32 * s_), k1f = *(const bf16x8*)(bk + koff + 32 * AT_KROW + 32 * s_);
            pA0 = __builtin_amdgcn_mfma_f32_32x32x16_bf16(k0f, qf[s_], s_ == 0 ? negm : pA0, 0, 0, 0);
            pA1 = __builtin_amdgcn_mfma_f32_32x32x16_bf16(k1f, qf[s_], s_ == 0 ? negm : pA1, 0, 0, 0);
        }
        AT_DECIDE(pA0, pA1);
#pragma unroll
        for (int r = 0; r < 16; ++r) { pA0[r] = __builtin_amdgcn_exp2f(pA0[r]); pA1[r] = __builtin_amdgcn_exp2f(pA1[r]); }
    }
    int t = 1;
#pragma unroll 1
    for (; t + 1 < ntiles; t += 2) {
        s_prev = s_cur; s_cur = AT_NEXT(s_cur); AT_SYNC(t, s_iss); s_iss = AT_NEXT(s_iss);
        AT_STEP(pB0, pB1, pA0, pA1, lds + s_cur, lds + s_prev);
        s_prev = s_cur; s_cur = AT_NEXT(s_cur); AT_SYNC(t + 1, s_iss); s_iss = AT_NEXT(s_iss);
        AT_STEP(pA0, pA1, pB0, pB1, lds + s_cur, lds + s_prev);
    }
    {
        s_prev = s_cur; s_cur = AT_NEXT(s_cur); AT_SYNC(t, s_iss); s_iss = AT_NEXT(s_iss);
        AT_STEP(pB0, pB1, pA0, pA1, lds + s_cur, lds + s_prev);
    }
    {
        float sacc = 0.f;
#pragma unroll
        for (int r = 0; r < 16; ++r) sacc += pB0[r] + pB1[r];
        l += sacc;
        u32x4 pw[4];
#pragma unroll
        for (int s2 = 0; s2 < 2; ++s2) {
            pw[s2] = (u32x4){cvtpk(pB0[8 * s2], pB0[8 * s2 + 1]), cvtpk(pB0[8 * s2 + 2], pB0[8 * s2 + 3]), cvtpk(pB0[8 * s2 + 4], pB0[8 * s2 + 5]), cvtpk(pB0[8 * s2 + 6], pB0[8 * s2 + 7])};
            pw[2 + s2] = (u32x4){cvtpk(pB1[8 * s2], pB1[8 * s2 + 1]), cvtpk(pB1[8 * s2 + 2], pB1[8 * s2 + 3]), cvtpk(pB1[8 * s2 + 4], pB1[8 * s2 + 5]), cvtpk(pB1[8 * s2 + 6], pB1[8 * s2 + 7])};
        }
        const unsigned char* bv = lds + s_cur;
#pragma unroll
        for (int ks = 0; ks < 4; ++ks) {
            const unsigned char* vb = bv + voff + ks * 16 * 64; const bf16x8 pf = __builtin_bit_cast(bf16x8, pw[ks]);
            o0 = __builtin_amdgcn_mfma_f32_32x32x16_bf16(tr8(vb, vb + 8 * 64), pf, o0, 0, 0, 0);
            o1 = __builtin_amdgcn_mfma_f32_32x32x16_bf16(tr8(vb + 4096, vb + 4096 + 8 * 64), pf, o1, 0, 0, 0);
        }
    }
#undef AT_GLDS
#undef AT_ISSUE
#undef AT_SB
#undef AT_PIN
#undef AT_NEXT
#undef AT_SYNC
#undef AT_DECIDE
#undef AT_MFS
#undef AT_KF
#undef AT_STEP
    l += __shfl_xor(l, 32);
    const float rl = 1.f / l;
    bf16_t* orow = (bf16_t*)(p.ws + WS_CC) + (size_t)qrow * D + 512 + h * 64 + 4 * hh;
#pragma unroll
    for (int r4 = 0; r4 < 4; ++r4) {
        u32x2 w0; w0.x = cvtpk(o0[4 * r4] * rl, o0[4 * r4 + 1] * rl); w0.y = cvtpk(o0[4 * r4 + 2] * rl, o0[4 * r4 + 3] * rl);
        u32x2 w1; w1.x = cvtpk(o1[4 * r4] * rl, o1[4 * r4 + 1] * rl); w1.y = cvtpk(o1[4 * r4 + 2] * rl, o1[4 * r4 + 3] * rl);
        *(u32x2*)(orow + 8 * r4) = w0; *(u32x2*)(orow + 32 + 8 * r4) = w1;
    }
}
__device__ __forceinline__ void retout_unit(unsigned char* lds, const P& p, int L, int gc, int h) {
    float* qs = (float*)lds; float* ks = qs + 128 * 33; float* vs = ks + 128 * 33; float* Sf = vs + 128 * 64; float* Sb = Sf + 2048;
    const int tid = threadIdx.x;
    const float l2f = log2_gamma(p, L, 0, h), l2b = log2_gamma(p, L, 1, h);
    load_ret_qk(qs, p, gc, h, Z_RQ, 1.f);
    load_ret_qk(ks, p, gc, h, Z_RK, 0.17677669529663687f);
    load_ret_v(vs, p, gc, h);
    {
        const bool lat = gc < 256; const int b = lat ? gc >> 4 : (gc - 256) >> 1;
        const int mme = lat ? 2 + (gc & 15) : (gc - 256) & 1;
        const int u = mme, w = mme < 2 ? 1 - mme : 19 - mme;
        f32x4 sf = (f32x4){0.f, 0.f, 0.f, 0.f}, sb = sf;
        const float* KVb = (const float*)(p.ws + WS_KV);
#pragma unroll 1
        for (int mm = 0; mm < 18; ++mm) {
            const int gcm = mm < 2 ? 256 + b * 2 + mm : b * 16 + (mm - 2);
            const int um = mm, wm = mm < 2 ? 1 - mm : 19 - mm;
            const float* kv = KVb + ((size_t)(gcm * 4 + h) * 2) * 2048 + tid * 4;
            if (um < u) { const float wgt = exp2f(l2f * 128.f * (float)(u - 1 - um)); sf += wgt * *(const f32x4*)kv; }
            if (wm < w) { const float wgt = exp2f(l2b * 128.f * (float)(w - 1 - wm)); sb += wgt * *(const f32x4*)(kv + 2048); }
        }
        *(f32x4*)(Sf + tid * 4) = sf; *(f32x4*)(Sb + tid * 4) = sb;
    }
    __syncthreads();
    const int i = tid >> 2, e0 = (tid & 3) * 16;
    float q[32];
#pragma unroll
    for (int d = 0; d < 32; ++d) q[d] = qs[i * 33 + d];
    float acc[16];
#pragma unroll
    for (int e = 0; e < 16; ++e) acc[e] = 0.f;
#pragma unroll 1
    for (int j = 0; j < 128; ++j) {
        float s = 0.f;
#pragma unroll
        for (int d = 0; d < 32; ++d) s += q[d] * ks[j * 33 + d];
        float wgt = 0.f;
        if (j <= i) wgt += exp2f(l2f * (float)(i - j));
        if (j >= i) wgt += exp2f(l2b * (float)(j - i));
        s *= wgt;
#pragma unroll
        for (int e4 = 0; e4 < 4; ++e4) { const f32x4 v4 = *(const f32x4*)(vs + j * 64 + e0 + 4 * e4); acc[4 * e4] += s * v4.x; acc[4 * e4 + 1] += s * v4.y; acc[4 * e4 + 2] += s * v4.z; acc[4 * e4 + 3] += s * v4.w; }
    }
    {
        const float cf = exp2f(l2f * (float)(i + 1)), cb = exp2f(l2b * (float)(128 - i));
#pragma unroll 2
        for (int d = 0; d < 32; ++d) {
            const float qd = qs[i * 33 + d]; const float qf = qd * cf, qb = qd * cb;
#pragma unroll
            for (int e4 = 0; e4 < 4; ++e4) { const f32x4 a = *(const f32x4*)(Sf + d * 64 + e0 + 4 * e4), bq = *(const f32x4*)(Sb + d * 64 + e0 + 4 * e4);
                acc[4 * e4] += qf * a.x + qb * bq.x; acc[4 * e4 + 1] += qf * a.y + qb * bq.y; acc[4 * e4 + 2] += qf * a.z + qb * bq.z; acc[4 * e4 + 3] += qf * a.w + qb * bq.w; }
        }
    }
    float s1 = 0.f;
#pragma unroll
    for (int e = 0; e < 16; ++e) s1 += acc[e];
    s1 += __shfl_xor(s1, 1); s1 += __shfl_xor(s1, 2);
    const float mu = s1 * (1.f / 64.f);
    float s2 = 0.f;
#pragma unroll
    for (int e = 0; e < 16; ++e) { const float dd = acc[e] - mu; s2 += dd * dd; }
    s2 += __shfl_xor(s2, 1); s2 += __shfl_xor(s2, 2);
    const float rstd = rsqrtf(s2 * (1.f / 64.f) + NORM_EPS);
    const int row = gc * 128 + i;
    const bf16_t* zg = (const bf16_t*)(p.ws + WS_Z) + (size_t)row * ZC + Z_RG + h * 64 + e0;
    const float* gw = p.in[13] + L * 256 + h * 64 + e0;
    const u32x4 g0 = *(const u32x4*)zg, g1 = *(const u32x4*)(zg + 8);
    float g[16];
#pragma unroll
    for (int k = 0; k < 4; ++k) { g[2 * k] = lo16(g0[k]); g[2 * k + 1] = hi16(g0[k]); g[8 + 2 * k] = lo16(g1[k]); g[8 + 2 * k + 1] = hi16(g1[k]); }
    unsigned o[8];
#pragma unroll
    for (int k = 0; k < 8; ++k) {
        const float y0 = siluf(g[2 * k]) * ((acc[2 * k] - mu) * rstd * gw[2 * k]), y1 = siluf(g[2 * k + 1]) * ((acc[2 * k + 1] - mu) * rstd * gw[2 * k + 1]);
        o[k] = pk2(y0, y1);
    }
    u32x4* op = (u32x4*)((bf16_t*)(p.ws + WS_CC) + (size_t)row * D + 256 + h * 64 + e0);
    u32x4 w0; w0.x = o[0]; w0.y = o[1]; w0.z = o[2]; w0.w = o[3]; u32x4 w1; w1.x = o[4]; w1.y = o[5]; w1.z = o[6]; w1.w = o[7];
    op[0] = w0; op[1] = w1;
    __syncthreads();
}
__device__ __forceinline__ void phase_c(unsigned char* lds, const P& p, int L) {
    const int G = gridDim.x, bid = blockIdx.x;
    const int nat = 16 * 8 * 8, nac = (L == 0) ? 128 : 0, nro = (L == 0 ? 288 : 256) * 4;
    const int total = nat + nac + nro;
    for (int u = bid; u < total; u += G) {
        int r = u;
#ifndef TEST_C
#define TEST_C 3
#endif
        if (r < nat) { if (TEST_C & 1) attn_unit_mfma(lds, p, r >> 6, (r >> 3) & 7, r & 7, false); continue; } r -= nat;
        if (r < nac) { if (TEST_C & 1) attn_unit_mfma(lds, p, r >> 3, r & 7, 0, true); continue; } r -= nac;
        if (TEST_C & 2) retout_unit_mfma(lds, p, L, r >> 2, r & 3);
    }
    if (L == 0) convert_expert_weights(lds, p, 0);
}

struct EpiY {
    bf16_t* Y; const float* g1;
    __device__ __forceinline__ void operator()(const ge::Acc& acc, const ge::Unit& u, int wr, int wc, int fr, int fq) const {
        const float* gr = g1 + (size_t)mod_row(u.a * 256) * 6144 + u.b * 256 + wc * 32 + 8 * fq;
        f32x4 g[2][2];
#pragma unroll
        for (int bj = 0; bj < 2; ++bj)
#pragma unroll
            for (int n = 0; n < 2; ++n) g[bj][n] = *(const f32x4*)(gr + bj * 128 + n * 4);
#pragma unroll
        for (int ai = 0; ai < 2; ++ai)
#pragma unroll
            for (int m = 0; m < 4; ++m) {
                bf16_t* yr = Y + (size_t)(u.a * 256 + ai * 128 + wr * 64 + m * 16 + fr) * D + u.b * 256 + wc * 32 + 8 * fq;
#pragma unroll
                for (int bj = 0; bj < 2; ++bj) { const f32x4 v0 = acc[ai][bj][m][0] * g[bj][0], v1 = acc[ai][bj][m][1] * g[bj][1];
                    u32x4 w; w.x = cvtpk(v0.x, v0.y); w.y = cvtpk(v0.z, v0.w); w.z = cvtpk(v1.x, v1.y); w.w = cvtpk(v1.z, v1.w); *(u32x4*)(yr + bj * 128) = w; }
            }
    }
};
__device__ __forceinline__ void phase_d(unsigned char* lds, const P& p, int L) {
    ge::DenseOrder S; S.nM = (L == 0 ? NTOK : NLAT) / 256; S.nN = 4; S.nwg = S.nM * 4; S.G = gridDim.x; S.c = blockIdx.x;
    S.Bt = (const char*)((const bf16_t*)(p.ws + WS_WOUT) + (size_t)L * D * D); S.btile = (size_t)256 * D * 2; S.arow = D * 2;
    EpiY E{(bf16_t*)(p.ws + WS_Y), (const float*)(p.ws + WS_MODV) + (size_t)L * 17 * 6144 + 2048};
    ge::gemm_stream<ge::DenseOrder, EpiY, true>((LAS unsigned char*)lds, (const char*)(p.ws + WS_CC), D, S, E);
}

__device__ __forceinline__ void norm_mod_store(const P& p, int L, int which, int tok, int lane, const f32x4 (&v)[4], bf16_t* Hdst) {
    const float* nw = (which == 0 ? p.in[6] : p.in[19]) + L * D;
    const float* mrow = (const float*)(p.ws + WS_MODV) + ((size_t)L * 17 + mod_row(tok)) * 6144 + which * 3072;
    float s = 0.f;
#pragma unroll
    for (int j = 0; j < 4; ++j) s += v[j].x * v[j].x + v[j].y * v[j].y + v[j].z * v[j].z + v[j].w * v[j].w;
    const float rstd = rsqrtf(wave_sum(s) * (1.f / D) + NORM_EPS);
    u32x2* o = (u32x2*)(Hdst + (size_t)tok * D) + lane;
#pragma unroll
    for (int j = 0; j < 4; ++j) {
        const int k = 4 * lane + 256 * j;
        const f32x4 w4 = *(const f32x4*)(nw + k), sh = *(const f32x4*)(mrow + k), sc = *(const f32x4*)(mrow + 1024 + k);
        const f32x4 y = v[j] * rstd * w4 * (sc + 1.f) + sh;
        u32x2 w; w.x = cvtpk(y.x, y.y); w.y = cvtpk(y.z, y.w); o[64 * j] = w;
    }
}
__device__ __forceinline__ int half_n(int L) { return L == 0 ? NTOK / 2 : NLAT / 2; }
__device__ __forceinline__ void phase_router(unsigned char* lds, const P& p, int L) {
    constexpr int O_LG = 41472, O_CNT = 83072, O_SEL = 83584, O_SELW = 87424;
    const bf16_t* H = (const bf16_t*)(p.ws + WS_H); const bf16_t* W = (const bf16_t*)(p.ws + WS_RT) + (size_t)L * 128 * D;
    const bf16_t* Y = (const bf16_t*)(p.ws + WS_Y);
    float* lg = (float*)(lds + O_LG);
    int* lcnt = (int*)(lds + O_CNT);
    int* sel = (int*)(lds + O_SEL);
    float* selw = (float*)(lds + O_SELW);
    int* ltok = (int*)(p.ws + WS_LTOK); float* lw = (float*)(p.ws + WS_LW);
    const int tid = threadIdx.x, lane = tid & 63, wave = tid >> 6;
    const int ntok = (L == 0 ? NTOK : NLAT), TS = (L == 0 ? 144 : 128), nmt = ntok / TS, RW = TS / 8;
    for (int mt = blockIdx.x; mt < nmt; mt += gridDim.x) {
        const int t0 = mt * TS;
        if (tid < 64) lcnt[tid] = 0;
#pragma unroll 2
        for (int q = 0; q < RW; ++q) {
            const int tok = t0 + wave * RW + q;
            const u32x2* yr = (const u32x2*)(Y + (size_t)tok * D) + lane;
            u32x2* xo = (u32x2*)x_row(p, tok) + lane;
            f32x4 v[4];
            if (L == 0) {
                const f32x4* xi = (const f32x4*)x_in_row(p, tok) + lane;
#pragma unroll
                for (int j = 0; j < 4; ++j) { const f32x4 a = xi[64 * j]; const u32x2 y = yr[64 * j]; v[j] = (f32x4){a.x + lo16(y.x), a.y + hi16(y.x), a.z + lo16(y.y), a.w + hi16(y.y)}; }
            } else {
#pragma unroll
                for (int j = 0; j < 4; ++j) { const u32x2 a = xo[64 * j]; const u32x2 y = yr[64 * j]; v[j] = (f32x4){lo16(a.x) + lo16(y.x), hi16(a.x) + hi16(y.x), lo16(a.y) + lo16(y.y), hi16(a.y) + hi16(y.y)}; }
            }
#pragma unroll
            for (int j = 0; j < 4; ++j) { u32x2 w; w.x = cvtpk(v[j].x, v[j].y); w.y = cvtpk(v[j].z, v[j].w); xo[64 * j] = w; }
            norm_mod_store(p, L, 1, tok, lane, v, (bf16_t*)(p.ws + WS_H));
        }
        asm volatile("s_waitcnt vmcnt(0)" ::: "memory");
        __syncthreads();
        auto rs = [&](int pr) { return H + (size_t)(t0 + (pr < TS ? pr : TS - 1)) * D; };
        auto epi = [&](int r, int c, f32x4 v) { if (c < 64) { float* d = lg + r * 65 + c; d[0] = v.x; d[1] = v.y; d[2] = v.z; d[3] = v.w; } };
        gemm_tile<5>(lds, rs, W, D, D, epi);
        __syncthreads();
        if (tid < TS) {
            const float* rbp = p.in[21] + L * NEXP; const float* lrow = lg + tid * 65;
            float bv[6], bs[6]; int bi[6];
#pragma unroll
            for (int k = 0; k < 6; ++k) { bv[k] = -INFINITY; bs[k] = 0.f; bi[k] = 0; }
#pragma unroll 4
            for (int e = 0; e < NEXP; ++e) {
                float sc = __builtin_amdgcn_rcpf(1.f + __expf(-lrow[e])); float sv = sc + rbp[e]; int ei = e;
#pragma unroll
                for (int k = 0; k < 6; ++k) { const bool gt = sv > bv[k]; const float tv = gt ? bv[k] : sv, ts = gt ? bs[k] : sc; const int ti = gt ? bi[k] : ei;
                    bv[k] = gt ? sv : bv[k]; bs[k] = gt ? sc : bs[k]; bi[k] = gt ? ei : bi[k]; sv = tv; sc = ts; ei = ti; }
            }
            const float rs6 = 2.5f / (bs[0] + bs[1] + bs[2] + bs[3] + bs[4] + bs[5]);
#pragma unroll
            for (int k = 0; k < 6; ++k) { const int rank = atomicAdd(&lcnt[bi[k]], 1); sel[tid * 6 + k] = (bi[k] << 8) | rank; selw[tid * 6 + k] = bs[k] * rs6; }
        }
        __syncthreads();
        if (tid < 64) {
            unsigned* ecnt = (unsigned*)(p.ws + WS_CTL) + CW_ECNT + L * 4096;
            const int c = lcnt[tid];
            lcnt[64 + tid] = c ? (int)atomicAdd(ecnt + tid * 64, (unsigned)c) : 0;
        }
        __syncthreads();
        for (int i = tid; i < TS * 6; i += NTHREADS) {
            const int sv = sel[i], e = sv >> 8, pos = lcnt[64 + e] + (sv & 255), tok = t0 + i / 6, k = i % 6;
            ltok[(size_t)e * LCAP + pos] = tok * 8 + k;
            lw[(size_t)e * LCAP + pos] = selw[i];
        }
        __syncthreads();
    }
}

__device__ __forceinline__ void build_etab(unsigned char* lds, const P& p, int L) {
    int* tstart = (int*)(lds + ETAB_OFF); int* cnt = tstart + 80;
    __syncthreads();
    if (threadIdx.x < 64) { const unsigned* ecnt = (const unsigned*)(p.ws + WS_CTL) + CW_ECNT + L * 4096;
        cnt[threadIdx.x] = (int)__hip_atomic_load(ecnt + threadIdx.x * 64, __ATOMIC_RELAXED, __HIP_MEMORY_SCOPE_AGENT); }
    __syncthreads();
    if (threadIdx.x == 0) { int s = 0; for (int e = 0; e < 64; ++e) { tstart[e] = s; s += (cnt[e] + 255) >> 8; } tstart[64] = s; s += (L == 0 ? NTOK : NLAT) / 256; tstart[65] = s; }
    __syncthreads();
}
struct MoeOrder {
    int TT, nN, G, c; const int* tstart; const char* Bexp; size_t bexp; const char* Bsh; size_t btile; const int* rowbuf; unsigned arow; bool ident;
    __device__ __forceinline__ bool next(int i, ge::Unit& u) const {
        const int Lq = i * G + c; if (Lq >= TT * nN) return false;
        const int t = Lq / nN, pn = Lq % nN;
        int lo = 0, hi = 64;
        while (lo < hi) { const int mid = (lo + hi + 1) >> 1; if (tstart[mid] <= t) lo = mid; else hi = mid - 1; }
        const int e = __builtin_amdgcn_readfirstlane(lo);
        u.a = t; u.b = pn; u.c = e; u.d = i;
        u.B = (e < 64 ? Bexp + (size_t)e * bexp : Bsh) + (size_t)pn * btile;
        return true;
    }
    __device__ __forceinline__ unsigned aoff(int i, const ge::Unit& u, int R) const { return (unsigned)(ident ? u.a * 256 + R : rowbuf[i * 256 + R]) * arow; }
};
__device__ __forceinline__ void phase_gateup(unsigned char* lds, const P& p, int L) {
    build_etab(lds, p, L);
    const int* tstart = (const int*)(lds + ETAB_OFF); const int* cnt = tstart + 80;
    int* rowbuf = (int*)(lds + RB0_OFF); float* wbuf = (float*)(lds + RB1_OFF);
    const int* ltok = (const int*)(p.ws + WS_LTOK); const float* lw = (const float*)(p.ws + WS_LW);
    bf16_t* ACT = (bf16_t*)(p.ws + WS_ACT);
    const int G = gridDim.x, bid = blockIdx.x, vcu = (G % 8 == 0) ? (bid % 8) * (G / 8) + bid / 8 : bid;
    MoeOrder S; S.TT = tstart[65]; S.nN = 2; S.G = G; S.c = vcu; S.tstart = tstart; S.Bexp = (const char*)(p.ws + WS_EGU); S.bexp = (size_t)512 * D * 2;
    S.Bsh = (const char*)((const bf16_t*)(p.ws + WS_SHGU) + (size_t)L * 512 * D); S.btile = (size_t)256 * D * 2; S.rowbuf = rowbuf; S.arow = D * 2; S.ident = false;
    {
        ge::Unit u;
        for (int i = 0; i < 10 && S.next(i, u); ++i) {
            if (threadIdx.x < 256) {
                const int R = threadIdx.x, e = u.c, mt = u.a - tstart[e];
                int tok; float w;
                if (e < 64) { const int lp = mt * 256 + R; const bool ok = lp < cnt[e]; tok = ok ? (ltok[(size_t)e * LCAP + lp] >> 3) : 0; w = ok ? lw[(size_t)e * LCAP + lp] : 0.f; }
                else { tok = mt * 256 + R; w = 1.f; }
                rowbuf[i * 256 + R] = tok; wbuf[i * 256 + R] = w;
            }
        }
        __syncthreads();
    }
    auto f = [&](const ge::Unit& u, int r, int c, f32x4 v0, f32x4 v1) {
        const float w = wbuf[u.d * 256 + r];
        u32x2 o; o.x = cvtpk(siluf(v0.x) * v0.y * w, siluf(v0.z) * v0.w * w); o.y = cvtpk(siluf(v1.x) * v1.y * w, siluf(v1.z) * v1.w * w);
        *(u32x2*)(ACT + (size_t)(u.a * 256 + r) * EDIM + ((u.b * 256 + c) >> 1)) = o;
    };
    ge::EpiFn<decltype(f)> E{f};
    ge::gemm_stream<MoeOrder, ge::EpiFn<decltype(f)>, true>((LAS unsigned char*)lds, (const char*)(p.ws + WS_H), D, S, E);
}
__device__ __forceinline__ void phase_down(unsigned char* lds, const P& p, int L) {
    build_etab(lds, p, L);
    const int* tstart = (const int*)(lds + ETAB_OFF); const int* cnt = tstart + 80;
    int* sbuf = (int*)(lds + RB0_OFF);
    const int* ltok = (const int*)(p.ws + WS_LTOK);
    unsigned char* SLOT = (unsigned char*)(p.ws + WS_SLOT);
    const int G = gridDim.x, bid = blockIdx.x, vcu = (G % 8 == 0) ? (bid % 8) * (G / 8) + bid / 8 : bid;
    MoeOrder S; S.TT = tstart[65]; S.nN = 4; S.G = G; S.c = vcu; S.tstart = tstart; S.Bexp = (const char*)(p.ws + WS_ED); S.bexp = (size_t)D * EDIM * 2;
    S.Bsh = (const char*)((const bf16_t*)(p.ws + WS_SHD) + (size_t)L * D * EDIM); S.btile = (size_t)256 * EDIM * 2; S.rowbuf = sbuf; S.arow = EDIM * 2; S.ident = true;
    {
        ge::Unit u;
        for (int i = 0; i < 18 && S.next(i, u); ++i) {
            if (threadIdx.x < 256) {
                const int R = threadIdx.x, e = u.c, mt = u.a - tstart[e];
                int srow;
                if (e < 64) { const int lp = mt * 256 + R; if (lp < cnt[e]) { const int ent = ltok[(size_t)e * LCAP + lp]; srow = (ent >> 3) * 7 + (ent & 7); } else srow = NTOK * 7; }
                else srow = (mt * 256 + R) * 7 + 6;
                sbuf[i * 256 + R] = srow;
            }
        }
        __syncthreads();
    }
    auto f = [&](const ge::Unit& u, int r, int c, f32x4 v0, f32x4 v1) {
        const int srow = sbuf[u.d * 256 + r];
        int w0 = 0, w1 = 0;
        w0 = __builtin_amdgcn_cvt_pk_fp8_f32(__builtin_amdgcn_fmed3f(v0.x, -440.f, 440.f), __builtin_amdgcn_fmed3f(v0.y, -440.f, 440.f), w0, false);
        w0 = __builtin_amdgcn_cvt_pk_fp8_f32(__builtin_amdgcn_fmed3f(v0.z, -440.f, 440.f), __builtin_amdgcn_fmed3f(v0.w, -440.f, 440.f), w0, true);
        w1 = __builtin_amdgcn_cvt_pk_fp8_f32(__builtin_amdgcn_fmed3f(v1.x, -440.f, 440.f), __builtin_amdgcn_fmed3f(v1.y, -440.f, 440.f), w1, false);
        w1 = __builtin_amdgcn_cvt_pk_fp8_f32(__builtin_amdgcn_fmed3f(v1.z, -440.f, 440.f), __builtin_amdgcn_fmed3f(v1.w, -440.f, 440.f), w1, true);
        u32x2 w; w.x = (unsigned)w0; w.y = (unsigned)w1; *(u32x2*)(SLOT + (size_t)srow * D + u.b * 256 + c) = w;
    };
    ge::EpiFn<decltype(f)> E{f};
    ge::gemm_stream<MoeOrder, ge::EpiFn<decltype(f)>, true>((LAS unsigned char*)lds, (const char*)(p.ws + WS_ACT), EDIM, S, E);
}
__device__ __forceinline__ void phase_combine(const P& p, int L) {
    const int tid = threadIdx.x, lane = tid & 63, wave = tid >> 6, gw = blockIdx.x * NWAVES + wave, NGW = gridDim.x * NWAVES;
    const unsigned char* SLOT = (const unsigned char*)(p.ws + WS_SLOT);
    const float* modv = (const float*)(p.ws + WS_MODV) + (size_t)L * 17 * 6144;
    const int ntok = (L == 0 ? NTOK : NLAT);
    for (int tok = gw; tok < ntok; tok += NGW) {
        f32x4 acc[4];
#pragma unroll
        for (int j = 0; j < 4; ++j) acc[j] = (f32x4){0.f, 0.f, 0.f, 0.f};
#pragma unroll
        for (int k = 0; k < 7; ++k) {
            const int* sr = (const int*)(SLOT + ((size_t)tok * 7 + k) * D) + lane;
#pragma unroll
            for (int j = 0; j < 4; ++j) { const int w = sr[64 * j]; const f32x2_t a = __builtin_amdgcn_cvt_pk_f32_fp8(w, false), b = __builtin_amdgcn_cvt_pk_f32_fp8(w, true); acc[j].x += a.x; acc[j].y += a.y; acc[j].z += b.x; acc[j].w += b.y; }
        }
        const float* g2 = modv + (size_t)mod_row(tok) * 6144 + 5120;
        u32x2* xr = (u32x2*)x_row(p, tok) + lane;
        f32x4 v[4];
#pragma unroll
        for (int j = 0; j < 4; ++j) { const f32x4 g = *(const f32x4*)(g2 + 4 * lane + 256 * j); const u32x2 a = xr[64 * j];
            v[j] = (f32x4){lo16(a.x), hi16(a.x), lo16(a.y), hi16(a.y)} + g * acc[j]; }
        if (L == 0) {
#pragma unroll
            for (int j = 0; j < 4; ++j) { u32x2 w; w.x = cvtpk(v[j].x, v[j].y); w.y = cvtpk(v[j].z, v[j].w); xr[64 * j] = w; }
            norm_mod_store(p, 1, 0, tok, lane, v, (bf16_t*)(p.ws + WS_H1));
        } else {
            const float* nw = p.in[28]; float s = 0.f;
#pragma unroll
            for (int j = 0; j < 4; ++j) s += v[j].x * v[j].x + v[j].y * v[j].y + v[j].z * v[j].z + v[j].w * v[j].w;
            const float rstd = rsqrtf(wave_sum(s) * (1.f / D) + NORM_EPS);
            f32x4* orow = (f32x4*)(p.out + (size_t)tok * D) + lane;
#pragma unroll
            for (int j = 0; j < 4; ++j) { const f32x4 w4 = *(const f32x4*)(nw + 4 * lane + 256 * j); orow[64 * j] = v[j] * rstd * w4; }
        }
    }
}

constexpr int PH_LAYER0 = 2, PH_PER_LAYER = 8, PH_LAYER1 = PH_LAYER0 + PH_PER_LAYER, NPHASES = PH_LAYER1 + PH_PER_LAYER;

__global__ void __launch_bounds__(NTHREADS, 2) mk_fwd(P p) {
    extern __shared__ __attribute__((aligned(16))) unsigned char lds[];
    volatile LAS unsigned* MISC = (volatile LAS unsigned*)((LAS unsigned char*)lds + MISC_OFF);
    if (threadIdx.x < 64) MISC[threadIdx.x] = 0u;
    __syncthreads();
    unsigned* ctl = (unsigned*)(p.ws + WS_CTL);
    XcdBarrier bar; bar.bar = ctl + CW_BAR; bar.x = 0; bar.st = MISC + 8;
    if (!MK_PER_PHASE) bar = xcd_barrier_post(ctl + CW_BAR, MISC + 8);
    const int lo = p.ph_lo, hi = p.ph_hi;
#ifndef PH_MASK
#define PH_MASK 0xffffu
#endif
#define HAS(b) ((PH_MASK >> (b)) & 1u)
#define IN(k) (lo <= (k) && (k) < hi)
#define SEAM(k) do { if (IN(k) && IN((k) + 1)) xcd_barrier(bar); } while (0)

#ifdef PROBE_MASK
    unsigned long long tacc = 0ull, t0p = 0ull;
#define PT0() t0p = __builtin_amdgcn_s_memrealtime()
#define PT1(b) do { if ((PROBE_MASK >> (b)) & 1u) tacc += __builtin_amdgcn_s_memrealtime() - t0p; } while (0)
#else
#define PT0() do {} while (0)
#define PT1(b) do {} while (0)
#endif
#define PH(b, k, body) do { PT0(); if (HAS(b) && IN(k)) { body; } SEAM(k); PT1(b); } while (0)
    PH(0, 0, phase_prep0(lds, p));
    PH(1, 1, (phase_prep1(lds, p), phase_norm_mod(p, 0, 0, NTOK)));
#define LAYER(L, pb) \
        PH(2, pb + 0, phase_zgemm(lds, p, L)); \
        PH(3, pb + 1, phase_b(lds, p, L)); \
        PH(4, pb + 2, phase_c(lds, p, L)); \
        PH(5, pb + 3, phase_d(lds, p, L)); \
        PH(7, pb + 4, phase_router(lds, p, L)); \
        PH(8, pb + 5, phase_gateup(lds, p, L)); \
        PH(9, pb + 6, phase_down(lds, p, L)); \
        PH(10, pb + 7, phase_combine(p, L));
    LAYER(0, PH_LAYER0)
    LAYER(1, PH_LAYER1)
#ifdef PROBE_MASK
    if (blockIdx.x == 0) {
        const unsigned long long tend = __builtin_amdgcn_s_memrealtime();
        while (__builtin_amdgcn_s_memrealtime() - tend < (unsigned long long)PROBE_AMP * tacc) __builtin_amdgcn_s_sleep(8);
    }
#endif
#undef IN
#undef SEAM
}

extern "C" void kernel_launch(void* const* d_in, const int* in_sizes, int n_in, void* d_out, int out_size, void* d_ws, size_t ws_size, hipStream_t stream) {
    static int grid = 0;
    if (grid == 0) {
        if (n_in != 29 || in_sizes[0] != NLAT * D || out_size != NLAT * D || ws_size < WS_END) {
            fprintf(stderr, "kernel_launch: unexpected shapes / workspace (n_in %d, ws %zu, need %zu); nothing launched\n", n_in, ws_size, (size_t)WS_END); grid = -1; return; }
        int dev = 0, cus = 0, per_cu = 0;
        if (hipGetDevice(&dev) != hipSuccess || hipDeviceGetAttribute(&cus, hipDeviceAttributeMultiprocessorCount, dev) != hipSuccess) { grid = -1; return; }
        if (hipFuncSetAttribute((const void*)mk_fwd, hipFuncAttributeMaxDynamicSharedMemorySize, LDS_BYTES) != hipSuccess) { grid = -1; return; }
        if (hipOccupancyMaxActiveBlocksPerMultiprocessor(&per_cu, (const void*)mk_fwd, NTHREADS, LDS_BYTES) != hipSuccess || per_cu < 1) { fprintf(stderr, "kernel_launch: occupancy query says %d\n", per_cu); }
        (void)hipGetLastError();
        grid = cus;
    }
    if (grid < 0) return;
    (void)hipMemsetAsync((char*)d_ws + WS_CTL, 0, CTL_ZERO_BYTES, stream);
    P a{};
    for (int i = 0; i < 29; ++i) a.in[i] = (const float*)d_in[i];
    a.out = (float*)d_out; a.ws = (unsigned char*)d_ws;
#if MK_PER_PHASE
    for (int ph = 0; ph < NPHASES; ++ph) { a.ph_lo = ph; a.ph_hi = ph + 1; hipLaunchKernelGGL(mk_fwd, dim3(grid), dim3(NTHREADS), LDS_BYTES, stream, a); }
#else
    a.ph_lo = 0; a.ph_hi = NPHASES;
    hipLaunchKernelGGL(mk_fwd, dim3(grid), dim3(NTHREADS), LDS_BYTES, stream, a);
#endif
}
```

```cpp
#include <hip/hip_runtime.h>
#include <cstdio>
#include <cstdint>

#ifndef MK_PER_PHASE
#define MK_PER_PHASE 0
#endif

typedef unsigned short bf16_t;
typedef short bf16x8 __attribute__((ext_vector_type(8)));
typedef float f32x4 __attribute__((ext_vector_type(4)));
typedef unsigned u32x4 __attribute__((ext_vector_type(4)));
typedef unsigned u32x2 __attribute__((ext_vector_type(2)));
typedef float f32x16 __attribute__((ext_vector_type(16)));
typedef short v4i16_t __attribute__((ext_vector_type(4)));
#define LAS __attribute__((address_space(3)))

constexpr int D = 1024, BATCH = 16, SEQ = 2048, CTXL = 256;
constexpr int NLAT = BATCH * SEQ, NCTX = BATCH * CTXL, NTOK = NLAT + NCTX;
constexpr int ZC = 1792;
constexpr int Z_RQ = 512, Z_RK = 640, Z_RV = 768, Z_RG = 1024, Z_CQ = 1280, Z_CKV = 1536, Z_KR = 1664, Z_END = 1696;
constexpr int NEXP = 64, TOPK = 6, EDIM = 256;
constexpr float NORM_EPS = 1e-6f;
constexpr int NTHREADS = 512, NWAVES = 8;

constexpr size_t MiB = 1u << 20;
constexpr size_t WS_CTL = 0, CTL_ZERO_BYTES = 1 * MiB;
constexpr size_t WS_MODV = 1 * MiB;
constexpr size_t WS_ROPE = 2 * MiB;
constexpr size_t WS_WIN = 3 * MiB;
constexpr size_t WS_WUQ = 10 * MiB;
constexpr size_t WS_WUKV = 11 * MiB;
constexpr size_t WS_WOUT = 12 * MiB;
constexpr size_t WS_RT = 16 * MiB;
constexpr size_t WS_SHGU = 17 * MiB;
constexpr size_t WS_SHD = 19 * MiB;
constexpr size_t WS_EGU = 20 * MiB;
constexpr size_t WS_ED = 84 * MiB;
constexpr size_t WS_H1 = 20 * MiB;
constexpr size_t WS_X = 116 * MiB;
constexpr size_t WS_H = 188 * MiB;
constexpr size_t WS_CC = WS_H;
constexpr size_t WS_Z = 260 * MiB;
constexpr size_t WS_Y = WS_Z;
constexpr size_t WS_Q = 386 * MiB;
constexpr size_t WS_K = 440 * MiB;
constexpr size_t WS_V = 494 * MiB;
constexpr size_t WS_KV = 530 * MiB;
constexpr size_t WS_SLOT = 188 * MiB;
constexpr size_t WS_ACT = 441 * MiB;
constexpr size_t WS_LTOK = 583 * MiB;
constexpr size_t WS_LW = 592 * MiB;
constexpr size_t WS_SS = 601 * MiB;
constexpr size_t WS_END = 603 * MiB;
constexpr int LCAP = NTOK;
static_assert(WS_SLOT + ((size_t)NTOK * 7 + 1) * 1024 <= WS_ACT && WS_ACT + (size_t)1136 * 256 * 512 <= WS_LTOK, "MoE buffers");

constexpr int CW_TMO = 0;
constexpr int CW_BAR = 4096;
constexpr int CW_ECNT = 8192;

constexpr int LDS_BYTES = 162816;
constexpr int MISC_OFF = LDS_BYTES - 256;
constexpr int RB0_OFF = 131072;
constexpr int RB1_OFF = 149504;
constexpr int ETAB_OFF = 159744;
constexpr int GEMM_LDS = 36864;
constexpr int ROWSS_OFF = 36864;
constexpr int LG_OFF = 37376;

#define XB_TMO      128
#define XB_XCNT(j)  (256  + 64 * (j))
#define XB_XSUB(j)  (1280 + 64 * (j))
#define XB_XGEN(j)  (2304 + 64 * (j))
#define XB_TOP      3328
#define XB_TOPGEN   3392
#define XCD_BAR_WORDS 3456
#define XB_SPIN_CAP (1u << 24)
__device__ __forceinline__ unsigned xb_ld(unsigned* p)              { return __hip_atomic_load(p, __ATOMIC_RELAXED, __HIP_MEMORY_SCOPE_AGENT); }
__device__ __forceinline__ unsigned xb_add(unsigned* p, unsigned v) { return __hip_atomic_fetch_add(p, v, __ATOMIC_RELAXED, __HIP_MEMORY_SCOPE_AGENT); }
__device__ __forceinline__ unsigned xb_xcc_id() { return (unsigned)__builtin_amdgcn_s_getreg((3 << 11) | 20) & 0xFu; }
#define XB_SPIN(cond, bar) do { unsigned _sp = 0; while (cond) { __builtin_amdgcn_s_sleep(1); \
    if ((++_sp & 255u) == 0u) { if (xb_ld(&(bar)[XB_TMO])) break; if (_sp > XB_SPIN_CAP) { atomicAdd(&(bar)[XB_TMO], 1u); break; } } } } while (0)
struct XcdBarrier { unsigned* bar; unsigned x; volatile LAS unsigned* st; };
__device__ __forceinline__ XcdBarrier xcd_barrier_post(unsigned* bar, volatile LAS unsigned* st) {
    XcdBarrier b; b.bar = bar; b.x = xb_xcc_id(); b.st = st;
    if (threadIdx.x == 0) (void)xb_add(&bar[XB_XCNT(b.x)], 1u);
    return b;
}
__device__ __forceinline__ void xcd_barrier_complete(unsigned* bar, unsigned x, unsigned& nloc, unsigned& nx) {
    const unsigned G = gridDim.x * gridDim.y * gridDim.z;
    unsigned sum, cnt, mine, sp = 0u;
    for (;;) {
        sum = 0u; cnt = 0u; mine = 0u;
#pragma unroll
        for (unsigned j = 0; j < 16; ++j) { const unsigned c = xb_ld(&bar[XB_XCNT(j)]); sum += c; cnt += (c > 0u) ? 1u : 0u; mine = (j == x) ? c : mine; }
        if (sum == G) break;
        __builtin_amdgcn_s_sleep(1);
        if ((++sp & 255u) == 0u) { if (xb_ld(&bar[XB_TMO])) break; if (sp > XB_SPIN_CAP) { atomicAdd(&bar[XB_TMO], 1u); break; } }
    }
    nloc = mine > 0u ? mine : 1u; nx = cnt > 0u ? cnt : 1u;
}
__device__ __forceinline__ void xcd_barrier(const XcdBarrier& b) {
    asm volatile("s_waitcnt vmcnt(0)" ::: "memory");
    __syncthreads();
    if (threadIdx.x == 0) {
        unsigned* bar = b.bar;
        __builtin_amdgcn_s_waitcnt(0);
        unsigned nloc = b.st[0], nx = b.st[1];
        if (nloc == 0u) { xcd_barrier_complete(bar, b.x, nloc, nx); b.st[0] = nloc; b.st[1] = nx; }
        const unsigned old = xb_add(&bar[XB_XSUB(b.x)], 1u);
        const unsigned gen = old / nloc;
        if (old + 1u == (gen + 1u) * nloc) {
            __builtin_amdgcn_fence(__ATOMIC_RELEASE, "agent");
            asm volatile("s_waitcnt vmcnt(0)" ::: "memory");
            const unsigned og = xb_add(&bar[XB_TOP], 1u);
            const unsigned tg = og / nx;
            if (og + 1u == (tg + 1u) * nx) xb_add(&bar[XB_TOPGEN], 1u);
            else XB_SPIN(xb_ld(&bar[XB_TOPGEN]) == tg, bar);
            __builtin_amdgcn_fence(__ATOMIC_ACQUIRE, "agent");
            xb_add(&bar[XB_XGEN(b.x)], 1u);
            asm volatile("s_waitcnt vmcnt(0)" ::: "memory");
        } else {
            XB_SPIN(xb_ld(&bar[XB_XGEN(b.x)]) == gen, bar);
            __builtin_amdgcn_fence(__ATOMIC_ACQUIRE, "agent");
            asm volatile("s_waitcnt vmcnt(0)" ::: "memory");
        }
    }
    __syncthreads();
}

__device__ __forceinline__ float bf2f(unsigned h) { return __uint_as_float(h << 16); }
__device__ __forceinline__ unsigned f2bf(float f) { unsigned u = __float_as_uint(f); return (u + 0x7fffu + ((u >> 16) & 1u)) >> 16; }
__device__ __forceinline__ unsigned pk2(float lo, float hi) { return f2bf(lo) | (f2bf(hi) << 16); }
typedef float f32x2_t __attribute__((ext_vector_type(2)));
typedef __bf16 bf16x2_t __attribute__((ext_vector_type(2)));
__device__ __forceinline__ unsigned cvtpk(float lo, float hi) { f32x2_t v = {lo, hi}; bf16x2_t b = __builtin_convertvector(v, bf16x2_t); return __builtin_bit_cast(unsigned, b); }
__device__ __forceinline__ float lo16(unsigned w) { return __uint_as_float(w << 16); }
__device__ __forceinline__ float hi16(unsigned w) { return __uint_as_float(w & 0xffff0000u); }
__device__ __forceinline__ float wave_sum(float v) {
#pragma unroll
    for (int o = 1; o < 64; o <<= 1) v += __shfl_xor(v, o);
    return v;
}
__device__ __forceinline__ float siluf(float v) { return v * __builtin_amdgcn_rcpf(1.f + __expf(-v)); }
__device__ __forceinline__ int mod_row(int tok) { return tok < NLAT ? (tok >> 11) : 16; }

struct P { const float* in[29]; float* out; unsigned char* ws; int ph_lo, ph_hi; };

__device__ __forceinline__ bf16_t* x_row(const P& p, int tok) { return (bf16_t*)(p.ws + WS_X) + (size_t)tok * D; }
__device__ __forceinline__ const float* x_in_row(const P& p, int tok) {
    return tok < NLAT ? p.in[0] + (size_t)tok * D : p.in[2] + (size_t)(tok - NLAT) * D;
}

template <int MF, class RowSrc, class Epi>
__device__ __forceinline__ void gemm_tile(unsigned char* lds, const RowSrc& rs, const bf16_t* Bt, int ldb, int K, const Epi& epi) {
    constexpr int ROWS = 32 * MF, NPA = ROWS * 8;
    const int tid = threadIdx.x, lane = tid & 63, wid = tid >> 6, wr = wid >> 2, wc = wid & 3, fr = lane & 15, fq = lane >> 4;
    bf16_t* As = (bf16_t*)lds; bf16_t* Bs = As + ROWS * 72;
    const bf16_t* ap[3]; int al[3];
#pragma unroll
    for (int i = 0; i < 3; ++i) { const int id = tid + 512 * i, r = id >> 3, c = (id & 7) * 8; ap[i] = (id < NPA) ? rs(r) + c : nullptr; al[i] = r * 72 + c; }
    const int lr = tid >> 2, lc = (tid & 3) * 16;
    const bf16_t* bp = Bt + (size_t)lr * ldb + lc;
    u32x4 a[3], b0 = *(const u32x4*)bp, b1 = *(const u32x4*)(bp + 8);
#pragma unroll
    for (int i = 0; i < 3; ++i) if (ap[i]) a[i] = *(const u32x4*)ap[i];
    f32x4 acc[MF][2];
#pragma unroll
    for (int m = 0; m < MF; ++m)
#pragma unroll
        for (int n = 0; n < 2; ++n) acc[m][n] = (f32x4){0.f, 0.f, 0.f, 0.f};
    for (int k0 = 0; k0 < K; k0 += 64) {
        __syncthreads();
#pragma unroll
        for (int i = 0; i < 3; ++i) if (ap[i]) *(u32x4*)(As + al[i]) = a[i];
        *(u32x4*)(Bs + lr * 72 + lc) = b0; *(u32x4*)(Bs + lr * 72 + lc + 8) = b1;
        __syncthreads();
        if (k0 + 64 < K) {
#pragma unroll
            for (int i = 0; i < 3; ++i) if (ap[i]) { ap[i] += 64; a[i] = *(const u32x4*)ap[i]; }
            bp += 64; b0 = *(const u32x4*)bp; b1 = *(const u32x4*)(bp + 8);
        }
#pragma unroll
        for (int kk = 0; kk < 2; ++kk) {
            bf16x8 af[MF], bfr[2];
#pragma unroll
            for (int m = 0; m < MF; ++m) af[m] = *(const bf16x8*)(As + (wr * 16 * MF + m * 16 + fr) * 72 + kk * 32 + fq * 8);
#pragma unroll
            for (int n = 0; n < 2; ++n) bfr[n] = *(const bf16x8*)(Bs + (wc * 32 + n * 16 + fr) * 72 + kk * 32 + fq * 8);
#pragma unroll
            for (int m = 0; m < MF; ++m)
#pragma unroll
                for (int n = 0; n < 2; ++n) acc[m][n] = __builtin_amdgcn_mfma_f32_16x16x32_bf16(bfr[n], af[m], acc[m][n], 0, 0, 0);
        }
    }
#pragma unroll
    for (int m = 0; m < MF; ++m)
#pragma unroll
        for (int n = 0; n < 2; ++n) epi(wr * 16 * MF + m * 16 + fr, wc * 32 + n * 16 + 4 * fq, acc[m][n]);
}

namespace ge {
constexpr int BM = 256, BK = 64, HALF = 128, HTB = HALF * BK * 2;
__device__ __forceinline__ int lds_byte(int r, int c) { const int st = (r >> 4) * 2 + (c >> 5), rr = r & 15, cc = c & 31, ob = rr * 64 + cc * 2; return st * 1024 + (ob ^ (((ob >> 9) & 1) << 5)); }
__device__ __forceinline__ void stage_rc(int b, int& R, int& C) { const int st = b / 1024, sb = b % 1024, swz = sb ^ (((sb >> 9) & 1) << 5); R = (st >> 1) * 16 + swz / 64; C = (st & 1) * 32 + (swz % 64) / 2; }
struct Unit { const char* B; int a, b, c, d; };
typedef f32x4 Acc[2][2][4][2];

template <class Sched, class Epi, bool ALIGN_EPI>
__device__ __forceinline__ void gemm_stream(LAS unsigned char* lds, const char* Ab, int K, const Sched& S, const Epi& E) {
    const int tid = threadIdx.x, wid = __builtin_amdgcn_readfirstlane(tid >> 6), lane = tid & 63, wr = wid >> 2, wc = wid & 3, fr = lane & 15, fq = lane >> 4;
    const int nt = K / BK;
    int Rr[2], Cc[2]; unsigned voffB[2];
#pragma unroll
    for (int i = 0; i < 2; ++i) { stage_rc(tid * 16 + i * 8192, Rr[i], Cc[i]);
        const int rho = Rr[i] & 31, Rb = (Rr[i] & ~31) + 8 * ((rho & 15) >> 2) + 4 * (rho >> 4) + (rho & 3);
        voffB[i] = (unsigned)(Rb * K + Cc[i]) * 2u; }
    const size_t kstep = (size_t)(BK * 2), hstepB = (size_t)HALF * K * 2;
    const unsigned ldsw = (unsigned)wid * 1024u;
    const int aoff = lds_byte(wr * 64 + fr, fq * 8), boff = lds_byte(wc * 32 + fr, fq * 8);
#define GE_SA(b, h) (((b) * 2 + (h)) * HTB)
#define GE_SB(b, h) ((4 + (b) * 2 + (h)) * HTB)
#define GE_GLDS(gp, ldsoff) __builtin_amdgcn_global_load_lds((const unsigned*)(gp), (LAS unsigned*)(lds + (ldsoff)), 16, 0, 0)
#define GE_STAGE_B(bufoff, gbase) do { GE_GLDS((const char*)(gbase) + voffB[0], (bufoff) + ldsw); GE_GLDS((const char*)(gbase) + voffB[1], (bufoff) + ldsw + 8192); } while (0)
#define GE_STAGE_A(bufoff, kbytes, o0, o1) do { GE_GLDS(Ab + (kbytes) + (o0), (bufoff) + ldsw); GE_GLDS(Ab + (kbytes) + (o1), (bufoff) + ldsw + 8192); } while (0)
#define GE_LDA(dst, b, h) do { _Pragma("unroll") for (int m = 0; m < 4; ++m) _Pragma("unroll") for (int k = 0; k < 2; ++k) dst[m][k] = *(const LAS bf16x8*)(lds + GE_SA(b, h) + aoff + m * 2048 + k * 1024); } while (0)
#define GE_LDB(dst, b, h) do { _Pragma("unroll") for (int n = 0; n < 2; ++n) _Pragma("unroll") for (int k = 0; k < 2; ++k) dst[n][k] = *(const LAS bf16x8*)(lds + GE_SB(b, h) + boff + n * 2048 + k * 1024); } while (0)
#define GE_MMA(ai, bj, At, Bt) do { __builtin_amdgcn_s_setprio(1); _Pragma("unroll") for (int m = 0; m < 4; ++m) _Pragma("unroll") for (int n = 0; n < 2; ++n) _Pragma("unroll") for (int k = 0; k < 2; ++k) \
        acc[ai][bj][m][n] = __builtin_amdgcn_mfma_f32_16x16x32_bf16(Bt[n][k], At[m][k], acc[ai][bj][m][n], 0, 0, 0); __builtin_amdgcn_s_setprio(0); } while (0)
#define GE_WAIT_V(n) asm volatile("s_waitcnt vmcnt(" #n ")" ::: "memory")
#define GE_WAIT_L(n) asm volatile("s_waitcnt lgkmcnt(" #n ")" ::: "memory")
#define GE_BAR __builtin_amdgcn_s_barrier()
#define GE_SCHED __builtin_amdgcn_sched_barrier(0)
    Unit cur, nxt; int ui = 0;
    if (!S.next(0, cur)) return;
    Acc acc;
#pragma unroll
    for (int a = 0; a < 2; ++a)
#pragma unroll
        for (int b = 0; b < 2; ++b)
#pragma unroll
            for (int m = 0; m < 4; ++m)
#pragma unroll
                for (int n = 0; n < 2; ++n) acc[a][b][m][n] = (f32x4){0.f, 0.f, 0.f, 0.f};
    bf16x8 At[4][2], B0[2][2], B1[2][2];
    unsigned oc00, oc01, oc10, oc11, on00, on01, on10, on11;
    oc00 = S.aoff(0, cur, Rr[0]) + (unsigned)Cc[0] * 2u; oc01 = S.aoff(0, cur, Rr[1]) + (unsigned)Cc[1] * 2u;
    oc10 = S.aoff(0, cur, Rr[0] + 128) + (unsigned)Cc[0] * 2u; oc11 = S.aoff(0, cur, Rr[1] + 128) + (unsigned)Cc[1] * 2u;
    const char* cB = cur.B;
    GE_STAGE_B(GE_SB(0, 0), cB); GE_STAGE_B(GE_SB(0, 1), cB + hstepB); GE_STAGE_A(GE_SA(0, 0), 0, oc00, oc01); GE_STAGE_A(GE_SA(0, 1), 0, oc10, oc11);
    if (wr == 1) GE_BAR;
    GE_WAIT_V(2); GE_BAR;
    GE_STAGE_B(GE_SB(1, 0), cB + kstep); GE_STAGE_A(GE_SA(1, 0), kstep, oc00, oc01); GE_STAGE_B(GE_SB(1, 1), cB + hstepB + kstep);
    GE_WAIT_V(6); GE_BAR;
    for (;;) {
        const bool has_next = S.next(ui + 1, nxt);
        const char* nB = has_next ? nxt.B : cB;
        if (has_next) {
            on00 = S.aoff(ui + 1, nxt, Rr[0]) + (unsigned)Cc[0] * 2u; on01 = S.aoff(ui + 1, nxt, Rr[1]) + (unsigned)Cc[1] * 2u;
            on10 = S.aoff(ui + 1, nxt, Rr[0] + 128) + (unsigned)Cc[0] * 2u; on11 = S.aoff(ui + 1, nxt, Rr[1] + 128) + (unsigned)Cc[1] * 2u;
        } else { on00 = oc00; on01 = oc01; on10 = oc10; on11 = oc11; }
#pragma unroll 1
        for (int t = 0; t < nt; t += 2) {
            const bool last = (t == nt - 2);
            const size_t k1 = (size_t)(t + 1) * kstep;
            const size_t k2 = last ? 0 : (size_t)(t + 2) * kstep, k3 = k2 + kstep;
            const char* b2 = last ? nB : cB + (size_t)(t + 2) * kstep; const char* b3 = b2 + kstep;
            const unsigned o00 = last ? on00 : oc00, o01 = last ? on01 : oc01, o10 = last ? on10 : oc10, o11 = last ? on11 : oc11;
            GE_LDB(B0, 0, 0); GE_LDB(B1, 0, 1); GE_SCHED; GE_LDA(At, 0, 0); GE_STAGE_A(GE_SA(1, 1), k1, oc10, oc11);
            GE_WAIT_V(8); GE_WAIT_L(0); GE_BAR; GE_MMA(0, 0, At, B0); GE_MMA(0, 1, At, B1); GE_BAR; GE_SCHED;
            GE_LDA(At, 0, 1); GE_STAGE_B(GE_SB(0, 0), b2); GE_STAGE_B(GE_SB(0, 1), b2 + hstepB); GE_STAGE_A(GE_SA(0, 0), k2, o00, o01);
            GE_WAIT_V(8); GE_WAIT_L(0); GE_BAR; GE_MMA(1, 0, At, B0); GE_MMA(1, 1, At, B1); GE_BAR; GE_SCHED;
            GE_LDB(B0, 1, 0); GE_LDB(B1, 1, 1); GE_SCHED; GE_LDA(At, 1, 0); GE_STAGE_A(GE_SA(0, 1), k2, o10, o11);
            GE_WAIT_V(8); GE_WAIT_L(0); GE_BAR; GE_MMA(0, 0, At, B0); GE_MMA(0, 1, At, B1); GE_BAR; GE_SCHED;
            GE_LDA(At, 1, 1); GE_STAGE_B(GE_SB(1, 0), b3); GE_STAGE_B(GE_SB(1, 1), b3 + hstepB); GE_STAGE_A(GE_SA(1, 0), k3, o00, o01);
            GE_WAIT_V(8); GE_WAIT_L(0); GE_BAR; GE_MMA(1, 0, At, B0); GE_MMA(1, 1, At, B1); GE_BAR; GE_SCHED;
        }
        if constexpr (ALIGN_EPI) { if (wr == 0) GE_BAR; }
        E(acc, cur, wr, wc, fr, fq);
        if (!has_next) break;
#pragma unroll
        for (int a = 0; a < 2; ++a)
#pragma unroll
            for (int b = 0; b < 2; ++b)
#pragma unroll
                for (int m = 0; m < 4; ++m)
#pragma unroll
                    for (int n = 0; n < 2; ++n) acc[a][b][m][n] = (f32x4){0.f, 0.f, 0.f, 0.f};
        cur = nxt; cB = nB; ++ui; oc00 = on00; oc01 = on01; oc10 = on10; oc11 = on11;
        if constexpr (ALIGN_EPI) { if (wr == 1) GE_BAR; }
    }
    GE_WAIT_V(0);
    if constexpr (!ALIGN_EPI) { if (wr == 0) GE_BAR; }
    GE_BAR;
#undef GE_SA
#undef GE_SB
#undef GE_GLDS
#undef GE_STAGE_A
#undef GE_STAGE_B
#undef GE_LDA
#undef GE_LDB
#undef GE_MMA
#undef GE_WAIT_V
#undef GE_WAIT_L
#undef GE_BAR
#undef GE_SCHED
}
template <class F> struct EpiFn {
    F f;
    __device__ __forceinline__ void operator()(const Acc& acc, const Unit& u, int wr, int wc, int fr, int fq) const {
#pragma unroll
        for (int ai = 0; ai < 2; ++ai)
#pragma unroll
            for (int m = 0; m < 4; ++m)
#pragma unroll
                for (int bj = 0; bj < 2; ++bj) f(u, ai * 128 + wr * 64 + m * 16 + fr, bj * 128 + wc * 32 + 8 * fq, acc[ai][bj][m][0], acc[ai][bj][m][1]);
    }
};
struct DenseOrder {
    int nM, nN, nwg, G, c; const char* Bt; size_t btile; unsigned arow;
    __device__ __forceinline__ bool next(int i, Unit& u) const {
        const long L = (long)i * G + c; if (L >= nwg) return false;
        int wgid = (int)L; { const int q = nwg / 8, r = nwg % 8, xcd = wgid % 8, off = wgid / 8; wgid = (xcd < r ? xcd * (q + 1) : r * (q + 1) + (xcd - r) * q) + off; }
        const int nig = 8 * nN, gid = wgid / nig, fm = gid * 8, gsz = (nM - fm) < 8 ? (nM - fm) : 8;
        u.a = fm + ((wgid % nig) % gsz); u.b = (wgid % nig) / gsz; u.c = 0; u.d = 0; u.B = Bt + (size_t)u.b * btile; return true;
    }
    __device__ __forceinline__ unsigned aoff(int, const Unit& u, int R) const { return (unsigned)(u.a * 256 + R) * arow; }
};
}

struct TMap { const float* s0; const float* s1; int ld; int nvalid; const float* ksc; float gsc; };
template <int MODE> __device__ __forceinline__ const float* tmap_src(const float* s0, const float* s1, int nvalid, int n) {
    if (MODE == 0) return n < nvalid ? s0 + n : nullptr;
    if (MODE == 1) { const int h = n / 96, j = n % 96; const int c = j < 64 ? j : 64 + ((j - 64) & 1) * 16 + ((j - 64) >> 1); return s0 + h * 96 + c; }
    return ((n & 1) ? s1 : s0) + (n >> 1);
}
template <int MODE> __device__ __forceinline__ void transpose_unit(float* scr, const float* s0, const float* s1, int ld, int nvalid, const float* ksc, float gsc, int K, bf16_t* dst, int kb, int nb, int kvalid = 1 << 30) {
    const int tid = threadIdx.x, k0 = kb * 64, n0 = nb * 64;
    const int nn = tid & 63; const float* sp = tmap_src<MODE>(s0, s1, nvalid, n0 + nn);
#pragma unroll
    for (int i = 0; i < 8; ++i) {
        const int kk = (tid >> 6) + 8 * i; float v = (sp && k0 + kk < kvalid) ? sp[(size_t)(k0 + kk) * ld] : 0.f;
        if (ksc && k0 + kk < kvalid) v *= ksc[k0 + kk];
        scr[kk * 65 + nn] = v * gsc;
    }
    __syncthreads();
    {
        const int n2 = tid >> 3, kc = tid & 7; const float* s = scr + (kc * 8) * 65 + n2;
        u32x4 o; o.x = pk2(s[0], s[65]); o.y = pk2(s[2 * 65], s[3 * 65]); o.z = pk2(s[4 * 65], s[5 * 65]); o.w = pk2(s[6 * 65], s[7 * 65]);
        *(u32x4*)(dst + (size_t)(n0 + n2) * K + k0 + kc * 8) = o;
    }
    __syncthreads();
}
template <int MODE> __device__ __forceinline__ void transpose_matrix(float* scr, const float* s0, const float* s1, int ld, int nvalid, const float* ksc, float gsc, int K, int Nd, bf16_t* dst, int& rot, int kvalid = 1 << 30) {
    const int nkb = K / 64, nnb = Nd / 64, nu = nkb * nnb, G = gridDim.x;
    int first = ((int)blockIdx.x - rot) % G; if (first < 0) first += G;
    for (int u = first; u < nu; u += G) transpose_unit<MODE>(scr, s0, s1, ld, nvalid, ksc, gsc, K, dst, u / nnb, u % nnb, kvalid);
    rot = (rot + nu) % G;
}
__device__ __forceinline__ void convert_expert_weights(unsigned char* lds, const P& p, int L) {
    float* scr = (float*)lds; const int G = gridDim.x, tid = threadIdx.x;
    constexpr int S = 261;
    bf16_t* egu = (bf16_t*)(p.ws + WS_EGU); bf16_t* ed = (bf16_t*)(p.ws + WS_ED);
    for (int ub = blockIdx.x; ub < NEXP * 48; ub += G) {
        const int e = ub / 48, r = (ub % 48) * 4;
        bf16_t* dst; int K, k0;
        if (r < 128) {
            const int kb = r >> 3, nb0 = r & 7; k0 = kb * 64; K = D; dst = egu + ((size_t)e * 512 + nb0 * 64) * D;
            const float* gsrc = p.in[22] + ((size_t)L * NEXP + e) * D * EDIM + nb0 * 32; const float* usrc = p.in[23] + ((size_t)L * NEXP + e) * D * EDIM + nb0 * 32;
            f32x4 v[8];
#pragma unroll
            for (int i = 0; i < 8; ++i) { const int idx = tid + 512 * i, kk = idx >> 6, c = idx & 63; v[i] = *(const f32x4*)((c < 32 ? gsrc : usrc) + (size_t)(k0 + kk) * EDIM + (c & 31) * 4); }
#pragma unroll
            for (int i = 0; i < 8; ++i) { const int idx = tid + 512 * i, kk = idx >> 6, c = idx & 63; float* d = scr + kk * S + 8 * (c & 31) + (c >> 5);
                d[0] = v[i].x; d[2] = v[i].y; d[4] = v[i].z; d[6] = v[i].w; }
        } else {
            const int r2 = r - 128, kb = r2 >> 4, nb0 = r2 & 15; k0 = kb * 64; K = EDIM; dst = ed + ((size_t)e * D + nb0 * 64) * EDIM;
            const float* src = p.in[24] + ((size_t)L * NEXP + e) * EDIM * D + nb0 * 64;
            f32x4 v[8];
#pragma unroll
            for (int i = 0; i < 8; ++i) { const int idx = tid + 512 * i, kk = idx >> 6, c = idx & 63; v[i] = *(const f32x4*)(src + (size_t)(k0 + kk) * D + c * 4); }
#pragma unroll
            for (int i = 0; i < 8; ++i) { const int idx = tid + 512 * i, kk = idx >> 6, c = idx & 63; float* d = scr + kk * S + 4 * c;
                d[0] = v[i].x; d[1] = v[i].y; d[2] = v[i].z; d[3] = v[i].w; }
        }
        __syncthreads();
#pragma unroll
        for (int i = 0; i < 4; ++i) {
            const int id = tid + 512 * i, n = id >> 3, kc = id & 7; const float* sp = scr + (kc * 8) * S + n;
            u32x4 o; o.x = cvtpk(sp[0], sp[S]); o.y = cvtpk(sp[2 * S], sp[3 * S]); o.z = cvtpk(sp[4 * S], sp[5 * S]); o.w = cvtpk(sp[6 * S], sp[7 * S]);
            *(u32x4*)(dst + (size_t)n * K + k0 + kc * 8) = o;
        }
        __syncthreads();
    }
}
__device__ __forceinline__ void prep_mod_unit(unsigned char* lds, const P& p, int u) {
    float* sc = (float*)lds;
    float* part = sc + 17 * 1024;
    const int tid = threadIdx.x;
    const float* c = p.in[1]; const float* cctx = p.in[3];
    for (int i = tid; i < 17 * 1024; i += NTHREADS) { const int r = i >> 10, k = i & 1023; const float v = r < 16 ? c[r * 1024 + k] : cctx[k]; sc[i] = v * __builtin_amdgcn_rcpf(1.f + __expf(-v)); }
    __syncthreads();
    const int L = u / 192, cg = u % 192, ks = tid >> 5, cl = tid & 31, col = cg * 32 + cl;
    const float* w = p.in[4] + (size_t)L * 1024 * 6144 + (size_t)(ks * 64) * 6144 + col;
    float acc[17];
#pragma unroll
    for (int r = 0; r < 17; ++r) acc[r] = 0.f;
#pragma unroll 8
    for (int k = 0; k < 64; ++k) {
        const float wv = w[(size_t)k * 6144];
#pragma unroll
        for (int r = 0; r < 17; ++r) acc[r] += sc[r * 1024 + ks * 64 + k] * wv;
    }
#pragma unroll
    for (int r = 0; r < 17; ++r) part[(ks * 17 + r) * 32 + cl] = acc[r];
    __syncthreads();
    float* modv = (float*)(p.ws + WS_MODV);
    for (int i = tid; i < 17 * 32; i += NTHREADS) {
        const int r = i >> 5, c2 = i & 31;
        float s2 = p.in[5][L * 6144 + cg * 32 + c2];
#pragma unroll
        for (int q = 0; q < 16; ++q) s2 += part[(q * 17 + r) * 32 + c2];
        modv[((size_t)L * 17 + r) * 6144 + cg * 32 + c2] = s2;
    }
    __syncthreads();
}
__device__ __forceinline__ void phase_prep0(unsigned char* lds, const P& p) {
    const int tid = threadIdx.x, G = gridDim.x, bid = blockIdx.x;
    {
        float* ct = (float*)(p.ws + WS_ROPE); float* st = ct + 2048 * 16;
        for (int i = bid * NTHREADS + tid; i < 2048 * 16; i += G * NTHREADS) {
            const int pos = i >> 4, f = i & 15;
            const float inv = powf(10000.f, -(float)(f & 7) / 8.f);
            const float ang = (float)(f < 8 ? (pos >> 6) : (pos & 63)) * inv;
            ct[i] = cosf(ang); st[i] = sinf(ang);
        }
    }
    for (int u = bid; u < 384; u += G) prep_mod_unit(lds, p, u);
}
__device__ __forceinline__ void phase_prep1(unsigned char* lds, const P& p) {
    float* scr = (float*)lds; int rot = 0;
    for (int L = 0; L < 2; ++L) {
        transpose_matrix<0>(scr, p.in[7] + (size_t)L * D * Z_END, nullptr, Z_END, Z_END, nullptr, 1.f, D, ZC, (bf16_t*)(p.ws + WS_WIN) + (size_t)L * ZC * D, rot);
        transpose_matrix<1>(scr, p.in[15] + (size_t)L * 256 * 768, nullptr, 768, 768, p.in[14] + L * 256, 0.14724574f, 256, 768, (bf16_t*)(p.ws + WS_WUQ) + (size_t)L * 768 * 256, rot);
        transpose_matrix<0>(scr, p.in[17] + (size_t)L * 128 * 1024, nullptr, 1024, 1024, p.in[16] + L * 128, 1.f, 256, 1024, (bf16_t*)(p.ws + WS_WUKV) + (size_t)L * 1024 * 256, rot, 128);
        transpose_matrix<0>(scr, p.in[18] + (size_t)L * D * D, nullptr, D, D, nullptr, 1.f, D, D, (bf16_t*)(p.ws + WS_WOUT) + (size_t)L * D * D, rot);
        transpose_matrix<0>(scr, p.in[20] + (size_t)L * D * NEXP, nullptr, NEXP, NEXP, nullptr, 1.f, D, 128, (bf16_t*)(p.ws + WS_RT) + (size_t)L * 128 * D, rot);
        transpose_matrix<2>(scr, p.in[25] + (size_t)L * D * EDIM, p.in[26] + (size_t)L * D * EDIM, EDIM, 512, nullptr, 1.f, D, 512, (bf16_t*)(p.ws + WS_SHGU) + (size_t)L * 512 * D, rot);
        transpose_matrix<0>(scr, p.in[27] + (size_t)L * EDIM * D, nullptr, D, D, nullptr, 1.f, EDIM, D, (bf16_t*)(p.ws + WS_SHD) + (size_t)L * D * EDIM, rot);
    }
}

__device__ __forceinline__ void phase_norm_mod(const P& p, int L, int which  , int ntok) {
    const int tid = threadIdx.x, lane = tid & 63, wave = tid >> 6, gw = blockIdx.x * NWAVES + wave, NGW = gridDim.x * NWAVES;
    const float* nw = (which == 0 ? p.in[6] : p.in[19]) + L * D;
    const float* modv = (const float*)(p.ws + WS_MODV) + (size_t)L * 17 * 6144;
    bf16_t* H = (bf16_t*)(p.ws + WS_H);
    for (int tok = gw; tok < ntok; tok += NGW) {
        const f32x4* xr = (const f32x4*)x_in_row(p, tok) + lane;
        const float* mrow = modv + (size_t)mod_row(tok) * 6144 + which * 3072;
        f32x4 v[4]; float s = 0.f;
#pragma unroll
        for (int j = 0; j < 4; ++j) { v[j] = xr[64 * j]; s += v[j].x * v[j].x + v[j].y * v[j].y + v[j].z * v[j].z + v[j].w * v[j].w; }
        const float rstd = rsqrtf(wave_sum(s) * (1.f / D) + NORM_EPS);
        u32x2* o = (u32x2*)(H + (size_t)tok * D) + lane;
#pragma unroll
        for (int j = 0; j < 4; ++j) {
            const int k = 4 * lane + 256 * j;
            const f32x4 w4 = *(const f32x4*)(nw + k), sh = *(const f32x4*)(mrow + k), sc = *(const f32x4*)(mrow + 1024 + k);
            const float y0 = v[j].x * rstd * w4.x * (1.f + sc.x) + sh.x, y1 = v[j].y * rstd * w4.y * (1.f + sc.y) + sh.y;
            const float y2 = v[j].z * rstd * w4.z * (1.f + sc.z) + sh.z, y3 = v[j].w * rstd * w4.w * (1.f + sc.w) + sh.w;
            u32x2 w; w.x = pk2(y0, y1); w.y = pk2(y2, y3); o[64 * j] = w;
        }
    }
}

struct EpiZ {
    bf16_t* Z; float* ssq; float* sskv; bf16_t* Kb; const float* ct; const float* st;
    __device__ __forceinline__ void operator()(const ge::Acc& acc, const ge::Unit& u, int wr, int wc, int fr, int fq) const {
#pragma unroll
        for (int ai = 0; ai < 2; ++ai)
#pragma unroll
            for (int m = 0; m < 4; ++m) {
                const int row = u.a * 256 + ai * 128 + wr * 64 + m * 16 + fr;
#pragma unroll
                for (int bj = 0; bj < 2; ++bj) {
                    const f32x4 v0 = acc[ai][bj][m][0], v1 = acc[ai][bj][m][1];
                    u32x4 w; w.x = cvtpk(v0.x, v0.y); w.y = cvtpk(v0.z, v0.w); w.z = cvtpk(v1.x, v1.y); w.w = cvtpk(v1.z, v1.w);
                    *(u32x4*)(Z + (size_t)row * ZC + u.b * 256 + bj * 128 + wc * 32 + 8 * fq) = w;
                }
                if (u.b == 5) {
                    float sq = 0.f;
#pragma unroll
                    for (int bj = 0; bj < 2; ++bj)
#pragma unroll
                        for (int n = 0; n < 2; ++n) { const f32x4 v = acc[ai][bj][m][n]; sq += v.x * v.x + v.y * v.y + v.z * v.z + v.w * v.w; }
                    sq += __shfl_xor(sq, 16); sq += __shfl_xor(sq, 32);
                    if (fq == 0) ssq[(size_t)row * 4 + wc] = sq;
                }
                if (u.b == 6) {
                    float sq = 0.f;
#pragma unroll
                    for (int n = 0; n < 2; ++n) { const f32x4 v = acc[ai][0][m][n]; sq += v.x * v.x + v.y * v.y + v.z * v.z + v.w * v.w; }
                    sq += __shfl_xor(sq, 16); sq += __shfl_xor(sq, 32);
                    if (fq == 0) sskv[(size_t)row * 4 + wc] = sq;
                    if (wc == 0) {
                        const f32x4 a0 = acc[ai][1][m][0], a1 = acc[ai][1][m][1];
                        f32x4 b0, b1;
#pragma unroll
                        for (int j = 0; j < 4; ++j) { b0[j] = __shfl_xor(a0[j], 32); b1[j] = __shfl_xor(a1[j], 32); }
                        if (fq < 2) {
                            f32x4 c0 = (f32x4){1.f, 1.f, 1.f, 1.f}, c1 = c0, s0 = (f32x4){0.f, 0.f, 0.f, 0.f}, s1 = s0;
                            if (row < NLAT) { const int pos = row & (SEQ - 1); c0 = *(const f32x4*)(ct + pos * 16 + 8 * fq); c1 = *(const f32x4*)(ct + pos * 16 + 8 * fq + 4); s0 = *(const f32x4*)(st + pos * 16 + 8 * fq); s1 = *(const f32x4*)(st + pos * 16 + 8 * fq + 4); }
                            const f32x4 o10 = a0 * c0 - b0 * s0, o20 = a0 * s0 + b0 * c0, o11 = a1 * c1 - b1 * s1, o21 = a1 * s1 + b1 * c1;
                            u32x4 w0, w1; w0.x = cvtpk(o10.x, o20.x); w0.y = cvtpk(o10.y, o20.y); w0.z = cvtpk(o10.z, o20.z); w0.w = cvtpk(o10.w, o20.w);
                            w1.x = cvtpk(o11.x, o21.x); w1.y = cvtpk(o11.y, o21.y); w1.z = cvtpk(o11.z, o21.z); w1.w = cvtpk(o11.w, o21.w);
#pragma unroll
                            for (int h = 0; h < 8; ++h) { bf16_t* kp = Kb + (size_t)row * 768 + h * 96 + 64 + 16 * fq; *(u32x4*)kp = w0; *(u32x4*)(kp + 8) = w1; }
                        }
                    }
                }
            }
    }
};
__device__ __forceinline__ void phase_zgemm(unsigned char* lds, const P& p, int L) {
    const bf16_t* W = (const bf16_t*)(p.ws + WS_WIN) + (size_t)L * ZC * D;
    ge::DenseOrder S; S.nM = NTOK / 256; S.nN = ZC / 256; S.nwg = S.nM * S.nN; S.G = gridDim.x; S.c = blockIdx.x; S.Bt = (const char*)W; S.btile = (size_t)256 * D * 2; S.arow = D * 2;
    EpiZ E{(bf16_t*)(p.ws + WS_Z), (float*)(p.ws + WS_SS), (float*)(p.ws + WS_SS) + (size_t)NTOK * 4, (bf16_t*)(p.ws + WS_K), (const float*)(p.ws + WS_ROPE), (const float*)(p.ws + WS_ROPE) + 2048 * 16};
    ge::gemm_stream<ge::DenseOrder, EpiZ, true>((LAS unsigned char*)lds, (const char*)(p.ws + (L == 0 ? WS_H : WS_H1)), D, S, E);
}

__device__ __forceinline__ void conv_unit(unsigned char* lds, const P& p, int L, int s, int tt) {
    float* hg = (float*)lds;
    const int tid = threadIdx.x, lane = tid & 63, wave = tid >> 6;
    const int rb = s < 16 ? s * SEQ : NLAT + (s - 16) * CTXL, len = s < 16 ? SEQ : CTXL, t0 = tt * 64;
    const bf16_t* Z = (const bf16_t*)(p.ws + WS_Z);
    {
        u32x2 av[12], gv[12];
#pragma unroll
        for (int q = 0; q < 12; ++q) {
            const int i = tid + q * NTHREADS, jj = i >> 6, c4 = (i & 63) * 4; int t = t0 - 15 + jj; t = t < 0 ? 0 : (t >= len ? len - 1 : t);
            const bf16_t* zr = Z + (size_t)(rb + t) * ZC;
            av[q] = *(const u32x2*)(zr + c4); gv[q] = *(const u32x2*)(zr + 256 + c4);
        }
#pragma unroll
        for (int q = 0; q < 12; ++q) {
            const int i = tid + q * NTHREADS, jj = i >> 6, c4 = (i & 63) * 4, t = t0 - 15 + jj;
            if (i < 94 * 64) {
                f32x4 h = (f32x4){0.f, 0.f, 0.f, 0.f};
                if (t >= 0 && t < len) {
                    const u32x2 a = av[q], g = gv[q];
                    h.x = lo16(a.x) * __builtin_amdgcn_rcpf(1.f + __expf(-lo16(g.x))); h.y = hi16(a.x) * __builtin_amdgcn_rcpf(1.f + __expf(-hi16(g.x)));
                    h.z = lo16(a.y) * __builtin_amdgcn_rcpf(1.f + __expf(-lo16(g.y))); h.w = hi16(a.y) * __builtin_amdgcn_rcpf(1.f + __expf(-hi16(g.y)));
                }
                *(f32x4*)(hg + jj * 256 + c4) = h;
            }
        }
    }
    float* wl = hg + 94 * 256;
    for (int i = tid; i < 31 * 64; i += NTHREADS) *(f32x4*)(wl + i * 4) = *(const f32x4*)(p.in[8] + (size_t)L * 31 * 256 + i * 4);
    __syncthreads();
    const int c0 = lane * 4;
    const f32x4 cb = *(const f32x4*)(p.in[9] + L * 256 + c0), lw = *(const f32x4*)(p.in[10] + L * 256 + c0), lb = *(const f32x4*)(p.in[11] + L * 256 + c0);
    bf16_t* CC = (bf16_t*)(p.ws + WS_CC);
    {
        f32x4 w[31];
#pragma unroll
        for (int j = 0; j < 31; ++j) w[j] = *(const f32x4*)(wl + j * 256 + c0);
#pragma unroll 1
        for (int half = 0; half < 2; ++half) {
            f32x4 acc[4];
#pragma unroll
            for (int q = 0; q < 4; ++q) acc[q] = cb;
            const float* hrow = hg + (wave * 8 + half * 4) * 256 + c0;
#pragma unroll
            for (int r = 0; r < 34; ++r) {
                const f32x4 h = *(const f32x4*)(hrow + r * 256);
#pragma unroll
                for (int q = 0; q < 4; ++q) { if (r - q >= 0 && r - q <= 30) acc[q] += h * w[r - q]; }
            }
#pragma unroll
            for (int q = 0; q < 4; ++q) {
                const int tl = wave * 8 + half * 4 + q;
                const float mean = wave_sum(acc[q].x + acc[q].y + acc[q].z + acc[q].w) * (1.f / 256.f);
                const f32x4 d = acc[q] - mean;
                const float var = wave_sum(d.x * d.x + d.y * d.y + d.z * d.z + d.w * d.w) * (1.f / 256.f);
                const float rstd = rsqrtf(var + NORM_EPS);
                const f32x4 y = d * rstd * lw + lb;
                u32x2 o; o.x = cvtpk(siluf(y.x), siluf(y.y)); o.y = cvtpk(siluf(y.z), siluf(y.w));
                *(u32x2*)(CC + (size_t)(rb + t0 + tl) * D + c0) = o;
            }
        }
    }
    __syncthreads();
}

__device__ __forceinline__ float log2_gamma(const P& p, int L, int dir, int h) {
    const float x = p.in[12][(L * 2 + dir) * 4 + h];
    const float ls = fminf(x, 0.f) - log1pf(expf(-fabsf(x)));
    return ls * 1.4426950408889634f;
}
__device__ __forceinline__ void load_ret_qk(float* dst, const P& p, int gc, int h, int zoff, float scale) {
    const int tid = threadIdx.x, j = tid >> 2, i0 = (tid & 3) * 4, row = gc * 128 + j;
    const bf16_t* zr = (const bf16_t*)(p.ws + WS_Z) + (size_t)row * ZC + zoff + h * 32;
    const u32x2 a = *(const u32x2*)(zr + i0), b = *(const u32x2*)(zr + 16 + i0);
    float x1[4] = {lo16(a.x), hi16(a.x), lo16(a.y), hi16(a.y)}, x2[4] = {lo16(b.x), hi16(b.x), lo16(b.y), hi16(b.y)};
    const bool lat = row < NLAT; const int pos = row & (SEQ - 1);
    const float* ct = (const float*)(p.ws + WS_ROPE) + pos * 16 + i0; const float* st = ct + 2048 * 16;
#pragma unroll
    for (int i = 0; i < 4; ++i) {
        const float c = lat ? ct[i] : 1.f, s = lat ? st[i] : 0.f;
        dst[j * 33 + i0 + i] = (x1[i] * c - x2[i] * s) * scale;
        dst[j * 33 + 16 + i0 + i] = (x1[i] * s + x2[i] * c) * scale;
    }
}
__device__ __forceinline__ void load_ret_v(float* dst  , const P& p, int gc, int h) {
    const int tid = threadIdx.x, j = tid >> 2, e0 = (tid & 3) * 16;
    const bf16_t* zr = (const bf16_t*)(p.ws + WS_Z) + (size_t)(gc * 128 + j) * ZC + Z_RV + h * 64 + e0;
    const u32x4 a = *(const u32x4*)zr, b = *(const u32x4*)(zr + 8);
#pragma unroll
    for (int i = 0; i < 4; ++i) { dst[j * 64 + e0 + 2 * i] = lo16(a[i]); dst[j * 64 + e0 + 2 * i + 1] = hi16(a[i]); dst[j * 64 + e0 + 8 + 2 * i] = lo16(b[i]); dst[j * 64 + e0 + 8 + 2 * i + 1] = hi16(b[i]); }
}
__device__ __forceinline__ void retkv_unit(unsigned char* lds, const P& p, int L, int gc, int h) {
    float* ks = (float*)lds; float* vs = ks + 128 * 33; float* wf = vs + 128 * 64; float* wb = wf + 128;
    const int tid = threadIdx.x;
    const float l2f = log2_gamma(p, L, 0, h), l2b = log2_gamma(p, L, 1, h);
    load_ret_qk(ks, p, gc, h, Z_RK, 0.17677669529663687f);
    load_ret_v(vs, p, gc, h);
    if (tid < 128) { wf[tid] = exp2f(l2f * (float)(127 - tid)); wb[tid] = exp2f(l2b * (float)tid); }
    __syncthreads();
    const int d = tid >> 4, e0 = (tid & 15) * 4;
    f32x4 af = (f32x4){0.f, 0.f, 0.f, 0.f}, ab = af;
    for (int j = 0; j < 128; ++j) {
        const float kd = ks[j * 33 + d]; const f32x4 v4 = *(const f32x4*)(vs + j * 64 + e0);
        af += (kd * wf[j]) * v4; ab += (kd * wb[j]) * v4;
    }
    float* KV = (float*)(p.ws + WS_KV) + ((size_t)(gc * 4 + h) * 2) * 2048;
    *(f32x4*)(KV + d * 64 + e0) = af; *(f32x4*)(KV + 2048 + d * 64 + e0) = ab;
    __syncthreads();
}
__device__ __forceinline__ void ret_stage_k(unsigned char* kf, unsigned char* kb, int rowb, const P& p, int gc, int h, float ef, float jf0, float eb, float jb0) {
    const int tid = threadIdx.x, j = tid >> 2, i0 = (tid & 3) * 4, row = gc * 128 + j;
    const bf16_t* zr = (const bf16_t*)(p.ws + WS_Z) + (size_t)row * ZC + Z_RK + h * 32;
    const u32x2 a = *(const u32x2*)(zr + i0), b = *(const u32x2*)(zr + 16 + i0);
    const float x1[4] = {lo16(a.x), hi16(a.x), lo16(a.y), hi16(a.y)}, x2[4] = {lo16(b.x), hi16(b.x), lo16(b.y), hi16(b.y)};
    f32x4 c4 = (f32x4){1.f, 1.f, 1.f, 1.f}, s4 = (f32x4){0.f, 0.f, 0.f, 0.f};
    if (row < NLAT) { const int pos = row & (SEQ - 1); const float* ct = (const float*)(p.ws + WS_ROPE) + pos * 16 + i0; c4 = *(const f32x4*)ct; s4 = *(const f32x4*)(ct + 2048 * 16); }
    const float wf = __builtin_amdgcn_exp2f(ef * ((float)j - jf0)) * 0.17677669529663687f, wb = __builtin_amdgcn_exp2f(eb * ((float)j - jb0)) * 0.17677669529663687f;
    float o1[4], o2[4];
#pragma unroll
    for (int i = 0; i < 4; ++i) { o1[i] = x1[i] * c4[i] - x2[i] * s4[i]; o2[i] = x1[i] * s4[i] + x2[i] * c4[i]; }
    u32x2 w;
    w.x = cvtpk(o1[0] * wf, o1[1] * wf); w.y = cvtpk(o1[2] * wf, o1[3] * wf); *(u32x2*)(kf + j * rowb + i0 * 2) = w;
    w.x = cvtpk(o2[0] * wf, o2[1] * wf); w.y = cvtpk(o2[2] * wf, o2[3] * wf); *(u32x2*)(kf + j * rowb + 32 + i0 * 2) = w;
    w.x = cvtpk(o1[0] * wb, o1[1] * wb); w.y = cvtpk(o1[2] * wb, o1[3] * wb); *(u32x2*)(kb + j * rowb + i0 * 2) = w;
    w.x = cvtpk(o2[0] * wb, o2[1] * wb); w.y = cvtpk(o2[2] * wb, o2[3] * wb); *(u32x2*)(kb + j * rowb + 32 + i0 * 2) = w;
}
__device__ __forceinline__ void ret_stage_v(unsigned char* vt, const P& p, int gc, int h) {
    const int tid = threadIdx.x, j = tid >> 2, e0 = (tid & 3) * 16;
    const bf16_t* zr = (const bf16_t*)(p.ws + WS_Z) + (size_t)(gc * 128 + j) * ZC + Z_RV + h * 64 + e0;
    const u32x4 a = *(const u32x4*)zr, b = *(const u32x4*)(zr + 8);
    unsigned char* d = vt + (e0 >> 5) * 8192 + j * 64 + (e0 & 31) * 2;
    *(u32x4*)d = a; *(u32x4*)(d + 16) = b;
}
__device__ __forceinline__ bf16x8 tr8(const unsigned char* p0, const unsigned char* p1) {
    const v4i16_t a = __builtin_amdgcn_ds_read_tr16_b64_v4i16((LAS v4i16_t*)(const LAS unsigned char*)p0), b = __builtin_amdgcn_ds_read_tr16_b64_v4i16((LAS v4i16_t*)(const LAS unsigned char*)p1);
    return (bf16x8){a[0], a[1], a[2], a[3], b[0], b[1], b[2], b[3]};
}
__device__ __forceinline__ void retkv_unit_mfma(unsigned char* lds, const P& p, int L, int gc, int h) {
    const int tid = threadIdx.x, lane = tid & 63, wid = tid >> 6;
    const float l2f = log2_gamma(p, L, 0, h), l2b = log2_gamma(p, L, 1, h);
    ret_stage_k(lds, lds + 8192, 64, p, gc, h, -l2f, 127.f, l2b, 0.f);
    ret_stage_v(lds + 16384, p, gc, h);
    __syncthreads();
    if (wid < 4) {
        const int dir = wid >> 1, eb = wid & 1, g = lane >> 4, i = lane & 15, hh = lane >> 5;
        const int off = (8 * hh + (i >> 2)) * 64 + (g & 1) * 32 + (i & 3) * 8;
        const unsigned char* Kt = lds + dir * 8192 + off; const unsigned char* Vt = lds + 16384 + eb * 8192 + off;
        f32x16 acc;
#pragma unroll
        for (int r = 0; r < 16; ++r) acc[r] = 0.f;
#pragma unroll
        for (int s = 0; s < 8; ++s) acc = __builtin_amdgcn_mfma_f32_32x32x16_bf16(tr8(Vt + s * 1024, Vt + s * 1024 + 256), tr8(Kt + s * 1024, Kt + s * 1024 + 256), acc, 0, 0, 0);
        float* KV = (float*)(p.ws + WS_KV) + ((size_t)(gc * 4 + h) * 2 + dir) * 2048 + (lane & 31) * 64 + eb * 32 + 4 * hh;
#pragma unroll
        for (int r4 = 0; r4 < 4; ++r4) *(f32x4*)(KV + 8 * r4) = (f32x4){acc[4 * r4], acc[4 * r4 + 1], acc[4 * r4 + 2], acc[4 * r4 + 3]};
    }
    __syncthreads();
}
__device__ __forceinline__ void retout_unit_mfma(unsigned char* lds, const P& p, int L, int gc, int h) {
    constexpr int KROW = 80, O_KF = 0, O_KB = 10240, O_V = 20480, O_SF = 36864, O_SB = 41984, O_RED = 47104;
    const int tid = threadIdx.x, lane = tid & 63, wid = tid >> 6, r32 = lane & 31, hh = lane >> 5;
    const float l2f = log2_gamma(p, L, 0, h), l2b = log2_gamma(p, L, 1, h);
    ret_stage_k(lds + O_KF, lds + O_KB, KROW, p, gc, h, -l2f, 0.f, l2b, 0.f);
    ret_stage_v(lds + O_V, p, gc, h);
    {
        const bool lat = gc < 256; const int b = lat ? gc >> 4 : (gc - 256) >> 1;
        const int mme = lat ? 2 + (gc & 15) : (gc - 256) & 1;
        const int u = mme, w = mme < 2 ? 1 - mme : 19 - mme;
        f32x4 sf = (f32x4){0.f, 0.f, 0.f, 0.f}, sb = sf;
        const float* KVb = (const float*)(p.ws + WS_KV);
#pragma unroll 1
        for (int mm = 0; mm < 18; ++mm) {
            const int gcm = mm < 2 ? 256 + b * 2 + mm : b * 16 + (mm - 2);
            const int um = mm, wm = mm < 2 ? 1 - mm : 19 - mm;
            const float* kv = KVb + ((size_t)(gcm * 4 + h) * 2) * 2048 + tid * 4;
            if (um < u) { const float wgt = __builtin_amdgcn_exp2f(l2f * 128.f * (float)(u - 1 - um)); sf += wgt * *(const f32x4*)kv; }
            if (wm < w) { const float wgt = __builtin_amdgcn_exp2f(l2b * 128.f * (float)(w - 1 - wm)); sb += wgt * *(const f32x4*)(kv + 2048); }
        }
        const int d = tid >> 4, e0 = (tid & 15) * 4;
#pragma unroll
        for (int k = 0; k < 4; ++k) { *(bf16_t*)(lds + O_SF + (e0 + k) * KROW + d * 2) = (bf16_t)(cvtpk(sf[k], 0.f) & 0xffffu); *(bf16_t*)(lds + O_SB + (e0 + k) * KROW + d * 2) = (bf16_t)(cvtpk(sb[k], 0.f) & 0xffffu); }
    }
    __syncthreads();
    const int qb = wid & 3, eb = wid >> 2, i = qb * 32 + r32, row = gc * 128 + i;
    bf16x8 qf[2];
    {
        const bf16_t* zr = (const bf16_t*)(p.ws + WS_Z) + (size_t)row * ZC + Z_RQ + h * 32 + 8 * hh;
        const u32x4 a = *(const u32x4*)zr, b = *(const u32x4*)(zr + 16);
        float x1[8], x2[8];
#pragma unroll
        for (int k = 0; k < 4; ++k) { x1[2 * k] = lo16(a[k]); x1[2 * k + 1] = hi16(a[k]); x2[2 * k] = lo16(b[k]); x2[2 * k + 1] = hi16(b[k]); }
        if (row < NLAT) {
            const float* ct = (const float*)(p.ws + WS_ROPE) + (row & (SEQ - 1)) * 16 + 8 * hh; const float* st = ct + 2048 * 16;
#pragma unroll
            for (int k = 0; k < 8; ++k) { const float c = ct[k], sn = st[k], u1 = x1[k], u2 = x2[k]; x1[k] = u1 * c - u2 * sn; x2[k] = u1 * sn + u2 * c; }
        }
        const u32x4 q0 = (u32x4){cvtpk(x1[0], x1[1]), cvtpk(x1[2], x1[3]), cvtpk(x1[4], x1[5]), cvtpk(x1[6], x1[7])};
        const u32x4 q1 = (u32x4){cvtpk(x2[0], x2[1]), cvtpk(x2[2], x2[3]), cvtpk(x2[4], x2[5]), cvtpk(x2[6], x2[7])};
        qf[0] = __builtin_bit_cast(bf16x8, q0); qf[1] = __builtin_bit_cast(bf16x8, q1);
    }
    const float af = __builtin_amdgcn_exp2f(l2f * (float)i), ab = __builtin_amdgcn_exp2f(-l2b * (float)i), cf = __builtin_amdgcn_exp2f(l2f * (float)(i + 1)), cb = __builtin_amdgcn_exp2f(l2b * (float)(128 - i));
    f32x16 y, zero;
#pragma unroll
    for (int r = 0; r < 16; ++r) { y[r] = 0.f; zero[r] = 0.f; }
    const int koff = r32 * KROW + 16 * hh;
    const int voff = O_V + eb * 8192 + (4 * hh + ((lane & 15) >> 2)) * 64 + ((lane >> 4) & 1) * 32 + (lane & 3) * 8;
#pragma unroll
    for (int kb = 0; kb < 4; ++kb) {
        f32x16 pt;
        if (kb <= qb) {
            f32x16 sF = __builtin_amdgcn_mfma_f32_32x32x16_bf16(*(const bf16x8*)(lds + O_KF + kb * 32 * KROW + koff), qf[0], zero, 0, 0, 0);
            sF = __builtin_amdgcn_mfma_f32_32x32x16_bf16(*(const bf16x8*)(lds + O_KF + kb * 32 * KROW + koff + 32), qf[1], sF, 0, 0, 0);
            if (kb < qb) {
#pragma unroll
                for (int r = 0; r < 16; ++r) pt[r] = sF[r] * af;
            } else {
#pragma unroll
                for (int r = 0; r < 16; ++r) { const int j = (r & 3) + 8 * (r >> 2) + 4 * hh; pt[r] = (j <= r32) ? sF[r] * af : 0.f; }
            }
        }
        if (kb >= qb) {
            f32x16 sB = __builtin_amdgcn_mfma_f32_32x32x16_bf16(*(const bf16x8*)(lds + O_KB + kb * 32 * KROW + koff), qf[0], zero, 0, 0, 0);
            sB = __builtin_amdgcn_mfma_f32_32x32x16_bf16(*(const bf16x8*)(lds + O_KB + kb * 32 * KROW + koff + 32), qf[1], sB, 0, 0, 0);
            if (kb > qb) {
#pragma unroll
                for (int r = 0; r < 16; ++r) pt[r] = sB[r] * ab;
            } else {
#pragma unroll
                for (int r = 0; r < 16; ++r) { const int j = (r & 3) + 8 * (r >> 2) + 4 * hh; pt[r] += (j >= r32) ? sB[r] * ab : 0.f; }
            }
        }
#pragma unroll
        for (int s2 = 0; s2 < 2; ++s2) {
            const u32x4 pw = (u32x4){cvtpk(pt[8 * s2], pt[8 * s2 + 1]), cvtpk(pt[8 * s2 + 2], pt[8 * s2 + 3]), cvtpk(pt[8 * s2 + 4], pt[8 * s2 + 5]), cvtpk(pt[8 * s2 + 6], pt[8 * s2 + 7])};
            const unsigned char* vb = lds + voff + (kb * 32 + s2 * 16) * 64;
            y = __builtin_amdgcn_mfma_f32_32x32x16_bf16(tr8(vb, vb + 8 * 64), __builtin_bit_cast(bf16x8, pw), y, 0, 0, 0);
        }
    }
    {
        const int soff = (eb * 32 + r32) * KROW + 16 * hh;
        f32x16 tF = __builtin_amdgcn_mfma_f32_32x32x16_bf16(*(const bf16x8*)(lds + O_SF + soff), qf[0], zero, 0, 0, 0);
        tF = __builtin_amdgcn_mfma_f32_32x32x16_bf16(*(const bf16x8*)(lds + O_SF + soff + 32), qf[1], tF, 0, 0, 0);
        f32x16 tB = __builtin_amdgcn_mfma_f32_32x32x16_bf16(*(const bf16x8*)(lds + O_SB + soff), qf[0], zero, 0, 0, 0);
        tB = __builtin_amdgcn_mfma_f32_32x32x16_bf16(*(const bf16x8*)(lds + O_SB + soff + 32), qf[1], tB, 0, 0, 0);
#pragma unroll
        for (int r = 0; r < 16; ++r) y[r] += tF[r] * cf + tB[r] * cb;
    }
    float s1 = 0.f, s2 = 0.f;
#pragma unroll
    for (int r = 0; r < 16; ++r) { s1 += y[r]; s2 += y[r] * y[r]; }
    s1 += __shfl_xor(s1, 32); s2 += __shfl_xor(s2, 32);
    float* red = (float*)(lds + O_RED);
    if (hh == 0) { red[(eb * 128 + i) * 2] = s1; red[(eb * 128 + i) * 2 + 1] = s2; }
    __syncthreads();
    s1 = red[i * 2] + red[(128 + i) * 2]; s2 = red[i * 2 + 1] + red[(128 + i) * 2 + 1];
    const float mu = s1 * (1.f / 64.f), var = fmaxf(s2 * (1.f / 64.f) - mu * mu, 0.f), rstd = rsqrtf(var + NORM_EPS);
    const bf16_t* zg = (const bf16_t*)(p.ws + WS_Z) + (size_t)row * ZC + Z_RG + h * 64 + eb * 32 + 4 * hh;
    const float* gw = p.in[13] + L * 256 + h * 64 + eb * 32 + 4 * hh;
    bf16_t* orow = (bf16_t*)(p.ws + WS_CC) + (size_t)row * D + 256 + h * 64 + eb * 32 + 4 * hh;
#pragma unroll
    for (int r4 = 0; r4 < 4; ++r4) {
        const u32x2 gz = *(const u32x2*)(zg + 8 * r4); const f32x4 w4 = *(const f32x4*)(gw + 8 * r4);
        const float g0 = lo16(gz.x), g1 = hi16(gz.x), g2 = lo16(gz.y), g3 = hi16(gz.y);
        u32x2 o; o.x = cvtpk(siluf(g0) * ((y[4 * r4] - mu) * rstd * w4.x), siluf(g1) * ((y[4 * r4 + 1] - mu) * rstd * w4.y));
        o.y = cvtpk(siluf(g2) * ((y[4 * r4 + 2] - mu) * rstd * w4.z), siluf(g3) * ((y[4 * r4 + 3] - mu) * rstd * w4.w));
        *(u32x2*)(orow + 8 * r4) = o;
    }
    __syncthreads();
}
__device__ __forceinline__ void qkv_proj(unsigned char* lds, const P& p, int L) {
    const float* sskv = (const float*)(p.ws + WS_SS) + (size_t)NTOK * 4;
    const int G = gridDim.x, bid = blockIdx.x;
    {
        bf16_t* Q = (bf16_t*)(p.ws + WS_Q);
        ge::DenseOrder S; S.nM = NTOK / 256; S.nN = 3; S.nwg = S.nM * 3; S.G = G; S.c = bid; S.Bt = (const char*)((const bf16_t*)(p.ws + WS_WUQ) + (size_t)L * 768 * 256); S.btile = (size_t)256 * 256 * 2; S.arow = ZC * 2;
        auto f = [&](const ge::Unit& u, int r, int c, f32x4 v0, f32x4 v1) {
            u32x4 w; w.x = cvtpk(v0.x, v0.y); w.y = cvtpk(v0.z, v0.w); w.z = cvtpk(v1.x, v1.y); w.w = cvtpk(v1.z, v1.w); *(u32x4*)(Q + (size_t)(u.a * 256 + r) * 768 + u.b * 256 + c) = w;
        };
        ge::EpiFn<decltype(f)> E{f};
        ge::gemm_stream<ge::DenseOrder, ge::EpiFn<decltype(f)>, true>((LAS unsigned char*)lds, (const char*)(p.ws + WS_Z) + Z_CQ * 2, 256, S, E);
    }
    {
        bf16_t* Kb = (bf16_t*)(p.ws + WS_K); bf16_t* Vb = (bf16_t*)(p.ws + WS_V);
        ge::DenseOrder S; S.nM = NTOK / 256; S.nN = 4; S.nwg = S.nM * 4; S.G = G; S.c = (bid + 176) % G; S.Bt = (const char*)((const bf16_t*)(p.ws + WS_WUKV) + (size_t)L * 1024 * 256); S.btile = (size_t)256 * 256 * 2; S.arow = ZC * 2;
        struct EpiKV {
            bf16_t* Kb; bf16_t* Vb; const float* sskv;
            __device__ __forceinline__ void operator()(const ge::Acc& acc, const ge::Unit& u, int wr, int wc, int fr, int fq) const {
                float rstd[2][4];
#pragma unroll
                for (int ai = 0; ai < 2; ++ai)
#pragma unroll
                    for (int m = 0; m < 4; ++m) { const f32x4 s4 = *(const f32x4*)(sskv + (size_t)(u.a * 256 + ai * 128 + wr * 64 + m * 16 + fr) * 4); rstd[ai][m] = rsqrtf((s4.x + s4.y + s4.z + s4.w) * (1.f / 128.f) + NORM_EPS); }
#pragma unroll
                for (int ai = 0; ai < 2; ++ai)
#pragma unroll
                    for (int m = 0; m < 4; ++m) {
                        const int row = u.a * 256 + ai * 128 + wr * 64 + m * 16 + fr;
#pragma unroll
                        for (int bj = 0; bj < 2; ++bj) {
                            const int col = u.b * 256 + bj * 128 + wc * 32 + 8 * fq, h = col >> 7, j = col & 127;
                            const f32x4 v0 = acc[ai][bj][m][0] * rstd[ai][m], v1 = acc[ai][bj][m][1] * rstd[ai][m];
                            u32x4 w; w.x = cvtpk(v0.x, v0.y); w.y = cvtpk(v0.z, v0.w); w.z = cvtpk(v1.x, v1.y); w.w = cvtpk(v1.z, v1.w);
                            if (j < 64) *(u32x4*)(Kb + (size_t)row * 768 + h * 96 + j) = w;
                            else *(u32x4*)(Vb + (size_t)row * 512 + h * 64 + (j - 64)) = w;
                        }
                    }
            }
        };
        EpiKV E{Kb, Vb, sskv};
        ge::gemm_stream<ge::DenseOrder, EpiKV, true>((LAS unsigned char*)lds, (const char*)(p.ws + WS_Z) + Z_CKV * 2, 256, S, E);
    }
}
__device__ __forceinline__ void phase_b(unsigned char* lds, const P& p, int L) {
    const int G = gridDim.x, bid = blockIdx.x;
    qkv_proj(lds, p, L);
    const int nconv = (L == 0) ? 576 : 512;
    const int nkv = 288 * 4;
    const int total = nconv + nkv;
    for (int u = (bid + 96) % G; u < total; u += G) {
        int r = u;
        if (r < nconv) { if (r < 512) conv_unit(lds, p, L, r >> 5, r & 31); else conv_unit(lds, p, L, 16 + ((r - 512) >> 2), (r - 512) & 3); continue; } r -= nconv;
        retkv_unit_mfma(lds, p, L, r >> 2, r & 3);
    }
    if (L == 1) convert_expert_weights(lds, p, 1);
}

__device__ __forceinline__ void attn_unit_naive(unsigned char* lds, const P& p, int b, int h, int qb, bool ctxq) {
    float* Ks = (float*)lds;
    float* Vs = Ks + 64 * 96;
    const int tid = threadIdx.x, half = tid & 1, qi = tid >> 1;
    const bf16_t* Qb = (const bf16_t*)(p.ws + WS_Q); const bf16_t* Kb = (const bf16_t*)(p.ws + WS_K); const bf16_t* Vb = (const bf16_t*)(p.ws + WS_V);
    const int qrow = ctxq ? NLAT + b * CTXL + qi : b * SEQ + qb * 256 + qi;
    float q[48];
    {
        const u32x4* qp = (const u32x4*)(Qb + (size_t)qrow * 768 + h * 96 + half * 48);
#pragma unroll
        for (int i = 0; i < 6; ++i) { const u32x4 w = qp[i];
#pragma unroll
            for (int k = 0; k < 4; ++k) { q[i * 8 + 2 * k] = lo16(w[k]); q[i * 8 + 2 * k + 1] = hi16(w[k]); } }
    }
    float o[32];
#pragma unroll
    for (int e = 0; e < 32; ++e) o[e] = 0.f;
    float m = -1e30f, l = 0.f;
    const int ntiles = ctxq ? 4 : 36;
#pragma unroll 1
    for (int t = 0; t < ntiles; ++t) {
        const int krow0 = t < 4 ? NLAT + b * CTXL + t * 64 : b * SEQ + (t - 4) * 64;
        __syncthreads();
        for (int i = tid; i < 64 * 12; i += NTHREADS) { const int key = i / 12, c = i % 12; const u32x4 w = *(const u32x4*)(Kb + (size_t)(krow0 + key) * 768 + h * 96 + c * 8);
            float* d = Ks + key * 96 + c * 8;
#pragma unroll
            for (int k = 0; k < 4; ++k) { d[2 * k] = lo16(w[k]); d[2 * k + 1] = hi16(w[k]); } }
        for (int i = tid; i < 64 * 8; i += NTHREADS) { const int key = i >> 3, c = i & 7; const u32x4 w = *(const u32x4*)(Vb + (size_t)(krow0 + key) * 512 + h * 64 + c * 8);
            float* d = Vs + key * 64 + c * 8;
#pragma unroll
            for (int k = 0; k < 4; ++k) { d[2 * k] = lo16(w[k]); d[2 * k + 1] = hi16(w[k]); } }
        __syncthreads();
#pragma unroll 1
        for (int j0 = 0; j0 < 64; j0 += 2) {
            float s[2]; float mt = -1e30f;
#pragma unroll
            for (int jj = 0; jj < 2; ++jj) {
                const f32x4* kr = (const f32x4*)(Ks + (j0 + jj) * 96 + half * 48);
                float a = 0.f;
#pragma unroll
                for (int d4 = 0; d4 < 12; ++d4) { const f32x4 kv = kr[d4]; a += q[4 * d4] * kv.x + q[4 * d4 + 1] * kv.y + q[4 * d4 + 2] * kv.z + q[4 * d4 + 3] * kv.w; }
                a += __shfl_xor(a, 1);
                s[jj] = a; mt = fmaxf(mt, a);
            }
            const float mn = fmaxf(m, mt), alpha = exp2f(m - mn);
            m = mn; l *= alpha;
#pragma unroll
            for (int e = 0; e < 32; ++e) o[e] *= alpha;
#pragma unroll
            for (int jj = 0; jj < 2; ++jj) {
                const float pj = exp2f(s[jj] - mn); l += pj;
                const f32x4* vr = (const f32x4*)(Vs + (j0 + jj) * 64 + half * 32);
#pragma unroll
                for (int e4 = 0; e4 < 8; ++e4) { const f32x4 vv = vr[e4]; o[4 * e4] += pj * vv.x; o[4 * e4 + 1] += pj * vv.y; o[4 * e4 + 2] += pj * vv.z; o[4 * e4 + 3] += pj * vv.w; }
            }
        }
    }
    {
        const float rl = 1.f / l;
        u32x4* op = (u32x4*)((bf16_t*)(p.ws + WS_CC) + (size_t)qrow * D + 512 + h * 64 + half * 32);
#pragma unroll
        for (int i = 0; i < 4; ++i) { u32x4 w; w.x = pk2(o[8 * i] * rl, o[8 * i + 1] * rl); w.y = pk2(o[8 * i + 2] * rl, o[8 * i + 3] * rl); w.z = pk2(o[8 * i + 4] * rl, o[8 * i + 5] * rl); w.w = pk2(o[8 * i + 6] * rl, o[8 * i + 7] * rl); op[i] = w; }
    }
    __syncthreads();
}
__device__ __forceinline__ float max3f(float a, float b, float c) { float r; asm("v_max3_f32 %0, %1, %2, %3" : "=v"(r) : "v"(a), "v"(b), "v"(c)); return r; }
constexpr int AT_KROW = 208;
constexpr int AT_KBUF = 64 * AT_KROW;
constexpr int AT_VBUF = 8192;
constexpr int AT_BUF = AT_KBUF + AT_VBUF;
__device__ __forceinline__ void attn_unit_mfma(unsigned char* lds, const P& p, int b, int h, int qb, bool ctxq) {
    const int tid = threadIdx.x, lane = tid & 63, wid = tid >> 6, r32 = lane & 31, hh = lane >> 5;
    const bf16_t* Qb = (const bf16_t*)(p.ws + WS_Q); const bf16_t* Kb = (const bf16_t*)(p.ws + WS_K); const bf16_t* Vb = (const bf16_t*)(p.ws + WS_V);
    const int qrow = (ctxq ? NLAT + b * CTXL : b * SEQ + qb * 256) + wid * 32 + r32;
    bf16x8 qf[6];
    {
        const f32x4 s4 = *(const f32x4*)((const float*)(p.ws + WS_SS) + (size_t)qrow * 4);
        const float rstd = rsqrtf((s4.x + s4.y + s4.z + s4.w) * (1.f / 256.f) + NORM_EPS);
        const float* ct = (const float*)(p.ws + WS_ROPE) + (qrow & (SEQ - 1)) * 16; const float* st = ct + 2048 * 16;
#pragma unroll
        for (int s = 0; s < 6; ++s) {
            const u32x4 w = *(const u32x4*)(Qb + (size_t)qrow * 768 + h * 96 + 16 * s + 8 * hh);
            float x[8];
#pragma unroll
            for (int k = 0; k < 4; ++k) { x[2 * k] = lo16(w[k]) * rstd; x[2 * k + 1] = hi16(w[k]) * rstd; }
            if (s >= 4 && !ctxq) {
                const f32x4 c4 = *(const f32x4*)(ct + 8 * (s - 4) + 4 * hh), sn = *(const f32x4*)(st + 8 * (s - 4) + 4 * hh);
#pragma unroll
                for (int k = 0; k < 4; ++k) { const float a = x[2 * k], b2 = x[2 * k + 1]; x[2 * k] = a * c4[k] - b2 * sn[k]; x[2 * k + 1] = a * sn[k] + b2 * c4[k]; }
            }
            const u32x4 o = (u32x4){cvtpk(x[0], x[1]), cvtpk(x[2], x[3]), cvtpk(x[4], x[5]), cvtpk(x[6], x[7])};
            qf[s] = __builtin_bit_cast(bf16x8, o);
        }
    }
    f32x16 o0, o1, negm;
#pragma unroll
    for (int r = 0; r < 16; ++r) { o0[r] = 0.f; o1[r] = 0.f; negm[r] = 0.f; }
    asm volatile("" : "+v"(negm));
    float mhat = 0.f, l = 0.f;
    const int ntiles = ctxq ? 4 : 36;
    const int wv = __builtin_amdgcn_readfirstlane(wid);
    const int ia = wv, ib = (wv + 8 < 13) ? wv + 8 : 12;
    const int qa = ia * 64 + lane, qb2 = ib * 64 + lane, qv = wv * 64 + lane;
    const int ca = qa % 13, cb = qb2 % 13;
    const size_t ka = (size_t)(qa / 13) * 768 + h * 96 + (ca < 12 ? ca : 11) * 8, kbo = (size_t)(qb2 / 13) * 768 + h * 96 + (cb < 12 ? cb : 11) * 8;
    const size_t vo = (size_t)((qv >> 2) & 63) * 512 + h * 64 + (qv >> 8) * 32 + (qv & 3) * 8;
    auto krow0 = [&](int t) { return t < 4 ? NLAT + b * CTXL + t * 64 : b * SEQ + (t - 4) * 64; };
    const unsigned lds0 = (unsigned)(uintptr_t)lds;
#define AT_GLDS(gp, ldsoff) do { unsigned keep_; asm volatile("s_mov_b32 %0, m0\n\ts_mov_b32 m0, %2\n\ts_nop 0\n\tglobal_load_lds_dwordx4 %1, off\n\ts_mov_b32 m0, %0" : "=&s"(keep_) : "v"(gp), "s"((unsigned)__builtin_amdgcn_readfirstlane(lds0 + (unsigned)(ldsoff))) : "memory"); } while (0)
#define AT_ISSUE(t2, slot) do { const int kr_ = krow0(t2); const bf16_t* kb_ = Kb + (size_t)kr_ * 768; const bf16_t* vb_ = Vb + (size_t)kr_ * 512; \
        AT_GLDS(kb_ + ka, (slot) + ia * 1024); AT_GLDS(kb_ + kbo, (slot) + ib * 1024); AT_GLDS(vb_ + vo, (slot) + AT_KBUF + wv * 1024); } while (0)
#define AT_SB() __builtin_amdgcn_sched_barrier(0)
#define AT_PIN(x) asm volatile("" : "+v"(x))
#define AT_NEXT(x) ((x) == 3 * AT_BUF ? 0 : (x) + AT_BUF)
    __builtin_amdgcn_s_barrier();
    AT_ISSUE(0, 0);
    if (ntiles > 1) AT_ISSUE(1, AT_BUF);
    const int koff = r32 * AT_KROW + 16 * hh;
    const int voff = AT_KBUF + (4 * hh + ((lane & 15) >> 2)) * 64 + ((lane >> 4) & 1) * 32 + (lane & 3) * 8;
#define AT_SYNC(t, slot_issue) do { if ((t) + 1 < ntiles) asm volatile("s_waitcnt vmcnt(3)" ::: "memory"); else asm volatile("s_waitcnt vmcnt(0)" ::: "memory"); \
        __builtin_amdgcn_s_barrier(); asm volatile("" ::: "memory"); if ((t) + 2 < ntiles) AT_ISSUE((t) + 2, slot_issue); } while (0)
#define AT_DECIDE(C0, C1) do { \
        asm volatile("s_nop 15\n\ts_nop 7" : "+v"(C0), "+v"(C1)); \
        float rma = max3f(C0[0], C0[1], C1[0]), rmb = max3f(C0[2], C0[3], C1[1]); rma = max3f(rma, C1[2], C1[3]); \
        _Pragma("unroll") for (int r = 4; r < 16; r += 4) { rma = max3f(rma, C0[r], C0[r + 1]); rmb = max3f(rmb, C0[r + 2], C0[r + 3]); rma = max3f(rma, C1[r], C1[r + 1]); rmb = max3f(rmb, C1[r + 2], C1[r + 3]); } \
        float rm = fmaxf(rma, rmb); rm = fmaxf(rm, __shfl_xor(rm, 32)); \
        resc = false; \
        if (__any(rm > 8.f)) { const float dl = fmaxf(rm, 0.f); fres = __builtin_amdgcn_exp2f(-dl); mhat += dl; l *= fres; resc = true; \
            _Pragma("unroll") for (int r = 0; r < 16; ++r) { C0[r] -= dl; C1[r] -= dl; negm[r] = -mhat; } \
            asm volatile("" : "+v"(negm)); } \
    } while (0)
#define AT_MFS(kfrag, s_, C, first) C = __builtin_amdgcn_mfma_f32_32x32x16_bf16(kfrag, qf[s_], (first) ? negm : C, 0, 0, 0)
#define AT_KF(bk_, g) (*(const bf16x8*)((bk_) + koff + ((g) & 1) * 32 * AT_KROW + ((g) >> 1) * 32))
#define AT_STEP(C0, C1, P0, P1, bk, bv) do { \
        bf16x8 kf[12], vfa[4], vfc[4]; u32x4 pw[4]; float sacc = 0.f; \
        kf[0] = AT_KF(bk, 0); kf[1] = AT_KF(bk, 1); kf[2] = AT_KF(bk, 2); kf[3] = AT_KF(bk, 3); \
        AT_SB(); \
        AT_MFS(kf[0], 0, C0, true);  kf[4] = AT_KF(bk, 4);  sacc += (P0[0] + P0[1]) + (P0[2] + P0[3]); pw[0].x = cvtpk(P0[0], P0[1]); pw[0].y = cvtpk(P0[2], P0[3]); AT_PIN(sacc); AT_PIN(pw[0]); AT_SB(); \
        AT_MFS(kf[1], 0, C1, true);  kf[5] = AT_KF(bk, 5);  sacc += (P0[4] + P0[5]) + (P0[6] + P0[7]); pw[0].z = cvtpk(P0[4], P0[5]); pw[0].w = cvtpk(P0[6], P0[7]); AT_PIN(sacc); AT_PIN(pw[0]); AT_SB(); \
        AT_MFS(kf[2], 1, C0, false); kf[6] = AT_KF(bk, 6);  sacc += (P0[8] + P0[9]) + (P0[10] + P0[11]); pw[1].x = cvtpk(P0[8], P0[9]); pw[1].y = cvtpk(P0[10], P0[11]); AT_PIN(sacc); AT_PIN(pw[1]); AT_SB(); \
        AT_MFS(kf[3], 1, C1, false); kf[7] = AT_KF(bk, 7);  sacc += (P0[12] + P0[13]) + (P0[14] + P0[15]); pw[1].z = cvtpk(P0[12], P0[13]); pw[1].w = cvtpk(P0[14], P0[15]); AT_PIN(sacc); AT_PIN(pw[1]); AT_SB(); \
        AT_MFS(kf[4], 2, C0, false); kf[8] = AT_KF(bk, 8);  sacc += (P1[0] + P1[1]) + (P1[2] + P1[3]); pw[2].x = cvtpk(P1[0], P1[1]); pw[2].y = cvtpk(P1[2], P1[3]); AT_PIN(sacc); AT_PIN(pw[2]); AT_SB(); \
        AT_MFS(kf[5], 2, C1, false); kf[9] = AT_KF(bk, 9);  sacc += (P1[4] + P1[5]) + (P1[6] + P1[7]); pw[2].z = cvtpk(P1[4], P1[5]); pw[2].w = cvtpk(P1[6], P1[7]); AT_PIN(sacc); AT_PIN(pw[2]); AT_SB(); \
        AT_MFS(kf[6], 3, C0, false); kf[10] = AT_KF(bk, 10); sacc += (P1[8] + P1[9]) + (P1[10] + P1[11]); pw[3].x = cvtpk(P1[8], P1[9]); pw[3].y = cvtpk(P1[10], P1[11]); AT_PIN(sacc); AT_PIN(pw[3]); AT_SB(); \
        AT_MFS(kf[7], 3, C1, false); kf[11] = AT_KF(bk, 11); sacc += (P1[12] + P1[13]) + (P1[14] + P1[15]); pw[3].z = cvtpk(P1[12], P1[13]); pw[3].w = cvtpk(P1[14], P1[15]); AT_PIN(sacc); AT_PIN(pw[3]); AT_SB(); \
        AT_MFS(kf[8], 4, C0, false); { const unsigned char* vb_ = (bv) + voff; vfa[0] = tr8(vb_, vb_ + 512); vfc[0] = tr8(vb_ + 4096, vb_ + 4608); } AT_SB(); \
        AT_MFS(kf[9], 4, C1, false); { const unsigned char* vb_ = (bv) + voff + 1024; vfa[1] = tr8(vb_, vb_ + 512); vfc[1] = tr8(vb_ + 4096, vb_ + 4608); } AT_SB(); \
        AT_MFS(kf[10], 5, C0, false); { const unsigned char* vb_ = (bv) + voff + 2048; vfa[2] = tr8(vb_, vb_ + 512); vfc[2] = tr8(vb_ + 4096, vb_ + 4608); } AT_SB(); \
        AT_MFS(kf[11], 5, C1, false); { const unsigned char* vb_ = (bv) + voff + 3072; vfa[3] = tr8(vb_, vb_ + 512); vfc[3] = tr8(vb_ + 4096, vb_ + 4608); } AT_SB(); \
        l += sacc; \
        AT_DECIDE(C0, C1); \
        AT_SB(); \
        o0 = __builtin_amdgcn_mfma_f32_32x32x16_bf16(vfa[0], __builtin_bit_cast(bf16x8, pw[0]), o0, 0, 0, 0); C0[0] = __builtin_amdgcn_exp2f(C0[0]); C0[1] = __builtin_amdgcn_exp2f(C0[1]); C0[2] = __builtin_amdgcn_exp2f(C0[2]); C0[3] = __builtin_amdgcn_exp2f(C0[3]); AT_PIN(C0); AT_SB(); \
        o1 = __builtin_amdgcn_mfma_f32_32x32x16_bf16(vfc[0], __builtin_bit_cast(bf16x8, pw[0]), o1, 0, 0, 0); C0[4] = __builtin_amdgcn_exp2f(C0[4]); C0[5] = __builtin_amdgcn_exp2f(C0[5]); C0[6] = __builtin_amdgcn_exp2f(C0[6]); C0[7] = __builtin_amdgcn_exp2f(C0[7]); AT_PIN(C0); AT_SB(); \
        o0 = __builtin_amdgcn_mfma_f32_32x32x16_bf16(vfa[1], __builtin_bit_cast(bf16x8, pw[1]), o0, 0, 0, 0); C0[8] = __builtin_amdgcn_exp2f(C0[8]); C0[9] = __builtin_amdgcn_exp2f(C0[9]); C0[10] = __builtin_amdgcn_exp2f(C0[10]); C0[11] = __builtin_amdgcn_exp2f(C0[11]); AT_PIN(C0); AT_SB(); \
        o1 = __builtin_amdgcn_mfma_f32_32x32x16_bf16(vfc[1], __builtin_bit_cast(bf16x8, pw[1]), o1, 0, 0, 0); C0[12] = __builtin_amdgcn_exp2f(C0[12]); C0[13] = __builtin_amdgcn_exp2f(C0[13]); C0[14] = __builtin_amdgcn_exp2f(C0[14]); C0[15] = __builtin_amdgcn_exp2f(C0[15]); AT_PIN(C0); AT_SB(); \
        o0 = __builtin_amdgcn_mfma_f32_32x32x16_bf16(vfa[2], __builtin_bit_cast(bf16x8, pw[2]), o0, 0, 0, 0); C1[0] = __builtin_amdgcn_exp2f(C1[0]); C1[1] = __builtin_amdgcn_exp2f(C1[1]); C1[2] = __builtin_amdgcn_exp2f(C1[2]); C1[3] = __builtin_amdgcn_exp2f(C1[3]); AT_PIN(C1); AT_SB(); \
        o1 = __builtin_amdgcn_mfma_f32_32x32x16_bf16(vfc[2], __builtin_bit_cast(bf16x8, pw[2]), o1, 0, 0, 0); C1[4] = __builtin_amdgcn_exp2f(C1[4]); C1[5] = __builtin_amdgcn_exp2f(C1[5]); C1[6] = __builtin_amdgcn_exp2f(C1[6]); C1[7] = __builtin_amdgcn_exp2f(C1[7]); AT_PIN(C1); AT_SB(); \
        o0 = __builtin_amdgcn_mfma_f32_32x32x16_bf16(vfa[3], __builtin_bit_cast(bf16x8, pw[3]), o0, 0, 0, 0); C1[8] = __builtin_amdgcn_exp2f(C1[8]); C1[9] = __builtin_amdgcn_exp2f(C1[9]); C1[10] = __builtin_amdgcn_exp2f(C1[10]); C1[11] = __builtin_amdgcn_exp2f(C1[11]); AT_PIN(C1); AT_SB(); \
        o1 = __builtin_amdgcn_mfma_f32_32x32x16_bf16(vfc[3], __builtin_bit_cast(bf16x8, pw[3]), o1, 0, 0, 0); C1[12] = __builtin_amdgcn_exp2f(C1[12]); C1[13] = __builtin_amdgcn_exp2f(C1[13]); C1[14] = __builtin_amdgcn_exp2f(C1[14]); C1[15] = __builtin_amdgcn_exp2f(C1[15]); AT_PIN(C1); AT_SB(); \
        if (resc) { _Pragma("unroll") for (int r = 0; r < 16; ++r) { o0[r] *= fres; o1[r] *= fres; } } \
    } while (0)
    f32x16 pA0, pA1, pB0, pB1; bool resc = false; float fres = 1.f;
    int s_prev = 0, s_cur = 0, s_iss = 2 * AT_BUF;
    AT_SYNC(0, s_iss); s_iss = AT_NEXT(s_iss);
    {
        const unsigned char* bk = lds + s_cur;
#pragma unroll
        for (int s_ = 0; s_ < 6; ++s_) {
            const bf16x8 k0f = *(const bf16x8*)(bk + koff + 32 * s_), k1f = *(const bf16x8*)(bk + koff + 32 * AT_KROW + 32 * s_);
            pA0 = __builtin_amdgcn_mfma_f32_32x32x16_bf16(k0f, qf[s_], s_ == 0 ? negm : pA0, 0, 0, 0);
            pA1 = __builtin_amdgcn_mfma_f32_32x32x16_bf16(k1f, qf[s_], s_ == 0 ? negm : pA1, 0, 0, 0);
        }
        AT_DECIDE(pA0, pA1);
#pragma unroll
        for (int r = 0; r < 16; ++r) { pA0[r] = __builtin_amdgcn_exp2f(pA0[r]); pA1[r] = __builtin_amdgcn_exp2f(pA1[r]); }
    }
    int t = 1;
#pragma unroll 1
    for (; t + 1 < ntiles; t += 2) {
        s_prev = s_cur; s_cur = AT_NEXT(s_cur); AT_SYNC(t, s_iss); s_iss = AT_NEXT(s_iss);
        AT_STEP(pB0, pB1, pA0, pA1, lds + s_cur, lds + s_prev);
        s_prev = s_cur; s_cur = AT_NEXT(s_cur); AT_SYNC(t + 1, s_iss); s_iss = AT_NEXT(s_iss);
        AT_STEP(pA0, pA1, pB0, pB1, lds + s_cur, lds + s_prev);
    }
    {
        s_prev = s_cur; s_cur = AT_NEXT(s_cur); AT_SYNC(t, s_iss); s_iss = AT_NEXT(s_iss);
        AT_STEP(pB0, pB1, pA0, pA1, lds + s_cur, lds + s_prev);
    }
    {
        float sacc = 0.f;
#pragma unroll
        for (int r = 0; r < 16; ++r) sacc += pB0[r] + pB1[r];
        l += sacc;
        u32x4 pw[4];
#pragma unroll
        for (int s2 = 0; s2 < 2; ++s2) {
            pw[s2] = (u32x4){cvtpk(pB0[8 * s2], pB0[8 * s2 + 1]), cvtpk(pB0[8 * s2 + 2], pB0[8 * s2 + 3]), cvtpk(pB0[8 * s2 + 4], pB0[8 * s2 + 5]), cvtpk(pB0[8 * s2 + 6], pB0[8 * s2 + 7])};
            pw[2 + s2] = (u32x4){cvtpk(pB1[8 * s2], pB1[8 * s2 + 1]), cvtpk(pB1[8 * s2 + 2], pB1[8 * s2 + 3]), cvtpk(pB1[8 * s2 + 4], pB1[8 * s2 + 5]), cvtpk(pB1[8 * s2 + 6], pB1[8 * s2 + 7])};
        }
        const unsigned char* bv = lds + s_cur;
#pragma unroll
        for (int ks = 0; ks < 4; ++ks) {
            const unsigned char* vb = bv + voff + ks * 16 * 64; const bf16x8 pf = __builtin_bit_cast(bf16x8, pw[ks]);
            o0 = __builtin_amdgcn_mfma_f32_32x32x16_bf16(tr8(vb, vb + 8 * 64), pf, o0, 0, 0, 0);
            o1 = __builtin_amdgcn_mfma_f32_32x32x16_bf16(tr8(vb + 4096, vb + 4096 + 8 * 64), pf, o1, 0, 0, 0);
        }
    }
#undef AT_GLDS
#undef AT_ISSUE
#undef AT_SB
#undef AT_PIN
#undef AT_NEXT
#undef AT_SYNC
#undef AT_DECIDE
#undef AT_MFS
#undef AT_KF
#undef AT_STEP
    l += __shfl_xor(l, 32);
    const float rl = 1.f / l;
    bf16_t* orow = (bf16_t*)(p.ws + WS_CC) + (size_t)qrow * D + 512 + h * 64 + 4 * hh;
#pragma unroll
    for (int r4 = 0; r4 < 4; ++r4) {
        u32x2 w0; w0.x = cvtpk(o0[4 * r4] * rl, o0[4 * r4 + 1] * rl); w0.y = cvtpk(o0[4 * r4 + 2] * rl, o0[4 * r4 + 3] * rl);
        u32x2 w1; w1.x = cvtpk(o1[4 * r4] * rl, o1[4 * r4 + 1] * rl); w1.y = cvtpk(o1[4 * r4 + 2] * rl, o1[4 * r4 + 3] * rl);
        *(u32x2*)(orow + 8 * r4) = w0; *(u32x2*)(orow + 32 + 8 * r4) = w1;
    }
}
__device__ __forceinline__ void retout_unit(unsigned char* lds, const P& p, int L, int gc, int h) {
    float* qs = (float*)lds; float* ks = qs + 128 * 33; float* vs = ks + 128 * 33; float* Sf = vs + 128 * 64; float* Sb = Sf + 2048;
    const int tid = threadIdx.x;
    const float l2f = log2_gamma(p, L, 0, h), l2b = log2_gamma(p, L, 1, h);
    load_ret_qk(qs, p, gc, h, Z_RQ, 1.f);
    load_ret_qk(ks, p, gc, h, Z_RK, 0.17677669529663687f);
    load_ret_v(vs, p, gc, h);
    {
        const bool lat = gc < 256; const int b = lat ? gc >> 4 : (gc - 256) >> 1;
        const int mme = lat ? 2 + (gc & 15) : (gc - 256) & 1;
        const int u = mme, w = mme < 2 ? 1 - mme : 19 - mme;
        f32x4 sf = (f32x4){0.f, 0.f, 0.f, 0.f}, sb = sf;
        const float* KVb = (const float*)(p.ws + WS_KV);
#pragma unroll 1
        for (int mm = 0; mm < 18; ++mm) {
            const int gcm = mm < 2 ? 256 + b * 2 + mm : b * 16 + (mm - 2);
            const int um = mm, wm = mm < 2 ? 1 - mm : 19 - mm;
            const float* kv = KVb + ((size_t)(gcm * 4 + h) * 2) * 2048 + tid * 4;
            if (um < u) { const float wgt = exp2f(l2f * 128.f * (float)(u - 1 - um)); sf += wgt * *(const f32x4*)kv; }
            if (wm < w) { const float wgt = exp2f(l2b * 128.f * (float)(w - 1 - wm)); sb += wgt * *(const f32x4*)(kv + 2048); }
        }
        *(f32x4*)(Sf + tid * 4) = sf; *(f32x4*)(Sb + tid * 4) = sb;
    }
    __syncthreads();
    const int i = tid >> 2, e0 = (tid & 3) * 16;
    float q[32];
#pragma unroll
    for (int d = 0; d < 32; ++d) q[d] = qs[i * 33 + d];
    float acc[16];
#pragma unroll
    for (int e = 0; e < 16; ++e) acc[e] = 0.f;
#pragma unroll 1
    for (int j = 0; j < 128; ++j) {
        float s = 0.f;
#pragma unroll
        for (int d = 0; d < 32; ++d) s += q[d] * ks[j * 33 + d];
        float wgt = 0.f;
        if (j <= i) wgt += exp2f(l2f * (float)(i - j));
        if (j >= i) wgt += exp2f(l2b * (float)(j - i));
        s *= wgt;
#pragma unroll
        for (int e4 = 0; e4 < 4; ++e4) { const f32x4 v4 = *(const f32x4*)(vs + j * 64 + e0 + 4 * e4); acc[4 * e4] += s * v4.x; acc[4 * e4 + 1] += s * v4.y; acc[4 * e4 + 2] += s * v4.z; acc[4 * e4 + 3] += s * v4.w; }
    }
    {
        const float cf = exp2f(l2f * (float)(i + 1)), cb = exp2f(l2b * (float)(128 - i));
#pragma unroll 2
        for (int d = 0; d < 32; ++d) {
            const float qd = qs[i * 33 + d]; const float qf = qd * cf, qb = qd * cb;
#pragma unroll
            for (int e4 = 0; e4 < 4; ++e4) { const f32x4 a = *(const f32x4*)(Sf + d * 64 + e0 + 4 * e4), bq = *(const f32x4*)(Sb + d * 64 + e0 + 4 * e4);
                acc[4 * e4] += qf * a.x + qb * bq.x; acc[4 * e4 + 1] += qf * a.y + qb * bq.y; acc[4 * e4 + 2] += qf * a.z + qb * bq.z; acc[4 * e4 + 3] += qf * a.w + qb * bq.w; }
        }
    }
    float s1 = 0.f;
#pragma unroll
    for (int e = 0; e < 16; ++e) s1 += acc[e];
    s1 += __shfl_xor(s1, 1); s1 += __shfl_xor(s1, 2);
    const float mu = s1 * (1.f / 64.f);
    float s2 = 0.f;
#pragma unroll
    for (int e = 0; e < 16; ++e) { const float dd = acc[e] - mu; s2 += dd * dd; }
    s2 += __shfl_xor(s2, 1); s2 += __shfl_xor(s2, 2);
    const float rstd = rsqrtf(s2 * (1.f / 64.f) + NORM_EPS);
    const int row = gc * 128 + i;
    const bf16_t* zg = (const bf16_t*)(p.ws + WS_Z) + (size_t)row * ZC + Z_RG + h * 64 + e0;
    const float* gw = p.in[13] + L * 256 + h * 64 + e0;
    const u32x4 g0 = *(const u32x4*)zg, g1 = *(const u32x4*)(zg + 8);
    float g[16];
#pragma unroll
    for (int k = 0; k < 4; ++k) { g[2 * k] = lo16(g0[k]); g[2 * k + 1] = hi16(g0[k]); g[8 + 2 * k] = lo16(g1[k]); g[8 + 2 * k + 1] = hi16(g1[k]); }
    unsigned o[8];
#pragma unroll
    for (int k = 0; k < 8; ++k) {
        const float y0 = siluf(g[2 * k]) * ((acc[2 * k] - mu) * rstd * gw[2 * k]), y1 = siluf(g[2 * k + 1]) * ((acc[2 * k + 1] - mu) * rstd * gw[2 * k + 1]);
        o[k] = pk2(y0, y1);
    }
    u32x4* op = (u32x4*)((bf16_t*)(p.ws + WS_CC) + (size_t)row * D + 256 + h * 64 + e0);
    u32x4 w0; w0.x = o[0]; w0.y = o[1]; w0.z = o[2]; w0.w = o[3]; u32x4 w1; w1.x = o[4]; w1.y = o[5]; w1.z = o[6]; w1.w = o[7];
    op[0] = w0; op[1] = w1;
    __syncthreads();
}
__device__ __forceinline__ void phase_c(unsigned char* lds, const P& p, int L) {
    const int G = gridDim.x, bid = blockIdx.x;
    const int nat = 16 * 8 * 8, nac = (L == 0) ? 128 : 0, nro = (L == 0 ? 288 : 256) * 4;
    const int total = nat + nac + nro;
    const int vcu = (G % 8 == 0) ? (bid % 8) * (G / 8) + bid / 8 : bid;
    for (int u = vcu; u < total; u += G) {
        int r = u;
#ifndef TEST_C
#define TEST_C 3
#endif
        if (r < nat) { if (TEST_C & 1) attn_unit_mfma(lds, p, r >> 6, (r >> 3) & 7, r & 7, false); continue; } r -= nat;
        if (r < nac) { if (TEST_C & 1) attn_unit_mfma(lds, p, r >> 3, r & 7, 0, true); continue; } r -= nac;
        if (TEST_C & 2) retout_unit_mfma(lds, p, L, r >> 2, r & 3);
    }
    if (L == 0) convert_expert_weights(lds, p, 0);
}

struct EpiY {
    bf16_t* Y; const float* g1;
    __device__ __forceinline__ void operator()(const ge::Acc& acc, const ge::Unit& u, int wr, int wc, int fr, int fq) const {
        const float* gr = g1 + (size_t)mod_row(u.a * 256) * 6144 + u.b * 256 + wc * 32 + 8 * fq;
        f32x4 g[2][2];
#pragma unroll
        for (int bj = 0; bj < 2; ++bj)
#pragma unroll
            for (int n = 0; n < 2; ++n) g[bj][n] = *(const f32x4*)(gr + bj * 128 + n * 4);
#pragma unroll
        for (int ai = 0; ai < 2; ++ai)
#pragma unroll
            for (int m = 0; m < 4; ++m) {
                bf16_t* yr = Y + (size_t)(u.a * 256 + ai * 128 + wr * 64 + m * 16 + fr) * D + u.b * 256 + wc * 32 + 8 * fq;
#pragma unroll
                for (int bj = 0; bj < 2; ++bj) { const f32x4 v0 = acc[ai][bj][m][0] * g[bj][0], v1 = acc[ai][bj][m][1] * g[bj][1];
                    u32x4 w; w.x = cvtpk(v0.x, v0.y); w.y = cvtpk(v0.z, v0.w); w.z = cvtpk(v1.x, v1.y); w.w = cvtpk(v1.z, v1.w); *(u32x4*)(yr + bj * 128) = w; }
            }
    }
};
__device__ __forceinline__ void phase_d(unsigned char* lds, const P& p, int L) {
    ge::DenseOrder S; S.nM = (L == 0 ? NTOK : NLAT) / 256; S.nN = 4; S.nwg = S.nM * 4; S.G = gridDim.x; S.c = blockIdx.x;
    S.Bt = (const char*)((const bf16_t*)(p.ws + WS_WOUT) + (size_t)L * D * D); S.btile = (size_t)256 * D * 2; S.arow = D * 2;
    EpiY E{(bf16_t*)(p.ws + WS_Y), (const float*)(p.ws + WS_MODV) + (size_t)L * 17 * 6144 + 2048};
    ge::gemm_stream<ge::DenseOrder, EpiY, true>((LAS unsigned char*)lds, (const char*)(p.ws + WS_CC), D, S, E);
}

__device__ __forceinline__ void norm_mod_store(const P& p, int L, int which, int tok, int lane, const f32x4 (&v)[4], bf16_t* Hdst) {
    const float* nw = (which == 0 ? p.in[6] : p.in[19]) + L * D;
    const float* mrow = (const float*)(p.ws + WS_MODV) + ((size_t)L * 17 + mod_row(tok)) * 6144 + which * 3072;
    float s = 0.f;
#pragma unroll
    for (int j = 0; j < 4; ++j) s += v[j].x * v[j].x + v[j].y * v[j].y + v[j].z * v[j].z + v[j].w * v[j].w;
    const float rstd = rsqrtf(wave_sum(s) * (1.f / D) + NORM_EPS);
    u32x2* o = (u32x2*)(Hdst + (size_t)tok * D) + lane;
#pragma unroll
    for (int j = 0; j < 4; ++j) {
        const int k = 4 * lane + 256 * j;
        const f32x4 w4 = *(const f32x4*)(nw + k), sh = *(const f32x4*)(mrow + k), sc = *(const f32x4*)(mrow + 1024 + k);
        const f32x4 y = v[j] * rstd * w4 * (sc + 1.f) + sh;
        u32x2 w; w.x = cvtpk(y.x, y.y); w.y = cvtpk(y.z, y.w); o[64 * j] = w;
    }
}
__device__ __forceinline__ int half_n(int L) { return L == 0 ? NTOK / 2 : NLAT / 2; }
__device__ __forceinline__ void phase_router(unsigned char* lds, const P& p, int L) {
    constexpr int O_LG = 41472, O_CNT = 83072, O_SEL = 83584, O_SELW = 87424;
    const bf16_t* H = (const bf16_t*)(p.ws + WS_H); const bf16_t* W = (const bf16_t*)(p.ws + WS_RT) + (size_t)L * 128 * D;
    const bf16_t* Y = (const bf16_t*)(p.ws + WS_Y);
    float* lg = (float*)(lds + O_LG);
    int* lcnt = (int*)(lds + O_CNT);
    int* sel = (int*)(lds + O_SEL);
    float* selw = (float*)(lds + O_SELW);
    int* ltok = (int*)(p.ws + WS_LTOK); float* lw = (float*)(p.ws + WS_LW);
    const int tid = threadIdx.x, lane = tid & 63, wave = tid >> 6;
    const int ntok = (L == 0 ? NTOK : NLAT), TS = (L == 0 ? 144 : 128), nmt = ntok / TS, RW = TS / 8;
    for (int mt = blockIdx.x; mt < nmt; mt += gridDim.x) {
        const int t0 = mt * TS;
        if (tid < 64) lcnt[tid] = 0;
#pragma unroll 2
        for (int q = 0; q < RW; ++q) {
            const int tok = t0 + wave * RW + q;
            const u32x2* yr = (const u32x2*)(Y + (size_t)tok * D) + lane;
            u32x2* xo = (u32x2*)x_row(p, tok) + lane;
            f32x4 v[4];
            if (L == 0) {
                const f32x4* xi = (const f32x4*)x_in_row(p, tok) + lane;
#pragma unroll
                for (int j = 0; j < 4; ++j) { const f32x4 a = xi[64 * j]; const u32x2 y = yr[64 * j]; v[j] = (f32x4){a.x + lo16(y.x), a.y + hi16(y.x), a.z + lo16(y.y), a.w + hi16(y.y)}; }
            } else {
#pragma unroll
                for (int j = 0; j < 4; ++j) { const u32x2 a = xo[64 * j]; const u32x2 y = yr[64 * j]; v[j] = (f32x4){lo16(a.x) + lo16(y.x), hi16(a.x) + hi16(y.x), lo16(a.y) + lo16(y.y), hi16(a.y) + hi16(y.y)}; }
            }
#pragma unroll
            for (int j = 0; j < 4; ++j) { u32x2 w; w.x = cvtpk(v[j].x, v[j].y); w.y = cvtpk(v[j].z, v[j].w); xo[64 * j] = w; }
            norm_mod_store(p, L, 1, tok, lane, v, (bf16_t*)(p.ws + WS_H));
        }
        asm volatile("s_waitcnt vmcnt(0)" ::: "memory");
        __syncthreads();
        auto rs = [&](int pr) { return H + (size_t)(t0 + (pr < TS ? pr : TS - 1)) * D; };
        auto epi = [&](int r, int c, f32x4 v) { if (c < 64) { float* d = lg + r * 65 + c; d[0] = v.x; d[1] = v.y; d[2] = v.z; d[3] = v.w; } };
        gemm_tile<5>(lds, rs, W, D, D, epi);
        __syncthreads();
        if (tid < TS) {
            const float* rbp = p.in[21] + L * NEXP; const float* lrow = lg + tid * 65;
            float bv[6], bs[6]; int bi[6];
#pragma unroll
            for (int k = 0; k < 6; ++k) { bv[k] = -INFINITY; bs[k] = 0.f; bi[k] = 0; }
#pragma unroll 4
            for (int e = 0; e < NEXP; ++e) {
                float sc = __builtin_amdgcn_rcpf(1.f + __expf(-lrow[e])); float sv = sc + rbp[e]; int ei = e;
#pragma unroll
                for (int k = 0; k < 6; ++k) { const bool gt = sv > bv[k]; const float tv = gt ? bv[k] : sv, ts = gt ? bs[k] : sc; const int ti = gt ? bi[k] : ei;
                    bv[k] = gt ? sv : bv[k]; bs[k] = gt ? sc : bs[k]; bi[k] = gt ? ei : bi[k]; sv = tv; sc = ts; ei = ti; }
            }
            const float rs6 = 2.5f / (bs[0] + bs[1] + bs[2] + bs[3] + bs[4] + bs[5]);
#pragma unroll
            for (int k = 0; k < 6; ++k) { const int rank = atomicAdd(&lcnt[bi[k]], 1); sel[tid * 6 + k] = (bi[k] << 8) | rank; selw[tid * 6 + k] = bs[k] * rs6; }
        }
        __syncthreads();
        if (tid < 64) {
            unsigned* ecnt = (unsigned*)(p.ws + WS_CTL) + CW_ECNT + L * 4096;
            const int c = lcnt[tid];
            lcnt[64 + tid] = c ? (int)atomicAdd(ecnt + tid * 64, (unsigned)c) : 0;
        }
        __syncthreads();
        for (int i = tid; i < TS * 6; i += NTHREADS) {
            const int sv = sel[i], e = sv >> 8, pos = lcnt[64 + e] + (sv & 255), tok = t0 + i / 6, k = i % 6;
            ltok[(size_t)e * LCAP + pos] = tok * 8 + k;
            lw[(size_t)e * LCAP + pos] = selw[i];
        }
        __syncthreads();
    }
}

__device__ __forceinline__ void build_etab(unsigned char* lds, const P& p, int L) {
    int* tstart = (int*)(lds + ETAB_OFF); int* cnt = tstart + 80;
    __syncthreads();
    if (threadIdx.x < 64) { const unsigned* ecnt = (const unsigned*)(p.ws + WS_CTL) + CW_ECNT + L * 4096;
        cnt[threadIdx.x] = (int)__hip_atomic_load(ecnt + threadIdx.x * 64, __ATOMIC_RELAXED, __HIP_MEMORY_SCOPE_AGENT); }
    __syncthreads();
    if (threadIdx.x == 0) { int s = 0; for (int e = 0; e < 64; ++e) { tstart[e] = s; s += (cnt[e] + 255) >> 8; } tstart[64] = s; s += (L == 0 ? NTOK : NLAT) / 256; tstart[65] = s; }
    __syncthreads();
}
struct MoeOrder {
    int TT, nN, G, c; const int* tstart; const char* Bexp; size_t bexp; const char* Bsh; size_t btile; const int* rowbuf; unsigned arow; bool ident;
    __device__ __forceinline__ bool next(int i, ge::Unit& u) const {
        const int Lq = i * G + c; if (Lq >= TT * nN) return false;
        const int t = Lq / nN, pn = Lq % nN;
        int lo = 0, hi = 64;
        while (lo < hi) { const int mid = (lo + hi + 1) >> 1; if (tstart[mid] <= t) lo = mid; else hi = mid - 1; }
        const int e = __builtin_amdgcn_readfirstlane(lo);
        u.a = t; u.b = pn; u.c = e; u.d = i;
        u.B = (e < 64 ? Bexp + (size_t)e * bexp : Bsh) + (size_t)pn * btile;
        return true;
    }
    __device__ __forceinline__ unsigned aoff(int i, const ge::Unit& u, int R) const { return (unsigned)(ident ? u.a * 256 + R : rowbuf[i * 256 + R]) * arow; }
};
__device__ __forceinline__ void phase_gateup(unsigned char* lds, const P& p, int L) {
    build_etab(lds, p, L);
    const int* tstart = (const int*)(lds + ETAB_OFF); const int* cnt = tstart + 80;
    int* rowbuf = (int*)(lds + RB0_OFF); float* wbuf = (float*)(lds + RB1_OFF);
    const int* ltok = (const int*)(p.ws + WS_LTOK); const float* lw = (const float*)(p.ws + WS_LW);
    bf16_t* ACT = (bf16_t*)(p.ws + WS_ACT);
    const int G = gridDim.x, bid = blockIdx.x, vcu = (G % 8 == 0) ? (bid % 8) * (G / 8) + bid / 8 : bid;
    MoeOrder S; S.TT = tstart[65]; S.nN = 2; S.G = G; S.c = vcu; S.tstart = tstart; S.Bexp = (const char*)(p.ws + WS_EGU); S.bexp = (size_t)512 * D * 2;
    S.Bsh = (const char*)((const bf16_t*)(p.ws + WS_SHGU) + (size_t)L * 512 * D); S.btile = (size_t)256 * D * 2; S.rowbuf = rowbuf; S.arow = D * 2; S.ident = false;
    {
        ge::Unit u;
        for (int i = 0; i < 10 && S.next(i, u); ++i) {
            if (threadIdx.x < 256) {
                const int R = threadIdx.x, e = u.c, mt = u.a - tstart[e];
                int tok; float w;
                if (e < 64) { const int lp = mt * 256 + R; const bool ok = lp < cnt[e]; tok = ok ? (ltok[(size_t)e * LCAP + lp] >> 3) : 0; w = ok ? lw[(size_t)e * LCAP + lp] : 0.f; }
                else { tok = mt * 256 + R; w = 1.f; }
                rowbuf[i * 256 + R] = tok; wbuf[i * 256 + R] = w;
            }
        }
        __syncthreads();
    }
    auto f = [&](const ge::Unit& u, int r, int c, f32x4 v0, f32x4 v1) {
        const float w = wbuf[u.d * 256 + r];
        u32x2 o; o.x = cvtpk(siluf(v0.x) * v0.y * w, siluf(v0.z) * v0.w * w); o.y = cvtpk(siluf(v1.x) * v1.y * w, siluf(v1.z) * v1.w * w);
        *(u32x2*)(ACT + (size_t)(u.a * 256 + r) * EDIM + ((u.b * 256 + c) >> 1)) = o;
    };
    ge::EpiFn<decltype(f)> E{f};
    ge::gemm_stream<MoeOrder, ge::EpiFn<decltype(f)>, true>((LAS unsigned char*)lds, (const char*)(p.ws + WS_H), D, S, E);
}
__device__ __forceinline__ void phase_down(unsigned char* lds, const P& p, int L) {
    build_etab(lds, p, L);
    const int* tstart = (const int*)(lds + ETAB_OFF); const int* cnt = tstart + 80;
    int* sbuf = (int*)(lds + RB0_OFF);
    const int* ltok = (const int*)(p.ws + WS_LTOK);
    unsigned char* SLOT = (unsigned char*)(p.ws + WS_SLOT);
    const int G = gridDim.x, bid = blockIdx.x, vcu = (G % 8 == 0) ? (bid % 8) * (G / 8) + bid / 8 : bid;
    MoeOrder S; S.TT = tstart[65]; S.nN = 4; S.G = G; S.c = vcu; S.tstart = tstart; S.Bexp = (const char*)(p.ws + WS_ED); S.bexp = (size_t)D * EDIM * 2;
    S.Bsh = (const char*)((const bf16_t*)(p.ws + WS_SHD) + (size_t)L * D * EDIM); S.btile = (size_t)256 * EDIM * 2; S.rowbuf = sbuf; S.arow = EDIM * 2; S.ident = true;
    {
        ge::Unit u;
        for (int i = 0; i < 18 && S.next(i, u); ++i) {
            if (threadIdx.x < 256) {
                const int R = threadIdx.x, e = u.c, mt = u.a - tstart[e];
                int srow;
                if (e < 64) { const int lp = mt * 256 + R; if (lp < cnt[e]) { const int ent = ltok[(size_t)e * LCAP + lp]; srow = (ent >> 3) * 7 + (ent & 7); } else srow = NTOK * 7; }
                else srow = (mt * 256 + R) * 7 + 6;
                sbuf[i * 256 + R] = srow;
            }
        }
        __syncthreads();
    }
    auto f = [&](const ge::Unit& u, int r, int c, f32x4 v0, f32x4 v1) {
        const int srow = sbuf[u.d * 256 + r];
        int w0 = 0, w1 = 0;
        w0 = __builtin_amdgcn_cvt_pk_fp8_f32(__builtin_amdgcn_fmed3f(v0.x, -440.f, 440.f), __builtin_amdgcn_fmed3f(v0.y, -440.f, 440.f), w0, false);
        w0 = __builtin_amdgcn_cvt_pk_fp8_f32(__builtin_amdgcn_fmed3f(v0.z, -440.f, 440.f), __builtin_amdgcn_fmed3f(v0.w, -440.f, 440.f), w0, true);
        w1 = __builtin_amdgcn_cvt_pk_fp8_f32(__builtin_amdgcn_fmed3f(v1.x, -440.f, 440.f), __builtin_amdgcn_fmed3f(v1.y, -440.f, 440.f), w1, false);
        w1 = __builtin_amdgcn_cvt_pk_fp8_f32(__builtin_amdgcn_fmed3f(v1.z, -440.f, 440.f), __builtin_amdgcn_fmed3f(v1.w, -440.f, 440.f), w1, true);
        u32x2 w; w.x = (unsigned)w0; w.y = (unsigned)w1; *(u32x2*)(SLOT + (size_t)srow * D + u.b * 256 + c) = w;
    };
    ge::EpiFn<decltype(f)> E{f};
    ge::gemm_stream<MoeOrder, ge::EpiFn<decltype(f)>, true>((LAS unsigned char*)lds, (const char*)(p.ws + WS_ACT), EDIM, S, E);
}
__device__ __forceinline__ void phase_combine(const P& p, int L) {
    const int tid = threadIdx.x, lane = tid & 63, wave = tid >> 6, gw = blockIdx.x * NWAVES + wave, NGW = gridDim.x * NWAVES;
    const unsigned char* SLOT = (const unsigned char*)(p.ws + WS_SLOT);
    const float* modv = (const float*)(p.ws + WS_MODV) + (size_t)L * 17 * 6144;
    const int ntok = (L == 0 ? NTOK : NLAT);
    for (int tok = gw; tok < ntok; tok += NGW) {
        f32x4 acc[4];
#pragma unroll
        for (int j = 0; j < 4; ++j) acc[j] = (f32x4){0.f, 0.f, 0.f, 0.f};
#pragma unroll
        for (int k = 0; k < 7; ++k) {
            const int* sr = (const int*)(SLOT + ((size_t)tok * 7 + k) * D) + lane;
#pragma unroll
            for (int j = 0; j < 4; ++j) { const int w = sr[64 * j]; const f32x2_t a = __builtin_amdgcn_cvt_pk_f32_fp8(w, false), b = __builtin_amdgcn_cvt_pk_f32_fp8(w, true); acc[j].x += a.x; acc[j].y += a.y; acc[j].z += b.x; acc[j].w += b.y; }
        }
        const float* g2 = modv + (size_t)mod_row(tok) * 6144 + 5120;
        u32x2* xr = (u32x2*)x_row(p, tok) + lane;
        f32x4 v[4];
#pragma unroll
        for (int j = 0; j < 4; ++j) { const f32x4 g = *(const f32x4*)(g2 + 4 * lane + 256 * j); const u32x2 a = xr[64 * j];
            v[j] = (f32x4){lo16(a.x), hi16(a.x), lo16(a.y), hi16(a.y)} + g * acc[j]; }
        if (L == 0) {
#pragma unroll
            for (int j = 0; j < 4; ++j) { u32x2 w; w.x = cvtpk(v[j].x, v[j].y); w.y = cvtpk(v[j].z, v[j].w); xr[64 * j] = w; }
            norm_mod_store(p, 1, 0, tok, lane, v, (bf16_t*)(p.ws + WS_H1));
        } else {
            const float* nw = p.in[28]; float s = 0.f;
#pragma unroll
            for (int j = 0; j < 4; ++j) s += v[j].x * v[j].x + v[j].y * v[j].y + v[j].z * v[j].z + v[j].w * v[j].w;
            const float rstd = rsqrtf(wave_sum(s) * (1.f / D) + NORM_EPS);
            f32x4* orow = (f32x4*)(p.out + (size_t)tok * D) + lane;
#pragma unroll
            for (int j = 0; j < 4; ++j) { const f32x4 w4 = *(const f32x4*)(nw + 4 * lane + 256 * j); orow[64 * j] = v[j] * rstd * w4; }
        }
    }
}

constexpr int PH_LAYER0 = 2, PH_PER_LAYER = 8, PH_LAYER1 = PH_LAYER0 + PH_PER_LAYER, NPHASES = PH_LAYER1 + PH_PER_LAYER;

__global__ void __launch_bounds__(NTHREADS, 2) mk_fwd(P p) {
    extern __shared__ __attribute__((aligned(16))) unsigned char lds[];
    volatile LAS unsigned* MISC = (volatile LAS unsigned*)((LAS unsigned char*)lds + MISC_OFF);
    if (threadIdx.x < 64) MISC[threadIdx.x] = 0u;
    __syncthreads();
    unsigned* ctl = (unsigned*)(p.ws + WS_CTL);
    XcdBarrier bar; bar.bar = ctl + CW_BAR; bar.x = 0; bar.st = MISC + 8;
    if (!MK_PER_PHASE) bar = xcd_barrier_post(ctl + CW_BAR, MISC + 8);
    const int lo = p.ph_lo, hi = p.ph_hi;
#ifndef PH_MASK
#define PH_MASK 0xffffu
#endif
#define HAS(b) ((PH_MASK >> (b)) & 1u)
#define IN(k) (lo <= (k) && (k) < hi)
#define SEAM(k) do { if (IN(k) && IN((k) + 1)) xcd_barrier(bar); } while (0)

#ifdef PROBE_MASK
    unsigned long long tacc = 0ull, t0p = 0ull;
#define PT0() t0p = __builtin_amdgcn_s_memrealtime()
#define PT1(b) do { if ((PROBE_MASK >> (b)) & 1u) tacc += __builtin_amdgcn_s_memrealtime() - t0p; } while (0)
#else
#define PT0() do {} while (0)
#define PT1(b) do {} while (0)
#endif
#define PH(b, k, body) do { PT0(); if (HAS(b) && IN(k)) { body; } SEAM(k); PT1(b); } while (0)
    PH(0, 0, phase_prep0(lds, p));
    PH(1, 1, (phase_prep1(lds, p), phase_norm_mod(p, 0, 0, NTOK)));
#define LAYER(L, pb) \
        PH(2, pb + 0, phase_zgemm(lds, p, L)); \
        PH(3, pb + 1, phase_b(lds, p, L)); \
        PH(4, pb + 2, phase_c(lds, p, L)); \
        PH(5, pb + 3, phase_d(lds, p, L)); \
        PH(7, pb + 4, phase_router(lds, p, L)); \
        PH(8, pb + 5, phase_gateup(lds, p, L)); \
        PH(9, pb + 6, phase_down(lds, p, L)); \
        PH(10, pb + 7, phase_combine(p, L));
    LAYER(0, PH_LAYER0)
    LAYER(1, PH_LAYER1)
#ifdef PROBE_MASK
    if (blockIdx.x == 0) {
        const unsigned long long tend = __builtin_amdgcn_s_memrealtime();
        while (__builtin_amdgcn_s_memrealtime() - tend < (unsigned long long)PROBE_AMP * tacc) __builtin_amdgcn_s_sleep(8);
    }
#endif
#undef IN
#undef SEAM
}

extern "C" void kernel_launch(void* const* d_in, const int* in_sizes, int n_in, void* d_out, int out_size, void* d_ws, size_t ws_size, hipStream_t stream) {
    static int grid = 0;
    if (grid == 0) {
        if (n_in != 29 || in_sizes[0] != NLAT * D || out_size != NLAT * D || ws_size < WS_END) {
            fprintf(stderr, "kernel_launch: unexpected shapes / workspace (n_in %d, ws %zu, need %zu); nothing launched\n", n_in, ws_size, (size_t)WS_END); grid = -1; return; }
        int dev = 0, cus = 0, per_cu = 0;
        if (hipGetDevice(&dev) != hipSuccess || hipDeviceGetAttribute(&cus, hipDeviceAttributeMultiprocessorCount, dev) != hipSuccess) { grid = -1; return; }
        if (hipFuncSetAttribute((const void*)mk_fwd, hipFuncAttributeMaxDynamicSharedMemorySize, LDS_BYTES) != hipSuccess) { grid = -1; return; }
        if (hipOccupancyMaxActiveBlocksPerMultiprocessor(&per_cu, (const void*)mk_fwd, NTHREADS, LDS_BYTES) != hipSuccess || per_cu < 1) { fprintf(stderr, "kernel_launch: occupancy query says %d\n", per_cu); }
        (void)hipGetLastError();
        grid = cus;
    }
    if (grid < 0) return;
    (void)hipMemsetAsync((char*)d_ws + WS_CTL, 0, CTL_ZERO_BYTES, stream);
    P a{};
    for (int i = 0; i < 29; ++i) a.in[i] = (const float*)d_in[i];
    a.out = (float*)d_out; a.ws = (unsigned char*)d_ws;
#if MK_PER_PHASE
    for (int ph = 0; ph < NPHASES; ++ph) { a.ph_lo = ph; a.ph_hi = ph + 1; hipLaunchKernelGGL(mk_fwd, dim3(grid), dim3(NTHREADS), LDS_BYTES, stream, a); }
#else
    a.ph_lo = 0; a.ph_hi = NPHASES;
    hipLaunchKernelGGL(mk_fwd, dim3(grid), dim3(NTHREADS), LDS_BYTES, stream, a);
#endif
}
```

```cpp
#include <hip/hip_runtime.h>
#include <cstdio>
#include <cstdint>

#ifndef MK_PER_PHASE
#define MK_PER_PHASE 0
#endif

typedef unsigned short bf16_t;
typedef short bf16x8 __attribute__((ext_vector_type(8)));
typedef float f32x4 __attribute__((ext_vector_type(4)));
typedef unsigned u32x4 __attribute__((ext_vector_type(4)));
typedef unsigned u32x2 __attribute__((ext_vector_type(2)));
typedef float f32x16 __attribute__((ext_vector_type(16)));
typedef short v4i16_t __attribute__((ext_vector_type(4)));
#define LAS __attribute__((address_space(3)))

constexpr int D = 1024, BATCH = 16, SEQ = 2048, CTXL = 256;
constexpr int NLAT = BATCH * SEQ, NCTX = BATCH * CTXL, NTOK = NLAT + NCTX;
constexpr int ZC = 1792;
constexpr int Z_RQ = 512, Z_RK = 640, Z_RV = 768, Z_RG = 1024, Z_CQ = 1280, Z_CKV = 1536, Z_KR = 1664, Z_END = 1696;
constexpr int NEXP = 64, TOPK = 6, EDIM = 256;
constexpr float NORM_EPS = 1e-6f;
constexpr int NTHREADS = 512, NWAVES = 8;

constexpr size_t MiB = 1u << 20;
constexpr size_t WS_CTL = 0, CTL_ZERO_BYTES = 1 * MiB;
constexpr size_t WS_MODV = 1 * MiB;
constexpr size_t WS_ROPE = 2 * MiB;
constexpr size_t WS_WIN = 3 * MiB;
constexpr size_t WS_WUQ = 10 * MiB;
constexpr size_t WS_WUKV = 11 * MiB;
constexpr size_t WS_WOUT = 12 * MiB;
constexpr size_t WS_RT = 16 * MiB;
constexpr size_t WS_SHGU = 17 * MiB;
constexpr size_t WS_SHD = 19 * MiB;
constexpr size_t WS_EGU = 20 * MiB;
constexpr size_t WS_ED = 84 * MiB;
constexpr size_t WS_H1 = 20 * MiB;
constexpr size_t WS_X = 116 * MiB;
constexpr size_t WS_H = 188 * MiB;
constexpr size_t WS_CC = WS_H;
constexpr size_t WS_Z = 260 * MiB;
constexpr size_t WS_Y = WS_Z;
constexpr size_t WS_Q = 386 * MiB;
constexpr size_t WS_K = 440 * MiB;
constexpr size_t WS_V = 494 * MiB;
constexpr size_t WS_KV = 530 * MiB;
constexpr size_t WS_SLOT = 188 * MiB;
constexpr size_t WS_ACT = 441 * MiB;
constexpr size_t WS_LTOK = 583 * MiB;
constexpr size_t WS_LW = 592 * MiB;
constexpr size_t WS_SS = 601 * MiB;
constexpr size_t WS_END = 603 * MiB;
constexpr int LCAP = NTOK;
static_assert(WS_SLOT + ((size_t)NTOK * 7 + 1) * 1024 <= WS_ACT && WS_ACT + (size_t)1136 * 256 * 512 <= WS_LTOK, "MoE buffers");

constexpr int CW_TMO = 0;
constexpr int CW_BAR = 4096;
constexpr int CW_ECNT = 8192;

constexpr int LDS_BYTES = 162816;
constexpr int MISC_OFF = LDS_BYTES - 256;
constexpr int RB0_OFF = 131072;
constexpr int RB1_OFF = 149504;
constexpr int ETAB_OFF = 159744;
constexpr int GEMM_LDS = 36864;
constexpr int ROWSS_OFF = 36864;
constexpr int LG_OFF = 37376;

#define XB_TMO      128
#define XB_XCNT(j)  (256  + 64 * (j))
#define XB_XSUB(j)  (1280 + 64 * (j))
#define XB_XGEN(j)  (2304 + 64 * (j))
#define XB_TOP      3328
#define XB_TOPGEN   3392
#define XCD_BAR_WORDS 3456
#define XB_SPIN_CAP (1u << 24)
__device__ __forceinline__ unsigned xb_ld(unsigned* p)              { return __hip_atomic_load(p, __ATOMIC_RELAXED, __HIP_MEMORY_SCOPE_AGENT); }
__device__ __forceinline__ unsigned xb_add(unsigned* p, unsigned v) { return __hip_atomic_fetch_add(p, v, __ATOMIC_RELAXED, __HIP_MEMORY_SCOPE_AGENT); }
__device__ __forceinline__ unsigned xb_xcc_id() { return (unsigned)__builtin_amdgcn_s_getreg((3 << 11) | 20) & 0xFu; }
#define XB_SPIN(cond, bar) do { unsigned _sp = 0; while (cond) { __builtin_amdgcn_s_sleep(1); \
    if ((++_sp & 255u) == 0u) { if (xb_ld(&(bar)[XB_TMO])) break; if (_sp > XB_SPIN_CAP) { atomicAdd(&(bar)[XB_TMO], 1u); break; } } } } while (0)
struct XcdBarrier { unsigned* bar; unsigned x; volatile LAS unsigned* st; };
__device__ __forceinline__ XcdBarrier xcd_barrier_post(unsigned* bar, volatile LAS unsigned* st) {
    XcdBarrier b; b.bar = bar; b.x = xb_xcc_id(); b.st = st;
    if (threadIdx.x == 0) (void)xb_add(&bar[XB_XCNT(b.x)], 1u);
    return b;
}
__device__ __forceinline__ void xcd_barrier_complete(unsigned* bar, unsigned x, unsigned& nloc, unsigned& nx) {
    const unsigned G = gridDim.x * gridDim.y * gridDim.z;
    unsigned sum, cnt, mine, sp = 0u;
    for (;;) {
        sum = 0u; cnt = 0u; mine = 0u;
#pragma unroll
        for (unsigned j = 0; j < 16; ++j) { const unsigned c = xb_ld(&bar[XB_XCNT(j)]); sum += c; cnt += (c > 0u) ? 1u : 0u; mine = (j == x) ? c : mine; }
        if (sum == G) break;
        __builtin_amdgcn_s_sleep(1);
        if ((++sp & 255u) == 0u) { if (xb_ld(&bar[XB_TMO])) break; if (sp > XB_SPIN_CAP) { atomicAdd(&bar[XB_TMO], 1u); break; } }
    }
    nloc = mine > 0u ? mine : 1u; nx = cnt > 0u ? cnt : 1u;
}
__device__ __forceinline__ void xcd_barrier(const XcdBarrier& b) {
    asm volatile("s_waitcnt vmcnt(0)" ::: "memory");
    __syncthreads();
    if (threadIdx.x == 0) {
        unsigned* bar = b.bar;
        __builtin_amdgcn_s_waitcnt(0);
        unsigned nloc = b.st[0], nx = b.st[1];
        if (nloc == 0u) { xcd_barrier_complete(bar, b.x, nloc, nx); b.st[0] = nloc; b.st[1] = nx; }
        const unsigned old = xb_add(&bar[XB_XSUB(b.x)], 1u);
        const unsigned gen = old / nloc;
        if (old + 1u == (gen + 1u) * nloc) {
            __builtin_amdgcn_fence(__ATOMIC_RELEASE, "agent");
            asm volatile("s_waitcnt vmcnt(0)" ::: "memory");
            const unsigned og = xb_add(&bar[XB_TOP], 1u);
            const unsigned tg = og / nx;
            if (og + 1u == (tg + 1u) * nx) xb_add(&bar[XB_TOPGEN], 1u);
            else XB_SPIN(xb_ld(&bar[XB_TOPGEN]) == tg, bar);
            __builtin_amdgcn_fence(__ATOMIC_ACQUIRE, "agent");
            xb_add(&bar[XB_XGEN(b.x)], 1u);
            asm volatile("s_waitcnt vmcnt(0)" ::: "memory");
        } else {
            XB_SPIN(xb_ld(&bar[XB_XGEN(b.x)]) == gen, bar);
            __builtin_amdgcn_fence(__ATOMIC_ACQUIRE, "agent");
            asm volatile("s_waitcnt vmcnt(0)" ::: "memory");
        }
    }
    __syncthreads();
}

__device__ __forceinline__ float bf2f(unsigned h) { return __uint_as_float(h << 16); }
__device__ __forceinline__ unsigned f2bf(float f) { unsigned u = __float_as_uint(f); return (u + 0x7fffu + ((u >> 16) & 1u)) >> 16; }
__device__ __forceinline__ unsigned pk2(float lo, float hi) { return f2bf(lo) | (f2bf(hi) << 16); }
typedef float f32x2_t __attribute__((ext_vector_type(2)));
typedef __bf16 bf16x2_t __attribute__((ext_vector_type(2)));
__device__ __forceinline__ unsigned cvtpk(float lo, float hi) { f32x2_t v = {lo, hi}; bf16x2_t b = __builtin_convertvector(v, bf16x2_t); return __builtin_bit_cast(unsigned, b); }
__device__ __forceinline__ float lo16(unsigned w) { return __uint_as_float(w << 16); }
__device__ __forceinline__ float hi16(unsigned w) { return __uint_as_float(w & 0xffff0000u); }
__device__ __forceinline__ float wave_sum(float v) {
#pragma unroll
    for (int o = 1; o < 64; o <<= 1) v += __shfl_xor(v, o);
    return v;
}
__device__ __forceinline__ float siluf(float v) { return v * __builtin_amdgcn_rcpf(1.f + __expf(-v)); }
__device__ __forceinline__ int mod_row(int tok) { return tok < NLAT ? (tok >> 11) : 16; }

struct P { const float* in[29]; float* out; unsigned char* ws; int ph_lo, ph_hi; };

__device__ __forceinline__ bf16_t* x_row(const P& p, int tok) { return (bf16_t*)(p.ws + WS_X) + (size_t)tok * D; }
__device__ __forceinline__ const float* x_in_row(const P& p, int tok) {
    return tok < NLAT ? p.in[0] + (size_t)tok * D : p.in[2] + (size_t)(tok - NLAT) * D;
}

template <int MF, class RowSrc, class Epi>
__device__ __forceinline__ void gemm_tile(unsigned char* lds, const RowSrc& rs, const bf16_t* Bt, int ldb, int K, const Epi& epi) {
    constexpr int ROWS = 32 * MF, NPA = ROWS * 8;
    const int tid = threadIdx.x, lane = tid & 63, wid = tid >> 6, wr = wid >> 2, wc = wid & 3, fr = lane & 15, fq = lane >> 4;
    bf16_t* As = (bf16_t*)lds; bf16_t* Bs = As + ROWS * 72;
    const bf16_t* ap[3]; int al[3];
#pragma unroll
    for (int i = 0; i < 3; ++i) { const int id = tid + 512 * i, r = id >> 3, c = (id & 7) * 8; ap[i] = (id < NPA) ? rs(r) + c : nullptr; al[i] = r * 72 + c; }
    const int lr = tid >> 2, lc = (tid & 3) * 16;
    const bf16_t* bp = Bt + (size_t)lr * ldb + lc;
    u32x4 a[3], b0 = *(const u32x4*)bp, b1 = *(const u32x4*)(bp + 8);
#pragma unroll
    for (int i = 0; i < 3; ++i) if (ap[i]) a[i] = *(const u32x4*)ap[i];
    f32x4 acc[MF][2];
#pragma unroll
    for (int m = 0; m < MF; ++m)
#pragma unroll
        for (int n = 0; n < 2; ++n) acc[m][n] = (f32x4){0.f, 0.f, 0.f, 0.f};
    for (int k0 = 0; k0 < K; k0 += 64) {
        __syncthreads();
#pragma unroll
        for (int i = 0; i < 3; ++i) if (ap[i]) *(u32x4*)(As + al[i]) = a[i];
        *(u32x4*)(Bs + lr * 72 + lc) = b0; *(u32x4*)(Bs + lr * 72 + lc + 8) = b1;
        __syncthreads();
        if (k0 + 64 < K) {
#pragma unroll
            for (int i = 0; i < 3; ++i) if (ap[i]) { ap[i] += 64; a[i] = *(const u32x4*)ap[i]; }
            bp += 64; b0 = *(const u32x4*)bp; b1 = *(const u32x4*)(bp + 8);
        }
#pragma unroll
        for (int kk = 0; kk < 2; ++kk) {
            bf16x8 af[MF], bfr[2];
#pragma unroll
            for (int m = 0; m < MF; ++m) af[m] = *(const bf16x8*)(As + (wr * 16 * MF + m * 16 + fr) * 72 + kk * 32 + fq * 8);
#pragma unroll
            for (int n = 0; n < 2; ++n) bfr[n] = *(const bf16x8*)(Bs + (wc * 32 + n * 16 + fr) * 72 + kk * 32 + fq * 8);
#pragma unroll
            for (int m = 0; m < MF; ++m)
#pragma unroll
                for (int n = 0; n < 2; ++n) acc[m][n] = __builtin_amdgcn_mfma_f32_16x16x32_bf16(bfr[n], af[m], acc[m][n], 0, 0, 0);
        }
    }
#pragma unroll
    for (int m = 0; m < MF; ++m)
#pragma unroll
        for (int n = 0; n < 2; ++n) epi(wr * 16 * MF + m * 16 + fr, wc * 32 + n * 16 + 4 * fq, acc[m][n]);
}

namespace ge {
constexpr int BM = 256, BK = 64, HALF = 128, HTB = HALF * BK * 2;
__device__ __forceinline__ int lds_byte(int r, int c) { const int st = (r >> 4) * 2 + (c >> 5), rr = r & 15, cc = c & 31, ob = rr * 64 + cc * 2; return st * 1024 + (ob ^ (((ob >> 9) & 1) << 5)); }
__device__ __forceinline__ void stage_rc(int b, int& R, int& C) { const int st = b / 1024, sb = b % 1024, swz = sb ^ (((sb >> 9) & 1) << 5); R = (st >> 1) * 16 + swz / 64; C = (st & 1) * 32 + (swz % 64) / 2; }
struct Unit { const char* B; int a, b, c, d; };
typedef f32x4 Acc[2][2][4][2];

template <class Sched, class Epi, bool ALIGN_EPI>
__device__ __forceinline__ void gemm_stream(LAS unsigned char* lds, const char* Ab, int K, const Sched& S, const Epi& E) {
    const int tid = threadIdx.x, wid = __builtin_amdgcn_readfirstlane(tid >> 6), lane = tid & 63, wr = wid >> 2, wc = wid & 3, fr = lane & 15, fq = lane >> 4;
    const int nt = K / BK;
    int Rr[2], Cc[2]; unsigned voffB[2];
#pragma unroll
    for (int i = 0; i < 2; ++i) { stage_rc(tid * 16 + i * 8192, Rr[i], Cc[i]);
        const int rho = Rr[i] & 31, Rb = (Rr[i] & ~31) + 8 * ((rho & 15) >> 2) + 4 * (rho >> 4) + (rho & 3);
        voffB[i] = (unsigned)(Rb * K + Cc[i]) * 2u; }
    const size_t kstep = (size_t)(BK * 2), hstepB = (size_t)HALF * K * 2;
    const unsigned ldsw = (unsigned)wid * 1024u;
    const int aoff = lds_byte(wr * 64 + fr, fq * 8), boff = lds_byte(wc * 32 + fr, fq * 8);
#define GE_SA(b, h) (((b) * 2 + (h)) * HTB)
#define GE_SB(b, h) ((4 + (b) * 2 + (h)) * HTB)
#define GE_GLDS(gp, ldsoff) __builtin_amdgcn_global_load_lds((const unsigned*)(gp), (LAS unsigned*)(lds + (ldsoff)), 16, 0, 0)
#define GE_STAGE_B(bufoff, gbase) do { GE_GLDS((const char*)(gbase) + voffB[0], (bufoff) + ldsw); GE_GLDS((const char*)(gbase) + voffB[1], (bufoff) + ldsw + 8192); } while (0)
#define GE_STAGE_A(bufoff, kbytes, o0, o1) do { GE_GLDS(Ab + (kbytes) + (o0), (bufoff) + ldsw); GE_GLDS(Ab + (kbytes) + (o1), (bufoff) + ldsw + 8192); } while (0)
#define GE_LDA(dst, b, h) do { _Pragma("unroll") for (int m = 0; m < 4; ++m) _Pragma("unroll") for (int k = 0; k < 2; ++k) dst[m][k] = *(const LAS bf16x8*)(lds + GE_SA(b, h) + aoff + m * 2048 + k * 1024); } while (0)
#define GE_LDB(dst, b, h) do { _Pragma("unroll") for (int n = 0; n < 2; ++n) _Pragma("unroll") for (int k = 0; k < 2; ++k) dst[n][k] = *(const LAS bf16x8*)(lds + GE_SB(b, h) + boff + n * 2048 + k * 1024); } while (0)
#define GE_MMA(ai, bj, At, Bt) do { __builtin_amdgcn_s_setprio(1); _Pragma("unroll") for (int m = 0; m < 4; ++m) _Pragma("unroll") for (int n = 0; n < 2; ++n) _Pragma("unroll") for (int k = 0; k < 2; ++k) \
        acc[ai][bj][m][n] = __builtin_amdgcn_mfma_f32_16x16x32_bf16(Bt[n][k], At[m][k], acc[ai][bj][m][n], 0, 0, 0); __builtin_amdgcn_s_setprio(0); } while (0)
#define GE_WAIT_V(n) asm volatile("s_waitcnt vmcnt(" #n ")" ::: "memory")
#define GE_WAIT_L(n) asm volatile("s_waitcnt lgkmcnt(" #n ")" ::: "memory")
#define GE_BAR __builtin_amdgcn_s_barrier()
#define GE_SCHED __builtin_amdgcn_sched_barrier(0)
    Unit cur, nxt; int ui = 0;
    if (!S.next(0, cur)) return;
    Acc acc;
#pragma unroll
    for (int a = 0; a < 2; ++a)
#pragma unroll
        for (int b = 0; b < 2; ++b)
#pragma unroll
            for (int m = 0; m < 4; ++m)
#pragma unroll
                for (int n = 0; n < 2; ++n) acc[a][b][m][n] = (f32x4){0.f, 0.f, 0.f, 0.f};
    bf16x8 At[4][2], B0[2][2], B1[2][2];
    unsigned oc00, oc01, oc10, oc11, on00, on01, on10, on11;
    oc00 = S.aoff(0, cur, Rr[0]) + (unsigned)Cc[0] * 2u; oc01 = S.aoff(0, cur, Rr[1]) + (unsigned)Cc[1] * 2u;
    oc10 = S.aoff(0, cur, Rr[0] + 128) + (unsigned)Cc[0] * 2u; oc11 = S.aoff(0, cur, Rr[1] + 128) + (unsigned)Cc[1] * 2u;
    const char* cB = cur.B;
    GE_STAGE_B(GE_SB(0, 0), cB); GE_STAGE_B(GE_SB(0, 1), cB + hstepB); GE_STAGE_A(GE_SA(0, 0), 0, oc00, oc01); GE_STAGE_A(GE_SA(0, 1), 0, oc10, oc11);
    if (wr == 1) GE_BAR;
    GE_WAIT_V(2); GE_BAR;
    GE_STAGE_B(GE_SB(1, 0), cB + kstep); GE_STAGE_A(GE_SA(1, 0), kstep, oc00, oc01); GE_STAGE_B(GE_SB(1, 1), cB + hstepB + kstep);
    GE_WAIT_V(6); GE_BAR;
    for (;;) {
        const bool has_next = S.next(ui + 1, nxt);
        const char* nB = has_next ? nxt.B : cB;
        if (has_next) {
            on00 = S.aoff(ui + 1, nxt, Rr[0]) + (unsigned)Cc[0] * 2u; on01 = S.aoff(ui + 1, nxt, Rr[1]) + (unsigned)Cc[1] * 2u;
            on10 = S.aoff(ui + 1, nxt, Rr[0] + 128) + (unsigned)Cc[0] * 2u; on11 = S.aoff(ui + 1, nxt, Rr[1] + 128) + (unsigned)Cc[1] * 2u;
        } else { on00 = oc00; on01 = oc01; on10 = oc10; on11 = oc11; }
#pragma unroll 1
        for (int t = 0; t < nt; t += 2) {
            const bool last = (t == nt - 2);
            const size_t k1 = (size_t)(t + 1) * kstep;
            const size_t k2 = last ? 0 : (size_t)(t + 2) * kstep, k3 = k2 + kstep;
            const char* b2 = last ? nB : cB + (size_t)(t + 2) * kstep; const char* b3 = b2 + kstep;
            const unsigned o00 = last ? on00 : oc00, o01 = last ? on01 : oc01, o10 = last ? on10 : oc10, o11 = last ? on11 : oc11;
            GE_LDB(B0, 0, 0); GE_LDB(B1, 0, 1); GE_SCHED; GE_LDA(At, 0, 0); GE_STAGE_A(GE_SA(1, 1), k1, oc10, oc11);
            GE_WAIT_V(8); GE_WAIT_L(0); GE_BAR; GE_MMA(0, 0, At, B0); GE_MMA(0, 1, At, B1); GE_BAR; GE_SCHED;
            GE_LDA(At, 0, 1); GE_STAGE_B(GE_SB(0, 0), b2); GE_STAGE_B(GE_SB(0, 1), b2 + hstepB); GE_STAGE_A(GE_SA(0, 0), k2, o00, o01);
            GE_WAIT_V(8); GE_WAIT_L(0); GE_BAR; GE_MMA(1, 0, At, B0); GE_MMA(1, 1, At, B1); GE_BAR; GE_SCHED;
            GE_LDB(B0, 1, 0); GE_LDB(B1, 1, 1); GE_SCHED; GE_LDA(At, 1, 0); GE_STAGE_A(GE_SA(0, 1), k2, o10, o11);
            GE_WAIT_V(8); GE_WAIT_L(0); GE_BAR; GE_MMA(0, 0, At, B0); GE_MMA(0, 1, At, B1); GE_BAR; GE_SCHED;
            GE_LDA(At, 1, 1); GE_STAGE_B(GE_SB(1, 0), b3); GE_STAGE_B(GE_SB(1, 1), b3 + hstepB); GE_STAGE_A(GE_SA(1, 0), k3, o00, o01);
            GE_WAIT_V(8); GE_WAIT_L(0); GE_BAR; GE_MMA(1, 0, At, B0); GE_MMA(1, 1, At, B1); GE_BAR; GE_SCHED;
        }
        if constexpr (ALIGN_EPI) { if (wr == 0) GE_BAR; }
        E(acc, cur, wr, wc, fr, fq);
        if (!has_next) break;
#pragma unroll
        for (int a = 0; a < 2; ++a)
#pragma unroll
            for (int b = 0; b < 2; ++b)
#pragma unroll
                for (int m = 0; m < 4; ++m)
#pragma unroll
                    for (int n = 0; n < 2; ++n) acc[a][b][m][n] = (f32x4){0.f, 0.f, 0.f, 0.f};
        cur = nxt; cB = nB; ++ui; oc00 = on00; oc01 = on01; oc10 = on10; oc11 = on11;
        if constexpr (ALIGN_EPI) { if (wr == 1) GE_BAR; }
    }
    GE_WAIT_V(0);
    if constexpr (!ALIGN_EPI) { if (wr == 0) GE_BAR; }
    GE_BAR;
#undef GE_SA
#undef GE_SB
#undef GE_GLDS
#undef GE_STAGE_A
#undef GE_STAGE_B
#undef GE_LDA
#undef GE_LDB
#undef GE_MMA
#undef GE_WAIT_V
#undef GE_WAIT_L
#undef GE_BAR
#undef GE_SCHED
}
template <class F> struct EpiFn {
    F f;
    __device__ __forceinline__ void operator()(const Acc& acc, const Unit& u, int wr, int wc, int fr, int fq) const {
#pragma unroll
        for (int ai = 0; ai < 2; ++ai)
#pragma unroll
            for (int m = 0; m < 4; ++m)
#pragma unroll
                for (int bj = 0; bj < 2; ++bj) f(u, ai * 128 + wr * 64 + m * 16 + fr, bj * 128 + wc * 32 + 8 * fq, acc[ai][bj][m][0], acc[ai][bj][m][1]);
    }
};
struct DenseOrder {
    int nM, nN, nwg, G, c; const char* Bt; size_t btile; unsigned arow;
    __device__ __forceinline__ bool next(int i, Unit& u) const {
        const long L = (long)i * G + c; if (L >= nwg) return false;
        int wgid = (int)L; { const int q = nwg / 8, r = nwg % 8, xcd = wgid % 8, off = wgid / 8; wgid = (xcd < r ? xcd * (q + 1) : r * (q + 1) + (xcd - r) * q) + off; }
        const int nig = 8 * nN, gid = wgid / nig, fm = gid * 8, gsz = (nM - fm) < 8 ? (nM - fm) : 8;
        u.a = fm + ((wgid % nig) % gsz); u.b = (wgid % nig) / gsz; u.c = 0; u.d = 0; u.B = Bt + (size_t)u.b * btile; return true;
    }
    __device__ __forceinline__ unsigned aoff(int, const Unit& u, int R) const { return (unsigned)(u.a * 256 + R) * arow; }
};
}

struct TMap { const float* s0; const float* s1; int ld; int nvalid; const float* ksc; float gsc; };
template <int MODE> __device__ __forceinline__ const float* tmap_src(const float* s0, const float* s1, int nvalid, int n) {
    if (MODE == 0) return n < nvalid ? s0 + n : nullptr;
    if (MODE == 1) { const int h = n / 96, j = n % 96; const int c = j < 64 ? j : 64 + ((j - 64) & 1) * 16 + ((j - 64) >> 1); return s0 + h * 96 + c; }
    return ((n & 1) ? s1 : s0) + (n >> 1);
}
template <int MODE> __device__ __forceinline__ void transpose_unit(float* scr, const float* s0, const float* s1, int ld, int nvalid, const float* ksc, float gsc, int K, bf16_t* dst, int kb, int nb, int kvalid = 1 << 30) {
    const int tid = threadIdx.x, k0 = kb * 64, n0 = nb * 64;
    const int nn = tid & 63; const float* sp = tmap_src<MODE>(s0, s1, nvalid, n0 + nn);
#pragma unroll
    for (int i = 0; i < 8; ++i) {
        const int kk = (tid >> 6) + 8 * i; float v = (sp && k0 + kk < kvalid) ? sp[(size_t)(k0 + kk) * ld] : 0.f;
        if (ksc && k0 + kk < kvalid) v *= ksc[k0 + kk];
        scr[kk * 65 + nn] = v * gsc;
    }
    __syncthreads();
    {
        const int n2 = tid >> 3, kc = tid & 7; const float* s = scr + (kc * 8) * 65 + n2;
        u32x4 o; o.x = pk2(s[0], s[65]); o.y = pk2(s[2 * 65], s[3 * 65]); o.z = pk2(s[4 * 65], s[5 * 65]); o.w = pk2(s[6 * 65], s[7 * 65]);
        *(u32x4*)(dst + (size_t)(n0 + n2) * K + k0 + kc * 8) = o;
    }
    __syncthreads();
}
template <int MODE> __device__ __forceinline__ void transpose_matrix(float* scr, const float* s0, const float* s1, int ld, int nvalid, const float* ksc, float gsc, int K, int Nd, bf16_t* dst, int& rot, int kvalid = 1 << 30) {
    const int nkb = K / 64, nnb = Nd / 64, nu = nkb * nnb, G = gridDim.x;
    int first = ((int)blockIdx.x - rot) % G; if (first < 0) first += G;
    for (int u = first; u < nu; u += G) transpose_unit<MODE>(scr, s0, s1, ld, nvalid, ksc, gsc, K, dst, u / nnb, u % nnb, kvalid);
    rot = (rot + nu) % G;
}
__device__ __forceinline__ void convert_expert_weights(unsigned char* lds, const P& p, int L) {
    float* scr = (float*)lds; const int G = gridDim.x, tid = threadIdx.x;
    constexpr int S = 261;
    bf16_t* egu = (bf16_t*)(p.ws + WS_EGU); bf16_t* ed = (bf16_t*)(p.ws + WS_ED);
    for (int ub = blockIdx.x; ub < NEXP * 48; ub += G) {
        const int e = ub / 48, r = (ub % 48) * 4;
        bf16_t* dst; int K, k0;
        if (r < 128) {
            const int kb = r >> 3, nb0 = r & 7; k0 = kb * 64; K = D; dst = egu + ((size_t)e * 512 + nb0 * 64) * D;
            const float* gsrc = p.in[22] + ((size_t)L * NEXP + e) * D * EDIM + nb0 * 32; const float* usrc = p.in[23] + ((size_t)L * NEXP + e) * D * EDIM + nb0 * 32;
            f32x4 v[8];
#pragma unroll
            for (int i = 0; i < 8; ++i) { const int idx = tid + 512 * i, kk = idx >> 6, c = idx & 63; v[i] = *(const f32x4*)((c < 32 ? gsrc : usrc) + (size_t)(k0 + kk) * EDIM + (c & 31) * 4); }
#pragma unroll
            for (int i = 0; i < 8; ++i) { const int idx = tid + 512 * i, kk = idx >> 6, c = idx & 63; float* d = scr + kk * S + 8 * (c & 31) + (c >> 5);
                d[0] = v[i].x; d[2] = v[i].y; d[4] = v[i].z; d[6] = v[i].w; }
        } else {
            const int r2 = r - 128, kb = r2 >> 4, nb0 = r2 & 15; k0 = kb * 64; K = EDIM; dst = ed + ((size_t)e * D + nb0 * 64) * EDIM;
            const float* src = p.in[24] + ((size_t)L * NEXP + e) * EDIM * D + nb0 * 64;
            f32x4 v[8];
#pragma unroll
            for (int i = 0; i < 8; ++i) { const int idx = tid + 512 * i, kk = idx >> 6, c = idx & 63; v[i] = *(const f32x4*)(src + (size_t)(k0 + kk) * D + c * 4); }
#pragma unroll
            for (int i = 0; i < 8; ++i) { const int idx = tid + 512 * i, kk = idx >> 6, c = idx & 63; float* d = scr + kk * S + 4 * c;
                d[0] = v[i].x; d[1] = v[i].y; d[2] = v[i].z; d[3] = v[i].w; }
        }
        __syncthreads();
#pragma unroll
        for (int i = 0; i < 4; ++i) {
            const int id = tid + 512 * i, n = id >> 3, kc = id & 7; const float* sp = scr + (kc * 8) * S + n;
            u32x4 o; o.x = cvtpk(sp[0], sp[S]); o.y = cvtpk(sp[2 * S], sp[3 * S]); o.z = cvtpk(sp[4 * S], sp[5 * S]); o.w = cvtpk(sp[6 * S], sp[7 * S]);
            *(u32x4*)(dst + (size_t)n * K + k0 + kc * 8) = o;
        }
        __syncthreads();
    }
}
__device__ __forceinline__ void prep_mod_unit(unsigned char* lds, const P& p, int u) {
    float* sc = (float*)lds;
    float* part = sc + 17 * 1024;
    const int tid = threadIdx.x;
    const float* c = p.in[1]; const float* cctx = p.in[3];
    for (int i = tid; i < 17 * 1024; i += NTHREADS) { const int r = i >> 10, k = i & 1023; const float v = r < 16 ? c[r * 1024 + k] : cctx[k]; sc[i] = v * __builtin_amdgcn_rcpf(1.f + __expf(-v)); }
    __syncthreads();
    const int L = u / 192, cg = u % 192, ks = tid >> 5, cl = tid & 31, col = cg * 32 + cl;
    const float* w = p.in[4] + (size_t)L * 1024 * 6144 + (size_t)(ks * 64) * 6144 + col;
    float acc[17];
#pragma unroll
    for (int r = 0; r < 17; ++r) acc[r] = 0.f;
#pragma unroll 8
    for (int k = 0; k < 64; ++k) {
        const float wv = w[(size_t)k * 6144];
#pragma unroll
        for (int r = 0; r < 17; ++r) acc[r] += sc[r * 1024 + ks * 64 + k] * wv;
    }
#pragma unroll
    for (int r = 0; r < 17; ++r) part[(ks * 17 + r) * 32 + cl] = acc[r];
    __syncthreads();
    float* modv = (float*)(p.ws + WS_MODV);
    for (int i = tid; i < 17 * 32; i += NTHREADS) {
        const int r = i >> 5, c2 = i & 31;
        float s2 = p.in[5][L * 6144 + cg * 32 + c2];
#pragma unroll
        for (int q = 0; q < 16; ++q) s2 += part[(q * 17 + r) * 32 + c2];
        modv[((size_t)L * 17 + r) * 6144 + cg * 32 + c2] = s2;
    }
    __syncthreads();
}
__device__ __forceinline__ void phase_prep0(unsigned char* lds, const P& p) {
    const int tid = threadIdx.x, G = gridDim.x, bid = blockIdx.x;
    {
        float* ct = (float*)(p.ws + WS_ROPE); float* st = ct + 2048 * 16;
        for (int i = bid * NTHREADS + tid; i < 2048 * 16; i += G * NTHREADS) {
            const int pos = i >> 4, f = i & 15;
            const float inv = powf(10000.f, -(float)(f & 7) / 8.f);
            const float ang = (float)(f < 8 ? (pos >> 6) : (pos & 63)) * inv;
            ct[i] = cosf(ang); st[i] = sinf(ang);
        }
    }
    for (int u = bid; u < 384; u += G) prep_mod_unit(lds, p, u);
}
__device__ __forceinline__ void phase_prep1(unsigned char* lds, const P& p) {
    float* scr = (float*)lds; int rot = 0;
    for (int L = 0; L < 2; ++L) {
        transpose_matrix<0>(scr, p.in[7] + (size_t)L * D * Z_END, nullptr, Z_END, Z_END, nullptr, 1.f, D, ZC, (bf16_t*)(p.ws + WS_WIN) + (size_t)L * ZC * D, rot);
        transpose_matrix<1>(scr, p.in[15] + (size_t)L * 256 * 768, nullptr, 768, 768, p.in[14] + L * 256, 0.14724574f, 256, 768, (bf16_t*)(p.ws + WS_WUQ) + (size_t)L * 768 * 256, rot);
        transpose_matrix<0>(scr, p.in[17] + (size_t)L * 128 * 1024, nullptr, 1024, 1024, p.in[16] + L * 128, 1.f, 256, 1024, (bf16_t*)(p.ws + WS_WUKV) + (size_t)L * 1024 * 256, rot, 128);
        transpose_matrix<0>(scr, p.in[18] + (size_t)L * D * D, nullptr, D, D, nullptr, 1.f, D, D, (bf16_t*)(p.ws + WS_WOUT) + (size_t)L * D * D, rot);
        transpose_matrix<0>(scr, p.in[20] + (size_t)L * D * NEXP, nullptr, NEXP, NEXP, nullptr, 1.f, D, 128, (bf16_t*)(p.ws + WS_RT) + (size_t)L * 128 * D, rot);
        transpose_matrix<2>(scr, p.in[25] + (size_t)L * D * EDIM, p.in[26] + (size_t)L * D * EDIM, EDIM, 512, nullptr, 1.f, D, 512, (bf16_t*)(p.ws + WS_SHGU) + (size_t)L * 512 * D, rot);
        transpose_matrix<0>(scr, p.in[27] + (size_t)L * EDIM * D, nullptr, D, D, nullptr, 1.f, EDIM, D, (bf16_t*)(p.ws + WS_SHD) + (size_t)L * D * EDIM, rot);
    }
}

__device__ __forceinline__ void phase_norm_mod(const P& p, int L, int which  , int ntok) {
    const int tid = threadIdx.x, lane = tid & 63, wave = tid >> 6, gw = blockIdx.x * NWAVES + wave, NGW = gridDim.x * NWAVES;
    const float* nw = (which == 0 ? p.in[6] : p.in[19]) + L * D;
    const float* modv = (const float*)(p.ws + WS_MODV) + (size_t)L * 17 * 6144;
    bf16_t* H = (bf16_t*)(p.ws + WS_H);
    for (int tok = gw; tok < ntok; tok += NGW) {
        const f32x4* xr = (const f32x4*)x_in_row(p, tok) + lane;
        const float* mrow = modv + (size_t)mod_row(tok) * 6144 + which * 3072;
        f32x4 v[4]; float s = 0.f;
#pragma unroll
        for (int j = 0; j < 4; ++j) { v[j] = xr[64 * j]; s += v[j].x * v[j].x + v[j].y * v[j].y + v[j].z * v[j].z + v[j].w * v[j].w; }
        const float rstd = rsqrtf(wave_sum(s) * (1.f / D) + NORM_EPS);
        u32x2* o = (u32x2*)(H + (size_t)tok * D) + lane;
#pragma unroll
        for (int j = 0; j < 4; ++j) {
            const int k = 4 * lane + 256 * j;
            const f32x4 w4 = *(const f32x4*)(nw + k), sh = *(const f32x4*)(mrow + k), sc = *(const f32x4*)(mrow + 1024 + k);
            const float y0 = v[j].x * rstd * w4.x * (1.f + sc.x) + sh.x, y1 = v[j].y * rstd * w4.y * (1.f + sc.y) + sh.y;
            const float y2 = v[j].z * rstd * w4.z * (1.f + sc.z) + sh.z, y3 = v[j].w * rstd * w4.w * (1.f + sc.w) + sh.w;
            u32x2 w; w.x = pk2(y0, y1); w.y = pk2(y2, y3); o[64 * j] = w;
        }
    }
}

struct EpiZ {
    bf16_t* Z; float* ssq; float* sskv; bf16_t* Kb; const float* ct; const float* st;
    __device__ __forceinline__ void operator()(const ge::Acc& acc, const ge::Unit& u, int wr, int wc, int fr, int fq) const {
#pragma unroll
        for (int ai = 0; ai < 2; ++ai)
#pragma unroll
            for (int m = 0; m < 4; ++m) {
                const int row = u.a * 256 + ai * 128 + wr * 64 + m * 16 + fr;
#pragma unroll
                for (int bj = 0; bj < 2; ++bj) {
                    const f32x4 v0 = acc[ai][bj][m][0], v1 = acc[ai][bj][m][1];
                    u32x4 w; w.x = cvtpk(v0.x, v0.y); w.y = cvtpk(v0.z, v0.w); w.z = cvtpk(v1.x, v1.y); w.w = cvtpk(v1.z, v1.w);
                    *(u32x4*)(Z + (size_t)row * ZC + u.b * 256 + bj * 128 + wc * 32 + 8 * fq) = w;
                }
                if (u.b == 5) {
                    float sq = 0.f;
#pragma unroll
                    for (int bj = 0; bj < 2; ++bj)
#pragma unroll
                        for (int n = 0; n < 2; ++n) { const f32x4 v = acc[ai][bj][m][n]; sq += v.x * v.x + v.y * v.y + v.z * v.z + v.w * v.w; }
                    sq += __shfl_xor(sq, 16); sq += __shfl_xor(sq, 32);
                    if (fq == 0) ssq[(size_t)row * 4 + wc] = sq;
                }
                if (u.b == 6) {
                    float sq = 0.f;
#pragma unroll
                    for (int n = 0; n < 2; ++n) { const f32x4 v = acc[ai][0][m][n]; sq += v.x * v.x + v.y * v.y + v.z * v.z + v.w * v.w; }
                    sq += __shfl_xor(sq, 16); sq += __shfl_xor(sq, 32);
                    if (fq == 0) sskv[(size_t)row * 4 + wc] = sq;
                    if (wc == 0) {
                        const f32x4 a0 = acc[ai][1][m][0], a1 = acc[ai][1][m][1];
                        f32x4 b0, b1;
#pragma unroll
                        for (int j = 0; j < 4; ++j) { b0[j] = __shfl_xor(a0[j], 32); b1[j] = __shfl_xor(a1[j], 32); }
                        if (fq < 2) {
                            f32x4 c0 = (f32x4){1.f, 1.f, 1.f, 1.f}, c1 = c0, s0 = (f32x4){0.f, 0.f, 0.f, 0.f}, s1 = s0;
                            if (row < NLAT) { const int pos = row & (SEQ - 1); c0 = *(const f32x4*)(ct + pos * 16 + 8 * fq); c1 = *(const f32x4*)(ct + pos * 16 + 8 * fq + 4); s0 = *(const f32x4*)(st + pos * 16 + 8 * fq); s1 = *(const f32x4*)(st + pos * 16 + 8 * fq + 4); }
                            const f32x4 o10 = a0 * c0 - b0 * s0, o20 = a0 * s0 + b0 * c0, o11 = a1 * c1 - b1 * s1, o21 = a1 * s1 + b1 * c1;
                            u32x4 w0, w1; w0.x = cvtpk(o10.x, o20.x); w0.y = cvtpk(o10.y, o20.y); w0.z = cvtpk(o10.z, o20.z); w0.w = cvtpk(o10.w, o20.w);
                            w1.x = cvtpk(o11.x, o21.x); w1.y = cvtpk(o11.y, o21.y); w1.z = cvtpk(o11.z, o21.z); w1.w = cvtpk(o11.w, o21.w);
#pragma unroll
                            for (int h = 0; h < 8; ++h) { bf16_t* kp = Kb + (size_t)row * 768 + h * 96 + 64 + 16 * fq; *(u32x4*)kp = w0; *(u32x4*)(kp + 8) = w1; }
                        }
                    }
                }
            }
    }
};
__device__ __forceinline__ void phase_zgemm(unsigned char* lds, const P& p, int L) {
    const bf16_t* W = (const bf16_t*)(p.ws + WS_WIN) + (size_t)L * ZC * D;
    ge::DenseOrder S; S.nM = NTOK / 256; S.nN = ZC / 256; S.nwg = S.nM * S.nN; S.G = gridDim.x; S.c = blockIdx.x; S.Bt = (const char*)W; S.btile = (size_t)256 * D * 2; S.arow = D * 2;
    EpiZ E{(bf16_t*)(p.ws + WS_Z), (float*)(p.ws + WS_SS), (float*)(p.ws + WS_SS) + (size_t)NTOK * 4, (bf16_t*)(p.ws + WS_K), (const float*)(p.ws + WS_ROPE), (const float*)(p.ws + WS_ROPE) + 2048 * 16};
    ge::gemm_stream<ge::DenseOrder, EpiZ, true>((LAS unsigned char*)lds, (const char*)(p.ws + (L == 0 ? WS_H : WS_H1)), D, S, E);
}

__device__ __forceinline__ void conv_unit(unsigned char* lds, const P& p, int L, int s, int tt) {
    float* hg = (float*)lds;
    const int tid = threadIdx.x, lane = tid & 63, wave = tid >> 6;
    const int rb = s < 16 ? s * SEQ : NLAT + (s - 16) * CTXL, len = s < 16 ? SEQ : CTXL, t0 = tt * 64;
    const bf16_t* Z = (const bf16_t*)(p.ws + WS_Z);
    {
        u32x2 av[12], gv[12];
#pragma unroll
        for (int q = 0; q < 12; ++q) {
            const int i = tid + q * NTHREADS, jj = i >> 6, c4 = (i & 63) * 4; int t = t0 - 15 + jj; t = t < 0 ? 0 : (t >= len ? len - 1 : t);
            const bf16_t* zr = Z + (size_t)(rb + t) * ZC;
            av[q] = *(const u32x2*)(zr + c4); gv[q] = *(const u32x2*)(zr + 256 + c4);
        }
#pragma unroll
        for (int q = 0; q < 12; ++q) {
            const int i = tid + q * NTHREADS, jj = i >> 6, c4 = (i & 63) * 4, t = t0 - 15 + jj;
            if (i < 94 * 64) {
                f32x4 h = (f32x4){0.f, 0.f, 0.f, 0.f};
                if (t >= 0 && t < len) {
                    const u32x2 a = av[q], g = gv[q];
                    h.x = lo16(a.x) * __builtin_amdgcn_rcpf(1.f + __expf(-lo16(g.x))); h.y = hi16(a.x) * __builtin_amdgcn_rcpf(1.f + __expf(-hi16(g.x)));
                    h.z = lo16(a.y) * __builtin_amdgcn_rcpf(1.f + __expf(-lo16(g.y))); h.w = hi16(a.y) * __builtin_amdgcn_rcpf(1.f + __expf(-hi16(g.y)));
                }
                *(f32x4*)(hg + jj * 256 + c4) = h;
            }
        }
    }
    float* wl = hg + 94 * 256;
    for (int i = tid; i < 31 * 64; i += NTHREADS) *(f32x4*)(wl + i * 4) = *(const f32x4*)(p.in[8] + (size_t)L * 31 * 256 + i * 4);
    __syncthreads();
    const int c0 = lane * 4;
    const f32x4 cb = *(const f32x4*)(p.in[9] + L * 256 + c0), lw = *(const f32x4*)(p.in[10] + L * 256 + c0), lb = *(const f32x4*)(p.in[11] + L * 256 + c0);
    bf16_t* CC = (bf16_t*)(p.ws + WS_CC);
    {
        f32x4 w[31];
#pragma unroll
        for (int j = 0; j < 31; ++j) w[j] = *(const f32x4*)(wl + j * 256 + c0);
#pragma unroll 1
        for (int half = 0; half < 2; ++half) {
            f32x4 acc[4];
#pragma unroll
            for (int q = 0; q < 4; ++q) acc[q] = cb;
            const float* hrow = hg + (wave * 8 + half * 4) * 256 + c0;
#pragma unroll
            for (int r = 0; r < 34; ++r) {
                const f32x4 h = *(const f32x4*)(hrow + r * 256);
#pragma unroll
                for (int q = 0; q < 4; ++q) { if (r - q >= 0 && r - q <= 30) acc[q] += h * w[r - q]; }
            }
#pragma unroll
            for (int q = 0; q < 4; ++q) {
                const int tl = wave * 8 + half * 4 + q;
                const float mean = wave_sum(acc[q].x + acc[q].y + acc[q].z + acc[q].w) * (1.f / 256.f);
                const f32x4 d = acc[q] - mean;
                const float var = wave_sum(d.x * d.x + d.y * d.y + d.z * d.z + d.w * d.w) * (1.f / 256.f);
                const float rstd = rsqrtf(var + NORM_EPS);
                const f32x4 y = d * rstd * lw + lb;
                u32x2 o; o.x = cvtpk(siluf(y.x), siluf(y.y)); o.y = cvtpk(siluf(y.z), siluf(y.w));
                *(u32x2*)(CC + (size_t)(rb + t0 + tl) * D + c0) = o;
            }
        }
    }
    __syncthreads();
}

__device__ __forceinline__ float log2_gamma(const P& p, int L, int dir, int h) {
    const float x = p.in[12][(L * 2 + dir) * 4 + h];
    const float ls = fminf(x, 0.f) - log1pf(expf(-fabsf(x)));
    return ls * 1.4426950408889634f;
}
__device__ __forceinline__ void load_ret_qk(float* dst, const P& p, int gc, int h, int zoff, float scale) {
    const int tid = threadIdx.x, j = tid >> 2, i0 = (tid & 3) * 4, row = gc * 128 + j;
    const bf16_t* zr = (const bf16_t*)(p.ws + WS_Z) + (size_t)row * ZC + zoff + h * 32;
    const u32x2 a = *(const u32x2*)(zr + i0), b = *(const u32x2*)(zr + 16 + i0);
    float x1[4] = {lo16(a.x), hi16(a.x), lo16(a.y), hi16(a.y)}, x2[4] = {lo16(b.x), hi16(b.x), lo16(b.y), hi16(b.y)};
    const bool lat = row < NLAT; const int pos = row & (SEQ - 1);
    const float* ct = (const float*)(p.ws + WS_ROPE) + pos * 16 + i0; const float* st = ct + 2048 * 16;
#pragma unroll
    for (int i = 0; i < 4; ++i) {
        const float c = lat ? ct[i] : 1.f, s = lat ? st[i] : 0.f;
        dst[j * 33 + i0 + i] = (x1[i] * c - x2[i] * s) * scale;
        dst[j * 33 + 16 + i0 + i] = (x1[i] * s + x2[i] * c) * scale;
    }
}
__device__ __forceinline__ void load_ret_v(float* dst  , const P& p, int gc, int h) {
    const int tid = threadIdx.x, j = tid >> 2, e0 = (tid & 3) * 16;
    const bf16_t* zr = (const bf16_t*)(p.ws + WS_Z) + (size_t)(gc * 128 + j) * ZC + Z_RV + h * 64 + e0;
    const u32x4 a = *(const u32x4*)zr, b = *(const u32x4*)(zr + 8);
#pragma unroll
    for (int i = 0; i < 4; ++i) { dst[j * 64 + e0 + 2 * i] = lo16(a[i]); dst[j * 64 + e0 + 2 * i + 1] = hi16(a[i]); dst[j * 64 + e0 + 8 + 2 * i] = lo16(b[i]); dst[j * 64 + e0 + 8 + 2 * i + 1] = hi16(b[i]); }
}
__device__ __forceinline__ void retkv_unit(unsigned char* lds, const P& p, int L, int gc, int h) {
    float* ks = (float*)lds; float* vs = ks + 128 * 33; float* wf = vs + 128 * 64; float* wb = wf + 128;
    const int tid = threadIdx.x;
    const float l2f = log2_gamma(p, L, 0, h), l2b = log2_gamma(p, L, 1, h);
    load_ret_qk(ks, p, gc, h, Z_RK, 0.17677669529663687f);
    load_ret_v(vs, p, gc, h);
    if (tid < 128) { wf[tid] = exp2f(l2f * (float)(127 - tid)); wb[tid] = exp2f(l2b * (float)tid); }
    __syncthreads();
    const int d = tid >> 4, e0 = (tid & 15) * 4;
    f32x4 af = (f32x4){0.f, 0.f, 0.f, 0.f}, ab = af;
    for (int j = 0; j < 128; ++j) {
        const float kd = ks[j * 33 + d]; const f32x4 v4 = *(const f32x4*)(vs + j * 64 + e0);
        af += (kd * wf[j]) * v4; ab += (kd * wb[j]) * v4;
    }
    float* KV = (float*)(p.ws + WS_KV) + ((size_t)(gc * 4 + h) * 2) * 2048;
    *(f32x4*)(KV + d * 64 + e0) = af; *(f32x4*)(KV + 2048 + d * 64 + e0) = ab;
    __syncthreads();
}
__device__ __forceinline__ void ret_stage_k(unsigned char* kf, unsigned char* kb, int rowb, const P& p, int gc, int h, float ef, float jf0, float eb, float jb0) {
    const int tid = threadIdx.x, j = tid >> 2, i0 = (tid & 3) * 4, row = gc * 128 + j;
    const bf16_t* zr = (const bf16_t*)(p.ws + WS_Z) + (size_t)row * ZC + Z_RK + h * 32;
    const u32x2 a = *(const u32x2*)(zr + i0), b = *(const u32x2*)(zr + 16 + i0);
    const float x1[4] = {lo16(a.x), hi16(a.x), lo16(a.y), hi16(a.y)}, x2[4] = {lo16(b.x), hi16(b.x), lo16(b.y), hi16(b.y)};
    f32x4 c4 = (f32x4){1.f, 1.f, 1.f, 1.f}, s4 = (f32x4){0.f, 0.f, 0.f, 0.f};
    if (row < NLAT) { const int pos = row & (SEQ - 1); const float* ct = (const float*)(p.ws + WS_ROPE) + pos * 16 + i0; c4 = *(const f32x4*)ct; s4 = *(const f32x4*)(ct + 2048 * 16); }
    const float wf = __builtin_amdgcn_exp2f(ef * ((float)j - jf0)) * 0.17677669529663687f, wb = __builtin_amdgcn_exp2f(eb * ((float)j - jb0)) * 0.17677669529663687f;
    float o1[4], o2[4];
#pragma unroll
    for (int i = 0; i < 4; ++i) { o1[i] = x1[i] * c4[i] - x2[i] * s4[i]; o2[i] = x1[i] * s4[i] + x2[i] * c4[i]; }
    u32x2 w;
    w.x = cvtpk(o1[0] * wf, o1[1] * wf); w.y = cvtpk(o1[2] * wf, o1[3] * wf); *(u32x2*)(kf + j * rowb + i0 * 2) = w;
    w.x = cvtpk(o2[0] * wf, o2[1] * wf); w.y = cvtpk(o2[2] * wf, o2[3] * wf); *(u32x2*)(kf + j * rowb + 32 + i0 * 2) = w;
    w.x = cvtpk(o1[0] * wb, o1[1] * wb); w.y = cvtpk(o1[2] * wb, o1[3] * wb); *(u32x2*)(kb + j * rowb + i0 * 2) = w;
    w.x = cvtpk(o2[0] * wb, o2[1] * wb); w.y = cvtpk(o2[2] * wb, o2[3] * wb); *(u32x2*)(kb + j * rowb + 32 + i0 * 2) = w;
}
__device__ __forceinline__ void ret_stage_v(unsigned char* vt, const P& p, int gc, int h) {
    const int tid = threadIdx.x, j = tid >> 2, e0 = (tid & 3) * 16;
    const bf16_t* zr = (const bf16_t*)(p.ws + WS_Z) + (size_t)(gc * 128 + j) * ZC + Z_RV + h * 64 + e0;
    const u32x4 a = *(const u32x4*)zr, b = *(const u32x4*)(zr + 8);
    unsigned char* d = vt + (e0 >> 5) * 8192 + j * 64 + (e0 & 31) * 2;
    *(u32x4*)d = a; *(u32x4*)(d + 16) = b;
}
__device__ __forceinline__ bf16x8 tr8(const unsigned char* p0, const unsigned char* p1) {
    const v4i16_t a = __builtin_amdgcn_ds_read_tr16_b64_v4i16((LAS v4i16_t*)(const LAS unsigned char*)p0), b = __builtin_amdgcn_ds_read_tr16_b64_v4i16((LAS v4i16_t*)(const LAS unsigned char*)p1);
    return (bf16x8){a[0], a[1], a[2], a[3], b[0], b[1], b[2], b[3]};
}
__device__ __forceinline__ void retkv_unit_mfma(unsigned char* lds, const P& p, int L, int gc, int h) {
    const int tid = threadIdx.x, lane = tid & 63, wid = tid >> 6;
    const float l2f = log2_gamma(p, L, 0, h), l2b = log2_gamma(p, L, 1, h);
    ret_stage_k(lds, lds + 8192, 64, p, gc, h, -l2f, 127.f, l2b, 0.f);
    ret_stage_v(lds + 16384, p, gc, h);
    __syncthreads();
    if (wid < 4) {
        const int dir = wid >> 1, eb = wid & 1, g = lane >> 4, i = lane & 15, hh = lane >> 5;
        const int off = (8 * hh + (i >> 2)) * 64 + (g & 1) * 32 + (i & 3) * 8;
        const unsigned char* Kt = lds + dir * 8192 + off; const unsigned char* Vt = lds + 16384 + eb * 8192 + off;
        f32x16 acc;
#pragma unroll
        for (int r = 0; r < 16; ++r) acc[r] = 0.f;
#pragma unroll
        for (int s = 0; s < 8; ++s) acc = __builtin_amdgcn_mfma_f32_32x32x16_bf16(tr8(Vt + s * 1024, Vt + s * 1024 + 256), tr8(Kt + s * 1024, Kt + s * 1024 + 256), acc, 0, 0, 0);
        bf16_t* KV = (bf16_t*)(p.ws + WS_KV) + ((size_t)(gc * 4 + h) * 2 + dir) * 2048 + (lane & 31) * 64 + eb * 32 + 4 * hh;
#pragma unroll
        for (int r4 = 0; r4 < 4; ++r4) { u32x2 w; w.x = cvtpk(acc[4 * r4], acc[4 * r4 + 1]); w.y = cvtpk(acc[4 * r4 + 2], acc[4 * r4 + 3]); *(u32x2*)(KV + 8 * r4) = w; }
    }
    __syncthreads();
}
__device__ __forceinline__ void retout_unit_mfma(unsigned char* lds, const P& p, int L, int gc, int h) {
    constexpr int KROW = 80, O_KF = 0, O_KB = 10240, O_V = 20480, O_SF = 36864, O_SB = 41984, O_RED = 47104;
    const int tid = threadIdx.x, lane = tid & 63, wid = tid >> 6, r32 = lane & 31, hh = lane >> 5;
    const float l2f = log2_gamma(p, L, 0, h), l2b = log2_gamma(p, L, 1, h);
    const int qb = wid & 3, eb = wid >> 2, i = qb * 32 + r32, row = gc * 128 + i;
    const bf16_t* zq = (const bf16_t*)(p.ws + WS_Z) + (size_t)row * ZC + Z_RQ + h * 32 + 8 * hh;
    const u32x4 qa = *(const u32x4*)zq, qbv = *(const u32x4*)(zq + 16);
    f32x4 rc0 = (f32x4){1.f, 1.f, 1.f, 1.f}, rc1 = rc0, rs0 = (f32x4){0.f, 0.f, 0.f, 0.f}, rs1 = rs0;
    if (row < NLAT) { const float* ct = (const float*)(p.ws + WS_ROPE) + (row & (SEQ - 1)) * 16 + 8 * hh; const float* st = ct + 2048 * 16;
        rc0 = *(const f32x4*)ct; rc1 = *(const f32x4*)(ct + 4); rs0 = *(const f32x4*)st; rs1 = *(const f32x4*)(st + 4); }
    const bf16_t* zg = (const bf16_t*)(p.ws + WS_Z) + (size_t)row * ZC + Z_RG + h * 64 + eb * 32 + 4 * hh;
    const float* gw = p.in[13] + L * 256 + h * 64 + eb * 32 + 4 * hh;
    u32x2 gzv[4]; f32x4 gwv[4];
#pragma unroll
    for (int r4 = 0; r4 < 4; ++r4) { gzv[r4] = *(const u32x2*)(zg + 8 * r4); gwv[r4] = *(const f32x4*)(gw + 8 * r4); }
    const bool lat = gc < 256; const int b = lat ? gc >> 4 : (gc - 256) >> 1;
    u32x2 kvf[18], kvb[18];
    {
        const bf16_t* KVb = (const bf16_t*)(p.ws + WS_KV);
#pragma unroll
        for (int mm = 0; mm < 18; ++mm) {
            const int gcm = mm < 2 ? 256 + b * 2 + mm : b * 16 + (mm - 2);
            const bf16_t* kv = KVb + ((size_t)(gcm * 4 + h) * 2) * 2048 + tid * 4;
            kvf[mm] = *(const u32x2*)kv; kvb[mm] = *(const u32x2*)(kv + 2048);
        }
    }
    ret_stage_k(lds + O_KF, lds + O_KB, KROW, p, gc, h, -l2f, 0.f, l2b, 0.f);
    ret_stage_v(lds + O_V, p, gc, h);
    {
        const int mme = lat ? 2 + (gc & 15) : (gc - 256) & 1;
        const int u = mme, w = mme < 2 ? 1 - mme : 19 - mme;
        f32x4 sf = (f32x4){0.f, 0.f, 0.f, 0.f}, sb = sf;
#pragma unroll
        for (int mm = 0; mm < 18; ++mm) {
            const int um = mm, wm = mm < 2 ? 1 - mm : 19 - mm;
            const u32x2 kf2 = kvf[mm], kb2 = kvb[mm];
            const float wgf = um < u ? __builtin_amdgcn_exp2f(l2f * 128.f * (float)(u - 1 - um)) : 0.f;
            const float wgb = wm < w ? __builtin_amdgcn_exp2f(l2b * 128.f * (float)(w - 1 - wm)) : 0.f;
            sf += wgf * (f32x4){lo16(kf2.x), hi16(kf2.x), lo16(kf2.y), hi16(kf2.y)}; sb += wgb * (f32x4){lo16(kb2.x), hi16(kb2.x), lo16(kb2.y), hi16(kb2.y)};
        }
        const int d = tid >> 4, e0 = (tid & 15) * 4;
#pragma unroll
        for (int k = 0; k < 4; ++k) { *(bf16_t*)(lds + O_SF + (e0 + k) * KROW + d * 2) = (bf16_t)(cvtpk(sf[k], 0.f) & 0xffffu); *(bf16_t*)(lds + O_SB + (e0 + k) * KROW + d * 2) = (bf16_t)(cvtpk(sb[k], 0.f) & 0xffffu); }
    }
    __syncthreads();
    bf16x8 qf[2];
    {
        float x1[8], x2[8];
#pragma unroll
        for (int k = 0; k < 4; ++k) { x1[2 * k] = lo16(qa[k]); x1[2 * k + 1] = hi16(qa[k]); x2[2 * k] = lo16(qbv[k]); x2[2 * k + 1] = hi16(qbv[k]); }
#pragma unroll
        for (int k = 0; k < 8; ++k) { const float c = k < 4 ? rc0[k & 3] : rc1[k & 3], sn = k < 4 ? rs0[k & 3] : rs1[k & 3], u1 = x1[k], u2 = x2[k]; x1[k] = u1 * c - u2 * sn; x2[k] = u1 * sn + u2 * c; }
        const u32x4 q0 = (u32x4){cvtpk(x1[0], x1[1]), cvtpk(x1[2], x1[3]), cvtpk(x1[4], x1[5]), cvtpk(x1[6], x1[7])};
        const u32x4 q1 = (u32x4){cvtpk(x2[0], x2[1]), cvtpk(x2[2], x2[3]), cvtpk(x2[4], x2[5]), cvtpk(x2[6], x2[7])};
        qf[0] = __builtin_bit_cast(bf16x8, q0); qf[1] = __builtin_bit_cast(bf16x8, q1);
    }
    const float af = __builtin_amdgcn_exp2f(l2f * (float)i), ab = __builtin_amdgcn_exp2f(-l2b * (float)i), cf = __builtin_amdgcn_exp2f(l2f * (float)(i + 1)), cb = __builtin_amdgcn_exp2f(l2b * (float)(128 - i));
    f32x16 y, zero;
#pragma unroll
    for (int r = 0; r < 16; ++r) { y[r] = 0.f; zero[r] = 0.f; }
    const int koff = r32 * KROW + 16 * hh;
    const int voff = O_V + eb * 8192 + (4 * hh + ((lane & 15) >> 2)) * 64 + ((lane >> 4) & 1) * 32 + (lane & 3) * 8;
#pragma unroll
    for (int kb = 0; kb < 4; ++kb) {
        f32x16 pt;
        if (kb <= qb) {
            f32x16 sF = __builtin_amdgcn_mfma_f32_32x32x16_bf16(*(const bf16x8*)(lds + O_KF + kb * 32 * KROW + koff), qf[0], zero, 0, 0, 0);
            sF = __builtin_amdgcn_mfma_f32_32x32x16_bf16(*(const bf16x8*)(lds + O_KF + kb * 32 * KROW + koff + 32), qf[1], sF, 0, 0, 0);
            if (kb < qb) {
#pragma unroll
                for (int r = 0; r < 16; ++r) pt[r] = sF[r] * af;
            } else {
#pragma unroll
                for (int r = 0; r < 16; ++r) { const int j = (r & 3) + 8 * (r >> 2) + 4 * hh; pt[r] = (j <= r32) ? sF[r] * af : 0.f; }
            }
        }
        if (kb >= qb) {
            f32x16 sB = __builtin_amdgcn_mfma_f32_32x32x16_bf16(*(const bf16x8*)(lds + O_KB + kb * 32 * KROW + koff), qf[0], zero, 0, 0, 0);
            sB = __builtin_amdgcn_mfma_f32_32x32x16_bf16(*(const bf16x8*)(lds + O_KB + kb * 32 * KROW + koff + 32), qf[1], sB, 0, 0, 0);
            if (kb > qb) {
#pragma unroll
                for (int r = 0; r < 16; ++r) pt[r] = sB[r] * ab;
            } else {
#pragma unroll
                for (int r = 0; r < 16; ++r) { const int j = (r & 3) + 8 * (r >> 2) + 4 * hh; pt[r] += (j >= r32) ? sB[r] * ab : 0.f; }
            }
        }
#pragma unroll
        for (int s2 = 0; s2 < 2; ++s2) {
            const u32x4 pw = (u32x4){cvtpk(pt[8 * s2], pt[8 * s2 + 1]), cvtpk(pt[8 * s2 + 2], pt[8 * s2 + 3]), cvtpk(pt[8 * s2 + 4], pt[8 * s2 + 5]), cvtpk(pt[8 * s2 + 6], pt[8 * s2 + 7])};
            const unsigned char* vb = lds + voff + (kb * 32 + s2 * 16) * 64;
            y = __builtin_amdgcn_mfma_f32_32x32x16_bf16(tr8(vb, vb + 8 * 64), __builtin_bit_cast(bf16x8, pw), y, 0, 0, 0);
        }
    }
    {
        const int soff = (eb * 32 + r32) * KROW + 16 * hh;
        f32x16 tF = __builtin_amdgcn_mfma_f32_32x32x16_bf16(*(const bf16x8*)(lds + O_SF + soff), qf[0], zero, 0, 0, 0);
        tF = __builtin_amdgcn_mfma_f32_32x32x16_bf16(*(const bf16x8*)(lds + O_SF + soff + 32), qf[1], tF, 0, 0, 0);
        f32x16 tB = __builtin_amdgcn_mfma_f32_32x32x16_bf16(*(const bf16x8*)(lds + O_SB + soff), qf[0], zero, 0, 0, 0);
        tB = __builtin_amdgcn_mfma_f32_32x32x16_bf16(*(const bf16x8*)(lds + O_SB + soff + 32), qf[1], tB, 0, 0, 0);
#pragma unroll
        for (int r = 0; r < 16; ++r) y[r] += tF[r] * cf + tB[r] * cb;
    }
    float s1 = 0.f, s2 = 0.f;
#pragma unroll
    for (int r = 0; r < 16; ++r) { s1 += y[r]; s2 += y[r] * y[r]; }
    s1 += __shfl_xor(s1, 32); s2 += __shfl_xor(s2, 32);
    float* red = (float*)(lds + O_RED);
    if (hh == 0) { red[(eb * 128 + i) * 2] = s1; red[(eb * 128 + i) * 2 + 1] = s2; }
    __syncthreads();
    s1 = red[i * 2] + red[(128 + i) * 2]; s2 = red[i * 2 + 1] + red[(128 + i) * 2 + 1];
    const float mu = s1 * (1.f / 64.f), var = fmaxf(s2 * (1.f / 64.f) - mu * mu, 0.f), rstd = rsqrtf(var + NORM_EPS);
    bf16_t* orow = (bf16_t*)(p.ws + WS_CC) + (size_t)row * D + 256 + h * 64 + eb * 32 + 4 * hh;
#pragma unroll
    for (int r4 = 0; r4 < 4; ++r4) {
        const u32x2 gz = gzv[r4]; const f32x4 w4 = gwv[r4];
        const float g0 = lo16(gz.x), g1 = hi16(gz.x), g2 = lo16(gz.y), g3 = hi16(gz.y);
        u32x2 o; o.x = cvtpk(siluf(g0) * ((y[4 * r4] - mu) * rstd * w4.x), siluf(g1) * ((y[4 * r4 + 1] - mu) * rstd * w4.y));
        o.y = cvtpk(siluf(g2) * ((y[4 * r4 + 2] - mu) * rstd * w4.z), siluf(g3) * ((y[4 * r4 + 3] - mu) * rstd * w4.w));
        *(u32x2*)(orow + 8 * r4) = o;
    }
    __syncthreads();
}
__device__ __forceinline__ void qkv_proj(unsigned char* lds, const P& p, int L) {
    const float* sskv = (const float*)(p.ws + WS_SS) + (size_t)NTOK * 4;
    const int G = gridDim.x, bid = blockIdx.x;
    {
        bf16_t* Q = (bf16_t*)(p.ws + WS_Q);
        ge::DenseOrder S; S.nM = NTOK / 256; S.nN = 3; S.nwg = S.nM * 3; S.G = G; S.c = bid; S.Bt = (const char*)((const bf16_t*)(p.ws + WS_WUQ) + (size_t)L * 768 * 256); S.btile = (size_t)256 * 256 * 2; S.arow = ZC * 2;
        auto f = [&](const ge::Unit& u, int r, int c, f32x4 v0, f32x4 v1) {
            u32x4 w; w.x = cvtpk(v0.x, v0.y); w.y = cvtpk(v0.z, v0.w); w.z = cvtpk(v1.x, v1.y); w.w = cvtpk(v1.z, v1.w); *(u32x4*)(Q + (size_t)(u.a * 256 + r) * 768 + u.b * 256 + c) = w;
        };
        ge::EpiFn<decltype(f)> E{f};
        ge::gemm_stream<ge::DenseOrder, ge::EpiFn<decltype(f)>, true>((LAS unsigned char*)lds, (const char*)(p.ws + WS_Z) + Z_CQ * 2, 256, S, E);
    }
    {
        bf16_t* Kb = (bf16_t*)(p.ws + WS_K); bf16_t* Vb = (bf16_t*)(p.ws + WS_V);
        ge::DenseOrder S; S.nM = NTOK / 256; S.nN = 4; S.nwg = S.nM * 4; S.G = G; S.c = (bid + 176) % G; S.Bt = (const char*)((const bf16_t*)(p.ws + WS_WUKV) + (size_t)L * 1024 * 256); S.btile = (size_t)256 * 256 * 2; S.arow = ZC * 2;
        struct EpiKV {
            bf16_t* Kb; bf16_t* Vb; const float* sskv;
            __device__ __forceinline__ void operator()(const ge::Acc& acc, const ge::Unit& u, int wr, int wc, int fr, int fq) const {
                float rstd[2][4];
#pragma unroll
                for (int ai = 0; ai < 2; ++ai)
#pragma unroll
                    for (int m = 0; m < 4; ++m) { const f32x4 s4 = *(const f32x4*)(sskv + (size_t)(u.a * 256 + ai * 128 + wr * 64 + m * 16 + fr) * 4); rstd[ai][m] = rsqrtf((s4.x + s4.y + s4.z + s4.w) * (1.f / 128.f) + NORM_EPS); }
#pragma unroll
                for (int ai = 0; ai < 2; ++ai)
#pragma unroll
                    for (int m = 0; m < 4; ++m) {
                        const int row = u.a * 256 + ai * 128 + wr * 64 + m * 16 + fr;
#pragma unroll
                        for (int bj = 0; bj < 2; ++bj) {
                            const int col = u.b * 256 + bj * 128 + wc * 32 + 8 * fq, h = col >> 7, j = col & 127;
                            const f32x4 v0 = acc[ai][bj][m][0] * rstd[ai][m], v1 = acc[ai][bj][m][1] * rstd[ai][m];
                            u32x4 w; w.x = cvtpk(v0.x, v0.y); w.y = cvtpk(v0.z, v0.w); w.z = cvtpk(v1.x, v1.y); w.w = cvtpk(v1.z, v1.w);
                            if (j < 64) *(u32x4*)(Kb + (size_t)row * 768 + h * 96 + j) = w;
                            else *(u32x4*)(Vb + (size_t)row * 512 + h * 64 + (j - 64)) = w;
                        }
                    }
            }
        };
        EpiKV E{Kb, Vb, sskv};
        ge::gemm_stream<ge::DenseOrder, EpiKV, true>((LAS unsigned char*)lds, (const char*)(p.ws + WS_Z) + Z_CKV * 2, 256, S, E);
    }
}
__device__ __forceinline__ void phase_b(unsigned char* lds, const P& p, int L) {
    const int G = gridDim.x, bid = blockIdx.x;
    qkv_proj(lds, p, L);
    const int nconv = (L == 0) ? 576 : 512;
    const int nkv = 288 * 4;
    const int total = nconv + nkv;
    for (int u = (bid + 96) % G; u < total; u += G) {
        int r = u;
        if (r < nconv) { if (r < 512) conv_unit(lds, p, L, r >> 5, r & 31); else conv_unit(lds, p, L, 16 + ((r - 512) >> 2), (r - 512) & 3); continue; } r -= nconv;
        retkv_unit_mfma(lds, p, L, r >> 2, r & 3);
    }
    if (L == 1) convert_expert_weights(lds, p, 1);
}

__device__ __forceinline__ void attn_unit_naive(unsigned char* lds, const P& p, int b, int h, int qb, bool ctxq) {
    float* Ks = (float*)lds;
    float* Vs = Ks + 64 * 96;
    const int tid = threadIdx.x, half = tid & 1, qi = tid >> 1;
    const bf16_t* Qb = (const bf16_t*)(p.ws + WS_Q); const bf16_t* Kb = (const bf16_t*)(p.ws + WS_K); const bf16_t* Vb = (const bf16_t*)(p.ws + WS_V);
    const int qrow = ctxq ? NLAT + b * CTXL + qi : b * SEQ + qb * 256 + qi;
    float q[48];
    {
        const u32x4* qp = (const u32x4*)(Qb + (size_t)qrow * 768 + h * 96 + half * 48);
#pragma unroll
        for (int i = 0; i < 6; ++i) { const u32x4 w = qp[i];
#pragma unroll
            for (int k = 0; k < 4; ++k) { q[i * 8 + 2 * k] = lo16(w[k]); q[i * 8 + 2 * k + 1] = hi16(w[k]); } }
    }
    float o[32];
#pragma unroll
    for (int e = 0; e < 32; ++e) o[e] = 0.f;
    float m = -1e30f, l = 0.f;
    const int ntiles = ctxq ? 4 : 36;
#pragma unroll 1
    for (int t = 0; t < ntiles; ++t) {
        const int krow0 = t < 4 ? NLAT + b * CTXL + t * 64 : b * SEQ + (t - 4) * 64;
        __syncthreads();
        for (int i = tid; i < 64 * 12; i += NTHREADS) { const int key = i / 12, c = i % 12; const u32x4 w = *(const u32x4*)(Kb + (size_t)(krow0 + key) * 768 + h * 96 + c * 8);
            float* d = Ks + key * 96 + c * 8;
#pragma unroll
            for (int k = 0; k < 4; ++k) { d[2 * k] = lo16(w[k]); d[2 * k + 1] = hi16(w[k]); } }
        for (int i = tid; i < 64 * 8; i += NTHREADS) { const int key = i >> 3, c = i & 7; const u32x4 w = *(const u32x4*)(Vb + (size_t)(krow0 + key) * 512 + h * 64 + c * 8);
            float* d = Vs + key * 64 + c * 8;
#pragma unroll
            for (int k = 0; k < 4; ++k) { d[2 * k] = lo16(w[k]); d[2 * k + 1] = hi16(w[k]); } }
        __syncthreads();
#pragma unroll 1
        for (int j0 = 0; j0 < 64; j0 += 2) {
            float s[2]; float mt = -1e30f;
#pragma unroll
            for (int jj = 0; jj < 2; ++jj) {
                const f32x4* kr = (const f32x4*)(Ks + (j0 + jj) * 96 + half * 48);
                float a = 0.f;
#pragma unroll
                for (int d4 = 0; d4 < 12; ++d4) { const f32x4 kv = kr[d4]; a += q[4 * d4] * kv.x + q[4 * d4 + 1] * kv.y + q[4 * d4 + 2] * kv.z + q[4 * d4 + 3] * kv.w; }
                a += __shfl_xor(a, 1);
                s[jj] = a; mt = fmaxf(mt, a);
            }
            const float mn = fmaxf(m, mt), alpha = exp2f(m - mn);
            m = mn; l *= alpha;
#pragma unroll
            for (int e = 0; e < 32; ++e) o[e] *= alpha;
#pragma unroll
            for (int jj = 0; jj < 2; ++jj) {
                const float pj = exp2f(s[jj] - mn); l += pj;
                const f32x4* vr = (const f32x4*)(Vs + (j0 + jj) * 64 + half * 32);
#pragma unroll
                for (int e4 = 0; e4 < 8; ++e4) { const f32x4 vv = vr[e4]; o[4 * e4] += pj * vv.x; o[4 * e4 + 1] += pj * vv.y; o[4 * e4 + 2] += pj * vv.z; o[4 * e4 + 3] += pj * vv.w; }
            }
        }
    }
    {
        const float rl = 1.f / l;
        u32x4* op = (u32x4*)((bf16_t*)(p.ws + WS_CC) + (size_t)qrow * D + 512 + h * 64 + half * 32);
#pragma unroll
        for (int i = 0; i < 4; ++i) { u32x4 w; w.x = pk2(o[8 * i] * rl, o[8 * i + 1] * rl); w.y = pk2(o[8 * i + 2] * rl, o[8 * i + 3] * rl); w.z = pk2(o[8 * i + 4] * rl, o[8 * i + 5] * rl); w.w = pk2(o[8 * i + 6] * rl, o[8 * i + 7] * rl); op[i] = w; }
    }
    __syncthreads();
}
__device__ __forceinline__ float max3f(float a, float b, float c) { float r; asm("v_max3_f32 %0, %1, %2, %3" : "=v"(r) : "v"(a), "v"(b), "v"(c)); return r; }
constexpr int AT_KROW = 208;
constexpr int AT_KBUF = 64 * AT_KROW;
constexpr int AT_VBUF = 8192;
constexpr int AT_BUF = AT_KBUF + AT_VBUF;
__device__ __forceinline__ void attn_unit_mfma(unsigned char* lds, const P& p, int b, int h, int qb, bool ctxq) {
    const int tid = threadIdx.x, lane = tid & 63, wid = tid >> 6, r32 = lane & 31, hh = lane >> 5;
    const bf16_t* Qb = (const bf16_t*)(p.ws + WS_Q); const bf16_t* Kb = (const bf16_t*)(p.ws + WS_K); const bf16_t* Vb = (const bf16_t*)(p.ws + WS_V);
    const int qrow = (ctxq ? NLAT + b * CTXL : b * SEQ + qb * 256) + wid * 32 + r32;
    bf16x8 qf[6];
    {
        const f32x4 s4 = *(const f32x4*)((const float*)(p.ws + WS_SS) + (size_t)qrow * 4);
        const float rstd = rsqrtf((s4.x + s4.y + s4.z + s4.w) * (1.f / 256.f) + NORM_EPS);
        const float* ct = (const float*)(p.ws + WS_ROPE) + (qrow & (SEQ - 1)) * 16; const float* st = ct + 2048 * 16;
#pragma unroll
        for (int s = 0; s < 6; ++s) {
            const u32x4 w = *(const u32x4*)(Qb + (size_t)qrow * 768 + h * 96 + 16 * s + 8 * hh);
            float x[8];
#pragma unroll
            for (int k = 0; k < 4; ++k) { x[2 * k] = lo16(w[k]) * rstd; x[2 * k + 1] = hi16(w[k]) * rstd; }
            if (s >= 4 && !ctxq) {
                const f32x4 c4 = *(const f32x4*)(ct + 8 * (s - 4) + 4 * hh), sn = *(const f32x4*)(st + 8 * (s - 4) + 4 * hh);
#pragma unroll
                for (int k = 0; k < 4; ++k) { const float a = x[2 * k], b2 = x[2 * k + 1]; x[2 * k] = a * c4[k] - b2 * sn[k]; x[2 * k + 1] = a * sn[k] + b2 * c4[k]; }
            }
            const u32x4 o = (u32x4){cvtpk(x[0], x[1]), cvtpk(x[2], x[3]), cvtpk(x[4], x[5]), cvtpk(x[6], x[7])};
            qf[s] = __builtin_bit_cast(bf16x8, o);
        }
    }
    f32x16 o0, o1, negm;
#pragma unroll
    for (int r = 0; r < 16; ++r) { o0[r] = 0.f; o1[r] = 0.f; negm[r] = 0.f; }
    asm volatile("" : "+v"(negm));
    float mhat = 0.f, l = 0.f;
    const int ntiles = ctxq ? 4 : 36;
    const int wv = __builtin_amdgcn_readfirstlane(wid);
    const int ia = wv, ib = (wv + 8 < 13) ? wv + 8 : 12;
    const int qa = ia * 64 + lane, qb2 = ib * 64 + lane, qv = wv * 64 + lane;
    const int ca = qa % 13, cb = qb2 % 13;
    const size_t ka = (size_t)(qa / 13) * 768 + h * 96 + (ca < 12 ? ca : 11) * 8, kbo = (size_t)(qb2 / 13) * 768 + h * 96 + (cb < 12 ? cb : 11) * 8;
    const size_t vo = (size_t)((qv >> 2) & 63) * 512 + h * 64 + (qv >> 8) * 32 + (qv & 3) * 8;
    auto krow0 = [&](int t) { return t < 4 ? NLAT + b * CTXL + t * 64 : b * SEQ + (t - 4) * 64; };
    const unsigned lds0 = (unsigned)(uintptr_t)lds;
#define AT_GLDS(gp, ldsoff) do { unsigned keep_; asm volatile("s_mov_b32 %0, m0\n\ts_mov_b32 m0, %2\n\ts_nop 0\n\tglobal_load_lds_dwordx4 %1, off\n\ts_mov_b32 m0, %0" : "=&s"(keep_) : "v"(gp), "s"((unsigned)__builtin_amdgcn_readfirstlane(lds0 + (unsigned)(ldsoff))) : "memory"); } while (0)
#define AT_ISSUE(t2, slot) do { const int kr_ = krow0(t2); const bf16_t* kb_ = Kb + (size_t)kr_ * 768; const bf16_t* vb_ = Vb + (size_t)kr_ * 512; \
        AT_GLDS(kb_ + ka, (slot) + ia * 1024); AT_GLDS(kb_ + kbo, (slot) + ib * 1024); AT_GLDS(vb_ + vo, (slot) + AT_KBUF + wv * 1024); } while (0)
#define AT_SB() __builtin_amdgcn_sched_barrier(0)
#define AT_PIN(x) asm volatile("" : "+v"(x))
#define AT_NEXT(x) ((x) == 3 * AT_BUF ? 0 : (x) + AT_BUF)
    __builtin_amdgcn_s_barrier();
    AT_ISSUE(0, 0);
    if (ntiles > 1) AT_ISSUE(1, AT_BUF);
    const int koff = r32 * AT_KROW + 16 * hh;
    const int voff = AT_KBUF + (4 * hh + ((lane & 15) >> 2)) * 64 + ((lane >> 4) & 1) * 32 + (lane & 3) * 8;
#define AT_SYNC(t, slot_issue) do { if ((t) + 1 < ntiles) asm volatile("s_waitcnt vmcnt(3)" ::: "memory"); else asm volatile("s_waitcnt vmcnt(0)" ::: "memory"); \
        __builtin_amdgcn_s_barrier(); asm volatile("" ::: "memory"); if ((t) + 2 < ntiles) AT_ISSUE((t) + 2, slot_issue); } while (0)
#define AT_DECIDE(C0, C1) do { \
        asm volatile("s_nop 15\n\ts_nop 7" : "+v"(C0), "+v"(C1)); \
        float rma = max3f(C0[0], C0[1], C1[0]), rmb = max3f(C0[2], C0[3], C1[1]); rma = max3f(rma, C1[2], C1[3]); \
        _Pragma("unroll") for (int r = 4; r < 16; r += 4) { rma = max3f(rma, C0[r], C0[r + 1]); rmb = max3f(rmb, C0[r + 2], C0[r + 3]); rma = max3f(rma, C1[r], C1[r + 1]); rmb = max3f(rmb, C1[r + 2], C1[r + 3]); } \
        float rm = fmaxf(rma, rmb); rm = fmaxf(rm, __shfl_xor(rm, 32)); \
        resc = false; \
        if (__any(rm > 8.f)) { const float dl = fmaxf(rm, 0.f); fres = __builtin_amdgcn_exp2f(-dl); mhat += dl; l *= fres; resc = true; \
            _Pragma("unroll") for (int r = 0; r < 16; ++r) { C0[r] -= dl; C1[r] -= dl; negm[r] = -mhat; } \
            asm volatile("" : "+v"(negm)); } \
    } while (0)
#define AT_MFS(kfrag, s_, C, first) C = __builtin_amdgcn_mfma_f32_32x32x16_bf16(kfrag, qf[s_], (first) ? negm : C, 0, 0, 0)
#define AT_KF(bk_, g) (*(const bf16x8*)((bk_) + koff + ((g) & 1) * 32 * AT_KROW + ((g) >> 1) * 32))
#define AT_STEP(C0, C1, P0, P1, bk, bv) do { \
        bf16x8 kf[12], vfa[4], vfc[4]; u32x4 pw[4]; float sacc = 0.f; \
        kf[0] = AT_KF(bk, 0); kf[1] = AT_KF(bk, 1); kf[2] = AT_KF(bk, 2); kf[3] = AT_KF(bk, 3); \
        AT_SB(); \
        AT_MFS(kf[0], 0, C0, true);  kf[4] = AT_KF(bk, 4);  sacc += (P0[0] + P0[1]) + (P0[2] + P0[3]); pw[0].x = cvtpk(P0[0], P0[1]); pw[0].y = cvtpk(P0[2], P0[3]); AT_PIN(sacc); AT_PIN(pw[0]); AT_SB(); \
        AT_MFS(kf[1], 0, C1, true);  kf[5] = AT_KF(bk, 5);  sacc += (P0[4] + P0[5]) + (P0[6] + P0[7]); pw[0].z = cvtpk(P0[4], P0[5]); pw[0].w = cvtpk(P0[6], P0[7]); AT_PIN(sacc); AT_PIN(pw[0]); AT_SB(); \
        AT_MFS(kf[2], 1, C0, false); kf[6] = AT_KF(bk, 6);  sacc += (P0[8] + P0[9]) + (P0[10] + P0[11]); pw[1].x = cvtpk(P0[8], P0[9]); pw[1].y = cvtpk(P0[10], P0[11]); AT_PIN(sacc); AT_PIN(pw[1]); AT_SB(); \
        AT_MFS(kf[3], 1, C1, false); kf[7] = AT_KF(bk, 7);  sacc += (P0[12] + P0[13]) + (P0[14] + P0[15]); pw[1].z = cvtpk(P0[12], P0[13]); pw[1].w = cvtpk(P0[14], P0[15]); AT_PIN(sacc); AT_PIN(pw[1]); AT_SB(); \
        AT_MFS(kf[4], 2, C0, false); kf[8] = AT_KF(bk, 8);  sacc += (P1[0] + P1[1]) + (P1[2] + P1[3]); pw[2].x = cvtpk(P1[0], P1[1]); pw[2].y = cvtpk(P1[2], P1[3]); AT_PIN(sacc); AT_PIN(pw[2]); AT_SB(); \
        AT_MFS(kf[5], 2, C1, false); kf[9] = AT_KF(bk, 9);  sacc += (P1[4] + P1[5]) + (P1[6] + P1[7]); pw[2].z = cvtpk(P1[4], P1[5]); pw[2].w = cvtpk(P1[6], P1[7]); AT_PIN(sacc); AT_PIN(pw[2]); AT_SB(); \
        AT_MFS(kf[6], 3, C0, false); kf[10] = AT_KF(bk, 10); sacc += (P1[8] + P1[9]) + (P1[10] + P1[11]); pw[3].x = cvtpk(P1[8], P1[9]); pw[3].y = cvtpk(P1[10], P1[11]); AT_PIN(sacc); AT_PIN(pw[3]); AT_SB(); \
        AT_MFS(kf[7], 3, C1, false); kf[11] = AT_KF(bk, 11); sacc += (P1[12] + P1[13]) + (P1[14] + P1[15]); pw[3].z = cvtpk(P1[12], P1[13]); pw[3].w = cvtpk(P1[14], P1[15]); AT_PIN(sacc); AT_PIN(pw[3]); AT_SB(); \
        AT_MFS(kf[8], 4, C0, false); { const unsigned char* vb_ = (bv) + voff; vfa[0] = tr8(vb_, vb_ + 512); vfc[0] = tr8(vb_ + 4096, vb_ + 4608); } AT_SB(); \
        AT_MFS(kf[9], 4, C1, false); { const unsigned char* vb_ = (bv) + voff + 1024; vfa[1] = tr8(vb_, vb_ + 512); vfc[1] = tr8(vb_ + 4096, vb_ + 4608); } AT_SB(); \
        AT_MFS(kf[10], 5, C0, false); { const unsigned char* vb_ = (bv) + voff + 2048; vfa[2] = tr8(vb_, vb_ + 512); vfc[2] = tr8(vb_ + 4096, vb_ + 4608); } AT_SB(); \
        AT_MFS(kf[11], 5, C1, false); { const unsigned char* vb_ = (bv) + voff + 3072; vfa[3] = tr8(vb_, vb_ + 512); vfc[3] = tr8(vb_ + 4096, vb_ + 4608); } AT_SB(); \
        l += sacc; \
        AT_DECIDE(C0, C1); \
        AT_SB(); \
        o0 = __builtin_amdgcn_mfma_f32_32x32x16_bf16(vfa[0], __builtin_bit_cast(bf16x8, pw[0]), o0, 0, 0, 0); C0[0] = __builtin_amdgcn_exp2f(C0[0]); C0[1] = __builtin_amdgcn_exp2f(C0[1]); C0[2] = __builtin_amdgcn_exp2f(C0[2]); C0[3] = __builtin_amdgcn_exp2f(C0[3]); AT_PIN(C0); AT_SB(); \
        o1 = __builtin_amdgcn_mfma_f32_32x32x16_bf16(vfc[0], __builtin_bit_cast(bf16x8, pw[0]), o1, 0, 0, 0); C0[4] = __builtin_amdgcn_exp2f(C0[4]); C0[5] = __builtin_amdgcn_exp2f(C0[5]); C0[6] = __builtin_amdgcn_exp2f(C0[6]); C0[7] = __builtin_amdgcn_exp2f(C0[7]); AT_PIN(C0); AT_SB(); \
        o0 = __builtin_amdgcn_mfma_f32_32x32x16_bf16(vfa[1], __builtin_bit_cast(bf16x8, pw[1]), o0, 0, 0, 0); C0[8] = __builtin_amdgcn_exp2f(C0[8]); C0[9] = __builtin_amdgcn_exp2f(C0[9]); C0[10] = __builtin_amdgcn_exp2f(C0[10]); C0[11] = __builtin_amdgcn_exp2f(C0[11]); AT_PIN(C0); AT_SB(); \
        o1 = __builtin_amdgcn_mfma_f32_32x32x16_bf16(vfc[1], __builtin_bit_cast(bf16x8, pw[1]), o1, 0, 0, 0); C0[12] = __builtin_amdgcn_exp2f(C0[12]); C0[13] = __builtin_amdgcn_exp2f(C0[13]); C0[14] = __builtin_amdgcn_exp2f(C0[14]); C0[15] = __builtin_amdgcn_exp2f(C0[15]); AT_PIN(C0); AT_SB(); \
        o0 = __builtin_amdgcn_mfma_f32_32x32x16_bf16(vfa[2], __builtin_bit_cast(bf16x8, pw[2]), o0, 0, 0, 0); C1[0] = __builtin_amdgcn_exp2f(C1[0]); C1[1] = __builtin_amdgcn_exp2f(C1[1]); C1[2] = __builtin_amdgcn_exp2f(C1[2]); C1[3] = __builtin_amdgcn_exp2f(C1[3]); AT_PIN(C1); AT_SB(); \
        o1 = __builtin_amdgcn_mfma_f32_32x32x16_bf16(vfc[2], __builtin_bit_cast(bf16x8, pw[2]), o1, 0, 0, 0); C1[4] = __builtin_amdgcn_exp2f(C1[4]); C1[5] = __builtin_amdgcn_exp2f(C1[5]); C1[6] = __builtin_amdgcn_exp2f(C1[6]); C1[7] = __builtin_amdgcn_exp2f(C1[7]); AT_PIN(C1); AT_SB(); \
        o0 = __builtin_amdgcn_mfma_f32_32x32x16_bf16(vfa[3], __builtin_bit_cast(bf16x8, pw[3]), o0, 0, 0, 0); C1[8] = __builtin_amdgcn_exp2f(C1[8]); C1[9] = __builtin_amdgcn_exp2f(C1[9]); C1[10] = __builtin_amdgcn_exp2f(C1[10]); C1[11] = __builtin_amdgcn_exp2f(C1[11]); AT_PIN(C1); AT_SB(); \
        o1 = __builtin_amdgcn_mfma_f32_32x32x16_bf16(vfc[3], __builtin_bit_cast(bf16x8, pw[3]), o1, 0, 0, 0); C1[12] = __builtin_amdgcn_exp2f(C1[12]); C1[13] = __builtin_amdgcn_exp2f(C1[13]); C1[14] = __builtin_amdgcn_exp2f(C1[14]); C1[15] = __builtin_amdgcn_exp2f(C1[15]); AT_PIN(C1); AT_SB(); \
        if (resc) { _Pragma("unroll") for (int r = 0; r < 16; ++r) { o0[r] *= fres; o1[r] *= fres; } } \
    } while (0)
    f32x16 pA0, pA1, pB0, pB1; bool resc = false; float fres = 1.f;
    int s_prev = 0, s_cur = 0, s_iss = 2 * AT_BUF;
    AT_SYNC(0, s_iss); s_iss = AT_NEXT(s_iss);
    {
        const unsigned char* bk = lds + s_cur;
#pragma unroll
        for (int s_ = 0; s_ < 6; ++s_) {
            const bf16x8 k0f = *(const bf16x8*)(bk + koff + 32 * s_), k1f = *(const bf16x8*)(bk + koff + 32 * AT_KROW + 32 * s_);
            pA0 = __builtin_amdgcn_mfma_f32_32x32x16_bf16(k0f, qf[s_], s_ == 0 ? negm : pA0, 0, 0, 0);
            pA1 = __builtin_amdgcn_mfma_f32_32x32x16_bf16(k1f, qf[s_], s_ == 0 ? negm : pA1, 0, 0, 0);
        }
        AT_DECIDE(pA0, pA1);
#pragma unroll
        for (int r = 0; r < 16; ++r) { pA0[r] = __builtin_amdgcn_exp2f(pA0[r]); pA1[r] = __builtin_amdgcn_exp2f(pA1[r]); }
    }
    int t = 1;
#pragma unroll 1
    for (; t + 1 < ntiles; t += 2) {
        s_prev = s_cur; s_cur = AT_NEXT(s_cur); AT_SYNC(t, s_iss); s_iss = AT_NEXT(s_iss);
        AT_STEP(pB0, pB1, pA0, pA1, lds + s_cur, lds + s_prev);
        s_prev = s_cur; s_cur = AT_NEXT(s_cur); AT_SYNC(t + 1, s_iss); s_iss = AT_NEXT(s_iss);
        AT_STEP(pA0, pA1, pB0, pB1, lds + s_cur, lds + s_prev);
    }
    {
        s_prev = s_cur; s_cur = AT_NEXT(s_cur); AT_SYNC(t, s_iss); s_iss = AT_NEXT(s_iss);
        AT_STEP(pB0, pB1, pA0, pA1, lds + s_cur, lds + s_prev);
    }
    {
        float sacc = 0.f;
#pragma unroll
        for (int r = 0; r < 16; ++r) sacc += pB0[r] + pB1[r];
        l += sacc;
        u32x4 pw[4];
#pragma unroll
        for (int s2 = 0; s2 < 2; ++s2) {
            pw[s2] = (u32x4){cvtpk(pB0[8 * s2], pB0[8 * s2 + 1]), cvtpk(pB0[8 * s2 + 2], pB0[8 * s2 + 3]), cvtpk(pB0[8 * s2 + 4], pB0[8 * s2 + 5]), cvtpk(pB0[8 * s2 + 6], pB0[8 * s2 + 7])};
            pw[2 + s2] = (u32x4){cvtpk(pB1[8 * s2], pB1[8 * s2 + 1]), cvtpk(pB1[8 * s2 + 2], pB1[8 * s2 + 3]), cvtpk(pB1[8 * s2 + 4], pB1[8 * s2 + 5]), cvtpk(pB1[8 * s2 + 6], pB1[8 * s2 + 7])};
        }
        const unsigned char* bv = lds + s_cur;
#pragma unroll
        for (int ks = 0; ks < 4; ++ks) {
            const unsigned char* vb = bv + voff + ks * 16 * 64; const bf16x8 pf = __builtin_bit_cast(bf16x8, pw[ks]);
            o0 = __builtin_amdgcn_mfma_f32_32x32x16_bf16(tr8(vb, vb + 8 * 64), pf, o0, 0, 0, 0);
            o1 = __builtin_amdgcn_mfma_f32_32x32x16_bf16(tr8(vb + 4096, vb + 4096 + 8 * 64), pf, o1, 0, 0, 0);
        }
    }
#undef AT_GLDS
#undef AT_ISSUE
#undef AT_SB
#undef AT_PIN
#undef AT_NEXT
#undef AT_SYNC
#undef AT_DECIDE
#undef AT_MFS
#undef AT_KF
#undef AT_STEP
    l += __shfl_xor(l, 32);
    const float rl = 1.f / l;
    bf16_t* orow = (bf16_t*)(p.ws + WS_CC) + (size_t)qrow * D + 512 + h * 64 + 4 * hh;
#pragma unroll
    for (int r4 = 0; r4 < 4; ++r4) {
        u32x2 w0; w0.x = cvtpk(o0[4 * r4] * rl, o0[4 * r4 + 1] * rl); w0.y = cvtpk(o0[4 * r4 + 2] * rl, o0[4 * r4 + 3] * rl);
        u32x2 w1; w1.x = cvtpk(o1[4 * r4] * rl, o1[4 * r4 + 1] * rl); w1.y = cvtpk(o1[4 * r4 + 2] * rl, o1[4 * r4 + 3] * rl);
        *(u32x2*)(orow + 8 * r4) = w0; *(u32x2*)(orow + 32 + 8 * r4) = w1;
    }
}
__device__ __forceinline__ void retout_unit(unsigned char* lds, const P& p, int L, int gc, int h) {
    float* qs = (float*)lds; float* ks = qs + 128 * 33; float* vs = ks + 128 * 33; float* Sf = vs + 128 * 64; float* Sb = Sf + 2048;
    const int tid = threadIdx.x;
    const float l2f = log2_gamma(p, L, 0, h), l2b = log2_gamma(p, L, 1, h);
    load_ret_qk(qs, p, gc, h, Z_RQ, 1.f);
    load_ret_qk(ks, p, gc, h, Z_RK, 0.17677669529663687f);
    load_ret_v(vs, p, gc, h);
    {
        const bool lat = gc < 256; const int b = lat ? gc >> 4 : (gc - 256) >> 1;
        const int mme = lat ? 2 + (gc & 15) : (gc - 256) & 1;
        const int u = mme, w = mme < 2 ? 1 - mme : 19 - mme;
        f32x4 sf = (f32x4){0.f, 0.f, 0.f, 0.f}, sb = sf;
        const float* KVb = (const float*)(p.ws + WS_KV);
#pragma unroll 1
        for (int mm = 0; mm < 18; ++mm) {
            const int gcm = mm < 2 ? 256 + b * 2 + mm : b * 16 + (mm - 2);
            const int um = mm, wm = mm < 2 ? 1 - mm : 19 - mm;
            const float* kv = KVb + ((size_t)(gcm * 4 + h) * 2) * 2048 + tid * 4;
            if (um < u) { const float wgt = exp2f(l2f * 128.f * (float)(u - 1 - um)); sf += wgt * *(const f32x4*)kv; }
            if (wm < w) { const float wgt = exp2f(l2b * 128.f * (float)(w - 1 - wm)); sb += wgt * *(const f32x4*)(kv + 2048); }
        }
        *(f32x4*)(Sf + tid * 4) = sf; *(f32x4*)(Sb + tid * 4) = sb;
    }
    __syncthreads();
    const int i = tid >> 2, e0 = (tid & 3) * 16;
    float q[32];
#pragma unroll
    for (int d = 0; d < 32; ++d) q[d] = qs[i * 33 + d];
    float acc[16];
#pragma unroll
    for (int e = 0; e < 16; ++e) acc[e] = 0.f;
#pragma unroll 1
    for (int j = 0; j < 128; ++j) {
        float s = 0.f;
#pragma unroll
        for (int d = 0; d < 32; ++d) s += q[d] * ks[j * 33 + d];
        float wgt = 0.f;
        if (j <= i) wgt += exp2f(l2f * (float)(i - j));
        if (j >= i) wgt += exp2f(l2b * (float)(j - i));
        s *= wgt;
#pragma unroll
        for (int e4 = 0; e4 < 4; ++e4) { const f32x4 v4 = *(const f32x4*)(vs + j * 64 + e0 + 4 * e4); acc[4 * e4] += s * v4.x; acc[4 * e4 + 1] += s * v4.y; acc[4 * e4 + 2] += s * v4.z; acc[4 * e4 + 3] += s * v4.w; }
    }
    {
        const float cf = exp2f(l2f * (float)(i + 1)), cb = exp2f(l2b * (float)(128 - i));
#pragma unroll 2
        for (int d = 0; d < 32; ++d) {
            const float qd = qs[i * 33 + d]; const float qf = qd * cf, qb = qd * cb;
#pragma unroll
            for (int e4 = 0; e4 < 4; ++e4) { const f32x4 a = *(const f32x4*)(Sf + d * 64 + e0 + 4 * e4), bq = *(const f32x4*)(Sb + d * 64 + e0 + 4 * e4);
                acc[4 * e4] += qf * a.x + qb * bq.x; acc[4 * e4 + 1] += qf * a.y + qb * bq.y; acc[4 * e4 + 2] += qf * a.z + qb * bq.z; acc[4 * e4 + 3] += qf * a.w + qb * bq.w; }
        }
    }
    float s1 = 0.f;
#pragma unroll
    for (int e = 0; e < 16; ++e) s1 += acc[e];
    s1 += __shfl_xor(s1, 1); s1 += __shfl_xor(s1, 2);
    const float mu = s1 * (1.f / 64.f);
    float s2 = 0.f;
#pragma unroll
    for (int e = 0; e < 16; ++e) { const float dd = acc[e] - mu; s2 += dd * dd; }
    s2 += __shfl_xor(s2, 1); s2 += __shfl_xor(s2, 2);
    const float rstd = rsqrtf(s2 * (1.f / 64.f) + NORM_EPS);
    const int row = gc * 128 + i;
    const bf16_t* zg = (const bf16_t*)(p.ws + WS_Z) + (size_t)row * ZC + Z_RG + h * 64 + e0;
    const float* gw = p.in[13] + L * 256 + h * 64 + e0;
    const u32x4 g0 = *(const u32x4*)zg, g1 = *(const u32x4*)(zg + 8);
    float g[16];
#pragma unroll
    for (int k = 0; k < 4; ++k) { g[2 * k] = lo16(g0[k]); g[2 * k + 1] = hi16(g0[k]); g[8 + 2 * k] = lo16(g1[k]); g[8 + 2 * k + 1] = hi16(g1[k]); }
    unsigned o[8];
#pragma unroll
    for (int k = 0; k < 8; ++k) {
        const float y0 = siluf(g[2 * k]) * ((acc[2 * k] - mu) * rstd * gw[2 * k]), y1 = siluf(g[2 * k + 1]) * ((acc[2 * k + 1] - mu) * rstd * gw[2 * k + 1]);
        o[k] = pk2(y0, y1);
    }
    u32x4* op = (u32x4*)((bf16_t*)(p.ws + WS_CC) + (size_t)row * D + 256 + h * 64 + e0);
    u32x4 w0; w0.x = o[0]; w0.y = o[1]; w0.z = o[2]; w0.w = o[3]; u32x4 w1; w1.x = o[4]; w1.y = o[5]; w1.z = o[6]; w1.w = o[7];
    op[0] = w0; op[1] = w1;
    __syncthreads();
}
__device__ __forceinline__ void phase_c(unsigned char* lds, const P& p, int L) {
    const int G = gridDim.x, bid = blockIdx.x;
    const int nat = 16 * 8 * 8, nac = (L == 0) ? 128 : 0, nro = (L == 0 ? 288 : 256) * 4;
    const int total = nat + nac + nro;
    const int vcu = (G % 8 == 0) ? (bid % 8) * (G / 8) + bid / 8 : bid;
    for (int u = vcu; u < total; u += G) {
        int r = u;
#ifndef TEST_C
#define TEST_C 3
#endif
        if (r < nat) { if (TEST_C & 1) attn_unit_mfma(lds, p, r >> 6, (r >> 3) & 7, r & 7, false); continue; } r -= nat;
        if (r < nac) { if (TEST_C & 1) attn_unit_mfma(lds, p, r >> 3, r & 7, 0, true); continue; } r -= nac;
        if (TEST_C & 2) retout_unit_mfma(lds, p, L, r >> 2, r & 3);
    }
    if (L == 0) convert_expert_weights(lds, p, 0);
}

struct EpiY {
    bf16_t* Y; const float* g1;
    __device__ __forceinline__ void operator()(const ge::Acc& acc, const ge::Unit& u, int wr, int wc, int fr, int fq) const {
        const float* gr = g1 + (size_t)mod_row(u.a * 256) * 6144 + u.b * 256 + wc * 32 + 8 * fq;
        f32x4 g[2][2];
#pragma unroll
        for (int bj = 0; bj < 2; ++bj)
#pragma unroll
            for (int n = 0; n < 2; ++n) g[bj][n] = *(const f32x4*)(gr + bj * 128 + n * 4);
#pragma unroll
        for (int ai = 0; ai < 2; ++ai)
#pragma unroll
            for (int m = 0; m < 4; ++m) {
                bf16_t* yr = Y + (size_t)(u.a * 256 + ai * 128 + wr * 64 + m * 16 + fr) * D + u.b * 256 + wc * 32 + 8 * fq;
#pragma unroll
                for (int bj = 0; bj < 2; ++bj) { const f32x4 v0 = acc[ai][bj][m][0] * g[bj][0], v1 = acc[ai][bj][m][1] * g[bj][1];
                    u32x4 w; w.x = cvtpk(v0.x, v0.y); w.y = cvtpk(v0.z, v0.w); w.z = cvtpk(v1.x, v1.y); w.w = cvtpk(v1.z, v1.w); *(u32x4*)(yr + bj * 128) = w; }
            }
    }
};
__device__ __forceinline__ void phase_d(unsigned char* lds, const P& p, int L) {
    ge::DenseOrder S; S.nM = (L == 0 ? NTOK : NLAT) / 256; S.nN = 4; S.nwg = S.nM * 4; S.G = gridDim.x; S.c = blockIdx.x;
    S.Bt = (const char*)((const bf16_t*)(p.ws + WS_WOUT) + (size_t)L * D * D); S.btile = (size_t)256 * D * 2; S.arow = D * 2;
    EpiY E{(bf16_t*)(p.ws + WS_Y), (const float*)(p.ws + WS_MODV) + (size_t)L * 17 * 6144 + 2048};
    ge::gemm_stream<ge::DenseOrder, EpiY, true>((LAS unsigned char*)lds, (const char*)(p.ws + WS_CC), D, S, E);
}

__device__ __forceinline__ void norm_mod_store(const P& p, int L, int which, int tok, int lane, const f32x4 (&v)[4], bf16_t* Hdst) {
    const float* nw = (which == 0 ? p.in[6] : p.in[19]) + L * D;
    const float* mrow = (const float*)(p.ws + WS_MODV) + ((size_t)L * 17 + mod_row(tok)) * 6144 + which * 3072;
    float s = 0.f;
#pragma unroll
    for (int j = 0; j < 4; ++j) s += v[j].x * v[j].x + v[j].y * v[j].y + v[j].z * v[j].z + v[j].w * v[j].w;
    const float rstd = rsqrtf(wave_sum(s) * (1.f / D) + NORM_EPS);
    u32x2* o = (u32x2*)(Hdst + (size_t)tok * D) + lane;
#pragma unroll
    for (int j = 0; j < 4; ++j) {
        const int k = 4 * lane + 256 * j;
        const f32x4 w4 = *(const f32x4*)(nw + k), sh = *(const f32x4*)(mrow + k), sc = *(const f32x4*)(mrow + 1024 + k);
        const f32x4 y = v[j] * rstd * w4 * (sc + 1.f) + sh;
        u32x2 w; w.x = cvtpk(y.x, y.y); w.y = cvtpk(y.z, y.w); o[64 * j] = w;
    }
}
__device__ __forceinline__ int half_n(int L) { return L == 0 ? NTOK / 2 : NLAT / 2; }
__device__ __forceinline__ void phase_router(unsigned char* lds, const P& p, int L) {
    constexpr int O_LG = 41472, O_CNT = 83072, O_SEL = 83584, O_SELW = 87424;
    const bf16_t* H = (const bf16_t*)(p.ws + WS_H); const bf16_t* W = (const bf16_t*)(p.ws + WS_RT) + (size_t)L * 128 * D;
    const bf16_t* Y = (const bf16_t*)(p.ws + WS_Y);
    float* lg = (float*)(lds + O_LG);
    int* lcnt = (int*)(lds + O_CNT);
    int* sel = (int*)(lds + O_SEL);
    float* selw = (float*)(lds + O_SELW);
    int* ltok = (int*)(p.ws + WS_LTOK); float* lw = (float*)(p.ws + WS_LW);
    const int tid = threadIdx.x, lane = tid & 63, wave = tid >> 6;
    const int ntok = (L == 0 ? NTOK : NLAT), TS = (L == 0 ? 144 : 128), nmt = ntok / TS, RW = TS / 8;
    for (int mt = blockIdx.x; mt < nmt; mt += gridDim.x) {
        const int t0 = mt * TS;
        if (tid < 64) lcnt[tid] = 0;
#pragma unroll 2
        for (int q = 0; q < RW; ++q) {
            const int tok = t0 + wave * RW + q;
            const u32x2* yr = (const u32x2*)(Y + (size_t)tok * D) + lane;
            u32x2* xo = (u32x2*)x_row(p, tok) + lane;
            f32x4 v[4];
            if (L == 0) {
                const f32x4* xi = (const f32x4*)x_in_row(p, tok) + lane;
#pragma unroll
                for (int j = 0; j < 4; ++j) { const f32x4 a = xi[64 * j]; const u32x2 y = yr[64 * j]; v[j] = (f32x4){a.x + lo16(y.x), a.y + hi16(y.x), a.z + lo16(y.y), a.w + hi16(y.y)}; }
            } else {
#pragma unroll
                for (int j = 0; j < 4; ++j) { const u32x2 a = xo[64 * j]; const u32x2 y = yr[64 * j]; v[j] = (f32x4){lo16(a.x) + lo16(y.x), hi16(a.x) + hi16(y.x), lo16(a.y) + lo16(y.y), hi16(a.y) + hi16(y.y)}; }
            }
#pragma unroll
            for (int j = 0; j < 4; ++j) { u32x2 w; w.x = cvtpk(v[j].x, v[j].y); w.y = cvtpk(v[j].z, v[j].w); xo[64 * j] = w; }
            norm_mod_store(p, L, 1, tok, lane, v, (bf16_t*)(p.ws + WS_H));
        }
        asm volatile("s_waitcnt vmcnt(0)" ::: "memory");
        __syncthreads();
        auto rs = [&](int pr) { return H + (size_t)(t0 + (pr < TS ? pr : TS - 1)) * D; };
        auto epi = [&](int r, int c, f32x4 v) { if (c < 64) { float* d = lg + r * 65 + c; d[0] = v.x; d[1] = v.y; d[2] = v.z; d[3] = v.w; } };
        gemm_tile<5>(lds, rs, W, D, D, epi);
        __syncthreads();
        if (tid < TS) {
            const float* rbp = p.in[21] + L * NEXP; const float* lrow = lg + tid * 65;
            float bv[6], bs[6]; int bi[6];
#pragma unroll
            for (int k = 0; k < 6; ++k) { bv[k] = -INFINITY; bs[k] = 0.f; bi[k] = 0; }
#pragma unroll 4
            for (int e = 0; e < NEXP; ++e) {
                float sc = __builtin_amdgcn_rcpf(1.f + __expf(-lrow[e])); float sv = sc + rbp[e]; int ei = e;
#pragma unroll
                for (int k = 0; k < 6; ++k) { const bool gt = sv > bv[k]; const float tv = gt ? bv[k] : sv, ts = gt ? bs[k] : sc; const int ti = gt ? bi[k] : ei;
                    bv[k] = gt ? sv : bv[k]; bs[k] = gt ? sc : bs[k]; bi[k] = gt ? ei : bi[k]; sv = tv; sc = ts; ei = ti; }
            }
            const float rs6 = 2.5f / (bs[0] + bs[1] + bs[2] + bs[3] + bs[4] + bs[5]);
#pragma unroll
            for (int k = 0; k < 6; ++k) { const int rank = atomicAdd(&lcnt[bi[k]], 1); sel[tid * 6 + k] = (bi[k] << 8) | rank; selw[tid * 6 + k] = bs[k] * rs6; }
        }
        __syncthreads();
        if (tid < 64) {
            unsigned* ecnt = (unsigned*)(p.ws + WS_CTL) + CW_ECNT + L * 4096;
            const int c = lcnt[tid];
            lcnt[64 + tid] = c ? (int)atomicAdd(ecnt + tid * 64, (unsigned)c) : 0;
        }
        __syncthreads();
        for (int i = tid; i < TS * 6; i += NTHREADS) {
            const int sv = sel[i], e = sv >> 8, pos = lcnt[64 + e] + (sv & 255), tok = t0 + i / 6, k = i % 6;
            ltok[(size_t)e * LCAP + pos] = tok * 8 + k;
            lw[(size_t)e * LCAP + pos] = selw[i];
        }
        __syncthreads();
    }
}

__device__ __forceinline__ void build_etab(unsigned char* lds, const P& p, int L) {
    int* tstart = (int*)(lds + ETAB_OFF); int* cnt = tstart + 80;
    __syncthreads();
    if (threadIdx.x < 64) { const unsigned* ecnt = (const unsigned*)(p.ws + WS_CTL) + CW_ECNT + L * 4096;
        cnt[threadIdx.x] = (int)__hip_atomic_load(ecnt + threadIdx.x * 64, __ATOMIC_RELAXED, __HIP_MEMORY_SCOPE_AGENT); }
    __syncthreads();
    if (threadIdx.x == 0) { int s = 0; for (int e = 0; e < 64; ++e) { tstart[e] = s; s += (cnt[e] + 255) >> 8; } tstart[64] = s; s += (L == 0 ? NTOK : NLAT) / 256; tstart[65] = s; }
    __syncthreads();
}
struct MoeOrder {
    int TT, nN, G, c; const int* tstart; const char* Bexp; size_t bexp; const char* Bsh; size_t btile; const int* rowbuf; unsigned arow; bool ident;
    __device__ __forceinline__ bool next(int i, ge::Unit& u) const {
        const int Lq = i * G + c; if (Lq >= TT * nN) return false;
        const int t = Lq / nN, pn = Lq % nN;
        int lo = 0, hi = 64;
        while (lo < hi) { const int mid = (lo + hi + 1) >> 1; if (tstart[mid] <= t) lo = mid; else hi = mid - 1; }
        const int e = __builtin_amdgcn_readfirstlane(lo);
        u.a = t; u.b = pn; u.c = e; u.d = i;
        u.B = (e < 64 ? Bexp + (size_t)e * bexp : Bsh) + (size_t)pn * btile;
        return true;
    }
    __device__ __forceinline__ unsigned aoff(int i, const ge::Unit& u, int R) const { return (unsigned)(ident ? u.a * 256 + R : rowbuf[i * 256 + R]) * arow; }
};
__device__ __forceinline__ void phase_gateup(unsigned char* lds, const P& p, int L) {
    build_etab(lds, p, L);
    const int* tstart = (const int*)(lds + ETAB_OFF); const int* cnt = tstart + 80;
    int* rowbuf = (int*)(lds + RB0_OFF); float* wbuf = (float*)(lds + RB1_OFF);
    const int* ltok = (const int*)(p.ws + WS_LTOK); const float* lw = (const float*)(p.ws + WS_LW);
    bf16_t* ACT = (bf16_t*)(p.ws + WS_ACT);
    const int G = gridDim.x, bid = blockIdx.x, vcu = (G % 8 == 0) ? (bid % 8) * (G / 8) + bid / 8 : bid;
    MoeOrder S; S.TT = tstart[65]; S.nN = 2; S.G = G; S.c = vcu; S.tstart = tstart; S.Bexp = (const char*)(p.ws + WS_EGU); S.bexp = (size_t)512 * D * 2;
    S.Bsh = (const char*)((const bf16_t*)(p.ws + WS_SHGU) + (size_t)L * 512 * D); S.btile = (size_t)256 * D * 2; S.rowbuf = rowbuf; S.arow = D * 2; S.ident = false;
    {
        ge::Unit u;
        for (int i = 0; i < 10 && S.next(i, u); ++i) {
            if (threadIdx.x < 256) {
                const int R = threadIdx.x, e = u.c, mt = u.a - tstart[e];
                int tok; float w;
                if (e < 64) { const int lp = mt * 256 + R; const bool ok = lp < cnt[e]; tok = ok ? (ltok[(size_t)e * LCAP + lp] >> 3) : 0; w = ok ? lw[(size_t)e * LCAP + lp] : 0.f; }
                else { tok = mt * 256 + R; w = 1.f; }
                rowbuf[i * 256 + R] = tok; wbuf[i * 256 + R] = w;
            }
        }
        __syncthreads();
    }
    auto f = [&](const ge::Unit& u, int r, int c, f32x4 v0, f32x4 v1) {
        const float w = wbuf[u.d * 256 + r];
        u32x2 o; o.x = cvtpk(siluf(v0.x) * v0.y * w, siluf(v0.z) * v0.w * w); o.y = cvtpk(siluf(v1.x) * v1.y * w, siluf(v1.z) * v1.w * w);
        *(u32x2*)(ACT + (size_t)(u.a * 256 + r) * EDIM + ((u.b * 256 + c) >> 1)) = o;
    };
    ge::EpiFn<decltype(f)> E{f};
    ge::gemm_stream<MoeOrder, ge::EpiFn<decltype(f)>, true>((LAS unsigned char*)lds, (const char*)(p.ws + WS_H), D, S, E);
}
__device__ __forceinline__ void phase_down(unsigned char* lds, const P& p, int L) {
    build_etab(lds, p, L);
    const int* tstart = (const int*)(lds + ETAB_OFF); const int* cnt = tstart + 80;
    int* sbuf = (int*)(lds + RB0_OFF);
    const int* ltok = (const int*)(p.ws + WS_LTOK);
    unsigned char* SLOT = (unsigned char*)(p.ws + WS_SLOT);
    const int G = gridDim.x, bid = blockIdx.x, vcu = (G % 8 == 0) ? (bid % 8) * (G / 8) + bid / 8 : bid;
    MoeOrder S; S.TT = tstart[65]; S.nN = 4; S.G = G; S.c = vcu; S.tstart = tstart; S.Bexp = (const char*)(p.ws + WS_ED); S.bexp = (size_t)D * EDIM * 2;
    S.Bsh = (const char*)((const bf16_t*)(p.ws + WS_SHD) + (size_t)L * D * EDIM); S.btile = (size_t)256 * EDIM * 2; S.rowbuf = sbuf; S.arow = EDIM * 2; S.ident = true;
    {
        ge::Unit u;
        for (int i = 0; i < 18 && S.next(i, u); ++i) {
            if (threadIdx.x < 256) {
                const int R = threadIdx.x, e = u.c, mt = u.a - tstart[e];
                int srow;
                if (e < 64) { const int lp = mt * 256 + R; if (lp < cnt[e]) { const int ent = ltok[(size_t)e * LCAP + lp]; srow = (ent >> 3) * 7 + (ent & 7); } else srow = NTOK * 7; }
                else srow = (mt * 256 + R) * 7 + 6;
                sbuf[i * 256 + R] = srow;
            }
        }
        __syncthreads();
    }
    auto f = [&](const ge::Unit& u, int r, int c, f32x4 v0, f32x4 v1) {
        const int srow = sbuf[u.d * 256 + r];
        int w0 = 0, w1 = 0;
        w0 = __builtin_amdgcn_cvt_pk_fp8_f32(__builtin_amdgcn_fmed3f(v0.x, -440.f, 440.f), __builtin_amdgcn_fmed3f(v0.y, -440.f, 440.f), w0, false);
        w0 = __builtin_amdgcn_cvt_pk_fp8_f32(__builtin_amdgcn_fmed3f(v0.z, -440.f, 440.f), __builtin_amdgcn_fmed3f(v0.w, -440.f, 440.f), w0, true);
        w1 = __builtin_amdgcn_cvt_pk_fp8_f32(__builtin_amdgcn_fmed3f(v1.x, -440.f, 440.f), __builtin_amdgcn_fmed3f(v1.y, -440.f, 440.f), w1, false);
        w1 = __builtin_amdgcn_cvt_pk_fp8_f32(__builtin_amdgcn_fmed3f(v1.z, -440.f, 440.f), __builtin_amdgcn_fmed3f(v1.w, -440.f, 440.f), w1, true);
        u32x2 w; w.x = (unsigned)w0; w.y = (unsigned)w1; *(u32x2*)(SLOT + (size_t)srow * D + u.b * 256 + c) = w;
    };
    ge::EpiFn<decltype(f)> E{f};
    ge::gemm_stream<MoeOrder, ge::EpiFn<decltype(f)>, true>((LAS unsigned char*)lds, (const char*)(p.ws + WS_ACT), EDIM, S, E);
}
__device__ __forceinline__ void phase_combine(const P& p, int L) {
    const int tid = threadIdx.x, lane = tid & 63, wave = tid >> 6, gw = blockIdx.x * NWAVES + wave, NGW = gridDim.x * NWAVES;
    const unsigned char* SLOT = (const unsigned char*)(p.ws + WS_SLOT);
    const float* modv = (const float*)(p.ws + WS_MODV) + (size_t)L * 17 * 6144;
    const int ntok = (L == 0 ? NTOK : NLAT);
    for (int tok = gw; tok < ntok; tok += NGW) {
        f32x4 acc[4];
#pragma unroll
        for (int j = 0; j < 4; ++j) acc[j] = (f32x4){0.f, 0.f, 0.f, 0.f};
#pragma unroll
        for (int k = 0; k < 7; ++k) {
            const int* sr = (const int*)(SLOT + ((size_t)tok * 7 + k) * D) + lane;
#pragma unroll
            for (int j = 0; j < 4; ++j) { const int w = sr[64 * j]; const f32x2_t a = __builtin_amdgcn_cvt_pk_f32_fp8(w, false), b = __builtin_amdgcn_cvt_pk_f32_fp8(w, true); acc[j].x += a.x; acc[j].y += a.y; acc[j].z += b.x; acc[j].w += b.y; }
        }
        const float* g2 = modv + (size_t)mod_row(tok) * 6144 + 5120;
        u32x2* xr = (u32x2*)x_row(p, tok) + lane;
        f32x4 v[4];
#pragma unroll
        for (int j = 0; j < 4; ++j) { const f32x4 g = *(const f32x4*)(g2 + 4 * lane + 256 * j); const u32x2 a = xr[64 * j];
            v[j] = (f32x4){lo16(a.x), hi16(a.x), lo16(a.y), hi16(a.y)} + g * acc[j]; }
        if (L == 0) {
#pragma unroll
            for (int j = 0; j < 4; ++j) { u32x2 w; w.x = cvtpk(v[j].x, v[j].y); w.y = cvtpk(v[j].z, v[j].w); xr[64 * j] = w; }
            norm_mod_store(p, 1, 0, tok, lane, v, (bf16_t*)(p.ws + WS_H1));
        } else {
            const float* nw = p.in[28]; float s = 0.f;
#pragma unroll
            for (int j = 0; j < 4; ++j) s += v[j].x * v[j].x + v[j].y * v[j].y + v[j].z * v[j].z + v[j].w * v[j].w;
            const float rstd = rsqrtf(wave_sum(s) * (1.f / D) + NORM_EPS);
            f32x4* orow = (f32x4*)(p.out + (size_t)tok * D) + lane;
#pragma unroll
            for (int j = 0; j < 4; ++j) { const f32x4 w4 = *(const f32x4*)(nw + 4 * lane + 256 * j); orow[64 * j] = v[j] * rstd * w4; }
        }
    }
}

constexpr int PH_LAYER0 = 2, PH_PER_LAYER = 8, PH_LAYER1 = PH_LAYER0 + PH_PER_LAYER, NPHASES = PH_LAYER1 + PH_PER_LAYER;

__global__ void __launch_bounds__(NTHREADS, 2) mk_fwd(P p) {
    extern __shared__ __attribute__((aligned(16))) unsigned char lds[];
    volatile LAS unsigned* MISC = (volatile LAS unsigned*)((LAS unsigned char*)lds + MISC_OFF);
    if (threadIdx.x < 64) MISC[threadIdx.x] = 0u;
    __syncthreads();
    unsigned* ctl = (unsigned*)(p.ws + WS_CTL);
    XcdBarrier bar; bar.bar = ctl + CW_BAR; bar.x = 0; bar.st = MISC + 8;
    if (!MK_PER_PHASE) bar = xcd_barrier_post(ctl + CW_BAR, MISC + 8);
    const int lo = p.ph_lo, hi = p.ph_hi;
#ifndef PH_MASK
#define PH_MASK 0xffffu
#endif
#define HAS(b) ((PH_MASK >> (b)) & 1u)
#define IN(k) (lo <= (k) && (k) < hi)
#define SEAM(k) do { if (IN(k) && IN((k) + 1)) xcd_barrier(bar); } while (0)

#ifdef PROBE_MASK
    unsigned long long tacc = 0ull, t0p = 0ull;
#define PT0() t0p = __builtin_amdgcn_s_memrealtime()
#define PT1(b) do { if ((PROBE_MASK >> (b)) & 1u) tacc += __builtin_amdgcn_s_memrealtime() - t0p; } while (0)
#else
#define PT0() do {} while (0)
#define PT1(b) do {} while (0)
#endif
#define PH(b, k, body) do { PT0(); if (HAS(b) && IN(k)) { body; } SEAM(k); PT1(b); } while (0)
    PH(0, 0, phase_prep0(lds, p));
    PH(1, 1, (phase_prep1(lds, p), phase_norm_mod(p, 0, 0, NTOK)));
#define LAYER(L, pb) \
        PH(2, pb + 0, phase_zgemm(lds, p, L)); \
        PH(3, pb + 1, phase_b(lds, p, L)); \
        PH(4, pb + 2, phase_c(lds, p, L)); \
        PH(5, pb + 3, phase_d(lds, p, L)); \
        PH(7, pb + 4, phase_router(lds, p, L)); \
        PH(8, pb + 5, phase_gateup(lds, p, L)); \
        PH(9, pb + 6, phase_down(lds, p, L)); \
        PH(10, pb + 7, phase_combine(p, L));
    LAYER(0, PH_LAYER0)
    LAYER(1, PH_LAYER1)
#ifdef PROBE_MASK
    if (blockIdx.x == 0) {
        const unsigned long long tend = __builtin_amdgcn_s_memrealtime();
        while (__builtin_amdgcn_s_memrealtime() - tend < (unsigned long long)PROBE_AMP * tacc) __builtin_amdgcn_s_sleep(8);
    }
#endif
#undef IN
#undef SEAM
}

extern "C" void kernel_launch(void* const* d_in, const int* in_sizes, int n_in, void* d_out, int out_size, void* d_ws, size_t ws_size, hipStream_t stream) {
    static int grid = 0;
    if (grid == 0) {
        if (n_in != 29 || in_sizes[0] != NLAT * D || out_size != NLAT * D || ws_size < WS_END) {
            fprintf(stderr, "kernel_launch: unexpected shapes / workspace (n_in %d, ws %zu, need %zu); nothing launched\n", n_in, ws_size, (size_t)WS_END); grid = -1; return; }
        int dev = 0, cus = 0, per_cu = 0;
        if (hipGetDevice(&dev) != hipSuccess || hipDeviceGetAttribute(&cus, hipDeviceAttributeMultiprocessorCount, dev) != hipSuccess) { grid = -1; return; }
        if (hipFuncSetAttribute((const void*)mk_fwd, hipFuncAttributeMaxDynamicSharedMemorySize, LDS_BYTES) != hipSuccess) { grid = -1; return; }
        if (hipOccupancyMaxActiveBlocksPerMultiprocessor(&per_cu, (const void*)mk_fwd, NTHREADS, LDS_BYTES) != hipSuccess || per_cu < 1) { fprintf(stderr, "kernel_launch: occupancy query says %d\n", per_cu); }
        (void)hipGetLastError();
        grid = cus;
    }
    if (grid < 0) return;
    (void)hipMemsetAsync((char*)d_ws + WS_CTL, 0, CTL_ZERO_BYTES, stream);
    P a{};
    for (int i = 0; i < 29; ++i) a.in[i] = (const float*)d_in[i];
    a.out = (float*)d_out; a.ws = (unsigned char*)d_ws;
#if MK_PER_PHASE
    for (int ph = 0; ph < NPHASES; ++ph) { a.ph_lo = ph; a.ph_hi = ph + 1; hipLaunchKernelGGL(mk_fwd, dim3(grid), dim3(NTHREADS), LDS_BYTES, stream, a); }
#else
    a.ph_lo = 0; a.ph_hi = NPHASES;
    hipLaunchKernelGGL(mk_fwd, dim3(grid), dim3(NTHREADS), LDS_BYTES, stream, a);
#endif
}
```

```cpp
#include <hip/hip_runtime.h>
#include <cstdio>
#include <cstdint>

#ifndef MK_PER_PHASE
#define MK_PER_PHASE 0
#endif

typedef unsigned short bf16_t;
typedef short bf16x8 __attribute__((ext_vector_type(8)));
typedef float f32x4 __attribute__((ext_vector_type(4)));
typedef unsigned u32x4 __attribute__((ext_vector_type(4)));
typedef unsigned u32x2 __attribute__((ext_vector_type(2)));
typedef float f32x16 __attribute__((ext_vector_type(16)));
typedef short v4i16_t __attribute__((ext_vector_type(4)));
#define LAS __attribute__((address_space(3)))

constexpr int D = 1024, BATCH = 16, SEQ = 2048, CTXL = 256;
constexpr int NLAT = BATCH * SEQ, NCTX = BATCH * CTXL, NTOK = NLAT + NCTX;
constexpr int ZC = 1792;
constexpr int Z_RQ = 512, Z_RK = 640, Z_RV = 768, Z_RG = 1024, Z_CQ = 1280, Z_CKV = 1536, Z_KR = 1664, Z_END = 1696;
constexpr int NEXP = 64, TOPK = 6, EDIM = 256;
constexpr float NORM_EPS = 1e-6f;
constexpr int NTHREADS = 512, NWAVES = 8;

constexpr size_t MiB = 1u << 20;
constexpr size_t WS_CTL = 0, CTL_ZERO_BYTES = 1 * MiB;
constexpr size_t WS_MODV = 1 * MiB;
constexpr size_t WS_ROPE = 2 * MiB;
constexpr size_t WS_WIN = 3 * MiB;
constexpr size_t WS_WUQ = 10 * MiB;
constexpr size_t WS_WUKV = 11 * MiB;
constexpr size_t WS_WOUT = 12 * MiB;
constexpr size_t WS_RT = 16 * MiB;
constexpr size_t WS_SHGU = 17 * MiB;
constexpr size_t WS_SHD = 19 * MiB;
constexpr size_t WS_EGU = 20 * MiB;
constexpr size_t WS_ED = 84 * MiB;
constexpr size_t WS_H1 = 20 * MiB;
constexpr size_t WS_X = 116 * MiB;
constexpr size_t WS_H = 188 * MiB;
constexpr size_t WS_CC = WS_H;
constexpr size_t WS_Z = 260 * MiB;
constexpr size_t WS_Y = WS_Z;
constexpr size_t WS_Q = 386 * MiB;
constexpr size_t WS_K = 440 * MiB;
constexpr size_t WS_V = 494 * MiB;
constexpr size_t WS_KV = 530 * MiB;
constexpr size_t WS_SLOT = 188 * MiB;
constexpr size_t WS_ACT = 441 * MiB;
constexpr size_t WS_LTOK = 583 * MiB;
constexpr size_t WS_LW = 592 * MiB;
constexpr size_t WS_SS = 601 * MiB;
constexpr size_t WS_END = 603 * MiB;
constexpr int LCAP = NTOK;
static_assert(WS_SLOT + ((size_t)NTOK * 7 + 1) * 1024 <= WS_ACT && WS_ACT + (size_t)1136 * 256 * 512 <= WS_LTOK, "MoE buffers");

constexpr int CW_TMO = 0;
constexpr int CW_BAR = 4096;
constexpr int CW_ECNT = 8192;

constexpr int LDS_BYTES = 162816;
constexpr int MISC_OFF = LDS_BYTES - 256;
constexpr int RB0_OFF = 131072;
constexpr int RB1_OFF = 149504;
constexpr int ETAB_OFF = 159744;
constexpr int GEMM_LDS = 36864;
constexpr int ROWSS_OFF = 36864;
constexpr int LG_OFF = 37376;

#define XB_TMO      128
#define XB_XCNT(j)  (256  + 64 * (j))
#define XB_XSUB(j)  (1280 + 64 * (j))
#define XB_XGEN(j)  (2304 + 64 * (j))
#define XB_TOP      3328
#define XB_TOPGEN   3392
#define XCD_BAR_WORDS 3456
#define XB_SPIN_CAP (1u << 24)
__device__ __forceinline__ unsigned xb_ld(unsigned* p)              { return __hip_atomic_load(p, __ATOMIC_RELAXED, __HIP_MEMORY_SCOPE_AGENT); }
__device__ __forceinline__ unsigned xb_add(unsigned* p, unsigned v) { return __hip_atomic_fetch_add(p, v, __ATOMIC_RELAXED, __HIP_MEMORY_SCOPE_AGENT); }
__device__ __forceinline__ unsigned xb_xcc_id() { return (unsigned)__builtin_amdgcn_s_getreg((3 << 11) | 20) & 0xFu; }
#define XB_SPIN(cond, bar) do { unsigned _sp = 0; while (cond) { __builtin_amdgcn_s_sleep(1); \
    if ((++_sp & 255u) == 0u) { if (xb_ld(&(bar)[XB_TMO])) break; if (_sp > XB_SPIN_CAP) { atomicAdd(&(bar)[XB_TMO], 1u); break; } } } } while (0)
struct XcdBarrier { unsigned* bar; unsigned x; volatile LAS unsigned* st; };
__device__ __forceinline__ XcdBarrier xcd_barrier_post(unsigned* bar, volatile LAS unsigned* st) {
    XcdBarrier b; b.bar = bar; b.x = xb_xcc_id(); b.st = st;
    if (threadIdx.x == 0) (void)xb_add(&bar[XB_XCNT(b.x)], 1u);
    return b;
}
__device__ __forceinline__ void xcd_barrier_complete(unsigned* bar, unsigned x, unsigned& nloc, unsigned& nx) {
    const unsigned G = gridDim.x * gridDim.y * gridDim.z;
    unsigned sum, cnt, mine, sp = 0u;
    for (;;) {
        sum = 0u; cnt = 0u; mine = 0u;
#pragma unroll
        for (unsigned j = 0; j < 16; ++j) { const unsigned c = xb_ld(&bar[XB_XCNT(j)]); sum += c; cnt += (c > 0u) ? 1u : 0u; mine = (j == x) ? c : mine; }
        if (sum == G) break;
        __builtin_amdgcn_s_sleep(1);
        if ((++sp & 255u) == 0u) { if (xb_ld(&bar[XB_TMO])) break; if (sp > XB_SPIN_CAP) { atomicAdd(&bar[XB_TMO], 1u); break; } }
    }
    nloc = mine > 0u ? mine : 1u; nx = cnt > 0u ? cnt : 1u;
}
__device__ __forceinline__ void xcd_barrier(const XcdBarrier& b) {
    asm volatile("s_waitcnt vmcnt(0)" ::: "memory");
    __syncthreads();
    if (threadIdx.x == 0) {
        unsigned* bar = b.bar;
        __builtin_amdgcn_s_waitcnt(0);
        unsigned nloc = b.st[0], nx = b.st[1];
        if (nloc == 0u) { xcd_barrier_complete(bar, b.x, nloc, nx); b.st[0] = nloc; b.st[1] = nx; }
        const unsigned old = xb_add(&bar[XB_XSUB(b.x)], 1u);
        const unsigned gen = old / nloc;
        if (old + 1u == (gen + 1u) * nloc) {
            __builtin_amdgcn_fence(__ATOMIC_RELEASE, "agent");
            asm volatile("s_waitcnt vmcnt(0)" ::: "memory");
            const unsigned og = xb_add(&bar[XB_TOP], 1u);
            const unsigned tg = og / nx;
            if (og + 1u == (tg + 1u) * nx) xb_add(&bar[XB_TOPGEN], 1u);
            else XB_SPIN(xb_ld(&bar[XB_TOPGEN]) == tg, bar);
            __builtin_amdgcn_fence(__ATOMIC_ACQUIRE, "agent");
            xb_add(&bar[XB_XGEN(b.x)], 1u);
            asm volatile("s_waitcnt vmcnt(0)" ::: "memory");
        } else {
            XB_SPIN(xb_ld(&bar[XB_XGEN(b.x)]) == gen, bar);
            __builtin_amdgcn_fence(__ATOMIC_ACQUIRE, "agent");
            asm volatile("s_waitcnt vmcnt(0)" ::: "memory");
        }
    }
    __syncthreads();
}

__device__ __forceinline__ float bf2f(unsigned h) { return __uint_as_float(h << 16); }
__device__ __forceinline__ unsigned f2bf(float f) { unsigned u = __float_as_uint(f); return (u + 0x7fffu + ((u >> 16) & 1u)) >> 16; }
__device__ __forceinline__ unsigned pk2(float lo, float hi) { return f2bf(lo) | (f2bf(hi) << 16); }
typedef float f32x2_t __attribute__((ext_vector_type(2)));
typedef __bf16 bf16x2_t __attribute__((ext_vector_type(2)));
__device__ __forceinline__ unsigned cvtpk(float lo, float hi) { f32x2_t v = {lo, hi}; bf16x2_t b = __builtin_convertvector(v, bf16x2_t); return __builtin_bit_cast(unsigned, b); }
__device__ __forceinline__ float lo16(unsigned w) { return __uint_as_float(w << 16); }
__device__ __forceinline__ float hi16(unsigned w) { return __uint_as_float(w & 0xffff0000u); }
__device__ __forceinline__ float wave_sum(float v) {
#pragma unroll
    for (int o = 1; o < 64; o <<= 1) v += __shfl_xor(v, o);
    return v;
}
__device__ __forceinline__ float siluf(float v) { return v * __builtin_amdgcn_rcpf(1.f + __expf(-v)); }
__device__ __forceinline__ int mod_row(int tok) { return tok < NLAT ? (tok >> 11) : 16; }

struct P { const float* in[29]; float* out; unsigned char* ws; int ph_lo, ph_hi; };

__device__ __forceinline__ bf16_t* x_row(const P& p, int tok) { return (bf16_t*)(p.ws + WS_X) + (size_t)tok * D; }
__device__ __forceinline__ const float* x_in_row(const P& p, int tok) {
    return tok < NLAT ? p.in[0] + (size_t)tok * D : p.in[2] + (size_t)(tok - NLAT) * D;
}

template <int MF, class RowSrc, class Epi>
__device__ __forceinline__ void gemm_tile(unsigned char* lds, const RowSrc& rs, const bf16_t* Bt, int ldb, int K, const Epi& epi) {
    constexpr int ROWS = 32 * MF, NPA = ROWS * 8;
    const int tid = threadIdx.x, lane = tid & 63, wid = tid >> 6, wr = wid >> 2, wc = wid & 3, fr = lane & 15, fq = lane >> 4;
    bf16_t* As = (bf16_t*)lds; bf16_t* Bs = As + ROWS * 72;
    const bf16_t* ap[3]; int al[3];
#pragma unroll
    for (int i = 0; i < 3; ++i) { const int id = tid + 512 * i, r = id >> 3, c = (id & 7) * 8; ap[i] = (id < NPA) ? rs(r) + c : nullptr; al[i] = r * 72 + c; }
    const int lr = tid >> 2, lc = (tid & 3) * 16;
    const bf16_t* bp = Bt + (size_t)lr * ldb + lc;
    u32x4 a[3], b0 = *(const u32x4*)bp, b1 = *(const u32x4*)(bp + 8);
#pragma unroll
    for (int i = 0; i < 3; ++i) if (ap[i]) a[i] = *(const u32x4*)ap[i];
    f32x4 acc[MF][2];
#pragma unroll
    for (int m = 0; m < MF; ++m)
#pragma unroll
        for (int n = 0; n < 2; ++n) acc[m][n] = (f32x4){0.f, 0.f, 0.f, 0.f};
    for (int k0 = 0; k0 < K; k0 += 64) {
        __syncthreads();
#pragma unroll
        for (int i = 0; i < 3; ++i) if (ap[i]) *(u32x4*)(As + al[i]) = a[i];
        *(u32x4*)(Bs + lr * 72 + lc) = b0; *(u32x4*)(Bs + lr * 72 + lc + 8) = b1;
        __syncthreads();
        if (k0 + 64 < K) {
#pragma unroll
            for (int i = 0; i < 3; ++i) if (ap[i]) { ap[i] += 64; a[i] = *(const u32x4*)ap[i]; }
            bp += 64; b0 = *(const u32x4*)bp; b1 = *(const u32x4*)(bp + 8);
        }
#pragma unroll
        for (int kk = 0; kk < 2; ++kk) {
            bf16x8 af[MF], bfr[2];
#pragma unroll
            for (int m = 0; m < MF; ++m) af[m] = *(const bf16x8*)(As + (wr * 16 * MF + m * 16 + fr) * 72 + kk * 32 + fq * 8);
#pragma unroll
            for (int n = 0; n < 2; ++n) bfr[n] = *(const bf16x8*)(Bs + (wc * 32 + n * 16 + fr) * 72 + kk * 32 + fq * 8);
#pragma unroll
            for (int m = 0; m < MF; ++m)
#pragma unroll
                for (int n = 0; n < 2; ++n) acc[m][n] = __builtin_amdgcn_mfma_f32_16x16x32_bf16(bfr[n], af[m], acc[m][n], 0, 0, 0);
        }
    }
#pragma unroll
    for (int m = 0; m < MF; ++m)
#pragma unroll
        for (int n = 0; n < 2; ++n) epi(wr * 16 * MF + m * 16 + fr, wc * 32 + n * 16 + 4 * fq, acc[m][n]);
}

namespace ge {
constexpr int BM = 256, BK = 64, HALF = 128, HTB = HALF * BK * 2;
__device__ __forceinline__ int lds_byte(int r, int c) { const int st = (r >> 4) * 2 + (c >> 5), rr = r & 15, cc = c & 31, ob = rr * 64 + cc * 2; return st * 1024 + (ob ^ (((ob >> 9) & 1) << 5)); }
__device__ __forceinline__ void stage_rc(int b, int& R, int& C) { const int st = b / 1024, sb = b % 1024, swz = sb ^ (((sb >> 9) & 1) << 5); R = (st >> 1) * 16 + swz / 64; C = (st & 1) * 32 + (swz % 64) / 2; }
struct Unit { const char* B; int a, b, c, d; };
typedef f32x4 Acc[2][2][4][2];

template <class Sched, class Epi, bool ALIGN_EPI>
__device__ __forceinline__ void gemm_stream(LAS unsigned char* lds, const char* Ab, int K, const Sched& S, const Epi& E) {
    const int tid = threadIdx.x, wid = __builtin_amdgcn_readfirstlane(tid >> 6), lane = tid & 63, wr = wid >> 2, wc = wid & 3, fr = lane & 15, fq = lane >> 4;
    const int nt = K / BK;
    int Rr[2], Cc[2]; unsigned voffB[2];
#pragma unroll
    for (int i = 0; i < 2; ++i) { stage_rc(tid * 16 + i * 8192, Rr[i], Cc[i]);
        const int rho = Rr[i] & 31, Rb = (Rr[i] & ~31) + 8 * ((rho & 15) >> 2) + 4 * (rho >> 4) + (rho & 3);
        voffB[i] = (unsigned)(Rb * K + Cc[i]) * 2u; }
    const size_t kstep = (size_t)(BK * 2), hstepB = (size_t)HALF * K * 2;
    const unsigned ldsw = (unsigned)wid * 1024u;
    const int aoff = lds_byte(wr * 64 + fr, fq * 8), boff = lds_byte(wc * 32 + fr, fq * 8);
#define GE_SA(b, h) (((b) * 2 + (h)) * HTB)
#define GE_SB(b, h) ((4 + (b) * 2 + (h)) * HTB)
#define GE_GLDS(gp, ldsoff) __builtin_amdgcn_global_load_lds((const unsigned*)(gp), (LAS unsigned*)(lds + (ldsoff)), 16, 0, 0)
#define GE_STAGE_B(bufoff, gbase) do { GE_GLDS((const char*)(gbase) + voffB[0], (bufoff) + ldsw); GE_GLDS((const char*)(gbase) + voffB[1], (bufoff) + ldsw + 8192); } while (0)
#define GE_STAGE_A(bufoff, kbytes, o0, o1) do { GE_GLDS(Ab + (kbytes) + (o0), (bufoff) + ldsw); GE_GLDS(Ab + (kbytes) + (o1), (bufoff) + ldsw + 8192); } while (0)
#define GE_LDA(dst, b, h) do { _Pragma("unroll") for (int m = 0; m < 4; ++m) _Pragma("unroll") for (int k = 0; k < 2; ++k) dst[m][k] = *(const LAS bf16x8*)(lds + GE_SA(b, h) + aoff + m * 2048 + k * 1024); } while (0)
#define GE_LDB(dst, b, h) do { _Pragma("unroll") for (int n = 0; n < 2; ++n) _Pragma("unroll") for (int k = 0; k < 2; ++k) dst[n][k] = *(const LAS bf16x8*)(lds + GE_SB(b, h) + boff + n * 2048 + k * 1024); } while (0)
#define GE_MMA(ai, bj, At, Bt) do { __builtin_amdgcn_s_setprio(1); _Pragma("unroll") for (int m = 0; m < 4; ++m) _Pragma("unroll") for (int n = 0; n < 2; ++n) _Pragma("unroll") for (int k = 0; k < 2; ++k) \
        acc[ai][bj][m][n] = __builtin_amdgcn_mfma_f32_16x16x32_bf16(Bt[n][k], At[m][k], acc[ai][bj][m][n], 0, 0, 0); __builtin_amdgcn_s_setprio(0); } while (0)
#define GE_WAIT_V(n) asm volatile("s_waitcnt vmcnt(" #n ")" ::: "memory")
#define GE_WAIT_L(n) asm volatile("s_waitcnt lgkmcnt(" #n ")" ::: "memory")
#define GE_BAR __builtin_amdgcn_s_barrier()
#define GE_SCHED __builtin_amdgcn_sched_barrier(0)
    Unit cur, nxt; int ui = 0;
    if (!S.next(0, cur)) return;
    Acc acc;
#pragma unroll
    for (int a = 0; a < 2; ++a)
#pragma unroll
        for (int b = 0; b < 2; ++b)
#pragma unroll
            for (int m = 0; m < 4; ++m)
#pragma unroll
                for (int n = 0; n < 2; ++n) acc[a][b][m][n] = (f32x4){0.f, 0.f, 0.f, 0.f};
    bf16x8 At[4][2], B0[2][2], B1[2][2];
    unsigned oc00, oc01, oc10, oc11, on00, on01, on10, on11;
    oc00 = S.aoff(0, cur, Rr[0]) + (unsigned)Cc[0] * 2u; oc01 = S.aoff(0, cur, Rr[1]) + (unsigned)Cc[1] * 2u;
    oc10 = S.aoff(0, cur, Rr[0] + 128) + (unsigned)Cc[0] * 2u; oc11 = S.aoff(0, cur, Rr[1] + 128) + (unsigned)Cc[1] * 2u;
    const char* cB = cur.B;
    GE_STAGE_B(GE_SB(0, 0), cB); GE_STAGE_B(GE_SB(0, 1), cB + hstepB); GE_STAGE_A(GE_SA(0, 0), 0, oc00, oc01); GE_STAGE_A(GE_SA(0, 1), 0, oc10, oc11);
    if (wr == 1) GE_BAR;
    GE_WAIT_V(2); GE_BAR;
    GE_STAGE_B(GE_SB(1, 0), cB + kstep); GE_STAGE_A(GE_SA(1, 0), kstep, oc00, oc01); GE_STAGE_B(GE_SB(1, 1), cB + hstepB + kstep);
    GE_WAIT_V(6); GE_BAR;
    for (;;) {
        const bool has_next = S.next(ui + 1, nxt);
        const char* nB = has_next ? nxt.B : cB;
        if (has_next) {
            on00 = S.aoff(ui + 1, nxt, Rr[0]) + (unsigned)Cc[0] * 2u; on01 = S.aoff(ui + 1, nxt, Rr[1]) + (unsigned)Cc[1] * 2u;
            on10 = S.aoff(ui + 1, nxt, Rr[0] + 128) + (unsigned)Cc[0] * 2u; on11 = S.aoff(ui + 1, nxt, Rr[1] + 128) + (unsigned)Cc[1] * 2u;
        } else { on00 = oc00; on01 = oc01; on10 = oc10; on11 = oc11; }
#pragma unroll 1
        for (int t = 0; t < nt; t += 2) {
            const bool last = (t == nt - 2);
            const size_t k1 = (size_t)(t + 1) * kstep;
            const size_t k2 = last ? 0 : (size_t)(t + 2) * kstep, k3 = k2 + kstep;
            const char* b2 = last ? nB : cB + (size_t)(t + 2) * kstep; const char* b3 = b2 + kstep;
            const unsigned o00 = last ? on00 : oc00, o01 = last ? on01 : oc01, o10 = last ? on10 : oc10, o11 = last ? on11 : oc11;
            GE_LDB(B0, 0, 0); GE_LDB(B1, 0, 1); GE_SCHED; GE_LDA(At, 0, 0); GE_STAGE_A(GE_SA(1, 1), k1, oc10, oc11);
            GE_WAIT_V(8); GE_WAIT_L(0); GE_BAR; GE_MMA(0, 0, At, B0); GE_MMA(0, 1, At, B1); GE_BAR; GE_SCHED;
            GE_LDA(At, 0, 1); GE_STAGE_B(GE_SB(0, 0), b2); GE_STAGE_B(GE_SB(0, 1), b2 + hstepB); GE_STAGE_A(GE_SA(0, 0), k2, o00, o01);
            GE_WAIT_V(8); GE_WAIT_L(0); GE_BAR; GE_MMA(1, 0, At, B0); GE_MMA(1, 1, At, B1); GE_BAR; GE_SCHED;
            GE_LDB(B0, 1, 0); GE_LDB(B1, 1, 1); GE_SCHED; GE_LDA(At, 1, 0); GE_STAGE_A(GE_SA(0, 1), k2, o10, o11);
            GE_WAIT_V(8); GE_WAIT_L(0); GE_BAR; GE_MMA(0, 0, At, B0); GE_MMA(0, 1, At, B1); GE_BAR; GE_SCHED;
            GE_LDA(At, 1, 1); GE_STAGE_B(GE_SB(1, 0), b3); GE_STAGE_B(GE_SB(1, 1), b3 + hstepB); GE_STAGE_A(GE_SA(1, 0), k3, o00, o01);
            GE_WAIT_V(8); GE_WAIT_L(0); GE_BAR; GE_MMA(1, 0, At, B0); GE_MMA(1, 1, At, B1); GE_BAR; GE_SCHED;
        }
        if constexpr (ALIGN_EPI) { if (wr == 0) GE_BAR; }
        E(acc, cur, wr, wc, fr, fq);
        if (!has_next) break;
#pragma unroll
        for (int a = 0; a < 2; ++a)
#pragma unroll
            for (int b = 0; b < 2; ++b)
#pragma unroll
                for (int m = 0; m < 4; ++m)
#pragma unroll
                    for (int n = 0; n < 2; ++n) acc[a][b][m][n] = (f32x4){0.f, 0.f, 0.f, 0.f};
        cur = nxt; cB = nB; ++ui; oc00 = on00; oc01 = on01; oc10 = on10; oc11 = on11;
        if constexpr (ALIGN_EPI) { if (wr == 1) GE_BAR; }
    }
    GE_WAIT_V(0);
    if constexpr (!ALIGN_EPI) { if (wr == 0) GE_BAR; }
    GE_BAR;
#undef GE_SA
#undef GE_SB
#undef GE_GLDS
#undef GE_STAGE_A
#undef GE_STAGE_B
#undef GE_LDA
#undef GE_LDB
#undef GE_MMA
#undef GE_WAIT_V
#undef GE_WAIT_L
#undef GE_BAR
#undef GE_SCHED
}
template <class F> struct EpiFn {
    F f;
    __device__ __forceinline__ void operator()(const Acc& acc, const Unit& u, int wr, int wc, int fr, int fq) const {
#pragma unroll
        for (int ai = 0; ai < 2; ++ai)
#pragma unroll
            for (int m = 0; m < 4; ++m)
#pragma unroll
                for (int bj = 0; bj < 2; ++bj) f(u, ai * 128 + wr * 64 + m * 16 + fr, bj * 128 + wc * 32 + 8 * fq, acc[ai][bj][m][0], acc[ai][bj][m][1]);
    }
};
struct DenseOrder {
    int nM, nN, nwg, G, c; const char* Bt; size_t btile; unsigned arow;
    __device__ __forceinline__ bool next(int i, Unit& u) const {
        const long L = (long)i * G + c; if (L >= nwg) return false;
        int wgid = (int)L; { const int q = nwg / 8, r = nwg % 8, xcd = wgid % 8, off = wgid / 8; wgid = (xcd < r ? xcd * (q + 1) : r * (q + 1) + (xcd - r) * q) + off; }
        const int nig = 8 * nN, gid = wgid / nig, fm = gid * 8, gsz = (nM - fm) < 8 ? (nM - fm) : 8;
        u.a = fm + ((wgid % nig) % gsz); u.b = (wgid % nig) / gsz; u.c = 0; u.d = 0; u.B = Bt + (size_t)u.b * btile; return true;
    }
    __device__ __forceinline__ unsigned aoff(int, const Unit& u, int R) const { return (unsigned)(u.a * 256 + R) * arow; }
};
}

struct TMap { const float* s0; const float* s1; int ld; int nvalid; const float* ksc; float gsc; };
template <int MODE> __device__ __forceinline__ const float* tmap_src(const float* s0, const float* s1, int nvalid, int n) {
    if (MODE == 0) return n < nvalid ? s0 + n : nullptr;
    if (MODE == 1) { const int h = n / 96, j = n % 96; const int c = j < 64 ? j : 64 + ((j - 64) & 1) * 16 + ((j - 64) >> 1); return s0 + h * 96 + c; }
    return ((n & 1) ? s1 : s0) + (n >> 1);
}
template <int MODE> __device__ __forceinline__ void transpose_unit(float* scr, const float* s0, const float* s1, int ld, int nvalid, const float* ksc, float gsc, int K, bf16_t* dst, int kb, int nb, int kvalid = 1 << 30) {
    const int tid = threadIdx.x, k0 = kb * 64, n0 = nb * 64;
    const int nn = tid & 63; const float* sp = tmap_src<MODE>(s0, s1, nvalid, n0 + nn);
#pragma unroll
    for (int i = 0; i < 8; ++i) {
        const int kk = (tid >> 6) + 8 * i; float v = (sp && k0 + kk < kvalid) ? sp[(size_t)(k0 + kk) * ld] : 0.f;
        if (ksc && k0 + kk < kvalid) v *= ksc[k0 + kk];
        scr[kk * 65 + nn] = v * gsc;
    }
    __syncthreads();
    {
        const int n2 = tid >> 3, kc = tid & 7; const float* s = scr + (kc * 8) * 65 + n2;
        u32x4 o; o.x = pk2(s[0], s[65]); o.y = pk2(s[2 * 65], s[3 * 65]); o.z = pk2(s[4 * 65], s[5 * 65]); o.w = pk2(s[6 * 65], s[7 * 65]);
        *(u32x4*)(dst + (size_t)(n0 + n2) * K + k0 + kc * 8) = o;
    }
    __syncthreads();
}
template <int MODE> __device__ __forceinline__ void transpose_matrix(float* scr, const float* s0, const float* s1, int ld, int nvalid, const float* ksc, float gsc, int K, int Nd, bf16_t* dst, int& rot, int kvalid = 1 << 30) {
    const int nkb = K / 64, nnb = Nd / 64, nu = nkb * nnb, G = gridDim.x;
    int first = ((int)blockIdx.x - rot) % G; if (first < 0) first += G;
    for (int u = first; u < nu; u += G) transpose_unit<MODE>(scr, s0, s1, ld, nvalid, ksc, gsc, K, dst, u / nnb, u % nnb, kvalid);
    rot = (rot + nu) % G;
}
__device__ __forceinline__ void convert_expert_weights(unsigned char* lds, const P& p, int L) {
    float* scr = (float*)lds; const int G = gridDim.x, tid = threadIdx.x;
    constexpr int S = 261;
    bf16_t* egu = (bf16_t*)(p.ws + WS_EGU); bf16_t* ed = (bf16_t*)(p.ws + WS_ED);
    for (int ub = blockIdx.x; ub < NEXP * 48; ub += G) {
        const int e = ub / 48, r = (ub % 48) * 4;
        bf16_t* dst; int K, k0;
        if (r < 128) {
            const int kb = r >> 3, nb0 = r & 7; k0 = kb * 64; K = D; dst = egu + ((size_t)e * 512 + nb0 * 64) * D;
            const float* gsrc = p.in[22] + ((size_t)L * NEXP + e) * D * EDIM + nb0 * 32; const float* usrc = p.in[23] + ((size_t)L * NEXP + e) * D * EDIM + nb0 * 32;
            f32x4 v[8];
#pragma unroll
            for (int i = 0; i < 8; ++i) { const int idx = tid + 512 * i, kk = idx >> 6, c = idx & 63; v[i] = *(const f32x4*)((c < 32 ? gsrc : usrc) + (size_t)(k0 + kk) * EDIM + (c & 31) * 4); }
#pragma unroll
            for (int i = 0; i < 8; ++i) { const int idx = tid + 512 * i, kk = idx >> 6, c = idx & 63; float* d = scr + kk * S + 8 * (c & 31) + (c >> 5);
                d[0] = v[i].x; d[2] = v[i].y; d[4] = v[i].z; d[6] = v[i].w; }
        } else {
            const int r2 = r - 128, kb = r2 >> 4, nb0 = r2 & 15; k0 = kb * 64; K = EDIM; dst = ed + ((size_t)e * D + nb0 * 64) * EDIM;
            const float* src = p.in[24] + ((size_t)L * NEXP + e) * EDIM * D + nb0 * 64;
            f32x4 v[8];
#pragma unroll
            for (int i = 0; i < 8; ++i) { const int idx = tid + 512 * i, kk = idx >> 6, c = idx & 63; v[i] = *(const f32x4*)(src + (size_t)(k0 + kk) * D + c * 4); }
#pragma unroll
            for (int i = 0; i < 8; ++i) { const int idx = tid + 512 * i, kk = idx >> 6, c = idx & 63; float* d = scr + kk * S + 4 * c;
                d[0] = v[i].x; d[1] = v[i].y; d[2] = v[i].z; d[3] = v[i].w; }
        }
        __syncthreads();
#pragma unroll
        for (int i = 0; i < 4; ++i) {
            const int id = tid + 512 * i, n = id >> 3, kc = id & 7; const float* sp = scr + (kc * 8) * S + n;
            u32x4 o; o.x = cvtpk(sp[0], sp[S]); o.y = cvtpk(sp[2 * S], sp[3 * S]); o.z = cvtpk(sp[4 * S], sp[5 * S]); o.w = cvtpk(sp[6 * S], sp[7 * S]);
            *(u32x4*)(dst + (size_t)n * K + k0 + kc * 8) = o;
        }
        __syncthreads();
    }
}
__device__ __forceinline__ void prep_mod_unit(unsigned char* lds, const P& p, int u) {
    float* sc = (float*)lds;
    float* part = sc + 17 * 1024;
    const int tid = threadIdx.x;
    const float* c = p.in[1]; const float* cctx = p.in[3];
    for (int i = tid; i < 17 * 1024; i += NTHREADS) { const int r = i >> 10, k = i & 1023; const float v = r < 16 ? c[r * 1024 + k] : cctx[k]; sc[i] = v * __builtin_amdgcn_rcpf(1.f + __expf(-v)); }
    __syncthreads();
    const int L = u / 192, cg = u % 192, ks = tid >> 5, cl = tid & 31, col = cg * 32 + cl;
    const float* w = p.in[4] + (size_t)L * 1024 * 6144 + (size_t)(ks * 64) * 6144 + col;
    float acc[17];
#pragma unroll
    for (int r = 0; r < 17; ++r) acc[r] = 0.f;
#pragma unroll 8
    for (int k = 0; k < 64; ++k) {
        const float wv = w[(size_t)k * 6144];
#pragma unroll
        for (int r = 0; r < 17; ++r) acc[r] += sc[r * 1024 + ks * 64 + k] * wv;
    }
#pragma unroll
    for (int r = 0; r < 17; ++r) part[(ks * 17 + r) * 32 + cl] = acc[r];
    __syncthreads();
    float* modv = (float*)(p.ws + WS_MODV);
    for (int i = tid; i < 17 * 32; i += NTHREADS) {
        const int r = i >> 5, c2 = i & 31;
        float s2 = p.in[5][L * 6144 + cg * 32 + c2];
#pragma unroll
        for (int q = 0; q < 16; ++q) s2 += part[(q * 17 + r) * 32 + c2];
        modv[((size_t)L * 17 + r) * 6144 + cg * 32 + c2] = s2;
    }
    __syncthreads();
}
__device__ __forceinline__ void phase_prep0(unsigned char* lds, const P& p) {
    const int tid = threadIdx.x, G = gridDim.x, bid = blockIdx.x;
    {
        float* ct = (float*)(p.ws + WS_ROPE); float* st = ct + 2048 * 16;
        for (int i = bid * NTHREADS + tid; i < 2048 * 16; i += G * NTHREADS) {
            const int pos = i >> 4, f = i & 15;
            const float inv = powf(10000.f, -(float)(f & 7) / 8.f);
            const float ang = (float)(f < 8 ? (pos >> 6) : (pos & 63)) * inv;
            ct[i] = cosf(ang); st[i] = sinf(ang);
        }
    }
    for (int u = bid; u < 384; u += G) prep_mod_unit(lds, p, u);
}
__device__ __forceinline__ void phase_prep1(unsigned char* lds, const P& p) {
    float* scr = (float*)lds; int rot = 0;
    for (int L = 0; L < 2; ++L) {
        transpose_matrix<0>(scr, p.in[7] + (size_t)L * D * Z_END, nullptr, Z_END, Z_END, nullptr, 1.f, D, ZC, (bf16_t*)(p.ws + WS_WIN) + (size_t)L * ZC * D, rot);
        transpose_matrix<1>(scr, p.in[15] + (size_t)L * 256 * 768, nullptr, 768, 768, p.in[14] + L * 256, 0.14724574f, 256, 768, (bf16_t*)(p.ws + WS_WUQ) + (size_t)L * 768 * 256, rot);
        transpose_matrix<0>(scr, p.in[17] + (size_t)L * 128 * 1024, nullptr, 1024, 1024, p.in[16] + L * 128, 1.f, 256, 1024, (bf16_t*)(p.ws + WS_WUKV) + (size_t)L * 1024 * 256, rot, 128);
        transpose_matrix<0>(scr, p.in[18] + (size_t)L * D * D, nullptr, D, D, nullptr, 1.f, D, D, (bf16_t*)(p.ws + WS_WOUT) + (size_t)L * D * D, rot);
        transpose_matrix<0>(scr, p.in[20] + (size_t)L * D * NEXP, nullptr, NEXP, NEXP, nullptr, 1.f, D, 128, (bf16_t*)(p.ws + WS_RT) + (size_t)L * 128 * D, rot);
        transpose_matrix<2>(scr, p.in[25] + (size_t)L * D * EDIM, p.in[26] + (size_t)L * D * EDIM, EDIM, 512, nullptr, 1.f, D, 512, (bf16_t*)(p.ws + WS_SHGU) + (size_t)L * 512 * D, rot);
        transpose_matrix<0>(scr, p.in[27] + (size_t)L * EDIM * D, nullptr, D, D, nullptr, 1.f, EDIM, D, (bf16_t*)(p.ws + WS_SHD) + (size_t)L * D * EDIM, rot);
    }
}

__device__ __forceinline__ void phase_norm_mod(const P& p, int L, int which  , int ntok) {
    const int tid = threadIdx.x, lane = tid & 63, wave = tid >> 6, gw = blockIdx.x * NWAVES + wave, NGW = gridDim.x * NWAVES;
    const float* nw = (which == 0 ? p.in[6] : p.in[19]) + L * D;
    const float* modv = (const float*)(p.ws + WS_MODV) + (size_t)L * 17 * 6144;
    bf16_t* H = (bf16_t*)(p.ws + WS_H);
    for (int tok = gw; tok < ntok; tok += NGW) {
        const f32x4* xr = (const f32x4*)x_in_row(p, tok) + lane;
        const float* mrow = modv + (size_t)mod_row(tok) * 6144 + which * 3072;
        f32x4 v[4]; float s = 0.f;
#pragma unroll
        for (int j = 0; j < 4; ++j) { v[j] = xr[64 * j]; s += v[j].x * v[j].x + v[j].y * v[j].y + v[j].z * v[j].z + v[j].w * v[j].w; }
        const float rstd = rsqrtf(wave_sum(s) * (1.f / D) + NORM_EPS);
        u32x2* o = (u32x2*)(H + (size_t)tok * D) + lane;
#pragma unroll
        for (int j = 0; j < 4; ++j) {
            const int k = 4 * lane + 256 * j;
            const f32x4 w4 = *(const f32x4*)(nw + k), sh = *(const f32x4*)(mrow + k), sc = *(const f32x4*)(mrow + 1024 + k);
            const float y0 = v[j].x * rstd * w4.x * (1.f + sc.x) + sh.x, y1 = v[j].y * rstd * w4.y * (1.f + sc.y) + sh.y;
            const float y2 = v[j].z * rstd * w4.z * (1.f + sc.z) + sh.z, y3 = v[j].w * rstd * w4.w * (1.f + sc.w) + sh.w;
            u32x2 w; w.x = pk2(y0, y1); w.y = pk2(y2, y3); o[64 * j] = w;
        }
    }
}

struct EpiZ {
    bf16_t* Z; float* ssq; float* sskv; bf16_t* Kb; const float* ct; const float* st;
    __device__ __forceinline__ void operator()(const ge::Acc& acc, const ge::Unit& u, int wr, int wc, int fr, int fq) const {
#pragma unroll
        for (int ai = 0; ai < 2; ++ai)
#pragma unroll
            for (int m = 0; m < 4; ++m) {
                const int row = u.a * 256 + ai * 128 + wr * 64 + m * 16 + fr;
#pragma unroll
                for (int bj = 0; bj < 2; ++bj) {
                    const f32x4 v0 = acc[ai][bj][m][0], v1 = acc[ai][bj][m][1];
                    u32x4 w; w.x = cvtpk(v0.x, v0.y); w.y = cvtpk(v0.z, v0.w); w.z = cvtpk(v1.x, v1.y); w.w = cvtpk(v1.z, v1.w);
                    *(u32x4*)(Z + (size_t)row * ZC + u.b * 256 + bj * 128 + wc * 32 + 8 * fq) = w;
                }
                if (u.b == 5) {
                    float sq = 0.f;
#pragma unroll
                    for (int bj = 0; bj < 2; ++bj)
#pragma unroll
                        for (int n = 0; n < 2; ++n) { const f32x4 v = acc[ai][bj][m][n]; sq += v.x * v.x + v.y * v.y + v.z * v.z + v.w * v.w; }
                    sq += __shfl_xor(sq, 16); sq += __shfl_xor(sq, 32);
                    if (fq == 0) ssq[(size_t)row * 4 + wc] = sq;
                }
                if (u.b == 6) {
                    float sq = 0.f;
#pragma unroll
                    for (int n = 0; n < 2; ++n) { const f32x4 v = acc[ai][0][m][n]; sq += v.x * v.x + v.y * v.y + v.z * v.z + v.w * v.w; }
                    sq += __shfl_xor(sq, 16); sq += __shfl_xor(sq, 32);
                    if (fq == 0) sskv[(size_t)row * 4 + wc] = sq;
                    if (wc == 0) {
                        const f32x4 a0 = acc[ai][1][m][0], a1 = acc[ai][1][m][1];
                        f32x4 b0, b1;
#pragma unroll
                        for (int j = 0; j < 4; ++j) { b0[j] = __shfl_xor(a0[j], 32); b1[j] = __shfl_xor(a1[j], 32); }
                        if (fq < 2) {
                            f32x4 c0 = (f32x4){1.f, 1.f, 1.f, 1.f}, c1 = c0, s0 = (f32x4){0.f, 0.f, 0.f, 0.f}, s1 = s0;
                            if (row < NLAT) { const int pos = row & (SEQ - 1); c0 = *(const f32x4*)(ct + pos * 16 + 8 * fq); c1 = *(const f32x4*)(ct + pos * 16 + 8 * fq + 4); s0 = *(const f32x4*)(st + pos * 16 + 8 * fq); s1 = *(const f32x4*)(st + pos * 16 + 8 * fq + 4); }
                            const f32x4 o10 = a0 * c0 - b0 * s0, o20 = a0 * s0 + b0 * c0, o11 = a1 * c1 - b1 * s1, o21 = a1 * s1 + b1 * c1;
                            u32x4 w0, w1; w0.x = cvtpk(o10.x, o20.x); w0.y = cvtpk(o10.y, o20.y); w0.z = cvtpk(o10.z, o20.z); w0.w = cvtpk(o10.w, o20.w);
                            w1.x = cvtpk(o11.x, o21.x); w1.y = cvtpk(o11.y, o21.y); w1.z = cvtpk(o11.z, o21.z); w1.w = cvtpk(o11.w, o21.w);
#pragma unroll
                            for (int h = 0; h < 8; ++h) { bf16_t* kp = Kb + (size_t)row * 768 + h * 96 + 64 + 16 * fq; *(u32x4*)kp = w0; *(u32x4*)(kp + 8) = w1; }
                        }
                    }
                }
            }
    }
};
__device__ __forceinline__ void phase_zgemm(unsigned char* lds, const P& p, int L) {
    const bf16_t* W = (const bf16_t*)(p.ws + WS_WIN) + (size_t)L * ZC * D;
    ge::DenseOrder S; S.nM = NTOK / 256; S.nN = ZC / 256; S.nwg = S.nM * S.nN; S.G = gridDim.x; S.c = blockIdx.x; S.Bt = (const char*)W; S.btile = (size_t)256 * D * 2; S.arow = D * 2;
    EpiZ E{(bf16_t*)(p.ws + WS_Z), (float*)(p.ws + WS_SS), (float*)(p.ws + WS_SS) + (size_t)NTOK * 4, (bf16_t*)(p.ws + WS_K), (const float*)(p.ws + WS_ROPE), (const float*)(p.ws + WS_ROPE) + 2048 * 16};
    ge::gemm_stream<ge::DenseOrder, EpiZ, true>((LAS unsigned char*)lds, (const char*)(p.ws + (L == 0 ? WS_H : WS_H1)), D, S, E);
}

__device__ __forceinline__ void conv_unit(unsigned char* lds, const P& p, int L, int s, int tt) {
    float* hg = (float*)lds;
    const int tid = threadIdx.x, lane = tid & 63, wave = tid >> 6;
    const int rb = s < 16 ? s * SEQ : NLAT + (s - 16) * CTXL, len = s < 16 ? SEQ : CTXL, t0 = tt * 64;
    const bf16_t* Z = (const bf16_t*)(p.ws + WS_Z);
    {
        u32x2 av[12], gv[12];
#pragma unroll
        for (int q = 0; q < 12; ++q) {
            const int i = tid + q * NTHREADS, jj = i >> 6, c4 = (i & 63) * 4; int t = t0 - 15 + jj; t = t < 0 ? 0 : (t >= len ? len - 1 : t);
            const bf16_t* zr = Z + (size_t)(rb + t) * ZC;
            av[q] = *(const u32x2*)(zr + c4); gv[q] = *(const u32x2*)(zr + 256 + c4);
        }
#pragma unroll
        for (int q = 0; q < 12; ++q) {
            const int i = tid + q * NTHREADS, jj = i >> 6, c4 = (i & 63) * 4, t = t0 - 15 + jj;
            if (i < 94 * 64) {
                f32x4 h = (f32x4){0.f, 0.f, 0.f, 0.f};
                if (t >= 0 && t < len) {
                    const u32x2 a = av[q], g = gv[q];
                    h.x = lo16(a.x) * __builtin_amdgcn_rcpf(1.f + __expf(-lo16(g.x))); h.y = hi16(a.x) * __builtin_amdgcn_rcpf(1.f + __expf(-hi16(g.x)));
                    h.z = lo16(a.y) * __builtin_amdgcn_rcpf(1.f + __expf(-lo16(g.y))); h.w = hi16(a.y) * __builtin_amdgcn_rcpf(1.f + __expf(-hi16(g.y)));
                }
                *(f32x4*)(hg + jj * 256 + c4) = h;
            }
        }
    }
    float* wl = hg + 94 * 256;
    for (int i = tid; i < 31 * 64; i += NTHREADS) *(f32x4*)(wl + i * 4) = *(const f32x4*)(p.in[8] + (size_t)L * 31 * 256 + i * 4);
    __syncthreads();
    const int c0 = lane * 4;
    const f32x4 cb = *(const f32x4*)(p.in[9] + L * 256 + c0), lw = *(const f32x4*)(p.in[10] + L * 256 + c0), lb = *(const f32x4*)(p.in[11] + L * 256 + c0);
    bf16_t* CC = (bf16_t*)(p.ws + WS_CC);
    {
        f32x4 w[31];
#pragma unroll
        for (int j = 0; j < 31; ++j) w[j] = *(const f32x4*)(wl + j * 256 + c0);
#pragma unroll 1
        for (int half = 0; half < 2; ++half) {
            f32x4 acc[4];
#pragma unroll
            for (int q = 0; q < 4; ++q) acc[q] = cb;
            const float* hrow = hg + (wave * 8 + half * 4) * 256 + c0;
#pragma unroll
            for (int r = 0; r < 34; ++r) {
                const f32x4 h = *(const f32x4*)(hrow + r * 256);
#pragma unroll
                for (int q = 0; q < 4; ++q) { if (r - q >= 0 && r - q <= 30) acc[q] += h * w[r - q]; }
            }
#pragma unroll
            for (int q = 0; q < 4; ++q) {
                const int tl = wave * 8 + half * 4 + q;
                const float mean = wave_sum(acc[q].x + acc[q].y + acc[q].z + acc[q].w) * (1.f / 256.f);
                const f32x4 d = acc[q] - mean;
                const float var = wave_sum(d.x * d.x + d.y * d.y + d.z * d.z + d.w * d.w) * (1.f / 256.f);
                const float rstd = rsqrtf(var + NORM_EPS);
                const f32x4 y = d * rstd * lw + lb;
                u32x2 o; o.x = cvtpk(siluf(y.x), siluf(y.y)); o.y = cvtpk(siluf(y.z), siluf(y.w));
                *(u32x2*)(CC + (size_t)(rb + t0 + tl) * D + c0) = o;
            }
        }
    }
    __syncthreads();
}

__device__ __forceinline__ float log2_gamma(const P& p, int L, int dir, int h) {
    const float x = p.in[12][(L * 2 + dir) * 4 + h];
    const float ls = fminf(x, 0.f) - log1pf(expf(-fabsf(x)));
    return ls * 1.4426950408889634f;
}
__device__ __forceinline__ void load_ret_qk(float* dst, const P& p, int gc, int h, int zoff, float scale) {
    const int tid = threadIdx.x, j = tid >> 2, i0 = (tid & 3) * 4, row = gc * 128 + j;
    const bf16_t* zr = (const bf16_t*)(p.ws + WS_Z) + (size_t)row * ZC + zoff + h * 32;
    const u32x2 a = *(const u32x2*)(zr + i0), b = *(const u32x2*)(zr + 16 + i0);
    float x1[4] = {lo16(a.x), hi16(a.x), lo16(a.y), hi16(a.y)}, x2[4] = {lo16(b.x), hi16(b.x), lo16(b.y), hi16(b.y)};
    const bool lat = row < NLAT; const int pos = row & (SEQ - 1);
    const float* ct = (const float*)(p.ws + WS_ROPE) + pos * 16 + i0; const float* st = ct + 2048 * 16;
#pragma unroll
    for (int i = 0; i < 4; ++i) {
        const float c = lat ? ct[i] : 1.f, s = lat ? st[i] : 0.f;
        dst[j * 33 + i0 + i] = (x1[i] * c - x2[i] * s) * scale;
        dst[j * 33 + 16 + i0 + i] = (x1[i] * s + x2[i] * c) * scale;
    }
}
__device__ __forceinline__ void load_ret_v(float* dst  , const P& p, int gc, int h) {
    const int tid = threadIdx.x, j = tid >> 2, e0 = (tid & 3) * 16;
    const bf16_t* zr = (const bf16_t*)(p.ws + WS_Z) + (size_t)(gc * 128 + j) * ZC + Z_RV + h * 64 + e0;
    const u32x4 a = *(const u32x4*)zr, b = *(const u32x4*)(zr + 8);
#pragma unroll
    for (int i = 0; i < 4; ++i) { dst[j * 64 + e0 + 2 * i] = lo16(a[i]); dst[j * 64 + e0 + 2 * i + 1] = hi16(a[i]); dst[j * 64 + e0 + 8 + 2 * i] = lo16(b[i]); dst[j * 64 + e0 + 8 + 2 * i + 1] = hi16(b[i]); }
}
__device__ __forceinline__ void retkv_unit(unsigned char* lds, const P& p, int L, int gc, int h) {
    float* ks = (float*)lds; float* vs = ks + 128 * 33; float* wf = vs + 128 * 64; float* wb = wf + 128;
    const int tid = threadIdx.x;
    const float l2f = log2_gamma(p, L, 0, h), l2b = log2_gamma(p, L, 1, h);
    load_ret_qk(ks, p, gc, h, Z_RK, 0.17677669529663687f);
    load_ret_v(vs, p, gc, h);
    if (tid < 128) { wf[tid] = exp2f(l2f * (float)(127 - tid)); wb[tid] = exp2f(l2b * (float)tid); }
    __syncthreads();
    const int d = tid >> 4, e0 = (tid & 15) * 4;
    f32x4 af = (f32x4){0.f, 0.f, 0.f, 0.f}, ab = af;
    for (int j = 0; j < 128; ++j) {
        const float kd = ks[j * 33 + d]; const f32x4 v4 = *(const f32x4*)(vs + j * 64 + e0);
        af += (kd * wf[j]) * v4; ab += (kd * wb[j]) * v4;
    }
    float* KV = (float*)(p.ws + WS_KV) + ((size_t)(gc * 4 + h) * 2) * 2048;
    *(f32x4*)(KV + d * 64 + e0) = af; *(f32x4*)(KV + 2048 + d * 64 + e0) = ab;
    __syncthreads();
}
__device__ __forceinline__ void ret_stage_k(unsigned char* kf, unsigned char* kb, int rowb, const P& p, int gc, int h, float ef, float jf0, float eb, float jb0) {
    const int tid = threadIdx.x, j = tid >> 2, i0 = (tid & 3) * 4, row = gc * 128 + j;
    const bf16_t* zr = (const bf16_t*)(p.ws + WS_Z) + (size_t)row * ZC + Z_RK + h * 32;
    const u32x2 a = *(const u32x2*)(zr + i0), b = *(const u32x2*)(zr + 16 + i0);
    const float x1[4] = {lo16(a.x), hi16(a.x), lo16(a.y), hi16(a.y)}, x2[4] = {lo16(b.x), hi16(b.x), lo16(b.y), hi16(b.y)};
    f32x4 c4 = (f32x4){1.f, 1.f, 1.f, 1.f}, s4 = (f32x4){0.f, 0.f, 0.f, 0.f};
    if (row < NLAT) { const int pos = row & (SEQ - 1); const float* ct = (const float*)(p.ws + WS_ROPE) + pos * 16 + i0; c4 = *(const f32x4*)ct; s4 = *(const f32x4*)(ct + 2048 * 16); }
    const float wf = __builtin_amdgcn_exp2f(ef * ((float)j - jf0)) * 0.17677669529663687f, wb = __builtin_amdgcn_exp2f(eb * ((float)j - jb0)) * 0.17677669529663687f;
    float o1[4], o2[4];
#pragma unroll
    for (int i = 0; i < 4; ++i) { o1[i] = x1[i] * c4[i] - x2[i] * s4[i]; o2[i] = x1[i] * s4[i] + x2[i] * c4[i]; }
    u32x2 w;
    w.x = cvtpk(o1[0] * wf, o1[1] * wf); w.y = cvtpk(o1[2] * wf, o1[3] * wf); *(u32x2*)(kf + j * rowb + i0 * 2) = w;
    w.x = cvtpk(o2[0] * wf, o2[1] * wf); w.y = cvtpk(o2[2] * wf, o2[3] * wf); *(u32x2*)(kf + j * rowb + 32 + i0 * 2) = w;
    w.x = cvtpk(o1[0] * wb, o1[1] * wb); w.y = cvtpk(o1[2] * wb, o1[3] * wb); *(u32x2*)(kb + j * rowb + i0 * 2) = w;
    w.x = cvtpk(o2[0] * wb, o2[1] * wb); w.y = cvtpk(o2[2] * wb, o2[3] * wb); *(u32x2*)(kb + j * rowb + 32 + i0 * 2) = w;
}
__device__ __forceinline__ void ret_stage_v(unsigned char* vt, const P& p, int gc, int h) {
    const int tid = threadIdx.x, j = tid >> 2, e0 = (tid & 3) * 16;
    const bf16_t* zr = (const bf16_t*)(p.ws + WS_Z) + (size_t)(gc * 128 + j) * ZC + Z_RV + h * 64 + e0;
    const u32x4 a = *(const u32x4*)zr, b = *(const u32x4*)(zr + 8);
    unsigned char* d = vt + (e0 >> 5) * 8192 + j * 64 + (e0 & 31) * 2;
    *(u32x4*)d = a; *(u32x4*)(d + 16) = b;
}
__device__ __forceinline__ bf16x8 tr8(const unsigned char* p0, const unsigned char* p1) {
    const v4i16_t a = __builtin_amdgcn_ds_read_tr16_b64_v4i16((LAS v4i16_t*)(const LAS unsigned char*)p0), b = __builtin_amdgcn_ds_read_tr16_b64_v4i16((LAS v4i16_t*)(const LAS unsigned char*)p1);
    return (bf16x8){a[0], a[1], a[2], a[3], b[0], b[1], b[2], b[3]};
}
__device__ __forceinline__ void retkv_unit_mfma(unsigned char* lds, const P& p, int L, int gc, int h) {
    const int tid = threadIdx.x, lane = tid & 63, wid = tid >> 6;
    const float l2f = log2_gamma(p, L, 0, h), l2b = log2_gamma(p, L, 1, h);
    ret_stage_k(lds, lds + 8192, 64, p, gc, h, -l2f, 127.f, l2b, 0.f);
    ret_stage_v(lds + 16384, p, gc, h);
    __syncthreads();
    if (wid < 4) {
        const int dir = wid >> 1, eb = wid & 1, g = lane >> 4, i = lane & 15, hh = lane >> 5;
        const int off = (8 * hh + (i >> 2)) * 64 + (g & 1) * 32 + (i & 3) * 8;
        const unsigned char* Kt = lds + dir * 8192 + off; const unsigned char* Vt = lds + 16384 + eb * 8192 + off;
        f32x16 acc;
#pragma unroll
        for (int r = 0; r < 16; ++r) acc[r] = 0.f;
#pragma unroll
        for (int s = 0; s < 8; ++s) acc = __builtin_amdgcn_mfma_f32_32x32x16_bf16(tr8(Vt + s * 1024, Vt + s * 1024 + 256), tr8(Kt + s * 1024, Kt + s * 1024 + 256), acc, 0, 0, 0);
        bf16_t* KV = (bf16_t*)(p.ws + WS_KV) + ((size_t)(gc * 4 + h) * 2 + dir) * 2048 + (lane & 31) * 64 + eb * 32 + 4 * hh;
#pragma unroll
        for (int r4 = 0; r4 < 4; ++r4) { u32x2 w; w.x = cvtpk(acc[4 * r4], acc[4 * r4 + 1]); w.y = cvtpk(acc[4 * r4 + 2], acc[4 * r4 + 3]); *(u32x2*)(KV + 8 * r4) = w; }
    }
    __syncthreads();
}
__device__ __forceinline__ void retout_unit_mfma(unsigned char* lds, const P& p, int L, int gc, int h) {
    constexpr int KROW = 80, O_KF = 0, O_KB = 10240, O_V = 20480, O_SF = 36864, O_SB = 41984, O_RED = 47104;
    const int tid = threadIdx.x, lane = tid & 63, wid = tid >> 6, r32 = lane & 31, hh = lane >> 5;
    const float l2f = log2_gamma(p, L, 0, h), l2b = log2_gamma(p, L, 1, h);
    const int qb = wid & 3, eb = wid >> 2, i = qb * 32 + r32, row = gc * 128 + i;
    const bf16_t* zq = (const bf16_t*)(p.ws + WS_Z) + (size_t)row * ZC + Z_RQ + h * 32 + 8 * hh;
    const u32x4 qa = *(const u32x4*)zq, qbv = *(const u32x4*)(zq + 16);
    f32x4 rc0 = (f32x4){1.f, 1.f, 1.f, 1.f}, rc1 = rc0, rs0 = (f32x4){0.f, 0.f, 0.f, 0.f}, rs1 = rs0;
    if (row < NLAT) { const float* ct = (const float*)(p.ws + WS_ROPE) + (row & (SEQ - 1)) * 16 + 8 * hh; const float* st = ct + 2048 * 16;
        rc0 = *(const f32x4*)ct; rc1 = *(const f32x4*)(ct + 4); rs0 = *(const f32x4*)st; rs1 = *(const f32x4*)(st + 4); }
    const bf16_t* zg = (const bf16_t*)(p.ws + WS_Z) + (size_t)row * ZC + Z_RG + h * 64 + eb * 32 + 4 * hh;
    const float* gw = p.in[13] + L * 256 + h * 64 + eb * 32 + 4 * hh;
    u32x2 gzv[4]; f32x4 gwv[4];
#pragma unroll
    for (int r4 = 0; r4 < 4; ++r4) { gzv[r4] = *(const u32x2*)(zg + 8 * r4); gwv[r4] = *(const f32x4*)(gw + 8 * r4); }
    const bool lat = gc < 256; const int b = lat ? gc >> 4 : (gc - 256) >> 1;
    u32x2 kvf[18], kvb[18];
    {
        const bf16_t* KVb = (const bf16_t*)(p.ws + WS_KV);
#pragma unroll
        for (int mm = 0; mm < 18; ++mm) {
            const int gcm = mm < 2 ? 256 + b * 2 + mm : b * 16 + (mm - 2);
            const bf16_t* kv = KVb + ((size_t)(gcm * 4 + h) * 2) * 2048 + tid * 4;
            kvf[mm] = *(const u32x2*)kv; kvb[mm] = *(const u32x2*)(kv + 2048);
        }
    }
    ret_stage_k(lds + O_KF, lds + O_KB, KROW, p, gc, h, -l2f, 0.f, l2b, 0.f);
    ret_stage_v(lds + O_V, p, gc, h);
    {
        const int mme = lat ? 2 + (gc & 15) : (gc - 256) & 1;
        const int u = mme, w = mme < 2 ? 1 - mme : 19 - mme;
        f32x4 sf = (f32x4){0.f, 0.f, 0.f, 0.f}, sb = sf;
#pragma unroll
        for (int mm = 0; mm < 18; ++mm) {
            const int um = mm, wm = mm < 2 ? 1 - mm : 19 - mm;
            const u32x2 kf2 = kvf[mm], kb2 = kvb[mm];
            const float wgf = um < u ? __builtin_amdgcn_exp2f(l2f * 128.f * (float)(u - 1 - um)) : 0.f;
            const float wgb = wm < w ? __builtin_amdgcn_exp2f(l2b * 128.f * (float)(w - 1 - wm)) : 0.f;
            sf += wgf * (f32x4){lo16(kf2.x), hi16(kf2.x), lo16(kf2.y), hi16(kf2.y)}; sb += wgb * (f32x4){lo16(kb2.x), hi16(kb2.x), lo16(kb2.y), hi16(kb2.y)};
        }
        const int d = tid >> 4, e0 = (tid & 15) * 4;
#pragma unroll
        for (int k = 0; k < 4; ++k) { *(bf16_t*)(lds + O_SF + (e0 + k) * KROW + d * 2) = (bf16_t)(cvtpk(sf[k], 0.f) & 0xffffu); *(bf16_t*)(lds + O_SB + (e0 + k) * KROW + d * 2) = (bf16_t)(cvtpk(sb[k], 0.f) & 0xffffu); }
    }
    __syncthreads();
    bf16x8 qf[2];
    {
        float x1[8], x2[8];
#pragma unroll
        for (int k = 0; k < 4; ++k) { x1[2 * k] = lo16(qa[k]); x1[2 * k + 1] = hi16(qa[k]); x2[2 * k] = lo16(qbv[k]); x2[2 * k + 1] = hi16(qbv[k]); }
#pragma unroll
        for (int k = 0; k < 8; ++k) { const float c = k < 4 ? rc0[k & 3] : rc1[k & 3], sn = k < 4 ? rs0[k & 3] : rs1[k & 3], u1 = x1[k], u2 = x2[k]; x1[k] = u1 * c - u2 * sn; x2[k] = u1 * sn + u2 * c; }
        const u32x4 q0 = (u32x4){cvtpk(x1[0], x1[1]), cvtpk(x1[2], x1[3]), cvtpk(x1[4], x1[5]), cvtpk(x1[6], x1[7])};
        const u32x4 q1 = (u32x4){cvtpk(x2[0], x2[1]), cvtpk(x2[2], x2[3]), cvtpk(x2[4], x2[5]), cvtpk(x2[6], x2[7])};
        qf[0] = __builtin_bit_cast(bf16x8, q0); qf[1] = __builtin_bit_cast(bf16x8, q1);
    }
    const float af = __builtin_amdgcn_exp2f(l2f * (float)i), ab = __builtin_amdgcn_exp2f(-l2b * (float)i), cf = __builtin_amdgcn_exp2f(l2f * (float)(i + 1)), cb = __builtin_amdgcn_exp2f(l2b * (float)(128 - i));
    f32x16 y, zero;
#pragma unroll
    for (int r = 0; r < 16; ++r) { y[r] = 0.f; zero[r] = 0.f; }
    const int koff = r32 * KROW + 16 * hh;
    const int voff = O_V + eb * 8192 + (4 * hh + ((lane & 15) >> 2)) * 64 + ((lane >> 4) & 1) * 32 + (lane & 3) * 8;
#pragma unroll
    for (int kb = 0; kb < 4; ++kb) {
        f32x16 pt;
        if (kb <= qb) {
            f32x16 sF = __builtin_amdgcn_mfma_f32_32x32x16_bf16(*(const bf16x8*)(lds + O_KF + kb * 32 * KROW + koff), qf[0], zero, 0, 0, 0);
            sF = __builtin_amdgcn_mfma_f32_32x32x16_bf16(*(const bf16x8*)(lds + O_KF + kb * 32 * KROW + koff + 32), qf[1], sF, 0, 0, 0);
            if (kb < qb) {
#pragma unroll
                for (int r = 0; r < 16; ++r) pt[r] = sF[r] * af;
            } else {
#pragma unroll
                for (int r = 0; r < 16; ++r) { const int j = (r & 3) + 8 * (r >> 2) + 4 * hh; pt[r] = (j <= r32) ? sF[r] * af : 0.f; }
            }
        }
        if (kb >= qb) {
            f32x16 sB = __builtin_amdgcn_mfma_f32_32x32x16_bf16(*(const bf16x8*)(lds + O_KB + kb * 32 * KROW + koff), qf[0], zero, 0, 0, 0);
            sB = __builtin_amdgcn_mfma_f32_32x32x16_bf16(*(const bf16x8*)(lds + O_KB + kb * 32 * KROW + koff + 32), qf[1], sB, 0, 0, 0);
            if (kb > qb) {
#pragma unroll
                for (int r = 0; r < 16; ++r) pt[r] = sB[r] * ab;
            } else {
#pragma unroll
                for (int r = 0; r < 16; ++r) { const int j = (r & 3) + 8 * (r >> 2) + 4 * hh; pt[r] += (j >= r32) ? sB[r] * ab : 0.f; }
            }
        }
#pragma unroll
        for (int s2 = 0; s2 < 2; ++s2) {
            const u32x4 pw = (u32x4){cvtpk(pt[8 * s2], pt[8 * s2 + 1]), cvtpk(pt[8 * s2 + 2], pt[8 * s2 + 3]), cvtpk(pt[8 * s2 + 4], pt[8 * s2 + 5]), cvtpk(pt[8 * s2 + 6], pt[8 * s2 + 7])};
            const unsigned char* vb = lds + voff + (kb * 32 + s2 * 16) * 64;
            y = __builtin_amdgcn_mfma_f32_32x32x16_bf16(tr8(vb, vb + 8 * 64), __builtin_bit_cast(bf16x8, pw), y, 0, 0, 0);
        }
    }
    {
        const int soff = (eb * 32 + r32) * KROW + 16 * hh;
        f32x16 tF = __builtin_amdgcn_mfma_f32_32x32x16_bf16(*(const bf16x8*)(lds + O_SF + soff), qf[0], zero, 0, 0, 0);
        tF = __builtin_amdgcn_mfma_f32_32x32x16_bf16(*(const bf16x8*)(lds + O_SF + soff + 32), qf[1], tF, 0, 0, 0);
        f32x16 tB = __builtin_amdgcn_mfma_f32_32x32x16_bf16(*(const bf16x8*)(lds + O_SB + soff), qf[0], zero, 0, 0, 0);
        tB = __builtin_amdgcn_mfma_f32_32x32x16_bf16(*(const bf16x8*)(lds + O_SB + soff + 32), qf[1], tB, 0, 0, 0);
#pragma unroll
        for (int r = 0; r < 16; ++r) y[r] += tF[r] * cf + tB[r] * cb;
    }
    float s1 = 0.f, s2 = 0.f;
#pragma unroll
    for (int r = 0; r < 16; ++r) { s1 += y[r]; s2 += y[r] * y[r]; }
    s1 += __shfl_xor(s1, 32); s2 += __shfl_xor(s2, 32);
    float* red = (float*)(lds + O_RED);
    if (hh == 0) { red[(eb * 128 + i) * 2] = s1; red[(eb * 128 + i) * 2 + 1] = s2; }
    __syncthreads();
    s1 = red[i * 2] + red[(128 + i) * 2]; s2 = red[i * 2 + 1] + red[(128 + i) * 2 + 1];
    const float mu = s1 * (1.f / 64.f), var = fmaxf(s2 * (1.f / 64.f) - mu * mu, 0.f), rstd = rsqrtf(var + NORM_EPS);
    bf16_t* orow = (bf16_t*)(p.ws + WS_CC) + (size_t)row * D + 256 + h * 64 + eb * 32 + 4 * hh;
#pragma unroll
    for (int r4 = 0; r4 < 4; ++r4) {
        const u32x2 gz = gzv[r4]; const f32x4 w4 = gwv[r4];
        const float g0 = lo16(gz.x), g1 = hi16(gz.x), g2 = lo16(gz.y), g3 = hi16(gz.y);
        u32x2 o; o.x = cvtpk(siluf(g0) * ((y[4 * r4] - mu) * rstd * w4.x), siluf(g1) * ((y[4 * r4 + 1] - mu) * rstd * w4.y));
        o.y = cvtpk(siluf(g2) * ((y[4 * r4 + 2] - mu) * rstd * w4.z), siluf(g3) * ((y[4 * r4 + 3] - mu) * rstd * w4.w));
        *(u32x2*)(orow + 8 * r4) = o;
    }
    __syncthreads();
}
__device__ __forceinline__ void qkv_proj(unsigned char* lds, const P& p, int L) {
    const float* sskv = (const float*)(p.ws + WS_SS) + (size_t)NTOK * 4;
    const int G = gridDim.x, bid = blockIdx.x;
    {
        bf16_t* Q = (bf16_t*)(p.ws + WS_Q);
        ge::DenseOrder S; S.nM = NTOK / 256; S.nN = 3; S.nwg = S.nM * 3; S.G = G; S.c = bid; S.Bt = (const char*)((const bf16_t*)(p.ws + WS_WUQ) + (size_t)L * 768 * 256); S.btile = (size_t)256 * 256 * 2; S.arow = ZC * 2;
        auto f = [&](const ge::Unit& u, int r, int c, f32x4 v0, f32x4 v1) {
            u32x4 w; w.x = cvtpk(v0.x, v0.y); w.y = cvtpk(v0.z, v0.w); w.z = cvtpk(v1.x, v1.y); w.w = cvtpk(v1.z, v1.w); *(u32x4*)(Q + (size_t)(u.a * 256 + r) * 768 + u.b * 256 + c) = w;
        };
        ge::EpiFn<decltype(f)> E{f};
        ge::gemm_stream<ge::DenseOrder, ge::EpiFn<decltype(f)>, true>((LAS unsigned char*)lds, (const char*)(p.ws + WS_Z) + Z_CQ * 2, 256, S, E);
    }
    {
        bf16_t* Kb = (bf16_t*)(p.ws + WS_K); bf16_t* Vb = (bf16_t*)(p.ws + WS_V);
        ge::DenseOrder S; S.nM = NTOK / 256; S.nN = 4; S.nwg = S.nM * 4; S.G = G; S.c = (bid + 176) % G; S.Bt = (const char*)((const bf16_t*)(p.ws + WS_WUKV) + (size_t)L * 1024 * 256); S.btile = (size_t)256 * 256 * 2; S.arow = ZC * 2;
        struct EpiKV {
            bf16_t* Kb; bf16_t* Vb; const float* sskv;
            __device__ __forceinline__ void operator()(const ge::Acc& acc, const ge::Unit& u, int wr, int wc, int fr, int fq) const {
                float rstd[2][4];
#pragma unroll
                for (int ai = 0; ai < 2; ++ai)
#pragma unroll
                    for (int m = 0; m < 4; ++m) { const f32x4 s4 = *(const f32x4*)(sskv + (size_t)(u.a * 256 + ai * 128 + wr * 64 + m * 16 + fr) * 4); rstd[ai][m] = rsqrtf((s4.x + s4.y + s4.z + s4.w) * (1.f / 128.f) + NORM_EPS); }
#pragma unroll
                for (int ai = 0; ai < 2; ++ai)
#pragma unroll
                    for (int m = 0; m < 4; ++m) {
                        const int row = u.a * 256 + ai * 128 + wr * 64 + m * 16 + fr;
#pragma unroll
                        for (int bj = 0; bj < 2; ++bj) {
                            const int col = u.b * 256 + bj * 128 + wc * 32 + 8 * fq, h = col >> 7, j = col & 127;
                            const f32x4 v0 = acc[ai][bj][m][0] * rstd[ai][m], v1 = acc[ai][bj][m][1] * rstd[ai][m];
                            u32x4 w; w.x = cvtpk(v0.x, v0.y); w.y = cvtpk(v0.z, v0.w); w.z = cvtpk(v1.x, v1.y); w.w = cvtpk(v1.z, v1.w);
                            if (j < 64) *(u32x4*)(Kb + (size_t)row * 768 + h * 96 + j) = w;
                            else *(u32x4*)(Vb + (size_t)row * 512 + h * 64 + (j - 64)) = w;
                        }
                    }
            }
        };
        EpiKV E{Kb, Vb, sskv};
        ge::gemm_stream<ge::DenseOrder, EpiKV, true>((LAS unsigned char*)lds, (const char*)(p.ws + WS_Z) + Z_CKV * 2, 256, S, E);
    }
}
__device__ __forceinline__ void phase_b(unsigned char* lds, const P& p, int L) {
    const int G = gridDim.x, bid = blockIdx.x;
    qkv_proj(lds, p, L);
    const int nconv = (L == 0) ? 576 : 512;
    const int nkv = 288 * 4;
    const int total = nconv + nkv;
    for (int u = (bid + 96) % G; u < total; u += G) {
        int r = u;
        if (r < nconv) { if (r < 512) conv_unit(lds, p, L, r >> 5, r & 31); else conv_unit(lds, p, L, 16 + ((r - 512) >> 2), (r - 512) & 3); continue; } r -= nconv;
        retkv_unit_mfma(lds, p, L, r >> 2, r & 3);
    }
    if (L == 1) convert_expert_weights(lds, p, 1);
}

__device__ __forceinline__ void attn_unit_naive(unsigned char* lds, const P& p, int b, int h, int qb, bool ctxq) {
    float* Ks = (float*)lds;
    float* Vs = Ks + 64 * 96;
    const int tid = threadIdx.x, half = tid & 1, qi = tid >> 1;
    const bf16_t* Qb = (const bf16_t*)(p.ws + WS_Q); const bf16_t* Kb = (const bf16_t*)(p.ws + WS_K); const bf16_t* Vb = (const bf16_t*)(p.ws + WS_V);
    const int qrow = ctxq ? NLAT + b * CTXL + qi : b * SEQ + qb * 256 + qi;
    float q[48];
    {
        const u32x4* qp = (const u32x4*)(Qb + (size_t)qrow * 768 + h * 96 + half * 48);
#pragma unroll
        for (int i = 0; i < 6; ++i) { const u32x4 w = qp[i];
#pragma unroll
            for (int k = 0; k < 4; ++k) { q[i * 8 + 2 * k] = lo16(w[k]); q[i * 8 + 2 * k + 1] = hi16(w[k]); } }
    }
    float o[32];
#pragma unroll
    for (int e = 0; e < 32; ++e) o[e] = 0.f;
    float m = -1e30f, l = 0.f;
    const int ntiles = ctxq ? 4 : 36;
#pragma unroll 1
    for (int t = 0; t < ntiles; ++t) {
        const int krow0 = t < 4 ? NLAT + b * CTXL + t * 64 : b * SEQ + (t - 4) * 64;
        __syncthreads();
        for (int i = tid; i < 64 * 12; i += NTHREADS) { const int key = i / 12, c = i % 12; const u32x4 w = *(const u32x4*)(Kb + (size_t)(krow0 + key) * 768 + h * 96 + c * 8);
            float* d = Ks + key * 96 + c * 8;
#pragma unroll
            for (int k = 0; k < 4; ++k) { d[2 * k] = lo16(w[k]); d[2 * k + 1] = hi16(w[k]); } }
        for (int i = tid; i < 64 * 8; i += NTHREADS) { const int key = i >> 3, c = i & 7; const u32x4 w = *(const u32x4*)(Vb + (size_t)(krow0 + key) * 512 + h * 64 + c * 8);
            float* d = Vs + key * 64 + c * 8;
#pragma unroll
            for (int k = 0; k < 4; ++k) { d[2 * k] = lo16(w[k]); d[2 * k + 1] = hi16(w[k]); } }
        __syncthreads();
#pragma unroll 1
        for (int j0 = 0; j0 < 64; j0 += 2) {
            float s[2]; float mt = -1e30f;
#pragma unroll
            for (int jj = 0; jj < 2; ++jj) {
                const f32x4* kr = (const f32x4*)(Ks + (j0 + jj) * 96 + half * 48);
                float a = 0.f;
#pragma unroll
                for (int d4 = 0; d4 < 12; ++d4) { const f32x4 kv = kr[d4]; a += q[4 * d4] * kv.x + q[4 * d4 + 1] * kv.y + q[4 * d4 + 2] * kv.z + q[4 * d4 + 3] * kv.w; }
                a += __shfl_xor(a, 1);
                s[jj] = a; mt = fmaxf(mt, a);
            }
            const float mn = fmaxf(m, mt), alpha = exp2f(m - mn);
            m = mn; l *= alpha;
#pragma unroll
            for (int e = 0; e < 32; ++e) o[e] *= alpha;
#pragma unroll
            for (int jj = 0; jj < 2; ++jj) {
                const float pj = exp2f(s[jj] - mn); l += pj;
                const f32x4* vr = (const f32x4*)(Vs + (j0 + jj) * 64 + half * 32);
#pragma unroll
                for (int e4 = 0; e4 < 8; ++e4) { const f32x4 vv = vr[e4]; o[4 * e4] += pj * vv.x; o[4 * e4 + 1] += pj * vv.y; o[4 * e4 + 2] += pj * vv.z; o[4 * e4 + 3] += pj * vv.w; }
            }
        }
    }
    {
        const float rl = 1.f / l;
        u32x4* op = (u32x4*)((bf16_t*)(p.ws + WS_CC) + (size_t)qrow * D + 512 + h * 64 + half * 32);
#pragma unroll
        for (int i = 0; i < 4; ++i) { u32x4 w; w.x = pk2(o[8 * i] * rl, o[8 * i + 1] * rl); w.y = pk2(o[8 * i + 2] * rl, o[8 * i + 3] * rl); w.z = pk2(o[8 * i + 4] * rl, o[8 * i + 5] * rl); w.w = pk2(o[8 * i + 6] * rl, o[8 * i + 7] * rl); op[i] = w; }
    }
    __syncthreads();
}
__device__ __forceinline__ float max3f(float a, float b, float c) { float r; asm("v_max3_f32 %0, %1, %2, %3" : "=v"(r) : "v"(a), "v"(b), "v"(c)); return r; }
constexpr int AT_KROW = 208;
constexpr int AT_KBUF = 64 * AT_KROW;
constexpr int AT_VBUF = 8192;
constexpr int AT_BUF = AT_KBUF + AT_VBUF;
__device__ __forceinline__ void attn_unit_mfma(unsigned char* lds, const P& p, int b, int h, int qb, bool ctxq) {
    const int tid = threadIdx.x, lane = tid & 63, wid = tid >> 6, r32 = lane & 31, hh = lane >> 5;
    const bf16_t* Qb = (const bf16_t*)(p.ws + WS_Q); const bf16_t* Kb = (const bf16_t*)(p.ws + WS_K); const bf16_t* Vb = (const bf16_t*)(p.ws + WS_V);
    const int qrow = (ctxq ? NLAT + b * CTXL : b * SEQ + qb * 256) + wid * 32 + r32;
    f32x16 o0, o1, negm;
#pragma unroll
    for (int r = 0; r < 16; ++r) { o0[r] = 0.f; o1[r] = 0.f; negm[r] = 0.f; }
    asm volatile("" : "+v"(negm));
    float mhat = 0.f, l = 0.f;
    const int ntiles = ctxq ? 4 : 36;
    const int wv = __builtin_amdgcn_readfirstlane(wid);
    const int ia = wv, ib = (wv + 8 < 13) ? wv + 8 : 12;
    const int qa = ia * 64 + lane, qb2 = ib * 64 + lane, qv = wv * 64 + lane;
    const int ca = qa % 13, cb = qb2 % 13;
    const size_t ka = (size_t)(qa / 13) * 768 + h * 96 + (ca < 12 ? ca : 11) * 8, kbo = (size_t)(qb2 / 13) * 768 + h * 96 + (cb < 12 ? cb : 11) * 8;
    const size_t vo = (size_t)((qv >> 2) & 63) * 512 + h * 64 + (qv >> 8) * 32 + (qv & 3) * 8;
    auto krow0 = [&](int t) { return t < 4 ? NLAT + b * CTXL + t * 64 : b * SEQ + (t - 4) * 64; };
    const unsigned lds0 = (unsigned)(uintptr_t)lds;
#define AT_GLDS(gp, ldsoff) do { unsigned keep_; asm volatile("s_mov_b32 %0, m0\n\ts_mov_b32 m0, %2\n\ts_nop 0\n\tglobal_load_lds_dwordx4 %1, off\n\ts_mov_b32 m0, %0" : "=&s"(keep_) : "v"(gp), "s"((unsigned)__builtin_amdgcn_readfirstlane(lds0 + (unsigned)(ldsoff))) : "memory"); } while (0)
#define AT_ISSUE(t2, slot) do { const int kr_ = krow0(t2); const bf16_t* kb_ = Kb + (size_t)kr_ * 768; const bf16_t* vb_ = Vb + (size_t)kr_ * 512; \
        AT_GLDS(kb_ + ka, (slot) + ia * 1024); AT_GLDS(kb_ + kbo, (slot) + ib * 1024); AT_GLDS(vb_ + vo, (slot) + AT_KBUF + wv * 1024); } while (0)
#define AT_SB() __builtin_amdgcn_sched_barrier(0)
#define AT_PIN(x) asm volatile("" : "+v"(x))
#define AT_NEXT(x) ((x) == 3 * AT_BUF ? 0 : (x) + AT_BUF)
    __builtin_amdgcn_s_barrier();
    AT_ISSUE(0, 0);
    if (ntiles > 1) AT_ISSUE(1, AT_BUF);
    bf16x8 qf[6];
    {
        const f32x4 s4 = *(const f32x4*)((const float*)(p.ws + WS_SS) + (size_t)qrow * 4);
        const float rstd = rsqrtf((s4.x + s4.y + s4.z + s4.w) * (1.f / 256.f) + NORM_EPS);
        const float* ct = (const float*)(p.ws + WS_ROPE) + (qrow & (SEQ - 1)) * 16; const float* st = ct + 2048 * 16;
#pragma unroll
        for (int s = 0; s < 6; ++s) {
            const u32x4 w = *(const u32x4*)(Qb + (size_t)qrow * 768 + h * 96 + 16 * s + 8 * hh);
            float x[8];
#pragma unroll
            for (int k = 0; k < 4; ++k) { x[2 * k] = lo16(w[k]) * rstd; x[2 * k + 1] = hi16(w[k]) * rstd; }
            if (s >= 4 && !ctxq) {
                const f32x4 c4 = *(const f32x4*)(ct + 8 * (s - 4) + 4 * hh), sn = *(const f32x4*)(st + 8 * (s - 4) + 4 * hh);
#pragma unroll
                for (int k = 0; k < 4; ++k) { const float a = x[2 * k], b2 = x[2 * k + 1]; x[2 * k] = a * c4[k] - b2 * sn[k]; x[2 * k + 1] = a * sn[k] + b2 * c4[k]; }
            }
            const u32x4 o = (u32x4){cvtpk(x[0], x[1]), cvtpk(x[2], x[3]), cvtpk(x[4], x[5]), cvtpk(x[6], x[7])};
            qf[s] = __builtin_bit_cast(bf16x8, o);
        }
    }
    const int koff = r32 * AT_KROW + 16 * hh;
    const int voff = AT_KBUF + (4 * hh + ((lane & 15) >> 2)) * 64 + ((lane >> 4) & 1) * 32 + (lane & 3) * 8;
#define AT_SYNC(t, slot_issue) do { if ((t) + 1 < ntiles) asm volatile("s_waitcnt vmcnt(3)" ::: "memory"); else asm volatile("s_waitcnt vmcnt(0)" ::: "memory"); \
        __builtin_amdgcn_s_barrier(); asm volatile("" ::: "memory"); if ((t) + 2 < ntiles) AT_ISSUE((t) + 2, slot_issue); } while (0)
#define AT_DECIDE(C0, C1) do { \
        asm volatile("s_nop 15\n\ts_nop 7" : "+v"(C0), "+v"(C1)); \
        float rma = max3f(C0[0], C0[1], C1[0]), rmb = max3f(C0[2], C0[3], C1[1]); rma = max3f(rma, C1[2], C1[3]); \
        _Pragma("unroll") for (int r = 4; r < 16; r += 4) { rma = max3f(rma, C0[r], C0[r + 1]); rmb = max3f(rmb, C0[r + 2], C0[r + 3]); rma = max3f(rma, C1[r], C1[r + 1]); rmb = max3f(rmb, C1[r + 2], C1[r + 3]); } \
        float rm = fmaxf(rma, rmb); rm = fmaxf(rm, __shfl_xor(rm, 32)); \
        resc = false; \
        if (__any(rm > 8.f)) { const float dl = fmaxf(rm, 0.f); fres = __builtin_amdgcn_exp2f(-dl); mhat += dl; l *= fres; resc = true; \
            _Pragma("unroll") for (int r = 0; r < 16; ++r) { C0[r] -= dl; C1[r] -= dl; negm[r] = -mhat; } \
            asm volatile("" : "+v"(negm)); } \
    } while (0)
#define AT_MFS(kfrag, s_, C, first) C = __builtin_amdgcn_mfma_f32_32x32x16_bf16(kfrag, qf[s_], (first) ? negm : C, 0, 0, 0)
#define AT_KF(bk_, g) (*(const bf16x8*)((bk_) + koff + ((g) & 1) * 32 * AT_KROW + ((g) >> 1) * 32))
#define AT_STEP(C0, C1, P0, P1, bk, bv) do { \
        bf16x8 kf[12], vfa[4], vfc[4]; u32x4 pw[4]; float sacc = 0.f; \
        kf[0] = AT_KF(bk, 0); kf[1] = AT_KF(bk, 1); kf[2] = AT_KF(bk, 2); kf[3] = AT_KF(bk, 3); \
        AT_SB(); \
        AT_MFS(kf[0], 0, C0, true);  kf[4] = AT_KF(bk, 4);  sacc += (P0[0] + P0[1]) + (P0[2] + P0[3]); pw[0].x = cvtpk(P0[0], P0[1]); pw[0].y = cvtpk(P0[2], P0[3]); AT_PIN(sacc); AT_PIN(pw[0]); AT_SB(); \
        AT_MFS(kf[1], 0, C1, true);  kf[5] = AT_KF(bk, 5);  sacc += (P0[4] + P0[5]) + (P0[6] + P0[7]); pw[0].z = cvtpk(P0[4], P0[5]); pw[0].w = cvtpk(P0[6], P0[7]); AT_PIN(sacc); AT_PIN(pw[0]); AT_SB(); \
        AT_MFS(kf[2], 1, C0, false); kf[6] = AT_KF(bk, 6);  sacc += (P0[8] + P0[9]) + (P0[10] + P0[11]); pw[1].x = cvtpk(P0[8], P0[9]); pw[1].y = cvtpk(P0[10], P0[11]); AT_PIN(sacc); AT_PIN(pw[1]); AT_SB(); \
        AT_MFS(kf[3], 1, C1, false); kf[7] = AT_KF(bk, 7);  sacc += (P0[12] + P0[13]) + (P0[14] + P0[15]); pw[1].z = cvtpk(P0[12], P0[13]); pw[1].w = cvtpk(P0[14], P0[15]); AT_PIN(sacc); AT_PIN(pw[1]); AT_SB(); \
        AT_MFS(kf[4], 2, C0, false); kf[8] = AT_KF(bk, 8);  sacc += (P1[0] + P1[1]) + (P1[2] + P1[3]); pw[2].x = cvtpk(P1[0], P1[1]); pw[2].y = cvtpk(P1[2], P1[3]); AT_PIN(sacc); AT_PIN(pw[2]); AT_SB(); \
        AT_MFS(kf[5], 2, C1, false); kf[9] = AT_KF(bk, 9);  sacc += (P1[4] + P1[5]) + (P1[6] + P1[7]); pw[2].z = cvtpk(P1[4], P1[5]); pw[2].w = cvtpk(P1[6], P1[7]); AT_PIN(sacc); AT_PIN(pw[2]); AT_SB(); \
        AT_MFS(kf[6], 3, C0, false); kf[10] = AT_KF(bk, 10); sacc += (P1[8] + P1[9]) + (P1[10] + P1[11]); pw[3].x = cvtpk(P1[8], P1[9]); pw[3].y = cvtpk(P1[10], P1[11]); AT_PIN(sacc); AT_PIN(pw[3]); AT_SB(); \
        AT_MFS(kf[7], 3, C1, false); kf[11] = AT_KF(bk, 11); sacc += (P1[12] + P1[13]) + (P1[14] + P1[15]); pw[3].z = cvtpk(P1[12], P1[13]); pw[3].w = cvtpk(P1[14], P1[15]); AT_PIN(sacc); AT_PIN(pw[3]); AT_SB(); \
        AT_MFS(kf[8], 4, C0, false); { const unsigned char* vb_ = (bv) + voff; vfa[0] = tr8(vb_, vb_ + 512); vfc[0] = tr8(vb_ + 4096, vb_ + 4608); } AT_SB(); \
        AT_MFS(kf[9], 4, C1, false); { const unsigned char* vb_ = (bv) + voff + 1024; vfa[1] = tr8(vb_, vb_ + 512); vfc[1] = tr8(vb_ + 4096, vb_ + 4608); } AT_SB(); \
        AT_MFS(kf[10], 5, C0, false); { const unsigned char* vb_ = (bv) + voff + 2048; vfa[2] = tr8(vb_, vb_ + 512); vfc[2] = tr8(vb_ + 4096, vb_ + 4608); } AT_SB(); \
        AT_MFS(kf[11], 5, C1, false); { const unsigned char* vb_ = (bv) + voff + 3072; vfa[3] = tr8(vb_, vb_ + 512); vfc[3] = tr8(vb_ + 4096, vb_ + 4608); } AT_SB(); \
        l += sacc; \
        AT_DECIDE(C0, C1); \
        AT_SB(); \
        o0 = __builtin_amdgcn_mfma_f32_32x32x16_bf16(vfa[0], __builtin_bit_cast(bf16x8, pw[0]), o0, 0, 0, 0); C0[0] = __builtin_amdgcn_exp2f(C0[0]); C0[1] = __builtin_amdgcn_exp2f(C0[1]); C0[2] = __builtin_amdgcn_exp2f(C0[2]); C0[3] = __builtin_amdgcn_exp2f(C0[3]); AT_PIN(C0); AT_SB(); \
        o1 = __builtin_amdgcn_mfma_f32_32x32x16_bf16(vfc[0], __builtin_bit_cast(bf16x8, pw[0]), o1, 0, 0, 0); C0[4] = __builtin_amdgcn_exp2f(C0[4]); C0[5] = __builtin_amdgcn_exp2f(C0[5]); C0[6] = __builtin_amdgcn_exp2f(C0[6]); C0[7] = __builtin_amdgcn_exp2f(C0[7]); AT_PIN(C0); AT_SB(); \
        o0 = __builtin_amdgcn_mfma_f32_32x32x16_bf16(vfa[1], __builtin_bit_cast(bf16x8, pw[1]), o0, 0, 0, 0); C0[8] = __builtin_amdgcn_exp2f(C0[8]); C0[9] = __builtin_amdgcn_exp2f(C0[9]); C0[10] = __builtin_amdgcn_exp2f(C0[10]); C0[11] = __builtin_amdgcn_exp2f(C0[11]); AT_PIN(C0); AT_SB(); \
        o1 = __builtin_amdgcn_mfma_f32_32x32x16_bf16(vfc[1], __builtin_bit_cast(bf16x8, pw[1]), o1, 0, 0, 0); C0[12] = __builtin_amdgcn_exp2f(C0[12]); C0[13] = __builtin_amdgcn_exp2f(C0[13]); C0[14] = __builtin_amdgcn_exp2f(C0[14]); C0[15] = __builtin_amdgcn_exp2f(C0[15]); AT_PIN(C0); AT_SB(); \
        o0 = __builtin_amdgcn_mfma_f32_32x32x16_bf16(vfa[2], __builtin_bit_cast(bf16x8, pw[2]), o0, 0, 0, 0); C1[0] = __builtin_amdgcn_exp2f(C1[0]); C1[1] = __builtin_amdgcn_exp2f(C1[1]); C1[2] = __builtin_amdgcn_exp2f(C1[2]); C1[3] = __builtin_amdgcn_exp2f(C1[3]); AT_PIN(C1); AT_SB(); \
        o1 = __builtin_amdgcn_mfma_f32_32x32x16_bf16(vfc[2], __builtin_bit_cast(bf16x8, pw[2]), o1, 0, 0, 0); C1[4] = __builtin_amdgcn_exp2f(C1[4]); C1[5] = __builtin_amdgcn_exp2f(C1[5]); C1[6] = __builtin_amdgcn_exp2f(C1[6]); C1[7] = __builtin_amdgcn_exp2f(C1[7]); AT_PIN(C1); AT_SB(); \
        o0 = __builtin_amdgcn_mfma_f32_32x32x16_bf16(vfa[3], __builtin_bit_cast(bf16x8, pw[3]), o0, 0, 0, 0); C1[8] = __builtin_amdgcn_exp2f(C1[8]); C1[9] = __builtin_amdgcn_exp2f(C1[9]); C1[10] = __builtin_amdgcn_exp2f(C1[10]); C1[11] = __builtin_amdgcn_exp2f(C1[11]); AT_PIN(C1); AT_SB(); \
        o1 = __builtin_amdgcn_mfma_f32_32x32x16_bf16(vfc[3], __builtin_bit_cast(bf16x8, pw[3]), o1, 0, 0, 0); C1[12] = __builtin_amdgcn_exp2f(C1[12]); C1[13] = __builtin_amdgcn_exp2f(C1[13]); C1[14] = __builtin_amdgcn_exp2f(C1[14]); C1[15] = __builtin_amdgcn_exp2f(C1[15]); AT_PIN(C1); AT_SB(); \
        if (resc) { _Pragma("unroll") for (int r = 0; r < 16; ++r) { o0[r] *= fres; o1[r] *= fres; } } \
    } while (0)
    f32x16 pA0, pA1, pB0, pB1; bool resc = false; float fres = 1.f;
    int s_prev = 0, s_cur = 0, s_iss = 2 * AT_BUF;
    AT_SYNC(0, s_iss); s_iss = AT_NEXT(s_iss);
    {
        const unsigned char* bk = lds + s_cur;
#pragma unroll
        for (int s_ = 0; s_ < 6; ++s_) {
            const bf16x8 k0f = *(const bf16x8*)(bk + koff + 32 * s_), k1f = *(const bf16x8*)(bk + koff + 32 * AT_KROW + 32 * s_);
            pA0 = __builtin_amdgcn_mfma_f32_32x32x16_bf16(k0f, qf[s_], s_ == 0 ? negm : pA0, 0, 0, 0);
            pA1 = __builtin_amdgcn_mfma_f32_32x32x16_bf16(k1f, qf[s_], s_ == 0 ? negm : pA1, 0, 0, 0);
        }
        AT_DECIDE(pA0, pA1);
#pragma unroll
        for (int r = 0; r < 16; ++r) { pA0[r] = __builtin_amdgcn_exp2f(pA0[r]); pA1[r] = __builtin_amdgcn_exp2f(pA1[r]); }
    }
    int t = 1;
#pragma unroll 1
    for (; t + 1 < ntiles; t += 2) {
        s_prev = s_cur; s_cur = AT_NEXT(s_cur); AT_SYNC(t, s_iss); s_iss = AT_NEXT(s_iss);
        AT_STEP(pB0, pB1, pA0, pA1, lds + s_cur, lds + s_prev);
        s_prev = s_cur; s_cur = AT_NEXT(s_cur); AT_SYNC(t + 1, s_iss); s_iss = AT_NEXT(s_iss);
        AT_STEP(pA0, pA1, pB0, pB1, lds + s_cur, lds + s_prev);
    }
    {
        s_prev = s_cur; s_cur = AT_NEXT(s_cur); AT_SYNC(t, s_iss); s_iss = AT_NEXT(s_iss);
        AT_STEP(pB0, pB1, pA0, pA1, lds + s_cur, lds + s_prev);
    }
    {
        float sacc = 0.f;
#pragma unroll
        for (int r = 0; r < 16; ++r) sacc += pB0[r] + pB1[r];
        l += sacc;
        u32x4 pw[4];
#pragma unroll
        for (int s2 = 0; s2 < 2; ++s2) {
            pw[s2] = (u32x4){cvtpk(pB0[8 * s2], pB0[8 * s2 + 1]), cvtpk(pB0[8 * s2 + 2], pB0[8 * s2 + 3]), cvtpk(pB0[8 * s2 + 4], pB0[8 * s2 + 5]), cvtpk(pB0[8 * s2 + 6], pB0[8 * s2 + 7])};
            pw[2 + s2] = (u32x4){cvtpk(pB1[8 * s2], pB1[8 * s2 + 1]), cvtpk(pB1[8 * s2 + 2], pB1[8 * s2 + 3]), cvtpk(pB1[8 * s2 + 4], pB1[8 * s2 + 5]), cvtpk(pB1[8 * s2 + 6], pB1[8 * s2 + 7])};
        }
        const unsigned char* bv = lds + s_cur;
#pragma unroll
        for (int ks = 0; ks < 4; ++ks) {
            const unsigned char* vb = bv + voff + ks * 16 * 64; const bf16x8 pf = __builtin_bit_cast(bf16x8, pw[ks]);
            o0 = __builtin_amdgcn_mfma_f32_32x32x16_bf16(tr8(vb, vb + 8 * 64), pf, o0, 0, 0, 0);
            o1 = __builtin_amdgcn_mfma_f32_32x32x16_bf16(tr8(vb + 4096, vb + 4096 + 8 * 64), pf, o1, 0, 0, 0);
        }
    }
#undef AT_GLDS
#undef AT_ISSUE
#undef AT_SB
#undef AT_PIN
#undef AT_NEXT
#undef AT_SYNC
#undef AT_DECIDE
#undef AT_MFS
#undef AT_KF
#undef AT_STEP
    l += __shfl_xor(l, 32);
    const float rl = 1.f / l;
    bf16_t* orow = (bf16_t*)(p.ws + WS_CC) + (size_t)qrow * D + 512 + h * 64 + 4 * hh;
#pragma unroll
    for (int r4 = 0; r4 < 4; ++r4) {
        u32x2 w0; w0.x = cvtpk(o0[4 * r4] * rl, o0[4 * r4 + 1] * rl); w0.y = cvtpk(o0[4 * r4 + 2] * rl, o0[4 * r4 + 3] * rl);
        u32x2 w1; w1.x = cvtpk(o1[4 * r4] * rl, o1[4 * r4 + 1] * rl); w1.y = cvtpk(o1[4 * r4 + 2] * rl, o1[4 * r4 + 3] * rl);
        *(u32x2*)(orow + 8 * r4) = w0; *(u32x2*)(orow + 32 + 8 * r4) = w1;
    }
}
__device__ __forceinline__ void retout_unit(unsigned char* lds, const P& p, int L, int gc, int h) {
    float* qs = (float*)lds; float* ks = qs + 128 * 33; float* vs = ks + 128 * 33; float* Sf = vs + 128 * 64; float* Sb = Sf + 2048;
    const int tid = threadIdx.x;
    const float l2f = log2_gamma(p, L, 0, h), l2b = log2_gamma(p, L, 1, h);
    load_ret_qk(qs, p, gc, h, Z_RQ, 1.f);
    load_ret_qk(ks, p, gc, h, Z_RK, 0.17677669529663687f);
    load_ret_v(vs, p, gc, h);
    {
        const bool lat = gc < 256; const int b = lat ? gc >> 4 : (gc - 256) >> 1;
        const int mme = lat ? 2 + (gc & 15) : (gc - 256) & 1;
        const int u = mme, w = mme < 2 ? 1 - mme : 19 - mme;
        f32x4 sf = (f32x4){0.f, 0.f, 0.f, 0.f}, sb = sf;
        const float* KVb = (const float*)(p.ws + WS_KV);
#pragma unroll 1
        for (int mm = 0; mm < 18; ++mm) {
            const int gcm = mm < 2 ? 256 + b * 2 + mm : b * 16 + (mm - 2);
            const int um = mm, wm = mm < 2 ? 1 - mm : 19 - mm;
            const float* kv = KVb + ((size_t)(gcm * 4 + h) * 2) * 2048 + tid * 4;
            if (um < u) { const float wgt = exp2f(l2f * 128.f * (float)(u - 1 - um)); sf += wgt * *(const f32x4*)kv; }
            if (wm < w) { const float wgt = exp2f(l2b * 128.f * (float)(w - 1 - wm)); sb += wgt * *(const f32x4*)(kv + 2048); }
        }
        *(f32x4*)(Sf + tid * 4) = sf; *(f32x4*)(Sb + tid * 4) = sb;
    }
    __syncthreads();
    const int i = tid >> 2, e0 = (tid & 3) * 16;
    float q[32];
#pragma unroll
    for (int d = 0; d < 32; ++d) q[d] = qs[i * 33 + d];
    float acc[16];
#pragma unroll
    for (int e = 0; e < 16; ++e) acc[e] = 0.f;
#pragma unroll 1
    for (int j = 0; j < 128; ++j) {
        float s = 0.f;
#pragma unroll
        for (int d = 0; d < 32; ++d) s += q[d] * ks[j * 33 + d];
        float wgt = 0.f;
        if (j <= i) wgt += exp2f(l2f * (float)(i - j));
        if (j >= i) wgt += exp2f(l2b * (float)(j - i));
        s *= wgt;
#pragma unroll
        for (int e4 = 0; e4 < 4; ++e4) { const f32x4 v4 = *(const f32x4*)(vs + j * 64 + e0 + 4 * e4); acc[4 * e4] += s * v4.x; acc[4 * e4 + 1] += s * v4.y; acc[4 * e4 + 2] += s * v4.z; acc[4 * e4 + 3] += s * v4.w; }
    }
    {
        const float cf = exp2f(l2f * (float)(i + 1)), cb = exp2f(l2b * (float)(128 - i));
#pragma unroll 2
        for (int d = 0; d < 32; ++d) {
            const float qd = qs[i * 33 + d]; const float qf = qd * cf, qb = qd * cb;
#pragma unroll
            for (int e4 = 0; e4 < 4; ++e4) { const f32x4 a = *(const f32x4*)(Sf + d * 64 + e0 + 4 * e4), bq = *(const f32x4*)(Sb + d * 64 + e0 + 4 * e4);
                acc[4 * e4] += qf * a.x + qb * bq.x; acc[4 * e4 + 1] += qf * a.y + qb * bq.y; acc[4 * e4 + 2] += qf * a.z + qb * bq.z; acc[4 * e4 + 3] += qf * a.w + qb * bq.w; }
        }
    }
    float s1 = 0.f;
#pragma unroll
    for (int e = 0; e < 16; ++e) s1 += acc[e];
    s1 += __shfl_xor(s1, 1); s1 += __shfl_xor(s1, 2);
    const float mu = s1 * (1.f / 64.f);
    float s2 = 0.f;
#pragma unroll
    for (int e = 0; e < 16; ++e) { const float dd = acc[e] - mu; s2 += dd * dd; }
    s2 += __shfl_xor(s2, 1); s2 += __shfl_xor(s2, 2);
    const float rstd = rsqrtf(s2 * (1.f / 64.f) + NORM_EPS);
    const int row = gc * 128 + i;
    const bf16_t* zg = (const bf16_t*)(p.ws + WS_Z) + (size_t)row * ZC + Z_RG + h * 64 + e0;
    const float* gw = p.in[13] + L * 256 + h * 64 + e0;
    const u32x4 g0 = *(const u32x4*)zg, g1 = *(const u32x4*)(zg + 8);
    float g[16];
#pragma unroll
    for (int k = 0; k < 4; ++k) { g[2 * k] = lo16(g0[k]); g[2 * k + 1] = hi16(g0[k]); g[8 + 2 * k] = lo16(g1[k]); g[8 + 2 * k + 1] = hi16(g1[k]); }
    unsigned o[8];
#pragma unroll
    for (int k = 0; k < 8; ++k) {
        const float y0 = siluf(g[2 * k]) * ((acc[2 * k] - mu) * rstd * gw[2 * k]), y1 = siluf(g[2 * k + 1]) * ((acc[2 * k + 1] - mu) * rstd * gw[2 * k + 1]);
        o[k] = pk2(y0, y1);
    }
    u32x4* op = (u32x4*)((bf16_t*)(p.ws + WS_CC) + (size_t)row * D + 256 + h * 64 + e0);
    u32x4 w0; w0.x = o[0]; w0.y = o[1]; w0.z = o[2]; w0.w = o[3]; u32x4 w1; w1.x = o[4]; w1.y = o[5]; w1.z = o[6]; w1.w = o[7];
    op[0] = w0; op[1] = w1;
    __syncthreads();
}
__device__ __forceinline__ void phase_c(unsigned char* lds, const P& p, int L) {
    const int G = gridDim.x, bid = blockIdx.x;
    const int nat = 16 * 8 * 8, nac = (L == 0) ? 128 : 0, nro = (L == 0 ? 288 : 256) * 4;
    const int total = nat + nac + nro;
    const int vcu = (G % 8 == 0) ? (bid % 8) * (G / 8) + bid / 8 : bid;
    for (int u = vcu; u < total; u += G) {
        int r = u;
#ifndef TEST_C
#define TEST_C 3
#endif
        if (r < nat) { if (TEST_C & 1) attn_unit_mfma(lds, p, r >> 6, (r >> 3) & 7, r & 7, false); continue; } r -= nat;
        if (r < nac) { if (TEST_C & 1) attn_unit_mfma(lds, p, r >> 3, r & 7, 0, true); continue; } r -= nac;
        if (TEST_C & 2) retout_unit_mfma(lds, p, L, r >> 2, r & 3);
    }
    if (L == 0) convert_expert_weights(lds, p, 0);
}

struct EpiY {
    bf16_t* Y; const float* g1;
    __device__ __forceinline__ void operator()(const ge::Acc& acc, const ge::Unit& u, int wr, int wc, int fr, int fq) const {
        const float* gr = g1 + (size_t)mod_row(u.a * 256) * 6144 + u.b * 256 + wc * 32 + 8 * fq;
        f32x4 g[2][2];
#pragma unroll
        for (int bj = 0; bj < 2; ++bj)
#pragma unroll
            for (int n = 0; n < 2; ++n) g[bj][n] = *(const f32x4*)(gr + bj * 128 + n * 4);
#pragma unroll
        for (int ai = 0; ai < 2; ++ai)
#pragma unroll
            for (int m = 0; m < 4; ++m) {
                bf16_t* yr = Y + (size_t)(u.a * 256 + ai * 128 + wr * 64 + m * 16 + fr) * D + u.b * 256 + wc * 32 + 8 * fq;
#pragma unroll
                for (int bj = 0; bj < 2; ++bj) { const f32x4 v0 = acc[ai][bj][m][0] * g[bj][0], v1 = acc[ai][bj][m][1] * g[bj][1];
                    u32x4 w; w.x = cvtpk(v0.x, v0.y); w.y = cvtpk(v0.z, v0.w); w.z = cvtpk(v1.x, v1.y); w.w = cvtpk(v1.z, v1.w); *(u32x4*)(yr + bj * 128) = w; }
            }
    }
};
__device__ __forceinline__ void phase_d(unsigned char* lds, const P& p, int L) {
    ge::DenseOrder S; S.nM = (L == 0 ? NTOK : NLAT) / 256; S.nN = 4; S.nwg = S.nM * 4; S.G = gridDim.x; S.c = blockIdx.x;
    S.Bt = (const char*)((const bf16_t*)(p.ws + WS_WOUT) + (size_t)L * D * D); S.btile = (size_t)256 * D * 2; S.arow = D * 2;
    EpiY E{(bf16_t*)(p.ws + WS_Y), (const float*)(p.ws + WS_MODV) + (size_t)L * 17 * 6144 + 2048};
    ge::gemm_stream<ge::DenseOrder, EpiY, true>((LAS unsigned char*)lds, (const char*)(p.ws + WS_CC), D, S, E);
}

__device__ __forceinline__ void norm_mod_store(const P& p, int L, int which, int tok, int lane, const f32x4 (&v)[4], bf16_t* Hdst) {
    const float* nw = (which == 0 ? p.in[6] : p.in[19]) + L * D;
    const float* mrow = (const float*)(p.ws + WS_MODV) + ((size_t)L * 17 + mod_row(tok)) * 6144 + which * 3072;
    float s = 0.f;
#pragma unroll
    for (int j = 0; j < 4; ++j) s += v[j].x * v[j].x + v[j].y * v[j].y + v[j].z * v[j].z + v[j].w * v[j].w;
    const float rstd = rsqrtf(wave_sum(s) * (1.f / D) + NORM_EPS);
    u32x2* o = (u32x2*)(Hdst + (size_t)tok * D) + lane;
#pragma unroll
    for (int j = 0; j < 4; ++j) {
        const int k = 4 * lane + 256 * j;
        const f32x4 w4 = *(const f32x4*)(nw + k), sh = *(const f32x4*)(mrow + k), sc = *(const f32x4*)(mrow + 1024 + k);
        const f32x4 y = v[j] * rstd * w4 * (sc + 1.f) + sh;
        u32x2 w; w.x = cvtpk(y.x, y.y); w.y = cvtpk(y.z, y.w); o[64 * j] = w;
    }
}
__device__ __forceinline__ int half_n(int L) { return L == 0 ? NTOK / 2 : NLAT / 2; }
__device__ __forceinline__ void phase_router(unsigned char* lds, const P& p, int L) {
    constexpr int O_LG = 41472, O_CNT = 83072, O_SEL = 83584, O_SELW = 87424;
    const bf16_t* H = (const bf16_t*)(p.ws + WS_H); const bf16_t* W = (const bf16_t*)(p.ws + WS_RT) + (size_t)L * 128 * D;
    const bf16_t* Y = (const bf16_t*)(p.ws + WS_Y);
    float* lg = (float*)(lds + O_LG);
    int* lcnt = (int*)(lds + O_CNT);
    int* sel = (int*)(lds + O_SEL);
    float* selw = (float*)(lds + O_SELW);
    int* ltok = (int*)(p.ws + WS_LTOK); float* lw = (float*)(p.ws + WS_LW);
    const int tid = threadIdx.x, lane = tid & 63, wave = tid >> 6;
    const int ntok = (L == 0 ? NTOK : NLAT), TS = (L == 0 ? 144 : 128), nmt = ntok / TS, RW = TS / 8;
    for (int mt = blockIdx.x; mt < nmt; mt += gridDim.x) {
        const int t0 = mt * TS;
        if (tid < 64) lcnt[tid] = 0;
#pragma unroll 2
        for (int q = 0; q < RW; ++q) {
            const int tok = t0 + wave * RW + q;
            const u32x2* yr = (const u32x2*)(Y + (size_t)tok * D) + lane;
            u32x2* xo = (u32x2*)x_row(p, tok) + lane;
            f32x4 v[4];
            if (L == 0) {
                const f32x4* xi = (const f32x4*)x_in_row(p, tok) + lane;
#pragma unroll
                for (int j = 0; j < 4; ++j) { const f32x4 a = xi[64 * j]; const u32x2 y = yr[64 * j]; v[j] = (f32x4){a.x + lo16(y.x), a.y + hi16(y.x), a.z + lo16(y.y), a.w + hi16(y.y)}; }
            } else {
#pragma unroll
                for (int j = 0; j < 4; ++j) { const u32x2 a = xo[64 * j]; const u32x2 y = yr[64 * j]; v[j] = (f32x4){lo16(a.x) + lo16(y.x), hi16(a.x) + hi16(y.x), lo16(a.y) + lo16(y.y), hi16(a.y) + hi16(y.y)}; }
            }
#pragma unroll
            for (int j = 0; j < 4; ++j) { u32x2 w; w.x = cvtpk(v[j].x, v[j].y); w.y = cvtpk(v[j].z, v[j].w); xo[64 * j] = w; }
            norm_mod_store(p, L, 1, tok, lane, v, (bf16_t*)(p.ws + WS_H));
        }
        asm volatile("s_waitcnt vmcnt(0)" ::: "memory");
        __syncthreads();
        auto rs = [&](int pr) { return H + (size_t)(t0 + (pr < TS ? pr : TS - 1)) * D; };
        auto epi = [&](int r, int c, f32x4 v) { if (c < 64) { float* d = lg + r * 65 + c; d[0] = v.x; d[1] = v.y; d[2] = v.z; d[3] = v.w; } };
        gemm_tile<5>(lds, rs, W, D, D, epi);
        __syncthreads();
        if (tid < TS) {
            const float* rbp = p.in[21] + L * NEXP; const float* lrow = lg + tid * 65;
            float bv[6], bs[6]; int bi[6];
#pragma unroll
            for (int k = 0; k < 6; ++k) { bv[k] = -INFINITY; bs[k] = 0.f; bi[k] = 0; }
#pragma unroll 4
            for (int e = 0; e < NEXP; ++e) {
                float sc = __builtin_amdgcn_rcpf(1.f + __expf(-lrow[e])); float sv = sc + rbp[e]; int ei = e;
#pragma unroll
                for (int k = 0; k < 6; ++k) { const bool gt = sv > bv[k]; const float tv = gt ? bv[k] : sv, ts = gt ? bs[k] : sc; const int ti = gt ? bi[k] : ei;
                    bv[k] = gt ? sv : bv[k]; bs[k] = gt ? sc : bs[k]; bi[k] = gt ? ei : bi[k]; sv = tv; sc = ts; ei = ti; }
            }
            const float rs6 = 2.5f / (bs[0] + bs[1] + bs[2] + bs[3] + bs[4] + bs[5]);
#pragma unroll
            for (int k = 0; k < 6; ++k) { const int rank = atomicAdd(&lcnt[bi[k]], 1); sel[tid * 6 + k] = (bi[k] << 8) | rank; selw[tid * 6 + k] = bs[k] * rs6; }
        }
        __syncthreads();
        if (tid < 64) {
            unsigned* ecnt = (unsigned*)(p.ws + WS_CTL) + CW_ECNT + L * 4096;
            const int c = lcnt[tid];
            lcnt[64 + tid] = c ? (int)atomicAdd(ecnt + tid * 64, (unsigned)c) : 0;
        }
        __syncthreads();
        for (int i = tid; i < TS * 6; i += NTHREADS) {
            const int sv = sel[i], e = sv >> 8, pos = lcnt[64 + e] + (sv & 255), tok = t0 + i / 6, k = i % 6;
            ltok[(size_t)e * LCAP + pos] = tok * 8 + k;
            lw[(size_t)e * LCAP + pos] = selw[i];
        }
        __syncthreads();
    }
}

__device__ __forceinline__ void build_etab(unsigned char* lds, const P& p, int L) {
    int* tstart = (int*)(lds + ETAB_OFF); int* cnt = tstart + 80;
    __syncthreads();
    if (threadIdx.x < 64) { const unsigned* ecnt = (const unsigned*)(p.ws + WS_CTL) + CW_ECNT + L * 4096;
        cnt[threadIdx.x] = (int)__hip_atomic_load(ecnt + threadIdx.x * 64, __ATOMIC_RELAXED, __HIP_MEMORY_SCOPE_AGENT); }
    __syncthreads();
    if (threadIdx.x < 64) {
        const int e = threadIdx.x, tl = (cnt[e] + 255) >> 8; int inc = tl;
#pragma unroll
        for (int o = 1; o < 64; o <<= 1) { const int v = __shfl_up(inc, o); if (e >= o) inc += v; }
        tstart[e] = inc - tl;
        if (e == 63) { tstart[64] = inc; tstart[65] = inc + (L == 0 ? NTOK : NLAT) / 256; }
    }
    __syncthreads();
}
struct MoeOrder {
    int TT, nN, G, c; const int* tstart; const char* Bexp; size_t bexp; const char* Bsh; size_t btile; const int* rowbuf; unsigned arow; bool ident;
    __device__ __forceinline__ bool next(int i, ge::Unit& u) const {
        const int Lq = i * G + c; if (Lq >= TT * nN) return false;
        const int t = Lq / nN, pn = Lq % nN;
        int lo = 0, hi = 64;
        while (lo < hi) { const int mid = (lo + hi + 1) >> 1; if (tstart[mid] <= t) lo = mid; else hi = mid - 1; }
        const int e = __builtin_amdgcn_readfirstlane(lo);
        u.a = t; u.b = pn; u.c = e; u.d = i;
        u.B = (e < 64 ? Bexp + (size_t)e * bexp : Bsh) + (size_t)pn * btile;
        return true;
    }
    __device__ __forceinline__ unsigned aoff(int i, const ge::Unit& u, int R) const { return (unsigned)(ident ? u.a * 256 + R : rowbuf[i * 256 + R]) * arow; }
};
__device__ __forceinline__ void phase_gateup(unsigned char* lds, const P& p, int L) {
    build_etab(lds, p, L);
    const int* tstart = (const int*)(lds + ETAB_OFF); const int* cnt = tstart + 80;
    int* rowbuf = (int*)(lds + RB0_OFF); float* wbuf = (float*)(lds + RB1_OFF);
    const int* ltok = (const int*)(p.ws + WS_LTOK); const float* lw = (const float*)(p.ws + WS_LW);
    bf16_t* ACT = (bf16_t*)(p.ws + WS_ACT);
    const int G = gridDim.x, bid = blockIdx.x, vcu = (G % 8 == 0) ? (bid % 8) * (G / 8) + bid / 8 : bid;
    MoeOrder S; S.TT = tstart[65]; S.nN = 2; S.G = G; S.c = vcu; S.tstart = tstart; S.Bexp = (const char*)(p.ws + WS_EGU); S.bexp = (size_t)512 * D * 2;
    S.Bsh = (const char*)((const bf16_t*)(p.ws + WS_SHGU) + (size_t)L * 512 * D); S.btile = (size_t)256 * D * 2; S.rowbuf = rowbuf; S.arow = D * 2; S.ident = false;
    {
        int nun = 0; { ge::Unit u; while (nun < 10 && S.next(nun, u)) ++nun; }
        for (int it0 = threadIdx.x; it0 < nun * 256; it0 += NTHREADS * 4) {
            int tokv[4]; float wv4[4];
#pragma unroll
            for (int q = 0; q < 4; ++q) {
                const int item = it0 + q * NTHREADS; tokv[q] = 0; wv4[q] = 0.f;
                if (item < nun * 256) {
                    ge::Unit u; S.next(item >> 8, u);
                    const int R = item & 255, e = u.c, mt = u.a - tstart[e];
                    if (e < 64) { const int lp = mt * 256 + R; if (lp < cnt[e]) { tokv[q] = ltok[(size_t)e * LCAP + lp] >> 3; wv4[q] = lw[(size_t)e * LCAP + lp]; } }
                    else { tokv[q] = mt * 256 + R; wv4[q] = 1.f; }
                }
            }
#pragma unroll
            for (int q = 0; q < 4; ++q) { const int item = it0 + q * NTHREADS; if (item < nun * 256) { rowbuf[item] = tokv[q]; wbuf[item] = wv4[q]; } }
        }
        __syncthreads();
    }
    auto f = [&](const ge::Unit& u, int r, int c, f32x4 v0, f32x4 v1) {
        const float w = wbuf[u.d * 256 + r];
        u32x2 o; o.x = cvtpk(siluf(v0.x) * v0.y * w, siluf(v0.z) * v0.w * w); o.y = cvtpk(siluf(v1.x) * v1.y * w, siluf(v1.z) * v1.w * w);
        *(u32x2*)(ACT + (size_t)(u.a * 256 + r) * EDIM + ((u.b * 256 + c) >> 1)) = o;
    };
    ge::EpiFn<decltype(f)> E{f};
    ge::gemm_stream<MoeOrder, ge::EpiFn<decltype(f)>, true>((LAS unsigned char*)lds, (const char*)(p.ws + WS_H), D, S, E);
}
__device__ __forceinline__ void phase_down(unsigned char* lds, const P& p, int L) {
    build_etab(lds, p, L);
    const int* tstart = (const int*)(lds + ETAB_OFF); const int* cnt = tstart + 80;
    int* sbuf = (int*)(lds + RB0_OFF);
    const int* ltok = (const int*)(p.ws + WS_LTOK);
    unsigned char* SLOT = (unsigned char*)(p.ws + WS_SLOT);
    const int G = gridDim.x, bid = blockIdx.x, vcu = (G % 8 == 0) ? (bid % 8) * (G / 8) + bid / 8 : bid;
    MoeOrder S; S.TT = tstart[65]; S.nN = 4; S.G = G; S.c = vcu; S.tstart = tstart; S.Bexp = (const char*)(p.ws + WS_ED); S.bexp = (size_t)D * EDIM * 2;
    S.Bsh = (const char*)((const bf16_t*)(p.ws + WS_SHD) + (size_t)L * D * EDIM); S.btile = (size_t)256 * EDIM * 2; S.rowbuf = sbuf; S.arow = EDIM * 2; S.ident = true;
    {
        int nun = 0; { ge::Unit u; while (nun < 18 && S.next(nun, u)) ++nun; }
        for (int it0 = threadIdx.x; it0 < nun * 256; it0 += NTHREADS * 4) {
            int sv[4];
#pragma unroll
            for (int q = 0; q < 4; ++q) {
                const int item = it0 + q * NTHREADS; sv[q] = NTOK * 7;
                if (item < nun * 256) {
                    ge::Unit u; S.next(item >> 8, u);
                    const int R = item & 255, e = u.c, mt = u.a - tstart[e];
                    if (e < 64) { const int lp = mt * 256 + R; if (lp < cnt[e]) { const int ent = ltok[(size_t)e * LCAP + lp]; sv[q] = (ent >> 3) * 7 + (ent & 7); } }
                    else sv[q] = (mt * 256 + R) * 7 + 6;
                }
            }
#pragma unroll
            for (int q = 0; q < 4; ++q) { const int item = it0 + q * NTHREADS; if (item < nun * 256) sbuf[item] = sv[q]; }
        }
        __syncthreads();
    }
    auto f = [&](const ge::Unit& u, int r, int c, f32x4 v0, f32x4 v1) {
        const int srow = sbuf[u.d * 256 + r];
        int w0 = 0, w1 = 0;
        w0 = __builtin_amdgcn_cvt_pk_fp8_f32(__builtin_amdgcn_fmed3f(v0.x, -440.f, 440.f), __builtin_amdgcn_fmed3f(v0.y, -440.f, 440.f), w0, false);
        w0 = __builtin_amdgcn_cvt_pk_fp8_f32(__builtin_amdgcn_fmed3f(v0.z, -440.f, 440.f), __builtin_amdgcn_fmed3f(v0.w, -440.f, 440.f), w0, true);
        w1 = __builtin_amdgcn_cvt_pk_fp8_f32(__builtin_amdgcn_fmed3f(v1.x, -440.f, 440.f), __builtin_amdgcn_fmed3f(v1.y, -440.f, 440.f), w1, false);
        w1 = __builtin_amdgcn_cvt_pk_fp8_f32(__builtin_amdgcn_fmed3f(v1.z, -440.f, 440.f), __builtin_amdgcn_fmed3f(v1.w, -440.f, 440.f), w1, true);
        u32x2 w; w.x = (unsigned)w0; w.y = (unsigned)w1; *(u32x2*)(SLOT + (size_t)srow * D + u.b * 256 + c) = w;
    };
    ge::EpiFn<decltype(f)> E{f};
    ge::gemm_stream<MoeOrder, ge::EpiFn<decltype(f)>, true>((LAS unsigned char*)lds, (const char*)(p.ws + WS_ACT), EDIM, S, E);
}
__device__ __forceinline__ void phase_combine(const P& p, int L) {
    const int tid = threadIdx.x, lane = tid & 63, wave = tid >> 6, gw = blockIdx.x * NWAVES + wave, NGW = gridDim.x * NWAVES;
    const unsigned char* SLOT = (const unsigned char*)(p.ws + WS_SLOT);
    const float* modv = (const float*)(p.ws + WS_MODV) + (size_t)L * 17 * 6144;
    const int ntok = (L == 0 ? NTOK : NLAT);
    for (int tok = gw; tok < ntok; tok += NGW) {
        f32x4 acc[4];
#pragma unroll
        for (int j = 0; j < 4; ++j) acc[j] = (f32x4){0.f, 0.f, 0.f, 0.f};
#pragma unroll
        for (int k = 0; k < 7; ++k) {
            const int* sr = (const int*)(SLOT + ((size_t)tok * 7 + k) * D) + lane;
#pragma unroll
            for (int j = 0; j < 4; ++j) { const int w = sr[64 * j]; const f32x2_t a = __builtin_amdgcn_cvt_pk_f32_fp8(w, false), b = __builtin_amdgcn_cvt_pk_f32_fp8(w, true); acc[j].x += a.x; acc[j].y += a.y; acc[j].z += b.x; acc[j].w += b.y; }
        }
        const float* g2 = modv + (size_t)mod_row(tok) * 6144 + 5120;
        u32x2* xr = (u32x2*)x_row(p, tok) + lane;
        f32x4 v[4];
#pragma unroll
        for (int j = 0; j < 4; ++j) { const f32x4 g = *(const f32x4*)(g2 + 4 * lane + 256 * j); const u32x2 a = xr[64 * j];
            v[j] = (f32x4){lo16(a.x), hi16(a.x), lo16(a.y), hi16(a.y)} + g * acc[j]; }
        if (L == 0) {
#pragma unroll
            for (int j = 0; j < 4; ++j) { u32x2 w; w.x = cvtpk(v[j].x, v[j].y); w.y = cvtpk(v[j].z, v[j].w); xr[64 * j] = w; }
            norm_mod_store(p, 1, 0, tok, lane, v, (bf16_t*)(p.ws + WS_H1));
        } else {
            const float* nw = p.in[28]; float s = 0.f;
#pragma unroll
            for (int j = 0; j < 4; ++j) s += v[j].x * v[j].x + v[j].y * v[j].y + v[j].z * v[j].z + v[j].w * v[j].w;
            const float rstd = rsqrtf(wave_sum(s) * (1.f / D) + NORM_EPS);
            f32x4* orow = (f32x4*)(p.out + (size_t)tok * D) + lane;
#pragma unroll
            for (int j = 0; j < 4; ++j) { const f32x4 w4 = *(const f32x4*)(nw + 4 * lane + 256 * j); orow[64 * j] = v[j] * rstd * w4; }
        }
    }
}

constexpr int PH_LAYER0 = 2, PH_PER_LAYER = 8, PH_LAYER1 = PH_LAYER0 + PH_PER_LAYER, NPHASES = PH_LAYER1 + PH_PER_LAYER;

__global__ void __launch_bounds__(NTHREADS, 2) mk_fwd(P p) {
    extern __shared__ __attribute__((aligned(16))) unsigned char lds[];
    volatile LAS unsigned* MISC = (volatile LAS unsigned*)((LAS unsigned char*)lds + MISC_OFF);
    if (threadIdx.x < 64) MISC[threadIdx.x] = 0u;
    __syncthreads();
    unsigned* ctl = (unsigned*)(p.ws + WS_CTL);
    XcdBarrier bar; bar.bar = ctl + CW_BAR; bar.x = 0; bar.st = MISC + 8;
    if (!MK_PER_PHASE) bar = xcd_barrier_post(ctl + CW_BAR, MISC + 8);
    const int lo = p.ph_lo, hi = p.ph_hi;
#ifndef PH_MASK
#define PH_MASK 0xffffu
#endif
#define HAS(b) ((PH_MASK >> (b)) & 1u)
#define IN(k) (lo <= (k) && (k) < hi)
#define SEAM(k) do { if (IN(k) && IN((k) + 1)) xcd_barrier(bar); } while (0)

#ifdef PROBE_MASK
    unsigned long long tacc = 0ull, t0p = 0ull;
#define PT0() t0p = __builtin_amdgcn_s_memrealtime()
#define PT1(b) do { if ((PROBE_MASK >> (b)) & 1u) tacc += __builtin_amdgcn_s_memrealtime() - t0p; } while (0)
#else
#define PT0() do {} while (0)
#define PT1(b) do {} while (0)
#endif
#define PH(b, k, body) do { PT0(); if (HAS(b) && IN(k)) { body; } SEAM(k); PT1(b); } while (0)
    PH(0, 0, phase_prep0(lds, p));
    PH(1, 1, (phase_prep1(lds, p), phase_norm_mod(p, 0, 0, NTOK)));
#define LAYER(L, pb) \
        PH(2, pb + 0, phase_zgemm(lds, p, L)); \
        PH(3, pb + 1, phase_b(lds, p, L)); \
        PH(4, pb + 2, phase_c(lds, p, L)); \
        PH(5, pb + 3, phase_d(lds, p, L)); \
        PH(7, pb + 4, phase_router(lds, p, L)); \
        PH(8, pb + 5, phase_gateup(lds, p, L)); \
        PH(9, pb + 6, phase_down(lds, p, L)); \
        PH(10, pb + 7, phase_combine(p, L));
    LAYER(0, PH_LAYER0)
    LAYER(1, PH_LAYER1)
#ifdef PROBE_MASK
    if (blockIdx.x == 0) {
        const unsigned long long tend = __builtin_amdgcn_s_memrealtime();
        while (__builtin_amdgcn_s_memrealtime() - tend < (unsigned long long)PROBE_AMP * tacc) __builtin_amdgcn_s_sleep(8);
    }
#endif
#undef IN
#undef SEAM
}

extern "C" void kernel_launch(void* const* d_in, const int* in_sizes, int n_in, void* d_out, int out_size, void* d_ws, size_t ws_size, hipStream_t stream) {
    static int grid = 0;
    if (grid == 0) {
        if (n_in != 29 || in_sizes[0] != NLAT * D || out_size != NLAT * D || ws_size < WS_END) {
            fprintf(stderr, "kernel_launch: unexpected shapes / workspace (n_in %d, ws %zu, need %zu); nothing launched\n", n_in, ws_size, (size_t)WS_END); grid = -1; return; }
        int dev = 0, cus = 0, per_cu = 0;
        if (hipGetDevice(&dev) != hipSuccess || hipDeviceGetAttribute(&cus, hipDeviceAttributeMultiprocessorCount, dev) != hipSuccess) { grid = -1; return; }
        if (hipFuncSetAttribute((const void*)mk_fwd, hipFuncAttributeMaxDynamicSharedMemorySize, LDS_BYTES) != hipSuccess) { grid = -1; return; }
        if (hipOccupancyMaxActiveBlocksPerMultiprocessor(&per_cu, (const void*)mk_fwd, NTHREADS, LDS_BYTES) != hipSuccess || per_cu < 1) { fprintf(stderr, "kernel_launch: occupancy query says %d\n", per_cu); }
        (void)hipGetLastError();
        grid = cus;
    }
    if (grid < 0) return;
    (void)hipMemsetAsync((char*)d_ws + WS_CTL, 0, CTL_ZERO_BYTES, stream);
    P a{};
    for (int i = 0; i < 29; ++i) a.in[i] = (const float*)d_in[i];
    a.out = (float*)d_out; a.ws = (unsigned char*)d_ws;
#if MK_PER_PHASE
    for (int ph = 0; ph < NPHASES; ++ph) { a.ph_lo = ph; a.ph_hi = ph + 1; hipLaunchKernelGGL(mk_fwd, dim3(grid), dim3(NTHREADS), LDS_BYTES, stream, a); }
#else
    a.ph_lo = 0; a.ph_hi = NPHASES;
    hipLaunchKernelGGL(mk_fwd, dim3(grid), dim3(NTHREADS), LDS_BYTES, stream, a);
#endif
}
```

```cpp
#include <hip/hip_runtime.h>
#include <cstdio>
#include <cstdint>

#ifndef MK_PER_PHASE
#define MK_PER_PHASE 0
#endif

typedef unsigned short bf16_t;
typedef short bf16x8 __attribute__((ext_vector_type(8)));
typedef float f32x4 __attribute__((ext_vector_type(4)));
typedef unsigned u32x4 __attribute__((ext_vector_type(4)));
typedef unsigned u32x2 __attribute__((ext_vector_type(2)));
typedef float f32x16 __attribute__((ext_vector_type(16)));
typedef short v4i16_t __attribute__((ext_vector_type(4)));
#define LAS __attribute__((address_space(3)))

constexpr int D = 1024, BATCH = 16, SEQ = 2048, CTXL = 256;
constexpr int NLAT = BATCH * SEQ, NCTX = BATCH * CTXL, NTOK = NLAT + NCTX;
constexpr int ZC = 1792;
constexpr int Z_RQ = 512, Z_RK = 640, Z_RV = 768, Z_RG = 1024, Z_CQ = 1280, Z_CKV = 1536, Z_KR = 1664, Z_END = 1696;
constexpr int NEXP = 64, TOPK = 6, EDIM = 256;
constexpr float NORM_EPS = 1e-6f;
constexpr int NTHREADS = 512, NWAVES = 8;

constexpr size_t MiB = 1u << 20;
constexpr size_t WS_CTL = 0, CTL_ZERO_BYTES = 1 * MiB;
constexpr size_t WS_MODV = 1 * MiB;
constexpr size_t WS_ROPE = 2 * MiB;
constexpr size_t WS_WIN = 3 * MiB;
constexpr size_t WS_WUQ = 10 * MiB;
constexpr size_t WS_WUKV = 11 * MiB;
constexpr size_t WS_WOUT = 12 * MiB;
constexpr size_t WS_RT = 16 * MiB;
constexpr size_t WS_SHGU = 17 * MiB;
constexpr size_t WS_SHD = 19 * MiB;
constexpr size_t WS_EGU = 20 * MiB;
constexpr size_t WS_ED = 84 * MiB;
constexpr size_t WS_H1 = 20 * MiB;
constexpr size_t WS_X = 116 * MiB;
constexpr size_t WS_H = 188 * MiB;
constexpr size_t WS_CC = WS_H;
constexpr size_t WS_Z = 260 * MiB;
constexpr size_t WS_Y = WS_Z;
constexpr size_t WS_Q = 386 * MiB;
constexpr size_t WS_K = 440 * MiB;
constexpr size_t WS_V = 494 * MiB;
constexpr size_t WS_KV = 530 * MiB;
constexpr size_t WS_SLOT = 188 * MiB;
constexpr size_t WS_ACT = 441 * MiB;
constexpr size_t WS_LTOK = 583 * MiB;
constexpr size_t WS_LW = 592 * MiB;
constexpr size_t WS_SS = 601 * MiB;
constexpr size_t WS_END = 603 * MiB;
constexpr int LCAP = NTOK;
static_assert(WS_SLOT + ((size_t)NTOK * 7 + 1) * 1024 <= WS_ACT && WS_ACT + (size_t)1136 * 256 * 512 <= WS_LTOK, "MoE buffers");

constexpr int CW_TMO = 0;
constexpr int CW_BAR = 4096;
constexpr int CW_ECNT = 8192;

constexpr int LDS_BYTES = 162816;
constexpr int MISC_OFF = LDS_BYTES - 256;
constexpr int RB0_OFF = 131072;
constexpr int RB1_OFF = 149504;
constexpr int ETAB_OFF = 159744;
constexpr int GEMM_LDS = 36864;
constexpr int ROWSS_OFF = 36864;
constexpr int LG_OFF = 37376;

#define XB_TMO      128
#define XB_XCNT(j)  (256  + 64 * (j))
#define XB_XSUB(j)  (1280 + 64 * (j))
#define XB_XGEN(j)  (2304 + 64 * (j))
#define XB_TOP      3328
#define XB_TOPGEN   3392
#define XCD_BAR_WORDS 3456
#define XB_SPIN_CAP (1u << 24)
__device__ __forceinline__ unsigned xb_ld(unsigned* p)              { return __hip_atomic_load(p, __ATOMIC_RELAXED, __HIP_MEMORY_SCOPE_AGENT); }
__device__ __forceinline__ unsigned xb_add(unsigned* p, unsigned v) { return __hip_atomic_fetch_add(p, v, __ATOMIC_RELAXED, __HIP_MEMORY_SCOPE_AGENT); }
__device__ __forceinline__ unsigned xb_xcc_id() { return (unsigned)__builtin_amdgcn_s_getreg((3 << 11) | 20) & 0xFu; }
#define XB_SPIN(cond, bar) do { unsigned _sp = 0; while (cond) { __builtin_amdgcn_s_sleep(1); \
    if ((++_sp & 255u) == 0u) { if (xb_ld(&(bar)[XB_TMO])) break; if (_sp > XB_SPIN_CAP) { atomicAdd(&(bar)[XB_TMO], 1u); break; } } } } while (0)
struct XcdBarrier { unsigned* bar; unsigned x; volatile LAS unsigned* st; };
__device__ __forceinline__ XcdBarrier xcd_barrier_post(unsigned* bar, volatile LAS unsigned* st) {
    XcdBarrier b; b.bar = bar; b.x = xb_xcc_id(); b.st = st;
    if (threadIdx.x == 0) (void)xb_add(&bar[XB_XCNT(b.x)], 1u);
    return b;
}
__device__ __forceinline__ void xcd_barrier_complete(unsigned* bar, unsigned x, unsigned& nloc, unsigned& nx) {
    const unsigned G = gridDim.x * gridDim.y * gridDim.z;
    unsigned sum, cnt, mine, sp = 0u;
    for (;;) {
        sum = 0u; cnt = 0u; mine = 0u;
#pragma unroll
        for (unsigned j = 0; j < 16; ++j) { const unsigned c = xb_ld(&bar[XB_XCNT(j)]); sum += c; cnt += (c > 0u) ? 1u : 0u; mine = (j == x) ? c : mine; }
        if (sum == G) break;
        __builtin_amdgcn_s_sleep(1);
        if ((++sp & 255u) == 0u) { if (xb_ld(&bar[XB_TMO])) break; if (sp > XB_SPIN_CAP) { atomicAdd(&bar[XB_TMO], 1u); break; } }
    }
    nloc = mine > 0u ? mine : 1u; nx = cnt > 0u ? cnt : 1u;
}
__device__ __forceinline__ void xcd_barrier(const XcdBarrier& b) {
    asm volatile("s_waitcnt vmcnt(0)" ::: "memory");
    __syncthreads();
    if (threadIdx.x == 0) {
        unsigned* bar = b.bar;
        __builtin_amdgcn_s_waitcnt(0);
        unsigned nloc = b.st[0], nx = b.st[1];
        if (nloc == 0u) { xcd_barrier_complete(bar, b.x, nloc, nx); b.st[0] = nloc; b.st[1] = nx; }
        const unsigned old = xb_add(&bar[XB_XSUB(b.x)], 1u);
        const unsigned gen = old / nloc;
        if (old + 1u == (gen + 1u) * nloc) {
            __builtin_amdgcn_fence(__ATOMIC_RELEASE, "agent");
            asm volatile("s_waitcnt vmcnt(0)" ::: "memory");
            const unsigned og = xb_add(&bar[XB_TOP], 1u);
            const unsigned tg = og / nx;
            if (og + 1u == (tg + 1u) * nx) xb_add(&bar[XB_TOPGEN], 1u);
            else XB_SPIN(xb_ld(&bar[XB_TOPGEN]) == tg, bar);
            __builtin_amdgcn_fence(__ATOMIC_ACQUIRE, "agent");
            xb_add(&bar[XB_XGEN(b.x)], 1u);
            asm volatile("s_waitcnt vmcnt(0)" ::: "memory");
        } else {
            XB_SPIN(xb_ld(&bar[XB_XGEN(b.x)]) == gen, bar);
            __builtin_amdgcn_fence(__ATOMIC_ACQUIRE, "agent");
            asm volatile("s_waitcnt vmcnt(0)" ::: "memory");
        }
    }
    __syncthreads();
}

__device__ __forceinline__ float bf2f(unsigned h) { return __uint_as_float(h << 16); }
__device__ __forceinline__ unsigned f2bf(float f) { unsigned u = __float_as_uint(f); return (u + 0x7fffu + ((u >> 16) & 1u)) >> 16; }
__device__ __forceinline__ unsigned pk2(float lo, float hi) { return f2bf(lo) | (f2bf(hi) << 16); }
typedef float f32x2_t __attribute__((ext_vector_type(2)));
typedef __bf16 bf16x2_t __attribute__((ext_vector_type(2)));
__device__ __forceinline__ unsigned cvtpk(float lo, float hi) { f32x2_t v = {lo, hi}; bf16x2_t b = __builtin_convertvector(v, bf16x2_t); return __builtin_bit_cast(unsigned, b); }
__device__ __forceinline__ float lo16(unsigned w) { return __uint_as_float(w << 16); }
__device__ __forceinline__ float hi16(unsigned w) { return __uint_as_float(w & 0xffff0000u); }
__device__ __forceinline__ float wave_sum(float v) {
#pragma unroll
    for (int o = 1; o < 64; o <<= 1) v += __shfl_xor(v, o);
    return v;
}
__device__ __forceinline__ float siluf(float v) { return v * __builtin_amdgcn_rcpf(1.f + __expf(-v)); }
__device__ __forceinline__ int mod_row(int tok) { return tok < NLAT ? (tok >> 11) : 16; }

struct P { const float* in[29]; float* out; unsigned char* ws; int ph_lo, ph_hi; };

__device__ __forceinline__ bf16_t* x_row(const P& p, int tok) { return (bf16_t*)(p.ws + WS_X) + (size_t)tok * D; }
__device__ __forceinline__ const float* x_in_row(const P& p, int tok) {
    return tok < NLAT ? p.in[0] + (size_t)tok * D : p.in[2] + (size_t)(tok - NLAT) * D;
}

template <int MF, class RowSrc, class Epi>
__device__ __forceinline__ void gemm_tile(unsigned char* lds, const RowSrc& rs, const bf16_t* Bt, int ldb, int K, const Epi& epi) {
    constexpr int ROWS = 32 * MF, NPA = ROWS * 8;
    const int tid = threadIdx.x, lane = tid & 63, wid = tid >> 6, wr = wid >> 2, wc = wid & 3, fr = lane & 15, fq = lane >> 4;
    bf16_t* As = (bf16_t*)lds; bf16_t* Bs = As + ROWS * 72;
    const bf16_t* ap[3]; int al[3];
#pragma unroll
    for (int i = 0; i < 3; ++i) { const int id = tid + 512 * i, r = id >> 3, c = (id & 7) * 8; ap[i] = (id < NPA) ? rs(r) + c : nullptr; al[i] = r * 72 + c; }
    const int lr = tid >> 2, lc = (tid & 3) * 16;
    const bf16_t* bp = Bt + (size_t)lr * ldb + lc;
    u32x4 a[3], b0 = *(const u32x4*)bp, b1 = *(const u32x4*)(bp + 8);
#pragma unroll
    for (int i = 0; i < 3; ++i) if (ap[i]) a[i] = *(const u32x4*)ap[i];
    f32x4 acc[MF][2];
#pragma unroll
    for (int m = 0; m < MF; ++m)
#pragma unroll
        for (int n = 0; n < 2; ++n) acc[m][n] = (f32x4){0.f, 0.f, 0.f, 0.f};
    for (int k0 = 0; k0 < K; k0 += 64) {
        __syncthreads();
#pragma unroll
        for (int i = 0; i < 3; ++i) if (ap[i]) *(u32x4*)(As + al[i]) = a[i];
        *(u32x4*)(Bs + lr * 72 + lc) = b0; *(u32x4*)(Bs + lr * 72 + lc + 8) = b1;
        __syncthreads();
        if (k0 + 64 < K) {
#pragma unroll
            for (int i = 0; i < 3; ++i) if (ap[i]) { ap[i] += 64; a[i] = *(const u32x4*)ap[i]; }
            bp += 64; b0 = *(const u32x4*)bp; b1 = *(const u32x4*)(bp + 8);
        }
#pragma unroll
        for (int kk = 0; kk < 2; ++kk) {
            bf16x8 af[MF], bfr[2];
#pragma unroll
            for (int m = 0; m < MF; ++m) af[m] = *(const bf16x8*)(As + (wr * 16 * MF + m * 16 + fr) * 72 + kk * 32 + fq * 8);
#pragma unroll
            for (int n = 0; n < 2; ++n) bfr[n] = *(const bf16x8*)(Bs + (wc * 32 + n * 16 + fr) * 72 + kk * 32 + fq * 8);
#pragma unroll
            for (int m = 0; m < MF; ++m)
#pragma unroll
                for (int n = 0; n < 2; ++n) acc[m][n] = __builtin_amdgcn_mfma_f32_16x16x32_bf16(bfr[n], af[m], acc[m][n], 0, 0, 0);
        }
    }
#pragma unroll
    for (int m = 0; m < MF; ++m)
#pragma unroll
        for (int n = 0; n < 2; ++n) epi(wr * 16 * MF + m * 16 + fr, wc * 32 + n * 16 + 4 * fq, acc[m][n]);
}

namespace ge {
constexpr int BM = 256, BK = 64, HALF = 128, HTB = HALF * BK * 2;
__device__ __forceinline__ int lds_byte(int r, int c) { const int st = (r >> 4) * 2 + (c >> 5), rr = r & 15, cc = c & 31, ob = rr * 64 + cc * 2; return st * 1024 + (ob ^ (((ob >> 9) & 1) << 5)); }
__device__ __forceinline__ void stage_rc(int b, int& R, int& C) { const int st = b / 1024, sb = b % 1024, swz = sb ^ (((sb >> 9) & 1) << 5); R = (st >> 1) * 16 + swz / 64; C = (st & 1) * 32 + (swz % 64) / 2; }
struct Unit { const char* B; int a, b, c, d; };
typedef f32x4 Acc[2][2][4][2];

template <class Sched, class Epi, bool ALIGN_EPI>
__device__ __forceinline__ void gemm_stream(LAS unsigned char* lds, const char* Ab, int K, const Sched& S, const Epi& E) {
    const int tid = threadIdx.x, wid = __builtin_amdgcn_readfirstlane(tid >> 6), lane = tid & 63, wr = wid >> 2, wc = wid & 3, fr = lane & 15, fq = lane >> 4;
    const int nt = K / BK;
    int Rr[2], Cc[2]; unsigned voffB[2];
#pragma unroll
    for (int i = 0; i < 2; ++i) { stage_rc(tid * 16 + i * 8192, Rr[i], Cc[i]);
        const int rho = Rr[i] & 31, Rb = (Rr[i] & ~31) + 8 * ((rho & 15) >> 2) + 4 * (rho >> 4) + (rho & 3);
        voffB[i] = (unsigned)(Rb * K + Cc[i]) * 2u; }
    const size_t kstep = (size_t)(BK * 2), hstepB = (size_t)HALF * K * 2;
    const unsigned ldsw = (unsigned)wid * 1024u;
    const int aoff = lds_byte(wr * 64 + fr, fq * 8), boff = lds_byte(wc * 32 + fr, fq * 8);
#define GE_SA(b, h) (((b) * 2 + (h)) * HTB)
#define GE_SB(b, h) ((4 + (b) * 2 + (h)) * HTB)
#define GE_GLDS(gp, ldsoff) __builtin_amdgcn_global_load_lds((const unsigned*)(gp), (LAS unsigned*)(lds + (ldsoff)), 16, 0, 0)
#define GE_STAGE_B(bufoff, gbase) do { GE_GLDS((const char*)(gbase) + voffB[0], (bufoff) + ldsw); GE_GLDS((const char*)(gbase) + voffB[1], (bufoff) + ldsw + 8192); } while (0)
#define GE_STAGE_A(bufoff, kbytes, o0, o1) do { GE_GLDS(Ab + (kbytes) + (o0), (bufoff) + ldsw); GE_GLDS(Ab + (kbytes) + (o1), (bufoff) + ldsw + 8192); } while (0)
#define GE_LDA(dst, b, h) do { _Pragma("unroll") for (int m = 0; m < 4; ++m) _Pragma("unroll") for (int k = 0; k < 2; ++k) dst[m][k] = *(const LAS bf16x8*)(lds + GE_SA(b, h) + aoff + m * 2048 + k * 1024); } while (0)
#define GE_LDB(dst, b, h) do { _Pragma("unroll") for (int n = 0; n < 2; ++n) _Pragma("unroll") for (int k = 0; k < 2; ++k) dst[n][k] = *(const LAS bf16x8*)(lds + GE_SB(b, h) + boff + n * 2048 + k * 1024); } while (0)
#define GE_MMA(ai, bj, At, Bt) do { __builtin_amdgcn_s_setprio(1); _Pragma("unroll") for (int m = 0; m < 4; ++m) _Pragma("unroll") for (int n = 0; n < 2; ++n) _Pragma("unroll") for (int k = 0; k < 2; ++k) \
        acc[ai][bj][m][n] = __builtin_amdgcn_mfma_f32_16x16x32_bf16(Bt[n][k], At[m][k], acc[ai][bj][m][n], 0, 0, 0); __builtin_amdgcn_s_setprio(0); } while (0)
#define GE_WAIT_V(n) asm volatile("s_waitcnt vmcnt(" #n ")" ::: "memory")
#define GE_WAIT_L(n) asm volatile("s_waitcnt lgkmcnt(" #n ")" ::: "memory")
#define GE_BAR __builtin_amdgcn_s_barrier()
#define GE_SCHED __builtin_amdgcn_sched_barrier(0)
    Unit cur, nxt; int ui = 0;
    if (!S.next(0, cur)) return;
    Acc acc;
#pragma unroll
    for (int a = 0; a < 2; ++a)
#pragma unroll
        for (int b = 0; b < 2; ++b)
#pragma unroll
            for (int m = 0; m < 4; ++m)
#pragma unroll
                for (int n = 0; n < 2; ++n) acc[a][b][m][n] = (f32x4){0.f, 0.f, 0.f, 0.f};
    bf16x8 At[4][2], B0[2][2], B1[2][2];
    unsigned oc00, oc01, oc10, oc11, on00, on01, on10, on11;
    oc00 = S.aoff(0, cur, Rr[0]) + (unsigned)Cc[0] * 2u; oc01 = S.aoff(0, cur, Rr[1]) + (unsigned)Cc[1] * 2u;
    oc10 = S.aoff(0, cur, Rr[0] + 128) + (unsigned)Cc[0] * 2u; oc11 = S.aoff(0, cur, Rr[1] + 128) + (unsigned)Cc[1] * 2u;
    const char* cB = cur.B;
    GE_STAGE_B(GE_SB(0, 0), cB); GE_STAGE_B(GE_SB(0, 1), cB + hstepB); GE_STAGE_A(GE_SA(0, 0), 0, oc00, oc01); GE_STAGE_A(GE_SA(0, 1), 0, oc10, oc11);
    if (wr == 1) GE_BAR;
    GE_WAIT_V(2); GE_BAR;
    GE_STAGE_B(GE_SB(1, 0), cB + kstep); GE_STAGE_A(GE_SA(1, 0), kstep, oc00, oc01); GE_STAGE_B(GE_SB(1, 1), cB + hstepB + kstep);
    GE_WAIT_V(6); GE_BAR;
    for (;;) {
        const bool has_next = S.next(ui + 1, nxt);
        const char* nB = has_next ? nxt.B : cB;
        if (has_next) {
            on00 = S.aoff(ui + 1, nxt, Rr[0]) + (unsigned)Cc[0] * 2u; on01 = S.aoff(ui + 1, nxt, Rr[1]) + (unsigned)Cc[1] * 2u;
            on10 = S.aoff(ui + 1, nxt, Rr[0] + 128) + (unsigned)Cc[0] * 2u; on11 = S.aoff(ui + 1, nxt, Rr[1] + 128) + (unsigned)Cc[1] * 2u;
        } else { on00 = oc00; on01 = oc01; on10 = oc10; on11 = oc11; }
#pragma unroll 1
        for (int t = 0; t < nt; t += 2) {
            const bool last = (t == nt - 2);
            const size_t k1 = (size_t)(t + 1) * kstep;
            const size_t k2 = last ? 0 : (size_t)(t + 2) * kstep, k3 = k2 + kstep;
            const char* b2 = last ? nB : cB + (size_t)(t + 2) * kstep; const char* b3 = b2 + kstep;
            const unsigned o00 = last ? on00 : oc00, o01 = last ? on01 : oc01, o10 = last ? on10 : oc10, o11 = last ? on11 : oc11;
            GE_LDB(B0, 0, 0); GE_LDB(B1, 0, 1); GE_SCHED; GE_LDA(At, 0, 0); GE_STAGE_A(GE_SA(1, 1), k1, oc10, oc11);
            GE_WAIT_V(8); GE_WAIT_L(0); GE_BAR; GE_MMA(0, 0, At, B0); GE_MMA(0, 1, At, B1); GE_BAR; GE_SCHED;
            GE_LDA(At, 0, 1); GE_STAGE_B(GE_SB(0, 0), b2); GE_STAGE_B(GE_SB(0, 1), b2 + hstepB); GE_STAGE_A(GE_SA(0, 0), k2, o00, o01);
            GE_WAIT_V(8); GE_WAIT_L(0); GE_BAR; GE_MMA(1, 0, At, B0); GE_MMA(1, 1, At, B1); GE_BAR; GE_SCHED;
            GE_LDB(B0, 1, 0); GE_LDB(B1, 1, 1); GE_SCHED; GE_LDA(At, 1, 0); GE_STAGE_A(GE_SA(0, 1), k2, o10, o11);
            GE_WAIT_V(8); GE_WAIT_L(0); GE_BAR; GE_MMA(0, 0, At, B0); GE_MMA(0, 1, At, B1); GE_BAR; GE_SCHED;
            GE_LDA(At, 1, 1); GE_STAGE_B(GE_SB(1, 0), b3); GE_STAGE_B(GE_SB(1, 1), b3 + hstepB); GE_STAGE_A(GE_SA(1, 0), k3, o00, o01);
            GE_WAIT_V(8); GE_WAIT_L(0); GE_BAR; GE_MMA(1, 0, At, B0); GE_MMA(1, 1, At, B1); GE_BAR; GE_SCHED;
        }
        if constexpr (ALIGN_EPI) { if (wr == 0) GE_BAR; }
        E(acc, cur, wr, wc, fr, fq);
        if (!has_next) break;
#pragma unroll
        for (int a = 0; a < 2; ++a)
#pragma unroll
            for (int b = 0; b < 2; ++b)
#pragma unroll
                for (int m = 0; m < 4; ++m)
#pragma unroll
                    for (int n = 0; n < 2; ++n) acc[a][b][m][n] = (f32x4){0.f, 0.f, 0.f, 0.f};
        cur = nxt; cB = nB; ++ui; oc00 = on00; oc01 = on01; oc10 = on10; oc11 = on11;
        if constexpr (ALIGN_EPI) { if (wr == 1) GE_BAR; }
    }
    GE_WAIT_V(0);
    if constexpr (!ALIGN_EPI) { if (wr == 0) GE_BAR; }
    GE_BAR;
#undef GE_SA
#undef GE_SB
#undef GE_GLDS
#undef GE_STAGE_A
#undef GE_STAGE_B
#undef GE_LDA
#undef GE_LDB
#undef GE_MMA
#undef GE_WAIT_V
#undef GE_WAIT_L
#undef GE_BAR
#undef GE_SCHED
}
template <class F> struct EpiFn {
    F f;
    __device__ __forceinline__ void operator()(const Acc& acc, const Unit& u, int wr, int wc, int fr, int fq) const {
#pragma unroll
        for (int ai = 0; ai < 2; ++ai)
#pragma unroll
            for (int m = 0; m < 4; ++m)
#pragma unroll
                for (int bj = 0; bj < 2; ++bj) f(u, ai * 128 + wr * 64 + m * 16 + fr, bj * 128 + wc * 32 + 8 * fq, acc[ai][bj][m][0], acc[ai][bj][m][1]);
    }
};
struct DenseOrder {
    int nM, nN, nwg, G, c; const char* Bt; size_t btile; unsigned arow;
    __device__ __forceinline__ bool next(int i, Unit& u) const {
        const long L = (long)i * G + c; if (L >= nwg) return false;
        int wgid = (int)L; { const int q = nwg / 8, r = nwg % 8, xcd = wgid % 8, off = wgid / 8; wgid = (xcd < r ? xcd * (q + 1) : r * (q + 1) + (xcd - r) * q) + off; }
        const int nig = 8 * nN, gid = wgid / nig, fm = gid * 8, gsz = (nM - fm) < 8 ? (nM - fm) : 8;
        u.a = fm + ((wgid % nig) % gsz); u.b = (wgid % nig) / gsz; u.c = 0; u.d = 0; u.B = Bt + (size_t)u.b * btile; return true;
    }
    __device__ __forceinline__ unsigned aoff(int, const Unit& u, int R) const { return (unsigned)(u.a * 256 + R) * arow; }
};
}

struct TMap { const float* s0; const float* s1; int ld; int nvalid; const float* ksc; float gsc; };
template <int MODE> __device__ __forceinline__ const float* tmap_src(const float* s0, const float* s1, int nvalid, int n) {
    if (MODE == 0) return n < nvalid ? s0 + n : nullptr;
    if (MODE == 1) { const int h = n / 96, j = n % 96; const int c = j < 64 ? j : 64 + ((j - 64) & 1) * 16 + ((j - 64) >> 1); return s0 + h * 96 + c; }
    return ((n & 1) ? s1 : s0) + (n >> 1);
}
template <int MODE> __device__ __forceinline__ void transpose_unit(float* scr, const float* s0, const float* s1, int ld, int nvalid, const float* ksc, float gsc, int K, bf16_t* dst, int kb, int nb, int kvalid = 1 << 30) {
    const int tid = threadIdx.x, k0 = kb * 64, n0 = nb * 64;
    const int nn = tid & 63; const float* sp = tmap_src<MODE>(s0, s1, nvalid, n0 + nn);
#pragma unroll
    for (int i = 0; i < 8; ++i) {
        const int kk = (tid >> 6) + 8 * i; float v = (sp && k0 + kk < kvalid) ? sp[(size_t)(k0 + kk) * ld] : 0.f;
        if (ksc && k0 + kk < kvalid) v *= ksc[k0 + kk];
        scr[kk * 65 + nn] = v * gsc;
    }
    __syncthreads();
    {
        const int n2 = tid >> 3, kc = tid & 7; const float* s = scr + (kc * 8) * 65 + n2;
        u32x4 o; o.x = pk2(s[0], s[65]); o.y = pk2(s[2 * 65], s[3 * 65]); o.z = pk2(s[4 * 65], s[5 * 65]); o.w = pk2(s[6 * 65], s[7 * 65]);
        *(u32x4*)(dst + (size_t)(n0 + n2) * K + k0 + kc * 8) = o;
    }
    __syncthreads();
}
template <int MODE> __device__ __forceinline__ void transpose_matrix(float* scr, const float* s0, const float* s1, int ld, int nvalid, const float* ksc, float gsc, int K, int Nd, bf16_t* dst, int& rot, int kvalid = 1 << 30) {
    const int nkb = K / 64, nnb = Nd / 64, nu = nkb * nnb, G = gridDim.x;
    int first = ((int)blockIdx.x - rot) % G; if (first < 0) first += G;
    for (int u = first; u < nu; u += G) transpose_unit<MODE>(scr, s0, s1, ld, nvalid, ksc, gsc, K, dst, u / nnb, u % nnb, kvalid);
    rot = (rot + nu) % G;
}
__device__ __forceinline__ void convert_expert_weights(unsigned char* lds, const P& p, int L) {
    float* scr = (float*)lds; const int G = gridDim.x, tid = threadIdx.x;
    constexpr int S = 261;
    bf16_t* egu = (bf16_t*)(p.ws + WS_EGU); bf16_t* ed = (bf16_t*)(p.ws + WS_ED);
    for (int ub = blockIdx.x; ub < NEXP * 48; ub += G) {
        const int e = ub / 48, r = (ub % 48) * 4;
        bf16_t* dst; int K, k0;
        if (r < 128) {
            const int kb = r >> 3, nb0 = r & 7; k0 = kb * 64; K = D; dst = egu + ((size_t)e * 512 + nb0 * 64) * D;
            const float* gsrc = p.in[22] + ((size_t)L * NEXP + e) * D * EDIM + nb0 * 32; const float* usrc = p.in[23] + ((size_t)L * NEXP + e) * D * EDIM + nb0 * 32;
            f32x4 v[8];
#pragma unroll
            for (int i = 0; i < 8; ++i) { const int idx = tid + 512 * i, kk = idx >> 6, c = idx & 63; v[i] = *(const f32x4*)((c < 32 ? gsrc : usrc) + (size_t)(k0 + kk) * EDIM + (c & 31) * 4); }
#pragma unroll
            for (int i = 0; i < 8; ++i) { const int idx = tid + 512 * i, kk = idx >> 6, c = idx & 63; float* d = scr + kk * S + 8 * (c & 31) + (c >> 5);
                d[0] = v[i].x; d[2] = v[i].y; d[4] = v[i].z; d[6] = v[i].w; }
        } else {
            const int r2 = r - 128, kb = r2 >> 4, nb0 = r2 & 15; k0 = kb * 64; K = EDIM; dst = ed + ((size_t)e * D + nb0 * 64) * EDIM;
            const float* src = p.in[24] + ((size_t)L * NEXP + e) * EDIM * D + nb0 * 64;
            f32x4 v[8];
#pragma unroll
            for (int i = 0; i < 8; ++i) { const int idx = tid + 512 * i, kk = idx >> 6, c = idx & 63; v[i] = *(const f32x4*)(src + (size_t)(k0 + kk) * D + c * 4); }
#pragma unroll
            for (int i = 0; i < 8; ++i) { const int idx = tid + 512 * i, kk = idx >> 6, c = idx & 63; float* d = scr + kk * S + 4 * c;
                d[0] = v[i].x; d[1] = v[i].y; d[2] = v[i].z; d[3] = v[i].w; }
        }
        __syncthreads();
#pragma unroll
        for (int i = 0; i < 4; ++i) {
            const int id = tid + 512 * i, n = id >> 3, kc = id & 7; const float* sp = scr + (kc * 8) * S + n;
            u32x4 o; o.x = cvtpk(sp[0], sp[S]); o.y = cvtpk(sp[2 * S], sp[3 * S]); o.z = cvtpk(sp[4 * S], sp[5 * S]); o.w = cvtpk(sp[6 * S], sp[7 * S]);
            *(u32x4*)(dst + (size_t)n * K + k0 + kc * 8) = o;
        }
        __syncthreads();
    }
}
__device__ __forceinline__ void prep_mod_unit(unsigned char* lds, const P& p, int u) {
    float* sc = (float*)lds;
    float* part = sc + 17 * 1024;
    const int tid = threadIdx.x;
    const float* c = p.in[1]; const float* cctx = p.in[3];
    for (int i = tid; i < 17 * 1024; i += NTHREADS) { const int r = i >> 10, k = i & 1023; const float v = r < 16 ? c[r * 1024 + k] : cctx[k]; sc[i] = v * __builtin_amdgcn_rcpf(1.f + __expf(-v)); }
    __syncthreads();
    const int L = u / 192, cg = u % 192, ks = tid >> 5, cl = tid & 31, col = cg * 32 + cl;
    const float* w = p.in[4] + (size_t)L * 1024 * 6144 + (size_t)(ks * 64) * 6144 + col;
    float acc[17];
#pragma unroll
    for (int r = 0; r < 17; ++r) acc[r] = 0.f;
#pragma unroll 8
    for (int k = 0; k < 64; ++k) {
        const float wv = w[(size_t)k * 6144];
#pragma unroll
        for (int r = 0; r < 17; ++r) acc[r] += sc[r * 1024 + ks * 64 + k] * wv;
    }
#pragma unroll
    for (int r = 0; r < 17; ++r) part[(ks * 17 + r) * 32 + cl] = acc[r];
    __syncthreads();
    float* modv = (float*)(p.ws + WS_MODV);
    for (int i = tid; i < 17 * 32; i += NTHREADS) {
        const int r = i >> 5, c2 = i & 31;
        float s2 = p.in[5][L * 6144 + cg * 32 + c2];
#pragma unroll
        for (int q = 0; q < 16; ++q) s2 += part[(q * 17 + r) * 32 + c2];
        modv[((size_t)L * 17 + r) * 6144 + cg * 32 + c2] = s2;
    }
    __syncthreads();
}
__device__ __forceinline__ void phase_prep0(unsigned char* lds, const P& p) {
    const int tid = threadIdx.x, G = gridDim.x, bid = blockIdx.x;
    {
        float* ct = (float*)(p.ws + WS_ROPE); float* st = ct + 2048 * 16;
        for (int i = bid * NTHREADS + tid; i < 2048 * 16; i += G * NTHREADS) {
            const int pos = i >> 4, f = i & 15;
            const float inv = powf(10000.f, -(float)(f & 7) / 8.f);
            const float ang = (float)(f < 8 ? (pos >> 6) : (pos & 63)) * inv;
            ct[i] = cosf(ang); st[i] = sinf(ang);
        }
    }
    for (int u = bid; u < 384; u += G) prep_mod_unit(lds, p, u);
}
__device__ __forceinline__ void phase_prep1(unsigned char* lds, const P& p) {
    float* scr = (float*)lds; int rot = 0;
    for (int L = 0; L < 2; ++L) {
        transpose_matrix<0>(scr, p.in[7] + (size_t)L * D * Z_END, nullptr, Z_END, Z_END, nullptr, 1.f, D, ZC, (bf16_t*)(p.ws + WS_WIN) + (size_t)L * ZC * D, rot);
        transpose_matrix<1>(scr, p.in[15] + (size_t)L * 256 * 768, nullptr, 768, 768, p.in[14] + L * 256, 0.14724574f, 256, 768, (bf16_t*)(p.ws + WS_WUQ) + (size_t)L * 768 * 256, rot);
        transpose_matrix<0>(scr, p.in[17] + (size_t)L * 128 * 1024, nullptr, 1024, 1024, p.in[16] + L * 128, 1.f, 256, 1024, (bf16_t*)(p.ws + WS_WUKV) + (size_t)L * 1024 * 256, rot, 128);
        transpose_matrix<0>(scr, p.in[18] + (size_t)L * D * D, nullptr, D, D, nullptr, 1.f, D, D, (bf16_t*)(p.ws + WS_WOUT) + (size_t)L * D * D, rot);
        transpose_matrix<0>(scr, p.in[20] + (size_t)L * D * NEXP, nullptr, NEXP, NEXP, nullptr, 1.f, D, 128, (bf16_t*)(p.ws + WS_RT) + (size_t)L * 128 * D, rot);
        transpose_matrix<2>(scr, p.in[25] + (size_t)L * D * EDIM, p.in[26] + (size_t)L * D * EDIM, EDIM, 512, nullptr, 1.f, D, 512, (bf16_t*)(p.ws + WS_SHGU) + (size_t)L * 512 * D, rot);
        transpose_matrix<0>(scr, p.in[27] + (size_t)L * EDIM * D, nullptr, D, D, nullptr, 1.f, EDIM, D, (bf16_t*)(p.ws + WS_SHD) + (size_t)L * D * EDIM, rot);
    }
}

__device__ __forceinline__ void phase_norm_mod(const P& p, int L, int which  , int ntok) {
    const int tid = threadIdx.x, lane = tid & 63, wave = tid >> 6, gw = blockIdx.x * NWAVES + wave, NGW = gridDim.x * NWAVES;
    const float* nw = (which == 0 ? p.in[6] : p.in[19]) + L * D;
    const float* modv = (const float*)(p.ws + WS_MODV) + (size_t)L * 17 * 6144;
    bf16_t* H = (bf16_t*)(p.ws + WS_H);
    for (int tok = gw; tok < ntok; tok += NGW) {
        const f32x4* xr = (const f32x4*)x_in_row(p, tok) + lane;
        const float* mrow = modv + (size_t)mod_row(tok) * 6144 + which * 3072;
        f32x4 v[4]; float s = 0.f;
#pragma unroll
        for (int j = 0; j < 4; ++j) { v[j] = xr[64 * j]; s += v[j].x * v[j].x + v[j].y * v[j].y + v[j].z * v[j].z + v[j].w * v[j].w; }
        const float rstd = rsqrtf(wave_sum(s) * (1.f / D) + NORM_EPS);
        u32x2* o = (u32x2*)(H + (size_t)tok * D) + lane;
#pragma unroll
        for (int j = 0; j < 4; ++j) {
            const int k = 4 * lane + 256 * j;
            const f32x4 w4 = *(const f32x4*)(nw + k), sh = *(const f32x4*)(mrow + k), sc = *(const f32x4*)(mrow + 1024 + k);
            const float y0 = v[j].x * rstd * w4.x * (1.f + sc.x) + sh.x, y1 = v[j].y * rstd * w4.y * (1.f + sc.y) + sh.y;
            const float y2 = v[j].z * rstd * w4.z * (1.f + sc.z) + sh.z, y3 = v[j].w * rstd * w4.w * (1.f + sc.w) + sh.w;
            u32x2 w; w.x = pk2(y0, y1); w.y = pk2(y2, y3); o[64 * j] = w;
        }
    }
}

struct EpiZ {
    bf16_t* Z; float* ssq; float* sskv; bf16_t* Kb; const float* ct; const float* st;
    __device__ __forceinline__ void operator()(const ge::Acc& acc, const ge::Unit& u, int wr, int wc, int fr, int fq) const {
#pragma unroll
        for (int ai = 0; ai < 2; ++ai)
#pragma unroll
            for (int m = 0; m < 4; ++m) {
                const int row = u.a * 256 + ai * 128 + wr * 64 + m * 16 + fr;
#pragma unroll
                for (int bj = 0; bj < 2; ++bj) {
                    const f32x4 v0 = acc[ai][bj][m][0], v1 = acc[ai][bj][m][1];
                    u32x4 w; w.x = cvtpk(v0.x, v0.y); w.y = cvtpk(v0.z, v0.w); w.z = cvtpk(v1.x, v1.y); w.w = cvtpk(v1.z, v1.w);
                    *(u32x4*)(Z + (size_t)row * ZC + u.b * 256 + bj * 128 + wc * 32 + 8 * fq) = w;
                }
                if (u.b == 5) {
                    float sq = 0.f;
#pragma unroll
                    for (int bj = 0; bj < 2; ++bj)
#pragma unroll
                        for (int n = 0; n < 2; ++n) { const f32x4 v = acc[ai][bj][m][n]; sq += v.x * v.x + v.y * v.y + v.z * v.z + v.w * v.w; }
                    sq += __shfl_xor(sq, 16); sq += __shfl_xor(sq, 32);
                    if (fq == 0) ssq[(size_t)row * 4 + wc] = sq;
                }
                if (u.b == 6) {
                    float sq = 0.f;
#pragma unroll
                    for (int n = 0; n < 2; ++n) { const f32x4 v = acc[ai][0][m][n]; sq += v.x * v.x + v.y * v.y + v.z * v.z + v.w * v.w; }
                    sq += __shfl_xor(sq, 16); sq += __shfl_xor(sq, 32);
                    if (fq == 0) sskv[(size_t)row * 4 + wc] = sq;
                    if (wc == 0) {
                        const f32x4 a0 = acc[ai][1][m][0], a1 = acc[ai][1][m][1];
                        f32x4 b0, b1;
#pragma unroll
                        for (int j = 0; j < 4; ++j) { b0[j] = __shfl_xor(a0[j], 32); b1[j] = __shfl_xor(a1[j], 32); }
                        if (fq < 2) {
                            f32x4 c0 = (f32x4){1.f, 1.f, 1.f, 1.f}, c1 = c0, s0 = (f32x4){0.f, 0.f, 0.f, 0.f}, s1 = s0;
                            if (row < NLAT) { const int pos = row & (SEQ - 1); c0 = *(const f32x4*)(ct + pos * 16 + 8 * fq); c1 = *(const f32x4*)(ct + pos * 16 + 8 * fq + 4); s0 = *(const f32x4*)(st + pos * 16 + 8 * fq); s1 = *(const f32x4*)(st + pos * 16 + 8 * fq + 4); }
                            const f32x4 o10 = a0 * c0 - b0 * s0, o20 = a0 * s0 + b0 * c0, o11 = a1 * c1 - b1 * s1, o21 = a1 * s1 + b1 * c1;
                            u32x4 w0, w1; w0.x = cvtpk(o10.x, o20.x); w0.y = cvtpk(o10.y, o20.y); w0.z = cvtpk(o10.z, o20.z); w0.w = cvtpk(o10.w, o20.w);
                            w1.x = cvtpk(o11.x, o21.x); w1.y = cvtpk(o11.y, o21.y); w1.z = cvtpk(o11.z, o21.z); w1.w = cvtpk(o11.w, o21.w);
#pragma unroll
                            for (int h = 0; h < 8; ++h) { bf16_t* kp = Kb + (size_t)row * 768 + h * 96 + 64 + 16 * fq; *(u32x4*)kp = w0; *(u32x4*)(kp + 8) = w1; }
                        }
                    }
                }
            }
    }
};
__device__ __forceinline__ void phase_zgemm(unsigned char* lds, const P& p, int L) {
    const bf16_t* W = (const bf16_t*)(p.ws + WS_WIN) + (size_t)L * ZC * D;
    ge::DenseOrder S; S.nM = NTOK / 256; S.nN = ZC / 256; S.nwg = S.nM * S.nN; S.G = gridDim.x; S.c = blockIdx.x; S.Bt = (const char*)W; S.btile = (size_t)256 * D * 2; S.arow = D * 2;
    EpiZ E{(bf16_t*)(p.ws + WS_Z), (float*)(p.ws + WS_SS), (float*)(p.ws + WS_SS) + (size_t)NTOK * 4, (bf16_t*)(p.ws + WS_K), (const float*)(p.ws + WS_ROPE), (const float*)(p.ws + WS_ROPE) + 2048 * 16};
    ge::gemm_stream<ge::DenseOrder, EpiZ, true>((LAS unsigned char*)lds, (const char*)(p.ws + (L == 0 ? WS_H : WS_H1)), D, S, E);
}

__device__ __forceinline__ void conv_unit(unsigned char* lds, const P& p, int L, int s, int tt) {
    float* hg = (float*)lds;
    const int tid = threadIdx.x, lane = tid & 63, wave = tid >> 6;
    const int rb = s < 16 ? s * SEQ : NLAT + (s - 16) * CTXL, len = s < 16 ? SEQ : CTXL, t0 = tt * 64;
    const bf16_t* Z = (const bf16_t*)(p.ws + WS_Z);
    {
        u32x2 av[12], gv[12];
#pragma unroll
        for (int q = 0; q < 12; ++q) {
            const int i = tid + q * NTHREADS, jj = i >> 6, c4 = (i & 63) * 4; int t = t0 - 15 + jj; t = t < 0 ? 0 : (t >= len ? len - 1 : t);
            const bf16_t* zr = Z + (size_t)(rb + t) * ZC;
            av[q] = *(const u32x2*)(zr + c4); gv[q] = *(const u32x2*)(zr + 256 + c4);
        }
#pragma unroll
        for (int q = 0; q < 12; ++q) {
            const int i = tid + q * NTHREADS, jj = i >> 6, c4 = (i & 63) * 4, t = t0 - 15 + jj;
            if (i < 94 * 64) {
                f32x4 h = (f32x4){0.f, 0.f, 0.f, 0.f};
                if (t >= 0 && t < len) {
                    const u32x2 a = av[q], g = gv[q];
                    h.x = lo16(a.x) * __builtin_amdgcn_rcpf(1.f + __expf(-lo16(g.x))); h.y = hi16(a.x) * __builtin_amdgcn_rcpf(1.f + __expf(-hi16(g.x)));
                    h.z = lo16(a.y) * __builtin_amdgcn_rcpf(1.f + __expf(-lo16(g.y))); h.w = hi16(a.y) * __builtin_amdgcn_rcpf(1.f + __expf(-hi16(g.y)));
                }
                *(f32x4*)(hg + jj * 256 + c4) = h;
            }
        }
    }
    float* wl = hg + 94 * 256;
    for (int i = tid; i < 31 * 64; i += NTHREADS) *(f32x4*)(wl + i * 4) = *(const f32x4*)(p.in[8] + (size_t)L * 31 * 256 + i * 4);
    __syncthreads();
    const int c0 = lane * 4;
    const f32x4 cb = *(const f32x4*)(p.in[9] + L * 256 + c0), lw = *(const f32x4*)(p.in[10] + L * 256 + c0), lb = *(const f32x4*)(p.in[11] + L * 256 + c0);
    bf16_t* CC = (bf16_t*)(p.ws + WS_CC);
    {
        f32x4 w[31];
#pragma unroll
        for (int j = 0; j < 31; ++j) w[j] = *(const f32x4*)(wl + j * 256 + c0);
#pragma unroll 1
        for (int half = 0; half < 2; ++half) {
            f32x4 acc[4];
#pragma unroll
            for (int q = 0; q < 4; ++q) acc[q] = cb;
            const float* hrow = hg + (wave * 8 + half * 4) * 256 + c0;
#pragma unroll
            for (int r = 0; r < 34; ++r) {
                const f32x4 h = *(const f32x4*)(hrow + r * 256);
#pragma unroll
                for (int q = 0; q < 4; ++q) { if (r - q >= 0 && r - q <= 30) acc[q] += h * w[r - q]; }
            }
#pragma unroll
            for (int q = 0; q < 4; ++q) {
                const int tl = wave * 8 + half * 4 + q;
                const float mean = wave_sum(acc[q].x + acc[q].y + acc[q].z + acc[q].w) * (1.f / 256.f);
                const f32x4 d = acc[q] - mean;
                const float var = wave_sum(d.x * d.x + d.y * d.y + d.z * d.z + d.w * d.w) * (1.f / 256.f);
                const float rstd = rsqrtf(var + NORM_EPS);
                const f32x4 y = d * rstd * lw + lb;
                u32x2 o; o.x = cvtpk(siluf(y.x), siluf(y.y)); o.y = cvtpk(siluf(y.z), siluf(y.w));
                *(u32x2*)(CC + (size_t)(rb + t0 + tl) * D + c0) = o;
            }
        }
    }
    __syncthreads();
}

__device__ __forceinline__ float log2_gamma(const P& p, int L, int dir, int h) {
    const float x = p.in[12][(L * 2 + dir) * 4 + h];
    const float ls = fminf(x, 0.f) - log1pf(expf(-fabsf(x)));
    return ls * 1.4426950408889634f;
}
__device__ __forceinline__ void load_ret_qk(float* dst, const P& p, int gc, int h, int zoff, float scale) {
    const int tid = threadIdx.x, j = tid >> 2, i0 = (tid & 3) * 4, row = gc * 128 + j;
    const bf16_t* zr = (const bf16_t*)(p.ws + WS_Z) + (size_t)row * ZC + zoff + h * 32;
    const u32x2 a = *(const u32x2*)(zr + i0), b = *(const u32x2*)(zr + 16 + i0);
    float x1[4] = {lo16(a.x), hi16(a.x), lo16(a.y), hi16(a.y)}, x2[4] = {lo16(b.x), hi16(b.x), lo16(b.y), hi16(b.y)};
    const bool lat = row < NLAT; const int pos = row & (SEQ - 1);
    const float* ct = (const float*)(p.ws + WS_ROPE) + pos * 16 + i0; const float* st = ct + 2048 * 16;
#pragma unroll
    for (int i = 0; i < 4; ++i) {
        const float c = lat ? ct[i] : 1.f, s = lat ? st[i] : 0.f;
        dst[j * 33 + i0 + i] = (x1[i] * c - x2[i] * s) * scale;
        dst[j * 33 + 16 + i0 + i] = (x1[i] * s + x2[i] * c) * scale;
    }
}
__device__ __forceinline__ void load_ret_v(float* dst  , const P& p, int gc, int h) {
    const int tid = threadIdx.x, j = tid >> 2, e0 = (tid & 3) * 16;
    const bf16_t* zr = (const bf16_t*)(p.ws + WS_Z) + (size_t)(gc * 128 + j) * ZC + Z_RV + h * 64 + e0;
    const u32x4 a = *(const u32x4*)zr, b = *(const u32x4*)(zr + 8);
#pragma unroll
    for (int i = 0; i < 4; ++i) { dst[j * 64 + e0 + 2 * i] = lo16(a[i]); dst[j * 64 + e0 + 2 * i + 1] = hi16(a[i]); dst[j * 64 + e0 + 8 + 2 * i] = lo16(b[i]); dst[j * 64 + e0 + 8 + 2 * i + 1] = hi16(b[i]); }
}
__device__ __forceinline__ void retkv_unit(unsigned char* lds, const P& p, int L, int gc, int h) {
    float* ks = (float*)lds; float* vs = ks + 128 * 33; float* wf = vs + 128 * 64; float* wb = wf + 128;
    const int tid = threadIdx.x;
    const float l2f = log2_gamma(p, L, 0, h), l2b = log2_gamma(p, L, 1, h);
    load_ret_qk(ks, p, gc, h, Z_RK, 0.17677669529663687f);
    load_ret_v(vs, p, gc, h);
    if (tid < 128) { wf[tid] = exp2f(l2f * (float)(127 - tid)); wb[tid] = exp2f(l2b * (float)tid); }
    __syncthreads();
    const int d = tid >> 4, e0 = (tid & 15) * 4;
    f32x4 af = (f32x4){0.f, 0.f, 0.f, 0.f}, ab = af;
    for (int j = 0; j < 128; ++j) {
        const float kd = ks[j * 33 + d]; const f32x4 v4 = *(const f32x4*)(vs + j * 64 + e0);
        af += (kd * wf[j]) * v4; ab += (kd * wb[j]) * v4;
    }
    float* KV = (float*)(p.ws + WS_KV) + ((size_t)(gc * 4 + h) * 2) * 2048;
    *(f32x4*)(KV + d * 64 + e0) = af; *(f32x4*)(KV + 2048 + d * 64 + e0) = ab;
    __syncthreads();
}
__device__ __forceinline__ void ret_stage_k(unsigned char* kf, unsigned char* kb, int rowb, const P& p, int gc, int h, float ef, float jf0, float eb, float jb0) {
    const int tid = threadIdx.x, j = tid >> 2, i0 = (tid & 3) * 4, row = gc * 128 + j;
    const bf16_t* zr = (const bf16_t*)(p.ws + WS_Z) + (size_t)row * ZC + Z_RK + h * 32;
    const u32x2 a = *(const u32x2*)(zr + i0), b = *(const u32x2*)(zr + 16 + i0);
    const float x1[4] = {lo16(a.x), hi16(a.x), lo16(a.y), hi16(a.y)}, x2[4] = {lo16(b.x), hi16(b.x), lo16(b.y), hi16(b.y)};
    f32x4 c4 = (f32x4){1.f, 1.f, 1.f, 1.f}, s4 = (f32x4){0.f, 0.f, 0.f, 0.f};
    if (row < NLAT) { const int pos = row & (SEQ - 1); const float* ct = (const float*)(p.ws + WS_ROPE) + pos * 16 + i0; c4 = *(const f32x4*)ct; s4 = *(const f32x4*)(ct + 2048 * 16); }
    const float wf = __builtin_amdgcn_exp2f(ef * ((float)j - jf0)) * 0.17677669529663687f, wb = __builtin_amdgcn_exp2f(eb * ((float)j - jb0)) * 0.17677669529663687f;
    float o1[4], o2[4];
#pragma unroll
    for (int i = 0; i < 4; ++i) { o1[i] = x1[i] * c4[i] - x2[i] * s4[i]; o2[i] = x1[i] * s4[i] + x2[i] * c4[i]; }
    u32x2 w;
    w.x = cvtpk(o1[0] * wf, o1[1] * wf); w.y = cvtpk(o1[2] * wf, o1[3] * wf); *(u32x2*)(kf + j * rowb + i0 * 2) = w;
    w.x = cvtpk(o2[0] * wf, o2[1] * wf); w.y = cvtpk(o2[2] * wf, o2[3] * wf); *(u32x2*)(kf + j * rowb + 32 + i0 * 2) = w;
    w.x = cvtpk(o1[0] * wb, o1[1] * wb); w.y = cvtpk(o1[2] * wb, o1[3] * wb); *(u32x2*)(kb + j * rowb + i0 * 2) = w;
    w.x = cvtpk(o2[0] * wb, o2[1] * wb); w.y = cvtpk(o2[2] * wb, o2[3] * wb); *(u32x2*)(kb + j * rowb + 32 + i0 * 2) = w;
}
__device__ __forceinline__ void ret_stage_v(unsigned char* vt, const P& p, int gc, int h) {
    const int tid = threadIdx.x, j = tid >> 2, e0 = (tid & 3) * 16;
    const bf16_t* zr = (const bf16_t*)(p.ws + WS_Z) + (size_t)(gc * 128 + j) * ZC + Z_RV + h * 64 + e0;
    const u32x4 a = *(const u32x4*)zr, b = *(const u32x4*)(zr + 8);
    unsigned char* d = vt + (e0 >> 5) * 8192 + j * 64 + (e0 & 31) * 2;
    *(u32x4*)d = a; *(u32x4*)(d + 16) = b;
}
__device__ __forceinline__ bf16x8 tr8(const unsigned char* p0, const unsigned char* p1) {
    const v4i16_t a = __builtin_amdgcn_ds_read_tr16_b64_v4i16((LAS v4i16_t*)(const LAS unsigned char*)p0), b = __builtin_amdgcn_ds_read_tr16_b64_v4i16((LAS v4i16_t*)(const LAS unsigned char*)p1);
    return (bf16x8){a[0], a[1], a[2], a[3], b[0], b[1], b[2], b[3]};
}
__device__ __forceinline__ void retkv_unit_mfma(unsigned char* lds, const P& p, int L, int gc, int h) {
    const int tid = threadIdx.x, lane = tid & 63, wid = tid >> 6;
    const float l2f = log2_gamma(p, L, 0, h), l2b = log2_gamma(p, L, 1, h);
    ret_stage_k(lds, lds + 8192, 64, p, gc, h, -l2f, 127.f, l2b, 0.f);
    ret_stage_v(lds + 16384, p, gc, h);
    __syncthreads();
    if (wid < 4) {
        const int dir = wid >> 1, eb = wid & 1, g = lane >> 4, i = lane & 15, hh = lane >> 5;
        const int off = (8 * hh + (i >> 2)) * 64 + (g & 1) * 32 + (i & 3) * 8;
        const unsigned char* Kt = lds + dir * 8192 + off; const unsigned char* Vt = lds + 16384 + eb * 8192 + off;
        f32x16 acc;
#pragma unroll
        for (int r = 0; r < 16; ++r) acc[r] = 0.f;
#pragma unroll
        for (int s = 0; s < 8; ++s) acc = __builtin_amdgcn_mfma_f32_32x32x16_bf16(tr8(Vt + s * 1024, Vt + s * 1024 + 256), tr8(Kt + s * 1024, Kt + s * 1024 + 256), acc, 0, 0, 0);
        bf16_t* KV = (bf16_t*)(p.ws + WS_KV) + ((size_t)(gc * 4 + h) * 2 + dir) * 2048 + (lane & 31) * 64 + eb * 32 + 4 * hh;
#pragma unroll
        for (int r4 = 0; r4 < 4; ++r4) { u32x2 w; w.x = cvtpk(acc[4 * r4], acc[4 * r4 + 1]); w.y = cvtpk(acc[4 * r4 + 2], acc[4 * r4 + 3]); *(u32x2*)(KV + 8 * r4) = w; }
    }
    __syncthreads();
}
__device__ __forceinline__ void retout_unit_mfma(unsigned char* lds, const P& p, int L, int gc, int h) {
    constexpr int KROW = 80, O_KF = 0, O_KB = 10240, O_V = 20480, O_SF = 36864, O_SB = 41984, O_RED = 47104;
    const int tid = threadIdx.x, lane = tid & 63, wid = tid >> 6, r32 = lane & 31, hh = lane >> 5;
    const float l2f = log2_gamma(p, L, 0, h), l2b = log2_gamma(p, L, 1, h);
    const int qb = wid & 3, eb = wid >> 2, i = qb * 32 + r32, row = gc * 128 + i;
    const bf16_t* zq = (const bf16_t*)(p.ws + WS_Z) + (size_t)row * ZC + Z_RQ + h * 32 + 8 * hh;
    const u32x4 qa = *(const u32x4*)zq, qbv = *(const u32x4*)(zq + 16);
    f32x4 rc0 = (f32x4){1.f, 1.f, 1.f, 1.f}, rc1 = rc0, rs0 = (f32x4){0.f, 0.f, 0.f, 0.f}, rs1 = rs0;
    if (row < NLAT) { const float* ct = (const float*)(p.ws + WS_ROPE) + (row & (SEQ - 1)) * 16 + 8 * hh; const float* st = ct + 2048 * 16;
        rc0 = *(const f32x4*)ct; rc1 = *(const f32x4*)(ct + 4); rs0 = *(const f32x4*)st; rs1 = *(const f32x4*)(st + 4); }
    const bf16_t* zg = (const bf16_t*)(p.ws + WS_Z) + (size_t)row * ZC + Z_RG + h * 64 + eb * 32 + 4 * hh;
    const float* gw = p.in[13] + L * 256 + h * 64 + eb * 32 + 4 * hh;
    u32x2 gzv[4]; f32x4 gwv[4];
#pragma unroll
    for (int r4 = 0; r4 < 4; ++r4) { gzv[r4] = *(const u32x2*)(zg + 8 * r4); gwv[r4] = *(const f32x4*)(gw + 8 * r4); }
    const bool lat = gc < 256; const int b = lat ? gc >> 4 : (gc - 256) >> 1;
    u32x2 kvf[18], kvb[18];
    {
        const bf16_t* KVb = (const bf16_t*)(p.ws + WS_KV);
#pragma unroll
        for (int mm = 0; mm < 18; ++mm) {
            const int gcm = mm < 2 ? 256 + b * 2 + mm : b * 16 + (mm - 2);
            const bf16_t* kv = KVb + ((size_t)(gcm * 4 + h) * 2) * 2048 + tid * 4;
            kvf[mm] = *(const u32x2*)kv; kvb[mm] = *(const u32x2*)(kv + 2048);
        }
    }
    ret_stage_k(lds + O_KF, lds + O_KB, KROW, p, gc, h, -l2f, 0.f, l2b, 0.f);
    ret_stage_v(lds + O_V, p, gc, h);
    {
        const int mme = lat ? 2 + (gc & 15) : (gc - 256) & 1;
        const int u = mme, w = mme < 2 ? 1 - mme : 19 - mme;
        f32x4 sf = (f32x4){0.f, 0.f, 0.f, 0.f}, sb = sf;
#pragma unroll
        for (int mm = 0; mm < 18; ++mm) {
            const int um = mm, wm = mm < 2 ? 1 - mm : 19 - mm;
            const u32x2 kf2 = kvf[mm], kb2 = kvb[mm];
            const float wgf = um < u ? __builtin_amdgcn_exp2f(l2f * 128.f * (float)(u - 1 - um)) : 0.f;
            const float wgb = wm < w ? __builtin_amdgcn_exp2f(l2b * 128.f * (float)(w - 1 - wm)) : 0.f;
            sf += wgf * (f32x4){lo16(kf2.x), hi16(kf2.x), lo16(kf2.y), hi16(kf2.y)}; sb += wgb * (f32x4){lo16(kb2.x), hi16(kb2.x), lo16(kb2.y), hi16(kb2.y)};
        }
        const int d = tid >> 4, e0 = (tid & 15) * 4;
#pragma unroll
        for (int k = 0; k < 4; ++k) { *(bf16_t*)(lds + O_SF + (e0 + k) * KROW + d * 2) = (bf16_t)(cvtpk(sf[k], 0.f) & 0xffffu); *(bf16_t*)(lds + O_SB + (e0 + k) * KROW + d * 2) = (bf16_t)(cvtpk(sb[k], 0.f) & 0xffffu); }
    }
    __syncthreads();
    bf16x8 qf[2];
    {
        float x1[8], x2[8];
#pragma unroll
        for (int k = 0; k < 4; ++k) { x1[2 * k] = lo16(qa[k]); x1[2 * k + 1] = hi16(qa[k]); x2[2 * k] = lo16(qbv[k]); x2[2 * k + 1] = hi16(qbv[k]); }
#pragma unroll
        for (int k = 0; k < 8; ++k) { const float c = k < 4 ? rc0[k & 3] : rc1[k & 3], sn = k < 4 ? rs0[k & 3] : rs1[k & 3], u1 = x1[k], u2 = x2[k]; x1[k] = u1 * c - u2 * sn; x2[k] = u1 * sn + u2 * c; }
        const u32x4 q0 = (u32x4){cvtpk(x1[0], x1[1]), cvtpk(x1[2], x1[3]), cvtpk(x1[4], x1[5]), cvtpk(x1[6], x1[7])};
        const u32x4 q1 = (u32x4){cvtpk(x2[0], x2[1]), cvtpk(x2[2], x2[3]), cvtpk(x2[4], x2[5]), cvtpk(x2[6], x2[7])};
        qf[0] = __builtin_bit_cast(bf16x8, q0); qf[1] = __builtin_bit_cast(bf16x8, q1);
    }
    const float af = __builtin_amdgcn_exp2f(l2f * (float)i), ab = __builtin_amdgcn_exp2f(-l2b * (float)i), cf = __builtin_amdgcn_exp2f(l2f * (float)(i + 1)), cb = __builtin_amdgcn_exp2f(l2b * (float)(128 - i));
    f32x16 y, zero;
#pragma unroll
    for (int r = 0; r < 16; ++r) { y[r] = 0.f; zero[r] = 0.f; }
    const int koff = r32 * KROW + 16 * hh;
    const int voff = O_V + eb * 8192 + (4 * hh + ((lane & 15) >> 2)) * 64 + ((lane >> 4) & 1) * 32 + (lane & 3) * 8;
#pragma unroll
    for (int kb = 0; kb < 4; ++kb) {
        f32x16 pt;
        if (kb <= qb) {
            f32x16 sF = __builtin_amdgcn_mfma_f32_32x32x16_bf16(*(const bf16x8*)(lds + O_KF + kb * 32 * KROW + koff), qf[0], zero, 0, 0, 0);
            sF = __builtin_amdgcn_mfma_f32_32x32x16_bf16(*(const bf16x8*)(lds + O_KF + kb * 32 * KROW + koff + 32), qf[1], sF, 0, 0, 0);
            if (kb < qb) {
#pragma unroll
                for (int r = 0; r < 16; ++r) pt[r] = sF[r] * af;
            } else {
#pragma unroll
                for (int r = 0; r < 16; ++r) { const int j = (r & 3) + 8 * (r >> 2) + 4 * hh; pt[r] = (j <= r32) ? sF[r] * af : 0.f; }
            }
        }
        if (kb >= qb) {
            f32x16 sB = __builtin_amdgcn_mfma_f32_32x32x16_bf16(*(const bf16x8*)(lds + O_KB + kb * 32 * KROW + koff), qf[0], zero, 0, 0, 0);
            sB = __builtin_amdgcn_mfma_f32_32x32x16_bf16(*(const bf16x8*)(lds + O_KB + kb * 32 * KROW + koff + 32), qf[1], sB, 0, 0, 0);
            if (kb > qb) {
#pragma unroll
                for (int r = 0; r < 16; ++r) pt[r] = sB[r] * ab;
            } else {
#pragma unroll
                for (int r = 0; r < 16; ++r) { const int j = (r & 3) + 8 * (r >> 2) + 4 * hh; pt[r] += (j >= r32) ? sB[r] * ab : 0.f; }
            }
        }
#pragma unroll
        for (int s2 = 0; s2 < 2; ++s2) {
            const u32x4 pw = (u32x4){cvtpk(pt[8 * s2], pt[8 * s2 + 1]), cvtpk(pt[8 * s2 + 2], pt[8 * s2 + 3]), cvtpk(pt[8 * s2 + 4], pt[8 * s2 + 5]), cvtpk(pt[8 * s2 + 6], pt[8 * s2 + 7])};
            const unsigned char* vb = lds + voff + (kb * 32 + s2 * 16) * 64;
            y = __builtin_amdgcn_mfma_f32_32x32x16_bf16(tr8(vb, vb + 8 * 64), __builtin_bit_cast(bf16x8, pw), y, 0, 0, 0);
        }
    }
    {
        const int soff = (eb * 32 + r32) * KROW + 16 * hh;
        f32x16 tF = __builtin_amdgcn_mfma_f32_32x32x16_bf16(*(const bf16x8*)(lds + O_SF + soff), qf[0], zero, 0, 0, 0);
        tF = __builtin_amdgcn_mfma_f32_32x32x16_bf16(*(const bf16x8*)(lds + O_SF + soff + 32), qf[1], tF, 0, 0, 0);
        f32x16 tB = __builtin_amdgcn_mfma_f32_32x32x16_bf16(*(const bf16x8*)(lds + O_SB + soff), qf[0], zero, 0, 0, 0);
        tB = __builtin_amdgcn_mfma_f32_32x32x16_bf16(*(const bf16x8*)(lds + O_SB + soff + 32), qf[1], tB, 0, 0, 0);
#pragma unroll
        for (int r = 0; r < 16; ++r) y[r] += tF[r] * cf + tB[r] * cb;
    }
    float s1 = 0.f, s2 = 0.f;
#pragma unroll
    for (int r = 0; r < 16; ++r) { s1 += y[r]; s2 += y[r] * y[r]; }
    s1 += __shfl_xor(s1, 32); s2 += __shfl_xor(s2, 32);
    float* red = (float*)(lds + O_RED);
    if (hh == 0) { red[(eb * 128 + i) * 2] = s1; red[(eb * 128 + i) * 2 + 1] = s2; }
    __syncthreads();
    s1 = red[i * 2] + red[(128 + i) * 2]; s2 = red[i * 2 + 1] + red[(128 + i) * 2 + 1];
    const float mu = s1 * (1.f / 64.f), var = fmaxf(s2 * (1.f / 64.f) - mu * mu, 0.f), rstd = rsqrtf(var + NORM_EPS);
    bf16_t* orow = (bf16_t*)(p.ws + WS_CC) + (size_t)row * D + 256 + h * 64 + eb * 32 + 4 * hh;
#pragma unroll
    for (int r4 = 0; r4 < 4; ++r4) {
        const u32x2 gz = gzv[r4]; const f32x4 w4 = gwv[r4];
        const float g0 = lo16(gz.x), g1 = hi16(gz.x), g2 = lo16(gz.y), g3 = hi16(gz.y);
        u32x2 o; o.x = cvtpk(siluf(g0) * ((y[4 * r4] - mu) * rstd * w4.x), siluf(g1) * ((y[4 * r4 + 1] - mu) * rstd * w4.y));
        o.y = cvtpk(siluf(g2) * ((y[4 * r4 + 2] - mu) * rstd * w4.z), siluf(g3) * ((y[4 * r4 + 3] - mu) * rstd * w4.w));
        *(u32x2*)(orow + 8 * r4) = o;
    }
    __syncthreads();
}
__device__ __forceinline__ void qkv_proj(unsigned char* lds, const P& p, int L) {
    const float* sskv = (const float*)(p.ws + WS_SS) + (size_t)NTOK * 4;
    const int G = gridDim.x, bid = blockIdx.x;
    {
        bf16_t* Q = (bf16_t*)(p.ws + WS_Q);
        ge::DenseOrder S; S.nM = NTOK / 256; S.nN = 3; S.nwg = S.nM * 3; S.G = G; S.c = bid; S.Bt = (const char*)((const bf16_t*)(p.ws + WS_WUQ) + (size_t)L * 768 * 256); S.btile = (size_t)256 * 256 * 2; S.arow = ZC * 2;
        auto f = [&](const ge::Unit& u, int r, int c, f32x4 v0, f32x4 v1) {
            u32x4 w; w.x = cvtpk(v0.x, v0.y); w.y = cvtpk(v0.z, v0.w); w.z = cvtpk(v1.x, v1.y); w.w = cvtpk(v1.z, v1.w); *(u32x4*)(Q + (size_t)(u.a * 256 + r) * 768 + u.b * 256 + c) = w;
        };
        ge::EpiFn<decltype(f)> E{f};
        ge::gemm_stream<ge::DenseOrder, ge::EpiFn<decltype(f)>, true>((LAS unsigned char*)lds, (const char*)(p.ws + WS_Z) + Z_CQ * 2, 256, S, E);
    }
    {
        bf16_t* Kb = (bf16_t*)(p.ws + WS_K); bf16_t* Vb = (bf16_t*)(p.ws + WS_V);
        ge::DenseOrder S; S.nM = NTOK / 256; S.nN = 4; S.nwg = S.nM * 4; S.G = G; S.c = (bid + 176) % G; S.Bt = (const char*)((const bf16_t*)(p.ws + WS_WUKV) + (size_t)L * 1024 * 256); S.btile = (size_t)256 * 256 * 2; S.arow = ZC * 2;
        struct EpiKV {
            bf16_t* Kb; bf16_t* Vb; const float* sskv;
            __device__ __forceinline__ void operator()(const ge::Acc& acc, const ge::Unit& u, int wr, int wc, int fr, int fq) const {
                float rstd[2][4];
#pragma unroll
                for (int ai = 0; ai < 2; ++ai)
#pragma unroll
                    for (int m = 0; m < 4; ++m) { const f32x4 s4 = *(const f32x4*)(sskv + (size_t)(u.a * 256 + ai * 128 + wr * 64 + m * 16 + fr) * 4); rstd[ai][m] = rsqrtf((s4.x + s4.y + s4.z + s4.w) * (1.f / 128.f) + NORM_EPS); }
#pragma unroll
                for (int ai = 0; ai < 2; ++ai)
#pragma unroll
                    for (int m = 0; m < 4; ++m) {
                        const int row = u.a * 256 + ai * 128 + wr * 64 + m * 16 + fr;
#pragma unroll
                        for (int bj = 0; bj < 2; ++bj) {
                            const int col = u.b * 256 + bj * 128 + wc * 32 + 8 * fq, h = col >> 7, j = col & 127;
                            const f32x4 v0 = acc[ai][bj][m][0] * rstd[ai][m], v1 = acc[ai][bj][m][1] * rstd[ai][m];
                            u32x4 w; w.x = cvtpk(v0.x, v0.y); w.y = cvtpk(v0.z, v0.w); w.z = cvtpk(v1.x, v1.y); w.w = cvtpk(v1.z, v1.w);
                            if (j < 64) *(u32x4*)(Kb + (size_t)row * 768 + h * 96 + j) = w;
                            else *(u32x4*)(Vb + (size_t)row * 512 + h * 64 + (j - 64)) = w;
                        }
                    }
            }
        };
        EpiKV E{Kb, Vb, sskv};
        ge::gemm_stream<ge::DenseOrder, EpiKV, true>((LAS unsigned char*)lds, (const char*)(p.ws + WS_Z) + Z_CKV * 2, 256, S, E);
    }
}
__device__ __forceinline__ void phase_b(unsigned char* lds, const P& p, int L) {
    const int G = gridDim.x, bid = blockIdx.x;
    qkv_proj(lds, p, L);
    const int nconv = (L == 0) ? 576 : 512;
    const int nkv = 288 * 4;
    const int total = nconv + nkv;
    for (int u = (bid + 96) % G; u < total; u += G) {
        int r = u;
        if (r < nconv) { if (r < 512) conv_unit(lds, p, L, r >> 5, r & 31); else conv_unit(lds, p, L, 16 + ((r - 512) >> 2), (r - 512) & 3); continue; } r -= nconv;
        retkv_unit_mfma(lds, p, L, r >> 2, r & 3);
    }
    if (L == 1) convert_expert_weights(lds, p, 1);
}

__device__ __forceinline__ void attn_unit_naive(unsigned char* lds, const P& p, int b, int h, int qb, bool ctxq) {
    float* Ks = (float*)lds;
    float* Vs = Ks + 64 * 96;
    const int tid = threadIdx.x, half = tid & 1, qi = tid >> 1;
    const bf16_t* Qb = (const bf16_t*)(p.ws + WS_Q); const bf16_t* Kb = (const bf16_t*)(p.ws + WS_K); const bf16_t* Vb = (const bf16_t*)(p.ws + WS_V);
    const int qrow = ctxq ? NLAT + b * CTXL + qi : b * SEQ + qb * 256 + qi;
    float q[48];
    {
        const u32x4* qp = (const u32x4*)(Qb + (size_t)qrow * 768 + h * 96 + half * 48);
#pragma unroll
        for (int i = 0; i < 6; ++i) { const u32x4 w = qp[i];
#pragma unroll
            for (int k = 0; k < 4; ++k) { q[i * 8 + 2 * k] = lo16(w[k]); q[i * 8 + 2 * k + 1] = hi16(w[k]); } }
    }
    float o[32];
#pragma unroll
    for (int e = 0; e < 32; ++e) o[e] = 0.f;
    float m = -1e30f, l = 0.f;
    const int ntiles = ctxq ? 4 : 36;
#pragma unroll 1
    for (int t = 0; t < ntiles; ++t) {
        const int krow0 = t < 4 ? NLAT + b * CTXL + t * 64 : b * SEQ + (t - 4) * 64;
        __syncthreads();
        for (int i = tid; i < 64 * 12; i += NTHREADS) { const int key = i / 12, c = i % 12; const u32x4 w = *(const u32x4*)(Kb + (size_t)(krow0 + key) * 768 + h * 96 + c * 8);
            float* d = Ks + key * 96 + c * 8;
#pragma unroll
            for (int k = 0; k < 4; ++k) { d[2 * k] = lo16(w[k]); d[2 * k + 1] = hi16(w[k]); } }
        for (int i = tid; i < 64 * 8; i += NTHREADS) { const int key = i >> 3, c = i & 7; const u32x4 w = *(const u32x4*)(Vb + (size_t)(krow0 + key) * 512 + h * 64 + c * 8);
            float* d = Vs + key * 64 + c * 8;
#pragma unroll
            for (int k = 0; k < 4; ++k) { d[2 * k] = lo16(w[k]); d[2 * k + 1] = hi16(w[k]); } }
        __syncthreads();
#pragma unroll 1
        for (int j0 = 0; j0 < 64; j0 += 2) {
            float s[2]; float mt = -1e30f;
#pragma unroll
            for (int jj = 0; jj < 2; ++jj) {
                const f32x4* kr = (const f32x4*)(Ks + (j0 + jj) * 96 + half * 48);
                float a = 0.f;
#pragma unroll
                for (int d4 = 0; d4 < 12; ++d4) { const f32x4 kv = kr[d4]; a += q[4 * d4] * kv.x + q[4 * d4 + 1] * kv.y + q[4 * d4 + 2] * kv.z + q[4 * d4 + 3] * kv.w; }
                a += __shfl_xor(a, 1);
                s[jj] = a; mt = fmaxf(mt, a);
            }
            const float mn = fmaxf(m, mt), alpha = exp2f(m - mn);
            m = mn; l *= alpha;
#pragma unroll
            for (int e = 0; e < 32; ++e) o[e] *= alpha;
#pragma unroll
            for (int jj = 0; jj < 2; ++jj) {
                const float pj = exp2f(s[jj] - mn); l += pj;
                const f32x4* vr = (const f32x4*)(Vs + (j0 + jj) * 64 + half * 32);
#pragma unroll
                for (int e4 = 0; e4 < 8; ++e4) { const f32x4 vv = vr[e4]; o[4 * e4] += pj * vv.x; o[4 * e4 + 1] += pj * vv.y; o[4 * e4 + 2] += pj * vv.z; o[4 * e4 + 3] += pj * vv.w; }
            }
        }
    }
    {
        const float rl = 1.f / l;
        u32x4* op = (u32x4*)((bf16_t*)(p.ws + WS_CC) + (size_t)qrow * D + 512 + h * 64 + half * 32);
#pragma unroll
        for (int i = 0; i < 4; ++i) { u32x4 w; w.x = pk2(o[8 * i] * rl, o[8 * i + 1] * rl); w.y = pk2(o[8 * i + 2] * rl, o[8 * i + 3] * rl); w.z = pk2(o[8 * i + 4] * rl, o[8 * i + 5] * rl); w.w = pk2(o[8 * i + 6] * rl, o[8 * i + 7] * rl); op[i] = w; }
    }
    __syncthreads();
}
__device__ __forceinline__ float max3f(float a, float b, float c) { float r; asm("v_max3_f32 %0, %1, %2, %3" : "=v"(r) : "v"(a), "v"(b), "v"(c)); return r; }
constexpr int AT_KROW = 208;
constexpr int AT_KBUF = 64 * AT_KROW;
constexpr int AT_VBUF = 8192;
constexpr int AT_BUF = AT_KBUF + AT_VBUF;
__device__ __forceinline__ void attn_unit_mfma(unsigned char* lds, const P& p, int b, int h, int qb, bool ctxq) {
    const int tid = threadIdx.x, lane = tid & 63, wid = tid >> 6, r32 = lane & 31, hh = lane >> 5;
    const bf16_t* Qb = (const bf16_t*)(p.ws + WS_Q); const bf16_t* Kb = (const bf16_t*)(p.ws + WS_K); const bf16_t* Vb = (const bf16_t*)(p.ws + WS_V);
    const int qrow = (ctxq ? NLAT + b * CTXL : b * SEQ + qb * 256) + wid * 32 + r32;
    f32x16 o0, o1, negm;
#pragma unroll
    for (int r = 0; r < 16; ++r) { o0[r] = 0.f; o1[r] = 0.f; negm[r] = 0.f; }
    asm volatile("" : "+v"(negm));
    float mhat = 0.f, l = 0.f;
    const int ntiles = ctxq ? 4 : 36;
    const int wv = __builtin_amdgcn_readfirstlane(wid);
    const int ia = wv, ib = (wv + 8 < 13) ? wv + 8 : 12;
    const int qa = ia * 64 + lane, qb2 = ib * 64 + lane, qv = wv * 64 + lane;
    const int ca = qa % 13, cb = qb2 % 13;
    const size_t ka = (size_t)(qa / 13) * 768 + h * 96 + (ca < 12 ? ca : 11) * 8, kbo = (size_t)(qb2 / 13) * 768 + h * 96 + (cb < 12 ? cb : 11) * 8;
    const size_t vo = (size_t)((qv >> 2) & 63) * 512 + h * 64 + (qv >> 8) * 32 + (qv & 3) * 8;
    auto krow0 = [&](int t) { return t < 4 ? NLAT + b * CTXL + t * 64 : b * SEQ + (t - 4) * 64; };
    const unsigned lds0 = (unsigned)(uintptr_t)lds;
#define AT_GLDS(gp, ldsoff) do { unsigned keep_; asm volatile("s_mov_b32 %0, m0\n\ts_mov_b32 m0, %2\n\ts_nop 0\n\tglobal_load_lds_dwordx4 %1, off\n\ts_mov_b32 m0, %0" : "=&s"(keep_) : "v"(gp), "s"((unsigned)__builtin_amdgcn_readfirstlane(lds0 + (unsigned)(ldsoff))) : "memory"); } while (0)
#define AT_ISSUE(t2, slot) do { const int kr_ = krow0(t2); const bf16_t* kb_ = Kb + (size_t)kr_ * 768; const bf16_t* vb_ = Vb + (size_t)kr_ * 512; \
        AT_GLDS(kb_ + ka, (slot) + ia * 1024); AT_GLDS(kb_ + kbo, (slot) + ib * 1024); AT_GLDS(vb_ + vo, (slot) + AT_KBUF + wv * 1024); } while (0)
#define AT_SB() __builtin_amdgcn_sched_barrier(0)
#define AT_PIN(x) asm volatile("" : "+v"(x))
#define AT_NEXT(x) ((x) == 3 * AT_BUF ? 0 : (x) + AT_BUF)
    __builtin_amdgcn_s_barrier();
    AT_ISSUE(0, 0);
    if (ntiles > 1) AT_ISSUE(1, AT_BUF);
    bf16x8 qf[6];
    {
        const f32x4 s4 = *(const f32x4*)((const float*)(p.ws + WS_SS) + (size_t)qrow * 4);
        const float rstd = rsqrtf((s4.x + s4.y + s4.z + s4.w) * (1.f / 256.f) + NORM_EPS);
        const float* ct = (const float*)(p.ws + WS_ROPE) + (qrow & (SEQ - 1)) * 16; const float* st = ct + 2048 * 16;
#pragma unroll
        for (int s = 0; s < 6; ++s) {
            const u32x4 w = *(const u32x4*)(Qb + (size_t)qrow * 768 + h * 96 + 16 * s + 8 * hh);
            float x[8];
#pragma unroll
            for (int k = 0; k < 4; ++k) { x[2 * k] = lo16(w[k]) * rstd; x[2 * k + 1] = hi16(w[k]) * rstd; }
            if (s >= 4 && !ctxq) {
                const f32x4 c4 = *(const f32x4*)(ct + 8 * (s - 4) + 4 * hh), sn = *(const f32x4*)(st + 8 * (s - 4) + 4 * hh);
#pragma unroll
                for (int k = 0; k < 4; ++k) { const float a = x[2 * k], b2 = x[2 * k + 1]; x[2 * k] = a * c4[k] - b2 * sn[k]; x[2 * k + 1] = a * sn[k] + b2 * c4[k]; }
            }
            const u32x4 o = (u32x4){cvtpk(x[0], x[1]), cvtpk(x[2], x[3]), cvtpk(x[4], x[5]), cvtpk(x[6], x[7])};
            qf[s] = __builtin_bit_cast(bf16x8, o);
        }
    }
    const int koff = r32 * AT_KROW + 16 * hh;
    const int voff = AT_KBUF + (4 * hh + ((lane & 15) >> 2)) * 64 + ((lane >> 4) & 1) * 32 + (lane & 3) * 8;
#define AT_SYNC(t, slot_issue) do { if ((t) + 1 < ntiles) asm volatile("s_waitcnt vmcnt(3)" ::: "memory"); else asm volatile("s_waitcnt vmcnt(0)" ::: "memory"); \
        __builtin_amdgcn_s_barrier(); asm volatile("" ::: "memory"); if ((t) + 2 < ntiles) AT_ISSUE((t) + 2, slot_issue); } while (0)
#define AT_DECIDE(C0, C1) do { \
        asm volatile("s_nop 15\n\ts_nop 7" : "+v"(C0), "+v"(C1)); \
        float rma = max3f(C0[0], C0[1], C1[0]), rmb = max3f(C0[2], C0[3], C1[1]); rma = max3f(rma, C1[2], C1[3]); \
        _Pragma("unroll") for (int r = 4; r < 16; r += 4) { rma = max3f(rma, C0[r], C0[r + 1]); rmb = max3f(rmb, C0[r + 2], C0[r + 3]); rma = max3f(rma, C1[r], C1[r + 1]); rmb = max3f(rmb, C1[r + 2], C1[r + 3]); } \
        float rm = fmaxf(rma, rmb); rm = fmaxf(rm, __shfl_xor(rm, 32)); \
        resc = false; \
        if (__any(rm > 8.f)) { const float dl = fmaxf(rm, 0.f); fres = __builtin_amdgcn_exp2f(-dl); mhat += dl; l *= fres; resc = true; \
            _Pragma("unroll") for (int r = 0; r < 16; ++r) { C0[r] -= dl; C1[r] -= dl; negm[r] = -mhat; } \
            asm volatile("" : "+v"(negm)); } \
    } while (0)
#define AT_MFS(kfrag, s_, C, first) C = __builtin_amdgcn_mfma_f32_32x32x16_bf16(kfrag, qf[s_], (first) ? negm : C, 0, 0, 0)
#define AT_KF(bk_, g) (*(const bf16x8*)((bk_) + koff + ((g) & 1) * 32 * AT_KROW + ((g) >> 1) * 32))
#define AT_STEP(C0, C1, P0, P1, bk, bv) do { \
        bf16x8 kf[12], vfa[4], vfc[4]; u32x4 pw[4]; float sacc = 0.f; \
        kf[0] = AT_KF(bk, 0); kf[1] = AT_KF(bk, 1); kf[2] = AT_KF(bk, 2); kf[3] = AT_KF(bk, 3); \
        AT_SB(); \
        AT_MFS(kf[0], 0, C0, true);  kf[4] = AT_KF(bk, 4);  sacc += (P0[0] + P0[1]) + (P0[2] + P0[3]); pw[0].x = cvtpk(P0[0], P0[1]); pw[0].y = cvtpk(P0[2], P0[3]); AT_PIN(sacc); AT_PIN(pw[0]); AT_SB(); \
        AT_MFS(kf[1], 0, C1, true);  kf[5] = AT_KF(bk, 5);  sacc += (P0[4] + P0[5]) + (P0[6] + P0[7]); pw[0].z = cvtpk(P0[4], P0[5]); pw[0].w = cvtpk(P0[6], P0[7]); AT_PIN(sacc); AT_PIN(pw[0]); AT_SB(); \
        AT_MFS(kf[2], 1, C0, false); kf[6] = AT_KF(bk, 6);  sacc += (P0[8] + P0[9]) + (P0[10] + P0[11]); pw[1].x = cvtpk(P0[8], P0[9]); pw[1].y = cvtpk(P0[10], P0[11]); AT_PIN(sacc); AT_PIN(pw[1]); AT_SB(); \
        AT_MFS(kf[3], 1, C1, false); kf[7] = AT_KF(bk, 7);  sacc += (P0[12] + P0[13]) + (P0[14] + P0[15]); pw[1].z = cvtpk(P0[12], P0[13]); pw[1].w = cvtpk(P0[14], P0[15]); AT_PIN(sacc); AT_PIN(pw[1]); AT_SB(); \
        AT_MFS(kf[4], 2, C0, false); kf[8] = AT_KF(bk, 8);  sacc += (P1[0] + P1[1]) + (P1[2] + P1[3]); pw[2].x = cvtpk(P1[0], P1[1]); pw[2].y = cvtpk(P1[2], P1[3]); AT_PIN(sacc); AT_PIN(pw[2]); AT_SB(); \
        AT_MFS(kf[5], 2, C1, false); kf[9] = AT_KF(bk, 9);  sacc += (P1[4] + P1[5]) + (P1[6] + P1[7]); pw[2].z = cvtpk(P1[4], P1[5]); pw[2].w = cvtpk(P1[6], P1[7]); AT_PIN(sacc); AT_PIN(pw[2]); AT_SB(); \
        AT_MFS(kf[6], 3, C0, false); kf[10] = AT_KF(bk, 10); sacc += (P1[8] + P1[9]) + (P1[10] + P1[11]); pw[3].x = cvtpk(P1[8], P1[9]); pw[3].y = cvtpk(P1[10], P1[11]); AT_PIN(sacc); AT_PIN(pw[3]); AT_SB(); \
        AT_MFS(kf[7], 3, C1, false); kf[11] = AT_KF(bk, 11); sacc += (P1[12] + P1[13]) + (P1[14] + P1[15]); pw[3].z = cvtpk(P1[12], P1[13]); pw[3].w = cvtpk(P1[14], P1[15]); AT_PIN(sacc); AT_PIN(pw[3]); AT_SB(); \
        AT_MFS(kf[8], 4, C0, false); { const unsigned char* vb_ = (bv) + voff; vfa[0] = tr8(vb_, vb_ + 512); vfc[0] = tr8(vb_ + 4096, vb_ + 4608); } AT_SB(); \
        AT_MFS(kf[9], 4, C1, false); { const unsigned char* vb_ = (bv) + voff + 1024; vfa[1] = tr8(vb_, vb_ + 512); vfc[1] = tr8(vb_ + 4096, vb_ + 4608); } AT_SB(); \
        AT_MFS(kf[10], 5, C0, false); { const unsigned char* vb_ = (bv) + voff + 2048; vfa[2] = tr8(vb_, vb_ + 512); vfc[2] = tr8(vb_ + 4096, vb_ + 4608); } AT_SB(); \
        AT_MFS(kf[11], 5, C1, false); { const unsigned char* vb_ = (bv) + voff + 3072; vfa[3] = tr8(vb_, vb_ + 512); vfc[3] = tr8(vb_ + 4096, vb_ + 4608); } AT_SB(); \
        l += sacc; \
        AT_DECIDE(C0, C1); \
        AT_SB(); \
        o0 = __builtin_amdgcn_mfma_f32_32x32x16_bf16(vfa[0], __builtin_bit_cast(bf16x8, pw[0]), o0, 0, 0, 0); C0[0] = __builtin_amdgcn_exp2f(C0[0]); C0[1] = __builtin_amdgcn_exp2f(C0[1]); C0[2] = __builtin_amdgcn_exp2f(C0[2]); C0[3] = __builtin_amdgcn_exp2f(C0[3]); AT_PIN(C0); AT_SB(); \
        o1 = __builtin_amdgcn_mfma_f32_32x32x16_bf16(vfc[0], __builtin_bit_cast(bf16x8, pw[0]), o1, 0, 0, 0); C0[4] = __builtin_amdgcn_exp2f(C0[4]); C0[5] = __builtin_amdgcn_exp2f(C0[5]); C0[6] = __builtin_amdgcn_exp2f(C0[6]); C0[7] = __builtin_amdgcn_exp2f(C0[7]); AT_PIN(C0); AT_SB(); \
        o0 = __builtin_amdgcn_mfma_f32_32x32x16_bf16(vfa[1], __builtin_bit_cast(bf16x8, pw[1]), o0, 0, 0, 0); C0[8] = __builtin_amdgcn_exp2f(C0[8]); C0[9] = __builtin_amdgcn_exp2f(C0[9]); C0[10] = __builtin_amdgcn_exp2f(C0[10]); C0[11] = __builtin_amdgcn_exp2f(C0[11]); AT_PIN(C0); AT_SB(); \
        o1 = __builtin_amdgcn_mfma_f32_32x32x16_bf16(vfc[1], __builtin_bit_cast(bf16x8, pw[1]), o1, 0, 0, 0); C0[12] = __builtin_amdgcn_exp2f(C0[12]); C0[13] = __builtin_amdgcn_exp2f(C0[13]); C0[14] = __builtin_amdgcn_exp2f(C0[14]); C0[15] = __builtin_amdgcn_exp2f(C0[15]); AT_PIN(C0); AT_SB(); \
        o0 = __builtin_amdgcn_mfma_f32_32x32x16_bf16(vfa[2], __builtin_bit_cast(bf16x8, pw[2]), o0, 0, 0, 0); C1[0] = __builtin_amdgcn_exp2f(C1[0]); C1[1] = __builtin_amdgcn_exp2f(C1[1]); C1[2] = __builtin_amdgcn_exp2f(C1[2]); C1[3] = __builtin_amdgcn_exp2f(C1[3]); AT_PIN(C1); AT_SB(); \
        o1 = __builtin_amdgcn_mfma_f32_32x32x16_bf16(vfc[2], __builtin_bit_cast(bf16x8, pw[2]), o1, 0, 0, 0); C1[4] = __builtin_amdgcn_exp2f(C1[4]); C1[5] = __builtin_amdgcn_exp2f(C1[5]); C1[6] = __builtin_amdgcn_exp2f(C1[6]); C1[7] = __builtin_amdgcn_exp2f(C1[7]); AT_PIN(C1); AT_SB(); \
        o0 = __builtin_amdgcn_mfma_f32_32x32x16_bf16(vfa[3], __builtin_bit_cast(bf16x8, pw[3]), o0, 0, 0, 0); C1[8] = __builtin_amdgcn_exp2f(C1[8]); C1[9] = __builtin_amdgcn_exp2f(C1[9]); C1[10] = __builtin_amdgcn_exp2f(C1[10]); C1[11] = __builtin_amdgcn_exp2f(C1[11]); AT_PIN(C1); AT_SB(); \
        o1 = __builtin_amdgcn_mfma_f32_32x32x16_bf16(vfc[3], __builtin_bit_cast(bf16x8, pw[3]), o1, 0, 0, 0); C1[12] = __builtin_amdgcn_exp2f(C1[12]); C1[13] = __builtin_amdgcn_exp2f(C1[13]); C1[14] = __builtin_amdgcn_exp2f(C1[14]); C1[15] = __builtin_amdgcn_exp2f(C1[15]); AT_PIN(C1); AT_SB(); \
        if (resc) { _Pragma("unroll") for (int r = 0; r < 16; ++r) { o0[r] *= fres; o1[r] *= fres; } } \
    } while (0)
    f32x16 pA0, pA1, pB0, pB1; bool resc = false; float fres = 1.f;
    int s_prev = 0, s_cur = 0, s_iss = 2 * AT_BUF;
    AT_SYNC(0, s_iss); s_iss = AT_NEXT(s_iss);
    {
        const unsigned char* bk = lds + s_cur;
#pragma unroll
        for (int s_ = 0; s_ < 6; ++s_) {
            const bf16x8 k0f = *(const bf16x8*)(bk + koff + 32 * s_), k1f = *(const bf16x8*)(bk + koff + 32 * AT_KROW + 32 * s_);
            pA0 = __builtin_amdgcn_mfma_f32_32x32x16_bf16(k0f, qf[s_], s_ == 0 ? negm : pA0, 0, 0, 0);
            pA1 = __builtin_amdgcn_mfma_f32_32x32x16_bf16(k1f, qf[s_], s_ == 0 ? negm : pA1, 0, 0, 0);
        }
        AT_DECIDE(pA0, pA1);
#pragma unroll
        for (int r = 0; r < 16; ++r) { pA0[r] = __builtin_amdgcn_exp2f(pA0[r]); pA1[r] = __builtin_amdgcn_exp2f(pA1[r]); }
    }
    int t = 1;
#pragma unroll 1
    for (; t + 1 < ntiles; t += 2) {
        s_prev = s_cur; s_cur = AT_NEXT(s_cur); AT_SYNC(t, s_iss); s_iss = AT_NEXT(s_iss);
        AT_STEP(pB0, pB1, pA0, pA1, lds + s_cur, lds + s_prev);
        s_prev = s_cur; s_cur = AT_NEXT(s_cur); AT_SYNC(t + 1, s_iss); s_iss = AT_NEXT(s_iss);
        AT_STEP(pA0, pA1, pB0, pB1, lds + s_cur, lds + s_prev);
    }
    {
        s_prev = s_cur; s_cur = AT_NEXT(s_cur); AT_SYNC(t, s_iss); s_iss = AT_NEXT(s_iss);
        AT_STEP(pB0, pB1, pA0, pA1, lds + s_cur, lds + s_prev);
    }
    {
        float sacc = 0.f;
#pragma unroll
        for (int r = 0; r < 16; ++r) sacc += pB0[r] + pB1[r];
        l += sacc;
        u32x4 pw[4];
#pragma unroll
        for (int s2 = 0; s2 < 2; ++s2) {
            pw[s2] = (u32x4){cvtpk(pB0[8 * s2], pB0[8 * s2 + 1]), cvtpk(pB0[8 * s2 + 2], pB0[8 * s2 + 3]), cvtpk(pB0[8 * s2 + 4], pB0[8 * s2 + 5]), cvtpk(pB0[8 * s2 + 6], pB0[8 * s2 + 7])};
            pw[2 + s2] = (u32x4){cvtpk(pB1[8 * s2], pB1[8 * s2 + 1]), cvtpk(pB1[8 * s2 + 2], pB1[8 * s2 + 3]), cvtpk(pB1[8 * s2 + 4], pB1[8 * s2 + 5]), cvtpk(pB1[8 * s2 + 6], pB1[8 * s2 + 7])};
        }
        const unsigned char* bv = lds + s_cur;
#pragma unroll
        for (int ks = 0; ks < 4; ++ks) {
            const unsigned char* vb = bv + voff + ks * 16 * 64; const bf16x8 pf = __builtin_bit_cast(bf16x8, pw[ks]);
            o0 = __builtin_amdgcn_mfma_f32_32x32x16_bf16(tr8(vb, vb + 8 * 64), pf, o0, 0, 0, 0);
            o1 = __builtin_amdgcn_mfma_f32_32x32x16_bf16(tr8(vb + 4096, vb + 4096 + 8 * 64), pf, o1, 0, 0, 0);
        }
    }
#undef AT_GLDS
#undef AT_ISSUE
#undef AT_SB
#undef AT_PIN
#undef AT_NEXT
#undef AT_SYNC
#undef AT_DECIDE
#undef AT_MFS
#undef AT_KF
#undef AT_STEP
    l += __shfl_xor(l, 32);
    const float rl = 1.f / l;
    bf16_t* orow = (bf16_t*)(p.ws + WS_CC) + (size_t)qrow * D + 512 + h * 64 + 4 * hh;
#pragma unroll
    for (int r4 = 0; r4 < 4; ++r4) {
        u32x2 w0; w0.x = cvtpk(o0[4 * r4] * rl, o0[4 * r4 + 1] * rl); w0.y = cvtpk(o0[4 * r4 + 2] * rl, o0[4 * r4 + 3] * rl);
        u32x2 w1; w1.x = cvtpk(o1[4 * r4] * rl, o1[4 * r4 + 1] * rl); w1.y = cvtpk(o1[4 * r4 + 2] * rl, o1[4 * r4 + 3] * rl);
        *(u32x2*)(orow + 8 * r4) = w0; *(u32x2*)(orow + 32 + 8 * r4) = w1;
    }
}
__device__ __forceinline__ void retout_unit(unsigned char* lds, const P& p, int L, int gc, int h) {
    float* qs = (float*)lds; float* ks = qs + 128 * 33; float* vs = ks + 128 * 33; float* Sf = vs + 128 * 64; float* Sb = Sf + 2048;
    const int tid = threadIdx.x;
    const float l2f = log2_gamma(p, L, 0, h), l2b = log2_gamma(p, L, 1, h);
    load_ret_qk(qs, p, gc, h, Z_RQ, 1.f);
    load_ret_qk(ks, p, gc, h, Z_RK, 0.17677669529663687f);
    load_ret_v(vs, p, gc, h);
    {
        const bool lat = gc < 256; const int b = lat ? gc >> 4 : (gc - 256) >> 1;
        const int mme = lat ? 2 + (gc & 15) : (gc - 256) & 1;
        const int u = mme, w = mme < 2 ? 1 - mme : 19 - mme;
        f32x4 sf = (f32x4){0.f, 0.f, 0.f, 0.f}, sb = sf;
        const float* KVb = (const float*)(p.ws + WS_KV);
#pragma unroll 1
        for (int mm = 0; mm < 18; ++mm) {
            const int gcm = mm < 2 ? 256 + b * 2 + mm : b * 16 + (mm - 2);
            const int um = mm, wm = mm < 2 ? 1 - mm : 19 - mm;
            const float* kv = KVb + ((size_t)(gcm * 4 + h) * 2) * 2048 + tid * 4;
            if (um < u) { const float wgt = exp2f(l2f * 128.f * (float)(u - 1 - um)); sf += wgt * *(const f32x4*)kv; }
            if (wm < w) { const float wgt = exp2f(l2b * 128.f * (float)(w - 1 - wm)); sb += wgt * *(const f32x4*)(kv + 2048); }
        }
        *(f32x4*)(Sf + tid * 4) = sf; *(f32x4*)(Sb + tid * 4) = sb;
    }
    __syncthreads();
    const int i = tid >> 2, e0 = (tid & 3) * 16;
    float q[32];
#pragma unroll
    for (int d = 0; d < 32; ++d) q[d] = qs[i * 33 + d];
    float acc[16];
#pragma unroll
    for (int e = 0; e < 16; ++e) acc[e] = 0.f;
#pragma unroll 1
    for (int j = 0; j < 128; ++j) {
        float s = 0.f;
#pragma unroll
        for (int d = 0; d < 32; ++d) s += q[d] * ks[j * 33 + d];
        float wgt = 0.f;
        if (j <= i) wgt += exp2f(l2f * (float)(i - j));
        if (j >= i) wgt += exp2f(l2b * (float)(j - i));
        s *= wgt;
#pragma unroll
        for (int e4 = 0; e4 < 4; ++e4) { const f32x4 v4 = *(const f32x4*)(vs + j * 64 + e0 + 4 * e4); acc[4 * e4] += s * v4.x; acc[4 * e4 + 1] += s * v4.y; acc[4 * e4 + 2] += s * v4.z; acc[4 * e4 + 3] += s * v4.w; }
    }
    {
        const float cf = exp2f(l2f * (float)(i + 1)), cb = exp2f(l2b * (float)(128 - i));
#pragma unroll 2
        for (int d = 0; d < 32; ++d) {
            const float qd = qs[i * 33 + d]; const float qf = qd * cf, qb = qd * cb;
#pragma unroll
            for (int e4 = 0; e4 < 4; ++e4) { const f32x4 a = *(const f32x4*)(Sf + d * 64 + e0 + 4 * e4), bq = *(const f32x4*)(Sb + d * 64 + e0 + 4 * e4);
                acc[4 * e4] += qf * a.x + qb * bq.x; acc[4 * e4 + 1] += qf * a.y + qb * bq.y; acc[4 * e4 + 2] += qf * a.z + qb * bq.z; acc[4 * e4 + 3] += qf * a.w + qb * bq.w; }
        }
    }
    float s1 = 0.f;
#pragma unroll
    for (int e = 0; e < 16; ++e) s1 += acc[e];
    s1 += __shfl_xor(s1, 1); s1 += __shfl_xor(s1, 2);
    const float mu = s1 * (1.f / 64.f);
    float s2 = 0.f;
#pragma unroll
    for (int e = 0; e < 16; ++e) { const float dd = acc[e] - mu; s2 += dd * dd; }
    s2 += __shfl_xor(s2, 1); s2 += __shfl_xor(s2, 2);
    const float rstd = rsqrtf(s2 * (1.f / 64.f) + NORM_EPS);
    const int row = gc * 128 + i;
    const bf16_t* zg = (const bf16_t*)(p.ws + WS_Z) + (size_t)row * ZC + Z_RG + h * 64 + e0;
    const float* gw = p.in[13] + L * 256 + h * 64 + e0;
    const u32x4 g0 = *(const u32x4*)zg, g1 = *(const u32x4*)(zg + 8);
    float g[16];
#pragma unroll
    for (int k = 0; k < 4; ++k) { g[2 * k] = lo16(g0[k]); g[2 * k + 1] = hi16(g0[k]); g[8 + 2 * k] = lo16(g1[k]); g[8 + 2 * k + 1] = hi16(g1[k]); }
    unsigned o[8];
#pragma unroll
    for (int k = 0; k < 8; ++k) {
        const float y0 = siluf(g[2 * k]) * ((acc[2 * k] - mu) * rstd * gw[2 * k]), y1 = siluf(g[2 * k + 1]) * ((acc[2 * k + 1] - mu) * rstd * gw[2 * k + 1]);
        o[k] = pk2(y0, y1);
    }
    u32x4* op = (u32x4*)((bf16_t*)(p.ws + WS_CC) + (size_t)row * D + 256 + h * 64 + e0);
    u32x4 w0; w0.x = o[0]; w0.y = o[1]; w0.z = o[2]; w0.w = o[3]; u32x4 w1; w1.x = o[4]; w1.y = o[5]; w1.z = o[6]; w1.w = o[7];
    op[0] = w0; op[1] = w1;
    __syncthreads();
}
__device__ __forceinline__ void phase_c(unsigned char* lds, const P& p, int L) {
    const int G = gridDim.x, bid = blockIdx.x;
    const int nat = 16 * 8 * 8, nac = (L == 0) ? 128 : 0, nro = (L == 0 ? 288 : 256) * 4;
    const int total = nat + nac + nro;
    const int vcu = (G % 8 == 0) ? (bid % 8) * (G / 8) + bid / 8 : bid;
    for (int u = vcu; u < total; u += G) {
        int r = u;
#ifndef TEST_C
#define TEST_C 3
#endif
        if (r < nat) { if (TEST_C & 1) attn_unit_mfma(lds, p, r >> 6, (r >> 3) & 7, r & 7, false); continue; } r -= nat;
        if (r < nac) { if (TEST_C & 1) attn_unit_mfma(lds, p, r >> 3, r & 7, 0, true); continue; } r -= nac;
        if (TEST_C & 2) retout_unit_mfma(lds, p, L, r >> 2, r & 3);
    }
    if (L == 0) convert_expert_weights(lds, p, 0);
}

struct EpiY {
    bf16_t* Y; const float* g1;
    __device__ __forceinline__ void operator()(const ge::Acc& acc, const ge::Unit& u, int wr, int wc, int fr, int fq) const {
        const float* gr = g1 + (size_t)mod_row(u.a * 256) * 6144 + u.b * 256 + wc * 32 + 8 * fq;
        f32x4 g[2][2];
#pragma unroll
        for (int bj = 0; bj < 2; ++bj)
#pragma unroll
            for (int n = 0; n < 2; ++n) g[bj][n] = *(const f32x4*)(gr + bj * 128 + n * 4);
#pragma unroll
        for (int ai = 0; ai < 2; ++ai)
#pragma unroll
            for (int m = 0; m < 4; ++m) {
                bf16_t* yr = Y + (size_t)(u.a * 256 + ai * 128 + wr * 64 + m * 16 + fr) * D + u.b * 256 + wc * 32 + 8 * fq;
#pragma unroll
                for (int bj = 0; bj < 2; ++bj) { const f32x4 v0 = acc[ai][bj][m][0] * g[bj][0], v1 = acc[ai][bj][m][1] * g[bj][1];
                    u32x4 w; w.x = cvtpk(v0.x, v0.y); w.y = cvtpk(v0.z, v0.w); w.z = cvtpk(v1.x, v1.y); w.w = cvtpk(v1.z, v1.w); *(u32x4*)(yr + bj * 128) = w; }
            }
    }
};
__device__ __forceinline__ void phase_d(unsigned char* lds, const P& p, int L) {
    ge::DenseOrder S; S.nM = (L == 0 ? NTOK : NLAT) / 256; S.nN = 4; S.nwg = S.nM * 4; S.G = gridDim.x; S.c = blockIdx.x;
    S.Bt = (const char*)((const bf16_t*)(p.ws + WS_WOUT) + (size_t)L * D * D); S.btile = (size_t)256 * D * 2; S.arow = D * 2;
    EpiY E{(bf16_t*)(p.ws + WS_Y), (const float*)(p.ws + WS_MODV) + (size_t)L * 17 * 6144 + 2048};
    ge::gemm_stream<ge::DenseOrder, EpiY, true>((LAS unsigned char*)lds, (const char*)(p.ws + WS_CC), D, S, E);
}

__device__ __forceinline__ void norm_mod_store(const P& p, int L, int which, int tok, int lane, const f32x4 (&v)[4], bf16_t* Hdst) {
    const float* nw = (which == 0 ? p.in[6] : p.in[19]) + L * D;
    const float* mrow = (const float*)(p.ws + WS_MODV) + ((size_t)L * 17 + mod_row(tok)) * 6144 + which * 3072;
    float s = 0.f;
#pragma unroll
    for (int j = 0; j < 4; ++j) s += v[j].x * v[j].x + v[j].y * v[j].y + v[j].z * v[j].z + v[j].w * v[j].w;
    const float rstd = rsqrtf(wave_sum(s) * (1.f / D) + NORM_EPS);
    u32x2* o = (u32x2*)(Hdst + (size_t)tok * D) + lane;
#pragma unroll
    for (int j = 0; j < 4; ++j) {
        const int k = 4 * lane + 256 * j;
        const f32x4 w4 = *(const f32x4*)(nw + k), sh = *(const f32x4*)(mrow + k), sc = *(const f32x4*)(mrow + 1024 + k);
        const f32x4 y = v[j] * rstd * w4 * (sc + 1.f) + sh;
        u32x2 w; w.x = cvtpk(y.x, y.y); w.y = cvtpk(y.z, y.w); o[64 * j] = w;
    }
}
__device__ __forceinline__ int half_n(int L) { return L == 0 ? NTOK / 2 : NLAT / 2; }
__device__ __forceinline__ void phase_router(unsigned char* lds, const P& p, int L) {
    constexpr int O_LG = 41472, O_CNT = 83072, O_SEL = 83584, O_SELW = 87424;
    const bf16_t* H = (const bf16_t*)(p.ws + WS_H); const bf16_t* W = (const bf16_t*)(p.ws + WS_RT) + (size_t)L * 128 * D;
    const bf16_t* Y = (const bf16_t*)(p.ws + WS_Y);
    float* lg = (float*)(lds + O_LG);
    int* lcnt = (int*)(lds + O_CNT);
    int* sel = (int*)(lds + O_SEL);
    float* selw = (float*)(lds + O_SELW);
    int* ltok = (int*)(p.ws + WS_LTOK); float* lw = (float*)(p.ws + WS_LW);
    const int tid = threadIdx.x, lane = tid & 63, wave = tid >> 6;
    const int ntok = (L == 0 ? NTOK : NLAT), TS = (L == 0 ? 144 : 128), nmt = ntok / TS, RW = TS / 8;
    for (int mt = blockIdx.x; mt < nmt; mt += gridDim.x) {
        const int t0 = mt * TS;
        if (tid < 64) lcnt[tid] = 0;
#pragma unroll 3
        for (int q = 0; q < RW; ++q) {
            const int tok = t0 + wave * RW + q;
            const u32x2* yr = (const u32x2*)(Y + (size_t)tok * D) + lane;
            u32x2* xo = (u32x2*)x_row(p, tok) + lane;
            f32x4 v[4];
            if (L == 0) {
                const f32x4* xi = (const f32x4*)x_in_row(p, tok) + lane;
#pragma unroll
                for (int j = 0; j < 4; ++j) { const f32x4 a = xi[64 * j]; const u32x2 y = yr[64 * j]; v[j] = (f32x4){a.x + lo16(y.x), a.y + hi16(y.x), a.z + lo16(y.y), a.w + hi16(y.y)}; }
            } else {
#pragma unroll
                for (int j = 0; j < 4; ++j) { const u32x2 a = xo[64 * j]; const u32x2 y = yr[64 * j]; v[j] = (f32x4){lo16(a.x) + lo16(y.x), hi16(a.x) + hi16(y.x), lo16(a.y) + lo16(y.y), hi16(a.y) + hi16(y.y)}; }
            }
#pragma unroll
            for (int j = 0; j < 4; ++j) { u32x2 w; w.x = cvtpk(v[j].x, v[j].y); w.y = cvtpk(v[j].z, v[j].w); xo[64 * j] = w; }
            norm_mod_store(p, L, 1, tok, lane, v, (bf16_t*)(p.ws + WS_H));
        }
        asm volatile("s_waitcnt vmcnt(0)" ::: "memory");
        __syncthreads();
        auto rs = [&](int pr) { return H + (size_t)(t0 + (pr < TS ? pr : TS - 1)) * D; };
        auto epi = [&](int r, int c, f32x4 v) { if (c < 64) { float* d = lg + r * 65 + c; d[0] = v.x; d[1] = v.y; d[2] = v.z; d[3] = v.w; } };
        gemm_tile<5>(lds, rs, W, D, D, epi);
        __syncthreads();
        if (tid < TS) {
            const float* rbp = p.in[21] + L * NEXP; const float* lrow = lg + tid * 65;
            float bv[6], bs[6]; int bi[6];
#pragma unroll
            for (int k = 0; k < 6; ++k) { bv[k] = -INFINITY; bs[k] = 0.f; bi[k] = 0; }
#pragma unroll 4
            for (int e = 0; e < NEXP; ++e) {
                float sc = __builtin_amdgcn_rcpf(1.f + __expf(-lrow[e])); float sv = sc + rbp[e]; int ei = e;
#pragma unroll
                for (int k = 0; k < 6; ++k) { const bool gt = sv > bv[k]; const float tv = gt ? bv[k] : sv, ts = gt ? bs[k] : sc; const int ti = gt ? bi[k] : ei;
                    bv[k] = gt ? sv : bv[k]; bs[k] = gt ? sc : bs[k]; bi[k] = gt ? ei : bi[k]; sv = tv; sc = ts; ei = ti; }
            }
            const float rs6 = 2.5f / (bs[0] + bs[1] + bs[2] + bs[3] + bs[4] + bs[5]);
#pragma unroll
            for (int k = 0; k < 6; ++k) { const int rank = atomicAdd(&lcnt[bi[k]], 1); sel[tid * 6 + k] = (bi[k] << 8) | rank; selw[tid * 6 + k] = bs[k] * rs6; }
        }
        __syncthreads();
        if (tid < 64) {
            unsigned* ecnt = (unsigned*)(p.ws + WS_CTL) + CW_ECNT + L * 4096;
            const int c = lcnt[tid];
            lcnt[64 + tid] = c ? (int)atomicAdd(ecnt + tid * 64, (unsigned)c) : 0;
        }
        __syncthreads();
        for (int i = tid; i < TS * 6; i += NTHREADS) {
            const int sv = sel[i], e = sv >> 8, pos = lcnt[64 + e] + (sv & 255), tok = t0 + i / 6, k = i % 6;
            ltok[(size_t)e * LCAP + pos] = tok * 8 + k;
            lw[(size_t)e * LCAP + pos] = selw[i];
        }
        __syncthreads();
    }
}

__device__ __forceinline__ void build_etab(unsigned char* lds, const P& p, int L) {
    int* tstart = (int*)(lds + ETAB_OFF); int* cnt = tstart + 80;
    __syncthreads();
    if (threadIdx.x < 64) { const unsigned* ecnt = (const unsigned*)(p.ws + WS_CTL) + CW_ECNT + L * 4096;
        cnt[threadIdx.x] = (int)__hip_atomic_load(ecnt + threadIdx.x * 64, __ATOMIC_RELAXED, __HIP_MEMORY_SCOPE_AGENT); }
    __syncthreads();
    if (threadIdx.x < 64) {
        const int e = threadIdx.x, tl = (cnt[e] + 255) >> 8; int inc = tl;
#pragma unroll
        for (int o = 1; o < 64; o <<= 1) { const int v = __shfl_up(inc, o); if (e >= o) inc += v; }
        tstart[e] = inc - tl;
        if (e == 63) { tstart[64] = inc; tstart[65] = inc + (L == 0 ? NTOK : NLAT) / 256; }
    }
    __syncthreads();
}
struct MoeOrder {
    int TT, nN, G, c; const int* tstart; const char* Bexp; size_t bexp; const char* Bsh; size_t btile; const int* rowbuf; unsigned arow; bool ident;
    __device__ __forceinline__ bool next(int i, ge::Unit& u) const {
        const int Lq = i * G + c; if (Lq >= TT * nN) return false;
        const int t = Lq / nN, pn = Lq % nN;
        int lo = 0, hi = 64;
        while (lo < hi) { const int mid = (lo + hi + 1) >> 1; if (tstart[mid] <= t) lo = mid; else hi = mid - 1; }
        const int e = __builtin_amdgcn_readfirstlane(lo);
        u.a = t; u.b = pn; u.c = e; u.d = i;
        u.B = (e < 64 ? Bexp + (size_t)e * bexp : Bsh) + (size_t)pn * btile;
        return true;
    }
    __device__ __forceinline__ unsigned aoff(int i, const ge::Unit& u, int R) const { return (unsigned)(ident ? u.a * 256 + R : rowbuf[i * 256 + R]) * arow; }
};
__device__ __forceinline__ void phase_gateup(unsigned char* lds, const P& p, int L) {
    build_etab(lds, p, L);
    const int* tstart = (const int*)(lds + ETAB_OFF); const int* cnt = tstart + 80;
    int* rowbuf = (int*)(lds + RB0_OFF); float* wbuf = (float*)(lds + RB1_OFF);
    const int* ltok = (const int*)(p.ws + WS_LTOK); const float* lw = (const float*)(p.ws + WS_LW);
    bf16_t* ACT = (bf16_t*)(p.ws + WS_ACT);
    const int G = gridDim.x, bid = blockIdx.x, vcu = (G % 8 == 0) ? (bid % 8) * (G / 8) + bid / 8 : bid;
    MoeOrder S; S.TT = tstart[65]; S.nN = 2; S.G = G; S.c = vcu; S.tstart = tstart; S.Bexp = (const char*)(p.ws + WS_EGU); S.bexp = (size_t)512 * D * 2;
    S.Bsh = (const char*)((const bf16_t*)(p.ws + WS_SHGU) + (size_t)L * 512 * D); S.btile = (size_t)256 * D * 2; S.rowbuf = rowbuf; S.arow = D * 2; S.ident = false;
    {
        int nun = 0; { ge::Unit u; while (nun < 10 && S.next(nun, u)) ++nun; }
        for (int it0 = threadIdx.x; it0 < nun * 256; it0 += NTHREADS * 4) {
            int tokv[4]; float wv4[4];
#pragma unroll
            for (int q = 0; q < 4; ++q) {
                const int item = it0 + q * NTHREADS; tokv[q] = 0; wv4[q] = 0.f;
                if (item < nun * 256) {
                    ge::Unit u; S.next(item >> 8, u);
                    const int R = item & 255, e = u.c, mt = u.a - tstart[e];
                    if (e < 64) { const int lp = mt * 256 + R; if (lp < cnt[e]) { tokv[q] = ltok[(size_t)e * LCAP + lp] >> 3; wv4[q] = lw[(size_t)e * LCAP + lp]; } }
                    else { tokv[q] = mt * 256 + R; wv4[q] = 1.f; }
                }
            }
#pragma unroll
            for (int q = 0; q < 4; ++q) { const int item = it0 + q * NTHREADS; if (item < nun * 256) { rowbuf[item] = tokv[q]; wbuf[item] = wv4[q]; } }
        }
        __syncthreads();
    }
    auto f = [&](const ge::Unit& u, int r, int c, f32x4 v0, f32x4 v1) {
        const float w = wbuf[u.d * 256 + r];
        u32x2 o; o.x = cvtpk(siluf(v0.x) * v0.y * w, siluf(v0.z) * v0.w * w); o.y = cvtpk(siluf(v1.x) * v1.y * w, siluf(v1.z) * v1.w * w);
        *(u32x2*)(ACT + (size_t)(u.a * 256 + r) * EDIM + ((u.b * 256 + c) >> 1)) = o;
    };
    ge::EpiFn<decltype(f)> E{f};
    ge::gemm_stream<MoeOrder, ge::EpiFn<decltype(f)>, true>((LAS unsigned char*)lds, (const char*)(p.ws + WS_H), D, S, E);
}
__device__ __forceinline__ void phase_down(unsigned char* lds, const P& p, int L) {
    build_etab(lds, p, L);
    const int* tstart = (const int*)(lds + ETAB_OFF); const int* cnt = tstart + 80;
    int* sbuf = (int*)(lds + RB0_OFF);
    const int* ltok = (const int*)(p.ws + WS_LTOK);
    unsigned char* SLOT = (unsigned char*)(p.ws + WS_SLOT);
    const int G = gridDim.x, bid = blockIdx.x, vcu = (G % 8 == 0) ? (bid % 8) * (G / 8) + bid / 8 : bid;
    MoeOrder S; S.TT = tstart[65]; S.nN = 4; S.G = G; S.c = vcu; S.tstart = tstart; S.Bexp = (const char*)(p.ws + WS_ED); S.bexp = (size_t)D * EDIM * 2;
    S.Bsh = (const char*)((const bf16_t*)(p.ws + WS_SHD) + (size_t)L * D * EDIM); S.btile = (size_t)256 * EDIM * 2; S.rowbuf = sbuf; S.arow = EDIM * 2; S.ident = true;
    {
        int nun = 0; { ge::Unit u; while (nun < 18 && S.next(nun, u)) ++nun; }
        for (int it0 = threadIdx.x; it0 < nun * 256; it0 += NTHREADS * 4) {
            int sv[4];
#pragma unroll
            for (int q = 0; q < 4; ++q) {
                const int item = it0 + q * NTHREADS; sv[q] = NTOK * 7;
                if (item < nun * 256) {
                    ge::Unit u; S.next(item >> 8, u);
                    const int R = item & 255, e = u.c, mt = u.a - tstart[e];
                    if (e < 64) { const int lp = mt * 256 + R; if (lp < cnt[e]) { const int ent = ltok[(size_t)e * LCAP + lp]; sv[q] = (ent >> 3) * 7 + (ent & 7); } }
                    else sv[q] = (mt * 256 + R) * 7 + 6;
                }
            }
#pragma unroll
            for (int q = 0; q < 4; ++q) { const int item = it0 + q * NTHREADS; if (item < nun * 256) sbuf[item] = sv[q]; }
        }
        __syncthreads();
    }
    auto f = [&](const ge::Unit& u, int r, int c, f32x4 v0, f32x4 v1) {
        const int srow = sbuf[u.d * 256 + r];
        int w0 = 0, w1 = 0;
        w0 = __builtin_amdgcn_cvt_pk_fp8_f32(__builtin_amdgcn_fmed3f(v0.x, -440.f, 440.f), __builtin_amdgcn_fmed3f(v0.y, -440.f, 440.f), w0, false);
        w0 = __builtin_amdgcn_cvt_pk_fp8_f32(__builtin_amdgcn_fmed3f(v0.z, -440.f, 440.f), __builtin_amdgcn_fmed3f(v0.w, -440.f, 440.f), w0, true);
        w1 = __builtin_amdgcn_cvt_pk_fp8_f32(__builtin_amdgcn_fmed3f(v1.x, -440.f, 440.f), __builtin_amdgcn_fmed3f(v1.y, -440.f, 440.f), w1, false);
        w1 = __builtin_amdgcn_cvt_pk_fp8_f32(__builtin_amdgcn_fmed3f(v1.z, -440.f, 440.f), __builtin_amdgcn_fmed3f(v1.w, -440.f, 440.f), w1, true);
        u32x2 w; w.x = (unsigned)w0; w.y = (unsigned)w1; *(u32x2*)(SLOT + (size_t)srow * D + u.b * 256 + c) = w;
    };
    ge::EpiFn<decltype(f)> E{f};
    ge::gemm_stream<MoeOrder, ge::EpiFn<decltype(f)>, true>((LAS unsigned char*)lds, (const char*)(p.ws + WS_ACT), EDIM, S, E);
}
__device__ __forceinline__ void phase_combine(const P& p, int L) {
    const int tid = threadIdx.x, lane = tid & 63, wave = tid >> 6, gw = blockIdx.x * NWAVES + wave, NGW = gridDim.x * NWAVES;
    const unsigned char* SLOT = (const unsigned char*)(p.ws + WS_SLOT);
    const float* modv = (const float*)(p.ws + WS_MODV) + (size_t)L * 17 * 6144;
    const int ntok = (L == 0 ? NTOK : NLAT);
    for (int tok = gw; tok < ntok; tok += NGW) {
        f32x4 acc[4];
#pragma unroll
        for (int j = 0; j < 4; ++j) acc[j] = (f32x4){0.f, 0.f, 0.f, 0.f};
#pragma unroll
        for (int k = 0; k < 7; ++k) {
            const int* sr = (const int*)(SLOT + ((size_t)tok * 7 + k) * D) + lane;
#pragma unroll
            for (int j = 0; j < 4; ++j) { const int w = sr[64 * j]; const f32x2_t a = __builtin_amdgcn_cvt_pk_f32_fp8(w, false), b = __builtin_amdgcn_cvt_pk_f32_fp8(w, true); acc[j].x += a.x; acc[j].y += a.y; acc[j].z += b.x; acc[j].w += b.y; }
        }
        const float* g2 = modv + (size_t)mod_row(tok) * 6144 + 5120;
        u32x2* xr = (u32x2*)x_row(p, tok) + lane;
        f32x4 v[4];
#pragma unroll
        for (int j = 0; j < 4; ++j) { const f32x4 g = *(const f32x4*)(g2 + 4 * lane + 256 * j); const u32x2 a = xr[64 * j];
            v[j] = (f32x4){lo16(a.x), hi16(a.x), lo16(a.y), hi16(a.y)} + g * acc[j]; }
        if (L == 0) {
#pragma unroll
            for (int j = 0; j < 4; ++j) { u32x2 w; w.x = cvtpk(v[j].x, v[j].y); w.y = cvtpk(v[j].z, v[j].w); xr[64 * j] = w; }
            norm_mod_store(p, 1, 0, tok, lane, v, (bf16_t*)(p.ws + WS_H1));
        } else {
            const float* nw = p.in[28]; float s = 0.f;
#pragma unroll
            for (int j = 0; j < 4; ++j) s += v[j].x * v[j].x + v[j].y * v[j].y + v[j].z * v[j].z + v[j].w * v[j].w;
            const float rstd = rsqrtf(wave_sum(s) * (1.f / D) + NORM_EPS);
            f32x4* orow = (f32x4*)(p.out + (size_t)tok * D) + lane;
#pragma unroll
            for (int j = 0; j < 4; ++j) { const f32x4 w4 = *(const f32x4*)(nw + 4 * lane + 256 * j); orow[64 * j] = v[j] * rstd * w4; }
        }
    }
}

constexpr int PH_LAYER0 = 2, PH_PER_LAYER = 8, PH_LAYER1 = PH_LAYER0 + PH_PER_LAYER, NPHASES = PH_LAYER1 + PH_PER_LAYER;

__global__ void __launch_bounds__(NTHREADS, 2) mk_fwd(P p) {
    extern __shared__ __attribute__((aligned(16))) unsigned char lds[];
    volatile LAS unsigned* MISC = (volatile LAS unsigned*)((LAS unsigned char*)lds + MISC_OFF);
    if (threadIdx.x < 64) MISC[threadIdx.x] = 0u;
    __syncthreads();
    unsigned* ctl = (unsigned*)(p.ws + WS_CTL);
    XcdBarrier bar; bar.bar = ctl + CW_BAR; bar.x = 0; bar.st = MISC + 8;
    if (!MK_PER_PHASE) bar = xcd_barrier_post(ctl + CW_BAR, MISC + 8);
    const int lo = p.ph_lo, hi = p.ph_hi;
#ifndef PH_MASK
#define PH_MASK 0xffffu
#endif
#define HAS(b) ((PH_MASK >> (b)) & 1u)
#define IN(k) (lo <= (k) && (k) < hi)
#define SEAM(k) do { if (IN(k) && IN((k) + 1)) xcd_barrier(bar); } while (0)

#ifdef PROBE_MASK
    unsigned long long tacc = 0ull, t0p = 0ull;
#define PT0() t0p = __builtin_amdgcn_s_memrealtime()
#define PT1(b) do { if ((PROBE_MASK >> (b)) & 1u) tacc += __builtin_amdgcn_s_memrealtime() - t0p; } while (0)
#else
#define PT0() do {} while (0)
#define PT1(b) do {} while (0)
#endif
#define PH(b, k, body) do { PT0(); if (HAS(b) && IN(k)) { body; } SEAM(k); PT1(b); } while (0)
    PH(0, 0, phase_prep0(lds, p));
    PH(1, 1, (phase_prep1(lds, p), phase_norm_mod(p, 0, 0, NTOK)));
#define LAYER(L, pb) \
        PH(2, pb + 0, phase_zgemm(lds, p, L)); \
        PH(3, pb + 1, phase_b(lds, p, L)); \
        PH(4, pb + 2, phase_c(lds, p, L)); \
        PH(5, pb + 3, phase_d(lds, p, L)); \
        PH(7, pb + 4, phase_router(lds, p, L)); \
        PH(8, pb + 5, phase_gateup(lds, p, L)); \
        PH(9, pb + 6, phase_down(lds, p, L)); \
        PH(10, pb + 7, phase_combine(p, L));
    LAYER(0, PH_LAYER0)
    LAYER(1, PH_LAYER1)
#ifdef PROBE_MASK
    if (blockIdx.x == 0) {
        const unsigned long long tend = __builtin_amdgcn_s_memrealtime();
        while (__builtin_amdgcn_s_memrealtime() - tend < (unsigned long long)PROBE_AMP * tacc) __builtin_amdgcn_s_sleep(8);
    }
#endif
#undef IN
#undef SEAM
}

extern "C" void kernel_launch(void* const* d_in, const int* in_sizes, int n_in, void* d_out, int out_size, void* d_ws, size_t ws_size, hipStream_t stream) {
    static int grid = 0;
    if (grid == 0) {
        if (n_in != 29 || in_sizes[0] != NLAT * D || out_size != NLAT * D || ws_size < WS_END) {
            fprintf(stderr, "kernel_launch: unexpected shapes / workspace (n_in %d, ws %zu, need %zu); nothing launched\n", n_in, ws_size, (size_t)WS_END); grid = -1; return; }
        int dev = 0, cus = 0, per_cu = 0;
        if (hipGetDevice(&dev) != hipSuccess || hipDeviceGetAttribute(&cus, hipDeviceAttributeMultiprocessorCount, dev) != hipSuccess) { grid = -1; return; }
        if (hipFuncSetAttribute((const void*)mk_fwd, hipFuncAttributeMaxDynamicSharedMemorySize, LDS_BYTES) != hipSuccess) { grid = -1; return; }
        if (hipOccupancyMaxActiveBlocksPerMultiprocessor(&per_cu, (const void*)mk_fwd, NTHREADS, LDS_BYTES) != hipSuccess || per_cu < 1) { fprintf(stderr, "kernel_launch: occupancy query says %d\n", per_cu); }
        (void)hipGetLastError();
        grid = cus;
    }
    if (grid < 0) return;
    (void)hipMemsetAsync((char*)d_ws + WS_CTL, 0, CTL_ZERO_BYTES, stream);
    P a{};
    for (int i = 0; i < 29; ++i) a.in[i] = (const float*)d_in[i];
    a.out = (float*)d_out; a.ws = (unsigned char*)d_ws;
#if MK_PER_PHASE
    for (int ph = 0; ph < NPHASES; ++ph) { a.ph_lo = ph; a.ph_hi = ph + 1; hipLaunchKernelGGL(mk_fwd, dim3(grid), dim3(NTHREADS), LDS_BYTES, stream, a); }
#else
    a.ph_lo = 0; a.ph_hi = NPHASES;
    hipLaunchKernelGGL(mk_fwd, dim3(grid), dim3(NTHREADS), LDS_BYTES, stream, a);
#endif
}
```

```cpp
#include <hip/hip_runtime.h>
#include <cstdio>
#include <cstdint>

#ifndef MK_PER_PHASE
#define MK_PER_PHASE 0
#endif

typedef unsigned short bf16_t;
typedef short bf16x8 __attribute__((ext_vector_type(8)));
typedef float f32x4 __attribute__((ext_vector_type(4)));
typedef unsigned u32x4 __attribute__((ext_vector_type(4)));
typedef unsigned u32x2 __attribute__((ext_vector_type(2)));
typedef float f32x16 __attribute__((ext_vector_type(16)));
typedef short v4i16_t __attribute__((ext_vector_type(4)));
#define LAS __attribute__((address_space(3)))

constexpr int D = 1024, BATCH = 16, SEQ = 2048, CTXL = 256;
constexpr int NLAT = BATCH * SEQ, NCTX = BATCH * CTXL, NTOK = NLAT + NCTX;
constexpr int ZC = 1792;
constexpr int Z_RQ = 512, Z_RK = 640, Z_RV = 768, Z_RG = 1024, Z_CQ = 1280, Z_CKV = 1536, Z_KR = 1664, Z_END = 1696;
constexpr int NEXP = 64, TOPK = 6, EDIM = 256;
constexpr float NORM_EPS = 1e-6f;
constexpr int NTHREADS = 512, NWAVES = 8;

constexpr size_t MiB = 1u << 20;
constexpr size_t WS_CTL = 0, CTL_ZERO_BYTES = 1 * MiB;
constexpr size_t WS_MODV = 1 * MiB;
constexpr size_t WS_ROPE = 2 * MiB;
constexpr size_t WS_WIN = 3 * MiB;
constexpr size_t WS_WUQ = 10 * MiB;
constexpr size_t WS_WUKV = 11 * MiB;
constexpr size_t WS_WOUT = 12 * MiB;
constexpr size_t WS_RT = 16 * MiB;
constexpr size_t WS_SHGU = 17 * MiB;
constexpr size_t WS_SHD = 19 * MiB;
constexpr size_t WS_EGU = 20 * MiB;
constexpr size_t WS_ED = 84 * MiB;
constexpr size_t WS_H1 = 20 * MiB;
constexpr size_t WS_X = 116 * MiB;
constexpr size_t WS_H = 188 * MiB;
constexpr size_t WS_CC = WS_H;
constexpr size_t WS_Z = 260 * MiB;
constexpr size_t WS_Y = WS_Z;
constexpr size_t WS_Q = 386 * MiB;
constexpr size_t WS_K = 440 * MiB;
constexpr size_t WS_V = 494 * MiB;
constexpr size_t WS_KV = 530 * MiB;
constexpr size_t WS_SLOT = 188 * MiB;
constexpr size_t WS_ACT = 441 * MiB;
constexpr size_t WS_LTOK = 583 * MiB;
constexpr size_t WS_LW = 592 * MiB;
constexpr size_t WS_SS = 601 * MiB;
constexpr size_t WS_END = 603 * MiB;
constexpr int LCAP = NTOK;
static_assert(WS_SLOT + ((size_t)NTOK * 7 + 1) * 1024 <= WS_ACT && WS_ACT + (size_t)1136 * 256 * 512 <= WS_LTOK, "MoE buffers");

constexpr int CW_TMO = 0;
constexpr int CW_BAR = 4096;
constexpr int CW_ECNT = 8192;

constexpr int LDS_BYTES = 162816;
constexpr int MISC_OFF = LDS_BYTES - 256;
constexpr int RB0_OFF = 131072;
constexpr int RB1_OFF = 149504;
constexpr int ETAB_OFF = 159744;
constexpr int GEMM_LDS = 36864;
constexpr int ROWSS_OFF = 36864;
constexpr int LG_OFF = 37376;

#define XB_TMO      128
#define XB_XCNT(j)  (256  + 64 * (j))
#define XB_XSUB(j)  (1280 + 64 * (j))
#define XB_XGEN(j)  (2304 + 64 * (j))
#define XB_TOP      3328
#define XB_TOPGEN   3392
#define XCD_BAR_WORDS 3456
#define XB_SPIN_CAP (1u << 24)
__device__ __forceinline__ unsigned xb_ld(unsigned* p)              { return __hip_atomic_load(p, __ATOMIC_RELAXED, __HIP_MEMORY_SCOPE_AGENT); }
__device__ __forceinline__ unsigned xb_add(unsigned* p, unsigned v) { return __hip_atomic_fetch_add(p, v, __ATOMIC_RELAXED, __HIP_MEMORY_SCOPE_AGENT); }
__device__ __forceinline__ unsigned xb_xcc_id() { return (unsigned)__builtin_amdgcn_s_getreg((3 << 11) | 20) & 0xFu; }
#define XB_SPIN(cond, bar) do { unsigned _sp = 0; while (cond) { __builtin_amdgcn_s_sleep(1); \
    if ((++_sp & 255u) == 0u) { if (xb_ld(&(bar)[XB_TMO])) break; if (_sp > XB_SPIN_CAP) { atomicAdd(&(bar)[XB_TMO], 1u); break; } } } } while (0)
struct XcdBarrier { unsigned* bar; unsigned x; volatile LAS unsigned* st; };
__device__ __forceinline__ XcdBarrier xcd_barrier_post(unsigned* bar, volatile LAS unsigned* st) {
    XcdBarrier b; b.bar = bar; b.x = xb_xcc_id(); b.st = st;
    if (threadIdx.x == 0) (void)xb_add(&bar[XB_XCNT(b.x)], 1u);
    return b;
}
__device__ __forceinline__ void xcd_barrier_complete(unsigned* bar, unsigned x, unsigned& nloc, unsigned& nx) {
    const unsigned G = gridDim.x * gridDim.y * gridDim.z;
    unsigned sum, cnt, mine, sp = 0u;
    for (;;) {
        sum = 0u; cnt = 0u; mine = 0u;
#pragma unroll
        for (unsigned j = 0; j < 16; ++j) { const unsigned c = xb_ld(&bar[XB_XCNT(j)]); sum += c; cnt += (c > 0u) ? 1u : 0u; mine = (j == x) ? c : mine; }
        if (sum == G) break;
        __builtin_amdgcn_s_sleep(1);
        if ((++sp & 255u) == 0u) { if (xb_ld(&bar[XB_TMO])) break; if (sp > XB_SPIN_CAP) { atomicAdd(&bar[XB_TMO], 1u); break; } }
    }
    nloc = mine > 0u ? mine : 1u; nx = cnt > 0u ? cnt : 1u;
}
__device__ __forceinline__ void xcd_barrier(const XcdBarrier& b) {
    asm volatile("s_waitcnt vmcnt(0)" ::: "memory");
    __syncthreads();
    if (threadIdx.x == 0) {
        unsigned* bar = b.bar;
        __builtin_amdgcn_s_waitcnt(0);
        unsigned nloc = b.st[0], nx = b.st[1];
        if (nloc == 0u) { xcd_barrier_complete(bar, b.x, nloc, nx); b.st[0] = nloc; b.st[1] = nx; }
        const unsigned old = xb_add(&bar[XB_XSUB(b.x)], 1u);
        const unsigned gen = old / nloc;
        if (old + 1u == (gen + 1u) * nloc) {
            __builtin_amdgcn_fence(__ATOMIC_RELEASE, "agent");
            asm volatile("s_waitcnt vmcnt(0)" ::: "memory");
            const unsigned og = xb_add(&bar[XB_TOP], 1u);
            const unsigned tg = og / nx;
            if (og + 1u == (tg + 1u) * nx) xb_add(&bar[XB_TOPGEN], 1u);
            else XB_SPIN(xb_ld(&bar[XB_TOPGEN]) == tg, bar);
            __builtin_amdgcn_fence(__ATOMIC_ACQUIRE, "agent");
            xb_add(&bar[XB_XGEN(b.x)], 1u);
            asm volatile("s_waitcnt vmcnt(0)" ::: "memory");
        } else {
            XB_SPIN(xb_ld(&bar[XB_XGEN(b.x)]) == gen, bar);
            __builtin_amdgcn_fence(__ATOMIC_ACQUIRE, "agent");
            asm volatile("s_waitcnt vmcnt(0)" ::: "memory");
        }
    }
    __syncthreads();
}

__device__ __forceinline__ float bf2f(unsigned h) { return __uint_as_float(h << 16); }
__device__ __forceinline__ unsigned f2bf(float f) { unsigned u = __float_as_uint(f); return (u + 0x7fffu + ((u >> 16) & 1u)) >> 16; }
__device__ __forceinline__ unsigned pk2(float lo, float hi) { return f2bf(lo) | (f2bf(hi) << 16); }
typedef float f32x2_t __attribute__((ext_vector_type(2)));
typedef __bf16 bf16x2_t __attribute__((ext_vector_type(2)));
__device__ __forceinline__ unsigned cvtpk(float lo, float hi) { f32x2_t v = {lo, hi}; bf16x2_t b = __builtin_convertvector(v, bf16x2_t); return __builtin_bit_cast(unsigned, b); }
__device__ __forceinline__ float lo16(unsigned w) { return __uint_as_float(w << 16); }
__device__ __forceinline__ float hi16(unsigned w) { return __uint_as_float(w & 0xffff0000u); }
__device__ __forceinline__ float wave_sum(float v) {
#pragma unroll
    for (int o = 1; o < 64; o <<= 1) v += __shfl_xor(v, o);
    return v;
}
__device__ __forceinline__ float siluf(float v) { return v * __builtin_amdgcn_rcpf(1.f + __expf(-v)); }
__device__ __forceinline__ int mod_row(int tok) { return tok < NLAT ? (tok >> 11) : 16; }

struct P { const float* in[29]; float* out; unsigned char* ws; int ph_lo, ph_hi; };

__device__ __forceinline__ bf16_t* x_row(const P& p, int tok) { return (bf16_t*)(p.ws + WS_X) + (size_t)tok * D; }
__device__ __forceinline__ const float* x_in_row(const P& p, int tok) {
    return tok < NLAT ? p.in[0] + (size_t)tok * D : p.in[2] + (size_t)(tok - NLAT) * D;
}

template <int MF, class RowSrc, class Epi>
__device__ __forceinline__ void gemm_tile(unsigned char* lds, const RowSrc& rs, const bf16_t* Bt, int ldb, int K, const Epi& epi) {
    constexpr int ROWS = 32 * MF, NPA = ROWS * 8;
    const int tid = threadIdx.x, lane = tid & 63, wid = tid >> 6, wr = wid >> 2, wc = wid & 3, fr = lane & 15, fq = lane >> 4;
    bf16_t* As = (bf16_t*)lds; bf16_t* Bs = As + ROWS * 72;
    const bf16_t* ap[3]; int al[3];
#pragma unroll
    for (int i = 0; i < 3; ++i) { const int id = tid + 512 * i, r = id >> 3, c = (id & 7) * 8; ap[i] = (id < NPA) ? rs(r) + c : nullptr; al[i] = r * 72 + c; }
    const int lr = tid >> 2, lc = (tid & 3) * 16;
    const bf16_t* bp = Bt + (size_t)lr * ldb + lc;
    u32x4 a[3], b0 = *(const u32x4*)bp, b1 = *(const u32x4*)(bp + 8);
#pragma unroll
    for (int i = 0; i < 3; ++i) if (ap[i]) a[i] = *(const u32x4*)ap[i];
    f32x4 acc[MF][2];
#pragma unroll
    for (int m = 0; m < MF; ++m)
#pragma unroll
        for (int n = 0; n < 2; ++n) acc[m][n] = (f32x4){0.f, 0.f, 0.f, 0.f};
    for (int k0 = 0; k0 < K; k0 += 64) {
        __syncthreads();
#pragma unroll
        for (int i = 0; i < 3; ++i) if (ap[i]) *(u32x4*)(As + al[i]) = a[i];
        *(u32x4*)(Bs + lr * 72 + lc) = b0; *(u32x4*)(Bs + lr * 72 + lc + 8) = b1;
        __syncthreads();
        if (k0 + 64 < K) {
#pragma unroll
            for (int i = 0; i < 3; ++i) if (ap[i]) { ap[i] += 64; a[i] = *(const u32x4*)ap[i]; }
            bp += 64; b0 = *(const u32x4*)bp; b1 = *(const u32x4*)(bp + 8);
        }
#pragma unroll
        for (int kk = 0; kk < 2; ++kk) {
            bf16x8 af[MF], bfr[2];
#pragma unroll
            for (int m = 0; m < MF; ++m) af[m] = *(const bf16x8*)(As + (wr * 16 * MF + m * 16 + fr) * 72 + kk * 32 + fq * 8);
#pragma unroll
            for (int n = 0; n < 2; ++n) bfr[n] = *(const bf16x8*)(Bs + (wc * 32 + n * 16 + fr) * 72 + kk * 32 + fq * 8);
#pragma unroll
            for (int m = 0; m < MF; ++m)
#pragma unroll
                for (int n = 0; n < 2; ++n) acc[m][n] = __builtin_amdgcn_mfma_f32_16x16x32_bf16(bfr[n], af[m], acc[m][n], 0, 0, 0);
        }
    }
#pragma unroll
    for (int m = 0; m < MF; ++m)
#pragma unroll
        for (int n = 0; n < 2; ++n) epi(wr * 16 * MF + m * 16 + fr, wc * 32 + n * 16 + 4 * fq, acc[m][n]);
}

namespace ge {
constexpr int BM = 256, BK = 64, HALF = 128, HTB = HALF * BK * 2;
__device__ __forceinline__ int lds_byte(int r, int c) { const int st = (r >> 4) * 2 + (c >> 5), rr = r & 15, cc = c & 31, ob = rr * 64 + cc * 2; return st * 1024 + (ob ^ (((ob >> 9) & 1) << 5)); }
__device__ __forceinline__ void stage_rc(int b, int& R, int& C) { const int st = b / 1024, sb = b % 1024, swz = sb ^ (((sb >> 9) & 1) << 5); R = (st >> 1) * 16 + swz / 64; C = (st & 1) * 32 + (swz % 64) / 2; }
struct Unit { const char* B; int a, b, c, d; };
typedef f32x4 Acc[2][2][4][2];

template <class Sched, class Epi, bool ALIGN_EPI>
__device__ __forceinline__ void gemm_stream(LAS unsigned char* lds, const char* Ab, int K, const Sched& S, const Epi& E) {
    const int tid = threadIdx.x, wid = __builtin_amdgcn_readfirstlane(tid >> 6), lane = tid & 63, wr = wid >> 2, wc = wid & 3, fr = lane & 15, fq = lane >> 4;
    const int nt = K / BK;
    int Rr[2], Cc[2]; unsigned voffB[2];
#pragma unroll
    for (int i = 0; i < 2; ++i) { stage_rc(tid * 16 + i * 8192, Rr[i], Cc[i]);
        const int rho = Rr[i] & 31, Rb = (Rr[i] & ~31) + 8 * ((rho & 15) >> 2) + 4 * (rho >> 4) + (rho & 3);
        voffB[i] = (unsigned)(Rb * K + Cc[i]) * 2u; }
    const size_t kstep = (size_t)(BK * 2), hstepB = (size_t)HALF * K * 2;
    const unsigned ldsw = (unsigned)wid * 1024u;
    const int aoff = lds_byte(wr * 64 + fr, fq * 8), boff = lds_byte(wc * 32 + fr, fq * 8);
#define GE_SA(b, h) (((b) * 2 + (h)) * HTB)
#define GE_SB(b, h) ((4 + (b) * 2 + (h)) * HTB)
#define GE_GLDS(gp, ldsoff) __builtin_amdgcn_global_load_lds((const unsigned*)(gp), (LAS unsigned*)(lds + (ldsoff)), 16, 0, 0)
#define GE_STAGE_B(bufoff, gbase) do { GE_GLDS((const char*)(gbase) + voffB[0], (bufoff) + ldsw); GE_GLDS((const char*)(gbase) + voffB[1], (bufoff) + ldsw + 8192); } while (0)
#define GE_STAGE_A(bufoff, kbytes, o0, o1) do { GE_GLDS(Ab + (kbytes) + (o0), (bufoff) + ldsw); GE_GLDS(Ab + (kbytes) + (o1), (bufoff) + ldsw + 8192); } while (0)
#define GE_LDA(dst, b, h) do { _Pragma("unroll") for (int m = 0; m < 4; ++m) _Pragma("unroll") for (int k = 0; k < 2; ++k) dst[m][k] = *(const LAS bf16x8*)(lds + GE_SA(b, h) + aoff + m * 2048 + k * 1024); } while (0)
#define GE_LDB(dst, b, h) do { _Pragma("unroll") for (int n = 0; n < 2; ++n) _Pragma("unroll") for (int k = 0; k < 2; ++k) dst[n][k] = *(const LAS bf16x8*)(lds + GE_SB(b, h) + boff + n * 2048 + k * 1024); } while (0)
#define GE_MMA(ai, bj, At, Bt) do { __builtin_amdgcn_s_setprio(1); _Pragma("unroll") for (int m = 0; m < 4; ++m) _Pragma("unroll") for (int n = 0; n < 2; ++n) _Pragma("unroll") for (int k = 0; k < 2; ++k) \
        acc[ai][bj][m][n] = __builtin_amdgcn_mfma_f32_16x16x32_bf16(Bt[n][k], At[m][k], acc[ai][bj][m][n], 0, 0, 0); __builtin_amdgcn_s_setprio(0); } while (0)
#define GE_WAIT_V(n) asm volatile("s_waitcnt vmcnt(" #n ")" ::: "memory")
#define GE_WAIT_L(n) asm volatile("s_waitcnt lgkmcnt(" #n ")" ::: "memory")
#define GE_BAR __builtin_amdgcn_s_barrier()
#define GE_SCHED __builtin_amdgcn_sched_barrier(0)
    Unit cur, nxt; int ui = 0;
    if (!S.next(0, cur)) return;
    Acc acc;
#pragma unroll
    for (int a = 0; a < 2; ++a)
#pragma unroll
        for (int b = 0; b < 2; ++b)
#pragma unroll
            for (int m = 0; m < 4; ++m)
#pragma unroll
                for (int n = 0; n < 2; ++n) acc[a][b][m][n] = (f32x4){0.f, 0.f, 0.f, 0.f};
    bf16x8 At[4][2], B0[2][2], B1[2][2];
    unsigned oc00, oc01, oc10, oc11, on00, on01, on10, on11;
    oc00 = S.aoff(0, cur, Rr[0]) + (unsigned)Cc[0] * 2u; oc01 = S.aoff(0, cur, Rr[1]) + (unsigned)Cc[1] * 2u;
    oc10 = S.aoff(0, cur, Rr[0] + 128) + (unsigned)Cc[0] * 2u; oc11 = S.aoff(0, cur, Rr[1] + 128) + (unsigned)Cc[1] * 2u;
    const char* cB = cur.B;
    GE_STAGE_B(GE_SB(0, 0), cB); GE_STAGE_B(GE_SB(0, 1), cB + hstepB); GE_STAGE_A(GE_SA(0, 0), 0, oc00, oc01); GE_STAGE_A(GE_SA(0, 1), 0, oc10, oc11);
    if (wr == 1) GE_BAR;
    GE_WAIT_V(2); GE_BAR;
    GE_STAGE_B(GE_SB(1, 0), cB + kstep); GE_STAGE_A(GE_SA(1, 0), kstep, oc00, oc01); GE_STAGE_B(GE_SB(1, 1), cB + hstepB + kstep);
    GE_WAIT_V(6); GE_BAR;
    for (;;) {
        const bool has_next = S.next(ui + 1, nxt);
        const char* nB = has_next ? nxt.B : cB;
        if (has_next) {
            on00 = S.aoff(ui + 1, nxt, Rr[0]) + (unsigned)Cc[0] * 2u; on01 = S.aoff(ui + 1, nxt, Rr[1]) + (unsigned)Cc[1] * 2u;
            on10 = S.aoff(ui + 1, nxt, Rr[0] + 128) + (unsigned)Cc[0] * 2u; on11 = S.aoff(ui + 1, nxt, Rr[1] + 128) + (unsigned)Cc[1] * 2u;
        } else { on00 = oc00; on01 = oc01; on10 = oc10; on11 = oc11; }
#pragma unroll 1
        for (int t = 0; t < nt; t += 2) {
            const bool last = (t == nt - 2);
            const size_t k1 = (size_t)(t + 1) * kstep;
            const size_t k2 = last ? 0 : (size_t)(t + 2) * kstep, k3 = k2 + kstep;
            const char* b2 = last ? nB : cB + (size_t)(t + 2) * kstep; const char* b3 = b2 + kstep;
            const unsigned o00 = last ? on00 : oc00, o01 = last ? on01 : oc01, o10 = last ? on10 : oc10, o11 = last ? on11 : oc11;
            GE_LDB(B0, 0, 0); GE_LDB(B1, 0, 1); GE_SCHED; GE_LDA(At, 0, 0); GE_STAGE_A(GE_SA(1, 1), k1, oc10, oc11);
            GE_WAIT_V(8); GE_WAIT_L(0); GE_BAR; GE_MMA(0, 0, At, B0); GE_MMA(0, 1, At, B1); GE_BAR; GE_SCHED;
            GE_LDA(At, 0, 1); GE_STAGE_B(GE_SB(0, 0), b2); GE_STAGE_B(GE_SB(0, 1), b2 + hstepB); GE_STAGE_A(GE_SA(0, 0), k2, o00, o01);
            GE_WAIT_V(8); GE_WAIT_L(0); GE_BAR; GE_MMA(1, 0, At, B0); GE_MMA(1, 1, At, B1); GE_BAR; GE_SCHED;
            GE_LDB(B0, 1, 0); GE_LDB(B1, 1, 1); GE_SCHED; GE_LDA(At, 1, 0); GE_STAGE_A(GE_SA(0, 1), k2, o10, o11);
            GE_WAIT_V(8); GE_WAIT_L(0); GE_BAR; GE_MMA(0, 0, At, B0); GE_MMA(0, 1, At, B1); GE_BAR; GE_SCHED;
            GE_LDA(At, 1, 1); GE_STAGE_B(GE_SB(1, 0), b3); GE_STAGE_B(GE_SB(1, 1), b3 + hstepB); GE_STAGE_A(GE_SA(1, 0), k3, o00, o01);
            GE_WAIT_V(8); GE_WAIT_L(0); GE_BAR; GE_MMA(1, 0, At, B0); GE_MMA(1, 1, At, B1); GE_BAR; GE_SCHED;
        }
        if constexpr (ALIGN_EPI) { if (wr == 0) GE_BAR; }
        E(acc, cur, wr, wc, fr, fq);
        if (!has_next) break;
#pragma unroll
        for (int a = 0; a < 2; ++a)
#pragma unroll
            for (int b = 0; b < 2; ++b)
#pragma unroll
                for (int m = 0; m < 4; ++m)
#pragma unroll
                    for (int n = 0; n < 2; ++n) acc[a][b][m][n] = (f32x4){0.f, 0.f, 0.f, 0.f};
        cur = nxt; cB = nB; ++ui; oc00 = on00; oc01 = on01; oc10 = on10; oc11 = on11;
        if constexpr (ALIGN_EPI) { if (wr == 1) GE_BAR; }
    }
    GE_WAIT_V(0);
    if constexpr (!ALIGN_EPI) { if (wr == 0) GE_BAR; }
    GE_BAR;
#undef GE_SA
#undef GE_SB
#undef GE_GLDS
#undef GE_STAGE_A
#undef GE_STAGE_B
#undef GE_LDA
#undef GE_LDB
#undef GE_MMA
#undef GE_WAIT_V
#undef GE_WAIT_L
#undef GE_BAR
#undef GE_SCHED
}
template <class F> struct EpiFn {
    F f;
    __device__ __forceinline__ void operator()(const Acc& acc, const Unit& u, int wr, int wc, int fr, int fq) const {
#pragma unroll
        for (int ai = 0; ai < 2; ++ai)
#pragma unroll
            for (int m = 0; m < 4; ++m)
#pragma unroll
                for (int bj = 0; bj < 2; ++bj) f(u, ai * 128 + wr * 64 + m * 16 + fr, bj * 128 + wc * 32 + 8 * fq, acc[ai][bj][m][0], acc[ai][bj][m][1]);
    }
};
struct DenseOrder {
    int nM, nN, nwg, G, c; const char* Bt; size_t btile; unsigned arow;
    __device__ __forceinline__ bool next(int i, Unit& u) const {
        const long L = (long)i * G + c; if (L >= nwg) return false;
        int wgid = (int)L; { const int q = nwg / 8, r = nwg % 8, xcd = wgid % 8, off = wgid / 8; wgid = (xcd < r ? xcd * (q + 1) : r * (q + 1) + (xcd - r) * q) + off; }
        const int nig = 8 * nN, gid = wgid / nig, fm = gid * 8, gsz = (nM - fm) < 8 ? (nM - fm) : 8;
        u.a = fm + ((wgid % nig) % gsz); u.b = (wgid % nig) / gsz; u.c = 0; u.d = 0; u.B = Bt + (size_t)u.b * btile; return true;
    }
    __device__ __forceinline__ unsigned aoff(int, const Unit& u, int R) const { return (unsigned)(u.a * 256 + R) * arow; }
};
}

struct TMap { const float* s0; const float* s1; int ld; int nvalid; const float* ksc; float gsc; };
template <int MODE> __device__ __forceinline__ const float* tmap_src(const float* s0, const float* s1, int nvalid, int n) {
    if (MODE == 0) return n < nvalid ? s0 + n : nullptr;
    if (MODE == 1) { const int h = n / 96, j = n % 96; const int c = j < 64 ? j : 64 + ((j - 64) & 1) * 16 + ((j - 64) >> 1); return s0 + h * 96 + c; }
    return ((n & 1) ? s1 : s0) + (n >> 1);
}
template <int MODE> __device__ __forceinline__ void transpose_unit(float* scr, const float* s0, const float* s1, int ld, int nvalid, const float* ksc, float gsc, int K, bf16_t* dst, int kb, int nb, int kvalid = 1 << 30) {
    const int tid = threadIdx.x, k0 = kb * 64, n0 = nb * 64;
    const int nn = tid & 63; const float* sp = tmap_src<MODE>(s0, s1, nvalid, n0 + nn);
#pragma unroll
    for (int i = 0; i < 8; ++i) {
        const int kk = (tid >> 6) + 8 * i; float v = (sp && k0 + kk < kvalid) ? sp[(size_t)(k0 + kk) * ld] : 0.f;
        if (ksc && k0 + kk < kvalid) v *= ksc[k0 + kk];
        scr[kk * 65 + nn] = v * gsc;
    }
    __syncthreads();
    {
        const int n2 = tid >> 3, kc = tid & 7; const float* s = scr + (kc * 8) * 65 + n2;
        u32x4 o; o.x = pk2(s[0], s[65]); o.y = pk2(s[2 * 65], s[3 * 65]); o.z = pk2(s[4 * 65], s[5 * 65]); o.w = pk2(s[6 * 65], s[7 * 65]);
        *(u32x4*)(dst + (size_t)(n0 + n2) * K + k0 + kc * 8) = o;
    }
    __syncthreads();
}
template <int MODE> __device__ __forceinline__ void transpose_matrix(float* scr, const float* s0, const float* s1, int ld, int nvalid, const float* ksc, float gsc, int K, int Nd, bf16_t* dst, int& rot, int kvalid = 1 << 30) {
    const int nkb = K / 64, nnb = Nd / 64, nu = nkb * nnb, G = gridDim.x;
    int first = ((int)blockIdx.x - rot) % G; if (first < 0) first += G;
    for (int u = first; u < nu; u += G) transpose_unit<MODE>(scr, s0, s1, ld, nvalid, ksc, gsc, K, dst, u / nnb, u % nnb, kvalid);
    rot = (rot + nu) % G;
}
__device__ __forceinline__ void convert_expert_weights(unsigned char* lds, const P& p, int L) {
    float* scr = (float*)lds; const int G = gridDim.x, tid = threadIdx.x;
    constexpr int S = 261;
    bf16_t* egu = (bf16_t*)(p.ws + WS_EGU); bf16_t* ed = (bf16_t*)(p.ws + WS_ED);
    for (int ub = blockIdx.x; ub < NEXP * 48; ub += G) {
        const int e = ub / 48, r = (ub % 48) * 4;
        bf16_t* dst; int K, k0;
        if (r < 128) {
            const int kb = r >> 3, nb0 = r & 7; k0 = kb * 64; K = D; dst = egu + ((size_t)e * 512 + nb0 * 64) * D;
            const float* gsrc = p.in[22] + ((size_t)L * NEXP + e) * D * EDIM + nb0 * 32; const float* usrc = p.in[23] + ((size_t)L * NEXP + e) * D * EDIM + nb0 * 32;
            f32x4 v[8];
#pragma unroll
            for (int i = 0; i < 8; ++i) { const int idx = tid + 512 * i, kk = idx >> 6, c = idx & 63; v[i] = *(const f32x4*)((c < 32 ? gsrc : usrc) + (size_t)(k0 + kk) * EDIM + (c & 31) * 4); }
#pragma unroll
            for (int i = 0; i < 8; ++i) { const int idx = tid + 512 * i, kk = idx >> 6, c = idx & 63; float* d = scr + kk * S + 8 * (c & 31) + (c >> 5);
                d[0] = v[i].x; d[2] = v[i].y; d[4] = v[i].z; d[6] = v[i].w; }
        } else {
            const int r2 = r - 128, kb = r2 >> 4, nb0 = r2 & 15; k0 = kb * 64; K = EDIM; dst = ed + ((size_t)e * D + nb0 * 64) * EDIM;
            const float* src = p.in[24] + ((size_t)L * NEXP + e) * EDIM * D + nb0 * 64;
            f32x4 v[8];
#pragma unroll
            for (int i = 0; i < 8; ++i) { const int idx = tid + 512 * i, kk = idx >> 6, c = idx & 63; v[i] = *(const f32x4*)(src + (size_t)(k0 + kk) * D + c * 4); }
#pragma unroll
            for (int i = 0; i < 8; ++i) { const int idx = tid + 512 * i, kk = idx >> 6, c = idx & 63; float* d = scr + kk * S + 4 * c;
                d[0] = v[i].x; d[1] = v[i].y; d[2] = v[i].z; d[3] = v[i].w; }
        }
        __syncthreads();
#pragma unroll
        for (int i = 0; i < 4; ++i) {
            const int id = tid + 512 * i, n = id >> 3, kc = id & 7; const float* sp = scr + (kc * 8) * S + n;
            u32x4 o; o.x = cvtpk(sp[0], sp[S]); o.y = cvtpk(sp[2 * S], sp[3 * S]); o.z = cvtpk(sp[4 * S], sp[5 * S]); o.w = cvtpk(sp[6 * S], sp[7 * S]);
            *(u32x4*)(dst + (size_t)n * K + k0 + kc * 8) = o;
        }
        __syncthreads();
    }
}
__device__ __forceinline__ void prep_mod_unit(unsigned char* lds, const P& p, int u) {
    float* sc = (float*)lds;
    float* part = sc + 17 * 1024;
    const int tid = threadIdx.x;
    const float* c = p.in[1]; const float* cctx = p.in[3];
    for (int i = tid; i < 17 * 1024; i += NTHREADS) { const int r = i >> 10, k = i & 1023; const float v = r < 16 ? c[r * 1024 + k] : cctx[k]; sc[i] = v * __builtin_amdgcn_rcpf(1.f + __expf(-v)); }
    __syncthreads();
    const int L = u / 192, cg = u % 192, ks = tid >> 5, cl = tid & 31, col = cg * 32 + cl;
    const float* w = p.in[4] + (size_t)L * 1024 * 6144 + (size_t)(ks * 64) * 6144 + col;
    float acc[17];
#pragma unroll
    for (int r = 0; r < 17; ++r) acc[r] = 0.f;
#pragma unroll 8
    for (int k = 0; k < 64; ++k) {
        const float wv = w[(size_t)k * 6144];
#pragma unroll
        for (int r = 0; r < 17; ++r) acc[r] += sc[r * 1024 + ks * 64 + k] * wv;
    }
#pragma unroll
    for (int r = 0; r < 17; ++r) part[(ks * 17 + r) * 32 + cl] = acc[r];
    __syncthreads();
    float* modv = (float*)(p.ws + WS_MODV);
    for (int i = tid; i < 17 * 32; i += NTHREADS) {
        const int r = i >> 5, c2 = i & 31;
        float s2 = p.in[5][L * 6144 + cg * 32 + c2];
#pragma unroll
        for (int q = 0; q < 16; ++q) s2 += part[(q * 17 + r) * 32 + c2];
        modv[((size_t)L * 17 + r) * 6144 + cg * 32 + c2] = s2;
    }
    __syncthreads();
}
__device__ __forceinline__ void phase_prep0(unsigned char* lds, const P& p) {
    const int tid = threadIdx.x, G = gridDim.x, bid = blockIdx.x;
    {
        float* ct = (float*)(p.ws + WS_ROPE); float* st = ct + 2048 * 16;
        for (int i = bid * NTHREADS + tid; i < 2048 * 16; i += G * NTHREADS) {
            const int pos = i >> 4, f = i & 15;
            const float inv = powf(10000.f, -(float)(f & 7) / 8.f);
            const float ang = (float)(f < 8 ? (pos >> 6) : (pos & 63)) * inv;
            ct[i] = cosf(ang); st[i] = sinf(ang);
        }
    }
    for (int u = bid; u < 384; u += G) prep_mod_unit(lds, p, u);
}
__device__ __forceinline__ void phase_prep1(unsigned char* lds, const P& p) {
    float* scr = (float*)lds; int rot = 0;
    for (int L = 0; L < 2; ++L) {
        transpose_matrix<0>(scr, p.in[7] + (size_t)L * D * Z_END, nullptr, Z_END, Z_END, nullptr, 1.f, D, ZC, (bf16_t*)(p.ws + WS_WIN) + (size_t)L * ZC * D, rot);
        transpose_matrix<1>(scr, p.in[15] + (size_t)L * 256 * 768, nullptr, 768, 768, p.in[14] + L * 256, 0.14724574f, 256, 768, (bf16_t*)(p.ws + WS_WUQ) + (size_t)L * 768 * 256, rot);
        transpose_matrix<0>(scr, p.in[17] + (size_t)L * 128 * 1024, nullptr, 1024, 1024, p.in[16] + L * 128, 1.f, 256, 1024, (bf16_t*)(p.ws + WS_WUKV) + (size_t)L * 1024 * 256, rot, 128);
        transpose_matrix<0>(scr, p.in[18] + (size_t)L * D * D, nullptr, D, D, nullptr, 1.f, D, D, (bf16_t*)(p.ws + WS_WOUT) + (size_t)L * D * D, rot);
        transpose_matrix<0>(scr, p.in[20] + (size_t)L * D * NEXP, nullptr, NEXP, NEXP, nullptr, 1.f, D, 128, (bf16_t*)(p.ws + WS_RT) + (size_t)L * 128 * D, rot);
        transpose_matrix<2>(scr, p.in[25] + (size_t)L * D * EDIM, p.in[26] + (size_t)L * D * EDIM, EDIM, 512, nullptr, 1.f, D, 512, (bf16_t*)(p.ws + WS_SHGU) + (size_t)L * 512 * D, rot);
        transpose_matrix<0>(scr, p.in[27] + (size_t)L * EDIM * D, nullptr, D, D, nullptr, 1.f, EDIM, D, (bf16_t*)(p.ws + WS_SHD) + (size_t)L * D * EDIM, rot);
    }
}

__device__ __forceinline__ void phase_norm_mod(const P& p, int L, int which  , int ntok) {
    const int tid = threadIdx.x, lane = tid & 63, wave = tid >> 6, gw = blockIdx.x * NWAVES + wave, NGW = gridDim.x * NWAVES;
    const float* nw = (which == 0 ? p.in[6] : p.in[19]) + L * D;
    const float* modv = (const float*)(p.ws + WS_MODV) + (size_t)L * 17 * 6144;
    bf16_t* H = (bf16_t*)(p.ws + WS_H);
    for (int tok = gw; tok < ntok; tok += NGW) {
        const f32x4* xr = (const f32x4*)x_in_row(p, tok) + lane;
        const float* mrow = modv + (size_t)mod_row(tok) * 6144 + which * 3072;
        f32x4 v[4]; float s = 0.f;
#pragma unroll
        for (int j = 0; j < 4; ++j) { v[j] = xr[64 * j]; s += v[j].x * v[j].x + v[j].y * v[j].y + v[j].z * v[j].z + v[j].w * v[j].w; }
        const float rstd = rsqrtf(wave_sum(s) * (1.f / D) + NORM_EPS);
        u32x2* o = (u32x2*)(H + (size_t)tok * D) + lane;
#pragma unroll
        for (int j = 0; j < 4; ++j) {
            const int k = 4 * lane + 256 * j;
            const f32x4 w4 = *(const f32x4*)(nw + k), sh = *(const f32x4*)(mrow + k), sc = *(const f32x4*)(mrow + 1024 + k);
            const float y0 = v[j].x * rstd * w4.x * (1.f + sc.x) + sh.x, y1 = v[j].y * rstd * w4.y * (1.f + sc.y) + sh.y;
            const float y2 = v[j].z * rstd * w4.z * (1.f + sc.z) + sh.z, y3 = v[j].w * rstd * w4.w * (1.f + sc.w) + sh.w;
            u32x2 w; w.x = pk2(y0, y1); w.y = pk2(y2, y3); o[64 * j] = w;
        }
    }
}

struct EpiZ {
    bf16_t* Z; float* ssq; float* sskv; bf16_t* Kb; const float* ct; const float* st;
    __device__ __forceinline__ void operator()(const ge::Acc& acc, const ge::Unit& u, int wr, int wc, int fr, int fq) const {
#pragma unroll
        for (int ai = 0; ai < 2; ++ai)
#pragma unroll
            for (int m = 0; m < 4; ++m) {
                const int row = u.a * 256 + ai * 128 + wr * 64 + m * 16 + fr;
#pragma unroll
                for (int bj = 0; bj < 2; ++bj) {
                    const f32x4 v0 = acc[ai][bj][m][0], v1 = acc[ai][bj][m][1];
                    u32x4 w; w.x = cvtpk(v0.x, v0.y); w.y = cvtpk(v0.z, v0.w); w.z = cvtpk(v1.x, v1.y); w.w = cvtpk(v1.z, v1.w);
                    *(u32x4*)(Z + (size_t)row * ZC + u.b * 256 + bj * 128 + wc * 32 + 8 * fq) = w;
                }
                if (u.b == 5) {
                    float sq = 0.f;
#pragma unroll
                    for (int bj = 0; bj < 2; ++bj)
#pragma unroll
                        for (int n = 0; n < 2; ++n) { const f32x4 v = acc[ai][bj][m][n]; sq += v.x * v.x + v.y * v.y + v.z * v.z + v.w * v.w; }
                    sq += __shfl_xor(sq, 16); sq += __shfl_xor(sq, 32);
                    if (fq == 0) ssq[(size_t)row * 4 + wc] = sq;
                }
                if (u.b == 6) {
                    float sq = 0.f;
#pragma unroll
                    for (int n = 0; n < 2; ++n) { const f32x4 v = acc[ai][0][m][n]; sq += v.x * v.x + v.y * v.y + v.z * v.z + v.w * v.w; }
                    sq += __shfl_xor(sq, 16); sq += __shfl_xor(sq, 32);
                    if (fq == 0) sskv[(size_t)row * 4 + wc] = sq;
                    if (wc == 0) {
                        const f32x4 a0 = acc[ai][1][m][0], a1 = acc[ai][1][m][1];
                        f32x4 b0, b1;
#pragma unroll
                        for (int j = 0; j < 4; ++j) { b0[j] = __shfl_xor(a0[j], 32); b1[j] = __shfl_xor(a1[j], 32); }
                        if (fq < 2) {
                            f32x4 c0 = (f32x4){1.f, 1.f, 1.f, 1.f}, c1 = c0, s0 = (f32x4){0.f, 0.f, 0.f, 0.f}, s1 = s0;
                            if (row < NLAT) { const int pos = row & (SEQ - 1); c0 = *(const f32x4*)(ct + pos * 16 + 8 * fq); c1 = *(const f32x4*)(ct + pos * 16 + 8 * fq + 4); s0 = *(const f32x4*)(st + pos * 16 + 8 * fq); s1 = *(const f32x4*)(st + pos * 16 + 8 * fq + 4); }
                            const f32x4 o10 = a0 * c0 - b0 * s0, o20 = a0 * s0 + b0 * c0, o11 = a1 * c1 - b1 * s1, o21 = a1 * s1 + b1 * c1;
                            u32x4 w0, w1; w0.x = cvtpk(o10.x, o20.x); w0.y = cvtpk(o10.y, o20.y); w0.z = cvtpk(o10.z, o20.z); w0.w = cvtpk(o10.w, o20.w);
                            w1.x = cvtpk(o11.x, o21.x); w1.y = cvtpk(o11.y, o21.y); w1.z = cvtpk(o11.z, o21.z); w1.w = cvtpk(o11.w, o21.w);
#pragma unroll
                            for (int h = 0; h < 8; ++h) { bf16_t* kp = Kb + (size_t)row * 768 + h * 96 + 64 + 16 * fq; *(u32x4*)kp = w0; *(u32x4*)(kp + 8) = w1; }
                        }
                    }
                }
            }
    }
};
__device__ __forceinline__ void phase_zgemm(unsigned char* lds, const P& p, int L) {
    const bf16_t* W = (const bf16_t*)(p.ws + WS_WIN) + (size_t)L * ZC * D;
    ge::DenseOrder S; S.nM = NTOK / 256; S.nN = ZC / 256; S.nwg = S.nM * S.nN; S.G = gridDim.x; S.c = blockIdx.x; S.Bt = (const char*)W; S.btile = (size_t)256 * D * 2; S.arow = D * 2;
    EpiZ E{(bf16_t*)(p.ws + WS_Z), (float*)(p.ws + WS_SS), (float*)(p.ws + WS_SS) + (size_t)NTOK * 4, (bf16_t*)(p.ws + WS_K), (const float*)(p.ws + WS_ROPE), (const float*)(p.ws + WS_ROPE) + 2048 * 16};
    ge::gemm_stream<ge::DenseOrder, EpiZ, true>((LAS unsigned char*)lds, (const char*)(p.ws + (L == 0 ? WS_H : WS_H1)), D, S, E);
}

__device__ __forceinline__ void conv_unit(unsigned char* lds, const P& p, int L, int s, int tt) {
    float* hg = (float*)lds;
    const int tid = threadIdx.x, lane = tid & 63, wave = tid >> 6;
    const int rb = s < 16 ? s * SEQ : NLAT + (s - 16) * CTXL, len = s < 16 ? SEQ : CTXL, t0 = tt * 64;
    const bf16_t* Z = (const bf16_t*)(p.ws + WS_Z);
    {
        u32x2 av[12], gv[12];
#pragma unroll
        for (int q = 0; q < 12; ++q) {
            const int i = tid + q * NTHREADS, jj = i >> 6, c4 = (i & 63) * 4; int t = t0 - 15 + jj; t = t < 0 ? 0 : (t >= len ? len - 1 : t);
            const bf16_t* zr = Z + (size_t)(rb + t) * ZC;
            av[q] = *(const u32x2*)(zr + c4); gv[q] = *(const u32x2*)(zr + 256 + c4);
        }
#pragma unroll
        for (int q = 0; q < 12; ++q) {
            const int i = tid + q * NTHREADS, jj = i >> 6, c4 = (i & 63) * 4, t = t0 - 15 + jj;
            if (i < 94 * 64) {
                f32x4 h = (f32x4){0.f, 0.f, 0.f, 0.f};
                if (t >= 0 && t < len) {
                    const u32x2 a = av[q], g = gv[q];
                    h.x = lo16(a.x) * __builtin_amdgcn_rcpf(1.f + __expf(-lo16(g.x))); h.y = hi16(a.x) * __builtin_amdgcn_rcpf(1.f + __expf(-hi16(g.x)));
                    h.z = lo16(a.y) * __builtin_amdgcn_rcpf(1.f + __expf(-lo16(g.y))); h.w = hi16(a.y) * __builtin_amdgcn_rcpf(1.f + __expf(-hi16(g.y)));
                }
                *(f32x4*)(hg + jj * 256 + c4) = h;
            }
        }
    }
    float* wl = hg + 94 * 256;
    for (int i = tid; i < 31 * 64; i += NTHREADS) *(f32x4*)(wl + i * 4) = *(const f32x4*)(p.in[8] + (size_t)L * 31 * 256 + i * 4);
    __syncthreads();
    const int c0 = lane * 4;
    const f32x4 cb = *(const f32x4*)(p.in[9] + L * 256 + c0), lw = *(const f32x4*)(p.in[10] + L * 256 + c0), lb = *(const f32x4*)(p.in[11] + L * 256 + c0);
    bf16_t* CC = (bf16_t*)(p.ws + WS_CC);
    {
        f32x4 w[31];
#pragma unroll
        for (int j = 0; j < 31; ++j) w[j] = *(const f32x4*)(wl + j * 256 + c0);
#pragma unroll 1
        for (int half = 0; half < 2; ++half) {
            f32x4 acc[4];
#pragma unroll
            for (int q = 0; q < 4; ++q) acc[q] = cb;
            const float* hrow = hg + (wave * 8 + half * 4) * 256 + c0;
#pragma unroll
            for (int r = 0; r < 34; ++r) {
                const f32x4 h = *(const f32x4*)(hrow + r * 256);
#pragma unroll
                for (int q = 0; q < 4; ++q) { if (r - q >= 0 && r - q <= 30) acc[q] += h * w[r - q]; }
            }
#pragma unroll
            for (int q = 0; q < 4; ++q) {
                const int tl = wave * 8 + half * 4 + q;
                const float mean = wave_sum(acc[q].x + acc[q].y + acc[q].z + acc[q].w) * (1.f / 256.f);
                const f32x4 d = acc[q] - mean;
                const float var = wave_sum(d.x * d.x + d.y * d.y + d.z * d.z + d.w * d.w) * (1.f / 256.f);
                const float rstd = rsqrtf(var + NORM_EPS);
                const f32x4 y = d * rstd * lw + lb;
                u32x2 o; o.x = cvtpk(siluf(y.x), siluf(y.y)); o.y = cvtpk(siluf(y.z), siluf(y.w));
                *(u32x2*)(CC + (size_t)(rb + t0 + tl) * D + c0) = o;
            }
        }
    }
    __syncthreads();
}

__device__ __forceinline__ float log2_gamma(const P& p, int L, int dir, int h) {
    const float x = p.in[12][(L * 2 + dir) * 4 + h];
    const float ls = fminf(x, 0.f) - log1pf(expf(-fabsf(x)));
    return ls * 1.4426950408889634f;
}
__device__ __forceinline__ void load_ret_qk(float* dst, const P& p, int gc, int h, int zoff, float scale) {
    const int tid = threadIdx.x, j = tid >> 2, i0 = (tid & 3) * 4, row = gc * 128 + j;
    const bf16_t* zr = (const bf16_t*)(p.ws + WS_Z) + (size_t)row * ZC + zoff + h * 32;
    const u32x2 a = *(const u32x2*)(zr + i0), b = *(const u32x2*)(zr + 16 + i0);
    float x1[4] = {lo16(a.x), hi16(a.x), lo16(a.y), hi16(a.y)}, x2[4] = {lo16(b.x), hi16(b.x), lo16(b.y), hi16(b.y)};
    const bool lat = row < NLAT; const int pos = row & (SEQ - 1);
    const float* ct = (const float*)(p.ws + WS_ROPE) + pos * 16 + i0; const float* st = ct + 2048 * 16;
#pragma unroll
    for (int i = 0; i < 4; ++i) {
        const float c = lat ? ct[i] : 1.f, s = lat ? st[i] : 0.f;
        dst[j * 33 + i0 + i] = (x1[i] * c - x2[i] * s) * scale;
        dst[j * 33 + 16 + i0 + i] = (x1[i] * s + x2[i] * c) * scale;
    }
}
__device__ __forceinline__ void load_ret_v(float* dst  , const P& p, int gc, int h) {
    const int tid = threadIdx.x, j = tid >> 2, e0 = (tid & 3) * 16;
    const bf16_t* zr = (const bf16_t*)(p.ws + WS_Z) + (size_t)(gc * 128 + j) * ZC + Z_RV + h * 64 + e0;
    const u32x4 a = *(const u32x4*)zr, b = *(const u32x4*)(zr + 8);
#pragma unroll
    for (int i = 0; i < 4; ++i) { dst[j * 64 + e0 + 2 * i] = lo16(a[i]); dst[j * 64 + e0 + 2 * i + 1] = hi16(a[i]); dst[j * 64 + e0 + 8 + 2 * i] = lo16(b[i]); dst[j * 64 + e0 + 8 + 2 * i + 1] = hi16(b[i]); }
}
__device__ __forceinline__ void retkv_unit(unsigned char* lds, const P& p, int L, int gc, int h) {
    float* ks = (float*)lds; float* vs = ks + 128 * 33; float* wf = vs + 128 * 64; float* wb = wf + 128;
    const int tid = threadIdx.x;
    const float l2f = log2_gamma(p, L, 0, h), l2b = log2_gamma(p, L, 1, h);
    load_ret_qk(ks, p, gc, h, Z_RK, 0.17677669529663687f);
    load_ret_v(vs, p, gc, h);
    if (tid < 128) { wf[tid] = exp2f(l2f * (float)(127 - tid)); wb[tid] = exp2f(l2b * (float)tid); }
    __syncthreads();
    const int d = tid >> 4, e0 = (tid & 15) * 4;
    f32x4 af = (f32x4){0.f, 0.f, 0.f, 0.f}, ab = af;
    for (int j = 0; j < 128; ++j) {
        const float kd = ks[j * 33 + d]; const f32x4 v4 = *(const f32x4*)(vs + j * 64 + e0);
        af += (kd * wf[j]) * v4; ab += (kd * wb[j]) * v4;
    }
    float* KV = (float*)(p.ws + WS_KV) + ((size_t)(gc * 4 + h) * 2) * 2048;
    *(f32x4*)(KV + d * 64 + e0) = af; *(f32x4*)(KV + 2048 + d * 64 + e0) = ab;
    __syncthreads();
}
__device__ __forceinline__ void ret_stage_k(unsigned char* kf, unsigned char* kb, int rowb, const P& p, int gc, int h, float ef, float jf0, float eb, float jb0) {
    const int tid = threadIdx.x, j = tid >> 2, i0 = (tid & 3) * 4, row = gc * 128 + j;
    const bf16_t* zr = (const bf16_t*)(p.ws + WS_Z) + (size_t)row * ZC + Z_RK + h * 32;
    const u32x2 a = *(const u32x2*)(zr + i0), b = *(const u32x2*)(zr + 16 + i0);
    const float x1[4] = {lo16(a.x), hi16(a.x), lo16(a.y), hi16(a.y)}, x2[4] = {lo16(b.x), hi16(b.x), lo16(b.y), hi16(b.y)};
    f32x4 c4 = (f32x4){1.f, 1.f, 1.f, 1.f}, s4 = (f32x4){0.f, 0.f, 0.f, 0.f};
    if (row < NLAT) { const int pos = row & (SEQ - 1); const float* ct = (const float*)(p.ws + WS_ROPE) + pos * 16 + i0; c4 = *(const f32x4*)ct; s4 = *(const f32x4*)(ct + 2048 * 16); }
    const float wf = __builtin_amdgcn_exp2f(ef * ((float)j - jf0)) * 0.17677669529663687f, wb = __builtin_amdgcn_exp2f(eb * ((float)j - jb0)) * 0.17677669529663687f;
    float o1[4], o2[4];
#pragma unroll
    for (int i = 0; i < 4; ++i) { o1[i] = x1[i] * c4[i] - x2[i] * s4[i]; o2[i] = x1[i] * s4[i] + x2[i] * c4[i]; }
    u32x2 w;
    w.x = cvtpk(o1[0] * wf, o1[1] * wf); w.y = cvtpk(o1[2] * wf, o1[3] * wf); *(u32x2*)(kf + j * rowb + i0 * 2) = w;
    w.x = cvtpk(o2[0] * wf, o2[1] * wf); w.y = cvtpk(o2[2] * wf, o2[3] * wf); *(u32x2*)(kf + j * rowb + 32 + i0 * 2) = w;
    w.x = cvtpk(o1[0] * wb, o1[1] * wb); w.y = cvtpk(o1[2] * wb, o1[3] * wb); *(u32x2*)(kb + j * rowb + i0 * 2) = w;
    w.x = cvtpk(o2[0] * wb, o2[1] * wb); w.y = cvtpk(o2[2] * wb, o2[3] * wb); *(u32x2*)(kb + j * rowb + 32 + i0 * 2) = w;
}
__device__ __forceinline__ void ret_stage_v(unsigned char* vt, const P& p, int gc, int h) {
    const int tid = threadIdx.x, j = tid >> 2, e0 = (tid & 3) * 16;
    const bf16_t* zr = (const bf16_t*)(p.ws + WS_Z) + (size_t)(gc * 128 + j) * ZC + Z_RV + h * 64 + e0;
    const u32x4 a = *(const u32x4*)zr, b = *(const u32x4*)(zr + 8);
    unsigned char* d = vt + (e0 >> 5) * 8192 + j * 64 + (e0 & 31) * 2;
    *(u32x4*)d = a; *(u32x4*)(d + 16) = b;
}
__device__ __forceinline__ bf16x8 tr8(const unsigned char* p0, const unsigned char* p1) {
    const v4i16_t a = __builtin_amdgcn_ds_read_tr16_b64_v4i16((LAS v4i16_t*)(const LAS unsigned char*)p0), b = __builtin_amdgcn_ds_read_tr16_b64_v4i16((LAS v4i16_t*)(const LAS unsigned char*)p1);
    return (bf16x8){a[0], a[1], a[2], a[3], b[0], b[1], b[2], b[3]};
}
__device__ __forceinline__ void retkv_unit_mfma(unsigned char* lds, const P& p, int L, int gc, int h) {
    const int tid = threadIdx.x, lane = tid & 63, wid = tid >> 6;
    const float l2f = log2_gamma(p, L, 0, h), l2b = log2_gamma(p, L, 1, h);
    ret_stage_k(lds, lds + 8192, 64, p, gc, h, -l2f, 127.f, l2b, 0.f);
    ret_stage_v(lds + 16384, p, gc, h);
    __syncthreads();
    if (wid < 4) {
        const int dir = wid >> 1, eb = wid & 1, g = lane >> 4, i = lane & 15, hh = lane >> 5;
        const int off = (8 * hh + (i >> 2)) * 64 + (g & 1) * 32 + (i & 3) * 8;
        const unsigned char* Kt = lds + dir * 8192 + off; const unsigned char* Vt = lds + 16384 + eb * 8192 + off;
        f32x16 acc;
#pragma unroll
        for (int r = 0; r < 16; ++r) acc[r] = 0.f;
#pragma unroll
        for (int s = 0; s < 8; ++s) acc = __builtin_amdgcn_mfma_f32_32x32x16_bf16(tr8(Vt + s * 1024, Vt + s * 1024 + 256), tr8(Kt + s * 1024, Kt + s * 1024 + 256), acc, 0, 0, 0);
        bf16_t* KV = (bf16_t*)(p.ws + WS_KV) + ((size_t)(gc * 4 + h) * 2 + dir) * 2048 + (lane & 31) * 64 + eb * 32 + 4 * hh;
#pragma unroll
        for (int r4 = 0; r4 < 4; ++r4) { u32x2 w; w.x = cvtpk(acc[4 * r4], acc[4 * r4 + 1]); w.y = cvtpk(acc[4 * r4 + 2], acc[4 * r4 + 3]); *(u32x2*)(KV + 8 * r4) = w; }
    }
    __syncthreads();
}
__device__ __forceinline__ void retout_unit_mfma(unsigned char* lds, const P& p, int L, int gc, int h) {
    constexpr int KROW = 80, O_KF = 0, O_KB = 10240, O_V = 20480, O_SF = 36864, O_SB = 41984, O_RED = 47104;
    int tid = threadIdx.x; asm volatile("" : "+v"(tid));
    const int lane = tid & 63, wid = tid >> 6, r32 = lane & 31, hh = lane >> 5;
    const float l2f = log2_gamma(p, L, 0, h), l2b = log2_gamma(p, L, 1, h);
    const int qb = wid & 3, eb = wid >> 2, i = qb * 32 + r32, row = gc * 128 + i;
    const bf16_t* zq = (const bf16_t*)(p.ws + WS_Z) + (size_t)row * ZC + Z_RQ + h * 32 + 8 * hh;
    const u32x4 qa = *(const u32x4*)zq, qbv = *(const u32x4*)(zq + 16);
    f32x4 rc0 = (f32x4){1.f, 1.f, 1.f, 1.f}, rc1 = rc0, rs0 = (f32x4){0.f, 0.f, 0.f, 0.f}, rs1 = rs0;
    if (row < NLAT) { const float* ct = (const float*)(p.ws + WS_ROPE) + (row & (SEQ - 1)) * 16 + 8 * hh; const float* st = ct + 2048 * 16;
        rc0 = *(const f32x4*)ct; rc1 = *(const f32x4*)(ct + 4); rs0 = *(const f32x4*)st; rs1 = *(const f32x4*)(st + 4); }
    const bf16_t* zg = (const bf16_t*)(p.ws + WS_Z) + (size_t)row * ZC + Z_RG + h * 64 + eb * 32 + 4 * hh;
    const float* gw = p.in[13] + L * 256 + h * 64 + eb * 32 + 4 * hh;
    u32x2 gzv[4]; f32x4 gwv[4];
#pragma unroll
    for (int r4 = 0; r4 < 4; ++r4) { gzv[r4] = *(const u32x2*)(zg + 8 * r4); gwv[r4] = *(const f32x4*)(gw + 8 * r4); }
    const bool lat = gc < 256; const int b = lat ? gc >> 4 : (gc - 256) >> 1;
    u32x2 kvf[18], kvb[18];
    {
        const bf16_t* KVb = (const bf16_t*)(p.ws + WS_KV);
#pragma unroll
        for (int mm = 0; mm < 18; ++mm) {
            const int gcm = mm < 2 ? 256 + b * 2 + mm : b * 16 + (mm - 2);
            const bf16_t* kv = KVb + ((size_t)(gcm * 4 + h) * 2) * 2048 + tid * 4;
            kvf[mm] = *(const u32x2*)kv; kvb[mm] = *(const u32x2*)(kv + 2048);
        }
    }
    ret_stage_k(lds + O_KF, lds + O_KB, KROW, p, gc, h, -l2f, 0.f, l2b, 0.f);
    ret_stage_v(lds + O_V, p, gc, h);
    {
        const int mme = lat ? 2 + (gc & 15) : (gc - 256) & 1;
        const int u = mme, w = mme < 2 ? 1 - mme : 19 - mme;
        f32x4 sf = (f32x4){0.f, 0.f, 0.f, 0.f}, sb = sf;
#pragma unroll
        for (int mm = 0; mm < 18; ++mm) {
            const int um = mm, wm = mm < 2 ? 1 - mm : 19 - mm;
            const u32x2 kf2 = kvf[mm], kb2 = kvb[mm];
            const float wgf = um < u ? __builtin_amdgcn_exp2f(l2f * 128.f * (float)(u - 1 - um)) : 0.f;
            const float wgb = wm < w ? __builtin_amdgcn_exp2f(l2b * 128.f * (float)(w - 1 - wm)) : 0.f;
            sf += wgf * (f32x4){lo16(kf2.x), hi16(kf2.x), lo16(kf2.y), hi16(kf2.y)}; sb += wgb * (f32x4){lo16(kb2.x), hi16(kb2.x), lo16(kb2.y), hi16(kb2.y)};
        }
        const int d = tid >> 4, e0 = (tid & 15) * 4;
#pragma unroll
        for (int k = 0; k < 4; ++k) { *(bf16_t*)(lds + O_SF + (e0 + k) * KROW + d * 2) = (bf16_t)(cvtpk(sf[k], 0.f) & 0xffffu); *(bf16_t*)(lds + O_SB + (e0 + k) * KROW + d * 2) = (bf16_t)(cvtpk(sb[k], 0.f) & 0xffffu); }
    }
    __syncthreads();
    bf16x8 qf[2];
    {
        float x1[8], x2[8];
#pragma unroll
        for (int k = 0; k < 4; ++k) { x1[2 * k] = lo16(qa[k]); x1[2 * k + 1] = hi16(qa[k]); x2[2 * k] = lo16(qbv[k]); x2[2 * k + 1] = hi16(qbv[k]); }
#pragma unroll
        for (int k = 0; k < 8; ++k) { const float c = k < 4 ? rc0[k & 3] : rc1[k & 3], sn = k < 4 ? rs0[k & 3] : rs1[k & 3], u1 = x1[k], u2 = x2[k]; x1[k] = u1 * c - u2 * sn; x2[k] = u1 * sn + u2 * c; }
        const u32x4 q0 = (u32x4){cvtpk(x1[0], x1[1]), cvtpk(x1[2], x1[3]), cvtpk(x1[4], x1[5]), cvtpk(x1[6], x1[7])};
        const u32x4 q1 = (u32x4){cvtpk(x2[0], x2[1]), cvtpk(x2[2], x2[3]), cvtpk(x2[4], x2[5]), cvtpk(x2[6], x2[7])};
        qf[0] = __builtin_bit_cast(bf16x8, q0); qf[1] = __builtin_bit_cast(bf16x8, q1);
    }
    const float af = __builtin_amdgcn_exp2f(l2f * (float)i), ab = __builtin_amdgcn_exp2f(-l2b * (float)i), cf = __builtin_amdgcn_exp2f(l2f * (float)(i + 1)), cb = __builtin_amdgcn_exp2f(l2b * (float)(128 - i));
    f32x16 y, zero;
#pragma unroll
    for (int r = 0; r < 16; ++r) { y[r] = 0.f; zero[r] = 0.f; }
    const int koff = r32 * KROW + 16 * hh;
    const int voff = O_V + eb * 8192 + (4 * hh + ((lane & 15) >> 2)) * 64 + ((lane >> 4) & 1) * 32 + (lane & 3) * 8;
#pragma unroll
    for (int kb = 0; kb < 4; ++kb) {
        f32x16 pt;
        if (kb <= qb) {
            f32x16 sF = __builtin_amdgcn_mfma_f32_32x32x16_bf16(*(const bf16x8*)(lds + O_KF + kb * 32 * KROW + koff), qf[0], zero, 0, 0, 0);
            sF = __builtin_amdgcn_mfma_f32_32x32x16_bf16(*(const bf16x8*)(lds + O_KF + kb * 32 * KROW + koff + 32), qf[1], sF, 0, 0, 0);
            if (kb < qb) {
#pragma unroll
                for (int r = 0; r < 16; ++r) pt[r] = sF[r] * af;
            } else {
#pragma unroll
                for (int r = 0; r < 16; ++r) { const int j = (r & 3) + 8 * (r >> 2) + 4 * hh; pt[r] = (j <= r32) ? sF[r] * af : 0.f; }
            }
        }
        if (kb >= qb) {
            f32x16 sB = __builtin_amdgcn_mfma_f32_32x32x16_bf16(*(const bf16x8*)(lds + O_KB + kb * 32 * KROW + koff), qf[0], zero, 0, 0, 0);
            sB = __builtin_amdgcn_mfma_f32_32x32x16_bf16(*(const bf16x8*)(lds + O_KB + kb * 32 * KROW + koff + 32), qf[1], sB, 0, 0, 0);
            if (kb > qb) {
#pragma unroll
                for (int r = 0; r < 16; ++r) pt[r] = sB[r] * ab;
            } else {
#pragma unroll
                for (int r = 0; r < 16; ++r) { const int j = (r & 3) + 8 * (r >> 2) + 4 * hh; pt[r] += (j >= r32) ? sB[r] * ab : 0.f; }
            }
        }
#pragma unroll
        for (int s2 = 0; s2 < 2; ++s2) {
            const u32x4 pw = (u32x4){cvtpk(pt[8 * s2], pt[8 * s2 + 1]), cvtpk(pt[8 * s2 + 2], pt[8 * s2 + 3]), cvtpk(pt[8 * s2 + 4], pt[8 * s2 + 5]), cvtpk(pt[8 * s2 + 6], pt[8 * s2 + 7])};
            const unsigned char* vb = lds + voff + (kb * 32 + s2 * 16) * 64;
            y = __builtin_amdgcn_mfma_f32_32x32x16_bf16(tr8(vb, vb + 8 * 64), __builtin_bit_cast(bf16x8, pw), y, 0, 0, 0);
        }
    }
    {
        const int soff = (eb * 32 + r32) * KROW + 16 * hh;
        f32x16 tF = __builtin_amdgcn_mfma_f32_32x32x16_bf16(*(const bf16x8*)(lds + O_SF + soff), qf[0], zero, 0, 0, 0);
        tF = __builtin_amdgcn_mfma_f32_32x32x16_bf16(*(const bf16x8*)(lds + O_SF + soff + 32), qf[1], tF, 0, 0, 0);
        f32x16 tB = __builtin_amdgcn_mfma_f32_32x32x16_bf16(*(const bf16x8*)(lds + O_SB + soff), qf[0], zero, 0, 0, 0);
        tB = __builtin_amdgcn_mfma_f32_32x32x16_bf16(*(const bf16x8*)(lds + O_SB + soff + 32), qf[1], tB, 0, 0, 0);
#pragma unroll
        for (int r = 0; r < 16; ++r) y[r] += tF[r] * cf + tB[r] * cb;
    }
    float s1 = 0.f, s2 = 0.f;
#pragma unroll
    for (int r = 0; r < 16; ++r) { s1 += y[r]; s2 += y[r] * y[r]; }
    s1 += __shfl_xor(s1, 32); s2 += __shfl_xor(s2, 32);
    float* red = (float*)(lds + O_RED);
    if (hh == 0) { red[(eb * 128 + i) * 2] = s1; red[(eb * 128 + i) * 2 + 1] = s2; }
    __syncthreads();
    s1 = red[i * 2] + red[(128 + i) * 2]; s2 = red[i * 2 + 1] + red[(128 + i) * 2 + 1];
    const float mu = s1 * (1.f / 64.f), var = fmaxf(s2 * (1.f / 64.f) - mu * mu, 0.f), rstd = rsqrtf(var + NORM_EPS);
    bf16_t* orow = (bf16_t*)(p.ws + WS_CC) + (size_t)row * D + 256 + h * 64 + eb * 32 + 4 * hh;
#pragma unroll
    for (int r4 = 0; r4 < 4; ++r4) {
        const u32x2 gz = gzv[r4]; const f32x4 w4 = gwv[r4];
        const float g0 = lo16(gz.x), g1 = hi16(gz.x), g2 = lo16(gz.y), g3 = hi16(gz.y);
        u32x2 o; o.x = cvtpk(siluf(g0) * ((y[4 * r4] - mu) * rstd * w4.x), siluf(g1) * ((y[4 * r4 + 1] - mu) * rstd * w4.y));
        o.y = cvtpk(siluf(g2) * ((y[4 * r4 + 2] - mu) * rstd * w4.z), siluf(g3) * ((y[4 * r4 + 3] - mu) * rstd * w4.w));
        *(u32x2*)(orow + 8 * r4) = o;
    }
    __syncthreads();
}
__device__ __forceinline__ void qkv_proj(unsigned char* lds, const P& p, int L) {
    const float* sskv = (const float*)(p.ws + WS_SS) + (size_t)NTOK * 4;
    const int G = gridDim.x, bid = blockIdx.x;
    {
        bf16_t* Q = (bf16_t*)(p.ws + WS_Q);
        ge::DenseOrder S; S.nM = NTOK / 256; S.nN = 3; S.nwg = S.nM * 3; S.G = G; S.c = bid; S.Bt = (const char*)((const bf16_t*)(p.ws + WS_WUQ) + (size_t)L * 768 * 256); S.btile = (size_t)256 * 256 * 2; S.arow = ZC * 2;
        auto f = [&](const ge::Unit& u, int r, int c, f32x4 v0, f32x4 v1) {
            u32x4 w; w.x = cvtpk(v0.x, v0.y); w.y = cvtpk(v0.z, v0.w); w.z = cvtpk(v1.x, v1.y); w.w = cvtpk(v1.z, v1.w); *(u32x4*)(Q + (size_t)(u.a * 256 + r) * 768 + u.b * 256 + c) = w;
        };
        ge::EpiFn<decltype(f)> E{f};
        ge::gemm_stream<ge::DenseOrder, ge::EpiFn<decltype(f)>, true>((LAS unsigned char*)lds, (const char*)(p.ws + WS_Z) + Z_CQ * 2, 256, S, E);
    }
    {
        bf16_t* Kb = (bf16_t*)(p.ws + WS_K); bf16_t* Vb = (bf16_t*)(p.ws + WS_V);
        ge::DenseOrder S; S.nM = NTOK / 256; S.nN = 4; S.nwg = S.nM * 4; S.G = G; S.c = (bid + 176) % G; S.Bt = (const char*)((const bf16_t*)(p.ws + WS_WUKV) + (size_t)L * 1024 * 256); S.btile = (size_t)256 * 256 * 2; S.arow = ZC * 2;
        struct EpiKV {
            bf16_t* Kb; bf16_t* Vb; const float* sskv;
            __device__ __forceinline__ void operator()(const ge::Acc& acc, const ge::Unit& u, int wr, int wc, int fr, int fq) const {
                float rstd[2][4];
#pragma unroll
                for (int ai = 0; ai < 2; ++ai)
#pragma unroll
                    for (int m = 0; m < 4; ++m) { const f32x4 s4 = *(const f32x4*)(sskv + (size_t)(u.a * 256 + ai * 128 + wr * 64 + m * 16 + fr) * 4); rstd[ai][m] = rsqrtf((s4.x + s4.y + s4.z + s4.w) * (1.f / 128.f) + NORM_EPS); }
#pragma unroll
                for (int ai = 0; ai < 2; ++ai)
#pragma unroll
                    for (int m = 0; m < 4; ++m) {
                        const int row = u.a * 256 + ai * 128 + wr * 64 + m * 16 + fr;
#pragma unroll
                        for (int bj = 0; bj < 2; ++bj) {
                            const int col = u.b * 256 + bj * 128 + wc * 32 + 8 * fq, h = col >> 7, j = col & 127;
                            const f32x4 v0 = acc[ai][bj][m][0] * rstd[ai][m], v1 = acc[ai][bj][m][1] * rstd[ai][m];
                            u32x4 w; w.x = cvtpk(v0.x, v0.y); w.y = cvtpk(v0.z, v0.w); w.z = cvtpk(v1.x, v1.y); w.w = cvtpk(v1.z, v1.w);
                            if (j < 64) *(u32x4*)(Kb + (size_t)row * 768 + h * 96 + j) = w;
                            else *(u32x4*)(Vb + (size_t)row * 512 + h * 64 + (j - 64)) = w;
                        }
                    }
            }
        };
        EpiKV E{Kb, Vb, sskv};
        ge::gemm_stream<ge::DenseOrder, EpiKV, true>((LAS unsigned char*)lds, (const char*)(p.ws + WS_Z) + Z_CKV * 2, 256, S, E);
    }
}
__device__ __forceinline__ void phase_b(unsigned char* lds, const P& p, int L) {
    const int G = gridDim.x, bid = blockIdx.x;
    qkv_proj(lds, p, L);
    const int nconv = (L == 0) ? 576 : 512;
    const int nkv = 288 * 4;
    const int total = nconv + nkv;
    for (int u = (bid + 96) % G; u < total; u += G) {
        int r = u;
        if (r < nconv) { if (r < 512) conv_unit(lds, p, L, r >> 5, r & 31); else conv_unit(lds, p, L, 16 + ((r - 512) >> 2), (r - 512) & 3); continue; } r -= nconv;
        retkv_unit_mfma(lds, p, L, r >> 2, r & 3);
    }
    if (L == 1) convert_expert_weights(lds, p, 1);
}

__device__ __forceinline__ void attn_unit_naive(unsigned char* lds, const P& p, int b, int h, int qb, bool ctxq) {
    float* Ks = (float*)lds;
    float* Vs = Ks + 64 * 96;
    const int tid = threadIdx.x, half = tid & 1, qi = tid >> 1;
    const bf16_t* Qb = (const bf16_t*)(p.ws + WS_Q); const bf16_t* Kb = (const bf16_t*)(p.ws + WS_K); const bf16_t* Vb = (const bf16_t*)(p.ws + WS_V);
    const int qrow = ctxq ? NLAT + b * CTXL + qi : b * SEQ + qb * 256 + qi;
    float q[48];
    {
        const u32x4* qp = (const u32x4*)(Qb + (size_t)qrow * 768 + h * 96 + half * 48);
#pragma unroll
        for (int i = 0; i < 6; ++i) { const u32x4 w = qp[i];
#pragma unroll
            for (int k = 0; k < 4; ++k) { q[i * 8 + 2 * k] = lo16(w[k]); q[i * 8 + 2 * k + 1] = hi16(w[k]); } }
    }
    float o[32];
#pragma unroll
    for (int e = 0; e < 32; ++e) o[e] = 0.f;
    float m = -1e30f, l = 0.f;
    const int ntiles = ctxq ? 4 : 36;
#pragma unroll 1
    for (int t = 0; t < ntiles; ++t) {
        const int krow0 = t < 4 ? NLAT + b * CTXL + t * 64 : b * SEQ + (t - 4) * 64;
        __syncthreads();
        for (int i = tid; i < 64 * 12; i += NTHREADS) { const int key = i / 12, c = i % 12; const u32x4 w = *(const u32x4*)(Kb + (size_t)(krow0 + key) * 768 + h * 96 + c * 8);
            float* d = Ks + key * 96 + c * 8;
#pragma unroll
            for (int k = 0; k < 4; ++k) { d[2 * k] = lo16(w[k]); d[2 * k + 1] = hi16(w[k]); } }
        for (int i = tid; i < 64 * 8; i += NTHREADS) { const int key = i >> 3, c = i & 7; const u32x4 w = *(const u32x4*)(Vb + (size_t)(krow0 + key) * 512 + h * 64 + c * 8);
            float* d = Vs + key * 64 + c * 8;
#pragma unroll
            for (int k = 0; k < 4; ++k) { d[2 * k] = lo16(w[k]); d[2 * k + 1] = hi16(w[k]); } }
        __syncthreads();
#pragma unroll 1
        for (int j0 = 0; j0 < 64; j0 += 2) {
            float s[2]; float mt = -1e30f;
#pragma unroll
            for (int jj = 0; jj < 2; ++jj) {
                const f32x4* kr = (const f32x4*)(Ks + (j0 + jj) * 96 + half * 48);
                float a = 0.f;
#pragma unroll
                for (int d4 = 0; d4 < 12; ++d4) { const f32x4 kv = kr[d4]; a += q[4 * d4] * kv.x + q[4 * d4 + 1] * kv.y + q[4 * d4 + 2] * kv.z + q[4 * d4 + 3] * kv.w; }
                a += __shfl_xor(a, 1);
                s[jj] = a; mt = fmaxf(mt, a);
            }
            const float mn = fmaxf(m, mt), alpha = exp2f(m - mn);
            m = mn; l *= alpha;
#pragma unroll
            for (int e = 0; e < 32; ++e) o[e] *= alpha;
#pragma unroll
            for (int jj = 0; jj < 2; ++jj) {
                const float pj = exp2f(s[jj] - mn); l += pj;
                const f32x4* vr = (const f32x4*)(Vs + (j0 + jj) * 64 + half * 32);
#pragma unroll
                for (int e4 = 0; e4 < 8; ++e4) { const f32x4 vv = vr[e4]; o[4 * e4] += pj * vv.x; o[4 * e4 + 1] += pj * vv.y; o[4 * e4 + 2] += pj * vv.z; o[4 * e4 + 3] += pj * vv.w; }
            }
        }
    }
    {
        const float rl = 1.f / l;
        u32x4* op = (u32x4*)((bf16_t*)(p.ws + WS_CC) + (size_t)qrow * D + 512 + h * 64 + half * 32);
#pragma unroll
        for (int i = 0; i < 4; ++i) { u32x4 w; w.x = pk2(o[8 * i] * rl, o[8 * i + 1] * rl); w.y = pk2(o[8 * i + 2] * rl, o[8 * i + 3] * rl); w.z = pk2(o[8 * i + 4] * rl, o[8 * i + 5] * rl); w.w = pk2(o[8 * i + 6] * rl, o[8 * i + 7] * rl); op[i] = w; }
    }
    __syncthreads();
}
__device__ __forceinline__ float max3f(float a, float b, float c) { float r; asm("v_max3_f32 %0, %1, %2, %3" : "=v"(r) : "v"(a), "v"(b), "v"(c)); return r; }
constexpr int AT_KROW = 208;
constexpr int AT_KBUF = 64 * AT_KROW;
constexpr int AT_VBUF = 8192;
constexpr int AT_BUF = AT_KBUF + AT_VBUF;
constexpr int AT_NSLOT = 6, AT_AHEAD = 3;
static_assert(AT_NSLOT * AT_BUF <= 131072, "attention ring");
#ifndef AT_GRP
#define AT_GRP(w) ((w) >> 2)
#endif
__device__ __forceinline__ void attn_unit_mfma(unsigned char* lds, const P& p, int b, int h, int qb, bool ctxq) {
    const int tid = threadIdx.x, lane = tid & 63, wid = tid >> 6, r32 = lane & 31, hh = lane >> 5;
    const bf16_t* Qb = (const bf16_t*)(p.ws + WS_Q); const bf16_t* Kb = (const bf16_t*)(p.ws + WS_K); const bf16_t* Vb = (const bf16_t*)(p.ws + WS_V);
    const int qrow = (ctxq ? NLAT + b * CTXL : b * SEQ + qb * 256) + wid * 32 + r32;
    f32x16 o0, o1, negm;
#pragma unroll
    for (int r = 0; r < 16; ++r) { o0[r] = 0.f; o1[r] = 0.f; negm[r] = 0.f; }
    asm volatile("" : "+v"(negm));
    float mhat = 0.f, l = 0.f;
    const int ntiles = ctxq ? 4 : 36;
    const int wv = __builtin_amdgcn_readfirstlane(wid);
    const int ia = wv, ib = (wv + 8 < 13) ? wv + 8 : 12;
    const int qa = ia * 64 + lane, qb2 = ib * 64 + lane, qv = wv * 64 + lane;
    const int ca = qa % 13, cb = qb2 % 13;
    const size_t ka = (size_t)(qa / 13) * 768 + h * 96 + (ca < 12 ? ca : 11) * 8, kbo = (size_t)(qb2 / 13) * 768 + h * 96 + (cb < 12 ? cb : 11) * 8;
    const size_t vo = (size_t)((qv >> 2) & 63) * 512 + h * 64 + (qv >> 8) * 32 + (qv & 3) * 8;
    auto krow0 = [&](int t) { return t < 4 ? NLAT + b * CTXL + t * 64 : b * SEQ + (t - 4) * 64; };
    const unsigned lds0 = (unsigned)(uintptr_t)lds;
#define AT_GLDS(gp, ldsoff) do { unsigned keep_; asm volatile("s_mov_b32 %0, m0\n\ts_mov_b32 m0, %2\n\ts_nop 0\n\tglobal_load_lds_dwordx4 %1, off\n\ts_mov_b32 m0, %0" : "=&s"(keep_) : "v"(gp), "s"((unsigned)__builtin_amdgcn_readfirstlane(lds0 + (unsigned)(ldsoff))) : "memory"); } while (0)
#define AT_ISSUE(t2, slot) do { const int kr_ = krow0(t2); const bf16_t* kb_ = Kb + (size_t)kr_ * 768; const bf16_t* vb_ = Vb + (size_t)kr_ * 512; \
        AT_GLDS(kb_ + ka, (slot) + ia * 1024); AT_GLDS(kb_ + kbo, (slot) + ib * 1024); AT_GLDS(vb_ + vo, (slot) + AT_KBUF + wv * 1024); } while (0)
#define AT_SB() __builtin_amdgcn_sched_barrier(0)
#define AT_PIN(x) asm volatile("" : "+v"(x))
#define AT_NEXT(x) ((x) == (AT_NSLOT - 1) * AT_BUF ? 0 : (x) + AT_BUF)
    __builtin_amdgcn_s_barrier();
    AT_ISSUE(0, 0); AT_ISSUE(1, AT_BUF); AT_ISSUE(2, 2 * AT_BUF);
    bf16x8 qf[6];
    {
        const f32x4 s4 = *(const f32x4*)((const float*)(p.ws + WS_SS) + (size_t)qrow * 4);
        const float rstd = rsqrtf((s4.x + s4.y + s4.z + s4.w) * (1.f / 256.f) + NORM_EPS);
        const float* ct = (const float*)(p.ws + WS_ROPE) + (qrow & (SEQ - 1)) * 16; const float* st = ct + 2048 * 16;
#pragma unroll
        for (int s = 0; s < 6; ++s) {
            const u32x4 w = *(const u32x4*)(Qb + (size_t)qrow * 768 + h * 96 + 16 * s + 8 * hh);
            float x[8];
#pragma unroll
            for (int k = 0; k < 4; ++k) { x[2 * k] = lo16(w[k]) * rstd; x[2 * k + 1] = hi16(w[k]) * rstd; }
            if (s >= 4 && !ctxq) {
                const f32x4 c4 = *(const f32x4*)(ct + 8 * (s - 4) + 4 * hh), sn = *(const f32x4*)(st + 8 * (s - 4) + 4 * hh);
#pragma unroll
                for (int k = 0; k < 4; ++k) { const float a = x[2 * k], b2 = x[2 * k + 1]; x[2 * k] = a * c4[k] - b2 * sn[k]; x[2 * k + 1] = a * sn[k] + b2 * c4[k]; }
            }
            const u32x4 o = (u32x4){cvtpk(x[0], x[1]), cvtpk(x[2], x[3]), cvtpk(x[4], x[5]), cvtpk(x[6], x[7])};
            qf[s] = __builtin_bit_cast(bf16x8, o);
        }
    }
    const int koff = r32 * AT_KROW + 16 * hh;
    const int voff = AT_KBUF + (4 * hh + ((lane & 15) >> 2)) * 64 + ((lane >> 4) & 1) * 32 + (lane & 3) * 8;
#define AT_WAIT(n) do { if ((n) >= 2) asm volatile("s_waitcnt vmcnt(6)" ::: "memory"); else if ((n) == 1) asm volatile("s_waitcnt vmcnt(3)" ::: "memory"); else asm volatile("s_waitcnt vmcnt(0)" ::: "memory"); } while (0)
#define AT_EVEN() do { __builtin_amdgcn_s_barrier(); asm volatile("" ::: "memory"); } while (0)
#define AT_ODD(t) do { if ((t) + 1 < ntiles) AT_WAIT(ntiles - 2 - (t)); __builtin_amdgcn_s_barrier(); asm volatile("" ::: "memory"); \
        if ((t) + AT_AHEAD < ntiles) AT_ISSUE((t) + AT_AHEAD, s_iss); s_iss = AT_NEXT(s_iss); } while (0)
#define AT_DECIDE(C0, C1) do { \
        asm volatile("s_nop 15\n\ts_nop 7" : "+v"(C0), "+v"(C1)); \
        float rma = max3f(C0[0], C0[1], C1[0]), rmb = max3f(C0[2], C0[3], C1[1]); rma = max3f(rma, C1[2], C1[3]); \
        _Pragma("unroll") for (int r = 4; r < 16; r += 4) { rma = max3f(rma, C0[r], C0[r + 1]); rmb = max3f(rmb, C0[r + 2], C0[r + 3]); rma = max3f(rma, C1[r], C1[r + 1]); rmb = max3f(rmb, C1[r + 2], C1[r + 3]); } \
        float rm = fmaxf(rma, rmb); rm = fmaxf(rm, __shfl_xor(rm, 32)); \
        resc = false; \
        if (__any(rm > 8.f)) { const float dl = fmaxf(rm, 0.f); fres = __builtin_amdgcn_exp2f(-dl); mhat += dl; l *= fres; resc = true; \
            _Pragma("unroll") for (int r = 0; r < 16; ++r) { C0[r] -= dl; C1[r] -= dl; negm[r] = -mhat; } \
            asm volatile("" : "+v"(negm)); } \
    } while (0)
#define AT_MFS(kfrag, s_, C, first) C = __builtin_amdgcn_mfma_f32_32x32x16_bf16(kfrag, qf[s_], (first) ? negm : C, 0, 0, 0)
#define AT_KF(bk_, g) (*(const bf16x8*)((bk_) + koff + ((g) & 1) * 32 * AT_KROW + ((g) >> 1) * 32))
#define AT_S(C0, C1, P0, P1, bk, bv) do { \
        bf16x8 kf[12]; float sacc = 0.f; \
        kf[0] = AT_KF(bk, 0); kf[1] = AT_KF(bk, 1); kf[2] = AT_KF(bk, 2); kf[3] = AT_KF(bk, 3); \
        AT_SB(); \
        AT_MFS(kf[0], 0, C0, true);  kf[4] = AT_KF(bk, 4);  sacc += (P0[0] + P0[1]) + (P0[2] + P0[3]); pw[0].x = cvtpk(P0[0], P0[1]); pw[0].y = cvtpk(P0[2], P0[3]); AT_PIN(sacc); AT_PIN(pw[0]); AT_SB(); \
        AT_MFS(kf[1], 0, C1, true);  kf[5] = AT_KF(bk, 5);  sacc += (P0[4] + P0[5]) + (P0[6] + P0[7]); pw[0].z = cvtpk(P0[4], P0[5]); pw[0].w = cvtpk(P0[6], P0[7]); AT_PIN(sacc); AT_PIN(pw[0]); AT_SB(); \
        AT_MFS(kf[2], 1, C0, false); kf[6] = AT_KF(bk, 6);  sacc += (P0[8] + P0[9]) + (P0[10] + P0[11]); pw[1].x = cvtpk(P0[8], P0[9]); pw[1].y = cvtpk(P0[10], P0[11]); AT_PIN(sacc); AT_PIN(pw[1]); AT_SB(); \
        AT_MFS(kf[3], 1, C1, false); kf[7] = AT_KF(bk, 7);  sacc += (P0[12] + P0[13]) + (P0[14] + P0[15]); pw[1].z = cvtpk(P0[12], P0[13]); pw[1].w = cvtpk(P0[14], P0[15]); AT_PIN(sacc); AT_PIN(pw[1]); AT_SB(); \
        AT_MFS(kf[4], 2, C0, false); kf[8] = AT_KF(bk, 8);  sacc += (P1[0] + P1[1]) + (P1[2] + P1[3]); pw[2].x = cvtpk(P1[0], P1[1]); pw[2].y = cvtpk(P1[2], P1[3]); AT_PIN(sacc); AT_PIN(pw[2]); AT_SB(); \
        AT_MFS(kf[5], 2, C1, false); kf[9] = AT_KF(bk, 9);  sacc += (P1[4] + P1[5]) + (P1[6] + P1[7]); pw[2].z = cvtpk(P1[4], P1[5]); pw[2].w = cvtpk(P1[6], P1[7]); AT_PIN(sacc); AT_PIN(pw[2]); AT_SB(); \
        AT_MFS(kf[6], 3, C0, false); kf[10] = AT_KF(bk, 10); sacc += (P1[8] + P1[9]) + (P1[10] + P1[11]); pw[3].x = cvtpk(P1[8], P1[9]); pw[3].y = cvtpk(P1[10], P1[11]); AT_PIN(sacc); AT_PIN(pw[3]); AT_SB(); \
        AT_MFS(kf[7], 3, C1, false); kf[11] = AT_KF(bk, 11); sacc += (P1[12] + P1[13]) + (P1[14] + P1[15]); pw[3].z = cvtpk(P1[12], P1[13]); pw[3].w = cvtpk(P1[14], P1[15]); AT_PIN(sacc); AT_PIN(pw[3]); AT_SB(); \
        AT_MFS(kf[8], 4, C0, false); { const unsigned char* vb_ = (bv) + voff; vfa[0] = tr8(vb_, vb_ + 512); } AT_SB(); \
        AT_MFS(kf[9], 4, C1, false); { const unsigned char* vb_ = (bv) + voff; vfc[0] = tr8(vb_ + 4096, vb_ + 4608); } AT_SB(); \
        AT_MFS(kf[10], 5, C0, false); { const unsigned char* vb_ = (bv) + voff + 1024; vfa[1] = tr8(vb_, vb_ + 512); } AT_SB(); \
        AT_MFS(kf[11], 5, C1, false); { const unsigned char* vb_ = (bv) + voff + 1024; vfc[1] = tr8(vb_ + 4096, vb_ + 4608); } AT_SB(); \
        l += sacc; \
        AT_DECIDE(C0, C1); \
        AT_SB(); \
    } while (0)
#define AT_PV(C0, C1, bv) do { \
        AT_SB(); \
        { const unsigned char* vb_ = (bv) + voff + 2048; vfa[2] = tr8(vb_, vb_ + 512); vfc[2] = tr8(vb_ + 4096, vb_ + 4608); } \
        o0 = __builtin_amdgcn_mfma_f32_32x32x16_bf16(vfa[0], __builtin_bit_cast(bf16x8, pw[0]), o0, 0, 0, 0); C0[0] = __builtin_amdgcn_exp2f(C0[0]); C0[1] = __builtin_amdgcn_exp2f(C0[1]); C0[2] = __builtin_amdgcn_exp2f(C0[2]); C0[3] = __builtin_amdgcn_exp2f(C0[3]); AT_PIN(C0); AT_SB(); \
        o1 = __builtin_amdgcn_mfma_f32_32x32x16_bf16(vfc[0], __builtin_bit_cast(bf16x8, pw[0]), o1, 0, 0, 0); C0[4] = __builtin_amdgcn_exp2f(C0[4]); C0[5] = __builtin_amdgcn_exp2f(C0[5]); C0[6] = __builtin_amdgcn_exp2f(C0[6]); C0[7] = __builtin_amdgcn_exp2f(C0[7]); AT_PIN(C0); \
        { const unsigned char* vb_ = (bv) + voff + 3072; vfa[3] = tr8(vb_, vb_ + 512); vfc[3] = tr8(vb_ + 4096, vb_ + 4608); } AT_SB(); \
        o0 = __builtin_amdgcn_mfma_f32_32x32x16_bf16(vfa[1], __builtin_bit_cast(bf16x8, pw[1]), o0, 0, 0, 0); C0[8] = __builtin_amdgcn_exp2f(C0[8]); C0[9] = __builtin_amdgcn_exp2f(C0[9]); C0[10] = __builtin_amdgcn_exp2f(C0[10]); C0[11] = __builtin_amdgcn_exp2f(C0[11]); AT_PIN(C0); AT_SB(); \
        o1 = __builtin_amdgcn_mfma_f32_32x32x16_bf16(vfc[1], __builtin_bit_cast(bf16x8, pw[1]), o1, 0, 0, 0); C0[12] = __builtin_amdgcn_exp2f(C0[12]); C0[13] = __builtin_amdgcn_exp2f(C0[13]); C0[14] = __builtin_amdgcn_exp2f(C0[14]); C0[15] = __builtin_amdgcn_exp2f(C0[15]); AT_PIN(C0); AT_SB(); \
        o0 = __builtin_amdgcn_mfma_f32_32x32x16_bf16(vfa[2], __builtin_bit_cast(bf16x8, pw[2]), o0, 0, 0, 0); C1[0] = __builtin_amdgcn_exp2f(C1[0]); C1[1] = __builtin_amdgcn_exp2f(C1[1]); C1[2] = __builtin_amdgcn_exp2f(C1[2]); C1[3] = __builtin_amdgcn_exp2f(C1[3]); AT_PIN(C1); AT_SB(); \
        o1 = __builtin_amdgcn_mfma_f32_32x32x16_bf16(vfc[2], __builtin_bit_cast(bf16x8, pw[2]), o1, 0, 0, 0); C1[4] = __builtin_amdgcn_exp2f(C1[4]); C1[5] = __builtin_amdgcn_exp2f(C1[5]); C1[6] = __builtin_amdgcn_exp2f(C1[6]); C1[7] = __builtin_amdgcn_exp2f(C1[7]); AT_PIN(C1); AT_SB(); \
        o0 = __builtin_amdgcn_mfma_f32_32x32x16_bf16(vfa[3], __builtin_bit_cast(bf16x8, pw[3]), o0, 0, 0, 0); C1[8] = __builtin_amdgcn_exp2f(C1[8]); C1[9] = __builtin_amdgcn_exp2f(C1[9]); C1[10] = __builtin_amdgcn_exp2f(C1[10]); C1[11] = __builtin_amdgcn_exp2f(C1[11]); AT_PIN(C1); AT_SB(); \
        o1 = __builtin_amdgcn_mfma_f32_32x32x16_bf16(vfc[3], __builtin_bit_cast(bf16x8, pw[3]), o1, 0, 0, 0); C1[12] = __builtin_amdgcn_exp2f(C1[12]); C1[13] = __builtin_amdgcn_exp2f(C1[13]); C1[14] = __builtin_amdgcn_exp2f(C1[14]); C1[15] = __builtin_amdgcn_exp2f(C1[15]); AT_PIN(C1); AT_SB(); \
        if (resc) { _Pragma("unroll") for (int r = 0; r < 16; ++r) { o0[r] *= fres; o1[r] *= fres; } } \
    } while (0)
#define AT_S0(C0, C1, bk) do { \
        _Pragma("unroll") for (int s_ = 0; s_ < 6; ++s_) { \
            const bf16x8 k0f = *(const bf16x8*)((bk) + koff + 32 * s_), k1f = *(const bf16x8*)((bk) + koff + 32 * AT_KROW + 32 * s_); \
            C0 = __builtin_amdgcn_mfma_f32_32x32x16_bf16(k0f, qf[s_], s_ == 0 ? negm : C0, 0, 0, 0); \
            C1 = __builtin_amdgcn_mfma_f32_32x32x16_bf16(k1f, qf[s_], s_ == 0 ? negm : C1, 0, 0, 0); } \
        AT_DECIDE(C0, C1); } while (0)
#define AT_E0(C0, C1) do { _Pragma("unroll") for (int r = 0; r < 16; ++r) { C0[r] = __builtin_amdgcn_exp2f(C0[r]); C1[r] = __builtin_amdgcn_exp2f(C1[r]); } } while (0)
#define AT_DRAIN(P0, P1, bvp) do { \
        float sacc = 0.f; \
        _Pragma("unroll") for (int r = 0; r < 16; ++r) sacc += P0[r] + P1[r]; \
        l += sacc; \
        _Pragma("unroll") for (int s2 = 0; s2 < 2; ++s2) { \
            pw[s2] = (u32x4){cvtpk(P0[8 * s2], P0[8 * s2 + 1]), cvtpk(P0[8 * s2 + 2], P0[8 * s2 + 3]), cvtpk(P0[8 * s2 + 4], P0[8 * s2 + 5]), cvtpk(P0[8 * s2 + 6], P0[8 * s2 + 7])}; \
            pw[2 + s2] = (u32x4){cvtpk(P1[8 * s2], P1[8 * s2 + 1]), cvtpk(P1[8 * s2 + 2], P1[8 * s2 + 3]), cvtpk(P1[8 * s2 + 4], P1[8 * s2 + 5]), cvtpk(P1[8 * s2 + 6], P1[8 * s2 + 7])}; } \
        _Pragma("unroll") for (int ks = 0; ks < 4; ++ks) { \
            const unsigned char* vb = (bvp) + voff + ks * 16 * 64; const bf16x8 pf = __builtin_bit_cast(bf16x8, pw[ks]); \
            o0 = __builtin_amdgcn_mfma_f32_32x32x16_bf16(tr8(vb, vb + 8 * 64), pf, o0, 0, 0, 0); \
            o1 = __builtin_amdgcn_mfma_f32_32x32x16_bf16(tr8(vb + 4096, vb + 4096 + 8 * 64), pf, o1, 0, 0, 0); } } while (0)
    f32x16 pA0, pA1, pB0, pB1; bool resc = false; float fres = 1.f;
    bf16x8 vfa[4], vfc[4]; u32x4 pw[4];
    int s_prev = 0, s_cur = 0, s_iss = AT_AHEAD * AT_BUF;
    const int grp = __builtin_amdgcn_readfirstlane(AT_GRP(wid));
#define AT_BAR(t) do { if ((t) < ntiles) AT_WAIT(ntiles - 1 - (t)); __builtin_amdgcn_s_barrier(); asm volatile("" ::: "memory"); \
        if ((t) + AT_AHEAD < ntiles) AT_ISSUE((t) + AT_AHEAD, s_iss); s_iss = AT_NEXT(s_iss); } while (0)
    if (grp == 0) {
        AT_BAR(0);
        AT_S0(pA0, pA1, lds + s_cur);
        AT_E0(pA0, pA1);
        int t = 1;
#pragma unroll 1
        for (; t + 1 < ntiles; t += 2) {
            s_prev = s_cur; s_cur = AT_NEXT(s_cur);
            AT_BAR(t); AT_S(pB0, pB1, pA0, pA1, lds + s_cur, lds + s_prev); AT_PV(pB0, pB1, lds + s_prev);
            s_prev = s_cur; s_cur = AT_NEXT(s_cur);
            AT_BAR(t + 1); AT_S(pA0, pA1, pB0, pB1, lds + s_cur, lds + s_prev); AT_PV(pA0, pA1, lds + s_prev);
        }
        s_prev = s_cur; s_cur = AT_NEXT(s_cur);
        AT_BAR(t); AT_S(pB0, pB1, pA0, pA1, lds + s_cur, lds + s_prev); AT_PV(pB0, pB1, lds + s_prev);
        AT_BAR(t + 1);
        AT_DRAIN(pB0, pB1, lds + s_cur);
    } else {
        AT_BAR(0);
        AT_S0(pA0, pA1, lds + s_cur);
        int t = 1;
        s_prev = s_cur; s_cur = AT_NEXT(s_cur);
        AT_BAR(1); AT_E0(pA0, pA1); AT_S(pB0, pB1, pA0, pA1, lds + s_cur, lds + s_prev);
#pragma unroll 1
        for (t = 2; t + 1 < ntiles; t += 2) {
            AT_BAR(t); AT_PV(pB0, pB1, lds + s_prev);
            s_prev = s_cur; s_cur = AT_NEXT(s_cur);
            AT_S(pA0, pA1, pB0, pB1, lds + s_cur, lds + s_prev);
            AT_BAR(t + 1); AT_PV(pA0, pA1, lds + s_prev);
            s_prev = s_cur; s_cur = AT_NEXT(s_cur);
            AT_S(pB0, pB1, pA0, pA1, lds + s_cur, lds + s_prev);
        }
        AT_BAR(t);
        AT_PV(pB0, pB1, lds + s_prev);
        AT_DRAIN(pB0, pB1, lds + s_cur);
    }
#undef AT_BAR
#undef AT_WAIT
#undef AT_EVEN
#undef AT_ODD
#undef AT_S
#undef AT_PV
#undef AT_S0
#undef AT_E0
#undef AT_DRAIN
#undef AT_GLDS
#undef AT_ISSUE
#undef AT_SB
#undef AT_PIN
#undef AT_NEXT
#undef AT_DECIDE
#undef AT_MFS
#undef AT_KF
    l += __shfl_xor(l, 32);
    const float rl = 1.f / l;
    bf16_t* orow = (bf16_t*)(p.ws + WS_CC) + (size_t)qrow * D + 512 + h * 64 + 4 * hh;
#pragma unroll
    for (int r4 = 0; r4 < 4; ++r4) {
        u32x2 w0; w0.x = cvtpk(o0[4 * r4] * rl, o0[4 * r4 + 1] * rl); w0.y = cvtpk(o0[4 * r4 + 2] * rl, o0[4 * r4 + 3] * rl);
        u32x2 w1; w1.x = cvtpk(o1[4 * r4] * rl, o1[4 * r4 + 1] * rl); w1.y = cvtpk(o1[4 * r4 + 2] * rl, o1[4 * r4 + 3] * rl);
        *(u32x2*)(orow + 8 * r4) = w0; *(u32x2*)(orow + 32 + 8 * r4) = w1;
    }
}
__device__ __forceinline__ void retout_unit(unsigned char* lds, const P& p, int L, int gc, int h) {
    float* qs = (float*)lds; float* ks = qs + 128 * 33; float* vs = ks + 128 * 33; float* Sf = vs + 128 * 64; float* Sb = Sf + 2048;
    const int tid = threadIdx.x;
    const float l2f = log2_gamma(p, L, 0, h), l2b = log2_gamma(p, L, 1, h);
    load_ret_qk(qs, p, gc, h, Z_RQ, 1.f);
    load_ret_qk(ks, p, gc, h, Z_RK, 0.17677669529663687f);
    load_ret_v(vs, p, gc, h);
    {
        const bool lat = gc < 256; const int b = lat ? gc >> 4 : (gc - 256) >> 1;
        const int mme = lat ? 2 + (gc & 15) : (gc - 256) & 1;
        const int u = mme, w = mme < 2 ? 1 - mme : 19 - mme;
        f32x4 sf = (f32x4){0.f, 0.f, 0.f, 0.f}, sb = sf;
        const float* KVb = (const float*)(p.ws + WS_KV);
#pragma unroll 1
        for (int mm = 0; mm < 18; ++mm) {
            const int gcm = mm < 2 ? 256 + b * 2 + mm : b * 16 + (mm - 2);
            const int um = mm, wm = mm < 2 ? 1 - mm : 19 - mm;
            const float* kv = KVb + ((size_t)(gcm * 4 + h) * 2) * 2048 + tid * 4;
            if (um < u) { const float wgt = exp2f(l2f * 128.f * (float)(u - 1 - um)); sf += wgt * *(const f32x4*)kv; }
            if (wm < w) { const float wgt = exp2f(l2b * 128.f * (float)(w - 1 - wm)); sb += wgt * *(const f32x4*)(kv + 2048); }
        }
        *(f32x4*)(Sf + tid * 4) = sf; *(f32x4*)(Sb + tid * 4) = sb;
    }
    __syncthreads();
    const int i = tid >> 2, e0 = (tid & 3) * 16;
    float q[32];
#pragma unroll
    for (int d = 0; d < 32; ++d) q[d] = qs[i * 33 + d];
    float acc[16];
#pragma unroll
    for (int e = 0; e < 16; ++e) acc[e] = 0.f;
#pragma unroll 1
    for (int j = 0; j < 128; ++j) {
        float s = 0.f;
#pragma unroll
        for (int d = 0; d < 32; ++d) s += q[d] * ks[j * 33 + d];
        float wgt = 0.f;
        if (j <= i) wgt += exp2f(l2f * (float)(i - j));
        if (j >= i) wgt += exp2f(l2b * (float)(j - i));
        s *= wgt;
#pragma unroll
        for (int e4 = 0; e4 < 4; ++e4) { const f32x4 v4 = *(const f32x4*)(vs + j * 64 + e0 + 4 * e4); acc[4 * e4] += s * v4.x; acc[4 * e4 + 1] += s * v4.y; acc[4 * e4 + 2] += s * v4.z; acc[4 * e4 + 3] += s * v4.w; }
    }
    {
        const float cf = exp2f(l2f * (float)(i + 1)), cb = exp2f(l2b * (float)(128 - i));
#pragma unroll 2
        for (int d = 0; d < 32; ++d) {
            const float qd = qs[i * 33 + d]; const float qf = qd * cf, qb = qd * cb;
#pragma unroll
            for (int e4 = 0; e4 < 4; ++e4) { const f32x4 a = *(const f32x4*)(Sf + d * 64 + e0 + 4 * e4), bq = *(const f32x4*)(Sb + d * 64 + e0 + 4 * e4);
                acc[4 * e4] += qf * a.x + qb * bq.x; acc[4 * e4 + 1] += qf * a.y + qb * bq.y; acc[4 * e4 + 2] += qf * a.z + qb * bq.z; acc[4 * e4 + 3] += qf * a.w + qb * bq.w; }
        }
    }
    float s1 = 0.f;
#pragma unroll
    for (int e = 0; e < 16; ++e) s1 += acc[e];
    s1 += __shfl_xor(s1, 1); s1 += __shfl_xor(s1, 2);
    const float mu = s1 * (1.f / 64.f);
    float s2 = 0.f;
#pragma unroll
    for (int e = 0; e < 16; ++e) { const float dd = acc[e] - mu; s2 += dd * dd; }
    s2 += __shfl_xor(s2, 1); s2 += __shfl_xor(s2, 2);
    const float rstd = rsqrtf(s2 * (1.f / 64.f) + NORM_EPS);
    const int row = gc * 128 + i;
    const bf16_t* zg = (const bf16_t*)(p.ws + WS_Z) + (size_t)row * ZC + Z_RG + h * 64 + e0;
    const float* gw = p.in[13] + L * 256 + h * 64 + e0;
    const u32x4 g0 = *(const u32x4*)zg, g1 = *(const u32x4*)(zg + 8);
    float g[16];
#pragma unroll
    for (int k = 0; k < 4; ++k) { g[2 * k] = lo16(g0[k]); g[2 * k + 1] = hi16(g0[k]); g[8 + 2 * k] = lo16(g1[k]); g[8 + 2 * k + 1] = hi16(g1[k]); }
    unsigned o[8];
#pragma unroll
    for (int k = 0; k < 8; ++k) {
        const float y0 = siluf(g[2 * k]) * ((acc[2 * k] - mu) * rstd * gw[2 * k]), y1 = siluf(g[2 * k + 1]) * ((acc[2 * k + 1] - mu) * rstd * gw[2 * k + 1]);
        o[k] = pk2(y0, y1);
    }
    u32x4* op = (u32x4*)((bf16_t*)(p.ws + WS_CC) + (size_t)row * D + 256 + h * 64 + e0);
    u32x4 w0; w0.x = o[0]; w0.y = o[1]; w0.z = o[2]; w0.w = o[3]; u32x4 w1; w1.x = o[4]; w1.y = o[5]; w1.z = o[6]; w1.w = o[7];
    op[0] = w0; op[1] = w1;
    __syncthreads();
}
__device__ __forceinline__ void phase_c(unsigned char* lds, const P& p, int L) {
    const int G = gridDim.x, bid = blockIdx.x;
    const int nat = 16 * 8 * 8, nac = (L == 0) ? 128 : 0, nro = (L == 0 ? 288 : 256) * 4;
    const int total = nat + nac + nro;
    const int vcu = (G % 8 == 0) ? (bid % 8) * (G / 8) + bid / 8 : bid;
    int u = vcu;
#pragma unroll 1
    for (; u < nat + nac; u += G) {
        const bool cq = u >= nat; const int r = cq ? u - nat : u;
        attn_unit_mfma(lds, p, cq ? r >> 3 : r >> 6, cq ? r & 7 : (r >> 3) & 7, cq ? 0 : r & 7, cq);
    }
#pragma unroll 1
    for (; u < total; u += G) { const int r = u - nat - nac; retout_unit_mfma(lds, p, L, r >> 2, r & 3); }
    if (L == 0) convert_expert_weights(lds, p, 0);
}

struct EpiY {
    bf16_t* Y; const float* g1;
    __device__ __forceinline__ void operator()(const ge::Acc& acc, const ge::Unit& u, int wr, int wc, int fr, int fq) const {
        const float* gr = g1 + (size_t)mod_row(u.a * 256) * 6144 + u.b * 256 + wc * 32 + 8 * fq;
        f32x4 g[2][2];
#pragma unroll
        for (int bj = 0; bj < 2; ++bj)
#pragma unroll
            for (int n = 0; n < 2; ++n) g[bj][n] = *(const f32x4*)(gr + bj * 128 + n * 4);
#pragma unroll
        for (int ai = 0; ai < 2; ++ai)
#pragma unroll
            for (int m = 0; m < 4; ++m) {
                bf16_t* yr = Y + (size_t)(u.a * 256 + ai * 128 + wr * 64 + m * 16 + fr) * D + u.b * 256 + wc * 32 + 8 * fq;
#pragma unroll
                for (int bj = 0; bj < 2; ++bj) { const f32x4 v0 = acc[ai][bj][m][0] * g[bj][0], v1 = acc[ai][bj][m][1] * g[bj][1];
                    u32x4 w; w.x = cvtpk(v0.x, v0.y); w.y = cvtpk(v0.z, v0.w); w.z = cvtpk(v1.x, v1.y); w.w = cvtpk(v1.z, v1.w); *(u32x4*)(yr + bj * 128) = w; }
            }
    }
};
__device__ __forceinline__ void phase_d(unsigned char* lds, const P& p, int L) {
    ge::DenseOrder S; S.nM = (L == 0 ? NTOK : NLAT) / 256; S.nN = 4; S.nwg = S.nM * 4; S.G = gridDim.x; S.c = blockIdx.x;
    S.Bt = (const char*)((const bf16_t*)(p.ws + WS_WOUT) + (size_t)L * D * D); S.btile = (size_t)256 * D * 2; S.arow = D * 2;
    EpiY E{(bf16_t*)(p.ws + WS_Y), (const float*)(p.ws + WS_MODV) + (size_t)L * 17 * 6144 + 2048};
    ge::gemm_stream<ge::DenseOrder, EpiY, true>((LAS unsigned char*)lds, (const char*)(p.ws + WS_CC), D, S, E);
}

__device__ __forceinline__ void norm_mod_store(const P& p, int L, int which, int tok, int lane, const f32x4 (&v)[4], bf16_t* Hdst) {
    const float* nw = (which == 0 ? p.in[6] : p.in[19]) + L * D;
    const float* mrow = (const float*)(p.ws + WS_MODV) + ((size_t)L * 17 + mod_row(tok)) * 6144 + which * 3072;
    float s = 0.f;
#pragma unroll
    for (int j = 0; j < 4; ++j) s += v[j].x * v[j].x + v[j].y * v[j].y + v[j].z * v[j].z + v[j].w * v[j].w;
    const float rstd = rsqrtf(wave_sum(s) * (1.f / D) + NORM_EPS);
    u32x2* o = (u32x2*)(Hdst + (size_t)tok * D) + lane;
#pragma unroll
    for (int j = 0; j < 4; ++j) {
        const int k = 4 * lane + 256 * j;
        const f32x4 w4 = *(const f32x4*)(nw + k), sh = *(const f32x4*)(mrow + k), sc = *(const f32x4*)(mrow + 1024 + k);
        const f32x4 y = v[j] * rstd * w4 * (sc + 1.f) + sh;
        u32x2 w; w.x = cvtpk(y.x, y.y); w.y = cvtpk(y.z, y.w); o[64 * j] = w;
    }
}
__device__ __forceinline__ int half_n(int L) { return L == 0 ? NTOK / 2 : NLAT / 2; }
__device__ __forceinline__ void phase_router(unsigned char* lds, const P& p, int L) {
    constexpr int O_LG = 41472, O_CNT = 83072, O_SEL = 83584, O_SELW = 87424;
    const bf16_t* H = (const bf16_t*)(p.ws + WS_H); const bf16_t* W = (const bf16_t*)(p.ws + WS_RT) + (size_t)L * 128 * D;
    const bf16_t* Y = (const bf16_t*)(p.ws + WS_Y);
    float* lg = (float*)(lds + O_LG);
    int* lcnt = (int*)(lds + O_CNT);
    int* sel = (int*)(lds + O_SEL);
    float* selw = (float*)(lds + O_SELW);
    int* ltok = (int*)(p.ws + WS_LTOK); float* lw = (float*)(p.ws + WS_LW);
    const int tid = threadIdx.x, lane = tid & 63, wave = tid >> 6;
    const int ntok = (L == 0 ? NTOK : NLAT), TS = (L == 0 ? 144 : 128), nmt = ntok / TS, RW = TS / 8;
    for (int mt = blockIdx.x; mt < nmt; mt += gridDim.x) {
        const int t0 = mt * TS;
        if (tid < 64) lcnt[tid] = 0;
#pragma unroll 3
        for (int q = 0; q < RW; ++q) {
            const int tok = t0 + wave * RW + q;
            const u32x2* yr = (const u32x2*)(Y + (size_t)tok * D) + lane;
            u32x2* xo = (u32x2*)x_row(p, tok) + lane;
            f32x4 v[4];
            if (L == 0) {
                const f32x4* xi = (const f32x4*)x_in_row(p, tok) + lane;
#pragma unroll
                for (int j = 0; j < 4; ++j) { const f32x4 a = xi[64 * j]; const u32x2 y = yr[64 * j]; v[j] = (f32x4){a.x + lo16(y.x), a.y + hi16(y.x), a.z + lo16(y.y), a.w + hi16(y.y)}; }
            } else {
#pragma unroll
                for (int j = 0; j < 4; ++j) { const u32x2 a = xo[64 * j]; const u32x2 y = yr[64 * j]; v[j] = (f32x4){lo16(a.x) + lo16(y.x), hi16(a.x) + hi16(y.x), lo16(a.y) + lo16(y.y), hi16(a.y) + hi16(y.y)}; }
            }
#pragma unroll
            for (int j = 0; j < 4; ++j) { u32x2 w; w.x = cvtpk(v[j].x, v[j].y); w.y = cvtpk(v[j].z, v[j].w); xo[64 * j] = w; }
            norm_mod_store(p, L, 1, tok, lane, v, (bf16_t*)(p.ws + WS_H));
        }
        asm volatile("s_waitcnt vmcnt(0)" ::: "memory");
        __syncthreads();
        auto rs = [&](int pr) { return H + (size_t)(t0 + (pr < TS ? pr : TS - 1)) * D; };
        auto epi = [&](int r, int c, f32x4 v) { if (c < 64) { float* d = lg + r * 65 + c; d[0] = v.x; d[1] = v.y; d[2] = v.z; d[3] = v.w; } };
        gemm_tile<5>(lds, rs, W, D, D, epi);
        __syncthreads();
        if (tid < TS) {
            const float* rbp = p.in[21] + L * NEXP; const float* lrow = lg + tid * 65;
            float bv[6], bs[6]; int bi[6];
#pragma unroll
            for (int k = 0; k < 6; ++k) { bv[k] = -INFINITY; bs[k] = 0.f; bi[k] = 0; }
#pragma unroll 4
            for (int e = 0; e < NEXP; ++e) {
                float sc = __builtin_amdgcn_rcpf(1.f + __expf(-lrow[e])); float sv = sc + rbp[e]; int ei = e;
#pragma unroll
                for (int k = 0; k < 6; ++k) { const bool gt = sv > bv[k]; const float tv = gt ? bv[k] : sv, ts = gt ? bs[k] : sc; const int ti = gt ? bi[k] : ei;
                    bv[k] = gt ? sv : bv[k]; bs[k] = gt ? sc : bs[k]; bi[k] = gt ? ei : bi[k]; sv = tv; sc = ts; ei = ti; }
            }
            const float rs6 = 2.5f / (bs[0] + bs[1] + bs[2] + bs[3] + bs[4] + bs[5]);
#pragma unroll
            for (int k = 0; k < 6; ++k) { const int rank = atomicAdd(&lcnt[bi[k]], 1); sel[tid * 6 + k] = (bi[k] << 8) | rank; selw[tid * 6 + k] = bs[k] * rs6; }
        }
        __syncthreads();
        if (tid < 64) {
            unsigned* ecnt = (unsigned*)(p.ws + WS_CTL) + CW_ECNT + L * 4096;
            const int c = lcnt[tid];
            lcnt[64 + tid] = c ? (int)atomicAdd(ecnt + tid * 64, (unsigned)c) : 0;
        }
        __syncthreads();
        for (int i = tid; i < TS * 6; i += NTHREADS) {
            const int sv = sel[i], e = sv >> 8, pos = lcnt[64 + e] + (sv & 255), tok = t0 + i / 6, k = i % 6;
            ltok[(size_t)e * LCAP + pos] = tok * 8 + k;
            lw[(size_t)e * LCAP + pos] = selw[i];
        }
        __syncthreads();
    }
}

__device__ __forceinline__ void build_etab(unsigned char* lds, const P& p, int L) {
    int* tstart = (int*)(lds + ETAB_OFF); int* cnt = tstart + 80;
    int tix = threadIdx.x; asm volatile("" : "+v"(tix));
    __syncthreads();
    if (tix < 64) { const unsigned* ecnt = (const unsigned*)(p.ws + WS_CTL) + CW_ECNT + L * 4096;
        cnt[tix] = (int)__hip_atomic_load(ecnt + tix * 64, __ATOMIC_RELAXED, __HIP_MEMORY_SCOPE_AGENT); }
    __syncthreads();
    if (tix < 64) {
        const int e = tix, tl = (cnt[e] + 255) >> 8; int inc = tl;
#pragma unroll
        for (int o = 1; o < 64; o <<= 1) { const int v = __shfl_up(inc, o); if (e >= o) inc += v; }
        tstart[e] = inc - tl;
        if (e == 63) { tstart[64] = inc; tstart[65] = inc + (L == 0 ? NTOK : NLAT) / 256; }
    }
    __syncthreads();
}
struct MoeOrder {
    int TT, nN, G, c; const int* tstart; const char* Bexp; size_t bexp; const char* Bsh; size_t btile; const int* rowbuf; unsigned arow; bool ident;
    __device__ __forceinline__ bool next(int i, ge::Unit& u) const {
        const int Lq = i * G + c; if (Lq >= TT * nN) return false;
        const int t = Lq / nN, pn = Lq % nN;
        int lo = 0, hi = 64;
        while (lo < hi) { const int mid = (lo + hi + 1) >> 1; if (tstart[mid] <= t) lo = mid; else hi = mid - 1; }
        const int e = __builtin_amdgcn_readfirstlane(lo);
        u.a = t; u.b = pn; u.c = e; u.d = i;
        u.B = (e < 64 ? Bexp + (size_t)e * bexp : Bsh) + (size_t)pn * btile;
        return true;
    }
    __device__ __forceinline__ unsigned aoff(int i, const ge::Unit& u, int R) const { return (unsigned)(ident ? u.a * 256 + R : rowbuf[i * 256 + R]) * arow; }
};
__device__ __forceinline__ void phase_gateup(unsigned char* lds, const P& p, int L) {
    build_etab(lds, p, L);
    const int* tstart = (const int*)(lds + ETAB_OFF); const int* cnt = tstart + 80;
    int* rowbuf = (int*)(lds + RB0_OFF); float* wbuf = (float*)(lds + RB1_OFF);
    const int* ltok = (const int*)(p.ws + WS_LTOK); const float* lw = (const float*)(p.ws + WS_LW);
    bf16_t* ACT = (bf16_t*)(p.ws + WS_ACT);
    const int G = gridDim.x, bid = blockIdx.x, vcu = (G % 8 == 0) ? (bid % 8) * (G / 8) + bid / 8 : bid;
    MoeOrder S; S.TT = tstart[65]; S.nN = 2; S.G = G; S.c = vcu; S.tstart = tstart; S.Bexp = (const char*)(p.ws + WS_EGU); S.bexp = (size_t)512 * D * 2;
    S.Bsh = (const char*)((const bf16_t*)(p.ws + WS_SHGU) + (size_t)L * 512 * D); S.btile = (size_t)256 * D * 2; S.rowbuf = rowbuf; S.arow = D * 2; S.ident = false;
    {
        int nun = 0; { ge::Unit u; while (nun < 10 && S.next(nun, u)) ++nun; }
        for (int it0 = threadIdx.x; it0 < nun * 256; it0 += NTHREADS * 4) {
            int tokv[4]; float wv4[4];
#pragma unroll
            for (int q = 0; q < 4; ++q) {
                const int item = it0 + q * NTHREADS; tokv[q] = 0; wv4[q] = 0.f;
                if (item < nun * 256) {
                    ge::Unit u; S.next(item >> 8, u);
                    const int R = item & 255, e = u.c, mt = u.a - tstart[e];
                    if (e < 64) { const int lp = mt * 256 + R; if (lp < cnt[e]) { tokv[q] = ltok[(size_t)e * LCAP + lp] >> 3; wv4[q] = lw[(size_t)e * LCAP + lp]; } }
                    else { tokv[q] = mt * 256 + R; wv4[q] = 1.f; }
                }
            }
#pragma unroll
            for (int q = 0; q < 4; ++q) { const int item = it0 + q * NTHREADS; if (item < nun * 256) { rowbuf[item] = tokv[q]; wbuf[item] = wv4[q]; } }
        }
        __syncthreads();
    }
    auto f = [&](const ge::Unit& u, int r, int c, f32x4 v0, f32x4 v1) {
        const float w = wbuf[u.d * 256 + r];
        u32x2 o; o.x = cvtpk(siluf(v0.x) * v0.y * w, siluf(v0.z) * v0.w * w); o.y = cvtpk(siluf(v1.x) * v1.y * w, siluf(v1.z) * v1.w * w);
        *(u32x2*)(ACT + (size_t)(u.a * 256 + r) * EDIM + ((u.b * 256 + c) >> 1)) = o;
    };
    ge::EpiFn<decltype(f)> E{f};
    ge::gemm_stream<MoeOrder, ge::EpiFn<decltype(f)>, true>((LAS unsigned char*)lds, (const char*)(p.ws + WS_H), D, S, E);
}
__device__ __forceinline__ void phase_down(unsigned char* lds, const P& p, int L) {
    build_etab(lds, p, L);
    const int* tstart = (const int*)(lds + ETAB_OFF); const int* cnt = tstart + 80;
    int* sbuf = (int*)(lds + RB0_OFF);
    const int* ltok = (const int*)(p.ws + WS_LTOK);
    unsigned char* SLOT = (unsigned char*)(p.ws + WS_SLOT);
    const int G = gridDim.x, bid = blockIdx.x, vcu = (G % 8 == 0) ? (bid % 8) * (G / 8) + bid / 8 : bid;
    MoeOrder S; S.TT = tstart[65]; S.nN = 4; S.G = G; S.c = vcu; S.tstart = tstart; S.Bexp = (const char*)(p.ws + WS_ED); S.bexp = (size_t)D * EDIM * 2;
    S.Bsh = (const char*)((const bf16_t*)(p.ws + WS_SHD) + (size_t)L * D * EDIM); S.btile = (size_t)256 * EDIM * 2; S.rowbuf = sbuf; S.arow = EDIM * 2; S.ident = true;
    {
        int nun = 0; { ge::Unit u; while (nun < 18 && S.next(nun, u)) ++nun; }
        for (int it0 = threadIdx.x; it0 < nun * 256; it0 += NTHREADS * 4) {
            int sv[4];
#pragma unroll
            for (int q = 0; q < 4; ++q) {
                const int item = it0 + q * NTHREADS; sv[q] = NTOK * 7;
                if (item < nun * 256) {
                    ge::Unit u; S.next(item >> 8, u);
                    const int R = item & 255, e = u.c, mt = u.a - tstart[e];
                    if (e < 64) { const int lp = mt * 256 + R; if (lp < cnt[e]) { const int ent = ltok[(size_t)e * LCAP + lp]; sv[q] = (ent >> 3) * 7 + (ent & 7); } }
                    else sv[q] = (mt * 256 + R) * 7 + 6;
                }
            }
#pragma unroll
            for (int q = 0; q < 4; ++q) { const int item = it0 + q * NTHREADS; if (item < nun * 256) sbuf[item] = sv[q]; }
        }
        __syncthreads();
    }
    auto f = [&](const ge::Unit& u, int r, int c, f32x4 v0, f32x4 v1) {
        const int srow = sbuf[u.d * 256 + r];
        int w0 = 0, w1 = 0;
        w0 = __builtin_amdgcn_cvt_pk_fp8_f32(__builtin_amdgcn_fmed3f(v0.x, -440.f, 440.f), __builtin_amdgcn_fmed3f(v0.y, -440.f, 440.f), w0, false);
        w0 = __builtin_amdgcn_cvt_pk_fp8_f32(__builtin_amdgcn_fmed3f(v0.z, -440.f, 440.f), __builtin_amdgcn_fmed3f(v0.w, -440.f, 440.f), w0, true);
        w1 = __builtin_amdgcn_cvt_pk_fp8_f32(__builtin_amdgcn_fmed3f(v1.x, -440.f, 440.f), __builtin_amdgcn_fmed3f(v1.y, -440.f, 440.f), w1, false);
        w1 = __builtin_amdgcn_cvt_pk_fp8_f32(__builtin_amdgcn_fmed3f(v1.z, -440.f, 440.f), __builtin_amdgcn_fmed3f(v1.w, -440.f, 440.f), w1, true);
        u32x2 w; w.x = (unsigned)w0; w.y = (unsigned)w1; *(u32x2*)(SLOT + (size_t)srow * D + u.b * 256 + c) = w;
    };
    ge::EpiFn<decltype(f)> E{f};
    ge::gemm_stream<MoeOrder, ge::EpiFn<decltype(f)>, true>((LAS unsigned char*)lds, (const char*)(p.ws + WS_ACT), EDIM, S, E);
}
__device__ __forceinline__ void phase_combine(const P& p, int L) {
    const int tid = threadIdx.x, lane = tid & 63, wave = tid >> 6, gw = blockIdx.x * NWAVES + wave, NGW = gridDim.x * NWAVES;
    const unsigned char* SLOT = (const unsigned char*)(p.ws + WS_SLOT);
    const float* modv = (const float*)(p.ws + WS_MODV) + (size_t)L * 17 * 6144;
    const int ntok = (L == 0 ? NTOK : NLAT);
    for (int tok = gw; tok < ntok; tok += NGW) {
        f32x4 acc[4];
#pragma unroll
        for (int j = 0; j < 4; ++j) acc[j] = (f32x4){0.f, 0.f, 0.f, 0.f};
#pragma unroll
        for (int k = 0; k < 7; ++k) {
            const int* sr = (const int*)(SLOT + ((size_t)tok * 7 + k) * D) + lane;
#pragma unroll
            for (int j = 0; j < 4; ++j) { const int w = sr[64 * j]; const f32x2_t a = __builtin_amdgcn_cvt_pk_f32_fp8(w, false), b = __builtin_amdgcn_cvt_pk_f32_fp8(w, true); acc[j].x += a.x; acc[j].y += a.y; acc[j].z += b.x; acc[j].w += b.y; }
        }
        const float* g2 = modv + (size_t)mod_row(tok) * 6144 + 5120;
        u32x2* xr = (u32x2*)x_row(p, tok) + lane;
        f32x4 v[4];
#pragma unroll
        for (int j = 0; j < 4; ++j) { const f32x4 g = *(const f32x4*)(g2 + 4 * lane + 256 * j); const u32x2 a = xr[64 * j];
            v[j] = (f32x4){lo16(a.x), hi16(a.x), lo16(a.y), hi16(a.y)} + g * acc[j]; }
        if (L == 0) {
#pragma unroll
            for (int j = 0; j < 4; ++j) { u32x2 w; w.x = cvtpk(v[j].x, v[j].y); w.y = cvtpk(v[j].z, v[j].w); xr[64 * j] = w; }
            norm_mod_store(p, 1, 0, tok, lane, v, (bf16_t*)(p.ws + WS_H1));
        } else {
            const float* nw = p.in[28]; float s = 0.f;
#pragma unroll
            for (int j = 0; j < 4; ++j) s += v[j].x * v[j].x + v[j].y * v[j].y + v[j].z * v[j].z + v[j].w * v[j].w;
            const float rstd = rsqrtf(wave_sum(s) * (1.f / D) + NORM_EPS);
            f32x4* orow = (f32x4*)(p.out + (size_t)tok * D) + lane;
#pragma unroll
            for (int j = 0; j < 4; ++j) { const f32x4 w4 = *(const f32x4*)(nw + 4 * lane + 256 * j); orow[64 * j] = v[j] * rstd * w4; }
        }
    }
}

constexpr int PH_LAYER0 = 2, PH_PER_LAYER = 8, PH_LAYER1 = PH_LAYER0 + PH_PER_LAYER, NPHASES = PH_LAYER1 + PH_PER_LAYER;

__global__ void __launch_bounds__(NTHREADS, 2) mk_fwd(P p) {
    extern __shared__ __attribute__((aligned(16))) unsigned char lds[];
    volatile LAS unsigned* MISC = (volatile LAS unsigned*)((LAS unsigned char*)lds + MISC_OFF);
    if (threadIdx.x < 64) MISC[threadIdx.x] = 0u;
    __syncthreads();
    unsigned* ctl = (unsigned*)(p.ws + WS_CTL);
    XcdBarrier bar; bar.bar = ctl + CW_BAR; bar.x = 0; bar.st = MISC + 8;
    if (!MK_PER_PHASE) bar = xcd_barrier_post(ctl + CW_BAR, MISC + 8);
    const int lo = p.ph_lo, hi = p.ph_hi;
#ifndef PH_MASK
#define PH_MASK 0xffffu
#endif
#define HAS(b) ((PH_MASK >> (b)) & 1u)
#define IN(k) (lo <= (k) && (k) < hi)
#define SEAM(k) do { if (IN(k) && IN((k) + 1)) xcd_barrier(bar); } while (0)

#ifdef PROBE_MASK
    unsigned long long tacc = 0ull, t0p = 0ull;
#define PT0() t0p = __builtin_amdgcn_s_memrealtime()
#define PT1(b) do { if ((PROBE_MASK >> (b)) & 1u) tacc += __builtin_amdgcn_s_memrealtime() - t0p; } while (0)
#else
#define PT0() do {} while (0)
#define PT1(b) do {} while (0)
#endif
#define PH(b, k, body) do { PT0(); if (HAS(b) && IN(k)) { body; } SEAM(k); PT1(b); } while (0)
    PH(0, 0, phase_prep0(lds, p));
    PH(1, 1, (phase_prep1(lds, p), phase_norm_mod(p, 0, 0, NTOK)));
#define LAYER(L, pb) \
        PH(2, pb + 0, phase_zgemm(lds, p, L)); \
        PH(3, pb + 1, phase_b(lds, p, L)); \
        PH(4, pb + 2, phase_c(lds, p, L)); \
        PH(5, pb + 3, phase_d(lds, p, L)); \
        PH(7, pb + 4, phase_router(lds, p, L)); \
        PH(8, pb + 5, phase_gateup(lds, p, L)); \
        PH(9, pb + 6, phase_down(lds, p, L)); \
        PH(10, pb + 7, phase_combine(p, L));
    LAYER(0, PH_LAYER0)
    LAYER(1, PH_LAYER1)
#ifdef PROBE_MASK
    if (blockIdx.x == 0) {
        const unsigned long long tend = __builtin_amdgcn_s_memrealtime();
        while (__builtin_amdgcn_s_memrealtime() - tend < (unsigned long long)PROBE_AMP * tacc) __builtin_amdgcn_s_sleep(8);
    }
#endif
#undef IN
#undef SEAM
}

extern "C" void kernel_launch(void* const* d_in, const int* in_sizes, int n_in, void* d_out, int out_size, void* d_ws, size_t ws_size, hipStream_t stream) {
    static int grid = 0;
    if (grid == 0) {
        if (n_in != 29 || in_sizes[0] != NLAT * D || out_size != NLAT * D || ws_size < WS_END) {
            fprintf(stderr, "kernel_launch: unexpected shapes / workspace (n_in %d, ws %zu, need %zu); nothing launched\n", n_in, ws_size, (size_t)WS_END); grid = -1; return; }
        int dev = 0, cus = 0, per_cu = 0;
        if (hipGetDevice(&dev) != hipSuccess || hipDeviceGetAttribute(&cus, hipDeviceAttributeMultiprocessorCount, dev) != hipSuccess) { grid = -1; return; }
        if (hipFuncSetAttribute((const void*)mk_fwd, hipFuncAttributeMaxDynamicSharedMemorySize, LDS_BYTES) != hipSuccess) { grid = -1; return; }
        if (hipOccupancyMaxActiveBlocksPerMultiprocessor(&per_cu, (const void*)mk_fwd, NTHREADS, LDS_BYTES) != hipSuccess || per_cu < 1) { fprintf(stderr, "kernel_launch: occupancy query says %d\n", per_cu); }
        (void)hipGetLastError();
        grid = cus;
    }
    if (grid < 0) return;
    (void)hipMemsetAsync((char*)d_ws + WS_CTL, 0, CTL_ZERO_BYTES, stream);
    P a{};
    for (int i = 0; i < 29; ++i) a.in[i] = (const float*)d_in[i];
    a.out = (float*)d_out; a.ws = (unsigned char*)d_ws;
#if MK_PER_PHASE
    for (int ph = 0; ph < NPHASES; ++ph) { a.ph_lo = ph; a.ph_hi = ph + 1; hipLaunchKernelGGL(mk_fwd, dim3(grid), dim3(NTHREADS), LDS_BYTES, stream, a); }
#else
    a.ph_lo = 0; a.ph_hi = NPHASES;
    hipLaunchKernelGGL(mk_fwd, dim3(grid), dim3(NTHREADS), LDS_BYTES, stream, a);
#endif
}
```

```cpp
#include <hip/hip_runtime.h>
#include <cstdio>
#include <cstdint>

#ifndef MK_PER_PHASE
#define MK_PER_PHASE 0
#endif

typedef unsigned short bf16_t;
typedef short bf16x8 __attribute__((ext_vector_type(8)));
typedef float f32x4 __attribute__((ext_vector_type(4)));
typedef unsigned u32x4 __attribute__((ext_vector_type(4)));
typedef unsigned u32x2 __attribute__((ext_vector_type(2)));
typedef float f32x16 __attribute__((ext_vector_type(16)));
typedef short v4i16_t __attribute__((ext_vector_type(4)));
#define LAS __attribute__((address_space(3)))

constexpr int D = 1024, BATCH = 16, SEQ = 2048, CTXL = 256;
constexpr int NLAT = BATCH * SEQ, NCTX = BATCH * CTXL, NTOK = NLAT + NCTX;
constexpr int ZC = 1792;
constexpr int Z_RQ = 512, Z_RK = 640, Z_RV = 768, Z_RG = 1024, Z_CQ = 1280, Z_CKV = 1536, Z_KR = 1664, Z_END = 1696;
constexpr int NEXP = 64, TOPK = 6, EDIM = 256;
constexpr float NORM_EPS = 1e-6f;
constexpr int NTHREADS = 512, NWAVES = 8;

constexpr size_t MiB = 1u << 20;
constexpr size_t WS_CTL = 0, CTL_ZERO_BYTES = 1 * MiB;
constexpr size_t WS_MODV = 1 * MiB;
constexpr size_t WS_ROPE = 2 * MiB;
constexpr size_t WS_WIN = 3 * MiB;
constexpr size_t WS_WUQ = 10 * MiB;
constexpr size_t WS_WUKV = 11 * MiB;
constexpr size_t WS_WOUT = 12 * MiB;
constexpr size_t WS_RT = 16 * MiB;
constexpr size_t WS_SHGU = 17 * MiB;
constexpr size_t WS_SHD = 19 * MiB;
constexpr size_t WS_EGU = 20 * MiB;
constexpr size_t WS_ED = 84 * MiB;
constexpr size_t WS_H1 = 20 * MiB;
constexpr size_t WS_X = 116 * MiB;
constexpr size_t WS_H = 188 * MiB;
constexpr size_t WS_CC = WS_H;
constexpr size_t WS_Z = 260 * MiB;
constexpr size_t WS_Y = WS_Z;
constexpr size_t WS_Q = 386 * MiB;
constexpr size_t WS_K = 440 * MiB;
constexpr size_t WS_V = 494 * MiB;
constexpr size_t WS_KV = 530 * MiB;
constexpr size_t WS_SLOT = 188 * MiB;
constexpr size_t WS_ACT = 441 * MiB;
constexpr size_t WS_LTOK = 583 * MiB;
constexpr size_t WS_LW = 592 * MiB;
constexpr size_t WS_SS = 601 * MiB;
constexpr size_t WS_END = 603 * MiB;
constexpr int LCAP = NTOK;
static_assert(WS_SLOT + ((size_t)NTOK * 7 + 1) * 1024 <= WS_ACT && WS_ACT + (size_t)1136 * 256 * 512 <= WS_LTOK, "MoE buffers");

constexpr int CW_TMO = 0;
constexpr int CW_BAR = 4096;
constexpr int CW_ECNT = 8192;

constexpr int LDS_BYTES = 162816;
constexpr int MISC_OFF = LDS_BYTES - 256;
constexpr int RB0_OFF = 131072;
constexpr int RB1_OFF = 149504;
constexpr int ETAB_OFF = 159744;
constexpr int GEMM_LDS = 36864;
constexpr int ROWSS_OFF = 36864;
constexpr int LG_OFF = 37376;

#define XB_TMO      128
#define XB_XCNT(j)  (256  + 64 * (j))
#define XB_XSUB(j)  (1280 + 64 * (j))
#define XB_XGEN(j)  (2304 + 64 * (j))
#define XB_TOP      3328
#define XB_TOPGEN   3392
#define XCD_BAR_WORDS 3456
#define XB_SPIN_CAP (1u << 24)
__device__ __forceinline__ unsigned xb_ld(unsigned* p)              { return __hip_atomic_load(p, __ATOMIC_RELAXED, __HIP_MEMORY_SCOPE_AGENT); }
__device__ __forceinline__ unsigned xb_add(unsigned* p, unsigned v) { return __hip_atomic_fetch_add(p, v, __ATOMIC_RELAXED, __HIP_MEMORY_SCOPE_AGENT); }
__device__ __forceinline__ unsigned xb_xcc_id() { return (unsigned)__builtin_amdgcn_s_getreg((3 << 11) | 20) & 0xFu; }
#define XB_SPIN(cond, bar) do { unsigned _sp = 0; while (cond) { __builtin_amdgcn_s_sleep(1); \
    if ((++_sp & 255u) == 0u) { if (xb_ld(&(bar)[XB_TMO])) break; if (_sp > XB_SPIN_CAP) { atomicAdd(&(bar)[XB_TMO], 1u); break; } } } } while (0)
struct XcdBarrier { unsigned* bar; unsigned x; volatile LAS unsigned* st; };
__device__ __forceinline__ XcdBarrier xcd_barrier_post(unsigned* bar, volatile LAS unsigned* st) {
    XcdBarrier b; b.bar = bar; b.x = xb_xcc_id(); b.st = st;
    if (threadIdx.x == 0) (void)xb_add(&bar[XB_XCNT(b.x)], 1u);
    return b;
}
__device__ __forceinline__ void xcd_barrier_complete(unsigned* bar, unsigned x, unsigned& nloc, unsigned& nx) {
    const unsigned G = gridDim.x * gridDim.y * gridDim.z;
    unsigned sum, cnt, mine, sp = 0u;
    for (;;) {
        sum = 0u; cnt = 0u; mine = 0u;
#pragma unroll
        for (unsigned j = 0; j < 16; ++j) { const unsigned c = xb_ld(&bar[XB_XCNT(j)]); sum += c; cnt += (c > 0u) ? 1u : 0u; mine = (j == x) ? c : mine; }
        if (sum == G) break;
        __builtin_amdgcn_s_sleep(1);
        if ((++sp & 255u) == 0u) { if (xb_ld(&bar[XB_TMO])) break; if (sp > XB_SPIN_CAP) { atomicAdd(&bar[XB_TMO], 1u); break; } }
    }
    nloc = mine > 0u ? mine : 1u; nx = cnt > 0u ? cnt : 1u;
}
__device__ __forceinline__ void xcd_barrier(const XcdBarrier& b) {
    asm volatile("s_waitcnt vmcnt(0)" ::: "memory");
    __syncthreads();
    if (threadIdx.x == 0) {
        unsigned* bar = b.bar;
        __builtin_amdgcn_s_waitcnt(0);
        unsigned nloc = b.st[0], nx = b.st[1];
        if (nloc == 0u) { xcd_barrier_complete(bar, b.x, nloc, nx); b.st[0] = nloc; b.st[1] = nx; }
        const unsigned old = xb_add(&bar[XB_XSUB(b.x)], 1u);
        const unsigned gen = old / nloc;
        if (old + 1u == (gen + 1u) * nloc) {
            __builtin_amdgcn_fence(__ATOMIC_RELEASE, "agent");
            asm volatile("s_waitcnt vmcnt(0)" ::: "memory");
            const unsigned og = xb_add(&bar[XB_TOP], 1u);
            const unsigned tg = og / nx;
            if (og + 1u == (tg + 1u) * nx) xb_add(&bar[XB_TOPGEN], 1u);
            else XB_SPIN(xb_ld(&bar[XB_TOPGEN]) == tg, bar);
            __builtin_amdgcn_fence(__ATOMIC_ACQUIRE, "agent");
            xb_add(&bar[XB_XGEN(b.x)], 1u);
            asm volatile("s_waitcnt vmcnt(0)" ::: "memory");
        } else {
            XB_SPIN(xb_ld(&bar[XB_XGEN(b.x)]) == gen, bar);
            __builtin_amdgcn_fence(__ATOMIC_ACQUIRE, "agent");
            asm volatile("s_waitcnt vmcnt(0)" ::: "memory");
        }
    }
    __syncthreads();
}

__device__ __forceinline__ float bf2f(unsigned h) { return __uint_as_float(h << 16); }
__device__ __forceinline__ unsigned f2bf(float f) { unsigned u = __float_as_uint(f); return (u + 0x7fffu + ((u >> 16) & 1u)) >> 16; }
__device__ __forceinline__ unsigned pk2(float lo, float hi) { return f2bf(lo) | (f2bf(hi) << 16); }
typedef float f32x2_t __attribute__((ext_vector_type(2)));
typedef __bf16 bf16x2_t __attribute__((ext_vector_type(2)));
__device__ __forceinline__ unsigned cvtpk(float lo, float hi) { f32x2_t v = {lo, hi}; bf16x2_t b = __builtin_convertvector(v, bf16x2_t); return __builtin_bit_cast(unsigned, b); }
__device__ __forceinline__ float lo16(unsigned w) { return __uint_as_float(w << 16); }
__device__ __forceinline__ float hi16(unsigned w) { return __uint_as_float(w & 0xffff0000u); }
__device__ __forceinline__ float wave_sum(float v) {
#pragma unroll
    for (int o = 1; o < 64; o <<= 1) v += __shfl_xor(v, o);
    return v;
}
__device__ __forceinline__ float siluf(float v) { return v * __builtin_amdgcn_rcpf(1.f + __expf(-v)); }
__device__ __forceinline__ int mod_row(int tok) { return tok < NLAT ? (tok >> 11) : 16; }

struct P { const float* in[29]; float* out; unsigned char* ws; int ph_lo, ph_hi; };

__device__ __forceinline__ bf16_t* x_row(const P& p, int tok) { return (bf16_t*)(p.ws + WS_X) + (size_t)tok * D; }
__device__ __forceinline__ const float* x_in_row(const P& p, int tok) {
    return tok < NLAT ? p.in[0] + (size_t)tok * D : p.in[2] + (size_t)(tok - NLAT) * D;
}

template <int MF, class RowSrc, class Epi>
__device__ __forceinline__ void gemm_tile(unsigned char* lds, const RowSrc& rs, const bf16_t* Bt, int ldb, int K, const Epi& epi) {
    constexpr int ROWS = 32 * MF, NPA = ROWS * 8;
    const int tid = threadIdx.x, lane = tid & 63, wid = tid >> 6, wr = wid >> 2, wc = wid & 3, fr = lane & 15, fq = lane >> 4;
    bf16_t* As = (bf16_t*)lds; bf16_t* Bs = As + ROWS * 72;
    const bf16_t* ap[3]; int al[3];
#pragma unroll
    for (int i = 0; i < 3; ++i) { const int id = tid + 512 * i, r = id >> 3, c = (id & 7) * 8; ap[i] = (id < NPA) ? rs(r) + c : nullptr; al[i] = r * 72 + c; }
    const int lr = tid >> 2, lc = (tid & 3) * 16;
    const bf16_t* bp = Bt + (size_t)lr * ldb + lc;
    u32x4 a[3], b0 = *(const u32x4*)bp, b1 = *(const u32x4*)(bp + 8);
#pragma unroll
    for (int i = 0; i < 3; ++i) if (ap[i]) a[i] = *(const u32x4*)ap[i];
    f32x4 acc[MF][2];
#pragma unroll
    for (int m = 0; m < MF; ++m)
#pragma unroll
        for (int n = 0; n < 2; ++n) acc[m][n] = (f32x4){0.f, 0.f, 0.f, 0.f};
    for (int k0 = 0; k0 < K; k0 += 64) {
        __syncthreads();
#pragma unroll
        for (int i = 0; i < 3; ++i) if (ap[i]) *(u32x4*)(As + al[i]) = a[i];
        *(u32x4*)(Bs + lr * 72 + lc) = b0; *(u32x4*)(Bs + lr * 72 + lc + 8) = b1;
        __syncthreads();
        if (k0 + 64 < K) {
#pragma unroll
            for (int i = 0; i < 3; ++i) if (ap[i]) { ap[i] += 64; a[i] = *(const u32x4*)ap[i]; }
            bp += 64; b0 = *(const u32x4*)bp; b1 = *(const u32x4*)(bp + 8);
        }
#pragma unroll
        for (int kk = 0; kk < 2; ++kk) {
            bf16x8 af[MF], bfr[2];
#pragma unroll
            for (int m = 0; m < MF; ++m) af[m] = *(const bf16x8*)(As + (wr * 16 * MF + m * 16 + fr) * 72 + kk * 32 + fq * 8);
#pragma unroll
            for (int n = 0; n < 2; ++n) bfr[n] = *(const bf16x8*)(Bs + (wc * 32 + n * 16 + fr) * 72 + kk * 32 + fq * 8);
#pragma unroll
            for (int m = 0; m < MF; ++m)
#pragma unroll
                for (int n = 0; n < 2; ++n) acc[m][n] = __builtin_amdgcn_mfma_f32_16x16x32_bf16(bfr[n], af[m], acc[m][n], 0, 0, 0);
        }
    }
#pragma unroll
    for (int m = 0; m < MF; ++m)
#pragma unroll
        for (int n = 0; n < 2; ++n) epi(wr * 16 * MF + m * 16 + fr, wc * 32 + n * 16 + 4 * fq, acc[m][n]);
}

namespace ge {
constexpr int BM = 256, BK = 64, HALF = 128, HTB = HALF * BK * 2;
__device__ __forceinline__ int lds_byte(int r, int c) { const int st = (r >> 4) * 2 + (c >> 5), rr = r & 15, cc = c & 31, ob = rr * 64 + cc * 2; return st * 1024 + (ob ^ (((ob >> 9) & 1) << 5)); }
__device__ __forceinline__ void stage_rc(int b, int& R, int& C) { const int st = b / 1024, sb = b % 1024, swz = sb ^ (((sb >> 9) & 1) << 5); R = (st >> 1) * 16 + swz / 64; C = (st & 1) * 32 + (swz % 64) / 2; }
struct Unit { const char* B; int a, b, c, d; };
typedef f32x4 Acc[2][2][4][2];

template <class Sched, class Epi, bool ALIGN_EPI>
__device__ __forceinline__ void gemm_stream(LAS unsigned char* lds, const char* Ab, int K, const Sched& S, const Epi& E) {
    const int tid = threadIdx.x, wid = __builtin_amdgcn_readfirstlane(tid >> 6), lane = tid & 63, wr = wid >> 2, wc = wid & 3, fr = lane & 15, fq = lane >> 4;
    const int nt = K / BK;
    int Rr[2], Cc[2]; unsigned voffB[2];
#pragma unroll
    for (int i = 0; i < 2; ++i) { stage_rc(tid * 16 + i * 8192, Rr[i], Cc[i]);
        const int rho = Rr[i] & 31, Rb = (Rr[i] & ~31) + 8 * ((rho & 15) >> 2) + 4 * (rho >> 4) + (rho & 3);
        voffB[i] = (unsigned)(Rb * K + Cc[i]) * 2u; }
    const size_t kstep = (size_t)(BK * 2), hstepB = (size_t)HALF * K * 2;
    const unsigned ldsw = (unsigned)wid * 1024u;
    const int aoff = lds_byte(wr * 64 + fr, fq * 8), boff = lds_byte(wc * 32 + fr, fq * 8);
#define GE_SA(b, h) (((b) * 2 + (h)) * HTB)
#define GE_SB(b, h) ((4 + (b) * 2 + (h)) * HTB)
#define GE_GLDS(gp, ldsoff) __builtin_amdgcn_global_load_lds((const unsigned*)(gp), (LAS unsigned*)(lds + (ldsoff)), 16, 0, 0)
#define GE_STAGE_B(bufoff, gbase) do { GE_GLDS((const char*)(gbase) + voffB[0], (bufoff) + ldsw); GE_GLDS((const char*)(gbase) + voffB[1], (bufoff) + ldsw + 8192); } while (0)
#define GE_STAGE_A(bufoff, kbytes, o0, o1) do { GE_GLDS(Ab + (kbytes) + (o0), (bufoff) + ldsw); GE_GLDS(Ab + (kbytes) + (o1), (bufoff) + ldsw + 8192); } while (0)
#define GE_LDA(dst, b, h) do { _Pragma("unroll") for (int m = 0; m < 4; ++m) _Pragma("unroll") for (int k = 0; k < 2; ++k) dst[m][k] = *(const LAS bf16x8*)(lds + GE_SA(b, h) + aoff + m * 2048 + k * 1024); } while (0)
#define GE_LDB(dst, b, h) do { _Pragma("unroll") for (int n = 0; n < 2; ++n) _Pragma("unroll") for (int k = 0; k < 2; ++k) dst[n][k] = *(const LAS bf16x8*)(lds + GE_SB(b, h) + boff + n * 2048 + k * 1024); } while (0)
#define GE_MMA(ai, bj, At, Bt) do { __builtin_amdgcn_s_setprio(1); _Pragma("unroll") for (int m = 0; m < 4; ++m) _Pragma("unroll") for (int n = 0; n < 2; ++n) _Pragma("unroll") for (int k = 0; k < 2; ++k) \
        acc[ai][bj][m][n] = __builtin_amdgcn_mfma_f32_16x16x32_bf16(Bt[n][k], At[m][k], acc[ai][bj][m][n], 0, 0, 0); __builtin_amdgcn_s_setprio(0); } while (0)
#define GE_WAIT_V(n) asm volatile("s_waitcnt vmcnt(" #n ")" ::: "memory")
#define GE_WAIT_L(n) asm volatile("s_waitcnt lgkmcnt(" #n ")" ::: "memory")
#define GE_BAR __builtin_amdgcn_s_barrier()
#define GE_SCHED __builtin_amdgcn_sched_barrier(0)
    Unit cur, nxt; int ui = 0;
    if (!S.next(0, cur)) return;
    Acc acc;
#pragma unroll
    for (int a = 0; a < 2; ++a)
#pragma unroll
        for (int b = 0; b < 2; ++b)
#pragma unroll
            for (int m = 0; m < 4; ++m)
#pragma unroll
                for (int n = 0; n < 2; ++n) acc[a][b][m][n] = (f32x4){0.f, 0.f, 0.f, 0.f};
    bf16x8 At[4][2], B0[2][2], B1[2][2];
    unsigned oc00, oc01, oc10, oc11, on00, on01, on10, on11;
    oc00 = S.aoff(0, cur, Rr[0]) + (unsigned)Cc[0] * 2u; oc01 = S.aoff(0, cur, Rr[1]) + (unsigned)Cc[1] * 2u;
    oc10 = S.aoff(0, cur, Rr[0] + 128) + (unsigned)Cc[0] * 2u; oc11 = S.aoff(0, cur, Rr[1] + 128) + (unsigned)Cc[1] * 2u;
    const char* cB = cur.B;
    GE_STAGE_B(GE_SB(0, 0), cB); GE_STAGE_B(GE_SB(0, 1), cB + hstepB); GE_STAGE_A(GE_SA(0, 0), 0, oc00, oc01); GE_STAGE_A(GE_SA(0, 1), 0, oc10, oc11);
    if (wr == 1) GE_BAR;
    GE_WAIT_V(2); GE_BAR;
    GE_STAGE_B(GE_SB(1, 0), cB + kstep); GE_STAGE_A(GE_SA(1, 0), kstep, oc00, oc01); GE_STAGE_B(GE_SB(1, 1), cB + hstepB + kstep);
    GE_WAIT_V(6); GE_BAR;
    for (;;) {
        const bool has_next = S.next(ui + 1, nxt);
        const char* nB = has_next ? nxt.B : cB;
        if (has_next) {
            on00 = S.aoff(ui + 1, nxt, Rr[0]) + (unsigned)Cc[0] * 2u; on01 = S.aoff(ui + 1, nxt, Rr[1]) + (unsigned)Cc[1] * 2u;
            on10 = S.aoff(ui + 1, nxt, Rr[0] + 128) + (unsigned)Cc[0] * 2u; on11 = S.aoff(ui + 1, nxt, Rr[1] + 128) + (unsigned)Cc[1] * 2u;
        } else { on00 = oc00; on01 = oc01; on10 = oc10; on11 = oc11; }
#pragma unroll 1
        for (int t = 0; t < nt; t += 2) {
            const bool last = (t == nt - 2);
            const size_t k1 = (size_t)(t + 1) * kstep;
            const size_t k2 = last ? 0 : (size_t)(t + 2) * kstep, k3 = k2 + kstep;
            const char* b2 = last ? nB : cB + (size_t)(t + 2) * kstep; const char* b3 = b2 + kstep;
            const unsigned o00 = last ? on00 : oc00, o01 = last ? on01 : oc01, o10 = last ? on10 : oc10, o11 = last ? on11 : oc11;
            GE_LDB(B0, 0, 0); GE_LDB(B1, 0, 1); GE_SCHED; GE_LDA(At, 0, 0); GE_STAGE_A(GE_SA(1, 1), k1, oc10, oc11);
            GE_WAIT_V(8); GE_WAIT_L(0); GE_BAR; GE_MMA(0, 0, At, B0); GE_MMA(0, 1, At, B1); GE_BAR; GE_SCHED;
            GE_LDA(At, 0, 1); GE_STAGE_B(GE_SB(0, 0), b2); GE_STAGE_B(GE_SB(0, 1), b2 + hstepB); GE_STAGE_A(GE_SA(0, 0), k2, o00, o01);
            GE_WAIT_V(8); GE_WAIT_L(0); GE_BAR; GE_MMA(1, 0, At, B0); GE_MMA(1, 1, At, B1); GE_BAR; GE_SCHED;
            GE_LDB(B0, 1, 0); GE_LDB(B1, 1, 1); GE_SCHED; GE_LDA(At, 1, 0); GE_STAGE_A(GE_SA(0, 1), k2, o10, o11);
            GE_WAIT_V(8); GE_WAIT_L(0); GE_BAR; GE_MMA(0, 0, At, B0); GE_MMA(0, 1, At, B1); GE_BAR; GE_SCHED;
            GE_LDA(At, 1, 1); GE_STAGE_B(GE_SB(1, 0), b3); GE_STAGE_B(GE_SB(1, 1), b3 + hstepB); GE_STAGE_A(GE_SA(1, 0), k3, o00, o01);
            GE_WAIT_V(8); GE_WAIT_L(0); GE_BAR; GE_MMA(1, 0, At, B0); GE_MMA(1, 1, At, B1); GE_BAR; GE_SCHED;
        }
        if constexpr (ALIGN_EPI) { if (wr == 0) GE_BAR; }
        E(acc, cur, wr, wc, fr, fq);
        if (!has_next) break;
#pragma unroll
        for (int a = 0; a < 2; ++a)
#pragma unroll
            for (int b = 0; b < 2; ++b)
#pragma unroll
                for (int m = 0; m < 4; ++m)
#pragma unroll
                    for (int n = 0; n < 2; ++n) acc[a][b][m][n] = (f32x4){0.f, 0.f, 0.f, 0.f};
        cur = nxt; cB = nB; ++ui; oc00 = on00; oc01 = on01; oc10 = on10; oc11 = on11;
        if constexpr (ALIGN_EPI) { if (wr == 1) GE_BAR; }
    }
    GE_WAIT_V(0);
    if constexpr (!ALIGN_EPI) { if (wr == 0) GE_BAR; }
    GE_BAR;
#undef GE_SA
#undef GE_SB
#undef GE_GLDS
#undef GE_STAGE_A
#undef GE_STAGE_B
#undef GE_LDA
#undef GE_LDB
#undef GE_MMA
#undef GE_WAIT_V
#undef GE_WAIT_L
#undef GE_BAR
#undef GE_SCHED
}
template <class F> struct EpiFn {
    F f;
    __device__ __forceinline__ void operator()(const Acc& acc, const Unit& u, int wr, int wc, int fr, int fq) const {
#pragma unroll
        for (int ai = 0; ai < 2; ++ai)
#pragma unroll
            for (int m = 0; m < 4; ++m)
#pragma unroll
                for (int bj = 0; bj < 2; ++bj) f(u, ai * 128 + wr * 64 + m * 16 + fr, bj * 128 + wc * 32 + 8 * fq, acc[ai][bj][m][0], acc[ai][bj][m][1]);
    }
};
struct DenseOrder {
    int nM, nN, nwg, G, c; const char* Bt; size_t btile; unsigned arow;
    __device__ __forceinline__ bool next(int i, Unit& u) const {
        const long L = (long)i * G + c; if (L >= nwg) return false;
        int wgid = (int)L; { const int q = nwg / 8, r = nwg % 8, xcd = wgid % 8, off = wgid / 8; wgid = (xcd < r ? xcd * (q + 1) : r * (q + 1) + (xcd - r) * q) + off; }
        const int nig = 8 * nN, gid = wgid / nig, fm = gid * 8, gsz = (nM - fm) < 8 ? (nM - fm) : 8;
        u.a = fm + ((wgid % nig) % gsz); u.b = (wgid % nig) / gsz; u.c = 0; u.d = 0; u.B = Bt + (size_t)u.b * btile; return true;
    }
    __device__ __forceinline__ unsigned aoff(int, const Unit& u, int R) const { return (unsigned)(u.a * 256 + R) * arow; }
};
}

struct TMap { const float* s0; const float* s1; int ld; int nvalid; const float* ksc; float gsc; };
template <int MODE> __device__ __forceinline__ const float* tmap_src(const float* s0, const float* s1, int nvalid, int n) {
    if (MODE == 0) return n < nvalid ? s0 + n : nullptr;
    if (MODE == 1) { const int h = n / 96, j = n % 96; const int c = j < 64 ? j : 64 + ((j - 64) & 1) * 16 + ((j - 64) >> 1); return s0 + h * 96 + c; }
    return ((n & 1) ? s1 : s0) + (n >> 1);
}
template <int MODE> __device__ __forceinline__ void transpose_unit(float* scr, const float* s0, const float* s1, int ld, int nvalid, const float* ksc, float gsc, int K, bf16_t* dst, int kb, int nb, int kvalid = 1 << 30) {
    const int tid = threadIdx.x, k0 = kb * 64, n0 = nb * 64;
    const int nn = tid & 63; const float* sp = tmap_src<MODE>(s0, s1, nvalid, n0 + nn);
#pragma unroll
    for (int i = 0; i < 8; ++i) {
        const int kk = (tid >> 6) + 8 * i; float v = (sp && k0 + kk < kvalid) ? sp[(size_t)(k0 + kk) * ld] : 0.f;
        if (ksc && k0 + kk < kvalid) v *= ksc[k0 + kk];
        scr[kk * 65 + nn] = v * gsc;
    }
    __syncthreads();
    {
        const int n2 = tid >> 3, kc = tid & 7; const float* s = scr + (kc * 8) * 65 + n2;
        u32x4 o; o.x = pk2(s[0], s[65]); o.y = pk2(s[2 * 65], s[3 * 65]); o.z = pk2(s[4 * 65], s[5 * 65]); o.w = pk2(s[6 * 65], s[7 * 65]);
        *(u32x4*)(dst + (size_t)(n0 + n2) * K + k0 + kc * 8) = o;
    }
    __syncthreads();
}
template <int MODE> __device__ __forceinline__ void transpose_matrix(float* scr, const float* s0, const float* s1, int ld, int nvalid, const float* ksc, float gsc, int K, int Nd, bf16_t* dst, int& rot, int kvalid = 1 << 30) {
    const int nkb = K / 64, nnb = Nd / 64, nu = nkb * nnb, G = gridDim.x;
    int first = ((int)blockIdx.x - rot) % G; if (first < 0) first += G;
    for (int u = first; u < nu; u += G) transpose_unit<MODE>(scr, s0, s1, ld, nvalid, ksc, gsc, K, dst, u / nnb, u % nnb, kvalid);
    rot = (rot + nu) % G;
}
__device__ __forceinline__ void convert_expert_weights(unsigned char* lds, const P& p, int L) {
    float* scr = (float*)lds; const int G = gridDim.x, tid = threadIdx.x;
    constexpr int S = 261;
    bf16_t* egu = (bf16_t*)(p.ws + WS_EGU); bf16_t* ed = (bf16_t*)(p.ws + WS_ED);
    for (int ub = blockIdx.x; ub < NEXP * 48; ub += G) {
        const int e = ub / 48, r = (ub % 48) * 4;
        bf16_t* dst; int K, k0;
        if (r < 128) {
            const int kb = r >> 3, nb0 = r & 7; k0 = kb * 64; K = D; dst = egu + ((size_t)e * 512 + nb0 * 64) * D;
            const float* gsrc = p.in[22] + ((size_t)L * NEXP + e) * D * EDIM + nb0 * 32; const float* usrc = p.in[23] + ((size_t)L * NEXP + e) * D * EDIM + nb0 * 32;
            f32x4 v[8];
#pragma unroll
            for (int i = 0; i < 8; ++i) { const int idx = tid + 512 * i, kk = idx >> 6, c = idx & 63; v[i] = *(const f32x4*)((c < 32 ? gsrc : usrc) + (size_t)(k0 + kk) * EDIM + (c & 31) * 4); }
#pragma unroll
            for (int i = 0; i < 8; ++i) { const int idx = tid + 512 * i, kk = idx >> 6, c = idx & 63; float* d = scr + kk * S + 8 * (c & 31) + (c >> 5);
                d[0] = v[i].x; d[2] = v[i].y; d[4] = v[i].z; d[6] = v[i].w; }
        } else {
            const int r2 = r - 128, kb = r2 >> 4, nb0 = r2 & 15; k0 = kb * 64; K = EDIM; dst = ed + ((size_t)e * D + nb0 * 64) * EDIM;
            const float* src = p.in[24] + ((size_t)L * NEXP + e) * EDIM * D + nb0 * 64;
            f32x4 v[8];
#pragma unroll
            for (int i = 0; i < 8; ++i) { const int idx = tid + 512 * i, kk = idx >> 6, c = idx & 63; v[i] = *(const f32x4*)(src + (size_t)(k0 + kk) * D + c * 4); }
#pragma unroll
            for (int i = 0; i < 8; ++i) { const int idx = tid + 512 * i, kk = idx >> 6, c = idx & 63; float* d = scr + kk * S + 4 * c;
                d[0] = v[i].x; d[1] = v[i].y; d[2] = v[i].z; d[3] = v[i].w; }
        }
        __syncthreads();
#pragma unroll
        for (int i = 0; i < 4; ++i) {
            const int id = tid + 512 * i, n = id >> 3, kc = id & 7; const float* sp = scr + (kc * 8) * S + n;
            u32x4 o; o.x = cvtpk(sp[0], sp[S]); o.y = cvtpk(sp[2 * S], sp[3 * S]); o.z = cvtpk(sp[4 * S], sp[5 * S]); o.w = cvtpk(sp[6 * S], sp[7 * S]);
            *(u32x4*)(dst + (size_t)n * K + k0 + kc * 8) = o;
        }
        __syncthreads();
    }
}
__device__ __forceinline__ void prep_mod_unit(unsigned char* lds, const P& p, int u) {
    float* sc = (float*)lds;
    float* part = sc + 17 * 1024;
    const int tid = threadIdx.x;
    const float* c = p.in[1]; const float* cctx = p.in[3];
    for (int i = tid; i < 17 * 1024; i += NTHREADS) { const int r = i >> 10, k = i & 1023; const float v = r < 16 ? c[r * 1024 + k] : cctx[k]; sc[i] = v * __builtin_amdgcn_rcpf(1.f + __expf(-v)); }
    __syncthreads();
    const int L = u / 192, cg = u % 192, ks = tid >> 5, cl = tid & 31, col = cg * 32 + cl;
    const float* w = p.in[4] + (size_t)L * 1024 * 6144 + (size_t)(ks * 64) * 6144 + col;
    float acc[17];
#pragma unroll
    for (int r = 0; r < 17; ++r) acc[r] = 0.f;
#pragma unroll 8
    for (int k = 0; k < 64; ++k) {
        const float wv = w[(size_t)k * 6144];
#pragma unroll
        for (int r = 0; r < 17; ++r) acc[r] += sc[r * 1024 + ks * 64 + k] * wv;
    }
#pragma unroll
    for (int r = 0; r < 17; ++r) part[(ks * 17 + r) * 32 + cl] = acc[r];
    __syncthreads();
    float* modv = (float*)(p.ws + WS_MODV);
    for (int i = tid; i < 17 * 32; i += NTHREADS) {
        const int r = i >> 5, c2 = i & 31;
        float s2 = p.in[5][L * 6144 + cg * 32 + c2];
#pragma unroll
        for (int q = 0; q < 16; ++q) s2 += part[(q * 17 + r) * 32 + c2];
        modv[((size_t)L * 17 + r) * 6144 + cg * 32 + c2] = s2;
    }
    __syncthreads();
}
__device__ __forceinline__ void phase_prep0(unsigned char* lds, const P& p) {
    const int tid = threadIdx.x, G = gridDim.x, bid = blockIdx.x;
    {
        float* ct = (float*)(p.ws + WS_ROPE); float* st = ct + 2048 * 16;
        for (int i = bid * NTHREADS + tid; i < 2048 * 16; i += G * NTHREADS) {
            const int pos = i >> 4, f = i & 15;
            const float inv = powf(10000.f, -(float)(f & 7) / 8.f);
            const float ang = (float)(f < 8 ? (pos >> 6) : (pos & 63)) * inv;
            ct[i] = cosf(ang); st[i] = sinf(ang);
        }
    }
    for (int u = bid; u < 384; u += G) prep_mod_unit(lds, p, u);
}
__device__ __forceinline__ void phase_prep1(unsigned char* lds, const P& p) {
    float* scr = (float*)lds; int rot = 0;
    for (int L = 0; L < 2; ++L) {
        transpose_matrix<0>(scr, p.in[7] + (size_t)L * D * Z_END, nullptr, Z_END, Z_END, nullptr, 1.f, D, ZC, (bf16_t*)(p.ws + WS_WIN) + (size_t)L * ZC * D, rot);
        transpose_matrix<1>(scr, p.in[15] + (size_t)L * 256 * 768, nullptr, 768, 768, p.in[14] + L * 256, 0.14724574f, 256, 768, (bf16_t*)(p.ws + WS_WUQ) + (size_t)L * 768 * 256, rot);
        transpose_matrix<0>(scr, p.in[17] + (size_t)L * 128 * 1024, nullptr, 1024, 1024, p.in[16] + L * 128, 1.f, 256, 1024, (bf16_t*)(p.ws + WS_WUKV) + (size_t)L * 1024 * 256, rot, 128);
        transpose_matrix<0>(scr, p.in[18] + (size_t)L * D * D, nullptr, D, D, nullptr, 1.f, D, D, (bf16_t*)(p.ws + WS_WOUT) + (size_t)L * D * D, rot);
        transpose_matrix<0>(scr, p.in[20] + (size_t)L * D * NEXP, nullptr, NEXP, NEXP, nullptr, 1.f, D, 128, (bf16_t*)(p.ws + WS_RT) + (size_t)L * 128 * D, rot);
        transpose_matrix<2>(scr, p.in[25] + (size_t)L * D * EDIM, p.in[26] + (size_t)L * D * EDIM, EDIM, 512, nullptr, 1.f, D, 512, (bf16_t*)(p.ws + WS_SHGU) + (size_t)L * 512 * D, rot);
        transpose_matrix<0>(scr, p.in[27] + (size_t)L * EDIM * D, nullptr, D, D, nullptr, 1.f, EDIM, D, (bf16_t*)(p.ws + WS_SHD) + (size_t)L * D * EDIM, rot);
    }
}

__device__ __forceinline__ void phase_norm_mod(const P& p, int L, int which  , int ntok) {
    const int tid = threadIdx.x, lane = tid & 63, wave = tid >> 6, gw = blockIdx.x * NWAVES + wave, NGW = gridDim.x * NWAVES;
    const float* nw = (which == 0 ? p.in[6] : p.in[19]) + L * D;
    const float* modv = (const float*)(p.ws + WS_MODV) + (size_t)L * 17 * 6144;
    bf16_t* H = (bf16_t*)(p.ws + WS_H);
    for (int tok = gw; tok < ntok; tok += NGW) {
        const f32x4* xr = (const f32x4*)x_in_row(p, tok) + lane;
        const float* mrow = modv + (size_t)mod_row(tok) * 6144 + which * 3072;
        f32x4 v[4]; float s = 0.f;
#pragma unroll
        for (int j = 0; j < 4; ++j) { v[j] = xr[64 * j]; s += v[j].x * v[j].x + v[j].y * v[j].y + v[j].z * v[j].z + v[j].w * v[j].w; }
        const float rstd = rsqrtf(wave_sum(s) * (1.f / D) + NORM_EPS);
        u32x2* o = (u32x2*)(H + (size_t)tok * D) + lane;
#pragma unroll
        for (int j = 0; j < 4; ++j) {
            const int k = 4 * lane + 256 * j;
            const f32x4 w4 = *(const f32x4*)(nw + k), sh = *(const f32x4*)(mrow + k), sc = *(const f32x4*)(mrow + 1024 + k);
            const float y0 = v[j].x * rstd * w4.x * (1.f + sc.x) + sh.x, y1 = v[j].y * rstd * w4.y * (1.f + sc.y) + sh.y;
            const float y2 = v[j].z * rstd * w4.z * (1.f + sc.z) + sh.z, y3 = v[j].w * rstd * w4.w * (1.f + sc.w) + sh.w;
            u32x2 w; w.x = pk2(y0, y1); w.y = pk2(y2, y3); o[64 * j] = w;
        }
    }
}

struct EpiZ {
    bf16_t* Z; float* ssq; float* sskv; bf16_t* Kb; const float* ct; const float* st;
    __device__ __forceinline__ void operator()(const ge::Acc& acc, const ge::Unit& u, int wr, int wc, int fr, int fq) const {
#pragma unroll
        for (int ai = 0; ai < 2; ++ai)
#pragma unroll
            for (int m = 0; m < 4; ++m) {
                const int row = u.a * 256 + ai * 128 + wr * 64 + m * 16 + fr;
#pragma unroll
                for (int bj = 0; bj < 2; ++bj) {
                    const f32x4 v0 = acc[ai][bj][m][0], v1 = acc[ai][bj][m][1];
                    u32x4 w; w.x = cvtpk(v0.x, v0.y); w.y = cvtpk(v0.z, v0.w); w.z = cvtpk(v1.x, v1.y); w.w = cvtpk(v1.z, v1.w);
                    *(u32x4*)(Z + (size_t)row * ZC + u.b * 256 + bj * 128 + wc * 32 + 8 * fq) = w;
                }
                if (u.b == 5) {
                    float sq = 0.f;
#pragma unroll
                    for (int bj = 0; bj < 2; ++bj)
#pragma unroll
                        for (int n = 0; n < 2; ++n) { const f32x4 v = acc[ai][bj][m][n]; sq += v.x * v.x + v.y * v.y + v.z * v.z + v.w * v.w; }
                    sq += __shfl_xor(sq, 16); sq += __shfl_xor(sq, 32);
                    if (fq == 0) ssq[(size_t)row * 4 + wc] = sq;
                }
                if (u.b == 6) {
                    float sq = 0.f;
#pragma unroll
                    for (int n = 0; n < 2; ++n) { const f32x4 v = acc[ai][0][m][n]; sq += v.x * v.x + v.y * v.y + v.z * v.z + v.w * v.w; }
                    sq += __shfl_xor(sq, 16); sq += __shfl_xor(sq, 32);
                    if (fq == 0) sskv[(size_t)row * 4 + wc] = sq;
                    if (wc == 0) {
                        const f32x4 a0 = acc[ai][1][m][0], a1 = acc[ai][1][m][1];
                        f32x4 b0, b1;
#pragma unroll
                        for (int j = 0; j < 4; ++j) { b0[j] = __shfl_xor(a0[j], 32); b1[j] = __shfl_xor(a1[j], 32); }
                        if (fq < 2) {
                            f32x4 c0 = (f32x4){1.f, 1.f, 1.f, 1.f}, c1 = c0, s0 = (f32x4){0.f, 0.f, 0.f, 0.f}, s1 = s0;
                            if (row < NLAT) { const int pos = row & (SEQ - 1); c0 = *(const f32x4*)(ct + pos * 16 + 8 * fq); c1 = *(const f32x4*)(ct + pos * 16 + 8 * fq + 4); s0 = *(const f32x4*)(st + pos * 16 + 8 * fq); s1 = *(const f32x4*)(st + pos * 16 + 8 * fq + 4); }
                            const f32x4 o10 = a0 * c0 - b0 * s0, o20 = a0 * s0 + b0 * c0, o11 = a1 * c1 - b1 * s1, o21 = a1 * s1 + b1 * c1;
                            u32x4 w0, w1; w0.x = cvtpk(o10.x, o20.x); w0.y = cvtpk(o10.y, o20.y); w0.z = cvtpk(o10.z, o20.z); w0.w = cvtpk(o10.w, o20.w);
                            w1.x = cvtpk(o11.x, o21.x); w1.y = cvtpk(o11.y, o21.y); w1.z = cvtpk(o11.z, o21.z); w1.w = cvtpk(o11.w, o21.w);
#pragma unroll
                            for (int h = 0; h < 8; ++h) { bf16_t* kp = Kb + (size_t)row * 768 + h * 96 + 64 + 16 * fq; *(u32x4*)kp = w0; *(u32x4*)(kp + 8) = w1; }
                        }
                    }
                }
            }
    }
};
__device__ __forceinline__ void phase_zgemm(unsigned char* lds, const P& p, int L) {
    const bf16_t* W = (const bf16_t*)(p.ws + WS_WIN) + (size_t)L * ZC * D;
    ge::DenseOrder S; S.nM = NTOK / 256; S.nN = ZC / 256; S.nwg = S.nM * S.nN; S.G = gridDim.x; S.c = blockIdx.x; S.Bt = (const char*)W; S.btile = (size_t)256 * D * 2; S.arow = D * 2;
    EpiZ E{(bf16_t*)(p.ws + WS_Z), (float*)(p.ws + WS_SS), (float*)(p.ws + WS_SS) + (size_t)NTOK * 4, (bf16_t*)(p.ws + WS_K), (const float*)(p.ws + WS_ROPE), (const float*)(p.ws + WS_ROPE) + 2048 * 16};
    ge::gemm_stream<ge::DenseOrder, EpiZ, true>((LAS unsigned char*)lds, (const char*)(p.ws + (L == 0 ? WS_H : WS_H1)), D, S, E);
}

__device__ __forceinline__ void conv_unit(unsigned char* lds, const P& p, int L, int s, int tt) {
    float* hg = (float*)lds;
    const int tid = threadIdx.x, lane = tid & 63, wave = tid >> 6;
    const int rb = s < 16 ? s * SEQ : NLAT + (s - 16) * CTXL, len = s < 16 ? SEQ : CTXL, t0 = tt * 64;
    const bf16_t* Z = (const bf16_t*)(p.ws + WS_Z);
    {
        u32x2 av[12], gv[12];
#pragma unroll
        for (int q = 0; q < 12; ++q) {
            const int i = tid + q * NTHREADS, jj = i >> 6, c4 = (i & 63) * 4; int t = t0 - 15 + jj; t = t < 0 ? 0 : (t >= len ? len - 1 : t);
            const bf16_t* zr = Z + (size_t)(rb + t) * ZC;
            av[q] = *(const u32x2*)(zr + c4); gv[q] = *(const u32x2*)(zr + 256 + c4);
        }
#pragma unroll
        for (int q = 0; q < 12; ++q) {
            const int i = tid + q * NTHREADS, jj = i >> 6, c4 = (i & 63) * 4, t = t0 - 15 + jj;
            if (i < 94 * 64) {
                f32x4 h = (f32x4){0.f, 0.f, 0.f, 0.f};
                if (t >= 0 && t < len) {
                    const u32x2 a = av[q], g = gv[q];
                    h.x = lo16(a.x) * __builtin_amdgcn_rcpf(1.f + __expf(-lo16(g.x))); h.y = hi16(a.x) * __builtin_amdgcn_rcpf(1.f + __expf(-hi16(g.x)));
                    h.z = lo16(a.y) * __builtin_amdgcn_rcpf(1.f + __expf(-lo16(g.y))); h.w = hi16(a.y) * __builtin_amdgcn_rcpf(1.f + __expf(-hi16(g.y)));
                }
                *(f32x4*)(hg + jj * 256 + c4) = h;
            }
        }
    }
    float* wl = hg + 94 * 256;
    for (int i = tid; i < 31 * 64; i += NTHREADS) *(f32x4*)(wl + i * 4) = *(const f32x4*)(p.in[8] + (size_t)L * 31 * 256 + i * 4);
    __syncthreads();
    const int c0 = lane * 4;
    const f32x4 cb = *(const f32x4*)(p.in[9] + L * 256 + c0), lw = *(const f32x4*)(p.in[10] + L * 256 + c0), lb = *(const f32x4*)(p.in[11] + L * 256 + c0);
    bf16_t* CC = (bf16_t*)(p.ws + WS_CC);
    {
        f32x4 w[31];
#pragma unroll
        for (int j = 0; j < 31; ++j) w[j] = *(const f32x4*)(wl + j * 256 + c0);
#pragma unroll 1
        for (int half = 0; half < 2; ++half) {
            f32x4 acc[4];
#pragma unroll
            for (int q = 0; q < 4; ++q) acc[q] = cb;
            const float* hrow = hg + (wave * 8 + half * 4) * 256 + c0;
#pragma unroll
            for (int r = 0; r < 34; ++r) {
                const f32x4 h = *(const f32x4*)(hrow + r * 256);
#pragma unroll
                for (int q = 0; q < 4; ++q) { if (r - q >= 0 && r - q <= 30) acc[q] += h * w[r - q]; }
            }
#pragma unroll
            for (int q = 0; q < 4; ++q) {
                const int tl = wave * 8 + half * 4 + q;
                const float mean = wave_sum(acc[q].x + acc[q].y + acc[q].z + acc[q].w) * (1.f / 256.f);
                const f32x4 d = acc[q] - mean;
                const float var = wave_sum(d.x * d.x + d.y * d.y + d.z * d.z + d.w * d.w) * (1.f / 256.f);
                const float rstd = rsqrtf(var + NORM_EPS);
                const f32x4 y = d * rstd * lw + lb;
                u32x2 o; o.x = cvtpk(siluf(y.x), siluf(y.y)); o.y = cvtpk(siluf(y.z), siluf(y.w));
                *(u32x2*)(CC + (size_t)(rb + t0 + tl) * D + c0) = o;
            }
        }
    }
    __syncthreads();
}

__device__ __forceinline__ float log2_gamma(const P& p, int L, int dir, int h) {
    const float x = p.in[12][(L * 2 + dir) * 4 + h];
    const float ls = fminf(x, 0.f) - log1pf(expf(-fabsf(x)));
    return ls * 1.4426950408889634f;
}
__device__ __forceinline__ void load_ret_qk(float* dst, const P& p, int gc, int h, int zoff, float scale) {
    const int tid = threadIdx.x, j = tid >> 2, i0 = (tid & 3) * 4, row = gc * 128 + j;
    const bf16_t* zr = (const bf16_t*)(p.ws + WS_Z) + (size_t)row * ZC + zoff + h * 32;
    const u32x2 a = *(const u32x2*)(zr + i0), b = *(const u32x2*)(zr + 16 + i0);
    float x1[4] = {lo16(a.x), hi16(a.x), lo16(a.y), hi16(a.y)}, x2[4] = {lo16(b.x), hi16(b.x), lo16(b.y), hi16(b.y)};
    const bool lat = row < NLAT; const int pos = row & (SEQ - 1);
    const float* ct = (const float*)(p.ws + WS_ROPE) + pos * 16 + i0; const float* st = ct + 2048 * 16;
#pragma unroll
    for (int i = 0; i < 4; ++i) {
        const float c = lat ? ct[i] : 1.f, s = lat ? st[i] : 0.f;
        dst[j * 33 + i0 + i] = (x1[i] * c - x2[i] * s) * scale;
        dst[j * 33 + 16 + i0 + i] = (x1[i] * s + x2[i] * c) * scale;
    }
}
__device__ __forceinline__ void load_ret_v(float* dst  , const P& p, int gc, int h) {
    const int tid = threadIdx.x, j = tid >> 2, e0 = (tid & 3) * 16;
    const bf16_t* zr = (const bf16_t*)(p.ws + WS_Z) + (size_t)(gc * 128 + j) * ZC + Z_RV + h * 64 + e0;
    const u32x4 a = *(const u32x4*)zr, b = *(const u32x4*)(zr + 8);
#pragma unroll
    for (int i = 0; i < 4; ++i) { dst[j * 64 + e0 + 2 * i] = lo16(a[i]); dst[j * 64 + e0 + 2 * i + 1] = hi16(a[i]); dst[j * 64 + e0 + 8 + 2 * i] = lo16(b[i]); dst[j * 64 + e0 + 8 + 2 * i + 1] = hi16(b[i]); }
}
__device__ __forceinline__ void retkv_unit(unsigned char* lds, const P& p, int L, int gc, int h) {
    float* ks = (float*)lds; float* vs = ks + 128 * 33; float* wf = vs + 128 * 64; float* wb = wf + 128;
    const int tid = threadIdx.x;
    const float l2f = log2_gamma(p, L, 0, h), l2b = log2_gamma(p, L, 1, h);
    load_ret_qk(ks, p, gc, h, Z_RK, 0.17677669529663687f);
    load_ret_v(vs, p, gc, h);
    if (tid < 128) { wf[tid] = exp2f(l2f * (float)(127 - tid)); wb[tid] = exp2f(l2b * (float)tid); }
    __syncthreads();
    const int d = tid >> 4, e0 = (tid & 15) * 4;
    f32x4 af = (f32x4){0.f, 0.f, 0.f, 0.f}, ab = af;
    for (int j = 0; j < 128; ++j) {
        const float kd = ks[j * 33 + d]; const f32x4 v4 = *(const f32x4*)(vs + j * 64 + e0);
        af += (kd * wf[j]) * v4; ab += (kd * wb[j]) * v4;
    }
    float* KV = (float*)(p.ws + WS_KV) + ((size_t)(gc * 4 + h) * 2) * 2048;
    *(f32x4*)(KV + d * 64 + e0) = af; *(f32x4*)(KV + 2048 + d * 64 + e0) = ab;
    __syncthreads();
}
__device__ __forceinline__ void ret_stage_k(unsigned char* kf, unsigned char* kb, int rowb, const P& p, int gc, int h, float ef, float jf0, float eb, float jb0) {
    const int tid = threadIdx.x, j = tid >> 2, i0 = (tid & 3) * 4, row = gc * 128 + j;
    const bf16_t* zr = (const bf16_t*)(p.ws + WS_Z) + (size_t)row * ZC + Z_RK + h * 32;
    const u32x2 a = *(const u32x2*)(zr + i0), b = *(const u32x2*)(zr + 16 + i0);
    const float x1[4] = {lo16(a.x), hi16(a.x), lo16(a.y), hi16(a.y)}, x2[4] = {lo16(b.x), hi16(b.x), lo16(b.y), hi16(b.y)};
    f32x4 c4 = (f32x4){1.f, 1.f, 1.f, 1.f}, s4 = (f32x4){0.f, 0.f, 0.f, 0.f};
    if (row < NLAT) { const int pos = row & (SEQ - 1); const float* ct = (const float*)(p.ws + WS_ROPE) + pos * 16 + i0; c4 = *(const f32x4*)ct; s4 = *(const f32x4*)(ct + 2048 * 16); }
    const float wf = __builtin_amdgcn_exp2f(ef * ((float)j - jf0)) * 0.17677669529663687f, wb = __builtin_amdgcn_exp2f(eb * ((float)j - jb0)) * 0.17677669529663687f;
    float o1[4], o2[4];
#pragma unroll
    for (int i = 0; i < 4; ++i) { o1[i] = x1[i] * c4[i] - x2[i] * s4[i]; o2[i] = x1[i] * s4[i] + x2[i] * c4[i]; }
    u32x2 w;
    w.x = cvtpk(o1[0] * wf, o1[1] * wf); w.y = cvtpk(o1[2] * wf, o1[3] * wf); *(u32x2*)(kf + j * rowb + i0 * 2) = w;
    w.x = cvtpk(o2[0] * wf, o2[1] * wf); w.y = cvtpk(o2[2] * wf, o2[3] * wf); *(u32x2*)(kf + j * rowb + 32 + i0 * 2) = w;
    w.x = cvtpk(o1[0] * wb, o1[1] * wb); w.y = cvtpk(o1[2] * wb, o1[3] * wb); *(u32x2*)(kb + j * rowb + i0 * 2) = w;
    w.x = cvtpk(o2[0] * wb, o2[1] * wb); w.y = cvtpk(o2[2] * wb, o2[3] * wb); *(u32x2*)(kb + j * rowb + 32 + i0 * 2) = w;
}
__device__ __forceinline__ void ret_stage_v(unsigned char* vt, const P& p, int gc, int h) {
    const int tid = threadIdx.x, j = tid >> 2, e0 = (tid & 3) * 16;
    const bf16_t* zr = (const bf16_t*)(p.ws + WS_Z) + (size_t)(gc * 128 + j) * ZC + Z_RV + h * 64 + e0;
    const u32x4 a = *(const u32x4*)zr, b = *(const u32x4*)(zr + 8);
    unsigned char* d = vt + (e0 >> 5) * 8192 + j * 64 + (e0 & 31) * 2;
    *(u32x4*)d = a; *(u32x4*)(d + 16) = b;
}
__device__ __forceinline__ bf16x8 tr8(const unsigned char* p0, const unsigned char* p1) {
    const v4i16_t a = __builtin_amdgcn_ds_read_tr16_b64_v4i16((LAS v4i16_t*)(const LAS unsigned char*)p0), b = __builtin_amdgcn_ds_read_tr16_b64_v4i16((LAS v4i16_t*)(const LAS unsigned char*)p1);
    return (bf16x8){a[0], a[1], a[2], a[3], b[0], b[1], b[2], b[3]};
}
__device__ __forceinline__ void retkv_unit_mfma(unsigned char* lds, const P& p, int L, int gc, int h) {
    const int tid = threadIdx.x, lane = tid & 63, wid = tid >> 6;
    const float l2f = log2_gamma(p, L, 0, h), l2b = log2_gamma(p, L, 1, h);
    ret_stage_k(lds, lds + 8192, 64, p, gc, h, -l2f, 127.f, l2b, 0.f);
    ret_stage_v(lds + 16384, p, gc, h);
    __syncthreads();
    if (wid < 4) {
        const int dir = wid >> 1, eb = wid & 1, g = lane >> 4, i = lane & 15, hh = lane >> 5;
        const int off = (8 * hh + (i >> 2)) * 64 + (g & 1) * 32 + (i & 3) * 8;
        const unsigned char* Kt = lds + dir * 8192 + off; const unsigned char* Vt = lds + 16384 + eb * 8192 + off;
        f32x16 acc;
#pragma unroll
        for (int r = 0; r < 16; ++r) acc[r] = 0.f;
#pragma unroll
        for (int s = 0; s < 8; ++s) acc = __builtin_amdgcn_mfma_f32_32x32x16_bf16(tr8(Vt + s * 1024, Vt + s * 1024 + 256), tr8(Kt + s * 1024, Kt + s * 1024 + 256), acc, 0, 0, 0);
        bf16_t* KV = (bf16_t*)(p.ws + WS_KV) + ((size_t)(gc * 4 + h) * 2 + dir) * 2048 + (lane & 31) * 64 + eb * 32 + 4 * hh;
#pragma unroll
        for (int r4 = 0; r4 < 4; ++r4) { u32x2 w; w.x = cvtpk(acc[4 * r4], acc[4 * r4 + 1]); w.y = cvtpk(acc[4 * r4 + 2], acc[4 * r4 + 3]); *(u32x2*)(KV + 8 * r4) = w; }
    }
    __syncthreads();
}
__device__ __forceinline__ void retout_unit_mfma(unsigned char* lds, const P& p, int L, int gc, int h) {
    constexpr int KROW = 80, O_KF = 0, O_KB = 10240, O_V = 20480, O_SF = 36864, O_SB = 41984, O_RED = 47104;
    int tid = threadIdx.x; asm volatile("" : "+v"(tid));
    const int lane = tid & 63, wid = tid >> 6, r32 = lane & 31, hh = lane >> 5;
    const float l2f = log2_gamma(p, L, 0, h), l2b = log2_gamma(p, L, 1, h);
    const int qb = wid & 3, eb = wid >> 2, i = qb * 32 + r32, row = gc * 128 + i;
    const bf16_t* zq = (const bf16_t*)(p.ws + WS_Z) + (size_t)row * ZC + Z_RQ + h * 32 + 8 * hh;
    const u32x4 qa = *(const u32x4*)zq, qbv = *(const u32x4*)(zq + 16);
    f32x4 rc0 = (f32x4){1.f, 1.f, 1.f, 1.f}, rc1 = rc0, rs0 = (f32x4){0.f, 0.f, 0.f, 0.f}, rs1 = rs0;
    if (row < NLAT) { const float* ct = (const float*)(p.ws + WS_ROPE) + (row & (SEQ - 1)) * 16 + 8 * hh; const float* st = ct + 2048 * 16;
        rc0 = *(const f32x4*)ct; rc1 = *(const f32x4*)(ct + 4); rs0 = *(const f32x4*)st; rs1 = *(const f32x4*)(st + 4); }
    const bf16_t* zg = (const bf16_t*)(p.ws + WS_Z) + (size_t)row * ZC + Z_RG + h * 64 + eb * 32 + 4 * hh;
    const float* gw = p.in[13] + L * 256 + h * 64 + eb * 32 + 4 * hh;
    u32x2 gzv[4]; f32x4 gwv[4];
#pragma unroll
    for (int r4 = 0; r4 < 4; ++r4) { gzv[r4] = *(const u32x2*)(zg + 8 * r4); gwv[r4] = *(const f32x4*)(gw + 8 * r4); }
    const bool lat = gc < 256; const int b = lat ? gc >> 4 : (gc - 256) >> 1;
    u32x2 kvf[18], kvb[18];
    {
        const bf16_t* KVb = (const bf16_t*)(p.ws + WS_KV);
#pragma unroll
        for (int mm = 0; mm < 18; ++mm) {
            const int gcm = mm < 2 ? 256 + b * 2 + mm : b * 16 + (mm - 2);
            const bf16_t* kv = KVb + ((size_t)(gcm * 4 + h) * 2) * 2048 + tid * 4;
            kvf[mm] = *(const u32x2*)kv; kvb[mm] = *(const u32x2*)(kv + 2048);
        }
    }
    ret_stage_k(lds + O_KF, lds + O_KB, KROW, p, gc, h, -l2f, 0.f, l2b, 0.f);
    ret_stage_v(lds + O_V, p, gc, h);
    {
        const int mme = lat ? 2 + (gc & 15) : (gc - 256) & 1;
        const int u = mme, w = mme < 2 ? 1 - mme : 19 - mme;
        f32x4 sf = (f32x4){0.f, 0.f, 0.f, 0.f}, sb = sf;
#pragma unroll
        for (int mm = 0; mm < 18; ++mm) {
            const int um = mm, wm = mm < 2 ? 1 - mm : 19 - mm;
            const u32x2 kf2 = kvf[mm], kb2 = kvb[mm];
            const float wgf = um < u ? __builtin_amdgcn_exp2f(l2f * 128.f * (float)(u - 1 - um)) : 0.f;
            const float wgb = wm < w ? __builtin_amdgcn_exp2f(l2b * 128.f * (float)(w - 1 - wm)) : 0.f;
            sf += wgf * (f32x4){lo16(kf2.x), hi16(kf2.x), lo16(kf2.y), hi16(kf2.y)}; sb += wgb * (f32x4){lo16(kb2.x), hi16(kb2.x), lo16(kb2.y), hi16(kb2.y)};
        }
        const int d = tid >> 4, e0 = (tid & 15) * 4;
#pragma unroll
        for (int k = 0; k < 4; ++k) { *(bf16_t*)(lds + O_SF + (e0 + k) * KROW + d * 2) = (bf16_t)(cvtpk(sf[k], 0.f) & 0xffffu); *(bf16_t*)(lds + O_SB + (e0 + k) * KROW + d * 2) = (bf16_t)(cvtpk(sb[k], 0.f) & 0xffffu); }
    }
    __syncthreads();
    bf16x8 qf[2];
    {
        float x1[8], x2[8];
#pragma unroll
        for (int k = 0; k < 4; ++k) { x1[2 * k] = lo16(qa[k]); x1[2 * k + 1] = hi16(qa[k]); x2[2 * k] = lo16(qbv[k]); x2[2 * k + 1] = hi16(qbv[k]); }
#pragma unroll
        for (int k = 0; k < 8; ++k) { const float c = k < 4 ? rc0[k & 3] : rc1[k & 3], sn = k < 4 ? rs0[k & 3] : rs1[k & 3], u1 = x1[k], u2 = x2[k]; x1[k] = u1 * c - u2 * sn; x2[k] = u1 * sn + u2 * c; }
        const u32x4 q0 = (u32x4){cvtpk(x1[0], x1[1]), cvtpk(x1[2], x1[3]), cvtpk(x1[4], x1[5]), cvtpk(x1[6], x1[7])};
        const u32x4 q1 = (u32x4){cvtpk(x2[0], x2[1]), cvtpk(x2[2], x2[3]), cvtpk(x2[4], x2[5]), cvtpk(x2[6], x2[7])};
        qf[0] = __builtin_bit_cast(bf16x8, q0); qf[1] = __builtin_bit_cast(bf16x8, q1);
    }
    const float af = __builtin_amdgcn_exp2f(l2f * (float)i), ab = __builtin_amdgcn_exp2f(-l2b * (float)i), cf = __builtin_amdgcn_exp2f(l2f * (float)(i + 1)), cb = __builtin_amdgcn_exp2f(l2b * (float)(128 - i));
    f32x16 y, zero;
#pragma unroll
    for (int r = 0; r < 16; ++r) { y[r] = 0.f; zero[r] = 0.f; }
    const int koff = r32 * KROW + 16 * hh;
    const int voff = O_V + eb * 8192 + (4 * hh + ((lane & 15) >> 2)) * 64 + ((lane >> 4) & 1) * 32 + (lane & 3) * 8;
#pragma unroll
    for (int kb = 0; kb < 4; ++kb) {
        f32x16 pt;
        if (kb <= qb) {
            f32x16 sF = __builtin_amdgcn_mfma_f32_32x32x16_bf16(*(const bf16x8*)(lds + O_KF + kb * 32 * KROW + koff), qf[0], zero, 0, 0, 0);
            sF = __builtin_amdgcn_mfma_f32_32x32x16_bf16(*(const bf16x8*)(lds + O_KF + kb * 32 * KROW + koff + 32), qf[1], sF, 0, 0, 0);
            if (kb < qb) {
#pragma unroll
                for (int r = 0; r < 16; ++r) pt[r] = sF[r] * af;
            } else {
#pragma unroll
                for (int r = 0; r < 16; ++r) { const int j = (r & 3) + 8 * (r >> 2) + 4 * hh; pt[r] = (j <= r32) ? sF[r] * af : 0.f; }
            }
        }
        if (kb >= qb) {
            f32x16 sB = __builtin_amdgcn_mfma_f32_32x32x16_bf16(*(const bf16x8*)(lds + O_KB + kb * 32 * KROW + koff), qf[0], zero, 0, 0, 0);
            sB = __builtin_amdgcn_mfma_f32_32x32x16_bf16(*(const bf16x8*)(lds + O_KB + kb * 32 * KROW + koff + 32), qf[1], sB, 0, 0, 0);
            if (kb > qb) {
#pragma unroll
                for (int r = 0; r < 16; ++r) pt[r] = sB[r] * ab;
            } else {
#pragma unroll
                for (int r = 0; r < 16; ++r) { const int j = (r & 3) + 8 * (r >> 2) + 4 * hh; pt[r] += (j >= r32) ? sB[r] * ab : 0.f; }
            }
        }
#pragma unroll
        for (int s2 = 0; s2 < 2; ++s2) {
            const u32x4 pw = (u32x4){cvtpk(pt[8 * s2], pt[8 * s2 + 1]), cvtpk(pt[8 * s2 + 2], pt[8 * s2 + 3]), cvtpk(pt[8 * s2 + 4], pt[8 * s2 + 5]), cvtpk(pt[8 * s2 + 6], pt[8 * s2 + 7])};
            const unsigned char* vb = lds + voff + (kb * 32 + s2 * 16) * 64;
            y = __builtin_amdgcn_mfma_f32_32x32x16_bf16(tr8(vb, vb + 8 * 64), __builtin_bit_cast(bf16x8, pw), y, 0, 0, 0);
        }
    }
    {
        const int soff = (eb * 32 + r32) * KROW + 16 * hh;
        f32x16 tF = __builtin_amdgcn_mfma_f32_32x32x16_bf16(*(const bf16x8*)(lds + O_SF + soff), qf[0], zero, 0, 0, 0);
        tF = __builtin_amdgcn_mfma_f32_32x32x16_bf16(*(const bf16x8*)(lds + O_SF + soff + 32), qf[1], tF, 0, 0, 0);
        f32x16 tB = __builtin_amdgcn_mfma_f32_32x32x16_bf16(*(const bf16x8*)(lds + O_SB + soff), qf[0], zero, 0, 0, 0);
        tB = __builtin_amdgcn_mfma_f32_32x32x16_bf16(*(const bf16x8*)(lds + O_SB + soff + 32), qf[1], tB, 0, 0, 0);
#pragma unroll
        for (int r = 0; r < 16; ++r) y[r] += tF[r] * cf + tB[r] * cb;
    }
    float s1 = 0.f, s2 = 0.f;
#pragma unroll
    for (int r = 0; r < 16; ++r) { s1 += y[r]; s2 += y[r] * y[r]; }
    s1 += __shfl_xor(s1, 32); s2 += __shfl_xor(s2, 32);
    float* red = (float*)(lds + O_RED);
    if (hh == 0) { red[(eb * 128 + i) * 2] = s1; red[(eb * 128 + i) * 2 + 1] = s2; }
    __syncthreads();
    s1 = red[i * 2] + red[(128 + i) * 2]; s2 = red[i * 2 + 1] + red[(128 + i) * 2 + 1];
    const float mu = s1 * (1.f / 64.f), var = fmaxf(s2 * (1.f / 64.f) - mu * mu, 0.f), rstd = rsqrtf(var + NORM_EPS);
    bf16_t* orow = (bf16_t*)(p.ws + WS_CC) + (size_t)row * D + 256 + h * 64 + eb * 32 + 4 * hh;
#pragma unroll
    for (int r4 = 0; r4 < 4; ++r4) {
        const u32x2 gz = gzv[r4]; const f32x4 w4 = gwv[r4];
        const float g0 = lo16(gz.x), g1 = hi16(gz.x), g2 = lo16(gz.y), g3 = hi16(gz.y);
        u32x2 o; o.x = cvtpk(siluf(g0) * ((y[4 * r4] - mu) * rstd * w4.x), siluf(g1) * ((y[4 * r4 + 1] - mu) * rstd * w4.y));
        o.y = cvtpk(siluf(g2) * ((y[4 * r4 + 2] - mu) * rstd * w4.z), siluf(g3) * ((y[4 * r4 + 3] - mu) * rstd * w4.w));
        *(u32x2*)(orow + 8 * r4) = o;
    }
    __syncthreads();
}
__device__ __forceinline__ void qkv_proj(unsigned char* lds, const P& p, int L) {
    const float* sskv = (const float*)(p.ws + WS_SS) + (size_t)NTOK * 4;
    const int G = gridDim.x, bid = blockIdx.x;
    {
        bf16_t* Q = (bf16_t*)(p.ws + WS_Q);
        ge::DenseOrder S; S.nM = NTOK / 256; S.nN = 3; S.nwg = S.nM * 3; S.G = G; S.c = bid; S.Bt = (const char*)((const bf16_t*)(p.ws + WS_WUQ) + (size_t)L * 768 * 256); S.btile = (size_t)256 * 256 * 2; S.arow = ZC * 2;
        auto f = [&](const ge::Unit& u, int r, int c, f32x4 v0, f32x4 v1) {
            u32x4 w; w.x = cvtpk(v0.x, v0.y); w.y = cvtpk(v0.z, v0.w); w.z = cvtpk(v1.x, v1.y); w.w = cvtpk(v1.z, v1.w); *(u32x4*)(Q + (size_t)(u.a * 256 + r) * 768 + u.b * 256 + c) = w;
        };
        ge::EpiFn<decltype(f)> E{f};
        ge::gemm_stream<ge::DenseOrder, ge::EpiFn<decltype(f)>, true>((LAS unsigned char*)lds, (const char*)(p.ws + WS_Z) + Z_CQ * 2, 256, S, E);
    }
    {
        bf16_t* Kb = (bf16_t*)(p.ws + WS_K); bf16_t* Vb = (bf16_t*)(p.ws + WS_V);
        ge::DenseOrder S; S.nM = NTOK / 256; S.nN = 4; S.nwg = S.nM * 4; S.G = G; S.c = (bid + 176) % G; S.Bt = (const char*)((const bf16_t*)(p.ws + WS_WUKV) + (size_t)L * 1024 * 256); S.btile = (size_t)256 * 256 * 2; S.arow = ZC * 2;
        struct EpiKV {
            bf16_t* Kb; bf16_t* Vb; const float* sskv;
            __device__ __forceinline__ void operator()(const ge::Acc& acc, const ge::Unit& u, int wr, int wc, int fr, int fq) const {
                float rstd[2][4];
#pragma unroll
                for (int ai = 0; ai < 2; ++ai)
#pragma unroll
                    for (int m = 0; m < 4; ++m) { const f32x4 s4 = *(const f32x4*)(sskv + (size_t)(u.a * 256 + ai * 128 + wr * 64 + m * 16 + fr) * 4); rstd[ai][m] = rsqrtf((s4.x + s4.y + s4.z + s4.w) * (1.f / 128.f) + NORM_EPS); }
#pragma unroll
                for (int ai = 0; ai < 2; ++ai)
#pragma unroll
                    for (int m = 0; m < 4; ++m) {
                        const int row = u.a * 256 + ai * 128 + wr * 64 + m * 16 + fr;
#pragma unroll
                        for (int bj = 0; bj < 2; ++bj) {
                            const int col = u.b * 256 + bj * 128 + wc * 32 + 8 * fq, h = col >> 7, j = col & 127;
                            const f32x4 v0 = acc[ai][bj][m][0] * rstd[ai][m], v1 = acc[ai][bj][m][1] * rstd[ai][m];
                            u32x4 w; w.x = cvtpk(v0.x, v0.y); w.y = cvtpk(v0.z, v0.w); w.z = cvtpk(v1.x, v1.y); w.w = cvtpk(v1.z, v1.w);
                            if (j < 64) *(u32x4*)(Kb + (size_t)row * 768 + h * 96 + j) = w;
                            else *(u32x4*)(Vb + (size_t)row * 512 + h * 64 + (j - 64)) = w;
                        }
                    }
            }
        };
        EpiKV E{Kb, Vb, sskv};
        ge::gemm_stream<ge::DenseOrder, EpiKV, true>((LAS unsigned char*)lds, (const char*)(p.ws + WS_Z) + Z_CKV * 2, 256, S, E);
    }
}
__device__ __forceinline__ void phase_b(unsigned char* lds, const P& p, int L) {
    const int G = gridDim.x, bid = blockIdx.x;
    qkv_proj(lds, p, L);
    const int nconv = (L == 0) ? 576 : 512;
    const int nkv = 288 * 4;
    const int total = nconv + nkv;
    for (int u = (bid + 96) % G; u < total; u += G) {
        int r = u;
        if (r < nconv) { if (r < 512) conv_unit(lds, p, L, r >> 5, r & 31); else conv_unit(lds, p, L, 16 + ((r - 512) >> 2), (r - 512) & 3); continue; } r -= nconv;
        retkv_unit_mfma(lds, p, L, r >> 2, r & 3);
    }
    if (L == 1) convert_expert_weights(lds, p, 1);
}

__device__ __forceinline__ void attn_unit_naive(unsigned char* lds, const P& p, int b, int h, int qb, bool ctxq) {
    float* Ks = (float*)lds;
    float* Vs = Ks + 64 * 96;
    const int tid = threadIdx.x, half = tid & 1, qi = tid >> 1;
    const bf16_t* Qb = (const bf16_t*)(p.ws + WS_Q); const bf16_t* Kb = (const bf16_t*)(p.ws + WS_K); const bf16_t* Vb = (const bf16_t*)(p.ws + WS_V);
    const int qrow = ctxq ? NLAT + b * CTXL + qi : b * SEQ + qb * 256 + qi;
    float q[48];
    {
        const u32x4* qp = (const u32x4*)(Qb + (size_t)qrow * 768 + h * 96 + half * 48);
#pragma unroll
        for (int i = 0; i < 6; ++i) { const u32x4 w = qp[i];
#pragma unroll
            for (int k = 0; k < 4; ++k) { q[i * 8 + 2 * k] = lo16(w[k]); q[i * 8 + 2 * k + 1] = hi16(w[k]); } }
    }
    float o[32];
#pragma unroll
    for (int e = 0; e < 32; ++e) o[e] = 0.f;
    float m = -1e30f, l = 0.f;
    const int ntiles = ctxq ? 4 : 36;
#pragma unroll 1
    for (int t = 0; t < ntiles; ++t) {
        const int krow0 = t < 4 ? NLAT + b * CTXL + t * 64 : b * SEQ + (t - 4) * 64;
        __syncthreads();
        for (int i = tid; i < 64 * 12; i += NTHREADS) { const int key = i / 12, c = i % 12; const u32x4 w = *(const u32x4*)(Kb + (size_t)(krow0 + key) * 768 + h * 96 + c * 8);
            float* d = Ks + key * 96 + c * 8;
#pragma unroll
            for (int k = 0; k < 4; ++k) { d[2 * k] = lo16(w[k]); d[2 * k + 1] = hi16(w[k]); } }
        for (int i = tid; i < 64 * 8; i += NTHREADS) { const int key = i >> 3, c = i & 7; const u32x4 w = *(const u32x4*)(Vb + (size_t)(krow0 + key) * 512 + h * 64 + c * 8);
            float* d = Vs + key * 64 + c * 8;
#pragma unroll
            for (int k = 0; k < 4; ++k) { d[2 * k] = lo16(w[k]); d[2 * k + 1] = hi16(w[k]); } }
        __syncthreads();
#pragma unroll 1
        for (int j0 = 0; j0 < 64; j0 += 2) {
            float s[2]; float mt = -1e30f;
#pragma unroll
            for (int jj = 0; jj < 2; ++jj) {
                const f32x4* kr = (const f32x4*)(Ks + (j0 + jj) * 96 + half * 48);
                float a = 0.f;
#pragma unroll
                for (int d4 = 0; d4 < 12; ++d4) { const f32x4 kv = kr[d4]; a += q[4 * d4] * kv.x + q[4 * d4 + 1] * kv.y + q[4 * d4 + 2] * kv.z + q[4 * d4 + 3] * kv.w; }
                a += __shfl_xor(a, 1);
                s[jj] = a; mt = fmaxf(mt, a);
            }
            const float mn = fmaxf(m, mt), alpha = exp2f(m - mn);
            m = mn; l *= alpha;
#pragma unroll
            for (int e = 0; e < 32; ++e) o[e] *= alpha;
#pragma unroll
            for (int jj = 0; jj < 2; ++jj) {
                const float pj = exp2f(s[jj] - mn); l += pj;
                const f32x4* vr = (const f32x4*)(Vs + (j0 + jj) * 64 + half * 32);
#pragma unroll
                for (int e4 = 0; e4 < 8; ++e4) { const f32x4 vv = vr[e4]; o[4 * e4] += pj * vv.x; o[4 * e4 + 1] += pj * vv.y; o[4 * e4 + 2] += pj * vv.z; o[4 * e4 + 3] += pj * vv.w; }
            }
        }
    }
    {
        const float rl = 1.f / l;
        u32x4* op = (u32x4*)((bf16_t*)(p.ws + WS_CC) + (size_t)qrow * D + 512 + h * 64 + half * 32);
#pragma unroll
        for (int i = 0; i < 4; ++i) { u32x4 w; w.x = pk2(o[8 * i] * rl, o[8 * i + 1] * rl); w.y = pk2(o[8 * i + 2] * rl, o[8 * i + 3] * rl); w.z = pk2(o[8 * i + 4] * rl, o[8 * i + 5] * rl); w.w = pk2(o[8 * i + 6] * rl, o[8 * i + 7] * rl); op[i] = w; }
    }
    __syncthreads();
}
__device__ __forceinline__ float max3f(float a, float b, float c) { float r; asm("v_max3_f32 %0, %1, %2, %3" : "=v"(r) : "v"(a), "v"(b), "v"(c)); return r; }
__device__ __forceinline__ float addf(float a, float b) { float r; asm("v_add_f32 %0, %1, %2" : "=v"(r) : "v"(a), "v"(b)); return r; }
constexpr int AT_KROW = 208;
constexpr int AT_KBUF = 64 * AT_KROW;
constexpr int AT_VBUF = 8192;
constexpr int AT_BUF = AT_KBUF + AT_VBUF;
constexpr int AT_NSLOT = 6, AT_AHEAD = 3;
static_assert(AT_NSLOT * AT_BUF <= 131072, "attention ring");
#ifndef AT_GRP
#define AT_GRP(w) ((w) >> 2)
#endif
__device__ __forceinline__ void attn_unit_mfma(unsigned char* lds, const P& p, int b, int h, int qb, bool ctxq) {
    const int tid = threadIdx.x, lane = tid & 63, wid = tid >> 6, r32 = lane & 31, hh = lane >> 5;
    const bf16_t* Qb = (const bf16_t*)(p.ws + WS_Q); const bf16_t* Kb = (const bf16_t*)(p.ws + WS_K); const bf16_t* Vb = (const bf16_t*)(p.ws + WS_V);
    const int qrow = (ctxq ? NLAT + b * CTXL : b * SEQ + qb * 256) + wid * 32 + r32;
    f32x16 o0, o1, negm;
#pragma unroll
    for (int r = 0; r < 16; ++r) { o0[r] = 0.f; o1[r] = 0.f; negm[r] = 0.f; }
    asm volatile("" : "+v"(negm));
    float mhat = 0.f, l = 0.f;
    const int ntiles = ctxq ? 4 : 36;
    const int wv = __builtin_amdgcn_readfirstlane(wid);
    const int ia = wv, ib = (wv + 8 < 13) ? wv + 8 : 12;
    const int qa = ia * 64 + lane, qb2 = ib * 64 + lane, qv = wv * 64 + lane;
    const int ca = qa % 13, cb = qb2 % 13;
    const size_t ka = (size_t)(qa / 13) * 768 + h * 96 + (ca < 12 ? ca : 11) * 8, kbo = (size_t)(qb2 / 13) * 768 + h * 96 + (cb < 12 ? cb : 11) * 8;
    const size_t vo = (size_t)((qv >> 2) & 63) * 512 + h * 64 + (qv >> 8) * 32 + (qv & 3) * 8;
    auto krow0 = [&](int t) { return t < 4 ? NLAT + b * CTXL + t * 64 : b * SEQ + (t - 4) * 64; };
    const unsigned lds0 = (unsigned)(uintptr_t)lds;
#define AT_GLDS(gp, ldsoff) do { unsigned keep_; asm volatile("s_mov_b32 %0, m0\n\ts_mov_b32 m0, %2\n\ts_nop 0\n\tglobal_load_lds_dwordx4 %1, off\n\ts_mov_b32 m0, %0" : "=&s"(keep_) : "v"(gp), "s"((unsigned)__builtin_amdgcn_readfirstlane(lds0 + (unsigned)(ldsoff))) : "memory"); } while (0)
#define AT_ISSUE(t2, slot) do { const int kr_ = krow0(t2); const bf16_t* kb_ = Kb + (size_t)kr_ * 768; const bf16_t* vb_ = Vb + (size_t)kr_ * 512; \
        AT_GLDS(kb_ + ka, (slot) + ia * 1024); AT_GLDS(kb_ + kbo, (slot) + ib * 1024); AT_GLDS(vb_ + vo, (slot) + AT_KBUF + wv * 1024); } while (0)
#define AT_SB() __builtin_amdgcn_sched_barrier(0)
#define AT_PIN(x) asm volatile("" : "+v"(x))
#define AT_NEXT(x) ((x) == (AT_NSLOT - 1) * AT_BUF ? 0 : (x) + AT_BUF)
    __builtin_amdgcn_s_barrier();
    AT_ISSUE(0, 0); AT_ISSUE(1, AT_BUF); AT_ISSUE(2, 2 * AT_BUF);
    bf16x8 qf[6];
    {
        const f32x4 s4 = *(const f32x4*)((const float*)(p.ws + WS_SS) + (size_t)qrow * 4);
        const float rstd = rsqrtf((s4.x + s4.y + s4.z + s4.w) * (1.f / 256.f) + NORM_EPS);
        const float* ct = (const float*)(p.ws + WS_ROPE) + (qrow & (SEQ - 1)) * 16; const float* st = ct + 2048 * 16;
#pragma unroll
        for (int s = 0; s < 6; ++s) {
            const u32x4 w = *(const u32x4*)(Qb + (size_t)qrow * 768 + h * 96 + 16 * s + 8 * hh);
            float x[8];
#pragma unroll
            for (int k = 0; k < 4; ++k) { x[2 * k] = lo16(w[k]) * rstd; x[2 * k + 1] = hi16(w[k]) * rstd; }
            if (s >= 4 && !ctxq) {
                const f32x4 c4 = *(const f32x4*)(ct + 8 * (s - 4) + 4 * hh), sn = *(const f32x4*)(st + 8 * (s - 4) + 4 * hh);
#pragma unroll
                for (int k = 0; k < 4; ++k) { const float a = x[2 * k], b2 = x[2 * k + 1]; x[2 * k] = a * c4[k] - b2 * sn[k]; x[2 * k + 1] = a * sn[k] + b2 * c4[k]; }
            }
            const u32x4 o = (u32x4){cvtpk(x[0], x[1]), cvtpk(x[2], x[3]), cvtpk(x[4], x[5]), cvtpk(x[6], x[7])};
            qf[s] = __builtin_bit_cast(bf16x8, o);
        }
    }
    const int koff = r32 * AT_KROW + 16 * hh;
    const int voff = AT_KBUF + (4 * hh + ((lane & 15) >> 2)) * 64 + ((lane >> 4) & 1) * 32 + (lane & 3) * 8;
#define AT_WAIT(n) do { if ((n) >= 2) asm volatile("s_waitcnt vmcnt(6)" ::: "memory"); else if ((n) == 1) asm volatile("s_waitcnt vmcnt(3)" ::: "memory"); else asm volatile("s_waitcnt vmcnt(0)" ::: "memory"); } while (0)
#define AT_EVEN() do { __builtin_amdgcn_s_barrier(); asm volatile("" ::: "memory"); } while (0)
#define AT_ODD(t) do { if ((t) + 1 < ntiles) AT_WAIT(ntiles - 2 - (t)); __builtin_amdgcn_s_barrier(); asm volatile("" ::: "memory"); \
        if ((t) + AT_AHEAD < ntiles) AT_ISSUE((t) + AT_AHEAD, s_iss); s_iss = AT_NEXT(s_iss); } while (0)
#define AT_DECIDE(C0, C1) do { \
        asm volatile("s_nop 15\n\ts_nop 7" : "+v"(C0), "+v"(C1)); \
        float rma = max3f(C0[0], C0[1], C1[0]), rmb = max3f(C0[2], C0[3], C1[1]); rma = max3f(rma, C1[2], C1[3]); \
        _Pragma("unroll") for (int r = 4; r < 16; r += 4) { rma = max3f(rma, C0[r], C0[r + 1]); rmb = max3f(rmb, C0[r + 2], C0[r + 3]); rma = max3f(rma, C1[r], C1[r + 1]); rmb = max3f(rmb, C1[r + 2], C1[r + 3]); } \
        float rm = fmaxf(rma, rmb); rm = fmaxf(rm, __shfl_xor(rm, 32)); \
        resc = false; \
        if (__any(rm > 8.f)) { const float dl = fmaxf(rm, 0.f); fres = __builtin_amdgcn_exp2f(-dl); mhat += dl; l *= fres; resc = true; \
            _Pragma("unroll") for (int r = 0; r < 16; ++r) { C0[r] -= dl; C1[r] -= dl; negm[r] = -mhat; } \
            asm volatile("" : "+v"(negm)); } \
    } while (0)
#define AT_MFS(kfrag, s_, C, first) C = __builtin_amdgcn_mfma_f32_32x32x16_bf16(kfrag, qf[s_], (first) ? negm : C, 0, 0, 0)
#define AT_KF(bk_, g) (*(const bf16x8*)((bk_) + koff + ((g) & 1) * 32 * AT_KROW + ((g) >> 1) * 32))
#define AT_S(C0, C1, P0, P1, bk, bv) do { \
        bf16x8 kf[12]; float sacc = 0.f; \
        kf[0] = AT_KF(bk, 0); kf[1] = AT_KF(bk, 1); kf[2] = AT_KF(bk, 2); kf[3] = AT_KF(bk, 3); \
        AT_SB(); \
        AT_MFS(kf[0], 0, C0, true);  kf[4] = AT_KF(bk, 4);  sacc = addf(sacc, addf(addf(P0[0], P0[1]), addf(P0[2], P0[3]))); pw[0].x = cvtpk(P0[0], P0[1]); pw[0].y = cvtpk(P0[2], P0[3]); AT_PIN(sacc); AT_PIN(pw[0]); AT_SB(); \
        AT_MFS(kf[1], 0, C1, true);  kf[5] = AT_KF(bk, 5);  sacc = addf(sacc, addf(addf(P0[4], P0[5]), addf(P0[6], P0[7]))); pw[0].z = cvtpk(P0[4], P0[5]); pw[0].w = cvtpk(P0[6], P0[7]); AT_PIN(sacc); AT_PIN(pw[0]); AT_SB(); \
        AT_MFS(kf[2], 1, C0, false); kf[6] = AT_KF(bk, 6);  sacc = addf(sacc, addf(addf(P0[8], P0[9]), addf(P0[10], P0[11]))); pw[1].x = cvtpk(P0[8], P0[9]); pw[1].y = cvtpk(P0[10], P0[11]); AT_PIN(sacc); AT_PIN(pw[1]); AT_SB(); \
        AT_MFS(kf[3], 1, C1, false); kf[7] = AT_KF(bk, 7);  sacc = addf(sacc, addf(addf(P0[12], P0[13]), addf(P0[14], P0[15]))); pw[1].z = cvtpk(P0[12], P0[13]); pw[1].w = cvtpk(P0[14], P0[15]); AT_PIN(sacc); AT_PIN(pw[1]); AT_SB(); \
        AT_MFS(kf[4], 2, C0, false); kf[8] = AT_KF(bk, 8);  sacc = addf(sacc, addf(addf(P1[0], P1[1]), addf(P1[2], P1[3]))); pw[2].x = cvtpk(P1[0], P1[1]); pw[2].y = cvtpk(P1[2], P1[3]); AT_PIN(sacc); AT_PIN(pw[2]); AT_SB(); \
        AT_MFS(kf[5], 2, C1, false); kf[9] = AT_KF(bk, 9);  sacc = addf(sacc, addf(addf(P1[4], P1[5]), addf(P1[6], P1[7]))); pw[2].z = cvtpk(P1[4], P1[5]); pw[2].w = cvtpk(P1[6], P1[7]); AT_PIN(sacc); AT_PIN(pw[2]); AT_SB(); \
        AT_MFS(kf[6], 3, C0, false); kf[10] = AT_KF(bk, 10); sacc = addf(sacc, addf(addf(P1[8], P1[9]), addf(P1[10], P1[11]))); pw[3].x = cvtpk(P1[8], P1[9]); pw[3].y = cvtpk(P1[10], P1[11]); AT_PIN(sacc); AT_PIN(pw[3]); AT_SB(); \
        AT_MFS(kf[7], 3, C1, false); kf[11] = AT_KF(bk, 11); sacc = addf(sacc, addf(addf(P1[12], P1[13]), addf(P1[14], P1[15]))); pw[3].z = cvtpk(P1[12], P1[13]); pw[3].w = cvtpk(P1[14], P1[15]); AT_PIN(sacc); AT_PIN(pw[3]); AT_SB(); \
        AT_MFS(kf[8], 4, C0, false); { const unsigned char* vb_ = (bv) + voff; vfa[0] = tr8(vb_, vb_ + 512); } AT_SB(); \
        AT_MFS(kf[9], 4, C1, false); { const unsigned char* vb_ = (bv) + voff; vfc[0] = tr8(vb_ + 4096, vb_ + 4608); } AT_SB(); \
        AT_MFS(kf[10], 5, C0, false); { const unsigned char* vb_ = (bv) + voff + 1024; vfa[1] = tr8(vb_, vb_ + 512); } AT_SB(); \
        AT_MFS(kf[11], 5, C1, false); { const unsigned char* vb_ = (bv) + voff + 1024; vfc[1] = tr8(vb_ + 4096, vb_ + 4608); } AT_SB(); \
        l += sacc; \
        AT_DECIDE(C0, C1); \
        AT_SB(); \
    } while (0)
#define AT_PV(C0, C1, bv) do { \
        AT_SB(); \
        { const unsigned char* vb_ = (bv) + voff + 2048; vfa[2] = tr8(vb_, vb_ + 512); vfc[2] = tr8(vb_ + 4096, vb_ + 4608); } \
        o0 = __builtin_amdgcn_mfma_f32_32x32x16_bf16(vfa[0], __builtin_bit_cast(bf16x8, pw[0]), o0, 0, 0, 0); C0[0] = __builtin_amdgcn_exp2f(C0[0]); C0[1] = __builtin_amdgcn_exp2f(C0[1]); C0[2] = __builtin_amdgcn_exp2f(C0[2]); C0[3] = __builtin_amdgcn_exp2f(C0[3]); AT_PIN(C0); AT_SB(); \
        o1 = __builtin_amdgcn_mfma_f32_32x32x16_bf16(vfc[0], __builtin_bit_cast(bf16x8, pw[0]), o1, 0, 0, 0); C0[4] = __builtin_amdgcn_exp2f(C0[4]); C0[5] = __builtin_amdgcn_exp2f(C0[5]); C0[6] = __builtin_amdgcn_exp2f(C0[6]); C0[7] = __builtin_amdgcn_exp2f(C0[7]); AT_PIN(C0); \
        { const unsigned char* vb_ = (bv) + voff + 3072; vfa[3] = tr8(vb_, vb_ + 512); vfc[3] = tr8(vb_ + 4096, vb_ + 4608); } AT_SB(); \
        o0 = __builtin_amdgcn_mfma_f32_32x32x16_bf16(vfa[1], __builtin_bit_cast(bf16x8, pw[1]), o0, 0, 0, 0); C0[8] = __builtin_amdgcn_exp2f(C0[8]); C0[9] = __builtin_amdgcn_exp2f(C0[9]); C0[10] = __builtin_amdgcn_exp2f(C0[10]); C0[11] = __builtin_amdgcn_exp2f(C0[11]); AT_PIN(C0); AT_SB(); \
        o1 = __builtin_amdgcn_mfma_f32_32x32x16_bf16(vfc[1], __builtin_bit_cast(bf16x8, pw[1]), o1, 0, 0, 0); C0[12] = __builtin_amdgcn_exp2f(C0[12]); C0[13] = __builtin_amdgcn_exp2f(C0[13]); C0[14] = __builtin_amdgcn_exp2f(C0[14]); C0[15] = __builtin_amdgcn_exp2f(C0[15]); AT_PIN(C0); AT_SB(); \
        o0 = __builtin_amdgcn_mfma_f32_32x32x16_bf16(vfa[2], __builtin_bit_cast(bf16x8, pw[2]), o0, 0, 0, 0); C1[0] = __builtin_amdgcn_exp2f(C1[0]); C1[1] = __builtin_amdgcn_exp2f(C1[1]); C1[2] = __builtin_amdgcn_exp2f(C1[2]); C1[3] = __builtin_amdgcn_exp2f(C1[3]); AT_PIN(C1); AT_SB(); \
        o1 = __builtin_amdgcn_mfma_f32_32x32x16_bf16(vfc[2], __builtin_bit_cast(bf16x8, pw[2]), o1, 0, 0, 0); C1[4] = __builtin_amdgcn_exp2f(C1[4]); C1[5] = __builtin_amdgcn_exp2f(C1[5]); C1[6] = __builtin_amdgcn_exp2f(C1[6]); C1[7] = __builtin_amdgcn_exp2f(C1[7]); AT_PIN(C1); AT_SB(); \
        o0 = __builtin_amdgcn_mfma_f32_32x32x16_bf16(vfa[3], __builtin_bit_cast(bf16x8, pw[3]), o0, 0, 0, 0); C1[8] = __builtin_amdgcn_exp2f(C1[8]); C1[9] = __builtin_amdgcn_exp2f(C1[9]); C1[10] = __builtin_amdgcn_exp2f(C1[10]); C1[11] = __builtin_amdgcn_exp2f(C1[11]); AT_PIN(C1); AT_SB(); \
        o1 = __builtin_amdgcn_mfma_f32_32x32x16_bf16(vfc[3], __builtin_bit_cast(bf16x8, pw[3]), o1, 0, 0, 0); C1[12] = __builtin_amdgcn_exp2f(C1[12]); C1[13] = __builtin_amdgcn_exp2f(C1[13]); C1[14] = __builtin_amdgcn_exp2f(C1[14]); C1[15] = __builtin_amdgcn_exp2f(C1[15]); AT_PIN(C1); AT_SB(); \
        if (resc) { _Pragma("unroll") for (int r = 0; r < 16; ++r) { o0[r] *= fres; o1[r] *= fres; } } \
    } while (0)
#define AT_S0(C0, C1, bk) do { \
        _Pragma("unroll") for (int s_ = 0; s_ < 6; ++s_) { \
            const bf16x8 k0f = *(const bf16x8*)((bk) + koff + 32 * s_), k1f = *(const bf16x8*)((bk) + koff + 32 * AT_KROW + 32 * s_); \
            C0 = __builtin_amdgcn_mfma_f32_32x32x16_bf16(k0f, qf[s_], s_ == 0 ? negm : C0, 0, 0, 0); \
            C1 = __builtin_amdgcn_mfma_f32_32x32x16_bf16(k1f, qf[s_], s_ == 0 ? negm : C1, 0, 0, 0); } \
        AT_DECIDE(C0, C1); } while (0)
#define AT_E0(C0, C1) do { _Pragma("unroll") for (int r = 0; r < 16; ++r) { C0[r] = __builtin_amdgcn_exp2f(C0[r]); C1[r] = __builtin_amdgcn_exp2f(C1[r]); } } while (0)
#define AT_DRAIN(P0, P1, bvp) do { \
        float sacc = 0.f; \
        _Pragma("unroll") for (int r = 0; r < 16; ++r) sacc += P0[r] + P1[r]; \
        l += sacc; \
        _Pragma("unroll") for (int s2 = 0; s2 < 2; ++s2) { \
            pw[s2] = (u32x4){cvtpk(P0[8 * s2], P0[8 * s2 + 1]), cvtpk(P0[8 * s2 + 2], P0[8 * s2 + 3]), cvtpk(P0[8 * s2 + 4], P0[8 * s2 + 5]), cvtpk(P0[8 * s2 + 6], P0[8 * s2 + 7])}; \
            pw[2 + s2] = (u32x4){cvtpk(P1[8 * s2], P1[8 * s2 + 1]), cvtpk(P1[8 * s2 + 2], P1[8 * s2 + 3]), cvtpk(P1[8 * s2 + 4], P1[8 * s2 + 5]), cvtpk(P1[8 * s2 + 6], P1[8 * s2 + 7])}; } \
        _Pragma("unroll") for (int ks = 0; ks < 4; ++ks) { \
            const unsigned char* vb = (bvp) + voff + ks * 16 * 64; const bf16x8 pf = __builtin_bit_cast(bf16x8, pw[ks]); \
            o0 = __builtin_amdgcn_mfma_f32_32x32x16_bf16(tr8(vb, vb + 8 * 64), pf, o0, 0, 0, 0); \
            o1 = __builtin_amdgcn_mfma_f32_32x32x16_bf16(tr8(vb + 4096, vb + 4096 + 8 * 64), pf, o1, 0, 0, 0); } } while (0)
    f32x16 pA0, pA1, pB0, pB1; bool resc = false; float fres = 1.f;
    bf16x8 vfa[4], vfc[4]; u32x4 pw[4];
    int s_prev = 0, s_cur = 0, s_iss = AT_AHEAD * AT_BUF;
    const int grp = __builtin_amdgcn_readfirstlane(AT_GRP(wid));
#define AT_BAR(t) do { if ((t) < ntiles) AT_WAIT(ntiles - 1 - (t)); __builtin_amdgcn_s_barrier(); asm volatile("" ::: "memory"); \
        if ((t) + AT_AHEAD < ntiles) AT_ISSUE((t) + AT_AHEAD, s_iss); s_iss = AT_NEXT(s_iss); } while (0)
    if (grp == 0) {
        AT_BAR(0);
        AT_S0(pA0, pA1, lds + s_cur);
        AT_E0(pA0, pA1);
        int t = 1;
#pragma unroll 1
        for (; t + 1 < ntiles; t += 2) {
            s_prev = s_cur; s_cur = AT_NEXT(s_cur);
            AT_BAR(t); AT_S(pB0, pB1, pA0, pA1, lds + s_cur, lds + s_prev); AT_PV(pB0, pB1, lds + s_prev);
            s_prev = s_cur; s_cur = AT_NEXT(s_cur);
            AT_BAR(t + 1); AT_S(pA0, pA1, pB0, pB1, lds + s_cur, lds + s_prev); AT_PV(pA0, pA1, lds + s_prev);
        }
        s_prev = s_cur; s_cur = AT_NEXT(s_cur);
        AT_BAR(t); AT_S(pB0, pB1, pA0, pA1, lds + s_cur, lds + s_prev); AT_PV(pB0, pB1, lds + s_prev);
        AT_BAR(t + 1);
        AT_DRAIN(pB0, pB1, lds + s_cur);
    } else {
        __builtin_amdgcn_s_setprio(1);
        AT_BAR(0);
        AT_S0(pA0, pA1, lds + s_cur);
        int t = 1;
        s_prev = s_cur; s_cur = AT_NEXT(s_cur);
        AT_BAR(1); AT_E0(pA0, pA1); AT_S(pB0, pB1, pA0, pA1, lds + s_cur, lds + s_prev);
#pragma unroll 1
        for (t = 2; t + 1 < ntiles; t += 2) {
            AT_BAR(t); AT_PV(pB0, pB1, lds + s_prev);
            s_prev = s_cur; s_cur = AT_NEXT(s_cur);
            AT_S(pA0, pA1, pB0, pB1, lds + s_cur, lds + s_prev);
            AT_BAR(t + 1); AT_PV(pA0, pA1, lds + s_prev);
            s_prev = s_cur; s_cur = AT_NEXT(s_cur);
            AT_S(pB0, pB1, pA0, pA1, lds + s_cur, lds + s_prev);
        }
        AT_BAR(t);
        AT_PV(pB0, pB1, lds + s_prev);
        AT_DRAIN(pB0, pB1, lds + s_cur);
        __builtin_amdgcn_s_setprio(0);
    }
#undef AT_BAR
#undef AT_WAIT
#undef AT_EVEN
#undef AT_ODD
#undef AT_S
#undef AT_PV
#undef AT_S0
#undef AT_E0
#undef AT_DRAIN
#undef AT_GLDS
#undef AT_ISSUE
#undef AT_SB
#undef AT_PIN
#undef AT_NEXT
#undef AT_DECIDE
#undef AT_MFS
#undef AT_KF
    l += __shfl_xor(l, 32);
    const float rl = 1.f / l;
    bf16_t* orow = (bf16_t*)(p.ws + WS_CC) + (size_t)qrow * D + 512 + h * 64 + 4 * hh;
#pragma unroll
    for (int r4 = 0; r4 < 4; ++r4) {
        u32x2 w0; w0.x = cvtpk(o0[4 * r4] * rl, o0[4 * r4 + 1] * rl); w0.y = cvtpk(o0[4 * r4 + 2] * rl, o0[4 * r4 + 3] * rl);
        u32x2 w1; w1.x = cvtpk(o1[4 * r4] * rl, o1[4 * r4 + 1] * rl); w1.y = cvtpk(o1[4 * r4 + 2] * rl, o1[4 * r4 + 3] * rl);
        *(u32x2*)(orow + 8 * r4) = w0; *(u32x2*)(orow + 32 + 8 * r4) = w1;
    }
}
__device__ __forceinline__ void retout_unit(unsigned char* lds, const P& p, int L, int gc, int h) {
    float* qs = (float*)lds; float* ks = qs + 128 * 33; float* vs = ks + 128 * 33; float* Sf = vs + 128 * 64; float* Sb = Sf + 2048;
    const int tid = threadIdx.x;
    const float l2f = log2_gamma(p, L, 0, h), l2b = log2_gamma(p, L, 1, h);
    load_ret_qk(qs, p, gc, h, Z_RQ, 1.f);
    load_ret_qk(ks, p, gc, h, Z_RK, 0.17677669529663687f);
    load_ret_v(vs, p, gc, h);
    {
        const bool lat = gc < 256; const int b = lat ? gc >> 4 : (gc - 256) >> 1;
        const int mme = lat ? 2 + (gc & 15) : (gc - 256) & 1;
        const int u = mme, w = mme < 2 ? 1 - mme : 19 - mme;
        f32x4 sf = (f32x4){0.f, 0.f, 0.f, 0.f}, sb = sf;
        const float* KVb = (const float*)(p.ws + WS_KV);
#pragma unroll 1
        for (int mm = 0; mm < 18; ++mm) {
            const int gcm = mm < 2 ? 256 + b * 2 + mm : b * 16 + (mm - 2);
            const int um = mm, wm = mm < 2 ? 1 - mm : 19 - mm;
            const float* kv = KVb + ((size_t)(gcm * 4 + h) * 2) * 2048 + tid * 4;
            if (um < u) { const float wgt = exp2f(l2f * 128.f * (float)(u - 1 - um)); sf += wgt * *(const f32x4*)kv; }
            if (wm < w) { const float wgt = exp2f(l2b * 128.f * (float)(w - 1 - wm)); sb += wgt * *(const f32x4*)(kv + 2048); }
        }
        *(f32x4*)(Sf + tid * 4) = sf; *(f32x4*)(Sb + tid * 4) = sb;
    }
    __syncthreads();
    const int i = tid >> 2, e0 = (tid & 3) * 16;
    float q[32];
#pragma unroll
    for (int d = 0; d < 32; ++d) q[d] = qs[i * 33 + d];
    float acc[16];
#pragma unroll
    for (int e = 0; e < 16; ++e) acc[e] = 0.f;
#pragma unroll 1
    for (int j = 0; j < 128; ++j) {
        float s = 0.f;
#pragma unroll
        for (int d = 0; d < 32; ++d) s += q[d] * ks[j * 33 + d];
        float wgt = 0.f;
        if (j <= i) wgt += exp2f(l2f * (float)(i - j));
        if (j >= i) wgt += exp2f(l2b * (float)(j - i));
        s *= wgt;
#pragma unroll
        for (int e4 = 0; e4 < 4; ++e4) { const f32x4 v4 = *(const f32x4*)(vs + j * 64 + e0 + 4 * e4); acc[4 * e4] += s * v4.x; acc[4 * e4 + 1] += s * v4.y; acc[4 * e4 + 2] += s * v4.z; acc[4 * e4 + 3] += s * v4.w; }
    }
    {
        const float cf = exp2f(l2f * (float)(i + 1)), cb = exp2f(l2b * (float)(128 - i));
#pragma unroll 2
        for (int d = 0; d < 32; ++d) {
            const float qd = qs[i * 33 + d]; const float qf = qd * cf, qb = qd * cb;
#pragma unroll
            for (int e4 = 0; e4 < 4; ++e4) { const f32x4 a = *(const f32x4*)(Sf + d * 64 + e0 + 4 * e4), bq = *(const f32x4*)(Sb + d * 64 + e0 + 4 * e4);
                acc[4 * e4] += qf * a.x + qb * bq.x; acc[4 * e4 + 1] += qf * a.y + qb * bq.y; acc[4 * e4 + 2] += qf * a.z + qb * bq.z; acc[4 * e4 + 3] += qf * a.w + qb * bq.w; }
        }
    }
    float s1 = 0.f;
#pragma unroll
    for (int e = 0; e < 16; ++e) s1 += acc[e];
    s1 += __shfl_xor(s1, 1); s1 += __shfl_xor(s1, 2);
    const float mu = s1 * (1.f / 64.f);
    float s2 = 0.f;
#pragma unroll
    for (int e = 0; e < 16; ++e) { const float dd = acc[e] - mu; s2 += dd * dd; }
    s2 += __shfl_xor(s2, 1); s2 += __shfl_xor(s2, 2);
    const float rstd = rsqrtf(s2 * (1.f / 64.f) + NORM_EPS);
    const int row = gc * 128 + i;
    const bf16_t* zg = (const bf16_t*)(p.ws + WS_Z) + (size_t)row * ZC + Z_RG + h * 64 + e0;
    const float* gw = p.in[13] + L * 256 + h * 64 + e0;
    const u32x4 g0 = *(const u32x4*)zg, g1 = *(const u32x4*)(zg + 8);
    float g[16];
#pragma unroll
    for (int k = 0; k < 4; ++k) { g[2 * k] = lo16(g0[k]); g[2 * k + 1] = hi16(g0[k]); g[8 + 2 * k] = lo16(g1[k]); g[8 + 2 * k + 1] = hi16(g1[k]); }
    unsigned o[8];
#pragma unroll
    for (int k = 0; k < 8; ++k) {
        const float y0 = siluf(g[2 * k]) * ((acc[2 * k] - mu) * rstd * gw[2 * k]), y1 = siluf(g[2 * k + 1]) * ((acc[2 * k + 1] - mu) * rstd * gw[2 * k + 1]);
        o[k] = pk2(y0, y1);
    }
    u32x4* op = (u32x4*)((bf16_t*)(p.ws + WS_CC) + (size_t)row * D + 256 + h * 64 + e0);
    u32x4 w0; w0.x = o[0]; w0.y = o[1]; w0.z = o[2]; w0.w = o[3]; u32x4 w1; w1.x = o[4]; w1.y = o[5]; w1.z = o[6]; w1.w = o[7];
    op[0] = w0; op[1] = w1;
    __syncthreads();
}
__device__ __forceinline__ void phase_c(unsigned char* lds, const P& p, int L) {
    const int G = gridDim.x, bid = blockIdx.x;
    const int nat = 16 * 8 * 8, nac = (L == 0) ? 128 : 0, nro = (L == 0 ? 288 : 256) * 4;
    const int total = nat + nac + nro;
    const int vcu = (G % 8 == 0) ? (bid % 8) * (G / 8) + bid / 8 : bid;
    int u = vcu;
#pragma unroll 1
    for (; u < nat + nac; u += G) {
        const bool cq = u >= nat; const int r = cq ? u - nat : u;
        attn_unit_mfma(lds, p, cq ? r >> 3 : r >> 6, cq ? r & 7 : (r >> 3) & 7, cq ? 0 : r & 7, cq);
    }
#pragma unroll 1
    for (; u < total; u += G) { const int r = u - nat - nac; retout_unit_mfma(lds, p, L, r >> 2, r & 3); }
    if (L == 0) convert_expert_weights(lds, p, 0);
}

struct EpiY {
    bf16_t* Y; const float* g1;
    __device__ __forceinline__ void operator()(const ge::Acc& acc, const ge::Unit& u, int wr, int wc, int fr, int fq) const {
        const float* gr = g1 + (size_t)mod_row(u.a * 256) * 6144 + u.b * 256 + wc * 32 + 8 * fq;
        f32x4 g[2][2];
#pragma unroll
        for (int bj = 0; bj < 2; ++bj)
#pragma unroll
            for (int n = 0; n < 2; ++n) g[bj][n] = *(const f32x4*)(gr + bj * 128 + n * 4);
#pragma unroll
        for (int ai = 0; ai < 2; ++ai)
#pragma unroll
            for (int m = 0; m < 4; ++m) {
                bf16_t* yr = Y + (size_t)(u.a * 256 + ai * 128 + wr * 64 + m * 16 + fr) * D + u.b * 256 + wc * 32 + 8 * fq;
#pragma unroll
                for (int bj = 0; bj < 2; ++bj) { const f32x4 v0 = acc[ai][bj][m][0] * g[bj][0], v1 = acc[ai][bj][m][1] * g[bj][1];
                    u32x4 w; w.x = cvtpk(v0.x, v0.y); w.y = cvtpk(v0.z, v0.w); w.z = cvtpk(v1.x, v1.y); w.w = cvtpk(v1.z, v1.w); *(u32x4*)(yr + bj * 128) = w; }
            }
    }
};
__device__ __forceinline__ void phase_d(unsigned char* lds, const P& p, int L) {
    ge::DenseOrder S; S.nM = (L == 0 ? NTOK : NLAT) / 256; S.nN = 4; S.nwg = S.nM * 4; S.G = gridDim.x; S.c = blockIdx.x;
    S.Bt = (const char*)((const bf16_t*)(p.ws + WS_WOUT) + (size_t)L * D * D); S.btile = (size_t)256 * D * 2; S.arow = D * 2;
    EpiY E{(bf16_t*)(p.ws + WS_Y), (const float*)(p.ws + WS_MODV) + (size_t)L * 17 * 6144 + 2048};
    ge::gemm_stream<ge::DenseOrder, EpiY, true>((LAS unsigned char*)lds, (const char*)(p.ws + WS_CC), D, S, E);
}

__device__ __forceinline__ void norm_mod_store(const P& p, int L, int which, int tok, int lane, const f32x4 (&v)[4], bf16_t* Hdst) {
    const float* nw = (which == 0 ? p.in[6] : p.in[19]) + L * D;
    const float* mrow = (const float*)(p.ws + WS_MODV) + ((size_t)L * 17 + mod_row(tok)) * 6144 + which * 3072;
    float s = 0.f;
#pragma unroll
    for (int j = 0; j < 4; ++j) s += v[j].x * v[j].x + v[j].y * v[j].y + v[j].z * v[j].z + v[j].w * v[j].w;
    const float rstd = rsqrtf(wave_sum(s) * (1.f / D) + NORM_EPS);
    u32x2* o = (u32x2*)(Hdst + (size_t)tok * D) + lane;
#pragma unroll
    for (int j = 0; j < 4; ++j) {
        const int k = 4 * lane + 256 * j;
        const f32x4 w4 = *(const f32x4*)(nw + k), sh = *(const f32x4*)(mrow + k), sc = *(const f32x4*)(mrow + 1024 + k);
        const f32x4 y = v[j] * rstd * w4 * (sc + 1.f) + sh;
        u32x2 w; w.x = cvtpk(y.x, y.y); w.y = cvtpk(y.z, y.w); o[64 * j] = w;
    }
}
__device__ __forceinline__ int half_n(int L) { return L == 0 ? NTOK / 2 : NLAT / 2; }
__device__ __forceinline__ void phase_router(unsigned char* lds, const P& p, int L) {
    constexpr int O_LG = 41472, O_CNT = 83072, O_SEL = 83584, O_SELW = 87424;
    const bf16_t* H = (const bf16_t*)(p.ws + WS_H); const bf16_t* W = (const bf16_t*)(p.ws + WS_RT) + (size_t)L * 128 * D;
    const bf16_t* Y = (const bf16_t*)(p.ws + WS_Y);
    float* lg = (float*)(lds + O_LG);
    int* lcnt = (int*)(lds + O_CNT);
    int* sel = (int*)(lds + O_SEL);
    float* selw = (float*)(lds + O_SELW);
    int* ltok = (int*)(p.ws + WS_LTOK); float* lw = (float*)(p.ws + WS_LW);
    const int tid = threadIdx.x, lane = tid & 63, wave = tid >> 6;
    const int ntok = (L == 0 ? NTOK : NLAT), TS = (L == 0 ? 144 : 128), nmt = ntok / TS, RW = TS / 8;
    for (int mt = blockIdx.x; mt < nmt; mt += gridDim.x) {
        const int t0 = mt * TS;
        if (tid < 64) lcnt[tid] = 0;
#pragma unroll 3
        for (int q = 0; q < RW; ++q) {
            const int tok = t0 + wave * RW + q;
            const u32x2* yr = (const u32x2*)(Y + (size_t)tok * D) + lane;
            u32x2* xo = (u32x2*)x_row(p, tok) + lane;
            f32x4 v[4];
            if (L == 0) {
                const f32x4* xi = (const f32x4*)x_in_row(p, tok) + lane;
#pragma unroll
                for (int j = 0; j < 4; ++j) { const f32x4 a = xi[64 * j]; const u32x2 y = yr[64 * j]; v[j] = (f32x4){a.x + lo16(y.x), a.y + hi16(y.x), a.z + lo16(y.y), a.w + hi16(y.y)}; }
            } else {
#pragma unroll
                for (int j = 0; j < 4; ++j) { const u32x2 a = xo[64 * j]; const u32x2 y = yr[64 * j]; v[j] = (f32x4){lo16(a.x) + lo16(y.x), hi16(a.x) + hi16(y.x), lo16(a.y) + lo16(y.y), hi16(a.y) + hi16(y.y)}; }
            }
#pragma unroll
            for (int j = 0; j < 4; ++j) { u32x2 w; w.x = cvtpk(v[j].x, v[j].y); w.y = cvtpk(v[j].z, v[j].w); xo[64 * j] = w; }
            norm_mod_store(p, L, 1, tok, lane, v, (bf16_t*)(p.ws + WS_H));
        }
        asm volatile("s_waitcnt vmcnt(0)" ::: "memory");
        __syncthreads();
        auto rs = [&](int pr) { return H + (size_t)(t0 + (pr < TS ? pr : TS - 1)) * D; };
        auto epi = [&](int r, int c, f32x4 v) { if (c < 64) { float* d = lg + r * 65 + c; d[0] = v.x; d[1] = v.y; d[2] = v.z; d[3] = v.w; } };
        gemm_tile<5>(lds, rs, W, D, D, epi);
        __syncthreads();
        if (tid < TS) {
            const float* rbp = p.in[21] + L * NEXP; const float* lrow = lg + tid * 65;
            float bv[6], bs[6]; int bi[6];
#pragma unroll
            for (int k = 0; k < 6; ++k) { bv[k] = -INFINITY; bs[k] = 0.f; bi[k] = 0; }
#pragma unroll 4
            for (int e = 0; e < NEXP; ++e) {
                float sc = __builtin_amdgcn_rcpf(1.f + __expf(-lrow[e])); float sv = sc + rbp[e]; int ei = e;
#pragma unroll
                for (int k = 0; k < 6; ++k) { const bool gt = sv > bv[k]; const float tv = gt ? bv[k] : sv, ts = gt ? bs[k] : sc; const int ti = gt ? bi[k] : ei;
                    bv[k] = gt ? sv : bv[k]; bs[k] = gt ? sc : bs[k]; bi[k] = gt ? ei : bi[k]; sv = tv; sc = ts; ei = ti; }
            }
            const float rs6 = 2.5f / (bs[0] + bs[1] + bs[2] + bs[3] + bs[4] + bs[5]);
#pragma unroll
            for (int k = 0; k < 6; ++k) { const int rank = atomicAdd(&lcnt[bi[k]], 1); sel[tid * 6 + k] = (bi[k] << 8) | rank; selw[tid * 6 + k] = bs[k] * rs6; }
        }
        __syncthreads();
        if (tid < 64) {
            unsigned* ecnt = (unsigned*)(p.ws + WS_CTL) + CW_ECNT + L * 4096;
            const int c = lcnt[tid];
            lcnt[64 + tid] = c ? (int)atomicAdd(ecnt + tid * 64, (unsigned)c) : 0;
        }
        __syncthreads();
        for (int i = tid; i < TS * 6; i += NTHREADS) {
            const int sv = sel[i], e = sv >> 8, pos = lcnt[64 + e] + (sv & 255), tok = t0 + i / 6, k = i % 6;
            ltok[(size_t)e * LCAP + pos] = tok * 8 + k;
            lw[(size_t)e * LCAP + pos] = selw[i];
        }
        __syncthreads();
    }
}

__device__ __forceinline__ void build_etab(unsigned char* lds, const P& p, int L) {
    int* tstart = (int*)(lds + ETAB_OFF); int* cnt = tstart + 80;
    int tix = threadIdx.x; asm volatile("" : "+v"(tix));
    __syncthreads();
    if (tix < 64) { const unsigned* ecnt = (const unsigned*)(p.ws + WS_CTL) + CW_ECNT + L * 4096;
        cnt[tix] = (int)__hip_atomic_load(ecnt + tix * 64, __ATOMIC_RELAXED, __HIP_MEMORY_SCOPE_AGENT); }
    __syncthreads();
    if (tix < 64) {
        const int e = tix, tl = (cnt[e] + 255) >> 8; int inc = tl;
#pragma unroll
        for (int o = 1; o < 64; o <<= 1) { const int v = __shfl_up(inc, o); if (e >= o) inc += v; }
        tstart[e] = inc - tl;
        if (e == 63) { tstart[64] = inc; tstart[65] = inc + (L == 0 ? NTOK : NLAT) / 256; }
    }
    __syncthreads();
}
struct MoeOrder {
    int TT, nN, G, c; const int* tstart; const char* Bexp; size_t bexp; const char* Bsh; size_t btile; const int* rowbuf; unsigned arow; bool ident;
    __device__ __forceinline__ bool next(int i, ge::Unit& u) const {
        const int Lq = i * G + c; if (Lq >= TT * nN) return false;
        const int t = Lq / nN, pn = Lq % nN;
        int lo = 0, hi = 64;
        while (lo < hi) { const int mid = (lo + hi + 1) >> 1; if (tstart[mid] <= t) lo = mid; else hi = mid - 1; }
        const int e = __builtin_amdgcn_readfirstlane(lo);
        u.a = t; u.b = pn; u.c = e; u.d = i;
        u.B = (e < 64 ? Bexp + (size_t)e * bexp : Bsh) + (size_t)pn * btile;
        return true;
    }
    __device__ __forceinline__ unsigned aoff(int i, const ge::Unit& u, int R) const { return (unsigned)(ident ? u.a * 256 + R : rowbuf[i * 256 + R]) * arow; }
};
__device__ __forceinline__ void phase_gateup(unsigned char* lds, const P& p, int L) {
    build_etab(lds, p, L);
    const int* tstart = (const int*)(lds + ETAB_OFF); const int* cnt = tstart + 80;
    int* rowbuf = (int*)(lds + RB0_OFF); float* wbuf = (float*)(lds + RB1_OFF);
    const int* ltok = (const int*)(p.ws + WS_LTOK); const float* lw = (const float*)(p.ws + WS_LW);
    bf16_t* ACT = (bf16_t*)(p.ws + WS_ACT);
    const int G = gridDim.x, bid = blockIdx.x, vcu = (G % 8 == 0) ? (bid % 8) * (G / 8) + bid / 8 : bid;
    MoeOrder S; S.TT = tstart[65]; S.nN = 2; S.G = G; S.c = vcu; S.tstart = tstart; S.Bexp = (const char*)(p.ws + WS_EGU); S.bexp = (size_t)512 * D * 2;
    S.Bsh = (const char*)((const bf16_t*)(p.ws + WS_SHGU) + (size_t)L * 512 * D); S.btile = (size_t)256 * D * 2; S.rowbuf = rowbuf; S.arow = D * 2; S.ident = false;
    {
        int nun = 0; { ge::Unit u; while (nun < 10 && S.next(nun, u)) ++nun; }
        for (int it0 = threadIdx.x; it0 < nun * 256; it0 += NTHREADS * 4) {
            int tokv[4]; float wv4[4];
#pragma unroll
            for (int q = 0; q < 4; ++q) {
                const int item = it0 + q * NTHREADS; tokv[q] = 0; wv4[q] = 0.f;
                if (item < nun * 256) {
                    ge::Unit u; S.next(item >> 8, u);
                    const int R = item & 255, e = u.c, mt = u.a - tstart[e];
                    if (e < 64) { const int lp = mt * 256 + R; if (lp < cnt[e]) { tokv[q] = ltok[(size_t)e * LCAP + lp] >> 3; wv4[q] = lw[(size_t)e * LCAP + lp]; } }
                    else { tokv[q] = mt * 256 + R; wv4[q] = 1.f; }
                }
            }
#pragma unroll
            for (int q = 0; q < 4; ++q) { const int item = it0 + q * NTHREADS; if (item < nun * 256) { rowbuf[item] = tokv[q]; wbuf[item] = wv4[q]; } }
        }
        __syncthreads();
    }
    auto f = [&](const ge::Unit& u, int r, int c, f32x4 v0, f32x4 v1) {
        const float w = wbuf[u.d * 256 + r];
        u32x2 o; o.x = cvtpk(siluf(v0.x) * v0.y * w, siluf(v0.z) * v0.w * w); o.y = cvtpk(siluf(v1.x) * v1.y * w, siluf(v1.z) * v1.w * w);
        *(u32x2*)(ACT + (size_t)(u.a * 256 + r) * EDIM + ((u.b * 256 + c) >> 1)) = o;
    };
    ge::EpiFn<decltype(f)> E{f};
    ge::gemm_stream<MoeOrder, ge::EpiFn<decltype(f)>, true>((LAS unsigned char*)lds, (const char*)(p.ws + WS_H), D, S, E);
}
__device__ __forceinline__ void phase_down(unsigned char* lds, const P& p, int L) {
    build_etab(lds, p, L);
    const int* tstart = (const int*)(lds + ETAB_OFF); const int* cnt = tstart + 80;
    int* sbuf = (int*)(lds + RB0_OFF);
    const int* ltok = (const int*)(p.ws + WS_LTOK);
    unsigned char* SLOT = (unsigned char*)(p.ws + WS_SLOT);
    const int G = gridDim.x, bid = blockIdx.x, vcu = (G % 8 == 0) ? (bid % 8) * (G / 8) + bid / 8 : bid;
    MoeOrder S; S.TT = tstart[65]; S.nN = 4; S.G = G; S.c = vcu; S.tstart = tstart; S.Bexp = (const char*)(p.ws + WS_ED); S.bexp = (size_t)D * EDIM * 2;
    S.Bsh = (const char*)((const bf16_t*)(p.ws + WS_SHD) + (size_t)L * D * EDIM); S.btile = (size_t)256 * EDIM * 2; S.rowbuf = sbuf; S.arow = EDIM * 2; S.ident = true;
    {
        int nun = 0; { ge::Unit u; while (nun < 18 && S.next(nun, u)) ++nun; }
        for (int it0 = threadIdx.x; it0 < nun * 256; it0 += NTHREADS * 4) {
            int sv[4];
#pragma unroll
            for (int q = 0; q < 4; ++q) {
                const int item = it0 + q * NTHREADS; sv[q] = NTOK * 7;
                if (item < nun * 256) {
                    ge::Unit u; S.next(item >> 8, u);
                    const int R = item & 255, e = u.c, mt = u.a - tstart[e];
                    if (e < 64) { const int lp = mt * 256 + R; if (lp < cnt[e]) { const int ent = ltok[(size_t)e * LCAP + lp]; sv[q] = (ent >> 3) * 7 + (ent & 7); } }
                    else sv[q] = (mt * 256 + R) * 7 + 6;
                }
            }
#pragma unroll
            for (int q = 0; q < 4; ++q) { const int item = it0 + q * NTHREADS; if (item < nun * 256) sbuf[item] = sv[q]; }
        }
        __syncthreads();
    }
    auto f = [&](const ge::Unit& u, int r, int c, f32x4 v0, f32x4 v1) {
        const int srow = sbuf[u.d * 256 + r];
        int w0 = 0, w1 = 0;
        w0 = __builtin_amdgcn_cvt_pk_fp8_f32(__builtin_amdgcn_fmed3f(v0.x, -440.f, 440.f), __builtin_amdgcn_fmed3f(v0.y, -440.f, 440.f), w0, false);
        w0 = __builtin_amdgcn_cvt_pk_fp8_f32(__builtin_amdgcn_fmed3f(v0.z, -440.f, 440.f), __builtin_amdgcn_fmed3f(v0.w, -440.f, 440.f), w0, true);
        w1 = __builtin_amdgcn_cvt_pk_fp8_f32(__builtin_amdgcn_fmed3f(v1.x, -440.f, 440.f), __builtin_amdgcn_fmed3f(v1.y, -440.f, 440.f), w1, false);
        w1 = __builtin_amdgcn_cvt_pk_fp8_f32(__builtin_amdgcn_fmed3f(v1.z, -440.f, 440.f), __builtin_amdgcn_fmed3f(v1.w, -440.f, 440.f), w1, true);
        u32x2 w; w.x = (unsigned)w0; w.y = (unsigned)w1; *(u32x2*)(SLOT + (size_t)srow * D + u.b * 256 + c) = w;
    };
    ge::EpiFn<decltype(f)> E{f};
    ge::gemm_stream<MoeOrder, ge::EpiFn<decltype(f)>, true>((LAS unsigned char*)lds, (const char*)(p.ws + WS_ACT), EDIM, S, E);
}
__device__ __forceinline__ void phase_combine(const P& p, int L) {
    const int tid = threadIdx.x, lane = tid & 63, wave = tid >> 6, gw = blockIdx.x * NWAVES + wave, NGW = gridDim.x * NWAVES;
    const unsigned char* SLOT = (const unsigned char*)(p.ws + WS_SLOT);
    const float* modv = (const float*)(p.ws + WS_MODV) + (size_t)L * 17 * 6144;
    const int ntok = (L == 0 ? NTOK : NLAT);
    for (int tok = gw; tok < ntok; tok += NGW) {
        f32x4 acc[4];
#pragma unroll
        for (int j = 0; j < 4; ++j) acc[j] = (f32x4){0.f, 0.f, 0.f, 0.f};
#pragma unroll
        for (int k = 0; k < 7; ++k) {
            const int* sr = (const int*)(SLOT + ((size_t)tok * 7 + k) * D) + lane;
#pragma unroll
            for (int j = 0; j < 4; ++j) { const int w = sr[64 * j]; const f32x2_t a = __builtin_amdgcn_cvt_pk_f32_fp8(w, false), b = __builtin_amdgcn_cvt_pk_f32_fp8(w, true); acc[j].x += a.x; acc[j].y += a.y; acc[j].z += b.x; acc[j].w += b.y; }
        }
        const float* g2 = modv + (size_t)mod_row(tok) * 6144 + 5120;
        u32x2* xr = (u32x2*)x_row(p, tok) + lane;
        f32x4 v[4];
#pragma unroll
        for (int j = 0; j < 4; ++j) { const f32x4 g = *(const f32x4*)(g2 + 4 * lane + 256 * j); const u32x2 a = xr[64 * j];
            v[j] = (f32x4){lo16(a.x), hi16(a.x), lo16(a.y), hi16(a.y)} + g * acc[j]; }
        if (L == 0) {
#pragma unroll
            for (int j = 0; j < 4; ++j) { u32x2 w; w.x = cvtpk(v[j].x, v[j].y); w.y = cvtpk(v[j].z, v[j].w); xr[64 * j] = w; }
            norm_mod_store(p, 1, 0, tok, lane, v, (bf16_t*)(p.ws + WS_H1));
        } else {
            const float* nw = p.in[28]; float s = 0.f;
#pragma unroll
            for (int j = 0; j < 4; ++j) s += v[j].x * v[j].x + v[j].y * v[j].y + v[j].z * v[j].z + v[j].w * v[j].w;
            const float rstd = rsqrtf(wave_sum(s) * (1.f / D) + NORM_EPS);
            f32x4* orow = (f32x4*)(p.out + (size_t)tok * D) + lane;
#pragma unroll
            for (int j = 0; j < 4; ++j) { const f32x4 w4 = *(const f32x4*)(nw + 4 * lane + 256 * j); orow[64 * j] = v[j] * rstd * w4; }
        }
    }
}

constexpr int PH_LAYER0 = 2, PH_PER_LAYER = 8, PH_LAYER1 = PH_LAYER0 + PH_PER_LAYER, NPHASES = PH_LAYER1 + PH_PER_LAYER;

__global__ void __launch_bounds__(NTHREADS, 2) mk_fwd(P p) {
    extern __shared__ __attribute__((aligned(16))) unsigned char lds[];
    volatile LAS unsigned* MISC = (volatile LAS unsigned*)((LAS unsigned char*)lds + MISC_OFF);
    if (threadIdx.x < 64) MISC[threadIdx.x] = 0u;
    __syncthreads();
    unsigned* ctl = (unsigned*)(p.ws + WS_CTL);
    XcdBarrier bar; bar.bar = ctl + CW_BAR; bar.x = 0; bar.st = MISC + 8;
    if (!MK_PER_PHASE) bar = xcd_barrier_post(ctl + CW_BAR, MISC + 8);
    const int lo = p.ph_lo, hi = p.ph_hi;
#ifndef PH_MASK
#define PH_MASK 0xffffu
#endif
#define HAS(b) ((PH_MASK >> (b)) & 1u)
#define IN(k) (lo <= (k) && (k) < hi)
#define SEAM(k) do { if (IN(k) && IN((k) + 1)) xcd_barrier(bar); } while (0)

#ifdef PROBE_MASK
    unsigned long long tacc = 0ull, t0p = 0ull;
#define PT0() t0p = __builtin_amdgcn_s_memrealtime()
#define PT1(b) do { if ((PROBE_MASK >> (b)) & 1u) tacc += __builtin_amdgcn_s_memrealtime() - t0p; } while (0)
#else
#define PT0() do {} while (0)
#define PT1(b) do {} while (0)
#endif
#define PH(b, k, body) do { PT0(); if (HAS(b) && IN(k)) { body; } SEAM(k); PT1(b); } while (0)
    PH(0, 0, phase_prep0(lds, p));
    PH(1, 1, (phase_prep1(lds, p), phase_norm_mod(p, 0, 0, NTOK)));
#define LAYER(L, pb) \
        PH(2, pb + 0, phase_zgemm(lds, p, L)); \
        PH(3, pb + 1, phase_b(lds, p, L)); \
        PH(4, pb + 2, phase_c(lds, p, L)); \
        PH(5, pb + 3, phase_d(lds, p, L)); \
        PH(7, pb + 4, phase_router(lds, p, L)); \
        PH(8, pb + 5, phase_gateup(lds, p, L)); \
        PH(9, pb + 6, phase_down(lds, p, L)); \
        PH(10, pb + 7, phase_combine(p, L));
    LAYER(0, PH_LAYER0)
    LAYER(1, PH_LAYER1)
#ifdef PROBE_MASK
    if (blockIdx.x == 0) {
        const unsigned long long tend = __builtin_amdgcn_s_memrealtime();
        while (__builtin_amdgcn_s_memrealtime() - tend < (unsigned long long)PROBE_AMP * tacc) __builtin_amdgcn_s_sleep(8);
    }
#endif
#undef IN
#undef SEAM
}

extern "C" void kernel_launch(void* const* d_in, const int* in_sizes, int n_in, void* d_out, int out_size, void* d_ws, size_t ws_size, hipStream_t stream) {
    static int grid = 0;
    if (grid == 0) {
        if (n_in != 29 || in_sizes[0] != NLAT * D || out_size != NLAT * D || ws_size < WS_END) {
            fprintf(stderr, "kernel_launch: unexpected shapes / workspace (n_in %d, ws %zu, need %zu); nothing launched\n", n_in, ws_size, (size_t)WS_END); grid = -1; return; }
        int dev = 0, cus = 0, per_cu = 0;
        if (hipGetDevice(&dev) != hipSuccess || hipDeviceGetAttribute(&cus, hipDeviceAttributeMultiprocessorCount, dev) != hipSuccess) { grid = -1; return; }
        if (hipFuncSetAttribute((const void*)mk_fwd, hipFuncAttributeMaxDynamicSharedMemorySize, LDS_BYTES) != hipSuccess) { grid = -1; return; }
        if (hipOccupancyMaxActiveBlocksPerMultiprocessor(&per_cu, (const void*)mk_fwd, NTHREADS, LDS_BYTES) != hipSuccess || per_cu < 1) { fprintf(stderr, "kernel_launch: occupancy query says %d\n", per_cu); }
        (void)hipGetLastError();
        grid = cus;
    }
    if (grid < 0) return;
    (void)hipMemsetAsync((char*)d_ws + WS_CTL, 0, CTL_ZERO_BYTES, stream);
    P a{};
    for (int i = 0; i < 29; ++i) a.in[i] = (const float*)d_in[i];
    a.out = (float*)d_out; a.ws = (unsigned char*)d_ws;
#if MK_PER_PHASE
    for (int ph = 0; ph < NPHASES; ++ph) { a.ph_lo = ph; a.ph_hi = ph + 1; hipLaunchKernelGGL(mk_fwd, dim3(grid), dim3(NTHREADS), LDS_BYTES, stream, a); }
#else
    a.ph_lo = 0; a.ph_hi = NPHASES;
    hipLaunchKernelGGL(mk_fwd, dim3(grid), dim3(NTHREADS), LDS_BYTES, stream, a);
#endif
}
```
